# Optimizing an MI355X kernel written in HIP

```python
import math
import jax, jax.numpy as jnp
from jax import lax
import numpy as np

D_MODEL = 2048
BATCH = 2
SEQ = 8192
DEPTH = 4

GRID_W = 64
CTX_LEN = 256
EPS = 1e-6

S5_WIDTH = D_MODEL // 4
S5_GROUP = 16
S5_GROUPS = S5_WIDTH // S5_GROUP
S5_STATE = 64

HY_WIDTH = D_MODEL // 4
HY_ORDER = 2
HY_POS_FREQS = 16
HY_POS_DIM = 1 + 2 * HY_POS_FREQS
HY_FILTER_HIDDEN = 64
HY_DECAY_TARGET = 1e-2
HY_SHORT_DECAY_PCT = 0.3
HY_LONG_DECAY_PCT = 1.5

GLA_HEADS = 4
GLA_DK = D_MODEL // 16
GLA_DV = D_MODEL // 8
GLA_KEY = GLA_HEADS * GLA_DK
GLA_VAL = GLA_HEADS * GLA_DV
GLA_GATE_RANK = 16
GLA_GATE_TEMP = 16.0
GLA_CHUNK = 64

MIX_WIDTH = S5_WIDTH + HY_WIDTH + GLA_VAL
N_BRANCH = 3
FF_HIDDEN = 11 * D_MODEL // 4

C_S5 = 0
C_GK = C_S5 + S5_WIDTH
C_GV = C_GK + GLA_KEY
C_GG = C_GV + GLA_VAL
C_GQ = C_GG + 2 * GLA_GATE_RANK
STATE_COLS = C_GQ
C_GR = C_GQ + GLA_KEY
C_HY = C_GR + GLA_VAL
C_MG = C_HY + (HY_ORDER + 1) * HY_WIDTH
IN_WIDTH = C_MG + N_BRANCH * D_MODEL

kernel_name = "hybrid_s5_hyena_gla_dit_block"

F32 = jnp.float32


def rmsnorm(x, g):
    xf = x.astype(F32)
    y = xf * lax.rsqrt(jnp.mean(xf * xf, axis=-1, keepdims=True) + EPS)
    return (y * g.astype(F32)).astype(x.dtype)


def dwconv3(x, w, b):
    xp = jnp.pad(x, ((0, 0), (1, 1), (0, 0)))
    return xp[:, :-2] * w[0] + xp[:, 1:-1] * w[1] + xp[:, 2:] * w[2] + b


def to_col_major(t):
    bsz, n = t.shape[:2]
    rows = n // GRID_W
    return t.reshape(bsz, rows, GRID_W, *t.shape[2:]).swapaxes(1, 2).reshape(bsz, n, *t.shape[2:])


def from_col_major(t):
    bsz, n = t.shape[:2]
    rows = n // GRID_W
    return t.reshape(bsz, GRID_W, rows, *t.shape[2:]).swapaxes(1, 2).reshape(bsz, n, *t.shape[2:])


def flip_seq(t):
    return None if t is None else jnp.flip(t, axis=1)


def _linear_op(e1, e2):
    a1, b1 = e1
    a2, b2 = e2
    return a1 * a2, a2 * b1 + b2


def s5_scan(bu, a_bar, reverse):
    a = jnp.broadcast_to(a_bar, bu.shape)
    _, xs = lax.associative_scan(_linear_op, (a, bu), reverse=reverse, axis=1)
    return xs


def s5_carry(lam_dt, s0, n, reverse):
    steps = (jnp.arange(n, 0, -1) if reverse else jnp.arange(1, n + 1)).astype(F32)
    decay = jnp.exp(lam_dt[None] * steps[:, None, None])
    return decay[None] * s0[:, None]


def s5_drive(u, b_bar):
    ug = u.astype(F32).reshape(u.shape[0], u.shape[1], S5_GROUPS, S5_GROUP).astype(jnp.complex64)
    return jnp.einsum('blgh,gnh->blgn', ug, b_bar)


def s5_readout(c_mat, xs):
    y = jnp.real(jnp.einsum('ghn,blgn->blgh', c_mat, xs))
    return y.reshape(y.shape[0], y.shape[1], S5_WIDTH)


def s5_mixer(ux, uc, p, ctx_out):
    yx, yc = [], []
    for d in range(2):
        rev = d == 1
        lam = lax.complex(p['s5_a_re'][d].astype(F32), p['s5_a_im'][d].astype(F32))
        lam_dt = lam * jnp.exp(p['s5_log_step'][d].astype(F32))[:, None]
        a_bar = jnp.exp(lam_dt)
        b_mat = lax.complex(p['s5_b_re'][d].astype(F32), p['s5_b_im'][d].astype(F32))
        b_bar = ((a_bar - 1.0) / lam)[..., None] * b_mat
        c_mat = lax.complex(p['s5_c_re'][d].astype(F32), p['s5_c_im'][d].astype(F32))
        xs_c = s5_scan(s5_drive(uc, b_bar), a_bar, rev)
        s0 = xs_c[:, 0] if rev else xs_c[:, -1]
        xs_x = s5_scan(s5_drive(ux, b_bar), a_bar, rev) + s5_carry(lam_dt, s0, ux.shape[1], rev)
        yx.append(s5_readout(c_mat, xs_x))
        if ctx_out:
            yc.append(s5_readout(c_mat, xs_c))

    def finish(ys, u):
        y = ys[0] + ys[1] + p['s5_d'].astype(F32) * u.astype(F32)
        y = jax.nn.gelu(y)
        y = y * jax.nn.sigmoid(y @ p['s5_glu_w'].astype(F32) + p['s5_glu_b'].astype(F32))
        return y.astype(u.dtype)

    return finish(yx, ux), (finish(yc, uc) if ctx_out else None)


def hyena_filters(n, p):
    pos = jnp.arange(n, dtype=F32)
    t = pos / max(n - 1, 1)
    freqs = jnp.linspace(1e-4, HY_POS_FREQS - 1, HY_POS_FREQS, dtype=F32)
    ang = (2.0 * math.pi / n) * pos[:, None] * freqs[None]
    feats = jnp.concatenate([t[:, None], jnp.cos(ang), -jnp.sin(ang)], axis=-1)
    h = jnp.sin(p['hy_f_freq1'].astype(F32) * (feats @ p['hy_f_w1'].astype(F32) + p['hy_f_b1'].astype(F32)))
    h = jnp.sin(p['hy_f_freq2'].astype(F32) * (h @ p['hy_f_w2'].astype(F32) + p['hy_f_b2'].astype(F32)))
    h = (h @ p['hy_f_w3'].astype(F32) + p['hy_f_b3'].astype(F32)).reshape(n, HY_ORDER, 2, HY_WIDTH)
    rates = jnp.abs(jnp.linspace(math.log(HY_DECAY_TARGET) / HY_LONG_DECAY_PCT,
                                 math.log(HY_DECAY_TARGET) / HY_SHORT_DECAY_PCT, HY_WIDTH, dtype=F32))
    h = h * jnp.exp(-t[:, None] * rates)[:, None, None, :]
    fwd, bwd = h[:, :, 0], h[:, :, 1]
    filt = jnp.concatenate([fwd, jnp.zeros_like(fwd[:1]), jnp.flip(bwd[1:], axis=0)], axis=0)
    filt = filt / (jnp.sum(jnp.abs(filt), axis=0, keepdims=True) + EPS)
    return jnp.fft.rfft(filt, axis=0)


def hyena_seq(z, p):
    n = z.shape[1]
    zc = dwconv3(z, p['hy_conv_w'], p['hy_conv_b']).astype(F32)
    v, x1, x2 = jnp.split(zc, 3, axis=-1)
    filt_f = hyena_filters(n, p)
    y = v
    for o, gate in enumerate((x1, x2)):
        yf = jnp.fft.rfft(y, n=2 * n, axis=1)
        conv = jnp.fft.irfft(yf * filt_f[None, :, o], n=2 * n, axis=1)[:, :n]
        y = gate * (conv + y * p['hy_bias'][o].astype(F32))
    return y.astype(z.dtype)


def gla_chunked(q, k, v, g, s0):
    bsz, n = k.shape[:2]
    nc = n // GLA_CHUNK
    chunk = lambda t: t.reshape(bsz, nc, GLA_CHUNK, *t.shape[2:])
    k, v, g = chunk(k), chunk(v), chunk(g)
    b = jnp.cumsum(g, axis=2)
    b_last = b[:, :, -1]
    kv = jnp.einsum('bnjhd,bnjhe->bnhde', k * jnp.exp(b_last[:, :, None] - b), v)
    step = lambda s, inp: (jnp.exp(inp[0])[..., None] * s + inp[1], s)
    s_fin, s_prev = lax.scan(step, s0, (jnp.moveaxis(b_last, 1, 0), jnp.moveaxis(kv, 1, 0)))
    if q is None:
        return None, s_fin
    q_in = chunk(q) * jnp.exp(b)
    scores = jnp.einsum('bnihd,bnjhd->bnhij', q_in, k * jnp.exp(-b))
    lower = jnp.tril(jnp.ones((GLA_CHUNK, GLA_CHUNK), dtype=bool))
    scores = jnp.where(lower, scores, 0.0)
    o = (jnp.einsum('bnhij,bnjhe->bnihe', scores, v)
         + jnp.einsum('bnihd,bnhde->bnihe', q_in, jnp.moveaxis(s_prev, 0, 1)))
    return o.reshape(bsz, n, *o.shape[3:]), s_fin


def gla_mixer(px, pc, p, ctx_out):
    heads = lambda t, dh: t.astype(F32).reshape(t.shape[0], t.shape[1], GLA_HEADS, dh)
    scale = GLA_DK ** -0.5

    def gate(lr, d):
        pre = lr[..., d * GLA_GATE_RANK:(d + 1) * GLA_GATE_RANK] @ p['gla_wg'][d] + p['gla_bg'][d]
        return heads(jax.nn.log_sigmoid(pre.astype(F32)) / GLA_GATE_TEMP, GLA_DK)

    qx = heads(to_col_major(px[..., C_GQ:C_GR]), GLA_DK) * scale
    kx = heads(to_col_major(px[..., C_GK:C_GV]), GLA_DK)
    vx = heads(to_col_major(px[..., C_GV:C_GG]), GLA_DV)
    lx = to_col_major(px[..., C_GG:C_GQ])
    qc = heads(pc[..., C_GQ:C_GR], GLA_DK) * scale if ctx_out else None
    kc = heads(pc[..., C_GK:C_GV], GLA_DK)
    vc = heads(pc[..., C_GV:C_GG], GLA_DV)
    lc = pc[..., C_GG:C_GQ]
    zero = jnp.zeros((kc.shape[0], GLA_HEADS, GLA_DK, GLA_DV), F32)
    ox, oc = [], []
    for d in range(2):
        f = flip_seq if d == 1 else (lambda t: t)
        o_c, s_c = gla_chunked(f(qc), f(kc), f(vc), f(gate(lc, d)), zero)
        o_x, _ = gla_chunked(f(qx), f(kx), f(vx), f(gate(lx, d)), s_c)
        ox.append(f(o_x))
        if ctx_out:
            oc.append(f(o_c))

    def finish(o, r):
        o = rmsnorm(o, p['gla_norm_g']).reshape(o.shape[0], o.shape[1], GLA_VAL)
        return (o * jax.nn.silu(r.astype(F32))).astype(r.dtype)

    yx = finish(from_col_major(ox[0] + ox[1]), px[..., C_GR:C_HY])
    yc = finish(oc[0] + oc[1], pc[..., C_GR:C_HY]) if ctx_out else None
    return yx, yc


def merge(ya, yb, yc, gate_logits, p):
    wb = p['w_branch']
    g = jax.nn.sigmoid(gate_logits.astype(F32)).astype(ya.dtype)
    m = (g[..., :D_MODEL] * (ya @ wb[:S5_WIDTH])
         + g[..., D_MODEL:2 * D_MODEL] * (yb @ wb[S5_WIDTH:S5_WIDTH + HY_WIDTH])
         + g[..., 2 * D_MODEL:] * (yc @ wb[S5_WIDTH + HY_WIDTH:]))
    return m @ p['w_out']


def token_mixer(hx, hc, p, ctx_out):
    px = hx @ p['w_in']
    pc = hc @ (p['w_in'] if ctx_out else p['w_in'][:, :STATE_COLS])
    ya_x, ya_c = s5_mixer(px[..., C_S5:C_GK], pc[..., C_S5:C_GK], p, ctx_out)
    yc_x, yc_c = gla_mixer(px, pc, p, ctx_out)
    yb_x = hyena_seq(px[..., C_HY:C_MG], p)
    out_x = merge(ya_x, yb_x, yc_x, px[..., C_MG:], p)
    if not ctx_out:
        return out_x, None
    yb_c = hyena_seq(pc[..., C_HY:C_MG], p)
    out_c = merge(ya_c, yb_c, yc_c, pc[..., C_MG:], p)
    return out_x, out_c


def conv_ffn(h, w_up, conv_w, conv_b, w_down):
    a, b = jnp.split(h @ w_up, 2, axis=-1)
    a = dwconv3(a, conv_w, conv_b)
    return (jax.nn.silu(a) * b) @ w_down


def setup_inputs(seed: int = 0) -> dict:
    key = jax.random.key(seed)
    ks = iter(jax.random.split(key, 64))

    def nrm(shape, scale=1.0):
        return scale * jax.random.normal(next(ks), shape, F32)

    def gain(shape):
        return 1.0 + nrm(shape, 0.02)

    G, N, H = S5_GROUPS, S5_STATE, S5_GROUP
    return {
        "x": nrm((BATCH, SEQ, D_MODEL)),
        "c": nrm((BATCH, D_MODEL)),
        "ctx": nrm((BATCH, CTX_LEN, D_MODEL)),
        "c_ctx": nrm((D_MODEL,)),
        "w_mod": nrm((DEPTH, D_MODEL, 6 * D_MODEL), 0.5 * D_MODEL ** -0.5),
        "b_mod": nrm((DEPTH, 6 * D_MODEL), 0.01),
        "norm1_g": gain((DEPTH, D_MODEL)),
        "norm2_g": gain((DEPTH, D_MODEL)),
        "w_in": nrm((DEPTH, D_MODEL, IN_WIDTH), D_MODEL ** -0.5),
        "s5_a_re": -0.5 + nrm((DEPTH, 2, G, N), 0.01),
        "s5_a_im": math.pi * jnp.arange(N, dtype=F32) + nrm((DEPTH, 2, G, N), 0.01),
        "s5_log_step": jax.random.uniform(next(ks), (DEPTH, 2, G), F32, math.log(1e-3), math.log(1e-1)),
        "s5_b_re": nrm((DEPTH, 2, G, N, H), (2 * H) ** -0.5),
        "s5_b_im": nrm((DEPTH, 2, G, N, H), (2 * H) ** -0.5),
        "s5_c_re": nrm((DEPTH, 2, G, H, N), N ** -0.5),
        "s5_c_im": nrm((DEPTH, 2, G, H, N), N ** -0.5),
        "s5_d": nrm((DEPTH, S5_WIDTH)),
        "s5_glu_w": nrm((DEPTH, S5_WIDTH, S5_WIDTH), S5_WIDTH ** -0.5),
        "s5_glu_b": nrm((DEPTH, S5_WIDTH), 0.01),
        "hy_conv_w": nrm((DEPTH, 3, (HY_ORDER + 1) * HY_WIDTH), 0.5),
        "hy_conv_b": nrm((DEPTH, (HY_ORDER + 1) * HY_WIDTH), 0.01),
        "hy_f_w1": nrm((DEPTH, HY_POS_DIM, HY_FILTER_HIDDEN), HY_POS_DIM ** -0.5),
        "hy_f_b1": nrm((DEPTH, HY_FILTER_HIDDEN), 0.1),
        "hy_f_freq1": 1.0 + nrm((DEPTH, HY_FILTER_HIDDEN), 0.1),
        "hy_f_w2": nrm((DEPTH, HY_FILTER_HIDDEN, HY_FILTER_HIDDEN), HY_FILTER_HIDDEN ** -0.5),
        "hy_f_b2": nrm((DEPTH, HY_FILTER_HIDDEN), 0.1),
        "hy_f_freq2": 1.0 + nrm((DEPTH, HY_FILTER_HIDDEN), 0.1),
        "hy_f_w3": nrm((DEPTH, HY_FILTER_HIDDEN, HY_ORDER * 2 * HY_WIDTH), HY_FILTER_HIDDEN ** -0.5),
        "hy_f_b3": nrm((DEPTH, HY_ORDER * 2 * HY_WIDTH), 0.01),
        "hy_bias": nrm((DEPTH, HY_ORDER, HY_WIDTH)),
        "gla_wg": nrm((DEPTH, 2, GLA_GATE_RANK, GLA_KEY), GLA_GATE_RANK ** -0.5),
        "gla_bg": nrm((DEPTH, 2, GLA_KEY), 0.01),
        "gla_norm_g": gain((DEPTH, GLA_DV)),
        "w_branch": jnp.concatenate([nrm((DEPTH, S5_WIDTH, D_MODEL), S5_WIDTH ** -0.5),
                                     nrm((DEPTH, HY_WIDTH, D_MODEL), HY_WIDTH ** -0.5),
                                     nrm((DEPTH, GLA_VAL, D_MODEL), GLA_VAL ** -0.5)], axis=1),
        "w_out": nrm((DEPTH, D_MODEL, D_MODEL), D_MODEL ** -0.5),
        "ff_w_up": nrm((DEPTH, D_MODEL, 2 * FF_HIDDEN), D_MODEL ** -0.5),
        "ff_conv_w": nrm((DEPTH, 3, FF_HIDDEN), 0.5),
        "ff_conv_b": nrm((DEPTH, FF_HIDDEN), 0.01),
        "ff_w_down": nrm((DEPTH, FF_HIDDEN, D_MODEL), FF_HIDDEN ** -0.5),
        "final_norm_g": gain((D_MODEL,)),
    }


def reference(x, c, ctx, c_ctx, w_mod, b_mod, norm1_g, norm2_g, w_in,
              s5_a_re, s5_a_im, s5_log_step, s5_b_re, s5_b_im, s5_c_re, s5_c_im,
              s5_d, s5_glu_w, s5_glu_b,
              hy_conv_w, hy_conv_b, hy_f_w1, hy_f_b1, hy_f_freq1, hy_f_w2, hy_f_b2,
              hy_f_freq2, hy_f_w3, hy_f_b3, hy_bias,
              gla_wg, gla_bg, gla_norm_g, w_branch, w_out,
              ff_w_up, ff_conv_w, ff_conv_b, ff_w_down, final_norm_g):
    dt = x.dtype
    sc = jax.nn.silu(c.astype(F32)).astype(dt)
    scc = jax.nn.silu(c_ctx.astype(F32)).astype(dt)
    for l in range(DEPTH):
        ctx_out = l < DEPTH - 1
        mod_x = (sc @ w_mod[l] + b_mod[l])[:, None, :]
        mod_c = scc @ w_mod[l] + b_mod[l]
        sh1, s1, g1, sh2, s2, g2 = jnp.split(mod_x, 6, axis=-1)
        csh1, cs1, cg1, csh2, cs2, cg2 = jnp.split(mod_c, 6, axis=-1)
        p = dict(w_in=w_in[l], s5_a_re=s5_a_re[l], s5_a_im=s5_a_im[l], s5_log_step=s5_log_step[l],
                 s5_b_re=s5_b_re[l], s5_b_im=s5_b_im[l], s5_c_re=s5_c_re[l], s5_c_im=s5_c_im[l],
                 s5_d=s5_d[l], s5_glu_w=s5_glu_w[l], s5_glu_b=s5_glu_b[l],
                 hy_conv_w=hy_conv_w[l], hy_conv_b=hy_conv_b[l], hy_f_w1=hy_f_w1[l], hy_f_b1=hy_f_b1[l],
                 hy_f_freq1=hy_f_freq1[l], hy_f_w2=hy_f_w2[l], hy_f_b2=hy_f_b2[l],
                 hy_f_freq2=hy_f_freq2[l], hy_f_w3=hy_f_w3[l], hy_f_b3=hy_f_b3[l], hy_bias=hy_bias[l],
                 gla_wg=gla_wg[l], gla_bg=gla_bg[l], gla_norm_g=gla_norm_g[l],
                 w_branch=w_branch[l], w_out=w_out[l])
        hx = rmsnorm(x, norm1_g[l]) * (1 + s1) + sh1
        hc = rmsnorm(ctx, norm1_g[l]) * (1 + cs1) + csh1
        ox, oc = token_mixer(hx, hc, p, ctx_out)
        x = x + g1 * ox
        hx = rmsnorm(x, norm2_g[l]) * (1 + s2) + sh2
        x = x + g2 * conv_ffn(hx, ff_w_up[l], ff_conv_w[l], ff_conv_b[l], ff_w_down[l])
        if ctx_out:
            ctx = ctx + cg1 * oc
            hc = rmsnorm(ctx, norm2_g[l]) * (1 + cs2) + csh2
            ctx = ctx + cg2 * conv_ffn(hc, ff_w_up[l], ff_conv_w[l], ff_conv_b[l], ff_w_down[l])
    return rmsnorm(x, final_norm_g)
```

```cpp
#include <hip/hip_runtime.h>
#include <stdio.h>

#ifndef MK_ONE
#define MK_ONE 1
#endif

#define GAS __attribute__((address_space(1)))
#define LAS __attribute__((address_space(3)))
typedef _Float16 f16;
typedef _Float16 f16x8 __attribute__((ext_vector_type(8)));
typedef _Float16 f16x4 __attribute__((ext_vector_type(4)));
typedef _Float16 f16x2 __attribute__((ext_vector_type(2)));
typedef float f32x4 __attribute__((ext_vector_type(4)));
typedef float f32x2 __attribute__((ext_vector_type(2)));

constexpr int D = 2048, NB = 2, SEQ = 8192, LC = 256, DEPTH = 4;
constexpr int MX = NB * SEQ, MC = NB * LC, MT = MX + MC;
constexpr int PXLD = 11520, FFH = 5632, UPLD = 2 * FFH;
constexpr int P_S5 = 0, P_GK = 512, P_GV = 1024, P_GQ = 2048, P_GR = 2560, P_HY = 3584, P_MG = 5120, P_GG = 11264;
constexpr int INW = 11296;
constexpr int NCHK = 1056;
constexpr float S5SCALE = 1024.f;
constexpr float EPS = 1e-6f;
constexpr int NSC = 33;

constexpr size_t MiB = 1u << 20;
constexpr size_t WS_CTL = 0, CTL_ZERO_BYTES = 1 * MiB;
constexpr size_t WS_MOD = 1 * MiB;
constexpr size_t WS_TW = 2 * MiB;
constexpr size_t WS_S5AT = 3 * MiB;
constexpr size_t WS_WIN = 4 * MiB;
constexpr size_t WS_WGLU = WS_WIN + 45 * MiB;
constexpr size_t WS_WBR = WS_WGLU + 1 * MiB;
constexpr size_t WS_WOUT = WS_WBR + 8 * MiB;
constexpr size_t WS_WUP = WS_WOUT + 8 * MiB;
constexpr size_t WS_WDN = WS_WUP + 44 * MiB;
constexpr size_t WS_S5W = WS_WDN + 22 * MiB;
constexpr size_t WS_S5M = WS_S5W + 8 * MiB;
constexpr size_t WS_H2 = WS_S5M + 4 * MiB;
constexpr size_t WS_FSD = WS_H2 + 3 * MiB;
constexpr size_t FSD_C_OFF = (size_t)2 * 256 * 8193 * 16;
constexpr size_t WS_XRES = WS_FSD + 68 * MiB;
constexpr size_t WS_HN = WS_XRES + 132 * MiB;
constexpr size_t WS_PX = WS_HN + 66 * MiB;
constexpr size_t WS_S5A = WS_PX + 372 * MiB;
constexpr size_t WS_S5S = WS_S5A + 40 * MiB;
constexpr size_t WS_YAPRE = WS_S5S + 40 * MiB;
constexpr size_t WS_YCAT = WS_YAPRE + 20 * MiB;
constexpr size_t WS_MBUF = WS_YCAT + 66 * MiB;
constexpr size_t WS_GSLOC = WS_MBUF + 66 * MiB;
constexpr size_t WS_GSIN = WS_GSLOC + 66 * MiB;
constexpr size_t WS_GOF = WS_GSIN + 66 * MiB;
constexpr size_t WS_GDT = WS_GOF + 66 * MiB;
constexpr size_t WS_ACT = WS_GSLOC;
constexpr size_t WS_END = WS_GDT + 1 * MiB;
static_assert((size_t)MT * FFH * 2 <= 198 * MiB, "ACT overlay");
constexpr int CW_BAR = 4096;

constexpr int RING_BYTES = 131072;
constexpr int EXTRA_OFF = RING_BYTES, EXTRA_BYTES = 8192;
constexpr int LDSCTL_OFF = EXTRA_OFF + EXTRA_BYTES;
constexpr int LDS_BYTES = LDSCTL_OFF + 256;

__device__ __forceinline__ float wave_sum(float v) {
#pragma unroll
    for (int o = 1; o < 64; o <<= 1) v += __shfl_xor(v, o);
    return v;
}
__device__ __forceinline__ float sigmoidf_(float x) { return 1.0f / (1.0f + __expf(-x)); }
__device__ __forceinline__ float siluf_(float x) { return x * sigmoidf_(x); }
__device__ __forceinline__ float gelu_tanh_(float x) { const float u = 0.7978845608028654f * (x + 0.044715f * x * x * x); return x / (1.0f + __expf(-2.0f * u)); }
__device__ __forceinline__ float logsigmoidf_(float x) { return fminf(x, 0.f) - log1pf(expf(-fabsf(x))); }
__device__ __forceinline__ f32x2 cmul(f32x2 a, f32x2 b) { return (f32x2){a.x * b.x - a.y * b.y, a.x * b.y + a.y * b.x}; }
__device__ __forceinline__ f32x2 cconj(f32x2 a) { return (f32x2){a.x, -a.y}; }
__device__ __forceinline__ int opq(int x) { asm volatile("" : "+v"(x)); return x; }
#define LDS_WAIT() asm volatile("s_waitcnt lgkmcnt(0)" ::: "memory")
#define VM_WAIT() asm volatile("s_waitcnt vmcnt(0)" ::: "memory")

#define XB_TMO      128
#define XB_XCNT(j)  (256  + 64 * (j))
#define XB_XSUB(j)  (1280 + 64 * (j))
#define XB_XGEN(j)  (2304 + 64 * (j))
#define XB_TOP      3328
#define XB_TOPGEN   3392
#define XCD_BAR_WORDS 3456
#define XB_SPIN_CAP (1u << 18)
__device__ __forceinline__ unsigned xb_ld(unsigned* p)              { return __hip_atomic_load(p, __ATOMIC_RELAXED, __HIP_MEMORY_SCOPE_AGENT); }
__device__ __forceinline__ unsigned xb_add(unsigned* p, unsigned v) { return __hip_atomic_fetch_add(p, v, __ATOMIC_RELAXED, __HIP_MEMORY_SCOPE_AGENT); }
__device__ __forceinline__ unsigned xb_xcc_id() { return (unsigned)__builtin_amdgcn_s_getreg((3 << 11) | 20) & 0xFu; }
#define XB_SPIN(cond, bar) do { unsigned _sp = 0; while (cond) { __builtin_amdgcn_s_sleep(1); \
    if ((++_sp & 255u) == 0u) { if (xb_ld(&(bar)[XB_TMO])) break; if (_sp > XB_SPIN_CAP) { atomicAdd(&(bar)[XB_TMO], 1u); break; } } } } while (0)
struct XcdBarrier { unsigned* bar; unsigned x; volatile LAS unsigned* st; };
__device__ __forceinline__ XcdBarrier xcd_barrier_post(unsigned* bar, volatile LAS unsigned* st) {
    XcdBarrier b; b.bar = bar; b.x = xb_xcc_id(); b.st = st;
    if (threadIdx.x == 0) (void)xb_add(&bar[XB_XCNT(b.x)], 1u);
    return b;
}
__device__ __forceinline__ void xcd_barrier_complete(unsigned* bar, unsigned x, unsigned& nloc, unsigned& nx) {
    const unsigned G = gridDim.x * gridDim.y * gridDim.z;
    unsigned sum, cnt, mine, sp = 0u;
    for (;;) {
        sum = 0u; cnt = 0u; mine = 0u;
#pragma unroll
        for (unsigned j = 0; j < 16; ++j) { const unsigned c = xb_ld(&bar[XB_XCNT(j)]); sum += c; cnt += (c > 0u) ? 1u : 0u; mine = (j == x) ? c : mine; }
        if (sum == G) break;
        __builtin_amdgcn_s_sleep(1);
        if ((++sp & 255u) == 0u) { if (xb_ld(&bar[XB_TMO])) break; if (sp > XB_SPIN_CAP) { atomicAdd(&bar[XB_TMO], 1u); break; } }
    }
    nloc = mine > 0u ? mine : 1u; nx = cnt > 0u ? cnt : 1u;
}
__device__ __forceinline__ void xcd_barrier(const XcdBarrier& b) {
    asm volatile("s_waitcnt vmcnt(0)" ::: "memory");
    __syncthreads();
    if (threadIdx.x == 0) {
        unsigned* bar = b.bar;
        __builtin_amdgcn_s_waitcnt(0);
        unsigned nloc = b.st[0], nx = b.st[1];
        if (nloc == 0u) { xcd_barrier_complete(bar, b.x, nloc, nx); b.st[0] = nloc; b.st[1] = nx; }
        const unsigned old = xb_add(&bar[XB_XSUB(b.x)], 1u);
        const unsigned gen = old / nloc;
        if (old + 1u == (gen + 1u) * nloc) {
            __builtin_amdgcn_fence(__ATOMIC_RELEASE, "agent");
            asm volatile("s_waitcnt vmcnt(0)" ::: "memory");
            const unsigned og = xb_add(&bar[XB_TOP], 1u);
            const unsigned tg = og / nx;
            if (og + 1u == (tg + 1u) * nx) xb_add(&bar[XB_TOPGEN], 1u);
            else XB_SPIN(xb_ld(&bar[XB_TOPGEN]) == tg, bar);
            __builtin_amdgcn_fence(__ATOMIC_ACQUIRE, "agent");
            xb_add(&bar[XB_XGEN(b.x)], 1u);
            asm volatile("s_waitcnt vmcnt(0)" ::: "memory");
        } else {
            XB_SPIN(xb_ld(&bar[XB_XGEN(b.x)]) == gen, bar);
            __builtin_amdgcn_fence(__ATOMIC_ACQUIRE, "agent");
            asm volatile("s_waitcnt vmcnt(0)" ::: "memory");
        }
    }
    __syncthreads();
}

struct Args {
    const float* in[40];
    float* out; unsigned char* ws;
    int ph_lo, ph_hi;
};
struct Ctx {
    LAS unsigned char* lds;
    int tid, lane, wave, G, bid;
    unsigned char* ws;
};
enum { I_X = 0, I_C, I_CTX, I_CCTX, I_WMOD, I_BMOD, I_N1G, I_N2G, I_WIN, I_S5ARE, I_S5AIM, I_S5STEP, I_S5BRE, I_S5BIM, I_S5CRE, I_S5CIM,
       I_S5D, I_GLUW, I_GLUB, I_HYCW, I_HYCB, I_HYW1, I_HYB1, I_HYF1, I_HYW2, I_HYB2, I_HYF2, I_HYW3, I_HYB3, I_HYBIAS,
       I_GLAWG, I_GLABG, I_GLANG, I_WBR, I_WOUT, I_WUP, I_FFCW, I_FFCB, I_WDN, I_FNG };

namespace pg8 {
constexpr int BM = 256, BK = 64, HALF = 128, HTB = HALF * BK * 2, STAGE_BYTES = 8 * HTB, NXCD = 8, WGM = 8;
__device__ __forceinline__ int lds_byte(int r, int c) { const int st = (r >> 4) * 2 + (c >> 5), rr = r & 15, cc = c & 31, ob = rr * 64 + cc * 2; return st * 1024 + (ob ^ (((ob >> 9) & 1) << 5)); }
__device__ __forceinline__ void stage_rc(int b, int& R, int& C) { const int st = b / 1024, sb = b % 1024, swz = sb ^ (((sb >> 9) & 1) << 5); R = (st >> 1) * 16 + swz / 64; C = (st & 1) * 32 + (swz % 64) / 2; }
__device__ __forceinline__ int perm32(int rho) { const int n = rho >> 4, i = rho & 15; return 8 * (i >> 2) + 4 * n + (i & 3); }
struct Unit { const char* a; const char* b; int pm, pn; };
struct Order2D {
    int nM, nN, nwg, G, c;
    __device__ __forceinline__ void init(int nM_, int nN_, int G_, int c_) { nM = nM_; nN = nN_; nwg = nM * nN; G = G_; c = c_; }
    __device__ __forceinline__ bool nx(int i, int& pm, int& pn) const {
        const long L = (long)i * G + c; if (L >= nwg) return false;
        int wgid = (int)L; { const int q = nwg / NXCD, r = nwg % NXCD, xcd = wgid % NXCD, off = wgid / NXCD; wgid = (xcd < r ? xcd * (q + 1) : r * (q + 1) + (xcd - r) * q) + off; }
        const int nig = WGM * nN, gid = wgid / nig, fm = gid * WGM, gsz = (nM - fm) < WGM ? (nM - fm) : WGM;
        pm = fm + ((wgid % nig) % gsz); pn = (wgid % nig) / gsz; return true;
    }
};
struct SchedPlain : Order2D {
    const char* A; const char* B; size_t aTile, bTile;
    __device__ __forceinline__ bool next(int i, Unit& u) const { int pm, pn; if (!nx(i, pm, pn)) return false; u.pm = pm; u.pn = pn; u.a = A + (size_t)pm * aTile; u.b = B + (size_t)pn * bTile; return true; }
};
struct SchedS5 {
    const char* A; const char* B; size_t bGroup; int G, c;
    __device__ __forceinline__ bool next(int i, Unit& u) const { const int L = i * G + c; if (L >= 160) return false; const int g = L & 31, pm = L >> 5;
        u.pm = pm; u.pn = g; u.a = A + ((size_t)pm * 256 * 16384 + (size_t)g * 512) * 2; u.b = B + (size_t)g * bGroup; return true; }
};

#define PG8_SA(b, h) (((b) * 2 + (h)) * HTB)
#define PG8_SB(b, h) ((4 + (b) * 2 + (h)) * HTB)
#define PG8_STAGE(bufoff, gbase, voff) do { _Pragma("unroll") for (int _i = 0; _i < 2; ++_i) \
        __builtin_amdgcn_global_load_lds((const unsigned*)((const char*)(gbase) + (voff)[_i]), (LAS unsigned*)(lds + (bufoff) + ldsw + _i * 8192), 16, 0, 0); } while (0)
#define PG8_LDA(dst, b, h) do { _Pragma("unroll") for (int m = 0; m < 4; ++m) _Pragma("unroll") for (int k = 0; k < 2; ++k) dst[m][k] = *(const LAS f16x8*)(lds + PG8_SA(b, h) + aoff + m * 2048 + k * 1024); } while (0)
#define PG8_LDB(dst, b, h) do { _Pragma("unroll") for (int n = 0; n < 2; ++n) _Pragma("unroll") for (int k = 0; k < 2; ++k) dst[n][k] = *(const LAS f16x8*)(lds + PG8_SB(b, h) + boff + n * 2048 + k * 1024); } while (0)
#define PG8_MMA(ai, bj, At, Bt) do { __builtin_amdgcn_s_setprio(1); _Pragma("unroll") for (int m = 0; m < 4; ++m) _Pragma("unroll") for (int n = 0; n < 2; ++n) _Pragma("unroll") for (int k = 0; k < 2; ++k) \
        acc[ai][bj][m][n] = __builtin_amdgcn_mfma_f32_16x16x32_f16(Bt[n][k], At[m][k], acc[ai][bj][m][n], 0, 0, 0); __builtin_amdgcn_s_setprio(0); } while (0)
#define PG8_WAIT_V(n) asm volatile("s_waitcnt vmcnt(" #n ")" ::: "memory")
#define PG8_WAIT_L(n) asm volatile("s_waitcnt lgkmcnt(" #n ")" ::: "memory")
#define PG8_BAR __builtin_amdgcn_s_barrier()
#define PG8_SCHED __builtin_amdgcn_sched_barrier(0)

template <class Epi, class Sched>
__device__ __forceinline__ void gemm_phase(LAS unsigned char* lds, const int lda, const int ldb, const int nt, const Sched& S, const Epi& E) {
    const int tid = opq((int)threadIdx.x), wid = __builtin_amdgcn_readfirstlane(tid >> 6), lane = tid & 63, wr = wid >> 2, wc = wid & 3, fr = lane & 15, fq = lane >> 4;
    unsigned voffA[2], voffB[2];
#pragma unroll
    for (int i = 0; i < 2; ++i) { int R, C; stage_rc(tid * 16 + i * 8192, R, C); const int Rb = Epi::PERM ? ((R & ~31) + perm32(R & 31)) : R;
        voffA[i] = (unsigned)(R * lda + C) * 2u; voffB[i] = (unsigned)(Rb * ldb + C) * 2u; }
    const size_t kstep = (size_t)(BK * 2);
    const size_t hstepA = (size_t)HALF * lda * 2, hstepB = (size_t)HALF * ldb * 2;
    const unsigned ldsw = (unsigned)wid * 1024u;
    const int aoff = lds_byte(wr * 64 + fr, fq * 8), boff = lds_byte(wc * 32 + fr, fq * 8);
    Unit cur, nxt; int ui = 0;
    if (!S.next(0, cur)) return;
    f32x4 acc[2][2][4][2];
#pragma unroll
    for (int a = 0; a < 2; ++a)
#pragma unroll
        for (int b = 0; b < 2; ++b)
#pragma unroll
            for (int m = 0; m < 4; ++m)
#pragma unroll
                for (int n = 0; n < 2; ++n) acc[a][b][m][n] = (f32x4){0.f, 0.f, 0.f, 0.f};
    f16x8 At[4][2], B0[2][2], B1[2][2];
    const char* cA = cur.a; const char* cB = cur.b;
    PG8_STAGE(PG8_SB(0, 0), cB, voffB); PG8_STAGE(PG8_SA(0, 0), cA, voffA); PG8_STAGE(PG8_SB(0, 1), cB + hstepB, voffB); PG8_STAGE(PG8_SA(0, 1), cA + hstepA, voffA);
    if (wr == 1) PG8_BAR;
    PG8_WAIT_V(4); PG8_BAR;
    PG8_STAGE(PG8_SB(1, 0), cB + kstep, voffB); PG8_STAGE(PG8_SA(1, 0), cA + kstep, voffA); PG8_STAGE(PG8_SB(1, 1), cB + hstepB + kstep, voffB);
    PG8_WAIT_V(6); PG8_BAR;
    for (;;) {
        const bool has_next = S.next(ui + 1, nxt);
        const char* nA = has_next ? nxt.a : cA; const char* nB = has_next ? nxt.b : cB;
        for (int t = 0; t < nt; t += 2) {
            const bool last = (t == nt - 2);
            const char* a1 = cA + (size_t)(t + 1) * kstep;
            const char* a2 = last ? nA : cA + (size_t)(t + 2) * kstep; const char* b2 = last ? nB : cB + (size_t)(t + 2) * kstep;
            const char* a3 = a2 + kstep; const char* b3 = b2 + kstep;
            PG8_LDB(B0, 0, 0); PG8_SCHED; PG8_LDA(At, 0, 0); PG8_STAGE(PG8_SA(1, 1), a1 + hstepA, voffA);
            PG8_WAIT_L(8); PG8_BAR; PG8_WAIT_L(0); PG8_MMA(0, 0, At, B0); PG8_BAR; PG8_SCHED;
            PG8_LDB(B1, 0, 1); PG8_STAGE(PG8_SB(0, 0), b2, voffB);
            PG8_BAR; PG8_WAIT_L(0); PG8_MMA(0, 1, At, B1); PG8_BAR;
            PG8_LDA(At, 0, 1); PG8_STAGE(PG8_SA(0, 0), a2, voffA);
            PG8_BAR; PG8_WAIT_L(0); PG8_MMA(1, 0, At, B0); PG8_BAR; PG8_SCHED;
            PG8_STAGE(PG8_SB(0, 1), b2 + hstepB, voffB);
            PG8_WAIT_V(6); PG8_BAR; PG8_MMA(1, 1, At, B1); PG8_BAR;
            PG8_LDB(B0, 1, 0); PG8_SCHED; PG8_LDA(At, 1, 0); PG8_STAGE(PG8_SA(0, 1), a2 + hstepA, voffA);
            PG8_WAIT_L(8); PG8_BAR; PG8_WAIT_L(0); PG8_MMA(0, 0, At, B0); PG8_BAR; PG8_SCHED;
            PG8_LDB(B1, 1, 1); PG8_STAGE(PG8_SB(1, 0), b3, voffB);
            PG8_BAR; PG8_WAIT_L(0); PG8_MMA(0, 1, At, B1); PG8_BAR;
            PG8_LDA(At, 1, 1); PG8_STAGE(PG8_SA(1, 0), a3, voffA);
            PG8_BAR; PG8_WAIT_L(0); PG8_MMA(1, 0, At, B0); PG8_BAR; PG8_SCHED;
            PG8_STAGE(PG8_SB(1, 1), b3 + hstepB, voffB);
            PG8_WAIT_V(6); PG8_BAR; PG8_MMA(1, 1, At, B1); PG8_BAR;
        }
        E(acc, cur, wr, wc, fr, fq);
        if (!has_next) break;
#pragma unroll
        for (int a = 0; a < 2; ++a)
#pragma unroll
            for (int b = 0; b < 2; ++b)
#pragma unroll
                for (int m = 0; m < 4; ++m)
#pragma unroll
                    for (int n = 0; n < 2; ++n) acc[a][b][m][n] = (f32x4){0.f, 0.f, 0.f, 0.f};
        cur = nxt; cA = nA; cB = nB; ++ui;
    }
    PG8_WAIT_V(0);
    if (wr == 0) PG8_BAR;
    PG8_BAR;
}
#undef PG8_SA
#undef PG8_SB
#undef PG8_STAGE
#undef PG8_LDA
#undef PG8_LDB
#undef PG8_MMA
#undef PG8_WAIT_V
#undef PG8_WAIT_L
#undef PG8_BAR
#undef PG8_SCHED

typedef const f32x4 (&AccRef)[2][2][4][2];
__device__ __forceinline__ f16x8 pack8(f32x4 a, f32x4 b) { f16x8 w; w[0] = (f16)a[0]; w[1] = (f16)a[1]; w[2] = (f16)a[2]; w[3] = (f16)a[3]; w[4] = (f16)b[0]; w[5] = (f16)b[1]; w[6] = (f16)b[2]; w[7] = (f16)b[3]; return w; }

struct EpiPx {
    static constexpr bool PERM = true; f16* PX; f16* S5A;
    __device__ __forceinline__ void operator()(AccRef acc, const Unit& u, int wr, int wc, int fr, int fq) const { fr = opq(fr); fq = opq(fq);
        const int row0 = u.pm * BM + wr * 64 + fr, col0 = u.pn * BM + wc * 32 + 8 * fq;
#pragma unroll
        for (int ai = 0; ai < 2; ++ai)
#pragma unroll
            for (int m = 0; m < 4; ++m) { const int row = row0 + ai * HALF + m * 16;
#pragma unroll
                for (int bj = 0; bj < 2; ++bj) { const int c = col0 + bj * HALF; const f16x8 w = pack8(acc[ai][bj][m][0], acc[ai][bj][m][1]);
                    if (u.pn < 2) *(f16x8*)(S5A + (size_t)(row >> 4) * 16384 + (size_t)(c >> 4) * 512 + (row & 15) * 16 + (c & 15)) = w;
                    else *(f16x8*)(PX + (size_t)row * PXLD + c) = w; } }
    }
};
struct EpiF16 {
    static constexpr bool PERM = true; f16* O; int ldc;
    __device__ __forceinline__ void operator()(AccRef acc, const Unit& u, int wr, int wc, int fr, int fq) const { fr = opq(fr); fq = opq(fq);
        const int row0 = u.pm * BM + wr * 64 + fr, col0 = u.pn * BM + wc * 32 + 8 * fq;
#pragma unroll
        for (int ai = 0; ai < 2; ++ai)
#pragma unroll
            for (int m = 0; m < 4; ++m) { f16* rowp = O + (size_t)(row0 + ai * HALF + m * 16) * ldc + col0;
#pragma unroll
                for (int bj = 0; bj < 2; ++bj) *(f16x8*)(rowp + bj * HALF) = pack8(acc[ai][bj][m][0], acc[ai][bj][m][1]); }
    }
};
struct EpiS5In {
    static constexpr bool PERM = false; float* S;
    __device__ __forceinline__ void operator()(AccRef acc, const Unit& u, int wr, int wc, int fr, int fq) const { fr = opq(fr); fq = opq(fq);
        const int row0 = u.pm * BM + wr * 64 + fr, col0 = wc * 32 + 4 * fq, g = u.pn;
#pragma unroll
        for (int ai = 0; ai < 2; ++ai)
#pragma unroll
            for (int m = 0; m < 4; ++m) { const int row = row0 + ai * HALF + m * 16; { float* rowp = S + ((size_t)row * 32 + g) * 256 + col0;
#pragma unroll
                for (int bj = 0; bj < 2; ++bj)
#pragma unroll
                    for (int n = 0; n < 2; ++n) *(f32x4*)(rowp + bj * HALF + n * 16) = acc[ai][bj][m][n]; } }
    }
};
struct EpiS5Out {
    static constexpr bool PERM = true; const f16* S5A; f16* Y; const float* dvec;
    __device__ __forceinline__ void operator()(AccRef acc, const Unit& u, int wr, int wc, int fr, int fq) const { fr = opq(fr); fq = opq(fq);
        const int row0 = u.pm * BM + wr * 64 + fr, col0 = wc * 32 + 8 * fq, g = u.pn;
#pragma unroll
        for (int ai = 0; ai < 2; ++ai)
#pragma unroll
            for (int m = 0; m < 4; ++m) { const int chunk = row0 + ai * HALF + m * 16; {
#pragma unroll
                for (int bj = 0; bj < 2; ++bj) { const int c = col0 + bj * HALF, t = c >> 4, h0 = c & 15;
                    const f16x8 uu = *(const f16x8*)(S5A + (size_t)chunk * 16384 + (size_t)g * 512 + c);
                    const f32x4 d0 = *(const f32x4*)(dvec + g * 16 + h0), d1 = *(const f32x4*)(dvec + g * 16 + h0 + 4);
                    f16x8 w;
#pragma unroll
                    for (int j = 0; j < 4; ++j) { w[j] = (f16)gelu_tanh_(acc[ai][bj][m][0][j] * (1.0f / S5SCALE) + d0[j] * (float)uu[j]);
                                                  w[4 + j] = (f16)gelu_tanh_(acc[ai][bj][m][1][j] * (1.0f / S5SCALE) + d1[j] * (float)uu[4 + j]); }
                    *(f16x8*)(Y + (size_t)(chunk * 16 + t) * 512 + g * 16 + h0) = w; } asm volatile("" ::: "memory"); } }
    }
};
struct EpiGlu {
    static constexpr bool PERM = true; const f16* YP; f16* O; const float* bias;
    __device__ __forceinline__ void operator()(AccRef acc, const Unit& u, int wr, int wc, int fr, int fq) const { fr = opq(fr); fq = opq(fq);
        const int row0 = u.pm * BM + wr * 64 + fr, col0 = u.pn * BM + wc * 32 + 8 * fq;
#pragma unroll
        for (int ai = 0; ai < 2; ++ai)
#pragma unroll
            for (int m = 0; m < 4; ++m) { const int row = row0 + ai * HALF + m * 16;
#pragma unroll
                for (int bj = 0; bj < 2; ++bj) { const int c = col0 + bj * HALF;
                    const f16x8 yp = *(const f16x8*)(YP + (size_t)row * 512 + c);
                    const f32x4 b0 = *(const f32x4*)(bias + c), b1 = *(const f32x4*)(bias + c + 4);
                    f16x8 w;
#pragma unroll
                    for (int j = 0; j < 4; ++j) { w[j] = (f16)((float)yp[j] * sigmoidf_(acc[ai][bj][m][0][j] + b0[j])); w[4 + j] = (f16)((float)yp[4 + j] * sigmoidf_(acc[ai][bj][m][1][j] + b1[j])); }
                    *(f16x8*)(O + (size_t)row * 2048 + c) = w; } asm volatile("" ::: "memory"); }
    }
};
template <int BR> struct EpiBranch {
    static constexpr bool PERM = true; const f16* PX; f16* M;
    __device__ __forceinline__ void operator()(AccRef acc, const Unit& u, int wr, int wc, int fr, int fq) const { fr = opq(fr); fq = opq(fq);
        const int row0 = u.pm * BM + wr * 64 + fr, col0 = u.pn * BM + wc * 32 + 8 * fq;
#pragma unroll
        for (int ai = 0; ai < 2; ++ai)
#pragma unroll
            for (int m = 0; m < 4; ++m) { const int row = row0 + ai * HALF + m * 16;
#pragma unroll
                for (int bj = 0; bj < 2; ++bj) { const int c = col0 + bj * HALF;
                    const f16x8 gl = *(const f16x8*)(PX + (size_t)row * PXLD + P_MG + BR * 2048 + c);
                    f16* mp = M + (size_t)row * 2048 + c;
                    f16x8 prev; if (BR > 0) prev = *(const f16x8*)mp;
                    f16x8 w;
#pragma unroll
                    for (int j = 0; j < 4; ++j) { float v0 = sigmoidf_((float)gl[j]) * acc[ai][bj][m][0][j], v1 = sigmoidf_((float)gl[4 + j]) * acc[ai][bj][m][1][j];
                        if (BR > 0) { v0 += (float)prev[j]; v1 += (float)prev[4 + j]; } w[j] = (f16)v0; w[4 + j] = (f16)v1; }
                    *(f16x8*)mp = w; } asm volatile("" ::: "memory"); }
    }
};
struct EpiResid {
    static constexpr bool PERM = false; float* X; const float* mod; int goff;
    __device__ __forceinline__ void operator()(AccRef acc, const Unit& u, int wr, int wc, int fr, int fq) const { fr = opq(fr); fq = opq(fq);
        const int row0 = u.pm * BM + wr * 64 + fr, col0 = u.pn * BM + wc * 32 + 4 * fq;
        const int bsel = u.pm < 32 ? 0 : (u.pm < 64 ? 1 : 2);
        const float* gp = mod + bsel * 12288 + goff + col0;
        f32x4 gv[2][2];
#pragma unroll
        for (int bj = 0; bj < 2; ++bj)
#pragma unroll
            for (int n = 0; n < 2; ++n) gv[bj][n] = *(const f32x4*)(gp + bj * HALF + n * 16);
#pragma unroll
        for (int ai = 0; ai < 2; ++ai)
#pragma unroll
            for (int m = 0; m < 4; ++m) { float* rowp = X + (size_t)(row0 + ai * HALF + m * 16) * D + col0;
#pragma unroll
                for (int bj = 0; bj < 2; ++bj)
#pragma unroll
                    for (int n = 0; n < 2; ++n) { f32x4* p = (f32x4*)(rowp + bj * HALF + n * 16); *p = *p + gv[bj][n] * acc[ai][bj][m][n]; } asm volatile("" ::: "memory"); }
    }
};
}


__device__ __forceinline__ void ph_prologue(const Ctx& F, const Args& A) {
    const int gt = F.bid * 512 + F.tid, NT = F.G * 512;
    { const f32x4* xs = (const f32x4*)A.in[I_X]; const f32x4* cs = (const f32x4*)A.in[I_CTX]; f32x4* xr = (f32x4*)(F.ws + WS_XRES);
      for (int i = gt; i < MX * D / 4; i += NT) xr[i] = xs[i];
      for (int i = gt; i < MC * D / 4; i += NT) xr[MX * D / 4 + i] = cs[i]; }
    { f32x2* tw = (f32x2*)(F.ws + WS_TW);
      for (int k = gt; k < 16384; k += NT) { float s, c; sincospif((float)k * (2.0f / 16384.0f), &s, &c); tw[k] = (f32x2){c, -s}; } }
    LAS float* sc = (LAS float*)F.lds;
    LAS float* red = (LAS float*)(F.lds + 3 * 2048 * 4);
    for (int i = F.tid; i < 3 * 2048; i += 512) { const int r = i / 2048, k = i % 2048; const float v = r < 2 ? A.in[I_C][r * 2048 + k] : A.in[I_CCTX][k]; sc[i] = siluf_(v); }
    __syncthreads();
    const int col = F.tid & 63, ks = F.tid >> 6;
    for (int chunk = F.bid; chunk < DEPTH * 192; chunk += F.G) {
        const int l = chunk / 192, n0 = (chunk % 192) * 64;
        const float* w = A.in[I_WMOD] + (size_t)l * 2048 * 12288 + n0 + col;
        float s0 = 0.f, s1 = 0.f, s2 = 0.f;
#pragma unroll 8
        for (int k = ks * 256; k < ks * 256 + 256; ++k) { const float wv = w[(size_t)k * 12288]; s0 += sc[k] * wv; s1 += sc[2048 + k] * wv; s2 += sc[4096 + k] * wv; }
        red[(ks * 3 + 0) * 64 + col] = s0; red[(ks * 3 + 1) * 64 + col] = s1; red[(ks * 3 + 2) * 64 + col] = s2;
        __syncthreads();
        if (F.tid < 192) { const int r = F.tid >> 6, c2 = F.tid & 63; float s = 0.f;
#pragma unroll
            for (int q = 0; q < 8; ++q) s += red[(q * 3 + r) * 64 + c2];
            ((float*)(F.ws + WS_MOD))[((size_t)l * 3 + r) * 12288 + n0 + c2] = s + A.in[I_BMOD][(size_t)l * 12288 + n0 + c2]; }
        __syncthreads();
    }
}

__device__ __forceinline__ void transpose_item(const float* W, int ldw, int k0, int srccol0, f16* WT, int dstrow0, int ldk, LAS float* scr, int lane) {
#pragma unroll 8
    for (int i = 0; i < 32; ++i) { const int kk = 2 * i + (lane >> 5); scr[kk * 33 + (lane & 31)] = srccol0 >= 0 ? W[(size_t)(k0 + kk) * ldw + srccol0 + (lane & 31)] : 0.f; }
    LDS_WAIT(); asm volatile("" ::: "memory");
    const int c = lane & 7;
#pragma unroll
    for (int j = 0; j < 4; ++j) { const int n = (lane >> 3) + 8 * j; const LAS float* s = scr + (8 * c) * 33 + n;
        f16x8 o;
#pragma unroll
        for (int e = 0; e < 8; ++e) o[e] = (f16)s[e * 33];
        *(f16x8*)(WT + (size_t)(dstrow0 + n) * ldk + k0 + 8 * c) = o; }
    LDS_WAIT(); asm volatile("" ::: "memory");
}
__device__ __forceinline__ void ph_convert_weights(const Ctx& F, const Args& A, int l) {
    LAS float* scr = (LAS float*)(F.lds + F.wave * 16384);
    const int gw = F.bid * 8 + F.wave, NGW = F.G * 8;
    constexpr int I_IN = 32 * 360, I_GLU = 8 * 16, I_BR = 32 * 64, I_OUT = 32 * 64, I_UP = 32 * 352, I_DN = 88 * 64;
    constexpr int NIT = I_IN + I_GLU + I_BR + I_OUT + I_UP + I_DN;
    for (int it = gw; it < NIT; it += NGW) {
        int r = it;
        if (r < I_IN) { const int kb = r / 360, nb = r % 360, j0 = nb * 32;
            const int src = j0 < 2048 ? j0 : (j0 < 11264 ? j0 + 32 : (j0 < 11296 ? 2048 + (j0 - 11264) : -1));
            transpose_item(A.in[I_WIN] + (size_t)l * 2048 * INW, INW, kb * 64, src, (f16*)(F.ws + WS_WIN), j0, 2048, scr, F.lane); continue; } r -= I_IN;
        if (r < I_GLU) { const int kb = r / 16, nb = r % 16; transpose_item(A.in[I_GLUW] + (size_t)l * 512 * 512, 512, kb * 64, nb * 32, (f16*)(F.ws + WS_WGLU), nb * 32, 512, scr, F.lane); continue; } r -= I_GLU;
        if (r < I_BR) { const int kb = r / 64, nb = r % 64; transpose_item(A.in[I_WBR] + (size_t)l * 2048 * 2048, 2048, kb * 64, nb * 32, (f16*)(F.ws + WS_WBR), nb * 32, 2048, scr, F.lane); continue; } r -= I_BR;
        if (r < I_OUT) { const int kb = r / 64, nb = r % 64; transpose_item(A.in[I_WOUT] + (size_t)l * 2048 * 2048, 2048, kb * 64, nb * 32, (f16*)(F.ws + WS_WOUT), nb * 32, 2048, scr, F.lane); continue; } r -= I_OUT;
        if (r < I_UP) { const int kb = r / 352, nb = r % 352; transpose_item(A.in[I_WUP] + (size_t)l * 2048 * UPLD, UPLD, kb * 64, nb * 32, (f16*)(F.ws + WS_WUP), nb * 32, 2048, scr, F.lane); continue; } r -= I_UP;
        { const int kb = r / 64, nb = r % 64; transpose_item(A.in[I_WDN] + (size_t)l * FFH * 2048, 2048, kb * 64, nb * 32, (f16*)(F.ws + WS_WDN), nb * 32, FFH, scr, F.lane); }
    }
}

__device__ __forceinline__ void s5_mats_group(const Ctx& F, const Args& A, int l, int g) {
    LAS f32x2* APOW = (LAS f32x2*)F.lds;
    LAS f32x2* BBAR = APOW + 2 * 17 * 64;
    LAS f32x2* CM = BBAR + 2 * 64 * 16;
    LAS float* KLAG = (LAS float*)(CM + 2 * 16 * 64);
    __syncthreads();
    for (int i = F.tid; i < 2 * 17 * 64; i += 512) { const int d = i / (17 * 64), e = (i / 64) % 17, n = i % 64;
        const size_t pi = (((size_t)l * 2 + d) * 32 + g) * 64 + n;
        const float are = A.in[I_S5ARE][pi], aim = A.in[I_S5AIM][pi], dt = expf(A.in[I_S5STEP][((size_t)l * 2 + d) * 32 + g]);
        const float zr = are * dt * (float)e, zi = aim * dt * (float)e; float s, c; sincosf(zi, &s, &c); const float m = expf(zr);
        APOW[i] = (f32x2){m * c, m * s}; }
    __syncthreads();
    for (int i = F.tid; i < 2 * 64 * 16; i += 512) { const int d = i / 1024, n = (i / 16) % 64, h = i % 16;
        const size_t pi = (((size_t)l * 2 + d) * 32 + g) * 64 + n;
        const float are = A.in[I_S5ARE][pi], aim = A.in[I_S5AIM][pi];
        const f32x2 ab = APOW[(d * 17 + 1) * 64 + n]; const f32x2 num = (f32x2){ab.x - 1.0f, ab.y};
        const float den = are * are + aim * aim; const f32x2 q = (f32x2){(num.x * are + num.y * aim) / den, (num.y * are - num.x * aim) / den};
        const size_t bi = (pi * 16) + h;
        BBAR[i] = cmul(q, (f32x2){A.in[I_S5BRE][bi], A.in[I_S5BIM][bi]});
        const size_t ci = ((((size_t)l * 2 + d) * 32 + g) * 16 + h) * 64 + n;
        CM[(d * 16 + h) * 64 + n] = (f32x2){A.in[I_S5CRE][ci], A.in[I_S5CIM][ci]}; }
    __syncthreads();
    for (int i = F.tid; i < 2 * 16 * 256; i += 512) { const int d = i / 4096, lag = (i / 256) % 16, h = (i / 16) % 16, hp = i % 16; float s = 0.f;
        for (int n = 0; n < 64; ++n) { const f32x2 t = cmul(CM[(d * 16 + h) * 64 + n], APOW[(d * 17 + lag) * 64 + n]); const f32x2 b = BBAR[(d * 64 + n) * 16 + hp]; s += t.x * b.x - t.y * b.y; }
        KLAG[i] = s; }
    __syncthreads();
    f16* W = (f16*)(F.ws + WS_S5W) + (size_t)g * 256 * 512;
    for (int i = F.tid; i < 256 * 64; i += 512) { const int n = i / 64, k8 = (i % 64) * 8, t = n >> 4, h = n & 15; f16x8 o;
#pragma unroll
        for (int e = 0; e < 8; ++e) { const int k = k8 + e; float v;
            if (k < 256) { const int s = k >> 4, hp = k & 15; v = 0.f;
                if (t >= s) v += KLAG[((0 * 16 + (t - s)) * 16 + h) * 16 + hp];
                if (s >= t) v += KLAG[((1 * 16 + (s - t)) * 16 + h) * 16 + hp];
                v *= S5SCALE; }
            else { const int d = (k - 256) >> 7, nn2 = (k - 256) & 127, nn = nn2 & 63, im = nn2 >> 6, ex = d == 0 ? t + 1 : 16 - t;
                const f32x2 z = cmul(CM[(d * 16 + h) * 64 + nn], APOW[(d * 17 + ex) * 64 + nn]); v = im ? -z.y : z.x; }
            o[e] = (f16)v; }
        *(f16x8*)(W + (size_t)n * 512 + k8) = o; }
    f16* Mx = (f16*)(F.ws + WS_S5M) + (size_t)g * 256 * 256;
    for (int i = F.tid; i < 256 * 32; i += 512) { const int n = i / 32, k8 = (i % 32) * 8, d = n >> 7, ri = (n >> 6) & 1, nn = n & 63; f16x8 o;
#pragma unroll
        for (int e = 0; e < 8; ++e) { const int k = k8 + e, s = k >> 4, hp = k & 15, ex = d == 0 ? 15 - s : s;
            const f32x2 z = cmul(APOW[(d * 17 + ex) * 64 + nn], BBAR[(d * 64 + nn) * 16 + hp]); o[e] = (f16)((ri ? z.y : z.x) * S5SCALE); }
        *(f16x8*)(Mx + (size_t)n * 256 + k8) = o; }
    if (F.tid < 128) { const int d = F.tid >> 6, nn = F.tid & 63; ((f32x2*)(F.ws + WS_S5AT))[(d * 32 + g) * 64 + nn] = APOW[(d * 17 + 16) * 64 + nn]; }
    __syncthreads();
}

__device__ __forceinline__ void ph_hyena_h2(const Ctx& F, const Args& A, int l) {
    LAS float* W1 = (LAS float*)F.lds;
    LAS float* W2 = W1 + 33 * 64;
    LAS float* PV = W2 + 64 * 64;
    LAS float* SCR = PV + 256;
    __syncthreads();
    for (int i = F.tid; i < 33 * 64; i += 512) W1[i] = A.in[I_HYW1][(size_t)l * 33 * 64 + i];
    for (int i = F.tid; i < 64 * 64; i += 512) W2[i] = A.in[I_HYW2][(size_t)l * 4096 + i];
    if (F.tid < 64) { PV[F.tid] = A.in[I_HYB1][l * 64 + F.tid]; PV[64 + F.tid] = A.in[I_HYF1][l * 64 + F.tid]; PV[128 + F.tid] = A.in[I_HYB2][l * 64 + F.tid]; PV[192 + F.tid] = A.in[I_HYF2][l * 64 + F.tid]; }
    __syncthreads();
    LAS float* scr = SCR + F.wave * 64;
    const int gw = F.bid * 8 + F.wave, NGW = F.G * 8, j = F.lane;
    float* H2 = (float*)(F.ws + WS_H2);
    for (int p = gw; p < SEQ + LC; p += NGW) {
        const int n = p < SEQ ? SEQ : LC, pos = p < SEQ ? p : p - SEQ;
        float feat = 0.f;
        if (j == 0) feat = (float)pos / (float)(n - 1);
        else if (j < 33) { const int fi = (j - 1) & 15; const float fr = 1e-4f + (float)fi * ((15.0f - 1e-4f) / 15.0f);
            const float ang = (6.283185307179586f / (float)n) * (float)pos * fr; float s, c; sincosf(ang, &s, &c); feat = j < 17 ? c : -s; }
        scr[j] = feat; LDS_WAIT(); asm volatile("" ::: "memory");
        float a = PV[j];
        for (int i = 0; i < 33; ++i) a += scr[i] * W1[i * 64 + j];
        const float h1 = sinf(PV[64 + j] * a);
        LDS_WAIT(); asm volatile("" ::: "memory");
        scr[j] = h1; LDS_WAIT(); asm volatile("" ::: "memory");
        float b = PV[128 + j];
        for (int i = 0; i < 64; ++i) b += scr[i] * W2[i * 64 + j];
        H2[(size_t)p * 64 + j] = sinf(PV[192 + j] * b);
        LDS_WAIT(); asm volatile("" ::: "memory");
    }
}

__device__ __forceinline__ void ph_norm(const Ctx& F, const Args& A, int l, int which) {
    const int gw = F.bid * 8 + F.wave, NGW = F.G * 8;
    const float* X = (const float*)(F.ws + WS_XRES); f16* O = (f16*)(F.ws + WS_HN);
    const float* gain = A.in[which ? I_N2G : I_N1G] + (size_t)l * D;
    const float* mod = (const float*)(F.ws + WS_MOD) + (size_t)l * 3 * 12288;
    const int shoff = which ? 6144 : 0, soff = which ? 8192 : 2048;
    for (int m = gw; m < MT; m += NGW) {
        const int bsel = m < SEQ ? 0 : (m < MX ? 1 : 2);
        const f32x4* xr = (const f32x4*)(X + (size_t)m * D) + F.lane;
        f32x4 v[8]; float s = 0.f;
#pragma unroll
        for (int j = 0; j < 8; ++j) { v[j] = xr[64 * j]; s += (v[j].x * v[j].x + v[j].y * v[j].y) + (v[j].z * v[j].z + v[j].w * v[j].w); }
        const float rstd = 1.0f / sqrtf(wave_sum(s) * (1.0f / D) + EPS);
        const float* mp = mod + bsel * 12288;
#pragma unroll
        for (int j = 0; j < 8; ++j) { const int c = 4 * F.lane + 256 * j;
            const f32x4 g = *(const f32x4*)(gain + c), sh = *(const f32x4*)(mp + shoff + c), sc = *(const f32x4*)(mp + soff + c);
            f16x4 o;
#pragma unroll
            for (int e = 0; e < 4; ++e) o[e] = (f16)(v[j][e] * rstd * g[e] * (1.0f + sc[e]) + sh[e]);
            *(f16x4*)(O + (size_t)m * D + c) = o; }
    }
}
__device__ __forceinline__ void ph_final_norm(const Ctx& F, const Args& A) {
    const int gw = F.bid * 8 + F.wave, NGW = F.G * 8;
    const float* X = (const float*)(F.ws + WS_XRES); const float* gain = A.in[I_FNG];
    for (int m = gw; m < MX; m += NGW) {
        const f32x4* xr = (const f32x4*)(X + (size_t)m * D) + F.lane;
        f32x4 v[8]; float s = 0.f;
#pragma unroll
        for (int j = 0; j < 8; ++j) { v[j] = xr[64 * j]; s += (v[j].x * v[j].x + v[j].y * v[j].y) + (v[j].z * v[j].z + v[j].w * v[j].w); }
        const float rstd = 1.0f / sqrtf(wave_sum(s) * (1.0f / D) + EPS);
#pragma unroll
        for (int j = 0; j < 8; ++j) { const int c = 4 * F.lane + 256 * j; const f32x4 g = *(const f32x4*)(gain + c);
            *(f32x4*)(A.out + (size_t)m * D + c) = v[j] * rstd * g; }
    }
}

__device__ __forceinline__ void ph_s5_scan(const Ctx& F) {
    const int gt = F.bid * 512 + F.tid;
    if (gt >= 2 * 2 * 32 * 64) return;
    const int nn = gt & 63, g = (gt >> 6) & 31, d = (gt >> 11) & 1, b = gt >> 12;
    const float* S = (const float*)(F.ws + WS_S5S); f16* SA = (f16*)(F.ws + WS_S5A);
    const f32x2 at = ((const f32x2*)(F.ws + WS_S5AT))[(d * 32 + g) * 64 + nn];
    f32x2 st = (f32x2){0.f, 0.f};
    for (int step = 0; step < 16 + 512; ++step) {
        int chunk;
        if (d == 0) chunk = step < 16 ? 1024 + b * 16 + step : b * 512 + (step - 16);
        else chunk = step < 16 ? 1024 + b * 16 + (15 - step) : b * 512 + (511 - (step - 16));
        const size_t so = ((size_t)chunk * 32 + g) * 256 + d * 128 + nn;
        const f32x2 loc = (f32x2){S[so], S[so + 64]};
        f16* xp = SA + (size_t)chunk * 16384 + (size_t)g * 512 + 256 + d * 128 + nn;
        xp[0] = (f16)st.x; xp[64] = (f16)st.y;
        st = cmul(at, st) + loc;
    }
}

__device__ __forceinline__ void ph_ffn_act(const Ctx& F, const Args& A, int l) {
    const f16* UP = (const f16*)(F.ws + WS_PX); f16* ACT = (f16*)(F.ws + WS_ACT);
    const float* cw = A.in[I_FFCW] + (size_t)l * 3 * FFH; const float* cb = A.in[I_FFCB] + (size_t)l * FFH;
    const int NTASK = (MT / 16) * (FFH / 8);
    for (int task = F.bid * 512 + F.tid; task < NTASK; task += F.G * 512) {
        const int rb = task / (FFH / 8), cg = task % (FFH / 8), c0 = cg * 8, r0 = rb * 16;
        int seq0, seqn; if (r0 < MX) { seq0 = (r0 / SEQ) * SEQ; seqn = SEQ; } else { seq0 = MX + ((r0 - MX) / LC) * LC; seqn = LC; }
        float w0[8], w1[8], w2[8], bb[8];
#pragma unroll
        for (int e = 0; e < 8; ++e) { w0[e] = cw[c0 + e]; w1[e] = cw[FFH + c0 + e]; w2[e] = cw[2 * FFH + c0 + e]; bb[e] = cb[c0 + e]; }
        f16x8 zero;
#pragma unroll
        for (int e = 0; e < 8; ++e) zero[e] = (f16)0.f;
        f16x8 pm = (r0 > seq0) ? *(const f16x8*)(UP + (size_t)(r0 - 1) * UPLD + c0) : zero;
        f16x8 pc = *(const f16x8*)(UP + (size_t)r0 * UPLD + c0);
#pragma unroll 4
        for (int i = 0; i < 16; ++i) { const int r = r0 + i;
            const f16x8 pn = (r + 1 < seq0 + seqn) ? *(const f16x8*)(UP + (size_t)(r + 1) * UPLD + c0) : zero;
            const f16x8 bv = *(const f16x8*)(UP + (size_t)r * UPLD + FFH + c0);
            f16x8 o;
#pragma unroll
            for (int e = 0; e < 8; ++e) { const float a = w0[e] * (float)pm[e] + w1[e] * (float)pc[e] + w2[e] * (float)pn[e] + bb[e]; o[e] = (f16)(siluf_(a) * (float)bv[e]); }
            *(f16x8*)(ACT + (size_t)r * FFH + c0) = o;
            pm = pc; pc = pn; }
    }
}

namespace gla {
constexpr int QK_LD = 136, KH_LD = 72, VT_LD = 72, P_LD = 72;
constexpr int OFF_QT = 0;
constexpr int OFF_KT = 17408;
constexpr int OFF_VT = OFF_KT + 18432;
constexpr int OFF_P = OFF_VT + 36864;
constexpr int OFF_LR = OFF_P + 9216;
constexpr int OFF_GT = OFF_LR + 4096;
constexpr int OFF_DEC = OFF_GT + 2048;
constexpr int OFF_RS = OFF_DEC + 512;
constexpr int OFF_QR = OFF_RS + 2048;
constexpr int OFF_KR = OFF_QR + 17408;
constexpr int OFF_WG = OFF_KR + 17408;
static_assert(OFF_WG + 8192 <= LDSCTL_OFF, "gla lds");

__device__ __forceinline__ int grow(int b, int sc, int j, int i) {
    if (sc < 32) { const int col = 2 * sc + (j >> 1), r = (j & 1) * 64 + i; return b * SEQ + r * 64 + col; }
    return MX + b * LC + j * 64 + i;
}
#define GLA_MFMA(a, b, c) __builtin_amdgcn_mfma_f32_16x16x32_f16(a, b, c, 0, 0, 0)

template <bool FULL>
__device__ __forceinline__ void gla_unit(const Ctx& F, const Args& A, int l, int unit) {
    const int b = unit / (4 * NSC), h = (unit / NSC) % 4, sc = unit % NSC;
    LAS f16* QT = (LAS f16*)(F.lds + OFF_QT); LAS f16* KT = (LAS f16*)(F.lds + OFF_KT); LAS f16* VT = (LAS f16*)(F.lds + OFF_VT);
    LAS f16* PP = (LAS f16*)(F.lds + OFF_P); LAS f16* LR = (LAS f16*)(F.lds + OFF_LR);
    LAS float* GT = (LAS float*)(F.lds + OFF_GT); LAS float* DEC = (LAS float*)(F.lds + OFF_DEC); LAS float* RS = (LAS float*)(F.lds + OFF_RS);
    LAS f16* QR = (LAS f16*)(F.lds + OFF_QR); LAS f16* KR = (LAS f16*)(F.lds + OFF_KR); LAS float* WG = (LAS float*)(F.lds + OFF_WG);
    const int tid = F.tid, lane = F.lane, w = F.wave, q0 = lane >> 4, c0 = lane & 15;
    const int dk0 = tid & 127, ig0 = tid >> 7;
    const f16* PX = (const f16*)(F.ws + WS_PX);
    const float scale = 0.08838834764831845f;
    for (int dir = 0; dir < 2; ++dir) {
        __syncthreads();
        for (int i = tid; i < 16 * 128; i += 512) WG[i] = A.in[I_GLAWG][(((size_t)l * 2 + dir) * 16 + (i >> 7)) * 512 + h * 128 + (i & 127)];
        const float bgv = A.in[I_GLABG][((size_t)l * 2 + dir) * 512 + h * 128 + dk0];
        const size_t sidx = ((((size_t)b * 4 + h) * NSC + sc) * 2 + dir);
        f32x4 accS[8][2];
        if (FULL) { const float* Sin = (const float*)(F.ws + WS_GSIN) + sidx * 32768; const int q = opq(q0), c = opq(c0);
#pragma unroll
            for (int dt = 0; dt < 8; ++dt)
#pragma unroll
                for (int et = 0; et < 2; ++et)
#pragma unroll
                    for (int r = 0; r < 4; ++r) accS[dt][et][r] = Sin[(16 * dt + 4 * q + r) * 256 + 32 * w + 16 * et + c]; }
        else {
#pragma unroll
            for (int dt = 0; dt < 8; ++dt)
#pragma unroll
                for (int et = 0; et < 2; ++et) accS[dt][et] = (f32x4){0.f, 0.f, 0.f, 0.f}; }
        float sumtot = 0.f;
        for (int jj = 0; jj < 4; ++jj) {
            const int j = dir ? 3 - jj : jj;
            __syncthreads();
            const int tid = opq(F.tid);
            if (tid < 256) { const int row = tid >> 2, part = tid & 3; const int gr = grow(b, sc, j, row);
                *(LAS f16x8*)(LR + row * 32 + part * 8) = *(const f16x8*)(PX + (size_t)gr * PXLD + P_GG + part * 8); }
#pragma unroll 1
            for (int k = 0; k < 4; ++k) { const int idx = tid + 512 * k, wi = idx >> 6, ln = idx & 63, rr = ln >> 2, cc = ln & 3;
                const int row = (wi & 3) * 16 + rr, chunk = (wi >> 2) * 4 + cc; const int gr = grow(b, sc, j, row);
                const f16x8 v8 = *(const f16x8*)(PX + (size_t)gr * PXLD + P_GV + h * 256 + chunk * 8);
#pragma unroll
                for (int e = 0; e < 8; ++e) VT[(chunk * 8 + e) * VT_LD + row] = v8[e]; }
#pragma unroll 1
            for (int k = 0; k < 2; ++k) { const int idx = tid + 512 * k, row = idx >> 4, ch = idx & 15; const int gr = grow(b, sc, j, row);
                *(LAS f16x8*)(KR + row * QK_LD + ch * 8) = *(const f16x8*)(PX + (size_t)gr * PXLD + P_GK + h * 128 + ch * 8);
                if (FULL) *(LAS f16x8*)(QR + row * QK_LD + ch * 8) = *(const f16x8*)(PX + (size_t)gr * PXLD + P_GQ + h * 128 + ch * 8); }
            __syncthreads();
            const int dk = opq(dk0), ig = opq(ig0);
            float bv[16];
#pragma unroll
            for (int ii = 0; ii < 16; ++ii) { const int i = ig * 16 + ii; float pre = bgv;
                const f16x8 l0 = *(const LAS f16x8*)(LR + i * 32 + dir * 16), l1 = *(const LAS f16x8*)(LR + i * 32 + dir * 16 + 8);
#pragma unroll
                for (int r = 0; r < 8; ++r) pre += (float)l0[r] * WG[r * 128 + dk] + (float)l1[r] * WG[(8 + r) * 128 + dk];
                bv[ii] = logsigmoidf_(pre) * (1.0f / 16.0f); asm volatile("" ::: "memory"); }
            float totloc;
            if (dir == 0) {
#pragma unroll
                for (int ii = 1; ii < 16; ++ii) bv[ii] += bv[ii - 1];
                totloc = bv[15]; }
            else {
#pragma unroll
                for (int ii = 14; ii >= 0; --ii) bv[ii] += bv[ii + 1];
                totloc = bv[0]; }
            GT[ig * 128 + dk] = totloc;
            __syncthreads();
            const float g0 = GT[dk], g1 = GT[128 + dk], g2 = GT[256 + dk], g3 = GT[384 + dk];
            const float total = (g0 + g1) + (g2 + g3);
            float off, bmid;
            if (dir == 0) { off = (ig > 0 ? g0 : 0.f) + (ig > 1 ? g1 : 0.f) + (ig > 2 ? g2 : 0.f); bmid = g0 + g1; }
            else { off = (ig < 3 ? g3 : 0.f) + (ig < 2 ? g2 : 0.f) + (ig < 1 ? g1 : 0.f); bmid = g2 + g3; }
#pragma unroll
            for (int ii = 0; ii < 16; ++ii) bv[ii] += off;
            if (FULL) {
#pragma unroll
                for (int ii = 0; ii < 16; ++ii) { const int i = ig * 16 + ii;
                    QT[i * QK_LD + dk] = (f16)((float)QR[i * QK_LD + dk] * scale * __expf(fminf(bv[ii] - bmid, 9.f)));
                    KT[i * QK_LD + dk] = (f16)((float)KR[i * QK_LD + dk] * __expf(fminf(bmid - bv[ii], 9.f))); if ((ii & 3) == 3) asm volatile("" ::: "memory"); }
                __syncthreads();
                { const int c = opq(c0), q = opq(q0);
#pragma unroll
                for (int s = 0; s < 2; ++s) { const int T = 2 * w + s, it = T >> 2, jt = T & 3; f32x4 a = (f32x4){0.f, 0.f, 0.f, 0.f};
#pragma unroll
                    for (int kk = 0; kk < 4; ++kk) { const f16x8 kf = *(const LAS f16x8*)(KT + (jt * 16 + c) * QK_LD + kk * 32 + 8 * q);
                        const f16x8 qf = *(const LAS f16x8*)(QT + (it * 16 + c) * QK_LD + kk * 32 + 8 * q); a = GLA_MFMA(kf, qf, a); }
                    const int i = it * 16 + c; f16x4 pv;
#pragma unroll
                    for (int r = 0; r < 4; ++r) { const int jx = jt * 16 + 4 * q + r; const bool keep = dir == 0 ? (jx <= i) : (jx >= i); pv[r] = keep ? (f16)a[r] : (f16)0.f; }
                    *(LAS f16x4*)(PP + i * P_LD + jt * 16 + 4 * q) = pv; } }
                __syncthreads();
#pragma unroll
                for (int ii = 0; ii < 16; ++ii) { const int i = ig * 16 + ii; QT[i * QK_LD + dk] = (f16)((float)QR[i * QK_LD + dk] * scale * __expf(bv[ii])); if ((ii & 3) == 3) asm volatile("" ::: "memory"); }
            }
            { f16x8 k0, k1;
#pragma unroll
              for (int ii = 0; ii < 8; ++ii) { k0[ii] = (f16)((float)KR[(ig * 16 + ii) * QK_LD + dk] * __expf(total - bv[ii])); k1[ii] = (f16)((float)KR[(ig * 16 + 8 + ii) * QK_LD + dk] * __expf(total - bv[8 + ii])); }
              *(LAS f16x8*)(KT + dk * KH_LD + ig * 16) = k0; *(LAS f16x8*)(KT + dk * KH_LD + ig * 16 + 8) = k1; }
            if (ig == 0) { DEC[dk] = __expf(total); sumtot += total; }
            __syncthreads();
            const int c = opq(c0), q = opq(q0);
            if (FULL) {
                f32x4 accO[4][2];
#pragma unroll
                for (int it = 0; it < 4; ++it)
#pragma unroll
                    for (int et = 0; et < 2; ++et) accO[it][et] = (f32x4){0.f, 0.f, 0.f, 0.f};
#pragma unroll
                for (int et = 0; et < 2; ++et)
#pragma unroll
                    for (int kk = 0; kk < 2; ++kk) { const f16x8 vf = *(const LAS f16x8*)(VT + (32 * w + 16 * et + c) * VT_LD + kk * 32 + 8 * q);
#pragma unroll
                        for (int it = 0; it < 4; ++it) { const f16x8 pf = *(const LAS f16x8*)(PP + (it * 16 + c) * P_LD + kk * 32 + 8 * q); accO[it][et] = GLA_MFMA(vf, pf, accO[it][et]); } asm volatile("" ::: "memory"); }
#pragma unroll
                for (int kb = 0; kb < 4; ++kb)
#pragma unroll
                    for (int et = 0; et < 2; ++et) { f16x8 sf; asm volatile("" ::: "memory");
#pragma unroll
                        for (int e = 0; e < 4; ++e) { sf[e] = (f16)accS[2 * kb][et][e]; sf[4 + e] = (f16)accS[2 * kb + 1][et][e]; }
#pragma unroll
                        for (int it = 0; it < 4; ++it) { const f16x4 lo = *(const LAS f16x4*)(QT + (it * 16 + c) * QK_LD + 32 * kb + 4 * q), hi = *(const LAS f16x4*)(QT + (it * 16 + c) * QK_LD + 32 * kb + 16 + 4 * q);
                            f16x8 qf; qf[0] = lo[0]; qf[1] = lo[1]; qf[2] = lo[2]; qf[3] = lo[3]; qf[4] = hi[0]; qf[5] = hi[1]; qf[6] = hi[2]; qf[7] = hi[3];
                            accO[it][et] = GLA_MFMA(sf, qf, accO[it][et]); } }
                float* OF = (float*)(F.ws + WS_GOF);
                if (dir == 0) {
#pragma unroll
                    for (int it = 0; it < 4; ++it) { const int gr = grow(b, sc, j, it * 16 + c);
#pragma unroll
                        for (int et = 0; et < 2; ++et) *(f32x4*)(OF + (size_t)gr * 1024 + h * 256 + 32 * w + 16 * et + 4 * q) = accO[it][et];
                        asm volatile("" ::: "memory"); } }
                else {
                    int grs[4];
#pragma unroll
                    for (int it = 0; it < 4; ++it) { grs[it] = grow(b, sc, j, it * 16 + c); float ss = 0.f;
#pragma unroll
                        for (int et = 0; et < 2; ++et) { accO[it][et] = accO[it][et] + *(const f32x4*)(OF + (size_t)grs[it] * 1024 + h * 256 + 32 * w + 16 * et + 4 * q);
                            ss += (accO[it][et][0] * accO[it][et][0] + accO[it][et][1] * accO[it][et][1]) + (accO[it][et][2] * accO[it][et][2] + accO[it][et][3] * accO[it][et][3]); }
                        ss += __shfl_xor(ss, 16); ss += __shfl_xor(ss, 32);
                        if (q == 0) RS[(it * 16 + c) * 8 + w] = ss; asm volatile("" ::: "memory"); }
                    __syncthreads();
                    const float* ng = A.in[I_GLANG] + (size_t)l * 256;
                    f16* Y = (f16*)(F.ws + WS_YCAT);
#pragma unroll
                    for (int it = 0; it < 4; ++it) { const int i = it * 16 + c; const f32x4 ra = *(const LAS f32x4*)(RS + i * 8), rb = *(const LAS f32x4*)(RS + i * 8 + 4);
                        const float tot = ((ra[0] + ra[1]) + (ra[2] + ra[3])) + ((rb[0] + rb[1]) + (rb[2] + rb[3]));
                        const float rstd = 1.0f / sqrtf(tot * (1.0f / 256.0f) + EPS);
#pragma unroll
                        for (int et = 0; et < 2; ++et) { const int e0 = 32 * w + 16 * et + 4 * q;
                            const f32x4 gv = *(const f32x4*)(ng + e0); const f16x4 rv = *(const f16x4*)(PX + (size_t)grs[it] * PXLD + P_GR + h * 256 + e0);
                            f16x4 o;
#pragma unroll
                            for (int r = 0; r < 4; ++r) o[r] = (f16)(accO[it][et][r] * rstd * gv[r] * siluf_((float)rv[r]));
                            *(f16x4*)(Y + (size_t)grs[it] * 2048 + 1024 + h * 256 + e0) = o; } asm volatile("" ::: "memory"); }
                }
            }
#pragma unroll
            for (int dt = 0; dt < 8; ++dt) { const f32x4 dv = *(const LAS f32x4*)(DEC + 16 * dt + 4 * q);
#pragma unroll
                for (int et = 0; et < 2; ++et) accS[dt][et] = accS[dt][et] * dv; }
#pragma unroll
            for (int kk = 0; kk < 2; ++kk) { f16x8 vf[2];
#pragma unroll
                for (int et = 0; et < 2; ++et) vf[et] = *(const LAS f16x8*)(VT + (32 * w + 16 * et + c) * VT_LD + kk * 32 + 8 * q);
#pragma unroll
                for (int dt = 0; dt < 8; ++dt) { const f16x8 kf = *(const LAS f16x8*)(KT + (16 * dt + c) * KH_LD + kk * 32 + 8 * q);
#pragma unroll
                    for (int et = 0; et < 2; ++et) accS[dt][et] = GLA_MFMA(kf, vf[et], accS[dt][et]); if (dt & 1) asm volatile("" ::: "memory"); } }
        }
        if (!FULL) { float* Sl = (float*)(F.ws + WS_GSLOC) + sidx * 32768; const int q = opq(q0), c = opq(c0);
#pragma unroll
            for (int dt = 0; dt < 8; ++dt)
#pragma unroll
                for (int et = 0; et < 2; ++et)
#pragma unroll
                    for (int r = 0; r < 4; ++r) Sl[(16 * dt + 4 * q + r) * 256 + 32 * w + 16 * et + c] = accS[dt][et][r];
            if (ig0 == 0) ((float*)(F.ws + WS_GDT))[sidx * 128 + dk0] = __expf(sumtot); }
        VM_WAIT();
    }
}
__device__ __forceinline__ void ph_gla_scan(const Ctx& F) {
    const float* Sl = (const float*)(F.ws + WS_GSLOC); float* Si = (float*)(F.ws + WS_GSIN); const float* Dt = (const float*)(F.ws + WS_GDT);
    for (int gt = F.bid * 512 + F.tid; gt < 2 * 4 * 2 * 32768; gt += F.G * 512) {
        const int e = gt & 32767, dir = (gt >> 15) & 1, h = (gt >> 16) & 3, b = gt >> 18;
        float S = 0.f;
        for (int step = 0; step < NSC; ++step) { const int sc = step == 0 ? 32 : (dir == 0 ? step - 1 : 32 - step);
            const size_t idx = ((((size_t)b * 4 + h) * NSC + sc) * 2 + dir);
            Si[idx * 32768 + e] = S; S = Dt[idx * 128 + (e >> 8)] * S + Sl[idx * 32768 + e]; }
    }
}
#undef GLA_MFMA
}

namespace hy {
__device__ __forceinline__ void fft_fwd(LAS f32x2* x, int m, const f32x2* tw, int tid) {
    const int N = 1 << m, tws = 16384 >> m;
    int lh = m - 1;
    if (m & 1) { const int h = 1 << lh;
        for (int i = tid; i < (N >> 1); i += 512) { const f32x2 a = x[i], b = x[i + h]; x[i] = a + b; x[i + h] = cmul(a - b, tw[i * tws]); }
        __syncthreads(); lh -= 1; }
    for (; lh >= 1; lh -= 2) { const int h = 1 << lh, hh = h >> 1, lhh = lh - 1, s = (N >> 1) >> lh;
        for (int q = tid; q < (N >> 2); q += 512) { const int j = q & (hh - 1), blk = q >> lhh, i = (blk << (lh + 1)) + j;
            const f32x2 x0 = x[i], x1 = x[i + hh], x2 = x[i + h], x3 = x[i + h + hh];
            const f32x2 w1 = tw[(j * s) * tws], w2 = tw[(2 * j * s) * tws];
            const f32x2 a0 = x0 + x2, a2 = cmul(x0 - x2, w1), a1 = x1 + x3, t3 = cmul(x1 - x3, w1), a3 = (f32x2){t3.y, -t3.x};
            x[i] = a0 + a1; x[i + hh] = cmul(a0 - a1, w2); x[i + h] = a2 + a3; x[i + h + hh] = cmul(a2 - a3, w2); }
        __syncthreads(); }
}
__device__ __forceinline__ void fft_inv(LAS f32x2* x, int m, const f32x2* tw, int tid) {
    const int N = 1 << m, tws = 16384 >> m;
    int lh = 0;
    for (int p = 0; p < (m >> 1); ++p, lh += 2) { const int h = 1 << lh, s1 = (N >> 1) >> lh, s2 = s1 >> 1;
        for (int q = tid; q < (N >> 2); q += 512) { const int j = q & (h - 1), blk = q >> lh, i = (blk << (lh + 2)) + j;
            const f32x2 x0 = x[i], x1 = x[i + h], x2 = x[i + 2 * h], x3 = x[i + 3 * h];
            const f32x2 w1 = cconj(tw[(j * s1) * tws]), w2 = cconj(tw[(j * s2) * tws]), w3 = (f32x2){-w2.y, w2.x};
            const f32x2 b1 = cmul(x1, w1), b3 = cmul(x3, w1);
            const f32x2 a0 = x0 + b1, a1 = x0 - b1, a2 = x2 + b3, a3 = x2 - b3;
            const f32x2 c2 = cmul(a2, w2), c3 = cmul(a3, w3);
            x[i] = a0 + c2; x[i + 2 * h] = a0 - c2; x[i + h] = a1 + c3; x[i + 3 * h] = a1 - c3; }
        __syncthreads(); }
    if (m & 1) { const int h = 1 << lh;
        for (int i = tid; i < (N >> 1); i += 512) { const f32x2 a = x[i], b = cmul(x[i + h], cconj(tw[i * tws])); x[i] = a + b; x[i + h] = a - b; }
        __syncthreads(); }
}
__device__ __forceinline__ int brev(int k, int m) { return (int)(__brev((unsigned)k) >> (32 - m)); }

__device__ __forceinline__ void filt_unit(const Ctx& F, const Args& A, int l, int unit) {
    const int kind = unit >> 9, o = (unit >> 8) & 1, pair = unit & 255;
    const int n = kind ? LC : SEQ, m = kind ? 9 : 14, N = 2 * n, tid = F.tid;
    LAS f32x2* buf = (LAS f32x2*)F.lds;
    LAS float* W3 = (LAS float*)(F.lds + EXTRA_OFF);
    LAS float* B3 = W3 + 256;
    LAS float* RED = B3 + 4;
    LAS float* INV = RED + 16;
    __syncthreads();
    if (tid < 256) { const int j = tid >> 2, ci = tid & 3; const int col = o * 1024 + (ci >> 1) * 512 + 2 * pair + (ci & 1);
        W3[j * 4 + ci] = A.in[I_HYW3][((size_t)l * 64 + j) * 2048 + col]; if (j == 0) B3[ci] = A.in[I_HYB3][(size_t)l * 2048 + col]; }
    __syncthreads();
    const float* H2 = (const float*)(F.ws + WS_H2) + (kind ? (size_t)SEQ * 64 : 0);
    const float lo = -3.0701134573253945f, hi = -15.350567286626973f;
    const float ra = fabsf(lo + (hi - lo) * (float)(2 * pair) / 511.0f), rb = fabsf(lo + (hi - lo) * (float)(2 * pair + 1) / 511.0f);
    float sa = 0.f, sb = 0.f;
    for (int t = tid; t < n; t += 512) {
        float a0 = B3[0], a1 = B3[1], a2 = B3[2], a3 = B3[3];
        const f32x4* hr = (const f32x4*)(H2 + (size_t)t * 64);
#pragma unroll 4
        for (int j4 = 0; j4 < 16; ++j4) { const f32x4 hv = hr[j4];
#pragma unroll
            for (int e = 0; e < 4; ++e) { const f32x4 wv = *(const LAS f32x4*)(W3 + (j4 * 4 + e) * 4); a0 += hv[e] * wv[0]; a1 += hv[e] * wv[1]; a2 += hv[e] * wv[2]; a3 += hv[e] * wv[3]; } }
        const float tn = (float)t / (float)(n - 1), da = expf(-tn * ra), db = expf(-tn * rb);
        const float fa = a0 * da, fb = a1 * db, ba = a2 * da, bb = a3 * db;
        buf[t] = (f32x2){fa, fb}; sa += fabsf(fa); sb += fabsf(fb);
        if (t >= 1) { buf[N - t] = (f32x2){ba, bb}; sa += fabsf(ba); sb += fabsf(bb); }
    }
    if (tid == 0) buf[n] = (f32x2){0.f, 0.f};
    sa = wave_sum(sa); sb = wave_sum(sb);
    if (F.lane == 0) { RED[F.wave * 2] = sa; RED[F.wave * 2 + 1] = sb; }
    __syncthreads();
    if (tid < 2) { float s = 0.f;
#pragma unroll
        for (int w = 0; w < 8; ++w) s += RED[w * 2 + tid];
        INV[tid] = 1.0f / (s + EPS); }
    __syncthreads();
    { const float ia = INV[0], ib = INV[1];
      for (int i = tid; i < N; i += 512) { f32x2 v = buf[i]; v.x *= ia; v.y *= ib; buf[i] = v; } }
    __syncthreads();
    const f32x2* tw = (const f32x2*)(F.ws + WS_TW);
    fft_fwd(buf, m, tw, tid);
    f32x4* out = (f32x4*)(F.ws + WS_FSD + (kind ? FSD_C_OFF : 0)) + (size_t)(o * 256 + pair) * (n + 1);
    for (int k = tid; k <= n; k += 512) { const f32x2 zk = buf[brev(k, m)], zn = cconj(buf[brev((N - k) & (N - 1), m)]);
        const f32x2 fa = (zk + zn) * 0.5f, df = zk - zn, fb = (f32x2){df.y * 0.5f, -df.x * 0.5f};
        const f32x2 fs = (fa + fb) * 0.5f, fd = (fa - fb) * 0.5f;
        out[k] = (f32x4){fs.x, fs.y, fd.x, fd.y}; }
    __syncthreads();
}

__device__ __forceinline__ void main_unit(const Ctx& F, const Args& A, int l, int unit) {
    const int kind = unit >> 9, b = (unit >> 8) & 1, pair = unit & 255;
    const int n = kind ? LC : SEQ, m = kind ? 9 : 14, N = 2 * n, tid = F.tid;
    const int row0 = kind ? MX + b * LC : b * SEQ;
    LAS f32x2* buf = (LAS f32x2*)F.lds;
    const f16* PX = (const f16*)(F.ws + WS_PX) + P_HY + 2 * pair;
    const float* cw = A.in[I_HYCW] + (size_t)l * 3 * 1536 + 2 * pair; const float* cb = A.in[I_HYCB] + (size_t)l * 1536 + 2 * pair;
    f32x2 yv[16], g1[16], g2[16];
    {
        f32x2 w[3][3], bs[3];
#pragma unroll
        for (int g = 0; g < 3; ++g) { bs[g] = (f32x2){cb[g * 512], cb[g * 512 + 1]};
#pragma unroll
            for (int tp = 0; tp < 3; ++tp) w[g][tp] = (f32x2){cw[tp * 1536 + g * 512], cw[tp * 1536 + g * 512 + 1]}; }
#pragma unroll
        for (int i = 0; i < 16; ++i) { const int t = tid + 512 * i; f32x2 r[3] = {bs[0], bs[1], bs[2]};
            if (t < n) {
#pragma unroll
                for (int tp = 0; tp < 3; ++tp) { const int tt = t + tp - 1;
                    if (tt >= 0 && tt < n) { const f16* p = PX + (size_t)(row0 + tt) * PXLD;
#pragma unroll
                        for (int g = 0; g < 3; ++g) { const f16x2 z = *(const f16x2*)(p + g * 512); r[g].x += w[g][tp].x * (float)z[0]; r[g].y += w[g][tp].y * (float)z[1]; } } } }
            yv[i] = r[0]; g1[i] = r[1]; g2[i] = r[2]; }
    }
    const f32x2* tw = (const f32x2*)(F.ws + WS_TW);
    const float invN = 1.0f / (float)N;
#pragma unroll
    for (int o = 0; o < 2; ++o) {
        __syncthreads();
#pragma unroll
        for (int i = 0; i < 16; ++i) { const int t = tid + 512 * i; if (t < n) { buf[t] = yv[i]; buf[n + t] = (f32x2){0.f, 0.f}; } }
        __syncthreads();
        fft_fwd(buf, m, tw, tid);
        const f32x4* fsd = (const f32x4*)(F.ws + WS_FSD + (kind ? FSD_C_OFF : 0)) + (size_t)(o * 256 + pair) * (n + 1);
        for (int k = tid; k <= n; k += 512) { const int pk = brev(k, m), pn = brev((N - k) & (N - 1), m);
            const f32x2 zk = buf[pk], zn = buf[pn]; const f32x4 f = fsd[k]; const f32x2 fs = (f32x2){f[0], f[1]}, fd = (f32x2){f[2], f[3]};
            const f32x2 wk = cmul(zk, fs) + cmul(cconj(zn), fd), wn = cmul(zn, cconj(fs)) + cmul(cconj(zk), cconj(fd));
            buf[pn] = wn; buf[pk] = wk; }
        __syncthreads();
        fft_inv(buf, m, tw, tid);
        const float* hb = A.in[I_HYBIAS] + ((size_t)l * 2 + o) * 512 + 2 * pair; const f32x2 bias = (f32x2){hb[0], hb[1]};
#pragma unroll
        for (int i = 0; i < 16; ++i) { const int t = tid + 512 * i; if (t < n) { const f32x2 cv = buf[t] * invN; const f32x2 gt = o == 0 ? g1[i] : g2[i];
            yv[i] = gt * (cv + yv[i] * bias); } }
    }
    f16* Y = (f16*)(F.ws + WS_YCAT) + 512 + 2 * pair;
#pragma unroll
    for (int i = 0; i < 16; ++i) { const int t = tid + 512 * i; if (t < n) { f16x2 o2; o2[0] = (f16)yv[i].x; o2[1] = (f16)yv[i].y; *(f16x2*)(Y + (size_t)(row0 + t) * 2048) = o2; } }
    __syncthreads();
}
}

#ifndef PHMASK
#define PHMASK 0xFFFF
#endif
#define PH_EN(k) (((PHMASK) >> (k)) & 1)
#ifndef SUBMASK
#define SUBMASK 7
#endif
#define SUB_EN(k) (((SUBMASK) >> (k)) & 1)
constexpr int NPH = 2 + 12 * DEPTH;

__global__ void __launch_bounds__(512, 2) mk_fwd(Args args) {
    extern __shared__ __attribute__((aligned(16))) unsigned char lds_raw[];
    Ctx F; F.lds = (LAS unsigned char*)lds_raw; F.tid = threadIdx.x; F.lane = F.tid & 63; F.wave = __builtin_amdgcn_readfirstlane(F.tid >> 6);
    F.G = gridDim.x; F.bid = blockIdx.x; F.ws = args.ws;
    const Ctx F0 = F;
#define FRESH() do { F.tid = opq(F0.tid); F.lane = F.tid & 63; F.wave = __builtin_amdgcn_readfirstlane(F.tid >> 6); } while (0)
    volatile LAS unsigned* MISC = (volatile LAS unsigned*)(F.lds + LDSCTL_OFF);
    if (F.tid < 64) MISC[F.tid] = 0u;
    __syncthreads();
    unsigned* barw = (unsigned*)(F.ws + WS_CTL) + CW_BAR;
    XcdBarrier bar; bar.bar = barw; bar.x = 0; bar.st = nullptr;
    const int lo = args.ph_lo, hi = args.ph_hi;
    if (hi - lo > 1) bar = xcd_barrier_post(barw, MISC + 8);
#define IN(k) (lo <= (k) && (k) < hi)
#define SEAM(k) do { if (IN(k) && IN((k) + 1)) xcd_barrier(bar); } while (0)
    unsigned char* ws = F.ws;
    const int rank160 = (F.bid + F.G - 160 % F.G) % F.G;

    if (PH_EN(12) && IN(0)) { FRESH(); ph_prologue(F, args); }
    SEAM(0);

    for (int l = 0; l < DEPTH; ++l) {
        const int pb = 1 + 12 * l;
        const float* modl = (const float*)(ws + WS_MOD) + (size_t)l * 3 * 12288;
        if (PH_EN(0) && IN(pb + 0)) {
            FRESH(); ph_convert_weights(F, args, l);
            __syncthreads();
            FRESH(); if (F.bid < 32) s5_mats_group(F, args, l, F.bid);
            FRESH(); ph_hyena_h2(F, args, l);
            FRESH(); ph_norm(F, args, l, 0);
        }
        SEAM(pb + 0);
        if (PH_EN(1) && IN(pb + 1)) {
            pg8::SchedPlain S; S.init(MT / 256, PXLD / 256, F.G, F.bid); S.A = (const char*)(ws + WS_HN); S.B = (const char*)(ws + WS_WIN); S.aTile = (size_t)256 * 2048 * 2; S.bTile = (size_t)256 * 2048 * 2;
            pg8::EpiPx E{(f16*)(ws + WS_PX), (f16*)(ws + WS_S5A)};
            pg8::gemm_phase(F.lds, 2048, 2048, 32, S, E);
        }
        SEAM(pb + 1);
        if (PH_EN(2) && IN(pb + 2)) {
            if (SUB_EN(0)) { pg8::SchedS5 S{(const char*)(ws + WS_S5A), (const char*)(ws + WS_S5M), (size_t)256 * 256 * 2, F.G, F.bid};
              pg8::EpiS5In E{(float*)(ws + WS_S5S)};
              pg8::gemm_phase(F.lds, 16384, 256, 4, S, E); }
            FRESH();
            if (SUB_EN(1)) for (int u = rank160; u < 2 * 4 * NSC; u += F.G) gla::gla_unit<false>(F, args, l, u);
            FRESH();
            if (SUB_EN(2)) for (int u = rank160; u < 1024; u += F.G) hy::filt_unit(F, args, l, u);
        }
        SEAM(pb + 2);
        if (PH_EN(3) && IN(pb + 3)) { FRESH(); ph_s5_scan(F); FRESH(); gla::ph_gla_scan(F); }
        SEAM(pb + 3);
        if (PH_EN(4) && IN(pb + 4)) {
            if (SUB_EN(0)) { pg8::SchedS5 S{(const char*)(ws + WS_S5A), (const char*)(ws + WS_S5W), (size_t)256 * 512 * 2, F.G, F.bid};
              pg8::EpiS5Out E{(const f16*)(ws + WS_S5A), (f16*)(ws + WS_YAPRE), args.in[I_S5D] + (size_t)l * 512};
              pg8::gemm_phase(F.lds, 16384, 512, 8, S, E); }
            FRESH();
            if (SUB_EN(1)) for (int u = rank160; u < 2 * 4 * NSC; u += F.G) gla::gla_unit<true>(F, args, l, u);
            FRESH();
            if (SUB_EN(2)) for (int u = rank160; u < 1024; u += F.G) hy::main_unit(F, args, l, u);
        }
        SEAM(pb + 4);
        if (PH_EN(5) && IN(pb + 5)) {
            pg8::SchedPlain S; S.init(MT / 256, 2, F.G, F.bid); S.A = (const char*)(ws + WS_YAPRE); S.B = (const char*)(ws + WS_WGLU); S.aTile = (size_t)256 * 512 * 2; S.bTile = (size_t)256 * 512 * 2;
            pg8::EpiGlu E{(const f16*)(ws + WS_YAPRE), (f16*)(ws + WS_YCAT), args.in[I_GLUB] + (size_t)l * 512};
            pg8::gemm_phase(F.lds, 512, 512, 8, S, E);
        }
        SEAM(pb + 5);
        if (PH_EN(6) && IN(pb + 6)) {
            pg8::SchedPlain S; S.init(MT / 256, 8, F.G, F.bid); S.aTile = (size_t)256 * 2048 * 2; S.bTile = (size_t)256 * 2048 * 2;
            S.A = (const char*)(ws + WS_YCAT); S.B = (const char*)(ws + WS_WBR);
            if (SUB_EN(0)) { pg8::EpiBranch<0> E{(const f16*)(ws + WS_PX), (f16*)(ws + WS_MBUF)}; pg8::gemm_phase(F.lds, 2048, 2048, 8, S, E); }
            S.A = (const char*)(ws + WS_YCAT) + 512 * 2; S.B = (const char*)(ws + WS_WBR) + 512 * 2;
            if (SUB_EN(1)) { pg8::EpiBranch<1> E{(const f16*)(ws + WS_PX), (f16*)(ws + WS_MBUF)}; pg8::gemm_phase(F.lds, 2048, 2048, 8, S, E); }
            S.A = (const char*)(ws + WS_YCAT) + 1024 * 2; S.B = (const char*)(ws + WS_WBR) + 1024 * 2;
            if (SUB_EN(2)) { pg8::EpiBranch<2> E{(const f16*)(ws + WS_PX), (f16*)(ws + WS_MBUF)}; pg8::gemm_phase(F.lds, 2048, 2048, 16, S, E); }
        }
        SEAM(pb + 6);
        if (PH_EN(7) && IN(pb + 7)) {
            pg8::SchedPlain S; S.init(MT / 256, 8, F.G, F.bid); S.A = (const char*)(ws + WS_MBUF); S.B = (const char*)(ws + WS_WOUT); S.aTile = (size_t)256 * 2048 * 2; S.bTile = (size_t)256 * 2048 * 2;
            pg8::EpiResid E{(float*)(ws + WS_XRES), modl, 4096};
            pg8::gemm_phase(F.lds, 2048, 2048, 32, S, E);
        }
        SEAM(pb + 7);
        if (PH_EN(8) && IN(pb + 8)) { FRESH(); ph_norm(F, args, l, 1); }
        SEAM(pb + 8);
        if (PH_EN(9) && IN(pb + 9)) {
            pg8::SchedPlain S; S.init(MT / 256, UPLD / 256, F.G, F.bid); S.A = (const char*)(ws + WS_HN); S.B = (const char*)(ws + WS_WUP); S.aTile = (size_t)256 * 2048 * 2; S.bTile = (size_t)256 * 2048 * 2;
            pg8::EpiF16 E{(f16*)(ws + WS_PX), UPLD};
            pg8::gemm_phase(F.lds, 2048, 2048, 32, S, E);
        }
        SEAM(pb + 9);
        if (PH_EN(10) && IN(pb + 10)) { FRESH(); ph_ffn_act(F, args, l); }
        SEAM(pb + 10);
        if (PH_EN(11) && IN(pb + 11)) {
            pg8::SchedPlain S; S.init(MT / 256, 8, F.G, F.bid); S.A = (const char*)(ws + WS_ACT); S.B = (const char*)(ws + WS_WDN); S.aTile = (size_t)256 * FFH * 2; S.bTile = (size_t)256 * FFH * 2;
            pg8::EpiResid E{(float*)(ws + WS_XRES), modl, 10240};
            pg8::gemm_phase(F.lds, FFH, FFH, FFH / 64, S, E);
        }
        SEAM(pb + 11);
    }
    if (PH_EN(13) && IN(NPH - 1)) { FRESH(); ph_final_norm(F, args); }
#undef IN
#undef SEAM
#undef FRESH
}

extern "C" void kernel_launch(void* const* d_in, const int* in_sizes, int n_in, void* d_out, int out_size, void* d_ws, size_t ws_size, hipStream_t stream) {
    static int grid = 0;
    if (grid == 0) {
        if (n_in != 40 || out_size != MX * D || ws_size < WS_END) { fprintf(stderr, "kernel_launch: unexpected problem (n_in %d out %d ws %zu, need %zu)\n", n_in, out_size, ws_size, (size_t)WS_END); grid = -1; return; }
        int dev = 0, cus = 0, per_cu = 0;
        if (hipGetDevice(&dev) != hipSuccess || hipDeviceGetAttribute(&cus, hipDeviceAttributeMultiprocessorCount, dev) != hipSuccess) { grid = -1; return; }
        if (hipFuncSetAttribute((const void*)mk_fwd, hipFuncAttributeMaxDynamicSharedMemorySize, LDS_BYTES) != hipSuccess) { fprintf(stderr, "kernel_launch: hipFuncSetAttribute failed\n"); grid = -1; return; }
        if (hipOccupancyMaxActiveBlocksPerMultiprocessor(&per_cu, (const void*)mk_fwd, 512, LDS_BYTES) != hipSuccess || per_cu < 1)
            fprintf(stderr, "kernel_launch: occupancy query reports %d\n", per_cu);
        (void)hipGetLastError();
        grid = cus;
    }
    if (grid < 0) return;
    if (hipMemsetAsync((char*)d_ws + WS_CTL, 0, CTL_ZERO_BYTES, stream) != hipSuccess) return;
    Args a{};
    for (int i = 0; i < 40; ++i) a.in[i] = (const float*)d_in[i];
    a.out = (float*)d_out; a.ws = (unsigned char*)d_ws;
#if MK_ONE
    a.ph_lo = 0; a.ph_hi = NPH;
    hipLaunchKernelGGL(mk_fwd, dim3(grid), dim3(512), LDS_BYTES, stream, a);
#else
    for (int p = 0; p < NPH; ++p) { a.ph_lo = p; a.ph_hi = p + 1; hipLaunchKernelGGL(mk_fwd, dim3(grid), dim3(512), LDS_BYTES, stream, a); }
#endif
}
```

```cpp
#include <hip/hip_runtime.h>
#include <stdio.h>

#ifndef MK_ONE
#define MK_ONE 1
#define STAMP_MASK 0
#define STAMP_K 1
#endif

#define GAS __attribute__((address_space(1)))
#define LAS __attribute__((address_space(3)))
typedef _Float16 f16;
typedef _Float16 f16x8 __attribute__((ext_vector_type(8)));
typedef _Float16 f16x4 __attribute__((ext_vector_type(4)));
typedef _Float16 f16x2 __attribute__((ext_vector_type(2)));
typedef float f32x4 __attribute__((ext_vector_type(4)));
typedef float f32x2 __attribute__((ext_vector_type(2)));

constexpr int D = 2048, NB = 2, SEQ = 8192, LC = 256, DEPTH = 4;
constexpr int MX = NB * SEQ, MC = NB * LC, MT = MX + MC;
constexpr int PXLD = 11520, FFH = 5632, UPLD = 2 * FFH;
constexpr int P_S5 = 0, P_GK = 512, P_GV = 1024, P_GQ = 2048, P_GR = 2560, P_HY = 3584, P_MG = 5120, P_GG = 11264;
constexpr int INW = 11296;
constexpr int NCHK = 1056;
constexpr float S5SCALE = 1024.f;
constexpr float EPS = 1e-6f;
constexpr int NSC = 33;

constexpr size_t MiB = 1u << 20;
constexpr size_t WS_CTL = 0, CTL_ZERO_BYTES = 1 * MiB;
constexpr size_t WS_MOD = 1 * MiB;
constexpr size_t WS_TW = 2 * MiB;
constexpr size_t WS_S5AT = 3 * MiB;
constexpr size_t WS_WIN = 4 * MiB;
constexpr size_t WS_WGLU = WS_WIN + 45 * MiB;
constexpr size_t WS_WBR = WS_WGLU + 1 * MiB;
constexpr size_t WS_WOUT = WS_WBR + 8 * MiB;
constexpr size_t WS_WUP = WS_WOUT + 8 * MiB;
constexpr size_t WS_WDN = WS_WUP + 44 * MiB;
constexpr size_t WS_S5W = WS_WDN + 22 * MiB;
constexpr size_t WS_S5M = WS_S5W + 8 * MiB;
constexpr size_t WS_H2 = WS_S5M + 4 * MiB;
constexpr size_t WS_FSD = WS_H2 + 3 * MiB;
constexpr size_t FSD_C_OFF = (size_t)2 * 256 * 8193 * 16;
constexpr size_t WS_XRES = WS_FSD + 68 * MiB;
constexpr size_t WS_HN = WS_XRES + 132 * MiB;
constexpr size_t WS_PX = WS_HN + 66 * MiB;
constexpr size_t WS_S5A = WS_PX + 372 * MiB;
constexpr size_t WS_S5S = WS_S5A + 40 * MiB;
constexpr size_t WS_YAPRE = WS_S5S + 40 * MiB;
constexpr size_t WS_YCAT = WS_YAPRE + 20 * MiB;
constexpr size_t WS_MBUF = WS_YCAT + 66 * MiB;
constexpr size_t WS_GSLOC = WS_MBUF + 66 * MiB;
constexpr size_t WS_GSIN = WS_GSLOC + 66 * MiB;
constexpr size_t WS_GOF = WS_GSIN + 66 * MiB;
constexpr size_t WS_GDT = WS_GOF + 66 * MiB;
constexpr size_t WS_ACT = WS_GSLOC;
constexpr size_t WS_END = WS_GDT + 1 * MiB;
static_assert((size_t)MT * FFH * 2 <= 198 * MiB, "ACT overlay");
constexpr int CW_BAR = 4096;

constexpr int RING_BYTES = 131072;
constexpr int EXTRA_OFF = RING_BYTES, EXTRA_BYTES = 8192;
constexpr int LDSCTL_OFF = EXTRA_OFF + EXTRA_BYTES;
constexpr int LDS_BYTES = LDSCTL_OFF + 256;

__device__ __forceinline__ float wave_sum(float v) {
#pragma unroll
    for (int o = 1; o < 64; o <<= 1) v += __shfl_xor(v, o);
    return v;
}
__device__ __forceinline__ float sigmoidf_(float x) { return 1.0f / (1.0f + __expf(-x)); }
__device__ __forceinline__ float siluf_(float x) { return x * sigmoidf_(x); }
__device__ __forceinline__ float gelu_tanh_(float x) { const float u = 0.7978845608028654f * (x + 0.044715f * x * x * x); return x / (1.0f + __expf(-2.0f * u)); }
__device__ __forceinline__ float logsigmoidf_(float x) { return fminf(x, 0.f) - log1pf(expf(-fabsf(x))); }
__device__ __forceinline__ f32x2 cmul(f32x2 a, f32x2 b) { return (f32x2){a.x * b.x - a.y * b.y, a.x * b.y + a.y * b.x}; }
__device__ __forceinline__ f32x2 cconj(f32x2 a) { return (f32x2){a.x, -a.y}; }
__device__ __forceinline__ int opq(int x) { asm volatile("" : "+v"(x)); return x; }
#define LDS_WAIT() asm volatile("s_waitcnt lgkmcnt(0)" ::: "memory")
#define VM_WAIT() asm volatile("s_waitcnt vmcnt(0)" ::: "memory")

#define XB_TMO      128
#define XB_XCNT(j)  (256  + 64 * (j))
#define XB_XSUB(j)  (1280 + 64 * (j))
#define XB_XGEN(j)  (2304 + 64 * (j))
#define XB_TOP      3328
#define XB_TOPGEN   3392
#define XCD_BAR_WORDS 3456
#define XB_SPIN_CAP (1u << 18)
__device__ __forceinline__ unsigned xb_ld(unsigned* p)              { return __hip_atomic_load(p, __ATOMIC_RELAXED, __HIP_MEMORY_SCOPE_AGENT); }
__device__ __forceinline__ unsigned xb_add(unsigned* p, unsigned v) { return __hip_atomic_fetch_add(p, v, __ATOMIC_RELAXED, __HIP_MEMORY_SCOPE_AGENT); }
__device__ __forceinline__ unsigned xb_xcc_id() { return (unsigned)__builtin_amdgcn_s_getreg((3 << 11) | 20) & 0xFu; }
#define XB_SPIN(cond, bar) do { unsigned _sp = 0; while (cond) { __builtin_amdgcn_s_sleep(1); \
    if ((++_sp & 255u) == 0u) { if (xb_ld(&(bar)[XB_TMO])) break; if (_sp > XB_SPIN_CAP) { atomicAdd(&(bar)[XB_TMO], 1u); break; } } } } while (0)
struct XcdBarrier { unsigned* bar; unsigned x; volatile LAS unsigned* st; };
__device__ __forceinline__ XcdBarrier xcd_barrier_post(unsigned* bar, volatile LAS unsigned* st) {
    XcdBarrier b; b.bar = bar; b.x = xb_xcc_id(); b.st = st;
    if (threadIdx.x == 0) (void)xb_add(&bar[XB_XCNT(b.x)], 1u);
    return b;
}
__device__ __forceinline__ void xcd_barrier_complete(unsigned* bar, unsigned x, unsigned& nloc, unsigned& nx) {
    const unsigned G = gridDim.x * gridDim.y * gridDim.z;
    unsigned sum, cnt, mine, sp = 0u;
    for (;;) {
        sum = 0u; cnt = 0u; mine = 0u;
#pragma unroll
        for (unsigned j = 0; j < 16; ++j) { const unsigned c = xb_ld(&bar[XB_XCNT(j)]); sum += c; cnt += (c > 0u) ? 1u : 0u; mine = (j == x) ? c : mine; }
        if (sum == G) break;
        __builtin_amdgcn_s_sleep(1);
        if ((++sp & 255u) == 0u) { if (xb_ld(&bar[XB_TMO])) break; if (sp > XB_SPIN_CAP) { atomicAdd(&bar[XB_TMO], 1u); break; } }
    }
    nloc = mine > 0u ? mine : 1u; nx = cnt > 0u ? cnt : 1u;
}
__device__ __forceinline__ void xcd_barrier(const XcdBarrier& b) {
    asm volatile("s_waitcnt vmcnt(0)" ::: "memory");
    __syncthreads();
    if (threadIdx.x == 0) {
        unsigned* bar = b.bar;
        __builtin_amdgcn_s_waitcnt(0);
        unsigned nloc = b.st[0], nx = b.st[1];
        if (nloc == 0u) { xcd_barrier_complete(bar, b.x, nloc, nx); b.st[0] = nloc; b.st[1] = nx; }
        const unsigned old = xb_add(&bar[XB_XSUB(b.x)], 1u);
        const unsigned gen = old / nloc;
        if (old + 1u == (gen + 1u) * nloc) {
            __builtin_amdgcn_fence(__ATOMIC_RELEASE, "agent");
            asm volatile("s_waitcnt vmcnt(0)" ::: "memory");
            const unsigned og = xb_add(&bar[XB_TOP], 1u);
            const unsigned tg = og / nx;
            if (og + 1u == (tg + 1u) * nx) xb_add(&bar[XB_TOPGEN], 1u);
            else XB_SPIN(xb_ld(&bar[XB_TOPGEN]) == tg, bar);
            __builtin_amdgcn_fence(__ATOMIC_ACQUIRE, "agent");
            xb_add(&bar[XB_XGEN(b.x)], 1u);
            asm volatile("s_waitcnt vmcnt(0)" ::: "memory");
        } else {
            XB_SPIN(xb_ld(&bar[XB_XGEN(b.x)]) == gen, bar);
            __builtin_amdgcn_fence(__ATOMIC_ACQUIRE, "agent");
            asm volatile("s_waitcnt vmcnt(0)" ::: "memory");
        }
    }
    __syncthreads();
}

struct Args {
    const float* in[40];
    float* out; unsigned char* ws;
    int ph_lo, ph_hi;
};
struct Ctx {
    LAS unsigned char* lds;
    int tid, lane, wave, G, bid;
    unsigned char* ws;
};
enum { I_X = 0, I_C, I_CTX, I_CCTX, I_WMOD, I_BMOD, I_N1G, I_N2G, I_WIN, I_S5ARE, I_S5AIM, I_S5STEP, I_S5BRE, I_S5BIM, I_S5CRE, I_S5CIM,
       I_S5D, I_GLUW, I_GLUB, I_HYCW, I_HYCB, I_HYW1, I_HYB1, I_HYF1, I_HYW2, I_HYB2, I_HYF2, I_HYW3, I_HYB3, I_HYBIAS,
       I_GLAWG, I_GLABG, I_GLANG, I_WBR, I_WOUT, I_WUP, I_FFCW, I_FFCB, I_WDN, I_FNG };

namespace pg8 {
constexpr int BM = 256, BK = 64, HALF = 128, HTB = HALF * BK * 2, STAGE_BYTES = 8 * HTB, NXCD = 8, WGM = 8;
__device__ __forceinline__ int lds_byte(int r, int c) { const int st = (r >> 4) * 2 + (c >> 5), rr = r & 15, cc = c & 31, ob = rr * 64 + cc * 2; return st * 1024 + (ob ^ (((ob >> 9) & 1) << 5)); }
__device__ __forceinline__ void stage_rc(int b, int& R, int& C) { const int st = b / 1024, sb = b % 1024, swz = sb ^ (((sb >> 9) & 1) << 5); R = (st >> 1) * 16 + swz / 64; C = (st & 1) * 32 + (swz % 64) / 2; }
__device__ __forceinline__ int perm32(int rho) { const int n = rho >> 4, i = rho & 15; return 8 * (i >> 2) + 4 * n + (i & 3); }
struct Unit { const char* a; const char* b; int pm, pn; };
struct Order2D {
    int nM, nN, nwg, G, c;
    __device__ __forceinline__ void init(int nM_, int nN_, int G_, int c_) { nM = nM_; nN = nN_; nwg = nM * nN; G = G_; c = c_; }
    __device__ __forceinline__ bool nx(int i, int& pm, int& pn) const {
        const long L = (long)i * G + c; if (L >= nwg) return false;
        int wgid = (int)L; { const int q = nwg / NXCD, r = nwg % NXCD, xcd = wgid % NXCD, off = wgid / NXCD; wgid = (xcd < r ? xcd * (q + 1) : r * (q + 1) + (xcd - r) * q) + off; }
        const int nig = WGM * nN, gid = wgid / nig, fm = gid * WGM, gsz = (nM - fm) < WGM ? (nM - fm) : WGM;
        pm = fm + ((wgid % nig) % gsz); pn = (wgid % nig) / gsz; return true;
    }
};
struct SchedPlain : Order2D {
    const char* A; const char* B; size_t aTile, bTile;
    __device__ __forceinline__ bool next(int i, Unit& u) const { int pm, pn; if (!nx(i, pm, pn)) return false; u.pm = pm; u.pn = pn; u.a = A + (size_t)pm * aTile; u.b = B + (size_t)pn * bTile; return true; }
};
struct SchedS5 {
    const char* A; const char* B; size_t bGroup; int G, c;
    __device__ __forceinline__ bool next(int i, Unit& u) const { const int L = i * G + c; if (L >= 160) return false; const int g = L & 31, pm = L >> 5;
        u.pm = pm; u.pn = g; u.a = A + ((size_t)pm * 256 * 16384 + (size_t)g * 512) * 2; u.b = B + (size_t)g * bGroup; return true; }
};

#define PG8_SA(b, h) (((b) * 2 + (h)) * HTB)
#define PG8_SB(b, h) ((4 + (b) * 2 + (h)) * HTB)
#define PG8_STAGE(bufoff, gbase, voff) do { _Pragma("unroll") for (int _i = 0; _i < 2; ++_i) \
        __builtin_amdgcn_global_load_lds((const unsigned*)((const char*)(gbase) + (voff)[_i]), (LAS unsigned*)(lds + (bufoff) + ldsw + _i * 8192), 16, 0, 0); } while (0)
#define PG8_LDA(dst, b, h) do { _Pragma("unroll") for (int m = 0; m < 4; ++m) _Pragma("unroll") for (int k = 0; k < 2; ++k) dst[m][k] = *(const LAS f16x8*)(lds + PG8_SA(b, h) + aoff + m * 2048 + k * 1024); } while (0)
#define PG8_LDB(dst, b, h) do { _Pragma("unroll") for (int n = 0; n < 2; ++n) _Pragma("unroll") for (int k = 0; k < 2; ++k) dst[n][k] = *(const LAS f16x8*)(lds + PG8_SB(b, h) + boff + n * 2048 + k * 1024); } while (0)
#define PG8_MMA(ai, bj, At, Bt) do { __builtin_amdgcn_s_setprio(1); _Pragma("unroll") for (int m = 0; m < 4; ++m) _Pragma("unroll") for (int n = 0; n < 2; ++n) _Pragma("unroll") for (int k = 0; k < 2; ++k) \
        acc[ai][bj][m][n] = __builtin_amdgcn_mfma_f32_16x16x32_f16(Bt[n][k], At[m][k], acc[ai][bj][m][n], 0, 0, 0); __builtin_amdgcn_s_setprio(0); } while (0)
#define PG8_WAIT_V(n) asm volatile("s_waitcnt vmcnt(" #n ")" ::: "memory")
#define PG8_WAIT_L(n) asm volatile("s_waitcnt lgkmcnt(" #n ")" ::: "memory")
#define PG8_BAR __builtin_amdgcn_s_barrier()
#define PG8_SCHED __builtin_amdgcn_sched_barrier(0)

template <class Epi, class Sched>
__device__ __forceinline__ void gemm_phase(LAS unsigned char* lds, const int lda, const int ldb, const int nt, const Sched& S, const Epi& E) {
    const int tid = opq((int)threadIdx.x), wid = __builtin_amdgcn_readfirstlane(tid >> 6), lane = tid & 63, wr = wid >> 2, wc = wid & 3, fr = lane & 15, fq = lane >> 4;
    unsigned voffA[2], voffB[2];
#pragma unroll
    for (int i = 0; i < 2; ++i) { int R, C; stage_rc(tid * 16 + i * 8192, R, C); const int Rb = Epi::PERM ? ((R & ~31) + perm32(R & 31)) : R;
        voffA[i] = (unsigned)(R * lda + C) * 2u; voffB[i] = (unsigned)(Rb * ldb + C) * 2u; }
    const size_t kstep = (size_t)(BK * 2);
    const size_t hstepA = (size_t)HALF * lda * 2, hstepB = (size_t)HALF * ldb * 2;
    const unsigned ldsw = (unsigned)wid * 1024u;
    const int aoff = lds_byte(wr * 64 + fr, fq * 8), boff = lds_byte(wc * 32 + fr, fq * 8);
    Unit cur, nxt; int ui = 0;
    if (!S.next(0, cur)) return;
    f32x4 acc[2][2][4][2];
#pragma unroll
    for (int a = 0; a < 2; ++a)
#pragma unroll
        for (int b = 0; b < 2; ++b)
#pragma unroll
            for (int m = 0; m < 4; ++m)
#pragma unroll
                for (int n = 0; n < 2; ++n) acc[a][b][m][n] = (f32x4){0.f, 0.f, 0.f, 0.f};
    f16x8 At[4][2], B0[2][2], B1[2][2];
    const char* cA = cur.a; const char* cB = cur.b;
    PG8_STAGE(PG8_SB(0, 0), cB, voffB); PG8_STAGE(PG8_SA(0, 0), cA, voffA); PG8_STAGE(PG8_SB(0, 1), cB + hstepB, voffB); PG8_STAGE(PG8_SA(0, 1), cA + hstepA, voffA);
    if (wr == 1) PG8_BAR;
    PG8_WAIT_V(4); PG8_BAR;
    PG8_STAGE(PG8_SB(1, 0), cB + kstep, voffB); PG8_STAGE(PG8_SA(1, 0), cA + kstep, voffA); PG8_STAGE(PG8_SB(1, 1), cB + hstepB + kstep, voffB);
    PG8_WAIT_V(6); PG8_BAR;
    for (;;) {
        const bool has_next = S.next(ui + 1, nxt);
        const char* nA = has_next ? nxt.a : cA; const char* nB = has_next ? nxt.b : cB;
        for (int t = 0; t < nt; t += 2) {
            const bool last = (t == nt - 2);
            const char* a1 = cA + (size_t)(t + 1) * kstep;
            const char* a2 = last ? nA : cA + (size_t)(t + 2) * kstep; const char* b2 = last ? nB : cB + (size_t)(t + 2) * kstep;
            const char* a3 = a2 + kstep; const char* b3 = b2 + kstep;
            PG8_LDB(B0, 0, 0); PG8_SCHED; PG8_LDA(At, 0, 0); PG8_STAGE(PG8_SA(1, 1), a1 + hstepA, voffA);
            PG8_WAIT_L(8); PG8_BAR; PG8_WAIT_L(0); PG8_MMA(0, 0, At, B0); PG8_BAR; PG8_SCHED;
            PG8_LDB(B1, 0, 1); PG8_STAGE(PG8_SB(0, 0), b2, voffB);
            PG8_BAR; PG8_WAIT_L(0); PG8_MMA(0, 1, At, B1); PG8_BAR;
            PG8_LDA(At, 0, 1); PG8_STAGE(PG8_SA(0, 0), a2, voffA);
            PG8_BAR; PG8_WAIT_L(0); PG8_MMA(1, 0, At, B0); PG8_BAR; PG8_SCHED;
            PG8_STAGE(PG8_SB(0, 1), b2 + hstepB, voffB);
            PG8_WAIT_V(6); PG8_BAR; PG8_MMA(1, 1, At, B1); PG8_BAR;
            PG8_LDB(B0, 1, 0); PG8_SCHED; PG8_LDA(At, 1, 0); PG8_STAGE(PG8_SA(0, 1), a2 + hstepA, voffA);
            PG8_WAIT_L(8); PG8_BAR; PG8_WAIT_L(0); PG8_MMA(0, 0, At, B0); PG8_BAR; PG8_SCHED;
            PG8_LDB(B1, 1, 1); PG8_STAGE(PG8_SB(1, 0), b3, voffB);
            PG8_BAR; PG8_WAIT_L(0); PG8_MMA(0, 1, At, B1); PG8_BAR;
            PG8_LDA(At, 1, 1); PG8_STAGE(PG8_SA(1, 0), a3, voffA);
            PG8_BAR; PG8_WAIT_L(0); PG8_MMA(1, 0, At, B0); PG8_BAR; PG8_SCHED;
            PG8_STAGE(PG8_SB(1, 1), b3 + hstepB, voffB);
            PG8_WAIT_V(6); PG8_BAR; PG8_MMA(1, 1, At, B1); PG8_BAR;
        }
        E(acc, cur, wr, wc, fr, fq);
        if (!has_next) break;
#pragma unroll
        for (int a = 0; a < 2; ++a)
#pragma unroll
            for (int b = 0; b < 2; ++b)
#pragma unroll
                for (int m = 0; m < 4; ++m)
#pragma unroll
                    for (int n = 0; n < 2; ++n) acc[a][b][m][n] = (f32x4){0.f, 0.f, 0.f, 0.f};
        cur = nxt; cA = nA; cB = nB; ++ui;
    }
    PG8_WAIT_V(0);
    if (wr == 0) PG8_BAR;
    PG8_BAR;
}
#undef PG8_SA
#undef PG8_SB
#undef PG8_STAGE
#undef PG8_LDA
#undef PG8_LDB
#undef PG8_MMA
#undef PG8_WAIT_V
#undef PG8_WAIT_L
#undef PG8_BAR
#undef PG8_SCHED

typedef const f32x4 (&AccRef)[2][2][4][2];
__device__ __forceinline__ f16x8 pack8(f32x4 a, f32x4 b) { f16x8 w; w[0] = (f16)a[0]; w[1] = (f16)a[1]; w[2] = (f16)a[2]; w[3] = (f16)a[3]; w[4] = (f16)b[0]; w[5] = (f16)b[1]; w[6] = (f16)b[2]; w[7] = (f16)b[3]; return w; }

struct EpiPx {
    static constexpr bool PERM = true; f16* PX; f16* S5A;
    __device__ __forceinline__ void operator()(AccRef acc, const Unit& u, int wr, int wc, int fr, int fq) const { fr = opq(fr); fq = opq(fq);
        const int row0 = u.pm * BM + wr * 64 + fr, col0 = u.pn * BM + wc * 32 + 8 * fq;
#pragma unroll
        for (int ai = 0; ai < 2; ++ai)
#pragma unroll
            for (int m = 0; m < 4; ++m) { const int row = row0 + ai * HALF + m * 16;
#pragma unroll
                for (int bj = 0; bj < 2; ++bj) { const int c = col0 + bj * HALF; const f16x8 w = pack8(acc[ai][bj][m][0], acc[ai][bj][m][1]);
                    if (u.pn < 2) *(f16x8*)(S5A + (size_t)(row >> 4) * 16384 + (size_t)(c >> 4) * 512 + (row & 15) * 16 + (c & 15)) = w;
                    else *(f16x8*)(PX + (size_t)row * PXLD + c) = w; } }
    }
};
struct EpiF16 {
    static constexpr bool PERM = true; f16* O; int ldc;
    __device__ __forceinline__ void operator()(AccRef acc, const Unit& u, int wr, int wc, int fr, int fq) const { fr = opq(fr); fq = opq(fq);
        const int row0 = u.pm * BM + wr * 64 + fr, col0 = u.pn * BM + wc * 32 + 8 * fq;
#pragma unroll
        for (int ai = 0; ai < 2; ++ai)
#pragma unroll
            for (int m = 0; m < 4; ++m) { f16* rowp = O + (size_t)(row0 + ai * HALF + m * 16) * ldc + col0;
#pragma unroll
                for (int bj = 0; bj < 2; ++bj) *(f16x8*)(rowp + bj * HALF) = pack8(acc[ai][bj][m][0], acc[ai][bj][m][1]); }
    }
};
struct EpiS5In {
    static constexpr bool PERM = false; float* S;
    __device__ __forceinline__ void operator()(AccRef acc, const Unit& u, int wr, int wc, int fr, int fq) const { fr = opq(fr); fq = opq(fq);
        const int row0 = u.pm * BM + wr * 64 + fr, col0 = wc * 32 + 4 * fq, g = u.pn;
#pragma unroll
        for (int ai = 0; ai < 2; ++ai)
#pragma unroll
            for (int m = 0; m < 4; ++m) { const int row = row0 + ai * HALF + m * 16; { float* rowp = S + ((size_t)row * 32 + g) * 256 + col0;
#pragma unroll
                for (int bj = 0; bj < 2; ++bj)
#pragma unroll
                    for (int n = 0; n < 2; ++n) *(f32x4*)(rowp + bj * HALF + n * 16) = acc[ai][bj][m][n]; } }
    }
};
struct EpiS5Out {
    static constexpr bool PERM = true; const f16* S5A; f16* Y; const float* dvec;
    __device__ __forceinline__ void operator()(AccRef acc, const Unit& u, int wr, int wc, int fr, int fq) const { fr = opq(fr); fq = opq(fq);
        const int row0 = u.pm * BM + wr * 64 + fr, col0 = wc * 32 + 8 * fq, g = u.pn;
#pragma unroll
        for (int ai = 0; ai < 2; ++ai)
#pragma unroll
            for (int m = 0; m < 4; ++m) { const int chunk = row0 + ai * HALF + m * 16; {
#pragma unroll
                for (int bj = 0; bj < 2; ++bj) { const int c = col0 + bj * HALF, t = c >> 4, h0 = c & 15;
                    const f16x8 uu = *(const f16x8*)(S5A + (size_t)chunk * 16384 + (size_t)g * 512 + c);
                    const f32x4 d0 = *(const f32x4*)(dvec + g * 16 + h0), d1 = *(const f32x4*)(dvec + g * 16 + h0 + 4);
                    f16x8 w;
#pragma unroll
                    for (int j = 0; j < 4; ++j) { w[j] = (f16)gelu_tanh_(acc[ai][bj][m][0][j] * (1.0f / S5SCALE) + d0[j] * (float)uu[j]);
                                                  w[4 + j] = (f16)gelu_tanh_(acc[ai][bj][m][1][j] * (1.0f / S5SCALE) + d1[j] * (float)uu[4 + j]); }
                    *(f16x8*)(Y + (size_t)(chunk * 16 + t) * 512 + g * 16 + h0) = w; } asm volatile("" ::: "memory"); } }
    }
};
struct EpiGlu {
    static constexpr bool PERM = true; const f16* YP; f16* O; const float* bias;
    __device__ __forceinline__ void operator()(AccRef acc, const Unit& u, int wr, int wc, int fr, int fq) const { fr = opq(fr); fq = opq(fq);
        const int row0 = u.pm * BM + wr * 64 + fr, col0 = u.pn * BM + wc * 32 + 8 * fq;
#pragma unroll
        for (int ai = 0; ai < 2; ++ai)
#pragma unroll
            for (int m = 0; m < 4; ++m) { const int row = row0 + ai * HALF + m * 16;
#pragma unroll
                for (int bj = 0; bj < 2; ++bj) { const int c = col0 + bj * HALF;
                    const f16x8 yp = *(const f16x8*)(YP + (size_t)row * 512 + c);
                    const f32x4 b0 = *(const f32x4*)(bias + c), b1 = *(const f32x4*)(bias + c + 4);
                    f16x8 w;
#pragma unroll
                    for (int j = 0; j < 4; ++j) { w[j] = (f16)((float)yp[j] * sigmoidf_(acc[ai][bj][m][0][j] + b0[j])); w[4 + j] = (f16)((float)yp[4 + j] * sigmoidf_(acc[ai][bj][m][1][j] + b1[j])); }
                    *(f16x8*)(O + (size_t)row * 2048 + c) = w; } asm volatile("" ::: "memory"); }
    }
};
template <int BR> struct EpiBranch {
    static constexpr bool PERM = true; const f16* PX; f16* M;
    __device__ __forceinline__ void operator()(AccRef acc, const Unit& u, int wr, int wc, int fr, int fq) const { fr = opq(fr); fq = opq(fq);
        const int row0 = u.pm * BM + wr * 64 + fr, col0 = u.pn * BM + wc * 32 + 8 * fq;
#pragma unroll
        for (int ai = 0; ai < 2; ++ai)
#pragma unroll
            for (int m = 0; m < 4; ++m) { const int row = row0 + ai * HALF + m * 16;
#pragma unroll
                for (int bj = 0; bj < 2; ++bj) { const int c = col0 + bj * HALF;
                    const f16x8 gl = *(const f16x8*)(PX + (size_t)row * PXLD + P_MG + BR * 2048 + c);
                    f16* mp = M + (size_t)row * 2048 + c;
                    f16x8 prev; if (BR > 0) prev = *(const f16x8*)mp;
                    f16x8 w;
#pragma unroll
                    for (int j = 0; j < 4; ++j) { float v0 = sigmoidf_((float)gl[j]) * acc[ai][bj][m][0][j], v1 = sigmoidf_((float)gl[4 + j]) * acc[ai][bj][m][1][j];
                        if (BR > 0) { v0 += (float)prev[j]; v1 += (float)prev[4 + j]; } w[j] = (f16)v0; w[4 + j] = (f16)v1; }
                    *(f16x8*)mp = w; } asm volatile("" ::: "memory"); }
    }
};
struct EpiResid {
    static constexpr bool PERM = false; float* X; const float* mod; int goff;
    __device__ __forceinline__ void operator()(AccRef acc, const Unit& u, int wr, int wc, int fr, int fq) const { fr = opq(fr); fq = opq(fq);
        const int row0 = u.pm * BM + wr * 64 + fr, col0 = u.pn * BM + wc * 32 + 4 * fq;
        const int bsel = u.pm < 32 ? 0 : (u.pm < 64 ? 1 : 2);
        const float* gp = mod + bsel * 12288 + goff + col0;
        f32x4 gv[2][2];
#pragma unroll
        for (int bj = 0; bj < 2; ++bj)
#pragma unroll
            for (int n = 0; n < 2; ++n) gv[bj][n] = *(const f32x4*)(gp + bj * HALF + n * 16);
#pragma unroll
        for (int ai = 0; ai < 2; ++ai)
#pragma unroll
            for (int m = 0; m < 4; ++m) { float* rowp = X + (size_t)(row0 + ai * HALF + m * 16) * D + col0;
#pragma unroll
                for (int bj = 0; bj < 2; ++bj)
#pragma unroll
                    for (int n = 0; n < 2; ++n) { f32x4* p = (f32x4*)(rowp + bj * HALF + n * 16); *p = *p + gv[bj][n] * acc[ai][bj][m][n]; } asm volatile("" ::: "memory"); }
    }
};
}


__device__ __forceinline__ void ph_prologue(const Ctx& F, const Args& A) {
    const int gt = F.bid * 512 + F.tid, NT = F.G * 512;
    { const f32x4* xs = (const f32x4*)A.in[I_X]; const f32x4* cs = (const f32x4*)A.in[I_CTX]; f32x4* xr = (f32x4*)(F.ws + WS_XRES);
      for (int i = gt; i < MX * D / 4; i += NT) xr[i] = xs[i];
      for (int i = gt; i < MC * D / 4; i += NT) xr[MX * D / 4 + i] = cs[i]; }
    { f32x2* tw = (f32x2*)(F.ws + WS_TW);
      for (int k = gt; k < 16384; k += NT) { float s, c; sincospif((float)k * (2.0f / 16384.0f), &s, &c); tw[k] = (f32x2){c, -s}; } }
    LAS float* sc = (LAS float*)F.lds;
    LAS float* red = (LAS float*)(F.lds + 3 * 2048 * 4);
    for (int i = F.tid; i < 3 * 2048; i += 512) { const int r = i / 2048, k = i % 2048; const float v = r < 2 ? A.in[I_C][r * 2048 + k] : A.in[I_CCTX][k]; sc[i] = siluf_(v); }
    __syncthreads();
    const int col = F.tid & 63, ks = F.tid >> 6;
    for (int chunk = F.bid; chunk < DEPTH * 192; chunk += F.G) {
        const int l = chunk / 192, n0 = (chunk % 192) * 64;
        const float* w = A.in[I_WMOD] + (size_t)l * 2048 * 12288 + n0 + col;
        float s0 = 0.f, s1 = 0.f, s2 = 0.f;
#pragma unroll 8
        for (int k = ks * 256; k < ks * 256 + 256; ++k) { const float wv = w[(size_t)k * 12288]; s0 += sc[k] * wv; s1 += sc[2048 + k] * wv; s2 += sc[4096 + k] * wv; }
        red[(ks * 3 + 0) * 64 + col] = s0; red[(ks * 3 + 1) * 64 + col] = s1; red[(ks * 3 + 2) * 64 + col] = s2;
        __syncthreads();
        if (F.tid < 192) { const int r = F.tid >> 6, c2 = F.tid & 63; float s = 0.f;
#pragma unroll
            for (int q = 0; q < 8; ++q) s += red[(q * 3 + r) * 64 + c2];
            ((float*)(F.ws + WS_MOD))[((size_t)l * 3 + r) * 12288 + n0 + c2] = s + A.in[I_BMOD][(size_t)l * 12288 + n0 + c2]; }
        __syncthreads();
    }
}

__device__ __forceinline__ void transpose_item(const float* W, int ldw, int k0, int srccol0, f16* WT, int dstrow0, int ldk, LAS float* scr, int lane) {
#pragma unroll 8
    for (int i = 0; i < 32; ++i) { const int kk = 2 * i + (lane >> 5); scr[kk * 33 + (lane & 31)] = srccol0 >= 0 ? W[(size_t)(k0 + kk) * ldw + srccol0 + (lane & 31)] : 0.f; }
    LDS_WAIT(); asm volatile("" ::: "memory");
    const int c = lane & 7;
#pragma unroll
    for (int j = 0; j < 4; ++j) { const int n = (lane >> 3) + 8 * j; const LAS float* s = scr + (8 * c) * 33 + n;
        f16x8 o;
#pragma unroll
        for (int e = 0; e < 8; ++e) o[e] = (f16)s[e * 33];
        *(f16x8*)(WT + (size_t)(dstrow0 + n) * ldk + k0 + 8 * c) = o; }
    LDS_WAIT(); asm volatile("" ::: "memory");
}
__device__ __forceinline__ void ph_convert_weights(const Ctx& F, const Args& A, int l) {
    LAS float* scr = (LAS float*)(F.lds + F.wave * 16384);
    const int gw = F.bid * 8 + F.wave, NGW = F.G * 8;
    constexpr int I_IN = 32 * 360, I_GLU = 8 * 16, I_BR = 32 * 64, I_OUT = 32 * 64, I_UP = 32 * 352, I_DN = 88 * 64;
    constexpr int NIT = I_IN + I_GLU + I_BR + I_OUT + I_UP + I_DN;
    for (int it = gw; it < NIT; it += NGW) {
        int r = it;
        if (r < I_IN) { const int kb = r / 360, nb = r % 360, j0 = nb * 32;
            const int src = j0 < 2048 ? j0 : (j0 < 11264 ? j0 + 32 : (j0 < 11296 ? 2048 + (j0 - 11264) : -1));
            transpose_item(A.in[I_WIN] + (size_t)l * 2048 * INW, INW, kb * 64, src, (f16*)(F.ws + WS_WIN), j0, 2048, scr, F.lane); continue; } r -= I_IN;
        if (r < I_GLU) { const int kb = r / 16, nb = r % 16; transpose_item(A.in[I_GLUW] + (size_t)l * 512 * 512, 512, kb * 64, nb * 32, (f16*)(F.ws + WS_WGLU), nb * 32, 512, scr, F.lane); continue; } r -= I_GLU;
        if (r < I_BR) { const int kb = r / 64, nb = r % 64; transpose_item(A.in[I_WBR] + (size_t)l * 2048 * 2048, 2048, kb * 64, nb * 32, (f16*)(F.ws + WS_WBR), nb * 32, 2048, scr, F.lane); continue; } r -= I_BR;
        if (r < I_OUT) { const int kb = r / 64, nb = r % 64; transpose_item(A.in[I_WOUT] + (size_t)l * 2048 * 2048, 2048, kb * 64, nb * 32, (f16*)(F.ws + WS_WOUT), nb * 32, 2048, scr, F.lane); continue; } r -= I_OUT;
        if (r < I_UP) { const int kb = r / 352, nb = r % 352; transpose_item(A.in[I_WUP] + (size_t)l * 2048 * UPLD, UPLD, kb * 64, nb * 32, (f16*)(F.ws + WS_WUP), nb * 32, 2048, scr, F.lane); continue; } r -= I_UP;
        { const int kb = r / 64, nb = r % 64; transpose_item(A.in[I_WDN] + (size_t)l * FFH * 2048, 2048, kb * 64, nb * 32, (f16*)(F.ws + WS_WDN), nb * 32, FFH, scr, F.lane); }
    }
}

__device__ __forceinline__ void s5_mats_group(const Ctx& F, const Args& A, int l, int g) {
    LAS f32x2* APOW = (LAS f32x2*)F.lds;
    LAS f32x2* BBAR = APOW + 2 * 17 * 64;
    LAS f32x2* CM = BBAR + 2 * 64 * 16;
    LAS float* KLAG = (LAS float*)(CM + 2 * 16 * 64);
    __syncthreads();
    for (int i = F.tid; i < 2 * 17 * 64; i += 512) { const int d = i / (17 * 64), e = (i / 64) % 17, n = i % 64;
        const size_t pi = (((size_t)l * 2 + d) * 32 + g) * 64 + n;
        const float are = A.in[I_S5ARE][pi], aim = A.in[I_S5AIM][pi], dt = expf(A.in[I_S5STEP][((size_t)l * 2 + d) * 32 + g]);
        const float zr = are * dt * (float)e, zi = aim * dt * (float)e; float s, c; sincosf(zi, &s, &c); const float m = expf(zr);
        APOW[i] = (f32x2){m * c, m * s}; }
    __syncthreads();
    for (int i = F.tid; i < 2 * 64 * 16; i += 512) { const int d = i / 1024, n = (i / 16) % 64, h = i % 16;
        const size_t pi = (((size_t)l * 2 + d) * 32 + g) * 64 + n;
        const float are = A.in[I_S5ARE][pi], aim = A.in[I_S5AIM][pi];
        const f32x2 ab = APOW[(d * 17 + 1) * 64 + n]; const f32x2 num = (f32x2){ab.x - 1.0f, ab.y};
        const float den = are * are + aim * aim; const f32x2 q = (f32x2){(num.x * are + num.y * aim) / den, (num.y * are - num.x * aim) / den};
        const size_t bi = (pi * 16) + h;
        BBAR[i] = cmul(q, (f32x2){A.in[I_S5BRE][bi], A.in[I_S5BIM][bi]});
        const size_t ci = ((((size_t)l * 2 + d) * 32 + g) * 16 + h) * 64 + n;
        CM[(d * 16 + h) * 64 + n] = (f32x2){A.in[I_S5CRE][ci], A.in[I_S5CIM][ci]}; }
    __syncthreads();
    for (int i = F.tid; i < 2 * 16 * 256; i += 512) { const int d = i / 4096, lag = (i / 256) % 16, h = (i / 16) % 16, hp = i % 16; float s = 0.f;
        for (int n = 0; n < 64; ++n) { const f32x2 t = cmul(CM[(d * 16 + h) * 64 + n], APOW[(d * 17 + lag) * 64 + n]); const f32x2 b = BBAR[(d * 64 + n) * 16 + hp]; s += t.x * b.x - t.y * b.y; }
        KLAG[i] = s; }
    __syncthreads();
    f16* W = (f16*)(F.ws + WS_S5W) + (size_t)g * 256 * 512;
    for (int i = F.tid; i < 256 * 64; i += 512) { const int n = i / 64, k8 = (i % 64) * 8, t = n >> 4, h = n & 15; f16x8 o;
#pragma unroll
        for (int e = 0; e < 8; ++e) { const int k = k8 + e; float v;
            if (k < 256) { const int s = k >> 4, hp = k & 15; v = 0.f;
                if (t >= s) v += KLAG[((0 * 16 + (t - s)) * 16 + h) * 16 + hp];
                if (s >= t) v += KLAG[((1 * 16 + (s - t)) * 16 + h) * 16 + hp];
                v *= S5SCALE; }
            else { const int d = (k - 256) >> 7, nn2 = (k - 256) & 127, nn = nn2 & 63, im = nn2 >> 6, ex = d == 0 ? t + 1 : 16 - t;
                const f32x2 z = cmul(CM[(d * 16 + h) * 64 + nn], APOW[(d * 17 + ex) * 64 + nn]); v = im ? -z.y : z.x; }
            o[e] = (f16)v; }
        *(f16x8*)(W + (size_t)n * 512 + k8) = o; }
    f16* Mx = (f16*)(F.ws + WS_S5M) + (size_t)g * 256 * 256;
    for (int i = F.tid; i < 256 * 32; i += 512) { const int n = i / 32, k8 = (i % 32) * 8, d = n >> 7, ri = (n >> 6) & 1, nn = n & 63; f16x8 o;
#pragma unroll
        for (int e = 0; e < 8; ++e) { const int k = k8 + e, s = k >> 4, hp = k & 15, ex = d == 0 ? 15 - s : s;
            const f32x2 z = cmul(APOW[(d * 17 + ex) * 64 + nn], BBAR[(d * 64 + nn) * 16 + hp]); o[e] = (f16)((ri ? z.y : z.x) * S5SCALE); }
        *(f16x8*)(Mx + (size_t)n * 256 + k8) = o; }
    if (F.tid < 128) { const int d = F.tid >> 6, nn = F.tid & 63; ((f32x2*)(F.ws + WS_S5AT))[(d * 32 + g) * 64 + nn] = APOW[(d * 17 + 16) * 64 + nn]; }
    __syncthreads();
}

__device__ __forceinline__ void ph_hyena_h2(const Ctx& F, const Args& A, int l) {
    LAS float* W1 = (LAS float*)F.lds;
    LAS float* W2 = W1 + 33 * 64;
    LAS float* PV = W2 + 64 * 64;
    LAS float* SCR = PV + 256;
    __syncthreads();
    for (int i = F.tid; i < 33 * 64; i += 512) W1[i] = A.in[I_HYW1][(size_t)l * 33 * 64 + i];
    for (int i = F.tid; i < 64 * 64; i += 512) W2[i] = A.in[I_HYW2][(size_t)l * 4096 + i];
    if (F.tid < 64) { PV[F.tid] = A.in[I_HYB1][l * 64 + F.tid]; PV[64 + F.tid] = A.in[I_HYF1][l * 64 + F.tid]; PV[128 + F.tid] = A.in[I_HYB2][l * 64 + F.tid]; PV[192 + F.tid] = A.in[I_HYF2][l * 64 + F.tid]; }
    __syncthreads();
    LAS float* scr = SCR + F.wave * 64;
    const int gw = F.bid * 8 + F.wave, NGW = F.G * 8, j = F.lane;
    float* H2 = (float*)(F.ws + WS_H2);
    for (int p = gw; p < SEQ + LC; p += NGW) {
        const int n = p < SEQ ? SEQ : LC, pos = p < SEQ ? p : p - SEQ;
        float feat = 0.f;
        if (j == 0) feat = (float)pos / (float)(n - 1);
        else if (j < 33) { const int fi = (j - 1) & 15; const float fr = 1e-4f + (float)fi * ((15.0f - 1e-4f) / 15.0f);
            const float ang = (6.283185307179586f / (float)n) * (float)pos * fr; float s, c; sincosf(ang, &s, &c); feat = j < 17 ? c : -s; }
        scr[j] = feat; LDS_WAIT(); asm volatile("" ::: "memory");
        float a = PV[j];
        for (int i = 0; i < 33; ++i) a += scr[i] * W1[i * 64 + j];
        const float h1 = sinf(PV[64 + j] * a);
        LDS_WAIT(); asm volatile("" ::: "memory");
        scr[j] = h1; LDS_WAIT(); asm volatile("" ::: "memory");
        float b = PV[128 + j];
        for (int i = 0; i < 64; ++i) b += scr[i] * W2[i * 64 + j];
        H2[(size_t)p * 64 + j] = sinf(PV[192 + j] * b);
        LDS_WAIT(); asm volatile("" ::: "memory");
    }
}

__device__ __forceinline__ void ph_norm(const Ctx& F, const Args& A, int l, int which) {
    const int gw = F.bid * 8 + F.wave, NGW = F.G * 8;
    const float* X = (const float*)(F.ws + WS_XRES); f16* O = (f16*)(F.ws + WS_HN);
    const float* gain = A.in[which ? I_N2G : I_N1G] + (size_t)l * D;
    const float* mod = (const float*)(F.ws + WS_MOD) + (size_t)l * 3 * 12288;
    const int shoff = which ? 6144 : 0, soff = which ? 8192 : 2048;
    for (int m = gw; m < MT; m += NGW) {
        const int bsel = m < SEQ ? 0 : (m < MX ? 1 : 2);
        const f32x4* xr = (const f32x4*)(X + (size_t)m * D) + F.lane;
        f32x4 v[8]; float s = 0.f;
#pragma unroll
        for (int j = 0; j < 8; ++j) { v[j] = xr[64 * j]; s += (v[j].x * v[j].x + v[j].y * v[j].y) + (v[j].z * v[j].z + v[j].w * v[j].w); }
        const float rstd = 1.0f / sqrtf(wave_sum(s) * (1.0f / D) + EPS);
        const float* mp = mod + bsel * 12288;
#pragma unroll
        for (int j = 0; j < 8; ++j) { const int c = 4 * F.lane + 256 * j;
            const f32x4 g = *(const f32x4*)(gain + c), sh = *(const f32x4*)(mp + shoff + c), sc = *(const f32x4*)(mp + soff + c);
            f16x4 o;
#pragma unroll
            for (int e = 0; e < 4; ++e) o[e] = (f16)(v[j][e] * rstd * g[e] * (1.0f + sc[e]) + sh[e]);
            *(f16x4*)(O + (size_t)m * D + c) = o; }
    }
}
__device__ __forceinline__ void ph_final_norm(const Ctx& F, const Args& A) {
    const int gw = F.bid * 8 + F.wave, NGW = F.G * 8;
    const float* X = (const float*)(F.ws + WS_XRES); const float* gain = A.in[I_FNG];
    for (int m = gw; m < MX; m += NGW) {
        const f32x4* xr = (const f32x4*)(X + (size_t)m * D) + F.lane;
        f32x4 v[8]; float s = 0.f;
#pragma unroll
        for (int j = 0; j < 8; ++j) { v[j] = xr[64 * j]; s += (v[j].x * v[j].x + v[j].y * v[j].y) + (v[j].z * v[j].z + v[j].w * v[j].w); }
        const float rstd = 1.0f / sqrtf(wave_sum(s) * (1.0f / D) + EPS);
#pragma unroll
        for (int j = 0; j < 8; ++j) { const int c = 4 * F.lane + 256 * j; const f32x4 g = *(const f32x4*)(gain + c);
            *(f32x4*)(A.out + (size_t)m * D + c) = v[j] * rstd * g; }
    }
}

__device__ __forceinline__ void ph_s5_scan(const Ctx& F) {
    if (F.tid >= 32) return;
    const float* S = (const float*)(F.ws + WS_S5S); f16* SA = (f16*)(F.ws + WS_S5A);
    for (int gt = F.bid * 32 + F.tid; gt < 2 * 2 * 32 * 64; gt += F.G * 32) {
        const int nn = gt & 63, g = (gt >> 6) & 31, d = (gt >> 11) & 1, b = gt >> 12;
        const f32x2 at = ((const f32x2*)(F.ws + WS_S5AT))[(d * 32 + g) * 64 + nn];
        f32x2 st = (f32x2){0.f, 0.f};
        for (int base = 0; base < 16 + 512; base += 16) {
            f32x2 loc[16]; int chk[16];
#pragma unroll
            for (int u = 0; u < 16; ++u) { const int step = base + u; int chunk;
                if (d == 0) chunk = step < 16 ? 1024 + b * 16 + step : b * 512 + (step - 16);
                else chunk = step < 16 ? 1024 + b * 16 + (15 - step) : b * 512 + (511 - (step - 16));
                chk[u] = chunk; const size_t so = ((size_t)chunk * 32 + g) * 256 + d * 128 + nn;
                loc[u] = (f32x2){S[so], S[so + 64]}; }
#pragma unroll
            for (int u = 0; u < 16; ++u) { f16* xp = SA + (size_t)chk[u] * 16384 + (size_t)g * 512 + 256 + d * 128 + nn;
                xp[0] = (f16)st.x; xp[64] = (f16)st.y;
                st = cmul(at, st) + loc[u]; }
        }
    }
}

__device__ __forceinline__ void ph_ffn_act(const Ctx& F, const Args& A, int l) {
    const f16* UP = (const f16*)(F.ws + WS_PX); f16* ACT = (f16*)(F.ws + WS_ACT);
    const float* cw = A.in[I_FFCW] + (size_t)l * 3 * FFH; const float* cb = A.in[I_FFCB] + (size_t)l * FFH;
    const int NTASK = (MT / 16) * (FFH / 8);
    for (int task = F.bid * 512 + F.tid; task < NTASK; task += F.G * 512) {
        const int rb = task / (FFH / 8), cg = task % (FFH / 8), c0 = cg * 8, r0 = rb * 16;
        int seq0, seqn; if (r0 < MX) { seq0 = (r0 / SEQ) * SEQ; seqn = SEQ; } else { seq0 = MX + ((r0 - MX) / LC) * LC; seqn = LC; }
        float w0[8], w1[8], w2[8], bb[8];
#pragma unroll
        for (int e = 0; e < 8; ++e) { w0[e] = cw[c0 + e]; w1[e] = cw[FFH + c0 + e]; w2[e] = cw[2 * FFH + c0 + e]; bb[e] = cb[c0 + e]; }
        f16x8 zero;
#pragma unroll
        for (int e = 0; e < 8; ++e) zero[e] = (f16)0.f;
        f16x8 pm = (r0 > seq0) ? *(const f16x8*)(UP + (size_t)(r0 - 1) * UPLD + c0) : zero;
        f16x8 pc = *(const f16x8*)(UP + (size_t)r0 * UPLD + c0);
#pragma unroll 4
        for (int i = 0; i < 16; ++i) { const int r = r0 + i;
            const f16x8 pn = (r + 1 < seq0 + seqn) ? *(const f16x8*)(UP + (size_t)(r + 1) * UPLD + c0) : zero;
            const f16x8 bv = *(const f16x8*)(UP + (size_t)r * UPLD + FFH + c0);
            f16x8 o;
#pragma unroll
            for (int e = 0; e < 8; ++e) { const float a = w0[e] * (float)pm[e] + w1[e] * (float)pc[e] + w2[e] * (float)pn[e] + bb[e]; o[e] = (f16)(siluf_(a) * (float)bv[e]); }
            *(f16x8*)(ACT + (size_t)r * FFH + c0) = o;
            pm = pc; pc = pn; }
    }
}

namespace gla {
constexpr int QK_LD = 136, KH_LD = 72, VT_LD = 72, P_LD = 72;
constexpr int OFF_QT = 0;
constexpr int OFF_KT = 17408;
constexpr int OFF_VT = OFF_KT + 18432;
constexpr int OFF_P = OFF_VT + 36864;
constexpr int OFF_LR = OFF_P + 9216;
constexpr int OFF_GT = OFF_LR + 4096;
constexpr int OFF_DEC = OFF_GT + 2048;
constexpr int OFF_RS = OFF_DEC + 512;
constexpr int OFF_QR = OFF_RS + 2048;
constexpr int OFF_KR = OFF_QR + 17408;
constexpr int OFF_WG = OFF_KR + 17408;
static_assert(OFF_WG + 8192 <= LDSCTL_OFF, "gla lds");

__device__ __forceinline__ int grow(int b, int sc, int j, int i) {
    if (sc < 32) { const int col = 2 * sc + (j >> 1), r = (j & 1) * 64 + i; return b * SEQ + r * 64 + col; }
    return MX + b * LC + j * 64 + i;
}
#define GLA_MFMA(a, b, c) __builtin_amdgcn_mfma_f32_16x16x32_f16(a, b, c, 0, 0, 0)

template <bool FULL>
__device__ __forceinline__ void gla_unit(const Ctx& F, const Args& A, int l, int unit) {
    const int b = unit / (4 * NSC), h = (unit / NSC) % 4, sc = unit % NSC;
    LAS f16* QT = (LAS f16*)(F.lds + OFF_QT); LAS f16* KT = (LAS f16*)(F.lds + OFF_KT); LAS f16* VT = (LAS f16*)(F.lds + OFF_VT);
    LAS f16* PP = (LAS f16*)(F.lds + OFF_P); LAS f16* LR = (LAS f16*)(F.lds + OFF_LR);
    LAS float* GT = (LAS float*)(F.lds + OFF_GT); LAS float* DEC = (LAS float*)(F.lds + OFF_DEC); LAS float* RS = (LAS float*)(F.lds + OFF_RS);
    LAS f16* QR = (LAS f16*)(F.lds + OFF_QR); LAS f16* KR = (LAS f16*)(F.lds + OFF_KR); LAS float* WG = (LAS float*)(F.lds + OFF_WG);
    const int tid = F.tid, lane = F.lane, w = F.wave, q0 = lane >> 4, c0 = lane & 15;
    const int dk0 = tid & 127, ig0 = tid >> 7;
    const f16* PX = (const f16*)(F.ws + WS_PX);
    const float scale = 0.08838834764831845f;
    for (int dir = 0; dir < 2; ++dir) {
        __syncthreads();
        for (int i = tid; i < 16 * 128; i += 512) WG[i] = A.in[I_GLAWG][(((size_t)l * 2 + dir) * 16 + (i >> 7)) * 512 + h * 128 + (i & 127)];
        const float bgv = A.in[I_GLABG][((size_t)l * 2 + dir) * 512 + h * 128 + dk0];
        const size_t sidx = ((((size_t)b * 4 + h) * NSC + sc) * 2 + dir);
        f32x4 accS[8][2];
        if (FULL) { const float* Sin = (const float*)(F.ws + WS_GSIN) + sidx * 32768; const int q = opq(q0), c = opq(c0);
#pragma unroll
            for (int dt = 0; dt < 8; ++dt)
#pragma unroll
                for (int et = 0; et < 2; ++et)
#pragma unroll
                    for (int r = 0; r < 4; ++r) accS[dt][et][r] = Sin[(16 * dt + 4 * q + r) * 256 + 32 * w + 16 * et + c]; }
        else {
#pragma unroll
            for (int dt = 0; dt < 8; ++dt)
#pragma unroll
                for (int et = 0; et < 2; ++et) accS[dt][et] = (f32x4){0.f, 0.f, 0.f, 0.f}; }
        float sumtot = 0.f;
        for (int jj = 0; jj < 4; ++jj) {
            const int j = dir ? 3 - jj : jj;
            __syncthreads();
            const int tid = opq(F.tid);
            if (tid < 256) { const int row = tid >> 2, part = tid & 3; const int gr = grow(b, sc, j, row);
                *(LAS f16x8*)(LR + row * 32 + part * 8) = *(const f16x8*)(PX + (size_t)gr * PXLD + P_GG + part * 8); }
#pragma unroll 1
            for (int k = 0; k < 4; ++k) { const int idx = tid + 512 * k, wi = idx >> 6, ln = idx & 63, rr = ln >> 2, cc = ln & 3;
                const int row = (wi & 3) * 16 + rr, chunk = (wi >> 2) * 4 + cc; const int gr = grow(b, sc, j, row);
                const f16x8 v8 = *(const f16x8*)(PX + (size_t)gr * PXLD + P_GV + h * 256 + chunk * 8);
#pragma unroll
                for (int e = 0; e < 8; ++e) VT[(chunk * 8 + e) * VT_LD + row] = v8[e]; }
#pragma unroll 1
            for (int k = 0; k < 2; ++k) { const int idx = tid + 512 * k, row = idx >> 4, ch = idx & 15; const int gr = grow(b, sc, j, row);
                *(LAS f16x8*)(KR + row * QK_LD + ch * 8) = *(const f16x8*)(PX + (size_t)gr * PXLD + P_GK + h * 128 + ch * 8);
                if (FULL) *(LAS f16x8*)(QR + row * QK_LD + ch * 8) = *(const f16x8*)(PX + (size_t)gr * PXLD + P_GQ + h * 128 + ch * 8); }
            __syncthreads();
            const int dk = opq(dk0), ig = opq(ig0);
            float bv[16];
#pragma unroll
            for (int ii = 0; ii < 16; ++ii) { const int i = ig * 16 + ii; float pre = bgv;
                const f16x8 l0 = *(const LAS f16x8*)(LR + i * 32 + dir * 16), l1 = *(const LAS f16x8*)(LR + i * 32 + dir * 16 + 8);
#pragma unroll
                for (int r = 0; r < 8; ++r) pre += (float)l0[r] * WG[r * 128 + dk] + (float)l1[r] * WG[(8 + r) * 128 + dk];
                bv[ii] = logsigmoidf_(pre) * (1.0f / 16.0f); asm volatile("" ::: "memory"); }
            float totloc;
            if (dir == 0) {
#pragma unroll
                for (int ii = 1; ii < 16; ++ii) bv[ii] += bv[ii - 1];
                totloc = bv[15]; }
            else {
#pragma unroll
                for (int ii = 14; ii >= 0; --ii) bv[ii] += bv[ii + 1];
                totloc = bv[0]; }
            GT[ig * 128 + dk] = totloc;
            __syncthreads();
            const float g0 = GT[dk], g1 = GT[128 + dk], g2 = GT[256 + dk], g3 = GT[384 + dk];
            const float total = (g0 + g1) + (g2 + g3);
            float off, bmid;
            if (dir == 0) { off = (ig > 0 ? g0 : 0.f) + (ig > 1 ? g1 : 0.f) + (ig > 2 ? g2 : 0.f); bmid = g0 + g1; }
            else { off = (ig < 3 ? g3 : 0.f) + (ig < 2 ? g2 : 0.f) + (ig < 1 ? g1 : 0.f); bmid = g2 + g3; }
#pragma unroll
            for (int ii = 0; ii < 16; ++ii) bv[ii] += off;
            if (FULL) {
#pragma unroll
                for (int ii = 0; ii < 16; ++ii) { const int i = ig * 16 + ii;
                    QT[i * QK_LD + dk] = (f16)((float)QR[i * QK_LD + dk] * scale * __expf(fminf(bv[ii] - bmid, 9.f)));
                    KT[i * QK_LD + dk] = (f16)((float)KR[i * QK_LD + dk] * __expf(fminf(bmid - bv[ii], 9.f))); if ((ii & 3) == 3) asm volatile("" ::: "memory"); }
                __syncthreads();
                { const int c = opq(c0), q = opq(q0);
#pragma unroll
                for (int s = 0; s < 2; ++s) { const int T = 2 * w + s, it = T >> 2, jt = T & 3; f32x4 a = (f32x4){0.f, 0.f, 0.f, 0.f};
#pragma unroll
                    for (int kk = 0; kk < 4; ++kk) { const f16x8 kf = *(const LAS f16x8*)(KT + (jt * 16 + c) * QK_LD + kk * 32 + 8 * q);
                        const f16x8 qf = *(const LAS f16x8*)(QT + (it * 16 + c) * QK_LD + kk * 32 + 8 * q); a = GLA_MFMA(kf, qf, a); }
                    const int i = it * 16 + c; f16x4 pv;
#pragma unroll
                    for (int r = 0; r < 4; ++r) { const int jx = jt * 16 + 4 * q + r; const bool keep = dir == 0 ? (jx <= i) : (jx >= i); pv[r] = keep ? (f16)a[r] : (f16)0.f; }
                    *(LAS f16x4*)(PP + i * P_LD + jt * 16 + 4 * q) = pv; } }
                __syncthreads();
#pragma unroll
                for (int ii = 0; ii < 16; ++ii) { const int i = ig * 16 + ii; QT[i * QK_LD + dk] = (f16)((float)QR[i * QK_LD + dk] * scale * __expf(bv[ii])); if ((ii & 3) == 3) asm volatile("" ::: "memory"); }
            }
            { f16x8 k0, k1;
#pragma unroll
              for (int ii = 0; ii < 8; ++ii) { k0[ii] = (f16)((float)KR[(ig * 16 + ii) * QK_LD + dk] * __expf(total - bv[ii])); k1[ii] = (f16)((float)KR[(ig * 16 + 8 + ii) * QK_LD + dk] * __expf(total - bv[8 + ii])); }
              *(LAS f16x8*)(KT + dk * KH_LD + ig * 16) = k0; *(LAS f16x8*)(KT + dk * KH_LD + ig * 16 + 8) = k1; }
            if (ig == 0) { DEC[dk] = __expf(total); sumtot += total; }
            __syncthreads();
            const int c = opq(c0), q = opq(q0);
            if (FULL) {
                f32x4 accO[4][2];
#pragma unroll
                for (int it = 0; it < 4; ++it)
#pragma unroll
                    for (int et = 0; et < 2; ++et) accO[it][et] = (f32x4){0.f, 0.f, 0.f, 0.f};
#pragma unroll
                for (int et = 0; et < 2; ++et)
#pragma unroll
                    for (int kk = 0; kk < 2; ++kk) { const f16x8 vf = *(const LAS f16x8*)(VT + (32 * w + 16 * et + c) * VT_LD + kk * 32 + 8 * q);
#pragma unroll
                        for (int it = 0; it < 4; ++it) { const f16x8 pf = *(const LAS f16x8*)(PP + (it * 16 + c) * P_LD + kk * 32 + 8 * q); accO[it][et] = GLA_MFMA(vf, pf, accO[it][et]); } asm volatile("" ::: "memory"); }
#pragma unroll
                for (int kb = 0; kb < 4; ++kb)
#pragma unroll
                    for (int et = 0; et < 2; ++et) { f16x8 sf; asm volatile("" ::: "memory");
#pragma unroll
                        for (int e = 0; e < 4; ++e) { sf[e] = (f16)accS[2 * kb][et][e]; sf[4 + e] = (f16)accS[2 * kb + 1][et][e]; }
#pragma unroll
                        for (int it = 0; it < 4; ++it) { const f16x4 lo = *(const LAS f16x4*)(QT + (it * 16 + c) * QK_LD + 32 * kb + 4 * q), hi = *(const LAS f16x4*)(QT + (it * 16 + c) * QK_LD + 32 * kb + 16 + 4 * q);
                            f16x8 qf; qf[0] = lo[0]; qf[1] = lo[1]; qf[2] = lo[2]; qf[3] = lo[3]; qf[4] = hi[0]; qf[5] = hi[1]; qf[6] = hi[2]; qf[7] = hi[3];
                            accO[it][et] = GLA_MFMA(sf, qf, accO[it][et]); } }
                float* OF = (float*)(F.ws + WS_GOF);
                if (dir == 0) {
#pragma unroll
                    for (int it = 0; it < 4; ++it) { const int gr = grow(b, sc, j, it * 16 + c);
#pragma unroll
                        for (int et = 0; et < 2; ++et) *(f32x4*)(OF + (size_t)gr * 1024 + h * 256 + 32 * w + 16 * et + 4 * q) = accO[it][et];
                        asm volatile("" ::: "memory"); } }
                else {
                    int grs[4];
#pragma unroll
                    for (int it = 0; it < 4; ++it) { grs[it] = grow(b, sc, j, it * 16 + c); float ss = 0.f;
#pragma unroll
                        for (int et = 0; et < 2; ++et) { accO[it][et] = accO[it][et] + *(const f32x4*)(OF + (size_t)grs[it] * 1024 + h * 256 + 32 * w + 16 * et + 4 * q);
                            ss += (accO[it][et][0] * accO[it][et][0] + accO[it][et][1] * accO[it][et][1]) + (accO[it][et][2] * accO[it][et][2] + accO[it][et][3] * accO[it][et][3]); }
                        ss += __shfl_xor(ss, 16); ss += __shfl_xor(ss, 32);
                        if (q == 0) RS[(it * 16 + c) * 8 + w] = ss; asm volatile("" ::: "memory"); }
                    __syncthreads();
                    const float* ng = A.in[I_GLANG] + (size_t)l * 256;
                    f16* Y = (f16*)(F.ws + WS_YCAT);
#pragma unroll
                    for (int it = 0; it < 4; ++it) { const int i = it * 16 + c; const f32x4 ra = *(const LAS f32x4*)(RS + i * 8), rb = *(const LAS f32x4*)(RS + i * 8 + 4);
                        const float tot = ((ra[0] + ra[1]) + (ra[2] + ra[3])) + ((rb[0] + rb[1]) + (rb[2] + rb[3]));
                        const float rstd = 1.0f / sqrtf(tot * (1.0f / 256.0f) + EPS);
#pragma unroll
                        for (int et = 0; et < 2; ++et) { const int e0 = 32 * w + 16 * et + 4 * q;
                            const f32x4 gv = *(const f32x4*)(ng + e0); const f16x4 rv = *(const f16x4*)(PX + (size_t)grs[it] * PXLD + P_GR + h * 256 + e0);
                            f16x4 o;
#pragma unroll
                            for (int r = 0; r < 4; ++r) o[r] = (f16)(accO[it][et][r] * rstd * gv[r] * siluf_((float)rv[r]));
                            *(f16x4*)(Y + (size_t)grs[it] * 2048 + 1024 + h * 256 + e0) = o; } asm volatile("" ::: "memory"); }
                }
            }
#pragma unroll
            for (int dt = 0; dt < 8; ++dt) { const f32x4 dv = *(const LAS f32x4*)(DEC + 16 * dt + 4 * q);
#pragma unroll
                for (int et = 0; et < 2; ++et) accS[dt][et] = accS[dt][et] * dv; }
#pragma unroll
            for (int kk = 0; kk < 2; ++kk) { f16x8 vf[2];
#pragma unroll
                for (int et = 0; et < 2; ++et) vf[et] = *(const LAS f16x8*)(VT + (32 * w + 16 * et + c) * VT_LD + kk * 32 + 8 * q);
#pragma unroll
                for (int dt = 0; dt < 8; ++dt) { const f16x8 kf = *(const LAS f16x8*)(KT + (16 * dt + c) * KH_LD + kk * 32 + 8 * q);
#pragma unroll
                    for (int et = 0; et < 2; ++et) accS[dt][et] = GLA_MFMA(kf, vf[et], accS[dt][et]); if (dt & 1) asm volatile("" ::: "memory"); } }
        }
        if (!FULL) { float* Sl = (float*)(F.ws + WS_GSLOC) + sidx * 32768; const int q = opq(q0), c = opq(c0);
#pragma unroll
            for (int dt = 0; dt < 8; ++dt)
#pragma unroll
                for (int et = 0; et < 2; ++et)
#pragma unroll
                    for (int r = 0; r < 4; ++r) Sl[(16 * dt + 4 * q + r) * 256 + 32 * w + 16 * et + c] = accS[dt][et][r];
            if (ig0 == 0) ((float*)(F.ws + WS_GDT))[sidx * 128 + dk0] = __expf(sumtot); }
        VM_WAIT();
    }
}
__device__ __forceinline__ void ph_gla_scan(const Ctx& F) {
    const float* Sl = (const float*)(F.ws + WS_GSLOC); float* Si = (float*)(F.ws + WS_GSIN); const float* Dt = (const float*)(F.ws + WS_GDT);
    for (int gt = F.bid * 512 + F.tid; gt < 2 * 4 * 2 * 32768; gt += F.G * 512) {
        const int e = gt & 32767, dir = (gt >> 15) & 1, h = (gt >> 16) & 3, b = gt >> 18;
        float S = 0.f;
        for (int base = 0; base < NSC; base += 11) {
            float sl[11], dt[11]; size_t ix[11];
#pragma unroll
            for (int u = 0; u < 11; ++u) { const int step = base + u; const int sc = step == 0 ? 32 : (dir == 0 ? step - 1 : 32 - step);
                const size_t idx = ((((size_t)b * 4 + h) * NSC + sc) * 2 + dir); ix[u] = idx;
                sl[u] = Sl[idx * 32768 + e]; dt[u] = Dt[idx * 128 + (e >> 8)]; }
#pragma unroll
            for (int u = 0; u < 11; ++u) { Si[ix[u] * 32768 + e] = S; S = dt[u] * S + sl[u]; }
        }
    }
}
#undef GLA_MFMA
}

namespace hy {
__device__ __forceinline__ void fft_fwd(LAS f32x2* x, int m, const f32x2* tw, int tid) {
    const int N = 1 << m, tws = 16384 >> m;
    int lh = m - 1;
    if (m & 1) { const int h = 1 << lh;
        for (int i = tid; i < (N >> 1); i += 512) { const f32x2 a = x[i], b = x[i + h]; x[i] = a + b; x[i + h] = cmul(a - b, tw[i * tws]); }
        __syncthreads(); lh -= 1; }
    for (; lh >= 1; lh -= 2) { const int h = 1 << lh, hh = h >> 1, lhh = lh - 1, s = (N >> 1) >> lh;
        for (int q = tid; q < (N >> 2); q += 512) { const int j = q & (hh - 1), blk = q >> lhh, i = (blk << (lh + 1)) + j;
            const f32x2 x0 = x[i], x1 = x[i + hh], x2 = x[i + h], x3 = x[i + h + hh];
            const f32x2 w1 = tw[(j * s) * tws], w2 = tw[(2 * j * s) * tws];
            const f32x2 a0 = x0 + x2, a2 = cmul(x0 - x2, w1), a1 = x1 + x3, t3 = cmul(x1 - x3, w1), a3 = (f32x2){t3.y, -t3.x};
            x[i] = a0 + a1; x[i + hh] = cmul(a0 - a1, w2); x[i + h] = a2 + a3; x[i + h + hh] = cmul(a2 - a3, w2); }
        __syncthreads(); }
}
__device__ __forceinline__ void fft_inv(LAS f32x2* x, int m, const f32x2* tw, int tid) {
    const int N = 1 << m, tws = 16384 >> m;
    int lh = 0;
    for (int p = 0; p < (m >> 1); ++p, lh += 2) { const int h = 1 << lh, s1 = (N >> 1) >> lh, s2 = s1 >> 1;
        for (int q = tid; q < (N >> 2); q += 512) { const int j = q & (h - 1), blk = q >> lh, i = (blk << (lh + 2)) + j;
            const f32x2 x0 = x[i], x1 = x[i + h], x2 = x[i + 2 * h], x3 = x[i + 3 * h];
            const f32x2 w1 = cconj(tw[(j * s1) * tws]), w2 = cconj(tw[(j * s2) * tws]), w3 = (f32x2){-w2.y, w2.x};
            const f32x2 b1 = cmul(x1, w1), b3 = cmul(x3, w1);
            const f32x2 a0 = x0 + b1, a1 = x0 - b1, a2 = x2 + b3, a3 = x2 - b3;
            const f32x2 c2 = cmul(a2, w2), c3 = cmul(a3, w3);
            x[i] = a0 + c2; x[i + 2 * h] = a0 - c2; x[i + h] = a1 + c3; x[i + 3 * h] = a1 - c3; }
        __syncthreads(); }
    if (m & 1) { const int h = 1 << lh;
        for (int i = tid; i < (N >> 1); i += 512) { const f32x2 a = x[i], b = cmul(x[i + h], cconj(tw[i * tws])); x[i] = a + b; x[i + h] = a - b; }
        __syncthreads(); }
}
__device__ __forceinline__ int brev(int k, int m) { return (int)(__brev((unsigned)k) >> (32 - m)); }

__device__ __forceinline__ void filt_unit(const Ctx& F, const Args& A, int l, int unit) {
    const int kind = unit >> 9, o = (unit >> 8) & 1, pair = unit & 255;
    const int n = kind ? LC : SEQ, m = kind ? 9 : 14, N = 2 * n, tid = F.tid;
    LAS f32x2* buf = (LAS f32x2*)F.lds;
    LAS float* W3 = (LAS float*)(F.lds + EXTRA_OFF);
    LAS float* B3 = W3 + 256;
    LAS float* RED = B3 + 4;
    LAS float* INV = RED + 16;
    __syncthreads();
    if (tid < 256) { const int j = tid >> 2, ci = tid & 3; const int col = o * 1024 + (ci >> 1) * 512 + 2 * pair + (ci & 1);
        W3[j * 4 + ci] = A.in[I_HYW3][((size_t)l * 64 + j) * 2048 + col]; if (j == 0) B3[ci] = A.in[I_HYB3][(size_t)l * 2048 + col]; }
    __syncthreads();
    const float* H2 = (const float*)(F.ws + WS_H2) + (kind ? (size_t)SEQ * 64 : 0);
    const float lo = -3.0701134573253945f, hi = -15.350567286626973f;
    const float ra = fabsf(lo + (hi - lo) * (float)(2 * pair) / 511.0f), rb = fabsf(lo + (hi - lo) * (float)(2 * pair + 1) / 511.0f);
    float sa = 0.f, sb = 0.f;
    for (int t = tid; t < n; t += 512) {
        float a0 = B3[0], a1 = B3[1], a2 = B3[2], a3 = B3[3];
        const f32x4* hr = (const f32x4*)(H2 + (size_t)t * 64);
#pragma unroll 4
        for (int j4 = 0; j4 < 16; ++j4) { const f32x4 hv = hr[j4];
#pragma unroll
            for (int e = 0; e < 4; ++e) { const f32x4 wv = *(const LAS f32x4*)(W3 + (j4 * 4 + e) * 4); a0 += hv[e] * wv[0]; a1 += hv[e] * wv[1]; a2 += hv[e] * wv[2]; a3 += hv[e] * wv[3]; } }
        const float tn = (float)t / (float)(n - 1), da = expf(-tn * ra), db = expf(-tn * rb);
        const float fa = a0 * da, fb = a1 * db, ba = a2 * da, bb = a3 * db;
        buf[t] = (f32x2){fa, fb}; sa += fabsf(fa); sb += fabsf(fb);
        if (t >= 1) { buf[N - t] = (f32x2){ba, bb}; sa += fabsf(ba); sb += fabsf(bb); }
    }
    if (tid == 0) buf[n] = (f32x2){0.f, 0.f};
    sa = wave_sum(sa); sb = wave_sum(sb);
    if (F.lane == 0) { RED[F.wave * 2] = sa; RED[F.wave * 2 + 1] = sb; }
    __syncthreads();
    if (tid < 2) { float s = 0.f;
#pragma unroll
        for (int w = 0; w < 8; ++w) s += RED[w * 2 + tid];
        INV[tid] = 1.0f / (s + EPS); }
    __syncthreads();
    { const float ia = INV[0], ib = INV[1];
      for (int i = tid; i < N; i += 512) { f32x2 v = buf[i]; v.x *= ia; v.y *= ib; buf[i] = v; } }
    __syncthreads();
    const f32x2* tw = (const f32x2*)(F.ws + WS_TW);
    fft_fwd(buf, m, tw, tid);
    f32x4* out = (f32x4*)(F.ws + WS_FSD + (kind ? FSD_C_OFF : 0)) + (size_t)(o * 256 + pair) * (n + 1);
    for (int k = tid; k <= n; k += 512) { const f32x2 zk = buf[brev(k, m)], zn = cconj(buf[brev((N - k) & (N - 1), m)]);
        const f32x2 fa = (zk + zn) * 0.5f, df = zk - zn, fb = (f32x2){df.y * 0.5f, -df.x * 0.5f};
        const f32x2 fs = (fa + fb) * 0.5f, fd = (fa - fb) * 0.5f;
        out[k] = (f32x4){fs.x, fs.y, fd.x, fd.y}; }
    __syncthreads();
}

__device__ __forceinline__ void main_unit(const Ctx& F, const Args& A, int l, int unit) {
    const int kind = unit >> 9, b = (unit >> 8) & 1, pair = unit & 255;
    const int n = kind ? LC : SEQ, m = kind ? 9 : 14, N = 2 * n, tid = F.tid;
    const int row0 = kind ? MX + b * LC : b * SEQ;
    LAS f32x2* buf = (LAS f32x2*)F.lds;
    const f16* PX = (const f16*)(F.ws + WS_PX) + P_HY + 2 * pair;
    const float* cw = A.in[I_HYCW] + (size_t)l * 3 * 1536 + 2 * pair; const float* cb = A.in[I_HYCB] + (size_t)l * 1536 + 2 * pair;
    f32x2 yv[16], g1[16], g2[16];
    {
        f32x2 w[3][3], bs[3];
#pragma unroll
        for (int g = 0; g < 3; ++g) { bs[g] = (f32x2){cb[g * 512], cb[g * 512 + 1]};
#pragma unroll
            for (int tp = 0; tp < 3; ++tp) w[g][tp] = (f32x2){cw[tp * 1536 + g * 512], cw[tp * 1536 + g * 512 + 1]}; }
#pragma unroll
        for (int i = 0; i < 16; ++i) { const int t = tid + 512 * i; f32x2 r[3] = {bs[0], bs[1], bs[2]};
            if (t < n) {
#pragma unroll
                for (int tp = 0; tp < 3; ++tp) { const int tt = t + tp - 1;
                    if (tt >= 0 && tt < n) { const f16* p = PX + (size_t)(row0 + tt) * PXLD;
#pragma unroll
                        for (int g = 0; g < 3; ++g) { const f16x2 z = *(const f16x2*)(p + g * 512); r[g].x += w[g][tp].x * (float)z[0]; r[g].y += w[g][tp].y * (float)z[1]; } } } }
            yv[i] = r[0]; g1[i] = r[1]; g2[i] = r[2]; }
    }
    const f32x2* tw = (const f32x2*)(F.ws + WS_TW);
    const float invN = 1.0f / (float)N;
#pragma unroll
    for (int o = 0; o < 2; ++o) {
        __syncthreads();
#pragma unroll
        for (int i = 0; i < 16; ++i) { const int t = tid + 512 * i; if (t < n) { buf[t] = yv[i]; buf[n + t] = (f32x2){0.f, 0.f}; } }
        __syncthreads();
        fft_fwd(buf, m, tw, tid);
        const f32x4* fsd = (const f32x4*)(F.ws + WS_FSD + (kind ? FSD_C_OFF : 0)) + (size_t)(o * 256 + pair) * (n + 1);
        for (int k = tid; k <= n; k += 512) { const int pk = brev(k, m), pn = brev((N - k) & (N - 1), m);
            const f32x2 zk = buf[pk], zn = buf[pn]; const f32x4 f = fsd[k]; const f32x2 fs = (f32x2){f[0], f[1]}, fd = (f32x2){f[2], f[3]};
            const f32x2 wk = cmul(zk, fs) + cmul(cconj(zn), fd), wn = cmul(zn, cconj(fs)) + cmul(cconj(zk), cconj(fd));
            buf[pn] = wn; buf[pk] = wk; }
        __syncthreads();
        fft_inv(buf, m, tw, tid);
        const float* hb = A.in[I_HYBIAS] + ((size_t)l * 2 + o) * 512 + 2 * pair; const f32x2 bias = (f32x2){hb[0], hb[1]};
#pragma unroll
        for (int i = 0; i < 16; ++i) { const int t = tid + 512 * i; if (t < n) { const f32x2 cv = buf[t] * invN; const f32x2 gt = o == 0 ? g1[i] : g2[i];
            yv[i] = gt * (cv + yv[i] * bias); } }
    }
    f16* Y = (f16*)(F.ws + WS_YCAT) + 512 + 2 * pair;
#pragma unroll
    for (int i = 0; i < 16; ++i) { const int t = tid + 512 * i; if (t < n) { f16x2 o2; o2[0] = (f16)yv[i].x; o2[1] = (f16)yv[i].y; *(f16x2*)(Y + (size_t)(row0 + t) * 2048) = o2; } }
    __syncthreads();
}
}

#ifndef PHMASK
#define PHMASK 0xFFFF
#endif
#define PH_EN(k) (((PHMASK) >> (k)) & 1)
#ifndef STAMP_MASK
#define STAMP_MASK 0
#endif
#ifndef STAMP_K
#define STAMP_K 1
#endif
#ifndef SUBMASK
#define SUBMASK 7
#endif
#define SUB_EN(k) (((SUBMASK) >> (k)) & 1)
constexpr int NPH = 2 + 12 * DEPTH;

__global__ void __launch_bounds__(512, 2) mk_fwd(Args args) {
    extern __shared__ __attribute__((aligned(16))) unsigned char lds_raw[];
    Ctx F; F.lds = (LAS unsigned char*)lds_raw; F.tid = threadIdx.x; F.lane = F.tid & 63; F.wave = __builtin_amdgcn_readfirstlane(F.tid >> 6);
    F.G = gridDim.x; F.bid = blockIdx.x; F.ws = args.ws;
    const Ctx F0 = F;
#define FRESH() do { F.tid = opq(F0.tid); F.lane = F.tid & 63; F.wave = __builtin_amdgcn_readfirstlane(F.tid >> 6); } while (0)
    volatile LAS unsigned* MISC = (volatile LAS unsigned*)(F.lds + LDSCTL_OFF);
    if (F.tid < 64) MISC[F.tid] = 0u;
    __syncthreads();
    unsigned* barw = (unsigned*)(F.ws + WS_CTL) + CW_BAR;
    XcdBarrier bar; bar.bar = barw; bar.x = 0; bar.st = nullptr;
    const int lo = args.ph_lo, hi = args.ph_hi;
    if (hi - lo > 1) bar = xcd_barrier_post(barw, MISC + 8);
#define IN(k) (lo <= (k) && (k) < hi)
#define SEAM(k) do { if (IN(k) && IN((k) + 1)) xcd_barrier(bar); } while (0)
#if STAMP_MASK
    unsigned long long t_acc = 0ull, t_last = 0ull;
#define TSTART(k) do { if ((((STAMP_MASK) >> (k)) & 1) && blockIdx.x == 0 && threadIdx.x == 0) t_last = __builtin_amdgcn_s_memrealtime(); } while (0)
#define TSTOP(k) do { if ((((STAMP_MASK) >> (k)) & 1) && blockIdx.x == 0 && threadIdx.x == 0) t_acc += __builtin_amdgcn_s_memrealtime() - t_last; } while (0)
#else
#define TSTART(k) do {} while (0)
#define TSTOP(k) do {} while (0)
#endif
    unsigned char* ws = F.ws;
    const int rank160 = (F.bid + F.G - 160 % F.G) % F.G;

    TSTART(12);
    if (PH_EN(12) && IN(0)) { FRESH(); ph_prologue(F, args); }
    SEAM(0);
    TSTOP(12);

    for (int l = 0; l < DEPTH; ++l) {
        const int pb = 1 + 12 * l;
        const float* modl = (const float*)(ws + WS_MOD) + (size_t)l * 3 * 12288;
        TSTART(0);
        if (PH_EN(0) && IN(pb + 0)) {
            FRESH(); ph_convert_weights(F, args, l);
            __syncthreads();
            FRESH(); if (F.bid < 32) s5_mats_group(F, args, l, F.bid);
            FRESH(); ph_hyena_h2(F, args, l);
            FRESH(); ph_norm(F, args, l, 0);
        }
        SEAM(pb + 0);
        TSTOP(0);
        TSTART(1);
        if (PH_EN(1) && IN(pb + 1)) {
            pg8::SchedPlain S; S.init(MT / 256, PXLD / 256, F.G, F.bid); S.A = (const char*)(ws + WS_HN); S.B = (const char*)(ws + WS_WIN); S.aTile = (size_t)256 * 2048 * 2; S.bTile = (size_t)256 * 2048 * 2;
            pg8::EpiPx E{(f16*)(ws + WS_PX), (f16*)(ws + WS_S5A)};
            pg8::gemm_phase(F.lds, 2048, 2048, 32, S, E);
        }
        SEAM(pb + 1);
        TSTOP(1);
        TSTART(2);
        if (PH_EN(2) && IN(pb + 2)) {
            if (SUB_EN(0)) { pg8::SchedS5 S{(const char*)(ws + WS_S5A), (const char*)(ws + WS_S5M), (size_t)256 * 256 * 2, F.G, F.bid};
              pg8::EpiS5In E{(float*)(ws + WS_S5S)};
              pg8::gemm_phase(F.lds, 16384, 256, 4, S, E); }
            FRESH();
            if (SUB_EN(1)) for (int u = rank160; u < 2 * 4 * NSC; u += F.G) gla::gla_unit<false>(F, args, l, u);
            FRESH();
            if (SUB_EN(2)) for (int u = rank160; u < 1024; u += F.G) hy::filt_unit(F, args, l, u);
        }
        SEAM(pb + 2);
        TSTOP(2);
        TSTART(3);
        if (PH_EN(3) && IN(pb + 3)) { FRESH(); ph_s5_scan(F); FRESH(); gla::ph_gla_scan(F); }
        SEAM(pb + 3);
        TSTOP(3);
        TSTART(4);
        if (PH_EN(4) && IN(pb + 4)) {
            if (SUB_EN(0)) { pg8::SchedS5 S{(const char*)(ws + WS_S5A), (const char*)(ws + WS_S5W), (size_t)256 * 512 * 2, F.G, F.bid};
              pg8::EpiS5Out E{(const f16*)(ws + WS_S5A), (f16*)(ws + WS_YAPRE), args.in[I_S5D] + (size_t)l * 512};
              pg8::gemm_phase(F.lds, 16384, 512, 8, S, E); }
            FRESH();
            if (SUB_EN(1)) for (int u = rank160; u < 2 * 4 * NSC; u += F.G) gla::gla_unit<true>(F, args, l, u);
            FRESH();
            if (SUB_EN(2)) for (int u = rank160; u < 1024; u += F.G) hy::main_unit(F, args, l, u);
        }
        SEAM(pb + 4);
        TSTOP(4);
        TSTART(5);
        if (PH_EN(5) && IN(pb + 5)) {
            pg8::SchedPlain S; S.init(MT / 256, 2, F.G, F.bid); S.A = (const char*)(ws + WS_YAPRE); S.B = (const char*)(ws + WS_WGLU); S.aTile = (size_t)256 * 512 * 2; S.bTile = (size_t)256 * 512 * 2;
            pg8::EpiGlu E{(const f16*)(ws + WS_YAPRE), (f16*)(ws + WS_YCAT), args.in[I_GLUB] + (size_t)l * 512};
            pg8::gemm_phase(F.lds, 512, 512, 8, S, E);
        }
        SEAM(pb + 5);
        TSTOP(5);
        TSTART(6);
        if (PH_EN(6) && IN(pb + 6)) {
            pg8::SchedPlain S; S.init(MT / 256, 8, F.G, F.bid); S.aTile = (size_t)256 * 2048 * 2; S.bTile = (size_t)256 * 2048 * 2;
            S.A = (const char*)(ws + WS_YCAT); S.B = (const char*)(ws + WS_WBR);
            if (SUB_EN(0)) { pg8::EpiBranch<0> E{(const f16*)(ws + WS_PX), (f16*)(ws + WS_MBUF)}; pg8::gemm_phase(F.lds, 2048, 2048, 8, S, E); }
            S.A = (const char*)(ws + WS_YCAT) + 512 * 2; S.B = (const char*)(ws + WS_WBR) + 512 * 2;
            if (SUB_EN(1)) { pg8::EpiBranch<1> E{(const f16*)(ws + WS_PX), (f16*)(ws + WS_MBUF)}; pg8::gemm_phase(F.lds, 2048, 2048, 8, S, E); }
            S.A = (const char*)(ws + WS_YCAT) + 1024 * 2; S.B = (const char*)(ws + WS_WBR) + 1024 * 2;
            if (SUB_EN(2)) { pg8::EpiBranch<2> E{(const f16*)(ws + WS_PX), (f16*)(ws + WS_MBUF)}; pg8::gemm_phase(F.lds, 2048, 2048, 16, S, E); }
        }
        SEAM(pb + 6);
        TSTOP(6);
        TSTART(7);
        if (PH_EN(7) && IN(pb + 7)) {
            pg8::SchedPlain S; S.init(MT / 256, 8, F.G, F.bid); S.A = (const char*)(ws + WS_MBUF); S.B = (const char*)(ws + WS_WOUT); S.aTile = (size_t)256 * 2048 * 2; S.bTile = (size_t)256 * 2048 * 2;
            pg8::EpiResid E{(float*)(ws + WS_XRES), modl, 4096};
            pg8::gemm_phase(F.lds, 2048, 2048, 32, S, E);
        }
        SEAM(pb + 7);
        TSTOP(7);
        TSTART(8);
        if (PH_EN(8) && IN(pb + 8)) { FRESH(); ph_norm(F, args, l, 1); }
        SEAM(pb + 8);
        TSTOP(8);
        TSTART(9);
        if (PH_EN(9) && IN(pb + 9)) {
            pg8::SchedPlain S; S.init(MT / 256, UPLD / 256, F.G, F.bid); S.A = (const char*)(ws + WS_HN); S.B = (const char*)(ws + WS_WUP); S.aTile = (size_t)256 * 2048 * 2; S.bTile = (size_t)256 * 2048 * 2;
            pg8::EpiF16 E{(f16*)(ws + WS_PX), UPLD};
            pg8::gemm_phase(F.lds, 2048, 2048, 32, S, E);
        }
        SEAM(pb + 9);
        TSTOP(9);
        TSTART(10);
        if (PH_EN(10) && IN(pb + 10)) { FRESH(); ph_ffn_act(F, args, l); }
        SEAM(pb + 10);
        TSTOP(10);
        TSTART(11);
        if (PH_EN(11) && IN(pb + 11)) {
            pg8::SchedPlain S; S.init(MT / 256, 8, F.G, F.bid); S.A = (const char*)(ws + WS_ACT); S.B = (const char*)(ws + WS_WDN); S.aTile = (size_t)256 * FFH * 2; S.bTile = (size_t)256 * FFH * 2;
            pg8::EpiResid E{(float*)(ws + WS_XRES), modl, 10240};
            pg8::gemm_phase(F.lds, FFH, FFH, FFH / 64, S, E);
        }
        SEAM(pb + 11);
        TSTOP(11);
    }
    if (PH_EN(13) && IN(NPH - 1)) { FRESH(); ph_final_norm(F, args); }
#if STAMP_MASK
    if (blockIdx.x == 0 && threadIdx.x == 0) { const unsigned long long t0 = __builtin_amdgcn_s_memrealtime(); while (__builtin_amdgcn_s_memrealtime() - t0 < (unsigned long long)(STAMP_K) * t_acc) __builtin_amdgcn_s_sleep(8); }
#endif
#undef IN
#undef SEAM
#undef FRESH
}

extern "C" void kernel_launch(void* const* d_in, const int* in_sizes, int n_in, void* d_out, int out_size, void* d_ws, size_t ws_size, hipStream_t stream) {
    static int grid = 0;
    if (grid == 0) {
        if (n_in != 40 || out_size != MX * D || ws_size < WS_END) { fprintf(stderr, "kernel_launch: unexpected problem (n_in %d out %d ws %zu, need %zu)\n", n_in, out_size, ws_size, (size_t)WS_END); grid = -1; return; }
        int dev = 0, cus = 0, per_cu = 0;
        if (hipGetDevice(&dev) != hipSuccess || hipDeviceGetAttribute(&cus, hipDeviceAttributeMultiprocessorCount, dev) != hipSuccess) { grid = -1; return; }
        if (hipFuncSetAttribute((const void*)mk_fwd, hipFuncAttributeMaxDynamicSharedMemorySize, LDS_BYTES) != hipSuccess) { fprintf(stderr, "kernel_launch: hipFuncSetAttribute failed\n"); grid = -1; return; }
        if (hipOccupancyMaxActiveBlocksPerMultiprocessor(&per_cu, (const void*)mk_fwd, 512, LDS_BYTES) != hipSuccess || per_cu < 1)
            fprintf(stderr, "kernel_launch: occupancy query reports %d\n", per_cu);
        (void)hipGetLastError();
        grid = cus;
    }
    if (grid < 0) return;
    if (hipMemsetAsync((char*)d_ws + WS_CTL, 0, CTL_ZERO_BYTES, stream) != hipSuccess) return;
    Args a{};
    for (int i = 0; i < 40; ++i) a.in[i] = (const float*)d_in[i];
    a.out = (float*)d_out; a.ws = (unsigned char*)d_ws;
#if MK_ONE
    a.ph_lo = 0; a.ph_hi = NPH;
    hipLaunchKernelGGL(mk_fwd, dim3(grid), dim3(512), LDS_BYTES, stream, a);
#else
    for (int p = 0; p < NPH; ++p) { a.ph_lo = p; a.ph_hi = p + 1; hipLaunchKernelGGL(mk_fwd, dim3(grid), dim3(512), LDS_BYTES, stream, a); }
#endif
}
```

```cpp
#include <hip/hip_runtime.h>
#include <stdio.h>

#ifndef MK_ONE
#define MK_ONE 1
#define STAMP_MASK 0
#define STAMP_K 1
#endif

#define GAS __attribute__((address_space(1)))
#define LAS __attribute__((address_space(3)))
typedef _Float16 f16;
typedef _Float16 f16x8 __attribute__((ext_vector_type(8)));
typedef _Float16 f16x4 __attribute__((ext_vector_type(4)));
typedef _Float16 f16x2 __attribute__((ext_vector_type(2)));
typedef float f32x4 __attribute__((ext_vector_type(4)));
typedef float f32x2 __attribute__((ext_vector_type(2)));

constexpr int D = 2048, NB = 2, SEQ = 8192, LC = 256, DEPTH = 4;
constexpr int MX = NB * SEQ, MC = NB * LC, MT = MX + MC;
constexpr int PXLD = 11520, FFH = 5632, UPLD = 2 * FFH;
constexpr int P_S5 = 0, P_GK = 512, P_GV = 1024, P_GQ = 2048, P_GR = 2560, P_HY = 3584, P_MG = 5120, P_GG = 11264;
constexpr int INW = 11296;
constexpr int NCHK = 1056;
constexpr float S5SCALE = 1024.f;
constexpr float EPS = 1e-6f;
constexpr int NSC = 33;

constexpr size_t MiB = 1u << 20;
constexpr size_t WS_CTL = 0, CTL_ZERO_BYTES = 1 * MiB;
constexpr size_t WS_MOD = 1 * MiB;
constexpr size_t WS_TW = 2 * MiB;
constexpr size_t WS_S5AT = 3 * MiB;
constexpr size_t WS_WIN = 4 * MiB;
constexpr size_t WS_WGLU = WS_WIN + 45 * MiB;
constexpr size_t WS_WBR = WS_WGLU + 1 * MiB;
constexpr size_t WS_WOUT = WS_WBR + 8 * MiB;
constexpr size_t WS_WUP = WS_WOUT + 8 * MiB;
constexpr size_t WS_WDN = WS_WUP + 44 * MiB;
constexpr size_t WS_S5W = WS_WDN + 22 * MiB;
constexpr size_t WS_S5M = WS_S5W + 8 * MiB;
constexpr size_t WS_H2 = WS_S5M + 4 * MiB;
constexpr size_t WS_FSD = WS_H2 + 3 * MiB;
constexpr size_t FSD_C_OFF = (size_t)2 * 256 * 8193 * 16;
constexpr size_t WS_XRES = WS_FSD + 68 * MiB;
constexpr size_t WS_HN = WS_XRES + 132 * MiB;
constexpr size_t WS_PX = WS_HN + 66 * MiB;
constexpr size_t WS_S5A = WS_PX + 372 * MiB;
constexpr size_t WS_S5S = WS_S5A + 40 * MiB;
constexpr size_t WS_YAPRE = WS_S5S + 40 * MiB;
constexpr size_t WS_YCAT = WS_YAPRE + 20 * MiB;
constexpr size_t WS_MBUF = WS_YCAT + 66 * MiB;
constexpr size_t WS_GSLOC = WS_MBUF + 66 * MiB;
constexpr size_t WS_GSIN = WS_GSLOC + 66 * MiB;
constexpr size_t WS_GOF = WS_GSIN + 66 * MiB;
constexpr size_t WS_GDT = WS_GOF + 66 * MiB;
constexpr size_t WS_ACT = WS_GSLOC;
constexpr size_t WS_END = WS_GDT + 1 * MiB;
static_assert((size_t)MT * FFH * 2 <= 198 * MiB, "ACT overlay");
constexpr int CW_BAR = 4096;

constexpr int RING_BYTES = 131072;
constexpr int EXTRA_OFF = RING_BYTES, EXTRA_BYTES = 8192;
constexpr int LDSCTL_OFF = EXTRA_OFF + EXTRA_BYTES;
constexpr int LDS_BYTES = LDSCTL_OFF + 256;

__device__ __forceinline__ float wave_sum(float v) {
#pragma unroll
    for (int o = 1; o < 64; o <<= 1) v += __shfl_xor(v, o);
    return v;
}
__device__ __forceinline__ float sigmoidf_(float x) { return 1.0f / (1.0f + __expf(-x)); }
__device__ __forceinline__ float siluf_(float x) { return x * sigmoidf_(x); }
__device__ __forceinline__ float gelu_tanh_(float x) { const float u = 0.7978845608028654f * (x + 0.044715f * x * x * x); return x / (1.0f + __expf(-2.0f * u)); }
__device__ __forceinline__ float logsigmoidf_(float x) { return fminf(x, 0.f) - log1pf(expf(-fabsf(x))); }
__device__ __forceinline__ f32x2 cmul(f32x2 a, f32x2 b) { return (f32x2){a.x * b.x - a.y * b.y, a.x * b.y + a.y * b.x}; }
__device__ __forceinline__ f32x2 cconj(f32x2 a) { return (f32x2){a.x, -a.y}; }
__device__ __forceinline__ int opq(int x) { asm volatile("" : "+v"(x)); return x; }
#define LDS_WAIT() asm volatile("s_waitcnt lgkmcnt(0)" ::: "memory")
#define VM_WAIT() asm volatile("s_waitcnt vmcnt(0)" ::: "memory")

#define XB_TMO      128
#define XB_XCNT(j)  (256  + 64 * (j))
#define XB_XSUB(j)  (1280 + 64 * (j))
#define XB_XGEN(j)  (2304 + 64 * (j))
#define XB_TOP      3328
#define XB_TOPGEN   3392
#define XCD_BAR_WORDS 3456
#define XB_SPIN_CAP (1u << 18)
__device__ __forceinline__ unsigned xb_ld(unsigned* p)              { return __hip_atomic_load(p, __ATOMIC_RELAXED, __HIP_MEMORY_SCOPE_AGENT); }
__device__ __forceinline__ unsigned xb_add(unsigned* p, unsigned v) { return __hip_atomic_fetch_add(p, v, __ATOMIC_RELAXED, __HIP_MEMORY_SCOPE_AGENT); }
__device__ __forceinline__ unsigned xb_xcc_id() { return (unsigned)__builtin_amdgcn_s_getreg((3 << 11) | 20) & 0xFu; }
#define XB_SPIN(cond, bar) do { unsigned _sp = 0; while (cond) { __builtin_amdgcn_s_sleep(1); \
    if ((++_sp & 255u) == 0u) { if (xb_ld(&(bar)[XB_TMO])) break; if (_sp > XB_SPIN_CAP) { atomicAdd(&(bar)[XB_TMO], 1u); break; } } } } while (0)
struct XcdBarrier { unsigned* bar; unsigned x; volatile LAS unsigned* st; };
__device__ __forceinline__ XcdBarrier xcd_barrier_post(unsigned* bar, volatile LAS unsigned* st) {
    XcdBarrier b; b.bar = bar; b.x = xb_xcc_id(); b.st = st;
    if (threadIdx.x == 0) (void)xb_add(&bar[XB_XCNT(b.x)], 1u);
    return b;
}
__device__ __forceinline__ void xcd_barrier_complete(unsigned* bar, unsigned x, unsigned& nloc, unsigned& nx) {
    const unsigned G = gridDim.x * gridDim.y * gridDim.z;
    unsigned sum, cnt, mine, sp = 0u;
    for (;;) {
        sum = 0u; cnt = 0u; mine = 0u;
#pragma unroll
        for (unsigned j = 0; j < 16; ++j) { const unsigned c = xb_ld(&bar[XB_XCNT(j)]); sum += c; cnt += (c > 0u) ? 1u : 0u; mine = (j == x) ? c : mine; }
        if (sum == G) break;
        __builtin_amdgcn_s_sleep(1);
        if ((++sp & 255u) == 0u) { if (xb_ld(&bar[XB_TMO])) break; if (sp > XB_SPIN_CAP) { atomicAdd(&bar[XB_TMO], 1u); break; } }
    }
    nloc = mine > 0u ? mine : 1u; nx = cnt > 0u ? cnt : 1u;
}
__device__ __forceinline__ void xcd_barrier(const XcdBarrier& b) {
    asm volatile("s_waitcnt vmcnt(0)" ::: "memory");
    __syncthreads();
    if (threadIdx.x == 0) {
        unsigned* bar = b.bar;
        __builtin_amdgcn_s_waitcnt(0);
        unsigned nloc = b.st[0], nx = b.st[1];
        if (nloc == 0u) { xcd_barrier_complete(bar, b.x, nloc, nx); b.st[0] = nloc; b.st[1] = nx; }
        const unsigned old = xb_add(&bar[XB_XSUB(b.x)], 1u);
        const unsigned gen = old / nloc;
        if (old + 1u == (gen + 1u) * nloc) {
            __builtin_amdgcn_fence(__ATOMIC_RELEASE, "agent");
            asm volatile("s_waitcnt vmcnt(0)" ::: "memory");
            const unsigned og = xb_add(&bar[XB_TOP], 1u);
            const unsigned tg = og / nx;
            if (og + 1u == (tg + 1u) * nx) xb_add(&bar[XB_TOPGEN], 1u);
            else XB_SPIN(xb_ld(&bar[XB_TOPGEN]) == tg, bar);
            __builtin_amdgcn_fence(__ATOMIC_ACQUIRE, "agent");
            xb_add(&bar[XB_XGEN(b.x)], 1u);
            asm volatile("s_waitcnt vmcnt(0)" ::: "memory");
        } else {
            XB_SPIN(xb_ld(&bar[XB_XGEN(b.x)]) == gen, bar);
            __builtin_amdgcn_fence(__ATOMIC_ACQUIRE, "agent");
            asm volatile("s_waitcnt vmcnt(0)" ::: "memory");
        }
    }
    __syncthreads();
}

struct Args {
    const float* in[40];
    float* out; unsigned char* ws;
    int ph_lo, ph_hi;
};
struct Ctx {
    LAS unsigned char* lds;
    int tid, lane, wave, G, bid;
    unsigned char* ws;
};
enum { I_X = 0, I_C, I_CTX, I_CCTX, I_WMOD, I_BMOD, I_N1G, I_N2G, I_WIN, I_S5ARE, I_S5AIM, I_S5STEP, I_S5BRE, I_S5BIM, I_S5CRE, I_S5CIM,
       I_S5D, I_GLUW, I_GLUB, I_HYCW, I_HYCB, I_HYW1, I_HYB1, I_HYF1, I_HYW2, I_HYB2, I_HYF2, I_HYW3, I_HYB3, I_HYBIAS,
       I_GLAWG, I_GLABG, I_GLANG, I_WBR, I_WOUT, I_WUP, I_FFCW, I_FFCB, I_WDN, I_FNG };

namespace pg8 {
constexpr int BM = 256, BK = 64, HALF = 128, HTB = HALF * BK * 2, STAGE_BYTES = 8 * HTB, NXCD = 8, WGM = 8;
__device__ __forceinline__ int lds_byte(int r, int c) { const int st = (r >> 4) * 2 + (c >> 5), rr = r & 15, cc = c & 31, ob = rr * 64 + cc * 2; return st * 1024 + (ob ^ (((ob >> 9) & 1) << 5)); }
__device__ __forceinline__ void stage_rc(int b, int& R, int& C) { const int st = b / 1024, sb = b % 1024, swz = sb ^ (((sb >> 9) & 1) << 5); R = (st >> 1) * 16 + swz / 64; C = (st & 1) * 32 + (swz % 64) / 2; }
__device__ __forceinline__ int perm32(int rho) { const int n = rho >> 4, i = rho & 15; return 8 * (i >> 2) + 4 * n + (i & 3); }
struct Unit { const char* a; const char* b; int pm, pn; };
struct Order2D {
    int nM, nN, nwg, G, c;
    __device__ __forceinline__ void init(int nM_, int nN_, int G_, int c_) { nM = nM_; nN = nN_; nwg = nM * nN; G = G_; c = c_; }
    __device__ __forceinline__ bool nx(int i, int& pm, int& pn) const {
        const long L = (long)i * G + c; if (L >= nwg) return false;
        int wgid = (int)L; { const int q = nwg / NXCD, r = nwg % NXCD, xcd = wgid % NXCD, off = wgid / NXCD; wgid = (xcd < r ? xcd * (q + 1) : r * (q + 1) + (xcd - r) * q) + off; }
        const int nig = WGM * nN, gid = wgid / nig, fm = gid * WGM, gsz = (nM - fm) < WGM ? (nM - fm) : WGM;
        pm = fm + ((wgid % nig) % gsz); pn = (wgid % nig) / gsz; return true;
    }
};
struct SchedPlain : Order2D {
    const char* A; const char* B; size_t aTile, bTile;
    __device__ __forceinline__ bool next(int i, Unit& u) const { int pm, pn; if (!nx(i, pm, pn)) return false; u.pm = pm; u.pn = pn; u.a = A + (size_t)pm * aTile; u.b = B + (size_t)pn * bTile; return true; }
};
struct SchedS5 {
    const char* A; const char* B; size_t bGroup; int G, c;
    __device__ __forceinline__ bool next(int i, Unit& u) const { const int L = i * G + c; if (L >= 160) return false; const int g = L & 31, pm = L >> 5;
        u.pm = pm; u.pn = g; u.a = A + ((size_t)pm * 256 * 16384 + (size_t)g * 512) * 2; u.b = B + (size_t)g * bGroup; return true; }
};

#define PG8_SA(b, h) (((b) * 2 + (h)) * HTB)
#define PG8_SB(b, h) ((4 + (b) * 2 + (h)) * HTB)
#define PG8_STAGE(bufoff, gbase, voff) do { _Pragma("unroll") for (int _i = 0; _i < 2; ++_i) \
        __builtin_amdgcn_global_load_lds((const unsigned*)((const char*)(gbase) + (voff)[_i]), (LAS unsigned*)(lds + (bufoff) + ldsw + _i * 8192), 16, 0, 0); } while (0)
#define PG8_LDA(dst, b, h) do { _Pragma("unroll") for (int m = 0; m < 4; ++m) _Pragma("unroll") for (int k = 0; k < 2; ++k) dst[m][k] = *(const LAS f16x8*)(lds + PG8_SA(b, h) + aoff + m * 2048 + k * 1024); } while (0)
#define PG8_LDB(dst, b, h) do { _Pragma("unroll") for (int n = 0; n < 2; ++n) _Pragma("unroll") for (int k = 0; k < 2; ++k) dst[n][k] = *(const LAS f16x8*)(lds + PG8_SB(b, h) + boff + n * 2048 + k * 1024); } while (0)
#define PG8_MMA(ai, bj, At, Bt) do { __builtin_amdgcn_s_setprio(1); _Pragma("unroll") for (int m = 0; m < 4; ++m) _Pragma("unroll") for (int n = 0; n < 2; ++n) _Pragma("unroll") for (int k = 0; k < 2; ++k) \
        acc[ai][bj][m][n] = __builtin_amdgcn_mfma_f32_16x16x32_f16(Bt[n][k], At[m][k], acc[ai][bj][m][n], 0, 0, 0); __builtin_amdgcn_s_setprio(0); } while (0)
#define PG8_WAIT_V(n) asm volatile("s_waitcnt vmcnt(" #n ")" ::: "memory")
#define PG8_WAIT_L(n) asm volatile("s_waitcnt lgkmcnt(" #n ")" ::: "memory")
#define PG8_BAR __builtin_amdgcn_s_barrier()
#define PG8_SCHED __builtin_amdgcn_sched_barrier(0)

template <class Epi, class Sched>
__device__ __forceinline__ void gemm_phase(LAS unsigned char* lds, const int lda, const int ldb, const int nt, const Sched& S, const Epi& E) {
    const int tid = opq((int)threadIdx.x), wid = __builtin_amdgcn_readfirstlane(tid >> 6), lane = tid & 63, wr = wid >> 2, wc = wid & 3, fr = lane & 15, fq = lane >> 4;
    unsigned voffA[2], voffB[2];
#pragma unroll
    for (int i = 0; i < 2; ++i) { int R, C; stage_rc(tid * 16 + i * 8192, R, C); const int Rb = Epi::PERM ? ((R & ~31) + perm32(R & 31)) : R;
        voffA[i] = (unsigned)(R * lda + C) * 2u; voffB[i] = (unsigned)(Rb * ldb + C) * 2u; }
    const size_t kstep = (size_t)(BK * 2);
    const size_t hstepA = (size_t)HALF * lda * 2, hstepB = (size_t)HALF * ldb * 2;
    const unsigned ldsw = (unsigned)wid * 1024u;
    const int aoff = lds_byte(wr * 64 + fr, fq * 8), boff = lds_byte(wc * 32 + fr, fq * 8);
    Unit cur, nxt; int ui = 0;
    if (!S.next(0, cur)) return;
    f32x4 acc[2][2][4][2];
#pragma unroll
    for (int a = 0; a < 2; ++a)
#pragma unroll
        for (int b = 0; b < 2; ++b)
#pragma unroll
            for (int m = 0; m < 4; ++m)
#pragma unroll
                for (int n = 0; n < 2; ++n) acc[a][b][m][n] = (f32x4){0.f, 0.f, 0.f, 0.f};
    f16x8 At[4][2], B0[2][2], B1[2][2];
    const char* cA = cur.a; const char* cB = cur.b;
    PG8_STAGE(PG8_SB(0, 0), cB, voffB); PG8_STAGE(PG8_SA(0, 0), cA, voffA); PG8_STAGE(PG8_SB(0, 1), cB + hstepB, voffB); PG8_STAGE(PG8_SA(0, 1), cA + hstepA, voffA);
    if (wr == 1) PG8_BAR;
    PG8_WAIT_V(4); PG8_BAR;
    PG8_STAGE(PG8_SB(1, 0), cB + kstep, voffB); PG8_STAGE(PG8_SA(1, 0), cA + kstep, voffA); PG8_STAGE(PG8_SB(1, 1), cB + hstepB + kstep, voffB);
    PG8_WAIT_V(6); PG8_BAR;
    for (;;) {
        const bool has_next = S.next(ui + 1, nxt);
        const char* nA = has_next ? nxt.a : cA; const char* nB = has_next ? nxt.b : cB;
        for (int t = 0; t < nt; t += 2) {
            const bool last = (t == nt - 2);
            const char* a1 = cA + (size_t)(t + 1) * kstep;
            const char* a2 = last ? nA : cA + (size_t)(t + 2) * kstep; const char* b2 = last ? nB : cB + (size_t)(t + 2) * kstep;
            const char* a3 = a2 + kstep; const char* b3 = b2 + kstep;
            PG8_LDB(B0, 0, 0); PG8_SCHED; PG8_LDA(At, 0, 0); PG8_STAGE(PG8_SA(1, 1), a1 + hstepA, voffA);
            PG8_WAIT_L(8); PG8_BAR; PG8_WAIT_L(0); PG8_MMA(0, 0, At, B0); PG8_BAR; PG8_SCHED;
            PG8_LDB(B1, 0, 1); PG8_STAGE(PG8_SB(0, 0), b2, voffB);
            PG8_BAR; PG8_WAIT_L(0); PG8_MMA(0, 1, At, B1); PG8_BAR;
            PG8_LDA(At, 0, 1); PG8_STAGE(PG8_SA(0, 0), a2, voffA);
            PG8_BAR; PG8_WAIT_L(0); PG8_MMA(1, 0, At, B0); PG8_BAR; PG8_SCHED;
            PG8_STAGE(PG8_SB(0, 1), b2 + hstepB, voffB);
            PG8_WAIT_V(6); PG8_BAR; PG8_MMA(1, 1, At, B1); PG8_BAR;
            PG8_LDB(B0, 1, 0); PG8_SCHED; PG8_LDA(At, 1, 0); PG8_STAGE(PG8_SA(0, 1), a2 + hstepA, voffA);
            PG8_WAIT_L(8); PG8_BAR; PG8_WAIT_L(0); PG8_MMA(0, 0, At, B0); PG8_BAR; PG8_SCHED;
            PG8_LDB(B1, 1, 1); PG8_STAGE(PG8_SB(1, 0), b3, voffB);
            PG8_BAR; PG8_WAIT_L(0); PG8_MMA(0, 1, At, B1); PG8_BAR;
            PG8_LDA(At, 1, 1); PG8_STAGE(PG8_SA(1, 0), a3, voffA);
            PG8_BAR; PG8_WAIT_L(0); PG8_MMA(1, 0, At, B0); PG8_BAR; PG8_SCHED;
            PG8_STAGE(PG8_SB(1, 1), b3 + hstepB, voffB);
            PG8_WAIT_V(6); PG8_BAR; PG8_MMA(1, 1, At, B1); PG8_BAR;
        }
        E(acc, cur, wr, wc, fr, fq);
        if (!has_next) break;
#pragma unroll
        for (int a = 0; a < 2; ++a)
#pragma unroll
            for (int b = 0; b < 2; ++b)
#pragma unroll
                for (int m = 0; m < 4; ++m)
#pragma unroll
                    for (int n = 0; n < 2; ++n) acc[a][b][m][n] = (f32x4){0.f, 0.f, 0.f, 0.f};
        cur = nxt; cA = nA; cB = nB; ++ui;
    }
    PG8_WAIT_V(0);
    if (wr == 0) PG8_BAR;
    PG8_BAR;
}
#undef PG8_SA
#undef PG8_SB
#undef PG8_STAGE
#undef PG8_LDA
#undef PG8_LDB
#undef PG8_MMA
#undef PG8_WAIT_V
#undef PG8_WAIT_L
#undef PG8_BAR
#undef PG8_SCHED

typedef const f32x4 (&AccRef)[2][2][4][2];
__device__ __forceinline__ f16x8 pack8(f32x4 a, f32x4 b) { f16x8 w; w[0] = (f16)a[0]; w[1] = (f16)a[1]; w[2] = (f16)a[2]; w[3] = (f16)a[3]; w[4] = (f16)b[0]; w[5] = (f16)b[1]; w[6] = (f16)b[2]; w[7] = (f16)b[3]; return w; }

struct EpiPx {
    static constexpr bool PERM = true; f16* PX; f16* S5A;
    __device__ __forceinline__ void operator()(AccRef acc, const Unit& u, int wr, int wc, int fr, int fq) const { fr = opq(fr); fq = opq(fq);
        const int row0 = u.pm * BM + wr * 64 + fr, col0 = u.pn * BM + wc * 32 + 8 * fq;
#pragma unroll
        for (int ai = 0; ai < 2; ++ai)
#pragma unroll
            for (int m = 0; m < 4; ++m) { const int row = row0 + ai * HALF + m * 16;
#pragma unroll
                for (int bj = 0; bj < 2; ++bj) { const int c = col0 + bj * HALF; const f16x8 w = pack8(acc[ai][bj][m][0], acc[ai][bj][m][1]);
                    if (u.pn < 2) *(f16x8*)(S5A + (size_t)(row >> 4) * 16384 + (size_t)(c >> 4) * 512 + (row & 15) * 16 + (c & 15)) = w;
                    else *(f16x8*)(PX + (size_t)row * PXLD + c) = w; } }
    }
};
struct EpiF16 {
    static constexpr bool PERM = true; f16* O; int ldc;
    __device__ __forceinline__ void operator()(AccRef acc, const Unit& u, int wr, int wc, int fr, int fq) const { fr = opq(fr); fq = opq(fq);
        const int row0 = u.pm * BM + wr * 64 + fr, col0 = u.pn * BM + wc * 32 + 8 * fq;
#pragma unroll
        for (int ai = 0; ai < 2; ++ai)
#pragma unroll
            for (int m = 0; m < 4; ++m) { f16* rowp = O + (size_t)(row0 + ai * HALF + m * 16) * ldc + col0;
#pragma unroll
                for (int bj = 0; bj < 2; ++bj) *(f16x8*)(rowp + bj * HALF) = pack8(acc[ai][bj][m][0], acc[ai][bj][m][1]); }
    }
};
struct EpiS5In {
    static constexpr bool PERM = false; float* S;
    __device__ __forceinline__ void operator()(AccRef acc, const Unit& u, int wr, int wc, int fr, int fq) const { fr = opq(fr); fq = opq(fq);
        const int row0 = u.pm * BM + wr * 64 + fr, col0 = wc * 32 + 4 * fq, g = u.pn;
#pragma unroll
        for (int ai = 0; ai < 2; ++ai)
#pragma unroll
            for (int m = 0; m < 4; ++m) { const int row = row0 + ai * HALF + m * 16; { float* rowp = S + ((size_t)row * 32 + g) * 256 + col0;
#pragma unroll
                for (int bj = 0; bj < 2; ++bj)
#pragma unroll
                    for (int n = 0; n < 2; ++n) *(f32x4*)(rowp + bj * HALF + n * 16) = acc[ai][bj][m][n]; } }
    }
};
struct EpiS5Out {
    static constexpr bool PERM = true; const f16* S5A; f16* Y; const float* dvec;
    __device__ __forceinline__ void operator()(AccRef acc, const Unit& u, int wr, int wc, int fr, int fq) const { fr = opq(fr); fq = opq(fq);
        const int row0 = u.pm * BM + wr * 64 + fr, col0 = wc * 32 + 8 * fq, g = u.pn;
#pragma unroll
        for (int ai = 0; ai < 2; ++ai)
#pragma unroll
            for (int m = 0; m < 4; ++m) { const int chunk = row0 + ai * HALF + m * 16; {
#pragma unroll
                for (int bj = 0; bj < 2; ++bj) { const int c = col0 + bj * HALF, t = c >> 4, h0 = c & 15;
                    const f16x8 uu = *(const f16x8*)(S5A + (size_t)chunk * 16384 + (size_t)g * 512 + c);
                    const f32x4 d0 = *(const f32x4*)(dvec + g * 16 + h0), d1 = *(const f32x4*)(dvec + g * 16 + h0 + 4);
                    f16x8 w;
#pragma unroll
                    for (int j = 0; j < 4; ++j) { w[j] = (f16)gelu_tanh_(acc[ai][bj][m][0][j] * (1.0f / S5SCALE) + d0[j] * (float)uu[j]);
                                                  w[4 + j] = (f16)gelu_tanh_(acc[ai][bj][m][1][j] * (1.0f / S5SCALE) + d1[j] * (float)uu[4 + j]); }
                    *(f16x8*)(Y + (size_t)(chunk * 16 + t) * 512 + g * 16 + h0) = w; } asm volatile("" ::: "memory"); } }
    }
};
struct EpiGlu {
    static constexpr bool PERM = true; const f16* YP; f16* O; const float* bias;
    __device__ __forceinline__ void operator()(AccRef acc, const Unit& u, int wr, int wc, int fr, int fq) const { fr = opq(fr); fq = opq(fq);
        const int row0 = u.pm * BM + wr * 64 + fr, col0 = u.pn * BM + wc * 32 + 8 * fq;
#pragma unroll
        for (int ai = 0; ai < 2; ++ai)
#pragma unroll
            for (int m = 0; m < 4; ++m) { const int row = row0 + ai * HALF + m * 16;
#pragma unroll
                for (int bj = 0; bj < 2; ++bj) { const int c = col0 + bj * HALF;
                    const f16x8 yp = *(const f16x8*)(YP + (size_t)row * 512 + c);
                    const f32x4 b0 = *(const f32x4*)(bias + c), b1 = *(const f32x4*)(bias + c + 4);
                    f16x8 w;
#pragma unroll
                    for (int j = 0; j < 4; ++j) { w[j] = (f16)((float)yp[j] * sigmoidf_(acc[ai][bj][m][0][j] + b0[j])); w[4 + j] = (f16)((float)yp[4 + j] * sigmoidf_(acc[ai][bj][m][1][j] + b1[j])); }
                    *(f16x8*)(O + (size_t)row * 2048 + c) = w; } asm volatile("" ::: "memory"); }
    }
};
template <int BR> struct EpiBranch {
    static constexpr bool PERM = true; const f16* PX; f16* M;
    __device__ __forceinline__ void operator()(AccRef acc, const Unit& u, int wr, int wc, int fr, int fq) const { fr = opq(fr); fq = opq(fq);
        const int row0 = u.pm * BM + wr * 64 + fr, col0 = u.pn * BM + wc * 32 + 8 * fq;
#pragma unroll
        for (int ai = 0; ai < 2; ++ai)
#pragma unroll
            for (int m = 0; m < 4; ++m) { const int row = row0 + ai * HALF + m * 16;
#pragma unroll
                for (int bj = 0; bj < 2; ++bj) { const int c = col0 + bj * HALF;
                    const f16x8 gl = *(const f16x8*)(PX + (size_t)row * PXLD + P_MG + BR * 2048 + c);
                    f16* mp = M + (size_t)row * 2048 + c;
                    f16x8 prev; if (BR > 0) prev = *(const f16x8*)mp;
                    f16x8 w;
#pragma unroll
                    for (int j = 0; j < 4; ++j) { float v0 = sigmoidf_((float)gl[j]) * acc[ai][bj][m][0][j], v1 = sigmoidf_((float)gl[4 + j]) * acc[ai][bj][m][1][j];
                        if (BR > 0) { v0 += (float)prev[j]; v1 += (float)prev[4 + j]; } w[j] = (f16)v0; w[4 + j] = (f16)v1; }
                    *(f16x8*)mp = w; } asm volatile("" ::: "memory"); }
    }
};
struct EpiResid {
    static constexpr bool PERM = false; float* X; const float* mod; int goff;
    __device__ __forceinline__ void operator()(AccRef acc, const Unit& u, int wr, int wc, int fr, int fq) const { fr = opq(fr); fq = opq(fq);
        const int row0 = u.pm * BM + wr * 64 + fr, col0 = u.pn * BM + wc * 32 + 4 * fq;
        const int bsel = u.pm < 32 ? 0 : (u.pm < 64 ? 1 : 2);
        const float* gp = mod + bsel * 12288 + goff + col0;
        f32x4 gv[2][2];
#pragma unroll
        for (int bj = 0; bj < 2; ++bj)
#pragma unroll
            for (int n = 0; n < 2; ++n) gv[bj][n] = *(const f32x4*)(gp + bj * HALF + n * 16);
#pragma unroll
        for (int ai = 0; ai < 2; ++ai)
#pragma unroll
            for (int m = 0; m < 4; ++m) { float* rowp = X + (size_t)(row0 + ai * HALF + m * 16) * D + col0;
#pragma unroll
                for (int bj = 0; bj < 2; ++bj)
#pragma unroll
                    for (int n = 0; n < 2; ++n) { f32x4* p = (f32x4*)(rowp + bj * HALF + n * 16); *p = *p + gv[bj][n] * acc[ai][bj][m][n]; } asm volatile("" ::: "memory"); }
    }
};
}


__device__ __forceinline__ void ph_prologue(const Ctx& F, const Args& A) {
    const int gt = F.bid * 512 + F.tid, NT = F.G * 512;
    { const f32x4* xs = (const f32x4*)A.in[I_X]; const f32x4* cs = (const f32x4*)A.in[I_CTX]; f32x4* xr = (f32x4*)(F.ws + WS_XRES);
      for (int i = gt; i < MX * D / 4; i += NT) xr[i] = xs[i];
      for (int i = gt; i < MC * D / 4; i += NT) xr[MX * D / 4 + i] = cs[i]; }
    { f32x2* tw = (f32x2*)(F.ws + WS_TW);
      for (int k = gt; k < 16384; k += NT) { float s, c; sincospif((float)k * (2.0f / 16384.0f), &s, &c); tw[k] = (f32x2){c, -s}; } }
    LAS float* sc = (LAS float*)F.lds;
    LAS float* red = (LAS float*)(F.lds + 3 * 2048 * 4);
    for (int i = F.tid; i < 3 * 2048; i += 512) { const int r = i / 2048, k = i % 2048; const float v = r < 2 ? A.in[I_C][r * 2048 + k] : A.in[I_CCTX][k]; sc[i] = siluf_(v); }
    __syncthreads();
    const int col = F.tid & 63, ks = F.tid >> 6;
    for (int chunk = F.bid; chunk < DEPTH * 192; chunk += F.G) {
        const int l = chunk / 192, n0 = (chunk % 192) * 64;
        const float* w = A.in[I_WMOD] + (size_t)l * 2048 * 12288 + n0 + col;
        float s0 = 0.f, s1 = 0.f, s2 = 0.f;
#pragma unroll 8
        for (int k = ks * 256; k < ks * 256 + 256; ++k) { const float wv = w[(size_t)k * 12288]; s0 += sc[k] * wv; s1 += sc[2048 + k] * wv; s2 += sc[4096 + k] * wv; }
        red[(ks * 3 + 0) * 64 + col] = s0; red[(ks * 3 + 1) * 64 + col] = s1; red[(ks * 3 + 2) * 64 + col] = s2;
        __syncthreads();
        if (F.tid < 192) { const int r = F.tid >> 6, c2 = F.tid & 63; float s = 0.f;
#pragma unroll
            for (int q = 0; q < 8; ++q) s += red[(q * 3 + r) * 64 + c2];
            ((float*)(F.ws + WS_MOD))[((size_t)l * 3 + r) * 12288 + n0 + c2] = s + A.in[I_BMOD][(size_t)l * 12288 + n0 + c2]; }
        __syncthreads();
    }
}

__device__ __forceinline__ void transpose_item(const float* W, int ldw, int k0, int srccol0, f16* WT, int dstrow0, int ldk, LAS float* scr, int lane) {
#pragma unroll 8
    for (int i = 0; i < 32; ++i) { const int kk = 2 * i + (lane >> 5); scr[kk * 33 + (lane & 31)] = srccol0 >= 0 ? W[(size_t)(k0 + kk) * ldw + srccol0 + (lane & 31)] : 0.f; }
    LDS_WAIT(); asm volatile("" ::: "memory");
    const int c = lane & 7;
#pragma unroll
    for (int j = 0; j < 4; ++j) { const int n = (lane >> 3) + 8 * j; const LAS float* s = scr + (8 * c) * 33 + n;
        f16x8 o;
#pragma unroll
        for (int e = 0; e < 8; ++e) o[e] = (f16)s[e * 33];
        *(f16x8*)(WT + (size_t)(dstrow0 + n) * ldk + k0 + 8 * c) = o; }
    LDS_WAIT(); asm volatile("" ::: "memory");
}
__device__ __forceinline__ void ph_convert_weights(const Ctx& F, const Args& A, int l) {
    LAS float* scr = (LAS float*)(F.lds + F.wave * 16384);
    const int gw = F.bid * 8 + F.wave, NGW = F.G * 8;
    constexpr int I_IN = 32 * 360, I_GLU = 8 * 16, I_BR = 32 * 64, I_OUT = 32 * 64, I_UP = 32 * 352, I_DN = 88 * 64;
    constexpr int NIT = I_IN + I_GLU + I_BR + I_OUT + I_UP + I_DN;
    for (int it = gw; it < NIT; it += NGW) {
        int r = it;
        if (r < I_IN) { const int kb = r / 360, nb = r % 360, j0 = nb * 32;
            const int src = j0 < 2048 ? j0 : (j0 < 11264 ? j0 + 32 : (j0 < 11296 ? 2048 + (j0 - 11264) : -1));
            transpose_item(A.in[I_WIN] + (size_t)l * 2048 * INW, INW, kb * 64, src, (f16*)(F.ws + WS_WIN), j0, 2048, scr, F.lane); continue; } r -= I_IN;
        if (r < I_GLU) { const int kb = r / 16, nb = r % 16; transpose_item(A.in[I_GLUW] + (size_t)l * 512 * 512, 512, kb * 64, nb * 32, (f16*)(F.ws + WS_WGLU), nb * 32, 512, scr, F.lane); continue; } r -= I_GLU;
        if (r < I_BR) { const int kb = r / 64, nb = r % 64; transpose_item(A.in[I_WBR] + (size_t)l * 2048 * 2048, 2048, kb * 64, nb * 32, (f16*)(F.ws + WS_WBR), nb * 32, 2048, scr, F.lane); continue; } r -= I_BR;
        if (r < I_OUT) { const int kb = r / 64, nb = r % 64; transpose_item(A.in[I_WOUT] + (size_t)l * 2048 * 2048, 2048, kb * 64, nb * 32, (f16*)(F.ws + WS_WOUT), nb * 32, 2048, scr, F.lane); continue; } r -= I_OUT;
        if (r < I_UP) { const int kb = r / 352, nb = r % 352; transpose_item(A.in[I_WUP] + (size_t)l * 2048 * UPLD, UPLD, kb * 64, nb * 32, (f16*)(F.ws + WS_WUP), nb * 32, 2048, scr, F.lane); continue; } r -= I_UP;
        { const int kb = r / 64, nb = r % 64; transpose_item(A.in[I_WDN] + (size_t)l * FFH * 2048, 2048, kb * 64, nb * 32, (f16*)(F.ws + WS_WDN), nb * 32, FFH, scr, F.lane); }
    }
}

__device__ __forceinline__ void s5_mats_group(const Ctx& F, const Args& A, int l, int g) {
    LAS f32x2* APOW = (LAS f32x2*)F.lds;
    LAS f32x2* BBAR = APOW + 2 * 17 * 64;
    LAS f32x2* CM = BBAR + 2 * 64 * 16;
    LAS float* KLAG = (LAS float*)(CM + 2 * 16 * 64);
    __syncthreads();
    for (int i = F.tid; i < 2 * 17 * 64; i += 512) { const int d = i / (17 * 64), e = (i / 64) % 17, n = i % 64;
        const size_t pi = (((size_t)l * 2 + d) * 32 + g) * 64 + n;
        const float are = A.in[I_S5ARE][pi], aim = A.in[I_S5AIM][pi], dt = expf(A.in[I_S5STEP][((size_t)l * 2 + d) * 32 + g]);
        const float zr = are * dt * (float)e, zi = aim * dt * (float)e; float s, c; sincosf(zi, &s, &c); const float m = expf(zr);
        APOW[i] = (f32x2){m * c, m * s}; }
    __syncthreads();
    for (int i = F.tid; i < 2 * 64 * 16; i += 512) { const int d = i / 1024, n = (i / 16) % 64, h = i % 16;
        const size_t pi = (((size_t)l * 2 + d) * 32 + g) * 64 + n;
        const float are = A.in[I_S5ARE][pi], aim = A.in[I_S5AIM][pi];
        const f32x2 ab = APOW[(d * 17 + 1) * 64 + n]; const f32x2 num = (f32x2){ab.x - 1.0f, ab.y};
        const float den = are * are + aim * aim; const f32x2 q = (f32x2){(num.x * are + num.y * aim) / den, (num.y * are - num.x * aim) / den};
        const size_t bi = (pi * 16) + h;
        BBAR[i] = cmul(q, (f32x2){A.in[I_S5BRE][bi], A.in[I_S5BIM][bi]});
        const size_t ci = ((((size_t)l * 2 + d) * 32 + g) * 16 + h) * 64 + n;
        CM[(d * 16 + h) * 64 + n] = (f32x2){A.in[I_S5CRE][ci], A.in[I_S5CIM][ci]}; }
    __syncthreads();
    for (int i = F.tid; i < 2 * 16 * 256; i += 512) { const int d = i / 4096, lag = (i / 256) % 16, h = (i / 16) % 16, hp = i % 16; float s = 0.f;
        for (int n = 0; n < 64; ++n) { const f32x2 t = cmul(CM[(d * 16 + h) * 64 + n], APOW[(d * 17 + lag) * 64 + n]); const f32x2 b = BBAR[(d * 64 + n) * 16 + hp]; s += t.x * b.x - t.y * b.y; }
        KLAG[i] = s; }
    __syncthreads();
    f16* W = (f16*)(F.ws + WS_S5W) + (size_t)g * 256 * 512;
    for (int i = F.tid; i < 256 * 64; i += 512) { const int n = i / 64, k8 = (i % 64) * 8, t = n >> 4, h = n & 15; f16x8 o;
#pragma unroll
        for (int e = 0; e < 8; ++e) { const int k = k8 + e; float v;
            if (k < 256) { const int s = k >> 4, hp = k & 15; v = 0.f;
                if (t >= s) v += KLAG[((0 * 16 + (t - s)) * 16 + h) * 16 + hp];
                if (s >= t) v += KLAG[((1 * 16 + (s - t)) * 16 + h) * 16 + hp];
                v *= S5SCALE; }
            else { const int d = (k - 256) >> 7, nn2 = (k - 256) & 127, nn = nn2 & 63, im = nn2 >> 6, ex = d == 0 ? t + 1 : 16 - t;
                const f32x2 z = cmul(CM[(d * 16 + h) * 64 + nn], APOW[(d * 17 + ex) * 64 + nn]); v = im ? -z.y : z.x; }
            o[e] = (f16)v; }
        *(f16x8*)(W + (size_t)n * 512 + k8) = o; }
    f16* Mx = (f16*)(F.ws + WS_S5M) + (size_t)g * 256 * 256;
    for (int i = F.tid; i < 256 * 32; i += 512) { const int n = i / 32, k8 = (i % 32) * 8, d = n >> 7, ri = (n >> 6) & 1, nn = n & 63; f16x8 o;
#pragma unroll
        for (int e = 0; e < 8; ++e) { const int k = k8 + e, s = k >> 4, hp = k & 15, ex = d == 0 ? 15 - s : s;
            const f32x2 z = cmul(APOW[(d * 17 + ex) * 64 + nn], BBAR[(d * 64 + nn) * 16 + hp]); o[e] = (f16)((ri ? z.y : z.x) * S5SCALE); }
        *(f16x8*)(Mx + (size_t)n * 256 + k8) = o; }
    if (F.tid < 128) { const int d = F.tid >> 6, nn = F.tid & 63; ((f32x2*)(F.ws + WS_S5AT))[(d * 32 + g) * 64 + nn] = APOW[(d * 17 + 16) * 64 + nn]; }
    __syncthreads();
}

__device__ __forceinline__ void ph_hyena_h2(const Ctx& F, const Args& A, int l) {
    LAS float* W1 = (LAS float*)F.lds;
    LAS float* W2 = W1 + 33 * 64;
    LAS float* PV = W2 + 64 * 64;
    LAS float* SCR = PV + 256;
    __syncthreads();
    for (int i = F.tid; i < 33 * 64; i += 512) W1[i] = A.in[I_HYW1][(size_t)l * 33 * 64 + i];
    for (int i = F.tid; i < 64 * 64; i += 512) W2[i] = A.in[I_HYW2][(size_t)l * 4096 + i];
    if (F.tid < 64) { PV[F.tid] = A.in[I_HYB1][l * 64 + F.tid]; PV[64 + F.tid] = A.in[I_HYF1][l * 64 + F.tid]; PV[128 + F.tid] = A.in[I_HYB2][l * 64 + F.tid]; PV[192 + F.tid] = A.in[I_HYF2][l * 64 + F.tid]; }
    __syncthreads();
    LAS float* scr = SCR + F.wave * 64;
    const int gw = F.bid * 8 + F.wave, NGW = F.G * 8, j = F.lane;
    float* H2 = (float*)(F.ws + WS_H2);
    for (int p = gw; p < SEQ + LC; p += NGW) {
        const int n = p < SEQ ? SEQ : LC, pos = p < SEQ ? p : p - SEQ;
        float feat = 0.f;
        if (j == 0) feat = (float)pos / (float)(n - 1);
        else if (j < 33) { const int fi = (j - 1) & 15; const float fr = 1e-4f + (float)fi * ((15.0f - 1e-4f) / 15.0f);
            const float ang = (6.283185307179586f / (float)n) * (float)pos * fr; float s, c; sincosf(ang, &s, &c); feat = j < 17 ? c : -s; }
        scr[j] = feat; LDS_WAIT(); asm volatile("" ::: "memory");
        float a = PV[j];
        for (int i = 0; i < 33; ++i) a += scr[i] * W1[i * 64 + j];
        const float h1 = sinf(PV[64 + j] * a);
        LDS_WAIT(); asm volatile("" ::: "memory");
        scr[j] = h1; LDS_WAIT(); asm volatile("" ::: "memory");
        float b = PV[128 + j];
        for (int i = 0; i < 64; ++i) b += scr[i] * W2[i * 64 + j];
        H2[(size_t)p * 64 + j] = sinf(PV[192 + j] * b);
        LDS_WAIT(); asm volatile("" ::: "memory");
    }
}

__device__ __forceinline__ void ph_norm(const Ctx& F, const Args& A, int l, int which) {
    const int gw = F.bid * 8 + F.wave, NGW = F.G * 8;
    const float* X = (const float*)(F.ws + WS_XRES); f16* O = (f16*)(F.ws + WS_HN);
    const float* gain = A.in[which ? I_N2G : I_N1G] + (size_t)l * D;
    const float* mod = (const float*)(F.ws + WS_MOD) + (size_t)l * 3 * 12288;
    const int shoff = which ? 6144 : 0, soff = which ? 8192 : 2048;
    for (int m = gw; m < MT; m += NGW) {
        const int bsel = m < SEQ ? 0 : (m < MX ? 1 : 2);
        const f32x4* xr = (const f32x4*)(X + (size_t)m * D) + F.lane;
        f32x4 v[8]; float s = 0.f;
#pragma unroll
        for (int j = 0; j < 8; ++j) { v[j] = xr[64 * j]; s += (v[j].x * v[j].x + v[j].y * v[j].y) + (v[j].z * v[j].z + v[j].w * v[j].w); }
        const float rstd = 1.0f / sqrtf(wave_sum(s) * (1.0f / D) + EPS);
        const float* mp = mod + bsel * 12288;
#pragma unroll
        for (int j = 0; j < 8; ++j) { const int c = 4 * F.lane + 256 * j;
            const f32x4 g = *(const f32x4*)(gain + c), sh = *(const f32x4*)(mp + shoff + c), sc = *(const f32x4*)(mp + soff + c);
            f16x4 o;
#pragma unroll
            for (int e = 0; e < 4; ++e) o[e] = (f16)(v[j][e] * rstd * g[e] * (1.0f + sc[e]) + sh[e]);
            *(f16x4*)(O + (size_t)m * D + c) = o; }
    }
}
__device__ __forceinline__ void ph_final_norm(const Ctx& F, const Args& A) {
    const int gw = F.bid * 8 + F.wave, NGW = F.G * 8;
    const float* X = (const float*)(F.ws + WS_XRES); const float* gain = A.in[I_FNG];
    for (int m = gw; m < MX; m += NGW) {
        const f32x4* xr = (const f32x4*)(X + (size_t)m * D) + F.lane;
        f32x4 v[8]; float s = 0.f;
#pragma unroll
        for (int j = 0; j < 8; ++j) { v[j] = xr[64 * j]; s += (v[j].x * v[j].x + v[j].y * v[j].y) + (v[j].z * v[j].z + v[j].w * v[j].w); }
        const float rstd = 1.0f / sqrtf(wave_sum(s) * (1.0f / D) + EPS);
#pragma unroll
        for (int j = 0; j < 8; ++j) { const int c = 4 * F.lane + 256 * j; const f32x4 g = *(const f32x4*)(gain + c);
            *(f32x4*)(A.out + (size_t)m * D + c) = v[j] * rstd * g; }
    }
}

__device__ __forceinline__ void ph_s5_scan(const Ctx& F) {
    if (F.tid >= 32) return;
    const float* S = (const float*)(F.ws + WS_S5S); f16* SA = (f16*)(F.ws + WS_S5A);
    for (int gt = F.bid * 32 + F.tid; gt < 2 * 2 * 32 * 64; gt += F.G * 32) {
        const int nn = gt & 63, g = (gt >> 6) & 31, d = (gt >> 11) & 1, b = gt >> 12;
        const f32x2 at = ((const f32x2*)(F.ws + WS_S5AT))[(d * 32 + g) * 64 + nn];
        f32x2 st = (f32x2){0.f, 0.f};
        for (int base = 0; base < 16 + 512; base += 16) {
            f32x2 loc[16]; int chk[16];
#pragma unroll
            for (int u = 0; u < 16; ++u) { const int step = base + u; int chunk;
                if (d == 0) chunk = step < 16 ? 1024 + b * 16 + step : b * 512 + (step - 16);
                else chunk = step < 16 ? 1024 + b * 16 + (15 - step) : b * 512 + (511 - (step - 16));
                chk[u] = chunk; const size_t so = ((size_t)chunk * 32 + g) * 256 + d * 128 + nn;
                loc[u] = (f32x2){S[so], S[so + 64]}; }
#pragma unroll
            for (int u = 0; u < 16; ++u) { f16* xp = SA + (size_t)chk[u] * 16384 + (size_t)g * 512 + 256 + d * 128 + nn;
                xp[0] = (f16)st.x; xp[64] = (f16)st.y;
                st = cmul(at, st) + loc[u]; }
        }
    }
}

__device__ __forceinline__ void ph_ffn_act(const Ctx& F, const Args& A, int l) {
    const f16* UP = (const f16*)(F.ws + WS_PX); f16* ACT = (f16*)(F.ws + WS_ACT);
    const float* cw = A.in[I_FFCW] + (size_t)l * 3 * FFH; const float* cb = A.in[I_FFCB] + (size_t)l * FFH;
    const int NTASK = (MT / 16) * (FFH / 8);
    for (int task = F.bid * 512 + F.tid; task < NTASK; task += F.G * 512) {
        const int rb = task / (FFH / 8), cg = task % (FFH / 8), c0 = cg * 8, r0 = rb * 16;
        int seq0, seqn; if (r0 < MX) { seq0 = (r0 / SEQ) * SEQ; seqn = SEQ; } else { seq0 = MX + ((r0 - MX) / LC) * LC; seqn = LC; }
        float w0[8], w1[8], w2[8], bb[8];
#pragma unroll
        for (int e = 0; e < 8; ++e) { w0[e] = cw[c0 + e]; w1[e] = cw[FFH + c0 + e]; w2[e] = cw[2 * FFH + c0 + e]; bb[e] = cb[c0 + e]; }
        f16x8 zero;
#pragma unroll
        for (int e = 0; e < 8; ++e) zero[e] = (f16)0.f;
        f16x8 pm = (r0 > seq0) ? *(const f16x8*)(UP + (size_t)(r0 - 1) * UPLD + c0) : zero;
        f16x8 pc = *(const f16x8*)(UP + (size_t)r0 * UPLD + c0);
#pragma unroll 4
        for (int i = 0; i < 16; ++i) { const int r = r0 + i;
            const f16x8 pn = (r + 1 < seq0 + seqn) ? *(const f16x8*)(UP + (size_t)(r + 1) * UPLD + c0) : zero;
            const f16x8 bv = *(const f16x8*)(UP + (size_t)r * UPLD + FFH + c0);
            f16x8 o;
#pragma unroll
            for (int e = 0; e < 8; ++e) { const float a = w0[e] * (float)pm[e] + w1[e] * (float)pc[e] + w2[e] * (float)pn[e] + bb[e]; o[e] = (f16)(siluf_(a) * (float)bv[e]); }
            *(f16x8*)(ACT + (size_t)r * FFH + c0) = o;
            pm = pc; pc = pn; }
    }
}

namespace gla {
constexpr int QK_LD = 136, KH_LD = 72, VT_LD = 72, P_LD = 72;
constexpr int OFF_QT = 0;
constexpr int OFF_KT = 17408;
constexpr int OFF_VT = OFF_KT + 18432;
constexpr int OFF_P = OFF_VT + 36864;
constexpr int OFF_LR = OFF_P + 9216;
constexpr int OFF_GT = OFF_LR + 4096;
constexpr int OFF_DEC = OFF_GT + 2048;
constexpr int OFF_RS = OFF_DEC + 512;
constexpr int OFF_QR = OFF_RS + 2048;
constexpr int OFF_KR = OFF_QR + 17408;
constexpr int OFF_WG = OFF_KR + 17408;
static_assert(OFF_WG + 8192 <= LDSCTL_OFF, "gla lds");

__device__ __forceinline__ int grow(int b, int sc, int j, int i) {
    if (sc < 32) { const int col = 2 * sc + (j >> 1), r = (j & 1) * 64 + i; return b * SEQ + r * 64 + col; }
    return MX + b * LC + j * 64 + i;
}
#define GLA_MFMA(a, b, c) __builtin_amdgcn_mfma_f32_16x16x32_f16(a, b, c, 0, 0, 0)

template <bool FULL>
__device__ __forceinline__ void gla_unit(const Ctx& F, const Args& A, int l, int unit) {
    const int b = unit / (4 * NSC), h = (unit / NSC) % 4, sc = unit % NSC;
    LAS f16* QT = (LAS f16*)(F.lds + OFF_QT); LAS f16* KT = (LAS f16*)(F.lds + OFF_KT); LAS f16* VT = (LAS f16*)(F.lds + OFF_VT);
    LAS f16* PP = (LAS f16*)(F.lds + OFF_P); LAS f16* LR = (LAS f16*)(F.lds + OFF_LR);
    LAS float* GT = (LAS float*)(F.lds + OFF_GT); LAS float* DEC = (LAS float*)(F.lds + OFF_DEC); LAS float* RS = (LAS float*)(F.lds + OFF_RS);
    LAS f16* QR = (LAS f16*)(F.lds + OFF_QR); LAS f16* KR = (LAS f16*)(F.lds + OFF_KR); LAS float* WG = (LAS float*)(F.lds + OFF_WG);
    const int tid = F.tid, lane = F.lane, w = F.wave, q0 = lane >> 4, c0 = lane & 15;
    const int dk0 = tid & 127, ig0 = tid >> 7;
    const f16* PX = (const f16*)(F.ws + WS_PX);
    const float scale = 0.08838834764831845f;
    for (int dir = 0; dir < 2; ++dir) {
        __syncthreads();
        for (int i = tid; i < 16 * 128; i += 512) WG[i] = A.in[I_GLAWG][(((size_t)l * 2 + dir) * 16 + (i >> 7)) * 512 + h * 128 + (i & 127)];
        const float bgv = A.in[I_GLABG][((size_t)l * 2 + dir) * 512 + h * 128 + dk0];
        const size_t sidx = ((((size_t)b * 4 + h) * NSC + sc) * 2 + dir);
        f32x4 accS[8][2];
        if (FULL) { const float* Sin = (const float*)(F.ws + WS_GSIN) + sidx * 32768; const int q = opq(q0), c = opq(c0);
#pragma unroll
            for (int dt = 0; dt < 8; ++dt)
#pragma unroll
                for (int et = 0; et < 2; ++et)
#pragma unroll
                    for (int r = 0; r < 4; ++r) accS[dt][et][r] = Sin[(16 * dt + 4 * q + r) * 256 + 32 * w + 16 * et + c]; }
        else {
#pragma unroll
            for (int dt = 0; dt < 8; ++dt)
#pragma unroll
                for (int et = 0; et < 2; ++et) accS[dt][et] = (f32x4){0.f, 0.f, 0.f, 0.f}; }
        float sumtot = 0.f;
        for (int jj = 0; jj < 4; ++jj) {
            const int j = dir ? 3 - jj : jj;
            __syncthreads();
            const int tid = opq(F.tid);
            if (tid < 256) { const int row = tid >> 2, part = tid & 3; const int gr = grow(b, sc, j, row);
                *(LAS f16x8*)(LR + row * 32 + part * 8) = *(const f16x8*)(PX + (size_t)gr * PXLD + P_GG + part * 8); }
#pragma unroll 1
            for (int k = 0; k < 4; ++k) { const int idx = tid + 512 * k, wi = idx >> 6, ln = idx & 63, rr = ln >> 2, cc = ln & 3;
                const int row = (wi & 3) * 16 + rr, chunk = (wi >> 2) * 4 + cc; const int gr = grow(b, sc, j, row);
                const f16x8 v8 = *(const f16x8*)(PX + (size_t)gr * PXLD + P_GV + h * 256 + chunk * 8);
#pragma unroll
                for (int e = 0; e < 8; ++e) VT[(chunk * 8 + e) * VT_LD + row] = v8[e]; }
#pragma unroll 1
            for (int k = 0; k < 2; ++k) { const int idx = tid + 512 * k, row = idx >> 4, ch = idx & 15; const int gr = grow(b, sc, j, row);
                *(LAS f16x8*)(KR + row * QK_LD + ch * 8) = *(const f16x8*)(PX + (size_t)gr * PXLD + P_GK + h * 128 + ch * 8);
                if (FULL) *(LAS f16x8*)(QR + row * QK_LD + ch * 8) = *(const f16x8*)(PX + (size_t)gr * PXLD + P_GQ + h * 128 + ch * 8); }
            __syncthreads();
            const int dk = opq(dk0), ig = opq(ig0);
            float bv[16];
#pragma unroll
            for (int ii = 0; ii < 16; ++ii) { const int i = ig * 16 + ii; float pre = bgv;
                const f16x8 l0 = *(const LAS f16x8*)(LR + i * 32 + dir * 16), l1 = *(const LAS f16x8*)(LR + i * 32 + dir * 16 + 8);
#pragma unroll
                for (int r = 0; r < 8; ++r) pre += (float)l0[r] * WG[r * 128 + dk] + (float)l1[r] * WG[(8 + r) * 128 + dk];
                bv[ii] = logsigmoidf_(pre) * (1.0f / 16.0f); asm volatile("" ::: "memory"); }
            float totloc;
            if (dir == 0) {
#pragma unroll
                for (int ii = 1; ii < 16; ++ii) bv[ii] += bv[ii - 1];
                totloc = bv[15]; }
            else {
#pragma unroll
                for (int ii = 14; ii >= 0; --ii) bv[ii] += bv[ii + 1];
                totloc = bv[0]; }
            GT[ig * 128 + dk] = totloc;
            __syncthreads();
            const float g0 = GT[dk], g1 = GT[128 + dk], g2 = GT[256 + dk], g3 = GT[384 + dk];
            const float total = (g0 + g1) + (g2 + g3);
            float off, bmid;
            if (dir == 0) { off = (ig > 0 ? g0 : 0.f) + (ig > 1 ? g1 : 0.f) + (ig > 2 ? g2 : 0.f); bmid = g0 + g1; }
            else { off = (ig < 3 ? g3 : 0.f) + (ig < 2 ? g2 : 0.f) + (ig < 1 ? g1 : 0.f); bmid = g2 + g3; }
#pragma unroll
            for (int ii = 0; ii < 16; ++ii) bv[ii] += off;
            if (FULL) {
#pragma unroll
                for (int ii = 0; ii < 16; ++ii) { const int i = ig * 16 + ii;
                    QT[i * QK_LD + dk] = (f16)((float)QR[i * QK_LD + dk] * scale * __expf(fminf(bv[ii] - bmid, 9.f)));
                    KT[i * QK_LD + dk] = (f16)((float)KR[i * QK_LD + dk] * __expf(fminf(bmid - bv[ii], 9.f))); if ((ii & 3) == 3) asm volatile("" ::: "memory"); }
                __syncthreads();
                { const int c = opq(c0), q = opq(q0);
#pragma unroll
                for (int s = 0; s < 2; ++s) { const int T = 2 * w + s, it = T >> 2, jt = T & 3; f32x4 a = (f32x4){0.f, 0.f, 0.f, 0.f};
#pragma unroll
                    for (int kk = 0; kk < 4; ++kk) { const f16x8 kf = *(const LAS f16x8*)(KT + (jt * 16 + c) * QK_LD + kk * 32 + 8 * q);
                        const f16x8 qf = *(const LAS f16x8*)(QT + (it * 16 + c) * QK_LD + kk * 32 + 8 * q); a = GLA_MFMA(kf, qf, a); }
                    const int i = it * 16 + c; f16x4 pv;
#pragma unroll
                    for (int r = 0; r < 4; ++r) { const int jx = jt * 16 + 4 * q + r; const bool keep = dir == 0 ? (jx <= i) : (jx >= i); pv[r] = keep ? (f16)a[r] : (f16)0.f; }
                    *(LAS f16x4*)(PP + i * P_LD + jt * 16 + 4 * q) = pv; } }
                __syncthreads();
#pragma unroll
                for (int ii = 0; ii < 16; ++ii) { const int i = ig * 16 + ii; QT[i * QK_LD + dk] = (f16)((float)QR[i * QK_LD + dk] * scale * __expf(bv[ii])); if ((ii & 3) == 3) asm volatile("" ::: "memory"); }
            }
            { f16x8 k0, k1;
#pragma unroll
              for (int ii = 0; ii < 8; ++ii) { k0[ii] = (f16)((float)KR[(ig * 16 + ii) * QK_LD + dk] * __expf(total - bv[ii])); k1[ii] = (f16)((float)KR[(ig * 16 + 8 + ii) * QK_LD + dk] * __expf(total - bv[8 + ii])); }
              *(LAS f16x8*)(KT + dk * KH_LD + ig * 16) = k0; *(LAS f16x8*)(KT + dk * KH_LD + ig * 16 + 8) = k1; }
            if (ig == 0) { DEC[dk] = __expf(total); sumtot += total; }
            __syncthreads();
            const int c = opq(c0), q = opq(q0);
            if (FULL) {
                f32x4 accO[4][2];
#pragma unroll
                for (int it = 0; it < 4; ++it)
#pragma unroll
                    for (int et = 0; et < 2; ++et) accO[it][et] = (f32x4){0.f, 0.f, 0.f, 0.f};
#pragma unroll
                for (int et = 0; et < 2; ++et)
#pragma unroll
                    for (int kk = 0; kk < 2; ++kk) { const f16x8 vf = *(const LAS f16x8*)(VT + (32 * w + 16 * et + c) * VT_LD + kk * 32 + 8 * q);
#pragma unroll
                        for (int it = 0; it < 4; ++it) { const f16x8 pf = *(const LAS f16x8*)(PP + (it * 16 + c) * P_LD + kk * 32 + 8 * q); accO[it][et] = GLA_MFMA(vf, pf, accO[it][et]); } asm volatile("" ::: "memory"); }
#pragma unroll
                for (int kb = 0; kb < 4; ++kb)
#pragma unroll
                    for (int et = 0; et < 2; ++et) { f16x8 sf; asm volatile("" ::: "memory");
#pragma unroll
                        for (int e = 0; e < 4; ++e) { sf[e] = (f16)accS[2 * kb][et][e]; sf[4 + e] = (f16)accS[2 * kb + 1][et][e]; }
#pragma unroll
                        for (int it = 0; it < 4; ++it) { const f16x4 lo = *(const LAS f16x4*)(QT + (it * 16 + c) * QK_LD + 32 * kb + 4 * q), hi = *(const LAS f16x4*)(QT + (it * 16 + c) * QK_LD + 32 * kb + 16 + 4 * q);
                            f16x8 qf; qf[0] = lo[0]; qf[1] = lo[1]; qf[2] = lo[2]; qf[3] = lo[3]; qf[4] = hi[0]; qf[5] = hi[1]; qf[6] = hi[2]; qf[7] = hi[3];
                            accO[it][et] = GLA_MFMA(sf, qf, accO[it][et]); } }
                float* OF = (float*)(F.ws + WS_GOF);
                if (dir == 0) {
#pragma unroll
                    for (int it = 0; it < 4; ++it) { const int gr = grow(b, sc, j, it * 16 + c);
#pragma unroll
                        for (int et = 0; et < 2; ++et) *(f32x4*)(OF + (size_t)gr * 1024 + h * 256 + 32 * w + 16 * et + 4 * q) = accO[it][et];
                        asm volatile("" ::: "memory"); } }
                else {
                    int grs[4];
#pragma unroll
                    for (int it = 0; it < 4; ++it) { grs[it] = grow(b, sc, j, it * 16 + c); float ss = 0.f;
#pragma unroll
                        for (int et = 0; et < 2; ++et) { accO[it][et] = accO[it][et] + *(const f32x4*)(OF + (size_t)grs[it] * 1024 + h * 256 + 32 * w + 16 * et + 4 * q);
                            ss += (accO[it][et][0] * accO[it][et][0] + accO[it][et][1] * accO[it][et][1]) + (accO[it][et][2] * accO[it][et][2] + accO[it][et][3] * accO[it][et][3]); }
                        ss += __shfl_xor(ss, 16); ss += __shfl_xor(ss, 32);
                        if (q == 0) RS[(it * 16 + c) * 8 + w] = ss; asm volatile("" ::: "memory"); }
                    __syncthreads();
                    const float* ng = A.in[I_GLANG] + (size_t)l * 256;
                    f16* Y = (f16*)(F.ws + WS_YCAT);
#pragma unroll
                    for (int it = 0; it < 4; ++it) { const int i = it * 16 + c; const f32x4 ra = *(const LAS f32x4*)(RS + i * 8), rb = *(const LAS f32x4*)(RS + i * 8 + 4);
                        const float tot = ((ra[0] + ra[1]) + (ra[2] + ra[3])) + ((rb[0] + rb[1]) + (rb[2] + rb[3]));
                        const float rstd = 1.0f / sqrtf(tot * (1.0f / 256.0f) + EPS);
#pragma unroll
                        for (int et = 0; et < 2; ++et) { const int e0 = 32 * w + 16 * et + 4 * q;
                            const f32x4 gv = *(const f32x4*)(ng + e0); const f16x4 rv = *(const f16x4*)(PX + (size_t)grs[it] * PXLD + P_GR + h * 256 + e0);
                            f16x4 o;
#pragma unroll
                            for (int r = 0; r < 4; ++r) o[r] = (f16)(accO[it][et][r] * rstd * gv[r] * siluf_((float)rv[r]));
                            *(f16x4*)(Y + (size_t)grs[it] * 2048 + 1024 + h * 256 + e0) = o; } asm volatile("" ::: "memory"); }
                }
            }
#pragma unroll
            for (int dt = 0; dt < 8; ++dt) { const f32x4 dv = *(const LAS f32x4*)(DEC + 16 * dt + 4 * q);
#pragma unroll
                for (int et = 0; et < 2; ++et) accS[dt][et] = accS[dt][et] * dv; }
#pragma unroll
            for (int kk = 0; kk < 2; ++kk) { f16x8 vf[2];
#pragma unroll
                for (int et = 0; et < 2; ++et) vf[et] = *(const LAS f16x8*)(VT + (32 * w + 16 * et + c) * VT_LD + kk * 32 + 8 * q);
#pragma unroll
                for (int dt = 0; dt < 8; ++dt) { const f16x8 kf = *(const LAS f16x8*)(KT + (16 * dt + c) * KH_LD + kk * 32 + 8 * q);
#pragma unroll
                    for (int et = 0; et < 2; ++et) accS[dt][et] = GLA_MFMA(kf, vf[et], accS[dt][et]); if (dt & 1) asm volatile("" ::: "memory"); } }
        }
        if (!FULL) { float* Sl = (float*)(F.ws + WS_GSLOC) + sidx * 32768; const int q = opq(q0), c = opq(c0);
#pragma unroll
            for (int dt = 0; dt < 8; ++dt)
#pragma unroll
                for (int et = 0; et < 2; ++et)
#pragma unroll
                    for (int r = 0; r < 4; ++r) Sl[(16 * dt + 4 * q + r) * 256 + 32 * w + 16 * et + c] = accS[dt][et][r];
            if (ig0 == 0) ((float*)(F.ws + WS_GDT))[sidx * 128 + dk0] = __expf(sumtot); }
        VM_WAIT();
    }
}
__device__ __forceinline__ void ph_gla_scan(const Ctx& F) {
    const float* Sl = (const float*)(F.ws + WS_GSLOC); float* Si = (float*)(F.ws + WS_GSIN); const float* Dt = (const float*)(F.ws + WS_GDT);
    for (int gt = F.bid * 512 + F.tid; gt < 2 * 4 * 2 * 32768; gt += F.G * 512) {
        const int e = gt & 32767, dir = (gt >> 15) & 1, h = (gt >> 16) & 3, b = gt >> 18;
        float S = 0.f;
        for (int base = 0; base < NSC; base += 11) {
            float sl[11], dt[11]; size_t ix[11];
#pragma unroll
            for (int u = 0; u < 11; ++u) { const int step = base + u; const int sc = step == 0 ? 32 : (dir == 0 ? step - 1 : 32 - step);
                const size_t idx = ((((size_t)b * 4 + h) * NSC + sc) * 2 + dir); ix[u] = idx;
                sl[u] = Sl[idx * 32768 + e]; dt[u] = Dt[idx * 128 + (e >> 8)]; }
#pragma unroll
            for (int u = 0; u < 11; ++u) { Si[ix[u] * 32768 + e] = S; S = dt[u] * S + sl[u]; }
        }
    }
}
#undef GLA_MFMA
}

namespace hy {
__device__ __forceinline__ f32x2 twid(int k, float invN) { const float xr = (float)k * invN; return (f32x2){__builtin_amdgcn_cosf(xr), -__builtin_amdgcn_sinf(xr)}; }
__device__ __forceinline__ void fft_fwd(LAS f32x2* x, int m, const f32x2* tw, int tid) {
    const int N = 1 << m; const float invN = 1.0f / (float)N;
    int lh = m - 1;
    if (m & 1) { const int h = 1 << lh;
        for (int i = tid; i < (N >> 1); i += 512) { const f32x2 a = x[i], b = x[i + h]; x[i] = a + b; x[i + h] = cmul(a - b, twid(i, invN)); }
        __syncthreads(); lh -= 1; }
    for (; lh >= 1; lh -= 2) { const int h = 1 << lh, hh = h >> 1, lhh = lh - 1, s = (N >> 1) >> lh;
        for (int q = tid; q < (N >> 2); q += 512) { const int j = q & (hh - 1), blk = q >> lhh, i = (blk << (lh + 1)) + j;
            const f32x2 x0 = x[i], x1 = x[i + hh], x2 = x[i + h], x3 = x[i + h + hh];
            const f32x2 w1 = twid(j * s, invN), w2 = cmul(w1, w1);
            const f32x2 a0 = x0 + x2, a2 = cmul(x0 - x2, w1), a1 = x1 + x3, t3 = cmul(x1 - x3, w1), a3 = (f32x2){t3.y, -t3.x};
            x[i] = a0 + a1; x[i + hh] = cmul(a0 - a1, w2); x[i + h] = a2 + a3; x[i + h + hh] = cmul(a2 - a3, w2); }
        __syncthreads(); }
}
__device__ __forceinline__ void fft_inv(LAS f32x2* x, int m, const f32x2* tw, int tid) {
    const int N = 1 << m; const float invN = 1.0f / (float)N;
    int lh = 0;
    for (int p = 0; p < (m >> 1); ++p, lh += 2) { const int h = 1 << lh, s1 = (N >> 1) >> lh, s2 = s1 >> 1;
        for (int q = tid; q < (N >> 2); q += 512) { const int j = q & (h - 1), blk = q >> lh, i = (blk << (lh + 2)) + j;
            const f32x2 x0 = x[i], x1 = x[i + h], x2 = x[i + 2 * h], x3 = x[i + 3 * h];
            const f32x2 w2 = cconj(twid(j * s2, invN)), w1 = cmul(w2, w2), w3 = (f32x2){-w2.y, w2.x};
            const f32x2 b1 = cmul(x1, w1), b3 = cmul(x3, w1);
            const f32x2 a0 = x0 + b1, a1 = x0 - b1, a2 = x2 + b3, a3 = x2 - b3;
            const f32x2 c2 = cmul(a2, w2), c3 = cmul(a3, w3);
            x[i] = a0 + c2; x[i + 2 * h] = a0 - c2; x[i + h] = a1 + c3; x[i + 3 * h] = a1 - c3; }
        __syncthreads(); }
    if (m & 1) { const int h = 1 << lh;
        for (int i = tid; i < (N >> 1); i += 512) { const f32x2 a = x[i], b = cmul(x[i + h], cconj(twid(i, invN))); x[i] = a + b; x[i + h] = a - b; }
        __syncthreads(); }
}
__device__ __forceinline__ int brev(int k, int m) { return (int)(__brev((unsigned)k) >> (32 - m)); }

__device__ __forceinline__ void filt_unit(const Ctx& F, const Args& A, int l, int unit) {
    const int kind = unit >> 9, o = (unit >> 8) & 1, pair = unit & 255;
    const int n = kind ? LC : SEQ, m = kind ? 9 : 14, N = 2 * n, tid = F.tid;
    LAS f32x2* buf = (LAS f32x2*)F.lds;
    LAS float* W3 = (LAS float*)(F.lds + EXTRA_OFF);
    LAS float* B3 = W3 + 256;
    LAS float* RED = B3 + 4;
    LAS float* INV = RED + 16;
    __syncthreads();
    if (tid < 256) { const int j = tid >> 2, ci = tid & 3; const int col = o * 1024 + (ci >> 1) * 512 + 2 * pair + (ci & 1);
        W3[j * 4 + ci] = A.in[I_HYW3][((size_t)l * 64 + j) * 2048 + col]; if (j == 0) B3[ci] = A.in[I_HYB3][(size_t)l * 2048 + col]; }
    __syncthreads();
    const float* H2 = (const float*)(F.ws + WS_H2) + (kind ? (size_t)SEQ * 64 : 0);
    const float lo = -3.0701134573253945f, hi = -15.350567286626973f;
    const float ra = fabsf(lo + (hi - lo) * (float)(2 * pair) / 511.0f), rb = fabsf(lo + (hi - lo) * (float)(2 * pair + 1) / 511.0f);
    float sa = 0.f, sb = 0.f;
    for (int t = tid; t < n; t += 512) {
        float a0 = B3[0], a1 = B3[1], a2 = B3[2], a3 = B3[3];
        const f32x4* hr = (const f32x4*)(H2 + (size_t)t * 64);
#pragma unroll 4
        for (int j4 = 0; j4 < 16; ++j4) { const f32x4 hv = hr[j4];
#pragma unroll
            for (int e = 0; e < 4; ++e) { const f32x4 wv = *(const LAS f32x4*)(W3 + (j4 * 4 + e) * 4); a0 += hv[e] * wv[0]; a1 += hv[e] * wv[1]; a2 += hv[e] * wv[2]; a3 += hv[e] * wv[3]; } }
        const float tn = (float)t / (float)(n - 1), da = expf(-tn * ra), db = expf(-tn * rb);
        const float fa = a0 * da, fb = a1 * db, ba = a2 * da, bb = a3 * db;
        buf[t] = (f32x2){fa, fb}; sa += fabsf(fa); sb += fabsf(fb);
        if (t >= 1) { buf[N - t] = (f32x2){ba, bb}; sa += fabsf(ba); sb += fabsf(bb); }
    }
    if (tid == 0) buf[n] = (f32x2){0.f, 0.f};
    sa = wave_sum(sa); sb = wave_sum(sb);
    if (F.lane == 0) { RED[F.wave * 2] = sa; RED[F.wave * 2 + 1] = sb; }
    __syncthreads();
    if (tid < 2) { float s = 0.f;
#pragma unroll
        for (int w = 0; w < 8; ++w) s += RED[w * 2 + tid];
        INV[tid] = 1.0f / (s + EPS); }
    __syncthreads();
    { const float ia = INV[0], ib = INV[1];
      for (int i = tid; i < N; i += 512) { f32x2 v = buf[i]; v.x *= ia; v.y *= ib; buf[i] = v; } }
    __syncthreads();
    const f32x2* tw = (const f32x2*)(F.ws + WS_TW);
    fft_fwd(buf, m, tw, tid);
    f32x4* out = (f32x4*)(F.ws + WS_FSD + (kind ? FSD_C_OFF : 0)) + (size_t)(o * 256 + pair) * (n + 1);
    for (int k = tid; k <= n; k += 512) { const f32x2 zk = buf[brev(k, m)], zn = cconj(buf[brev((N - k) & (N - 1), m)]);
        const f32x2 fa = (zk + zn) * 0.5f, df = zk - zn, fb = (f32x2){df.y * 0.5f, -df.x * 0.5f};
        const f32x2 fs = (fa + fb) * 0.5f, fd = (fa - fb) * 0.5f;
        out[k] = (f32x4){fs.x, fs.y, fd.x, fd.y}; }
    __syncthreads();
}

__device__ __forceinline__ void main_unit(const Ctx& F, const Args& A, int l, int unit) {
    const int kind = unit >> 9, b = (unit >> 8) & 1, pair = unit & 255;
    const int n = kind ? LC : SEQ, m = kind ? 9 : 14, N = 2 * n, tid = F.tid;
    const int row0 = kind ? MX + b * LC : b * SEQ;
    LAS f32x2* buf = (LAS f32x2*)F.lds;
    const f16* PX = (const f16*)(F.ws + WS_PX) + P_HY + 2 * pair;
    const float* cw = A.in[I_HYCW] + (size_t)l * 3 * 1536 + 2 * pair; const float* cb = A.in[I_HYCB] + (size_t)l * 1536 + 2 * pair;
    f32x2 yv[16], g1[16], g2[16];
    {
        f32x2 w[3][3], bs[3];
#pragma unroll
        for (int g = 0; g < 3; ++g) { bs[g] = (f32x2){cb[g * 512], cb[g * 512 + 1]};
#pragma unroll
            for (int tp = 0; tp < 3; ++tp) w[g][tp] = (f32x2){cw[tp * 1536 + g * 512], cw[tp * 1536 + g * 512 + 1]}; }
#pragma unroll
        for (int i = 0; i < 16; ++i) { const int t = tid + 512 * i; f32x2 r[3] = {bs[0], bs[1], bs[2]};
            if (t < n) {
#pragma unroll
                for (int tp = 0; tp < 3; ++tp) { const int tt = t + tp - 1;
                    if (tt >= 0 && tt < n) { const f16* p = PX + (size_t)(row0 + tt) * PXLD;
#pragma unroll
                        for (int g = 0; g < 3; ++g) { const f16x2 z = *(const f16x2*)(p + g * 512); r[g].x += w[g][tp].x * (float)z[0]; r[g].y += w[g][tp].y * (float)z[1]; } } } }
            yv[i] = r[0]; g1[i] = r[1]; g2[i] = r[2]; }
    }
    const f32x2* tw = (const f32x2*)(F.ws + WS_TW);
    const float invN = 1.0f / (float)N;
#pragma unroll
    for (int o = 0; o < 2; ++o) {
        __syncthreads();
#pragma unroll
        for (int i = 0; i < 16; ++i) { const int t = tid + 512 * i; if (t < n) { buf[t] = yv[i]; buf[n + t] = (f32x2){0.f, 0.f}; } }
        __syncthreads();
        fft_fwd(buf, m, tw, tid);
        const f32x4* fsd = (const f32x4*)(F.ws + WS_FSD + (kind ? FSD_C_OFF : 0)) + (size_t)(o * 256 + pair) * (n + 1);
        for (int k = tid; k <= n; k += 512) { const int pk = brev(k, m), pn = brev((N - k) & (N - 1), m);
            const f32x2 zk = buf[pk], zn = buf[pn]; const f32x4 f = fsd[k]; const f32x2 fs = (f32x2){f[0], f[1]}, fd = (f32x2){f[2], f[3]};
            const f32x2 wk = cmul(zk, fs) + cmul(cconj(zn), fd), wn = cmul(zn, cconj(fs)) + cmul(cconj(zk), cconj(fd));
            buf[pn] = wn; buf[pk] = wk; }
        __syncthreads();
        fft_inv(buf, m, tw, tid);
        const float* hb = A.in[I_HYBIAS] + ((size_t)l * 2 + o) * 512 + 2 * pair; const f32x2 bias = (f32x2){hb[0], hb[1]};
#pragma unroll
        for (int i = 0; i < 16; ++i) { const int t = tid + 512 * i; if (t < n) { const f32x2 cv = buf[t] * invN; const f32x2 gt = o == 0 ? g1[i] : g2[i];
            yv[i] = gt * (cv + yv[i] * bias); } }
    }
    f16* Y = (f16*)(F.ws + WS_YCAT) + 512 + 2 * pair;
#pragma unroll
    for (int i = 0; i < 16; ++i) { const int t = tid + 512 * i; if (t < n) { f16x2 o2; o2[0] = (f16)yv[i].x; o2[1] = (f16)yv[i].y; *(f16x2*)(Y + (size_t)(row0 + t) * 2048) = o2; } }
    __syncthreads();
}
}

#ifndef PHMASK
#define PHMASK 0xFFFF
#endif
#define PH_EN(k) (((PHMASK) >> (k)) & 1)
#ifndef STAMP_MASK
#define STAMP_MASK 0
#endif
#ifndef STAMP_K
#define STAMP_K 1
#endif
#ifndef SUBMASK
#define SUBMASK 7
#endif
#define SUB_EN(k) (((SUBMASK) >> (k)) & 1)
constexpr int NPH = 2 + 12 * DEPTH;
constexpr int CW_Q = 8192;
__device__ __forceinline__ int q_pull(unsigned* ctr, volatile LAS int* slot) {
    __syncthreads();
    if (threadIdx.x == 0) *slot = (int)__hip_atomic_fetch_add(ctr, 1u, __ATOMIC_RELAXED, __HIP_MEMORY_SCOPE_AGENT);
    __syncthreads();
    return *slot;
}

__global__ void __launch_bounds__(512, 2) mk_fwd(Args args) {
    extern __shared__ __attribute__((aligned(16))) unsigned char lds_raw[];
    Ctx F; F.lds = (LAS unsigned char*)lds_raw; F.tid = threadIdx.x; F.lane = F.tid & 63; F.wave = __builtin_amdgcn_readfirstlane(F.tid >> 6);
    F.G = gridDim.x; F.bid = blockIdx.x; F.ws = args.ws;
    const Ctx F0 = F;
#define FRESH() do { F.tid = opq(F0.tid); F.lane = F.tid & 63; F.wave = __builtin_amdgcn_readfirstlane(F.tid >> 6); } while (0)
    volatile LAS unsigned* MISC = (volatile LAS unsigned*)(F.lds + LDSCTL_OFF);
    if (F.tid < 64) MISC[F.tid] = 0u;
    __syncthreads();
    unsigned* barw = (unsigned*)(F.ws + WS_CTL) + CW_BAR;
    XcdBarrier bar; bar.bar = barw; bar.x = 0; bar.st = nullptr;
    const int lo = args.ph_lo, hi = args.ph_hi;
    if (hi - lo > 1) bar = xcd_barrier_post(barw, MISC + 8);
#define IN(k) (lo <= (k) && (k) < hi)
#define SEAM(k) do { if (IN(k) && IN((k) + 1)) xcd_barrier(bar); } while (0)
#if STAMP_MASK
    volatile LAS unsigned long long* TS = (volatile LAS unsigned long long*)(F.lds + LDSCTL_OFF + 128);
#define TSTART(k) do { if ((((STAMP_MASK) >> (k)) & 1) && blockIdx.x == 0 && threadIdx.x == 0) TS[0] = __builtin_amdgcn_s_memrealtime(); } while (0)
#define TSTOP(k) do { if ((((STAMP_MASK) >> (k)) & 1) && blockIdx.x == 0 && threadIdx.x == 0) TS[1] = TS[1] + (__builtin_amdgcn_s_memrealtime() - TS[0]); } while (0)
#else
#define TSTART(k) do {} while (0)
#define TSTOP(k) do {} while (0)
#endif
    unsigned char* ws = F.ws;
    const int rank160 = (F.bid + F.G - 160 % F.G) % F.G;

    TSTART(12);
    if (PH_EN(12) && IN(0)) { FRESH(); ph_prologue(F, args); }
    SEAM(0);
    TSTOP(12);

    for (int l = 0; l < DEPTH; ++l) {
        const int pb = 1 + 12 * l;
        const float* modl = (const float*)(ws + WS_MOD) + (size_t)l * 3 * 12288;
        TSTART(0);
        if (PH_EN(0) && IN(pb + 0)) {
            FRESH(); ph_convert_weights(F, args, l);
            __syncthreads();
            FRESH(); if (F.bid < 32) s5_mats_group(F, args, l, F.bid);
            FRESH(); ph_hyena_h2(F, args, l);
            FRESH(); ph_norm(F, args, l, 0);
        }
        SEAM(pb + 0);
        TSTOP(0);
        TSTART(1);
        if (PH_EN(1) && IN(pb + 1)) {
            pg8::SchedPlain S; S.init(MT / 256, PXLD / 256, F.G, F.bid); S.A = (const char*)(ws + WS_HN); S.B = (const char*)(ws + WS_WIN); S.aTile = (size_t)256 * 2048 * 2; S.bTile = (size_t)256 * 2048 * 2;
            pg8::EpiPx E{(f16*)(ws + WS_PX), (f16*)(ws + WS_S5A)};
            pg8::gemm_phase(F.lds, 2048, 2048, 32, S, E);
        }
        SEAM(pb + 1);
        TSTOP(1);
        TSTART(2);
        if (PH_EN(2) && IN(pb + 2)) {
            TSTART(16);
            if (SUB_EN(0)) { pg8::SchedS5 S{(const char*)(ws + WS_S5A), (const char*)(ws + WS_S5M), (size_t)256 * 256 * 2, F.G, F.bid};
              pg8::EpiS5In E{(float*)(ws + WS_S5S)};
              pg8::gemm_phase(F.lds, 16384, 256, 4, S, E); }
            TSTOP(16); TSTART(17);
            { unsigned* qc = (unsigned*)(ws + WS_CTL) + CW_Q + (l * 2 + 0) * 64; volatile LAS int* slot = (volatile LAS int*)(MISC + 16);
              for (;;) { const int u = q_pull(qc, slot); if (u >= 264 + 1024) break;
                  if (u < 264) { FRESH(); gla::gla_unit<false>(F, args, l, u); } else { FRESH(); hy::filt_unit(F, args, l, u - 264); } } }
            TSTOP(17);
        }
        SEAM(pb + 2);
        TSTOP(2);
        TSTART(3);
        if (PH_EN(3) && IN(pb + 3)) { FRESH(); ph_s5_scan(F); FRESH(); gla::ph_gla_scan(F); }
        SEAM(pb + 3);
        TSTOP(3);
        TSTART(4);
        if (PH_EN(4) && IN(pb + 4)) {
            TSTART(19);
            if (SUB_EN(0)) { pg8::SchedS5 S{(const char*)(ws + WS_S5A), (const char*)(ws + WS_S5W), (size_t)256 * 512 * 2, F.G, F.bid};
              pg8::EpiS5Out E{(const f16*)(ws + WS_S5A), (f16*)(ws + WS_YAPRE), args.in[I_S5D] + (size_t)l * 512};
              pg8::gemm_phase(F.lds, 16384, 512, 8, S, E); }
            TSTOP(19); TSTART(20);
            { unsigned* qc = (unsigned*)(ws + WS_CTL) + CW_Q + (l * 2 + 1) * 64; volatile LAS int* slot = (volatile LAS int*)(MISC + 16);
              for (;;) { const int u = q_pull(qc, slot); if (u >= 264 + 1024) break;
                  if (u < 264) { FRESH(); gla::gla_unit<true>(F, args, l, u); } else { FRESH(); hy::main_unit(F, args, l, u - 264); } } }
            TSTOP(20);
        }
        SEAM(pb + 4);
        TSTOP(4);
        TSTART(5);
        if (PH_EN(5) && IN(pb + 5)) {
            pg8::SchedPlain S; S.init(MT / 256, 2, F.G, F.bid); S.A = (const char*)(ws + WS_YAPRE); S.B = (const char*)(ws + WS_WGLU); S.aTile = (size_t)256 * 512 * 2; S.bTile = (size_t)256 * 512 * 2;
            pg8::EpiGlu E{(const f16*)(ws + WS_YAPRE), (f16*)(ws + WS_YCAT), args.in[I_GLUB] + (size_t)l * 512};
            pg8::gemm_phase(F.lds, 512, 512, 8, S, E);
        }
        SEAM(pb + 5);
        TSTOP(5);
        TSTART(6);
        if (PH_EN(6) && IN(pb + 6)) {
            pg8::SchedPlain S; S.init(MT / 256, 8, F.G, F.bid); S.aTile = (size_t)256 * 2048 * 2; S.bTile = (size_t)256 * 2048 * 2;
            S.A = (const char*)(ws + WS_YCAT); S.B = (const char*)(ws + WS_WBR);
            if (SUB_EN(0)) { pg8::EpiBranch<0> E{(const f16*)(ws + WS_PX), (f16*)(ws + WS_MBUF)}; pg8::gemm_phase(F.lds, 2048, 2048, 8, S, E); }
            S.A = (const char*)(ws + WS_YCAT) + 512 * 2; S.B = (const char*)(ws + WS_WBR) + 512 * 2;
            if (SUB_EN(1)) { pg8::EpiBranch<1> E{(const f16*)(ws + WS_PX), (f16*)(ws + WS_MBUF)}; pg8::gemm_phase(F.lds, 2048, 2048, 8, S, E); }
            S.A = (const char*)(ws + WS_YCAT) + 1024 * 2; S.B = (const char*)(ws + WS_WBR) + 1024 * 2;
            if (SUB_EN(2)) { pg8::EpiBranch<2> E{(const f16*)(ws + WS_PX), (f16*)(ws + WS_MBUF)}; pg8::gemm_phase(F.lds, 2048, 2048, 16, S, E); }
        }
        SEAM(pb + 6);
        TSTOP(6);
        TSTART(7);
        if (PH_EN(7) && IN(pb + 7)) {
            pg8::SchedPlain S; S.init(MT / 256, 8, F.G, F.bid); S.A = (const char*)(ws + WS_MBUF); S.B = (const char*)(ws + WS_WOUT); S.aTile = (size_t)256 * 2048 * 2; S.bTile = (size_t)256 * 2048 * 2;
            pg8::EpiResid E{(float*)(ws + WS_XRES), modl, 4096};
            pg8::gemm_phase(F.lds, 2048, 2048, 32, S, E);
        }
        SEAM(pb + 7);
        TSTOP(7);
        TSTART(8);
        if (PH_EN(8) && IN(pb + 8)) { FRESH(); ph_norm(F, args, l, 1); }
        SEAM(pb + 8);
        TSTOP(8);
        TSTART(9);
        if (PH_EN(9) && IN(pb + 9)) {
            pg8::SchedPlain S; S.init(MT / 256, UPLD / 256, F.G, F.bid); S.A = (const char*)(ws + WS_HN); S.B = (const char*)(ws + WS_WUP); S.aTile = (size_t)256 * 2048 * 2; S.bTile = (size_t)256 * 2048 * 2;
            pg8::EpiF16 E{(f16*)(ws + WS_PX), UPLD};
            pg8::gemm_phase(F.lds, 2048, 2048, 32, S, E);
        }
        SEAM(pb + 9);
        TSTOP(9);
        TSTART(10);
        if (PH_EN(10) && IN(pb + 10)) { FRESH(); ph_ffn_act(F, args, l); }
        SEAM(pb + 10);
        TSTOP(10);
        TSTART(11);
        if (PH_EN(11) && IN(pb + 11)) {
            pg8::SchedPlain S; S.init(MT / 256, 8, F.G, F.bid); S.A = (const char*)(ws + WS_ACT); S.B = (const char*)(ws + WS_WDN); S.aTile = (size_t)256 * FFH * 2; S.bTile = (size_t)256 * FFH * 2;
            pg8::EpiResid E{(float*)(ws + WS_XRES), modl, 10240};
            pg8::gemm_phase(F.lds, FFH, FFH, FFH / 64, S, E);
        }
        SEAM(pb + 11);
        TSTOP(11);
    }
    if (PH_EN(13) && IN(NPH - 1)) { FRESH(); ph_final_norm(F, args); }
#if STAMP_MASK
    if (blockIdx.x == 0 && threadIdx.x == 0) { const unsigned long long t0 = __builtin_amdgcn_s_memrealtime(); while (__builtin_amdgcn_s_memrealtime() - t0 < (unsigned long long)(STAMP_K) * TS[1]) __builtin_amdgcn_s_sleep(8); }
#endif
#undef IN
#undef SEAM
#undef FRESH
}

extern "C" void kernel_launch(void* const* d_in, const int* in_sizes, int n_in, void* d_out, int out_size, void* d_ws, size_t ws_size, hipStream_t stream) {
    static int grid = 0;
    if (grid == 0) {
        if (n_in != 40 || out_size != MX * D || ws_size < WS_END) { fprintf(stderr, "kernel_launch: unexpected problem (n_in %d out %d ws %zu, need %zu)\n", n_in, out_size, ws_size, (size_t)WS_END); grid = -1; return; }
        int dev = 0, cus = 0, per_cu = 0;
        if (hipGetDevice(&dev) != hipSuccess || hipDeviceGetAttribute(&cus, hipDeviceAttributeMultiprocessorCount, dev) != hipSuccess) { grid = -1; return; }
        if (hipFuncSetAttribute((const void*)mk_fwd, hipFuncAttributeMaxDynamicSharedMemorySize, LDS_BYTES) != hipSuccess) { fprintf(stderr, "kernel_launch: hipFuncSetAttribute failed\n"); grid = -1; return; }
        if (hipOccupancyMaxActiveBlocksPerMultiprocessor(&per_cu, (const void*)mk_fwd, 512, LDS_BYTES) != hipSuccess || per_cu < 1)
            fprintf(stderr, "kernel_launch: occupancy query reports %d\n", per_cu);
        (void)hipGetLastError();
        grid = cus;
    }
    if (grid < 0) return;
    if (hipMemsetAsync((char*)d_ws + WS_CTL, 0, CTL_ZERO_BYTES, stream) != hipSuccess) return;
    Args a{};
    for (int i = 0; i < 40; ++i) a.in[i] = (const float*)d_in[i];
    a.out = (float*)d_out; a.ws = (unsigned char*)d_ws;
#if MK_ONE
    a.ph_lo = 0; a.ph_hi = NPH;
    hipLaunchKernelGGL(mk_fwd, dim3(grid), dim3(512), LDS_BYTES, stream, a);
#else
    for (int p = 0; p < NPH; ++p) { a.ph_lo = p; a.ph_hi = p + 1; hipLaunchKernelGGL(mk_fwd, dim3(grid), dim3(512), LDS_BYTES, stream, a); }
#endif
}
```

```cpp
#include <hip/hip_runtime.h>
#include <stdio.h>

#ifndef MK_ONE
#define MK_ONE 1
#define STAMP_MASK 0
#define STAMP_K 1
#endif

#define GAS __attribute__((address_space(1)))
#define LAS __attribute__((address_space(3)))
typedef _Float16 f16;
typedef _Float16 f16x8 __attribute__((ext_vector_type(8)));
typedef _Float16 f16x4 __attribute__((ext_vector_type(4)));
typedef _Float16 f16x2 __attribute__((ext_vector_type(2)));
typedef float f32x4 __attribute__((ext_vector_type(4)));
typedef float f32x2 __attribute__((ext_vector_type(2)));

constexpr int D = 2048, NB = 2, SEQ = 8192, LC = 256, DEPTH = 4;
constexpr int MX = NB * SEQ, MC = NB * LC, MT = MX + MC;
constexpr int PXLD = 11520, FFH = 5632, UPLD = 2 * FFH;
constexpr int P_S5 = 0, P_GK = 512, P_GV = 1024, P_GQ = 2048, P_GR = 2560, P_HY = 3584, P_MG = 5120, P_GG = 11264;
constexpr int INW = 11296;
constexpr int NCHK = 1056;
constexpr float S5SCALE = 1024.f;
constexpr float EPS = 1e-6f;
constexpr int NSC = 33;

constexpr size_t MiB = 1u << 20;
constexpr size_t WS_CTL = 0, CTL_ZERO_BYTES = 1 * MiB;
constexpr size_t WS_MOD = 1 * MiB;
constexpr size_t WS_TW = 2 * MiB;
constexpr size_t WS_S5AT = 3 * MiB;
constexpr size_t WS_WIN = 4 * MiB;
constexpr size_t WS_WGLU = WS_WIN + 45 * MiB;
constexpr size_t WS_WBR = WS_WGLU + 1 * MiB;
constexpr size_t WS_WOUT = WS_WBR + 8 * MiB;
constexpr size_t WS_WUP = WS_WOUT + 8 * MiB;
constexpr size_t WS_WDN = WS_WUP + 44 * MiB;
constexpr size_t WS_S5W = WS_WDN + 22 * MiB;
constexpr size_t WS_S5M = WS_S5W + 8 * MiB;
constexpr size_t WS_H2 = WS_S5M + 4 * MiB;
constexpr size_t WS_FSD = WS_H2 + 3 * MiB;
constexpr size_t FSD_C_OFF = (size_t)2 * 256 * 8193 * 16;
constexpr size_t WS_XRES = WS_FSD + 68 * MiB;
constexpr size_t WS_HN = WS_XRES + 132 * MiB;
constexpr size_t WS_PX = WS_HN + 66 * MiB;
constexpr size_t WS_S5A = WS_PX + 372 * MiB;
constexpr size_t WS_S5S = WS_S5A + 40 * MiB;
constexpr size_t WS_YAPRE = WS_S5S + 40 * MiB;
constexpr size_t WS_YCAT = WS_YAPRE + 20 * MiB;
constexpr size_t WS_MBUF = WS_YCAT + 66 * MiB;
constexpr size_t WS_GSLOC = WS_MBUF + 66 * MiB;
constexpr size_t WS_GSIN = WS_GSLOC + 66 * MiB;
constexpr size_t WS_GOF = WS_GSIN + 66 * MiB;
constexpr size_t WS_GDT = WS_GOF + 66 * MiB;
constexpr size_t WS_ACT = WS_GSLOC;
constexpr size_t WS_ZT = WS_GDT + 1 * MiB;
constexpr size_t WS_YBT = WS_ZT + 50 * MiB;
constexpr size_t WS_END = WS_YBT + 17 * MiB;
static_assert((size_t)MT * FFH * 2 <= 198 * MiB, "ACT overlay");
constexpr int CW_BAR = 4096;

constexpr int RING_BYTES = 131072;
constexpr int EXTRA_OFF = RING_BYTES, EXTRA_BYTES = 8192;
constexpr int LDSCTL_OFF = EXTRA_OFF + EXTRA_BYTES;
constexpr int LDS_BYTES = LDSCTL_OFF + 256;

__device__ __forceinline__ float wave_sum(float v) {
#pragma unroll
    for (int o = 1; o < 64; o <<= 1) v += __shfl_xor(v, o);
    return v;
}
__device__ __forceinline__ float sigmoidf_(float x) { return 1.0f / (1.0f + __expf(-x)); }
__device__ __forceinline__ float siluf_(float x) { return x * sigmoidf_(x); }
__device__ __forceinline__ float gelu_tanh_(float x) { const float u = 0.7978845608028654f * (x + 0.044715f * x * x * x); return x / (1.0f + __expf(-2.0f * u)); }
__device__ __forceinline__ float logsigmoidf_(float x) { return fminf(x, 0.f) - log1pf(expf(-fabsf(x))); }
__device__ __forceinline__ f32x2 cmul(f32x2 a, f32x2 b) { return (f32x2){a.x * b.x - a.y * b.y, a.x * b.y + a.y * b.x}; }
__device__ __forceinline__ f32x2 cconj(f32x2 a) { return (f32x2){a.x, -a.y}; }
__device__ __forceinline__ int opq(int x) { asm volatile("" : "+v"(x)); return x; }
#define LDS_WAIT() asm volatile("s_waitcnt lgkmcnt(0)" ::: "memory")
#define VM_WAIT() asm volatile("s_waitcnt vmcnt(0)" ::: "memory")

#define XB_TMO      128
#define XB_XCNT(j)  (256  + 64 * (j))
#define XB_XSUB(j)  (1280 + 64 * (j))
#define XB_XGEN(j)  (2304 + 64 * (j))
#define XB_TOP      3328
#define XB_TOPGEN   3392
#define XCD_BAR_WORDS 3456
#define XB_SPIN_CAP (1u << 18)
__device__ __forceinline__ unsigned xb_ld(unsigned* p)              { return __hip_atomic_load(p, __ATOMIC_RELAXED, __HIP_MEMORY_SCOPE_AGENT); }
__device__ __forceinline__ unsigned xb_add(unsigned* p, unsigned v) { return __hip_atomic_fetch_add(p, v, __ATOMIC_RELAXED, __HIP_MEMORY_SCOPE_AGENT); }
__device__ __forceinline__ unsigned xb_xcc_id() { return (unsigned)__builtin_amdgcn_s_getreg((3 << 11) | 20) & 0xFu; }
#define XB_SPIN(cond, bar) do { unsigned _sp = 0; while (cond) { __builtin_amdgcn_s_sleep(1); \
    if ((++_sp & 255u) == 0u) { if (xb_ld(&(bar)[XB_TMO])) break; if (_sp > XB_SPIN_CAP) { atomicAdd(&(bar)[XB_TMO], 1u); break; } } } } while (0)
struct XcdBarrier { unsigned* bar; unsigned x; volatile LAS unsigned* st; };
__device__ __forceinline__ XcdBarrier xcd_barrier_post(unsigned* bar, volatile LAS unsigned* st) {
    XcdBarrier b; b.bar = bar; b.x = xb_xcc_id(); b.st = st;
    if (threadIdx.x == 0) (void)xb_add(&bar[XB_XCNT(b.x)], 1u);
    return b;
}
__device__ __forceinline__ void xcd_barrier_complete(unsigned* bar, unsigned x, unsigned& nloc, unsigned& nx) {
    const unsigned G = gridDim.x * gridDim.y * gridDim.z;
    unsigned sum, cnt, mine, sp = 0u;
    for (;;) {
        sum = 0u; cnt = 0u; mine = 0u;
#pragma unroll
        for (unsigned j = 0; j < 16; ++j) { const unsigned c = xb_ld(&bar[XB_XCNT(j)]); sum += c; cnt += (c > 0u) ? 1u : 0u; mine = (j == x) ? c : mine; }
        if (sum == G) break;
        __builtin_amdgcn_s_sleep(1);
        if ((++sp & 255u) == 0u) { if (xb_ld(&bar[XB_TMO])) break; if (sp > XB_SPIN_CAP) { atomicAdd(&bar[XB_TMO], 1u); break; } }
    }
    nloc = mine > 0u ? mine : 1u; nx = cnt > 0u ? cnt : 1u;
}
__device__ __forceinline__ void xcd_barrier(const XcdBarrier& b) {
    asm volatile("s_waitcnt vmcnt(0)" ::: "memory");
    __syncthreads();
    if (threadIdx.x == 0) {
        unsigned* bar = b.bar;
        __builtin_amdgcn_s_waitcnt(0);
        unsigned nloc = b.st[0], nx = b.st[1];
        if (nloc == 0u) { xcd_barrier_complete(bar, b.x, nloc, nx); b.st[0] = nloc; b.st[1] = nx; }
        const unsigned old = xb_add(&bar[XB_XSUB(b.x)], 1u);
        const unsigned gen = old / nloc;
        if (old + 1u == (gen + 1u) * nloc) {
            __builtin_amdgcn_fence(__ATOMIC_RELEASE, "agent");
            asm volatile("s_waitcnt vmcnt(0)" ::: "memory");
            const unsigned og = xb_add(&bar[XB_TOP], 1u);
            const unsigned tg = og / nx;
            if (og + 1u == (tg + 1u) * nx) xb_add(&bar[XB_TOPGEN], 1u);
            else XB_SPIN(xb_ld(&bar[XB_TOPGEN]) == tg, bar);
            __builtin_amdgcn_fence(__ATOMIC_ACQUIRE, "agent");
            xb_add(&bar[XB_XGEN(b.x)], 1u);
            asm volatile("s_waitcnt vmcnt(0)" ::: "memory");
        } else {
            XB_SPIN(xb_ld(&bar[XB_XGEN(b.x)]) == gen, bar);
            __builtin_amdgcn_fence(__ATOMIC_ACQUIRE, "agent");
            asm volatile("s_waitcnt vmcnt(0)" ::: "memory");
        }
    }
    __syncthreads();
}

struct Args {
    const float* in[40];
    float* out; unsigned char* ws;
    int ph_lo, ph_hi;
};
struct Ctx {
    LAS unsigned char* lds;
    int tid, lane, wave, G, bid;
    unsigned char* ws;
};
enum { I_X = 0, I_C, I_CTX, I_CCTX, I_WMOD, I_BMOD, I_N1G, I_N2G, I_WIN, I_S5ARE, I_S5AIM, I_S5STEP, I_S5BRE, I_S5BIM, I_S5CRE, I_S5CIM,
       I_S5D, I_GLUW, I_GLUB, I_HYCW, I_HYCB, I_HYW1, I_HYB1, I_HYF1, I_HYW2, I_HYB2, I_HYF2, I_HYW3, I_HYB3, I_HYBIAS,
       I_GLAWG, I_GLABG, I_GLANG, I_WBR, I_WOUT, I_WUP, I_FFCW, I_FFCB, I_WDN, I_FNG };

namespace pg8 {
constexpr int BM = 256, BK = 64, HALF = 128, HTB = HALF * BK * 2, STAGE_BYTES = 8 * HTB, NXCD = 8, WGM = 8;
__device__ __forceinline__ int lds_byte(int r, int c) { const int st = (r >> 4) * 2 + (c >> 5), rr = r & 15, cc = c & 31, ob = rr * 64 + cc * 2; return st * 1024 + (ob ^ (((ob >> 9) & 1) << 5)); }
__device__ __forceinline__ void stage_rc(int b, int& R, int& C) { const int st = b / 1024, sb = b % 1024, swz = sb ^ (((sb >> 9) & 1) << 5); R = (st >> 1) * 16 + swz / 64; C = (st & 1) * 32 + (swz % 64) / 2; }
__device__ __forceinline__ int perm32(int rho) { const int n = rho >> 4, i = rho & 15; return 8 * (i >> 2) + 4 * n + (i & 3); }
struct Unit { const char* a; const char* b; int pm, pn; };
struct Order2D {
    int nM, nN, nwg, G, c;
    __device__ __forceinline__ void init(int nM_, int nN_, int G_, int c_) { nM = nM_; nN = nN_; nwg = nM * nN; G = G_; c = c_; }
    __device__ __forceinline__ bool nx(int i, int& pm, int& pn) const {
        const long L = (long)i * G + c; if (L >= nwg) return false;
        int wgid = (int)L; { const int q = nwg / NXCD, r = nwg % NXCD, xcd = wgid % NXCD, off = wgid / NXCD; wgid = (xcd < r ? xcd * (q + 1) : r * (q + 1) + (xcd - r) * q) + off; }
        const int nig = WGM * nN, gid = wgid / nig, fm = gid * WGM, gsz = (nM - fm) < WGM ? (nM - fm) : WGM;
        pm = fm + ((wgid % nig) % gsz); pn = (wgid % nig) / gsz; return true;
    }
};
struct SchedPlain : Order2D {
    const char* A; const char* B; size_t aTile, bTile;
    __device__ __forceinline__ bool next(int i, Unit& u) const { int pm, pn; if (!nx(i, pm, pn)) return false; u.pm = pm; u.pn = pn; u.a = A + (size_t)pm * aTile; u.b = B + (size_t)pn * bTile; return true; }
};
struct SchedS5 {
    const char* A; const char* B; size_t bGroup; int G, c;
    __device__ __forceinline__ bool next(int i, Unit& u) const { const int L = i * G + c; if (L >= 160) return false; const int g = L & 31, pm = L >> 5;
        u.pm = pm; u.pn = g; u.a = A + ((size_t)pm * 256 * 16384 + (size_t)g * 512) * 2; u.b = B + (size_t)g * bGroup; return true; }
};

#define PG8_SA(b, h) (((b) * 2 + (h)) * HTB)
#define PG8_SB(b, h) ((4 + (b) * 2 + (h)) * HTB)
#define PG8_STAGE(bufoff, gbase, voff) do { _Pragma("unroll") for (int _i = 0; _i < 2; ++_i) \
        __builtin_amdgcn_global_load_lds((const unsigned*)((const char*)(gbase) + (voff)[_i]), (LAS unsigned*)(lds + (bufoff) + ldsw + _i * 8192), 16, 0, 0); } while (0)
#define PG8_LDA(dst, b, h) do { _Pragma("unroll") for (int m = 0; m < 4; ++m) _Pragma("unroll") for (int k = 0; k < 2; ++k) dst[m][k] = *(const LAS f16x8*)(lds + PG8_SA(b, h) + aoff + m * 2048 + k * 1024); } while (0)
#define PG8_LDB(dst, b, h) do { _Pragma("unroll") for (int n = 0; n < 2; ++n) _Pragma("unroll") for (int k = 0; k < 2; ++k) dst[n][k] = *(const LAS f16x8*)(lds + PG8_SB(b, h) + boff + n * 2048 + k * 1024); } while (0)
#define PG8_MMA(ai, bj, At, Bt) do { __builtin_amdgcn_s_setprio(1); _Pragma("unroll") for (int m = 0; m < 4; ++m) _Pragma("unroll") for (int n = 0; n < 2; ++n) _Pragma("unroll") for (int k = 0; k < 2; ++k) \
        acc[ai][bj][m][n] = __builtin_amdgcn_mfma_f32_16x16x32_f16(Bt[n][k], At[m][k], acc[ai][bj][m][n], 0, 0, 0); __builtin_amdgcn_s_setprio(0); } while (0)
#define PG8_WAIT_V(n) asm volatile("s_waitcnt vmcnt(" #n ")" ::: "memory")
#define PG8_WAIT_L(n) asm volatile("s_waitcnt lgkmcnt(" #n ")" ::: "memory")
#define PG8_BAR __builtin_amdgcn_s_barrier()
#define PG8_SCHED __builtin_amdgcn_sched_barrier(0)

template <class Epi, class Sched>
__device__ __forceinline__ void gemm_phase(LAS unsigned char* lds, const int lda, const int ldb, const int nt, const Sched& S, const Epi& E) {
    const int tid = opq((int)threadIdx.x), wid = __builtin_amdgcn_readfirstlane(tid >> 6), lane = tid & 63, wr = wid >> 2, wc = wid & 3, fr = lane & 15, fq = lane >> 4;
    unsigned voffA[2], voffB[2];
#pragma unroll
    for (int i = 0; i < 2; ++i) { int R, C; stage_rc(tid * 16 + i * 8192, R, C); const int Rb = Epi::PERM ? ((R & ~31) + perm32(R & 31)) : R;
        voffA[i] = (unsigned)(R * lda + C) * 2u; voffB[i] = (unsigned)(Rb * ldb + C) * 2u; }
    const size_t kstep = (size_t)(BK * 2);
    const size_t hstepA = (size_t)HALF * lda * 2, hstepB = (size_t)HALF * ldb * 2;
    const unsigned ldsw = (unsigned)wid * 1024u;
    const int aoff = lds_byte(wr * 64 + fr, fq * 8), boff = lds_byte(wc * 32 + fr, fq * 8);
    Unit cur, nxt; int ui = 0;
    if (!S.next(0, cur)) return;
    f32x4 acc[2][2][4][2];
#pragma unroll
    for (int a = 0; a < 2; ++a)
#pragma unroll
        for (int b = 0; b < 2; ++b)
#pragma unroll
            for (int m = 0; m < 4; ++m)
#pragma unroll
                for (int n = 0; n < 2; ++n) acc[a][b][m][n] = (f32x4){0.f, 0.f, 0.f, 0.f};
    f16x8 At[4][2], B0[2][2], B1[2][2];
    const char* cA = cur.a; const char* cB = cur.b;
    PG8_STAGE(PG8_SB(0, 0), cB, voffB); PG8_STAGE(PG8_SA(0, 0), cA, voffA); PG8_STAGE(PG8_SB(0, 1), cB + hstepB, voffB); PG8_STAGE(PG8_SA(0, 1), cA + hstepA, voffA);
    if (wr == 1) PG8_BAR;
    PG8_WAIT_V(4); PG8_BAR;
    PG8_STAGE(PG8_SB(1, 0), cB + kstep, voffB); PG8_STAGE(PG8_SA(1, 0), cA + kstep, voffA); PG8_STAGE(PG8_SB(1, 1), cB + hstepB + kstep, voffB);
    PG8_WAIT_V(6); PG8_BAR;
    for (;;) {
        const bool has_next = S.next(ui + 1, nxt);
        const char* nA = has_next ? nxt.a : cA; const char* nB = has_next ? nxt.b : cB;
        for (int t = 0; t < nt; t += 2) {
            const bool last = (t == nt - 2);
            const char* a1 = cA + (size_t)(t + 1) * kstep;
            const char* a2 = last ? nA : cA + (size_t)(t + 2) * kstep; const char* b2 = last ? nB : cB + (size_t)(t + 2) * kstep;
            const char* a3 = a2 + kstep; const char* b3 = b2 + kstep;
            PG8_LDB(B0, 0, 0); PG8_SCHED; PG8_LDA(At, 0, 0); PG8_STAGE(PG8_SA(1, 1), a1 + hstepA, voffA);
            PG8_WAIT_L(8); PG8_BAR; PG8_WAIT_L(0); PG8_MMA(0, 0, At, B0); PG8_BAR; PG8_SCHED;
            PG8_LDB(B1, 0, 1); PG8_STAGE(PG8_SB(0, 0), b2, voffB);
            PG8_BAR; PG8_WAIT_L(0); PG8_MMA(0, 1, At, B1); PG8_BAR;
            PG8_LDA(At, 0, 1); PG8_STAGE(PG8_SA(0, 0), a2, voffA);
            PG8_BAR; PG8_WAIT_L(0); PG8_MMA(1, 0, At, B0); PG8_BAR; PG8_SCHED;
            PG8_STAGE(PG8_SB(0, 1), b2 + hstepB, voffB);
            PG8_WAIT_V(6); PG8_BAR; PG8_MMA(1, 1, At, B1); PG8_BAR;
            PG8_LDB(B0, 1, 0); PG8_SCHED; PG8_LDA(At, 1, 0); PG8_STAGE(PG8_SA(0, 1), a2 + hstepA, voffA);
            PG8_WAIT_L(8); PG8_BAR; PG8_WAIT_L(0); PG8_MMA(0, 0, At, B0); PG8_BAR; PG8_SCHED;
            PG8_LDB(B1, 1, 1); PG8_STAGE(PG8_SB(1, 0), b3, voffB);
            PG8_BAR; PG8_WAIT_L(0); PG8_MMA(0, 1, At, B1); PG8_BAR;
            PG8_LDA(At, 1, 1); PG8_STAGE(PG8_SA(1, 0), a3, voffA);
            PG8_BAR; PG8_WAIT_L(0); PG8_MMA(1, 0, At, B0); PG8_BAR; PG8_SCHED;
            PG8_STAGE(PG8_SB(1, 1), b3 + hstepB, voffB);
            PG8_WAIT_V(6); PG8_BAR; PG8_MMA(1, 1, At, B1); PG8_BAR;
        }
        E(acc, cur, wr, wc, fr, fq);
        if (!has_next) break;
#pragma unroll
        for (int a = 0; a < 2; ++a)
#pragma unroll
            for (int b = 0; b < 2; ++b)
#pragma unroll
                for (int m = 0; m < 4; ++m)
#pragma unroll
                    for (int n = 0; n < 2; ++n) acc[a][b][m][n] = (f32x4){0.f, 0.f, 0.f, 0.f};
        cur = nxt; cA = nA; cB = nB; ++ui;
    }
    PG8_WAIT_V(0);
    if (wr == 0) PG8_BAR;
    PG8_BAR;
}
#undef PG8_SA
#undef PG8_SB
#undef PG8_STAGE
#undef PG8_LDA
#undef PG8_LDB
#undef PG8_MMA
#undef PG8_WAIT_V
#undef PG8_WAIT_L
#undef PG8_BAR
#undef PG8_SCHED

typedef const f32x4 (&AccRef)[2][2][4][2];
__device__ __forceinline__ f16x8 pack8(f32x4 a, f32x4 b) { f16x8 w; w[0] = (f16)a[0]; w[1] = (f16)a[1]; w[2] = (f16)a[2]; w[3] = (f16)a[3]; w[4] = (f16)b[0]; w[5] = (f16)b[1]; w[6] = (f16)b[2]; w[7] = (f16)b[3]; return w; }

struct EpiPx {
    static constexpr bool PERM = true; f16* PX; f16* S5A; f16* ZT;
    __device__ __forceinline__ void operator()(AccRef acc, const Unit& u, int wr, int wc, int fr, int fq) const { fr = opq(fr); fq = opq(fq);
        const int row0 = u.pm * BM + wr * 64 + fr, col0 = u.pn * BM + wc * 32 + 8 * fq;
#pragma unroll
        for (int ai = 0; ai < 2; ++ai)
#pragma unroll
            for (int m = 0; m < 4; ++m) { const int row = row0 + ai * HALF + m * 16;
#pragma unroll
                for (int bj = 0; bj < 2; ++bj) { const int c = col0 + bj * HALF; const f16x8 w = pack8(acc[ai][bj][m][0], acc[ai][bj][m][1]);
                    if (u.pn < 2) *(f16x8*)(S5A + (size_t)(row >> 4) * 16384 + (size_t)(c >> 4) * 512 + (row & 15) * 16 + (c & 15)) = w;
                    else if (u.pn >= 14 && u.pn < 20) {
#pragma unroll
                        for (int j = 0; j < 8; ++j) ZT[(size_t)(c - P_HY + j) * MT + row] = w[j]; }
                    else *(f16x8*)(PX + (size_t)row * PXLD + c) = w; } }
    }
};
struct EpiF16 {
    static constexpr bool PERM = true; f16* O; int ldc;
    __device__ __forceinline__ void operator()(AccRef acc, const Unit& u, int wr, int wc, int fr, int fq) const { fr = opq(fr); fq = opq(fq);
        const int row0 = u.pm * BM + wr * 64 + fr, col0 = u.pn * BM + wc * 32 + 8 * fq;
#pragma unroll
        for (int ai = 0; ai < 2; ++ai)
#pragma unroll
            for (int m = 0; m < 4; ++m) { f16* rowp = O + (size_t)(row0 + ai * HALF + m * 16) * ldc + col0;
#pragma unroll
                for (int bj = 0; bj < 2; ++bj) *(f16x8*)(rowp + bj * HALF) = pack8(acc[ai][bj][m][0], acc[ai][bj][m][1]); }
    }
};
struct EpiS5In {
    static constexpr bool PERM = false; float* S;
    __device__ __forceinline__ void operator()(AccRef acc, const Unit& u, int wr, int wc, int fr, int fq) const { fr = opq(fr); fq = opq(fq);
        const int row0 = u.pm * BM + wr * 64 + fr, col0 = wc * 32 + 4 * fq, g = u.pn;
#pragma unroll
        for (int ai = 0; ai < 2; ++ai)
#pragma unroll
            for (int m = 0; m < 4; ++m) { const int row = row0 + ai * HALF + m * 16; { float* rowp = S + ((size_t)row * 32 + g) * 256 + col0;
#pragma unroll
                for (int bj = 0; bj < 2; ++bj)
#pragma unroll
                    for (int n = 0; n < 2; ++n) *(f32x4*)(rowp + bj * HALF + n * 16) = acc[ai][bj][m][n]; } }
    }
};
struct EpiS5Out {
    static constexpr bool PERM = true; const f16* S5A; f16* Y; const float* dvec;
    __device__ __forceinline__ void operator()(AccRef acc, const Unit& u, int wr, int wc, int fr, int fq) const { fr = opq(fr); fq = opq(fq);
        const int row0 = u.pm * BM + wr * 64 + fr, col0 = wc * 32 + 8 * fq, g = u.pn;
#pragma unroll
        for (int ai = 0; ai < 2; ++ai)
#pragma unroll
            for (int m = 0; m < 4; ++m) { const int chunk = row0 + ai * HALF + m * 16; {
#pragma unroll
                for (int bj = 0; bj < 2; ++bj) { const int c = col0 + bj * HALF, t = c >> 4, h0 = c & 15;
                    const f16x8 uu = *(const f16x8*)(S5A + (size_t)chunk * 16384 + (size_t)g * 512 + c);
                    const f32x4 d0 = *(const f32x4*)(dvec + g * 16 + h0), d1 = *(const f32x4*)(dvec + g * 16 + h0 + 4);
                    f16x8 w;
#pragma unroll
                    for (int j = 0; j < 4; ++j) { w[j] = (f16)gelu_tanh_(acc[ai][bj][m][0][j] * (1.0f / S5SCALE) + d0[j] * (float)uu[j]);
                                                  w[4 + j] = (f16)gelu_tanh_(acc[ai][bj][m][1][j] * (1.0f / S5SCALE) + d1[j] * (float)uu[4 + j]); }
                    *(f16x8*)(Y + (size_t)(chunk * 16 + t) * 512 + g * 16 + h0) = w; } asm volatile("" ::: "memory"); } }
    }
};
struct EpiGlu {
    static constexpr bool PERM = true; const f16* YP; f16* O; const float* bias;
    __device__ __forceinline__ void operator()(AccRef acc, const Unit& u, int wr, int wc, int fr, int fq) const { fr = opq(fr); fq = opq(fq);
        const int row0 = u.pm * BM + wr * 64 + fr, col0 = u.pn * BM + wc * 32 + 8 * fq;
#pragma unroll
        for (int ai = 0; ai < 2; ++ai)
#pragma unroll
            for (int m = 0; m < 4; ++m) { const int row = row0 + ai * HALF + m * 16;
#pragma unroll
                for (int bj = 0; bj < 2; ++bj) { const int c = col0 + bj * HALF;
                    const f16x8 yp = *(const f16x8*)(YP + (size_t)row * 512 + c);
                    const f32x4 b0 = *(const f32x4*)(bias + c), b1 = *(const f32x4*)(bias + c + 4);
                    f16x8 w;
#pragma unroll
                    for (int j = 0; j < 4; ++j) { w[j] = (f16)((float)yp[j] * sigmoidf_(acc[ai][bj][m][0][j] + b0[j])); w[4 + j] = (f16)((float)yp[4 + j] * sigmoidf_(acc[ai][bj][m][1][j] + b1[j])); }
                    *(f16x8*)(O + (size_t)row * 2048 + c) = w; } asm volatile("" ::: "memory"); }
    }
};
template <int BR> struct EpiBranch {
    static constexpr bool PERM = true; const f16* PX; f16* M;
    __device__ __forceinline__ void operator()(AccRef acc, const Unit& u, int wr, int wc, int fr, int fq) const { fr = opq(fr); fq = opq(fq);
        const int row0 = u.pm * BM + wr * 64 + fr, col0 = u.pn * BM + wc * 32 + 8 * fq;
#pragma unroll
        for (int ai = 0; ai < 2; ++ai)
#pragma unroll
            for (int m = 0; m < 4; ++m) { const int row = row0 + ai * HALF + m * 16;
#pragma unroll
                for (int bj = 0; bj < 2; ++bj) { const int c = col0 + bj * HALF;
                    const f16x8 gl = *(const f16x8*)(PX + (size_t)row * PXLD + P_MG + BR * 2048 + c);
                    f16* mp = M + (size_t)row * 2048 + c;
                    f16x8 prev; if (BR > 0) prev = *(const f16x8*)mp;
                    f16x8 w;
#pragma unroll
                    for (int j = 0; j < 4; ++j) { float v0 = sigmoidf_((float)gl[j]) * acc[ai][bj][m][0][j], v1 = sigmoidf_((float)gl[4 + j]) * acc[ai][bj][m][1][j];
                        if (BR > 0) { v0 += (float)prev[j]; v1 += (float)prev[4 + j]; } w[j] = (f16)v0; w[4 + j] = (f16)v1; }
                    *(f16x8*)mp = w; } asm volatile("" ::: "memory"); }
    }
};
struct EpiResid {
    static constexpr bool PERM = false; float* X; const float* mod; int goff;
    __device__ __forceinline__ void operator()(AccRef acc, const Unit& u, int wr, int wc, int fr, int fq) const { fr = opq(fr); fq = opq(fq);
        const int row0 = u.pm * BM + wr * 64 + fr, col0 = u.pn * BM + wc * 32 + 4 * fq;
        const int bsel = u.pm < 32 ? 0 : (u.pm < 64 ? 1 : 2);
        const float* gp = mod + bsel * 12288 + goff + col0;
        f32x4 gv[2][2];
#pragma unroll
        for (int bj = 0; bj < 2; ++bj)
#pragma unroll
            for (int n = 0; n < 2; ++n) gv[bj][n] = *(const f32x4*)(gp + bj * HALF + n * 16);
#pragma unroll
        for (int ai = 0; ai < 2; ++ai)
#pragma unroll
            for (int m = 0; m < 4; ++m) { float* rowp = X + (size_t)(row0 + ai * HALF + m * 16) * D + col0;
#pragma unroll
                for (int bj = 0; bj < 2; ++bj)
#pragma unroll
                    for (int n = 0; n < 2; ++n) { f32x4* p = (f32x4*)(rowp + bj * HALF + n * 16); *p = *p + gv[bj][n] * acc[ai][bj][m][n]; } asm volatile("" ::: "memory"); }
    }
};
}


__device__ __forceinline__ void ph_prologue(const Ctx& F, const Args& A) {
    const int gt = F.bid * 512 + F.tid, NT = F.G * 512;
    { const f32x4* xs = (const f32x4*)A.in[I_X]; const f32x4* cs = (const f32x4*)A.in[I_CTX]; f32x4* xr = (f32x4*)(F.ws + WS_XRES);
      for (int i = gt; i < MX * D / 4; i += NT) xr[i] = xs[i];
      for (int i = gt; i < MC * D / 4; i += NT) xr[MX * D / 4 + i] = cs[i]; }
    { f32x2* tw = (f32x2*)(F.ws + WS_TW);
      for (int k = gt; k < 16384; k += NT) { float s, c; sincospif((float)k * (2.0f / 16384.0f), &s, &c); tw[k] = (f32x2){c, -s}; } }
    LAS float* sc = (LAS float*)F.lds;
    LAS float* red = (LAS float*)(F.lds + 3 * 2048 * 4);
    for (int i = F.tid; i < 3 * 2048; i += 512) { const int r = i / 2048, k = i % 2048; const float v = r < 2 ? A.in[I_C][r * 2048 + k] : A.in[I_CCTX][k]; sc[i] = siluf_(v); }
    __syncthreads();
    const int col = F.tid & 63, ks = F.tid >> 6;
    for (int chunk = F.bid; chunk < DEPTH * 192; chunk += F.G) {
        const int l = chunk / 192, n0 = (chunk % 192) * 64;
        const float* w = A.in[I_WMOD] + (size_t)l * 2048 * 12288 + n0 + col;
        float s0 = 0.f, s1 = 0.f, s2 = 0.f;
#pragma unroll 8
        for (int k = ks * 256; k < ks * 256 + 256; ++k) { const float wv = w[(size_t)k * 12288]; s0 += sc[k] * wv; s1 += sc[2048 + k] * wv; s2 += sc[4096 + k] * wv; }
        red[(ks * 3 + 0) * 64 + col] = s0; red[(ks * 3 + 1) * 64 + col] = s1; red[(ks * 3 + 2) * 64 + col] = s2;
        __syncthreads();
        if (F.tid < 192) { const int r = F.tid >> 6, c2 = F.tid & 63; float s = 0.f;
#pragma unroll
            for (int q = 0; q < 8; ++q) s += red[(q * 3 + r) * 64 + c2];
            ((float*)(F.ws + WS_MOD))[((size_t)l * 3 + r) * 12288 + n0 + c2] = s + A.in[I_BMOD][(size_t)l * 12288 + n0 + c2]; }
        __syncthreads();
    }
}

__device__ __forceinline__ void transpose_item(const float* W, int ldw, int k0, int srccol0, f16* WT, int dstrow0, int ldk, LAS float* scr, int lane) {
#pragma unroll 8
    for (int i = 0; i < 32; ++i) { const int kk = 2 * i + (lane >> 5); scr[kk * 33 + (lane & 31)] = srccol0 >= 0 ? W[(size_t)(k0 + kk) * ldw + srccol0 + (lane & 31)] : 0.f; }
    LDS_WAIT(); asm volatile("" ::: "memory");
    const int c = lane & 7;
#pragma unroll
    for (int j = 0; j < 4; ++j) { const int n = (lane >> 3) + 8 * j; const LAS float* s = scr + (8 * c) * 33 + n;
        f16x8 o;
#pragma unroll
        for (int e = 0; e < 8; ++e) o[e] = (f16)s[e * 33];
        *(f16x8*)(WT + (size_t)(dstrow0 + n) * ldk + k0 + 8 * c) = o; }
    LDS_WAIT(); asm volatile("" ::: "memory");
}
__device__ __forceinline__ void ph_convert_weights(const Ctx& F, const Args& A, int l) {
    LAS float* scr = (LAS float*)(F.lds + F.wave * 16384);
    const int gw = F.bid * 8 + F.wave, NGW = F.G * 8;
    constexpr int I_IN = 32 * 360, I_GLU = 8 * 16, I_BR = 32 * 64, I_OUT = 32 * 64, I_UP = 32 * 352, I_DN = 88 * 64;
    constexpr int NIT = I_IN + I_GLU + I_BR + I_OUT + I_UP + I_DN;
    for (int it = gw; it < NIT; it += NGW) {
        int r = it;
        if (r < I_IN) { const int kb = r / 360, nb = r % 360, j0 = nb * 32;
            const int src = j0 < 2048 ? j0 : (j0 < 11264 ? j0 + 32 : (j0 < 11296 ? 2048 + (j0 - 11264) : -1));
            transpose_item(A.in[I_WIN] + (size_t)l * 2048 * INW, INW, kb * 64, src, (f16*)(F.ws + WS_WIN), j0, 2048, scr, F.lane); continue; } r -= I_IN;
        if (r < I_GLU) { const int kb = r / 16, nb = r % 16; transpose_item(A.in[I_GLUW] + (size_t)l * 512 * 512, 512, kb * 64, nb * 32, (f16*)(F.ws + WS_WGLU), nb * 32, 512, scr, F.lane); continue; } r -= I_GLU;
        if (r < I_BR) { const int kb = r / 64, nb = r % 64; transpose_item(A.in[I_WBR] + (size_t)l * 2048 * 2048, 2048, kb * 64, nb * 32, (f16*)(F.ws + WS_WBR), nb * 32, 2048, scr, F.lane); continue; } r -= I_BR;
        if (r < I_OUT) { const int kb = r / 64, nb = r % 64; transpose_item(A.in[I_WOUT] + (size_t)l * 2048 * 2048, 2048, kb * 64, nb * 32, (f16*)(F.ws + WS_WOUT), nb * 32, 2048, scr, F.lane); continue; } r -= I_OUT;
        if (r < I_UP) { const int kb = r / 352, nb = r % 352; transpose_item(A.in[I_WUP] + (size_t)l * 2048 * UPLD, UPLD, kb * 64, nb * 32, (f16*)(F.ws + WS_WUP), nb * 32, 2048, scr, F.lane); continue; } r -= I_UP;
        { const int kb = r / 64, nb = r % 64; transpose_item(A.in[I_WDN] + (size_t)l * FFH * 2048, 2048, kb * 64, nb * 32, (f16*)(F.ws + WS_WDN), nb * 32, FFH, scr, F.lane); }
    }
}

__device__ __forceinline__ void s5_mats_group(const Ctx& F, const Args& A, int l, int g) {
    LAS f32x2* APOW = (LAS f32x2*)F.lds;
    LAS f32x2* BBAR = APOW + 2 * 17 * 64;
    LAS f32x2* CM = BBAR + 2 * 64 * 16;
    LAS float* KLAG = (LAS float*)(CM + 2 * 16 * 64);
    __syncthreads();
    for (int i = F.tid; i < 2 * 17 * 64; i += 512) { const int d = i / (17 * 64), e = (i / 64) % 17, n = i % 64;
        const size_t pi = (((size_t)l * 2 + d) * 32 + g) * 64 + n;
        const float are = A.in[I_S5ARE][pi], aim = A.in[I_S5AIM][pi], dt = expf(A.in[I_S5STEP][((size_t)l * 2 + d) * 32 + g]);
        const float zr = are * dt * (float)e, zi = aim * dt * (float)e; float s, c; sincosf(zi, &s, &c); const float m = expf(zr);
        APOW[i] = (f32x2){m * c, m * s}; }
    __syncthreads();
    for (int i = F.tid; i < 2 * 64 * 16; i += 512) { const int d = i / 1024, n = (i / 16) % 64, h = i % 16;
        const size_t pi = (((size_t)l * 2 + d) * 32 + g) * 64 + n;
        const float are = A.in[I_S5ARE][pi], aim = A.in[I_S5AIM][pi];
        const f32x2 ab = APOW[(d * 17 + 1) * 64 + n]; const f32x2 num = (f32x2){ab.x - 1.0f, ab.y};
        const float den = are * are + aim * aim; const f32x2 q = (f32x2){(num.x * are + num.y * aim) / den, (num.y * are - num.x * aim) / den};
        const size_t bi = (pi * 16) + h;
        BBAR[i] = cmul(q, (f32x2){A.in[I_S5BRE][bi], A.in[I_S5BIM][bi]});
        const size_t ci = ((((size_t)l * 2 + d) * 32 + g) * 16 + h) * 64 + n;
        CM[(d * 16 + h) * 64 + n] = (f32x2){A.in[I_S5CRE][ci], A.in[I_S5CIM][ci]}; }
    __syncthreads();
    for (int i = F.tid; i < 2 * 16 * 256; i += 512) { const int d = i / 4096, lag = (i / 256) % 16, h = (i / 16) % 16, hp = i % 16; float s = 0.f;
        for (int n = 0; n < 64; ++n) { const f32x2 t = cmul(CM[(d * 16 + h) * 64 + n], APOW[(d * 17 + lag) * 64 + n]); const f32x2 b = BBAR[(d * 64 + n) * 16 + hp]; s += t.x * b.x - t.y * b.y; }
        KLAG[i] = s; }
    __syncthreads();
    f16* W = (f16*)(F.ws + WS_S5W) + (size_t)g * 256 * 512;
    for (int i = F.tid; i < 256 * 64; i += 512) { const int n = i / 64, k8 = (i % 64) * 8, t = n >> 4, h = n & 15; f16x8 o;
#pragma unroll
        for (int e = 0; e < 8; ++e) { const int k = k8 + e; float v;
            if (k < 256) { const int s = k >> 4, hp = k & 15; v = 0.f;
                if (t >= s) v += KLAG[((0 * 16 + (t - s)) * 16 + h) * 16 + hp];
                if (s >= t) v += KLAG[((1 * 16 + (s - t)) * 16 + h) * 16 + hp];
                v *= S5SCALE; }
            else { const int d = (k - 256) >> 7, nn2 = (k - 256) & 127, nn = nn2 & 63, im = nn2 >> 6, ex = d == 0 ? t + 1 : 16 - t;
                const f32x2 z = cmul(CM[(d * 16 + h) * 64 + nn], APOW[(d * 17 + ex) * 64 + nn]); v = im ? -z.y : z.x; }
            o[e] = (f16)v; }
        *(f16x8*)(W + (size_t)n * 512 + k8) = o; }
    f16* Mx = (f16*)(F.ws + WS_S5M) + (size_t)g * 256 * 256;
    for (int i = F.tid; i < 256 * 32; i += 512) { const int n = i / 32, k8 = (i % 32) * 8, d = n >> 7, ri = (n >> 6) & 1, nn = n & 63; f16x8 o;
#pragma unroll
        for (int e = 0; e < 8; ++e) { const int k = k8 + e, s = k >> 4, hp = k & 15, ex = d == 0 ? 15 - s : s;
            const f32x2 z = cmul(APOW[(d * 17 + ex) * 64 + nn], BBAR[(d * 64 + nn) * 16 + hp]); o[e] = (f16)((ri ? z.y : z.x) * S5SCALE); }
        *(f16x8*)(Mx + (size_t)n * 256 + k8) = o; }
    if (F.tid < 128) { const int d = F.tid >> 6, nn = F.tid & 63; ((f32x2*)(F.ws + WS_S5AT))[(d * 32 + g) * 64 + nn] = APOW[(d * 17 + 16) * 64 + nn]; }
    __syncthreads();
}

__device__ __forceinline__ void ph_hyena_h2(const Ctx& F, const Args& A, int l) {
    LAS float* W1 = (LAS float*)F.lds;
    LAS float* W2 = W1 + 33 * 64;
    LAS float* PV = W2 + 64 * 64;
    LAS float* SCR = PV + 256;
    __syncthreads();
    for (int i = F.tid; i < 33 * 64; i += 512) W1[i] = A.in[I_HYW1][(size_t)l * 33 * 64 + i];
    for (int i = F.tid; i < 64 * 64; i += 512) W2[i] = A.in[I_HYW2][(size_t)l * 4096 + i];
    if (F.tid < 64) { PV[F.tid] = A.in[I_HYB1][l * 64 + F.tid]; PV[64 + F.tid] = A.in[I_HYF1][l * 64 + F.tid]; PV[128 + F.tid] = A.in[I_HYB2][l * 64 + F.tid]; PV[192 + F.tid] = A.in[I_HYF2][l * 64 + F.tid]; }
    __syncthreads();
    LAS float* scr = SCR + F.wave * 64;
    const int gw = F.bid * 8 + F.wave, NGW = F.G * 8, j = F.lane;
    float* H2 = (float*)(F.ws + WS_H2);
    for (int p = gw; p < SEQ + LC; p += NGW) {
        const int n = p < SEQ ? SEQ : LC, pos = p < SEQ ? p : p - SEQ;
        float feat = 0.f;
        if (j == 0) feat = (float)pos / (float)(n - 1);
        else if (j < 33) { const int fi = (j - 1) & 15; const float fr = 1e-4f + (float)fi * ((15.0f - 1e-4f) / 15.0f);
            const float ang = (6.283185307179586f / (float)n) * (float)pos * fr; float s, c; sincosf(ang, &s, &c); feat = j < 17 ? c : -s; }
        scr[j] = feat; LDS_WAIT(); asm volatile("" ::: "memory");
        float a = PV[j];
        for (int i = 0; i < 33; ++i) a += scr[i] * W1[i * 64 + j];
        const float h1 = sinf(PV[64 + j] * a);
        LDS_WAIT(); asm volatile("" ::: "memory");
        scr[j] = h1; LDS_WAIT(); asm volatile("" ::: "memory");
        float b = PV[128 + j];
        for (int i = 0; i < 64; ++i) b += scr[i] * W2[i * 64 + j];
        H2[(size_t)p * 64 + j] = sinf(PV[192 + j] * b);
        LDS_WAIT(); asm volatile("" ::: "memory");
    }
}

__device__ __forceinline__ void ph_norm(const Ctx& F, const Args& A, int l, int which) {
    const int gw = F.bid * 8 + F.wave, NGW = F.G * 8;
    const float* X = (const float*)(F.ws + WS_XRES); f16* O = (f16*)(F.ws + WS_HN);
    const float* gain = A.in[which ? I_N2G : I_N1G] + (size_t)l * D;
    const float* mod = (const float*)(F.ws + WS_MOD) + (size_t)l * 3 * 12288;
    const int shoff = which ? 6144 : 0, soff = which ? 8192 : 2048;
    for (int m = gw; m < MT; m += NGW) {
        const int bsel = m < SEQ ? 0 : (m < MX ? 1 : 2);
        const f32x4* xr = (const f32x4*)(X + (size_t)m * D) + F.lane;
        f32x4 v[8]; float s = 0.f;
#pragma unroll
        for (int j = 0; j < 8; ++j) { v[j] = xr[64 * j]; s += (v[j].x * v[j].x + v[j].y * v[j].y) + (v[j].z * v[j].z + v[j].w * v[j].w); }
        const float rstd = 1.0f / sqrtf(wave_sum(s) * (1.0f / D) + EPS);
        const float* mp = mod + bsel * 12288;
#pragma unroll
        for (int j = 0; j < 8; ++j) { const int c = 4 * F.lane + 256 * j;
            const f32x4 g = *(const f32x4*)(gain + c), sh = *(const f32x4*)(mp + shoff + c), sc = *(const f32x4*)(mp + soff + c);
            f16x4 o;
#pragma unroll
            for (int e = 0; e < 4; ++e) o[e] = (f16)(v[j][e] * rstd * g[e] * (1.0f + sc[e]) + sh[e]);
            *(f16x4*)(O + (size_t)m * D + c) = o; }
    }
}
__device__ __forceinline__ void ph_final_norm(const Ctx& F, const Args& A) {
    const int gw = F.bid * 8 + F.wave, NGW = F.G * 8;
    const float* X = (const float*)(F.ws + WS_XRES); const float* gain = A.in[I_FNG];
    for (int m = gw; m < MX; m += NGW) {
        const f32x4* xr = (const f32x4*)(X + (size_t)m * D) + F.lane;
        f32x4 v[8]; float s = 0.f;
#pragma unroll
        for (int j = 0; j < 8; ++j) { v[j] = xr[64 * j]; s += (v[j].x * v[j].x + v[j].y * v[j].y) + (v[j].z * v[j].z + v[j].w * v[j].w); }
        const float rstd = 1.0f / sqrtf(wave_sum(s) * (1.0f / D) + EPS);
#pragma unroll
        for (int j = 0; j < 8; ++j) { const int c = 4 * F.lane + 256 * j; const f32x4 g = *(const f32x4*)(gain + c);
            *(f32x4*)(A.out + (size_t)m * D + c) = v[j] * rstd * g; }
    }
}

__device__ __forceinline__ void ph_s5_scan(const Ctx& F) {
    if (F.tid >= 32) return;
    const float* S = (const float*)(F.ws + WS_S5S); f16* SA = (f16*)(F.ws + WS_S5A);
    for (int gt = F.bid * 32 + F.tid; gt < 2 * 2 * 32 * 64; gt += F.G * 32) {
        const int nn = gt & 63, g = (gt >> 6) & 31, d = (gt >> 11) & 1, b = gt >> 12;
        const f32x2 at = ((const f32x2*)(F.ws + WS_S5AT))[(d * 32 + g) * 64 + nn];
        f32x2 st = (f32x2){0.f, 0.f};
        for (int base = 0; base < 16 + 512; base += 16) {
            f32x2 loc[16]; int chk[16];
#pragma unroll
            for (int u = 0; u < 16; ++u) { const int step = base + u; int chunk;
                if (d == 0) chunk = step < 16 ? 1024 + b * 16 + step : b * 512 + (step - 16);
                else chunk = step < 16 ? 1024 + b * 16 + (15 - step) : b * 512 + (511 - (step - 16));
                chk[u] = chunk; const size_t so = ((size_t)chunk * 32 + g) * 256 + d * 128 + nn;
                loc[u] = (f32x2){S[so], S[so + 64]}; }
#pragma unroll
            for (int u = 0; u < 16; ++u) { f16* xp = SA + (size_t)chk[u] * 16384 + (size_t)g * 512 + 256 + d * 128 + nn;
                xp[0] = (f16)st.x; xp[64] = (f16)st.y;
                st = cmul(at, st) + loc[u]; }
        }
    }
}

__device__ __forceinline__ void ph_ffn_act(const Ctx& F, const Args& A, int l) {
    const f16* UP = (const f16*)(F.ws + WS_PX); f16* ACT = (f16*)(F.ws + WS_ACT);
    const float* cw = A.in[I_FFCW] + (size_t)l * 3 * FFH; const float* cb = A.in[I_FFCB] + (size_t)l * FFH;
    const int NTASK = (MT / 16) * (FFH / 8);
    for (int task = F.bid * 512 + F.tid; task < NTASK; task += F.G * 512) {
        const int rb = task / (FFH / 8), cg = task % (FFH / 8), c0 = cg * 8, r0 = rb * 16;
        int seq0, seqn; if (r0 < MX) { seq0 = (r0 / SEQ) * SEQ; seqn = SEQ; } else { seq0 = MX + ((r0 - MX) / LC) * LC; seqn = LC; }
        float w0[8], w1[8], w2[8], bb[8];
#pragma unroll
        for (int e = 0; e < 8; ++e) { w0[e] = cw[c0 + e]; w1[e] = cw[FFH + c0 + e]; w2[e] = cw[2 * FFH + c0 + e]; bb[e] = cb[c0 + e]; }
        f16x8 zero;
#pragma unroll
        for (int e = 0; e < 8; ++e) zero[e] = (f16)0.f;
        f16x8 pm = (r0 > seq0) ? *(const f16x8*)(UP + (size_t)(r0 - 1) * UPLD + c0) : zero;
        f16x8 pc = *(const f16x8*)(UP + (size_t)r0 * UPLD + c0);
#pragma unroll 4
        for (int i = 0; i < 16; ++i) { const int r = r0 + i;
            const f16x8 pn = (r + 1 < seq0 + seqn) ? *(const f16x8*)(UP + (size_t)(r + 1) * UPLD + c0) : zero;
            const f16x8 bv = *(const f16x8*)(UP + (size_t)r * UPLD + FFH + c0);
            f16x8 o;
#pragma unroll
            for (int e = 0; e < 8; ++e) { const float a = w0[e] * (float)pm[e] + w1[e] * (float)pc[e] + w2[e] * (float)pn[e] + bb[e]; o[e] = (f16)(siluf_(a) * (float)bv[e]); }
            *(f16x8*)(ACT + (size_t)r * FFH + c0) = o;
            pm = pc; pc = pn; }
    }
}

namespace gla {
constexpr int QK_LD = 136, KH_LD = 72, VT_LD = 72, P_LD = 72;
constexpr int OFF_QT = 0;
constexpr int OFF_KT = 17408;
constexpr int OFF_VT = OFF_KT + 18432;
constexpr int OFF_P = OFF_VT + 36864;
constexpr int OFF_LR = OFF_P + 9216;
constexpr int OFF_GT = OFF_LR + 4096;
constexpr int OFF_DEC = OFF_GT + 2048;
constexpr int OFF_RS = OFF_DEC + 512;
constexpr int OFF_QR = OFF_RS + 2048;
constexpr int OFF_KR = OFF_QR + 17408;
constexpr int OFF_WG = OFF_KR + 17408;
static_assert(OFF_WG + 8192 <= LDSCTL_OFF, "gla lds");

__device__ __forceinline__ int grow(int b, int sc, int j, int i) {
    if (sc < 32) { const int col = 2 * sc + (j >> 1), r = (j & 1) * 64 + i; return b * SEQ + r * 64 + col; }
    return MX + b * LC + j * 64 + i;
}
#define GLA_MFMA(a, b, c) __builtin_amdgcn_mfma_f32_16x16x32_f16(a, b, c, 0, 0, 0)

template <bool FULL>
__device__ __forceinline__ void gla_unit(const Ctx& F, const Args& A, int l, int unit) {
    const int b = unit / (4 * NSC), h = (unit / NSC) % 4, sc = unit % NSC;
    LAS f16* QT = (LAS f16*)(F.lds + OFF_QT); LAS f16* KT = (LAS f16*)(F.lds + OFF_KT); LAS f16* VT = (LAS f16*)(F.lds + OFF_VT);
    LAS f16* PP = (LAS f16*)(F.lds + OFF_P); LAS f16* LR = (LAS f16*)(F.lds + OFF_LR);
    LAS float* GT = (LAS float*)(F.lds + OFF_GT); LAS float* DEC = (LAS float*)(F.lds + OFF_DEC); LAS float* RS = (LAS float*)(F.lds + OFF_RS);
    LAS f16* QR = (LAS f16*)(F.lds + OFF_QR); LAS f16* KR = (LAS f16*)(F.lds + OFF_KR); LAS float* WG = (LAS float*)(F.lds + OFF_WG);
    const int tid = F.tid, lane = F.lane, w = F.wave, q0 = lane >> 4, c0 = lane & 15;
    const int dk0 = tid & 127, ig0 = tid >> 7;
    const f16* PX = (const f16*)(F.ws + WS_PX);
    const float scale = 0.08838834764831845f;
    for (int dir = 0; dir < 2; ++dir) {
        __syncthreads();
        for (int i = tid; i < 16 * 128; i += 512) WG[i] = A.in[I_GLAWG][(((size_t)l * 2 + dir) * 16 + (i >> 7)) * 512 + h * 128 + (i & 127)];
        const float bgv = A.in[I_GLABG][((size_t)l * 2 + dir) * 512 + h * 128 + dk0];
        const size_t sidx = ((((size_t)b * 4 + h) * NSC + sc) * 2 + dir);
        f32x4 accS[8][2];
        if (FULL) { const float* Sin = (const float*)(F.ws + WS_GSIN) + sidx * 32768; const int q = opq(q0), c = opq(c0);
#pragma unroll
            for (int dt = 0; dt < 8; ++dt)
#pragma unroll
                for (int et = 0; et < 2; ++et)
#pragma unroll
                    for (int r = 0; r < 4; ++r) accS[dt][et][r] = Sin[(16 * dt + 4 * q + r) * 256 + 32 * w + 16 * et + c]; }
        else {
#pragma unroll
            for (int dt = 0; dt < 8; ++dt)
#pragma unroll
                for (int et = 0; et < 2; ++et) accS[dt][et] = (f32x4){0.f, 0.f, 0.f, 0.f}; }
        float sumtot = 0.f;
        for (int jj = 0; jj < 4; ++jj) {
            const int j = dir ? 3 - jj : jj;
            __syncthreads();
            const int tid = opq(F.tid);
            if (tid < 256) { const int row = tid >> 2, part = tid & 3; const int gr = grow(b, sc, j, row);
                *(LAS f16x8*)(LR + row * 32 + part * 8) = *(const f16x8*)(PX + (size_t)gr * PXLD + P_GG + part * 8); }
#pragma unroll 1
            for (int k = 0; k < 4; ++k) { const int idx = tid + 512 * k, wi = idx >> 6, ln = idx & 63, rr = ln >> 2, cc = ln & 3;
                const int row = (wi & 3) * 16 + rr, chunk = (wi >> 2) * 4 + cc; const int gr = grow(b, sc, j, row);
                const f16x8 v8 = *(const f16x8*)(PX + (size_t)gr * PXLD + P_GV + h * 256 + chunk * 8);
#pragma unroll
                for (int e = 0; e < 8; ++e) VT[(chunk * 8 + e) * VT_LD + row] = v8[e]; }
#pragma unroll 1
            for (int k = 0; k < 2; ++k) { const int idx = tid + 512 * k, row = idx >> 4, ch = idx & 15; const int gr = grow(b, sc, j, row);
                *(LAS f16x8*)(KR + row * QK_LD + ch * 8) = *(const f16x8*)(PX + (size_t)gr * PXLD + P_GK + h * 128 + ch * 8);
                if (FULL) *(LAS f16x8*)(QR + row * QK_LD + ch * 8) = *(const f16x8*)(PX + (size_t)gr * PXLD + P_GQ + h * 128 + ch * 8); }
            __syncthreads();
            const int dk = opq(dk0), ig = opq(ig0);
            float bv[16];
#pragma unroll
            for (int ii = 0; ii < 16; ++ii) { const int i = ig * 16 + ii; float pre = bgv;
                const f16x8 l0 = *(const LAS f16x8*)(LR + i * 32 + dir * 16), l1 = *(const LAS f16x8*)(LR + i * 32 + dir * 16 + 8);
#pragma unroll
                for (int r = 0; r < 8; ++r) pre += (float)l0[r] * WG[r * 128 + dk] + (float)l1[r] * WG[(8 + r) * 128 + dk];
                bv[ii] = logsigmoidf_(pre) * (1.0f / 16.0f); asm volatile("" ::: "memory"); }
            float totloc;
            if (dir == 0) {
#pragma unroll
                for (int ii = 1; ii < 16; ++ii) bv[ii] += bv[ii - 1];
                totloc = bv[15]; }
            else {
#pragma unroll
                for (int ii = 14; ii >= 0; --ii) bv[ii] += bv[ii + 1];
                totloc = bv[0]; }
            GT[ig * 128 + dk] = totloc;
            __syncthreads();
            const float g0 = GT[dk], g1 = GT[128 + dk], g2 = GT[256 + dk], g3 = GT[384 + dk];
            const float total = (g0 + g1) + (g2 + g3);
            float off, bmid;
            if (dir == 0) { off = (ig > 0 ? g0 : 0.f) + (ig > 1 ? g1 : 0.f) + (ig > 2 ? g2 : 0.f); bmid = g0 + g1; }
            else { off = (ig < 3 ? g3 : 0.f) + (ig < 2 ? g2 : 0.f) + (ig < 1 ? g1 : 0.f); bmid = g2 + g3; }
#pragma unroll
            for (int ii = 0; ii < 16; ++ii) bv[ii] += off;
            if (FULL) {
#pragma unroll
                for (int ii = 0; ii < 16; ++ii) { const int i = ig * 16 + ii;
                    QT[i * QK_LD + dk] = (f16)((float)QR[i * QK_LD + dk] * scale * __expf(fminf(bv[ii] - bmid, 9.f)));
                    KT[i * QK_LD + dk] = (f16)((float)KR[i * QK_LD + dk] * __expf(fminf(bmid - bv[ii], 9.f))); if ((ii & 3) == 3) asm volatile("" ::: "memory"); }
                __syncthreads();
                { const int c = opq(c0), q = opq(q0);
#pragma unroll
                for (int s = 0; s < 2; ++s) { const int T = 2 * w + s, it = T >> 2, jt = T & 3; f32x4 a = (f32x4){0.f, 0.f, 0.f, 0.f};
#pragma unroll
                    for (int kk = 0; kk < 4; ++kk) { const f16x8 kf = *(const LAS f16x8*)(KT + (jt * 16 + c) * QK_LD + kk * 32 + 8 * q);
                        const f16x8 qf = *(const LAS f16x8*)(QT + (it * 16 + c) * QK_LD + kk * 32 + 8 * q); a = GLA_MFMA(kf, qf, a); }
                    const int i = it * 16 + c; f16x4 pv;
#pragma unroll
                    for (int r = 0; r < 4; ++r) { const int jx = jt * 16 + 4 * q + r; const bool keep = dir == 0 ? (jx <= i) : (jx >= i); pv[r] = keep ? (f16)a[r] : (f16)0.f; }
                    *(LAS f16x4*)(PP + i * P_LD + jt * 16 + 4 * q) = pv; } }
                __syncthreads();
#pragma unroll
                for (int ii = 0; ii < 16; ++ii) { const int i = ig * 16 + ii; QT[i * QK_LD + dk] = (f16)((float)QR[i * QK_LD + dk] * scale * __expf(bv[ii])); if ((ii & 3) == 3) asm volatile("" ::: "memory"); }
            }
            { f16x8 k0, k1;
#pragma unroll
              for (int ii = 0; ii < 8; ++ii) { k0[ii] = (f16)((float)KR[(ig * 16 + ii) * QK_LD + dk] * __expf(total - bv[ii])); k1[ii] = (f16)((float)KR[(ig * 16 + 8 + ii) * QK_LD + dk] * __expf(total - bv[8 + ii])); }
              *(LAS f16x8*)(KT + dk * KH_LD + ig * 16) = k0; *(LAS f16x8*)(KT + dk * KH_LD + ig * 16 + 8) = k1; }
            if (ig == 0) { DEC[dk] = __expf(total); sumtot += total; }
            __syncthreads();
            const int c = opq(c0), q = opq(q0);
            if (FULL) {
                f32x4 accO[4][2];
#pragma unroll
                for (int it = 0; it < 4; ++it)
#pragma unroll
                    for (int et = 0; et < 2; ++et) accO[it][et] = (f32x4){0.f, 0.f, 0.f, 0.f};
#pragma unroll
                for (int et = 0; et < 2; ++et)
#pragma unroll
                    for (int kk = 0; kk < 2; ++kk) { const f16x8 vf = *(const LAS f16x8*)(VT + (32 * w + 16 * et + c) * VT_LD + kk * 32 + 8 * q);
#pragma unroll
                        for (int it = 0; it < 4; ++it) { const f16x8 pf = *(const LAS f16x8*)(PP + (it * 16 + c) * P_LD + kk * 32 + 8 * q); accO[it][et] = GLA_MFMA(vf, pf, accO[it][et]); } asm volatile("" ::: "memory"); }
#pragma unroll
                for (int kb = 0; kb < 4; ++kb)
#pragma unroll
                    for (int et = 0; et < 2; ++et) { f16x8 sf; asm volatile("" ::: "memory");
#pragma unroll
                        for (int e = 0; e < 4; ++e) { sf[e] = (f16)accS[2 * kb][et][e]; sf[4 + e] = (f16)accS[2 * kb + 1][et][e]; }
#pragma unroll
                        for (int it = 0; it < 4; ++it) { const f16x4 lo = *(const LAS f16x4*)(QT + (it * 16 + c) * QK_LD + 32 * kb + 4 * q), hi = *(const LAS f16x4*)(QT + (it * 16 + c) * QK_LD + 32 * kb + 16 + 4 * q);
                            f16x8 qf; qf[0] = lo[0]; qf[1] = lo[1]; qf[2] = lo[2]; qf[3] = lo[3]; qf[4] = hi[0]; qf[5] = hi[1]; qf[6] = hi[2]; qf[7] = hi[3];
                            accO[it][et] = GLA_MFMA(sf, qf, accO[it][et]); } }
                float* OF = (float*)(F.ws + WS_GOF);
                if (dir == 0) {
#pragma unroll
                    for (int it = 0; it < 4; ++it) { const int gr = grow(b, sc, j, it * 16 + c);
#pragma unroll
                        for (int et = 0; et < 2; ++et) *(f32x4*)(OF + (size_t)gr * 1024 + h * 256 + 32 * w + 16 * et + 4 * q) = accO[it][et];
                        asm volatile("" ::: "memory"); } }
                else {
                    int grs[4];
#pragma unroll
                    for (int it = 0; it < 4; ++it) { grs[it] = grow(b, sc, j, it * 16 + c); float ss = 0.f;
#pragma unroll
                        for (int et = 0; et < 2; ++et) { accO[it][et] = accO[it][et] + *(const f32x4*)(OF + (size_t)grs[it] * 1024 + h * 256 + 32 * w + 16 * et + 4 * q);
                            ss += (accO[it][et][0] * accO[it][et][0] + accO[it][et][1] * accO[it][et][1]) + (accO[it][et][2] * accO[it][et][2] + accO[it][et][3] * accO[it][et][3]); }
                        ss += __shfl_xor(ss, 16); ss += __shfl_xor(ss, 32);
                        if (q == 0) RS[(it * 16 + c) * 8 + w] = ss; asm volatile("" ::: "memory"); }
                    __syncthreads();
                    const float* ng = A.in[I_GLANG] + (size_t)l * 256;
                    f16* Y = (f16*)(F.ws + WS_YCAT);
#pragma unroll
                    for (int it = 0; it < 4; ++it) { const int i = it * 16 + c; const f32x4 ra = *(const LAS f32x4*)(RS + i * 8), rb = *(const LAS f32x4*)(RS + i * 8 + 4);
                        const float tot = ((ra[0] + ra[1]) + (ra[2] + ra[3])) + ((rb[0] + rb[1]) + (rb[2] + rb[3]));
                        const float rstd = 1.0f / sqrtf(tot * (1.0f / 256.0f) + EPS);
#pragma unroll
                        for (int et = 0; et < 2; ++et) { const int e0 = 32 * w + 16 * et + 4 * q;
                            const f32x4 gv = *(const f32x4*)(ng + e0); const f16x4 rv = *(const f16x4*)(PX + (size_t)grs[it] * PXLD + P_GR + h * 256 + e0);
                            f16x4 o;
#pragma unroll
                            for (int r = 0; r < 4; ++r) o[r] = (f16)(accO[it][et][r] * rstd * gv[r] * siluf_((float)rv[r]));
                            *(f16x4*)(Y + (size_t)grs[it] * 2048 + 1024 + h * 256 + e0) = o; } asm volatile("" ::: "memory"); }
                }
            }
#pragma unroll
            for (int dt = 0; dt < 8; ++dt) { const f32x4 dv = *(const LAS f32x4*)(DEC + 16 * dt + 4 * q);
#pragma unroll
                for (int et = 0; et < 2; ++et) accS[dt][et] = accS[dt][et] * dv; }
#pragma unroll
            for (int kk = 0; kk < 2; ++kk) { f16x8 vf[2];
#pragma unroll
                for (int et = 0; et < 2; ++et) vf[et] = *(const LAS f16x8*)(VT + (32 * w + 16 * et + c) * VT_LD + kk * 32 + 8 * q);
#pragma unroll
                for (int dt = 0; dt < 8; ++dt) { const f16x8 kf = *(const LAS f16x8*)(KT + (16 * dt + c) * KH_LD + kk * 32 + 8 * q);
#pragma unroll
                    for (int et = 0; et < 2; ++et) accS[dt][et] = GLA_MFMA(kf, vf[et], accS[dt][et]); if (dt & 1) asm volatile("" ::: "memory"); } }
        }
        if (!FULL) { float* Sl = (float*)(F.ws + WS_GSLOC) + sidx * 32768; const int q = opq(q0), c = opq(c0);
#pragma unroll
            for (int dt = 0; dt < 8; ++dt)
#pragma unroll
                for (int et = 0; et < 2; ++et)
#pragma unroll
                    for (int r = 0; r < 4; ++r) Sl[(16 * dt + 4 * q + r) * 256 + 32 * w + 16 * et + c] = accS[dt][et][r];
            if (ig0 == 0) ((float*)(F.ws + WS_GDT))[sidx * 128 + dk0] = __expf(sumtot); }
        VM_WAIT();
    }
}
__device__ __forceinline__ void ph_gla_scan(const Ctx& F) {
    const float* Sl = (const float*)(F.ws + WS_GSLOC); float* Si = (float*)(F.ws + WS_GSIN); const float* Dt = (const float*)(F.ws + WS_GDT);
    for (int gt = F.bid * 512 + F.tid; gt < 2 * 4 * 2 * 32768; gt += F.G * 512) {
        const int e = gt & 32767, dir = (gt >> 15) & 1, h = (gt >> 16) & 3, b = gt >> 18;
        float S = 0.f;
        for (int base = 0; base < NSC; base += 11) {
            float sl[11], dt[11]; size_t ix[11];
#pragma unroll
            for (int u = 0; u < 11; ++u) { const int step = base + u; const int sc = step == 0 ? 32 : (dir == 0 ? step - 1 : 32 - step);
                const size_t idx = ((((size_t)b * 4 + h) * NSC + sc) * 2 + dir); ix[u] = idx;
                sl[u] = Sl[idx * 32768 + e]; dt[u] = Dt[idx * 128 + (e >> 8)]; }
#pragma unroll
            for (int u = 0; u < 11; ++u) { Si[ix[u] * 32768 + e] = S; S = dt[u] * S + sl[u]; }
        }
    }
}
#undef GLA_MFMA
}

namespace hy {
#define PADI(i) ((i) + ((i) >> 5))
constexpr int HY_BUF_BYTES = (16384 + 512) * 8;
constexpr int HY_SCR_OFF = HY_BUF_BYTES;
static_assert(HY_SCR_OFF + 2048 <= LDSCTL_OFF, "hyena lds");
__device__ __forceinline__ f32x2 twid(int k, float invN) { const float xr = (float)k * invN; return (f32x2){__builtin_amdgcn_cosf(xr), -__builtin_amdgcn_sinf(xr)}; }
__device__ __forceinline__ f32x2 mul_w16(f32x2 d, int a) {
    constexpr float c1 = 0.9238795325112867f, s1 = 0.3826834323650898f, r = 0.7071067811865476f;
    float c, s;
    switch (a & 15) {
        case 0: return d; case 4: return (f32x2){d.y, -d.x}; case 8: return (f32x2){-d.x, -d.y}; case 12: return (f32x2){-d.y, d.x};
        case 1: c = c1; s = s1; break; case 2: c = r; s = r; break; case 3: c = s1; s = c1; break;
        case 5: c = -s1; s = c1; break; case 6: c = -r; s = r; break; case 7: c = -c1; s = s1; break;
        case 9: c = -c1; s = -s1; break; case 10: c = -r; s = -r; break; case 11: c = -s1; s = -c1; break;
        case 13: c = s1; s = -c1; break; case 14: c = r; s = -r; break; default: c = c1; s = -s1; break; }
    return (f32x2){d.x * c + d.y * s, d.y * c - d.x * s};
}
template <int R> __device__ __forceinline__ void dif_pass(LAS f32x2* x, int m, int lh, int tid) {
    const int N = 1 << m; const float invN = 1.0f / (float)N; const int lg = lh - R + 1, g = 1 << lg, S = (N >> 1) >> lh;
    for (int q = tid; q < (N >> R); q += 512) { const int j = q & (g - 1), blk = q >> lg, base = (blk << (lh + 1)) + j;
        f32x2 v[1 << R];
#pragma unroll
        for (int k = 0; k < (1 << R); ++k) v[k] = x[PADI(base + k * g)];
        f32x2 w = twid(j * S, invN);
#pragma unroll
        for (int s = 0; s < R; ++s) { const int half = 1 << (R - 1 - s);
#pragma unroll
            for (int k = 0; k < (1 << R); ++k) if (!(k & half)) { const f32x2 a = v[k], b = v[k + half]; v[k] = a + b;
                v[k + half] = mul_w16(cmul(a - b, w), ((k & (half - 1)) << s) * (16 >> R)); }
            w = cmul(w, w); }
#pragma unroll
        for (int k = 0; k < (1 << R); ++k) x[PADI(base + k * g)] = v[k]; }
    __syncthreads();
}
template <int R> __device__ __forceinline__ void dit_pass(LAS f32x2* x, int m, int lh, int tid) {
    const int N = 1 << m; const float invN = 1.0f / (float)N; const int h = 1 << lh, S1 = (N >> 1) >> lh;
    for (int q = tid; q < (N >> R); q += 512) { const int j = q & (h - 1), blk = q >> lh, base = (blk << (lh + R)) + j;
        f32x2 v[1 << R];
#pragma unroll
        for (int k = 0; k < (1 << R); ++k) v[k] = x[PADI(base + k * h)];
        f32x2 wp[R]; wp[R - 1] = cconj(twid(j * (S1 >> (R - 1)), invN));
#pragma unroll
        for (int s = R - 2; s >= 0; --s) wp[s] = cmul(wp[s + 1], wp[s + 1]);
#pragma unroll
        for (int s = 0; s < R; ++s) { const int half = 1 << s;
#pragma unroll
            for (int k = 0; k < (1 << R); ++k) if (!(k & half)) { const f32x2 a = v[k];
                const f32x2 b = mul_w16(cmul(v[k + half], wp[s]), (16 - (k & (half - 1)) * (16 >> (s + 1))) & 15);
                v[k] = a + b; v[k + half] = a - b; } }
#pragma unroll
        for (int k = 0; k < (1 << R); ++k) x[PADI(base + k * h)] = v[k]; }
    __syncthreads();
}
__device__ __forceinline__ void fft_fwd(LAS f32x2* x, int m, int tid) {
    int lh = m - 1;
    while (lh + 1 >= 4) { dif_pass<4>(x, m, lh, tid); lh -= 4; }
    if (lh + 1 == 2) dif_pass<2>(x, m, 1, tid); else if (lh + 1 == 1) dif_pass<1>(x, m, 0, tid);
}
__device__ __forceinline__ void fft_inv(LAS f32x2* x, int m, int tid) {
    int lh = 0;
    while (m - lh >= 4) { dit_pass<4>(x, m, lh, tid); lh += 4; }
    if (m - lh == 2) dit_pass<2>(x, m, lh, tid); else if (m - lh == 1) dit_pass<1>(x, m, lh, tid);
}
__device__ __forceinline__ int brev(int k, int m) { return (int)(__brev((unsigned)k) >> (32 - m)); }

__device__ __forceinline__ void filt_unit(const Ctx& F, const Args& A, int l, int unit) {
    const int kind = unit >> 9, o = (unit >> 8) & 1, pair = unit & 255;
    const int n = kind ? LC : SEQ, m = kind ? 9 : 14, N = 2 * n, tid = F.tid;
    LAS f32x2* buf = (LAS f32x2*)F.lds;
    LAS float* W3 = (LAS float*)(F.lds + HY_SCR_OFF);
    LAS float* B3 = W3 + 256;
    LAS float* RED = B3 + 4;
    LAS float* INV = RED + 16;
    __syncthreads();
    if (tid < 256) { const int j = tid >> 2, ci = tid & 3; const int col = o * 1024 + (ci >> 1) * 512 + 2 * pair + (ci & 1);
        W3[j * 4 + ci] = A.in[I_HYW3][((size_t)l * 64 + j) * 2048 + col]; if (j == 0) B3[ci] = A.in[I_HYB3][(size_t)l * 2048 + col]; }
    __syncthreads();
    const float* H2 = (const float*)(F.ws + WS_H2) + (kind ? (size_t)SEQ * 64 : 0);
    const float lo = -3.0701134573253945f, hi = -15.350567286626973f;
    const float ra = fabsf(lo + (hi - lo) * (float)(2 * pair) / 511.0f), rb = fabsf(lo + (hi - lo) * (float)(2 * pair + 1) / 511.0f);
    float sa = 0.f, sb = 0.f;
    for (int t = tid; t < n; t += 512) {
        float a0 = B3[0], a1 = B3[1], a2 = B3[2], a3 = B3[3];
        const f32x4* hr = (const f32x4*)(H2 + (size_t)t * 64);
#pragma unroll 4
        for (int j4 = 0; j4 < 16; ++j4) { const f32x4 hv = hr[j4];
#pragma unroll
            for (int e = 0; e < 4; ++e) { const f32x4 wv = *(const LAS f32x4*)(W3 + (j4 * 4 + e) * 4); a0 += hv[e] * wv[0]; a1 += hv[e] * wv[1]; a2 += hv[e] * wv[2]; a3 += hv[e] * wv[3]; } }
        const float tn = (float)t / (float)(n - 1), da = expf(-tn * ra), db = expf(-tn * rb);
        const float fa = a0 * da, fb = a1 * db, ba = a2 * da, bb = a3 * db;
        buf[PADI(t)] = (f32x2){fa, fb}; sa += fabsf(fa); sb += fabsf(fb);
        if (t >= 1) { buf[PADI(N - t)] = (f32x2){ba, bb}; sa += fabsf(ba); sb += fabsf(bb); }
    }
    if (tid == 0) buf[PADI(n)] = (f32x2){0.f, 0.f};
    sa = wave_sum(sa); sb = wave_sum(sb);
    if (F.lane == 0) { RED[F.wave * 2] = sa; RED[F.wave * 2 + 1] = sb; }
    __syncthreads();
    if (tid < 2) { float s = 0.f;
#pragma unroll
        for (int w = 0; w < 8; ++w) s += RED[w * 2 + tid];
        INV[tid] = 1.0f / (s + EPS); }
    __syncthreads();
    { const float ia = INV[0], ib = INV[1];
      for (int i = tid; i < N; i += 512) { f32x2 v = buf[PADI(i)]; v.x *= ia; v.y *= ib; buf[PADI(i)] = v; } }
    __syncthreads();
    fft_fwd(buf, m, tid);
    f32x4* out = (f32x4*)(F.ws + WS_FSD + (kind ? FSD_C_OFF : 0)) + (size_t)(o * 256 + pair) * (n + 1);
    for (int u = tid; u <= n; u += 512) { const int p = u < n ? 2 * u : 1, k = brev(p, m), pn = brev((N - k) & (N - 1), m);
        const f32x2 zk = buf[PADI(p)], zn = cconj(buf[PADI(pn)]);
        const f32x2 fa = (zk + zn) * 0.5f, df = zk - zn, fb = (f32x2){df.y * 0.5f, -df.x * 0.5f};
        const f32x2 fs = (fa + fb) * 0.5f, fd = (fa - fb) * 0.5f;
        out[u] = (f32x4){fs.x, fs.y, fd.x, fd.y}; }
    __syncthreads();
}

__device__ __forceinline__ void main_unit(const Ctx& F, const Args& A, int l, int unit) {
    const int kind = unit >> 9, b = (unit >> 8) & 1, pair = unit & 255;
    const int n = kind ? LC : SEQ, m = kind ? 9 : 14, N = 2 * n, tid = F.tid;
    const int row0 = kind ? MX + b * LC : b * SEQ;
    LAS f32x2* buf = (LAS f32x2*)F.lds;
    const f16* ZT = (const f16*)(F.ws + WS_ZT) + (size_t)(2 * pair) * MT + row0;
    const float* cw = A.in[I_HYCW] + (size_t)l * 3 * 1536 + 2 * pair; const float* cb = A.in[I_HYCB] + (size_t)l * 1536 + 2 * pair;
    f32x2 yv[16], g1[16], g2[16];
#pragma unroll
    for (int g = 0; g < 3; ++g)
#pragma unroll
        for (int cc = 0; cc < 2; ++cc) { const float w0 = cw[g * 512 + cc], w1 = cw[1536 + g * 512 + cc], w2 = cw[3072 + g * 512 + cc], bs = cb[g * 512 + cc];
            const f16* zt = ZT + (size_t)(g * 512 + cc) * MT;
#pragma unroll
            for (int gi = 0; gi < 2; ++gi) { const int t0 = 8 * (tid + 512 * gi);
                f16x8 mv; float pv = 0.f, nv = 0.f;
#pragma unroll
                for (int e = 0; e < 8; ++e) mv[e] = (f16)0.f;
                if (t0 < n) { mv = *(const f16x8*)(zt + t0); if (t0 > 0) pv = (float)zt[t0 - 1]; if (t0 + 8 < n) nv = (float)zt[t0 + 8]; }
#pragma unroll
                for (int e = 0; e < 8; ++e) { const float zm = e == 0 ? pv : (float)mv[e == 0 ? 0 : e - 1], zc = (float)mv[e], zp = e == 7 ? nv : (float)mv[e == 7 ? 7 : e + 1];
                    const float r = w0 * zm + w1 * zc + w2 * zp + bs;
                    if (g == 0) { if (cc == 0) yv[gi * 8 + e].x = r; else yv[gi * 8 + e].y = r; }
                    else if (g == 1) { if (cc == 0) g1[gi * 8 + e].x = r; else g1[gi * 8 + e].y = r; }
                    else { if (cc == 0) g2[gi * 8 + e].x = r; else g2[gi * 8 + e].y = r; } } } }
    const float invN = 1.0f / (float)N;
#pragma unroll
    for (int o = 0; o < 2; ++o) {
        __syncthreads();
#pragma unroll
        for (int gi = 0; gi < 2; ++gi) { const int t0 = 8 * (tid + 512 * gi);
            if (t0 < n) {
#pragma unroll
                for (int e = 0; e < 8; ++e) { buf[PADI(t0 + e)] = yv[gi * 8 + e]; buf[PADI(n + t0 + e)] = (f32x2){0.f, 0.f}; } } }
        __syncthreads();
        fft_fwd(buf, m, tid);
        const f32x4* fsd = (const f32x4*)(F.ws + WS_FSD + (kind ? FSD_C_OFF : 0)) + (size_t)(o * 256 + pair) * (n + 1);
        for (int u = tid; u <= n; u += 512) { const int p = u < n ? 2 * u : 1, k = brev(p, m), pn = brev((N - k) & (N - 1), m);
            const f32x2 zk = buf[PADI(p)], zn = buf[PADI(pn)]; const f32x4 f = fsd[u]; const f32x2 fs = (f32x2){f[0], f[1]}, fd = (f32x2){f[2], f[3]};
            const f32x2 wk = cmul(zk, fs) + cmul(cconj(zn), fd), wn = cmul(zn, cconj(fs)) + cmul(cconj(zk), cconj(fd));
            buf[PADI(pn)] = wn; buf[PADI(p)] = wk; }
        __syncthreads();
        fft_inv(buf, m, tid);
        const float* hb = A.in[I_HYBIAS] + ((size_t)l * 2 + o) * 512 + 2 * pair; const f32x2 bias = (f32x2){hb[0], hb[1]};
#pragma unroll
        for (int gi = 0; gi < 2; ++gi) { const int t0 = 8 * (tid + 512 * gi);
            if (t0 < n) {
#pragma unroll
                for (int e = 0; e < 8; ++e) { const f32x2 cv = buf[PADI(t0 + e)] * invN; const f32x2 gt = o == 0 ? g1[gi * 8 + e] : g2[gi * 8 + e];
                    yv[gi * 8 + e] = gt * (cv + yv[gi * 8 + e] * bias); } } }
    }
    f16* Y = (f16*)(F.ws + WS_YBT) + (size_t)(2 * pair) * MT + row0;
#pragma unroll
    for (int gi = 0; gi < 2; ++gi) { const int t0 = 8 * (tid + 512 * gi);
        if (t0 < n) { f16x8 oa, ob;
#pragma unroll
            for (int e = 0; e < 8; ++e) { oa[e] = (f16)yv[gi * 8 + e].x; ob[e] = (f16)yv[gi * 8 + e].y; }
            *(f16x8*)(Y + t0) = oa; *(f16x8*)(Y + MT + t0) = ob; } }
    __syncthreads();
}

__device__ __forceinline__ void ph_ybt_transpose(const Ctx& F) {
    LAS f16* T = (LAS f16*)F.lds;
    const f16* YBT = (const f16*)(F.ws + WS_YBT); f16* Y = (f16*)(F.ws + WS_YCAT);
    for (int rb = F.bid; rb < MT / 64; rb += F.G) { const int r0 = rb * 64;
        __syncthreads();
#pragma unroll
        for (int i = 0; i < 8; ++i) *(LAS f16x8*)(T + F.tid * 72 + 8 * i) = *(const f16x8*)(YBT + (size_t)F.tid * MT + r0 + 8 * i);
        __syncthreads();
        const int row = F.tid >> 3, cg = F.tid & 7;
#pragma unroll
        for (int jj = 0; jj < 8; ++jj) { const int gidx = cg + 8 * jj; f16x8 o;
#pragma unroll
            for (int e = 0; e < 8; ++e) o[e] = T[(8 * gidx + e) * 72 + row];
            *(f16x8*)(Y + (size_t)(r0 + row) * 2048 + 512 + 8 * gidx) = o; }
    }
    __syncthreads();
}
#undef PADI
}

#ifndef PHMASK
#define PHMASK 0xFFFF
#endif
#define PH_EN(k) (((PHMASK) >> (k)) & 1)
#ifndef STAMP_MASK
#define STAMP_MASK 0
#endif
#ifndef STAMP_K
#define STAMP_K 1
#endif
#ifndef SUBMASK
#define SUBMASK 7
#endif
#define SUB_EN(k) (((SUBMASK) >> (k)) & 1)
constexpr int NPH = 2 + 12 * DEPTH;
constexpr int CW_Q = 8192;
__device__ __forceinline__ int q_pull(unsigned* ctr, volatile LAS int* slot) {
    __syncthreads();
    if (threadIdx.x == 0) *slot = (int)__hip_atomic_fetch_add(ctr, 1u, __ATOMIC_RELAXED, __HIP_MEMORY_SCOPE_AGENT);
    __syncthreads();
    return *slot;
}

__global__ void __launch_bounds__(512, 2) mk_fwd(Args args) {
    extern __shared__ __attribute__((aligned(16))) unsigned char lds_raw[];
    Ctx F; F.lds = (LAS unsigned char*)lds_raw; F.tid = threadIdx.x; F.lane = F.tid & 63; F.wave = __builtin_amdgcn_readfirstlane(F.tid >> 6);
    F.G = gridDim.x; F.bid = blockIdx.x; F.ws = args.ws;
    const Ctx F0 = F;
#define FRESH() do { F.tid = opq(F0.tid); F.lane = F.tid & 63; F.wave = __builtin_amdgcn_readfirstlane(F.tid >> 6); } while (0)
    volatile LAS unsigned* MISC = (volatile LAS unsigned*)(F.lds + LDSCTL_OFF);
    if (F.tid < 64) MISC[F.tid] = 0u;
    __syncthreads();
    unsigned* barw = (unsigned*)(F.ws + WS_CTL) + CW_BAR;
    XcdBarrier bar; bar.bar = barw; bar.x = 0; bar.st = nullptr;
    const int lo = args.ph_lo, hi = args.ph_hi;
    if (hi - lo > 1) bar = xcd_barrier_post(barw, MISC + 8);
#define IN(k) (lo <= (k) && (k) < hi)
#define SEAM(k) do { if (IN(k) && IN((k) + 1)) xcd_barrier(bar); } while (0)
#if STAMP_MASK
    volatile LAS unsigned long long* TS = (volatile LAS unsigned long long*)(F.lds + LDSCTL_OFF + 128);
#define TSTART(k) do { if ((((STAMP_MASK) >> (k)) & 1) && blockIdx.x == 0 && threadIdx.x == 0) TS[0] = __builtin_amdgcn_s_memrealtime(); } while (0)
#define TSTOP(k) do { if ((((STAMP_MASK) >> (k)) & 1) && blockIdx.x == 0 && threadIdx.x == 0) TS[1] = TS[1] + (__builtin_amdgcn_s_memrealtime() - TS[0]); } while (0)
#else
#define TSTART(k) do {} while (0)
#define TSTOP(k) do {} while (0)
#endif
    unsigned char* ws = F.ws;
    const int rank160 = (F.bid + F.G - 160 % F.G) % F.G;

    TSTART(12);
    if (PH_EN(12) && IN(0)) { FRESH(); ph_prologue(F, args); }
    SEAM(0);
    TSTOP(12);

    for (int l = 0; l < DEPTH; ++l) {
        const int pb = 1 + 12 * l;
        const float* modl = (const float*)(ws + WS_MOD) + (size_t)l * 3 * 12288;
        TSTART(0);
        if (PH_EN(0) && IN(pb + 0)) {
            FRESH(); ph_convert_weights(F, args, l);
            __syncthreads();
            FRESH(); if (F.bid < 32) s5_mats_group(F, args, l, F.bid);
            FRESH(); ph_hyena_h2(F, args, l);
            FRESH(); ph_norm(F, args, l, 0);
        }
        SEAM(pb + 0);
        TSTOP(0);
        TSTART(1);
        if (PH_EN(1) && IN(pb + 1)) {
            pg8::SchedPlain S; S.init(MT / 256, PXLD / 256, F.G, F.bid); S.A = (const char*)(ws + WS_HN); S.B = (const char*)(ws + WS_WIN); S.aTile = (size_t)256 * 2048 * 2; S.bTile = (size_t)256 * 2048 * 2;
            pg8::EpiPx E{(f16*)(ws + WS_PX), (f16*)(ws + WS_S5A), (f16*)(ws + WS_ZT)};
            pg8::gemm_phase(F.lds, 2048, 2048, 32, S, E);
        }
        SEAM(pb + 1);
        TSTOP(1);
        TSTART(2);
        if (PH_EN(2) && IN(pb + 2)) {
            TSTART(16);
            if (SUB_EN(0)) { pg8::SchedS5 S{(const char*)(ws + WS_S5A), (const char*)(ws + WS_S5M), (size_t)256 * 256 * 2, F.G, F.bid};
              pg8::EpiS5In E{(float*)(ws + WS_S5S)};
              pg8::gemm_phase(F.lds, 16384, 256, 4, S, E); }
            TSTOP(16); TSTART(17);
            { unsigned* qc = (unsigned*)(ws + WS_CTL) + CW_Q + (l * 2 + 0) * 64; volatile LAS int* slot = (volatile LAS int*)(MISC + 16);
              for (;;) { const int u = q_pull(qc, slot); if (u >= 264 + 1024) break;
                  if (u < 264) { FRESH(); gla::gla_unit<false>(F, args, l, u); } else { FRESH(); hy::filt_unit(F, args, l, u - 264); } } }
            TSTOP(17);
        }
        SEAM(pb + 2);
        TSTOP(2);
        TSTART(3);
        if (PH_EN(3) && IN(pb + 3)) { FRESH(); ph_s5_scan(F); FRESH(); gla::ph_gla_scan(F); }
        SEAM(pb + 3);
        TSTOP(3);
        TSTART(4);
        if (PH_EN(4) && IN(pb + 4)) {
            TSTART(19);
            if (SUB_EN(0)) { pg8::SchedS5 S{(const char*)(ws + WS_S5A), (const char*)(ws + WS_S5W), (size_t)256 * 512 * 2, F.G, F.bid};
              pg8::EpiS5Out E{(const f16*)(ws + WS_S5A), (f16*)(ws + WS_YAPRE), args.in[I_S5D] + (size_t)l * 512};
              pg8::gemm_phase(F.lds, 16384, 512, 8, S, E); }
            TSTOP(19); TSTART(20);
            { unsigned* qc = (unsigned*)(ws + WS_CTL) + CW_Q + (l * 2 + 1) * 64; volatile LAS int* slot = (volatile LAS int*)(MISC + 16);
              for (;;) { const int u = q_pull(qc, slot); if (u >= 264 + 1024) break;
                  if (u < 264) { FRESH(); gla::gla_unit<true>(F, args, l, u); } else { FRESH(); hy::main_unit(F, args, l, u - 264); } } }
            TSTOP(20);
        }
        SEAM(pb + 4);
        TSTOP(4);
        TSTART(5);
        if (PH_EN(5) && IN(pb + 5)) {
            pg8::SchedPlain S; S.init(MT / 256, 2, F.G, F.bid); S.A = (const char*)(ws + WS_YAPRE); S.B = (const char*)(ws + WS_WGLU); S.aTile = (size_t)256 * 512 * 2; S.bTile = (size_t)256 * 512 * 2;
            pg8::EpiGlu E{(const f16*)(ws + WS_YAPRE), (f16*)(ws + WS_YCAT), args.in[I_GLUB] + (size_t)l * 512};
            pg8::gemm_phase(F.lds, 512, 512, 8, S, E);
            FRESH(); hy::ph_ybt_transpose(F);
        }
        SEAM(pb + 5);
        TSTOP(5);
        TSTART(6);
        if (PH_EN(6) && IN(pb + 6)) {
            pg8::SchedPlain S; S.init(MT / 256, 8, F.G, F.bid); S.aTile = (size_t)256 * 2048 * 2; S.bTile = (size_t)256 * 2048 * 2;
            S.A = (const char*)(ws + WS_YCAT); S.B = (const char*)(ws + WS_WBR);
            if (SUB_EN(0)) { pg8::EpiBranch<0> E{(const f16*)(ws + WS_PX), (f16*)(ws + WS_MBUF)}; pg8::gemm_phase(F.lds, 2048, 2048, 8, S, E); }
            S.A = (const char*)(ws + WS_YCAT) + 512 * 2; S.B = (const char*)(ws + WS_WBR) + 512 * 2;
            if (SUB_EN(1)) { pg8::EpiBranch<1> E{(const f16*)(ws + WS_PX), (f16*)(ws + WS_MBUF)}; pg8::gemm_phase(F.lds, 2048, 2048, 8, S, E); }
            S.A = (const char*)(ws + WS_YCAT) + 1024 * 2; S.B = (const char*)(ws + WS_WBR) + 1024 * 2;
            if (SUB_EN(2)) { pg8::EpiBranch<2> E{(const f16*)(ws + WS_PX), (f16*)(ws + WS_MBUF)}; pg8::gemm_phase(F.lds, 2048, 2048, 16, S, E); }
        }
        SEAM(pb + 6);
        TSTOP(6);
        TSTART(7);
        if (PH_EN(7) && IN(pb + 7)) {
            pg8::SchedPlain S; S.init(MT / 256, 8, F.G, F.bid); S.A = (const char*)(ws + WS_MBUF); S.B = (const char*)(ws + WS_WOUT); S.aTile = (size_t)256 * 2048 * 2; S.bTile = (size_t)256 * 2048 * 2;
            pg8::EpiResid E{(float*)(ws + WS_XRES), modl, 4096};
            pg8::gemm_phase(F.lds, 2048, 2048, 32, S, E);
        }
        SEAM(pb + 7);
        TSTOP(7);
        TSTART(8);
        if (PH_EN(8) && IN(pb + 8)) { FRESH(); ph_norm(F, args, l, 1); }
        SEAM(pb + 8);
        TSTOP(8);
        TSTART(9);
        if (PH_EN(9) && IN(pb + 9)) {
            pg8::SchedPlain S; S.init(MT / 256, UPLD / 256, F.G, F.bid); S.A = (const char*)(ws + WS_HN); S.B = (const char*)(ws + WS_WUP); S.aTile = (size_t)256 * 2048 * 2; S.bTile = (size_t)256 * 2048 * 2;
            pg8::EpiF16 E{(f16*)(ws + WS_PX), UPLD};
            pg8::gemm_phase(F.lds, 2048, 2048, 32, S, E);
        }
        SEAM(pb + 9);
        TSTOP(9);
        TSTART(10);
        if (PH_EN(10) && IN(pb + 10)) { FRESH(); ph_ffn_act(F, args, l); }
        SEAM(pb + 10);
        TSTOP(10);
        TSTART(11);
        if (PH_EN(11) && IN(pb + 11)) {
            pg8::SchedPlain S; S.init(MT / 256, 8, F.G, F.bid); S.A = (const char*)(ws + WS_ACT); S.B = (const char*)(ws + WS_WDN); S.aTile = (size_t)256 * FFH * 2; S.bTile = (size_t)256 * FFH * 2;
            pg8::EpiResid E{(float*)(ws + WS_XRES), modl, 10240};
            pg8::gemm_phase(F.lds, FFH, FFH, FFH / 64, S, E);
        }
        SEAM(pb + 11);
        TSTOP(11);
    }
    if (PH_EN(13) && IN(NPH - 1)) { FRESH(); ph_final_norm(F, args); }
#if STAMP_MASK
    if (blockIdx.x == 0 && threadIdx.x == 0) { const unsigned long long t0 = __builtin_amdgcn_s_memrealtime(); while (__builtin_amdgcn_s_memrealtime() - t0 < (unsigned long long)(STAMP_K) * TS[1]) __builtin_amdgcn_s_sleep(8); }
#endif
#undef IN
#undef SEAM
#undef FRESH
}

extern "C" void kernel_launch(void* const* d_in, const int* in_sizes, int n_in, void* d_out, int out_size, void* d_ws, size_t ws_size, hipStream_t stream) {
    static int grid = 0;
    if (grid == 0) {
        if (n_in != 40 || out_size != MX * D || ws_size < WS_END) { fprintf(stderr, "kernel_launch: unexpected problem (n_in %d out %d ws %zu, need %zu)\n", n_in, out_size, ws_size, (size_t)WS_END); grid = -1; return; }
        int dev = 0, cus = 0, per_cu = 0;
        if (hipGetDevice(&dev) != hipSuccess || hipDeviceGetAttribute(&cus, hipDeviceAttributeMultiprocessorCount, dev) != hipSuccess) { grid = -1; return; }
        if (hipFuncSetAttribute((const void*)mk_fwd, hipFuncAttributeMaxDynamicSharedMemorySize, LDS_BYTES) != hipSuccess) { fprintf(stderr, "kernel_launch: hipFuncSetAttribute failed\n"); grid = -1; return; }
        if (hipOccupancyMaxActiveBlocksPerMultiprocessor(&per_cu, (const void*)mk_fwd, 512, LDS_BYTES) != hipSuccess || per_cu < 1)
            fprintf(stderr, "kernel_launch: occupancy query reports %d\n", per_cu);
        (void)hipGetLastError();
        grid = cus;
    }
    if (grid < 0) return;
    if (hipMemsetAsync((char*)d_ws + WS_CTL, 0, CTL_ZERO_BYTES, stream) != hipSuccess) return;
    Args a{};
    for (int i = 0; i < 40; ++i) a.in[i] = (const float*)d_in[i];
    a.out = (float*)d_out; a.ws = (unsigned char*)d_ws;
#if MK_ONE
    a.ph_lo = 0; a.ph_hi = NPH;
    hipLaunchKernelGGL(mk_fwd, dim3(grid), dim3(512), LDS_BYTES, stream, a);
#else
    for (int p = 0; p < NPH; ++p) { a.ph_lo = p; a.ph_hi = p + 1; hipLaunchKernelGGL(mk_fwd, dim3(grid), dim3(512), LDS_BYTES, stream, a); }
#endif
}
```

```cpp
#include <hip/hip_runtime.h>
#include <stdio.h>

#ifndef MK_ONE
#define MK_ONE 1
#define STAMP_MASK 0
#define STAMP_K 1
#endif

#define GAS __attribute__((address_space(1)))
#define LAS __attribute__((address_space(3)))
typedef _Float16 f16;
typedef _Float16 f16x8 __attribute__((ext_vector_type(8)));
typedef _Float16 f16x4 __attribute__((ext_vector_type(4)));
typedef _Float16 f16x2 __attribute__((ext_vector_type(2)));
typedef float f32x4 __attribute__((ext_vector_type(4)));
typedef float f32x2 __attribute__((ext_vector_type(2)));

constexpr int D = 2048, NB = 2, SEQ = 8192, LC = 256, DEPTH = 4;
constexpr int MX = NB * SEQ, MC = NB * LC, MT = MX + MC;
constexpr int PXLD = 11520, FFH = 5632, UPLD = 2 * FFH;
constexpr int P_S5 = 0, P_GK = 512, P_GV = 1024, P_GQ = 2048, P_GR = 2560, P_HY = 3584, P_MG = 5120, P_GG = 11264;
constexpr int INW = 11296;
constexpr int NCHK = 1056;
constexpr float S5SCALE = 1024.f;
constexpr float EPS = 1e-6f;
constexpr int NSC = 33;

constexpr size_t MiB = 1u << 20;
constexpr size_t WS_CTL = 0, CTL_ZERO_BYTES = 1 * MiB;
constexpr size_t WS_MOD = 1 * MiB;
constexpr size_t WS_TW = 2 * MiB;
constexpr size_t WS_S5AT = 3 * MiB;
constexpr size_t WS_WIN = 4 * MiB;
constexpr size_t WS_WGLU = WS_WIN + 45 * MiB;
constexpr size_t WS_WBR = WS_WGLU + 1 * MiB;
constexpr size_t WS_WOUT = WS_WBR + 8 * MiB;
constexpr size_t WS_WUP = WS_WOUT + 8 * MiB;
constexpr size_t WS_WDN = WS_WUP + 44 * MiB;
constexpr size_t WS_S5W = WS_WDN + 22 * MiB;
constexpr size_t WS_S5M = WS_S5W + 8 * MiB;
constexpr size_t WS_H2 = WS_S5M + 4 * MiB;
constexpr size_t WS_FSD = WS_H2 + 3 * MiB;
constexpr size_t FSD_C_OFF = (size_t)2 * 256 * 8193 * 16;
constexpr size_t WS_XRES = WS_FSD + 68 * MiB;
constexpr size_t WS_HN = WS_XRES + 132 * MiB;
constexpr size_t WS_PX = WS_HN + 66 * MiB;
constexpr size_t WS_S5A = WS_PX + 372 * MiB;
constexpr size_t WS_S5S = WS_S5A + 40 * MiB;
constexpr size_t WS_YAPRE = WS_S5S + 40 * MiB;
constexpr size_t WS_YCAT = WS_YAPRE + 20 * MiB;
constexpr size_t WS_MBUF = WS_YCAT + 66 * MiB;
constexpr size_t WS_GSLOC = WS_MBUF + 66 * MiB;
constexpr size_t WS_GSIN = WS_GSLOC + 66 * MiB;
constexpr size_t WS_GOF = WS_GSIN + 66 * MiB;
constexpr size_t WS_GDT = WS_GOF + 66 * MiB;
constexpr size_t WS_ACT = WS_GSLOC;
constexpr size_t WS_ZT = WS_GDT + 1 * MiB;
constexpr size_t WS_YBT = WS_ZT + 50 * MiB;
constexpr size_t WS_SLAB = WS_YBT + 17 * MiB;
constexpr size_t WS_END = WS_SLAB + 44 * MiB;
static_assert((size_t)MT * FFH * 2 <= 198 * MiB, "ACT overlay");
constexpr int CW_BAR = 4096;

constexpr int RING_BYTES = 131072;
constexpr int EXTRA_OFF = RING_BYTES, EXTRA_BYTES = 8192;
constexpr int LDSCTL_OFF = EXTRA_OFF + EXTRA_BYTES;
constexpr int LDS_BYTES = LDSCTL_OFF + 256;

__device__ __forceinline__ float wave_sum(float v) {
#pragma unroll
    for (int o = 1; o < 64; o <<= 1) v += __shfl_xor(v, o);
    return v;
}
__device__ __forceinline__ float sigmoidf_(float x) { return 1.0f / (1.0f + __expf(-x)); }
__device__ __forceinline__ float siluf_(float x) { return x * sigmoidf_(x); }
__device__ __forceinline__ float gelu_tanh_(float x) { const float u = 0.7978845608028654f * (x + 0.044715f * x * x * x); return x / (1.0f + __expf(-2.0f * u)); }
__device__ __forceinline__ float logsigmoidf_(float x) { return fminf(x, 0.f) - __logf(1.0f + __expf(-fabsf(x))); }
__device__ __forceinline__ f32x2 cmul(f32x2 a, f32x2 b) { return (f32x2){a.x * b.x - a.y * b.y, a.x * b.y + a.y * b.x}; }
__device__ __forceinline__ f32x2 cconj(f32x2 a) { return (f32x2){a.x, -a.y}; }
__device__ __forceinline__ int opq(int x) { asm volatile("" : "+v"(x)); return x; }
#define LDS_WAIT() asm volatile("s_waitcnt lgkmcnt(0)" ::: "memory")
#define VM_WAIT() asm volatile("s_waitcnt vmcnt(0)" ::: "memory")

#define XB_TMO      128
#define XB_XCNT(j)  (256  + 64 * (j))
#define XB_XSUB(j)  (1280 + 64 * (j))
#define XB_XGEN(j)  (2304 + 64 * (j))
#define XB_TOP      3328
#define XB_TOPGEN   3392
#define XCD_BAR_WORDS 3456
#define XB_SPIN_CAP (1u << 18)
__device__ __forceinline__ unsigned xb_ld(unsigned* p)              { return __hip_atomic_load(p, __ATOMIC_RELAXED, __HIP_MEMORY_SCOPE_AGENT); }
__device__ __forceinline__ unsigned xb_add(unsigned* p, unsigned v) { return __hip_atomic_fetch_add(p, v, __ATOMIC_RELAXED, __HIP_MEMORY_SCOPE_AGENT); }
__device__ __forceinline__ unsigned xb_xcc_id() { return (unsigned)__builtin_amdgcn_s_getreg((3 << 11) | 20) & 0xFu; }
#define XB_SPIN(cond, bar) do { unsigned _sp = 0; while (cond) { __builtin_amdgcn_s_sleep(1); \
    if ((++_sp & 255u) == 0u) { if (xb_ld(&(bar)[XB_TMO])) break; if (_sp > XB_SPIN_CAP) { atomicAdd(&(bar)[XB_TMO], 1u); break; } } } } while (0)
struct XcdBarrier { unsigned* bar; unsigned x; volatile LAS unsigned* st; };
__device__ __forceinline__ XcdBarrier xcd_barrier_post(unsigned* bar, volatile LAS unsigned* st) {
    XcdBarrier b; b.bar = bar; b.x = xb_xcc_id(); b.st = st;
    if (threadIdx.x == 0) (void)xb_add(&bar[XB_XCNT(b.x)], 1u);
    return b;
}
__device__ __forceinline__ void xcd_barrier_complete(unsigned* bar, unsigned x, unsigned& nloc, unsigned& nx) {
    const unsigned G = gridDim.x * gridDim.y * gridDim.z;
    unsigned sum, cnt, mine, sp = 0u;
    for (;;) {
        sum = 0u; cnt = 0u; mine = 0u;
#pragma unroll
        for (unsigned j = 0; j < 16; ++j) { const unsigned c = xb_ld(&bar[XB_XCNT(j)]); sum += c; cnt += (c > 0u) ? 1u : 0u; mine = (j == x) ? c : mine; }
        if (sum == G) break;
        __builtin_amdgcn_s_sleep(1);
        if ((++sp & 255u) == 0u) { if (xb_ld(&bar[XB_TMO])) break; if (sp > XB_SPIN_CAP) { atomicAdd(&bar[XB_TMO], 1u); break; } }
    }
    nloc = mine > 0u ? mine : 1u; nx = cnt > 0u ? cnt : 1u;
}
__device__ __forceinline__ void xcd_barrier(const XcdBarrier& b) {
    asm volatile("s_waitcnt vmcnt(0)" ::: "memory");
    __syncthreads();
    if (threadIdx.x == 0) {
        unsigned* bar = b.bar;
        __builtin_amdgcn_s_waitcnt(0);
        unsigned nloc = b.st[0], nx = b.st[1];
        if (nloc == 0u) { xcd_barrier_complete(bar, b.x, nloc, nx); b.st[0] = nloc; b.st[1] = nx; }
        const unsigned old = xb_add(&bar[XB_XSUB(b.x)], 1u);
        const unsigned gen = old / nloc;
        if (old + 1u == (gen + 1u) * nloc) {
            __builtin_amdgcn_fence(__ATOMIC_RELEASE, "agent");
            asm volatile("s_waitcnt vmcnt(0)" ::: "memory");
            const unsigned og = xb_add(&bar[XB_TOP], 1u);
            const unsigned tg = og / nx;
            if (og + 1u == (tg + 1u) * nx) xb_add(&bar[XB_TOPGEN], 1u);
            else XB_SPIN(xb_ld(&bar[XB_TOPGEN]) == tg, bar);
            __builtin_amdgcn_fence(__ATOMIC_ACQUIRE, "agent");
            xb_add(&bar[XB_XGEN(b.x)], 1u);
            asm volatile("s_waitcnt vmcnt(0)" ::: "memory");
        } else {
            XB_SPIN(xb_ld(&bar[XB_XGEN(b.x)]) == gen, bar);
            __builtin_amdgcn_fence(__ATOMIC_ACQUIRE, "agent");
            asm volatile("s_waitcnt vmcnt(0)" ::: "memory");
        }
    }
    __syncthreads();
}

struct Args {
    const float* in[40];
    float* out; unsigned char* ws;
    int ph_lo, ph_hi;
};
struct Ctx {
    LAS unsigned char* lds;
    int tid, lane, wave, G, bid;
    unsigned char* ws;
};
enum { I_X = 0, I_C, I_CTX, I_CCTX, I_WMOD, I_BMOD, I_N1G, I_N2G, I_WIN, I_S5ARE, I_S5AIM, I_S5STEP, I_S5BRE, I_S5BIM, I_S5CRE, I_S5CIM,
       I_S5D, I_GLUW, I_GLUB, I_HYCW, I_HYCB, I_HYW1, I_HYB1, I_HYF1, I_HYW2, I_HYB2, I_HYF2, I_HYW3, I_HYB3, I_HYBIAS,
       I_GLAWG, I_GLABG, I_GLANG, I_WBR, I_WOUT, I_WUP, I_FFCW, I_FFCB, I_WDN, I_FNG };

namespace pg8 {
constexpr int BM = 256, BK = 64, HALF = 128, HTB = HALF * BK * 2, STAGE_BYTES = 8 * HTB, NXCD = 8, WGM = 8;
__device__ __forceinline__ int lds_byte(int r, int c) { const int st = (r >> 4) * 2 + (c >> 5), rr = r & 15, cc = c & 31, ob = rr * 64 + cc * 2; return st * 1024 + (ob ^ (((ob >> 9) & 1) << 5)); }
__device__ __forceinline__ void stage_rc(int b, int& R, int& C) { const int st = b / 1024, sb = b % 1024, swz = sb ^ (((sb >> 9) & 1) << 5); R = (st >> 1) * 16 + swz / 64; C = (st & 1) * 32 + (swz % 64) / 2; }
__device__ __forceinline__ int perm32(int rho) { const int n = rho >> 4, i = rho & 15; return 8 * (i >> 2) + 4 * n + (i & 3); }
struct Unit { const char* a; const char* b; int pm, pn; };
struct Order2D {
    int nM, nN, nwg, G, c;
    __device__ __forceinline__ void init(int nM_, int nN_, int G_, int c_) { nM = nM_; nN = nN_; nwg = nM * nN; G = G_; c = c_; }
    __device__ __forceinline__ bool nx(int i, int& pm, int& pn) const {
        const long L = (long)i * G + c; if (L >= nwg) return false;
        int wgid = (int)L; { const int q = nwg / NXCD, r = nwg % NXCD, xcd = wgid % NXCD, off = wgid / NXCD; wgid = (xcd < r ? xcd * (q + 1) : r * (q + 1) + (xcd - r) * q) + off; }
        const int nig = WGM * nN, gid = wgid / nig, fm = gid * WGM, gsz = (nM - fm) < WGM ? (nM - fm) : WGM;
        pm = fm + ((wgid % nig) % gsz); pn = (wgid % nig) / gsz; return true;
    }
};
struct SchedPlain : Order2D {
    const char* A; const char* B; size_t aTile, bTile;
    __device__ __forceinline__ bool next(int i, Unit& u) const { int pm, pn; if (!nx(i, pm, pn)) return false; u.pm = pm; u.pn = pn; u.a = A + (size_t)pm * aTile; u.b = B + (size_t)pn * bTile; return true; }
};
struct SchedSplit {
    const char* A; const char* B; size_t aTile, bTile, ksub; int nsplit, G, c;
    __device__ __forceinline__ bool next(int i, Unit& u) const { const int L = i * G + c; if (L >= 16 * nsplit) return false; const int t = L / nsplit, ks = L % nsplit, pm = 64 + (t >> 3), pn = t & 7;
        u.pm = pm; u.pn = pn | (ks << 8); u.a = A + (size_t)pm * aTile + (size_t)ks * ksub; u.b = B + (size_t)pn * bTile + (size_t)ks * ksub; return true; }
};
struct SchedS5 {
    const char* A; const char* B; size_t bGroup; int G, c;
    __device__ __forceinline__ bool next(int i, Unit& u) const { const int L = i * G + c; if (L >= 160) return false; const int g = L & 31, pm = L >> 5;
        u.pm = pm; u.pn = g; u.a = A + ((size_t)pm * 256 * 16384 + (size_t)g * 512) * 2; u.b = B + (size_t)g * bGroup; return true; }
};

#define PG8_SA(b, h) (((b) * 2 + (h)) * HTB)
#define PG8_SB(b, h) ((4 + (b) * 2 + (h)) * HTB)
#define PG8_STAGE(bufoff, gbase, voff) do { _Pragma("unroll") for (int _i = 0; _i < 2; ++_i) \
        __builtin_amdgcn_global_load_lds((const unsigned*)((const char*)(gbase) + (voff)[_i]), (LAS unsigned*)(lds + (bufoff) + ldsw + _i * 8192), 16, 0, 0); } while (0)
#define PG8_LDA(dst, b, h) do { _Pragma("unroll") for (int m = 0; m < 4; ++m) _Pragma("unroll") for (int k = 0; k < 2; ++k) dst[m][k] = *(const LAS f16x8*)(lds + PG8_SA(b, h) + aoff + m * 2048 + k * 1024); } while (0)
#define PG8_LDB(dst, b, h) do { _Pragma("unroll") for (int n = 0; n < 2; ++n) _Pragma("unroll") for (int k = 0; k < 2; ++k) dst[n][k] = *(const LAS f16x8*)(lds + PG8_SB(b, h) + boff + n * 2048 + k * 1024); } while (0)
#define PG8_MMA(ai, bj, At, Bt) do { __builtin_amdgcn_s_setprio(1); _Pragma("unroll") for (int m = 0; m < 4; ++m) _Pragma("unroll") for (int n = 0; n < 2; ++n) _Pragma("unroll") for (int k = 0; k < 2; ++k) \
        acc[ai][bj][m][n] = __builtin_amdgcn_mfma_f32_16x16x32_f16(Bt[n][k], At[m][k], acc[ai][bj][m][n], 0, 0, 0); __builtin_amdgcn_s_setprio(0); } while (0)
#define PG8_WAIT_V(n) asm volatile("s_waitcnt vmcnt(" #n ")" ::: "memory")
#define PG8_WAIT_L(n) asm volatile("s_waitcnt lgkmcnt(" #n ")" ::: "memory")
#define PG8_BAR __builtin_amdgcn_s_barrier()
#define PG8_SCHED __builtin_amdgcn_sched_barrier(0)

template <class Epi, class Sched>
__device__ __forceinline__ void gemm_phase(LAS unsigned char* lds, const int lda, const int ldb, const int nt, const Sched& S, const Epi& E) {
    const int tid = opq((int)threadIdx.x), wid = __builtin_amdgcn_readfirstlane(tid >> 6), lane = tid & 63, wr = wid >> 2, wc = wid & 3, fr = lane & 15, fq = lane >> 4;
    unsigned voffA[2], voffB[2];
#pragma unroll
    for (int i = 0; i < 2; ++i) { int R, C; stage_rc(tid * 16 + i * 8192, R, C); const int Rb = Epi::PERM ? ((R & ~31) + perm32(R & 31)) : R;
        voffA[i] = (unsigned)(R * lda + C) * 2u; voffB[i] = (unsigned)(Rb * ldb + C) * 2u; }
    const size_t kstep = (size_t)(BK * 2);
    const size_t hstepA = (size_t)HALF * lda * 2, hstepB = (size_t)HALF * ldb * 2;
    const unsigned ldsw = (unsigned)wid * 1024u;
    const int aoff = lds_byte(wr * 64 + fr, fq * 8), boff = lds_byte(wc * 32 + fr, fq * 8);
    Unit cur, nxt; int ui = 0;
    if (!S.next(0, cur)) return;
    f32x4 acc[2][2][4][2];
#pragma unroll
    for (int a = 0; a < 2; ++a)
#pragma unroll
        for (int b = 0; b < 2; ++b)
#pragma unroll
            for (int m = 0; m < 4; ++m)
#pragma unroll
                for (int n = 0; n < 2; ++n) acc[a][b][m][n] = (f32x4){0.f, 0.f, 0.f, 0.f};
    f16x8 At[4][2], B0[2][2], B1[2][2];
    const char* cA = cur.a; const char* cB = cur.b;
    PG8_STAGE(PG8_SB(0, 0), cB, voffB); PG8_STAGE(PG8_SA(0, 0), cA, voffA); PG8_STAGE(PG8_SB(0, 1), cB + hstepB, voffB); PG8_STAGE(PG8_SA(0, 1), cA + hstepA, voffA);
    if (wr == 1) PG8_BAR;
    PG8_WAIT_V(4); PG8_BAR;
    PG8_STAGE(PG8_SB(1, 0), cB + kstep, voffB); PG8_STAGE(PG8_SA(1, 0), cA + kstep, voffA); PG8_STAGE(PG8_SB(1, 1), cB + hstepB + kstep, voffB);
    PG8_WAIT_V(6); PG8_BAR;
    for (;;) {
        const bool has_next = S.next(ui + 1, nxt);
        const char* nA = has_next ? nxt.a : cA; const char* nB = has_next ? nxt.b : cB;
        for (int t = 0; t < nt; t += 2) {
            const bool last = (t == nt - 2);
            const char* a1 = cA + (size_t)(t + 1) * kstep;
            const char* a2 = last ? nA : cA + (size_t)(t + 2) * kstep; const char* b2 = last ? nB : cB + (size_t)(t + 2) * kstep;
            const char* a3 = a2 + kstep; const char* b3 = b2 + kstep;
            PG8_LDB(B0, 0, 0); PG8_SCHED; PG8_LDA(At, 0, 0); PG8_STAGE(PG8_SA(1, 1), a1 + hstepA, voffA);
            PG8_WAIT_L(8); PG8_BAR; PG8_WAIT_L(0); PG8_MMA(0, 0, At, B0); PG8_BAR; PG8_SCHED;
            PG8_LDB(B1, 0, 1); PG8_STAGE(PG8_SB(0, 0), b2, voffB);
            PG8_BAR; PG8_WAIT_L(0); PG8_MMA(0, 1, At, B1); PG8_BAR;
            PG8_LDA(At, 0, 1); PG8_STAGE(PG8_SA(0, 0), a2, voffA);
            PG8_BAR; PG8_WAIT_L(0); PG8_MMA(1, 0, At, B0); PG8_BAR; PG8_SCHED;
            PG8_STAGE(PG8_SB(0, 1), b2 + hstepB, voffB);
            PG8_WAIT_V(6); PG8_BAR; PG8_MMA(1, 1, At, B1); PG8_BAR;
            PG8_LDB(B0, 1, 0); PG8_SCHED; PG8_LDA(At, 1, 0); PG8_STAGE(PG8_SA(0, 1), a2 + hstepA, voffA);
            PG8_WAIT_L(8); PG8_BAR; PG8_WAIT_L(0); PG8_MMA(0, 0, At, B0); PG8_BAR; PG8_SCHED;
            PG8_LDB(B1, 1, 1); PG8_STAGE(PG8_SB(1, 0), b3, voffB);
            PG8_BAR; PG8_WAIT_L(0); PG8_MMA(0, 1, At, B1); PG8_BAR;
            PG8_LDA(At, 1, 1); PG8_STAGE(PG8_SA(1, 0), a3, voffA);
            PG8_BAR; PG8_WAIT_L(0); PG8_MMA(1, 0, At, B0); PG8_BAR; PG8_SCHED;
            PG8_STAGE(PG8_SB(1, 1), b3 + hstepB, voffB);
            PG8_WAIT_V(6); PG8_BAR; PG8_MMA(1, 1, At, B1); PG8_BAR;
        }
        E(acc, cur, wr, wc, fr, fq);
        if (!has_next) break;
#pragma unroll
        for (int a = 0; a < 2; ++a)
#pragma unroll
            for (int b = 0; b < 2; ++b)
#pragma unroll
                for (int m = 0; m < 4; ++m)
#pragma unroll
                    for (int n = 0; n < 2; ++n) acc[a][b][m][n] = (f32x4){0.f, 0.f, 0.f, 0.f};
        cur = nxt; cA = nA; cB = nB; ++ui;
    }
    PG8_WAIT_V(0);
    if (wr == 0) PG8_BAR;
    PG8_BAR;
}
#undef PG8_SA
#undef PG8_SB
#undef PG8_STAGE
#undef PG8_LDA
#undef PG8_LDB
#undef PG8_MMA
#undef PG8_WAIT_V
#undef PG8_WAIT_L
#undef PG8_BAR
#undef PG8_SCHED

typedef const f32x4 (&AccRef)[2][2][4][2];
__device__ __forceinline__ f16x8 pack8(f32x4 a, f32x4 b) { f16x8 w; w[0] = (f16)a[0]; w[1] = (f16)a[1]; w[2] = (f16)a[2]; w[3] = (f16)a[3]; w[4] = (f16)b[0]; w[5] = (f16)b[1]; w[6] = (f16)b[2]; w[7] = (f16)b[3]; return w; }

struct EpiPx {
    static constexpr bool PERM = true; f16* PX; f16* S5A; f16* ZT;
    __device__ __forceinline__ void operator()(AccRef acc, const Unit& u, int wr, int wc, int fr, int fq) const { fr = opq(fr); fq = opq(fq);
        const int row0 = u.pm * BM + wr * 64 + fr, col0 = u.pn * BM + wc * 32 + 8 * fq;
#pragma unroll
        for (int ai = 0; ai < 2; ++ai)
#pragma unroll
            for (int m = 0; m < 4; ++m) { const int row = row0 + ai * HALF + m * 16;
#pragma unroll
                for (int bj = 0; bj < 2; ++bj) { const int c = col0 + bj * HALF; const f16x8 w = pack8(acc[ai][bj][m][0], acc[ai][bj][m][1]);
                    if (u.pn < 2) *(f16x8*)(S5A + (size_t)(row >> 4) * 16384 + (size_t)(c >> 4) * 512 + (row & 15) * 16 + (c & 15)) = w;
                    else if (u.pn >= 14 && u.pn < 20) {
#pragma unroll
                        for (int j = 0; j < 8; ++j) ZT[(size_t)(c - P_HY + j) * MT + row] = w[j]; }
                    else *(f16x8*)(PX + (size_t)row * PXLD + c) = w; } }
    }
};
struct EpiF16 {
    static constexpr bool PERM = true; f16* O; int ldc;
    __device__ __forceinline__ void operator()(AccRef acc, const Unit& u, int wr, int wc, int fr, int fq) const { fr = opq(fr); fq = opq(fq);
        const int row0 = u.pm * BM + wr * 64 + fr, col0 = u.pn * BM + wc * 32 + 8 * fq;
#pragma unroll
        for (int ai = 0; ai < 2; ++ai)
#pragma unroll
            for (int m = 0; m < 4; ++m) { f16* rowp = O + (size_t)(row0 + ai * HALF + m * 16) * ldc + col0;
#pragma unroll
                for (int bj = 0; bj < 2; ++bj) *(f16x8*)(rowp + bj * HALF) = pack8(acc[ai][bj][m][0], acc[ai][bj][m][1]); }
    }
};
struct EpiS5In {
    static constexpr bool PERM = false; float* S;
    __device__ __forceinline__ void operator()(AccRef acc, const Unit& u, int wr, int wc, int fr, int fq) const { fr = opq(fr); fq = opq(fq);
        const int row0 = u.pm * BM + wr * 64 + fr, col0 = wc * 32 + 4 * fq, g = u.pn;
#pragma unroll
        for (int ai = 0; ai < 2; ++ai)
#pragma unroll
            for (int m = 0; m < 4; ++m) { const int row = row0 + ai * HALF + m * 16; { float* rowp = S + ((size_t)row * 32 + g) * 256 + col0;
#pragma unroll
                for (int bj = 0; bj < 2; ++bj)
#pragma unroll
                    for (int n = 0; n < 2; ++n) *(f32x4*)(rowp + bj * HALF + n * 16) = acc[ai][bj][m][n]; } }
    }
};
struct EpiS5Out {
    static constexpr bool PERM = true; const f16* S5A; f16* Y; const float* dvec;
    __device__ __forceinline__ void operator()(AccRef acc, const Unit& u, int wr, int wc, int fr, int fq) const { fr = opq(fr); fq = opq(fq);
        const int row0 = u.pm * BM + wr * 64 + fr, col0 = wc * 32 + 8 * fq, g = u.pn;
#pragma unroll
        for (int ai = 0; ai < 2; ++ai)
#pragma unroll
            for (int m = 0; m < 4; ++m) { const int chunk = row0 + ai * HALF + m * 16; {
#pragma unroll
                for (int bj = 0; bj < 2; ++bj) { const int c = col0 + bj * HALF, t = c >> 4, h0 = c & 15;
                    const f16x8 uu = *(const f16x8*)(S5A + (size_t)chunk * 16384 + (size_t)g * 512 + c);
                    const f32x4 d0 = *(const f32x4*)(dvec + g * 16 + h0), d1 = *(const f32x4*)(dvec + g * 16 + h0 + 4);
                    f16x8 w;
#pragma unroll
                    for (int j = 0; j < 4; ++j) { w[j] = (f16)gelu_tanh_(acc[ai][bj][m][0][j] * (1.0f / S5SCALE) + d0[j] * (float)uu[j]);
                                                  w[4 + j] = (f16)gelu_tanh_(acc[ai][bj][m][1][j] * (1.0f / S5SCALE) + d1[j] * (float)uu[4 + j]); }
                    *(f16x8*)(Y + (size_t)(chunk * 16 + t) * 512 + g * 16 + h0) = w; } asm volatile("" ::: "memory"); } }
    }
};
struct EpiGlu {
    static constexpr bool PERM = true; const f16* YP; f16* O; const float* bias;
    __device__ __forceinline__ void operator()(AccRef acc, const Unit& u, int wr, int wc, int fr, int fq) const { fr = opq(fr); fq = opq(fq);
        const int row0 = u.pm * BM + wr * 64 + fr, col0 = u.pn * BM + wc * 32 + 8 * fq;
#pragma unroll
        for (int ai = 0; ai < 2; ++ai)
#pragma unroll
            for (int m = 0; m < 4; ++m) { const int row = row0 + ai * HALF + m * 16;
#pragma unroll
                for (int bj = 0; bj < 2; ++bj) { const int c = col0 + bj * HALF;
                    const f16x8 yp = *(const f16x8*)(YP + (size_t)row * 512 + c);
                    const f32x4 b0 = *(const f32x4*)(bias + c), b1 = *(const f32x4*)(bias + c + 4);
                    f16x8 w;
#pragma unroll
                    for (int j = 0; j < 4; ++j) { w[j] = (f16)((float)yp[j] * sigmoidf_(acc[ai][bj][m][0][j] + b0[j])); w[4 + j] = (f16)((float)yp[4 + j] * sigmoidf_(acc[ai][bj][m][1][j] + b1[j])); }
                    *(f16x8*)(O + (size_t)row * 2048 + c) = w; } asm volatile("" ::: "memory"); }
    }
};
template <int BR> struct EpiBranch {
    static constexpr bool PERM = true; const f16* PX; f16* M;
    __device__ __forceinline__ void operator()(AccRef acc, const Unit& u, int wr, int wc, int fr, int fq) const { fr = opq(fr); fq = opq(fq);
        const int row0 = u.pm * BM + wr * 64 + fr, col0 = u.pn * BM + wc * 32 + 8 * fq;
#pragma unroll
        for (int ai = 0; ai < 2; ++ai)
#pragma unroll
            for (int m = 0; m < 4; ++m) { const int row = row0 + ai * HALF + m * 16;
#pragma unroll
                for (int bj = 0; bj < 2; ++bj) { const int c = col0 + bj * HALF;
                    const f16x8 gl = *(const f16x8*)(PX + (size_t)row * PXLD + P_MG + BR * 2048 + c);
                    f16* mp = M + (size_t)row * 2048 + c;
                    f16x8 prev; if (BR > 0) prev = *(const f16x8*)mp;
                    f16x8 w;
#pragma unroll
                    for (int j = 0; j < 4; ++j) { float v0 = sigmoidf_((float)gl[j]) * acc[ai][bj][m][0][j], v1 = sigmoidf_((float)gl[4 + j]) * acc[ai][bj][m][1][j];
                        if (BR > 0) { v0 += (float)prev[j]; v1 += (float)prev[4 + j]; } w[j] = (f16)v0; w[4 + j] = (f16)v1; }
                    *(f16x8*)mp = w; } asm volatile("" ::: "memory"); }
    }
};
struct EpiSlab {
    static constexpr bool PERM = false; float* slab; const float* mod; int goff;
    __device__ __forceinline__ void operator()(AccRef acc, const Unit& u, int wr, int wc, int fr, int fq) const { fr = opq(fr); fq = opq(fq);
        const int pn = u.pn & 255, ks = u.pn >> 8;
        const int row0 = (u.pm - 64) * BM + wr * 64 + fr, col0 = pn * BM + wc * 32 + 4 * fq;
        const float* gp = mod + 2 * 12288 + goff + col0;
        f32x4 gv[2][2];
#pragma unroll
        for (int bj = 0; bj < 2; ++bj)
#pragma unroll
            for (int n = 0; n < 2; ++n) gv[bj][n] = *(const f32x4*)(gp + bj * HALF + n * 16);
        float* sp = slab + (size_t)ks * MC * D;
#pragma unroll
        for (int ai = 0; ai < 2; ++ai)
#pragma unroll
            for (int m = 0; m < 4; ++m) { float* rowp = sp + (size_t)(row0 + ai * HALF + m * 16) * D + col0;
#pragma unroll
                for (int bj = 0; bj < 2; ++bj)
#pragma unroll
                    for (int n = 0; n < 2; ++n) *(f32x4*)(rowp + bj * HALF + n * 16) = gv[bj][n] * acc[ai][bj][m][n]; }
    }
};
struct EpiResid {
    static constexpr bool PERM = false; float* X; const float* mod; int goff;
    __device__ __forceinline__ void operator()(AccRef acc, const Unit& u, int wr, int wc, int fr, int fq) const { fr = opq(fr); fq = opq(fq);
        const int row0 = u.pm * BM + wr * 64 + fr, col0 = u.pn * BM + wc * 32 + 4 * fq;
        const int bsel = u.pm < 32 ? 0 : (u.pm < 64 ? 1 : 2);
        const float* gp = mod + bsel * 12288 + goff + col0;
        f32x4 gv[2][2];
#pragma unroll
        for (int bj = 0; bj < 2; ++bj)
#pragma unroll
            for (int n = 0; n < 2; ++n) gv[bj][n] = *(const f32x4*)(gp + bj * HALF + n * 16);
#pragma unroll
        for (int ai = 0; ai < 2; ++ai)
#pragma unroll
            for (int m = 0; m < 4; ++m) { float* rowp = X + (size_t)(row0 + ai * HALF + m * 16) * D + col0;
#pragma unroll
                for (int bj = 0; bj < 2; ++bj)
#pragma unroll
                    for (int n = 0; n < 2; ++n) { f32x4* p = (f32x4*)(rowp + bj * HALF + n * 16); *p = *p + gv[bj][n] * acc[ai][bj][m][n]; } asm volatile("" ::: "memory"); }
    }
};
}


__device__ __forceinline__ void ph_prologue(const Ctx& F, const Args& A) {
    const int gt = F.bid * 512 + F.tid, NT = F.G * 512;
    { const f32x4* xs = (const f32x4*)A.in[I_X]; const f32x4* cs = (const f32x4*)A.in[I_CTX]; f32x4* xr = (f32x4*)(F.ws + WS_XRES);
      for (int i = gt; i < MX * D / 4; i += NT) xr[i] = xs[i];
      for (int i = gt; i < MC * D / 4; i += NT) xr[MX * D / 4 + i] = cs[i]; }
    { f32x2* tw = (f32x2*)(F.ws + WS_TW);
      for (int k = gt; k < 16384; k += NT) { float s, c; sincospif((float)k * (2.0f / 16384.0f), &s, &c); tw[k] = (f32x2){c, -s}; } }
    LAS float* sc = (LAS float*)F.lds;
    LAS float* red = (LAS float*)(F.lds + 3 * 2048 * 4);
    for (int i = F.tid; i < 3 * 2048; i += 512) { const int r = i / 2048, k = i % 2048; const float v = r < 2 ? A.in[I_C][r * 2048 + k] : A.in[I_CCTX][k]; sc[i] = siluf_(v); }
    __syncthreads();
    const int col = F.tid & 63, ks = F.tid >> 6;
    for (int chunk = F.bid; chunk < DEPTH * 192; chunk += F.G) {
        const int l = chunk / 192, n0 = (chunk % 192) * 64;
        const float* w = A.in[I_WMOD] + (size_t)l * 2048 * 12288 + n0 + col;
        float s0 = 0.f, s1 = 0.f, s2 = 0.f;
#pragma unroll 8
        for (int k = ks * 256; k < ks * 256 + 256; ++k) { const float wv = w[(size_t)k * 12288]; s0 += sc[k] * wv; s1 += sc[2048 + k] * wv; s2 += sc[4096 + k] * wv; }
        red[(ks * 3 + 0) * 64 + col] = s0; red[(ks * 3 + 1) * 64 + col] = s1; red[(ks * 3 + 2) * 64 + col] = s2;
        __syncthreads();
        if (F.tid < 192) { const int r = F.tid >> 6, c2 = F.tid & 63; float s = 0.f;
#pragma unroll
            for (int q = 0; q < 8; ++q) s += red[(q * 3 + r) * 64 + c2];
            ((float*)(F.ws + WS_MOD))[((size_t)l * 3 + r) * 12288 + n0 + c2] = s + A.in[I_BMOD][(size_t)l * 12288 + n0 + c2]; }
        __syncthreads();
    }
}

__device__ __forceinline__ void transpose_item(const float* W, int ldw, int k0, int srccol0, f16* WT, int dstrow0, int ldk, LAS float* scr, int lane) {
#pragma unroll 8
    for (int i = 0; i < 32; ++i) { const int kk = 2 * i + (lane >> 5); scr[kk * 33 + (lane & 31)] = srccol0 >= 0 ? W[(size_t)(k0 + kk) * ldw + srccol0 + (lane & 31)] : 0.f; }
    LDS_WAIT(); asm volatile("" ::: "memory");
    const int c = lane & 7;
#pragma unroll
    for (int j = 0; j < 4; ++j) { const int n = (lane >> 3) + 8 * j; const LAS float* s = scr + (8 * c) * 33 + n;
        f16x8 o;
#pragma unroll
        for (int e = 0; e < 8; ++e) o[e] = (f16)s[e * 33];
        *(f16x8*)(WT + (size_t)(dstrow0 + n) * ldk + k0 + 8 * c) = o; }
    LDS_WAIT(); asm volatile("" ::: "memory");
}
__device__ __forceinline__ void ph_convert_weights(const Ctx& F, const Args& A, int l) {
    LAS float* scr = (LAS float*)(F.lds + F.wave * 16384);
    const int gw = F.bid * 8 + F.wave, NGW = F.G * 8;
    constexpr int I_IN = 32 * 360, I_GLU = 8 * 16, I_BR = 32 * 64, I_OUT = 32 * 64, I_UP = 32 * 352, I_DN = 88 * 64;
    constexpr int NIT = I_IN + I_GLU + I_BR + I_OUT + I_UP + I_DN;
    for (int it = gw; it < NIT; it += NGW) {
        int r = it;
        if (r < I_IN) { const int kb = r / 360, nb = r % 360, j0 = nb * 32;
            const int src = j0 < 2048 ? j0 : (j0 < 11264 ? j0 + 32 : (j0 < 11296 ? 2048 + (j0 - 11264) : -1));
            transpose_item(A.in[I_WIN] + (size_t)l * 2048 * INW, INW, kb * 64, src, (f16*)(F.ws + WS_WIN), j0, 2048, scr, F.lane); continue; } r -= I_IN;
        if (r < I_GLU) { const int kb = r / 16, nb = r % 16; transpose_item(A.in[I_GLUW] + (size_t)l * 512 * 512, 512, kb * 64, nb * 32, (f16*)(F.ws + WS_WGLU), nb * 32, 512, scr, F.lane); continue; } r -= I_GLU;
        if (r < I_BR) { const int kb = r / 64, nb = r % 64; transpose_item(A.in[I_WBR] + (size_t)l * 2048 * 2048, 2048, kb * 64, nb * 32, (f16*)(F.ws + WS_WBR), nb * 32, 2048, scr, F.lane); continue; } r -= I_BR;
        if (r < I_OUT) { const int kb = r / 64, nb = r % 64; transpose_item(A.in[I_WOUT] + (size_t)l * 2048 * 2048, 2048, kb * 64, nb * 32, (f16*)(F.ws + WS_WOUT), nb * 32, 2048, scr, F.lane); continue; } r -= I_OUT;
        if (r < I_UP) { const int kb = r / 352, nb = r % 352; transpose_item(A.in[I_WUP] + (size_t)l * 2048 * UPLD, UPLD, kb * 64, nb * 32, (f16*)(F.ws + WS_WUP), nb * 32, 2048, scr, F.lane); continue; } r -= I_UP;
        { const int kb = r / 64, nb = r % 64; transpose_item(A.in[I_WDN] + (size_t)l * FFH * 2048, 2048, kb * 64, nb * 32, (f16*)(F.ws + WS_WDN), nb * 32, FFH, scr, F.lane); }
    }
}

__device__ __forceinline__ void s5_mats_group(const Ctx& F, const Args& A, int l, int g) {
    LAS f32x2* APOW = (LAS f32x2*)F.lds;
    LAS f32x2* BBAR = APOW + 2 * 17 * 64;
    LAS f32x2* CM = BBAR + 2 * 64 * 16;
    LAS float* KLAG = (LAS float*)(CM + 2 * 16 * 64);
    __syncthreads();
    for (int i = F.tid; i < 2 * 17 * 64; i += 512) { const int d = i / (17 * 64), e = (i / 64) % 17, n = i % 64;
        const size_t pi = (((size_t)l * 2 + d) * 32 + g) * 64 + n;
        const float are = A.in[I_S5ARE][pi], aim = A.in[I_S5AIM][pi], dt = expf(A.in[I_S5STEP][((size_t)l * 2 + d) * 32 + g]);
        const float zr = are * dt * (float)e, zi = aim * dt * (float)e; float s, c; sincosf(zi, &s, &c); const float m = expf(zr);
        APOW[i] = (f32x2){m * c, m * s}; }
    __syncthreads();
    for (int i = F.tid; i < 2 * 64 * 16; i += 512) { const int d = i / 1024, n = (i / 16) % 64, h = i % 16;
        const size_t pi = (((size_t)l * 2 + d) * 32 + g) * 64 + n;
        const float are = A.in[I_S5ARE][pi], aim = A.in[I_S5AIM][pi];
        const f32x2 ab = APOW[(d * 17 + 1) * 64 + n]; const f32x2 num = (f32x2){ab.x - 1.0f, ab.y};
        const float den = are * are + aim * aim; const f32x2 q = (f32x2){(num.x * are + num.y * aim) / den, (num.y * are - num.x * aim) / den};
        const size_t bi = (pi * 16) + h;
        BBAR[i] = cmul(q, (f32x2){A.in[I_S5BRE][bi], A.in[I_S5BIM][bi]});
        const size_t ci = ((((size_t)l * 2 + d) * 32 + g) * 16 + h) * 64 + n;
        CM[(d * 16 + h) * 64 + n] = (f32x2){A.in[I_S5CRE][ci], A.in[I_S5CIM][ci]}; }
    __syncthreads();
    for (int i = F.tid; i < 2 * 16 * 256; i += 512) { const int d = i / 4096, lag = (i / 256) % 16, h = (i / 16) % 16, hp = i % 16; float s = 0.f;
        for (int n = 0; n < 64; ++n) { const f32x2 t = cmul(CM[(d * 16 + h) * 64 + n], APOW[(d * 17 + lag) * 64 + n]); const f32x2 b = BBAR[(d * 64 + n) * 16 + hp]; s += t.x * b.x - t.y * b.y; }
        KLAG[i] = s; }
    __syncthreads();
    f16* W = (f16*)(F.ws + WS_S5W) + (size_t)g * 256 * 512;
    for (int i = F.tid; i < 256 * 64; i += 512) { const int n = i / 64, k8 = (i % 64) * 8, t = n >> 4, h = n & 15; f16x8 o;
#pragma unroll
        for (int e = 0; e < 8; ++e) { const int k = k8 + e; float v;
            if (k < 256) { const int s = k >> 4, hp = k & 15; v = 0.f;
                if (t >= s) v += KLAG[((0 * 16 + (t - s)) * 16 + h) * 16 + hp];
                if (s >= t) v += KLAG[((1 * 16 + (s - t)) * 16 + h) * 16 + hp];
                v *= S5SCALE; }
            else { const int d = (k - 256) >> 7, nn2 = (k - 256) & 127, nn = nn2 & 63, im = nn2 >> 6, ex = d == 0 ? t + 1 : 16 - t;
                const f32x2 z = cmul(CM[(d * 16 + h) * 64 + nn], APOW[(d * 17 + ex) * 64 + nn]); v = im ? -z.y : z.x; }
            o[e] = (f16)v; }
        *(f16x8*)(W + (size_t)n * 512 + k8) = o; }
    f16* Mx = (f16*)(F.ws + WS_S5M) + (size_t)g * 256 * 256;
    for (int i = F.tid; i < 256 * 32; i += 512) { const int n = i / 32, k8 = (i % 32) * 8, d = n >> 7, ri = (n >> 6) & 1, nn = n & 63; f16x8 o;
#pragma unroll
        for (int e = 0; e < 8; ++e) { const int k = k8 + e, s = k >> 4, hp = k & 15, ex = d == 0 ? 15 - s : s;
            const f32x2 z = cmul(APOW[(d * 17 + ex) * 64 + nn], BBAR[(d * 64 + nn) * 16 + hp]); o[e] = (f16)((ri ? z.y : z.x) * S5SCALE); }
        *(f16x8*)(Mx + (size_t)n * 256 + k8) = o; }
    if (F.tid < 128) { const int d = F.tid >> 6, nn = F.tid & 63; ((f32x2*)(F.ws + WS_S5AT))[(d * 32 + g) * 64 + nn] = APOW[(d * 17 + 16) * 64 + nn]; }
    __syncthreads();
}

__device__ __forceinline__ void ph_hyena_h2(const Ctx& F, const Args& A, int l) {
    LAS float* W1 = (LAS float*)F.lds;
    LAS float* W2 = W1 + 33 * 64;
    LAS float* PV = W2 + 64 * 64;
    LAS float* SCR = PV + 256;
    __syncthreads();
    for (int i = F.tid; i < 33 * 64; i += 512) W1[i] = A.in[I_HYW1][(size_t)l * 33 * 64 + i];
    for (int i = F.tid; i < 64 * 64; i += 512) W2[i] = A.in[I_HYW2][(size_t)l * 4096 + i];
    if (F.tid < 64) { PV[F.tid] = A.in[I_HYB1][l * 64 + F.tid]; PV[64 + F.tid] = A.in[I_HYF1][l * 64 + F.tid]; PV[128 + F.tid] = A.in[I_HYB2][l * 64 + F.tid]; PV[192 + F.tid] = A.in[I_HYF2][l * 64 + F.tid]; }
    __syncthreads();
    LAS float* scr = SCR + F.wave * 64;
    const int gw = F.bid * 8 + F.wave, NGW = F.G * 8, j = F.lane;
    float* H2 = (float*)(F.ws + WS_H2);
    for (int p = gw; p < SEQ + LC; p += NGW) {
        const int n = p < SEQ ? SEQ : LC, pos = p < SEQ ? p : p - SEQ;
        float feat = 0.f;
        if (j == 0) feat = (float)pos / (float)(n - 1);
        else if (j < 33) { const int fi = (j - 1) & 15; const float fr = 1e-4f + (float)fi * ((15.0f - 1e-4f) / 15.0f);
            const float ang = (6.283185307179586f / (float)n) * (float)pos * fr; float s, c; sincosf(ang, &s, &c); feat = j < 17 ? c : -s; }
        scr[j] = feat; LDS_WAIT(); asm volatile("" ::: "memory");
        float a = PV[j];
        for (int i = 0; i < 33; ++i) a += scr[i] * W1[i * 64 + j];
        const float h1 = sinf(PV[64 + j] * a);
        LDS_WAIT(); asm volatile("" ::: "memory");
        scr[j] = h1; LDS_WAIT(); asm volatile("" ::: "memory");
        float b = PV[128 + j];
        for (int i = 0; i < 64; ++i) b += scr[i] * W2[i * 64 + j];
        H2[(size_t)p * 64 + j] = sinf(PV[192 + j] * b);
        LDS_WAIT(); asm volatile("" ::: "memory");
    }
}

__device__ __forceinline__ void ph_norm(const Ctx& F, const Args& A, int l, int which, int nrows, int nslab) {
    const int gw = F.bid * 8 + F.wave, NGW = F.G * 8;
    float* X = (float*)(F.ws + WS_XRES); f16* O = (f16*)(F.ws + WS_HN); const float* SL = (const float*)(F.ws + WS_SLAB);
    const float* gain = A.in[which ? I_N2G : I_N1G] + (size_t)l * D;
    const float* mod = (const float*)(F.ws + WS_MOD) + (size_t)l * 3 * 12288;
    const int shoff = which ? 6144 : 0, soff = which ? 8192 : 2048;
    for (int m = gw; m < nrows; m += NGW) {
        const int bsel = m < SEQ ? 0 : (m < MX ? 1 : 2);
        f32x4* xr = (f32x4*)(X + (size_t)m * D) + F.lane;
        f32x4 v[8]; float s = 0.f;
#pragma unroll
        for (int j = 0; j < 8; ++j) v[j] = xr[64 * j];
        if (m >= MX && nslab > 0) {
            for (int sl = 0; sl < nslab; ++sl) { const f32x4* sr = (const f32x4*)(SL + ((size_t)sl * MC + (m - MX)) * D) + F.lane;
#pragma unroll
                for (int j = 0; j < 8; ++j) v[j] = v[j] + sr[64 * j]; }
#pragma unroll
            for (int j = 0; j < 8; ++j) xr[64 * j] = v[j]; }
#pragma unroll
        for (int j = 0; j < 8; ++j) s += (v[j].x * v[j].x + v[j].y * v[j].y) + (v[j].z * v[j].z + v[j].w * v[j].w);
        const float rstd = 1.0f / sqrtf(wave_sum(s) * (1.0f / D) + EPS);
        const float* mp = mod + bsel * 12288;
#pragma unroll
        for (int j = 0; j < 8; ++j) { const int c = 4 * F.lane + 256 * j;
            const f32x4 g = *(const f32x4*)(gain + c), sh = *(const f32x4*)(mp + shoff + c), sc = *(const f32x4*)(mp + soff + c);
            f16x4 o;
#pragma unroll
            for (int e = 0; e < 4; ++e) o[e] = (f16)(v[j][e] * rstd * g[e] * (1.0f + sc[e]) + sh[e]);
            *(f16x4*)(O + (size_t)m * D + c) = o; }
    }
}
__device__ __forceinline__ void ph_final_norm(const Ctx& F, const Args& A) {
    const int gw = F.bid * 8 + F.wave, NGW = F.G * 8;
    const float* X = (const float*)(F.ws + WS_XRES); const float* gain = A.in[I_FNG];
    for (int m = gw; m < MX; m += NGW) {
        const f32x4* xr = (const f32x4*)(X + (size_t)m * D) + F.lane;
        f32x4 v[8]; float s = 0.f;
#pragma unroll
        for (int j = 0; j < 8; ++j) { v[j] = xr[64 * j]; s += (v[j].x * v[j].x + v[j].y * v[j].y) + (v[j].z * v[j].z + v[j].w * v[j].w); }
        const float rstd = 1.0f / sqrtf(wave_sum(s) * (1.0f / D) + EPS);
#pragma unroll
        for (int j = 0; j < 8; ++j) { const int c = 4 * F.lane + 256 * j; const f32x4 g = *(const f32x4*)(gain + c);
            *(f32x4*)(A.out + (size_t)m * D + c) = v[j] * rstd * g; }
    }
}

__device__ __forceinline__ void ph_s5_scan(const Ctx& F) {
    if (F.tid >= 32) return;
    const float* S = (const float*)(F.ws + WS_S5S); f16* SA = (f16*)(F.ws + WS_S5A);
    for (int gt = F.bid * 32 + F.tid; gt < 2 * 2 * 32 * 64; gt += F.G * 32) {
        const int nn = gt & 63, g = (gt >> 6) & 31, d = (gt >> 11) & 1, b = gt >> 12;
        const f32x2 at = ((const f32x2*)(F.ws + WS_S5AT))[(d * 32 + g) * 64 + nn];
        f32x2 st = (f32x2){0.f, 0.f};
        for (int base = 0; base < 16 + 512; base += 16) {
            f32x2 loc[16]; int chk[16];
#pragma unroll
            for (int u = 0; u < 16; ++u) { const int step = base + u; int chunk;
                if (d == 0) chunk = step < 16 ? 1024 + b * 16 + step : b * 512 + (step - 16);
                else chunk = step < 16 ? 1024 + b * 16 + (15 - step) : b * 512 + (511 - (step - 16));
                chk[u] = chunk; const size_t so = ((size_t)chunk * 32 + g) * 256 + d * 128 + nn;
                loc[u] = (f32x2){S[so], S[so + 64]}; }
#pragma unroll
            for (int u = 0; u < 16; ++u) { f16* xp = SA + (size_t)chk[u] * 16384 + (size_t)g * 512 + 256 + d * 128 + nn;
                xp[0] = (f16)st.x; xp[64] = (f16)st.y;
                st = cmul(at, st) + loc[u]; }
        }
    }
}

__device__ __forceinline__ void ph_ffn_act(const Ctx& F, const Args& A, int l, int nrows) {
    const f16* UP = (const f16*)(F.ws + WS_PX); f16* ACT = (f16*)(F.ws + WS_ACT);
    const float* cw = A.in[I_FFCW] + (size_t)l * 3 * FFH; const float* cb = A.in[I_FFCB] + (size_t)l * FFH;
    const int NTASK = (nrows / 16) * (FFH / 8);
    for (int task = F.bid * 512 + F.tid; task < NTASK; task += F.G * 512) {
        const int rb = task / (FFH / 8), cg = task % (FFH / 8), c0 = cg * 8, r0 = rb * 16;
        int seq0, seqn; if (r0 < MX) { seq0 = (r0 / SEQ) * SEQ; seqn = SEQ; } else { seq0 = MX + ((r0 - MX) / LC) * LC; seqn = LC; }
        float w0[8], w1[8], w2[8], bb[8];
#pragma unroll
        for (int e = 0; e < 8; ++e) { w0[e] = cw[c0 + e]; w1[e] = cw[FFH + c0 + e]; w2[e] = cw[2 * FFH + c0 + e]; bb[e] = cb[c0 + e]; }
        f16x8 zero;
#pragma unroll
        for (int e = 0; e < 8; ++e) zero[e] = (f16)0.f;
        f16x8 pm = (r0 > seq0) ? *(const f16x8*)(UP + (size_t)(r0 - 1) * UPLD + c0) : zero;
        f16x8 pc = *(const f16x8*)(UP + (size_t)r0 * UPLD + c0);
#pragma unroll 4
        for (int i = 0; i < 16; ++i) { const int r = r0 + i;
            const f16x8 pn = (r + 1 < seq0 + seqn) ? *(const f16x8*)(UP + (size_t)(r + 1) * UPLD + c0) : zero;
            const f16x8 bv = *(const f16x8*)(UP + (size_t)r * UPLD + FFH + c0);
            f16x8 o;
#pragma unroll
            for (int e = 0; e < 8; ++e) { const float a = w0[e] * (float)pm[e] + w1[e] * (float)pc[e] + w2[e] * (float)pn[e] + bb[e]; o[e] = (f16)(siluf_(a) * (float)bv[e]); }
            *(f16x8*)(ACT + (size_t)r * FFH + c0) = o;
            pm = pc; pc = pn; }
    }
}

namespace gla {
constexpr int QK_LD = 136, KH_LD = 72, VT_LD = 72, P_LD = 72;
constexpr int OFF_QT = 0;
constexpr int OFF_KT = 17408;
constexpr int OFF_VT = OFF_KT + 18432;
constexpr int OFF_P = OFF_VT + 36864;
constexpr int OFF_LR = OFF_P + 9216;
constexpr int OFF_GT = OFF_LR + 4096;
constexpr int OFF_DEC = OFF_GT + 2048;
constexpr int OFF_RS = OFF_DEC + 512;
constexpr int OFF_QR = OFF_RS + 2048;
constexpr int OFF_KR = OFF_QR + 17408;
constexpr int OFF_WG = OFF_KR + 17408;
static_assert(OFF_WG + 8192 <= LDSCTL_OFF, "gla lds");

__device__ __forceinline__ int grow(int b, int sc, int j, int i) {
    if (sc < 32) { const int col = 2 * sc + (j >> 1), r = (j & 1) * 64 + i; return b * SEQ + r * 64 + col; }
    return MX + b * LC + j * 64 + i;
}
#define GLA_MFMA(a, b, c) __builtin_amdgcn_mfma_f32_16x16x32_f16(a, b, c, 0, 0, 0)

template <bool FULL>
__device__ __forceinline__ void gla_unit(const Ctx& F, const Args& A, int l, int unit) {
    const int b = unit / (4 * NSC), h = (unit / NSC) % 4, sc = unit % NSC;
    LAS f16* QT = (LAS f16*)(F.lds + OFF_QT); LAS f16* KT = (LAS f16*)(F.lds + OFF_KT); LAS f16* VT = (LAS f16*)(F.lds + OFF_VT);
    LAS f16* PP = (LAS f16*)(F.lds + OFF_P); LAS f16* LR = (LAS f16*)(F.lds + OFF_LR);
    LAS float* GT = (LAS float*)(F.lds + OFF_GT); LAS float* DEC = (LAS float*)(F.lds + OFF_DEC); LAS float* RS = (LAS float*)(F.lds + OFF_RS);
    LAS f16* QR = (LAS f16*)(F.lds + OFF_QR); LAS f16* KR = (LAS f16*)(F.lds + OFF_KR); LAS float* WG = (LAS float*)(F.lds + OFF_WG);
    const int tid = F.tid, lane = F.lane, w = F.wave, q0 = lane >> 4, c0 = lane & 15;
    const int dk0 = tid & 127, ig0 = tid >> 7;
    const f16* PX = (const f16*)(F.ws + WS_PX);
    const float scale = 0.08838834764831845f;
    for (int dir = 0; dir < 2; ++dir) {
        __syncthreads();
        for (int i = tid; i < 16 * 128; i += 512) WG[i] = A.in[I_GLAWG][(((size_t)l * 2 + dir) * 16 + (i >> 7)) * 512 + h * 128 + (i & 127)];
        const float bgv = A.in[I_GLABG][((size_t)l * 2 + dir) * 512 + h * 128 + dk0];
        const size_t sidx = ((((size_t)b * 4 + h) * NSC + sc) * 2 + dir);
        f32x4 accS[8][2];
        if (FULL) { const float* Sin = (const float*)(F.ws + WS_GSIN) + sidx * 32768; const int q = opq(q0), c = opq(c0);
#pragma unroll
            for (int dt = 0; dt < 8; ++dt)
#pragma unroll
                for (int et = 0; et < 2; ++et)
#pragma unroll
                    for (int r = 0; r < 4; ++r) accS[dt][et][r] = Sin[(16 * dt + 4 * q + r) * 256 + 32 * w + 16 * et + c]; }
        else {
#pragma unroll
            for (int dt = 0; dt < 8; ++dt)
#pragma unroll
                for (int et = 0; et < 2; ++et) accS[dt][et] = (f32x4){0.f, 0.f, 0.f, 0.f}; }
        float sumtot = 0.f;
        for (int jj = 0; jj < 4; ++jj) {
            const int j = dir ? 3 - jj : jj;
            __syncthreads();
            const int tid = opq(F.tid);
            if (tid < 256) { const int row = tid >> 2, part = tid & 3; const int gr = grow(b, sc, j, row);
                *(LAS f16x8*)(LR + row * 32 + part * 8) = *(const f16x8*)(PX + (size_t)gr * PXLD + P_GG + part * 8); }
#pragma unroll 1
            for (int k = 0; k < 4; ++k) { const int idx = tid + 512 * k, wi = idx >> 6, ln = idx & 63, rr = ln >> 2, cc = ln & 3;
                const int row = (wi & 3) * 16 + rr, chunk = (wi >> 2) * 4 + cc; const int gr = grow(b, sc, j, row);
                const f16x8 v8 = *(const f16x8*)(PX + (size_t)gr * PXLD + P_GV + h * 256 + chunk * 8);
#pragma unroll
                for (int e = 0; e < 8; ++e) VT[(chunk * 8 + e) * VT_LD + row] = v8[e]; }
#pragma unroll 1
            for (int k = 0; k < 2; ++k) { const int idx = tid + 512 * k, row = idx >> 4, ch = idx & 15; const int gr = grow(b, sc, j, row);
                *(LAS f16x8*)(KR + row * QK_LD + ch * 8) = *(const f16x8*)(PX + (size_t)gr * PXLD + P_GK + h * 128 + ch * 8);
                if (FULL) *(LAS f16x8*)(QR + row * QK_LD + ch * 8) = *(const f16x8*)(PX + (size_t)gr * PXLD + P_GQ + h * 128 + ch * 8); }
            __syncthreads();
            const int dk = opq(dk0), ig = opq(ig0);
            float bv[16];
#pragma unroll
            for (int ii = 0; ii < 16; ++ii) { const int i = ig * 16 + ii; float pre = bgv;
                const f16x8 l0 = *(const LAS f16x8*)(LR + i * 32 + dir * 16), l1 = *(const LAS f16x8*)(LR + i * 32 + dir * 16 + 8);
#pragma unroll
                for (int r = 0; r < 8; ++r) pre += (float)l0[r] * WG[r * 128 + dk] + (float)l1[r] * WG[(8 + r) * 128 + dk];
                bv[ii] = logsigmoidf_(pre) * (1.0f / 16.0f); }
            float totloc;
            if (dir == 0) {
#pragma unroll
                for (int ii = 1; ii < 16; ++ii) bv[ii] += bv[ii - 1];
                totloc = bv[15]; }
            else {
#pragma unroll
                for (int ii = 14; ii >= 0; --ii) bv[ii] += bv[ii + 1];
                totloc = bv[0]; }
            GT[ig * 128 + dk] = totloc;
            __syncthreads();
            const float g0 = GT[dk], g1 = GT[128 + dk], g2 = GT[256 + dk], g3 = GT[384 + dk];
            const float total = (g0 + g1) + (g2 + g3);
            float off, bmid;
            if (dir == 0) { off = (ig > 0 ? g0 : 0.f) + (ig > 1 ? g1 : 0.f) + (ig > 2 ? g2 : 0.f); bmid = g0 + g1; }
            else { off = (ig < 3 ? g3 : 0.f) + (ig < 2 ? g2 : 0.f) + (ig < 1 ? g1 : 0.f); bmid = g2 + g3; }
#pragma unroll
            for (int ii = 0; ii < 16; ++ii) bv[ii] += off;
            if (FULL) {
#pragma unroll
                for (int ii = 0; ii < 16; ++ii) { const int i = ig * 16 + ii;
                    QT[i * QK_LD + dk] = (f16)((float)QR[i * QK_LD + dk] * scale * __expf(fminf(bv[ii] - bmid, 9.f)));
                    KT[i * QK_LD + dk] = (f16)((float)KR[i * QK_LD + dk] * __expf(fminf(bmid - bv[ii], 9.f))); }
                __syncthreads();
                { const int c = opq(c0), q = opq(q0);
#pragma unroll
                for (int s = 0; s < 2; ++s) { const int T = 2 * w + s, it = T >> 2, jt = T & 3; f32x4 a = (f32x4){0.f, 0.f, 0.f, 0.f};
#pragma unroll
                    for (int kk = 0; kk < 4; ++kk) { const f16x8 kf = *(const LAS f16x8*)(KT + (jt * 16 + c) * QK_LD + kk * 32 + 8 * q);
                        const f16x8 qf = *(const LAS f16x8*)(QT + (it * 16 + c) * QK_LD + kk * 32 + 8 * q); a = GLA_MFMA(kf, qf, a); }
                    const int i = it * 16 + c; f16x4 pv;
#pragma unroll
                    for (int r = 0; r < 4; ++r) { const int jx = jt * 16 + 4 * q + r; const bool keep = dir == 0 ? (jx <= i) : (jx >= i); pv[r] = keep ? (f16)a[r] : (f16)0.f; }
                    *(LAS f16x4*)(PP + i * P_LD + jt * 16 + 4 * q) = pv; } }
                __syncthreads();
#pragma unroll
                for (int ii = 0; ii < 16; ++ii) { const int i = ig * 16 + ii; QT[i * QK_LD + dk] = (f16)((float)QR[i * QK_LD + dk] * scale * __expf(bv[ii])); }
            }
            { f16x8 k0, k1;
#pragma unroll
              for (int ii = 0; ii < 8; ++ii) { k0[ii] = (f16)((float)KR[(ig * 16 + ii) * QK_LD + dk] * __expf(total - bv[ii])); k1[ii] = (f16)((float)KR[(ig * 16 + 8 + ii) * QK_LD + dk] * __expf(total - bv[8 + ii])); }
              *(LAS f16x8*)(KT + dk * KH_LD + ig * 16) = k0; *(LAS f16x8*)(KT + dk * KH_LD + ig * 16 + 8) = k1; }
            if (ig == 0) { DEC[dk] = __expf(total); sumtot += total; }
            __syncthreads();
            const int c = opq(c0), q = opq(q0);
            if (FULL) {
                f32x4 accO[4][2];
#pragma unroll
                for (int it = 0; it < 4; ++it)
#pragma unroll
                    for (int et = 0; et < 2; ++et) accO[it][et] = (f32x4){0.f, 0.f, 0.f, 0.f};
#pragma unroll
                for (int et = 0; et < 2; ++et)
#pragma unroll
                    for (int kk = 0; kk < 2; ++kk) { const f16x8 vf = *(const LAS f16x8*)(VT + (32 * w + 16 * et + c) * VT_LD + kk * 32 + 8 * q);
#pragma unroll
                        for (int it = 0; it < 4; ++it) { const f16x8 pf = *(const LAS f16x8*)(PP + (it * 16 + c) * P_LD + kk * 32 + 8 * q); accO[it][et] = GLA_MFMA(vf, pf, accO[it][et]); } asm volatile("" ::: "memory"); }
#pragma unroll
                for (int kb = 0; kb < 4; ++kb)
#pragma unroll
                    for (int et = 0; et < 2; ++et) { f16x8 sf; asm volatile("" ::: "memory");
#pragma unroll
                        for (int e = 0; e < 4; ++e) { sf[e] = (f16)accS[2 * kb][et][e]; sf[4 + e] = (f16)accS[2 * kb + 1][et][e]; }
#pragma unroll
                        for (int it = 0; it < 4; ++it) { const f16x4 lo = *(const LAS f16x4*)(QT + (it * 16 + c) * QK_LD + 32 * kb + 4 * q), hi = *(const LAS f16x4*)(QT + (it * 16 + c) * QK_LD + 32 * kb + 16 + 4 * q);
                            f16x8 qf; qf[0] = lo[0]; qf[1] = lo[1]; qf[2] = lo[2]; qf[3] = lo[3]; qf[4] = hi[0]; qf[5] = hi[1]; qf[6] = hi[2]; qf[7] = hi[3];
                            accO[it][et] = GLA_MFMA(sf, qf, accO[it][et]); } }
                float* OF = (float*)(F.ws + WS_GOF);
                if (dir == 0) {
#pragma unroll
                    for (int it = 0; it < 4; ++it) { const int gr = grow(b, sc, j, it * 16 + c);
#pragma unroll
                        for (int et = 0; et < 2; ++et) *(f32x4*)(OF + (size_t)gr * 1024 + h * 256 + 32 * w + 16 * et + 4 * q) = accO[it][et];
                        asm volatile("" ::: "memory"); } }
                else {
                    int grs[4];
#pragma unroll
                    for (int it = 0; it < 4; ++it) { grs[it] = grow(b, sc, j, it * 16 + c); float ss = 0.f;
#pragma unroll
                        for (int et = 0; et < 2; ++et) { accO[it][et] = accO[it][et] + *(const f32x4*)(OF + (size_t)grs[it] * 1024 + h * 256 + 32 * w + 16 * et + 4 * q);
                            ss += (accO[it][et][0] * accO[it][et][0] + accO[it][et][1] * accO[it][et][1]) + (accO[it][et][2] * accO[it][et][2] + accO[it][et][3] * accO[it][et][3]); }
                        ss += __shfl_xor(ss, 16); ss += __shfl_xor(ss, 32);
                        if (q == 0) RS[(it * 16 + c) * 8 + w] = ss; asm volatile("" ::: "memory"); }
                    __syncthreads();
                    const float* ng = A.in[I_GLANG] + (size_t)l * 256;
                    f16* Y = (f16*)(F.ws + WS_YCAT);
#pragma unroll
                    for (int it = 0; it < 4; ++it) { const int i = it * 16 + c; const f32x4 ra = *(const LAS f32x4*)(RS + i * 8), rb = *(const LAS f32x4*)(RS + i * 8 + 4);
                        const float tot = ((ra[0] + ra[1]) + (ra[2] + ra[3])) + ((rb[0] + rb[1]) + (rb[2] + rb[3]));
                        const float rstd = 1.0f / sqrtf(tot * (1.0f / 256.0f) + EPS);
#pragma unroll
                        for (int et = 0; et < 2; ++et) { const int e0 = 32 * w + 16 * et + 4 * q;
                            const f32x4 gv = *(const f32x4*)(ng + e0); const f16x4 rv = *(const f16x4*)(PX + (size_t)grs[it] * PXLD + P_GR + h * 256 + e0);
                            f16x4 o;
#pragma unroll
                            for (int r = 0; r < 4; ++r) o[r] = (f16)(accO[it][et][r] * rstd * gv[r] * siluf_((float)rv[r]));
                            *(f16x4*)(Y + (size_t)grs[it] * 2048 + 1024 + h * 256 + e0) = o; } asm volatile("" ::: "memory"); }
                }
            }
#pragma unroll
            for (int dt = 0; dt < 8; ++dt) { const f32x4 dv = *(const LAS f32x4*)(DEC + 16 * dt + 4 * q);
#pragma unroll
                for (int et = 0; et < 2; ++et) accS[dt][et] = accS[dt][et] * dv; }
#pragma unroll
            for (int kk = 0; kk < 2; ++kk) { f16x8 vf[2];
#pragma unroll
                for (int et = 0; et < 2; ++et) vf[et] = *(const LAS f16x8*)(VT + (32 * w + 16 * et + c) * VT_LD + kk * 32 + 8 * q);
#pragma unroll
                for (int dt = 0; dt < 8; ++dt) { const f16x8 kf = *(const LAS f16x8*)(KT + (16 * dt + c) * KH_LD + kk * 32 + 8 * q);
#pragma unroll
                    for (int et = 0; et < 2; ++et) accS[dt][et] = GLA_MFMA(kf, vf[et], accS[dt][et]); if (dt & 1) asm volatile("" ::: "memory"); } }
        }
        if (!FULL) { float* Sl = (float*)(F.ws + WS_GSLOC) + sidx * 32768; const int q = opq(q0), c = opq(c0);
#pragma unroll
            for (int dt = 0; dt < 8; ++dt)
#pragma unroll
                for (int et = 0; et < 2; ++et)
#pragma unroll
                    for (int r = 0; r < 4; ++r) Sl[(16 * dt + 4 * q + r) * 256 + 32 * w + 16 * et + c] = accS[dt][et][r];
            if (ig0 == 0) ((float*)(F.ws + WS_GDT))[sidx * 128 + dk0] = __expf(sumtot); }
        VM_WAIT();
    }
}
__device__ __forceinline__ void ph_gla_scan(const Ctx& F) {
    const float* Sl = (const float*)(F.ws + WS_GSLOC); float* Si = (float*)(F.ws + WS_GSIN); const float* Dt = (const float*)(F.ws + WS_GDT);
    for (int gt = F.bid * 512 + F.tid; gt < 2 * 4 * 2 * 32768; gt += F.G * 512) {
        const int e = gt & 32767, dir = (gt >> 15) & 1, h = (gt >> 16) & 3, b = gt >> 18;
        float S = 0.f;
        for (int base = 0; base < NSC; base += 11) {
            float sl[11], dt[11]; size_t ix[11];
#pragma unroll
            for (int u = 0; u < 11; ++u) { const int step = base + u; const int sc = step == 0 ? 32 : (dir == 0 ? step - 1 : 32 - step);
                const size_t idx = ((((size_t)b * 4 + h) * NSC + sc) * 2 + dir); ix[u] = idx;
                sl[u] = Sl[idx * 32768 + e]; dt[u] = Dt[idx * 128 + (e >> 8)]; }
#pragma unroll
            for (int u = 0; u < 11; ++u) { Si[ix[u] * 32768 + e] = S; S = dt[u] * S + sl[u]; }
        }
    }
}
#undef GLA_MFMA
}

namespace hy {
#define PADI(i) ((i) + ((i) >> 5))
constexpr int HY_BUF_BYTES = (16384 + 512) * 8;
constexpr int HY_SCR_OFF = HY_BUF_BYTES;
static_assert(HY_SCR_OFF + 2048 <= LDSCTL_OFF, "hyena lds");
__device__ __forceinline__ f32x2 twid(int k, float invN) { const float xr = (float)k * invN; return (f32x2){__builtin_amdgcn_cosf(xr), -__builtin_amdgcn_sinf(xr)}; }
__device__ __forceinline__ f32x2 mul_w16(f32x2 d, int a) {
    constexpr float c1 = 0.9238795325112867f, s1 = 0.3826834323650898f, r = 0.7071067811865476f;
    float c, s;
    switch (a & 15) {
        case 0: return d; case 4: return (f32x2){d.y, -d.x}; case 8: return (f32x2){-d.x, -d.y}; case 12: return (f32x2){-d.y, d.x};
        case 1: c = c1; s = s1; break; case 2: c = r; s = r; break; case 3: c = s1; s = c1; break;
        case 5: c = -s1; s = c1; break; case 6: c = -r; s = r; break; case 7: c = -c1; s = s1; break;
        case 9: c = -c1; s = -s1; break; case 10: c = -r; s = -r; break; case 11: c = -s1; s = -c1; break;
        case 13: c = s1; s = -c1; break; case 14: c = r; s = -r; break; default: c = c1; s = -s1; break; }
    return (f32x2){d.x * c + d.y * s, d.y * c - d.x * s};
}
template <int R> __device__ __forceinline__ void dif_pass(LAS f32x2* x, int m, int lh, int tid) {
    const int N = 1 << m; const float invN = 1.0f / (float)N; const int lg = lh - R + 1, g = 1 << lg, S = (N >> 1) >> lh;
    for (int q = tid; q < (N >> R); q += 512) { const int j = q & (g - 1), blk = q >> lg, base = (blk << (lh + 1)) + j;
        f32x2 v[1 << R];
#pragma unroll
        for (int k = 0; k < (1 << R); ++k) v[k] = x[PADI(base + k * g)];
        f32x2 w = twid(j * S, invN);
#pragma unroll
        for (int s = 0; s < R; ++s) { const int half = 1 << (R - 1 - s);
#pragma unroll
            for (int k = 0; k < (1 << R); ++k) if (!(k & half)) { const f32x2 a = v[k], b = v[k + half]; v[k] = a + b;
                v[k + half] = mul_w16(cmul(a - b, w), ((k & (half - 1)) << s) * (16 >> R)); }
            w = cmul(w, w); }
#pragma unroll
        for (int k = 0; k < (1 << R); ++k) x[PADI(base + k * g)] = v[k]; }
    __syncthreads();
}
template <int R> __device__ __forceinline__ void dit_pass(LAS f32x2* x, int m, int lh, int tid) {
    const int N = 1 << m; const float invN = 1.0f / (float)N; const int h = 1 << lh, S1 = (N >> 1) >> lh;
    for (int q = tid; q < (N >> R); q += 512) { const int j = q & (h - 1), blk = q >> lh, base = (blk << (lh + R)) + j;
        f32x2 v[1 << R];
#pragma unroll
        for (int k = 0; k < (1 << R); ++k) v[k] = x[PADI(base + k * h)];
        f32x2 wp[R]; wp[R - 1] = cconj(twid(j * (S1 >> (R - 1)), invN));
#pragma unroll
        for (int s = R - 2; s >= 0; --s) wp[s] = cmul(wp[s + 1], wp[s + 1]);
#pragma unroll
        for (int s = 0; s < R; ++s) { const int half = 1 << s;
#pragma unroll
            for (int k = 0; k < (1 << R); ++k) if (!(k & half)) { const f32x2 a = v[k];
                const f32x2 b = mul_w16(cmul(v[k + half], wp[s]), (16 - (k & (half - 1)) * (16 >> (s + 1))) & 15);
                v[k] = a + b; v[k + half] = a - b; } }
#pragma unroll
        for (int k = 0; k < (1 << R); ++k) x[PADI(base + k * h)] = v[k]; }
    __syncthreads();
}
__device__ __forceinline__ void fft_fwd(LAS f32x2* x, int m, int tid) {
    int lh = m - 1;
    while (lh + 1 >= 4) { dif_pass<4>(x, m, lh, tid); lh -= 4; }
    if (lh + 1 == 2) dif_pass<2>(x, m, 1, tid); else if (lh + 1 == 1) dif_pass<1>(x, m, 0, tid);
}
__device__ __forceinline__ void fft_inv(LAS f32x2* x, int m, int tid) {
    int lh = 0;
    while (m - lh >= 4) { dit_pass<4>(x, m, lh, tid); lh += 4; }
    if (m - lh == 2) dit_pass<2>(x, m, lh, tid); else if (m - lh == 1) dit_pass<1>(x, m, lh, tid);
}
__device__ __forceinline__ int brev(int k, int m) { return (int)(__brev((unsigned)k) >> (32 - m)); }

__device__ __forceinline__ void filt_unit(const Ctx& F, const Args& A, int l, int unit) {
    const int kind = unit >> 9, o = (unit >> 8) & 1, pair = unit & 255;
    const int n = kind ? LC : SEQ, m = kind ? 9 : 14, N = 2 * n, tid = F.tid;
    LAS f32x2* buf = (LAS f32x2*)F.lds;
    LAS float* W3 = (LAS float*)(F.lds + HY_SCR_OFF);
    LAS float* B3 = W3 + 256;
    LAS float* RED = B3 + 4;
    LAS float* INV = RED + 16;
    __syncthreads();
    if (tid < 256) { const int j = tid >> 2, ci = tid & 3; const int col = o * 1024 + (ci >> 1) * 512 + 2 * pair + (ci & 1);
        W3[j * 4 + ci] = A.in[I_HYW3][((size_t)l * 64 + j) * 2048 + col]; if (j == 0) B3[ci] = A.in[I_HYB3][(size_t)l * 2048 + col]; }
    __syncthreads();
    const float* H2 = (const float*)(F.ws + WS_H2) + (kind ? (size_t)SEQ * 64 : 0);
    const float lo = -3.0701134573253945f, hi = -15.350567286626973f;
    const float ra = fabsf(lo + (hi - lo) * (float)(2 * pair) / 511.0f), rb = fabsf(lo + (hi - lo) * (float)(2 * pair + 1) / 511.0f);
    float sa = 0.f, sb = 0.f;
    for (int t = tid; t < n; t += 512) {
        float a0 = B3[0], a1 = B3[1], a2 = B3[2], a3 = B3[3];
        const f32x4* hr = (const f32x4*)(H2 + (size_t)t * 64);
#pragma unroll 4
        for (int j4 = 0; j4 < 16; ++j4) { const f32x4 hv = hr[j4];
#pragma unroll
            for (int e = 0; e < 4; ++e) { const f32x4 wv = *(const LAS f32x4*)(W3 + (j4 * 4 + e) * 4); a0 += hv[e] * wv[0]; a1 += hv[e] * wv[1]; a2 += hv[e] * wv[2]; a3 += hv[e] * wv[3]; } }
        const float tn = (float)t / (float)(n - 1), da = expf(-tn * ra), db = expf(-tn * rb);
        const float fa = a0 * da, fb = a1 * db, ba = a2 * da, bb = a3 * db;
        buf[PADI(t)] = (f32x2){fa, fb}; sa += fabsf(fa); sb += fabsf(fb);
        if (t >= 1) { buf[PADI(N - t)] = (f32x2){ba, bb}; sa += fabsf(ba); sb += fabsf(bb); }
    }
    if (tid == 0) buf[PADI(n)] = (f32x2){0.f, 0.f};
    sa = wave_sum(sa); sb = wave_sum(sb);
    if (F.lane == 0) { RED[F.wave * 2] = sa; RED[F.wave * 2 + 1] = sb; }
    __syncthreads();
    if (tid < 2) { float s = 0.f;
#pragma unroll
        for (int w = 0; w < 8; ++w) s += RED[w * 2 + tid];
        INV[tid] = 1.0f / (s + EPS); }
    __syncthreads();
    { const float ia = INV[0], ib = INV[1];
      for (int i = tid; i < N; i += 512) { f32x2 v = buf[PADI(i)]; v.x *= ia; v.y *= ib; buf[PADI(i)] = v; } }
    __syncthreads();
    fft_fwd(buf, m, tid);
    f32x4* out = (f32x4*)(F.ws + WS_FSD + (kind ? FSD_C_OFF : 0)) + (size_t)(o * 256 + pair) * (n + 1);
    for (int u = tid; u <= n; u += 512) { const int p = u < n ? 2 * u : 1, k = brev(p, m), pn = brev((N - k) & (N - 1), m);
        const f32x2 zk = buf[PADI(p)], zn = cconj(buf[PADI(pn)]);
        const f32x2 fa = (zk + zn) * 0.5f, df = zk - zn, fb = (f32x2){df.y * 0.5f, -df.x * 0.5f};
        const f32x2 fs = (fa + fb) * 0.5f, fd = (fa - fb) * 0.5f;
        out[u] = (f32x4){fs.x, fs.y, fd.x, fd.y}; }
    __syncthreads();
}

__device__ __forceinline__ void main_unit(const Ctx& F, const Args& A, int l, int unit) {
    const int kind = unit >> 9, b = (unit >> 8) & 1, pair = unit & 255;
    const int n = kind ? LC : SEQ, m = kind ? 9 : 14, N = 2 * n, tid = F.tid;
    const int row0 = kind ? MX + b * LC : b * SEQ;
    LAS f32x2* buf = (LAS f32x2*)F.lds;
    const f16* ZT = (const f16*)(F.ws + WS_ZT) + (size_t)(2 * pair) * MT + row0;
    const float* cw = A.in[I_HYCW] + (size_t)l * 3 * 1536 + 2 * pair; const float* cb = A.in[I_HYCB] + (size_t)l * 1536 + 2 * pair;
    f32x2 yv[16], g1[16], g2[16];
#pragma unroll
    for (int g = 0; g < 3; ++g)
#pragma unroll
        for (int cc = 0; cc < 2; ++cc) { const float w0 = cw[g * 512 + cc], w1 = cw[1536 + g * 512 + cc], w2 = cw[3072 + g * 512 + cc], bs = cb[g * 512 + cc];
            const f16* zt = ZT + (size_t)(g * 512 + cc) * MT;
#pragma unroll
            for (int gi = 0; gi < 2; ++gi) { const int t0 = 8 * (tid + 512 * gi);
                f16x8 mv; float pv = 0.f, nv = 0.f;
#pragma unroll
                for (int e = 0; e < 8; ++e) mv[e] = (f16)0.f;
                if (t0 < n) { mv = *(const f16x8*)(zt + t0); if (t0 > 0) pv = (float)zt[t0 - 1]; if (t0 + 8 < n) nv = (float)zt[t0 + 8]; }
#pragma unroll
                for (int e = 0; e < 8; ++e) { const float zm = e == 0 ? pv : (float)mv[e == 0 ? 0 : e - 1], zc = (float)mv[e], zp = e == 7 ? nv : (float)mv[e == 7 ? 7 : e + 1];
                    const float r = w0 * zm + w1 * zc + w2 * zp + bs;
                    if (g == 0) { if (cc == 0) yv[gi * 8 + e].x = r; else yv[gi * 8 + e].y = r; }
                    else if (g == 1) { if (cc == 0) g1[gi * 8 + e].x = r; else g1[gi * 8 + e].y = r; }
                    else { if (cc == 0) g2[gi * 8 + e].x = r; else g2[gi * 8 + e].y = r; } } } }
    const float invN = 1.0f / (float)N;
#pragma unroll
    for (int o = 0; o < 2; ++o) {
        __syncthreads();
#pragma unroll
        for (int gi = 0; gi < 2; ++gi) { const int t0 = 8 * (tid + 512 * gi);
            if (t0 < n) {
#pragma unroll
                for (int e = 0; e < 8; ++e) { buf[PADI(t0 + e)] = yv[gi * 8 + e]; buf[PADI(n + t0 + e)] = (f32x2){0.f, 0.f}; } } }
        __syncthreads();
        fft_fwd(buf, m, tid);
        const f32x4* fsd = (const f32x4*)(F.ws + WS_FSD + (kind ? FSD_C_OFF : 0)) + (size_t)(o * 256 + pair) * (n + 1);
        for (int u = tid; u <= n; u += 512) { const int p = u < n ? 2 * u : 1, k = brev(p, m), pn = brev((N - k) & (N - 1), m);
            const f32x2 zk = buf[PADI(p)], zn = buf[PADI(pn)]; const f32x4 f = fsd[u]; const f32x2 fs = (f32x2){f[0], f[1]}, fd = (f32x2){f[2], f[3]};
            const f32x2 wk = cmul(zk, fs) + cmul(cconj(zn), fd), wn = cmul(zn, cconj(fs)) + cmul(cconj(zk), cconj(fd));
            buf[PADI(pn)] = wn; buf[PADI(p)] = wk; }
        __syncthreads();
        fft_inv(buf, m, tid);
        const float* hb = A.in[I_HYBIAS] + ((size_t)l * 2 + o) * 512 + 2 * pair; const f32x2 bias = (f32x2){hb[0], hb[1]};
#pragma unroll
        for (int gi = 0; gi < 2; ++gi) { const int t0 = 8 * (tid + 512 * gi);
            if (t0 < n) {
#pragma unroll
                for (int e = 0; e < 8; ++e) { const f32x2 cv = buf[PADI(t0 + e)] * invN; const f32x2 gt = o == 0 ? g1[gi * 8 + e] : g2[gi * 8 + e];
                    yv[gi * 8 + e] = gt * (cv + yv[gi * 8 + e] * bias); } } }
    }
    f16* Y = (f16*)(F.ws + WS_YBT) + (size_t)(2 * pair) * MT + row0;
#pragma unroll
    for (int gi = 0; gi < 2; ++gi) { const int t0 = 8 * (tid + 512 * gi);
        if (t0 < n) { f16x8 oa, ob;
#pragma unroll
            for (int e = 0; e < 8; ++e) { oa[e] = (f16)yv[gi * 8 + e].x; ob[e] = (f16)yv[gi * 8 + e].y; }
            *(f16x8*)(Y + t0) = oa; *(f16x8*)(Y + MT + t0) = ob; } }
    __syncthreads();
}

__device__ __forceinline__ void ph_ybt_transpose(const Ctx& F) {
    LAS f16* T = (LAS f16*)F.lds;
    const f16* YBT = (const f16*)(F.ws + WS_YBT); f16* Y = (f16*)(F.ws + WS_YCAT);
    for (int rb = F.bid; rb < MT / 64; rb += F.G) { const int r0 = rb * 64;
        __syncthreads();
#pragma unroll
        for (int i = 0; i < 8; ++i) *(LAS f16x8*)(T + F.tid * 72 + 8 * i) = *(const f16x8*)(YBT + (size_t)F.tid * MT + r0 + 8 * i);
        __syncthreads();
        const int row = F.tid >> 3, cg = F.tid & 7;
#pragma unroll
        for (int jj = 0; jj < 8; ++jj) { const int gidx = cg + 8 * jj; f16x8 o;
#pragma unroll
            for (int e = 0; e < 8; ++e) o[e] = T[(8 * gidx + e) * 72 + row];
            *(f16x8*)(Y + (size_t)(r0 + row) * 2048 + 512 + 8 * gidx) = o; }
    }
    __syncthreads();
}
#undef PADI
}

#ifndef PHMASK
#define PHMASK 0xFFFF
#endif
#define PH_EN(k) (((PHMASK) >> (k)) & 1)
#ifndef STAMP_MASK
#define STAMP_MASK 0
#endif
#ifndef STAMP_K
#define STAMP_K 1
#endif
#ifndef SUBMASK
#define SUBMASK 7
#endif
#define SUB_EN(k) (((SUBMASK) >> (k)) & 1)
constexpr int NPH = 2 + 12 * DEPTH;
constexpr int CW_Q = 8192;
__device__ __forceinline__ int q_pull(unsigned* ctr, volatile LAS int* slot) {
    __syncthreads();
    if (threadIdx.x == 0) *slot = (int)__hip_atomic_fetch_add(ctr, 1u, __ATOMIC_RELAXED, __HIP_MEMORY_SCOPE_AGENT);
    __syncthreads();
    return *slot;
}

__global__ void __launch_bounds__(512, 2) mk_fwd(Args args) {
    extern __shared__ __attribute__((aligned(16))) unsigned char lds_raw[];
    Ctx F; F.lds = (LAS unsigned char*)lds_raw; F.tid = threadIdx.x; F.lane = F.tid & 63; F.wave = __builtin_amdgcn_readfirstlane(F.tid >> 6);
    F.G = gridDim.x; F.bid = blockIdx.x; F.ws = args.ws;
    const Ctx F0 = F;
#define FRESH() do { F.tid = opq(F0.tid); F.lane = F.tid & 63; F.wave = __builtin_amdgcn_readfirstlane(F.tid >> 6); } while (0)
    volatile LAS unsigned* MISC = (volatile LAS unsigned*)(F.lds + LDSCTL_OFF);
    if (F.tid < 64) MISC[F.tid] = 0u;
    __syncthreads();
    unsigned* barw = (unsigned*)(F.ws + WS_CTL) + CW_BAR;
    XcdBarrier bar; bar.bar = barw; bar.x = 0; bar.st = nullptr;
    const int lo = args.ph_lo, hi = args.ph_hi;
    if (hi - lo > 1) bar = xcd_barrier_post(barw, MISC + 8);
#define IN(k) (lo <= (k) && (k) < hi)
#define SEAM(k) do { if (IN(k) && IN((k) + 1)) xcd_barrier(bar); } while (0)
#if STAMP_MASK
    volatile LAS unsigned long long* TS = (volatile LAS unsigned long long*)(F.lds + LDSCTL_OFF + 128);
#define TSTART(k) do { if ((((STAMP_MASK) >> (k)) & 1) && blockIdx.x == 0 && threadIdx.x == 0) TS[0] = __builtin_amdgcn_s_memrealtime(); } while (0)
#define TSTOP(k) do { if ((((STAMP_MASK) >> (k)) & 1) && blockIdx.x == 0 && threadIdx.x == 0) TS[1] = TS[1] + (__builtin_amdgcn_s_memrealtime() - TS[0]); } while (0)
#else
#define TSTART(k) do {} while (0)
#define TSTOP(k) do {} while (0)
#endif
    unsigned char* ws = F.ws;
    const int rank160 = (F.bid + F.G - 160 % F.G) % F.G;

    TSTART(12);
    if (PH_EN(12) && IN(0)) { FRESH(); ph_prologue(F, args); }
    SEAM(0);
    TSTOP(12);

    for (int l = 0; l < DEPTH; ++l) {
        const int pb = 1 + 12 * l;
        const float* modl = (const float*)(ws + WS_MOD) + (size_t)l * 3 * 12288;
        const bool ctx_on = l < DEPTH - 1;
        const int nMr = ctx_on ? MT / 256 : MX / 256, nrows = ctx_on ? MT : MX;
        TSTART(0);
        if (PH_EN(0) && IN(pb + 0)) {
            FRESH(); ph_convert_weights(F, args, l);
            __syncthreads();
            FRESH(); if (F.bid < 32) s5_mats_group(F, args, l, F.bid);
            FRESH(); ph_hyena_h2(F, args, l);
            FRESH(); ph_norm(F, args, l, 0, MT, l > 0 ? 11 : 0);
        }
        SEAM(pb + 0);
        TSTOP(0);
        TSTART(1);
        if (PH_EN(1) && IN(pb + 1)) {
            pg8::SchedPlain S; S.init(MT / 256, PXLD / 256, F.G, F.bid); S.A = (const char*)(ws + WS_HN); S.B = (const char*)(ws + WS_WIN); S.aTile = (size_t)256 * 2048 * 2; S.bTile = (size_t)256 * 2048 * 2;
            pg8::EpiPx E{(f16*)(ws + WS_PX), (f16*)(ws + WS_S5A), (f16*)(ws + WS_ZT)};
            pg8::gemm_phase(F.lds, 2048, 2048, 32, S, E);
        }
        SEAM(pb + 1);
        TSTOP(1);
        TSTART(2);
        if (PH_EN(2) && IN(pb + 2)) {
            TSTART(16);
            if (SUB_EN(0)) { pg8::SchedS5 S{(const char*)(ws + WS_S5A), (const char*)(ws + WS_S5M), (size_t)256 * 256 * 2, F.G, F.bid};
              pg8::EpiS5In E{(float*)(ws + WS_S5S)};
              pg8::gemm_phase(F.lds, 16384, 256, 4, S, E); }
            TSTOP(16);
            { unsigned* qc = (unsigned*)(ws + WS_CTL) + CW_Q + (l * 2 + 0) * 64; volatile LAS int* slot = (volatile LAS int*)(MISC + 16);
              for (;;) { const int u = q_pull(qc, slot); if (u >= 264 + 1024) break;
                  if (u < 264) { TSTART(17); FRESH(); gla::gla_unit<false>(F, args, l, u); TSTOP(17); } else { TSTART(18); FRESH(); hy::filt_unit(F, args, l, u - 264); TSTOP(18); } } }
        }
        SEAM(pb + 2);
        TSTOP(2);
        TSTART(3);
        if (PH_EN(3) && IN(pb + 3)) { FRESH(); ph_s5_scan(F); FRESH(); gla::ph_gla_scan(F); }
        SEAM(pb + 3);
        TSTOP(3);
        TSTART(4);
        if (PH_EN(4) && IN(pb + 4)) {
            TSTART(19);
            if (SUB_EN(0)) { pg8::SchedS5 S{(const char*)(ws + WS_S5A), (const char*)(ws + WS_S5W), (size_t)256 * 512 * 2, F.G, F.bid};
              pg8::EpiS5Out E{(const f16*)(ws + WS_S5A), (f16*)(ws + WS_YAPRE), args.in[I_S5D] + (size_t)l * 512};
              pg8::gemm_phase(F.lds, 16384, 512, 8, S, E); }
            TSTOP(19);
            { unsigned* qc = (unsigned*)(ws + WS_CTL) + CW_Q + (l * 2 + 1) * 64; volatile LAS int* slot = (volatile LAS int*)(MISC + 16);
              for (;;) { const int u = q_pull(qc, slot); if (u >= 264 + 1024) break;
                  if (u < 264) { TSTART(20); FRESH(); gla::gla_unit<true>(F, args, l, u); TSTOP(20); } else { TSTART(21); FRESH(); hy::main_unit(F, args, l, u - 264); TSTOP(21); } } }
        }
        SEAM(pb + 4);
        TSTOP(4);
        TSTART(5);
        if (PH_EN(5) && IN(pb + 5)) {
            pg8::SchedPlain S; S.init(nMr, 2, F.G, F.bid); S.A = (const char*)(ws + WS_YAPRE); S.B = (const char*)(ws + WS_WGLU); S.aTile = (size_t)256 * 512 * 2; S.bTile = (size_t)256 * 512 * 2;
            pg8::EpiGlu E{(const f16*)(ws + WS_YAPRE), (f16*)(ws + WS_YCAT), args.in[I_GLUB] + (size_t)l * 512};
            pg8::gemm_phase(F.lds, 512, 512, 8, S, E);
            FRESH(); hy::ph_ybt_transpose(F);
        }
        SEAM(pb + 5);
        TSTOP(5);
        TSTART(6);
        if (PH_EN(6) && IN(pb + 6)) {
            pg8::SchedPlain S; S.init(nMr, 8, F.G, F.bid); S.aTile = (size_t)256 * 2048 * 2; S.bTile = (size_t)256 * 2048 * 2;
            S.A = (const char*)(ws + WS_YCAT); S.B = (const char*)(ws + WS_WBR);
            if (SUB_EN(0)) { pg8::EpiBranch<0> E{(const f16*)(ws + WS_PX), (f16*)(ws + WS_MBUF)}; pg8::gemm_phase(F.lds, 2048, 2048, 8, S, E); }
            S.A = (const char*)(ws + WS_YCAT) + 512 * 2; S.B = (const char*)(ws + WS_WBR) + 512 * 2;
            if (SUB_EN(1)) { pg8::EpiBranch<1> E{(const f16*)(ws + WS_PX), (f16*)(ws + WS_MBUF)}; pg8::gemm_phase(F.lds, 2048, 2048, 8, S, E); }
            S.A = (const char*)(ws + WS_YCAT) + 1024 * 2; S.B = (const char*)(ws + WS_WBR) + 1024 * 2;
            if (SUB_EN(2)) { pg8::EpiBranch<2> E{(const f16*)(ws + WS_PX), (f16*)(ws + WS_MBUF)}; pg8::gemm_phase(F.lds, 2048, 2048, 16, S, E); }
        }
        SEAM(pb + 6);
        TSTOP(6);
        TSTART(7);
        if (PH_EN(7) && IN(pb + 7)) {
            pg8::SchedPlain S; S.init(MX / 256, 8, F.G, F.bid); S.A = (const char*)(ws + WS_MBUF); S.B = (const char*)(ws + WS_WOUT); S.aTile = (size_t)256 * 2048 * 2; S.bTile = (size_t)256 * 2048 * 2;
            pg8::EpiResid E{(float*)(ws + WS_XRES), modl, 4096};
            pg8::gemm_phase(F.lds, 2048, 2048, 32, S, E);
            if (ctx_on) { pg8::SchedSplit S2{(const char*)(ws + WS_MBUF), (const char*)(ws + WS_WOUT), (size_t)256 * 2048 * 2, (size_t)256 * 2048 * 2, (size_t)8 * 128, 4, F.G, F.bid};
                pg8::EpiSlab E2{(float*)(ws + WS_SLAB), modl, 4096};
                pg8::gemm_phase(F.lds, 2048, 2048, 8, S2, E2); }
        }
        SEAM(pb + 7);
        TSTOP(7);
        TSTART(8);
        if (PH_EN(8) && IN(pb + 8)) { FRESH(); ph_norm(F, args, l, 1, nrows, 4); }
        SEAM(pb + 8);
        TSTOP(8);
        TSTART(9);
        if (PH_EN(9) && IN(pb + 9)) {
            pg8::SchedPlain S; S.init(nMr, UPLD / 256, F.G, F.bid); S.A = (const char*)(ws + WS_HN); S.B = (const char*)(ws + WS_WUP); S.aTile = (size_t)256 * 2048 * 2; S.bTile = (size_t)256 * 2048 * 2;
            pg8::EpiF16 E{(f16*)(ws + WS_PX), UPLD};
            pg8::gemm_phase(F.lds, 2048, 2048, 32, S, E);
        }
        SEAM(pb + 9);
        TSTOP(9);
        TSTART(10);
        if (PH_EN(10) && IN(pb + 10)) { FRESH(); ph_ffn_act(F, args, l, nrows); }
        SEAM(pb + 10);
        TSTOP(10);
        TSTART(11);
        if (PH_EN(11) && IN(pb + 11)) {
            pg8::SchedPlain S; S.init(MX / 256, 8, F.G, F.bid); S.A = (const char*)(ws + WS_ACT); S.B = (const char*)(ws + WS_WDN); S.aTile = (size_t)256 * FFH * 2; S.bTile = (size_t)256 * FFH * 2;
            pg8::EpiResid E{(float*)(ws + WS_XRES), modl, 10240};
            pg8::gemm_phase(F.lds, FFH, FFH, FFH / 64, S, E);
            if (ctx_on) { pg8::SchedSplit S2{(const char*)(ws + WS_ACT), (const char*)(ws + WS_WDN), (size_t)256 * FFH * 2, (size_t)256 * FFH * 2, (size_t)8 * 128, 11, F.G, F.bid};
                pg8::EpiSlab E2{(float*)(ws + WS_SLAB), modl, 10240};
                pg8::gemm_phase(F.lds, FFH, FFH, 8, S2, E2); }
        }
        SEAM(pb + 11);
        TSTOP(11);
    }
    if (PH_EN(13) && IN(NPH - 1)) { FRESH(); ph_final_norm(F, args); }
#if STAMP_MASK
    if (blockIdx.x == 0 && threadIdx.x == 0) { const unsigned long long t0 = __builtin_amdgcn_s_memrealtime(); while (__builtin_amdgcn_s_memrealtime() - t0 < (unsigned long long)(STAMP_K) * TS[1]) __builtin_amdgcn_s_sleep(8); }
#endif
#undef IN
#undef SEAM
#undef FRESH
}

extern "C" void kernel_launch(void* const* d_in, const int* in_sizes, int n_in, void* d_out, int out_size, void* d_ws, size_t ws_size, hipStream_t stream) {
    static int grid = 0;
    if (grid == 0) {
        if (n_in != 40 || out_size != MX * D || ws_size < WS_END) { fprintf(stderr, "kernel_launch: unexpected problem (n_in %d out %d ws %zu, need %zu)\n", n_in, out_size, ws_size, (size_t)WS_END); grid = -1; return; }
        int dev = 0, cus = 0, per_cu = 0;
        if (hipGetDevice(&dev) != hipSuccess || hipDeviceGetAttribute(&cus, hipDeviceAttributeMultiprocessorCount, dev) != hipSuccess) { grid = -1; return; }
        if (hipFuncSetAttribute((const void*)mk_fwd, hipFuncAttributeMaxDynamicSharedMemorySize, LDS_BYTES) != hipSuccess) { fprintf(stderr, "kernel_launch: hipFuncSetAttribute failed\n"); grid = -1; return; }
        if (hipOccupancyMaxActiveBlocksPerMultiprocessor(&per_cu, (const void*)mk_fwd, 512, LDS_BYTES) != hipSuccess || per_cu < 1)
            fprintf(stderr, "kernel_launch: occupancy query reports %d\n", per_cu);
        (void)hipGetLastError();
        grid = cus;
    }
    if (grid < 0) return;
    if (hipMemsetAsync((char*)d_ws + WS_CTL, 0, CTL_ZERO_BYTES, stream) != hipSuccess) return;
    Args a{};
    for (int i = 0; i < 40; ++i) a.in[i] = (const float*)d_in[i];
    a.out = (float*)d_out; a.ws = (unsigned char*)d_ws;
#if MK_ONE
    a.ph_lo = 0; a.ph_hi = NPH;
    hipLaunchKernelGGL(mk_fwd, dim3(grid), dim3(512), LDS_BYTES, stream, a);
#else
    for (int p = 0; p < NPH; ++p) { a.ph_lo = p; a.ph_hi = p + 1; hipLaunchKernelGGL(mk_fwd, dim3(grid), dim3(512), LDS_BYTES, stream, a); }
#endif
}
```

```cpp
#include <hip/hip_runtime.h>
#include <stdio.h>

#ifndef MK_ONE
#define MK_ONE 1
#define STAMP_MASK 0
#define STAMP_K 1
#endif

#define GAS __attribute__((address_space(1)))
#define LAS __attribute__((address_space(3)))
typedef _Float16 f16;
typedef _Float16 f16x8 __attribute__((ext_vector_type(8)));
typedef _Float16 f16x4 __attribute__((ext_vector_type(4)));
typedef _Float16 f16x2 __attribute__((ext_vector_type(2)));
typedef float f32x4 __attribute__((ext_vector_type(4)));
typedef float f32x2 __attribute__((ext_vector_type(2)));

constexpr int D = 2048, NB = 2, SEQ = 8192, LC = 256, DEPTH = 4;
constexpr int MX = NB * SEQ, MC = NB * LC, MT = MX + MC;
constexpr int PXLD = 11520, FFH = 5632, UPLD = 2 * FFH;
constexpr int P_S5 = 0, P_GK = 512, P_GV = 1024, P_GQ = 2048, P_GR = 2560, P_HY = 3584, P_MG = 5120, P_GG = 11264;
constexpr int INW = 11296;
constexpr int NCHK = 1056;
constexpr float S5SCALE = 1024.f;
constexpr float EPS = 1e-6f;
constexpr int NSC = 33;

constexpr size_t MiB = 1u << 20;
constexpr size_t WS_CTL = 0, CTL_ZERO_BYTES = 1 * MiB;
constexpr size_t WS_MOD = 1 * MiB;
constexpr size_t WS_TW = 2 * MiB;
constexpr size_t WS_S5AT = 3 * MiB;
constexpr size_t WS_WIN = 4 * MiB;
constexpr size_t WS_WGLU = WS_WIN + 45 * MiB;
constexpr size_t WS_WBR = WS_WGLU + 1 * MiB;
constexpr size_t WS_WOUT = WS_WBR + 8 * MiB;
constexpr size_t WS_WUP = WS_WOUT + 8 * MiB;
constexpr size_t WS_WDN = WS_WUP + 44 * MiB;
constexpr size_t WS_S5W = WS_WDN + 22 * MiB;
constexpr size_t WS_S5M = WS_S5W + 8 * MiB;
constexpr size_t WS_H2 = WS_S5M + 4 * MiB;
constexpr size_t WS_FSD = WS_H2 + 3 * MiB;
constexpr size_t FSD_C_OFF = (size_t)2 * 256 * 8193 * 16;
constexpr size_t WS_XRES = WS_FSD + 68 * MiB;
constexpr size_t WS_HN = WS_XRES + 132 * MiB;
constexpr size_t WS_PX = WS_HN + 66 * MiB;
constexpr size_t WS_S5A = WS_PX + 372 * MiB;
constexpr size_t WS_S5S = WS_S5A + 40 * MiB;
constexpr size_t WS_YAPRE = WS_S5S + 40 * MiB;
constexpr size_t WS_YCAT = WS_YAPRE + 20 * MiB;
constexpr size_t WS_MBUF = WS_YCAT + 66 * MiB;
constexpr size_t WS_GSLOC = WS_MBUF + 66 * MiB;
constexpr size_t WS_GSIN = WS_GSLOC + 66 * MiB;
constexpr size_t WS_GOF = WS_GSIN + 66 * MiB;
constexpr size_t WS_GDT = WS_GOF + 66 * MiB;
constexpr size_t WS_ACT = WS_GSLOC;
constexpr size_t WS_ZT = WS_GDT + 1 * MiB;
constexpr size_t WS_YBT = WS_ZT + 50 * MiB;
constexpr size_t WS_SLAB = WS_YBT + 17 * MiB;
constexpr size_t WS_HALO = WS_SLAB + 44 * MiB;
constexpr size_t WS_END = WS_HALO + 9 * MiB;
static_assert((size_t)MT * FFH * 2 <= 198 * MiB, "ACT overlay");
constexpr int CW_BAR = 4096;

constexpr int RING_BYTES = 131072;
constexpr int EXTRA_OFF = RING_BYTES, EXTRA_BYTES = 8192;
constexpr int LDSCTL_OFF = EXTRA_OFF + EXTRA_BYTES;
constexpr int LDS_BYTES = LDSCTL_OFF + 256;

__device__ __forceinline__ float wave_sum(float v) {
#pragma unroll
    for (int o = 1; o < 64; o <<= 1) v += __shfl_xor(v, o);
    return v;
}
__device__ __forceinline__ float sigmoidf_(float x) { return 1.0f / (1.0f + __expf(-x)); }
__device__ __forceinline__ float siluf_(float x) { return x * sigmoidf_(x); }
__device__ __forceinline__ float gelu_tanh_(float x) { const float u = 0.7978845608028654f * (x + 0.044715f * x * x * x); return x / (1.0f + __expf(-2.0f * u)); }
__device__ __forceinline__ float logsigmoidf_(float x) { return fminf(x, 0.f) - __logf(1.0f + __expf(-fabsf(x))); }
__device__ __forceinline__ f32x2 cmul(f32x2 a, f32x2 b) { return (f32x2){a.x * b.x - a.y * b.y, a.x * b.y + a.y * b.x}; }
__device__ __forceinline__ f32x2 cconj(f32x2 a) { return (f32x2){a.x, -a.y}; }
__device__ __forceinline__ int opq(int x) { asm volatile("" : "+v"(x)); return x; }
#define LDS_WAIT() asm volatile("s_waitcnt lgkmcnt(0)" ::: "memory")
#define VM_WAIT() asm volatile("s_waitcnt vmcnt(0)" ::: "memory")

#define XB_TMO      128
#define XB_XCNT(j)  (256  + 64 * (j))
#define XB_XSUB(j)  (1280 + 64 * (j))
#define XB_XGEN(j)  (2304 + 64 * (j))
#define XB_TOP      3328
#define XB_TOPGEN   3392
#define XCD_BAR_WORDS 3456
#define XB_SPIN_CAP (1u << 18)
__device__ __forceinline__ unsigned xb_ld(unsigned* p)              { return __hip_atomic_load(p, __ATOMIC_RELAXED, __HIP_MEMORY_SCOPE_AGENT); }
__device__ __forceinline__ unsigned xb_add(unsigned* p, unsigned v) { return __hip_atomic_fetch_add(p, v, __ATOMIC_RELAXED, __HIP_MEMORY_SCOPE_AGENT); }
__device__ __forceinline__ unsigned xb_xcc_id() { return (unsigned)__builtin_amdgcn_s_getreg((3 << 11) | 20) & 0xFu; }
#define XB_SPIN(cond, bar) do { unsigned _sp = 0; while (cond) { __builtin_amdgcn_s_sleep(1); \
    if ((++_sp & 255u) == 0u) { if (xb_ld(&(bar)[XB_TMO])) break; if (_sp > XB_SPIN_CAP) { atomicAdd(&(bar)[XB_TMO], 1u); break; } } } } while (0)
struct XcdBarrier { unsigned* bar; unsigned x; volatile LAS unsigned* st; };
__device__ __forceinline__ XcdBarrier xcd_barrier_post(unsigned* bar, volatile LAS unsigned* st) {
    XcdBarrier b; b.bar = bar; b.x = xb_xcc_id(); b.st = st;
    if (threadIdx.x == 0) (void)xb_add(&bar[XB_XCNT(b.x)], 1u);
    return b;
}
__device__ __forceinline__ void xcd_barrier_complete(unsigned* bar, unsigned x, unsigned& nloc, unsigned& nx) {
    const unsigned G = gridDim.x * gridDim.y * gridDim.z;
    unsigned sum, cnt, mine, sp = 0u;
    for (;;) {
        sum = 0u; cnt = 0u; mine = 0u;
#pragma unroll
        for (unsigned j = 0; j < 16; ++j) { const unsigned c = xb_ld(&bar[XB_XCNT(j)]); sum += c; cnt += (c > 0u) ? 1u : 0u; mine = (j == x) ? c : mine; }
        if (sum == G) break;
        __builtin_amdgcn_s_sleep(1);
        if ((++sp & 255u) == 0u) { if (xb_ld(&bar[XB_TMO])) break; if (sp > XB_SPIN_CAP) { atomicAdd(&bar[XB_TMO], 1u); break; } }
    }
    nloc = mine > 0u ? mine : 1u; nx = cnt > 0u ? cnt : 1u;
}
__device__ __forceinline__ void xcd_barrier(const XcdBarrier& b) {
    asm volatile("s_waitcnt vmcnt(0)" ::: "memory");
    __syncthreads();
    if (threadIdx.x == 0) {
        unsigned* bar = b.bar;
        __builtin_amdgcn_s_waitcnt(0);
        unsigned nloc = b.st[0], nx = b.st[1];
        if (nloc == 0u) { xcd_barrier_complete(bar, b.x, nloc, nx); b.st[0] = nloc; b.st[1] = nx; }
        const unsigned old = xb_add(&bar[XB_XSUB(b.x)], 1u);
        const unsigned gen = old / nloc;
        if (old + 1u == (gen + 1u) * nloc) {
            __builtin_amdgcn_fence(__ATOMIC_RELEASE, "agent");
            asm volatile("s_waitcnt vmcnt(0)" ::: "memory");
            const unsigned og = xb_add(&bar[XB_TOP], 1u);
            const unsigned tg = og / nx;
            if (og + 1u == (tg + 1u) * nx) xb_add(&bar[XB_TOPGEN], 1u);
            else XB_SPIN(xb_ld(&bar[XB_TOPGEN]) == tg, bar);
            __builtin_amdgcn_fence(__ATOMIC_ACQUIRE, "agent");
            xb_add(&bar[XB_XGEN(b.x)], 1u);
            asm volatile("s_waitcnt vmcnt(0)" ::: "memory");
        } else {
            XB_SPIN(xb_ld(&bar[XB_XGEN(b.x)]) == gen, bar);
            __builtin_amdgcn_fence(__ATOMIC_ACQUIRE, "agent");
            asm volatile("s_waitcnt vmcnt(0)" ::: "memory");
        }
    }
    __syncthreads();
}

struct Args {
    const float* in[40];
    float* out; unsigned char* ws;
    int ph_lo, ph_hi;
};
struct Ctx {
    LAS unsigned char* lds;
    int tid, lane, wave, G, bid;
    unsigned char* ws;
};
enum { I_X = 0, I_C, I_CTX, I_CCTX, I_WMOD, I_BMOD, I_N1G, I_N2G, I_WIN, I_S5ARE, I_S5AIM, I_S5STEP, I_S5BRE, I_S5BIM, I_S5CRE, I_S5CIM,
       I_S5D, I_GLUW, I_GLUB, I_HYCW, I_HYCB, I_HYW1, I_HYB1, I_HYF1, I_HYW2, I_HYB2, I_HYF2, I_HYW3, I_HYB3, I_HYBIAS,
       I_GLAWG, I_GLABG, I_GLANG, I_WBR, I_WOUT, I_WUP, I_FFCW, I_FFCB, I_WDN, I_FNG };

namespace pg8 {
constexpr int BM = 256, BK = 64, HALF = 128, HTB = HALF * BK * 2, STAGE_BYTES = 8 * HTB, NXCD = 8, WGM = 8;
__device__ __forceinline__ int lds_byte(int r, int c) { const int st = (r >> 4) * 2 + (c >> 5), rr = r & 15, cc = c & 31, ob = rr * 64 + cc * 2; return st * 1024 + (ob ^ (((ob >> 9) & 1) << 5)); }
__device__ __forceinline__ void stage_rc(int b, int& R, int& C) { const int st = b / 1024, sb = b % 1024, swz = sb ^ (((sb >> 9) & 1) << 5); R = (st >> 1) * 16 + swz / 64; C = (st & 1) * 32 + (swz % 64) / 2; }
__device__ __forceinline__ int perm32(int rho) { const int n = rho >> 4, i = rho & 15; return 8 * (i >> 2) + 4 * n + (i & 3); }
struct Unit { const char* a; const char* b; int pm, pn; };
struct Order2D {
    int nM, nN, nwg, G, c;
    __device__ __forceinline__ void init(int nM_, int nN_, int G_, int c_) { nM = nM_; nN = nN_; nwg = nM * nN; G = G_; c = c_; }
    __device__ __forceinline__ bool nx(int i, int& pm, int& pn) const {
        const long L = (long)i * G + c; if (L >= nwg) return false;
        int wgid = (int)L; { const int q = nwg / NXCD, r = nwg % NXCD, xcd = wgid % NXCD, off = wgid / NXCD; wgid = (xcd < r ? xcd * (q + 1) : r * (q + 1) + (xcd - r) * q) + off; }
        const int nig = WGM * nN, gid = wgid / nig, fm = gid * WGM, gsz = (nM - fm) < WGM ? (nM - fm) : WGM;
        pm = fm + ((wgid % nig) % gsz); pn = (wgid % nig) / gsz; return true;
    }
};
struct SchedPlain : Order2D {
    const char* A; const char* B; size_t aTile, bTile;
    __device__ __forceinline__ bool next(int i, Unit& u) const { int pm, pn; if (!nx(i, pm, pn)) return false; u.pm = pm; u.pn = pn; u.a = A + (size_t)pm * aTile; u.b = B + (size_t)pn * bTile; return true; }
};
struct SchedSplit {
    const char* A; const char* B; size_t aTile, bTile, ksub; int nsplit, G, c;
    __device__ __forceinline__ bool next(int i, Unit& u) const { const int L = i * G + c; if (L >= 16 * nsplit) return false; const int t = L / nsplit, ks = L % nsplit, pm = 64 + (t >> 3), pn = t & 7;
        u.pm = pm; u.pn = pn | (ks << 8); u.a = A + (size_t)pm * aTile + (size_t)ks * ksub; u.b = B + (size_t)pn * bTile + (size_t)ks * ksub; return true; }
};
struct SchedS5 {
    const char* A; const char* B; size_t bGroup; int G, c;
    __device__ __forceinline__ bool next(int i, Unit& u) const { const int L = i * G + c; if (L >= 160) return false; const int g = L & 31, pm = L >> 5;
        u.pm = pm; u.pn = g; u.a = A + ((size_t)pm * 256 * 16384 + (size_t)g * 512) * 2; u.b = B + (size_t)g * bGroup; return true; }
};

#define PG8_SA(b, h) (((b) * 2 + (h)) * HTB)
#define PG8_SB(b, h) ((4 + (b) * 2 + (h)) * HTB)
#define PG8_STAGE(bufoff, gbase, voff) do { _Pragma("unroll") for (int _i = 0; _i < 2; ++_i) \
        __builtin_amdgcn_global_load_lds((const unsigned*)((const char*)(gbase) + (voff)[_i]), (LAS unsigned*)(lds + (bufoff) + ldsw + _i * 8192), 16, 0, 0); } while (0)
#define PG8_LDA(dst, b, h) do { _Pragma("unroll") for (int m = 0; m < 4; ++m) _Pragma("unroll") for (int k = 0; k < 2; ++k) dst[m][k] = *(const LAS f16x8*)(lds + PG8_SA(b, h) + aoff + m * 2048 + k * 1024); } while (0)
#define PG8_LDB(dst, b, h) do { _Pragma("unroll") for (int n = 0; n < 2; ++n) _Pragma("unroll") for (int k = 0; k < 2; ++k) dst[n][k] = *(const LAS f16x8*)(lds + PG8_SB(b, h) + boff + n * 2048 + k * 1024); } while (0)
#define PG8_MMA(ai, bj, At, Bt) do { __builtin_amdgcn_s_setprio(1); _Pragma("unroll") for (int m = 0; m < 4; ++m) _Pragma("unroll") for (int n = 0; n < 2; ++n) _Pragma("unroll") for (int k = 0; k < 2; ++k) \
        acc[ai][bj][m][n] = __builtin_amdgcn_mfma_f32_16x16x32_f16(Bt[n][k], At[m][k], acc[ai][bj][m][n], 0, 0, 0); __builtin_amdgcn_s_setprio(0); } while (0)
#define PG8_WAIT_V(n) asm volatile("s_waitcnt vmcnt(" #n ")" ::: "memory")
#define PG8_WAIT_L(n) asm volatile("s_waitcnt lgkmcnt(" #n ")" ::: "memory")
#define PG8_BAR __builtin_amdgcn_s_barrier()
#define PG8_SCHED __builtin_amdgcn_sched_barrier(0)

template <class Epi, class Sched>
__device__ __forceinline__ void gemm_phase(LAS unsigned char* lds, const int lda, const int ldb, const int nt, const Sched& S, const Epi& E) {
    const int tid = opq((int)threadIdx.x), wid = __builtin_amdgcn_readfirstlane(tid >> 6), lane = tid & 63, wr = wid >> 2, wc = wid & 3, fr = lane & 15, fq = lane >> 4;
    unsigned voffA[2], voffB[2];
#pragma unroll
    for (int i = 0; i < 2; ++i) { int R, C; stage_rc(tid * 16 + i * 8192, R, C); const int Rb = Epi::PERM ? ((R & ~31) + perm32(R & 31)) : R;
        voffA[i] = (unsigned)(R * lda + C) * 2u; voffB[i] = (unsigned)(Rb * ldb + C) * 2u; }
    const size_t kstep = (size_t)(BK * 2);
    const size_t hstepA = (size_t)HALF * lda * 2, hstepB = (size_t)HALF * ldb * 2;
    const unsigned ldsw = (unsigned)wid * 1024u;
    const int aoff = lds_byte(wr * 64 + fr, fq * 8), boff = lds_byte(wc * 32 + fr, fq * 8);
    Unit cur, nxt; int ui = 0;
    if (!S.next(0, cur)) return;
    f32x4 acc[2][2][4][2];
#pragma unroll
    for (int a = 0; a < 2; ++a)
#pragma unroll
        for (int b = 0; b < 2; ++b)
#pragma unroll
            for (int m = 0; m < 4; ++m)
#pragma unroll
                for (int n = 0; n < 2; ++n) acc[a][b][m][n] = (f32x4){0.f, 0.f, 0.f, 0.f};
    f16x8 At[4][2], B0[2][2], B1[2][2];
    const char* cA = cur.a; const char* cB = cur.b;
    PG8_STAGE(PG8_SB(0, 0), cB, voffB); PG8_STAGE(PG8_SA(0, 0), cA, voffA); PG8_STAGE(PG8_SB(0, 1), cB + hstepB, voffB); PG8_STAGE(PG8_SA(0, 1), cA + hstepA, voffA);
    if (wr == 1) PG8_BAR;
    PG8_WAIT_V(4); PG8_BAR;
    PG8_STAGE(PG8_SB(1, 0), cB + kstep, voffB); PG8_STAGE(PG8_SA(1, 0), cA + kstep, voffA); PG8_STAGE(PG8_SB(1, 1), cB + hstepB + kstep, voffB);
    PG8_WAIT_V(6); PG8_BAR;
    for (;;) {
        const bool has_next = S.next(ui + 1, nxt);
        const char* nA = has_next ? nxt.a : cA; const char* nB = has_next ? nxt.b : cB;
        for (int t = 0; t < nt; t += 2) {
            const bool last = (t == nt - 2);
            const char* a1 = cA + (size_t)(t + 1) * kstep;
            const char* a2 = last ? nA : cA + (size_t)(t + 2) * kstep; const char* b2 = last ? nB : cB + (size_t)(t + 2) * kstep;
            const char* a3 = a2 + kstep; const char* b3 = b2 + kstep;
            PG8_LDB(B0, 0, 0); PG8_SCHED; PG8_LDA(At, 0, 0); PG8_STAGE(PG8_SA(1, 1), a1 + hstepA, voffA);
            PG8_WAIT_L(8); PG8_BAR; PG8_WAIT_L(0); PG8_MMA(0, 0, At, B0); PG8_BAR; PG8_SCHED;
            PG8_LDB(B1, 0, 1); PG8_STAGE(PG8_SB(0, 0), b2, voffB);
            PG8_BAR; PG8_WAIT_L(0); PG8_MMA(0, 1, At, B1); PG8_BAR;
            PG8_LDA(At, 0, 1); PG8_STAGE(PG8_SA(0, 0), a2, voffA);
            PG8_BAR; PG8_WAIT_L(0); PG8_MMA(1, 0, At, B0); PG8_BAR; PG8_SCHED;
            PG8_STAGE(PG8_SB(0, 1), b2 + hstepB, voffB);
            PG8_WAIT_V(6); PG8_BAR; PG8_MMA(1, 1, At, B1); PG8_BAR;
            PG8_LDB(B0, 1, 0); PG8_SCHED; PG8_LDA(At, 1, 0); PG8_STAGE(PG8_SA(0, 1), a2 + hstepA, voffA);
            PG8_WAIT_L(8); PG8_BAR; PG8_WAIT_L(0); PG8_MMA(0, 0, At, B0); PG8_BAR; PG8_SCHED;
            PG8_LDB(B1, 1, 1); PG8_STAGE(PG8_SB(1, 0), b3, voffB);
            PG8_BAR; PG8_WAIT_L(0); PG8_MMA(0, 1, At, B1); PG8_BAR;
            PG8_LDA(At, 1, 1); PG8_STAGE(PG8_SA(1, 0), a3, voffA);
            PG8_BAR; PG8_WAIT_L(0); PG8_MMA(1, 0, At, B0); PG8_BAR; PG8_SCHED;
            PG8_STAGE(PG8_SB(1, 1), b3 + hstepB, voffB);
            PG8_WAIT_V(6); PG8_BAR; PG8_MMA(1, 1, At, B1); PG8_BAR;
        }
        E(acc, cur, wr, wc, fr, fq);
        if (!has_next) break;
#pragma unroll
        for (int a = 0; a < 2; ++a)
#pragma unroll
            for (int b = 0; b < 2; ++b)
#pragma unroll
                for (int m = 0; m < 4; ++m)
#pragma unroll
                    for (int n = 0; n < 2; ++n) acc[a][b][m][n] = (f32x4){0.f, 0.f, 0.f, 0.f};
        cur = nxt; cA = nA; cB = nB; ++ui;
    }
    PG8_WAIT_V(0);
    if (wr == 0) PG8_BAR;
    PG8_BAR;
}
#undef PG8_SA
#undef PG8_SB
#undef PG8_STAGE
#undef PG8_LDA
#undef PG8_LDB
#undef PG8_MMA
#undef PG8_WAIT_V
#undef PG8_WAIT_L
#undef PG8_BAR
#undef PG8_SCHED

typedef const f32x4 (&AccRef)[2][2][4][2];
__device__ __forceinline__ f16x8 pack8(f32x4 a, f32x4 b) { f16x8 w; w[0] = (f16)a[0]; w[1] = (f16)a[1]; w[2] = (f16)a[2]; w[3] = (f16)a[3]; w[4] = (f16)b[0]; w[5] = (f16)b[1]; w[6] = (f16)b[2]; w[7] = (f16)b[3]; return w; }

struct EpiPx {
    static constexpr bool PERM = true; f16* PX; f16* S5A; f16* ZT;
    __device__ __forceinline__ void operator()(AccRef acc, const Unit& u, int wr, int wc, int fr, int fq) const { fr = opq(fr); fq = opq(fq);
        const int row0 = u.pm * BM + wr * 64 + fr, col0 = u.pn * BM + wc * 32 + 8 * fq;
#pragma unroll
        for (int ai = 0; ai < 2; ++ai)
#pragma unroll
            for (int m = 0; m < 4; ++m) { const int row = row0 + ai * HALF + m * 16;
#pragma unroll
                for (int bj = 0; bj < 2; ++bj) { const int c = col0 + bj * HALF; const f16x8 w = pack8(acc[ai][bj][m][0], acc[ai][bj][m][1]);
                    if (u.pn < 2) *(f16x8*)(S5A + (size_t)(row >> 4) * 16384 + (size_t)(c >> 4) * 512 + (row & 15) * 16 + (c & 15)) = w;
                    else if (u.pn >= 14 && u.pn < 20) {
#pragma unroll
                        for (int j = 0; j < 8; ++j) ZT[(size_t)(c - P_HY + j) * MT + row] = w[j]; }
                    else *(f16x8*)(PX + (size_t)row * PXLD + c) = w; } }
    }
};
struct EpiF16 {
    static constexpr bool PERM = true; f16* O; int ldc;
    __device__ __forceinline__ void operator()(AccRef acc, const Unit& u, int wr, int wc, int fr, int fq) const { fr = opq(fr); fq = opq(fq);
        const int row0 = u.pm * BM + wr * 64 + fr, col0 = u.pn * BM + wc * 32 + 8 * fq;
#pragma unroll
        for (int ai = 0; ai < 2; ++ai)
#pragma unroll
            for (int m = 0; m < 4; ++m) { f16* rowp = O + (size_t)(row0 + ai * HALF + m * 16) * ldc + col0;
#pragma unroll
                for (int bj = 0; bj < 2; ++bj) *(f16x8*)(rowp + bj * HALF) = pack8(acc[ai][bj][m][0], acc[ai][bj][m][1]); }
    }
};
struct EpiS5In {
    static constexpr bool PERM = false; float* S;
    __device__ __forceinline__ void operator()(AccRef acc, const Unit& u, int wr, int wc, int fr, int fq) const { fr = opq(fr); fq = opq(fq);
        const int row0 = u.pm * BM + wr * 64 + fr, col0 = wc * 32 + 4 * fq, g = u.pn;
#pragma unroll
        for (int ai = 0; ai < 2; ++ai)
#pragma unroll
            for (int m = 0; m < 4; ++m) { const int row = row0 + ai * HALF + m * 16; { float* rowp = S + ((size_t)row * 32 + g) * 256 + col0;
#pragma unroll
                for (int bj = 0; bj < 2; ++bj)
#pragma unroll
                    for (int n = 0; n < 2; ++n) *(f32x4*)(rowp + bj * HALF + n * 16) = acc[ai][bj][m][n]; } }
    }
};
struct EpiS5Out {
    static constexpr bool PERM = true; const f16* S5A; f16* Y; const float* dvec;
    __device__ __forceinline__ void operator()(AccRef acc, const Unit& u, int wr, int wc, int fr, int fq) const { fr = opq(fr); fq = opq(fq);
        const int row0 = u.pm * BM + wr * 64 + fr, col0 = wc * 32 + 8 * fq, g = u.pn;
#pragma unroll
        for (int ai = 0; ai < 2; ++ai)
#pragma unroll
            for (int m = 0; m < 4; ++m) { const int chunk = row0 + ai * HALF + m * 16; {
#pragma unroll
                for (int bj = 0; bj < 2; ++bj) { const int c = col0 + bj * HALF, t = c >> 4, h0 = c & 15;
                    const f16x8 uu = *(const f16x8*)(S5A + (size_t)chunk * 16384 + (size_t)g * 512 + c);
                    const f32x4 d0 = *(const f32x4*)(dvec + g * 16 + h0), d1 = *(const f32x4*)(dvec + g * 16 + h0 + 4);
                    f16x8 w;
#pragma unroll
                    for (int j = 0; j < 4; ++j) { w[j] = (f16)gelu_tanh_(acc[ai][bj][m][0][j] * (1.0f / S5SCALE) + d0[j] * (float)uu[j]);
                                                  w[4 + j] = (f16)gelu_tanh_(acc[ai][bj][m][1][j] * (1.0f / S5SCALE) + d1[j] * (float)uu[4 + j]); }
                    *(f16x8*)(Y + (size_t)(chunk * 16 + t) * 512 + g * 16 + h0) = w; } asm volatile("" ::: "memory"); } }
    }
};
struct EpiGlu {
    static constexpr bool PERM = true; const f16* YP; f16* O; const float* bias;
    __device__ __forceinline__ void operator()(AccRef acc, const Unit& u, int wr, int wc, int fr, int fq) const { fr = opq(fr); fq = opq(fq);
        const int row0 = u.pm * BM + wr * 64 + fr, col0 = u.pn * BM + wc * 32 + 8 * fq;
#pragma unroll
        for (int ai = 0; ai < 2; ++ai)
#pragma unroll
            for (int m = 0; m < 4; ++m) { const int row = row0 + ai * HALF + m * 16;
#pragma unroll
                for (int bj = 0; bj < 2; ++bj) { const int c = col0 + bj * HALF;
                    const f16x8 yp = *(const f16x8*)(YP + (size_t)row * 512 + c);
                    const f32x4 b0 = *(const f32x4*)(bias + c), b1 = *(const f32x4*)(bias + c + 4);
                    f16x8 w;
#pragma unroll
                    for (int j = 0; j < 4; ++j) { w[j] = (f16)((float)yp[j] * sigmoidf_(acc[ai][bj][m][0][j] + b0[j])); w[4 + j] = (f16)((float)yp[4 + j] * sigmoidf_(acc[ai][bj][m][1][j] + b1[j])); }
                    *(f16x8*)(O + (size_t)row * 2048 + c) = w; } asm volatile("" ::: "memory"); }
    }
};
template <int BR> struct EpiBranch {
    static constexpr bool PERM = true; const f16* PX; f16* M;
    __device__ __forceinline__ void operator()(AccRef acc, const Unit& u, int wr, int wc, int fr, int fq) const { fr = opq(fr); fq = opq(fq);
        const int row0 = u.pm * BM + wr * 64 + fr, col0 = u.pn * BM + wc * 32 + 8 * fq;
#pragma unroll
        for (int ai = 0; ai < 2; ++ai)
#pragma unroll
            for (int m = 0; m < 4; ++m) { const int row = row0 + ai * HALF + m * 16;
#pragma unroll
                for (int bj = 0; bj < 2; ++bj) { const int c = col0 + bj * HALF;
                    const f16x8 gl = *(const f16x8*)(PX + (size_t)row * PXLD + P_MG + BR * 2048 + c);
                    f16* mp = M + (size_t)row * 2048 + c;
                    f16x8 prev; if (BR > 0) prev = *(const f16x8*)mp;
                    f16x8 w;
#pragma unroll
                    for (int j = 0; j < 4; ++j) { float v0 = sigmoidf_((float)gl[j]) * acc[ai][bj][m][0][j], v1 = sigmoidf_((float)gl[4 + j]) * acc[ai][bj][m][1][j];
                        if (BR > 0) { v0 += (float)prev[j]; v1 += (float)prev[4 + j]; } w[j] = (f16)v0; w[4 + j] = (f16)v1; }
                    *(f16x8*)mp = w; } asm volatile("" ::: "memory"); }
    }
};
struct EpiUpAct {
    static constexpr bool PERM = true; f16* ACT; float* HALO; const float* cw; const float* cb; LAS float* HL;
    __device__ __forceinline__ void operator()(AccRef acc, const Unit& u, int wr, int wc, int fr, int fq) const { fr = opq(fr); fq = opq(fq);
        const int lane = fq * 16 + fr;
#pragma unroll
        for (int ai = 0; ai < 2; ++ai) { LAS float* hp = HL + ((ai * 2 + wr) * 4 + wc) * 64 + 8 * fq;
            if (fr == 0) { *(LAS f32x4*)(hp) = acc[ai][0][0][0]; *(LAS f32x4*)(hp + 4) = acc[ai][0][0][1]; }
            if (fr == 15) { *(LAS f32x4*)(hp + 32) = acc[ai][0][3][0]; *(LAS f32x4*)(hp + 36) = acc[ai][0][3][1]; } }
        { float* gh = HALO + ((size_t)u.pm * 44 + u.pn) * 768 + wc * 32 + 8 * fq;
          if (wr == 0 && fr < 2) { *(f32x4*)(gh + fr * 128) = acc[0][0][0][0]; *(f32x4*)(gh + fr * 128 + 4) = acc[0][0][0][1]; }
          if (wr == 0 && fr == 0) { *(f32x4*)(gh + 4 * 128) = acc[0][1][0][0]; *(f32x4*)(gh + 4 * 128 + 4) = acc[0][1][0][1]; }
          if (wr == 1 && fr >= 14) { *(f32x4*)(gh + (fr - 12) * 128) = acc[1][0][3][0]; *(f32x4*)(gh + (fr - 12) * 128 + 4) = acc[1][0][3][1]; }
          if (wr == 1 && fr == 15) { *(f32x4*)(gh + 5 * 128) = acc[1][1][3][0]; *(f32x4*)(gh + 5 * 128 + 4) = acc[1][1][3][1]; } }
        asm volatile("s_waitcnt lgkmcnt(0)" ::: "memory"); __builtin_amdgcn_s_barrier(); __builtin_amdgcn_s_barrier(); asm volatile("" ::: "memory");
        const int colg = u.pn * 128 + wc * 32 + 8 * fq;
        const int srcR = (lane & 48) | ((fr + 15) & 15), srcL = (lane & 48) | ((fr + 1) & 15);
        const int row0 = u.pm * BM + wr * 64 + fr;
#pragma unroll
        for (int n = 0; n < 2; ++n) {
            const f32x4 w0 = *(const f32x4*)(cw + colg + 4 * n), w1 = *(const f32x4*)(cw + FFH + colg + 4 * n), w2 = *(const f32x4*)(cw + 2 * FFH + colg + 4 * n), bb = *(const f32x4*)(cb + colg + 4 * n);
#pragma unroll
            for (int ai = 0; ai < 2; ++ai) {
                const bool hasp = (wr == 1) || (ai == 1), hasn = (wr == 0) || (ai == 0);
                const LAS float* pp = HL + (((wr == 1 ? ai : 0) * 2 + (wr == 1 ? 0 : 1)) * 4 + wc) * 64 + 32 + 8 * fq + 4 * n;
                const LAS float* np = HL + (((wr == 0 ? ai : 1) * 2 + (wr == 0 ? 1 : 0)) * 4 + wc) * 64 + 8 * fq + 4 * n;
                const f32x4 hprev = hasp ? *(const LAS f32x4*)pp : (f32x4){0.f, 0.f, 0.f, 0.f}, hnext = hasn ? *(const LAS f32x4*)np : (f32x4){0.f, 0.f, 0.f, 0.f};
                f32x4 R[4], L[4];
#pragma unroll
                for (int m = 0; m < 4; ++m)
#pragma unroll
                    for (int j = 0; j < 4; ++j) { R[m][j] = __shfl(acc[ai][0][m][n][j], srcR); L[m][j] = __shfl(acc[ai][0][m][n][j], srcL); }
#pragma unroll
                for (int m = 0; m < 4; ++m) { const f32x4 pv = fr > 0 ? R[m] : (m > 0 ? R[m > 0 ? m - 1 : 0] : hprev); const f32x4 nv = fr < 15 ? L[m] : (m < 3 ? L[m < 3 ? m + 1 : 3] : hnext);
                    const f32x4 a = w0 * pv + w1 * acc[ai][0][m][n] + w2 * nv + bb;
                    f16x4 o;
#pragma unroll
                    for (int j = 0; j < 4; ++j) o[j] = (f16)(siluf_(a[j]) * acc[ai][1][m][n][j]);
                    *(f16x4*)(ACT + (size_t)(row0 + ai * HALF + m * 16) * FFH + colg + 4 * n) = o; }
                asm volatile("" ::: "memory");
            }
        }
    }
};
struct EpiSlab {
    static constexpr bool PERM = false; float* slab; const float* mod; int goff;
    __device__ __forceinline__ void operator()(AccRef acc, const Unit& u, int wr, int wc, int fr, int fq) const { fr = opq(fr); fq = opq(fq);
        const int pn = u.pn & 255, ks = u.pn >> 8;
        const int row0 = (u.pm - 64) * BM + wr * 64 + fr, col0 = pn * BM + wc * 32 + 4 * fq;
        const float* gp = mod + 2 * 12288 + goff + col0;
        f32x4 gv[2][2];
#pragma unroll
        for (int bj = 0; bj < 2; ++bj)
#pragma unroll
            for (int n = 0; n < 2; ++n) gv[bj][n] = *(const f32x4*)(gp + bj * HALF + n * 16);
        float* sp = slab + (size_t)ks * MC * D;
#pragma unroll
        for (int ai = 0; ai < 2; ++ai)
#pragma unroll
            for (int m = 0; m < 4; ++m) { float* rowp = sp + (size_t)(row0 + ai * HALF + m * 16) * D + col0;
#pragma unroll
                for (int bj = 0; bj < 2; ++bj)
#pragma unroll
                    for (int n = 0; n < 2; ++n) *(f32x4*)(rowp + bj * HALF + n * 16) = gv[bj][n] * acc[ai][bj][m][n]; }
    }
};
struct EpiResid {
    static constexpr bool PERM = false; float* X; const float* mod; int goff;
    __device__ __forceinline__ void operator()(AccRef acc, const Unit& u, int wr, int wc, int fr, int fq) const { fr = opq(fr); fq = opq(fq);
        const int row0 = u.pm * BM + wr * 64 + fr, col0 = u.pn * BM + wc * 32 + 4 * fq;
        const int bsel = u.pm < 32 ? 0 : (u.pm < 64 ? 1 : 2);
        const float* gp = mod + bsel * 12288 + goff + col0;
        f32x4 gv[2][2];
#pragma unroll
        for (int bj = 0; bj < 2; ++bj)
#pragma unroll
            for (int n = 0; n < 2; ++n) gv[bj][n] = *(const f32x4*)(gp + bj * HALF + n * 16);
#pragma unroll
        for (int ai = 0; ai < 2; ++ai)
#pragma unroll
            for (int m = 0; m < 4; ++m) { float* rowp = X + (size_t)(row0 + ai * HALF + m * 16) * D + col0;
#pragma unroll
                for (int bj = 0; bj < 2; ++bj)
#pragma unroll
                    for (int n = 0; n < 2; ++n) { f32x4* p = (f32x4*)(rowp + bj * HALF + n * 16); *p = *p + gv[bj][n] * acc[ai][bj][m][n]; } asm volatile("" ::: "memory"); }
    }
};
}


__device__ __forceinline__ void ph_prologue(const Ctx& F, const Args& A) {
    const int gt = F.bid * 512 + F.tid, NT = F.G * 512;
    { const f32x4* xs = (const f32x4*)A.in[I_X]; const f32x4* cs = (const f32x4*)A.in[I_CTX]; f32x4* xr = (f32x4*)(F.ws + WS_XRES);
      for (int i = gt; i < MX * D / 4; i += NT) xr[i] = xs[i];
      for (int i = gt; i < MC * D / 4; i += NT) xr[MX * D / 4 + i] = cs[i]; }
    { f32x2* tw = (f32x2*)(F.ws + WS_TW);
      for (int k = gt; k < 16384; k += NT) { float s, c; sincospif((float)k * (2.0f / 16384.0f), &s, &c); tw[k] = (f32x2){c, -s}; } }
    LAS float* sc = (LAS float*)F.lds;
    LAS float* red = (LAS float*)(F.lds + 3 * 2048 * 4);
    for (int i = F.tid; i < 3 * 2048; i += 512) { const int r = i / 2048, k = i % 2048; const float v = r < 2 ? A.in[I_C][r * 2048 + k] : A.in[I_CCTX][k]; sc[i] = siluf_(v); }
    __syncthreads();
    const int col = F.tid & 63, ks = F.tid >> 6;
    for (int chunk = F.bid; chunk < DEPTH * 192; chunk += F.G) {
        const int l = chunk / 192, n0 = (chunk % 192) * 64;
        const float* w = A.in[I_WMOD] + (size_t)l * 2048 * 12288 + n0 + col;
        float s0 = 0.f, s1 = 0.f, s2 = 0.f;
#pragma unroll 8
        for (int k = ks * 256; k < ks * 256 + 256; ++k) { const float wv = w[(size_t)k * 12288]; s0 += sc[k] * wv; s1 += sc[2048 + k] * wv; s2 += sc[4096 + k] * wv; }
        red[(ks * 3 + 0) * 64 + col] = s0; red[(ks * 3 + 1) * 64 + col] = s1; red[(ks * 3 + 2) * 64 + col] = s2;
        __syncthreads();
        if (F.tid < 192) { const int r = F.tid >> 6, c2 = F.tid & 63; float s = 0.f;
#pragma unroll
            for (int q = 0; q < 8; ++q) s += red[(q * 3 + r) * 64 + c2];
            ((float*)(F.ws + WS_MOD))[((size_t)l * 3 + r) * 12288 + n0 + c2] = s + A.in[I_BMOD][(size_t)l * 12288 + n0 + c2]; }
        __syncthreads();
    }
}

__device__ __forceinline__ void conv_item(const float* W, int ldw, int k0, int srccol, f16* WT, int dstrow, int ldk) {
    float v[64];
    const float* src = W + (size_t)k0 * ldw + (srccol >= 0 ? srccol : 0);
#pragma unroll
    for (int k = 0; k < 64; ++k) v[k] = src[(size_t)k * ldw];
    f16* dst = WT + (size_t)dstrow * ldk + k0;
#pragma unroll
    for (int kg = 0; kg < 8; ++kg) { f16x8 o;
#pragma unroll
        for (int e = 0; e < 8; ++e) o[e] = srccol >= 0 ? (f16)v[8 * kg + e] : (f16)0.f;
        *(f16x8*)(dst + 8 * kg) = o; }
}
__device__ __forceinline__ void ph_convert_weights(const Ctx& F, const Args& A, int l) {
    const int skip = F.G > 64 ? 32 : 0;
    if (F.bid < skip) return;
    const int gw = (F.bid - skip) * 8 + F.wave, NGW = (F.G - skip) * 8, lane = F.lane;
    constexpr int I_IN = 32 * 180, I_GLU = 8 * 8, I_BR = 32 * 32, I_OUT = 32 * 32, I_UP = 32 * 176, I_DN = 88 * 32;
    constexpr int NIT = I_IN + I_GLU + I_BR + I_OUT + I_UP + I_DN;
    for (int it = gw; it < NIT; it += NGW) {
        int r = it;
        if (r < I_IN) { const int kb = r / 180, nb = r % 180, j = nb * 64 + lane;
            const int src = j < 2048 ? j : (j < 11264 ? j + 32 : (j < 11296 ? 2048 + (j - 11264) : -1));
            conv_item(A.in[I_WIN] + (size_t)l * 2048 * INW, INW, kb * 64, src, (f16*)(F.ws + WS_WIN), j, 2048); continue; } r -= I_IN;
        if (r < I_GLU) { const int kb = r / 8, nb = r % 8, j = nb * 64 + lane; conv_item(A.in[I_GLUW] + (size_t)l * 512 * 512, 512, kb * 64, j, (f16*)(F.ws + WS_WGLU), j, 512); continue; } r -= I_GLU;
        if (r < I_BR) { const int kb = r / 32, nb = r % 32, j = nb * 64 + lane; conv_item(A.in[I_WBR] + (size_t)l * 2048 * 2048, 2048, kb * 64, j, (f16*)(F.ws + WS_WBR), j, 2048); continue; } r -= I_BR;
        if (r < I_OUT) { const int kb = r / 32, nb = r % 32, j = nb * 64 + lane; conv_item(A.in[I_WOUT] + (size_t)l * 2048 * 2048, 2048, kb * 64, j, (f16*)(F.ws + WS_WOUT), j, 2048); continue; } r -= I_OUT;
        if (r < I_UP) { const int kb = r / 176, nb = r % 176, j = nb * 64 + lane, pn = j >> 8, i = j & 255; const int src = i < 128 ? 128 * pn + i : FFH + 128 * pn + (i - 128);
            conv_item(A.in[I_WUP] + (size_t)l * 2048 * UPLD, UPLD, kb * 64, src, (f16*)(F.ws + WS_WUP), j, 2048); continue; } r -= I_UP;
        { const int kb = r / 32, nb = r % 32, j = nb * 64 + lane; conv_item(A.in[I_WDN] + (size_t)l * FFH * 2048, 2048, kb * 64, j, (f16*)(F.ws + WS_WDN), j, FFH); }
    }
}

__device__ __forceinline__ void s5_mats_group(const Ctx& F, const Args& A, int l, int g) {
    LAS f32x2* APOW = (LAS f32x2*)F.lds;
    LAS f32x2* BBAR = APOW + 2 * 17 * 64;
    LAS f32x2* CM = BBAR + 2 * 64 * 16;
    LAS float* KLAG = (LAS float*)(CM + 2 * 16 * 64);
    __syncthreads();
    for (int i = F.tid; i < 2 * 17 * 64; i += 512) { const int d = i / (17 * 64), e = (i / 64) % 17, n = i % 64;
        const size_t pi = (((size_t)l * 2 + d) * 32 + g) * 64 + n;
        const float are = A.in[I_S5ARE][pi], aim = A.in[I_S5AIM][pi], dt = expf(A.in[I_S5STEP][((size_t)l * 2 + d) * 32 + g]);
        const float zr = are * dt * (float)e, zi = aim * dt * (float)e; float s, c; sincosf(zi, &s, &c); const float m = expf(zr);
        APOW[i] = (f32x2){m * c, m * s}; }
    __syncthreads();
    for (int i = F.tid; i < 2 * 64 * 16; i += 512) { const int d = i / 1024, n = (i / 16) % 64, h = i % 16;
        const size_t pi = (((size_t)l * 2 + d) * 32 + g) * 64 + n;
        const float are = A.in[I_S5ARE][pi], aim = A.in[I_S5AIM][pi];
        const f32x2 ab = APOW[(d * 17 + 1) * 64 + n]; const f32x2 num = (f32x2){ab.x - 1.0f, ab.y};
        const float den = are * are + aim * aim; const f32x2 q = (f32x2){(num.x * are + num.y * aim) / den, (num.y * are - num.x * aim) / den};
        const size_t bi = (pi * 16) + h;
        BBAR[i] = cmul(q, (f32x2){A.in[I_S5BRE][bi], A.in[I_S5BIM][bi]});
        const size_t ci = ((((size_t)l * 2 + d) * 32 + g) * 16 + h) * 64 + n;
        CM[(d * 16 + h) * 64 + n] = (f32x2){A.in[I_S5CRE][ci], A.in[I_S5CIM][ci]}; }
    __syncthreads();
    for (int i = F.tid; i < 2 * 16 * 256; i += 512) { const int d = i / 4096, lag = (i / 256) % 16, h = (i / 16) % 16, hp = i % 16; float s = 0.f;
        for (int n = 0; n < 64; ++n) { const f32x2 t = cmul(CM[(d * 16 + h) * 64 + n], APOW[(d * 17 + lag) * 64 + n]); const f32x2 b = BBAR[(d * 64 + n) * 16 + hp]; s += t.x * b.x - t.y * b.y; }
        KLAG[i] = s; }
    __syncthreads();
    f16* W = (f16*)(F.ws + WS_S5W) + (size_t)g * 256 * 512;
    for (int i = F.tid; i < 256 * 64; i += 512) { const int n = i / 64, k8 = (i % 64) * 8, t = n >> 4, h = n & 15; f16x8 o;
#pragma unroll
        for (int e = 0; e < 8; ++e) { const int k = k8 + e; float v;
            if (k < 256) { const int s = k >> 4, hp = k & 15; v = 0.f;
                if (t >= s) v += KLAG[((0 * 16 + (t - s)) * 16 + h) * 16 + hp];
                if (s >= t) v += KLAG[((1 * 16 + (s - t)) * 16 + h) * 16 + hp];
                v *= S5SCALE; }
            else { const int d = (k - 256) >> 7, nn2 = (k - 256) & 127, nn = nn2 & 63, im = nn2 >> 6, ex = d == 0 ? t + 1 : 16 - t;
                const f32x2 z = cmul(CM[(d * 16 + h) * 64 + nn], APOW[(d * 17 + ex) * 64 + nn]); v = im ? -z.y : z.x; }
            o[e] = (f16)v; }
        *(f16x8*)(W + (size_t)n * 512 + k8) = o; }
    f16* Mx = (f16*)(F.ws + WS_S5M) + (size_t)g * 256 * 256;
    for (int i = F.tid; i < 256 * 32; i += 512) { const int n = i / 32, k8 = (i % 32) * 8, d = n >> 7, ri = (n >> 6) & 1, nn = n & 63; f16x8 o;
#pragma unroll
        for (int e = 0; e < 8; ++e) { const int k = k8 + e, s = k >> 4, hp = k & 15, ex = d == 0 ? 15 - s : s;
            const f32x2 z = cmul(APOW[(d * 17 + ex) * 64 + nn], BBAR[(d * 64 + nn) * 16 + hp]); o[e] = (f16)((ri ? z.y : z.x) * S5SCALE); }
        *(f16x8*)(Mx + (size_t)n * 256 + k8) = o; }
    if (F.tid < 128) { const int d = F.tid >> 6, nn = F.tid & 63; ((f32x2*)(F.ws + WS_S5AT))[(d * 32 + g) * 64 + nn] = APOW[(d * 17 + 16) * 64 + nn]; }
    __syncthreads();
}

__device__ __forceinline__ void ph_hyena_h2(const Ctx& F, const Args& A, int l) {
    LAS float* W1 = (LAS float*)F.lds;
    LAS float* W2 = W1 + 33 * 64;
    LAS float* PV = W2 + 64 * 64;
    LAS float* SCR = PV + 256;
    __syncthreads();
    for (int i = F.tid; i < 33 * 64; i += 512) W1[i] = A.in[I_HYW1][(size_t)l * 33 * 64 + i];
    for (int i = F.tid; i < 64 * 64; i += 512) W2[i] = A.in[I_HYW2][(size_t)l * 4096 + i];
    if (F.tid < 64) { PV[F.tid] = A.in[I_HYB1][l * 64 + F.tid]; PV[64 + F.tid] = A.in[I_HYF1][l * 64 + F.tid]; PV[128 + F.tid] = A.in[I_HYB2][l * 64 + F.tid]; PV[192 + F.tid] = A.in[I_HYF2][l * 64 + F.tid]; }
    __syncthreads();
    LAS float* scr = SCR + F.wave * 64;
    const int gw = F.bid * 8 + F.wave, NGW = F.G * 8, j = F.lane;
    float* H2 = (float*)(F.ws + WS_H2);
    for (int p = gw; p < SEQ + LC; p += NGW) {
        const int n = p < SEQ ? SEQ : LC, pos = p < SEQ ? p : p - SEQ;
        float feat = 0.f;
        if (j == 0) feat = (float)pos / (float)(n - 1);
        else if (j < 33) { const int fi = (j - 1) & 15; const float fr = 1e-4f + (float)fi * ((15.0f - 1e-4f) / 15.0f);
            const float ang = (6.283185307179586f / (float)n) * (float)pos * fr; float s, c; sincosf(ang, &s, &c); feat = j < 17 ? c : -s; }
        scr[j] = feat; LDS_WAIT(); asm volatile("" ::: "memory");
        float a = PV[j];
        for (int i = 0; i < 33; ++i) a += scr[i] * W1[i * 64 + j];
        const float h1 = sinf(PV[64 + j] * a);
        LDS_WAIT(); asm volatile("" ::: "memory");
        scr[j] = h1; LDS_WAIT(); asm volatile("" ::: "memory");
        float b = PV[128 + j];
        for (int i = 0; i < 64; ++i) b += scr[i] * W2[i * 64 + j];
        H2[(size_t)p * 64 + j] = sinf(PV[192 + j] * b);
        LDS_WAIT(); asm volatile("" ::: "memory");
    }
}

__device__ __forceinline__ void ph_norm(const Ctx& F, const Args& A, int l, int which, int nrows, int nslab) {
    const int gw = F.bid * 8 + F.wave, NGW = F.G * 8;
    float* X = (float*)(F.ws + WS_XRES); f16* O = (f16*)(F.ws + WS_HN); const float* SL = (const float*)(F.ws + WS_SLAB);
    const float* gain = A.in[which ? I_N2G : I_N1G] + (size_t)l * D;
    const float* mod = (const float*)(F.ws + WS_MOD) + (size_t)l * 3 * 12288;
    const int shoff = which ? 6144 : 0, soff = which ? 8192 : 2048;
    for (int m = gw; m < nrows; m += NGW) {
        const int bsel = m < SEQ ? 0 : (m < MX ? 1 : 2);
        f32x4* xr = (f32x4*)(X + (size_t)m * D) + F.lane;
        f32x4 v[8]; float s = 0.f;
#pragma unroll
        for (int j = 0; j < 8; ++j) v[j] = xr[64 * j];
        if (m >= MX && nslab > 0) {
            for (int sl = 0; sl < nslab; ++sl) { const f32x4* sr = (const f32x4*)(SL + ((size_t)sl * MC + (m - MX)) * D) + F.lane;
#pragma unroll
                for (int j = 0; j < 8; ++j) v[j] = v[j] + sr[64 * j]; }
#pragma unroll
            for (int j = 0; j < 8; ++j) xr[64 * j] = v[j]; }
#pragma unroll
        for (int j = 0; j < 8; ++j) s += (v[j].x * v[j].x + v[j].y * v[j].y) + (v[j].z * v[j].z + v[j].w * v[j].w);
        const float rstd = 1.0f / sqrtf(wave_sum(s) * (1.0f / D) + EPS);
        const float* mp = mod + bsel * 12288;
#pragma unroll
        for (int j = 0; j < 8; ++j) { const int c = 4 * F.lane + 256 * j;
            const f32x4 g = *(const f32x4*)(gain + c), sh = *(const f32x4*)(mp + shoff + c), sc = *(const f32x4*)(mp + soff + c);
            f16x4 o;
#pragma unroll
            for (int e = 0; e < 4; ++e) o[e] = (f16)(v[j][e] * rstd * g[e] * (1.0f + sc[e]) + sh[e]);
            *(f16x4*)(O + (size_t)m * D + c) = o; }
    }
}
__device__ __forceinline__ void ph_final_norm(const Ctx& F, const Args& A) {
    const int gw = F.bid * 8 + F.wave, NGW = F.G * 8;
    const float* X = (const float*)(F.ws + WS_XRES); const float* gain = A.in[I_FNG];
    for (int m = gw; m < MX; m += NGW) {
        const f32x4* xr = (const f32x4*)(X + (size_t)m * D) + F.lane;
        f32x4 v[8]; float s = 0.f;
#pragma unroll
        for (int j = 0; j < 8; ++j) { v[j] = xr[64 * j]; s += (v[j].x * v[j].x + v[j].y * v[j].y) + (v[j].z * v[j].z + v[j].w * v[j].w); }
        const float rstd = 1.0f / sqrtf(wave_sum(s) * (1.0f / D) + EPS);
#pragma unroll
        for (int j = 0; j < 8; ++j) { const int c = 4 * F.lane + 256 * j; const f32x4 g = *(const f32x4*)(gain + c);
            *(f32x4*)(A.out + (size_t)m * D + c) = v[j] * rstd * g; }
    }
}

__device__ __forceinline__ void ph_s5_scan(const Ctx& F) {
    if (F.tid >= 32) return;
    const float* S = (const float*)(F.ws + WS_S5S); f16* SA = (f16*)(F.ws + WS_S5A);
    for (int gt = F.bid * 32 + F.tid; gt < 2 * 2 * 32 * 64; gt += F.G * 32) {
        const int nn = gt & 63, g = (gt >> 6) & 31, d = (gt >> 11) & 1, b = gt >> 12;
        const f32x2 at = ((const f32x2*)(F.ws + WS_S5AT))[(d * 32 + g) * 64 + nn];
        f32x2 st = (f32x2){0.f, 0.f};
        for (int base = 0; base < 16 + 512; base += 16) {
            f32x2 loc[16]; int chk[16];
#pragma unroll
            for (int u = 0; u < 16; ++u) { const int step = base + u; int chunk;
                if (d == 0) chunk = step < 16 ? 1024 + b * 16 + step : b * 512 + (step - 16);
                else chunk = step < 16 ? 1024 + b * 16 + (15 - step) : b * 512 + (511 - (step - 16));
                chk[u] = chunk; const size_t so = ((size_t)chunk * 32 + g) * 256 + d * 128 + nn;
                loc[u] = (f32x2){S[so], S[so + 64]}; }
#pragma unroll
            for (int u = 0; u < 16; ++u) { f16* xp = SA + (size_t)chk[u] * 16384 + (size_t)g * 512 + 256 + d * 128 + nn;
                xp[0] = (f16)st.x; xp[64] = (f16)st.y;
                st = cmul(at, st) + loc[u]; }
        }
    }
}

__device__ __forceinline__ void ph_ffn_fix(const Ctx& F, const Args& A, int l, int nMr) {
    const float* HALO = (const float*)(F.ws + WS_HALO); f16* ACT = (f16*)(F.ws + WS_ACT);
    const float* cw = A.in[I_FFCW] + (size_t)l * 3 * FFH; const float* cb = A.in[I_FFCB] + (size_t)l * FFH;
    const int NT = nMr * 44 * 2 * 128;
    for (int task = F.bid * 512 + F.tid; task < NT; task += F.G * 512) {
        const int c = task & 127, which = (task >> 7) & 1, tile = task >> 8, pn = tile % 44, pm = tile / 44;
        const float* h = HALO + ((size_t)pm * 44 + pn) * 768 + c; const int col = pn * 128 + c;
        const bool first = (pm == 0 || pm == 32 || pm >= 64), last = (pm == 31 || pm >= 63);
        float ap, ac, an, b;
        if (which == 0) { ap = first ? 0.f : HALO[((size_t)(pm - 1) * 44 + pn) * 768 + 3 * 128 + c]; ac = h[0]; an = h[128]; b = h[4 * 128]; }
        else { ap = h[2 * 128]; ac = h[3 * 128]; an = last ? 0.f : HALO[((size_t)(pm + 1) * 44 + pn) * 768 + c]; b = h[5 * 128]; }
        const float a = cw[col] * ap + cw[FFH + col] * ac + cw[2 * FFH + col] * an + cb[col];
        ACT[(size_t)(pm * 256 + (which ? 255 : 0)) * FFH + col] = (f16)(siluf_(a) * b);
    }
}

namespace gla {
constexpr int QK_LD = 136, KH_LD = 72, VT_LD = 72, P_LD = 72;
constexpr int OFF_QT = 0;
constexpr int OFF_KT = 17408;
constexpr int OFF_VT = OFF_KT + 18432;
constexpr int OFF_P = OFF_VT + 36864;
constexpr int OFF_LR = OFF_P + 9216;
constexpr int OFF_GT = OFF_LR + 4096;
constexpr int OFF_DEC = OFF_GT + 2048;
constexpr int OFF_RS = OFF_DEC + 512;
constexpr int OFF_QR = OFF_RS + 2048;
constexpr int OFF_KR = OFF_QR + 17408;
constexpr int OFF_WG = OFF_KR + 17408;
static_assert(OFF_WG + 8192 <= LDSCTL_OFF, "gla lds");

__device__ __forceinline__ int grow(int b, int sc, int j, int i) {
    if (sc < 32) { const int col = 2 * sc + (j >> 1), r = (j & 1) * 64 + i; return b * SEQ + r * 64 + col; }
    return MX + b * LC + j * 64 + i;
}
#define GLA_MFMA(a, b, c) __builtin_amdgcn_mfma_f32_16x16x32_f16(a, b, c, 0, 0, 0)

template <bool FULL>
__device__ __forceinline__ void gla_unit(const Ctx& F, const Args& A, int l, int unit) {
    const int b = unit / (4 * NSC), h = (unit / NSC) % 4, sc = unit % NSC;
    LAS f16* QT = (LAS f16*)(F.lds + OFF_QT); LAS f16* KT = (LAS f16*)(F.lds + OFF_KT); LAS f16* VT = (LAS f16*)(F.lds + OFF_VT);
    LAS f16* PP = (LAS f16*)(F.lds + OFF_P); LAS f16* LR = (LAS f16*)(F.lds + OFF_LR);
    LAS float* GT = (LAS float*)(F.lds + OFF_GT); LAS float* DEC = (LAS float*)(F.lds + OFF_DEC); LAS float* RS = (LAS float*)(F.lds + OFF_RS);
    LAS f16* QR = (LAS f16*)(F.lds + OFF_QR); LAS f16* KR = (LAS f16*)(F.lds + OFF_KR); LAS float* WG = (LAS float*)(F.lds + OFF_WG);
    const int tid = F.tid, lane = F.lane, w = F.wave, q0 = lane >> 4, c0 = lane & 15;
    const int dk0 = tid & 127, ig0 = tid >> 7;
    const f16* PX = (const f16*)(F.ws + WS_PX);
    const float scale = 0.08838834764831845f;
    for (int dir = 0; dir < 2; ++dir) {
        __syncthreads();
        for (int i = tid; i < 16 * 128; i += 512) WG[i] = A.in[I_GLAWG][(((size_t)l * 2 + dir) * 16 + (i >> 7)) * 512 + h * 128 + (i & 127)];
        const float bgv = A.in[I_GLABG][((size_t)l * 2 + dir) * 512 + h * 128 + dk0];
        const size_t sidx = ((((size_t)b * 4 + h) * NSC + sc) * 2 + dir);
        f32x4 accS[8][2];
        if (FULL) { const float* Sin = (const float*)(F.ws + WS_GSIN) + sidx * 32768; const int q = opq(q0), c = opq(c0);
#pragma unroll
            for (int dt = 0; dt < 8; ++dt)
#pragma unroll
                for (int et = 0; et < 2; ++et)
#pragma unroll
                    for (int r = 0; r < 4; ++r) accS[dt][et][r] = Sin[(16 * dt + 4 * q + r) * 256 + 32 * w + 16 * et + c]; }
        else {
#pragma unroll
            for (int dt = 0; dt < 8; ++dt)
#pragma unroll
                for (int et = 0; et < 2; ++et) accS[dt][et] = (f32x4){0.f, 0.f, 0.f, 0.f}; }
        float sumtot = 0.f;
        for (int jj = 0; jj < 4; ++jj) {
            const int j = dir ? 3 - jj : jj;
            __syncthreads();
            const int tid = opq(F.tid);
            if (tid < 256) { const int row = tid >> 2, part = tid & 3; const int gr = grow(b, sc, j, row);
                *(LAS f16x8*)(LR + row * 32 + part * 8) = *(const f16x8*)(PX + (size_t)gr * PXLD + P_GG + part * 8); }
#pragma unroll 1
            for (int k = 0; k < 4; ++k) { const int idx = tid + 512 * k, wi = idx >> 6, ln = idx & 63, rr = ln >> 2, cc = ln & 3;
                const int row = (wi & 3) * 16 + rr, chunk = (wi >> 2) * 4 + cc; const int gr = grow(b, sc, j, row);
                const f16x8 v8 = *(const f16x8*)(PX + (size_t)gr * PXLD + P_GV + h * 256 + chunk * 8);
#pragma unroll
                for (int e = 0; e < 8; ++e) VT[(chunk * 8 + e) * VT_LD + row] = v8[e]; }
#pragma unroll 1
            for (int k = 0; k < 2; ++k) { const int idx = tid + 512 * k, row = idx >> 4, ch = idx & 15; const int gr = grow(b, sc, j, row);
                *(LAS f16x8*)(KR + row * QK_LD + ch * 8) = *(const f16x8*)(PX + (size_t)gr * PXLD + P_GK + h * 128 + ch * 8);
                if (FULL) *(LAS f16x8*)(QR + row * QK_LD + ch * 8) = *(const f16x8*)(PX + (size_t)gr * PXLD + P_GQ + h * 128 + ch * 8); }
            __syncthreads();
            const int dk = opq(dk0), ig = opq(ig0);
            float bv[16];
#pragma unroll
            for (int ii = 0; ii < 16; ++ii) { const int i = ig * 16 + ii; float pre = bgv;
                const f16x8 l0 = *(const LAS f16x8*)(LR + i * 32 + dir * 16), l1 = *(const LAS f16x8*)(LR + i * 32 + dir * 16 + 8);
#pragma unroll
                for (int r = 0; r < 8; ++r) pre += (float)l0[r] * WG[r * 128 + dk] + (float)l1[r] * WG[(8 + r) * 128 + dk];
                bv[ii] = logsigmoidf_(pre) * (1.0f / 16.0f); }
            float totloc;
            if (dir == 0) {
#pragma unroll
                for (int ii = 1; ii < 16; ++ii) bv[ii] += bv[ii - 1];
                totloc = bv[15]; }
            else {
#pragma unroll
                for (int ii = 14; ii >= 0; --ii) bv[ii] += bv[ii + 1];
                totloc = bv[0]; }
            GT[ig * 128 + dk] = totloc;
            __syncthreads();
            const float g0 = GT[dk], g1 = GT[128 + dk], g2 = GT[256 + dk], g3 = GT[384 + dk];
            const float total = (g0 + g1) + (g2 + g3);
            float off, bmid;
            if (dir == 0) { off = (ig > 0 ? g0 : 0.f) + (ig > 1 ? g1 : 0.f) + (ig > 2 ? g2 : 0.f); bmid = g0 + g1; }
            else { off = (ig < 3 ? g3 : 0.f) + (ig < 2 ? g2 : 0.f) + (ig < 1 ? g1 : 0.f); bmid = g2 + g3; }
#pragma unroll
            for (int ii = 0; ii < 16; ++ii) bv[ii] += off;
            if (FULL) {
#pragma unroll
                for (int ii = 0; ii < 16; ++ii) { const int i = ig * 16 + ii;
                    QT[i * QK_LD + dk] = (f16)((float)QR[i * QK_LD + dk] * scale * __expf(fminf(bv[ii] - bmid, 9.f)));
                    KT[i * QK_LD + dk] = (f16)((float)KR[i * QK_LD + dk] * __expf(fminf(bmid - bv[ii], 9.f))); }
                __syncthreads();
                { const int c = opq(c0), q = opq(q0);
#pragma unroll
                for (int s = 0; s < 2; ++s) { const int T = 2 * w + s, it = T >> 2, jt = T & 3; f32x4 a = (f32x4){0.f, 0.f, 0.f, 0.f};
#pragma unroll
                    for (int kk = 0; kk < 4; ++kk) { const f16x8 kf = *(const LAS f16x8*)(KT + (jt * 16 + c) * QK_LD + kk * 32 + 8 * q);
                        const f16x8 qf = *(const LAS f16x8*)(QT + (it * 16 + c) * QK_LD + kk * 32 + 8 * q); a = GLA_MFMA(kf, qf, a); }
                    const int i = it * 16 + c; f16x4 pv;
#pragma unroll
                    for (int r = 0; r < 4; ++r) { const int jx = jt * 16 + 4 * q + r; const bool keep = dir == 0 ? (jx <= i) : (jx >= i); pv[r] = keep ? (f16)a[r] : (f16)0.f; }
                    *(LAS f16x4*)(PP + i * P_LD + jt * 16 + 4 * q) = pv; } }
                __syncthreads();
#pragma unroll
                for (int ii = 0; ii < 16; ++ii) { const int i = ig * 16 + ii; QT[i * QK_LD + dk] = (f16)((float)QR[i * QK_LD + dk] * scale * __expf(bv[ii])); }
            }
            { f16x8 k0, k1;
#pragma unroll
              for (int ii = 0; ii < 8; ++ii) { k0[ii] = (f16)((float)KR[(ig * 16 + ii) * QK_LD + dk] * __expf(total - bv[ii])); k1[ii] = (f16)((float)KR[(ig * 16 + 8 + ii) * QK_LD + dk] * __expf(total - bv[8 + ii])); }
              *(LAS f16x8*)(KT + dk * KH_LD + ig * 16) = k0; *(LAS f16x8*)(KT + dk * KH_LD + ig * 16 + 8) = k1; }
            if (ig == 0) { DEC[dk] = __expf(total); sumtot += total; }
            __syncthreads();
            const int c = opq(c0), q = opq(q0);
            if (FULL) {
                f32x4 accO[4][2];
#pragma unroll
                for (int it = 0; it < 4; ++it)
#pragma unroll
                    for (int et = 0; et < 2; ++et) accO[it][et] = (f32x4){0.f, 0.f, 0.f, 0.f};
#pragma unroll
                for (int et = 0; et < 2; ++et)
#pragma unroll
                    for (int kk = 0; kk < 2; ++kk) { const f16x8 vf = *(const LAS f16x8*)(VT + (32 * w + 16 * et + c) * VT_LD + kk * 32 + 8 * q);
#pragma unroll
                        for (int it = 0; it < 4; ++it) { const f16x8 pf = *(const LAS f16x8*)(PP + (it * 16 + c) * P_LD + kk * 32 + 8 * q); accO[it][et] = GLA_MFMA(vf, pf, accO[it][et]); } asm volatile("" ::: "memory"); }
#pragma unroll
                for (int kb = 0; kb < 4; ++kb)
#pragma unroll
                    for (int et = 0; et < 2; ++et) { f16x8 sf; asm volatile("" ::: "memory");
#pragma unroll
                        for (int e = 0; e < 4; ++e) { sf[e] = (f16)accS[2 * kb][et][e]; sf[4 + e] = (f16)accS[2 * kb + 1][et][e]; }
#pragma unroll
                        for (int it = 0; it < 4; ++it) { const f16x4 lo = *(const LAS f16x4*)(QT + (it * 16 + c) * QK_LD + 32 * kb + 4 * q), hi = *(const LAS f16x4*)(QT + (it * 16 + c) * QK_LD + 32 * kb + 16 + 4 * q);
                            f16x8 qf; qf[0] = lo[0]; qf[1] = lo[1]; qf[2] = lo[2]; qf[3] = lo[3]; qf[4] = hi[0]; qf[5] = hi[1]; qf[6] = hi[2]; qf[7] = hi[3];
                            accO[it][et] = GLA_MFMA(sf, qf, accO[it][et]); } }
                float* OF = (float*)(F.ws + WS_GOF);
                if (dir == 0) {
#pragma unroll
                    for (int it = 0; it < 4; ++it) { const int gr = grow(b, sc, j, it * 16 + c);
#pragma unroll
                        for (int et = 0; et < 2; ++et) *(f32x4*)(OF + (size_t)gr * 1024 + h * 256 + 32 * w + 16 * et + 4 * q) = accO[it][et];
                        asm volatile("" ::: "memory"); } }
                else {
                    int grs[4];
#pragma unroll
                    for (int it = 0; it < 4; ++it) { grs[it] = grow(b, sc, j, it * 16 + c); float ss = 0.f;
#pragma unroll
                        for (int et = 0; et < 2; ++et) { accO[it][et] = accO[it][et] + *(const f32x4*)(OF + (size_t)grs[it] * 1024 + h * 256 + 32 * w + 16 * et + 4 * q);
                            ss += (accO[it][et][0] * accO[it][et][0] + accO[it][et][1] * accO[it][et][1]) + (accO[it][et][2] * accO[it][et][2] + accO[it][et][3] * accO[it][et][3]); }
                        ss += __shfl_xor(ss, 16); ss += __shfl_xor(ss, 32);
                        if (q == 0) RS[(it * 16 + c) * 8 + w] = ss; asm volatile("" ::: "memory"); }
                    __syncthreads();
                    const float* ng = A.in[I_GLANG] + (size_t)l * 256;
                    f16* Y = (f16*)(F.ws + WS_YCAT);
#pragma unroll
                    for (int it = 0; it < 4; ++it) { const int i = it * 16 + c; const f32x4 ra = *(const LAS f32x4*)(RS + i * 8), rb = *(const LAS f32x4*)(RS + i * 8 + 4);
                        const float tot = ((ra[0] + ra[1]) + (ra[2] + ra[3])) + ((rb[0] + rb[1]) + (rb[2] + rb[3]));
                        const float rstd = 1.0f / sqrtf(tot * (1.0f / 256.0f) + EPS);
#pragma unroll
                        for (int et = 0; et < 2; ++et) { const int e0 = 32 * w + 16 * et + 4 * q;
                            const f32x4 gv = *(const f32x4*)(ng + e0); const f16x4 rv = *(const f16x4*)(PX + (size_t)grs[it] * PXLD + P_GR + h * 256 + e0);
                            f16x4 o;
#pragma unroll
                            for (int r = 0; r < 4; ++r) o[r] = (f16)(accO[it][et][r] * rstd * gv[r] * siluf_((float)rv[r]));
                            *(f16x4*)(Y + (size_t)grs[it] * 2048 + 1024 + h * 256 + e0) = o; } asm volatile("" ::: "memory"); }
                }
            }
#pragma unroll
            for (int dt = 0; dt < 8; ++dt) { const f32x4 dv = *(const LAS f32x4*)(DEC + 16 * dt + 4 * q);
#pragma unroll
                for (int et = 0; et < 2; ++et) accS[dt][et] = accS[dt][et] * dv; }
#pragma unroll
            for (int kk = 0; kk < 2; ++kk) { f16x8 vf[2];
#pragma unroll
                for (int et = 0; et < 2; ++et) vf[et] = *(const LAS f16x8*)(VT + (32 * w + 16 * et + c) * VT_LD + kk * 32 + 8 * q);
#pragma unroll
                for (int dt = 0; dt < 8; ++dt) { const f16x8 kf = *(const LAS f16x8*)(KT + (16 * dt + c) * KH_LD + kk * 32 + 8 * q);
#pragma unroll
                    for (int et = 0; et < 2; ++et) accS[dt][et] = GLA_MFMA(kf, vf[et], accS[dt][et]); if (dt & 1) asm volatile("" ::: "memory"); } }
        }
        if (!FULL) { float* Sl = (float*)(F.ws + WS_GSLOC) + sidx * 32768; const int q = opq(q0), c = opq(c0);
#pragma unroll
            for (int dt = 0; dt < 8; ++dt)
#pragma unroll
                for (int et = 0; et < 2; ++et)
#pragma unroll
                    for (int r = 0; r < 4; ++r) Sl[(16 * dt + 4 * q + r) * 256 + 32 * w + 16 * et + c] = accS[dt][et][r];
            if (ig0 == 0) ((float*)(F.ws + WS_GDT))[sidx * 128 + dk0] = __expf(sumtot); }
        VM_WAIT();
    }
}
__device__ __forceinline__ void ph_gla_scan(const Ctx& F) {
    const float* Sl = (const float*)(F.ws + WS_GSLOC); float* Si = (float*)(F.ws + WS_GSIN); const float* Dt = (const float*)(F.ws + WS_GDT);
    for (int gt = F.bid * 512 + F.tid; gt < 2 * 4 * 2 * 32768; gt += F.G * 512) {
        const int e = gt & 32767, dir = (gt >> 15) & 1, h = (gt >> 16) & 3, b = gt >> 18;
        float S = 0.f;
        for (int base = 0; base < NSC; base += 11) {
            float sl[11], dt[11]; size_t ix[11];
#pragma unroll
            for (int u = 0; u < 11; ++u) { const int step = base + u; const int sc = step == 0 ? 32 : (dir == 0 ? step - 1 : 32 - step);
                const size_t idx = ((((size_t)b * 4 + h) * NSC + sc) * 2 + dir); ix[u] = idx;
                sl[u] = Sl[idx * 32768 + e]; dt[u] = Dt[idx * 128 + (e >> 8)]; }
#pragma unroll
            for (int u = 0; u < 11; ++u) { Si[ix[u] * 32768 + e] = S; S = dt[u] * S + sl[u]; }
        }
    }
}
#undef GLA_MFMA
}

namespace hy {
#define PADI(i) ((i) + ((i) >> 5))
constexpr int HY_BUF_BYTES = (16384 + 512) * 8;
constexpr int HY_SCR_OFF = HY_BUF_BYTES;
static_assert(HY_SCR_OFF + 2048 <= LDSCTL_OFF, "hyena lds");
__device__ __forceinline__ f32x2 twid(int k, float invN) { const float xr = (float)k * invN; return (f32x2){__builtin_amdgcn_cosf(xr), -__builtin_amdgcn_sinf(xr)}; }
__device__ __forceinline__ f32x2 mul_w16(f32x2 d, int a) {
    constexpr float c1 = 0.9238795325112867f, s1 = 0.3826834323650898f, r = 0.7071067811865476f;
    float c, s;
    switch (a & 15) {
        case 0: return d; case 4: return (f32x2){d.y, -d.x}; case 8: return (f32x2){-d.x, -d.y}; case 12: return (f32x2){-d.y, d.x};
        case 1: c = c1; s = s1; break; case 2: c = r; s = r; break; case 3: c = s1; s = c1; break;
        case 5: c = -s1; s = c1; break; case 6: c = -r; s = r; break; case 7: c = -c1; s = s1; break;
        case 9: c = -c1; s = -s1; break; case 10: c = -r; s = -r; break; case 11: c = -s1; s = -c1; break;
        case 13: c = s1; s = -c1; break; case 14: c = r; s = -r; break; default: c = c1; s = -s1; break; }
    return (f32x2){d.x * c + d.y * s, d.y * c - d.x * s};
}
template <int R> __device__ __forceinline__ void dif_pass(LAS f32x2* x, int m, int lh, int tid) {
    const int N = 1 << m; const float invN = 1.0f / (float)N; const int lg = lh - R + 1, g = 1 << lg, S = (N >> 1) >> lh;
    for (int q = tid; q < (N >> R); q += 512) { const int j = q & (g - 1), blk = q >> lg, base = (blk << (lh + 1)) + j;
        f32x2 v[1 << R];
#pragma unroll
        for (int k = 0; k < (1 << R); ++k) v[k] = x[PADI(base + k * g)];
        f32x2 w = twid(j * S, invN);
#pragma unroll
        for (int s = 0; s < R; ++s) { const int half = 1 << (R - 1 - s);
#pragma unroll
            for (int k = 0; k < (1 << R); ++k) if (!(k & half)) { const f32x2 a = v[k], b = v[k + half]; v[k] = a + b;
                v[k + half] = mul_w16(cmul(a - b, w), ((k & (half - 1)) << s) * (16 >> R)); }
            w = cmul(w, w); }
#pragma unroll
        for (int k = 0; k < (1 << R); ++k) x[PADI(base + k * g)] = v[k]; }
    __syncthreads();
}
template <int R> __device__ __forceinline__ void dit_pass(LAS f32x2* x, int m, int lh, int tid) {
    const int N = 1 << m; const float invN = 1.0f / (float)N; const int h = 1 << lh, S1 = (N >> 1) >> lh;
    for (int q = tid; q < (N >> R); q += 512) { const int j = q & (h - 1), blk = q >> lh, base = (blk << (lh + R)) + j;
        f32x2 v[1 << R];
#pragma unroll
        for (int k = 0; k < (1 << R); ++k) v[k] = x[PADI(base + k * h)];
        f32x2 wp[R]; wp[R - 1] = cconj(twid(j * (S1 >> (R - 1)), invN));
#pragma unroll
        for (int s = R - 2; s >= 0; --s) wp[s] = cmul(wp[s + 1], wp[s + 1]);
#pragma unroll
        for (int s = 0; s < R; ++s) { const int half = 1 << s;
#pragma unroll
            for (int k = 0; k < (1 << R); ++k) if (!(k & half)) { const f32x2 a = v[k];
                const f32x2 b = mul_w16(cmul(v[k + half], wp[s]), (16 - (k & (half - 1)) * (16 >> (s + 1))) & 15);
                v[k] = a + b; v[k + half] = a - b; } }
#pragma unroll
        for (int k = 0; k < (1 << R); ++k) x[PADI(base + k * h)] = v[k]; }
    __syncthreads();
}
__device__ __forceinline__ void fft_fwd(LAS f32x2* x, int m, int tid) {
    int lh = m - 1;
    while (lh + 1 >= 4) { dif_pass<4>(x, m, lh, tid); lh -= 4; }
    if (lh + 1 == 2) dif_pass<2>(x, m, 1, tid); else if (lh + 1 == 1) dif_pass<1>(x, m, 0, tid);
}
__device__ __forceinline__ void fft_inv(LAS f32x2* x, int m, int tid) {
    int lh = 0;
    while (m - lh >= 4) { dit_pass<4>(x, m, lh, tid); lh += 4; }
    if (m - lh == 2) dit_pass<2>(x, m, lh, tid); else if (m - lh == 1) dit_pass<1>(x, m, lh, tid);
}
__device__ __forceinline__ int brev(int k, int m) { return (int)(__brev((unsigned)k) >> (32 - m)); }

__device__ __forceinline__ void filt_unit(const Ctx& F, const Args& A, int l, int unit) {
    const int kind = unit >> 9, o = (unit >> 8) & 1, pair = unit & 255;
    const int n = kind ? LC : SEQ, m = kind ? 9 : 14, N = 2 * n, tid = F.tid;
    LAS f32x2* buf = (LAS f32x2*)F.lds;
    LAS float* W3 = (LAS float*)(F.lds + HY_SCR_OFF);
    LAS float* B3 = W3 + 256;
    LAS float* RED = B3 + 4;
    LAS float* INV = RED + 16;
    __syncthreads();
    if (tid < 256) { const int j = tid >> 2, ci = tid & 3; const int col = o * 1024 + (ci >> 1) * 512 + 2 * pair + (ci & 1);
        W3[j * 4 + ci] = A.in[I_HYW3][((size_t)l * 64 + j) * 2048 + col]; if (j == 0) B3[ci] = A.in[I_HYB3][(size_t)l * 2048 + col]; }
    __syncthreads();
    const float* H2 = (const float*)(F.ws + WS_H2) + (kind ? (size_t)SEQ * 64 : 0);
    const float lo = -3.0701134573253945f, hi = -15.350567286626973f;
    const float ra = fabsf(lo + (hi - lo) * (float)(2 * pair) / 511.0f), rb = fabsf(lo + (hi - lo) * (float)(2 * pair + 1) / 511.0f);
    float sa = 0.f, sb = 0.f;
    for (int t = tid; t < n; t += 512) {
        float a0 = B3[0], a1 = B3[1], a2 = B3[2], a3 = B3[3];
        const f32x4* hr = (const f32x4*)(H2 + (size_t)t * 64);
#pragma unroll 4
        for (int j4 = 0; j4 < 16; ++j4) { const f32x4 hv = hr[j4];
#pragma unroll
            for (int e = 0; e < 4; ++e) { const f32x4 wv = *(const LAS f32x4*)(W3 + (j4 * 4 + e) * 4); a0 += hv[e] * wv[0]; a1 += hv[e] * wv[1]; a2 += hv[e] * wv[2]; a3 += hv[e] * wv[3]; } }
        const float tn = (float)t / (float)(n - 1), da = expf(-tn * ra), db = expf(-tn * rb);
        const float fa = a0 * da, fb = a1 * db, ba = a2 * da, bb = a3 * db;
        buf[PADI(t)] = (f32x2){fa, fb}; sa += fabsf(fa); sb += fabsf(fb);
        if (t >= 1) { buf[PADI(N - t)] = (f32x2){ba, bb}; sa += fabsf(ba); sb += fabsf(bb); }
    }
    if (tid == 0) buf[PADI(n)] = (f32x2){0.f, 0.f};
    sa = wave_sum(sa); sb = wave_sum(sb);
    if (F.lane == 0) { RED[F.wave * 2] = sa; RED[F.wave * 2 + 1] = sb; }
    __syncthreads();
    if (tid < 2) { float s = 0.f;
#pragma unroll
        for (int w = 0; w < 8; ++w) s += RED[w * 2 + tid];
        INV[tid] = 1.0f / (s + EPS); }
    __syncthreads();
    { const float ia = INV[0], ib = INV[1];
      for (int i = tid; i < N; i += 512) { f32x2 v = buf[PADI(i)]; v.x *= ia; v.y *= ib; buf[PADI(i)] = v; } }
    __syncthreads();
    fft_fwd(buf, m, tid);
    f32x4* out = (f32x4*)(F.ws + WS_FSD + (kind ? FSD_C_OFF : 0)) + (size_t)(o * 256 + pair) * (n + 1);
    for (int u = tid; u <= n; u += 512) { const int p = u < n ? 2 * u : 1, k = brev(p, m), pn = brev((N - k) & (N - 1), m);
        const f32x2 zk = buf[PADI(p)], zn = cconj(buf[PADI(pn)]);
        const f32x2 fa = (zk + zn) * 0.5f, df = zk - zn, fb = (f32x2){df.y * 0.5f, -df.x * 0.5f};
        const f32x2 fs = (fa + fb) * 0.5f, fd = (fa - fb) * 0.5f;
        out[u] = (f32x4){fs.x, fs.y, fd.x, fd.y}; }
    __syncthreads();
}

__device__ __forceinline__ void main_unit(const Ctx& F, const Args& A, int l, int unit) {
    const int kind = unit >> 9, b = (unit >> 8) & 1, pair = unit & 255;
    const int n = kind ? LC : SEQ, m = kind ? 9 : 14, N = 2 * n, tid = F.tid;
    const int row0 = kind ? MX + b * LC : b * SEQ;
    LAS f32x2* buf = (LAS f32x2*)F.lds;
    const f16* ZT = (const f16*)(F.ws + WS_ZT) + (size_t)(2 * pair) * MT + row0;
    const float* cw = A.in[I_HYCW] + (size_t)l * 3 * 1536 + 2 * pair; const float* cb = A.in[I_HYCB] + (size_t)l * 1536 + 2 * pair;
    f32x2 yv[16], g1[16], g2[16];
#pragma unroll
    for (int g = 0; g < 3; ++g)
#pragma unroll
        for (int cc = 0; cc < 2; ++cc) { const float w0 = cw[g * 512 + cc], w1 = cw[1536 + g * 512 + cc], w2 = cw[3072 + g * 512 + cc], bs = cb[g * 512 + cc];
            const f16* zt = ZT + (size_t)(g * 512 + cc) * MT;
#pragma unroll
            for (int gi = 0; gi < 2; ++gi) { const int t0 = 8 * (tid + 512 * gi);
                f16x8 mv; float pv = 0.f, nv = 0.f;
#pragma unroll
                for (int e = 0; e < 8; ++e) mv[e] = (f16)0.f;
                if (t0 < n) { mv = *(const f16x8*)(zt + t0); if (t0 > 0) pv = (float)zt[t0 - 1]; if (t0 + 8 < n) nv = (float)zt[t0 + 8]; }
#pragma unroll
                for (int e = 0; e < 8; ++e) { const float zm = e == 0 ? pv : (float)mv[e == 0 ? 0 : e - 1], zc = (float)mv[e], zp = e == 7 ? nv : (float)mv[e == 7 ? 7 : e + 1];
                    const float r = w0 * zm + w1 * zc + w2 * zp + bs;
                    if (g == 0) { if (cc == 0) yv[gi * 8 + e].x = r; else yv[gi * 8 + e].y = r; }
                    else if (g == 1) { if (cc == 0) g1[gi * 8 + e].x = r; else g1[gi * 8 + e].y = r; }
                    else { if (cc == 0) g2[gi * 8 + e].x = r; else g2[gi * 8 + e].y = r; } } } }
    const float invN = 1.0f / (float)N;
#pragma unroll
    for (int o = 0; o < 2; ++o) {
        __syncthreads();
#pragma unroll
        for (int gi = 0; gi < 2; ++gi) { const int t0 = 8 * (tid + 512 * gi);
            if (t0 < n) {
#pragma unroll
                for (int e = 0; e < 8; ++e) { buf[PADI(t0 + e)] = yv[gi * 8 + e]; buf[PADI(n + t0 + e)] = (f32x2){0.f, 0.f}; } } }
        __syncthreads();
        fft_fwd(buf, m, tid);
        const f32x4* fsd = (const f32x4*)(F.ws + WS_FSD + (kind ? FSD_C_OFF : 0)) + (size_t)(o * 256 + pair) * (n + 1);
        for (int u = tid; u <= n; u += 512) { const int p = u < n ? 2 * u : 1, k = brev(p, m), pn = brev((N - k) & (N - 1), m);
            const f32x2 zk = buf[PADI(p)], zn = buf[PADI(pn)]; const f32x4 f = fsd[u]; const f32x2 fs = (f32x2){f[0], f[1]}, fd = (f32x2){f[2], f[3]};
            const f32x2 wk = cmul(zk, fs) + cmul(cconj(zn), fd), wn = cmul(zn, cconj(fs)) + cmul(cconj(zk), cconj(fd));
            buf[PADI(pn)] = wn; buf[PADI(p)] = wk; }
        __syncthreads();
        fft_inv(buf, m, tid);
        const float* hb = A.in[I_HYBIAS] + ((size_t)l * 2 + o) * 512 + 2 * pair; const f32x2 bias = (f32x2){hb[0], hb[1]};
#pragma unroll
        for (int gi = 0; gi < 2; ++gi) { const int t0 = 8 * (tid + 512 * gi);
            if (t0 < n) {
#pragma unroll
                for (int e = 0; e < 8; ++e) { const f32x2 cv = buf[PADI(t0 + e)] * invN; const f32x2 gt = o == 0 ? g1[gi * 8 + e] : g2[gi * 8 + e];
                    yv[gi * 8 + e] = gt * (cv + yv[gi * 8 + e] * bias); } } }
    }
    f16* Y = (f16*)(F.ws + WS_YBT) + (size_t)(2 * pair) * MT + row0;
#pragma unroll
    for (int gi = 0; gi < 2; ++gi) { const int t0 = 8 * (tid + 512 * gi);
        if (t0 < n) { f16x8 oa, ob;
#pragma unroll
            for (int e = 0; e < 8; ++e) { oa[e] = (f16)yv[gi * 8 + e].x; ob[e] = (f16)yv[gi * 8 + e].y; }
            *(f16x8*)(Y + t0) = oa; *(f16x8*)(Y + MT + t0) = ob; } }
    __syncthreads();
}

__device__ __forceinline__ void ph_ybt_transpose(const Ctx& F) {
    LAS f16* T = (LAS f16*)F.lds;
    const f16* YBT = (const f16*)(F.ws + WS_YBT); f16* Y = (f16*)(F.ws + WS_YCAT);
    for (int rb = F.bid; rb < MT / 64; rb += F.G) { const int r0 = rb * 64;
        __syncthreads();
#pragma unroll
        for (int i = 0; i < 8; ++i) *(LAS f16x8*)(T + F.tid * 72 + 8 * i) = *(const f16x8*)(YBT + (size_t)F.tid * MT + r0 + 8 * i);
        __syncthreads();
        const int row = F.tid >> 3, cg = F.tid & 7;
#pragma unroll
        for (int jj = 0; jj < 8; ++jj) { const int gidx = cg + 8 * jj; f16x8 o;
#pragma unroll
            for (int e = 0; e < 8; ++e) o[e] = T[(8 * gidx + e) * 72 + row];
            *(f16x8*)(Y + (size_t)(r0 + row) * 2048 + 512 + 8 * gidx) = o; }
    }
    __syncthreads();
}
#undef PADI
}

#ifndef PHMASK
#define PHMASK 0xFFFF
#endif
#define PH_EN(k) (((PHMASK) >> (k)) & 1)
#ifndef STAMP_MASK
#define STAMP_MASK 0
#endif
#ifndef STAMP_K
#define STAMP_K 1
#endif
#ifndef SUBMASK
#define SUBMASK 7
#endif
#define SUB_EN(k) (((SUBMASK) >> (k)) & 1)
constexpr int NPH = 2 + 12 * DEPTH;
constexpr int CW_Q = 8192;
__device__ __forceinline__ int q_pull(unsigned* ctr, volatile LAS int* slot) {
    __syncthreads();
    if (threadIdx.x == 0) *slot = (int)__hip_atomic_fetch_add(ctr, 1u, __ATOMIC_RELAXED, __HIP_MEMORY_SCOPE_AGENT);
    __syncthreads();
    return *slot;
}

__global__ void __launch_bounds__(512, 2) mk_fwd(Args args) {
    extern __shared__ __attribute__((aligned(16))) unsigned char lds_raw[];
    Ctx F; F.lds = (LAS unsigned char*)lds_raw; F.tid = threadIdx.x; F.lane = F.tid & 63; F.wave = __builtin_amdgcn_readfirstlane(F.tid >> 6);
    F.G = gridDim.x; F.bid = blockIdx.x; F.ws = args.ws;
    const Ctx F0 = F;
#define FRESH() do { F.tid = opq(F0.tid); F.lane = F.tid & 63; F.wave = __builtin_amdgcn_readfirstlane(F.tid >> 6); } while (0)
    volatile LAS unsigned* MISC = (volatile LAS unsigned*)(F.lds + LDSCTL_OFF);
    if (F.tid < 64) MISC[F.tid] = 0u;
    __syncthreads();
    unsigned* barw = (unsigned*)(F.ws + WS_CTL) + CW_BAR;
    XcdBarrier bar; bar.bar = barw; bar.x = 0; bar.st = nullptr;
    const int lo = args.ph_lo, hi = args.ph_hi;
    if (hi - lo > 1) bar = xcd_barrier_post(barw, MISC + 8);
#define IN(k) (lo <= (k) && (k) < hi)
#define SEAM(k) do { if (IN(k) && IN((k) + 1)) xcd_barrier(bar); } while (0)
#if STAMP_MASK
    volatile LAS unsigned long long* TS = (volatile LAS unsigned long long*)(F.lds + LDSCTL_OFF + 128);
#define TSTART(k) do { if ((((STAMP_MASK) >> (k)) & 1) && blockIdx.x == 0 && threadIdx.x == 0) TS[0] = __builtin_amdgcn_s_memrealtime(); } while (0)
#define TSTOP(k) do { if ((((STAMP_MASK) >> (k)) & 1) && blockIdx.x == 0 && threadIdx.x == 0) TS[1] = TS[1] + (__builtin_amdgcn_s_memrealtime() - TS[0]); } while (0)
#else
#define TSTART(k) do {} while (0)
#define TSTOP(k) do {} while (0)
#endif
    unsigned char* ws = F.ws;
    const int rank160 = (F.bid + F.G - 160 % F.G) % F.G;

    TSTART(12);
    if (PH_EN(12) && IN(0)) { FRESH(); ph_prologue(F, args); }
    SEAM(0);
    TSTOP(12);

    for (int l = 0; l < DEPTH; ++l) {
        const int pb = 1 + 12 * l;
        const float* modl = (const float*)(ws + WS_MOD) + (size_t)l * 3 * 12288;
        const bool ctx_on = l < DEPTH - 1;
        const int nMr = ctx_on ? MT / 256 : MX / 256, nrows = ctx_on ? MT : MX;
        TSTART(0);
        if (PH_EN(0) && IN(pb + 0)) {
            FRESH(); ph_convert_weights(F, args, l);
            __syncthreads();
            FRESH(); if (F.bid < 32) s5_mats_group(F, args, l, F.bid);
            FRESH(); ph_hyena_h2(F, args, l);
            FRESH(); ph_norm(F, args, l, 0, MT, l > 0 ? 11 : 0);
        }
        SEAM(pb + 0);
        TSTOP(0);
        TSTART(1);
        if (PH_EN(1) && IN(pb + 1)) {
            pg8::SchedPlain S; S.init(MT / 256, PXLD / 256, F.G, F.bid); S.A = (const char*)(ws + WS_HN); S.B = (const char*)(ws + WS_WIN); S.aTile = (size_t)256 * 2048 * 2; S.bTile = (size_t)256 * 2048 * 2;
            pg8::EpiPx E{(f16*)(ws + WS_PX), (f16*)(ws + WS_S5A), (f16*)(ws + WS_ZT)};
            pg8::gemm_phase(F.lds, 2048, 2048, 32, S, E);
        }
        SEAM(pb + 1);
        TSTOP(1);
        TSTART(2);
        if (PH_EN(2) && IN(pb + 2)) {
            TSTART(16);
            if (SUB_EN(0)) { pg8::SchedS5 S{(const char*)(ws + WS_S5A), (const char*)(ws + WS_S5M), (size_t)256 * 256 * 2, F.G, F.bid};
              pg8::EpiS5In E{(float*)(ws + WS_S5S)};
              pg8::gemm_phase(F.lds, 16384, 256, 4, S, E); }
            TSTOP(16);
            { unsigned* qc = (unsigned*)(ws + WS_CTL) + CW_Q + (l * 2 + 0) * 64; volatile LAS int* slot = (volatile LAS int*)(MISC + 16);
              for (;;) { const int u = q_pull(qc, slot); if (u >= 264 + 1024) break;
                  if (u < 264) { TSTART(17); FRESH(); gla::gla_unit<false>(F, args, l, u); TSTOP(17); } else { TSTART(18); FRESH(); hy::filt_unit(F, args, l, u - 264); TSTOP(18); } } }
        }
        SEAM(pb + 2);
        TSTOP(2);
        TSTART(3);
        if (PH_EN(3) && IN(pb + 3)) { FRESH(); ph_s5_scan(F); FRESH(); gla::ph_gla_scan(F); }
        SEAM(pb + 3);
        TSTOP(3);
        TSTART(4);
        if (PH_EN(4) && IN(pb + 4)) {
            TSTART(19);
            if (SUB_EN(0)) { pg8::SchedS5 S{(const char*)(ws + WS_S5A), (const char*)(ws + WS_S5W), (size_t)256 * 512 * 2, F.G, F.bid};
              pg8::EpiS5Out E{(const f16*)(ws + WS_S5A), (f16*)(ws + WS_YAPRE), args.in[I_S5D] + (size_t)l * 512};
              pg8::gemm_phase(F.lds, 16384, 512, 8, S, E); }
            TSTOP(19);
            { unsigned* qc = (unsigned*)(ws + WS_CTL) + CW_Q + (l * 2 + 1) * 64; volatile LAS int* slot = (volatile LAS int*)(MISC + 16);
              for (;;) { const int u = q_pull(qc, slot); if (u >= 264 + 1024) break;
                  if (u < 264) { TSTART(20); FRESH(); gla::gla_unit<true>(F, args, l, u); TSTOP(20); } else { TSTART(21); FRESH(); hy::main_unit(F, args, l, u - 264); TSTOP(21); } } }
        }
        SEAM(pb + 4);
        TSTOP(4);
        TSTART(5);
        if (PH_EN(5) && IN(pb + 5)) {
            pg8::SchedPlain S; S.init(nMr, 2, F.G, F.bid); S.A = (const char*)(ws + WS_YAPRE); S.B = (const char*)(ws + WS_WGLU); S.aTile = (size_t)256 * 512 * 2; S.bTile = (size_t)256 * 512 * 2;
            pg8::EpiGlu E{(const f16*)(ws + WS_YAPRE), (f16*)(ws + WS_YCAT), args.in[I_GLUB] + (size_t)l * 512};
            pg8::gemm_phase(F.lds, 512, 512, 8, S, E);
            FRESH(); hy::ph_ybt_transpose(F);
        }
        SEAM(pb + 5);
        TSTOP(5);
        TSTART(6);
        if (PH_EN(6) && IN(pb + 6)) {
            pg8::SchedPlain S; S.init(nMr, 8, F.G, F.bid); S.aTile = (size_t)256 * 2048 * 2; S.bTile = (size_t)256 * 2048 * 2;
            S.A = (const char*)(ws + WS_YCAT); S.B = (const char*)(ws + WS_WBR);
            if (SUB_EN(0)) { pg8::EpiBranch<0> E{(const f16*)(ws + WS_PX), (f16*)(ws + WS_MBUF)}; pg8::gemm_phase(F.lds, 2048, 2048, 8, S, E); }
            S.A = (const char*)(ws + WS_YCAT) + 512 * 2; S.B = (const char*)(ws + WS_WBR) + 512 * 2;
            if (SUB_EN(1)) { pg8::EpiBranch<1> E{(const f16*)(ws + WS_PX), (f16*)(ws + WS_MBUF)}; pg8::gemm_phase(F.lds, 2048, 2048, 8, S, E); }
            S.A = (const char*)(ws + WS_YCAT) + 1024 * 2; S.B = (const char*)(ws + WS_WBR) + 1024 * 2;
            if (SUB_EN(2)) { pg8::EpiBranch<2> E{(const f16*)(ws + WS_PX), (f16*)(ws + WS_MBUF)}; pg8::gemm_phase(F.lds, 2048, 2048, 16, S, E); }
        }
        SEAM(pb + 6);
        TSTOP(6);
        TSTART(7);
        if (PH_EN(7) && IN(pb + 7)) {
            pg8::SchedPlain S; S.init(MX / 256, 8, F.G, F.bid); S.A = (const char*)(ws + WS_MBUF); S.B = (const char*)(ws + WS_WOUT); S.aTile = (size_t)256 * 2048 * 2; S.bTile = (size_t)256 * 2048 * 2;
            pg8::EpiResid E{(float*)(ws + WS_XRES), modl, 4096};
            pg8::gemm_phase(F.lds, 2048, 2048, 32, S, E);
            if (ctx_on) { pg8::SchedSplit S2{(const char*)(ws + WS_MBUF), (const char*)(ws + WS_WOUT), (size_t)256 * 2048 * 2, (size_t)256 * 2048 * 2, (size_t)8 * 128, 4, F.G, F.bid};
                pg8::EpiSlab E2{(float*)(ws + WS_SLAB), modl, 4096};
                pg8::gemm_phase(F.lds, 2048, 2048, 8, S2, E2); }
        }
        SEAM(pb + 7);
        TSTOP(7);
        TSTART(8);
        if (PH_EN(8) && IN(pb + 8)) { FRESH(); ph_norm(F, args, l, 1, nrows, 4); }
        SEAM(pb + 8);
        TSTOP(8);
        TSTART(9);
        if (PH_EN(9) && IN(pb + 9)) {
            pg8::SchedPlain S; S.init(nMr, UPLD / 256, F.G, F.bid); S.A = (const char*)(ws + WS_HN); S.B = (const char*)(ws + WS_WUP); S.aTile = (size_t)256 * 2048 * 2; S.bTile = (size_t)256 * 2048 * 2;
            pg8::EpiUpAct E{(f16*)(ws + WS_ACT), (float*)(ws + WS_HALO), args.in[I_FFCW] + (size_t)l * 3 * FFH, args.in[I_FFCB] + (size_t)l * FFH, (LAS float*)(F.lds + EXTRA_OFF)};
            pg8::gemm_phase(F.lds, 2048, 2048, 32, S, E);
        }
        SEAM(pb + 9);
        TSTOP(9);
        TSTART(10);
        if (PH_EN(10) && IN(pb + 10)) { FRESH(); ph_ffn_fix(F, args, l, nMr); }
        SEAM(pb + 10);
        TSTOP(10);
        TSTART(11);
        if (PH_EN(11) && IN(pb + 11)) {
            pg8::SchedPlain S; S.init(MX / 256, 8, F.G, F.bid); S.A = (const char*)(ws + WS_ACT); S.B = (const char*)(ws + WS_WDN); S.aTile = (size_t)256 * FFH * 2; S.bTile = (size_t)256 * FFH * 2;
            pg8::EpiResid E{(float*)(ws + WS_XRES), modl, 10240};
            pg8::gemm_phase(F.lds, FFH, FFH, FFH / 64, S, E);
            if (ctx_on) { pg8::SchedSplit S2{(const char*)(ws + WS_ACT), (const char*)(ws + WS_WDN), (size_t)256 * FFH * 2, (size_t)256 * FFH * 2, (size_t)8 * 128, 11, F.G, F.bid};
                pg8::EpiSlab E2{(float*)(ws + WS_SLAB), modl, 10240};
                pg8::gemm_phase(F.lds, FFH, FFH, 8, S2, E2); }
        }
        SEAM(pb + 11);
        TSTOP(11);
    }
    if (PH_EN(13) && IN(NPH - 1)) { FRESH(); ph_final_norm(F, args); }
#if STAMP_MASK
    if (blockIdx.x == 0 && threadIdx.x == 0) { const unsigned long long t0 = __builtin_amdgcn_s_memrealtime(); while (__builtin_amdgcn_s_memrealtime() - t0 < (unsigned long long)(STAMP_K) * TS[1]) __builtin_amdgcn_s_sleep(8); }
#endif
#undef IN
#undef SEAM
#undef FRESH
}

extern "C" void kernel_launch(void* const* d_in, const int* in_sizes, int n_in, void* d_out, int out_size, void* d_ws, size_t ws_size, hipStream_t stream) {
    static int grid = 0;
    if (grid == 0) {
        if (n_in != 40 || out_size != MX * D || ws_size < WS_END) { fprintf(stderr, "kernel_launch: unexpected problem (n_in %d out %d ws %zu, need %zu)\n", n_in, out_size, ws_size, (size_t)WS_END); grid = -1; return; }
        int dev = 0, cus = 0, per_cu = 0;
        if (hipGetDevice(&dev) != hipSuccess || hipDeviceGetAttribute(&cus, hipDeviceAttributeMultiprocessorCount, dev) != hipSuccess) { grid = -1; return; }
        if (hipFuncSetAttribute((const void*)mk_fwd, hipFuncAttributeMaxDynamicSharedMemorySize, LDS_BYTES) != hipSuccess) { fprintf(stderr, "kernel_launch: hipFuncSetAttribute failed\n"); grid = -1; return; }
        if (hipOccupancyMaxActiveBlocksPerMultiprocessor(&per_cu, (const void*)mk_fwd, 512, LDS_BYTES) != hipSuccess || per_cu < 1)
            fprintf(stderr, "kernel_launch: occupancy query reports %d\n", per_cu);
        (void)hipGetLastError();
        grid = cus;
    }
    if (grid < 0) return;
    if (hipMemsetAsync((char*)d_ws + WS_CTL, 0, CTL_ZERO_BYTES, stream) != hipSuccess) return;
    Args a{};
    for (int i = 0; i < 40; ++i) a.in[i] = (const float*)d_in[i];
    a.out = (float*)d_out; a.ws = (unsigned char*)d_ws;
#if MK_ONE
    a.ph_lo = 0; a.ph_hi = NPH;
    hipLaunchKernelGGL(mk_fwd, dim3(grid), dim3(512), LDS_BYTES, stream, a);
#else
    for (int p = 0; p < NPH; ++p) { a.ph_lo = p; a.ph_hi = p + 1; hipLaunchKernelGGL(mk_fwd, dim3(grid), dim3(512), LDS_BYTES, stream, a); }
#endif
}
```

```cpp
#include <hip/hip_runtime.h>
#include <stdio.h>

#ifndef MK_ONE
#define MK_ONE 1
#define STAMP_MASK 0
#define STAMP_K 1
#endif

#define GAS __attribute__((address_space(1)))
#define LAS __attribute__((address_space(3)))
typedef _Float16 f16;
typedef _Float16 f16x8 __attribute__((ext_vector_type(8)));
typedef _Float16 f16x4 __attribute__((ext_vector_type(4)));
typedef _Float16 f16x2 __attribute__((ext_vector_type(2)));
typedef float f32x4 __attribute__((ext_vector_type(4)));
typedef float f32x2 __attribute__((ext_vector_type(2)));

constexpr int D = 2048, NB = 2, SEQ = 8192, LC = 256, DEPTH = 4;
constexpr int MX = NB * SEQ, MC = NB * LC, MT = MX + MC;
constexpr int PXLD = 11520, FFH = 5632, UPLD = 2 * FFH;
constexpr int P_S5 = 0, P_GK = 512, P_GV = 1024, P_GQ = 2048, P_GR = 2560, P_HY = 3584, P_MG = 5120, P_GG = 11264;
constexpr int INW = 11296;
constexpr int NCHK = 1056;
constexpr float S5SCALE = 1024.f;
constexpr float EPS = 1e-6f;
constexpr int NSC = 33;

constexpr size_t MiB = 1u << 20;
constexpr size_t WS_CTL = 0, CTL_ZERO_BYTES = 1 * MiB;
constexpr size_t WS_MOD = 1 * MiB;
constexpr size_t WS_TW = 2 * MiB;
constexpr size_t WS_S5AT = 3 * MiB;
constexpr size_t WS_WIN = 4 * MiB;
constexpr size_t WS_WGLU = WS_WIN + 45 * MiB;
constexpr size_t WS_WBR = WS_WGLU + 1 * MiB;
constexpr size_t WS_WOUT = WS_WBR + 8 * MiB;
constexpr size_t WS_WUP = WS_WOUT + 8 * MiB;
constexpr size_t WS_WDN = WS_WUP + 44 * MiB;
constexpr size_t WS_S5W = WS_WDN + 22 * MiB;
constexpr size_t WS_S5M = WS_S5W + 8 * MiB;
constexpr size_t WS_H2 = WS_S5M + 4 * MiB;
constexpr size_t WS_FSD = WS_H2 + 3 * MiB;
constexpr size_t FSD_C_OFF = (size_t)2 * 256 * 8193 * 16;
constexpr size_t WS_XRES = WS_FSD + 68 * MiB;
constexpr size_t WS_HN = WS_XRES + 132 * MiB;
constexpr size_t WS_PX = WS_HN + 66 * MiB;
constexpr size_t WS_S5A = WS_PX + 372 * MiB;
constexpr size_t WS_S5S = WS_S5A + 40 * MiB;
constexpr size_t WS_YAPRE = WS_S5S + 40 * MiB;
constexpr size_t WS_YCAT = WS_YAPRE + 20 * MiB;
constexpr size_t WS_MBUF = WS_YCAT + 66 * MiB;
constexpr size_t WS_GSLOC = WS_MBUF + 66 * MiB;
constexpr size_t WS_GSIN = WS_GSLOC + 66 * MiB;
constexpr size_t WS_GOF = WS_GSIN + 66 * MiB;
constexpr size_t WS_GDT = WS_GOF + 66 * MiB;
constexpr size_t WS_ACT = WS_GSLOC;
constexpr size_t WS_ZT = WS_GDT + 1 * MiB;
constexpr size_t WS_YBT = WS_ZT + 50 * MiB;
constexpr size_t WS_SLAB = WS_YBT + 17 * MiB;
constexpr size_t WS_HALO = WS_SLAB + 44 * MiB;
constexpr size_t WS_END = WS_HALO + 9 * MiB;
static_assert((size_t)MT * FFH * 2 <= 198 * MiB, "ACT overlay");
constexpr int CW_BAR = 4096;

constexpr int RING_BYTES = 131072;
constexpr int EXTRA_OFF = RING_BYTES, EXTRA_BYTES = 8192;
constexpr int LDSCTL_OFF = EXTRA_OFF + EXTRA_BYTES;
constexpr int LDS_BYTES = LDSCTL_OFF + 256;

__device__ __forceinline__ float wave_sum(float v) {
#pragma unroll
    for (int o = 1; o < 64; o <<= 1) v += __shfl_xor(v, o);
    return v;
}
__device__ __forceinline__ float sigmoidf_(float x) { return 1.0f / (1.0f + __expf(-x)); }
__device__ __forceinline__ float siluf_(float x) { return x * sigmoidf_(x); }
__device__ __forceinline__ float gelu_tanh_(float x) { const float u = 0.7978845608028654f * (x + 0.044715f * x * x * x); return x / (1.0f + __expf(-2.0f * u)); }
__device__ __forceinline__ float logsigmoidf_(float x) { return fminf(x, 0.f) - __logf(1.0f + __expf(-fabsf(x))); }
__device__ __forceinline__ f32x2 cmul(f32x2 a, f32x2 b) { return (f32x2){a.x * b.x - a.y * b.y, a.x * b.y + a.y * b.x}; }
__device__ __forceinline__ f32x2 cconj(f32x2 a) { return (f32x2){a.x, -a.y}; }
__device__ __forceinline__ int opq(int x) { asm volatile("" : "+v"(x)); return x; }
#define LDS_WAIT() asm volatile("s_waitcnt lgkmcnt(0)" ::: "memory")
#define VM_WAIT() asm volatile("s_waitcnt vmcnt(0)" ::: "memory")

#define XB_TMO      128
#define XB_XCNT(j)  (256  + 64 * (j))
#define XB_XSUB(j)  (1280 + 64 * (j))
#define XB_XGEN(j)  (2304 + 64 * (j))
#define XB_TOP      3328
#define XB_TOPGEN   3392
#define XCD_BAR_WORDS 3456
#define XB_SPIN_CAP (1u << 18)
__device__ __forceinline__ unsigned xb_ld(unsigned* p)              { return __hip_atomic_load(p, __ATOMIC_RELAXED, __HIP_MEMORY_SCOPE_AGENT); }
__device__ __forceinline__ unsigned xb_add(unsigned* p, unsigned v) { return __hip_atomic_fetch_add(p, v, __ATOMIC_RELAXED, __HIP_MEMORY_SCOPE_AGENT); }
__device__ __forceinline__ unsigned xb_xcc_id() { return (unsigned)__builtin_amdgcn_s_getreg((3 << 11) | 20) & 0xFu; }
#define XB_SPIN(cond, bar) do { unsigned _sp = 0; while (cond) { __builtin_amdgcn_s_sleep(1); \
    if ((++_sp & 255u) == 0u) { if (xb_ld(&(bar)[XB_TMO])) break; if (_sp > XB_SPIN_CAP) { atomicAdd(&(bar)[XB_TMO], 1u); break; } } } } while (0)
struct XcdBarrier { unsigned* bar; unsigned x; volatile LAS unsigned* st; };
__device__ __forceinline__ XcdBarrier xcd_barrier_post(unsigned* bar, volatile LAS unsigned* st) {
    XcdBarrier b; b.bar = bar; b.x = xb_xcc_id(); b.st = st;
    if (threadIdx.x == 0) (void)xb_add(&bar[XB_XCNT(b.x)], 1u);
    return b;
}
__device__ __forceinline__ void xcd_barrier_complete(unsigned* bar, unsigned x, unsigned& nloc, unsigned& nx) {
    const unsigned G = gridDim.x * gridDim.y * gridDim.z;
    unsigned sum, cnt, mine, sp = 0u;
    for (;;) {
        sum = 0u; cnt = 0u; mine = 0u;
#pragma unroll
        for (unsigned j = 0; j < 16; ++j) { const unsigned c = xb_ld(&bar[XB_XCNT(j)]); sum += c; cnt += (c > 0u) ? 1u : 0u; mine = (j == x) ? c : mine; }
        if (sum == G) break;
        __builtin_amdgcn_s_sleep(1);
        if ((++sp & 255u) == 0u) { if (xb_ld(&bar[XB_TMO])) break; if (sp > XB_SPIN_CAP) { atomicAdd(&bar[XB_TMO], 1u); break; } }
    }
    nloc = mine > 0u ? mine : 1u; nx = cnt > 0u ? cnt : 1u;
}
__device__ __forceinline__ void xcd_barrier(const XcdBarrier& b) {
    asm volatile("s_waitcnt vmcnt(0)" ::: "memory");
    __syncthreads();
    if (threadIdx.x == 0) {
        unsigned* bar = b.bar;
        __builtin_amdgcn_s_waitcnt(0);
        unsigned nloc = b.st[0], nx = b.st[1];
        if (nloc == 0u) { xcd_barrier_complete(bar, b.x, nloc, nx); b.st[0] = nloc; b.st[1] = nx; }
        const unsigned old = xb_add(&bar[XB_XSUB(b.x)], 1u);
        const unsigned gen = old / nloc;
        if (old + 1u == (gen + 1u) * nloc) {
            __builtin_amdgcn_fence(__ATOMIC_RELEASE, "agent");
            asm volatile("s_waitcnt vmcnt(0)" ::: "memory");
            const unsigned og = xb_add(&bar[XB_TOP], 1u);
            const unsigned tg = og / nx;
            if (og + 1u == (tg + 1u) * nx) xb_add(&bar[XB_TOPGEN], 1u);
            else XB_SPIN(xb_ld(&bar[XB_TOPGEN]) == tg, bar);
            __builtin_amdgcn_fence(__ATOMIC_ACQUIRE, "agent");
            xb_add(&bar[XB_XGEN(b.x)], 1u);
            asm volatile("s_waitcnt vmcnt(0)" ::: "memory");
        } else {
            XB_SPIN(xb_ld(&bar[XB_XGEN(b.x)]) == gen, bar);
            __builtin_amdgcn_fence(__ATOMIC_ACQUIRE, "agent");
            asm volatile("s_waitcnt vmcnt(0)" ::: "memory");
        }
    }
    __syncthreads();
}

struct Args {
    const float* in[40];
    float* out; unsigned char* ws;
    int ph_lo, ph_hi;
};
struct Ctx {
    LAS unsigned char* lds;
    int tid, lane, wave, G, bid;
    unsigned char* ws;
};
enum { I_X = 0, I_C, I_CTX, I_CCTX, I_WMOD, I_BMOD, I_N1G, I_N2G, I_WIN, I_S5ARE, I_S5AIM, I_S5STEP, I_S5BRE, I_S5BIM, I_S5CRE, I_S5CIM,
       I_S5D, I_GLUW, I_GLUB, I_HYCW, I_HYCB, I_HYW1, I_HYB1, I_HYF1, I_HYW2, I_HYB2, I_HYF2, I_HYW3, I_HYB3, I_HYBIAS,
       I_GLAWG, I_GLABG, I_GLANG, I_WBR, I_WOUT, I_WUP, I_FFCW, I_FFCB, I_WDN, I_FNG };

namespace pg8 {
constexpr int BM = 256, BK = 64, HALF = 128, HTB = HALF * BK * 2, STAGE_BYTES = 8 * HTB, NXCD = 8, WGM = 8;
__device__ __forceinline__ int lds_byte(int r, int c) { const int st = (r >> 4) * 2 + (c >> 5), rr = r & 15, cc = c & 31, ob = rr * 64 + cc * 2; return st * 1024 + (ob ^ (((ob >> 9) & 1) << 5)); }
__device__ __forceinline__ void stage_rc(int b, int& R, int& C) { const int st = b / 1024, sb = b % 1024, swz = sb ^ (((sb >> 9) & 1) << 5); R = (st >> 1) * 16 + swz / 64; C = (st & 1) * 32 + (swz % 64) / 2; }
__device__ __forceinline__ int perm32(int rho) { const int n = rho >> 4, i = rho & 15; return 8 * (i >> 2) + 4 * n + (i & 3); }
struct Unit { const char* a; const char* b; int pm, pn; };
struct Order2D {
    int nM, nN, nwg, G, c;
    __device__ __forceinline__ void init(int nM_, int nN_, int G_, int c_) { nM = nM_; nN = nN_; nwg = nM * nN; G = G_; c = c_; }
    __device__ __forceinline__ bool nx(int i, int& pm, int& pn) const {
        const long L = (long)i * G + c; if (L >= nwg) return false;
        int wgid = (int)L; { const int q = nwg / NXCD, r = nwg % NXCD, xcd = wgid % NXCD, off = wgid / NXCD; wgid = (xcd < r ? xcd * (q + 1) : r * (q + 1) + (xcd - r) * q) + off; }
        const int nig = WGM * nN, gid = wgid / nig, fm = gid * WGM, gsz = (nM - fm) < WGM ? (nM - fm) : WGM;
        pm = fm + ((wgid % nig) % gsz); pn = (wgid % nig) / gsz; return true;
    }
};
struct SchedPlain : Order2D {
    const char* A; const char* B; size_t aTile, bTile;
    __device__ __forceinline__ bool next(int i, Unit& u) const { int pm, pn; if (!nx(i, pm, pn)) return false; u.pm = pm; u.pn = pn; u.a = A + (size_t)pm * aTile; u.b = B + (size_t)pn * bTile; return true; }
};
struct SchedSplit {
    const char* A; const char* B; size_t aTile, bTile, ksub; int nsplit, G, c;
    __device__ __forceinline__ bool next(int i, Unit& u) const { const int L = i * G + c; if (L >= 16 * nsplit) return false; const int t = L / nsplit, ks = L % nsplit, pm = 64 + (t >> 3), pn = t & 7;
        u.pm = pm; u.pn = pn | (ks << 8); u.a = A + (size_t)pm * aTile + (size_t)ks * ksub; u.b = B + (size_t)pn * bTile + (size_t)ks * ksub; return true; }
};
struct SchedS5 {
    const char* A; const char* B; size_t bGroup; int G, c;
    __device__ __forceinline__ bool next(int i, Unit& u) const { const int L = i * G + c; if (L >= 160) return false; const int g = L & 31, pm = L >> 5;
        u.pm = pm; u.pn = g; u.a = A + ((size_t)pm * 256 * 16384 + (size_t)g * 512) * 2; u.b = B + (size_t)g * bGroup; return true; }
};

#define PG8_SA(b, h) (((b) * 2 + (h)) * HTB)
#define PG8_SB(b, h) ((4 + (b) * 2 + (h)) * HTB)
#define PG8_STAGE(bufoff, gbase, voff) do { _Pragma("unroll") for (int _i = 0; _i < 2; ++_i) \
        __builtin_amdgcn_global_load_lds((const unsigned*)((const char*)(gbase) + (voff)[_i]), (LAS unsigned*)(lds + (bufoff) + ldsw + _i * 8192), 16, 0, 0); } while (0)
#define PG8_LDA(dst, b, h) do { _Pragma("unroll") for (int m = 0; m < 4; ++m) _Pragma("unroll") for (int k = 0; k < 2; ++k) dst[m][k] = *(const LAS f16x8*)(lds + PG8_SA(b, h) + aoff + m * 2048 + k * 1024); } while (0)
#define PG8_LDB(dst, b, h) do { _Pragma("unroll") for (int n = 0; n < 2; ++n) _Pragma("unroll") for (int k = 0; k < 2; ++k) dst[n][k] = *(const LAS f16x8*)(lds + PG8_SB(b, h) + boff + n * 2048 + k * 1024); } while (0)
#define PG8_MMA(ai, bj, At, Bt) do { __builtin_amdgcn_s_setprio(1); _Pragma("unroll") for (int m = 0; m < 4; ++m) _Pragma("unroll") for (int n = 0; n < 2; ++n) _Pragma("unroll") for (int k = 0; k < 2; ++k) \
        acc[ai][bj][m][n] = __builtin_amdgcn_mfma_f32_16x16x32_f16(Bt[n][k], At[m][k], acc[ai][bj][m][n], 0, 0, 0); __builtin_amdgcn_s_setprio(0); } while (0)
#define PG8_WAIT_V(n) asm volatile("s_waitcnt vmcnt(" #n ")" ::: "memory")
#define PG8_WAIT_L(n) asm volatile("s_waitcnt lgkmcnt(" #n ")" ::: "memory")
#define PG8_BAR __builtin_amdgcn_s_barrier()
#define PG8_SCHED __builtin_amdgcn_sched_barrier(0)

template <class Epi, class Sched>
__device__ __forceinline__ void gemm_phase(LAS unsigned char* lds, const int lda, const int ldb, const int nt, const Sched& S, const Epi& E) {
    const int tid = opq((int)threadIdx.x), wid = __builtin_amdgcn_readfirstlane(tid >> 6), lane = tid & 63, wr = wid >> 2, wc = wid & 3, fr = lane & 15, fq = lane >> 4;
    unsigned voffA[2], voffB[2];
#pragma unroll
    for (int i = 0; i < 2; ++i) { int R, C; stage_rc(tid * 16 + i * 8192, R, C); const int Rb = Epi::PERM ? ((R & ~31) + perm32(R & 31)) : R;
        voffA[i] = (unsigned)(R * lda + C) * 2u; voffB[i] = (unsigned)(Rb * ldb + C) * 2u; }
    const size_t kstep = (size_t)(BK * 2);
    const size_t hstepA = (size_t)HALF * lda * 2, hstepB = (size_t)HALF * ldb * 2;
    const unsigned ldsw = (unsigned)wid * 1024u;
    const int aoff = lds_byte(wr * 64 + fr, fq * 8), boff = lds_byte(wc * 32 + fr, fq * 8);
    Unit cur, nxt; int ui = 0;
    if (!S.next(0, cur)) return;
    f32x4 acc[2][2][4][2];
#pragma unroll
    for (int a = 0; a < 2; ++a)
#pragma unroll
        for (int b = 0; b < 2; ++b)
#pragma unroll
            for (int m = 0; m < 4; ++m)
#pragma unroll
                for (int n = 0; n < 2; ++n) acc[a][b][m][n] = (f32x4){0.f, 0.f, 0.f, 0.f};
    f16x8 At[4][2], B0[2][2], B1[2][2];
    const char* cA = cur.a; const char* cB = cur.b;
    PG8_STAGE(PG8_SB(0, 0), cB, voffB); PG8_STAGE(PG8_SA(0, 0), cA, voffA); PG8_STAGE(PG8_SB(0, 1), cB + hstepB, voffB); PG8_STAGE(PG8_SA(0, 1), cA + hstepA, voffA);
    if (wr == 1) PG8_BAR;
    PG8_WAIT_V(4); PG8_BAR;
    PG8_STAGE(PG8_SB(1, 0), cB + kstep, voffB); PG8_STAGE(PG8_SA(1, 0), cA + kstep, voffA); PG8_STAGE(PG8_SB(1, 1), cB + hstepB + kstep, voffB);
    PG8_WAIT_V(6); PG8_BAR;
    for (;;) {
        const bool has_next = S.next(ui + 1, nxt);
        const char* nA = has_next ? nxt.a : cA; const char* nB = has_next ? nxt.b : cB;
        for (int t = 0; t < nt; t += 2) {
            const bool last = (t == nt - 2);
            const char* a1 = cA + (size_t)(t + 1) * kstep;
            const char* a2 = last ? nA : cA + (size_t)(t + 2) * kstep; const char* b2 = last ? nB : cB + (size_t)(t + 2) * kstep;
            const char* a3 = a2 + kstep; const char* b3 = b2 + kstep;
            PG8_LDB(B0, 0, 0); PG8_SCHED; PG8_LDA(At, 0, 0); PG8_STAGE(PG8_SA(1, 1), a1 + hstepA, voffA);
            PG8_WAIT_L(8); PG8_BAR; PG8_WAIT_L(0); PG8_MMA(0, 0, At, B0); PG8_BAR; PG8_SCHED;
            PG8_LDB(B1, 0, 1); PG8_STAGE(PG8_SB(0, 0), b2, voffB);
            PG8_BAR; PG8_WAIT_L(0); PG8_MMA(0, 1, At, B1); PG8_BAR;
            PG8_LDA(At, 0, 1); PG8_STAGE(PG8_SA(0, 0), a2, voffA);
            PG8_BAR; PG8_WAIT_L(0); PG8_MMA(1, 0, At, B0); PG8_BAR; PG8_SCHED;
            PG8_STAGE(PG8_SB(0, 1), b2 + hstepB, voffB);
            PG8_WAIT_V(6); PG8_BAR; PG8_MMA(1, 1, At, B1); PG8_BAR;
            PG8_LDB(B0, 1, 0); PG8_SCHED; PG8_LDA(At, 1, 0); PG8_STAGE(PG8_SA(0, 1), a2 + hstepA, voffA);
            PG8_WAIT_L(8); PG8_BAR; PG8_WAIT_L(0); PG8_MMA(0, 0, At, B0); PG8_BAR; PG8_SCHED;
            PG8_LDB(B1, 1, 1); PG8_STAGE(PG8_SB(1, 0), b3, voffB);
            PG8_BAR; PG8_WAIT_L(0); PG8_MMA(0, 1, At, B1); PG8_BAR;
            PG8_LDA(At, 1, 1); PG8_STAGE(PG8_SA(1, 0), a3, voffA);
            PG8_BAR; PG8_WAIT_L(0); PG8_MMA(1, 0, At, B0); PG8_BAR; PG8_SCHED;
            PG8_STAGE(PG8_SB(1, 1), b3 + hstepB, voffB);
            PG8_WAIT_V(6); PG8_BAR; PG8_MMA(1, 1, At, B1); PG8_BAR;
            if constexpr (Epi::HAS_MID) { if (t == Epi::MID1 || t == Epi::MID2) E.mid(acc, cur, t, wr, wc, fr, fq); }
        }
        E(acc, cur, wr, wc, fr, fq);
        if (!has_next) break;
#pragma unroll
        for (int a = 0; a < 2; ++a)
#pragma unroll
            for (int b = 0; b < 2; ++b)
#pragma unroll
                for (int m = 0; m < 4; ++m)
#pragma unroll
                    for (int n = 0; n < 2; ++n) acc[a][b][m][n] = (f32x4){0.f, 0.f, 0.f, 0.f};
        cur = nxt; cA = nA; cB = nB; ++ui;
    }
    PG8_WAIT_V(0);
    if (wr == 0) PG8_BAR;
    PG8_BAR;
}
#undef PG8_SA
#undef PG8_SB
#undef PG8_STAGE
#undef PG8_LDA
#undef PG8_LDB
#undef PG8_MMA
#undef PG8_WAIT_V
#undef PG8_WAIT_L
#undef PG8_BAR
#undef PG8_SCHED

typedef const f32x4 (&AccRef)[2][2][4][2];
__device__ __forceinline__ f16x8 pack8(f32x4 a, f32x4 b) { f16x8 w; w[0] = (f16)a[0]; w[1] = (f16)a[1]; w[2] = (f16)a[2]; w[3] = (f16)a[3]; w[4] = (f16)b[0]; w[5] = (f16)b[1]; w[6] = (f16)b[2]; w[7] = (f16)b[3]; return w; }

struct EpiPx {
    static constexpr bool PERM = true, HAS_MID = false; f16* PX; f16* S5A; f16* ZT;
    __device__ __forceinline__ void operator()(AccRef acc, const Unit& u, int wr, int wc, int fr, int fq) const { fr = opq(fr); fq = opq(fq);
        const int row0 = u.pm * BM + wr * 64 + fr, col0 = u.pn * BM + wc * 32 + 8 * fq;
#pragma unroll
        for (int ai = 0; ai < 2; ++ai)
#pragma unroll
            for (int m = 0; m < 4; ++m) { const int row = row0 + ai * HALF + m * 16;
#pragma unroll
                for (int bj = 0; bj < 2; ++bj) { const int c = col0 + bj * HALF; const f16x8 w = pack8(acc[ai][bj][m][0], acc[ai][bj][m][1]);
                    if (u.pn < 2) *(f16x8*)(S5A + (size_t)(row >> 4) * 16384 + (size_t)(c >> 4) * 512 + (row & 15) * 16 + (c & 15)) = w;
                    else if (u.pn >= 14 && u.pn < 20) {
#pragma unroll
                        for (int j = 0; j < 8; ++j) ZT[(size_t)(c - P_HY + j) * MT + row] = w[j]; }
                    else *(f16x8*)(PX + (size_t)row * PXLD + c) = w; } }
    }
};
struct EpiF16 {
    static constexpr bool PERM = true, HAS_MID = false; f16* O; int ldc;
    __device__ __forceinline__ void operator()(AccRef acc, const Unit& u, int wr, int wc, int fr, int fq) const { fr = opq(fr); fq = opq(fq);
        const int row0 = u.pm * BM + wr * 64 + fr, col0 = u.pn * BM + wc * 32 + 8 * fq;
#pragma unroll
        for (int ai = 0; ai < 2; ++ai)
#pragma unroll
            for (int m = 0; m < 4; ++m) { f16* rowp = O + (size_t)(row0 + ai * HALF + m * 16) * ldc + col0;
#pragma unroll
                for (int bj = 0; bj < 2; ++bj) *(f16x8*)(rowp + bj * HALF) = pack8(acc[ai][bj][m][0], acc[ai][bj][m][1]); }
    }
};
struct EpiS5In {
    static constexpr bool PERM = false, HAS_MID = false; float* S;
    __device__ __forceinline__ void operator()(AccRef acc, const Unit& u, int wr, int wc, int fr, int fq) const { fr = opq(fr); fq = opq(fq);
        const int row0 = u.pm * BM + wr * 64 + fr, col0 = wc * 32 + 4 * fq, g = u.pn;
#pragma unroll
        for (int ai = 0; ai < 2; ++ai)
#pragma unroll
            for (int m = 0; m < 4; ++m) { const int row = row0 + ai * HALF + m * 16; { float* rowp = S + ((size_t)row * 32 + g) * 256 + col0;
#pragma unroll
                for (int bj = 0; bj < 2; ++bj)
#pragma unroll
                    for (int n = 0; n < 2; ++n) *(f32x4*)(rowp + bj * HALF + n * 16) = acc[ai][bj][m][n]; } }
    }
};
struct EpiS5Out {
    static constexpr bool PERM = true, HAS_MID = false; const f16* S5A; f16* Y; const float* dvec;
    __device__ __forceinline__ void operator()(AccRef acc, const Unit& u, int wr, int wc, int fr, int fq) const { fr = opq(fr); fq = opq(fq);
        const int row0 = u.pm * BM + wr * 64 + fr, col0 = wc * 32 + 8 * fq, g = u.pn;
#pragma unroll
        for (int ai = 0; ai < 2; ++ai)
#pragma unroll
            for (int m = 0; m < 4; ++m) { const int chunk = row0 + ai * HALF + m * 16; {
#pragma unroll
                for (int bj = 0; bj < 2; ++bj) { const int c = col0 + bj * HALF, t = c >> 4, h0 = c & 15;
                    const f16x8 uu = *(const f16x8*)(S5A + (size_t)chunk * 16384 + (size_t)g * 512 + c);
                    const f32x4 d0 = *(const f32x4*)(dvec + g * 16 + h0), d1 = *(const f32x4*)(dvec + g * 16 + h0 + 4);
                    f16x8 w;
#pragma unroll
                    for (int j = 0; j < 4; ++j) { w[j] = (f16)gelu_tanh_(acc[ai][bj][m][0][j] * (1.0f / S5SCALE) + d0[j] * (float)uu[j]);
                                                  w[4 + j] = (f16)gelu_tanh_(acc[ai][bj][m][1][j] * (1.0f / S5SCALE) + d1[j] * (float)uu[4 + j]); }
                    *(f16x8*)(Y + (size_t)(chunk * 16 + t) * 512 + g * 16 + h0) = w; } asm volatile("" ::: "memory"); } }
    }
};
struct EpiGlu {
    static constexpr bool PERM = true, HAS_MID = false; const f16* YP; f16* O; const float* bias;
    __device__ __forceinline__ void operator()(AccRef acc, const Unit& u, int wr, int wc, int fr, int fq) const { fr = opq(fr); fq = opq(fq);
        const int row0 = u.pm * BM + wr * 64 + fr, col0 = u.pn * BM + wc * 32 + 8 * fq;
#pragma unroll
        for (int ai = 0; ai < 2; ++ai)
#pragma unroll
            for (int m = 0; m < 4; ++m) { const int row = row0 + ai * HALF + m * 16;
#pragma unroll
                for (int bj = 0; bj < 2; ++bj) { const int c = col0 + bj * HALF;
                    const f16x8 yp = *(const f16x8*)(YP + (size_t)row * 512 + c);
                    const f32x4 b0 = *(const f32x4*)(bias + c), b1 = *(const f32x4*)(bias + c + 4);
                    f16x8 w;
#pragma unroll
                    for (int j = 0; j < 4; ++j) { w[j] = (f16)((float)yp[j] * sigmoidf_(acc[ai][bj][m][0][j] + b0[j])); w[4 + j] = (f16)((float)yp[4 + j] * sigmoidf_(acc[ai][bj][m][1][j] + b1[j])); }
                    *(f16x8*)(O + (size_t)row * 2048 + c) = w; } asm volatile("" ::: "memory"); }
    }
};
template <int BR> struct EpiBranch {
    static constexpr bool PERM = true, HAS_MID = false; const f16* PX; f16* M;
    __device__ __forceinline__ void operator()(AccRef acc, const Unit& u, int wr, int wc, int fr, int fq) const { fr = opq(fr); fq = opq(fq);
        const int row0 = u.pm * BM + wr * 64 + fr, col0 = u.pn * BM + wc * 32 + 8 * fq;
#pragma unroll
        for (int ai = 0; ai < 2; ++ai)
#pragma unroll
            for (int m = 0; m < 4; ++m) { const int row = row0 + ai * HALF + m * 16;
#pragma unroll
                for (int bj = 0; bj < 2; ++bj) { const int c = col0 + bj * HALF;
                    const f16x8 gl = *(const f16x8*)(PX + (size_t)row * PXLD + P_MG + BR * 2048 + c);
                    f16* mp = M + (size_t)row * 2048 + c;
                    f16x8 prev; if (BR > 0) prev = *(const f16x8*)mp;
                    f16x8 w;
#pragma unroll
                    for (int j = 0; j < 4; ++j) { float v0 = sigmoidf_((float)gl[j]) * acc[ai][bj][m][0][j], v1 = sigmoidf_((float)gl[4 + j]) * acc[ai][bj][m][1][j];
                        if (BR > 0) { v0 += (float)prev[j]; v1 += (float)prev[4 + j]; } w[j] = (f16)v0; w[4 + j] = (f16)v1; }
                    *(f16x8*)mp = w; } asm volatile("" ::: "memory"); }
    }
};
typedef f32x4 (&AccMut)[2][2][4][2];
struct EpiBranchF {
    static constexpr bool PERM = true, HAS_MID = true; static constexpr int MID1 = 6, MID2 = 14;
    const f16* PX; f16* M;
    __device__ __forceinline__ void mid(AccMut acc, const Unit& u, int t, int wr, int wc, int fr, int fq) const { fr = opq(fr); fq = opq(fq);
        const int row0 = u.pm * BM + wr * 64 + fr, col0 = u.pn * BM + wc * 32 + 8 * fq;
        const int goff = P_MG + (t == MID1 ? 0 : 2048);
#pragma unroll
        for (int ai = 0; ai < 2; ++ai) { f16x8 za[4][2], zb[4][2];
#pragma unroll
            for (int m = 0; m < 4; ++m)
#pragma unroll
                for (int bj = 0; bj < 2; ++bj) { const f16* gp = PX + (size_t)(row0 + ai * HALF + m * 16) * PXLD + goff + col0 + bj * HALF; za[m][bj] = *(const f16x8*)gp; zb[m][bj] = *(const f16x8*)(gp + 2048); }
#pragma unroll
            for (int m = 0; m < 4; ++m)
#pragma unroll
                for (int bj = 0; bj < 2; ++bj)
#pragma unroll
                    for (int j = 0; j < 4; ++j) { acc[ai][bj][m][0][j] *= (1.0f + __expf(-(float)zb[m][bj][j])) / (1.0f + __expf(-(float)za[m][bj][j]));
                                                  acc[ai][bj][m][1][j] *= (1.0f + __expf(-(float)zb[m][bj][4 + j])) / (1.0f + __expf(-(float)za[m][bj][4 + j])); }
            asm volatile("" ::: "memory"); }
    }
    __device__ __forceinline__ void operator()(AccRef acc, const Unit& u, int wr, int wc, int fr, int fq) const { fr = opq(fr); fq = opq(fq);
        const int row0 = u.pm * BM + wr * 64 + fr, col0 = u.pn * BM + wc * 32 + 8 * fq;
#pragma unroll
        for (int ai = 0; ai < 2; ++ai) { f16x8 gl[4][2];
#pragma unroll
            for (int m = 0; m < 4; ++m)
#pragma unroll
                for (int bj = 0; bj < 2; ++bj) gl[m][bj] = *(const f16x8*)(PX + (size_t)(row0 + ai * HALF + m * 16) * PXLD + P_MG + 2 * 2048 + col0 + bj * HALF);
#pragma unroll
            for (int m = 0; m < 4; ++m)
#pragma unroll
                for (int bj = 0; bj < 2; ++bj) { f16x8 w;
#pragma unroll
                    for (int j = 0; j < 4; ++j) { w[j] = (f16)(sigmoidf_((float)gl[m][bj][j]) * acc[ai][bj][m][0][j]); w[4 + j] = (f16)(sigmoidf_((float)gl[m][bj][4 + j]) * acc[ai][bj][m][1][j]); }
                    *(f16x8*)(M + (size_t)(row0 + ai * HALF + m * 16) * 2048 + col0 + bj * HALF) = w; }
            asm volatile("" ::: "memory"); }
    }
};
struct EpiUpAct {
    static constexpr bool PERM = true, HAS_MID = false; f16* ACT; float* HALO; const float* cw; const float* cb; LAS float* HL;
    __device__ __forceinline__ void operator()(AccRef acc, const Unit& u, int wr, int wc, int fr, int fq) const { fr = opq(fr); fq = opq(fq);
        const int lane = fq * 16 + fr;
#pragma unroll
        for (int ai = 0; ai < 2; ++ai) { LAS float* hp = HL + ((ai * 2 + wr) * 4 + wc) * 64 + 8 * fq;
            if (fr == 0) { *(LAS f32x4*)(hp) = acc[ai][0][0][0]; *(LAS f32x4*)(hp + 4) = acc[ai][0][0][1]; }
            if (fr == 15) { *(LAS f32x4*)(hp + 32) = acc[ai][0][3][0]; *(LAS f32x4*)(hp + 36) = acc[ai][0][3][1]; } }
        { float* gh = HALO + ((size_t)u.pm * 44 + u.pn) * 768 + wc * 32 + 8 * fq;
          if (wr == 0 && fr < 2) { *(f32x4*)(gh + fr * 128) = acc[0][0][0][0]; *(f32x4*)(gh + fr * 128 + 4) = acc[0][0][0][1]; }
          if (wr == 0 && fr == 0) { *(f32x4*)(gh + 4 * 128) = acc[0][1][0][0]; *(f32x4*)(gh + 4 * 128 + 4) = acc[0][1][0][1]; }
          if (wr == 1 && fr >= 14) { *(f32x4*)(gh + (fr - 12) * 128) = acc[1][0][3][0]; *(f32x4*)(gh + (fr - 12) * 128 + 4) = acc[1][0][3][1]; }
          if (wr == 1 && fr == 15) { *(f32x4*)(gh + 5 * 128) = acc[1][1][3][0]; *(f32x4*)(gh + 5 * 128 + 4) = acc[1][1][3][1]; } }
        asm volatile("s_waitcnt lgkmcnt(0)" ::: "memory"); __builtin_amdgcn_s_barrier(); __builtin_amdgcn_s_barrier(); asm volatile("" ::: "memory");
        const int colg = u.pn * 128 + wc * 32 + 8 * fq;
        const int srcR = (lane & 48) | ((fr + 15) & 15), srcL = (lane & 48) | ((fr + 1) & 15);
        const int row0 = u.pm * BM + wr * 64 + fr;
#pragma unroll
        for (int n = 0; n < 2; ++n) {
            const f32x4 w0 = *(const f32x4*)(cw + colg + 4 * n), w1 = *(const f32x4*)(cw + FFH + colg + 4 * n), w2 = *(const f32x4*)(cw + 2 * FFH + colg + 4 * n), bb = *(const f32x4*)(cb + colg + 4 * n);
#pragma unroll
            for (int ai = 0; ai < 2; ++ai) {
                const bool hasp = (wr == 1) || (ai == 1), hasn = (wr == 0) || (ai == 0);
                const LAS float* pp = HL + (((wr == 1 ? ai : 0) * 2 + (wr == 1 ? 0 : 1)) * 4 + wc) * 64 + 32 + 8 * fq + 4 * n;
                const LAS float* np = HL + (((wr == 0 ? ai : 1) * 2 + (wr == 0 ? 1 : 0)) * 4 + wc) * 64 + 8 * fq + 4 * n;
                const f32x4 hprev = hasp ? *(const LAS f32x4*)pp : (f32x4){0.f, 0.f, 0.f, 0.f}, hnext = hasn ? *(const LAS f32x4*)np : (f32x4){0.f, 0.f, 0.f, 0.f};
                f32x4 R[4], L[4];
#pragma unroll
                for (int m = 0; m < 4; ++m)
#pragma unroll
                    for (int j = 0; j < 4; ++j) { R[m][j] = __shfl(acc[ai][0][m][n][j], srcR); L[m][j] = __shfl(acc[ai][0][m][n][j], srcL); }
#pragma unroll
                for (int m = 0; m < 4; ++m) { const f32x4 pv = fr > 0 ? R[m] : (m > 0 ? R[m > 0 ? m - 1 : 0] : hprev); const f32x4 nv = fr < 15 ? L[m] : (m < 3 ? L[m < 3 ? m + 1 : 3] : hnext);
                    const f32x4 a = w0 * pv + w1 * acc[ai][0][m][n] + w2 * nv + bb;
                    f16x4 o;
#pragma unroll
                    for (int j = 0; j < 4; ++j) o[j] = (f16)(siluf_(a[j]) * acc[ai][1][m][n][j]);
                    *(f16x4*)(ACT + (size_t)(row0 + ai * HALF + m * 16) * FFH + colg + 4 * n) = o; }
                asm volatile("" ::: "memory");
            }
        }
    }
};
struct EpiSlab {
    static constexpr bool PERM = false, HAS_MID = false; float* slab; const float* mod; int goff;
    __device__ __forceinline__ void operator()(AccRef acc, const Unit& u, int wr, int wc, int fr, int fq) const { fr = opq(fr); fq = opq(fq);
        const int pn = u.pn & 255, ks = u.pn >> 8;
        const int row0 = (u.pm - 64) * BM + wr * 64 + fr, col0 = pn * BM + wc * 32 + 4 * fq;
        const float* gp = mod + 2 * 12288 + goff + col0;
        f32x4 gv[2][2];
#pragma unroll
        for (int bj = 0; bj < 2; ++bj)
#pragma unroll
            for (int n = 0; n < 2; ++n) gv[bj][n] = *(const f32x4*)(gp + bj * HALF + n * 16);
        float* sp = slab + (size_t)ks * MC * D;
#pragma unroll
        for (int ai = 0; ai < 2; ++ai)
#pragma unroll
            for (int m = 0; m < 4; ++m) { float* rowp = sp + (size_t)(row0 + ai * HALF + m * 16) * D + col0;
#pragma unroll
                for (int bj = 0; bj < 2; ++bj)
#pragma unroll
                    for (int n = 0; n < 2; ++n) *(f32x4*)(rowp + bj * HALF + n * 16) = gv[bj][n] * acc[ai][bj][m][n]; }
    }
};
struct EpiResid {
    static constexpr bool PERM = false, HAS_MID = false; float* X; const float* mod; int goff;
    __device__ __forceinline__ void operator()(AccRef acc, const Unit& u, int wr, int wc, int fr, int fq) const { fr = opq(fr); fq = opq(fq);
        const int row0 = u.pm * BM + wr * 64 + fr, col0 = u.pn * BM + wc * 32 + 4 * fq;
        const int bsel = u.pm < 32 ? 0 : (u.pm < 64 ? 1 : 2);
        const float* gp = mod + bsel * 12288 + goff + col0;
        f32x4 gv[2][2];
#pragma unroll
        for (int bj = 0; bj < 2; ++bj)
#pragma unroll
            for (int n = 0; n < 2; ++n) gv[bj][n] = *(const f32x4*)(gp + bj * HALF + n * 16);
#pragma unroll
        for (int ai = 0; ai < 2; ++ai)
#pragma unroll
            for (int mp = 0; mp < 2; ++mp) { f32x4 xv[2][2][2];
#pragma unroll
                for (int mm = 0; mm < 2; ++mm) { const float* rowp = X + (size_t)(row0 + ai * HALF + (2 * mp + mm) * 16) * D + col0;
#pragma unroll
                    for (int bj = 0; bj < 2; ++bj)
#pragma unroll
                        for (int n = 0; n < 2; ++n) xv[mm][bj][n] = *(const f32x4*)(rowp + bj * HALF + n * 16); }
#pragma unroll
                for (int mm = 0; mm < 2; ++mm) { float* rowp = X + (size_t)(row0 + ai * HALF + (2 * mp + mm) * 16) * D + col0;
#pragma unroll
                    for (int bj = 0; bj < 2; ++bj)
#pragma unroll
                        for (int n = 0; n < 2; ++n) *(f32x4*)(rowp + bj * HALF + n * 16) = xv[mm][bj][n] + gv[bj][n] * acc[ai][bj][2 * mp + mm][n]; }
                asm volatile("" ::: "memory"); }
    }
};
}


__device__ __forceinline__ void ph_prologue(const Ctx& F, const Args& A) {
    const int gt = F.bid * 512 + F.tid, NT = F.G * 512;
    { const f32x4* xs = (const f32x4*)A.in[I_X]; const f32x4* cs = (const f32x4*)A.in[I_CTX]; f32x4* xr = (f32x4*)(F.ws + WS_XRES);
      for (int i = gt; i < MX * D / 4; i += NT) xr[i] = xs[i];
      for (int i = gt; i < MC * D / 4; i += NT) xr[MX * D / 4 + i] = cs[i]; }
    { f32x2* tw = (f32x2*)(F.ws + WS_TW);
      for (int k = gt; k < 16384; k += NT) { float s, c; sincospif((float)k * (2.0f / 16384.0f), &s, &c); tw[k] = (f32x2){c, -s}; } }
    LAS float* sc = (LAS float*)F.lds;
    LAS float* red = (LAS float*)(F.lds + 3 * 2048 * 4);
    for (int i = F.tid; i < 3 * 2048; i += 512) { const int r = i / 2048, k = i % 2048; const float v = r < 2 ? A.in[I_C][r * 2048 + k] : A.in[I_CCTX][k]; sc[i] = siluf_(v); }
    __syncthreads();
    const int col = F.tid & 63, ks = F.tid >> 6;
    for (int chunk = F.bid; chunk < DEPTH * 192; chunk += F.G) {
        const int l = chunk / 192, n0 = (chunk % 192) * 64;
        const float* w = A.in[I_WMOD] + (size_t)l * 2048 * 12288 + n0 + col;
        float s0 = 0.f, s1 = 0.f, s2 = 0.f;
#pragma unroll 8
        for (int k = ks * 256; k < ks * 256 + 256; ++k) { const float wv = w[(size_t)k * 12288]; s0 += sc[k] * wv; s1 += sc[2048 + k] * wv; s2 += sc[4096 + k] * wv; }
        red[(ks * 3 + 0) * 64 + col] = s0; red[(ks * 3 + 1) * 64 + col] = s1; red[(ks * 3 + 2) * 64 + col] = s2;
        __syncthreads();
        if (F.tid < 192) { const int r = F.tid >> 6, c2 = F.tid & 63; float s = 0.f;
#pragma unroll
            for (int q = 0; q < 8; ++q) s += red[(q * 3 + r) * 64 + c2];
            ((float*)(F.ws + WS_MOD))[((size_t)l * 3 + r) * 12288 + n0 + c2] = s + A.in[I_BMOD][(size_t)l * 12288 + n0 + c2]; }
        __syncthreads();
    }
}

__device__ __forceinline__ void conv_item(const float* W, int ldw, int k0, int srccol, f16* WT, int dstrow, int ldk) {
    float v[64];
    const float* src = W + (size_t)k0 * ldw + (srccol >= 0 ? srccol : 0);
#pragma unroll
    for (int k = 0; k < 64; ++k) v[k] = src[(size_t)k * ldw];
    f16* dst = WT + (size_t)dstrow * ldk + k0;
#pragma unroll
    for (int kg = 0; kg < 8; ++kg) { f16x8 o;
#pragma unroll
        for (int e = 0; e < 8; ++e) o[e] = srccol >= 0 ? (f16)v[8 * kg + e] : (f16)0.f;
        *(f16x8*)(dst + 8 * kg) = o; }
}
__device__ __forceinline__ void ph_convert_weights(const Ctx& F, const Args& A, int l) {
    const int skip = F.G > 64 ? 32 : 0;
    if (F.bid < skip) return;
    const int gw = (F.bid - skip) * 8 + F.wave, NGW = (F.G - skip) * 8, lane = F.lane;
    constexpr int I_IN = 32 * 180, I_GLU = 8 * 8, I_BR = 32 * 32, I_OUT = 32 * 32, I_UP = 32 * 176, I_DN = 88 * 32;
    constexpr int NIT = I_IN + I_GLU + I_BR + I_OUT + I_UP + I_DN;
    for (int it = gw; it < NIT; it += NGW) {
        int r = it;
        if (r < I_IN) { const int kb = r / 180, nb = r % 180, j = nb * 64 + lane;
            const int src = j < 2048 ? j : (j < 11264 ? j + 32 : (j < 11296 ? 2048 + (j - 11264) : -1));
            conv_item(A.in[I_WIN] + (size_t)l * 2048 * INW, INW, kb * 64, src, (f16*)(F.ws + WS_WIN), j, 2048); continue; } r -= I_IN;
        if (r < I_GLU) { const int kb = r / 8, nb = r % 8, j = nb * 64 + lane; conv_item(A.in[I_GLUW] + (size_t)l * 512 * 512, 512, kb * 64, j, (f16*)(F.ws + WS_WGLU), j, 512); continue; } r -= I_GLU;
        if (r < I_BR) { const int kb = r / 32, nb = r % 32, j = nb * 64 + lane; conv_item(A.in[I_WBR] + (size_t)l * 2048 * 2048, 2048, kb * 64, j, (f16*)(F.ws + WS_WBR), j, 2048); continue; } r -= I_BR;
        if (r < I_OUT) { const int kb = r / 32, nb = r % 32, j = nb * 64 + lane; conv_item(A.in[I_WOUT] + (size_t)l * 2048 * 2048, 2048, kb * 64, j, (f16*)(F.ws + WS_WOUT), j, 2048); continue; } r -= I_OUT;
        if (r < I_UP) { const int kb = r / 176, nb = r % 176, j = nb * 64 + lane, pn = j >> 8, i = j & 255; const int src = i < 128 ? 128 * pn + i : FFH + 128 * pn + (i - 128);
            conv_item(A.in[I_WUP] + (size_t)l * 2048 * UPLD, UPLD, kb * 64, src, (f16*)(F.ws + WS_WUP), j, 2048); continue; } r -= I_UP;
        { const int kb = r / 32, nb = r % 32, j = nb * 64 + lane; conv_item(A.in[I_WDN] + (size_t)l * FFH * 2048, 2048, kb * 64, j, (f16*)(F.ws + WS_WDN), j, FFH); }
    }
}

__device__ __forceinline__ void s5_mats_group(const Ctx& F, const Args& A, int l, int g) {
    LAS f32x2* APOW = (LAS f32x2*)F.lds;
    LAS f32x2* BBAR = APOW + 2 * 17 * 64;
    LAS f32x2* CM = BBAR + 2 * 64 * 16;
    LAS float* KLAG = (LAS float*)(CM + 2 * 16 * 64);
    __syncthreads();
    for (int i = F.tid; i < 2 * 17 * 64; i += 512) { const int d = i / (17 * 64), e = (i / 64) % 17, n = i % 64;
        const size_t pi = (((size_t)l * 2 + d) * 32 + g) * 64 + n;
        const float are = A.in[I_S5ARE][pi], aim = A.in[I_S5AIM][pi], dt = expf(A.in[I_S5STEP][((size_t)l * 2 + d) * 32 + g]);
        const float zr = are * dt * (float)e, zi = aim * dt * (float)e; float s, c; sincosf(zi, &s, &c); const float m = expf(zr);
        APOW[i] = (f32x2){m * c, m * s}; }
    __syncthreads();
    for (int i = F.tid; i < 2 * 64 * 16; i += 512) { const int d = i / 1024, n = (i / 16) % 64, h = i % 16;
        const size_t pi = (((size_t)l * 2 + d) * 32 + g) * 64 + n;
        const float are = A.in[I_S5ARE][pi], aim = A.in[I_S5AIM][pi];
        const f32x2 ab = APOW[(d * 17 + 1) * 64 + n]; const f32x2 num = (f32x2){ab.x - 1.0f, ab.y};
        const float den = are * are + aim * aim; const f32x2 q = (f32x2){(num.x * are + num.y * aim) / den, (num.y * are - num.x * aim) / den};
        const size_t bi = (pi * 16) + h;
        BBAR[i] = cmul(q, (f32x2){A.in[I_S5BRE][bi], A.in[I_S5BIM][bi]});
        const size_t ci = ((((size_t)l * 2 + d) * 32 + g) * 16 + h) * 64 + n;
        CM[(d * 16 + h) * 64 + n] = (f32x2){A.in[I_S5CRE][ci], A.in[I_S5CIM][ci]}; }
    __syncthreads();
    for (int i = F.tid; i < 2 * 16 * 256; i += 512) { const int d = i / 4096, lag = (i / 256) % 16, h = (i / 16) % 16, hp = i % 16; float s = 0.f;
        for (int n = 0; n < 64; ++n) { const f32x2 t = cmul(CM[(d * 16 + h) * 64 + n], APOW[(d * 17 + lag) * 64 + n]); const f32x2 b = BBAR[(d * 64 + n) * 16 + hp]; s += t.x * b.x - t.y * b.y; }
        KLAG[i] = s; }
    __syncthreads();
    f16* W = (f16*)(F.ws + WS_S5W) + (size_t)g * 256 * 512;
    for (int i = F.tid; i < 256 * 64; i += 512) { const int n = i / 64, k8 = (i % 64) * 8, t = n >> 4, h = n & 15; f16x8 o;
#pragma unroll
        for (int e = 0; e < 8; ++e) { const int k = k8 + e; float v;
            if (k < 256) { const int s = k >> 4, hp = k & 15; v = 0.f;
                if (t >= s) v += KLAG[((0 * 16 + (t - s)) * 16 + h) * 16 + hp];
                if (s >= t) v += KLAG[((1 * 16 + (s - t)) * 16 + h) * 16 + hp];
                v *= S5SCALE; }
            else { const int d = (k - 256) >> 7, nn2 = (k - 256) & 127, nn = nn2 & 63, im = nn2 >> 6, ex = d == 0 ? t + 1 : 16 - t;
                const f32x2 z = cmul(CM[(d * 16 + h) * 64 + nn], APOW[(d * 17 + ex) * 64 + nn]); v = im ? -z.y : z.x; }
            o[e] = (f16)v; }
        *(f16x8*)(W + (size_t)n * 512 + k8) = o; }
    f16* Mx = (f16*)(F.ws + WS_S5M) + (size_t)g * 256 * 256;
    for (int i = F.tid; i < 256 * 32; i += 512) { const int n = i / 32, k8 = (i % 32) * 8, d = n >> 7, ri = (n >> 6) & 1, nn = n & 63; f16x8 o;
#pragma unroll
        for (int e = 0; e < 8; ++e) { const int k = k8 + e, s = k >> 4, hp = k & 15, ex = d == 0 ? 15 - s : s;
            const f32x2 z = cmul(APOW[(d * 17 + ex) * 64 + nn], BBAR[(d * 64 + nn) * 16 + hp]); o[e] = (f16)((ri ? z.y : z.x) * S5SCALE); }
        *(f16x8*)(Mx + (size_t)n * 256 + k8) = o; }
    if (F.tid < 128) { const int d = F.tid >> 6, nn = F.tid & 63; ((f32x2*)(F.ws + WS_S5AT))[(d * 32 + g) * 64 + nn] = APOW[(d * 17 + 16) * 64 + nn]; }
    __syncthreads();
}

__device__ __forceinline__ void ph_hyena_h2(const Ctx& F, const Args& A, int l) {
    LAS float* W1 = (LAS float*)F.lds;
    LAS float* W2 = W1 + 33 * 64;
    LAS float* PV = W2 + 64 * 64;
    LAS float* SCR = PV + 256;
    __syncthreads();
    for (int i = F.tid; i < 33 * 64; i += 512) W1[i] = A.in[I_HYW1][(size_t)l * 33 * 64 + i];
    for (int i = F.tid; i < 64 * 64; i += 512) W2[i] = A.in[I_HYW2][(size_t)l * 4096 + i];
    if (F.tid < 64) { PV[F.tid] = A.in[I_HYB1][l * 64 + F.tid]; PV[64 + F.tid] = A.in[I_HYF1][l * 64 + F.tid]; PV[128 + F.tid] = A.in[I_HYB2][l * 64 + F.tid]; PV[192 + F.tid] = A.in[I_HYF2][l * 64 + F.tid]; }
    __syncthreads();
    LAS float* scr = SCR + F.wave * 64;
    const int gw = F.bid * 8 + F.wave, NGW = F.G * 8, j = F.lane;
    float* H2 = (float*)(F.ws + WS_H2);
    for (int p = gw; p < SEQ + LC; p += NGW) {
        const int n = p < SEQ ? SEQ : LC, pos = p < SEQ ? p : p - SEQ;
        float feat = 0.f;
        if (j == 0) feat = (float)pos / (float)(n - 1);
        else if (j < 33) { const int fi = (j - 1) & 15; const float fr = 1e-4f + (float)fi * ((15.0f - 1e-4f) / 15.0f);
            const float ang = (6.283185307179586f / (float)n) * (float)pos * fr; float s, c; sincosf(ang, &s, &c); feat = j < 17 ? c : -s; }
        scr[j] = feat; LDS_WAIT(); asm volatile("" ::: "memory");
        float a = PV[j];
        for (int i = 0; i < 33; ++i) a += scr[i] * W1[i * 64 + j];
        const float h1 = sinf(PV[64 + j] * a);
        LDS_WAIT(); asm volatile("" ::: "memory");
        scr[j] = h1; LDS_WAIT(); asm volatile("" ::: "memory");
        float b = PV[128 + j];
        for (int i = 0; i < 64; ++i) b += scr[i] * W2[i * 64 + j];
        H2[(size_t)p * 64 + j] = sinf(PV[192 + j] * b);
        LDS_WAIT(); asm volatile("" ::: "memory");
    }
}

__device__ __forceinline__ void ph_norm(const Ctx& F, const Args& A, int l, int which, int nrows, int nslab) {
    const int gw = F.bid * 8 + F.wave, NGW = F.G * 8;
    float* X = (float*)(F.ws + WS_XRES); f16* O = (f16*)(F.ws + WS_HN); const float* SL = (const float*)(F.ws + WS_SLAB);
    const float* gain = A.in[which ? I_N2G : I_N1G] + (size_t)l * D;
    const float* mod = (const float*)(F.ws + WS_MOD) + (size_t)l * 3 * 12288;
    const int shoff = which ? 6144 : 0, soff = which ? 8192 : 2048;
    for (int m = gw; m < nrows; m += NGW) {
        const int bsel = m < SEQ ? 0 : (m < MX ? 1 : 2);
        f32x4* xr = (f32x4*)(X + (size_t)m * D) + F.lane;
        f32x4 v[8]; float s = 0.f;
#pragma unroll
        for (int j = 0; j < 8; ++j) v[j] = xr[64 * j];
        if (m >= MX && nslab > 0) {
            for (int sl = 0; sl < nslab; ++sl) { const f32x4* sr = (const f32x4*)(SL + ((size_t)sl * MC + (m - MX)) * D) + F.lane;
#pragma unroll
                for (int j = 0; j < 8; ++j) v[j] = v[j] + sr[64 * j]; }
#pragma unroll
            for (int j = 0; j < 8; ++j) xr[64 * j] = v[j]; }
#pragma unroll
        for (int j = 0; j < 8; ++j) s += (v[j].x * v[j].x + v[j].y * v[j].y) + (v[j].z * v[j].z + v[j].w * v[j].w);
        const float rstd = 1.0f / sqrtf(wave_sum(s) * (1.0f / D) + EPS);
        const float* mp = mod + bsel * 12288;
#pragma unroll
        for (int j = 0; j < 8; ++j) { const int c = 4 * F.lane + 256 * j;
            const f32x4 g = *(const f32x4*)(gain + c), sh = *(const f32x4*)(mp + shoff + c), sc = *(const f32x4*)(mp + soff + c);
            f16x4 o;
#pragma unroll
            for (int e = 0; e < 4; ++e) o[e] = (f16)(v[j][e] * rstd * g[e] * (1.0f + sc[e]) + sh[e]);
            *(f16x4*)(O + (size_t)m * D + c) = o; }
    }
}
__device__ __forceinline__ void ph_final_norm(const Ctx& F, const Args& A) {
    const int gw = F.bid * 8 + F.wave, NGW = F.G * 8;
    const float* X = (const float*)(F.ws + WS_XRES); const float* gain = A.in[I_FNG];
    for (int m = gw; m < MX; m += NGW) {
        const f32x4* xr = (const f32x4*)(X + (size_t)m * D) + F.lane;
        f32x4 v[8]; float s = 0.f;
#pragma unroll
        for (int j = 0; j < 8; ++j) { v[j] = xr[64 * j]; s += (v[j].x * v[j].x + v[j].y * v[j].y) + (v[j].z * v[j].z + v[j].w * v[j].w); }
        const float rstd = 1.0f / sqrtf(wave_sum(s) * (1.0f / D) + EPS);
#pragma unroll
        for (int j = 0; j < 8; ++j) { const int c = 4 * F.lane + 256 * j; const f32x4 g = *(const f32x4*)(gain + c);
            *(f32x4*)(A.out + (size_t)m * D + c) = v[j] * rstd * g; }
    }
}

__device__ __forceinline__ void ph_s5_scan(const Ctx& F) {
    if (F.tid >= 32) return;
    const float* S = (const float*)(F.ws + WS_S5S); f16* SA = (f16*)(F.ws + WS_S5A);
    for (int gt = F.bid * 32 + F.tid; gt < 2 * 2 * 32 * 64; gt += F.G * 32) {
        const int nn = gt & 63, g = (gt >> 6) & 31, d = (gt >> 11) & 1, b = gt >> 12;
        const f32x2 at = ((const f32x2*)(F.ws + WS_S5AT))[(d * 32 + g) * 64 + nn];
        f32x2 st = (f32x2){0.f, 0.f};
        for (int base = 0; base < 16 + 512; base += 16) {
            f32x2 loc[16]; int chk[16];
#pragma unroll
            for (int u = 0; u < 16; ++u) { const int step = base + u; int chunk;
                if (d == 0) chunk = step < 16 ? 1024 + b * 16 + step : b * 512 + (step - 16);
                else chunk = step < 16 ? 1024 + b * 16 + (15 - step) : b * 512 + (511 - (step - 16));
                chk[u] = chunk; const size_t so = ((size_t)chunk * 32 + g) * 256 + d * 128 + nn;
                loc[u] = (f32x2){S[so], S[so + 64]}; }
#pragma unroll
            for (int u = 0; u < 16; ++u) { f16* xp = SA + (size_t)chk[u] * 16384 + (size_t)g * 512 + 256 + d * 128 + nn;
                xp[0] = (f16)st.x; xp[64] = (f16)st.y;
                st = cmul(at, st) + loc[u]; }
        }
    }
}

__device__ __forceinline__ void ph_ffn_fix(const Ctx& F, const Args& A, int l, int nMr) {
    const float* HALO = (const float*)(F.ws + WS_HALO); f16* ACT = (f16*)(F.ws + WS_ACT);
    const float* cw = A.in[I_FFCW] + (size_t)l * 3 * FFH; const float* cb = A.in[I_FFCB] + (size_t)l * FFH;
    const int NT = nMr * 44 * 2 * 128;
    for (int task = F.bid * 512 + F.tid; task < NT; task += F.G * 512) {
        const int c = task & 127, which = (task >> 7) & 1, tile = task >> 8, pn = tile % 44, pm = tile / 44;
        const float* h = HALO + ((size_t)pm * 44 + pn) * 768 + c; const int col = pn * 128 + c;
        const bool first = (pm == 0 || pm == 32 || pm >= 64), last = (pm == 31 || pm >= 63);
        float ap, ac, an, b;
        if (which == 0) { ap = first ? 0.f : HALO[((size_t)(pm - 1) * 44 + pn) * 768 + 3 * 128 + c]; ac = h[0]; an = h[128]; b = h[4 * 128]; }
        else { ap = h[2 * 128]; ac = h[3 * 128]; an = last ? 0.f : HALO[((size_t)(pm + 1) * 44 + pn) * 768 + c]; b = h[5 * 128]; }
        const float a = cw[col] * ap + cw[FFH + col] * ac + cw[2 * FFH + col] * an + cb[col];
        ACT[(size_t)(pm * 256 + (which ? 255 : 0)) * FFH + col] = (f16)(siluf_(a) * b);
    }
}

namespace gla {
constexpr int QK_LD = 136, KH_LD = 72, VT_LD = 72, P_LD = 72;
constexpr int OFF_QT = 0;
constexpr int OFF_KT = 17408;
constexpr int OFF_VT = OFF_KT + 18432;
constexpr int OFF_P = OFF_VT + 36864;
constexpr int OFF_LR = OFF_P + 9216;
constexpr int OFF_GT = OFF_LR + 4096;
constexpr int OFF_DEC = OFF_GT + 2048;
constexpr int OFF_RS = OFF_DEC + 512;
constexpr int OFF_QR = OFF_RS + 2048;
constexpr int OFF_KR = OFF_QR + 17408;
constexpr int OFF_WG = OFF_KR + 17408;
static_assert(OFF_WG + 8192 <= LDSCTL_OFF, "gla lds");

__device__ __forceinline__ int grow(int b, int sc, int j, int i) {
    if (sc < 32) { const int col = 2 * sc + (j >> 1), r = (j & 1) * 64 + i; return b * SEQ + r * 64 + col; }
    return MX + b * LC + j * 64 + i;
}
#define GLA_MFMA(a, b, c) __builtin_amdgcn_mfma_f32_16x16x32_f16(a, b, c, 0, 0, 0)

template <bool FULL>
__device__ __forceinline__ void gla_unit(const Ctx& F, const Args& A, int l, int unit) {
    const int b = unit / (4 * NSC), h = (unit / NSC) % 4, sc = unit % NSC;
    LAS f16* QT = (LAS f16*)(F.lds + OFF_QT); LAS f16* KT = (LAS f16*)(F.lds + OFF_KT); LAS f16* VT = (LAS f16*)(F.lds + OFF_VT);
    LAS f16* PP = (LAS f16*)(F.lds + OFF_P); LAS f16* LR = (LAS f16*)(F.lds + OFF_LR);
    LAS float* GT = (LAS float*)(F.lds + OFF_GT); LAS float* DEC = (LAS float*)(F.lds + OFF_DEC); LAS float* RS = (LAS float*)(F.lds + OFF_RS);
    LAS f16* QR = (LAS f16*)(F.lds + OFF_QR); LAS f16* KR = (LAS f16*)(F.lds + OFF_KR); LAS float* WG = (LAS float*)(F.lds + OFF_WG);
    const int tid = F.tid, lane = F.lane, w = F.wave, q0 = lane >> 4, c0 = lane & 15;
    const int dk0 = tid & 127, ig0 = tid >> 7;
    const f16* PX = (const f16*)(F.ws + WS_PX);
    const float scale = 0.08838834764831845f;
    for (int dir = 0; dir < 2; ++dir) {
        __syncthreads();
        for (int i = tid; i < 16 * 128; i += 512) WG[i] = A.in[I_GLAWG][(((size_t)l * 2 + dir) * 16 + (i >> 7)) * 512 + h * 128 + (i & 127)];
        const float bgv = A.in[I_GLABG][((size_t)l * 2 + dir) * 512 + h * 128 + dk0];
        const size_t sidx = ((((size_t)b * 4 + h) * NSC + sc) * 2 + dir);
        f32x4 accS[8][2];
        if (FULL) { const float* Sin = (const float*)(F.ws + WS_GSIN) + sidx * 32768; const int q = opq(q0), c = opq(c0);
#pragma unroll
            for (int dt = 0; dt < 8; ++dt)
#pragma unroll
                for (int et = 0; et < 2; ++et)
#pragma unroll
                    for (int r = 0; r < 4; ++r) accS[dt][et][r] = Sin[(16 * dt + 4 * q + r) * 256 + 32 * w + 16 * et + c]; }
        else {
#pragma unroll
            for (int dt = 0; dt < 8; ++dt)
#pragma unroll
                for (int et = 0; et < 2; ++et) accS[dt][et] = (f32x4){0.f, 0.f, 0.f, 0.f}; }
        float sumtot = 0.f;
        for (int jj = 0; jj < 4; ++jj) {
            const int j = dir ? 3 - jj : jj;
            __syncthreads();
            const int tid = opq(F.tid);
            if (tid < 256) { const int row = tid >> 2, part = tid & 3; const int gr = grow(b, sc, j, row);
                *(LAS f16x8*)(LR + row * 32 + part * 8) = *(const f16x8*)(PX + (size_t)gr * PXLD + P_GG + part * 8); }
#pragma unroll 1
            for (int k = 0; k < 4; ++k) { const int idx = tid + 512 * k, wi = idx >> 6, ln = idx & 63, rr = ln >> 2, cc = ln & 3;
                const int row = (wi & 3) * 16 + rr, chunk = (wi >> 2) * 4 + cc; const int gr = grow(b, sc, j, row);
                const f16x8 v8 = *(const f16x8*)(PX + (size_t)gr * PXLD + P_GV + h * 256 + chunk * 8);
#pragma unroll
                for (int e = 0; e < 8; ++e) VT[(chunk * 8 + e) * VT_LD + row] = v8[e]; }
#pragma unroll 1
            for (int k = 0; k < 2; ++k) { const int idx = tid + 512 * k, row = idx >> 4, ch = idx & 15; const int gr = grow(b, sc, j, row);
                *(LAS f16x8*)(KR + row * QK_LD + ch * 8) = *(const f16x8*)(PX + (size_t)gr * PXLD + P_GK + h * 128 + ch * 8);
                if (FULL) *(LAS f16x8*)(QR + row * QK_LD + ch * 8) = *(const f16x8*)(PX + (size_t)gr * PXLD + P_GQ + h * 128 + ch * 8); }
            __syncthreads();
            const int dk = opq(dk0), ig = opq(ig0);
            float bv[16];
#pragma unroll
            for (int ii = 0; ii < 16; ++ii) { const int i = ig * 16 + ii; float pre = bgv;
                const f16x8 l0 = *(const LAS f16x8*)(LR + i * 32 + dir * 16), l1 = *(const LAS f16x8*)(LR + i * 32 + dir * 16 + 8);
#pragma unroll
                for (int r = 0; r < 8; ++r) pre += (float)l0[r] * WG[r * 128 + dk] + (float)l1[r] * WG[(8 + r) * 128 + dk];
                bv[ii] = logsigmoidf_(pre) * (1.0f / 16.0f); }
            float totloc;
            if (dir == 0) {
#pragma unroll
                for (int ii = 1; ii < 16; ++ii) bv[ii] += bv[ii - 1];
                totloc = bv[15]; }
            else {
#pragma unroll
                for (int ii = 14; ii >= 0; --ii) bv[ii] += bv[ii + 1];
                totloc = bv[0]; }
            GT[ig * 128 + dk] = totloc;
            __syncthreads();
            const float g0 = GT[dk], g1 = GT[128 + dk], g2 = GT[256 + dk], g3 = GT[384 + dk];
            const float total = (g0 + g1) + (g2 + g3);
            float off, bmid;
            if (dir == 0) { off = (ig > 0 ? g0 : 0.f) + (ig > 1 ? g1 : 0.f) + (ig > 2 ? g2 : 0.f); bmid = g0 + g1; }
            else { off = (ig < 3 ? g3 : 0.f) + (ig < 2 ? g2 : 0.f) + (ig < 1 ? g1 : 0.f); bmid = g2 + g3; }
#pragma unroll
            for (int ii = 0; ii < 16; ++ii) bv[ii] += off;
            if (FULL) {
#pragma unroll
                for (int ii = 0; ii < 16; ++ii) { const int i = ig * 16 + ii;
                    QT[i * QK_LD + dk] = (f16)((float)QR[i * QK_LD + dk] * scale * __expf(fminf(bv[ii] - bmid, 9.f)));
                    KT[i * QK_LD + dk] = (f16)((float)KR[i * QK_LD + dk] * __expf(fminf(bmid - bv[ii], 9.f))); }
                __syncthreads();
                { const int c = opq(c0), q = opq(q0);
#pragma unroll
                for (int s = 0; s < 2; ++s) { const int T = 2 * w + s, it = T >> 2, jt = T & 3; f32x4 a = (f32x4){0.f, 0.f, 0.f, 0.f};
#pragma unroll
                    for (int kk = 0; kk < 4; ++kk) { const f16x8 kf = *(const LAS f16x8*)(KT + (jt * 16 + c) * QK_LD + kk * 32 + 8 * q);
                        const f16x8 qf = *(const LAS f16x8*)(QT + (it * 16 + c) * QK_LD + kk * 32 + 8 * q); a = GLA_MFMA(kf, qf, a); }
                    const int i = it * 16 + c; f16x4 pv;
#pragma unroll
                    for (int r = 0; r < 4; ++r) { const int jx = jt * 16 + 4 * q + r; const bool keep = dir == 0 ? (jx <= i) : (jx >= i); pv[r] = keep ? (f16)a[r] : (f16)0.f; }
                    *(LAS f16x4*)(PP + i * P_LD + jt * 16 + 4 * q) = pv; } }
                __syncthreads();
#pragma unroll
                for (int ii = 0; ii < 16; ++ii) { const int i = ig * 16 + ii; QT[i * QK_LD + dk] = (f16)((float)QR[i * QK_LD + dk] * scale * __expf(bv[ii])); }
            }
            { f16x8 k0, k1;
#pragma unroll
              for (int ii = 0; ii < 8; ++ii) { k0[ii] = (f16)((float)KR[(ig * 16 + ii) * QK_LD + dk] * __expf(total - bv[ii])); k1[ii] = (f16)((float)KR[(ig * 16 + 8 + ii) * QK_LD + dk] * __expf(total - bv[8 + ii])); }
              *(LAS f16x8*)(KT + dk * KH_LD + ig * 16) = k0; *(LAS f16x8*)(KT + dk * KH_LD + ig * 16 + 8) = k1; }
            if (ig == 0) { DEC[dk] = __expf(total); sumtot += total; }
            __syncthreads();
            const int c = opq(c0), q = opq(q0);
            if (FULL) {
                f32x4 accO[4][2];
#pragma unroll
                for (int it = 0; it < 4; ++it)
#pragma unroll
                    for (int et = 0; et < 2; ++et) accO[it][et] = (f32x4){0.f, 0.f, 0.f, 0.f};
#pragma unroll
                for (int et = 0; et < 2; ++et)
#pragma unroll
                    for (int kk = 0; kk < 2; ++kk) { const f16x8 vf = *(const LAS f16x8*)(VT + (32 * w + 16 * et + c) * VT_LD + kk * 32 + 8 * q);
#pragma unroll
                        for (int it = 0; it < 4; ++it) { const f16x8 pf = *(const LAS f16x8*)(PP + (it * 16 + c) * P_LD + kk * 32 + 8 * q); accO[it][et] = GLA_MFMA(vf, pf, accO[it][et]); } asm volatile("" ::: "memory"); }
#pragma unroll
                for (int kb = 0; kb < 4; ++kb)
#pragma unroll
                    for (int et = 0; et < 2; ++et) { f16x8 sf; asm volatile("" ::: "memory");
#pragma unroll
                        for (int e = 0; e < 4; ++e) { sf[e] = (f16)accS[2 * kb][et][e]; sf[4 + e] = (f16)accS[2 * kb + 1][et][e]; }
#pragma unroll
                        for (int it = 0; it < 4; ++it) { const f16x4 lo = *(const LAS f16x4*)(QT + (it * 16 + c) * QK_LD + 32 * kb + 4 * q), hi = *(const LAS f16x4*)(QT + (it * 16 + c) * QK_LD + 32 * kb + 16 + 4 * q);
                            f16x8 qf; qf[0] = lo[0]; qf[1] = lo[1]; qf[2] = lo[2]; qf[3] = lo[3]; qf[4] = hi[0]; qf[5] = hi[1]; qf[6] = hi[2]; qf[7] = hi[3];
                            accO[it][et] = GLA_MFMA(sf, qf, accO[it][et]); } }
                float* OF = (float*)(F.ws + WS_GOF);
                if (dir == 0) {
#pragma unroll
                    for (int it = 0; it < 4; ++it) { const int gr = grow(b, sc, j, it * 16 + c);
#pragma unroll
                        for (int et = 0; et < 2; ++et) *(f32x4*)(OF + (size_t)gr * 1024 + h * 256 + 32 * w + 16 * et + 4 * q) = accO[it][et];
                        asm volatile("" ::: "memory"); } }
                else {
                    int grs[4];
#pragma unroll
                    for (int it = 0; it < 4; ++it) { grs[it] = grow(b, sc, j, it * 16 + c); float ss = 0.f;
#pragma unroll
                        for (int et = 0; et < 2; ++et) { accO[it][et] = accO[it][et] + *(const f32x4*)(OF + (size_t)grs[it] * 1024 + h * 256 + 32 * w + 16 * et + 4 * q);
                            ss += (accO[it][et][0] * accO[it][et][0] + accO[it][et][1] * accO[it][et][1]) + (accO[it][et][2] * accO[it][et][2] + accO[it][et][3] * accO[it][et][3]); }
                        ss += __shfl_xor(ss, 16); ss += __shfl_xor(ss, 32);
                        if (q == 0) RS[(it * 16 + c) * 8 + w] = ss; asm volatile("" ::: "memory"); }
                    __syncthreads();
                    const float* ng = A.in[I_GLANG] + (size_t)l * 256;
                    f16* Y = (f16*)(F.ws + WS_YCAT);
#pragma unroll
                    for (int it = 0; it < 4; ++it) { const int i = it * 16 + c; const f32x4 ra = *(const LAS f32x4*)(RS + i * 8), rb = *(const LAS f32x4*)(RS + i * 8 + 4);
                        const float tot = ((ra[0] + ra[1]) + (ra[2] + ra[3])) + ((rb[0] + rb[1]) + (rb[2] + rb[3]));
                        const float rstd = 1.0f / sqrtf(tot * (1.0f / 256.0f) + EPS);
#pragma unroll
                        for (int et = 0; et < 2; ++et) { const int e0 = 32 * w + 16 * et + 4 * q;
                            const f32x4 gv = *(const f32x4*)(ng + e0); const f16x4 rv = *(const f16x4*)(PX + (size_t)grs[it] * PXLD + P_GR + h * 256 + e0);
                            f16x4 o;
#pragma unroll
                            for (int r = 0; r < 4; ++r) o[r] = (f16)(accO[it][et][r] * rstd * gv[r] * siluf_((float)rv[r]));
                            *(f16x4*)(Y + (size_t)grs[it] * 2048 + 1024 + h * 256 + e0) = o; } asm volatile("" ::: "memory"); }
                }
            }
#pragma unroll
            for (int dt = 0; dt < 8; ++dt) { const f32x4 dv = *(const LAS f32x4*)(DEC + 16 * dt + 4 * q);
#pragma unroll
                for (int et = 0; et < 2; ++et) accS[dt][et] = accS[dt][et] * dv; }
#pragma unroll
            for (int kk = 0; kk < 2; ++kk) { f16x8 vf[2];
#pragma unroll
                for (int et = 0; et < 2; ++et) vf[et] = *(const LAS f16x8*)(VT + (32 * w + 16 * et + c) * VT_LD + kk * 32 + 8 * q);
#pragma unroll
                for (int dt = 0; dt < 8; ++dt) { const f16x8 kf = *(const LAS f16x8*)(KT + (16 * dt + c) * KH_LD + kk * 32 + 8 * q);
#pragma unroll
                    for (int et = 0; et < 2; ++et) accS[dt][et] = GLA_MFMA(kf, vf[et], accS[dt][et]); if (dt & 1) asm volatile("" ::: "memory"); } }
        }
        if (!FULL) { float* Sl = (float*)(F.ws + WS_GSLOC) + sidx * 32768; const int q = opq(q0), c = opq(c0);
#pragma unroll
            for (int dt = 0; dt < 8; ++dt)
#pragma unroll
                for (int et = 0; et < 2; ++et)
#pragma unroll
                    for (int r = 0; r < 4; ++r) Sl[(16 * dt + 4 * q + r) * 256 + 32 * w + 16 * et + c] = accS[dt][et][r];
            if (ig0 == 0) ((float*)(F.ws + WS_GDT))[sidx * 128 + dk0] = __expf(sumtot); }
        VM_WAIT();
    }
}
__device__ __forceinline__ void ph_gla_scan(const Ctx& F) {
    const float* Sl = (const float*)(F.ws + WS_GSLOC); float* Si = (float*)(F.ws + WS_GSIN); const float* Dt = (const float*)(F.ws + WS_GDT);
    for (int gt = F.bid * 512 + F.tid; gt < 2 * 4 * 2 * 32768; gt += F.G * 512) {
        const int e = gt & 32767, dir = (gt >> 15) & 1, h = (gt >> 16) & 3, b = gt >> 18;
        float S = 0.f;
        for (int base = 0; base < NSC; base += 11) {
            float sl[11], dt[11]; size_t ix[11];
#pragma unroll
            for (int u = 0; u < 11; ++u) { const int step = base + u; const int sc = step == 0 ? 32 : (dir == 0 ? step - 1 : 32 - step);
                const size_t idx = ((((size_t)b * 4 + h) * NSC + sc) * 2 + dir); ix[u] = idx;
                sl[u] = Sl[idx * 32768 + e]; dt[u] = Dt[idx * 128 + (e >> 8)]; }
#pragma unroll
            for (int u = 0; u < 11; ++u) { Si[ix[u] * 32768 + e] = S; S = dt[u] * S + sl[u]; }
        }
    }
}
#undef GLA_MFMA
}

namespace hy {
#define PADI(i) ((i) + ((i) >> 5))
constexpr int HY_BUF_BYTES = (16384 + 512) * 8;
constexpr int HY_SCR_OFF = HY_BUF_BYTES;
static_assert(HY_SCR_OFF + 2048 <= LDSCTL_OFF, "hyena lds");
__device__ __forceinline__ f32x2 twid(int k, float invN) { const float xr = (float)k * invN; return (f32x2){__builtin_amdgcn_cosf(xr), -__builtin_amdgcn_sinf(xr)}; }
__device__ __forceinline__ f32x2 mul_w16(f32x2 d, int a) {
    constexpr float c1 = 0.9238795325112867f, s1 = 0.3826834323650898f, r = 0.7071067811865476f;
    float c, s;
    switch (a & 15) {
        case 0: return d; case 4: return (f32x2){d.y, -d.x}; case 8: return (f32x2){-d.x, -d.y}; case 12: return (f32x2){-d.y, d.x};
        case 1: c = c1; s = s1; break; case 2: c = r; s = r; break; case 3: c = s1; s = c1; break;
        case 5: c = -s1; s = c1; break; case 6: c = -r; s = r; break; case 7: c = -c1; s = s1; break;
        case 9: c = -c1; s = -s1; break; case 10: c = -r; s = -r; break; case 11: c = -s1; s = -c1; break;
        case 13: c = s1; s = -c1; break; case 14: c = r; s = -r; break; default: c = c1; s = -s1; break; }
    return (f32x2){d.x * c + d.y * s, d.y * c - d.x * s};
}
template <int R> __device__ __forceinline__ void dif_pass(LAS f32x2* x, int m, int lh, int tid) {
    const int N = 1 << m; const float invN = 1.0f / (float)N; const int lg = lh - R + 1, g = 1 << lg, S = (N >> 1) >> lh;
    for (int q = tid; q < (N >> R); q += 512) { const int j = q & (g - 1), blk = q >> lg, base = (blk << (lh + 1)) + j;
        f32x2 v[1 << R];
#pragma unroll
        for (int k = 0; k < (1 << R); ++k) v[k] = x[PADI(base + k * g)];
        f32x2 w = twid(j * S, invN);
#pragma unroll
        for (int s = 0; s < R; ++s) { const int half = 1 << (R - 1 - s);
#pragma unroll
            for (int k = 0; k < (1 << R); ++k) if (!(k & half)) { const f32x2 a = v[k], b = v[k + half]; v[k] = a + b;
                v[k + half] = mul_w16(cmul(a - b, w), ((k & (half - 1)) << s) * (16 >> R)); }
            w = cmul(w, w); }
#pragma unroll
        for (int k = 0; k < (1 << R); ++k) x[PADI(base + k * g)] = v[k]; }
    __syncthreads();
}
template <int R> __device__ __forceinline__ void dit_pass(LAS f32x2* x, int m, int lh, int tid) {
    const int N = 1 << m; const float invN = 1.0f / (float)N; const int h = 1 << lh, S1 = (N >> 1) >> lh;
    for (int q = tid; q < (N >> R); q += 512) { const int j = q & (h - 1), blk = q >> lh, base = (blk << (lh + R)) + j;
        f32x2 v[1 << R];
#pragma unroll
        for (int k = 0; k < (1 << R); ++k) v[k] = x[PADI(base + k * h)];
        f32x2 wp[R]; wp[R - 1] = cconj(twid(j * (S1 >> (R - 1)), invN));
#pragma unroll
        for (int s = R - 2; s >= 0; --s) wp[s] = cmul(wp[s + 1], wp[s + 1]);
#pragma unroll
        for (int s = 0; s < R; ++s) { const int half = 1 << s;
#pragma unroll
            for (int k = 0; k < (1 << R); ++k) if (!(k & half)) { const f32x2 a = v[k];
                const f32x2 b = mul_w16(cmul(v[k + half], wp[s]), (16 - (k & (half - 1)) * (16 >> (s + 1))) & 15);
                v[k] = a + b; v[k + half] = a - b; } }
#pragma unroll
        for (int k = 0; k < (1 << R); ++k) x[PADI(base + k * h)] = v[k]; }
    __syncthreads();
}
__device__ __forceinline__ void fft_fwd(LAS f32x2* x, int m, int tid) {
    int lh = m - 1;
    while (lh + 1 >= 4) { dif_pass<4>(x, m, lh, tid); lh -= 4; }
    if (lh + 1 == 2) dif_pass<2>(x, m, 1, tid); else if (lh + 1 == 1) dif_pass<1>(x, m, 0, tid);
}
__device__ __forceinline__ void fft_inv(LAS f32x2* x, int m, int tid) {
    int lh = 0;
    while (m - lh >= 4) { dit_pass<4>(x, m, lh, tid); lh += 4; }
    if (m - lh == 2) dit_pass<2>(x, m, lh, tid); else if (m - lh == 1) dit_pass<1>(x, m, lh, tid);
}
__device__ __forceinline__ int brev(int k, int m) { return (int)(__brev((unsigned)k) >> (32 - m)); }

__device__ __forceinline__ void filt_unit(const Ctx& F, const Args& A, int l, int unit) {
    const int kind = unit >> 9, o = (unit >> 8) & 1, pair = unit & 255;
    const int n = kind ? LC : SEQ, m = kind ? 9 : 14, N = 2 * n, tid = F.tid;
    LAS f32x2* buf = (LAS f32x2*)F.lds;
    LAS float* W3 = (LAS float*)(F.lds + HY_SCR_OFF);
    LAS float* B3 = W3 + 256;
    LAS float* RED = B3 + 4;
    LAS float* INV = RED + 16;
    __syncthreads();
    if (tid < 256) { const int j = tid >> 2, ci = tid & 3; const int col = o * 1024 + (ci >> 1) * 512 + 2 * pair + (ci & 1);
        W3[j * 4 + ci] = A.in[I_HYW3][((size_t)l * 64 + j) * 2048 + col]; if (j == 0) B3[ci] = A.in[I_HYB3][(size_t)l * 2048 + col]; }
    __syncthreads();
    const float* H2 = (const float*)(F.ws + WS_H2) + (kind ? (size_t)SEQ * 64 : 0);
    const float lo = -3.0701134573253945f, hi = -15.350567286626973f;
    const float ra = fabsf(lo + (hi - lo) * (float)(2 * pair) / 511.0f), rb = fabsf(lo + (hi - lo) * (float)(2 * pair + 1) / 511.0f);
    float sa = 0.f, sb = 0.f;
    for (int t = tid; t < n; t += 512) {
        float a0 = B3[0], a1 = B3[1], a2 = B3[2], a3 = B3[3];
        const f32x4* hr = (const f32x4*)(H2 + (size_t)t * 64);
#pragma unroll 4
        for (int j4 = 0; j4 < 16; ++j4) { const f32x4 hv = hr[j4];
#pragma unroll
            for (int e = 0; e < 4; ++e) { const f32x4 wv = *(const LAS f32x4*)(W3 + (j4 * 4 + e) * 4); a0 += hv[e] * wv[0]; a1 += hv[e] * wv[1]; a2 += hv[e] * wv[2]; a3 += hv[e] * wv[3]; } }
        const float tn = (float)t / (float)(n - 1), da = expf(-tn * ra), db = expf(-tn * rb);
        const float fa = a0 * da, fb = a1 * db, ba = a2 * da, bb = a3 * db;
        buf[PADI(t)] = (f32x2){fa, fb}; sa += fabsf(fa); sb += fabsf(fb);
        if (t >= 1) { buf[PADI(N - t)] = (f32x2){ba, bb}; sa += fabsf(ba); sb += fabsf(bb); }
    }
    if (tid == 0) buf[PADI(n)] = (f32x2){0.f, 0.f};
    sa = wave_sum(sa); sb = wave_sum(sb);
    if (F.lane == 0) { RED[F.wave * 2] = sa; RED[F.wave * 2 + 1] = sb; }
    __syncthreads();
    if (tid < 2) { float s = 0.f;
#pragma unroll
        for (int w = 0; w < 8; ++w) s += RED[w * 2 + tid];
        INV[tid] = 1.0f / (s + EPS); }
    __syncthreads();
    { const float ia = INV[0], ib = INV[1];
      for (int i = tid; i < N; i += 512) { f32x2 v = buf[PADI(i)]; v.x *= ia; v.y *= ib; buf[PADI(i)] = v; } }
    __syncthreads();
    fft_fwd(buf, m, tid);
    f32x4* out = (f32x4*)(F.ws + WS_FSD + (kind ? FSD_C_OFF : 0)) + (size_t)(o * 256 + pair) * (n + 1);
    for (int u = tid; u <= n; u += 512) { const int p = u < n ? 2 * u : 1, k = brev(p, m), pn = brev((N - k) & (N - 1), m);
        const f32x2 zk = buf[PADI(p)], zn = cconj(buf[PADI(pn)]);
        const f32x2 fa = (zk + zn) * 0.5f, df = zk - zn, fb = (f32x2){df.y * 0.5f, -df.x * 0.5f};
        const f32x2 fs = (fa + fb) * 0.5f, fd = (fa - fb) * 0.5f;
        out[u] = (f32x4){fs.x, fs.y, fd.x, fd.y}; }
    __syncthreads();
}

__device__ __forceinline__ void main_unit(const Ctx& F, const Args& A, int l, int unit) {
    const int kind = unit >> 9, b = (unit >> 8) & 1, pair = unit & 255;
    const int n = kind ? LC : SEQ, m = kind ? 9 : 14, N = 2 * n, tid = F.tid;
    const int row0 = kind ? MX + b * LC : b * SEQ;
    LAS f32x2* buf = (LAS f32x2*)F.lds;
    const f16* ZT = (const f16*)(F.ws + WS_ZT) + (size_t)(2 * pair) * MT + row0;
    const float* cw = A.in[I_HYCW] + (size_t)l * 3 * 1536 + 2 * pair; const float* cb = A.in[I_HYCB] + (size_t)l * 1536 + 2 * pair;
    f32x2 yv[16], g1[16], g2[16];
#pragma unroll
    for (int g = 0; g < 3; ++g)
#pragma unroll
        for (int cc = 0; cc < 2; ++cc) { const float w0 = cw[g * 512 + cc], w1 = cw[1536 + g * 512 + cc], w2 = cw[3072 + g * 512 + cc], bs = cb[g * 512 + cc];
            const f16* zt = ZT + (size_t)(g * 512 + cc) * MT;
#pragma unroll
            for (int gi = 0; gi < 2; ++gi) { const int t0 = 8 * (tid + 512 * gi);
                f16x8 mv; float pv = 0.f, nv = 0.f;
#pragma unroll
                for (int e = 0; e < 8; ++e) mv[e] = (f16)0.f;
                if (t0 < n) { mv = *(const f16x8*)(zt + t0); if (t0 > 0) pv = (float)zt[t0 - 1]; if (t0 + 8 < n) nv = (float)zt[t0 + 8]; }
#pragma unroll
                for (int e = 0; e < 8; ++e) { const float zm = e == 0 ? pv : (float)mv[e == 0 ? 0 : e - 1], zc = (float)mv[e], zp = e == 7 ? nv : (float)mv[e == 7 ? 7 : e + 1];
                    const float r = w0 * zm + w1 * zc + w2 * zp + bs;
                    if (g == 0) { if (cc == 0) yv[gi * 8 + e].x = r; else yv[gi * 8 + e].y = r; }
                    else if (g == 1) { if (cc == 0) g1[gi * 8 + e].x = r; else g1[gi * 8 + e].y = r; }
                    else { if (cc == 0) g2[gi * 8 + e].x = r; else g2[gi * 8 + e].y = r; } } } }
    const float invN = 1.0f / (float)N;
#pragma unroll
    for (int o = 0; o < 2; ++o) {
        __syncthreads();
#pragma unroll
        for (int gi = 0; gi < 2; ++gi) { const int t0 = 8 * (tid + 512 * gi);
            if (t0 < n) {
#pragma unroll
                for (int e = 0; e < 8; ++e) { buf[PADI(t0 + e)] = yv[gi * 8 + e]; buf[PADI(n + t0 + e)] = (f32x2){0.f, 0.f}; } } }
        __syncthreads();
        fft_fwd(buf, m, tid);
        const f32x4* fsd = (const f32x4*)(F.ws + WS_FSD + (kind ? FSD_C_OFF : 0)) + (size_t)(o * 256 + pair) * (n + 1);
        for (int u = tid; u <= n; u += 512) { const int p = u < n ? 2 * u : 1, k = brev(p, m), pn = brev((N - k) & (N - 1), m);
            const f32x2 zk = buf[PADI(p)], zn = buf[PADI(pn)]; const f32x4 f = fsd[u]; const f32x2 fs = (f32x2){f[0], f[1]}, fd = (f32x2){f[2], f[3]};
            const f32x2 wk = cmul(zk, fs) + cmul(cconj(zn), fd), wn = cmul(zn, cconj(fs)) + cmul(cconj(zk), cconj(fd));
            buf[PADI(pn)] = wn; buf[PADI(p)] = wk; }
        __syncthreads();
        fft_inv(buf, m, tid);
        const float* hb = A.in[I_HYBIAS] + ((size_t)l * 2 + o) * 512 + 2 * pair; const f32x2 bias = (f32x2){hb[0], hb[1]};
#pragma unroll
        for (int gi = 0; gi < 2; ++gi) { const int t0 = 8 * (tid + 512 * gi);
            if (t0 < n) {
#pragma unroll
                for (int e = 0; e < 8; ++e) { const f32x2 cv = buf[PADI(t0 + e)] * invN; const f32x2 gt = o == 0 ? g1[gi * 8 + e] : g2[gi * 8 + e];
                    yv[gi * 8 + e] = gt * (cv + yv[gi * 8 + e] * bias); } } }
    }
    f16* Y = (f16*)(F.ws + WS_YBT) + (size_t)(2 * pair) * MT + row0;
#pragma unroll
    for (int gi = 0; gi < 2; ++gi) { const int t0 = 8 * (tid + 512 * gi);
        if (t0 < n) { f16x8 oa, ob;
#pragma unroll
            for (int e = 0; e < 8; ++e) { oa[e] = (f16)yv[gi * 8 + e].x; ob[e] = (f16)yv[gi * 8 + e].y; }
            *(f16x8*)(Y + t0) = oa; *(f16x8*)(Y + MT + t0) = ob; } }
    __syncthreads();
}

__device__ __forceinline__ void ph_ybt_transpose(const Ctx& F) {
    LAS f16* T = (LAS f16*)F.lds;
    const f16* YBT = (const f16*)(F.ws + WS_YBT); f16* Y = (f16*)(F.ws + WS_YCAT);
    for (int rb = F.bid; rb < MT / 64; rb += F.G) { const int r0 = rb * 64;
        __syncthreads();
#pragma unroll
        for (int i = 0; i < 8; ++i) *(LAS f16x8*)(T + F.tid * 72 + 8 * i) = *(const f16x8*)(YBT + (size_t)F.tid * MT + r0 + 8 * i);
        __syncthreads();
        const int row = F.tid >> 3, cg = F.tid & 7;
#pragma unroll
        for (int jj = 0; jj < 8; ++jj) { const int gidx = cg + 8 * jj; f16x8 o;
#pragma unroll
            for (int e = 0; e < 8; ++e) o[e] = T[(8 * gidx + e) * 72 + row];
            *(f16x8*)(Y + (size_t)(r0 + row) * 2048 + 512 + 8 * gidx) = o; }
    }
    __syncthreads();
}
#undef PADI
}

#ifndef PHMASK
#define PHMASK 0xFFFF
#endif
#define PH_EN(k) (((PHMASK) >> (k)) & 1)
#ifndef STAMP_MASK
#define STAMP_MASK 0
#endif
#ifndef STAMP_K
#define STAMP_K 1
#endif
#ifndef SUBMASK
#define SUBMASK 7
#endif
#define SUB_EN(k) (((SUBMASK) >> (k)) & 1)
constexpr int NPH = 2 + 12 * DEPTH;
constexpr int CW_Q = 8192;
__device__ __forceinline__ int q_pull(unsigned* ctr, volatile LAS int* slot) {
    __syncthreads();
    if (threadIdx.x == 0) *slot = (int)__hip_atomic_fetch_add(ctr, 1u, __ATOMIC_RELAXED, __HIP_MEMORY_SCOPE_AGENT);
    __syncthreads();
    return *slot;
}

__global__ void __launch_bounds__(512, 2) mk_fwd(Args args) {
    extern __shared__ __attribute__((aligned(16))) unsigned char lds_raw[];
    Ctx F; F.lds = (LAS unsigned char*)lds_raw; F.tid = threadIdx.x; F.lane = F.tid & 63; F.wave = __builtin_amdgcn_readfirstlane(F.tid >> 6);
    F.G = gridDim.x; F.bid = blockIdx.x; F.ws = args.ws;
    const Ctx F0 = F;
#define FRESH() do { F.tid = opq(F0.tid); F.lane = F.tid & 63; F.wave = __builtin_amdgcn_readfirstlane(F.tid >> 6); } while (0)
    volatile LAS unsigned* MISC = (volatile LAS unsigned*)(F.lds + LDSCTL_OFF);
    if (F.tid < 64) MISC[F.tid] = 0u;
    __syncthreads();
    unsigned* barw = (unsigned*)(F.ws + WS_CTL) + CW_BAR;
    XcdBarrier bar; bar.bar = barw; bar.x = 0; bar.st = nullptr;
    const int lo = args.ph_lo, hi = args.ph_hi;
    if (hi - lo > 1) bar = xcd_barrier_post(barw, MISC + 8);
#define IN(k) (lo <= (k) && (k) < hi)
#define SEAM(k) do { if (IN(k) && IN((k) + 1)) xcd_barrier(bar); } while (0)
#if STAMP_MASK
    volatile LAS unsigned long long* TS = (volatile LAS unsigned long long*)(F.lds + LDSCTL_OFF + 128);
#define TSTART(k) do { if ((((STAMP_MASK) >> (k)) & 1) && blockIdx.x == 0 && threadIdx.x == 0) TS[0] = __builtin_amdgcn_s_memrealtime(); } while (0)
#define TSTOP(k) do { if ((((STAMP_MASK) >> (k)) & 1) && blockIdx.x == 0 && threadIdx.x == 0) TS[1] = TS[1] + (__builtin_amdgcn_s_memrealtime() - TS[0]); } while (0)
#else
#define TSTART(k) do {} while (0)
#define TSTOP(k) do {} while (0)
#endif
    unsigned char* ws = F.ws;
    const int rank160 = (F.bid + F.G - 160 % F.G) % F.G;

    TSTART(12);
    if (PH_EN(12) && IN(0)) { FRESH(); ph_prologue(F, args); }
    SEAM(0);
    TSTOP(12);

    for (int l = 0; l < DEPTH; ++l) {
        const int pb = 1 + 12 * l;
        const float* modl = (const float*)(ws + WS_MOD) + (size_t)l * 3 * 12288;
        const bool ctx_on = l < DEPTH - 1;
        const int nMr = ctx_on ? MT / 256 : MX / 256, nrows = ctx_on ? MT : MX;
        TSTART(0);
        if (PH_EN(0) && IN(pb + 0)) {
            FRESH(); ph_convert_weights(F, args, l);
            __syncthreads();
            FRESH(); if (F.bid < 32) s5_mats_group(F, args, l, F.bid);
            FRESH(); ph_hyena_h2(F, args, l);
            FRESH(); ph_norm(F, args, l, 0, MT, l > 0 ? 11 : 0);
        }
        SEAM(pb + 0);
        TSTOP(0);
        TSTART(1);
        if (PH_EN(1) && IN(pb + 1)) {
            pg8::SchedPlain S; S.init(MT / 256, PXLD / 256, F.G, F.bid); S.A = (const char*)(ws + WS_HN); S.B = (const char*)(ws + WS_WIN); S.aTile = (size_t)256 * 2048 * 2; S.bTile = (size_t)256 * 2048 * 2;
            pg8::EpiPx E{(f16*)(ws + WS_PX), (f16*)(ws + WS_S5A), (f16*)(ws + WS_ZT)};
            pg8::gemm_phase(F.lds, 2048, 2048, 32, S, E);
        }
        SEAM(pb + 1);
        TSTOP(1);
        TSTART(2);
        if (PH_EN(2) && IN(pb + 2)) {
            TSTART(16);
            if (SUB_EN(0)) { pg8::SchedS5 S{(const char*)(ws + WS_S5A), (const char*)(ws + WS_S5M), (size_t)256 * 256 * 2, F.G, F.bid};
              pg8::EpiS5In E{(float*)(ws + WS_S5S)};
              pg8::gemm_phase(F.lds, 16384, 256, 4, S, E); }
            TSTOP(16);
            { unsigned* qc = (unsigned*)(ws + WS_CTL) + CW_Q + (l * 2 + 0) * 64; volatile LAS int* slot = (volatile LAS int*)(MISC + 16);
              for (;;) { const int u = q_pull(qc, slot); if (u >= 264 + 1024) break;
                  if (u < 264) { TSTART(17); FRESH(); gla::gla_unit<false>(F, args, l, u); TSTOP(17); } else { TSTART(18); FRESH(); hy::filt_unit(F, args, l, u - 264); TSTOP(18); } } }
        }
        SEAM(pb + 2);
        TSTOP(2);
        TSTART(3);
        if (PH_EN(3) && IN(pb + 3)) { FRESH(); ph_s5_scan(F); FRESH(); gla::ph_gla_scan(F); }
        SEAM(pb + 3);
        TSTOP(3);
        TSTART(4);
        if (PH_EN(4) && IN(pb + 4)) {
            TSTART(19);
            if (SUB_EN(0)) { pg8::SchedS5 S{(const char*)(ws + WS_S5A), (const char*)(ws + WS_S5W), (size_t)256 * 512 * 2, F.G, F.bid};
              pg8::EpiS5Out E{(const f16*)(ws + WS_S5A), (f16*)(ws + WS_YAPRE), args.in[I_S5D] + (size_t)l * 512};
              pg8::gemm_phase(F.lds, 16384, 512, 8, S, E); }
            TSTOP(19);
            { unsigned* qc = (unsigned*)(ws + WS_CTL) + CW_Q + (l * 2 + 1) * 64; volatile LAS int* slot = (volatile LAS int*)(MISC + 16);
              for (;;) { const int u = q_pull(qc, slot); if (u >= 264 + 1024) break;
                  if (u < 264) { TSTART(20); FRESH(); gla::gla_unit<true>(F, args, l, u); TSTOP(20); } else { TSTART(21); FRESH(); hy::main_unit(F, args, l, u - 264); TSTOP(21); } } }
        }
        SEAM(pb + 4);
        TSTOP(4);
        TSTART(5);
        if (PH_EN(5) && IN(pb + 5)) {
            pg8::SchedPlain S; S.init(nMr, 2, F.G, F.bid); S.A = (const char*)(ws + WS_YAPRE); S.B = (const char*)(ws + WS_WGLU); S.aTile = (size_t)256 * 512 * 2; S.bTile = (size_t)256 * 512 * 2;
            pg8::EpiGlu E{(const f16*)(ws + WS_YAPRE), (f16*)(ws + WS_YCAT), args.in[I_GLUB] + (size_t)l * 512};
            pg8::gemm_phase(F.lds, 512, 512, 8, S, E);
            FRESH(); hy::ph_ybt_transpose(F);
        }
        SEAM(pb + 5);
        TSTOP(5);
        TSTART(6);
        if (PH_EN(6) && IN(pb + 6)) {
            pg8::SchedPlain S; S.init(nMr, 8, F.G, F.bid); S.aTile = (size_t)256 * 2048 * 2; S.bTile = (size_t)256 * 2048 * 2;
            S.A = (const char*)(ws + WS_YCAT); S.B = (const char*)(ws + WS_WBR);
            pg8::EpiBranchF E{(const f16*)(ws + WS_PX), (f16*)(ws + WS_MBUF)};
            pg8::gemm_phase(F.lds, 2048, 2048, 32, S, E);
        }
        SEAM(pb + 6);
        TSTOP(6);
        TSTART(7);
        if (PH_EN(7) && IN(pb + 7)) {
            pg8::SchedPlain S; S.init(MX / 256, 8, F.G, F.bid); S.A = (const char*)(ws + WS_MBUF); S.B = (const char*)(ws + WS_WOUT); S.aTile = (size_t)256 * 2048 * 2; S.bTile = (size_t)256 * 2048 * 2;
            pg8::EpiResid E{(float*)(ws + WS_XRES), modl, 4096};
            pg8::gemm_phase(F.lds, 2048, 2048, 32, S, E);
            if (ctx_on) { pg8::SchedSplit S2{(const char*)(ws + WS_MBUF), (const char*)(ws + WS_WOUT), (size_t)256 * 2048 * 2, (size_t)256 * 2048 * 2, (size_t)8 * 128, 4, F.G, F.bid};
                pg8::EpiSlab E2{(float*)(ws + WS_SLAB), modl, 4096};
                pg8::gemm_phase(F.lds, 2048, 2048, 8, S2, E2); }
        }
        SEAM(pb + 7);
        TSTOP(7);
        TSTART(8);
        if (PH_EN(8) && IN(pb + 8)) { FRESH(); ph_norm(F, args, l, 1, nrows, 4); }
        SEAM(pb + 8);
        TSTOP(8);
        TSTART(9);
        if (PH_EN(9) && IN(pb + 9)) {
            pg8::SchedPlain S; S.init(nMr, UPLD / 256, F.G, F.bid); S.A = (const char*)(ws + WS_HN); S.B = (const char*)(ws + WS_WUP); S.aTile = (size_t)256 * 2048 * 2; S.bTile = (size_t)256 * 2048 * 2;
            pg8::EpiUpAct E{(f16*)(ws + WS_ACT), (float*)(ws + WS_HALO), args.in[I_FFCW] + (size_t)l * 3 * FFH, args.in[I_FFCB] + (size_t)l * FFH, (LAS float*)(F.lds + EXTRA_OFF)};
            pg8::gemm_phase(F.lds, 2048, 2048, 32, S, E);
        }
        SEAM(pb + 9);
        TSTOP(9);
        TSTART(10);
        if (PH_EN(10) && IN(pb + 10)) { FRESH(); ph_ffn_fix(F, args, l, nMr); }
        SEAM(pb + 10);
        TSTOP(10);
        TSTART(11);
        if (PH_EN(11) && IN(pb + 11)) {
            pg8::SchedPlain S; S.init(MX / 256, 8, F.G, F.bid); S.A = (const char*)(ws + WS_ACT); S.B = (const char*)(ws + WS_WDN); S.aTile = (size_t)256 * FFH * 2; S.bTile = (size_t)256 * FFH * 2;
            pg8::EpiResid E{(float*)(ws + WS_XRES), modl, 10240};
            pg8::gemm_phase(F.lds, FFH, FFH, FFH / 64, S, E);
            if (ctx_on) { pg8::SchedSplit S2{(const char*)(ws + WS_ACT), (const char*)(ws + WS_WDN), (size_t)256 * FFH * 2, (size_t)256 * FFH * 2, (size_t)8 * 128, 11, F.G, F.bid};
                pg8::EpiSlab E2{(float*)(ws + WS_SLAB), modl, 10240};
                pg8::gemm_phase(F.lds, FFH, FFH, 8, S2, E2); }
        }
        SEAM(pb + 11);
        TSTOP(11);
    }
    if (PH_EN(13) && IN(NPH - 1)) { FRESH(); ph_final_norm(F, args); }
#if STAMP_MASK
    if (blockIdx.x == 0 && threadIdx.x == 0) { const unsigned long long t0 = __builtin_amdgcn_s_memrealtime(); while (__builtin_amdgcn_s_memrealtime() - t0 < (unsigned long long)(STAMP_K) * TS[1]) __builtin_amdgcn_s_sleep(8); }
#endif
#undef IN
#undef SEAM
#undef FRESH
}

extern "C" void kernel_launch(void* const* d_in, const int* in_sizes, int n_in, void* d_out, int out_size, void* d_ws, size_t ws_size, hipStream_t stream) {
    static int grid = 0;
    if (grid == 0) {
        if (n_in != 40 || out_size != MX * D || ws_size < WS_END) { fprintf(stderr, "kernel_launch: unexpected problem (n_in %d out %d ws %zu, need %zu)\n", n_in, out_size, ws_size, (size_t)WS_END); grid = -1; return; }
        int dev = 0, cus = 0, per_cu = 0;
        if (hipGetDevice(&dev) != hipSuccess || hipDeviceGetAttribute(&cus, hipDeviceAttributeMultiprocessorCount, dev) != hipSuccess) { grid = -1; return; }
        if (hipFuncSetAttribute((const void*)mk_fwd, hipFuncAttributeMaxDynamicSharedMemorySize, LDS_BYTES) != hipSuccess) { fprintf(stderr, "kernel_launch: hipFuncSetAttribute failed\n"); grid = -1; return; }
        if (hipOccupancyMaxActiveBlocksPerMultiprocessor(&per_cu, (const void*)mk_fwd, 512, LDS_BYTES) != hipSuccess || per_cu < 1)
            fprintf(stderr, "kernel_launch: occupancy query reports %d\n", per_cu);
        (void)hipGetLastError();
        grid = cus;
    }
    if (grid < 0) return;
    if (hipMemsetAsync((char*)d_ws + WS_CTL, 0, CTL_ZERO_BYTES, stream) != hipSuccess) return;
    Args a{};
    for (int i = 0; i < 40; ++i) a.in[i] = (const float*)d_in[i];
    a.out = (float*)d_out; a.ws = (unsigned char*)d_ws;
#if MK_ONE
    a.ph_lo = 0; a.ph_hi = NPH;
    hipLaunchKernelGGL(mk_fwd, dim3(grid), dim3(512), LDS_BYTES, stream, a);
#else
    for (int p = 0; p < NPH; ++p) { a.ph_lo = p; a.ph_hi = p + 1; hipLaunchKernelGGL(mk_fwd, dim3(grid), dim3(512), LDS_BYTES, stream, a); }
#endif
}
```

```cpp
#include <hip/hip_runtime.h>
#include <stdio.h>

#ifndef MK_ONE
#define MK_ONE 1
#define STAMP_MASK 0
#define STAMP_K 1
#endif

#define GAS __attribute__((address_space(1)))
#define LAS __attribute__((address_space(3)))
typedef _Float16 f16;
typedef _Float16 f16x8 __attribute__((ext_vector_type(8)));
typedef _Float16 f16x4 __attribute__((ext_vector_type(4)));
typedef _Float16 f16x2 __attribute__((ext_vector_type(2)));
typedef float f32x4 __attribute__((ext_vector_type(4)));
typedef float f32x2 __attribute__((ext_vector_type(2)));

constexpr int D = 2048, NB = 2, SEQ = 8192, LC = 256, DEPTH = 4;
constexpr int MX = NB * SEQ, MC = NB * LC, MT = MX + MC;
constexpr int PXLD = 3840, WINN = 11520, FFH = 5632, UPLD = 2 * FFH;
constexpr int P_S5 = 0, P_GK = 512, P_GV = 1024, P_GQ = 2048, P_GR = 2560, P_HY = 3584, P_MG = 5120, P_GG = 3584, W_GG = 11264;
constexpr int INW = 11296;
constexpr int NCHK = 1056;
constexpr float S5SCALE = 1024.f;
constexpr float EPS = 1e-6f;
constexpr int NSC = 33;

constexpr size_t MiB = 1u << 20;
constexpr size_t WS_CTL = 0, CTL_ZERO_BYTES = 1 * MiB;
constexpr size_t WS_MOD = 1 * MiB;
constexpr size_t WS_TW = 2 * MiB;
constexpr size_t WS_S5AT = 3 * MiB;
constexpr size_t WS_WIN = 4 * MiB;
constexpr size_t WS_WGLU = WS_WIN + 45 * MiB;
constexpr size_t WS_WBR = WS_WGLU + 1 * MiB;
constexpr size_t WS_WOUT = WS_WBR + 8 * MiB;
constexpr size_t WS_WUP = WS_WOUT + 8 * MiB;
constexpr size_t WS_WDN = WS_WUP + 44 * MiB;
constexpr size_t WS_S5W = WS_WDN + 22 * MiB;
constexpr size_t WS_S5M = WS_S5W + 8 * MiB;
constexpr size_t WS_H2 = WS_S5M + 4 * MiB;
constexpr size_t WS_FSD = WS_H2 + 3 * MiB;
constexpr size_t FSD_C_OFF = (size_t)2 * 256 * 8193 * 16;
constexpr size_t WS_XRES = WS_FSD + 68 * MiB;
constexpr size_t WS_HN = WS_XRES + 132 * MiB;
constexpr size_t WS_PX = WS_HN + 66 * MiB;
constexpr size_t WS_S5A = WS_PX + 372 * MiB;
constexpr size_t WS_S5S = WS_S5A + 40 * MiB;
constexpr size_t WS_YAPRE = WS_S5S + 40 * MiB;
constexpr size_t WS_YCAT = WS_YAPRE + 20 * MiB;
constexpr size_t WS_MBUF = WS_YCAT + 66 * MiB;
constexpr size_t WS_GSLOC = WS_MBUF + 66 * MiB;
constexpr size_t WS_GSIN = WS_GSLOC + 66 * MiB;
constexpr size_t WS_GOF = WS_GSIN + 66 * MiB;
constexpr size_t WS_GDT = WS_GOF + 66 * MiB;
constexpr size_t WS_ACT = WS_GSLOC;
constexpr size_t WS_ZT = WS_GDT + 1 * MiB;
constexpr size_t WS_YBT = WS_ZT + 50 * MiB;
constexpr size_t WS_SLAB = WS_YBT + 17 * MiB;
constexpr size_t WS_HALO = WS_SLAB + 44 * MiB;
constexpr size_t WS_GTL = WS_HALO + 9 * MiB;
constexpr size_t WS_END = WS_GTL + 198 * MiB;
static_assert((size_t)MT * FFH * 2 <= 198 * MiB, "ACT overlay");
constexpr int CW_BAR = 4096;

constexpr int RING_BYTES = 131072;
constexpr int EXTRA_OFF = RING_BYTES, EXTRA_BYTES = 8192;
constexpr int LDSCTL_OFF = EXTRA_OFF + EXTRA_BYTES;
constexpr int LDS_BYTES = LDSCTL_OFF + 256;

__device__ __forceinline__ float wave_sum(float v) {
#pragma unroll
    for (int o = 1; o < 64; o <<= 1) v += __shfl_xor(v, o);
    return v;
}
__device__ __forceinline__ float sigmoidf_(float x) { return 1.0f / (1.0f + __expf(-x)); }
__device__ __forceinline__ float siluf_(float x) { return x * sigmoidf_(x); }
__device__ __forceinline__ float gelu_tanh_(float x) { const float u = 0.7978845608028654f * (x + 0.044715f * x * x * x); return x / (1.0f + __expf(-2.0f * u)); }
__device__ __forceinline__ float logsigmoidf_(float x) { return fminf(x, 0.f) - __logf(1.0f + __expf(-fabsf(x))); }
__device__ __forceinline__ f32x2 cmul(f32x2 a, f32x2 b) { return (f32x2){a.x * b.x - a.y * b.y, a.x * b.y + a.y * b.x}; }
__device__ __forceinline__ f32x2 cconj(f32x2 a) { return (f32x2){a.x, -a.y}; }
__device__ __forceinline__ int opq(int x) { asm volatile("" : "+v"(x)); return x; }
#define PIN8(a, b, c, d, e, f, g, h) asm volatile("" : "+v"(a), "+v"(b), "+v"(c), "+v"(d), "+v"(e), "+v"(f), "+v"(g), "+v"(h))
#define PIN4(a, b, c, d) asm volatile("" : "+v"(a), "+v"(b), "+v"(c), "+v"(d))
#define LDS_WAIT() asm volatile("s_waitcnt lgkmcnt(0)" ::: "memory")
#define VM_WAIT() asm volatile("s_waitcnt vmcnt(0)" ::: "memory")

#define XB_TMO      128
#define XB_XCNT(j)  (256  + 64 * (j))
#define XB_XSUB(j)  (1280 + 64 * (j))
#define XB_XGEN(j)  (2304 + 64 * (j))
#define XB_TOP      3328
#define XB_TOPGEN   3392
#define XCD_BAR_WORDS 3456
#define XB_SPIN_CAP (1u << 18)
__device__ __forceinline__ unsigned xb_ld(unsigned* p)              { return __hip_atomic_load(p, __ATOMIC_RELAXED, __HIP_MEMORY_SCOPE_AGENT); }
__device__ __forceinline__ unsigned xb_add(unsigned* p, unsigned v) { return __hip_atomic_fetch_add(p, v, __ATOMIC_RELAXED, __HIP_MEMORY_SCOPE_AGENT); }
__device__ __forceinline__ unsigned xb_xcc_id() { return (unsigned)__builtin_amdgcn_s_getreg((3 << 11) | 20) & 0xFu; }
#define XB_SPIN(cond, bar) do { unsigned _sp = 0; while (cond) { __builtin_amdgcn_s_sleep(1); \
    if ((++_sp & 255u) == 0u) { if (xb_ld(&(bar)[XB_TMO])) break; if (_sp > XB_SPIN_CAP) { atomicAdd(&(bar)[XB_TMO], 1u); break; } } } } while (0)
struct XcdBarrier { unsigned* bar; unsigned x; volatile LAS unsigned* st; };
__device__ __forceinline__ XcdBarrier xcd_barrier_post(unsigned* bar, volatile LAS unsigned* st) {
    XcdBarrier b; b.bar = bar; b.x = xb_xcc_id(); b.st = st;
    if (threadIdx.x == 0) (void)xb_add(&bar[XB_XCNT(b.x)], 1u);
    return b;
}
__device__ __forceinline__ void xcd_barrier_complete(unsigned* bar, unsigned x, unsigned& nloc, unsigned& nx) {
    const unsigned G = gridDim.x * gridDim.y * gridDim.z;
    unsigned sum, cnt, mine, sp = 0u;
    for (;;) {
        sum = 0u; cnt = 0u; mine = 0u;
#pragma unroll
        for (unsigned j = 0; j < 16; ++j) { const unsigned c = xb_ld(&bar[XB_XCNT(j)]); sum += c; cnt += (c > 0u) ? 1u : 0u; mine = (j == x) ? c : mine; }
        if (sum == G) break;
        __builtin_amdgcn_s_sleep(1);
        if ((++sp & 255u) == 0u) { if (xb_ld(&bar[XB_TMO])) break; if (sp > XB_SPIN_CAP) { atomicAdd(&bar[XB_TMO], 1u); break; } }
    }
    nloc = mine > 0u ? mine : 1u; nx = cnt > 0u ? cnt : 1u;
}
__device__ __forceinline__ void xcd_barrier(const XcdBarrier& b) {
    asm volatile("s_waitcnt vmcnt(0)" ::: "memory");
    __syncthreads();
    if (threadIdx.x == 0) {
        unsigned* bar = b.bar;
        __builtin_amdgcn_s_waitcnt(0);
        unsigned nloc = b.st[0], nx = b.st[1];
        if (nloc == 0u) { xcd_barrier_complete(bar, b.x, nloc, nx); b.st[0] = nloc; b.st[1] = nx; }
        const unsigned old = xb_add(&bar[XB_XSUB(b.x)], 1u);
        const unsigned gen = old / nloc;
        if (old + 1u == (gen + 1u) * nloc) {
            __builtin_amdgcn_fence(__ATOMIC_RELEASE, "agent");
            asm volatile("s_waitcnt vmcnt(0)" ::: "memory");
            const unsigned og = xb_add(&bar[XB_TOP], 1u);
            const unsigned tg = og / nx;
            if (og + 1u == (tg + 1u) * nx) xb_add(&bar[XB_TOPGEN], 1u);
            else XB_SPIN(xb_ld(&bar[XB_TOPGEN]) == tg, bar);
            __builtin_amdgcn_fence(__ATOMIC_ACQUIRE, "agent");
            xb_add(&bar[XB_XGEN(b.x)], 1u);
            asm volatile("s_waitcnt vmcnt(0)" ::: "memory");
        } else {
            XB_SPIN(xb_ld(&bar[XB_XGEN(b.x)]) == gen, bar);
            __builtin_amdgcn_fence(__ATOMIC_ACQUIRE, "agent");
            asm volatile("s_waitcnt vmcnt(0)" ::: "memory");
        }
    }
    __syncthreads();
}

struct Args {
    const float* in[40];
    float* out; unsigned char* ws;
    int ph_lo, ph_hi;
};
struct ArgsV {
    __device__ __forceinline__ const float* in(int i) const {
        typedef const __attribute__((address_space(4))) unsigned long long* kp_t;
        kp_t ka = (kp_t)__builtin_amdgcn_kernarg_segment_ptr();
        return (const float*)(*(volatile const __attribute__((address_space(4))) unsigned long long*)(ka + i)); }
    float* out;
};
struct Ctx {
    LAS unsigned char* lds;
    int tid, lane, wave, G, bid;
    unsigned char* ws;
};
enum { I_X = 0, I_C, I_CTX, I_CCTX, I_WMOD, I_BMOD, I_N1G, I_N2G, I_WIN, I_S5ARE, I_S5AIM, I_S5STEP, I_S5BRE, I_S5BIM, I_S5CRE, I_S5CIM,
       I_S5D, I_GLUW, I_GLUB, I_HYCW, I_HYCB, I_HYW1, I_HYB1, I_HYF1, I_HYW2, I_HYB2, I_HYF2, I_HYW3, I_HYB3, I_HYBIAS,
       I_GLAWG, I_GLABG, I_GLANG, I_WBR, I_WOUT, I_WUP, I_FFCW, I_FFCB, I_WDN, I_FNG };

namespace pg8 {
constexpr int BM = 256, BK = 64, HALF = 128, HTB = HALF * BK * 2, STAGE_BYTES = 8 * HTB, NXCD = 8, WGM = 8;
__device__ __forceinline__ int lds_byte(int r, int c) { const int st = (r >> 4) * 2 + (c >> 5), rr = r & 15, cc = c & 31, ob = rr * 64 + cc * 2; return st * 1024 + (ob ^ (((ob >> 9) & 1) << 5)); }
__device__ __forceinline__ void stage_rc(int b, int& R, int& C) { const int st = b / 1024, sb = b % 1024, swz = sb ^ (((sb >> 9) & 1) << 5); R = (st >> 1) * 16 + swz / 64; C = (st & 1) * 32 + (swz % 64) / 2; }
__device__ __forceinline__ int perm32(int rho) { const int n = rho >> 4, i = rho & 15; return 8 * (i >> 2) + 4 * n + (i & 3); }
struct Unit { const char* a; const char* b; int pm, pn; };
struct Order2D {
    int nM, nN, nwg, G, c;
    __device__ __forceinline__ void init(int nM_, int nN_, int G_, int c_) { nM = nM_; nN = nN_; nwg = nM * nN; G = G_; c = c_; }
    __device__ __forceinline__ bool nx(int i, int& pm, int& pn) const {
        const long L = (long)i * G + c; if (L >= nwg) return false;
        int wgid = (int)L; { const int q = nwg / NXCD, r = nwg % NXCD, xcd = wgid % NXCD, off = wgid / NXCD; wgid = (xcd < r ? xcd * (q + 1) : r * (q + 1) + (xcd - r) * q) + off; }
        const int nig = WGM * nN, gid = wgid / nig, fm = gid * WGM, gsz = (nM - fm) < WGM ? (nM - fm) : WGM;
        pm = fm + ((wgid % nig) % gsz); pn = (wgid % nig) / gsz; return true;
    }
};
struct SchedPlain : Order2D {
    const char* A; const char* B; size_t aTile, bTile;
    __device__ __forceinline__ bool next(int i, Unit& u) const { int pm, pn; if (!nx(i, pm, pn)) return false; u.pm = pm; u.pn = pn; u.a = A + (size_t)pm * aTile; u.b = B + (size_t)pn * bTile; return true; }
};
struct SchedSplit {
    const char* A; const char* B; size_t aTile, bTile, ksub; int nsplit, G, c;
    __device__ __forceinline__ bool next(int i, Unit& u) const { const int L = i * G + c; if (L >= 16 * nsplit) return false; const int t = L / nsplit, ks = L % nsplit, pm = 64 + (t >> 3), pn = t & 7;
        u.pm = pm; u.pn = pn | (ks << 8); u.a = A + (size_t)pm * aTile + (size_t)ks * ksub; u.b = B + (size_t)pn * bTile + (size_t)ks * ksub; return true; }
};
struct SchedS5 {
    const char* A; const char* B; size_t bGroup; int G, c;
    __device__ __forceinline__ bool next(int i, Unit& u) const { const int L = i * G + c; if (L >= 160) return false; const int g = L & 31, pm = L >> 5;
        u.pm = pm; u.pn = g; u.a = A + ((size_t)pm * 256 * 16384 + (size_t)g * 512) * 2; u.b = B + (size_t)g * bGroup; return true; }
};

#define PG8_SA(b, h) (((b) * 2 + (h)) * HTB)
#define PG8_SB(b, h) ((4 + (b) * 2 + (h)) * HTB)
#define PG8_STAGE(bufoff, gbase, voff) do { _Pragma("unroll") for (int _i = 0; _i < 2; ++_i) \
        __builtin_amdgcn_global_load_lds((const unsigned*)((const char*)(gbase) + (voff)[_i]), (LAS unsigned*)(lds + (bufoff) + ldsw + _i * 8192), 16, 0, 0); } while (0)
#define PG8_LDA(dst, b, h) do { _Pragma("unroll") for (int m = 0; m < 4; ++m) _Pragma("unroll") for (int k = 0; k < 2; ++k) dst[m][k] = *(const LAS f16x8*)(lds + PG8_SA(b, h) + aoff + m * 2048 + k * 1024); } while (0)
#define PG8_LDB(dst, b, h) do { _Pragma("unroll") for (int n = 0; n < 2; ++n) _Pragma("unroll") for (int k = 0; k < 2; ++k) dst[n][k] = *(const LAS f16x8*)(lds + PG8_SB(b, h) + boff + n * 2048 + k * 1024); } while (0)
#define PG8_MMA(ai, bj, At, Bt) do { __builtin_amdgcn_s_setprio(1); _Pragma("unroll") for (int m = 0; m < 4; ++m) _Pragma("unroll") for (int n = 0; n < 2; ++n) _Pragma("unroll") for (int k = 0; k < 2; ++k) \
        acc[ai][bj][m][n] = __builtin_amdgcn_mfma_f32_16x16x32_f16(Bt[n][k], At[m][k], acc[ai][bj][m][n], 0, 0, 0); __builtin_amdgcn_s_setprio(0); } while (0)
#define PG8_WAIT_V(n) asm volatile("s_waitcnt vmcnt(" #n ")" ::: "memory")
#define PG8_WAIT_L(n) asm volatile("s_waitcnt lgkmcnt(" #n ")" ::: "memory")
#define PG8_BAR __builtin_amdgcn_s_barrier()
#define PG8_SCHED __builtin_amdgcn_sched_barrier(0)

template <class Epi, class Sched>
__device__ __forceinline__ void gemm_phase(LAS unsigned char* lds, const int lda, const int ldb, const int nt, const Sched& S, const Epi& E) {
    const int tid = opq((int)threadIdx.x), wid = __builtin_amdgcn_readfirstlane(tid >> 6), lane = tid & 63, wr = wid >> 2, wc = wid & 3, fr = lane & 15, fq = lane >> 4;
    unsigned voffA[2], voffB[2];
#pragma unroll
    for (int i = 0; i < 2; ++i) { int R, C; stage_rc(tid * 16 + i * 8192, R, C); const int Rb = Epi::PERM ? ((R & ~31) + perm32(R & 31)) : R;
        voffA[i] = (unsigned)(R * lda + C) * 2u; voffB[i] = (unsigned)(Rb * ldb + C) * 2u; }
    const size_t kstep = (size_t)(BK * 2);
    const size_t hstepA = (size_t)HALF * lda * 2, hstepB = (size_t)HALF * ldb * 2;
    const unsigned ldsw = (unsigned)wid * 1024u;
    const int aoff = lds_byte(wr * 64 + fr, fq * 8), boff = lds_byte(wc * 32 + fr, fq * 8);
    Unit cur, nxt; int ui = 0;
    if (!S.next(0, cur)) return;
    f32x4 acc[2][2][4][2];
#pragma unroll
    for (int a = 0; a < 2; ++a)
#pragma unroll
        for (int b = 0; b < 2; ++b)
#pragma unroll
            for (int m = 0; m < 4; ++m)
#pragma unroll
                for (int n = 0; n < 2; ++n) acc[a][b][m][n] = (f32x4){0.f, 0.f, 0.f, 0.f};
    f16x8 At[4][2], B0[2][2], B1[2][2];
    const char* cA = cur.a; const char* cB = cur.b;
    PG8_STAGE(PG8_SB(0, 0), cB, voffB); PG8_STAGE(PG8_SA(0, 0), cA, voffA); PG8_STAGE(PG8_SB(0, 1), cB + hstepB, voffB); PG8_STAGE(PG8_SA(0, 1), cA + hstepA, voffA);
    if (wr == 1) PG8_BAR;
    PG8_WAIT_V(4); PG8_BAR;
    PG8_STAGE(PG8_SB(1, 0), cB + kstep, voffB); PG8_STAGE(PG8_SA(1, 0), cA + kstep, voffA); PG8_STAGE(PG8_SB(1, 1), cB + hstepB + kstep, voffB);
    PG8_WAIT_V(6); PG8_BAR;
    for (;;) {
        const bool has_next = S.next(ui + 1, nxt);
        const char* nA = has_next ? nxt.a : cA; const char* nB = has_next ? nxt.b : cB;
        constexpr int NSEG = Epi::HAS_MID ? 3 : 1;
#pragma unroll
        for (int seg = 0; seg < NSEG; ++seg) {
        const int tb = Epi::HAS_MID ? (seg == 0 ? 0 : (seg == 1 ? Epi::MID1 + 2 : Epi::MID2 + 2)) : 0;
        const int te = Epi::HAS_MID ? (seg == 0 ? Epi::MID1 + 2 : (seg == 1 ? Epi::MID2 + 2 : nt)) : nt;
        for (int t = tb; t < te; t += 2) {
            const bool last = (t == nt - 2);
            const char* a1 = cA + (size_t)(t + 1) * kstep;
            const char* a2 = last ? nA : cA + (size_t)(t + 2) * kstep; const char* b2 = last ? nB : cB + (size_t)(t + 2) * kstep;
            const char* a3 = a2 + kstep; const char* b3 = b2 + kstep;
            PG8_LDB(B0, 0, 0); PG8_SCHED; PG8_LDA(At, 0, 0); PG8_STAGE(PG8_SA(1, 1), a1 + hstepA, voffA);
            PG8_WAIT_L(8); PG8_BAR; PG8_WAIT_L(0); PG8_MMA(0, 0, At, B0); PG8_BAR; PG8_SCHED;
            PG8_LDB(B1, 0, 1); PG8_STAGE(PG8_SB(0, 0), b2, voffB);
            PG8_BAR; PG8_WAIT_L(0); PG8_MMA(0, 1, At, B1); PG8_BAR;
            PG8_LDA(At, 0, 1); PG8_STAGE(PG8_SA(0, 0), a2, voffA);
            PG8_BAR; PG8_WAIT_L(0); PG8_MMA(1, 0, At, B0); PG8_BAR; PG8_SCHED;
            PG8_STAGE(PG8_SB(0, 1), b2 + hstepB, voffB);
            PG8_WAIT_V(6); PG8_BAR; PG8_MMA(1, 1, At, B1); PG8_BAR;
            PG8_LDB(B0, 1, 0); PG8_SCHED; PG8_LDA(At, 1, 0); PG8_STAGE(PG8_SA(0, 1), a2 + hstepA, voffA);
            PG8_WAIT_L(8); PG8_BAR; PG8_WAIT_L(0); PG8_MMA(0, 0, At, B0); PG8_BAR; PG8_SCHED;
            PG8_LDB(B1, 1, 1); PG8_STAGE(PG8_SB(1, 0), b3, voffB);
            PG8_BAR; PG8_WAIT_L(0); PG8_MMA(0, 1, At, B1); PG8_BAR;
            PG8_LDA(At, 1, 1); PG8_STAGE(PG8_SA(1, 0), a3, voffA);
            PG8_BAR; PG8_WAIT_L(0); PG8_MMA(1, 0, At, B0); PG8_BAR; PG8_SCHED;
            PG8_STAGE(PG8_SB(1, 1), b3 + hstepB, voffB);
            PG8_WAIT_V(6); PG8_BAR; PG8_MMA(1, 1, At, B1); PG8_BAR;
        }
        if constexpr (Epi::HAS_MID) { if (seg < 2) {
            E.mid(acc, cur, seg, wr, wc, fr, fq);
        } }
        }
#if STAMP_MASK & (1 << 23)
        if (Epi::HAS_MID && blockIdx.x == 0 && threadIdx.x == 0) ((volatile LAS unsigned long long*)(lds + LDSCTL_OFF + 128))[0] = __builtin_amdgcn_s_memrealtime();
#endif
        E(acc, cur, wr, wc, fr, fq);
#if STAMP_MASK & (1 << 23)
        if (Epi::HAS_MID && blockIdx.x == 0 && threadIdx.x == 0) { volatile LAS unsigned long long* TS = (volatile LAS unsigned long long*)(lds + LDSCTL_OFF + 128); TS[1] = TS[1] + (__builtin_amdgcn_s_memrealtime() - TS[0]); }
#endif
        if (!has_next) break;
#pragma unroll
        for (int a = 0; a < 2; ++a)
#pragma unroll
            for (int b = 0; b < 2; ++b)
#pragma unroll
                for (int m = 0; m < 4; ++m)
#pragma unroll
                    for (int n = 0; n < 2; ++n) acc[a][b][m][n] = (f32x4){0.f, 0.f, 0.f, 0.f};
        cur = nxt; cA = nA; cB = nB; ++ui;
    }
    PG8_WAIT_V(0);
    if (wr == 0) PG8_BAR;
    PG8_BAR;
}
#undef PG8_SA
#undef PG8_SB
#undef PG8_STAGE
#undef PG8_LDA
#undef PG8_LDB
#undef PG8_MMA
#undef PG8_WAIT_V
#undef PG8_WAIT_L
#undef PG8_BAR
#undef PG8_SCHED

typedef const f32x4 (&AccRef)[2][2][4][2];
__device__ __forceinline__ f16x8 pack8(f32x4 a, f32x4 b) { f16x8 w; w[0] = (f16)a[0]; w[1] = (f16)a[1]; w[2] = (f16)a[2]; w[3] = (f16)a[3]; w[4] = (f16)b[0]; w[5] = (f16)b[1]; w[6] = (f16)b[2]; w[7] = (f16)b[3]; return w; }

struct EpiPx {
    static constexpr bool PERM = true, HAS_MID = false; static constexpr int MID1 = 0, MID2 = 0; f16* PX; f16* S5A; f16* ZT; f16* GTL;
    __device__ __forceinline__ void operator()(AccRef acc, const Unit& u, int wr, int wc, int fr, int fq) const { fr = opq(fr); fq = opq(fq);
        const int row0 = u.pm * BM + wr * 64 + fr, col0 = u.pn * BM + wc * 32 + 8 * fq;
#pragma unroll
        for (int ai = 0; ai < 2; ++ai)
#pragma unroll
            for (int m = 0; m < 4; ++m) { const int row = row0 + ai * HALF + m * 16;
#pragma unroll
                for (int bj = 0; bj < 2; ++bj) { const int c = col0 + bj * HALF; const f16x8 w = pack8(acc[ai][bj][m][0], acc[ai][bj][m][1]);
                    if (u.pn < 2) *(f16x8*)(S5A + (size_t)(row >> 4) * 16384 + (size_t)(c >> 4) * 512 + (row & 15) * 16 + (c & 15)) = w;
                    else if (u.pn >= 14 && u.pn < 20) {
#pragma unroll
                        for (int j = 0; j < 8; ++j) ZT[(size_t)(c - P_HY + j) * MT + row] = w[j]; }
                    else if (u.pn >= 20 && u.pn < 44) *(f16x8*)(GTL + ((size_t)(u.pn - 20) * 66 + u.pm) * 65536 + (size_t)(row - u.pm * BM) * 256 + (c - u.pn * BM)) = w;
                    else { const int pr = row < MX ? (row & ~8191) + ((row & 63) << 7) + ((row & 8191) >> 6) : row;
                        *(f16x8*)(PX + (size_t)pr * PXLD + (u.pn == 44 ? c - (W_GG - P_GG) : c)) = w; } } }
    }
};
struct EpiF16 {
    static constexpr bool PERM = true, HAS_MID = false; static constexpr int MID1 = 0, MID2 = 0; f16* O; int ldc;
    __device__ __forceinline__ void operator()(AccRef acc, const Unit& u, int wr, int wc, int fr, int fq) const { fr = opq(fr); fq = opq(fq);
        const int row0 = u.pm * BM + wr * 64 + fr, col0 = u.pn * BM + wc * 32 + 8 * fq;
#pragma unroll
        for (int ai = 0; ai < 2; ++ai)
#pragma unroll
            for (int m = 0; m < 4; ++m) { f16* rowp = O + (size_t)(row0 + ai * HALF + m * 16) * ldc + col0;
#pragma unroll
                for (int bj = 0; bj < 2; ++bj) *(f16x8*)(rowp + bj * HALF) = pack8(acc[ai][bj][m][0], acc[ai][bj][m][1]); }
    }
};
struct EpiS5In {
    static constexpr bool PERM = false, HAS_MID = false; static constexpr int MID1 = 0, MID2 = 0; float* S;
    __device__ __forceinline__ void operator()(AccRef acc, const Unit& u, int wr, int wc, int fr, int fq) const { fr = opq(fr); fq = opq(fq);
        const int row0 = u.pm * BM + wr * 64 + fr, col0 = wc * 32 + 4 * fq, g = u.pn;
#pragma unroll
        for (int ai = 0; ai < 2; ++ai)
#pragma unroll
            for (int m = 0; m < 4; ++m) { const int row = row0 + ai * HALF + m * 16; { float* rowp = S + ((size_t)row * 32 + g) * 256 + col0;
#pragma unroll
                for (int bj = 0; bj < 2; ++bj)
#pragma unroll
                    for (int n = 0; n < 2; ++n) *(f32x4*)(rowp + bj * HALF + n * 16) = acc[ai][bj][m][n]; } }
    }
};
struct EpiS5Out {
    static constexpr bool PERM = true, HAS_MID = false; static constexpr int MID1 = 0, MID2 = 0; const f16* S5A; f16* Y; const float* dvec;
    __device__ __forceinline__ void operator()(AccRef acc, const Unit& u, int wr, int wc, int fr, int fq) const { fr = opq(fr); fq = opq(fq);
        const int row0 = u.pm * BM + wr * 64 + fr, col0 = wc * 32 + 8 * fq, g = u.pn;
        const int h0 = col0 & 15;
        const f32x4 d0 = *(const f32x4*)(dvec + g * 16 + h0), d1 = *(const f32x4*)(dvec + g * 16 + h0 + 4);
#pragma unroll
        for (int ai = 0; ai < 2; ++ai) { f16x8 uu[4][2];
#pragma unroll
            for (int m = 0; m < 4; ++m)
#pragma unroll
                for (int bj = 0; bj < 2; ++bj) uu[m][bj] = *(const f16x8*)(S5A + (size_t)(row0 + ai * HALF + m * 16) * 16384 + (size_t)g * 512 + col0 + bj * HALF);
            PIN8(uu[0][0], uu[0][1], uu[1][0], uu[1][1], uu[2][0], uu[2][1], uu[3][0], uu[3][1]);
#pragma unroll
            for (int m = 0; m < 4; ++m) { const int chunk = row0 + ai * HALF + m * 16;
#pragma unroll
                for (int bj = 0; bj < 2; ++bj) { const int c = col0 + bj * HALF, t = c >> 4; f16x8 w;
#pragma unroll
                    for (int j = 0; j < 4; ++j) { w[j] = (f16)gelu_tanh_(acc[ai][bj][m][0][j] * (1.0f / S5SCALE) + d0[j] * (float)uu[m][bj][j]);
                                                  w[4 + j] = (f16)gelu_tanh_(acc[ai][bj][m][1][j] * (1.0f / S5SCALE) + d1[j] * (float)uu[m][bj][4 + j]); }
                    *(f16x8*)(Y + (size_t)(chunk * 16 + t) * 512 + g * 16 + h0) = w; } }
            asm volatile("" ::: "memory"); }
    }
};
struct EpiGlu {
    static constexpr bool PERM = true, HAS_MID = false; static constexpr int MID1 = 0, MID2 = 0; const f16* YP; f16* O; const float* bias;
    __device__ __forceinline__ void operator()(AccRef acc, const Unit& u, int wr, int wc, int fr, int fq) const { fr = opq(fr); fq = opq(fq);
        const int row0 = u.pm * BM + wr * 64 + fr, col0 = u.pn * BM + wc * 32 + 8 * fq;
        f32x4 bv[2][2];
#pragma unroll
        for (int bj = 0; bj < 2; ++bj) { bv[bj][0] = *(const f32x4*)(bias + col0 + bj * HALF); bv[bj][1] = *(const f32x4*)(bias + col0 + bj * HALF + 4); }
#pragma unroll
        for (int ai = 0; ai < 2; ++ai) { f16x8 yp[4][2];
#pragma unroll
            for (int m = 0; m < 4; ++m)
#pragma unroll
                for (int bj = 0; bj < 2; ++bj) yp[m][bj] = *(const f16x8*)(YP + (size_t)(row0 + ai * HALF + m * 16) * 512 + col0 + bj * HALF);
            PIN8(yp[0][0], yp[0][1], yp[1][0], yp[1][1], yp[2][0], yp[2][1], yp[3][0], yp[3][1]);
#pragma unroll
            for (int m = 0; m < 4; ++m)
#pragma unroll
                for (int bj = 0; bj < 2; ++bj) { f16x8 w;
#pragma unroll
                    for (int j = 0; j < 4; ++j) { w[j] = (f16)((float)yp[m][bj][j] * sigmoidf_(acc[ai][bj][m][0][j] + bv[bj][0][j])); w[4 + j] = (f16)((float)yp[m][bj][4 + j] * sigmoidf_(acc[ai][bj][m][1][j] + bv[bj][1][j])); }
                    *(f16x8*)(O + (size_t)(row0 + ai * HALF + m * 16) * 2048 + col0 + bj * HALF) = w; }
            asm volatile("" ::: "memory"); }
    }
};
template <int BR> struct EpiBranch {
    static constexpr bool PERM = true, HAS_MID = false; static constexpr int MID1 = 0, MID2 = 0; const f16* PX; f16* M;
    __device__ __forceinline__ void operator()(AccRef acc, const Unit& u, int wr, int wc, int fr, int fq) const { fr = opq(fr); fq = opq(fq);
        const int row0 = u.pm * BM + wr * 64 + fr, col0 = u.pn * BM + wc * 32 + 8 * fq;
#pragma unroll
        for (int ai = 0; ai < 2; ++ai)
#pragma unroll
            for (int m = 0; m < 4; ++m) { const int row = row0 + ai * HALF + m * 16;
#pragma unroll
                for (int bj = 0; bj < 2; ++bj) { const int c = col0 + bj * HALF;
                    const f16x8 gl = *(const f16x8*)(PX + (size_t)row * PXLD + P_MG + BR * 2048 + c);
                    f16* mp = M + (size_t)row * 2048 + c;
                    f16x8 prev; if (BR > 0) prev = *(const f16x8*)mp;
                    f16x8 w;
#pragma unroll
                    for (int j = 0; j < 4; ++j) { float v0 = sigmoidf_((float)gl[j]) * acc[ai][bj][m][0][j], v1 = sigmoidf_((float)gl[4 + j]) * acc[ai][bj][m][1][j];
                        if (BR > 0) { v0 += (float)prev[j]; v1 += (float)prev[4 + j]; } w[j] = (f16)v0; w[4 + j] = (f16)v1; }
                    *(f16x8*)mp = w; } asm volatile("" ::: "memory"); }
    }
};
typedef f32x4 (&AccMut)[2][2][4][2];

struct EpiBranchF {
    static constexpr bool PERM = true, HAS_MID = true; static constexpr int MID1 = 6, MID2 = 14;
    const f16* GTL; f16* M;
    __device__ __forceinline__ void mid(AccMut acc, const Unit& u, int seg, int wr, int wc, int fr, int fq) const { fr = opq(fr); fq = opq(fq);
        const int lrow0 = wr * 64 + fr, lcol0 = wc * 32 + 8 * fq;
        const f16* ga = GTL + ((size_t)((seg == 0 ? 0 : 8) + u.pn) * 66 + u.pm) * 65536; const f16* gb = ga + (size_t)8 * 66 * 65536;
#pragma unroll
        for (int ai = 0; ai < 2; ++ai) { f16x8 za[4][2], zb[4][2];
#pragma unroll
            for (int m = 0; m < 4; ++m)
#pragma unroll
                for (int bj = 0; bj < 2; ++bj) { const int off = (lrow0 + ai * HALF + m * 16) * 256 + lcol0 + bj * HALF; za[m][bj] = *(const f16x8*)(ga + off); zb[m][bj] = *(const f16x8*)(gb + off); }
            PIN8(za[0][0], za[0][1], za[1][0], za[1][1], za[2][0], za[2][1], za[3][0], za[3][1]); PIN8(zb[0][0], zb[0][1], zb[1][0], zb[1][1], zb[2][0], zb[2][1], zb[3][0], zb[3][1]);
#pragma unroll
            for (int m = 0; m < 4; ++m)
#pragma unroll
                for (int bj = 0; bj < 2; ++bj)
#pragma unroll
                    for (int j = 0; j < 4; ++j) { acc[ai][bj][m][0][j] *= (1.0f + __expf(-(float)zb[m][bj][j])) * __builtin_amdgcn_rcpf(1.0f + __expf(-(float)za[m][bj][j]));
                                                  acc[ai][bj][m][1][j] *= (1.0f + __expf(-(float)zb[m][bj][4 + j])) * __builtin_amdgcn_rcpf(1.0f + __expf(-(float)za[m][bj][4 + j])); }
            asm volatile("" ::: "memory"); }
    }
    __device__ __forceinline__ void operator()(AccRef acc, const Unit& u, int wr, int wc, int fr, int fq) const { fr = opq(fr); fq = opq(fq);
        const int row0 = u.pm * BM + wr * 64 + fr, col0 = u.pn * BM + wc * 32 + 8 * fq;
#pragma unroll
        for (int ai = 0; ai < 2; ++ai) { f16x8 gl[4][2];
#pragma unroll
            for (int m = 0; m < 4; ++m)
#pragma unroll
                for (int bj = 0; bj < 2; ++bj) gl[m][bj] = *(const f16x8*)(GTL + ((size_t)(16 + u.pn) * 66 + u.pm) * 65536 + (wr * 64 + fr + ai * HALF + m * 16) * 256 + wc * 32 + 8 * fq + bj * HALF);
            PIN8(gl[0][0], gl[0][1], gl[1][0], gl[1][1], gl[2][0], gl[2][1], gl[3][0], gl[3][1]);
#pragma unroll
            for (int m = 0; m < 4; ++m)
#pragma unroll
                for (int bj = 0; bj < 2; ++bj) { f16x8 w;
#pragma unroll
                    for (int j = 0; j < 4; ++j) { w[j] = (f16)(sigmoidf_((float)gl[m][bj][j]) * acc[ai][bj][m][0][j]); w[4 + j] = (f16)(sigmoidf_((float)gl[m][bj][4 + j]) * acc[ai][bj][m][1][j]); }
                    *(f16x8*)(M + (size_t)(row0 + ai * HALF + m * 16) * 2048 + col0 + bj * HALF) = w; }
            asm volatile("" ::: "memory"); }
    }
};
struct EpiUpAct {
    static constexpr bool PERM = true, HAS_MID = false; static constexpr int MID1 = 0, MID2 = 0; f16* ACT; float* HALO; const float* cw; const float* cb; LAS float* HL;
    __device__ __forceinline__ void operator()(AccRef acc, const Unit& u, int wr, int wc, int fr, int fq) const { fr = opq(fr); fq = opq(fq);
        const int lane = fq * 16 + fr;
#pragma unroll
        for (int ai = 0; ai < 2; ++ai) { LAS float* hp = HL + ((ai * 2 + wr) * 4 + wc) * 64 + 8 * fq;
            if (fr == 0) { *(LAS f32x4*)(hp) = acc[ai][0][0][0]; *(LAS f32x4*)(hp + 4) = acc[ai][0][0][1]; }
            if (fr == 15) { *(LAS f32x4*)(hp + 32) = acc[ai][0][3][0]; *(LAS f32x4*)(hp + 36) = acc[ai][0][3][1]; } }
        { float* gh = HALO + ((size_t)u.pm * 44 + u.pn) * 768 + wc * 32 + 8 * fq;
          if (wr == 0 && fr < 2) { *(f32x4*)(gh + fr * 128) = acc[0][0][0][0]; *(f32x4*)(gh + fr * 128 + 4) = acc[0][0][0][1]; }
          if (wr == 0 && fr == 0) { *(f32x4*)(gh + 4 * 128) = acc[0][1][0][0]; *(f32x4*)(gh + 4 * 128 + 4) = acc[0][1][0][1]; }
          if (wr == 1 && fr >= 14) { *(f32x4*)(gh + (fr - 12) * 128) = acc[1][0][3][0]; *(f32x4*)(gh + (fr - 12) * 128 + 4) = acc[1][0][3][1]; }
          if (wr == 1 && fr == 15) { *(f32x4*)(gh + 5 * 128) = acc[1][1][3][0]; *(f32x4*)(gh + 5 * 128 + 4) = acc[1][1][3][1]; } }
        asm volatile("s_waitcnt lgkmcnt(0)" ::: "memory"); __builtin_amdgcn_s_barrier(); __builtin_amdgcn_s_barrier(); asm volatile("" ::: "memory");
        const int colg = u.pn * 128 + wc * 32 + 8 * fq;
        const int srcR = (lane & 48) | ((fr + 15) & 15), srcL = (lane & 48) | ((fr + 1) & 15);
        const int row0 = u.pm * BM + wr * 64 + fr;
#pragma unroll
        for (int n = 0; n < 2; ++n) {
            const f32x4 w0 = *(const f32x4*)(cw + colg + 4 * n), w1 = *(const f32x4*)(cw + FFH + colg + 4 * n), w2 = *(const f32x4*)(cw + 2 * FFH + colg + 4 * n), bb = *(const f32x4*)(cb + colg + 4 * n);
#pragma unroll
            for (int ai = 0; ai < 2; ++ai) {
                const bool hasp = (wr == 1) || (ai == 1), hasn = (wr == 0) || (ai == 0);
                const LAS float* pp = HL + (((wr == 1 ? ai : 0) * 2 + (wr == 1 ? 0 : 1)) * 4 + wc) * 64 + 32 + 8 * fq + 4 * n;
                const LAS float* np = HL + (((wr == 0 ? ai : 1) * 2 + (wr == 0 ? 1 : 0)) * 4 + wc) * 64 + 8 * fq + 4 * n;
                const f32x4 hprev = hasp ? *(const LAS f32x4*)pp : (f32x4){0.f, 0.f, 0.f, 0.f}, hnext = hasn ? *(const LAS f32x4*)np : (f32x4){0.f, 0.f, 0.f, 0.f};
                f32x4 R[4], L[4];
#pragma unroll
                for (int m = 0; m < 4; ++m)
#pragma unroll
                    for (int j = 0; j < 4; ++j) { R[m][j] = __shfl(acc[ai][0][m][n][j], srcR); L[m][j] = __shfl(acc[ai][0][m][n][j], srcL); }
#pragma unroll
                for (int m = 0; m < 4; ++m) { const f32x4 pv = fr > 0 ? R[m] : (m > 0 ? R[m > 0 ? m - 1 : 0] : hprev); const f32x4 nv = fr < 15 ? L[m] : (m < 3 ? L[m < 3 ? m + 1 : 3] : hnext);
                    const f32x4 a = w0 * pv + w1 * acc[ai][0][m][n] + w2 * nv + bb;
                    f16x4 o;
#pragma unroll
                    for (int j = 0; j < 4; ++j) o[j] = (f16)(siluf_(a[j]) * acc[ai][1][m][n][j]);
                    *(f16x4*)(ACT + (size_t)(row0 + ai * HALF + m * 16) * FFH + colg + 4 * n) = o; }
                asm volatile("" ::: "memory");
            }
        }
    }
};
struct EpiSlab {
    static constexpr bool PERM = false, HAS_MID = false; static constexpr int MID1 = 0, MID2 = 0; float* slab; const float* mod; int goff;
    __device__ __forceinline__ void operator()(AccRef acc, const Unit& u, int wr, int wc, int fr, int fq) const { fr = opq(fr); fq = opq(fq);
        const int pn = u.pn & 255, ks = u.pn >> 8;
        const int row0 = (u.pm - 64) * BM + wr * 64 + fr, col0 = pn * BM + wc * 32 + 4 * fq;
        const float* gp = mod + 2 * 12288 + goff + col0;
        f32x4 gv[2][2];
#pragma unroll
        for (int bj = 0; bj < 2; ++bj)
#pragma unroll
            for (int n = 0; n < 2; ++n) gv[bj][n] = *(const f32x4*)(gp + bj * HALF + n * 16);
        float* sp = slab + (size_t)ks * MC * D;
#pragma unroll
        for (int ai = 0; ai < 2; ++ai)
#pragma unroll
            for (int m = 0; m < 4; ++m) { float* rowp = sp + (size_t)(row0 + ai * HALF + m * 16) * D + col0;
#pragma unroll
                for (int bj = 0; bj < 2; ++bj)
#pragma unroll
                    for (int n = 0; n < 2; ++n) *(f32x4*)(rowp + bj * HALF + n * 16) = gv[bj][n] * acc[ai][bj][m][n]; }
    }
};
struct EpiResid {
    static constexpr bool PERM = false, HAS_MID = false; static constexpr int MID1 = 0, MID2 = 0; float* X; const float* mod; int goff;
    __device__ __forceinline__ void operator()(AccRef acc, const Unit& u, int wr, int wc, int fr, int fq) const { fr = opq(fr); fq = opq(fq);
        const int row0 = u.pm * BM + wr * 64 + fr, col0 = u.pn * BM + wc * 32 + 4 * fq;
        const int bsel = u.pm < 32 ? 0 : (u.pm < 64 ? 1 : 2);
        const float* gp = mod + bsel * 12288 + goff + col0;
        f32x4 gv[2][2];
#pragma unroll
        for (int bj = 0; bj < 2; ++bj)
#pragma unroll
            for (int n = 0; n < 2; ++n) gv[bj][n] = *(const f32x4*)(gp + bj * HALF + n * 16);
#pragma unroll
        for (int ai = 0; ai < 2; ++ai)
#pragma unroll
            for (int mp = 0; mp < 2; ++mp) { f32x4 xv[2][2][2];
#pragma unroll
                for (int mm = 0; mm < 2; ++mm) { const float* rowp = X + (size_t)(row0 + ai * HALF + (2 * mp + mm) * 16) * D + col0;
#pragma unroll
                    for (int bj = 0; bj < 2; ++bj)
#pragma unroll
                        for (int n = 0; n < 2; ++n) xv[mm][bj][n] = *(const f32x4*)(rowp + bj * HALF + n * 16); }
                PIN8(xv[0][0][0], xv[0][0][1], xv[0][1][0], xv[0][1][1], xv[1][0][0], xv[1][0][1], xv[1][1][0], xv[1][1][1]);
#pragma unroll
                for (int mm = 0; mm < 2; ++mm) { float* rowp = X + (size_t)(row0 + ai * HALF + (2 * mp + mm) * 16) * D + col0;
#pragma unroll
                    for (int bj = 0; bj < 2; ++bj)
#pragma unroll
                        for (int n = 0; n < 2; ++n) *(f32x4*)(rowp + bj * HALF + n * 16) = xv[mm][bj][n] + gv[bj][n] * acc[ai][bj][2 * mp + mm][n]; }
                asm volatile("" ::: "memory"); }
    }
};
}


__device__ __forceinline__ void ph_prologue(const Ctx& F, const ArgsV& AV) {
    const int gt = F.bid * 512 + F.tid, NT = F.G * 512;
    { const f32x4* xs = (const f32x4*)AV.in(I_X); const f32x4* cs = (const f32x4*)AV.in(I_CTX); f32x4* xr = (f32x4*)(F.ws + WS_XRES);
      for (int i = gt; i < MX * D / 4; i += NT) xr[i] = xs[i];
      for (int i = gt; i < MC * D / 4; i += NT) xr[MX * D / 4 + i] = cs[i]; }
    { f32x2* tw = (f32x2*)(F.ws + WS_TW);
      for (int k = gt; k < 16384; k += NT) { float s, c; sincospif((float)k * (2.0f / 16384.0f), &s, &c); tw[k] = (f32x2){c, -s}; } }
    LAS float* sc = (LAS float*)F.lds;
    LAS float* red = (LAS float*)(F.lds + 3 * 2048 * 4);
    for (int i = F.tid; i < 3 * 2048; i += 512) { const int r = i / 2048, k = i % 2048; const float v = r < 2 ? AV.in(I_C)[r * 2048 + k] : AV.in(I_CCTX)[k]; sc[i] = siluf_(v); }
    __syncthreads();
    const int col = F.tid & 63, ks = F.tid >> 6;
    for (int chunk = F.bid; chunk < DEPTH * 192; chunk += F.G) {
        const int l = chunk / 192, n0 = (chunk % 192) * 64;
        const float* w = AV.in(I_WMOD) + (size_t)l * 2048 * 12288 + n0 + col;
        float s0 = 0.f, s1 = 0.f, s2 = 0.f;
#pragma unroll 8
        for (int k = ks * 256; k < ks * 256 + 256; ++k) { const float wv = w[(size_t)k * 12288]; s0 += sc[k] * wv; s1 += sc[2048 + k] * wv; s2 += sc[4096 + k] * wv; }
        red[(ks * 3 + 0) * 64 + col] = s0; red[(ks * 3 + 1) * 64 + col] = s1; red[(ks * 3 + 2) * 64 + col] = s2;
        __syncthreads();
        if (F.tid < 192) { const int r = F.tid >> 6, c2 = F.tid & 63; float s = 0.f;
#pragma unroll
            for (int q = 0; q < 8; ++q) s += red[(q * 3 + r) * 64 + c2];
            ((float*)(F.ws + WS_MOD))[((size_t)l * 3 + r) * 12288 + n0 + c2] = s + AV.in(I_BMOD)[(size_t)l * 12288 + n0 + c2]; }
        __syncthreads();
    }
}

__device__ __forceinline__ void conv_item(const float* W, int ldw, int k0, int srccol, f16* WT, int dstrow, int ldk) {
    float v[64];
    const float* src = W + (size_t)k0 * ldw + (srccol >= 0 ? srccol : 0);
#pragma unroll
    for (int k = 0; k < 64; ++k) v[k] = src[(size_t)k * ldw];
#pragma unroll
    for (int k = 0; k < 64; k += 8) PIN8(v[k], v[k + 1], v[k + 2], v[k + 3], v[k + 4], v[k + 5], v[k + 6], v[k + 7]);
    f16* dst = WT + (size_t)dstrow * ldk + k0;
#pragma unroll
    for (int kg = 0; kg < 8; ++kg) { f16x8 o;
#pragma unroll
        for (int e = 0; e < 8; ++e) o[e] = srccol >= 0 ? (f16)v[8 * kg + e] : (f16)0.f;
        *(f16x8*)(dst + 8 * kg) = o; }
}
__device__ __forceinline__ void ph_convert_weights(const Ctx& F, const ArgsV& AV, int l) {
    const int skip = F.G > 64 ? 32 : 0;
    if (F.bid < skip) return;
    const int gw = (F.bid - skip) * 8 + F.wave, NGW = (F.G - skip) * 8, lane = F.lane;
    constexpr int I_IN = 32 * 180, I_GLU = 8 * 8, I_BR = 32 * 32, I_OUT = 32 * 32, I_UP = 32 * 176, I_DN = 88 * 32;
    constexpr int NIT = I_IN + I_GLU + I_BR + I_OUT + I_UP + I_DN;
    for (int it = gw; it < NIT; it += NGW) {
        int r = it;
        if (r < I_IN) { const int kb = r / 180, nb = r % 180, j = nb * 64 + lane;
            const int src = j < 2048 ? j : (j < 11264 ? j + 32 : (j < 11296 ? 2048 + (j - 11264) : -1));
            conv_item(AV.in(I_WIN) + (size_t)l * 2048 * INW, INW, kb * 64, src, (f16*)(F.ws + WS_WIN), j, 2048); continue; } r -= I_IN;
        if (r < I_GLU) { const int kb = r / 8, nb = r % 8, j = nb * 64 + lane; conv_item(AV.in(I_GLUW) + (size_t)l * 512 * 512, 512, kb * 64, j, (f16*)(F.ws + WS_WGLU), j, 512); continue; } r -= I_GLU;
        if (r < I_BR) { const int kb = r / 32, nb = r % 32, j = nb * 64 + lane; conv_item(AV.in(I_WBR) + (size_t)l * 2048 * 2048, 2048, kb * 64, j, (f16*)(F.ws + WS_WBR), j, 2048); continue; } r -= I_BR;
        if (r < I_OUT) { const int kb = r / 32, nb = r % 32, j = nb * 64 + lane; conv_item(AV.in(I_WOUT) + (size_t)l * 2048 * 2048, 2048, kb * 64, j, (f16*)(F.ws + WS_WOUT), j, 2048); continue; } r -= I_OUT;
        if (r < I_UP) { const int kb = r / 176, nb = r % 176, j = nb * 64 + lane, pn = j >> 8, i = j & 255; const int src = i < 128 ? 128 * pn + i : FFH + 128 * pn + (i - 128);
            conv_item(AV.in(I_WUP) + (size_t)l * 2048 * UPLD, UPLD, kb * 64, src, (f16*)(F.ws + WS_WUP), j, 2048); continue; } r -= I_UP;
        { const int kb = r / 32, nb = r % 32, j = nb * 64 + lane; conv_item(AV.in(I_WDN) + (size_t)l * FFH * 2048, 2048, kb * 64, j, (f16*)(F.ws + WS_WDN), j, FFH); }
    }
}

__device__ __forceinline__ void s5_mats_group(const Ctx& F, const ArgsV& AV, int l, int g) {
    LAS f32x2* APOW = (LAS f32x2*)F.lds;
    LAS f32x2* BBAR = APOW + 2 * 17 * 64;
    LAS f32x2* CM = BBAR + 2 * 64 * 16;
    LAS float* KLAG = (LAS float*)(CM + 2 * 16 * 64);
    __syncthreads();
    for (int i = F.tid; i < 2 * 17 * 64; i += 512) { const int d = i / (17 * 64), e = (i / 64) % 17, n = i % 64;
        const size_t pi = (((size_t)l * 2 + d) * 32 + g) * 64 + n;
        const float are = AV.in(I_S5ARE)[pi], aim = AV.in(I_S5AIM)[pi], dt = expf(AV.in(I_S5STEP)[((size_t)l * 2 + d) * 32 + g]);
        const float zr = are * dt * (float)e, zi = aim * dt * (float)e; float s, c; sincosf(zi, &s, &c); const float m = expf(zr);
        APOW[i] = (f32x2){m * c, m * s}; }
    __syncthreads();
    for (int i = F.tid; i < 2 * 64 * 16; i += 512) { const int d = i / 1024, n = (i / 16) % 64, h = i % 16;
        const size_t pi = (((size_t)l * 2 + d) * 32 + g) * 64 + n;
        const float are = AV.in(I_S5ARE)[pi], aim = AV.in(I_S5AIM)[pi];
        const f32x2 ab = APOW[(d * 17 + 1) * 64 + n]; const f32x2 num = (f32x2){ab.x - 1.0f, ab.y};
        const float den = are * are + aim * aim; const f32x2 q = (f32x2){(num.x * are + num.y * aim) / den, (num.y * are - num.x * aim) / den};
        const size_t bi = (pi * 16) + h;
        BBAR[i] = cmul(q, (f32x2){AV.in(I_S5BRE)[bi], AV.in(I_S5BIM)[bi]});
        const size_t ci = ((((size_t)l * 2 + d) * 32 + g) * 16 + h) * 64 + n;
        CM[(d * 16 + h) * 64 + n] = (f32x2){AV.in(I_S5CRE)[ci], AV.in(I_S5CIM)[ci]}; }
    __syncthreads();
    for (int i = F.tid; i < 2 * 16 * 256; i += 512) { const int d = i / 4096, lag = (i / 256) % 16, h = (i / 16) % 16, hp = i % 16; float s = 0.f;
        for (int n = 0; n < 64; ++n) { const f32x2 t = cmul(CM[(d * 16 + h) * 64 + n], APOW[(d * 17 + lag) * 64 + n]); const f32x2 b = BBAR[(d * 64 + n) * 16 + hp]; s += t.x * b.x - t.y * b.y; }
        KLAG[i] = s; }
    __syncthreads();
    f16* W = (f16*)(F.ws + WS_S5W) + (size_t)g * 256 * 512;
    for (int i = F.tid; i < 256 * 64; i += 512) { const int n = i / 64, k8 = (i % 64) * 8, t = n >> 4, h = n & 15; f16x8 o;
#pragma unroll
        for (int e = 0; e < 8; ++e) { const int k = k8 + e; float v;
            if (k < 256) { const int s = k >> 4, hp = k & 15; v = 0.f;
                if (t >= s) v += KLAG[((0 * 16 + (t - s)) * 16 + h) * 16 + hp];
                if (s >= t) v += KLAG[((1 * 16 + (s - t)) * 16 + h) * 16 + hp];
                v *= S5SCALE; }
            else { const int d = (k - 256) >> 7, nn2 = (k - 256) & 127, nn = nn2 & 63, im = nn2 >> 6, ex = d == 0 ? t + 1 : 16 - t;
                const f32x2 z = cmul(CM[(d * 16 + h) * 64 + nn], APOW[(d * 17 + ex) * 64 + nn]); v = im ? -z.y : z.x; }
            o[e] = (f16)v; }
        *(f16x8*)(W + (size_t)n * 512 + k8) = o; }
    f16* Mx = (f16*)(F.ws + WS_S5M) + (size_t)g * 256 * 256;
    for (int i = F.tid; i < 256 * 32; i += 512) { const int n = i / 32, k8 = (i % 32) * 8, d = n >> 7, ri = (n >> 6) & 1, nn = n & 63; f16x8 o;
#pragma unroll
        for (int e = 0; e < 8; ++e) { const int k = k8 + e, s = k >> 4, hp = k & 15, ex = d == 0 ? 15 - s : s;
            const f32x2 z = cmul(APOW[(d * 17 + ex) * 64 + nn], BBAR[(d * 64 + nn) * 16 + hp]); o[e] = (f16)((ri ? z.y : z.x) * S5SCALE); }
        *(f16x8*)(Mx + (size_t)n * 256 + k8) = o; }
    if (F.tid < 128) { const int d = F.tid >> 6, nn = F.tid & 63; ((f32x2*)(F.ws + WS_S5AT))[(d * 32 + g) * 64 + nn] = APOW[(d * 17 + 16) * 64 + nn]; }
    __syncthreads();
}

__device__ __forceinline__ void ph_hyena_h2(const Ctx& F, const ArgsV& AV, int l) {
    LAS float* W1 = (LAS float*)F.lds;
    LAS float* W2 = W1 + 33 * 64;
    LAS float* PV = W2 + 64 * 64;
    LAS float* SCR = PV + 256;
    __syncthreads();
    for (int i = F.tid; i < 33 * 64; i += 512) W1[i] = AV.in(I_HYW1)[(size_t)l * 33 * 64 + i];
    for (int i = F.tid; i < 64 * 64; i += 512) W2[i] = AV.in(I_HYW2)[(size_t)l * 4096 + i];
    if (F.tid < 64) { PV[F.tid] = AV.in(I_HYB1)[l * 64 + F.tid]; PV[64 + F.tid] = AV.in(I_HYF1)[l * 64 + F.tid]; PV[128 + F.tid] = AV.in(I_HYB2)[l * 64 + F.tid]; PV[192 + F.tid] = AV.in(I_HYF2)[l * 64 + F.tid]; }
    __syncthreads();
    LAS float* scr = SCR + F.wave * 64;
    const int gw = F.bid * 8 + F.wave, NGW = F.G * 8, j = F.lane;
    float* H2 = (float*)(F.ws + WS_H2);
    for (int p = gw; p < SEQ + LC; p += NGW) {
        const int n = p < SEQ ? SEQ : LC, pos = p < SEQ ? p : p - SEQ;
        float feat = 0.f;
        if (j == 0) feat = (float)pos / (float)(n - 1);
        else if (j < 33) { const int fi = (j - 1) & 15; const float fr = 1e-4f + (float)fi * ((15.0f - 1e-4f) / 15.0f);
            const float ang = (6.283185307179586f / (float)n) * (float)pos * fr; float s, c; sincosf(ang, &s, &c); feat = j < 17 ? c : -s; }
        scr[j] = feat; LDS_WAIT(); asm volatile("" ::: "memory");
        float a = PV[j];
        for (int i = 0; i < 33; ++i) a += scr[i] * W1[i * 64 + j];
        const float h1 = sinf(PV[64 + j] * a);
        LDS_WAIT(); asm volatile("" ::: "memory");
        scr[j] = h1; LDS_WAIT(); asm volatile("" ::: "memory");
        float b = PV[128 + j];
        for (int i = 0; i < 64; ++i) b += scr[i] * W2[i * 64 + j];
        H2[(size_t)p * 64 + j] = sinf(PV[192 + j] * b);
        LDS_WAIT(); asm volatile("" ::: "memory");
    }
}

__device__ __forceinline__ void ph_norm(const Ctx& F, const ArgsV& AV, int l, int which, int nrows, int nslab) {
    const int gw = F.bid * 8 + F.wave, NGW = F.G * 8;
    float* X = (float*)(F.ws + WS_XRES); f16* O = (f16*)(F.ws + WS_HN); const float* SL = (const float*)(F.ws + WS_SLAB);
    const float* gain = AV.in(which ? I_N2G : I_N1G) + (size_t)l * D;
    const float* mod = (const float*)(F.ws + WS_MOD) + (size_t)l * 3 * 12288;
    const int shoff = which ? 6144 : 0, soff = which ? 8192 : 2048;
    for (int m = gw; m < nrows; m += NGW) {
        const int bsel = m < SEQ ? 0 : (m < MX ? 1 : 2);
        f32x4* xr = (f32x4*)(X + (size_t)m * D) + F.lane;
        f32x4 v[8]; float s = 0.f;
#pragma unroll
        for (int j = 0; j < 8; ++j) v[j] = xr[64 * j];
        PIN8(v[0], v[1], v[2], v[3], v[4], v[5], v[6], v[7]);
        if (m >= MX && nslab > 0) {
            for (int sl = 0; sl < nslab; ++sl) { const f32x4* sr = (const f32x4*)(SL + ((size_t)sl * MC + (m - MX)) * D) + F.lane;
#pragma unroll
                for (int j = 0; j < 8; ++j) v[j] = v[j] + sr[64 * j]; }
#pragma unroll
            for (int j = 0; j < 8; ++j) xr[64 * j] = v[j]; }
#pragma unroll
        for (int j = 0; j < 8; ++j) s += (v[j].x * v[j].x + v[j].y * v[j].y) + (v[j].z * v[j].z + v[j].w * v[j].w);
        const float rstd = 1.0f / sqrtf(wave_sum(s) * (1.0f / D) + EPS);
        const float* mp = mod + bsel * 12288;
#pragma unroll
        for (int j = 0; j < 8; ++j) { const int c = 4 * F.lane + 256 * j;
            const f32x4 g = *(const f32x4*)(gain + c), sh = *(const f32x4*)(mp + shoff + c), sc = *(const f32x4*)(mp + soff + c);
            f16x4 o;
#pragma unroll
            for (int e = 0; e < 4; ++e) o[e] = (f16)(v[j][e] * rstd * g[e] * (1.0f + sc[e]) + sh[e]);
            *(f16x4*)(O + (size_t)m * D + c) = o; }
    }
}
__device__ __forceinline__ void ph_final_norm(const Ctx& F, const ArgsV& AV) {
    const int gw = F.bid * 8 + F.wave, NGW = F.G * 8;
    const float* X = (const float*)(F.ws + WS_XRES); const float* gain = AV.in(I_FNG);
    for (int m = gw; m < MX; m += NGW) {
        const f32x4* xr = (const f32x4*)(X + (size_t)m * D) + F.lane;
        f32x4 v[8]; float s = 0.f;
#pragma unroll
        for (int j = 0; j < 8; ++j) { v[j] = xr[64 * j]; s += (v[j].x * v[j].x + v[j].y * v[j].y) + (v[j].z * v[j].z + v[j].w * v[j].w); }
        const float rstd = 1.0f / sqrtf(wave_sum(s) * (1.0f / D) + EPS);
#pragma unroll
        for (int j = 0; j < 8; ++j) { const int c = 4 * F.lane + 256 * j; const f32x4 g = *(const f32x4*)(gain + c);
            *(f32x4*)(AV.out + (size_t)m * D + c) = v[j] * rstd * g; }
    }
}

__device__ __forceinline__ void ph_s5_scan(const Ctx& F) {
    if (F.tid >= 32) return;
    const float* S = (const float*)(F.ws + WS_S5S); f16* SA = (f16*)(F.ws + WS_S5A);
    for (int gt = F.bid * 32 + F.tid; gt < 2 * 2 * 32 * 64; gt += F.G * 32) {
        const int nn = gt & 63, g = (gt >> 6) & 31, d = (gt >> 11) & 1, b = gt >> 12;
        const f32x2 at = ((const f32x2*)(F.ws + WS_S5AT))[(d * 32 + g) * 64 + nn];
        f32x2 st = (f32x2){0.f, 0.f};
        for (int base = 0; base < 16 + 512; base += 16) {
            f32x2 loc[16]; int chk[16];
#pragma unroll
            for (int u = 0; u < 16; ++u) { const int step = base + u; int chunk;
                if (d == 0) chunk = step < 16 ? 1024 + b * 16 + step : b * 512 + (step - 16);
                else chunk = step < 16 ? 1024 + b * 16 + (15 - step) : b * 512 + (511 - (step - 16));
                chk[u] = chunk; const size_t so = ((size_t)chunk * 32 + g) * 256 + d * 128 + nn;
                loc[u] = (f32x2){S[so], S[so + 64]}; }
            PIN8(loc[0], loc[1], loc[2], loc[3], loc[4], loc[5], loc[6], loc[7]); PIN8(loc[8], loc[9], loc[10], loc[11], loc[12], loc[13], loc[14], loc[15]);
#pragma unroll
            for (int u = 0; u < 16; ++u) { f16* xp = SA + (size_t)chk[u] * 16384 + (size_t)g * 512 + 256 + d * 128 + nn;
                xp[0] = (f16)st.x; xp[64] = (f16)st.y;
                st = cmul(at, st) + loc[u]; }
        }
    }
}

__device__ __forceinline__ void ph_ffn_fix(const Ctx& F, const ArgsV& AV, int l, int nMr) {
    const float* HALO = (const float*)(F.ws + WS_HALO); f16* ACT = (f16*)(F.ws + WS_ACT);
    const float* cw = AV.in(I_FFCW) + (size_t)l * 3 * FFH; const float* cb = AV.in(I_FFCB) + (size_t)l * FFH;
    const int NT = nMr * 44 * 2 * 128;
    for (int task = F.bid * 512 + F.tid; task < NT; task += F.G * 512) {
        const int c = task & 127, which = (task >> 7) & 1, tile = task >> 8, pn = tile % 44, pm = tile / 44;
        const float* h = HALO + ((size_t)pm * 44 + pn) * 768 + c; const int col = pn * 128 + c;
        const bool first = (pm == 0 || pm == 32 || pm >= 64), last = (pm == 31 || pm >= 63);
        float ap, ac, an, b;
        if (which == 0) { ap = first ? 0.f : HALO[((size_t)(pm - 1) * 44 + pn) * 768 + 3 * 128 + c]; ac = h[0]; an = h[128]; b = h[4 * 128]; }
        else { ap = h[2 * 128]; ac = h[3 * 128]; an = last ? 0.f : HALO[((size_t)(pm + 1) * 44 + pn) * 768 + c]; b = h[5 * 128]; }
        const float a = cw[col] * ap + cw[FFH + col] * ac + cw[2 * FFH + col] * an + cb[col];
        ACT[(size_t)(pm * 256 + (which ? 255 : 0)) * FFH + col] = (f16)(siluf_(a) * b);
    }
}

namespace gla {
constexpr int QK_LD = 136, KH_LD = 72, VT_LD = 72, P_LD = 72;
constexpr int OFF_QT = 0;
constexpr int OFF_KT = 17408;
constexpr int OFF_VT = OFF_KT + 18432;
constexpr int OFF_P = OFF_VT + 36864;
constexpr int OFF_LR = OFF_P + 9216;
constexpr int OFF_GT = OFF_LR + 4096;
constexpr int OFF_DEC = OFF_GT + 2048;
constexpr int OFF_RS = OFF_DEC + 512;
constexpr int OFF_QR = OFF_RS + 2048;
constexpr int OFF_KR = OFF_QR + 17408;
constexpr int OFF_WG = OFF_KR + 17408;
static_assert(OFF_WG + 8192 <= LDSCTL_OFF, "gla lds");

__device__ __forceinline__ int grow(int b, int sc, int j, int i) {
    if (sc < 32) { const int col = 2 * sc + (j >> 1), r = (j & 1) * 64 + i; return b * SEQ + r * 64 + col; }
    return MX + b * LC + j * 64 + i;
}
__device__ __forceinline__ int prow(int b, int sc, int j, int i) {
    return sc < 32 ? b * SEQ + sc * 256 + j * 64 + i : MX + b * LC + j * 64 + i;
}
#define GLA_MFMA(a, b, c) __builtin_amdgcn_mfma_f32_16x16x32_f16(a, b, c, 0, 0, 0)

template <bool FULL>
__device__ __forceinline__ void gla_unit(const Ctx& F, const ArgsV& AV, int l, int unit) {
    const int b = unit / (4 * NSC), h = (unit / NSC) % 4, sc = unit % NSC;
    LAS f16* QT = (LAS f16*)(F.lds + OFF_QT); LAS f16* KT = (LAS f16*)(F.lds + OFF_KT); LAS f16* VT = (LAS f16*)(F.lds + OFF_VT);
    LAS f16* PP = (LAS f16*)(F.lds + OFF_P); LAS f16* LR = (LAS f16*)(F.lds + OFF_LR);
    LAS float* GT = (LAS float*)(F.lds + OFF_GT); LAS float* DEC = (LAS float*)(F.lds + OFF_DEC); LAS float* RS = (LAS float*)(F.lds + OFF_RS);
    LAS f16* QR = (LAS f16*)(F.lds + OFF_QR); LAS f16* KR = (LAS f16*)(F.lds + OFF_KR); LAS float* WG = (LAS float*)(F.lds + OFF_WG);
    const int tid = F.tid, lane = F.lane, w = F.wave, q0 = lane >> 4, c0 = lane & 15;
    const int dk0 = tid & 127, ig0 = tid >> 7;
    const f16* PX = (const f16*)(F.ws + WS_PX);
    const float scale = 0.08838834764831845f;
    for (int dir = 0; dir < 2; ++dir) {
        __syncthreads();
        for (int i = tid; i < 16 * 128; i += 512) WG[i] = AV.in(I_GLAWG)[(((size_t)l * 2 + dir) * 16 + (i >> 7)) * 512 + h * 128 + (i & 127)];
        const float bgv = AV.in(I_GLABG)[((size_t)l * 2 + dir) * 512 + h * 128 + dk0];
        const size_t sidx = ((((size_t)b * 4 + h) * NSC + sc) * 2 + dir);
        f32x4 accS[8][2];
        if (FULL) { const float* Sin = (const float*)(F.ws + WS_GSIN) + sidx * 32768; const int q = opq(q0), c = opq(c0);
#pragma unroll
            for (int dt = 0; dt < 8; ++dt)
#pragma unroll
                for (int et = 0; et < 2; ++et)
#pragma unroll
                    for (int r = 0; r < 4; ++r) accS[dt][et][r] = Sin[(16 * dt + 4 * q + r) * 256 + 32 * w + 16 * et + c]; }
        else {
#pragma unroll
            for (int dt = 0; dt < 8; ++dt)
#pragma unroll
                for (int et = 0; et < 2; ++et) accS[dt][et] = (f32x4){0.f, 0.f, 0.f, 0.f}; }
        float sumtot = 0.f;
        for (int jj = 0; jj < 4; ++jj) {
            const int j = dir ? 3 - jj : jj;
            __syncthreads();
            const int tid = opq(F.tid);
            if (tid < 256) { const int row = tid >> 2, part = tid & 3; const int gr = prow(b, sc, j, row);
                *(LAS f16x8*)(LR + row * 32 + part * 8) = *(const f16x8*)(PX + (size_t)gr * PXLD + P_GG + part * 8); }
#pragma unroll 1
            for (int k = 0; k < 4; ++k) { const int idx = tid + 512 * k, wi = idx >> 6, ln = idx & 63, rr = ln >> 2, cc = ln & 3;
                const int row = (wi & 3) * 16 + rr, chunk = (wi >> 2) * 4 + cc; const int gr = prow(b, sc, j, row);
                const f16x8 v8 = *(const f16x8*)(PX + (size_t)gr * PXLD + P_GV + h * 256 + chunk * 8);
#pragma unroll
                for (int e = 0; e < 8; ++e) VT[(chunk * 8 + e) * VT_LD + row] = v8[e]; }
#pragma unroll 1
            for (int k = 0; k < 2; ++k) { const int idx = tid + 512 * k, row = idx >> 4, ch = idx & 15; const int gr = prow(b, sc, j, row);
                *(LAS f16x8*)(KR + row * QK_LD + ch * 8) = *(const f16x8*)(PX + (size_t)gr * PXLD + P_GK + h * 128 + ch * 8);
                if (FULL) *(LAS f16x8*)(QR + row * QK_LD + ch * 8) = *(const f16x8*)(PX + (size_t)gr * PXLD + P_GQ + h * 128 + ch * 8); }
            __syncthreads();
            const int dk = opq(dk0), ig = opq(ig0);
            float bv[16];
#pragma unroll
            for (int ii = 0; ii < 16; ++ii) { const int i = ig * 16 + ii; float pre = bgv;
                const f16x8 l0 = *(const LAS f16x8*)(LR + i * 32 + dir * 16), l1 = *(const LAS f16x8*)(LR + i * 32 + dir * 16 + 8);
#pragma unroll
                for (int r = 0; r < 8; ++r) pre += (float)l0[r] * WG[r * 128 + dk] + (float)l1[r] * WG[(8 + r) * 128 + dk];
                bv[ii] = logsigmoidf_(pre) * (1.0f / 16.0f); }
            float totloc;
            if (dir == 0) {
#pragma unroll
                for (int ii = 1; ii < 16; ++ii) bv[ii] += bv[ii - 1];
                totloc = bv[15]; }
            else {
#pragma unroll
                for (int ii = 14; ii >= 0; --ii) bv[ii] += bv[ii + 1];
                totloc = bv[0]; }
            GT[ig * 128 + dk] = totloc;
            __syncthreads();
            const float g0 = GT[dk], g1 = GT[128 + dk], g2 = GT[256 + dk], g3 = GT[384 + dk];
            const float total = (g0 + g1) + (g2 + g3);
            float off, bmid;
            if (dir == 0) { off = (ig > 0 ? g0 : 0.f) + (ig > 1 ? g1 : 0.f) + (ig > 2 ? g2 : 0.f); bmid = g0 + g1; }
            else { off = (ig < 3 ? g3 : 0.f) + (ig < 2 ? g2 : 0.f) + (ig < 1 ? g1 : 0.f); bmid = g2 + g3; }
#pragma unroll
            for (int ii = 0; ii < 16; ++ii) bv[ii] += off;
            if (FULL) {
#pragma unroll
                for (int ii = 0; ii < 16; ++ii) { const int i = ig * 16 + ii;
                    QT[i * QK_LD + dk] = (f16)((float)QR[i * QK_LD + dk] * scale * __expf(fminf(bv[ii] - bmid, 9.f)));
                    KT[i * QK_LD + dk] = (f16)((float)KR[i * QK_LD + dk] * __expf(fminf(bmid - bv[ii], 9.f))); }
                __syncthreads();
                { const int c = opq(c0), q = opq(q0);
#pragma unroll
                for (int s = 0; s < 2; ++s) { const int T = 2 * w + s, it = T >> 2, jt = T & 3; f32x4 a = (f32x4){0.f, 0.f, 0.f, 0.f};
#pragma unroll
                    for (int kk = 0; kk < 4; ++kk) { const f16x8 kf = *(const LAS f16x8*)(KT + (jt * 16 + c) * QK_LD + kk * 32 + 8 * q);
                        const f16x8 qf = *(const LAS f16x8*)(QT + (it * 16 + c) * QK_LD + kk * 32 + 8 * q); a = GLA_MFMA(kf, qf, a); }
                    const int i = it * 16 + c; f16x4 pv;
#pragma unroll
                    for (int r = 0; r < 4; ++r) { const int jx = jt * 16 + 4 * q + r; const bool keep = dir == 0 ? (jx <= i) : (jx >= i); pv[r] = keep ? (f16)a[r] : (f16)0.f; }
                    *(LAS f16x4*)(PP + i * P_LD + jt * 16 + 4 * q) = pv; } }
                __syncthreads();
#pragma unroll
                for (int ii = 0; ii < 16; ++ii) { const int i = ig * 16 + ii; QT[i * QK_LD + dk] = (f16)((float)QR[i * QK_LD + dk] * scale * __expf(bv[ii])); }
            }
            { f16x8 k0, k1;
#pragma unroll
              for (int ii = 0; ii < 8; ++ii) { k0[ii] = (f16)((float)KR[(ig * 16 + ii) * QK_LD + dk] * __expf(total - bv[ii])); k1[ii] = (f16)((float)KR[(ig * 16 + 8 + ii) * QK_LD + dk] * __expf(total - bv[8 + ii])); }
              *(LAS f16x8*)(KT + dk * KH_LD + ig * 16) = k0; *(LAS f16x8*)(KT + dk * KH_LD + ig * 16 + 8) = k1; }
            if (ig == 0) { DEC[dk] = __expf(total); sumtot += total; }
            __syncthreads();
            const int c = opq(c0), q = opq(q0);
            if (FULL) {
                f32x4 accO[4][2];
#pragma unroll
                for (int it = 0; it < 4; ++it)
#pragma unroll
                    for (int et = 0; et < 2; ++et) accO[it][et] = (f32x4){0.f, 0.f, 0.f, 0.f};
#pragma unroll
                for (int et = 0; et < 2; ++et)
#pragma unroll
                    for (int kk = 0; kk < 2; ++kk) { const f16x8 vf = *(const LAS f16x8*)(VT + (32 * w + 16 * et + c) * VT_LD + kk * 32 + 8 * q);
#pragma unroll
                        for (int it = 0; it < 4; ++it) { const f16x8 pf = *(const LAS f16x8*)(PP + (it * 16 + c) * P_LD + kk * 32 + 8 * q); accO[it][et] = GLA_MFMA(vf, pf, accO[it][et]); } asm volatile("" ::: "memory"); }
#pragma unroll
                for (int kb = 0; kb < 4; ++kb)
#pragma unroll
                    for (int et = 0; et < 2; ++et) { f16x8 sf; asm volatile("" ::: "memory");
#pragma unroll
                        for (int e = 0; e < 4; ++e) { sf[e] = (f16)accS[2 * kb][et][e]; sf[4 + e] = (f16)accS[2 * kb + 1][et][e]; }
#pragma unroll
                        for (int it = 0; it < 4; ++it) { const f16x4 lo = *(const LAS f16x4*)(QT + (it * 16 + c) * QK_LD + 32 * kb + 4 * q), hi = *(const LAS f16x4*)(QT + (it * 16 + c) * QK_LD + 32 * kb + 16 + 4 * q);
                            f16x8 qf; qf[0] = lo[0]; qf[1] = lo[1]; qf[2] = lo[2]; qf[3] = lo[3]; qf[4] = hi[0]; qf[5] = hi[1]; qf[6] = hi[2]; qf[7] = hi[3];
                            accO[it][et] = GLA_MFMA(sf, qf, accO[it][et]); } }
                float* OF = (float*)(F.ws + WS_GOF);
                if (dir == 0) {
#pragma unroll
                    for (int it = 0; it < 4; ++it) { const int gr = prow(b, sc, j, it * 16 + c);
#pragma unroll
                        for (int et = 0; et < 2; ++et) *(f32x4*)(OF + (size_t)gr * 1024 + h * 256 + 32 * w + 16 * et + 4 * q) = accO[it][et];
                        asm volatile("" ::: "memory"); } }
                else {
                    int grs[4];
#pragma unroll
                    for (int it = 0; it < 4; ++it) { grs[it] = prow(b, sc, j, it * 16 + c); float ss = 0.f;
#pragma unroll
                        for (int et = 0; et < 2; ++et) { accO[it][et] = accO[it][et] + *(const f32x4*)(OF + (size_t)grs[it] * 1024 + h * 256 + 32 * w + 16 * et + 4 * q);
                            ss += (accO[it][et][0] * accO[it][et][0] + accO[it][et][1] * accO[it][et][1]) + (accO[it][et][2] * accO[it][et][2] + accO[it][et][3] * accO[it][et][3]); }
                        ss += __shfl_xor(ss, 16); ss += __shfl_xor(ss, 32);
                        if (q == 0) RS[(it * 16 + c) * 8 + w] = ss; asm volatile("" ::: "memory"); }
                    __syncthreads();
                    const float* ng = AV.in(I_GLANG) + (size_t)l * 256;
                    f16* Y = (f16*)(F.ws + WS_YCAT);
#pragma unroll
                    for (int it = 0; it < 4; ++it) { const int i = it * 16 + c; const f32x4 ra = *(const LAS f32x4*)(RS + i * 8), rb = *(const LAS f32x4*)(RS + i * 8 + 4);
                        const float tot = ((ra[0] + ra[1]) + (ra[2] + ra[3])) + ((rb[0] + rb[1]) + (rb[2] + rb[3]));
                        const float rstd = 1.0f / sqrtf(tot * (1.0f / 256.0f) + EPS);
#pragma unroll
                        for (int et = 0; et < 2; ++et) { const int e0 = 32 * w + 16 * et + 4 * q;
                            const f32x4 gv = *(const f32x4*)(ng + e0); const f16x4 rv = *(const f16x4*)(PX + (size_t)grs[it] * PXLD + P_GR + h * 256 + e0);
                            f16x4 o;
#pragma unroll
                            for (int r = 0; r < 4; ++r) o[r] = (f16)(accO[it][et][r] * rstd * gv[r] * siluf_((float)rv[r]));
                            *(f16x4*)(Y + (size_t)grow(b, sc, j, it * 16 + c) * 2048 + 1024 + h * 256 + e0) = o; } asm volatile("" ::: "memory"); }
                }
            }
#pragma unroll
            for (int dt = 0; dt < 8; ++dt) { const f32x4 dv = *(const LAS f32x4*)(DEC + 16 * dt + 4 * q);
#pragma unroll
                for (int et = 0; et < 2; ++et) accS[dt][et] = accS[dt][et] * dv; }
#pragma unroll
            for (int kk = 0; kk < 2; ++kk) { f16x8 vf[2];
#pragma unroll
                for (int et = 0; et < 2; ++et) vf[et] = *(const LAS f16x8*)(VT + (32 * w + 16 * et + c) * VT_LD + kk * 32 + 8 * q);
#pragma unroll
                for (int dt = 0; dt < 8; ++dt) { const f16x8 kf = *(const LAS f16x8*)(KT + (16 * dt + c) * KH_LD + kk * 32 + 8 * q);
#pragma unroll
                    for (int et = 0; et < 2; ++et) accS[dt][et] = GLA_MFMA(kf, vf[et], accS[dt][et]); if (dt & 1) asm volatile("" ::: "memory"); } }
        }
        if (!FULL) { float* Sl = (float*)(F.ws + WS_GSLOC) + sidx * 32768; const int q = opq(q0), c = opq(c0);
#pragma unroll
            for (int dt = 0; dt < 8; ++dt)
#pragma unroll
                for (int et = 0; et < 2; ++et)
#pragma unroll
                    for (int r = 0; r < 4; ++r) Sl[(16 * dt + 4 * q + r) * 256 + 32 * w + 16 * et + c] = accS[dt][et][r];
            if (ig0 == 0) ((float*)(F.ws + WS_GDT))[sidx * 128 + dk0] = __expf(sumtot); }
        VM_WAIT();
    }
}
__device__ __forceinline__ void ph_gla_scan(const Ctx& F) {
    const float* Sl = (const float*)(F.ws + WS_GSLOC); float* Si = (float*)(F.ws + WS_GSIN); const float* Dt = (const float*)(F.ws + WS_GDT);
    for (int gt = F.bid * 512 + F.tid; gt < 2 * 4 * 2 * 32768; gt += F.G * 512) {
        const int e = gt & 32767, dir = (gt >> 15) & 1, h = (gt >> 16) & 3, b = gt >> 18;
        float S = 0.f;
        for (int base = 0; base < NSC; base += 11) {
            float sl[11], dt[11]; size_t ix[11];
#pragma unroll
            for (int u = 0; u < 11; ++u) { const int step = base + u; const int sc = step == 0 ? 32 : (dir == 0 ? step - 1 : 32 - step);
                const size_t idx = ((((size_t)b * 4 + h) * NSC + sc) * 2 + dir); ix[u] = idx;
                sl[u] = Sl[idx * 32768 + e]; dt[u] = Dt[idx * 128 + (e >> 8)]; }
            PIN8(sl[0], sl[1], sl[2], sl[3], sl[4], sl[5], sl[6], sl[7]); PIN8(dt[0], dt[1], dt[2], dt[3], dt[4], dt[5], dt[6], dt[7]); PIN4(sl[8], sl[9], sl[10], dt[8]); asm volatile("" : "+v"(dt[9]), "+v"(dt[10]));
#pragma unroll
            for (int u = 0; u < 11; ++u) { Si[ix[u] * 32768 + e] = S; S = dt[u] * S + sl[u]; }
        }
    }
}
#undef GLA_MFMA
}

namespace hy {
#define PADI(i) ((i) + ((i) >> 5))
constexpr int HY_BUF_BYTES = (16384 + 512) * 8;
constexpr int HY_SCR_OFF = HY_BUF_BYTES;
static_assert(HY_SCR_OFF + 2048 <= LDSCTL_OFF, "hyena lds");
__device__ __forceinline__ f32x2 twid(int k, float invN) { const float xr = (float)k * invN; return (f32x2){__builtin_amdgcn_cosf(xr), -__builtin_amdgcn_sinf(xr)}; }
__device__ __forceinline__ f32x2 mul_w16(f32x2 d, int a) {
    constexpr float c1 = 0.9238795325112867f, s1 = 0.3826834323650898f, r = 0.7071067811865476f;
    float c, s;
    switch (a & 15) {
        case 0: return d; case 4: return (f32x2){d.y, -d.x}; case 8: return (f32x2){-d.x, -d.y}; case 12: return (f32x2){-d.y, d.x};
        case 1: c = c1; s = s1; break; case 2: c = r; s = r; break; case 3: c = s1; s = c1; break;
        case 5: c = -s1; s = c1; break; case 6: c = -r; s = r; break; case 7: c = -c1; s = s1; break;
        case 9: c = -c1; s = -s1; break; case 10: c = -r; s = -r; break; case 11: c = -s1; s = -c1; break;
        case 13: c = s1; s = -c1; break; case 14: c = r; s = -r; break; default: c = c1; s = -s1; break; }
    return (f32x2){d.x * c + d.y * s, d.y * c - d.x * s};
}
template <int R> __device__ __forceinline__ void dif_pass(LAS f32x2* x, int m, int lh, int tid) {
    const int N = 1 << m; const float invN = 1.0f / (float)N; const int lg = lh - R + 1, g = 1 << lg, S = (N >> 1) >> lh;
    for (int q = tid; q < (N >> R); q += 512) { const int j = q & (g - 1), blk = q >> lg, base = (blk << (lh + 1)) + j;
        f32x2 v[1 << R];
#pragma unroll
        for (int k = 0; k < (1 << R); ++k) v[k] = x[PADI(base + k * g)];
        f32x2 w = twid(j * S, invN);
#pragma unroll
        for (int s = 0; s < R; ++s) { const int half = 1 << (R - 1 - s);
#pragma unroll
            for (int k = 0; k < (1 << R); ++k) if (!(k & half)) { const f32x2 a = v[k], b = v[k + half]; v[k] = a + b;
                v[k + half] = mul_w16(cmul(a - b, w), ((k & (half - 1)) << s) * (16 >> R)); }
            w = cmul(w, w); }
#pragma unroll
        for (int k = 0; k < (1 << R); ++k) x[PADI(base + k * g)] = v[k]; }
    __syncthreads();
}
template <int R> __device__ __forceinline__ void dit_pass(LAS f32x2* x, int m, int lh, int tid) {
    const int N = 1 << m; const float invN = 1.0f / (float)N; const int h = 1 << lh, S1 = (N >> 1) >> lh;
    for (int q = tid; q < (N >> R); q += 512) { const int j = q & (h - 1), blk = q >> lh, base = (blk << (lh + R)) + j;
        f32x2 v[1 << R];
#pragma unroll
        for (int k = 0; k < (1 << R); ++k) v[k] = x[PADI(base + k * h)];
        f32x2 wp[R]; wp[R - 1] = cconj(twid(j * (S1 >> (R - 1)), invN));
#pragma unroll
        for (int s = R - 2; s >= 0; --s) wp[s] = cmul(wp[s + 1], wp[s + 1]);
#pragma unroll
        for (int s = 0; s < R; ++s) { const int half = 1 << s;
#pragma unroll
            for (int k = 0; k < (1 << R); ++k) if (!(k & half)) { const f32x2 a = v[k];
                const f32x2 b = mul_w16(cmul(v[k + half], wp[s]), (16 - (k & (half - 1)) * (16 >> (s + 1))) & 15);
                v[k] = a + b; v[k + half] = a - b; } }
#pragma unroll
        for (int k = 0; k < (1 << R); ++k) x[PADI(base + k * h)] = v[k]; }
    __syncthreads();
}
__device__ __forceinline__ void fft_fwd(LAS f32x2* x, int m, int tid) {
    int lh = m - 1;
    while (lh + 1 >= 4) { dif_pass<4>(x, m, lh, tid); lh -= 4; }
    if (lh + 1 == 2) dif_pass<2>(x, m, 1, tid); else if (lh + 1 == 1) dif_pass<1>(x, m, 0, tid);
}
__device__ __forceinline__ void fft_inv(LAS f32x2* x, int m, int tid) {
    int lh = 0;
    while (m - lh >= 4) { dit_pass<4>(x, m, lh, tid); lh += 4; }
    if (m - lh == 2) dit_pass<2>(x, m, lh, tid); else if (m - lh == 1) dit_pass<1>(x, m, lh, tid);
}
__device__ __forceinline__ int brev(int k, int m) { return (int)(__brev((unsigned)k) >> (32 - m)); }

__device__ __forceinline__ void filt_unit(const Ctx& F, const ArgsV& AV, int l, int unit) {
    const int kind = unit >> 9, o = (unit >> 8) & 1, pair = unit & 255;
    const int n = kind ? LC : SEQ, m = kind ? 9 : 14, N = 2 * n, tid = F.tid;
    LAS f32x2* buf = (LAS f32x2*)F.lds;
    LAS float* W3 = (LAS float*)(F.lds + HY_SCR_OFF);
    LAS float* B3 = W3 + 256;
    LAS float* RED = B3 + 4;
    LAS float* INV = RED + 16;
    __syncthreads();
    if (tid < 256) { const int j = tid >> 2, ci = tid & 3; const int col = o * 1024 + (ci >> 1) * 512 + 2 * pair + (ci & 1);
        W3[j * 4 + ci] = AV.in(I_HYW3)[((size_t)l * 64 + j) * 2048 + col]; if (j == 0) B3[ci] = AV.in(I_HYB3)[(size_t)l * 2048 + col]; }
    __syncthreads();
    const float* H2 = (const float*)(F.ws + WS_H2) + (kind ? (size_t)SEQ * 64 : 0);
    const float lo = -3.0701134573253945f, hi = -15.350567286626973f;
    const float ra = fabsf(lo + (hi - lo) * (float)(2 * pair) / 511.0f), rb = fabsf(lo + (hi - lo) * (float)(2 * pair + 1) / 511.0f);
    float sa = 0.f, sb = 0.f;
    for (int t = tid; t < n; t += 512) {
        float a0 = B3[0], a1 = B3[1], a2 = B3[2], a3 = B3[3];
        const f32x4* hr = (const f32x4*)(H2 + (size_t)t * 64);
#pragma unroll 4
        for (int j4 = 0; j4 < 16; ++j4) { const f32x4 hv = hr[j4];
#pragma unroll
            for (int e = 0; e < 4; ++e) { const f32x4 wv = *(const LAS f32x4*)(W3 + (j4 * 4 + e) * 4); a0 += hv[e] * wv[0]; a1 += hv[e] * wv[1]; a2 += hv[e] * wv[2]; a3 += hv[e] * wv[3]; } }
        const float tn = (float)t / (float)(n - 1), da = expf(-tn * ra), db = expf(-tn * rb);
        const float fa = a0 * da, fb = a1 * db, ba = a2 * da, bb = a3 * db;
        buf[PADI(t)] = (f32x2){fa, fb}; sa += fabsf(fa); sb += fabsf(fb);
        if (t >= 1) { buf[PADI(N - t)] = (f32x2){ba, bb}; sa += fabsf(ba); sb += fabsf(bb); }
    }
    if (tid == 0) { float z0 = 0.f; asm volatile("" : "+v"(z0)); buf[PADI(n)] = (f32x2){z0, z0}; }
    sa = wave_sum(sa); sb = wave_sum(sb);
    if (F.lane == 0) { RED[F.wave * 2] = sa; RED[F.wave * 2 + 1] = sb; }
    __syncthreads();
    if (tid < 2) { float s = 0.f;
#pragma unroll
        for (int w = 0; w < 8; ++w) s += RED[w * 2 + tid];
        INV[tid] = 1.0f / (s + EPS); }
    __syncthreads();
    { const float ia = INV[0], ib = INV[1];
      for (int i = tid; i < N; i += 512) { f32x2 v = buf[PADI(i)]; v.x *= ia; v.y *= ib; buf[PADI(i)] = v; } }
    __syncthreads();
    fft_fwd(buf, m, tid);
    f32x4* out = (f32x4*)(F.ws + WS_FSD + (kind ? FSD_C_OFF : 0)) + (size_t)(o * 256 + pair) * (n + 1);
    for (int u = tid; u <= n; u += 512) { const int p = u < n ? 2 * u : 1, k = brev(p, m), pn = brev((N - k) & (N - 1), m);
        const f32x2 zk = buf[PADI(p)], zn = cconj(buf[PADI(pn)]);
        const f32x2 fa = (zk + zn) * 0.5f, df = zk - zn, fb = (f32x2){df.y * 0.5f, -df.x * 0.5f};
        const f32x2 fs = (fa + fb) * 0.5f, fd = (fa - fb) * 0.5f;
        out[u] = (f32x4){fs.x, fs.y, fd.x, fd.y}; }
    __syncthreads();
}

__device__ __forceinline__ void main_unit(const Ctx& F, const ArgsV& AV, int l, int unit) {
    const int kind = unit >> 9, b = (unit >> 8) & 1, pair = unit & 255;
    const int n = kind ? LC : SEQ, m = kind ? 9 : 14, N = 2 * n, tid = F.tid;
    const int row0 = kind ? MX + b * LC : b * SEQ;
    LAS f32x2* buf = (LAS f32x2*)F.lds;
    const f16* ZT = (const f16*)(F.ws + WS_ZT) + (size_t)(2 * pair) * MT + row0;
    const float* cw = AV.in(I_HYCW) + (size_t)l * 3 * 1536 + 2 * pair; const float* cb = AV.in(I_HYCB) + (size_t)l * 1536 + 2 * pair;
    f32x2 yv[16], g1[16], g2[16];
#pragma unroll
    for (int g = 0; g < 3; ++g)
#pragma unroll
        for (int cc = 0; cc < 2; ++cc) { const float w0 = cw[g * 512 + cc], w1 = cw[1536 + g * 512 + cc], w2 = cw[3072 + g * 512 + cc], bs = cb[g * 512 + cc];
            const f16* zt = ZT + (size_t)(g * 512 + cc) * MT;
#pragma unroll
            for (int gi = 0; gi < 2; ++gi) { const int t0 = 8 * (tid + 512 * gi);
                f16x8 mv; float pv = 0.f, nv = 0.f;
#pragma unroll
                for (int e = 0; e < 8; ++e) mv[e] = (f16)0.f;
                if (t0 < n) { mv = *(const f16x8*)(zt + t0); if (t0 > 0) pv = (float)zt[t0 - 1]; if (t0 + 8 < n) nv = (float)zt[t0 + 8]; }
#pragma unroll
                for (int e = 0; e < 8; ++e) { const float zm = e == 0 ? pv : (float)mv[e == 0 ? 0 : e - 1], zc = (float)mv[e], zp = e == 7 ? nv : (float)mv[e == 7 ? 7 : e + 1];
                    const float r = w0 * zm + w1 * zc + w2 * zp + bs;
                    if (g == 0) { if (cc == 0) yv[gi * 8 + e].x = r; else yv[gi * 8 + e].y = r; }
                    else if (g == 1) { if (cc == 0) g1[gi * 8 + e].x = r; else g1[gi * 8 + e].y = r; }
                    else { if (cc == 0) g2[gi * 8 + e].x = r; else g2[gi * 8 + e].y = r; } } } }
    const float invN = 1.0f / (float)N;
#pragma unroll
    for (int o = 0; o < 2; ++o) {
        __syncthreads();
        float z0 = 0.f; asm volatile("" : "+v"(z0));
#pragma unroll
        for (int gi = 0; gi < 2; ++gi) { const int t0 = 8 * (tid + 512 * gi);
            if (t0 < n) {
#pragma unroll
                for (int e = 0; e < 8; ++e) { buf[PADI(t0 + e)] = yv[gi * 8 + e]; buf[PADI(n + t0 + e)] = (f32x2){z0, z0}; } } }
        __syncthreads();
        fft_fwd(buf, m, tid);
        const f32x4* fsd = (const f32x4*)(F.ws + WS_FSD + (kind ? FSD_C_OFF : 0)) + (size_t)(o * 256 + pair) * (n + 1);
        for (int u = tid; u <= n; u += 512) { const int p = u < n ? 2 * u : 1, k = brev(p, m), pn = brev((N - k) & (N - 1), m);
            const f32x2 zk = buf[PADI(p)], zn = buf[PADI(pn)]; const f32x4 f = fsd[u]; const f32x2 fs = (f32x2){f[0], f[1]}, fd = (f32x2){f[2], f[3]};
            const f32x2 wk = cmul(zk, fs) + cmul(cconj(zn), fd), wn = cmul(zn, cconj(fs)) + cmul(cconj(zk), cconj(fd));
            buf[PADI(pn)] = wn; buf[PADI(p)] = wk; }
        __syncthreads();
        fft_inv(buf, m, tid);
        const float* hb = AV.in(I_HYBIAS) + ((size_t)l * 2 + o) * 512 + 2 * pair; const f32x2 bias = (f32x2){hb[0], hb[1]};
#pragma unroll
        for (int gi = 0; gi < 2; ++gi) { const int t0 = 8 * (tid + 512 * gi);
            if (t0 < n) {
#pragma unroll
                for (int e = 0; e < 8; ++e) { const f32x2 cv = buf[PADI(t0 + e)] * invN; const f32x2 gt = o == 0 ? g1[gi * 8 + e] : g2[gi * 8 + e];
                    yv[gi * 8 + e] = gt * (cv + yv[gi * 8 + e] * bias); } } }
    }
    f16* Y = (f16*)(F.ws + WS_YBT) + (size_t)(2 * pair) * MT + row0;
#pragma unroll
    for (int gi = 0; gi < 2; ++gi) { const int t0 = 8 * (tid + 512 * gi);
        if (t0 < n) { f16x8 oa, ob;
#pragma unroll
            for (int e = 0; e < 8; ++e) { oa[e] = (f16)yv[gi * 8 + e].x; ob[e] = (f16)yv[gi * 8 + e].y; }
            *(f16x8*)(Y + t0) = oa; *(f16x8*)(Y + MT + t0) = ob; } }
    __syncthreads();
}

__device__ __forceinline__ void ph_ybt_transpose(const Ctx& F) {
    LAS f16* T = (LAS f16*)F.lds;
    const f16* YBT = (const f16*)(F.ws + WS_YBT); f16* Y = (f16*)(F.ws + WS_YCAT);
    for (int rb = F.bid; rb < MT / 64; rb += F.G) { const int r0 = rb * 64;
        __syncthreads();
#pragma unroll
        for (int i = 0; i < 8; ++i) *(LAS f16x8*)(T + F.tid * 72 + 8 * i) = *(const f16x8*)(YBT + (size_t)F.tid * MT + r0 + 8 * i);
        __syncthreads();
        const int row = F.tid >> 3, cg = F.tid & 7;
#pragma unroll
        for (int jj = 0; jj < 8; ++jj) { const int gidx = cg + 8 * jj; f16x8 o;
#pragma unroll
            for (int e = 0; e < 8; ++e) o[e] = T[(8 * gidx + e) * 72 + row];
            *(f16x8*)(Y + (size_t)(r0 + row) * 2048 + 512 + 8 * gidx) = o; }
    }
    __syncthreads();
}
#undef PADI
}

#ifndef PHMASK
#define PHMASK 0xFFFF
#endif
#define PH_EN(k) (((PHMASK) >> (k)) & 1)
#ifndef STAMP_MASK
#define STAMP_MASK 0
#endif
#ifndef STAMP_K
#define STAMP_K 1
#endif
#ifndef SUBMASK
#define SUBMASK 7
#endif
#define SUB_EN(k) (((SUBMASK) >> (k)) & 1)
constexpr int NPH = 2 + 12 * DEPTH;
constexpr int CW_Q = 8192;
__device__ __forceinline__ int q_pull(unsigned* ctr, volatile LAS int* slot) {
    __syncthreads();
    if (threadIdx.x == 0) *slot = (int)__hip_atomic_fetch_add(ctr, 1u, __ATOMIC_RELAXED, __HIP_MEMORY_SCOPE_AGENT);
    __syncthreads();
    return *slot;
}

__global__ void __launch_bounds__(512, 2) mk_fwd(Args args) {
    extern __shared__ __attribute__((aligned(16))) unsigned char lds_raw[];
    Ctx F; F.lds = (LAS unsigned char*)lds_raw; F.tid = threadIdx.x; F.lane = F.tid & 63; F.wave = __builtin_amdgcn_readfirstlane(F.tid >> 6);
    F.G = gridDim.x; F.bid = blockIdx.x; F.ws = args.ws;
    ArgsV AV; AV.out = args.out;
    const Ctx F0 = F;
#define FRESH() do { F.tid = opq(F0.tid); F.lane = F.tid & 63; F.wave = __builtin_amdgcn_readfirstlane(F.tid >> 6); } while (0)
    volatile LAS unsigned* MISC = (volatile LAS unsigned*)(F.lds + LDSCTL_OFF);
    if (F.tid < 64) MISC[F.tid] = 0u;
    __syncthreads();
    unsigned* barw = (unsigned*)(F.ws + WS_CTL) + CW_BAR;
    XcdBarrier bar; bar.bar = barw; bar.x = 0; bar.st = nullptr;
    const int lo = args.ph_lo, hi = args.ph_hi;
    if (hi - lo > 1) bar = xcd_barrier_post(barw, MISC + 8);
#define IN(k) (lo <= (k) && (k) < hi)
#define SEAM(k) do { if (IN(k) && IN((k) + 1)) xcd_barrier(bar); } while (0)
#if STAMP_MASK
    volatile LAS unsigned long long* TS = (volatile LAS unsigned long long*)(F.lds + LDSCTL_OFF + 128);
#define TSTART(k) do { if ((((STAMP_MASK) >> (k)) & 1) && blockIdx.x == 0 && threadIdx.x == 0) TS[0] = __builtin_amdgcn_s_memrealtime(); } while (0)
#define TSTOP(k) do { if ((((STAMP_MASK) >> (k)) & 1) && blockIdx.x == 0 && threadIdx.x == 0) TS[1] = TS[1] + (__builtin_amdgcn_s_memrealtime() - TS[0]); } while (0)
#else
#define TSTART(k) do {} while (0)
#define TSTOP(k) do {} while (0)
#endif
    unsigned char* ws = F.ws;
    const int rank160 = (F.bid + F.G - 160 % F.G) % F.G;

    TSTART(12);
    if (PH_EN(12) && IN(0)) { FRESH(); ph_prologue(F, AV); }
    SEAM(0);
    TSTOP(12);

    for (int l = 0; l < DEPTH; ++l) {
        const int pb = 1 + 12 * l;
        const float* modl = (const float*)(ws + WS_MOD) + (size_t)l * 3 * 12288;
        const bool ctx_on = l < DEPTH - 1;
        const int nMr = ctx_on ? MT / 256 : MX / 256, nrows = ctx_on ? MT : MX;
        TSTART(0);
        if (PH_EN(0) && IN(pb + 0)) {
            FRESH(); ph_convert_weights(F, AV, l);
            __syncthreads();
            FRESH(); if (F.bid < 32) s5_mats_group(F, AV, l, F.bid);
            FRESH(); ph_hyena_h2(F, AV, l);
            FRESH(); ph_norm(F, AV, l, 0, MT, l > 0 ? 11 : 0);
        }
        SEAM(pb + 0);
        TSTOP(0);
        TSTART(1);
        if (PH_EN(1) && IN(pb + 1)) {
            pg8::SchedPlain S; S.init(MT / 256, WINN / 256, F.G, F.bid); S.A = (const char*)(ws + WS_HN); S.B = (const char*)(ws + WS_WIN); S.aTile = (size_t)256 * 2048 * 2; S.bTile = (size_t)256 * 2048 * 2;
            pg8::EpiPx E{(f16*)(ws + WS_PX), (f16*)(ws + WS_S5A), (f16*)(ws + WS_ZT), (f16*)(ws + WS_GTL)};
            pg8::gemm_phase(F.lds, 2048, 2048, 32, S, E);
        }
        SEAM(pb + 1);
        TSTOP(1);
        TSTART(2);
        if (PH_EN(2) && IN(pb + 2)) {
            TSTART(16);
            if (SUB_EN(0)) { pg8::SchedS5 S{(const char*)(ws + WS_S5A), (const char*)(ws + WS_S5M), (size_t)256 * 256 * 2, F.G, F.bid};
              pg8::EpiS5In E{(float*)(ws + WS_S5S)};
              pg8::gemm_phase(F.lds, 16384, 256, 4, S, E); }
            TSTOP(16);
            { unsigned* qc = (unsigned*)(ws + WS_CTL) + CW_Q + (l * 2 + 0) * 64; volatile LAS int* slot = (volatile LAS int*)(MISC + 16);
              for (;;) { const int u = q_pull(qc, slot); if (u >= 264 + 1024) break;
                  if (u < 264) { TSTART(17); FRESH(); gla::gla_unit<false>(F, AV, l, u); TSTOP(17); } else { TSTART(18); FRESH(); hy::filt_unit(F, AV, l, u - 264); TSTOP(18); } } }
        }
        SEAM(pb + 2);
        TSTOP(2);
        TSTART(3);
        if (PH_EN(3) && IN(pb + 3)) { FRESH(); ph_s5_scan(F); FRESH(); gla::ph_gla_scan(F); }
        SEAM(pb + 3);
        TSTOP(3);
        TSTART(4);
        if (PH_EN(4) && IN(pb + 4)) {
            TSTART(19);
            if (SUB_EN(0)) { pg8::SchedS5 S{(const char*)(ws + WS_S5A), (const char*)(ws + WS_S5W), (size_t)256 * 512 * 2, F.G, F.bid};
              pg8::EpiS5Out E{(const f16*)(ws + WS_S5A), (f16*)(ws + WS_YAPRE), AV.in(I_S5D) + (size_t)l * 512};
              pg8::gemm_phase(F.lds, 16384, 512, 8, S, E); }
            TSTOP(19);
            { unsigned* qc = (unsigned*)(ws + WS_CTL) + CW_Q + (l * 2 + 1) * 64; volatile LAS int* slot = (volatile LAS int*)(MISC + 16);
              for (;;) { const int u = q_pull(qc, slot); if (u >= 264 + 1024) break;
                  if (u < 264) { TSTART(20); FRESH(); gla::gla_unit<true>(F, AV, l, u); TSTOP(20); } else { TSTART(21); FRESH(); hy::main_unit(F, AV, l, u - 264); TSTOP(21); } } }
        }
        SEAM(pb + 4);
        TSTOP(4);
        TSTART(5);
        if (PH_EN(5) && IN(pb + 5)) {
            pg8::SchedPlain S; S.init(nMr, 2, F.G, F.bid); S.A = (const char*)(ws + WS_YAPRE); S.B = (const char*)(ws + WS_WGLU); S.aTile = (size_t)256 * 512 * 2; S.bTile = (size_t)256 * 512 * 2;
            pg8::EpiGlu E{(const f16*)(ws + WS_YAPRE), (f16*)(ws + WS_YCAT), AV.in(I_GLUB) + (size_t)l * 512};
            pg8::gemm_phase(F.lds, 512, 512, 8, S, E);
            FRESH(); hy::ph_ybt_transpose(F);
        }
        SEAM(pb + 5);
        TSTOP(5);
        TSTART(6);
        if (PH_EN(6) && IN(pb + 6)) {
            pg8::SchedPlain S; S.init(nMr, 8, F.G, F.bid); S.aTile = (size_t)256 * 2048 * 2; S.bTile = (size_t)256 * 2048 * 2;
            S.A = (const char*)(ws + WS_YCAT); S.B = (const char*)(ws + WS_WBR);
            pg8::EpiBranchF E{(const f16*)(ws + WS_GTL), (f16*)(ws + WS_MBUF)};
            TSTART(24);
            pg8::gemm_phase(F.lds, 2048, 2048, 32, S, E);
            TSTOP(24);
#ifdef PG_DUMMY
            { pg8::EpiF16 E9{(f16*)(ws + WS_ACT), 2048}; pg8::gemm_phase(F.lds, 2048, 2048, 32, S, E9); }
#endif
        }
        SEAM(pb + 6);
        TSTOP(6);
        TSTART(7);
        if (PH_EN(7) && IN(pb + 7)) {
            pg8::SchedPlain S; S.init(MX / 256, 8, F.G, F.bid); S.A = (const char*)(ws + WS_MBUF); S.B = (const char*)(ws + WS_WOUT); S.aTile = (size_t)256 * 2048 * 2; S.bTile = (size_t)256 * 2048 * 2;
            pg8::EpiResid E{(float*)(ws + WS_XRES), modl, 4096};
            pg8::gemm_phase(F.lds, 2048, 2048, 32, S, E);
            if (ctx_on) { pg8::SchedSplit S2{(const char*)(ws + WS_MBUF), (const char*)(ws + WS_WOUT), (size_t)256 * 2048 * 2, (size_t)256 * 2048 * 2, (size_t)8 * 128, 4, F.G, F.bid};
                pg8::EpiSlab E2{(float*)(ws + WS_SLAB), modl, 4096};
                pg8::gemm_phase(F.lds, 2048, 2048, 8, S2, E2); }
        }
        SEAM(pb + 7);
        TSTOP(7);
        TSTART(8);
        if (PH_EN(8) && IN(pb + 8)) { FRESH(); ph_norm(F, AV, l, 1, nrows, 4); }
        SEAM(pb + 8);
        TSTOP(8);
        TSTART(9);
        if (PH_EN(9) && IN(pb + 9)) {
            pg8::SchedPlain S; S.init(nMr, UPLD / 256, F.G, F.bid); S.A = (const char*)(ws + WS_HN); S.B = (const char*)(ws + WS_WUP); S.aTile = (size_t)256 * 2048 * 2; S.bTile = (size_t)256 * 2048 * 2;
            pg8::EpiUpAct E{(f16*)(ws + WS_ACT), (float*)(ws + WS_HALO), AV.in(I_FFCW) + (size_t)l * 3 * FFH, AV.in(I_FFCB) + (size_t)l * FFH, (LAS float*)(F.lds + EXTRA_OFF)};
            pg8::gemm_phase(F.lds, 2048, 2048, 32, S, E);
        }
        SEAM(pb + 9);
        TSTOP(9);
        TSTART(10);
        if (PH_EN(10) && IN(pb + 10)) { FRESH(); ph_ffn_fix(F, AV, l, nMr); }
        SEAM(pb + 10);
        TSTOP(10);
        TSTART(11);
        if (PH_EN(11) && IN(pb + 11)) {
            pg8::SchedPlain S; S.init(MX / 256, 8, F.G, F.bid); S.A = (const char*)(ws + WS_ACT); S.B = (const char*)(ws + WS_WDN); S.aTile = (size_t)256 * FFH * 2; S.bTile = (size_t)256 * FFH * 2;
            pg8::EpiResid E{(float*)(ws + WS_XRES), modl, 10240};
            pg8::gemm_phase(F.lds, FFH, FFH, FFH / 64, S, E);
            if (ctx_on) { pg8::SchedSplit S2{(const char*)(ws + WS_ACT), (const char*)(ws + WS_WDN), (size_t)256 * FFH * 2, (size_t)256 * FFH * 2, (size_t)8 * 128, 11, F.G, F.bid};
                pg8::EpiSlab E2{(float*)(ws + WS_SLAB), modl, 10240};
                pg8::gemm_phase(F.lds, FFH, FFH, 8, S2, E2); }
        }
        SEAM(pb + 11);
        TSTOP(11);
    }
    if (PH_EN(13) && IN(NPH - 1)) { FRESH(); ph_final_norm(F, AV); }
#if STAMP_MASK
    if (blockIdx.x == 0 && threadIdx.x == 0) { const unsigned long long t0 = __builtin_amdgcn_s_memrealtime(); while (__builtin_amdgcn_s_memrealtime() - t0 < (unsigned long long)(STAMP_K) * TS[1]) __builtin_amdgcn_s_sleep(8); }
#endif
#undef IN
#undef SEAM
#undef FRESH
}

extern "C" void kernel_launch(void* const* d_in, const int* in_sizes, int n_in, void* d_out, int out_size, void* d_ws, size_t ws_size, hipStream_t stream) {
    static int grid = 0;
    if (grid == 0) {
        if (n_in != 40 || out_size != MX * D || ws_size < WS_END) { fprintf(stderr, "kernel_launch: unexpected problem (n_in %d out %d ws %zu, need %zu)\n", n_in, out_size, ws_size, (size_t)WS_END); grid = -1; return; }
        int dev = 0, cus = 0, per_cu = 0;
        if (hipGetDevice(&dev) != hipSuccess || hipDeviceGetAttribute(&cus, hipDeviceAttributeMultiprocessorCount, dev) != hipSuccess) { grid = -1; return; }
        if (hipFuncSetAttribute((const void*)mk_fwd, hipFuncAttributeMaxDynamicSharedMemorySize, LDS_BYTES) != hipSuccess) { fprintf(stderr, "kernel_launch: hipFuncSetAttribute failed\n"); grid = -1; return; }
        if (hipOccupancyMaxActiveBlocksPerMultiprocessor(&per_cu, (const void*)mk_fwd, 512, LDS_BYTES) != hipSuccess || per_cu < 1)
            fprintf(stderr, "kernel_launch: occupancy query reports %d\n", per_cu);
        (void)hipGetLastError();
        grid = cus;
    }
    if (grid < 0) return;
    if (hipMemsetAsync((char*)d_ws + WS_CTL, 0, CTL_ZERO_BYTES, stream) != hipSuccess) return;
    Args a{};
    for (int i = 0; i < 40; ++i) a.in[i] = (const float*)d_in[i];
    a.out = (float*)d_out; a.ws = (unsigned char*)d_ws;
#if MK_ONE
    a.ph_lo = 0; a.ph_hi = NPH;
    hipLaunchKernelGGL(mk_fwd, dim3(grid), dim3(512), LDS_BYTES, stream, a);
#else
    for (int p = 0; p < NPH; ++p) { a.ph_lo = p; a.ph_hi = p + 1; hipLaunchKernelGGL(mk_fwd, dim3(grid), dim3(512), LDS_BYTES, stream, a); }
#endif
}
```

```cpp
#include <hip/hip_runtime.h>
#include <stdio.h>

#ifndef MK_ONE
#define MK_ONE 1
#define STAMP_MASK 0
#define STAMP_K 1
#endif

#define GAS __attribute__((address_space(1)))
#define LAS __attribute__((address_space(3)))
typedef _Float16 f16;
typedef _Float16 f16x8 __attribute__((ext_vector_type(8)));
typedef _Float16 f16x4 __attribute__((ext_vector_type(4)));
typedef _Float16 f16x2 __attribute__((ext_vector_type(2)));
typedef float f32x4 __attribute__((ext_vector_type(4)));
typedef float f32x2 __attribute__((ext_vector_type(2)));

constexpr int D = 2048, NB = 2, SEQ = 8192, LC = 256, DEPTH = 4;
constexpr int MX = NB * SEQ, MC = NB * LC, MT = MX + MC;
constexpr int PXLD = 3840, WINN = 11520, FFH = 5632, UPLD = 2 * FFH;
constexpr int P_S5 = 0, P_GK = 512, P_GV = 1024, P_GQ = 2048, P_GR = 2560, P_HY = 3584, P_MG = 5120, P_GG = 3584, W_GG = 11264;
constexpr int INW = 11296;
constexpr int NCHK = 1056;
constexpr float S5SCALE = 1024.f;
constexpr float EPS = 1e-6f;
constexpr int NSC = 33;

constexpr size_t MiB = 1u << 20;
constexpr size_t WS_CTL = 0, CTL_ZERO_BYTES = 1 * MiB;
constexpr size_t WS_MOD = 1 * MiB;
constexpr size_t WS_TW = 2 * MiB;
constexpr size_t WS_S5AT = 3 * MiB;
constexpr size_t WS_WIN = 4 * MiB;
constexpr size_t WS_WGLU = WS_WIN + 45 * MiB;
constexpr size_t WS_WBR = WS_WGLU + 1 * MiB;
constexpr size_t WS_WOUT = WS_WBR + 8 * MiB;
constexpr size_t WS_WUP = WS_WOUT + 8 * MiB;
constexpr size_t WS_WDN = WS_WUP + 44 * MiB;
constexpr size_t WS_S5W = WS_WDN + 22 * MiB;
constexpr size_t WS_S5M = WS_S5W + 8 * MiB;
constexpr size_t WS_H2 = WS_S5M + 4 * MiB;
constexpr size_t WS_FSD = WS_H2 + 3 * MiB;
constexpr size_t FSD_C_OFF = (size_t)2 * 256 * 8193 * 16;
constexpr size_t WS_XRES = WS_FSD + 68 * MiB;
constexpr size_t WS_HN = WS_XRES + 132 * MiB;
constexpr size_t WS_PX = WS_HN + 66 * MiB;
constexpr size_t WS_S5A = WS_PX + 372 * MiB;
constexpr size_t WS_S5S = WS_S5A + 40 * MiB;
constexpr size_t WS_YAPRE = WS_S5S + 40 * MiB;
constexpr size_t WS_YCAT = WS_YAPRE + 20 * MiB;
constexpr size_t WS_MBUF = WS_YCAT + 66 * MiB;
constexpr size_t WS_GSLOC = WS_MBUF + 66 * MiB;
constexpr size_t WS_GSIN = WS_GSLOC + 66 * MiB;
constexpr size_t WS_GOF = WS_GSIN + 66 * MiB;
constexpr size_t WS_GDT = WS_GOF + 66 * MiB;
constexpr size_t WS_ACT = WS_GSLOC;
constexpr size_t WS_ZT = WS_GDT + 1 * MiB;
constexpr size_t WS_YBT = WS_ZT + 50 * MiB;
constexpr size_t WS_SLAB = WS_YBT + 17 * MiB;
constexpr size_t WS_HALO = WS_SLAB + 44 * MiB;
constexpr size_t WS_GTL = WS_HALO + 9 * MiB;
constexpr size_t WS_END = WS_GTL + 198 * MiB;
static_assert((size_t)MT * FFH * 2 <= 198 * MiB, "ACT overlay");
constexpr int CW_BAR = 4096;

constexpr int RING_BYTES = 131072;
constexpr int EXTRA_OFF = RING_BYTES, EXTRA_BYTES = 8192;
constexpr int LDSCTL_OFF = EXTRA_OFF + EXTRA_BYTES;
constexpr int LDS_BYTES = LDSCTL_OFF + 256;

__device__ __forceinline__ float wave_sum(float v) {
#pragma unroll
    for (int o = 1; o < 64; o <<= 1) v += __shfl_xor(v, o);
    return v;
}
__device__ __forceinline__ float sigmoidf_(float x) { return 1.0f / (1.0f + __expf(-x)); }
__device__ __forceinline__ float siluf_(float x) { return x * sigmoidf_(x); }
__device__ __forceinline__ float gelu_tanh_(float x) { const float u = 0.7978845608028654f * (x + 0.044715f * x * x * x); return x / (1.0f + __expf(-2.0f * u)); }
__device__ __forceinline__ float logsigmoidf_(float x) { return fminf(x, 0.f) - __logf(1.0f + __expf(-fabsf(x))); }
__device__ __forceinline__ f32x2 cmul(f32x2 a, f32x2 b) { return (f32x2){a.x * b.x - a.y * b.y, a.x * b.y + a.y * b.x}; }
__device__ __forceinline__ f32x2 cconj(f32x2 a) { return (f32x2){a.x, -a.y}; }
__device__ __forceinline__ int opq(int x) { asm volatile("" : "+v"(x)); return x; }
#define PIN8(a, b, c, d, e, f, g, h) asm volatile("" : "+v"(a), "+v"(b), "+v"(c), "+v"(d), "+v"(e), "+v"(f), "+v"(g), "+v"(h))
#define PIN4(a, b, c, d) asm volatile("" : "+v"(a), "+v"(b), "+v"(c), "+v"(d))
#define LDS_WAIT() asm volatile("s_waitcnt lgkmcnt(0)" ::: "memory")
#define VM_WAIT() asm volatile("s_waitcnt vmcnt(0)" ::: "memory")

#define XB_TMO      128
#define XB_XCNT(j)  (256  + 64 * (j))
#define XB_XSUB(j)  (1280 + 64 * (j))
#define XB_XGEN(j)  (2304 + 64 * (j))
#define XB_TOP      3328
#define XB_TOPGEN   3392
#define XCD_BAR_WORDS 3456
#define XB_SPIN_CAP (1u << 18)
__device__ __forceinline__ unsigned xb_ld(unsigned* p)              { return __hip_atomic_load(p, __ATOMIC_RELAXED, __HIP_MEMORY_SCOPE_AGENT); }
__device__ __forceinline__ unsigned xb_add(unsigned* p, unsigned v) { return __hip_atomic_fetch_add(p, v, __ATOMIC_RELAXED, __HIP_MEMORY_SCOPE_AGENT); }
__device__ __forceinline__ unsigned xb_xcc_id() { return (unsigned)__builtin_amdgcn_s_getreg((3 << 11) | 20) & 0xFu; }
#define XB_SPIN(cond, bar) do { unsigned _sp = 0; while (cond) { __builtin_amdgcn_s_sleep(1); \
    if ((++_sp & 255u) == 0u) { if (xb_ld(&(bar)[XB_TMO])) break; if (_sp > XB_SPIN_CAP) { atomicAdd(&(bar)[XB_TMO], 1u); break; } } } } while (0)
struct XcdBarrier { unsigned* bar; unsigned x; volatile LAS unsigned* st; };
__device__ __forceinline__ XcdBarrier xcd_barrier_post(unsigned* bar, volatile LAS unsigned* st) {
    XcdBarrier b; b.bar = bar; b.x = xb_xcc_id(); b.st = st;
    if (threadIdx.x == 0) (void)xb_add(&bar[XB_XCNT(b.x)], 1u);
    return b;
}
__device__ __forceinline__ void xcd_barrier_complete(unsigned* bar, unsigned x, unsigned& nloc, unsigned& nx) {
    const unsigned G = gridDim.x * gridDim.y * gridDim.z;
    unsigned sum, cnt, mine, sp = 0u;
    for (;;) {
        sum = 0u; cnt = 0u; mine = 0u;
#pragma unroll
        for (unsigned j = 0; j < 16; ++j) { const unsigned c = xb_ld(&bar[XB_XCNT(j)]); sum += c; cnt += (c > 0u) ? 1u : 0u; mine = (j == x) ? c : mine; }
        if (sum == G) break;
        __builtin_amdgcn_s_sleep(1);
        if ((++sp & 255u) == 0u) { if (xb_ld(&bar[XB_TMO])) break; if (sp > XB_SPIN_CAP) { atomicAdd(&bar[XB_TMO], 1u); break; } }
    }
    nloc = mine > 0u ? mine : 1u; nx = cnt > 0u ? cnt : 1u;
}
__device__ __forceinline__ void xcd_barrier(const XcdBarrier& b) {
    asm volatile("s_waitcnt vmcnt(0)" ::: "memory");
    __syncthreads();
    if (threadIdx.x == 0) {
        unsigned* bar = b.bar;
        __builtin_amdgcn_s_waitcnt(0);
        unsigned nloc = b.st[0], nx = b.st[1];
        if (nloc == 0u) { xcd_barrier_complete(bar, b.x, nloc, nx); b.st[0] = nloc; b.st[1] = nx; }
        const unsigned old = xb_add(&bar[XB_XSUB(b.x)], 1u);
        const unsigned gen = old / nloc;
        if (old + 1u == (gen + 1u) * nloc) {
            __builtin_amdgcn_fence(__ATOMIC_RELEASE, "agent");
            asm volatile("s_waitcnt vmcnt(0)" ::: "memory");
            const unsigned og = xb_add(&bar[XB_TOP], 1u);
            const unsigned tg = og / nx;
            if (og + 1u == (tg + 1u) * nx) xb_add(&bar[XB_TOPGEN], 1u);
            else XB_SPIN(xb_ld(&bar[XB_TOPGEN]) == tg, bar);
            __builtin_amdgcn_fence(__ATOMIC_ACQUIRE, "agent");
            xb_add(&bar[XB_XGEN(b.x)], 1u);
            asm volatile("s_waitcnt vmcnt(0)" ::: "memory");
        } else {
            XB_SPIN(xb_ld(&bar[XB_XGEN(b.x)]) == gen, bar);
            __builtin_amdgcn_fence(__ATOMIC_ACQUIRE, "agent");
            asm volatile("s_waitcnt vmcnt(0)" ::: "memory");
        }
    }
    __syncthreads();
}

struct Args {
    const float* in[40];
    float* out; unsigned char* ws;
    int ph_lo, ph_hi;
};
struct ArgsV {
    __device__ __forceinline__ const float* in(int i) const {
        typedef const __attribute__((address_space(4))) unsigned long long* kp_t;
        kp_t ka = (kp_t)__builtin_amdgcn_kernarg_segment_ptr();
        return (const float*)(*(volatile const __attribute__((address_space(4))) unsigned long long*)(ka + i)); }
    float* out;
};
struct Ctx {
    LAS unsigned char* lds;
    int tid, lane, wave, G, bid;
    unsigned char* ws;
};
enum { I_X = 0, I_C, I_CTX, I_CCTX, I_WMOD, I_BMOD, I_N1G, I_N2G, I_WIN, I_S5ARE, I_S5AIM, I_S5STEP, I_S5BRE, I_S5BIM, I_S5CRE, I_S5CIM,
       I_S5D, I_GLUW, I_GLUB, I_HYCW, I_HYCB, I_HYW1, I_HYB1, I_HYF1, I_HYW2, I_HYB2, I_HYF2, I_HYW3, I_HYB3, I_HYBIAS,
       I_GLAWG, I_GLABG, I_GLANG, I_WBR, I_WOUT, I_WUP, I_FFCW, I_FFCB, I_WDN, I_FNG };

namespace pg8 {
constexpr int BM = 256, BK = 64, HALF = 128, HTB = HALF * BK * 2, STAGE_BYTES = 8 * HTB, NXCD = 8, WGM = 8;
__device__ __forceinline__ int lds_byte(int r, int c) { const int st = (r >> 4) * 2 + (c >> 5), rr = r & 15, cc = c & 31, ob = rr * 64 + cc * 2; return st * 1024 + (ob ^ (((ob >> 9) & 1) << 5)); }
__device__ __forceinline__ void stage_rc(int b, int& R, int& C) { const int st = b / 1024, sb = b % 1024, swz = sb ^ (((sb >> 9) & 1) << 5); R = (st >> 1) * 16 + swz / 64; C = (st & 1) * 32 + (swz % 64) / 2; }
__device__ __forceinline__ int perm32(int rho) { const int n = rho >> 4, i = rho & 15; return 8 * (i >> 2) + 4 * n + (i & 3); }
struct Unit { const char* a; const char* b; int pm, pn; };
struct Order2D {
    int nM, nN, nwg, G, c;
    __device__ __forceinline__ void init(int nM_, int nN_, int G_, int c_) { nM = nM_; nN = nN_; nwg = nM * nN; G = G_; c = c_; }
    __device__ __forceinline__ bool nx(int i, int& pm, int& pn) const {
        const long L = (long)i * G + c; if (L >= nwg) return false;
        int wgid = (int)L; { const int q = nwg / NXCD, r = nwg % NXCD, xcd = wgid % NXCD, off = wgid / NXCD; wgid = (xcd < r ? xcd * (q + 1) : r * (q + 1) + (xcd - r) * q) + off; }
        const int nig = WGM * nN, gid = wgid / nig, fm = gid * WGM, gsz = (nM - fm) < WGM ? (nM - fm) : WGM;
        pm = fm + ((wgid % nig) % gsz); pn = (wgid % nig) / gsz; return true;
    }
};
struct SchedPlain : Order2D {
    const char* A; const char* B; size_t aTile, bTile;
    __device__ __forceinline__ bool next(int i, Unit& u) const { int pm, pn; if (!nx(i, pm, pn)) return false; u.pm = pm; u.pn = pn; u.a = A + (size_t)pm * aTile; u.b = B + (size_t)pn * bTile; return true; }
};
struct SchedSplit {
    const char* A; const char* B; size_t aTile, bTile, ksub; int nsplit, G, c;
    __device__ __forceinline__ bool next(int i, Unit& u) const { const int L = i * G + c; if (L >= 16 * nsplit) return false; const int t = L / nsplit, ks = L % nsplit, pm = 64 + (t >> 3), pn = t & 7;
        u.pm = pm; u.pn = pn | (ks << 8); u.a = A + (size_t)pm * aTile + (size_t)ks * ksub; u.b = B + (size_t)pn * bTile + (size_t)ks * ksub; return true; }
};
struct SchedS5 {
    const char* A; const char* B; size_t bGroup; int G, c;
    __device__ __forceinline__ bool next(int i, Unit& u) const { const int L = i * G + c; if (L >= 160) return false; const int g = L & 31, pm = L >> 5;
        u.pm = pm; u.pn = g; u.a = A + ((size_t)pm * 256 * 16384 + (size_t)g * 512) * 2; u.b = B + (size_t)g * bGroup; return true; }
};

#define PG8_SA(b, h) (((b) * 2 + (h)) * HTB)
#define PG8_SB(b, h) ((4 + (b) * 2 + (h)) * HTB)
#define PG8_STAGE(bufoff, gbase, voff) do { _Pragma("unroll") for (int _i = 0; _i < 2; ++_i) \
        __builtin_amdgcn_global_load_lds((const unsigned*)((const char*)(gbase) + (voff)[_i]), (LAS unsigned*)(lds + (bufoff) + ldsw + _i * 8192), 16, 0, 0); } while (0)
#define PG8_LDA(dst, b, h) do { _Pragma("unroll") for (int m = 0; m < 4; ++m) _Pragma("unroll") for (int k = 0; k < 2; ++k) dst[m][k] = *(const LAS f16x8*)(lds + PG8_SA(b, h) + aoff + m * 2048 + k * 1024); } while (0)
#define PG8_LDB(dst, b, h) do { _Pragma("unroll") for (int n = 0; n < 2; ++n) _Pragma("unroll") for (int k = 0; k < 2; ++k) dst[n][k] = *(const LAS f16x8*)(lds + PG8_SB(b, h) + boff + n * 2048 + k * 1024); } while (0)
#define PG8_MMA(ai, bj, At, Bt) do { __builtin_amdgcn_s_setprio(1); _Pragma("unroll") for (int m = 0; m < 4; ++m) _Pragma("unroll") for (int n = 0; n < 2; ++n) _Pragma("unroll") for (int k = 0; k < 2; ++k) \
        acc[ai][bj][m][n] = __builtin_amdgcn_mfma_f32_16x16x32_f16(Bt[n][k], At[m][k], acc[ai][bj][m][n], 0, 0, 0); __builtin_amdgcn_s_setprio(0); } while (0)
#define PG8_WAIT_V(n) asm volatile("s_waitcnt vmcnt(" #n ")" ::: "memory")
#define PG8_WAIT_L(n) asm volatile("s_waitcnt lgkmcnt(" #n ")" ::: "memory")
#define PG8_BAR __builtin_amdgcn_s_barrier()
#define PG8_SCHED __builtin_amdgcn_sched_barrier(0)

template <class Epi, class Sched>
__device__ __forceinline__ void gemm_phase(LAS unsigned char* lds, const int lda, const int ldb, const int nt, const Sched& S, const Epi& E) {
    const int tid = opq((int)threadIdx.x), wid = __builtin_amdgcn_readfirstlane(tid >> 6), lane = tid & 63, wr = wid >> 2, wc = wid & 3, fr = lane & 15, fq = lane >> 4;
    unsigned voffA[2], voffB[2];
#pragma unroll
    for (int i = 0; i < 2; ++i) { int R, C; stage_rc(tid * 16 + i * 8192, R, C); const int Rb = Epi::PERM ? ((R & ~31) + perm32(R & 31)) : R;
        voffA[i] = (unsigned)(R * lda + C) * 2u; voffB[i] = (unsigned)(Rb * ldb + C) * 2u; }
    const size_t kstep = (size_t)(BK * 2);
    const size_t hstepA = (size_t)HALF * lda * 2, hstepB = (size_t)HALF * ldb * 2;
    const unsigned ldsw = (unsigned)wid * 1024u;
    const int aoff = lds_byte(wr * 64 + fr, fq * 8), boff = lds_byte(wc * 32 + fr, fq * 8);
    Unit cur, nxt; int ui = 0;
    if (!S.next(0, cur)) return;
    f32x4 acc[2][2][4][2];
#pragma unroll
    for (int a = 0; a < 2; ++a)
#pragma unroll
        for (int b = 0; b < 2; ++b)
#pragma unroll
            for (int m = 0; m < 4; ++m)
#pragma unroll
                for (int n = 0; n < 2; ++n) acc[a][b][m][n] = (f32x4){0.f, 0.f, 0.f, 0.f};
    f16x8 At[4][2], B0[2][2], B1[2][2];
    const char* cA = cur.a; const char* cB = cur.b;
    PG8_STAGE(PG8_SB(0, 0), cB, voffB); PG8_STAGE(PG8_SA(0, 0), cA, voffA); PG8_STAGE(PG8_SB(0, 1), cB + hstepB, voffB); PG8_STAGE(PG8_SA(0, 1), cA + hstepA, voffA);
    if (wr == 1) PG8_BAR;
    PG8_WAIT_V(4); PG8_BAR;
    PG8_STAGE(PG8_SB(1, 0), cB + kstep, voffB); PG8_STAGE(PG8_SA(1, 0), cA + kstep, voffA); PG8_STAGE(PG8_SB(1, 1), cB + hstepB + kstep, voffB);
    PG8_WAIT_V(6); PG8_BAR;
    for (;;) {
        const bool has_next = S.next(ui + 1, nxt);
        const char* nA = has_next ? nxt.a : cA; const char* nB = has_next ? nxt.b : cB;
        constexpr int NSEG = Epi::HAS_MID ? 3 : 1;
#pragma unroll
        for (int seg = 0; seg < NSEG; ++seg) {
        const int tb = Epi::HAS_MID ? (seg == 0 ? 0 : (seg == 1 ? Epi::MID1 + 2 : Epi::MID2 + 2)) : 0;
        const int te = Epi::HAS_MID ? (seg == 0 ? Epi::MID1 + 2 : (seg == 1 ? Epi::MID2 + 2 : nt)) : nt;
        for (int t = tb; t < te; t += 2) {
            const bool last = (t == nt - 2);
            const char* a1 = cA + (size_t)(t + 1) * kstep;
            const char* a2 = last ? nA : cA + (size_t)(t + 2) * kstep; const char* b2 = last ? nB : cB + (size_t)(t + 2) * kstep;
            const char* a3 = a2 + kstep; const char* b3 = b2 + kstep;
            PG8_LDB(B0, 0, 0); PG8_SCHED; PG8_LDA(At, 0, 0); PG8_STAGE(PG8_SA(1, 1), a1 + hstepA, voffA);
            PG8_WAIT_L(8); PG8_BAR; PG8_WAIT_L(0); PG8_MMA(0, 0, At, B0); PG8_BAR; PG8_SCHED;
            PG8_LDB(B1, 0, 1); PG8_STAGE(PG8_SB(0, 0), b2, voffB);
            PG8_BAR; PG8_WAIT_L(0); PG8_MMA(0, 1, At, B1); PG8_BAR;
            PG8_LDA(At, 0, 1); PG8_STAGE(PG8_SA(0, 0), a2, voffA);
            PG8_BAR; PG8_WAIT_L(0); PG8_MMA(1, 0, At, B0); PG8_BAR; PG8_SCHED;
            PG8_STAGE(PG8_SB(0, 1), b2 + hstepB, voffB);
            PG8_WAIT_V(6); PG8_BAR; PG8_MMA(1, 1, At, B1); PG8_BAR;
            PG8_LDB(B0, 1, 0); PG8_SCHED; PG8_LDA(At, 1, 0); PG8_STAGE(PG8_SA(0, 1), a2 + hstepA, voffA);
            PG8_WAIT_L(8); PG8_BAR; PG8_WAIT_L(0); PG8_MMA(0, 0, At, B0); PG8_BAR; PG8_SCHED;
            PG8_LDB(B1, 1, 1); PG8_STAGE(PG8_SB(1, 0), b3, voffB);
            PG8_BAR; PG8_WAIT_L(0); PG8_MMA(0, 1, At, B1); PG8_BAR;
            PG8_LDA(At, 1, 1); PG8_STAGE(PG8_SA(1, 0), a3, voffA);
            PG8_BAR; PG8_WAIT_L(0); PG8_MMA(1, 0, At, B0); PG8_BAR; PG8_SCHED;
            PG8_STAGE(PG8_SB(1, 1), b3 + hstepB, voffB);
            PG8_WAIT_V(6); PG8_BAR; PG8_MMA(1, 1, At, B1); PG8_BAR;
        }
        if constexpr (Epi::HAS_MID) { if (seg < 2) {
            E.mid(acc, cur, seg, wr, wc, fr, fq);
        } }
        }
#if STAMP_MASK & (1 << 23)
        if (Epi::HAS_MID && blockIdx.x == 0 && threadIdx.x == 0) ((volatile LAS unsigned long long*)(lds + LDSCTL_OFF + 128))[0] = __builtin_amdgcn_s_memrealtime();
#endif
        E(acc, cur, wr, wc, fr, fq);
#if STAMP_MASK & (1 << 23)
        if (Epi::HAS_MID && blockIdx.x == 0 && threadIdx.x == 0) { volatile LAS unsigned long long* TS = (volatile LAS unsigned long long*)(lds + LDSCTL_OFF + 128); TS[1] = TS[1] + (__builtin_amdgcn_s_memrealtime() - TS[0]); }
#endif
        if (!has_next) break;
#pragma unroll
        for (int a = 0; a < 2; ++a)
#pragma unroll
            for (int b = 0; b < 2; ++b)
#pragma unroll
                for (int m = 0; m < 4; ++m)
#pragma unroll
                    for (int n = 0; n < 2; ++n) acc[a][b][m][n] = (f32x4){0.f, 0.f, 0.f, 0.f};
        cur = nxt; cA = nA; cB = nB; ++ui;
    }
    PG8_WAIT_V(0);
    if (wr == 0) PG8_BAR;
    PG8_BAR;
}
#undef PG8_SA
#undef PG8_SB
#undef PG8_STAGE
#undef PG8_LDA
#undef PG8_LDB
#undef PG8_MMA
#undef PG8_WAIT_V
#undef PG8_WAIT_L
#undef PG8_BAR
#undef PG8_SCHED

typedef const f32x4 (&AccRef)[2][2][4][2];
__device__ __forceinline__ f16x8 pack8(f32x4 a, f32x4 b) { f16x8 w; w[0] = (f16)a[0]; w[1] = (f16)a[1]; w[2] = (f16)a[2]; w[3] = (f16)a[3]; w[4] = (f16)b[0]; w[5] = (f16)b[1]; w[6] = (f16)b[2]; w[7] = (f16)b[3]; return w; }

struct EpiPx {
    static constexpr bool PERM = true, HAS_MID = false; static constexpr int MID1 = 0, MID2 = 0; f16* PX; f16* S5A; f16* ZT; f16* GTL;
    __device__ __forceinline__ void operator()(AccRef acc, const Unit& u, int wr, int wc, int fr, int fq) const { fr = opq(fr); fq = opq(fq);
        const int row0 = u.pm * BM + wr * 64 + fr, col0 = u.pn * BM + wc * 32 + 8 * fq;
#pragma unroll
        for (int ai = 0; ai < 2; ++ai)
#pragma unroll
            for (int m = 0; m < 4; ++m) { const int row = row0 + ai * HALF + m * 16;
#pragma unroll
                for (int bj = 0; bj < 2; ++bj) { const int c = col0 + bj * HALF; const f16x8 w = pack8(acc[ai][bj][m][0], acc[ai][bj][m][1]);
                    if (u.pn < 2) *(f16x8*)(S5A + (size_t)(row >> 4) * 16384 + (size_t)(c >> 4) * 512 + (row & 15) * 16 + (c & 15)) = w;
                    else if (u.pn >= 14 && u.pn < 20) {
#pragma unroll
                        for (int j = 0; j < 8; ++j) ZT[(size_t)(c - P_HY + j) * MT + row] = w[j]; }
                    else if (u.pn >= 20 && u.pn < 44) *(f16x8*)(GTL + ((size_t)(u.pn - 20) * 66 + u.pm) * 65536 + (size_t)(row - u.pm * BM) * 256 + (c - u.pn * BM)) = w;
                    else { const int pr = row < MX ? (row & ~8191) + ((row & 63) << 7) + ((row & 8191) >> 6) : row;
                        *(f16x8*)(PX + (size_t)pr * PXLD + (u.pn == 44 ? c - (W_GG - P_GG) : c)) = w; } } }
    }
};
struct EpiF16 {
    static constexpr bool PERM = true, HAS_MID = false; static constexpr int MID1 = 0, MID2 = 0; f16* O; int ldc;
    __device__ __forceinline__ void operator()(AccRef acc, const Unit& u, int wr, int wc, int fr, int fq) const { fr = opq(fr); fq = opq(fq);
        const int row0 = u.pm * BM + wr * 64 + fr, col0 = u.pn * BM + wc * 32 + 8 * fq;
#pragma unroll
        for (int ai = 0; ai < 2; ++ai)
#pragma unroll
            for (int m = 0; m < 4; ++m) { f16* rowp = O + (size_t)(row0 + ai * HALF + m * 16) * ldc + col0;
#pragma unroll
                for (int bj = 0; bj < 2; ++bj) *(f16x8*)(rowp + bj * HALF) = pack8(acc[ai][bj][m][0], acc[ai][bj][m][1]); }
    }
};
struct EpiS5In {
    static constexpr bool PERM = false, HAS_MID = false; static constexpr int MID1 = 0, MID2 = 0; float* S;
    __device__ __forceinline__ void operator()(AccRef acc, const Unit& u, int wr, int wc, int fr, int fq) const { fr = opq(fr); fq = opq(fq);
        const int row0 = u.pm * BM + wr * 64 + fr, col0 = wc * 32 + 4 * fq, g = u.pn;
#pragma unroll
        for (int ai = 0; ai < 2; ++ai)
#pragma unroll
            for (int m = 0; m < 4; ++m) { const int row = row0 + ai * HALF + m * 16; { float* rowp = S + ((size_t)row * 32 + g) * 256 + col0;
#pragma unroll
                for (int bj = 0; bj < 2; ++bj)
#pragma unroll
                    for (int n = 0; n < 2; ++n) *(f32x4*)(rowp + bj * HALF + n * 16) = acc[ai][bj][m][n]; } }
    }
};
struct EpiS5Out {
    static constexpr bool PERM = true, HAS_MID = false; static constexpr int MID1 = 0, MID2 = 0; const f16* S5A; f16* Y; const float* dvec;
    __device__ __forceinline__ void operator()(AccRef acc, const Unit& u, int wr, int wc, int fr, int fq) const { fr = opq(fr); fq = opq(fq);
        const int row0 = u.pm * BM + wr * 64 + fr, col0 = wc * 32 + 8 * fq, g = u.pn;
        const int h0 = col0 & 15;
        const f32x4 d0 = *(const f32x4*)(dvec + g * 16 + h0), d1 = *(const f32x4*)(dvec + g * 16 + h0 + 4);
#pragma unroll
        for (int ai = 0; ai < 2; ++ai) { f16x8 uu[4][2];
#pragma unroll
            for (int m = 0; m < 4; ++m)
#pragma unroll
                for (int bj = 0; bj < 2; ++bj) uu[m][bj] = *(const f16x8*)(S5A + (size_t)(row0 + ai * HALF + m * 16) * 16384 + (size_t)g * 512 + col0 + bj * HALF);
            PIN8(uu[0][0], uu[0][1], uu[1][0], uu[1][1], uu[2][0], uu[2][1], uu[3][0], uu[3][1]);
#pragma unroll
            for (int m = 0; m < 4; ++m) { const int chunk = row0 + ai * HALF + m * 16;
#pragma unroll
                for (int bj = 0; bj < 2; ++bj) { const int c = col0 + bj * HALF, t = c >> 4; f16x8 w;
#pragma unroll
                    for (int j = 0; j < 4; ++j) { w[j] = (f16)gelu_tanh_(acc[ai][bj][m][0][j] * (1.0f / S5SCALE) + d0[j] * (float)uu[m][bj][j]);
                                                  w[4 + j] = (f16)gelu_tanh_(acc[ai][bj][m][1][j] * (1.0f / S5SCALE) + d1[j] * (float)uu[m][bj][4 + j]); }
                    *(f16x8*)(Y + (size_t)(chunk * 16 + t) * 512 + g * 16 + h0) = w; } }
            asm volatile("" ::: "memory"); }
    }
};
struct EpiGlu {
    static constexpr bool PERM = true, HAS_MID = false; static constexpr int MID1 = 0, MID2 = 0; const f16* YP; f16* O; const float* bias;
    __device__ __forceinline__ void operator()(AccRef acc, const Unit& u, int wr, int wc, int fr, int fq) const { fr = opq(fr); fq = opq(fq);
        const int row0 = u.pm * BM + wr * 64 + fr, col0 = u.pn * BM + wc * 32 + 8 * fq;
        f32x4 bv[2][2];
#pragma unroll
        for (int bj = 0; bj < 2; ++bj) { bv[bj][0] = *(const f32x4*)(bias + col0 + bj * HALF); bv[bj][1] = *(const f32x4*)(bias + col0 + bj * HALF + 4); }
#pragma unroll
        for (int ai = 0; ai < 2; ++ai) { f16x8 yp[4][2];
#pragma unroll
            for (int m = 0; m < 4; ++m)
#pragma unroll
                for (int bj = 0; bj < 2; ++bj) yp[m][bj] = *(const f16x8*)(YP + (size_t)(row0 + ai * HALF + m * 16) * 512 + col0 + bj * HALF);
            PIN8(yp[0][0], yp[0][1], yp[1][0], yp[1][1], yp[2][0], yp[2][1], yp[3][0], yp[3][1]);
#pragma unroll
            for (int m = 0; m < 4; ++m)
#pragma unroll
                for (int bj = 0; bj < 2; ++bj) { f16x8 w;
#pragma unroll
                    for (int j = 0; j < 4; ++j) { w[j] = (f16)((float)yp[m][bj][j] * sigmoidf_(acc[ai][bj][m][0][j] + bv[bj][0][j])); w[4 + j] = (f16)((float)yp[m][bj][4 + j] * sigmoidf_(acc[ai][bj][m][1][j] + bv[bj][1][j])); }
                    *(f16x8*)(O + (size_t)(row0 + ai * HALF + m * 16) * 2048 + col0 + bj * HALF) = w; }
            asm volatile("" ::: "memory"); }
    }
};
template <int BR> struct EpiBranch {
    static constexpr bool PERM = true, HAS_MID = false; static constexpr int MID1 = 0, MID2 = 0; const f16* PX; f16* M;
    __device__ __forceinline__ void operator()(AccRef acc, const Unit& u, int wr, int wc, int fr, int fq) const { fr = opq(fr); fq = opq(fq);
        const int row0 = u.pm * BM + wr * 64 + fr, col0 = u.pn * BM + wc * 32 + 8 * fq;
#pragma unroll
        for (int ai = 0; ai < 2; ++ai)
#pragma unroll
            for (int m = 0; m < 4; ++m) { const int row = row0 + ai * HALF + m * 16;
#pragma unroll
                for (int bj = 0; bj < 2; ++bj) { const int c = col0 + bj * HALF;
                    const f16x8 gl = *(const f16x8*)(PX + (size_t)row * PXLD + P_MG + BR * 2048 + c);
                    f16* mp = M + (size_t)row * 2048 + c;
                    f16x8 prev; if (BR > 0) prev = *(const f16x8*)mp;
                    f16x8 w;
#pragma unroll
                    for (int j = 0; j < 4; ++j) { float v0 = sigmoidf_((float)gl[j]) * acc[ai][bj][m][0][j], v1 = sigmoidf_((float)gl[4 + j]) * acc[ai][bj][m][1][j];
                        if (BR > 0) { v0 += (float)prev[j]; v1 += (float)prev[4 + j]; } w[j] = (f16)v0; w[4 + j] = (f16)v1; }
                    *(f16x8*)mp = w; } asm volatile("" ::: "memory"); }
    }
};
typedef f32x4 (&AccMut)[2][2][4][2];

struct EpiBranchF {
    static constexpr bool PERM = true, HAS_MID = true; static constexpr int MID1 = 6, MID2 = 14;
    const f16* GTL; f16* M;
    __device__ __forceinline__ void mid(AccMut acc, const Unit& u, int seg, int wr, int wc, int fr, int fq) const { fr = opq(fr); fq = opq(fq);
        const int lrow0 = wr * 64 + fr, lcol0 = wc * 32 + 8 * fq;
        const f16* ga = GTL + ((size_t)((seg == 0 ? 0 : 8) + u.pn) * 66 + u.pm) * 65536; const f16* gb = ga + (size_t)8 * 66 * 65536;
#pragma unroll
        for (int ai = 0; ai < 2; ++ai) { f16x8 za[4][2], zb[4][2];
#pragma unroll
            for (int m = 0; m < 4; ++m)
#pragma unroll
                for (int bj = 0; bj < 2; ++bj) { const int off = (lrow0 + ai * HALF + m * 16) * 256 + lcol0 + bj * HALF; za[m][bj] = *(const f16x8*)(ga + off); zb[m][bj] = *(const f16x8*)(gb + off); }
            PIN8(za[0][0], za[0][1], za[1][0], za[1][1], za[2][0], za[2][1], za[3][0], za[3][1]); PIN8(zb[0][0], zb[0][1], zb[1][0], zb[1][1], zb[2][0], zb[2][1], zb[3][0], zb[3][1]);
#pragma unroll
            for (int m = 0; m < 4; ++m)
#pragma unroll
                for (int bj = 0; bj < 2; ++bj)
#pragma unroll
                    for (int j = 0; j < 4; ++j) { acc[ai][bj][m][0][j] *= (1.0f + __expf(-(float)zb[m][bj][j])) * __builtin_amdgcn_rcpf(1.0f + __expf(-(float)za[m][bj][j]));
                                                  acc[ai][bj][m][1][j] *= (1.0f + __expf(-(float)zb[m][bj][4 + j])) * __builtin_amdgcn_rcpf(1.0f + __expf(-(float)za[m][bj][4 + j])); }
            asm volatile("" ::: "memory"); }
    }
    __device__ __forceinline__ void operator()(AccRef acc, const Unit& u, int wr, int wc, int fr, int fq) const { fr = opq(fr); fq = opq(fq);
        const int row0 = u.pm * BM + wr * 64 + fr, col0 = u.pn * BM + wc * 32 + 8 * fq;
#pragma unroll
        for (int ai = 0; ai < 2; ++ai) { f16x8 gl[4][2];
#pragma unroll
            for (int m = 0; m < 4; ++m)
#pragma unroll
                for (int bj = 0; bj < 2; ++bj) gl[m][bj] = *(const f16x8*)(GTL + ((size_t)(16 + u.pn) * 66 + u.pm) * 65536 + (wr * 64 + fr + ai * HALF + m * 16) * 256 + wc * 32 + 8 * fq + bj * HALF);
            PIN8(gl[0][0], gl[0][1], gl[1][0], gl[1][1], gl[2][0], gl[2][1], gl[3][0], gl[3][1]);
#pragma unroll
            for (int m = 0; m < 4; ++m)
#pragma unroll
                for (int bj = 0; bj < 2; ++bj) { f16x8 w;
#pragma unroll
                    for (int j = 0; j < 4; ++j) { w[j] = (f16)(sigmoidf_((float)gl[m][bj][j]) * acc[ai][bj][m][0][j]); w[4 + j] = (f16)(sigmoidf_((float)gl[m][bj][4 + j]) * acc[ai][bj][m][1][j]); }
                    *(f16x8*)(M + (size_t)(row0 + ai * HALF + m * 16) * 2048 + col0 + bj * HALF) = w; }
            asm volatile("" ::: "memory"); }
    }
};
struct EpiUpAct {
    static constexpr bool PERM = true, HAS_MID = false; static constexpr int MID1 = 0, MID2 = 0; f16* ACT; float* HALO; const float* cw; const float* cb; LAS float* HL;
    __device__ __forceinline__ void operator()(AccRef acc, const Unit& u, int wr, int wc, int fr, int fq) const { fr = opq(fr); fq = opq(fq);
        const int lane = fq * 16 + fr;
#pragma unroll
        for (int ai = 0; ai < 2; ++ai) { LAS float* hp = HL + ((ai * 2 + wr) * 4 + wc) * 64 + 8 * fq;
            if (fr == 0) { *(LAS f32x4*)(hp) = acc[ai][0][0][0]; *(LAS f32x4*)(hp + 4) = acc[ai][0][0][1]; }
            if (fr == 15) { *(LAS f32x4*)(hp + 32) = acc[ai][0][3][0]; *(LAS f32x4*)(hp + 36) = acc[ai][0][3][1]; } }
        { float* gh = HALO + ((size_t)u.pm * 44 + u.pn) * 768 + wc * 32 + 8 * fq;
          if (wr == 0 && fr < 2) { *(f32x4*)(gh + fr * 128) = acc[0][0][0][0]; *(f32x4*)(gh + fr * 128 + 4) = acc[0][0][0][1]; }
          if (wr == 0 && fr == 0) { *(f32x4*)(gh + 4 * 128) = acc[0][1][0][0]; *(f32x4*)(gh + 4 * 128 + 4) = acc[0][1][0][1]; }
          if (wr == 1 && fr >= 14) { *(f32x4*)(gh + (fr - 12) * 128) = acc[1][0][3][0]; *(f32x4*)(gh + (fr - 12) * 128 + 4) = acc[1][0][3][1]; }
          if (wr == 1 && fr == 15) { *(f32x4*)(gh + 5 * 128) = acc[1][1][3][0]; *(f32x4*)(gh + 5 * 128 + 4) = acc[1][1][3][1]; } }
        asm volatile("s_waitcnt lgkmcnt(0)" ::: "memory"); __builtin_amdgcn_s_barrier(); __builtin_amdgcn_s_barrier(); asm volatile("" ::: "memory");
        const int colg = u.pn * 128 + wc * 32 + 8 * fq;
        const int srcR = (lane & 48) | ((fr + 15) & 15), srcL = (lane & 48) | ((fr + 1) & 15);
        const int row0 = u.pm * BM + wr * 64 + fr;
#pragma unroll
        for (int n = 0; n < 2; ++n) {
            const f32x4 w0 = *(const f32x4*)(cw + colg + 4 * n), w1 = *(const f32x4*)(cw + FFH + colg + 4 * n), w2 = *(const f32x4*)(cw + 2 * FFH + colg + 4 * n), bb = *(const f32x4*)(cb + colg + 4 * n);
#pragma unroll
            for (int ai = 0; ai < 2; ++ai) {
                const bool hasp = (wr == 1) || (ai == 1), hasn = (wr == 0) || (ai == 0);
                const LAS float* pp = HL + (((wr == 1 ? ai : 0) * 2 + (wr == 1 ? 0 : 1)) * 4 + wc) * 64 + 32 + 8 * fq + 4 * n;
                const LAS float* np = HL + (((wr == 0 ? ai : 1) * 2 + (wr == 0 ? 1 : 0)) * 4 + wc) * 64 + 8 * fq + 4 * n;
                const f32x4 hprev = hasp ? *(const LAS f32x4*)pp : (f32x4){0.f, 0.f, 0.f, 0.f}, hnext = hasn ? *(const LAS f32x4*)np : (f32x4){0.f, 0.f, 0.f, 0.f};
                f32x4 R[4], L[4];
#pragma unroll
                for (int m = 0; m < 4; ++m)
#pragma unroll
                    for (int j = 0; j < 4; ++j) { R[m][j] = __shfl(acc[ai][0][m][n][j], srcR); L[m][j] = __shfl(acc[ai][0][m][n][j], srcL); }
#pragma unroll
                for (int m = 0; m < 4; ++m) { const f32x4 pv = fr > 0 ? R[m] : (m > 0 ? R[m > 0 ? m - 1 : 0] : hprev); const f32x4 nv = fr < 15 ? L[m] : (m < 3 ? L[m < 3 ? m + 1 : 3] : hnext);
                    const f32x4 a = w0 * pv + w1 * acc[ai][0][m][n] + w2 * nv + bb;
                    f16x4 o;
#pragma unroll
                    for (int j = 0; j < 4; ++j) o[j] = (f16)(siluf_(a[j]) * acc[ai][1][m][n][j]);
                    *(f16x4*)(ACT + (size_t)(row0 + ai * HALF + m * 16) * FFH + colg + 4 * n) = o; }
                asm volatile("" ::: "memory");
            }
        }
    }
};
struct EpiSlab {
    static constexpr bool PERM = false, HAS_MID = false; static constexpr int MID1 = 0, MID2 = 0; float* slab; const float* mod; int goff;
    __device__ __forceinline__ void operator()(AccRef acc, const Unit& u, int wr, int wc, int fr, int fq) const { fr = opq(fr); fq = opq(fq);
        const int pn = u.pn & 255, ks = u.pn >> 8;
        const int row0 = (u.pm - 64) * BM + wr * 64 + fr, col0 = pn * BM + wc * 32 + 4 * fq;
        const float* gp = mod + 2 * 12288 + goff + col0;
        f32x4 gv[2][2];
#pragma unroll
        for (int bj = 0; bj < 2; ++bj)
#pragma unroll
            for (int n = 0; n < 2; ++n) gv[bj][n] = *(const f32x4*)(gp + bj * HALF + n * 16);
        float* sp = slab + (size_t)ks * MC * D;
#pragma unroll
        for (int ai = 0; ai < 2; ++ai)
#pragma unroll
            for (int m = 0; m < 4; ++m) { float* rowp = sp + (size_t)(row0 + ai * HALF + m * 16) * D + col0;
#pragma unroll
                for (int bj = 0; bj < 2; ++bj)
#pragma unroll
                    for (int n = 0; n < 2; ++n) *(f32x4*)(rowp + bj * HALF + n * 16) = gv[bj][n] * acc[ai][bj][m][n]; }
    }
};
struct EpiResid {
    static constexpr bool PERM = false, HAS_MID = false; static constexpr int MID1 = 0, MID2 = 0; float* X; const float* mod; int goff;
    __device__ __forceinline__ void operator()(AccRef acc, const Unit& u, int wr, int wc, int fr, int fq) const { fr = opq(fr); fq = opq(fq);
        const int row0 = u.pm * BM + wr * 64 + fr, col0 = u.pn * BM + wc * 32 + 4 * fq;
        const int bsel = u.pm < 32 ? 0 : (u.pm < 64 ? 1 : 2);
        const float* gp = mod + bsel * 12288 + goff + col0;
        f32x4 gv[2][2];
#pragma unroll
        for (int bj = 0; bj < 2; ++bj)
#pragma unroll
            for (int n = 0; n < 2; ++n) gv[bj][n] = *(const f32x4*)(gp + bj * HALF + n * 16);
#pragma unroll
        for (int ai = 0; ai < 2; ++ai)
#pragma unroll
            for (int mp = 0; mp < 2; ++mp) { f32x4 xv[2][2][2];
#pragma unroll
                for (int mm = 0; mm < 2; ++mm) { const float* rowp = X + (size_t)(row0 + ai * HALF + (2 * mp + mm) * 16) * D + col0;
#pragma unroll
                    for (int bj = 0; bj < 2; ++bj)
#pragma unroll
                        for (int n = 0; n < 2; ++n) xv[mm][bj][n] = *(const f32x4*)(rowp + bj * HALF + n * 16); }
                PIN8(xv[0][0][0], xv[0][0][1], xv[0][1][0], xv[0][1][1], xv[1][0][0], xv[1][0][1], xv[1][1][0], xv[1][1][1]);
#pragma unroll
                for (int mm = 0; mm < 2; ++mm) { float* rowp = X + (size_t)(row0 + ai * HALF + (2 * mp + mm) * 16) * D + col0;
#pragma unroll
                    for (int bj = 0; bj < 2; ++bj)
#pragma unroll
                        for (int n = 0; n < 2; ++n) *(f32x4*)(rowp + bj * HALF + n * 16) = xv[mm][bj][n] + gv[bj][n] * acc[ai][bj][2 * mp + mm][n]; }
                asm volatile("" ::: "memory"); }
    }
};
}


__device__ __forceinline__ void ph_prologue(const Ctx& F, const ArgsV& AV) {
    const int gt = F.bid * 512 + F.tid, NT = F.G * 512;
    { const f32x4* xs = (const f32x4*)AV.in(I_X); const f32x4* cs = (const f32x4*)AV.in(I_CTX); f32x4* xr = (f32x4*)(F.ws + WS_XRES);
      for (int i = gt; i < MX * D / 4; i += NT) xr[i] = xs[i];
      for (int i = gt; i < MC * D / 4; i += NT) xr[MX * D / 4 + i] = cs[i]; }
    { f32x2* tw = (f32x2*)(F.ws + WS_TW);
      for (int k = gt; k < 16384; k += NT) { float s, c; sincospif((float)k * (2.0f / 16384.0f), &s, &c); tw[k] = (f32x2){c, -s}; } }
    LAS float* sc = (LAS float*)F.lds;
    LAS float* red = (LAS float*)(F.lds + 3 * 2048 * 4);
    for (int i = F.tid; i < 3 * 2048; i += 512) { const int r = i / 2048, k = i % 2048; const float v = r < 2 ? AV.in(I_C)[r * 2048 + k] : AV.in(I_CCTX)[k]; sc[i] = siluf_(v); }
    __syncthreads();
    const int col = F.tid & 63, ks = F.tid >> 6;
    for (int chunk = F.bid; chunk < DEPTH * 192; chunk += F.G) {
        const int l = chunk / 192, n0 = (chunk % 192) * 64;
        const float* w = AV.in(I_WMOD) + (size_t)l * 2048 * 12288 + n0 + col;
        float s0 = 0.f, s1 = 0.f, s2 = 0.f;
#pragma unroll 8
        for (int k = ks * 256; k < ks * 256 + 256; ++k) { const float wv = w[(size_t)k * 12288]; s0 += sc[k] * wv; s1 += sc[2048 + k] * wv; s2 += sc[4096 + k] * wv; }
        red[(ks * 3 + 0) * 64 + col] = s0; red[(ks * 3 + 1) * 64 + col] = s1; red[(ks * 3 + 2) * 64 + col] = s2;
        __syncthreads();
        if (F.tid < 192) { const int r = F.tid >> 6, c2 = F.tid & 63; float s = 0.f;
#pragma unroll
            for (int q = 0; q < 8; ++q) s += red[(q * 3 + r) * 64 + c2];
            ((float*)(F.ws + WS_MOD))[((size_t)l * 3 + r) * 12288 + n0 + c2] = s + AV.in(I_BMOD)[(size_t)l * 12288 + n0 + c2]; }
        __syncthreads();
    }
}

__device__ __forceinline__ void conv_item(const float* W, int ldw, int k0, int srccol, f16* WT, int dstrow, int ldk) {
    float v[64];
    const float* src = W + (size_t)k0 * ldw + (srccol >= 0 ? srccol : 0);
#pragma unroll
    for (int k = 0; k < 64; ++k) v[k] = src[(size_t)k * ldw];
#pragma unroll
    for (int k = 0; k < 64; k += 8) PIN8(v[k], v[k + 1], v[k + 2], v[k + 3], v[k + 4], v[k + 5], v[k + 6], v[k + 7]);
    f16* dst = WT + (size_t)dstrow * ldk + k0;
#pragma unroll
    for (int kg = 0; kg < 8; ++kg) { f16x8 o;
#pragma unroll
        for (int e = 0; e < 8; ++e) o[e] = srccol >= 0 ? (f16)v[8 * kg + e] : (f16)0.f;
        *(f16x8*)(dst + 8 * kg) = o; }
}
__device__ __forceinline__ void ph_convert_weights(const Ctx& F, const ArgsV& AV, int l) {
    const int skip = F.G > 64 ? 32 : 0;
    if (F.bid < skip) return;
    const int gw = (F.bid - skip) * 8 + F.wave, NGW = (F.G - skip) * 8, lane = F.lane;
    constexpr int I_IN = 32 * 180, I_GLU = 8 * 8, I_BR = 32 * 32, I_OUT = 32 * 32, I_UP = 32 * 176, I_DN = 88 * 32;
    constexpr int NIT = I_IN + I_GLU + I_BR + I_OUT + I_UP + I_DN;
    for (int it = gw; it < NIT; it += NGW) {
        int r = it;
        if (r < I_IN) { const int kb = r / 180, nb = r % 180, j = nb * 64 + lane;
            const int src = j < 2048 ? j : (j < 11264 ? j + 32 : (j < 11296 ? 2048 + (j - 11264) : -1));
            conv_item(AV.in(I_WIN) + (size_t)l * 2048 * INW, INW, kb * 64, src, (f16*)(F.ws + WS_WIN), j, 2048); continue; } r -= I_IN;
        if (r < I_GLU) { const int kb = r / 8, nb = r % 8, j = nb * 64 + lane; conv_item(AV.in(I_GLUW) + (size_t)l * 512 * 512, 512, kb * 64, j, (f16*)(F.ws + WS_WGLU), j, 512); continue; } r -= I_GLU;
        if (r < I_BR) { const int kb = r / 32, nb = r % 32, j = nb * 64 + lane; conv_item(AV.in(I_WBR) + (size_t)l * 2048 * 2048, 2048, kb * 64, j, (f16*)(F.ws + WS_WBR), j, 2048); continue; } r -= I_BR;
        if (r < I_OUT) { const int kb = r / 32, nb = r % 32, j = nb * 64 + lane; conv_item(AV.in(I_WOUT) + (size_t)l * 2048 * 2048, 2048, kb * 64, j, (f16*)(F.ws + WS_WOUT), j, 2048); continue; } r -= I_OUT;
        if (r < I_UP) { const int kb = r / 176, nb = r % 176, j = nb * 64 + lane, pn = j >> 8, i = j & 255; const int src = i < 128 ? 128 * pn + i : FFH + 128 * pn + (i - 128);
            conv_item(AV.in(I_WUP) + (size_t)l * 2048 * UPLD, UPLD, kb * 64, src, (f16*)(F.ws + WS_WUP), j, 2048); continue; } r -= I_UP;
        { const int kb = r / 32, nb = r % 32, j = nb * 64 + lane; conv_item(AV.in(I_WDN) + (size_t)l * FFH * 2048, 2048, kb * 64, j, (f16*)(F.ws + WS_WDN), j, FFH); }
    }
}

__device__ __forceinline__ void s5_mats_group(const Ctx& F, const ArgsV& AV, int l, int g) {
    LAS f32x2* APOW = (LAS f32x2*)F.lds;
    LAS f32x2* BBAR = APOW + 2 * 17 * 64;
    LAS f32x2* CM = BBAR + 2 * 64 * 16;
    LAS float* KLAG = (LAS float*)(CM + 2 * 16 * 64);
    __syncthreads();
    for (int i = F.tid; i < 2 * 17 * 64; i += 512) { const int d = i / (17 * 64), e = (i / 64) % 17, n = i % 64;
        const size_t pi = (((size_t)l * 2 + d) * 32 + g) * 64 + n;
        const float are = AV.in(I_S5ARE)[pi], aim = AV.in(I_S5AIM)[pi], dt = expf(AV.in(I_S5STEP)[((size_t)l * 2 + d) * 32 + g]);
        const float zr = are * dt * (float)e, zi = aim * dt * (float)e; float s, c; sincosf(zi, &s, &c); const float m = expf(zr);
        APOW[i] = (f32x2){m * c, m * s}; }
    __syncthreads();
    for (int i = F.tid; i < 2 * 64 * 16; i += 512) { const int d = i / 1024, n = (i / 16) % 64, h = i % 16;
        const size_t pi = (((size_t)l * 2 + d) * 32 + g) * 64 + n;
        const float are = AV.in(I_S5ARE)[pi], aim = AV.in(I_S5AIM)[pi];
        const f32x2 ab = APOW[(d * 17 + 1) * 64 + n]; const f32x2 num = (f32x2){ab.x - 1.0f, ab.y};
        const float den = are * are + aim * aim; const f32x2 q = (f32x2){(num.x * are + num.y * aim) / den, (num.y * are - num.x * aim) / den};
        const size_t bi = (pi * 16) + h;
        BBAR[i] = cmul(q, (f32x2){AV.in(I_S5BRE)[bi], AV.in(I_S5BIM)[bi]});
        const size_t ci = ((((size_t)l * 2 + d) * 32 + g) * 16 + h) * 64 + n;
        CM[(d * 16 + h) * 64 + n] = (f32x2){AV.in(I_S5CRE)[ci], AV.in(I_S5CIM)[ci]}; }
    __syncthreads();
    for (int i = F.tid; i < 2 * 16 * 256; i += 512) { const int d = i / 4096, lag = (i / 256) % 16, h = (i / 16) % 16, hp = i % 16; float s = 0.f;
        for (int n = 0; n < 64; ++n) { const f32x2 t = cmul(CM[(d * 16 + h) * 64 + n], APOW[(d * 17 + lag) * 64 + n]); const f32x2 b = BBAR[(d * 64 + n) * 16 + hp]; s += t.x * b.x - t.y * b.y; }
        KLAG[i] = s; }
    __syncthreads();
    f16* W = (f16*)(F.ws + WS_S5W) + (size_t)g * 256 * 512;
    for (int i = F.tid; i < 256 * 64; i += 512) { const int n = i / 64, k8 = (i % 64) * 8, t = n >> 4, h = n & 15; f16x8 o;
#pragma unroll
        for (int e = 0; e < 8; ++e) { const int k = k8 + e; float v;
            if (k < 256) { const int s = k >> 4, hp = k & 15; v = 0.f;
                if (t >= s) v += KLAG[((0 * 16 + (t - s)) * 16 + h) * 16 + hp];
                if (s >= t) v += KLAG[((1 * 16 + (s - t)) * 16 + h) * 16 + hp];
                v *= S5SCALE; }
            else { const int d = (k - 256) >> 7, nn2 = (k - 256) & 127, nn = nn2 & 63, im = nn2 >> 6, ex = d == 0 ? t + 1 : 16 - t;
                const f32x2 z = cmul(CM[(d * 16 + h) * 64 + nn], APOW[(d * 17 + ex) * 64 + nn]); v = im ? -z.y : z.x; }
            o[e] = (f16)v; }
        *(f16x8*)(W + (size_t)n * 512 + k8) = o; }
    f16* Mx = (f16*)(F.ws + WS_S5M) + (size_t)g * 256 * 256;
    for (int i = F.tid; i < 256 * 32; i += 512) { const int n = i / 32, k8 = (i % 32) * 8, d = n >> 7, ri = (n >> 6) & 1, nn = n & 63; f16x8 o;
#pragma unroll
        for (int e = 0; e < 8; ++e) { const int k = k8 + e, s = k >> 4, hp = k & 15, ex = d == 0 ? 15 - s : s;
            const f32x2 z = cmul(APOW[(d * 17 + ex) * 64 + nn], BBAR[(d * 64 + nn) * 16 + hp]); o[e] = (f16)((ri ? z.y : z.x) * S5SCALE); }
        *(f16x8*)(Mx + (size_t)n * 256 + k8) = o; }
    if (F.tid < 128) { const int d = F.tid >> 6, nn = F.tid & 63; ((f32x2*)(F.ws + WS_S5AT))[(d * 32 + g) * 64 + nn] = APOW[(d * 17 + 16) * 64 + nn]; }
    __syncthreads();
}

__device__ __forceinline__ void ph_hyena_h2(const Ctx& F, const ArgsV& AV, int l) {
    LAS float* W1 = (LAS float*)F.lds;
    LAS float* W2 = W1 + 33 * 64;
    LAS float* PV = W2 + 64 * 64;
    LAS float* SCR = PV + 256;
    __syncthreads();
    for (int i = F.tid; i < 33 * 64; i += 512) W1[i] = AV.in(I_HYW1)[(size_t)l * 33 * 64 + i];
    for (int i = F.tid; i < 64 * 64; i += 512) W2[i] = AV.in(I_HYW2)[(size_t)l * 4096 + i];
    if (F.tid < 64) { PV[F.tid] = AV.in(I_HYB1)[l * 64 + F.tid]; PV[64 + F.tid] = AV.in(I_HYF1)[l * 64 + F.tid]; PV[128 + F.tid] = AV.in(I_HYB2)[l * 64 + F.tid]; PV[192 + F.tid] = AV.in(I_HYF2)[l * 64 + F.tid]; }
    __syncthreads();
    LAS float* scr = SCR + F.wave * 64;
    const int gw = F.bid * 8 + F.wave, NGW = F.G * 8, j = F.lane;
    float* H2 = (float*)(F.ws + WS_H2);
    for (int p = gw; p < SEQ + LC; p += NGW) {
        const int n = p < SEQ ? SEQ : LC, pos = p < SEQ ? p : p - SEQ;
        float feat = 0.f;
        if (j == 0) feat = (float)pos / (float)(n - 1);
        else if (j < 33) { const int fi = (j - 1) & 15; const float fr = 1e-4f + (float)fi * ((15.0f - 1e-4f) / 15.0f);
            const float ang = (6.283185307179586f / (float)n) * (float)pos * fr; float s, c; sincosf(ang, &s, &c); feat = j < 17 ? c : -s; }
        scr[j] = feat; LDS_WAIT(); asm volatile("" ::: "memory");
        float a = PV[j];
        for (int i = 0; i < 33; ++i) a += scr[i] * W1[i * 64 + j];
        const float h1 = sinf(PV[64 + j] * a);
        LDS_WAIT(); asm volatile("" ::: "memory");
        scr[j] = h1; LDS_WAIT(); asm volatile("" ::: "memory");
        float b = PV[128 + j];
        for (int i = 0; i < 64; ++i) b += scr[i] * W2[i * 64 + j];
        H2[(size_t)p * 64 + j] = sinf(PV[192 + j] * b);
        LDS_WAIT(); asm volatile("" ::: "memory");
    }
}

__device__ __forceinline__ void ph_norm(const Ctx& F, const ArgsV& AV, int l, int which, int nrows, int nslab) {
    const int gw = F.bid * 8 + F.wave, NGW = F.G * 8;
    float* X = (float*)(F.ws + WS_XRES); f16* O = (f16*)(F.ws + WS_HN); const float* SL = (const float*)(F.ws + WS_SLAB);
    const float* gain = AV.in(which ? I_N2G : I_N1G) + (size_t)l * D;
    const float* mod = (const float*)(F.ws + WS_MOD) + (size_t)l * 3 * 12288;
    const int shoff = which ? 6144 : 0, soff = which ? 8192 : 2048;
    for (int m = gw; m < nrows; m += NGW) {
        const int bsel = m < SEQ ? 0 : (m < MX ? 1 : 2);
        f32x4* xr = (f32x4*)(X + (size_t)m * D) + F.lane;
        f32x4 v[8]; float s = 0.f;
#pragma unroll
        for (int j = 0; j < 8; ++j) v[j] = xr[64 * j];
        PIN8(v[0], v[1], v[2], v[3], v[4], v[5], v[6], v[7]);
        if (m >= MX && nslab > 0) {
            for (int sl = 0; sl < nslab; ++sl) { const f32x4* sr = (const f32x4*)(SL + ((size_t)sl * MC + (m - MX)) * D) + F.lane;
#pragma unroll
                for (int j = 0; j < 8; ++j) v[j] = v[j] + sr[64 * j]; }
#pragma unroll
            for (int j = 0; j < 8; ++j) xr[64 * j] = v[j]; }
#pragma unroll
        for (int j = 0; j < 8; ++j) s += (v[j].x * v[j].x + v[j].y * v[j].y) + (v[j].z * v[j].z + v[j].w * v[j].w);
        const float rstd = 1.0f / sqrtf(wave_sum(s) * (1.0f / D) + EPS);
        const float* mp = mod + bsel * 12288;
#pragma unroll
        for (int j = 0; j < 8; ++j) { const int c = 4 * F.lane + 256 * j;
            const f32x4 g = *(const f32x4*)(gain + c), sh = *(const f32x4*)(mp + shoff + c), sc = *(const f32x4*)(mp + soff + c);
            f16x4 o;
#pragma unroll
            for (int e = 0; e < 4; ++e) o[e] = (f16)(v[j][e] * rstd * g[e] * (1.0f + sc[e]) + sh[e]);
            *(f16x4*)(O + (size_t)m * D + c) = o; }
    }
}
__device__ __forceinline__ void ph_final_norm(const Ctx& F, const ArgsV& AV) {
    const int gw = F.bid * 8 + F.wave, NGW = F.G * 8;
    const float* X = (const float*)(F.ws + WS_XRES); const float* gain = AV.in(I_FNG);
    for (int m = gw; m < MX; m += NGW) {
        const f32x4* xr = (const f32x4*)(X + (size_t)m * D) + F.lane;
        f32x4 v[8]; float s = 0.f;
#pragma unroll
        for (int j = 0; j < 8; ++j) { v[j] = xr[64 * j]; s += (v[j].x * v[j].x + v[j].y * v[j].y) + (v[j].z * v[j].z + v[j].w * v[j].w); }
        const float rstd = 1.0f / sqrtf(wave_sum(s) * (1.0f / D) + EPS);
#pragma unroll
        for (int j = 0; j < 8; ++j) { const int c = 4 * F.lane + 256 * j; const f32x4 g = *(const f32x4*)(gain + c);
            *(f32x4*)(AV.out + (size_t)m * D + c) = v[j] * rstd * g; }
    }
}

__device__ __forceinline__ void ph_s5_scan(const Ctx& F) {
    if (F.tid >= 32) return;
    const float* S = (const float*)(F.ws + WS_S5S); f16* SA = (f16*)(F.ws + WS_S5A);
    for (int gt = F.bid * 32 + F.tid; gt < 2 * 2 * 32 * 64; gt += F.G * 32) {
        const int nn = gt & 63, g = (gt >> 6) & 31, d = (gt >> 11) & 1, b = gt >> 12;
        const f32x2 at = ((const f32x2*)(F.ws + WS_S5AT))[(d * 32 + g) * 64 + nn];
        f32x2 st = (f32x2){0.f, 0.f};
        for (int base = 0; base < 16 + 512; base += 16) {
            f32x2 loc[16]; int chk[16];
#pragma unroll
            for (int u = 0; u < 16; ++u) { const int step = base + u; int chunk;
                if (d == 0) chunk = step < 16 ? 1024 + b * 16 + step : b * 512 + (step - 16);
                else chunk = step < 16 ? 1024 + b * 16 + (15 - step) : b * 512 + (511 - (step - 16));
                chk[u] = chunk; const size_t so = ((size_t)chunk * 32 + g) * 256 + d * 128 + nn;
                loc[u] = (f32x2){S[so], S[so + 64]}; }
            PIN8(loc[0], loc[1], loc[2], loc[3], loc[4], loc[5], loc[6], loc[7]); PIN8(loc[8], loc[9], loc[10], loc[11], loc[12], loc[13], loc[14], loc[15]);
#pragma unroll
            for (int u = 0; u < 16; ++u) { f16* xp = SA + (size_t)chk[u] * 16384 + (size_t)g * 512 + 256 + d * 128 + nn;
                xp[0] = (f16)st.x; xp[64] = (f16)st.y;
                st = cmul(at, st) + loc[u]; }
        }
    }
}

__device__ __forceinline__ void ph_ffn_fix(const Ctx& F, const ArgsV& AV, int l, int nMr) {
    const float* HALO = (const float*)(F.ws + WS_HALO); f16* ACT = (f16*)(F.ws + WS_ACT);
    const float* cw = AV.in(I_FFCW) + (size_t)l * 3 * FFH; const float* cb = AV.in(I_FFCB) + (size_t)l * FFH;
    const int NT = nMr * 44 * 2 * 128;
    for (int task = F.bid * 512 + F.tid; task < NT; task += F.G * 512) {
        const int c = task & 127, which = (task >> 7) & 1, tile = task >> 8, pn = tile % 44, pm = tile / 44;
        const float* h = HALO + ((size_t)pm * 44 + pn) * 768 + c; const int col = pn * 128 + c;
        const bool first = (pm == 0 || pm == 32 || pm >= 64), last = (pm == 31 || pm >= 63);
        float ap, ac, an, b;
        if (which == 0) { ap = first ? 0.f : HALO[((size_t)(pm - 1) * 44 + pn) * 768 + 3 * 128 + c]; ac = h[0]; an = h[128]; b = h[4 * 128]; }
        else { ap = h[2 * 128]; ac = h[3 * 128]; an = last ? 0.f : HALO[((size_t)(pm + 1) * 44 + pn) * 768 + c]; b = h[5 * 128]; }
        const float a = cw[col] * ap + cw[FFH + col] * ac + cw[2 * FFH + col] * an + cb[col];
        ACT[(size_t)(pm * 256 + (which ? 255 : 0)) * FFH + col] = (f16)(siluf_(a) * b);
    }
}

namespace gla {
constexpr int QK_LD = 136, KH_LD = 72, VT_LD = 72, P_LD = 72;
constexpr int OFF_QT = 0;
constexpr int OFF_KT = 17408;
constexpr int OFF_VT = OFF_KT + 18432;
constexpr int OFF_P = OFF_VT + 36864;
constexpr int OFF_LR = OFF_P + 9216;
constexpr int OFF_GT = OFF_LR + 4096;
constexpr int OFF_DEC = OFF_GT + 2048;
constexpr int OFF_RS = OFF_DEC + 512;
constexpr int OFF_QR = OFF_RS + 2048;
constexpr int OFF_KR = OFF_QR + 17408;
constexpr int OFF_WG = OFF_KR + 17408;
static_assert(OFF_WG + 8192 <= LDSCTL_OFF, "gla lds");

__device__ __forceinline__ int grow(int b, int sc, int j, int i) {
    if (sc < 32) { const int col = 2 * sc + (j >> 1), r = (j & 1) * 64 + i; return b * SEQ + r * 64 + col; }
    return MX + b * LC + j * 64 + i;
}
__device__ __forceinline__ int prow(int b, int sc, int j, int i) {
    return sc < 32 ? b * SEQ + sc * 256 + j * 64 + i : MX + b * LC + j * 64 + i;
}
#define GLA_MFMA(a, b, c) __builtin_amdgcn_mfma_f32_16x16x32_f16(a, b, c, 0, 0, 0)

template <bool FULL>
__device__ __forceinline__ void gla_unit(const Ctx& F, const ArgsV& AV, int l, int unit) {
    const int b = unit / (4 * NSC), h = (unit / NSC) % 4, sc = unit % NSC;
    LAS f16* QT = (LAS f16*)(F.lds + OFF_QT); LAS f16* KT = (LAS f16*)(F.lds + OFF_KT); LAS f16* VT = (LAS f16*)(F.lds + OFF_VT);
    LAS f16* PP = (LAS f16*)(F.lds + OFF_P); LAS f16* LR = (LAS f16*)(F.lds + OFF_LR);
    LAS float* GT = (LAS float*)(F.lds + OFF_GT); LAS float* DEC = (LAS float*)(F.lds + OFF_DEC); LAS float* RS = (LAS float*)(F.lds + OFF_RS);
    LAS f16* QR = (LAS f16*)(F.lds + OFF_QR); LAS f16* KR = (LAS f16*)(F.lds + OFF_KR); LAS float* WG = (LAS float*)(F.lds + OFF_WG);
    const int tid = F.tid, lane = F.lane, w = F.wave, q0 = lane >> 4, c0 = lane & 15;
    const int dk0 = tid & 127, ig0 = tid >> 7;
    const f16* PX = (const f16*)(F.ws + WS_PX);
    const float scale = 0.08838834764831845f;
    for (int dir = 0; dir < 2; ++dir) {
        __syncthreads();
        for (int i = tid; i < 16 * 128; i += 512) WG[i] = AV.in(I_GLAWG)[(((size_t)l * 2 + dir) * 16 + (i >> 7)) * 512 + h * 128 + (i & 127)];
        const float bgv = AV.in(I_GLABG)[((size_t)l * 2 + dir) * 512 + h * 128 + dk0];
        const size_t sidx = ((((size_t)b * 4 + h) * NSC + sc) * 2 + dir);
        f32x4 accS[8][2];
        if (FULL && sc < 32) { const float* Sin = (const float*)(F.ws + WS_GSIN) + sidx * 32768; const int q = opq(q0), c = opq(c0);
#pragma unroll
            for (int dt = 0; dt < 8; ++dt)
#pragma unroll
                for (int et = 0; et < 2; ++et)
#pragma unroll
                    for (int r = 0; r < 4; ++r) accS[dt][et][r] = Sin[(16 * dt + 4 * q + r) * 256 + 32 * w + 16 * et + c];
            PIN8(accS[0][0], accS[0][1], accS[1][0], accS[1][1], accS[2][0], accS[2][1], accS[3][0], accS[3][1]); PIN8(accS[4][0], accS[4][1], accS[5][0], accS[5][1], accS[6][0], accS[6][1], accS[7][0], accS[7][1]); }
        else {
#pragma unroll
            for (int dt = 0; dt < 8; ++dt)
#pragma unroll
                for (int et = 0; et < 2; ++et) accS[dt][et] = (f32x4){0.f, 0.f, 0.f, 0.f}; }
        float sumtot = 0.f;
#define GLA_FETCH(jn) f16x8 pf_lr, pf_v[4], pf_k[2], pf_q[2]; do { const int tf = opq(F.tid); \
            { const int row = (tf & 255) >> 2, part = tf & 3; pf_lr = *(const f16x8*)(PX + (size_t)prow(b, sc, (jn), row) * PXLD + P_GG + part * 8); } \
            _Pragma("unroll") for (int k = 0; k < 4; ++k) { const int idx = tf + 512 * k, wi = idx >> 6, ln = idx & 63, rr = ln >> 2, cc = ln & 3; const int row = (wi & 3) * 16 + rr, chunk = (wi >> 2) * 4 + cc; \
                pf_v[k] = *(const f16x8*)(PX + (size_t)prow(b, sc, (jn), row) * PXLD + P_GV + h * 256 + chunk * 8); } \
            _Pragma("unroll") for (int k = 0; k < 2; ++k) { const int idx = tf + 512 * k, row = idx >> 4, ch = idx & 15; const size_t ro = (size_t)prow(b, sc, (jn), row) * PXLD; \
                pf_k[k] = *(const f16x8*)(PX + ro + P_GK + h * 128 + ch * 8); if (FULL) pf_q[k] = *(const f16x8*)(PX + ro + P_GQ + h * 128 + ch * 8); else pf_q[k] = pf_k[k]; } } while (0)
        for (int jj = 0; jj < 4; ++jj) {
            const int j = dir ? 3 - jj : jj;
            if (FULL) {
            GLA_FETCH(j);
            __syncthreads();
            const int tid = opq(F.tid);
            PIN8(pf_lr, pf_v[0], pf_v[1], pf_v[2], pf_v[3], pf_k[0], pf_k[1], pf_q[0]); asm volatile("" : "+v"(pf_q[1]));
            if (tid < 256) { const int row = tid >> 2, part = tid & 3; *(LAS f16x8*)(LR + row * 32 + part * 8) = pf_lr; }
#pragma unroll
            for (int k = 0; k < 4; ++k) { const int idx = opq(tid) + 512 * k, wi = idx >> 6, ln = idx & 63, rr = ln >> 2, cc = ln & 3;
                const int row = (wi & 3) * 16 + rr, chunk = (wi >> 2) * 4 + cc; LAS f16* vp = VT + (chunk * 8) * VT_LD + row;
#pragma unroll
                for (int e = 0; e < 8; ++e) vp[e * VT_LD] = pf_v[k][e]; }
#pragma unroll
            for (int k = 0; k < 2; ++k) { const int idx = tid + 512 * k, row = idx >> 4, ch = idx & 15;
                *(LAS f16x8*)(KR + row * QK_LD + ch * 8) = pf_k[k];
                *(LAS f16x8*)(QR + row * QK_LD + ch * 8) = pf_q[k]; }
            } else {
            __syncthreads();
            const int tid = opq(F.tid);
            if (tid < 256) { const int row = tid >> 2, part = tid & 3; const int gr = prow(b, sc, j, row);
                *(LAS f16x8*)(LR + row * 32 + part * 8) = *(const f16x8*)(PX + (size_t)gr * PXLD + P_GG + part * 8); }
#pragma unroll 1
            for (int k = 0; k < 4; ++k) { const int idx = tid + 512 * k, wi = idx >> 6, ln = idx & 63, rr = ln >> 2, cc = ln & 3;
                const int row = (wi & 3) * 16 + rr, chunk = (wi >> 2) * 4 + cc; const int gr = prow(b, sc, j, row);
                const f16x8 v8 = *(const f16x8*)(PX + (size_t)gr * PXLD + P_GV + h * 256 + chunk * 8);
#pragma unroll
                for (int e = 0; e < 8; ++e) VT[(chunk * 8 + e) * VT_LD + row] = v8[e]; }
#pragma unroll 1
            for (int k = 0; k < 2; ++k) { const int idx = tid + 512 * k, row = idx >> 4, ch = idx & 15; const int gr = prow(b, sc, j, row);
                *(LAS f16x8*)(KR + row * QK_LD + ch * 8) = *(const f16x8*)(PX + (size_t)gr * PXLD + P_GK + h * 128 + ch * 8); }
            }
            __syncthreads();
            const int dk = opq(dk0), ig = opq(ig0);
            float bv[16];
#pragma unroll
            for (int ii = 0; ii < 16; ++ii) { const int i = ig * 16 + ii; float pre = bgv;
                const f16x8 l0 = *(const LAS f16x8*)(LR + i * 32 + dir * 16), l1 = *(const LAS f16x8*)(LR + i * 32 + dir * 16 + 8);
#pragma unroll
                for (int r = 0; r < 8; ++r) pre += (float)l0[r] * WG[r * 128 + dk] + (float)l1[r] * WG[(8 + r) * 128 + dk];
                bv[ii] = logsigmoidf_(pre) * (1.0f / 16.0f); }
            float totloc;
            if (dir == 0) {
#pragma unroll
                for (int ii = 1; ii < 16; ++ii) bv[ii] += bv[ii - 1];
                totloc = bv[15]; }
            else {
#pragma unroll
                for (int ii = 14; ii >= 0; --ii) bv[ii] += bv[ii + 1];
                totloc = bv[0]; }
            GT[ig * 128 + dk] = totloc;
            __syncthreads();
            const float g0 = GT[dk], g1 = GT[128 + dk], g2 = GT[256 + dk], g3 = GT[384 + dk];
            const float total = (g0 + g1) + (g2 + g3);
            float off, bmid;
            if (dir == 0) { off = (ig > 0 ? g0 : 0.f) + (ig > 1 ? g1 : 0.f) + (ig > 2 ? g2 : 0.f); bmid = g0 + g1; }
            else { off = (ig < 3 ? g3 : 0.f) + (ig < 2 ? g2 : 0.f) + (ig < 1 ? g1 : 0.f); bmid = g2 + g3; }
#pragma unroll
            for (int ii = 0; ii < 16; ++ii) bv[ii] += off;
            if (FULL) {
#pragma unroll
                for (int ii = 0; ii < 16; ++ii) { const int i = ig * 16 + ii;
                    QT[i * QK_LD + dk] = (f16)((float)QR[i * QK_LD + dk] * scale * __expf(fminf(bv[ii] - bmid, 9.f)));
                    KT[i * QK_LD + dk] = (f16)((float)KR[i * QK_LD + dk] * __expf(fminf(bmid - bv[ii], 9.f))); }
                __syncthreads();
                { const int c = opq(c0), q = opq(q0);
#pragma unroll
                for (int s = 0; s < 2; ++s) { const int T = 2 * w + s, it = T >> 2, jt = T & 3; f32x4 a = (f32x4){0.f, 0.f, 0.f, 0.f};
#pragma unroll
                    for (int kk = 0; kk < 4; ++kk) { const f16x8 kf = *(const LAS f16x8*)(KT + (jt * 16 + c) * QK_LD + kk * 32 + 8 * q);
                        const f16x8 qf = *(const LAS f16x8*)(QT + (it * 16 + c) * QK_LD + kk * 32 + 8 * q); a = GLA_MFMA(kf, qf, a); }
                    const int i = it * 16 + c; f16x4 pv;
#pragma unroll
                    for (int r = 0; r < 4; ++r) { const int jx = jt * 16 + 4 * q + r; const bool keep = dir == 0 ? (jx <= i) : (jx >= i); pv[r] = keep ? (f16)a[r] : (f16)0.f; }
                    *(LAS f16x4*)(PP + i * P_LD + jt * 16 + 4 * q) = pv; } }
                __syncthreads();
#pragma unroll
                for (int ii = 0; ii < 16; ++ii) { const int i = ig * 16 + ii; QT[i * QK_LD + dk] = (f16)((float)QR[i * QK_LD + dk] * scale * __expf(bv[ii])); }
            }
            { f16x8 k0, k1;
#pragma unroll
              for (int ii = 0; ii < 8; ++ii) { k0[ii] = (f16)((float)KR[(ig * 16 + ii) * QK_LD + dk] * __expf(total - bv[ii])); k1[ii] = (f16)((float)KR[(ig * 16 + 8 + ii) * QK_LD + dk] * __expf(total - bv[8 + ii])); }
              *(LAS f16x8*)(KT + dk * KH_LD + ig * 16) = k0; *(LAS f16x8*)(KT + dk * KH_LD + ig * 16 + 8) = k1; }
            if (ig == 0) { DEC[dk] = __expf(total); sumtot += total; }
            __syncthreads();
            const int c = opq(c0), q = opq(q0);
            if (FULL) {
                f32x4 accO[4][2];
#pragma unroll
                for (int it = 0; it < 4; ++it)
#pragma unroll
                    for (int et = 0; et < 2; ++et) accO[it][et] = (f32x4){0.f, 0.f, 0.f, 0.f};
#pragma unroll
                for (int et = 0; et < 2; ++et)
#pragma unroll
                    for (int kk = 0; kk < 2; ++kk) { const f16x8 vf = *(const LAS f16x8*)(VT + (32 * w + 16 * et + c) * VT_LD + kk * 32 + 8 * q);
#pragma unroll
                        for (int it = 0; it < 4; ++it) { const f16x8 pf = *(const LAS f16x8*)(PP + (it * 16 + c) * P_LD + kk * 32 + 8 * q); accO[it][et] = GLA_MFMA(vf, pf, accO[it][et]); } asm volatile("" ::: "memory"); }
#pragma unroll
                for (int kb = 0; kb < 4; ++kb)
#pragma unroll
                    for (int et = 0; et < 2; ++et) { f16x8 sf; asm volatile("" ::: "memory");
#pragma unroll
                        for (int e = 0; e < 4; ++e) { sf[e] = (f16)accS[2 * kb][et][e]; sf[4 + e] = (f16)accS[2 * kb + 1][et][e]; }
#pragma unroll
                        for (int it = 0; it < 4; ++it) { const f16x4 lo = *(const LAS f16x4*)(QT + (it * 16 + c) * QK_LD + 32 * kb + 4 * q), hi = *(const LAS f16x4*)(QT + (it * 16 + c) * QK_LD + 32 * kb + 16 + 4 * q);
                            f16x8 qf; qf[0] = lo[0]; qf[1] = lo[1]; qf[2] = lo[2]; qf[3] = lo[3]; qf[4] = hi[0]; qf[5] = hi[1]; qf[6] = hi[2]; qf[7] = hi[3];
                            accO[it][et] = GLA_MFMA(sf, qf, accO[it][et]); } }
                float* OF = (float*)(F.ws + WS_GOF);
                if (dir == 0) {
#pragma unroll
                    for (int it = 0; it < 4; ++it) { const int gr = prow(b, sc, j, it * 16 + c);
#pragma unroll
                        for (int et = 0; et < 2; ++et) *(f32x4*)(OF + (size_t)gr * 1024 + h * 256 + 32 * w + 16 * et + 4 * q) = accO[it][et];
                        asm volatile("" ::: "memory"); } }
                else {
                    int grs[4]; f32x4 ofv[4][2]; f16x4 rvv[4][2];
#pragma unroll
                    for (int it = 0; it < 4; ++it) { grs[it] = prow(b, sc, j, it * 16 + c);
#pragma unroll
                        for (int et = 0; et < 2; ++et) { ofv[it][et] = *(const f32x4*)(OF + (size_t)grs[it] * 1024 + h * 256 + 32 * w + 16 * et + 4 * q);
                            rvv[it][et] = *(const f16x4*)(PX + (size_t)grs[it] * PXLD + P_GR + h * 256 + 32 * w + 16 * et + 4 * q); } }
                    PIN8(ofv[0][0], ofv[0][1], ofv[1][0], ofv[1][1], ofv[2][0], ofv[2][1], ofv[3][0], ofv[3][1]);
#pragma unroll
                    for (int it = 0; it < 4; ++it) { float ss = 0.f;
#pragma unroll
                        for (int et = 0; et < 2; ++et) { accO[it][et] = accO[it][et] + ofv[it][et];
                            ss += (accO[it][et][0] * accO[it][et][0] + accO[it][et][1] * accO[it][et][1]) + (accO[it][et][2] * accO[it][et][2] + accO[it][et][3] * accO[it][et][3]); }
                        ss += __shfl_xor(ss, 16); ss += __shfl_xor(ss, 32);
                        if (q == 0) RS[(it * 16 + c) * 8 + w] = ss; }
                    __syncthreads();
                    PIN8(rvv[0][0], rvv[0][1], rvv[1][0], rvv[1][1], rvv[2][0], rvv[2][1], rvv[3][0], rvv[3][1]);
                    const float* ng = AV.in(I_GLANG) + (size_t)l * 256;
                    f16* Y = (f16*)(F.ws + WS_YCAT);
#pragma unroll
                    for (int it = 0; it < 4; ++it) { const int i = it * 16 + c; const f32x4 ra = *(const LAS f32x4*)(RS + i * 8), rb = *(const LAS f32x4*)(RS + i * 8 + 4);
                        const float tot = ((ra[0] + ra[1]) + (ra[2] + ra[3])) + ((rb[0] + rb[1]) + (rb[2] + rb[3]));
                        const float rstd = 1.0f / sqrtf(tot * (1.0f / 256.0f) + EPS);
#pragma unroll
                        for (int et = 0; et < 2; ++et) { const int e0 = 32 * w + 16 * et + 4 * q;
                            const f32x4 gv = *(const f32x4*)(ng + e0);
                            f16x4 o;
#pragma unroll
                            for (int r = 0; r < 4; ++r) o[r] = (f16)(accO[it][et][r] * rstd * gv[r] * siluf_((float)rvv[it][et][r]));
                            *(f16x4*)(Y + (size_t)grow(b, sc, j, it * 16 + c) * 2048 + 1024 + h * 256 + e0) = o; } }
                }
            }
#pragma unroll
            for (int dt = 0; dt < 8; ++dt) { const f32x4 dv = *(const LAS f32x4*)(DEC + 16 * dt + 4 * q);
#pragma unroll
                for (int et = 0; et < 2; ++et) accS[dt][et] = accS[dt][et] * dv; }
#pragma unroll
            for (int kk = 0; kk < 2; ++kk) { f16x8 vf[2];
#pragma unroll
                for (int et = 0; et < 2; ++et) vf[et] = *(const LAS f16x8*)(VT + (32 * w + 16 * et + c) * VT_LD + kk * 32 + 8 * q);
#pragma unroll
                for (int dt = 0; dt < 8; ++dt) { const f16x8 kf = *(const LAS f16x8*)(KT + (16 * dt + c) * KH_LD + kk * 32 + 8 * q);
#pragma unroll
                    for (int et = 0; et < 2; ++et) accS[dt][et] = GLA_MFMA(kf, vf[et], accS[dt][et]); if (dt & 1) asm volatile("" ::: "memory"); } }
        }
        if (!FULL) { float* Sl = (float*)(F.ws + WS_GSLOC) + sidx * 32768; const int q = opq(q0), c = opq(c0);
#pragma unroll
            for (int dt = 0; dt < 8; ++dt)
#pragma unroll
                for (int et = 0; et < 2; ++et)
#pragma unroll
                    for (int r = 0; r < 4; ++r) Sl[(16 * dt + 4 * q + r) * 256 + 32 * w + 16 * et + c] = accS[dt][et][r];
            if (ig0 == 0) ((float*)(F.ws + WS_GDT))[sidx * 128 + dk0] = __expf(sumtot); }
        VM_WAIT();
    }
}
__device__ __forceinline__ void ph_gla_scan(const Ctx& F) {
    const float* Sl = (const float*)(F.ws + WS_GSLOC); float* Si = (float*)(F.ws + WS_GSIN); const float* Dt = (const float*)(F.ws + WS_GDT);
    for (int gt = F.bid * 512 + F.tid; gt < 2 * 4 * 2 * 32768; gt += F.G * 512) {
        const int e = gt & 32767, dir = (gt >> 15) & 1, h = (gt >> 16) & 3, b = gt >> 18;
        float S = 0.f;
        for (int base = 0; base < NSC; base += 11) {
            float sl[11], dt[11]; size_t ix[11];
#pragma unroll
            for (int u = 0; u < 11; ++u) { const int step = base + u; const int sc = step == 0 ? 32 : (dir == 0 ? step - 1 : 32 - step);
                const size_t idx = ((((size_t)b * 4 + h) * NSC + sc) * 2 + dir); ix[u] = idx;
                sl[u] = Sl[idx * 32768 + e]; dt[u] = Dt[idx * 128 + (e >> 8)]; }
            PIN8(sl[0], sl[1], sl[2], sl[3], sl[4], sl[5], sl[6], sl[7]); PIN8(dt[0], dt[1], dt[2], dt[3], dt[4], dt[5], dt[6], dt[7]); PIN4(sl[8], sl[9], sl[10], dt[8]); asm volatile("" : "+v"(dt[9]), "+v"(dt[10]));
#pragma unroll
            for (int u = 0; u < 11; ++u) { Si[ix[u] * 32768 + e] = S; S = dt[u] * S + sl[u]; }
        }
    }
}
#undef GLA_FETCH
#undef GLA_MFMA
}

namespace hy {
#define PADI(i) ((i) + ((i) >> 5))
constexpr int HY_BUF_BYTES = (16384 + 512) * 8;
constexpr int HY_SCR_OFF = HY_BUF_BYTES;
static_assert(HY_SCR_OFF + 2048 <= LDSCTL_OFF, "hyena lds");
__device__ __forceinline__ f32x2 twid(int k, float invN) { const float xr = (float)k * invN; return (f32x2){__builtin_amdgcn_cosf(xr), -__builtin_amdgcn_sinf(xr)}; }
__device__ __forceinline__ f32x2 mul_w16(f32x2 d, int a) {
    constexpr float c1 = 0.9238795325112867f, s1 = 0.3826834323650898f, r = 0.7071067811865476f;
    float c, s;
    switch (a & 15) {
        case 0: return d; case 4: return (f32x2){d.y, -d.x}; case 8: return (f32x2){-d.x, -d.y}; case 12: return (f32x2){-d.y, d.x};
        case 1: c = c1; s = s1; break; case 2: c = r; s = r; break; case 3: c = s1; s = c1; break;
        case 5: c = -s1; s = c1; break; case 6: c = -r; s = r; break; case 7: c = -c1; s = s1; break;
        case 9: c = -c1; s = -s1; break; case 10: c = -r; s = -r; break; case 11: c = -s1; s = -c1; break;
        case 13: c = s1; s = -c1; break; case 14: c = r; s = -r; break; default: c = c1; s = -s1; break; }
    return (f32x2){d.x * c + d.y * s, d.y * c - d.x * s};
}
template <int R> __device__ __forceinline__ void dif_pass(LAS f32x2* x, int m, int lh, int tid) {
    const int N = 1 << m; const float invN = 1.0f / (float)N; const int lg = lh - R + 1, g = 1 << lg, S = (N >> 1) >> lh;
    for (int q = tid; q < (N >> R); q += 512) { const int j = q & (g - 1), blk = q >> lg, base = (blk << (lh + 1)) + j;
        f32x2 v[1 << R];
#pragma unroll
        for (int k = 0; k < (1 << R); ++k) v[k] = x[PADI(base + k * g)];
        f32x2 w = twid(j * S, invN);
#pragma unroll
        for (int s = 0; s < R; ++s) { const int half = 1 << (R - 1 - s);
#pragma unroll
            for (int k = 0; k < (1 << R); ++k) if (!(k & half)) { const f32x2 a = v[k], b = v[k + half]; v[k] = a + b;
                v[k + half] = mul_w16(cmul(a - b, w), ((k & (half - 1)) << s) * (16 >> R)); }
            w = cmul(w, w); }
#pragma unroll
        for (int k = 0; k < (1 << R); ++k) x[PADI(base + k * g)] = v[k]; }
    __syncthreads();
}
template <int R> __device__ __forceinline__ void dit_pass(LAS f32x2* x, int m, int lh, int tid) {
    const int N = 1 << m; const float invN = 1.0f / (float)N; const int h = 1 << lh, S1 = (N >> 1) >> lh;
    for (int q = tid; q < (N >> R); q += 512) { const int j = q & (h - 1), blk = q >> lh, base = (blk << (lh + R)) + j;
        f32x2 v[1 << R];
#pragma unroll
        for (int k = 0; k < (1 << R); ++k) v[k] = x[PADI(base + k * h)];
        f32x2 wp[R]; wp[R - 1] = cconj(twid(j * (S1 >> (R - 1)), invN));
#pragma unroll
        for (int s = R - 2; s >= 0; --s) wp[s] = cmul(wp[s + 1], wp[s + 1]);
#pragma unroll
        for (int s = 0; s < R; ++s) { const int half = 1 << s;
#pragma unroll
            for (int k = 0; k < (1 << R); ++k) if (!(k & half)) { const f32x2 a = v[k];
                const f32x2 b = mul_w16(cmul(v[k + half], wp[s]), (16 - (k & (half - 1)) * (16 >> (s + 1))) & 15);
                v[k] = a + b; v[k + half] = a - b; } }
#pragma unroll
        for (int k = 0; k < (1 << R); ++k) x[PADI(base + k * h)] = v[k]; }
    __syncthreads();
}
__device__ __forceinline__ void fft_fwd(LAS f32x2* x, int m, int tid) {
    int lh = m - 1;
    while (lh + 1 >= 4) { dif_pass<4>(x, m, lh, tid); lh -= 4; }
    if (lh + 1 == 2) dif_pass<2>(x, m, 1, tid); else if (lh + 1 == 1) dif_pass<1>(x, m, 0, tid);
}
__device__ __forceinline__ void fft_inv(LAS f32x2* x, int m, int tid) {
    int lh = 0;
    while (m - lh >= 4) { dit_pass<4>(x, m, lh, tid); lh += 4; }
    if (m - lh == 2) dit_pass<2>(x, m, lh, tid); else if (m - lh == 1) dit_pass<1>(x, m, lh, tid);
}
__device__ __forceinline__ int brev(int k, int m) { return (int)(__brev((unsigned)k) >> (32 - m)); }

__device__ __forceinline__ void filt_unit(const Ctx& F, const ArgsV& AV, int l, int unit) {
    const int kind = unit >> 9, o = (unit >> 8) & 1, pair = unit & 255;
    const int n = kind ? LC : SEQ, m = kind ? 9 : 14, N = 2 * n, tid = F.tid;
    LAS f32x2* buf = (LAS f32x2*)F.lds;
    LAS float* W3 = (LAS float*)(F.lds + HY_SCR_OFF);
    LAS float* B3 = W3 + 256;
    LAS float* RED = B3 + 4;
    LAS float* INV = RED + 16;
    __syncthreads();
    if (tid < 256) { const int j = tid >> 2, ci = tid & 3; const int col = o * 1024 + (ci >> 1) * 512 + 2 * pair + (ci & 1);
        W3[j * 4 + ci] = AV.in(I_HYW3)[((size_t)l * 64 + j) * 2048 + col]; if (j == 0) B3[ci] = AV.in(I_HYB3)[(size_t)l * 2048 + col]; }
    __syncthreads();
    const float* H2 = (const float*)(F.ws + WS_H2) + (kind ? (size_t)SEQ * 64 : 0);
    const float lo = -3.0701134573253945f, hi = -15.350567286626973f;
    const float ra = fabsf(lo + (hi - lo) * (float)(2 * pair) / 511.0f), rb = fabsf(lo + (hi - lo) * (float)(2 * pair + 1) / 511.0f);
    float sa = 0.f, sb = 0.f;
    for (int t = tid; t < n; t += 512) {
        float a0 = B3[0], a1 = B3[1], a2 = B3[2], a3 = B3[3];
        const f32x4* hr = (const f32x4*)(H2 + (size_t)t * 64);
#pragma unroll 4
        for (int j4 = 0; j4 < 16; ++j4) { const f32x4 hv = hr[j4];
#pragma unroll
            for (int e = 0; e < 4; ++e) { const f32x4 wv = *(const LAS f32x4*)(W3 + (j4 * 4 + e) * 4); a0 += hv[e] * wv[0]; a1 += hv[e] * wv[1]; a2 += hv[e] * wv[2]; a3 += hv[e] * wv[3]; } }
        const float tn = (float)t / (float)(n - 1), da = expf(-tn * ra), db = expf(-tn * rb);
        const float fa = a0 * da, fb = a1 * db, ba = a2 * da, bb = a3 * db;
        buf[PADI(t)] = (f32x2){fa, fb}; sa += fabsf(fa); sb += fabsf(fb);
        if (t >= 1) { buf[PADI(N - t)] = (f32x2){ba, bb}; sa += fabsf(ba); sb += fabsf(bb); }
    }
    if (tid == 0) { float z0 = 0.f; asm volatile("" : "+v"(z0)); buf[PADI(n)] = (f32x2){z0, z0}; }
    sa = wave_sum(sa); sb = wave_sum(sb);
    if (F.lane == 0) { RED[F.wave * 2] = sa; RED[F.wave * 2 + 1] = sb; }
    __syncthreads();
    if (tid < 2) { float s = 0.f;
#pragma unroll
        for (int w = 0; w < 8; ++w) s += RED[w * 2 + tid];
        INV[tid] = 1.0f / (s + EPS); }
    __syncthreads();
    { const float ia = INV[0], ib = INV[1];
      for (int i = tid; i < N; i += 512) { f32x2 v = buf[PADI(i)]; v.x *= ia; v.y *= ib; buf[PADI(i)] = v; } }
    __syncthreads();
    fft_fwd(buf, m, tid);
    f32x4* out = (f32x4*)(F.ws + WS_FSD + (kind ? FSD_C_OFF : 0)) + (size_t)(o * 256 + pair) * (n + 1);
    for (int u = tid; u <= n; u += 512) { const int p = u < n ? 2 * u : 1, k = brev(p, m), pn = brev((N - k) & (N - 1), m);
        const f32x2 zk = buf[PADI(p)], zn = cconj(buf[PADI(pn)]);
        const f32x2 fa = (zk + zn) * 0.5f, df = zk - zn, fb = (f32x2){df.y * 0.5f, -df.x * 0.5f};
        const f32x2 fs = (fa + fb) * 0.5f, fd = (fa - fb) * 0.5f;
        out[u] = (f32x4){fs.x, fs.y, fd.x, fd.y}; }
    __syncthreads();
}

__device__ __forceinline__ void main_unit(const Ctx& F, const ArgsV& AV, int l, int unit) {
    const int kind = unit >> 9, b = (unit >> 8) & 1, pair = unit & 255;
    const int n = kind ? LC : SEQ, m = kind ? 9 : 14, N = 2 * n, tid = F.tid;
    const int row0 = kind ? MX + b * LC : b * SEQ;
    LAS f32x2* buf = (LAS f32x2*)F.lds;
    const f16* ZT = (const f16*)(F.ws + WS_ZT) + (size_t)(2 * pair) * MT + row0;
    const float* cw = AV.in(I_HYCW) + (size_t)l * 3 * 1536 + 2 * pair; const float* cb = AV.in(I_HYCB) + (size_t)l * 1536 + 2 * pair;
    f32x2 yv[16], g1[16], g2[16];
#pragma unroll
    for (int g = 0; g < 3; ++g)
#pragma unroll
        for (int cc = 0; cc < 2; ++cc) { const float w0 = cw[g * 512 + cc], w1 = cw[1536 + g * 512 + cc], w2 = cw[3072 + g * 512 + cc], bs = cb[g * 512 + cc];
            const f16* zt = ZT + (size_t)(g * 512 + cc) * MT;
#pragma unroll
            for (int gi = 0; gi < 2; ++gi) { const int t0 = 8 * (tid + 512 * gi);
                f16x8 mv; float pv = 0.f, nv = 0.f;
#pragma unroll
                for (int e = 0; e < 8; ++e) mv[e] = (f16)0.f;
                if (t0 < n) { mv = *(const f16x8*)(zt + t0); if (t0 > 0) pv = (float)zt[t0 - 1]; if (t0 + 8 < n) nv = (float)zt[t0 + 8]; }
#pragma unroll
                for (int e = 0; e < 8; ++e) { const float zm = e == 0 ? pv : (float)mv[e == 0 ? 0 : e - 1], zc = (float)mv[e], zp = e == 7 ? nv : (float)mv[e == 7 ? 7 : e + 1];
                    const float r = w0 * zm + w1 * zc + w2 * zp + bs;
                    if (g == 0) { if (cc == 0) yv[gi * 8 + e].x = r; else yv[gi * 8 + e].y = r; }
                    else if (g == 1) { if (cc == 0) g1[gi * 8 + e].x = r; else g1[gi * 8 + e].y = r; }
                    else { if (cc == 0) g2[gi * 8 + e].x = r; else g2[gi * 8 + e].y = r; } } } }
    const float invN = 1.0f / (float)N;
#pragma unroll
    for (int o = 0; o < 2; ++o) {
        __syncthreads();
        float z0 = 0.f; asm volatile("" : "+v"(z0));
#pragma unroll
        for (int gi = 0; gi < 2; ++gi) { const int t0 = 8 * (tid + 512 * gi);
            if (t0 < n) {
#pragma unroll
                for (int e = 0; e < 8; ++e) { buf[PADI(t0 + e)] = yv[gi * 8 + e]; buf[PADI(n + t0 + e)] = (f32x2){z0, z0}; } } }
        __syncthreads();
        fft_fwd(buf, m, tid);
        const f32x4* fsd = (const f32x4*)(F.ws + WS_FSD + (kind ? FSD_C_OFF : 0)) + (size_t)(o * 256 + pair) * (n + 1);
        for (int u = tid; u <= n; u += 512) { const int p = u < n ? 2 * u : 1, k = brev(p, m), pn = brev((N - k) & (N - 1), m);
            const f32x2 zk = buf[PADI(p)], zn = buf[PADI(pn)]; const f32x4 f = fsd[u]; const f32x2 fs = (f32x2){f[0], f[1]}, fd = (f32x2){f[2], f[3]};
            const f32x2 wk = cmul(zk, fs) + cmul(cconj(zn), fd), wn = cmul(zn, cconj(fs)) + cmul(cconj(zk), cconj(fd));
            buf[PADI(pn)] = wn; buf[PADI(p)] = wk; }
        __syncthreads();
        fft_inv(buf, m, tid);
        const float* hb = AV.in(I_HYBIAS) + ((size_t)l * 2 + o) * 512 + 2 * pair; const f32x2 bias = (f32x2){hb[0], hb[1]};
#pragma unroll
        for (int gi = 0; gi < 2; ++gi) { const int t0 = 8 * (tid + 512 * gi);
            if (t0 < n) {
#pragma unroll
                for (int e = 0; e < 8; ++e) { const f32x2 cv = buf[PADI(t0 + e)] * invN; const f32x2 gt = o == 0 ? g1[gi * 8 + e] : g2[gi * 8 + e];
                    yv[gi * 8 + e] = gt * (cv + yv[gi * 8 + e] * bias); } } }
    }
    f16* Y = (f16*)(F.ws + WS_YBT) + (size_t)(2 * pair) * MT + row0;
#pragma unroll
    for (int gi = 0; gi < 2; ++gi) { const int t0 = 8 * (tid + 512 * gi);
        if (t0 < n) { f16x8 oa, ob;
#pragma unroll
            for (int e = 0; e < 8; ++e) { oa[e] = (f16)yv[gi * 8 + e].x; ob[e] = (f16)yv[gi * 8 + e].y; }
            *(f16x8*)(Y + t0) = oa; *(f16x8*)(Y + MT + t0) = ob; } }
    __syncthreads();
}

__device__ __forceinline__ void ph_ybt_transpose(const Ctx& F) {
    LAS f16* T = (LAS f16*)F.lds;
    const f16* YBT = (const f16*)(F.ws + WS_YBT); f16* Y = (f16*)(F.ws + WS_YCAT);
    for (int rb = F.bid; rb < MT / 64; rb += F.G) { const int r0 = rb * 64;
        __syncthreads();
#pragma unroll
        for (int i = 0; i < 8; ++i) *(LAS f16x8*)(T + F.tid * 72 + 8 * i) = *(const f16x8*)(YBT + (size_t)F.tid * MT + r0 + 8 * i);
        __syncthreads();
        const int row = F.tid >> 3, cg = F.tid & 7;
#pragma unroll
        for (int jj = 0; jj < 8; ++jj) { const int gidx = cg + 8 * jj; f16x8 o;
#pragma unroll
            for (int e = 0; e < 8; ++e) o[e] = T[(8 * gidx + e) * 72 + row];
            *(f16x8*)(Y + (size_t)(r0 + row) * 2048 + 512 + 8 * gidx) = o; }
    }
    __syncthreads();
}
#undef PADI
}

#ifndef PHMASK
#define PHMASK 0xFFFF
#endif
#define PH_EN(k) (((PHMASK) >> (k)) & 1)
#ifndef STAMP_MASK
#define STAMP_MASK 0
#endif
#ifndef STAMP_K
#define STAMP_K 1
#endif
#ifndef SUBMASK
#define SUBMASK 7
#endif
#define SUB_EN(k) (((SUBMASK) >> (k)) & 1)
constexpr int NPH = 2 + 12 * DEPTH;
constexpr int CW_Q = 8192;
__device__ __forceinline__ int q_pull(unsigned* ctr, volatile LAS int* slot) {
    __syncthreads();
    if (threadIdx.x == 0) *slot = (int)__hip_atomic_fetch_add(ctr, 1u, __ATOMIC_RELAXED, __HIP_MEMORY_SCOPE_AGENT);
    __syncthreads();
    return *slot;
}

__global__ void __launch_bounds__(512, 2) mk_fwd(Args args) {
    extern __shared__ __attribute__((aligned(16))) unsigned char lds_raw[];
    Ctx F; F.lds = (LAS unsigned char*)lds_raw; F.tid = threadIdx.x; F.lane = F.tid & 63; F.wave = __builtin_amdgcn_readfirstlane(F.tid >> 6);
    F.G = gridDim.x; F.bid = blockIdx.x; F.ws = args.ws;
    ArgsV AV; AV.out = args.out;
    const Ctx F0 = F;
#define FRESH() do { F.tid = opq(F0.tid); F.lane = F.tid & 63; F.wave = __builtin_amdgcn_readfirstlane(F.tid >> 6); } while (0)
    volatile LAS unsigned* MISC = (volatile LAS unsigned*)(F.lds + LDSCTL_OFF);
    if (F.tid < 64) MISC[F.tid] = 0u;
    __syncthreads();
    unsigned* barw = (unsigned*)(F.ws + WS_CTL) + CW_BAR;
    XcdBarrier bar; bar.bar = barw; bar.x = 0; bar.st = nullptr;
    const int lo = args.ph_lo, hi = args.ph_hi;
    if (hi - lo > 1) bar = xcd_barrier_post(barw, MISC + 8);
#define IN(k) (lo <= (k) && (k) < hi)
#define SEAM(k) do { if (IN(k) && IN((k) + 1)) xcd_barrier(bar); } while (0)
#if STAMP_MASK
    volatile LAS unsigned long long* TS = (volatile LAS unsigned long long*)(F.lds + LDSCTL_OFF + 128);
#define TSTART(k) do { if ((((STAMP_MASK) >> (k)) & 1) && blockIdx.x == 0 && threadIdx.x == 0) TS[0] = __builtin_amdgcn_s_memrealtime(); } while (0)
#define TSTOP(k) do { if ((((STAMP_MASK) >> (k)) & 1) && blockIdx.x == 0 && threadIdx.x == 0) TS[1] = TS[1] + (__builtin_amdgcn_s_memrealtime() - TS[0]); } while (0)
#else
#define TSTART(k) do {} while (0)
#define TSTOP(k) do {} while (0)
#endif
    unsigned char* ws = F.ws;
    const int rank160 = (F.bid + F.G - 160 % F.G) % F.G;

    TSTART(12);
    if (PH_EN(12) && IN(0)) { FRESH(); ph_prologue(F, AV); }
    SEAM(0);
    TSTOP(12);

    for (int l = 0; l < DEPTH; ++l) {
        const int pb = 1 + 12 * l;
        const float* modl = (const float*)(ws + WS_MOD) + (size_t)l * 3 * 12288;
        const bool ctx_on = l < DEPTH - 1;
        const int nMr = ctx_on ? MT / 256 : MX / 256, nrows = ctx_on ? MT : MX;
        TSTART(0);
        if (PH_EN(0) && IN(pb + 0)) {
            FRESH(); ph_convert_weights(F, AV, l);
            __syncthreads();
            FRESH(); if (F.bid < 32) s5_mats_group(F, AV, l, F.bid);
            FRESH(); ph_hyena_h2(F, AV, l);
            FRESH(); ph_norm(F, AV, l, 0, MT, l > 0 ? 11 : 0);
        }
        SEAM(pb + 0);
        TSTOP(0);
        TSTART(1);
        if (PH_EN(1) && IN(pb + 1)) {
            pg8::SchedPlain S; S.init(MT / 256, WINN / 256, F.G, F.bid); S.A = (const char*)(ws + WS_HN); S.B = (const char*)(ws + WS_WIN); S.aTile = (size_t)256 * 2048 * 2; S.bTile = (size_t)256 * 2048 * 2;
            pg8::EpiPx E{(f16*)(ws + WS_PX), (f16*)(ws + WS_S5A), (f16*)(ws + WS_ZT), (f16*)(ws + WS_GTL)};
            pg8::gemm_phase(F.lds, 2048, 2048, 32, S, E);
        }
        SEAM(pb + 1);
        TSTOP(1);
        TSTART(2);
        if (PH_EN(2) && IN(pb + 2)) {
            TSTART(16);
            if (SUB_EN(0)) { pg8::SchedS5 S{(const char*)(ws + WS_S5A), (const char*)(ws + WS_S5M), (size_t)256 * 256 * 2, F.G, F.bid};
              pg8::EpiS5In E{(float*)(ws + WS_S5S)};
              pg8::gemm_phase(F.lds, 16384, 256, 4, S, E); }
            TSTOP(16);
            { unsigned* qc = (unsigned*)(ws + WS_CTL) + CW_Q + (l * 2 + 0) * 64; volatile LAS int* slot = (volatile LAS int*)(MISC + 16);
              for (;;) { const int u = q_pull(qc, slot); if (u >= 264 + 1024) break;
                  if (u < 264) { TSTART(17); FRESH(); gla::gla_unit<false>(F, AV, l, u); TSTOP(17); } else { TSTART(18); FRESH(); hy::filt_unit(F, AV, l, u - 264); TSTOP(18); } } }
        }
        SEAM(pb + 2);
        TSTOP(2);
        TSTART(3);
        if (PH_EN(3) && IN(pb + 3)) { FRESH(); ph_s5_scan(F); FRESH(); gla::ph_gla_scan(F); }
        SEAM(pb + 3);
        TSTOP(3);
        TSTART(4);
        if (PH_EN(4) && IN(pb + 4)) {
            TSTART(19);
            if (SUB_EN(0)) { pg8::SchedS5 S{(const char*)(ws + WS_S5A), (const char*)(ws + WS_S5W), (size_t)256 * 512 * 2, F.G, F.bid};
              pg8::EpiS5Out E{(const f16*)(ws + WS_S5A), (f16*)(ws + WS_YAPRE), AV.in(I_S5D) + (size_t)l * 512};
              pg8::gemm_phase(F.lds, 16384, 512, 8, S, E); }
            TSTOP(19);
            { unsigned* qc = (unsigned*)(ws + WS_CTL) + CW_Q + (l * 2 + 1) * 64; volatile LAS int* slot = (volatile LAS int*)(MISC + 16);
              for (;;) { const int u = q_pull(qc, slot); if (u >= 264 + 1024) break;
                  if (u < 264) { TSTART(20); FRESH(); gla::gla_unit<true>(F, AV, l, u); TSTOP(20); } else { TSTART(21); FRESH(); hy::main_unit(F, AV, l, u - 264); TSTOP(21); } } }
        }
        SEAM(pb + 4);
        TSTOP(4);
        TSTART(5);
        if (PH_EN(5) && IN(pb + 5)) {
            pg8::SchedPlain S; S.init(nMr, 2, F.G, F.bid); S.A = (const char*)(ws + WS_YAPRE); S.B = (const char*)(ws + WS_WGLU); S.aTile = (size_t)256 * 512 * 2; S.bTile = (size_t)256 * 512 * 2;
            pg8::EpiGlu E{(const f16*)(ws + WS_YAPRE), (f16*)(ws + WS_YCAT), AV.in(I_GLUB) + (size_t)l * 512};
            pg8::gemm_phase(F.lds, 512, 512, 8, S, E);
            FRESH(); hy::ph_ybt_transpose(F);
        }
        SEAM(pb + 5);
        TSTOP(5);
        TSTART(6);
        if (PH_EN(6) && IN(pb + 6)) {
            pg8::SchedPlain S; S.init(nMr, 8, F.G, F.bid); S.aTile = (size_t)256 * 2048 * 2; S.bTile = (size_t)256 * 2048 * 2;
            S.A = (const char*)(ws + WS_YCAT); S.B = (const char*)(ws + WS_WBR);
            pg8::EpiBranchF E{(const f16*)(ws + WS_GTL), (f16*)(ws + WS_MBUF)};
            TSTART(24);
            pg8::gemm_phase(F.lds, 2048, 2048, 32, S, E);
            TSTOP(24);
#ifdef PG_DUMMY
            { pg8::EpiF16 E9{(f16*)(ws + WS_ACT), 2048}; pg8::gemm_phase(F.lds, 2048, 2048, 32, S, E9); }
#endif
        }
        SEAM(pb + 6);
        TSTOP(6);
        TSTART(7);
        if (PH_EN(7) && IN(pb + 7)) {
            pg8::SchedPlain S; S.init(MX / 256, 8, F.G, F.bid); S.A = (const char*)(ws + WS_MBUF); S.B = (const char*)(ws + WS_WOUT); S.aTile = (size_t)256 * 2048 * 2; S.bTile = (size_t)256 * 2048 * 2;
            pg8::EpiResid E{(float*)(ws + WS_XRES), modl, 4096};
            pg8::gemm_phase(F.lds, 2048, 2048, 32, S, E);
            if (ctx_on) { pg8::SchedSplit S2{(const char*)(ws + WS_MBUF), (const char*)(ws + WS_WOUT), (size_t)256 * 2048 * 2, (size_t)256 * 2048 * 2, (size_t)8 * 128, 4, F.G, F.bid};
                pg8::EpiSlab E2{(float*)(ws + WS_SLAB), modl, 4096};
                pg8::gemm_phase(F.lds, 2048, 2048, 8, S2, E2); }
        }
        SEAM(pb + 7);
        TSTOP(7);
        TSTART(8);
        if (PH_EN(8) && IN(pb + 8)) { FRESH(); ph_norm(F, AV, l, 1, nrows, 4); }
        SEAM(pb + 8);
        TSTOP(8);
        TSTART(9);
        if (PH_EN(9) && IN(pb + 9)) {
            pg8::SchedPlain S; S.init(nMr, UPLD / 256, F.G, F.bid); S.A = (const char*)(ws + WS_HN); S.B = (const char*)(ws + WS_WUP); S.aTile = (size_t)256 * 2048 * 2; S.bTile = (size_t)256 * 2048 * 2;
            pg8::EpiUpAct E{(f16*)(ws + WS_ACT), (float*)(ws + WS_HALO), AV.in(I_FFCW) + (size_t)l * 3 * FFH, AV.in(I_FFCB) + (size_t)l * FFH, (LAS float*)(F.lds + EXTRA_OFF)};
            pg8::gemm_phase(F.lds, 2048, 2048, 32, S, E);
        }
        SEAM(pb + 9);
        TSTOP(9);
        TSTART(10);
        if (PH_EN(10) && IN(pb + 10)) { FRESH(); ph_ffn_fix(F, AV, l, nMr); }
        SEAM(pb + 10);
        TSTOP(10);
        TSTART(11);
        if (PH_EN(11) && IN(pb + 11)) {
            pg8::SchedPlain S; S.init(MX / 256, 8, F.G, F.bid); S.A = (const char*)(ws + WS_ACT); S.B = (const char*)(ws + WS_WDN); S.aTile = (size_t)256 * FFH * 2; S.bTile = (size_t)256 * FFH * 2;
            pg8::EpiResid E{(float*)(ws + WS_XRES), modl, 10240};
            pg8::gemm_phase(F.lds, FFH, FFH, FFH / 64, S, E);
            if (ctx_on) { pg8::SchedSplit S2{(const char*)(ws + WS_ACT), (const char*)(ws + WS_WDN), (size_t)256 * FFH * 2, (size_t)256 * FFH * 2, (size_t)8 * 128, 11, F.G, F.bid};
                pg8::EpiSlab E2{(float*)(ws + WS_SLAB), modl, 10240};
                pg8::gemm_phase(F.lds, FFH, FFH, 8, S2, E2); }
        }
        SEAM(pb + 11);
        TSTOP(11);
    }
    if (PH_EN(13) && IN(NPH - 1)) { FRESH(); ph_final_norm(F, AV); }
#if STAMP_MASK
    if (blockIdx.x == 0 && threadIdx.x == 0) { const unsigned long long t0 = __builtin_amdgcn_s_memrealtime(); while (__builtin_amdgcn_s_memrealtime() - t0 < (unsigned long long)(STAMP_K) * TS[1]) __builtin_amdgcn_s_sleep(8); }
#endif
#undef IN
#undef SEAM
#undef FRESH
}

extern "C" void kernel_launch(void* const* d_in, const int* in_sizes, int n_in, void* d_out, int out_size, void* d_ws, size_t ws_size, hipStream_t stream) {
    static int grid = 0;
    if (grid == 0) {
        if (n_in != 40 || out_size != MX * D || ws_size < WS_END) { fprintf(stderr, "kernel_launch: unexpected problem (n_in %d out %d ws %zu, need %zu)\n", n_in, out_size, ws_size, (size_t)WS_END); grid = -1; return; }
        int dev = 0, cus = 0, per_cu = 0;
        if (hipGetDevice(&dev) != hipSuccess || hipDeviceGetAttribute(&cus, hipDeviceAttributeMultiprocessorCount, dev) != hipSuccess) { grid = -1; return; }
        if (hipFuncSetAttribute((const void*)mk_fwd, hipFuncAttributeMaxDynamicSharedMemorySize, LDS_BYTES) != hipSuccess) { fprintf(stderr, "kernel_launch: hipFuncSetAttribute failed\n"); grid = -1; return; }
        if (hipOccupancyMaxActiveBlocksPerMultiprocessor(&per_cu, (const void*)mk_fwd, 512, LDS_BYTES) != hipSuccess || per_cu < 1)
            fprintf(stderr, "kernel_launch: occupancy query reports %d\n", per_cu);
        (void)hipGetLastError();
        grid = cus;
    }
    if (grid < 0) return;
    if (hipMemsetAsync((char*)d_ws + WS_CTL, 0, CTL_ZERO_BYTES, stream) != hipSuccess) return;
    Args a{};
    for (int i = 0; i < 40; ++i) a.in[i] = (const float*)d_in[i];
    a.out = (float*)d_out; a.ws = (unsigned char*)d_ws;
#if MK_ONE
    a.ph_lo = 0; a.ph_hi = NPH;
    hipLaunchKernelGGL(mk_fwd, dim3(grid), dim3(512), LDS_BYTES, stream, a);
#else
    for (int p = 0; p < NPH; ++p) { a.ph_lo = p; a.ph_hi = p + 1; hipLaunchKernelGGL(mk_fwd, dim3(grid), dim3(512), LDS_BYTES, stream, a); }
#endif
}
```

```cpp
#include <hip/hip_runtime.h>
#include <stdio.h>

#ifndef MK_ONE
#define MK_ONE 1
#define STAMP_MASK 0
#define STAMP_K 1
#endif

#define GAS __attribute__((address_space(1)))
#define LAS __attribute__((address_space(3)))
typedef _Float16 f16;
typedef _Float16 f16x8 __attribute__((ext_vector_type(8)));
typedef _Float16 f16x4 __attribute__((ext_vector_type(4)));
typedef _Float16 f16x2 __attribute__((ext_vector_type(2)));
typedef float f32x4 __attribute__((ext_vector_type(4)));
typedef float f32x2 __attribute__((ext_vector_type(2)));

constexpr int D = 2048, NB = 2, SEQ = 8192, LC = 256, DEPTH = 4;
constexpr int MX = NB * SEQ, MC = NB * LC, MT = MX + MC;
constexpr int PXLD = 3840, WINN = 11520, FFH = 5632, UPLD = 2 * FFH;
constexpr int P_S5 = 0, P_GK = 512, P_GV = 1024, P_GQ = 2048, P_GR = 2560, P_HY = 3584, P_MG = 5120, P_GG = 3584, W_GG = 11264;
constexpr int INW = 11296;
constexpr int NCHK = 1056;
constexpr float S5SCALE = 1024.f;
constexpr float EPS = 1e-6f;
constexpr int NSC = 33;

constexpr size_t MiB = 1u << 20;
constexpr size_t WS_CTL = 0, CTL_ZERO_BYTES = 1 * MiB;
constexpr size_t WS_MOD = 1 * MiB;
constexpr size_t WS_TW = 2 * MiB;
constexpr size_t WS_S5AT = 3 * MiB;
constexpr size_t WS_WIN = 4 * MiB;
constexpr size_t WS_WGLU = WS_WIN + 45 * MiB;
constexpr size_t WS_WBR = WS_WGLU + 1 * MiB;
constexpr size_t WS_WOUT = WS_WBR + 8 * MiB;
constexpr size_t WS_WUP = WS_WOUT + 8 * MiB;
constexpr size_t WS_WDN = WS_WUP + 44 * MiB;
constexpr size_t WS_S5W = WS_WDN + 22 * MiB;
constexpr size_t WS_S5M = WS_S5W + 8 * MiB;
constexpr size_t WS_H2 = WS_S5M + 4 * MiB;
constexpr size_t WS_FSD = WS_H2 + 3 * MiB;
constexpr size_t FSD_C_OFF = (size_t)2 * 256 * 8193 * 16;
constexpr size_t WS_XRES = WS_FSD + 68 * MiB;
constexpr size_t WS_HN = WS_XRES + 132 * MiB;
constexpr size_t WS_PX = WS_HN + 66 * MiB;
constexpr size_t WS_S5A = WS_PX + 372 * MiB;
constexpr size_t WS_S5S = WS_S5A + 40 * MiB;
constexpr size_t WS_YAPRE = WS_S5S + 40 * MiB;
constexpr size_t WS_YCAT = WS_YAPRE + 20 * MiB;
constexpr size_t WS_MBUF = WS_YCAT + 66 * MiB;
constexpr size_t WS_GSLOC = WS_MBUF + 66 * MiB;
constexpr size_t WS_GSIN = WS_GSLOC + 66 * MiB;
constexpr size_t WS_GOF = WS_GSIN + 66 * MiB;
constexpr size_t WS_GDT = WS_GOF + 66 * MiB;
constexpr size_t WS_ACT = WS_GSLOC;
constexpr size_t WS_ZT = WS_GDT + 1 * MiB;
constexpr size_t WS_YBT = WS_ZT + 50 * MiB;
constexpr size_t WS_SLAB = WS_YBT + 17 * MiB;
constexpr size_t WS_HALO = WS_SLAB + 44 * MiB;
constexpr size_t WS_GTL = WS_HALO + 9 * MiB;
constexpr size_t WS_H2H = WS_GTL + 198 * MiB;
constexpr size_t WS_END = WS_H2H + 2 * MiB;
static_assert((size_t)MT * FFH * 2 <= 198 * MiB, "ACT overlay");
constexpr int CW_BAR = 4096;

constexpr int RING_BYTES = 131072;
constexpr int EXTRA_OFF = RING_BYTES, EXTRA_BYTES = 8192;
constexpr int LDSCTL_OFF = EXTRA_OFF + EXTRA_BYTES;
constexpr int LDS_BYTES = LDSCTL_OFF + 256;

__device__ __forceinline__ float wave_sum(float v) {
#pragma unroll
    for (int o = 1; o < 64; o <<= 1) v += __shfl_xor(v, o);
    return v;
}
__device__ __forceinline__ float sigmoidf_(float x) { return 1.0f / (1.0f + __expf(-x)); }
__device__ __forceinline__ float siluf_(float x) { return x * sigmoidf_(x); }
__device__ __forceinline__ float gelu_tanh_(float x) { const float u = 0.7978845608028654f * (x + 0.044715f * x * x * x); return x / (1.0f + __expf(-2.0f * u)); }
__device__ __forceinline__ float logsigmoidf_(float x) { return fminf(x, 0.f) - __logf(1.0f + __expf(-fabsf(x))); }
__device__ __forceinline__ f32x2 cmul(f32x2 a, f32x2 b) { return (f32x2){a.x * b.x - a.y * b.y, a.x * b.y + a.y * b.x}; }
__device__ __forceinline__ f32x2 cconj(f32x2 a) { return (f32x2){a.x, -a.y}; }
__device__ __forceinline__ int opq(int x) { asm volatile("" : "+v"(x)); return x; }
#define PIN8(a, b, c, d, e, f, g, h) asm volatile("" : "+v"(a), "+v"(b), "+v"(c), "+v"(d), "+v"(e), "+v"(f), "+v"(g), "+v"(h))
#define PIN4(a, b, c, d) asm volatile("" : "+v"(a), "+v"(b), "+v"(c), "+v"(d))
#define LDS_WAIT() asm volatile("s_waitcnt lgkmcnt(0)" ::: "memory")
#define VM_WAIT() asm volatile("s_waitcnt vmcnt(0)" ::: "memory")

#define XB_TMO      128
#define XB_XCNT(j)  (256  + 64 * (j))
#define XB_XSUB(j)  (1280 + 64 * (j))
#define XB_XGEN(j)  (2304 + 64 * (j))
#define XB_TOP      3328
#define XB_TOPGEN   3392
#define XCD_BAR_WORDS 3456
#define XB_SPIN_CAP (1u << 18)
__device__ __forceinline__ unsigned xb_ld(unsigned* p)              { return __hip_atomic_load(p, __ATOMIC_RELAXED, __HIP_MEMORY_SCOPE_AGENT); }
__device__ __forceinline__ unsigned xb_add(unsigned* p, unsigned v) { return __hip_atomic_fetch_add(p, v, __ATOMIC_RELAXED, __HIP_MEMORY_SCOPE_AGENT); }
__device__ __forceinline__ unsigned xb_xcc_id() { return (unsigned)__builtin_amdgcn_s_getreg((3 << 11) | 20) & 0xFu; }
#define XB_SPIN(cond, bar) do { unsigned _sp = 0; while (cond) { __builtin_amdgcn_s_sleep(1); \
    if ((++_sp & 255u) == 0u) { if (xb_ld(&(bar)[XB_TMO])) break; if (_sp > XB_SPIN_CAP) { atomicAdd(&(bar)[XB_TMO], 1u); break; } } } } while (0)
struct XcdBarrier { unsigned* bar; unsigned x; volatile LAS unsigned* st; };
__device__ __forceinline__ XcdBarrier xcd_barrier_post(unsigned* bar, volatile LAS unsigned* st) {
    XcdBarrier b; b.bar = bar; b.x = xb_xcc_id(); b.st = st;
    if (threadIdx.x == 0) (void)xb_add(&bar[XB_XCNT(b.x)], 1u);
    return b;
}
__device__ __forceinline__ void xcd_barrier_complete(unsigned* bar, unsigned x, unsigned& nloc, unsigned& nx) {
    const unsigned G = gridDim.x * gridDim.y * gridDim.z;
    unsigned sum, cnt, mine, sp = 0u;
    for (;;) {
        sum = 0u; cnt = 0u; mine = 0u;
#pragma unroll
        for (unsigned j = 0; j < 16; ++j) { const unsigned c = xb_ld(&bar[XB_XCNT(j)]); sum += c; cnt += (c > 0u) ? 1u : 0u; mine = (j == x) ? c : mine; }
        if (sum == G) break;
        __builtin_amdgcn_s_sleep(1);
        if ((++sp & 255u) == 0u) { if (xb_ld(&bar[XB_TMO])) break; if (sp > XB_SPIN_CAP) { atomicAdd(&bar[XB_TMO], 1u); break; } }
    }
    nloc = mine > 0u ? mine : 1u; nx = cnt > 0u ? cnt : 1u;
}
__device__ __forceinline__ void xcd_barrier(const XcdBarrier& b) {
    asm volatile("s_waitcnt vmcnt(0)" ::: "memory");
    __syncthreads();
    if (threadIdx.x == 0) {
        unsigned* bar = b.bar;
        __builtin_amdgcn_s_waitcnt(0);
        unsigned nloc = b.st[0], nx = b.st[1];
        if (nloc == 0u) { xcd_barrier_complete(bar, b.x, nloc, nx); b.st[0] = nloc; b.st[1] = nx; }
        const unsigned old = xb_add(&bar[XB_XSUB(b.x)], 1u);
        const unsigned gen = old / nloc;
        if (old + 1u == (gen + 1u) * nloc) {
            __builtin_amdgcn_fence(__ATOMIC_RELEASE, "agent");
            asm volatile("s_waitcnt vmcnt(0)" ::: "memory");
            const unsigned og = xb_add(&bar[XB_TOP], 1u);
            const unsigned tg = og / nx;
            if (og + 1u == (tg + 1u) * nx) xb_add(&bar[XB_TOPGEN], 1u);
            else XB_SPIN(xb_ld(&bar[XB_TOPGEN]) == tg, bar);
            __builtin_amdgcn_fence(__ATOMIC_ACQUIRE, "agent");
            xb_add(&bar[XB_XGEN(b.x)], 1u);
            asm volatile("s_waitcnt vmcnt(0)" ::: "memory");
        } else {
            XB_SPIN(xb_ld(&bar[XB_XGEN(b.x)]) == gen, bar);
            __builtin_amdgcn_fence(__ATOMIC_ACQUIRE, "agent");
            asm volatile("s_waitcnt vmcnt(0)" ::: "memory");
        }
    }
    __syncthreads();
}

struct Args {
    const float* in[40];
    float* out; unsigned char* ws;
    int ph_lo, ph_hi;
};
struct ArgsV {
    __device__ __forceinline__ const float* in(int i) const {
        typedef const __attribute__((address_space(4))) unsigned long long* kp_t;
        kp_t ka = (kp_t)__builtin_amdgcn_kernarg_segment_ptr();
        return (const float*)(*(volatile const __attribute__((address_space(4))) unsigned long long*)(ka + i)); }
    float* out;
};
struct Ctx {
    LAS unsigned char* lds;
    int tid, lane, wave, G, bid;
    unsigned char* ws;
};
enum { I_X = 0, I_C, I_CTX, I_CCTX, I_WMOD, I_BMOD, I_N1G, I_N2G, I_WIN, I_S5ARE, I_S5AIM, I_S5STEP, I_S5BRE, I_S5BIM, I_S5CRE, I_S5CIM,
       I_S5D, I_GLUW, I_GLUB, I_HYCW, I_HYCB, I_HYW1, I_HYB1, I_HYF1, I_HYW2, I_HYB2, I_HYF2, I_HYW3, I_HYB3, I_HYBIAS,
       I_GLAWG, I_GLABG, I_GLANG, I_WBR, I_WOUT, I_WUP, I_FFCW, I_FFCB, I_WDN, I_FNG };

namespace pg8 {
constexpr int BM = 256, BK = 64, HALF = 128, HTB = HALF * BK * 2, STAGE_BYTES = 8 * HTB, NXCD = 8, WGM = 8;
__device__ __forceinline__ int lds_byte(int r, int c) { const int st = (r >> 4) * 2 + (c >> 5), rr = r & 15, cc = c & 31, ob = rr * 64 + cc * 2; return st * 1024 + (ob ^ (((ob >> 9) & 1) << 5)); }
__device__ __forceinline__ void stage_rc(int b, int& R, int& C) { const int st = b / 1024, sb = b % 1024, swz = sb ^ (((sb >> 9) & 1) << 5); R = (st >> 1) * 16 + swz / 64; C = (st & 1) * 32 + (swz % 64) / 2; }
__device__ __forceinline__ int perm32(int rho) { const int n = rho >> 4, i = rho & 15; return 8 * (i >> 2) + 4 * n + (i & 3); }
struct Unit { const char* a; const char* b; int pm, pn; };
struct Order2D {
    int nM, nN, nwg, G, c;
    __device__ __forceinline__ void init(int nM_, int nN_, int G_, int c_) { nM = nM_; nN = nN_; nwg = nM * nN; G = G_; c = c_; }
    __device__ __forceinline__ bool nx(int i, int& pm, int& pn) const {
        const long L = (long)i * G + c; if (L >= nwg) return false;
        int wgid = (int)L; { const int q = nwg / NXCD, r = nwg % NXCD, xcd = wgid % NXCD, off = wgid / NXCD; wgid = (xcd < r ? xcd * (q + 1) : r * (q + 1) + (xcd - r) * q) + off; }
        const int nig = WGM * nN, gid = wgid / nig, fm = gid * WGM, gsz = (nM - fm) < WGM ? (nM - fm) : WGM;
        pm = fm + ((wgid % nig) % gsz); pn = (wgid % nig) / gsz; return true;
    }
};
struct SchedPlain : Order2D {
    const char* A; const char* B; size_t aTile, bTile;
    __device__ __forceinline__ bool next(int i, Unit& u) const { int pm, pn; if (!nx(i, pm, pn)) return false; u.pm = pm; u.pn = pn; u.a = A + (size_t)pm * aTile; u.b = B + (size_t)pn * bTile; return true; }
};
struct SchedSplit {
    const char* A; const char* B; size_t aTile, bTile, ksub; int nsplit, G, c;
    __device__ __forceinline__ bool next(int i, Unit& u) const { const int L = i * G + c; if (L >= 16 * nsplit) return false; const int t = L / nsplit, ks = L % nsplit, pm = 64 + (t >> 3), pn = t & 7;
        u.pm = pm; u.pn = pn | (ks << 8); u.a = A + (size_t)pm * aTile + (size_t)ks * ksub; u.b = B + (size_t)pn * bTile + (size_t)ks * ksub; return true; }
};
struct SchedS5 {
    const char* A; const char* B; size_t bGroup; int G, c;
    __device__ __forceinline__ bool next(int i, Unit& u) const { const int L = i * G + c; if (L >= 160) return false; const int g = L & 31, pm = L >> 5;
        u.pm = pm; u.pn = g; u.a = A + ((size_t)pm * 256 * 16384 + (size_t)g * 512) * 2; u.b = B + (size_t)g * bGroup; return true; }
};

#define PG8_SA(b, h) (((b) * 2 + (h)) * HTB)
#define PG8_SB(b, h) ((4 + (b) * 2 + (h)) * HTB)
#define PG8_STAGE(bufoff, gbase, voff) do { _Pragma("unroll") for (int _i = 0; _i < 2; ++_i) \
        __builtin_amdgcn_global_load_lds((const unsigned*)((const char*)(gbase) + (voff)[_i]), (LAS unsigned*)(lds + (bufoff) + ldsw + _i * 8192), 16, 0, 0); } while (0)
#define PG8_LDA(dst, b, h) do { _Pragma("unroll") for (int m = 0; m < 4; ++m) _Pragma("unroll") for (int k = 0; k < 2; ++k) dst[m][k] = *(const LAS f16x8*)(lds + PG8_SA(b, h) + aoff + m * 2048 + k * 1024); } while (0)
#define PG8_LDB(dst, b, h) do { _Pragma("unroll") for (int n = 0; n < 2; ++n) _Pragma("unroll") for (int k = 0; k < 2; ++k) dst[n][k] = *(const LAS f16x8*)(lds + PG8_SB(b, h) + boff + n * 2048 + k * 1024); } while (0)
#define PG8_MMA(ai, bj, At, Bt) do { __builtin_amdgcn_s_setprio(1); _Pragma("unroll") for (int m = 0; m < 4; ++m) _Pragma("unroll") for (int n = 0; n < 2; ++n) _Pragma("unroll") for (int k = 0; k < 2; ++k) \
        acc[ai][bj][m][n] = __builtin_amdgcn_mfma_f32_16x16x32_f16(Bt[n][k], At[m][k], acc[ai][bj][m][n], 0, 0, 0); __builtin_amdgcn_s_setprio(0); } while (0)
#define PG8_WAIT_V(n) asm volatile("s_waitcnt vmcnt(" #n ")" ::: "memory")
#define PG8_WAIT_L(n) asm volatile("s_waitcnt lgkmcnt(" #n ")" ::: "memory")
#define PG8_BAR __builtin_amdgcn_s_barrier()
#define PG8_SCHED __builtin_amdgcn_sched_barrier(0)

template <class Epi, class Sched>
__device__ __forceinline__ void gemm_phase(LAS unsigned char* lds, const int lda, const int ldb, const int nt, const Sched& S, const Epi& E) {
    const int tid = opq((int)threadIdx.x), wid = __builtin_amdgcn_readfirstlane(tid >> 6), lane = tid & 63, wr = wid >> 2, wc = wid & 3, fr = lane & 15, fq = lane >> 4;
    unsigned voffA[2], voffB[2];
#pragma unroll
    for (int i = 0; i < 2; ++i) { int R, C; stage_rc(tid * 16 + i * 8192, R, C); const int Rb = Epi::PERM ? ((R & ~31) + perm32(R & 31)) : R;
        voffA[i] = (unsigned)(R * lda + C) * 2u; voffB[i] = (unsigned)(Rb * ldb + C) * 2u; }
    const size_t kstep = (size_t)(BK * 2);
    const size_t hstepA = (size_t)HALF * lda * 2, hstepB = (size_t)HALF * ldb * 2;
    const unsigned ldsw = (unsigned)wid * 1024u;
    const int aoff = lds_byte(wr * 64 + fr, fq * 8), boff = lds_byte(wc * 32 + fr, fq * 8);
    Unit cur, nxt; int ui = 0;
    if (!S.next(0, cur)) return;
    f32x4 acc[2][2][4][2];
#pragma unroll
    for (int a = 0; a < 2; ++a)
#pragma unroll
        for (int b = 0; b < 2; ++b)
#pragma unroll
            for (int m = 0; m < 4; ++m)
#pragma unroll
                for (int n = 0; n < 2; ++n) acc[a][b][m][n] = (f32x4){0.f, 0.f, 0.f, 0.f};
    f16x8 At[4][2], B0[2][2], B1[2][2];
    const char* cA = cur.a; const char* cB = cur.b;
    PG8_STAGE(PG8_SB(0, 0), cB, voffB); PG8_STAGE(PG8_SA(0, 0), cA, voffA); PG8_STAGE(PG8_SB(0, 1), cB + hstepB, voffB); PG8_STAGE(PG8_SA(0, 1), cA + hstepA, voffA);
    if (wr == 1) PG8_BAR;
    PG8_WAIT_V(4); PG8_BAR;
    PG8_STAGE(PG8_SB(1, 0), cB + kstep, voffB); PG8_STAGE(PG8_SA(1, 0), cA + kstep, voffA); PG8_STAGE(PG8_SB(1, 1), cB + hstepB + kstep, voffB);
    PG8_WAIT_V(6); PG8_BAR;
    for (;;) {
        const bool has_next = S.next(ui + 1, nxt);
        const char* nA = has_next ? nxt.a : cA; const char* nB = has_next ? nxt.b : cB;
        constexpr int NSEG = Epi::HAS_MID ? 3 : 1;
#pragma unroll
        for (int seg = 0; seg < NSEG; ++seg) {
        const int tb = Epi::HAS_MID ? (seg == 0 ? 0 : (seg == 1 ? Epi::MID1 + 2 : Epi::MID2 + 2)) : 0;
        const int te = Epi::HAS_MID ? (seg == 0 ? Epi::MID1 + 2 : (seg == 1 ? Epi::MID2 + 2 : nt)) : nt;
        for (int t = tb; t < te; t += 2) {
            const bool last = (t == nt - 2);
            const char* a1 = cA + (size_t)(t + 1) * kstep;
            const char* a2 = last ? nA : cA + (size_t)(t + 2) * kstep; const char* b2 = last ? nB : cB + (size_t)(t + 2) * kstep;
            const char* a3 = a2 + kstep; const char* b3 = b2 + kstep;
            PG8_LDB(B0, 0, 0); PG8_SCHED; PG8_LDA(At, 0, 0); PG8_STAGE(PG8_SA(1, 1), a1 + hstepA, voffA);
            PG8_WAIT_L(8); PG8_BAR; PG8_WAIT_L(0); PG8_MMA(0, 0, At, B0); PG8_BAR; PG8_SCHED;
            PG8_LDB(B1, 0, 1); PG8_STAGE(PG8_SB(0, 0), b2, voffB);
            PG8_BAR; PG8_WAIT_L(0); PG8_MMA(0, 1, At, B1); PG8_BAR;
            PG8_LDA(At, 0, 1); PG8_STAGE(PG8_SA(0, 0), a2, voffA);
            PG8_BAR; PG8_WAIT_L(0); PG8_MMA(1, 0, At, B0); PG8_BAR; PG8_SCHED;
            PG8_STAGE(PG8_SB(0, 1), b2 + hstepB, voffB);
            PG8_WAIT_V(6); PG8_BAR; PG8_MMA(1, 1, At, B1); PG8_BAR;
            PG8_LDB(B0, 1, 0); PG8_SCHED; PG8_LDA(At, 1, 0); PG8_STAGE(PG8_SA(0, 1), a2 + hstepA, voffA);
            PG8_WAIT_L(8); PG8_BAR; PG8_WAIT_L(0); PG8_MMA(0, 0, At, B0); PG8_BAR; PG8_SCHED;
            PG8_LDB(B1, 1, 1); PG8_STAGE(PG8_SB(1, 0), b3, voffB);
            PG8_BAR; PG8_WAIT_L(0); PG8_MMA(0, 1, At, B1); PG8_BAR;
            PG8_LDA(At, 1, 1); PG8_STAGE(PG8_SA(1, 0), a3, voffA);
            PG8_BAR; PG8_WAIT_L(0); PG8_MMA(1, 0, At, B0); PG8_BAR; PG8_SCHED;
            PG8_STAGE(PG8_SB(1, 1), b3 + hstepB, voffB);
            PG8_WAIT_V(6); PG8_BAR; PG8_MMA(1, 1, At, B1); PG8_BAR;
        }
        if constexpr (Epi::HAS_MID) { if (seg < 2) {
            E.mid(acc, cur, seg, wr, wc, fr, fq);
        } }
        }
#if STAMP_MASK & (1 << 23)
        if (Epi::HAS_MID && blockIdx.x == 0 && threadIdx.x == 0) ((volatile LAS unsigned long long*)(lds + LDSCTL_OFF + 128))[0] = __builtin_amdgcn_s_memrealtime();
#endif
        E(acc, cur, wr, wc, fr, fq);
#if STAMP_MASK & (1 << 23)
        if (Epi::HAS_MID && blockIdx.x == 0 && threadIdx.x == 0) { volatile LAS unsigned long long* TS = (volatile LAS unsigned long long*)(lds + LDSCTL_OFF + 128); TS[1] = TS[1] + (__builtin_amdgcn_s_memrealtime() - TS[0]); }
#endif
        if (!has_next) break;
#pragma unroll
        for (int a = 0; a < 2; ++a)
#pragma unroll
            for (int b = 0; b < 2; ++b)
#pragma unroll
                for (int m = 0; m < 4; ++m)
#pragma unroll
                    for (int n = 0; n < 2; ++n) acc[a][b][m][n] = (f32x4){0.f, 0.f, 0.f, 0.f};
        cur = nxt; cA = nA; cB = nB; ++ui;
    }
    PG8_WAIT_V(0);
    if (wr == 0) PG8_BAR;
    PG8_BAR;
}
#undef PG8_SA
#undef PG8_SB
#undef PG8_STAGE
#undef PG8_LDA
#undef PG8_LDB
#undef PG8_MMA
#undef PG8_WAIT_V
#undef PG8_WAIT_L
#undef PG8_BAR
#undef PG8_SCHED

typedef const f32x4 (&AccRef)[2][2][4][2];
__device__ __forceinline__ f16x8 pack8(f32x4 a, f32x4 b) { f16x8 w; w[0] = (f16)a[0]; w[1] = (f16)a[1]; w[2] = (f16)a[2]; w[3] = (f16)a[3]; w[4] = (f16)b[0]; w[5] = (f16)b[1]; w[6] = (f16)b[2]; w[7] = (f16)b[3]; return w; }

struct EpiPx {
    static constexpr bool PERM = true, HAS_MID = false; static constexpr int MID1 = 0, MID2 = 0; f16* PX; f16* S5A; f16* ZT; f16* GTL;
    __device__ __forceinline__ void operator()(AccRef acc, const Unit& u, int wr, int wc, int fr, int fq) const { fr = opq(fr); fq = opq(fq);
        const int row0 = u.pm * BM + wr * 64 + fr, col0 = u.pn * BM + wc * 32 + 8 * fq;
#pragma unroll
        for (int ai = 0; ai < 2; ++ai)
#pragma unroll
            for (int m = 0; m < 4; ++m) { const int row = row0 + ai * HALF + m * 16;
#pragma unroll
                for (int bj = 0; bj < 2; ++bj) { const int c = col0 + bj * HALF; const f16x8 w = pack8(acc[ai][bj][m][0], acc[ai][bj][m][1]);
                    if (u.pn < 2) *(f16x8*)(S5A + (size_t)(row >> 4) * 16384 + (size_t)(c >> 4) * 512 + (row & 15) * 16 + (c & 15)) = w;
                    else if (u.pn >= 14 && u.pn < 20) {
#pragma unroll
                        for (int j = 0; j < 8; ++j) ZT[(size_t)(c - P_HY + j) * MT + row] = w[j]; }
                    else if (u.pn >= 20 && u.pn < 44) *(f16x8*)(GTL + ((size_t)(u.pn - 20) * 66 + u.pm) * 65536 + (size_t)(row - u.pm * BM) * 256 + (c - u.pn * BM)) = w;
                    else { const int pr = row < MX ? (row & ~8191) + ((row & 63) << 7) + ((row & 8191) >> 6) : row;
                        *(f16x8*)(PX + (size_t)pr * PXLD + (u.pn == 44 ? c - (W_GG - P_GG) : c)) = w; } } }
    }
};
struct EpiF16 {
    static constexpr bool PERM = true, HAS_MID = false; static constexpr int MID1 = 0, MID2 = 0; f16* O; int ldc;
    __device__ __forceinline__ void operator()(AccRef acc, const Unit& u, int wr, int wc, int fr, int fq) const { fr = opq(fr); fq = opq(fq);
        const int row0 = u.pm * BM + wr * 64 + fr, col0 = u.pn * BM + wc * 32 + 8 * fq;
#pragma unroll
        for (int ai = 0; ai < 2; ++ai)
#pragma unroll
            for (int m = 0; m < 4; ++m) { f16* rowp = O + (size_t)(row0 + ai * HALF + m * 16) * ldc + col0;
#pragma unroll
                for (int bj = 0; bj < 2; ++bj) *(f16x8*)(rowp + bj * HALF) = pack8(acc[ai][bj][m][0], acc[ai][bj][m][1]); }
    }
};
struct EpiS5In {
    static constexpr bool PERM = false, HAS_MID = false; static constexpr int MID1 = 0, MID2 = 0; float* S;
    __device__ __forceinline__ void operator()(AccRef acc, const Unit& u, int wr, int wc, int fr, int fq) const { fr = opq(fr); fq = opq(fq);
        const int row0 = u.pm * BM + wr * 64 + fr, col0 = wc * 32 + 4 * fq, g = u.pn;
#pragma unroll
        for (int ai = 0; ai < 2; ++ai)
#pragma unroll
            for (int m = 0; m < 4; ++m) { const int row = row0 + ai * HALF + m * 16; { float* rowp = S + ((size_t)row * 32 + g) * 256 + col0;
#pragma unroll
                for (int bj = 0; bj < 2; ++bj)
#pragma unroll
                    for (int n = 0; n < 2; ++n) *(f32x4*)(rowp + bj * HALF + n * 16) = acc[ai][bj][m][n]; } }
    }
};
struct EpiS5Out {
    static constexpr bool PERM = true, HAS_MID = false; static constexpr int MID1 = 0, MID2 = 0; const f16* S5A; f16* Y; const float* dvec;
    __device__ __forceinline__ void operator()(AccRef acc, const Unit& u, int wr, int wc, int fr, int fq) const { fr = opq(fr); fq = opq(fq);
        const int row0 = u.pm * BM + wr * 64 + fr, col0 = wc * 32 + 8 * fq, g = u.pn;
        const int h0 = col0 & 15;
        const f32x4 d0 = *(const f32x4*)(dvec + g * 16 + h0), d1 = *(const f32x4*)(dvec + g * 16 + h0 + 4);
#pragma unroll
        for (int ai = 0; ai < 2; ++ai) { f16x8 uu[4][2];
#pragma unroll
            for (int m = 0; m < 4; ++m)
#pragma unroll
                for (int bj = 0; bj < 2; ++bj) uu[m][bj] = *(const f16x8*)(S5A + (size_t)(row0 + ai * HALF + m * 16) * 16384 + (size_t)g * 512 + col0 + bj * HALF);
            PIN8(uu[0][0], uu[0][1], uu[1][0], uu[1][1], uu[2][0], uu[2][1], uu[3][0], uu[3][1]);
#pragma unroll
            for (int m = 0; m < 4; ++m) { const int chunk = row0 + ai * HALF + m * 16;
#pragma unroll
                for (int bj = 0; bj < 2; ++bj) { const int c = col0 + bj * HALF, t = c >> 4; f16x8 w;
#pragma unroll
                    for (int j = 0; j < 4; ++j) { w[j] = (f16)gelu_tanh_(acc[ai][bj][m][0][j] * (1.0f / S5SCALE) + d0[j] * (float)uu[m][bj][j]);
                                                  w[4 + j] = (f16)gelu_tanh_(acc[ai][bj][m][1][j] * (1.0f / S5SCALE) + d1[j] * (float)uu[m][bj][4 + j]); }
                    *(f16x8*)(Y + (size_t)(chunk * 16 + t) * 512 + g * 16 + h0) = w; } }
            asm volatile("" ::: "memory"); }
    }
};
struct EpiGlu {
    static constexpr bool PERM = true, HAS_MID = false; static constexpr int MID1 = 0, MID2 = 0; const f16* YP; f16* O; const float* bias;
    __device__ __forceinline__ void operator()(AccRef acc, const Unit& u, int wr, int wc, int fr, int fq) const { fr = opq(fr); fq = opq(fq);
        const int row0 = u.pm * BM + wr * 64 + fr, col0 = u.pn * BM + wc * 32 + 8 * fq;
        f32x4 bv[2][2];
#pragma unroll
        for (int bj = 0; bj < 2; ++bj) { bv[bj][0] = *(const f32x4*)(bias + col0 + bj * HALF); bv[bj][1] = *(const f32x4*)(bias + col0 + bj * HALF + 4); }
#pragma unroll
        for (int ai = 0; ai < 2; ++ai) { f16x8 yp[4][2];
#pragma unroll
            for (int m = 0; m < 4; ++m)
#pragma unroll
                for (int bj = 0; bj < 2; ++bj) yp[m][bj] = *(const f16x8*)(YP + (size_t)(row0 + ai * HALF + m * 16) * 512 + col0 + bj * HALF);
            PIN8(yp[0][0], yp[0][1], yp[1][0], yp[1][1], yp[2][0], yp[2][1], yp[3][0], yp[3][1]);
#pragma unroll
            for (int m = 0; m < 4; ++m)
#pragma unroll
                for (int bj = 0; bj < 2; ++bj) { f16x8 w;
#pragma unroll
                    for (int j = 0; j < 4; ++j) { w[j] = (f16)((float)yp[m][bj][j] * sigmoidf_(acc[ai][bj][m][0][j] + bv[bj][0][j])); w[4 + j] = (f16)((float)yp[m][bj][4 + j] * sigmoidf_(acc[ai][bj][m][1][j] + bv[bj][1][j])); }
                    *(f16x8*)(O + (size_t)(row0 + ai * HALF + m * 16) * 2048 + col0 + bj * HALF) = w; }
            asm volatile("" ::: "memory"); }
    }
};
template <int BR> struct EpiBranch {
    static constexpr bool PERM = true, HAS_MID = false; static constexpr int MID1 = 0, MID2 = 0; const f16* PX; f16* M;
    __device__ __forceinline__ void operator()(AccRef acc, const Unit& u, int wr, int wc, int fr, int fq) const { fr = opq(fr); fq = opq(fq);
        const int row0 = u.pm * BM + wr * 64 + fr, col0 = u.pn * BM + wc * 32 + 8 * fq;
#pragma unroll
        for (int ai = 0; ai < 2; ++ai)
#pragma unroll
            for (int m = 0; m < 4; ++m) { const int row = row0 + ai * HALF + m * 16;
#pragma unroll
                for (int bj = 0; bj < 2; ++bj) { const int c = col0 + bj * HALF;
                    const f16x8 gl = *(const f16x8*)(PX + (size_t)row * PXLD + P_MG + BR * 2048 + c);
                    f16* mp = M + (size_t)row * 2048 + c;
                    f16x8 prev; if (BR > 0) prev = *(const f16x8*)mp;
                    f16x8 w;
#pragma unroll
                    for (int j = 0; j < 4; ++j) { float v0 = sigmoidf_((float)gl[j]) * acc[ai][bj][m][0][j], v1 = sigmoidf_((float)gl[4 + j]) * acc[ai][bj][m][1][j];
                        if (BR > 0) { v0 += (float)prev[j]; v1 += (float)prev[4 + j]; } w[j] = (f16)v0; w[4 + j] = (f16)v1; }
                    *(f16x8*)mp = w; } asm volatile("" ::: "memory"); }
    }
};
typedef f32x4 (&AccMut)[2][2][4][2];

struct EpiBranchF {
    static constexpr bool PERM = true, HAS_MID = true; static constexpr int MID1 = 6, MID2 = 14;
    const f16* GTL; f16* M;
    __device__ __forceinline__ void mid(AccMut acc, const Unit& u, int seg, int wr, int wc, int fr, int fq) const { fr = opq(fr); fq = opq(fq);
        const int lrow0 = wr * 64 + fr, lcol0 = wc * 32 + 8 * fq;
        const f16* ga = GTL + ((size_t)((seg == 0 ? 0 : 8) + u.pn) * 66 + u.pm) * 65536; const f16* gb = ga + (size_t)8 * 66 * 65536;
#pragma unroll
        for (int ai = 0; ai < 2; ++ai) { f16x8 za[4][2], zb[4][2];
#pragma unroll
            for (int m = 0; m < 4; ++m)
#pragma unroll
                for (int bj = 0; bj < 2; ++bj) { const int off = (lrow0 + ai * HALF + m * 16) * 256 + lcol0 + bj * HALF; za[m][bj] = *(const f16x8*)(ga + off); zb[m][bj] = *(const f16x8*)(gb + off); }
            PIN8(za[0][0], za[0][1], za[1][0], za[1][1], za[2][0], za[2][1], za[3][0], za[3][1]); PIN8(zb[0][0], zb[0][1], zb[1][0], zb[1][1], zb[2][0], zb[2][1], zb[3][0], zb[3][1]);
#pragma unroll
            for (int m = 0; m < 4; ++m)
#pragma unroll
                for (int bj = 0; bj < 2; ++bj)
#pragma unroll
                    for (int j = 0; j < 4; ++j) { acc[ai][bj][m][0][j] *= (1.0f + __expf(-(float)zb[m][bj][j])) * __builtin_amdgcn_rcpf(1.0f + __expf(-(float)za[m][bj][j]));
                                                  acc[ai][bj][m][1][j] *= (1.0f + __expf(-(float)zb[m][bj][4 + j])) * __builtin_amdgcn_rcpf(1.0f + __expf(-(float)za[m][bj][4 + j])); }
            asm volatile("" ::: "memory"); }
    }
    __device__ __forceinline__ void operator()(AccRef acc, const Unit& u, int wr, int wc, int fr, int fq) const { fr = opq(fr); fq = opq(fq);
        const int row0 = u.pm * BM + wr * 64 + fr, col0 = u.pn * BM + wc * 32 + 8 * fq;
#pragma unroll
        for (int ai = 0; ai < 2; ++ai) { f16x8 gl[4][2];
#pragma unroll
            for (int m = 0; m < 4; ++m)
#pragma unroll
                for (int bj = 0; bj < 2; ++bj) gl[m][bj] = *(const f16x8*)(GTL + ((size_t)(16 + u.pn) * 66 + u.pm) * 65536 + (wr * 64 + fr + ai * HALF + m * 16) * 256 + wc * 32 + 8 * fq + bj * HALF);
            PIN8(gl[0][0], gl[0][1], gl[1][0], gl[1][1], gl[2][0], gl[2][1], gl[3][0], gl[3][1]);
#pragma unroll
            for (int m = 0; m < 4; ++m)
#pragma unroll
                for (int bj = 0; bj < 2; ++bj) { f16x8 w;
#pragma unroll
                    for (int j = 0; j < 4; ++j) { w[j] = (f16)(sigmoidf_((float)gl[m][bj][j]) * acc[ai][bj][m][0][j]); w[4 + j] = (f16)(sigmoidf_((float)gl[m][bj][4 + j]) * acc[ai][bj][m][1][j]); }
                    *(f16x8*)(M + (size_t)(row0 + ai * HALF + m * 16) * 2048 + col0 + bj * HALF) = w; }
            asm volatile("" ::: "memory"); }
    }
};
struct EpiUpAct {
    static constexpr bool PERM = true, HAS_MID = false; static constexpr int MID1 = 0, MID2 = 0; f16* ACT; float* HALO; const float* cw; const float* cb; LAS float* HL;
    __device__ __forceinline__ void operator()(AccRef acc, const Unit& u, int wr, int wc, int fr, int fq) const { fr = opq(fr); fq = opq(fq);
        const int lane = fq * 16 + fr;
#pragma unroll
        for (int ai = 0; ai < 2; ++ai) { LAS float* hp = HL + ((ai * 2 + wr) * 4 + wc) * 64 + 8 * fq;
            if (fr == 0) { *(LAS f32x4*)(hp) = acc[ai][0][0][0]; *(LAS f32x4*)(hp + 4) = acc[ai][0][0][1]; }
            if (fr == 15) { *(LAS f32x4*)(hp + 32) = acc[ai][0][3][0]; *(LAS f32x4*)(hp + 36) = acc[ai][0][3][1]; } }
        { float* gh = HALO + ((size_t)u.pm * 44 + u.pn) * 768 + wc * 32 + 8 * fq;
          if (wr == 0 && fr < 2) { *(f32x4*)(gh + fr * 128) = acc[0][0][0][0]; *(f32x4*)(gh + fr * 128 + 4) = acc[0][0][0][1]; }
          if (wr == 0 && fr == 0) { *(f32x4*)(gh + 4 * 128) = acc[0][1][0][0]; *(f32x4*)(gh + 4 * 128 + 4) = acc[0][1][0][1]; }
          if (wr == 1 && fr >= 14) { *(f32x4*)(gh + (fr - 12) * 128) = acc[1][0][3][0]; *(f32x4*)(gh + (fr - 12) * 128 + 4) = acc[1][0][3][1]; }
          if (wr == 1 && fr == 15) { *(f32x4*)(gh + 5 * 128) = acc[1][1][3][0]; *(f32x4*)(gh + 5 * 128 + 4) = acc[1][1][3][1]; } }
        asm volatile("s_waitcnt lgkmcnt(0)" ::: "memory"); __builtin_amdgcn_s_barrier(); __builtin_amdgcn_s_barrier(); asm volatile("" ::: "memory");
        const int colg = u.pn * 128 + wc * 32 + 8 * fq;
        const int srcR = (lane & 48) | ((fr + 15) & 15), srcL = (lane & 48) | ((fr + 1) & 15);
        const int row0 = u.pm * BM + wr * 64 + fr;
#pragma unroll
        for (int n = 0; n < 2; ++n) {
            const f32x4 w0 = *(const f32x4*)(cw + colg + 4 * n), w1 = *(const f32x4*)(cw + FFH + colg + 4 * n), w2 = *(const f32x4*)(cw + 2 * FFH + colg + 4 * n), bb = *(const f32x4*)(cb + colg + 4 * n);
#pragma unroll
            for (int ai = 0; ai < 2; ++ai) {
                const bool hasp = (wr == 1) || (ai == 1), hasn = (wr == 0) || (ai == 0);
                const LAS float* pp = HL + (((wr == 1 ? ai : 0) * 2 + (wr == 1 ? 0 : 1)) * 4 + wc) * 64 + 32 + 8 * fq + 4 * n;
                const LAS float* np = HL + (((wr == 0 ? ai : 1) * 2 + (wr == 0 ? 1 : 0)) * 4 + wc) * 64 + 8 * fq + 4 * n;
                const f32x4 hprev = hasp ? *(const LAS f32x4*)pp : (f32x4){0.f, 0.f, 0.f, 0.f}, hnext = hasn ? *(const LAS f32x4*)np : (f32x4){0.f, 0.f, 0.f, 0.f};
                f32x4 R[4], L[4];
#pragma unroll
                for (int m = 0; m < 4; ++m)
#pragma unroll
                    for (int j = 0; j < 4; ++j) { R[m][j] = __shfl(acc[ai][0][m][n][j], srcR); L[m][j] = __shfl(acc[ai][0][m][n][j], srcL); }
#pragma unroll
                for (int m = 0; m < 4; ++m) { const f32x4 pv = fr > 0 ? R[m] : (m > 0 ? R[m > 0 ? m - 1 : 0] : hprev); const f32x4 nv = fr < 15 ? L[m] : (m < 3 ? L[m < 3 ? m + 1 : 3] : hnext);
                    const f32x4 a = w0 * pv + w1 * acc[ai][0][m][n] + w2 * nv + bb;
                    f16x4 o;
#pragma unroll
                    for (int j = 0; j < 4; ++j) o[j] = (f16)(siluf_(a[j]) * acc[ai][1][m][n][j]);
                    *(f16x4*)(ACT + (size_t)(row0 + ai * HALF + m * 16) * FFH + colg + 4 * n) = o; }
                asm volatile("" ::: "memory");
            }
        }
    }
};
struct EpiSlab {
    static constexpr bool PERM = false, HAS_MID = false; static constexpr int MID1 = 0, MID2 = 0; float* slab; const float* mod; int goff;
    __device__ __forceinline__ void operator()(AccRef acc, const Unit& u, int wr, int wc, int fr, int fq) const { fr = opq(fr); fq = opq(fq);
        const int pn = u.pn & 255, ks = u.pn >> 8;
        const int row0 = (u.pm - 64) * BM + wr * 64 + fr, col0 = pn * BM + wc * 32 + 4 * fq;
        const float* gp = mod + 2 * 12288 + goff + col0;
        f32x4 gv[2][2];
#pragma unroll
        for (int bj = 0; bj < 2; ++bj)
#pragma unroll
            for (int n = 0; n < 2; ++n) gv[bj][n] = *(const f32x4*)(gp + bj * HALF + n * 16);
        float* sp = slab + (size_t)ks * MC * D;
#pragma unroll
        for (int ai = 0; ai < 2; ++ai)
#pragma unroll
            for (int m = 0; m < 4; ++m) { float* rowp = sp + (size_t)(row0 + ai * HALF + m * 16) * D + col0;
#pragma unroll
                for (int bj = 0; bj < 2; ++bj)
#pragma unroll
                    for (int n = 0; n < 2; ++n) *(f32x4*)(rowp + bj * HALF + n * 16) = gv[bj][n] * acc[ai][bj][m][n]; }
    }
};
struct EpiResid {
    static constexpr bool PERM = false, HAS_MID = false; static constexpr int MID1 = 0, MID2 = 0; float* X; const float* mod; int goff;
    __device__ __forceinline__ void operator()(AccRef acc, const Unit& u, int wr, int wc, int fr, int fq) const { fr = opq(fr); fq = opq(fq);
        const int row0 = u.pm * BM + wr * 64 + fr, col0 = u.pn * BM + wc * 32 + 4 * fq;
        const int bsel = u.pm < 32 ? 0 : (u.pm < 64 ? 1 : 2);
        const float* gp = mod + bsel * 12288 + goff + col0;
        f32x4 gv[2][2];
#pragma unroll
        for (int bj = 0; bj < 2; ++bj)
#pragma unroll
            for (int n = 0; n < 2; ++n) gv[bj][n] = *(const f32x4*)(gp + bj * HALF + n * 16);
#pragma unroll
        for (int ai = 0; ai < 2; ++ai)
#pragma unroll
            for (int mp = 0; mp < 2; ++mp) { f32x4 xv[2][2][2];
#pragma unroll
                for (int mm = 0; mm < 2; ++mm) { const float* rowp = X + (size_t)(row0 + ai * HALF + (2 * mp + mm) * 16) * D + col0;
#pragma unroll
                    for (int bj = 0; bj < 2; ++bj)
#pragma unroll
                        for (int n = 0; n < 2; ++n) xv[mm][bj][n] = *(const f32x4*)(rowp + bj * HALF + n * 16); }
                PIN8(xv[0][0][0], xv[0][0][1], xv[0][1][0], xv[0][1][1], xv[1][0][0], xv[1][0][1], xv[1][1][0], xv[1][1][1]);
#pragma unroll
                for (int mm = 0; mm < 2; ++mm) { float* rowp = X + (size_t)(row0 + ai * HALF + (2 * mp + mm) * 16) * D + col0;
#pragma unroll
                    for (int bj = 0; bj < 2; ++bj)
#pragma unroll
                        for (int n = 0; n < 2; ++n) *(f32x4*)(rowp + bj * HALF + n * 16) = xv[mm][bj][n] + gv[bj][n] * acc[ai][bj][2 * mp + mm][n]; }
                asm volatile("" ::: "memory"); }
    }
};
}


__device__ __forceinline__ void ph_prologue(const Ctx& F, const ArgsV& AV) {
    const int gt = F.bid * 512 + F.tid, NT = F.G * 512;
    { const f32x4* xs = (const f32x4*)AV.in(I_X); const f32x4* cs = (const f32x4*)AV.in(I_CTX); f32x4* xr = (f32x4*)(F.ws + WS_XRES);
      for (int i = gt; i < MX * D / 4; i += NT) xr[i] = xs[i];
      for (int i = gt; i < MC * D / 4; i += NT) xr[MX * D / 4 + i] = cs[i]; }
    { f32x2* tw = (f32x2*)(F.ws + WS_TW);
      for (int k = gt; k < 16384; k += NT) { float s, c; sincospif((float)k * (2.0f / 16384.0f), &s, &c); tw[k] = (f32x2){c, -s}; } }
    LAS float* sc = (LAS float*)F.lds;
    LAS float* red = (LAS float*)(F.lds + 3 * 2048 * 4);
    for (int i = F.tid; i < 3 * 2048; i += 512) { const int r = i / 2048, k = i % 2048; const float v = r < 2 ? AV.in(I_C)[r * 2048 + k] : AV.in(I_CCTX)[k]; sc[i] = siluf_(v); }
    __syncthreads();
    const int col = F.tid & 63, ks = F.tid >> 6;
    for (int chunk = F.bid; chunk < DEPTH * 192; chunk += F.G) {
        const int l = chunk / 192, n0 = (chunk % 192) * 64;
        const float* w = AV.in(I_WMOD) + (size_t)l * 2048 * 12288 + n0 + col;
        float s0 = 0.f, s1 = 0.f, s2 = 0.f;
#pragma unroll 8
        for (int k = ks * 256; k < ks * 256 + 256; ++k) { const float wv = w[(size_t)k * 12288]; s0 += sc[k] * wv; s1 += sc[2048 + k] * wv; s2 += sc[4096 + k] * wv; }
        red[(ks * 3 + 0) * 64 + col] = s0; red[(ks * 3 + 1) * 64 + col] = s1; red[(ks * 3 + 2) * 64 + col] = s2;
        __syncthreads();
        if (F.tid < 192) { const int r = F.tid >> 6, c2 = F.tid & 63; float s = 0.f;
#pragma unroll
            for (int q = 0; q < 8; ++q) s += red[(q * 3 + r) * 64 + c2];
            ((float*)(F.ws + WS_MOD))[((size_t)l * 3 + r) * 12288 + n0 + c2] = s + AV.in(I_BMOD)[(size_t)l * 12288 + n0 + c2]; }
        __syncthreads();
    }
}

__device__ __forceinline__ void conv_item(const float* W, int ldw, int k0, int srccol, f16* WT, int dstrow, int ldk) {
    float v[64];
    const float* src = W + (size_t)k0 * ldw + (srccol >= 0 ? srccol : 0);
#pragma unroll
    for (int k = 0; k < 64; ++k) v[k] = src[(size_t)k * ldw];
#pragma unroll
    for (int k = 0; k < 64; k += 8) PIN8(v[k], v[k + 1], v[k + 2], v[k + 3], v[k + 4], v[k + 5], v[k + 6], v[k + 7]);
    f16* dst = WT + (size_t)dstrow * ldk + k0;
#pragma unroll
    for (int kg = 0; kg < 8; ++kg) { f16x8 o;
#pragma unroll
        for (int e = 0; e < 8; ++e) o[e] = srccol >= 0 ? (f16)v[8 * kg + e] : (f16)0.f;
        *(f16x8*)(dst + 8 * kg) = o; }
}
__device__ __forceinline__ void ph_convert_weights(const Ctx& F, const ArgsV& AV, int l) {
    const int skip = F.G > 64 ? 32 : 0;
    if (F.bid < skip) return;
    const int gw = (F.bid - skip) * 8 + F.wave, NGW = (F.G - skip) * 8, lane = F.lane;
    constexpr int I_IN = 32 * 180, I_GLU = 8 * 8, I_BR = 32 * 32, I_OUT = 32 * 32, I_UP = 32 * 176, I_DN = 88 * 32;
    constexpr int NIT = I_IN + I_GLU + I_BR + I_OUT + I_UP + I_DN;
    for (int it = gw; it < NIT; it += NGW) {
        int r = it;
        if (r < I_IN) { const int kb = r / 180, nb = r % 180, j = nb * 64 + lane;
            const int src = j < 2048 ? j : (j < 11264 ? j + 32 : (j < 11296 ? 2048 + (j - 11264) : -1));
            conv_item(AV.in(I_WIN) + (size_t)l * 2048 * INW, INW, kb * 64, src, (f16*)(F.ws + WS_WIN), j, 2048); continue; } r -= I_IN;
        if (r < I_GLU) { const int kb = r / 8, nb = r % 8, j = nb * 64 + lane; conv_item(AV.in(I_GLUW) + (size_t)l * 512 * 512, 512, kb * 64, j, (f16*)(F.ws + WS_WGLU), j, 512); continue; } r -= I_GLU;
        if (r < I_BR) { const int kb = r / 32, nb = r % 32, j = nb * 64 + lane; conv_item(AV.in(I_WBR) + (size_t)l * 2048 * 2048, 2048, kb * 64, j, (f16*)(F.ws + WS_WBR), j, 2048); continue; } r -= I_BR;
        if (r < I_OUT) { const int kb = r / 32, nb = r % 32, j = nb * 64 + lane; conv_item(AV.in(I_WOUT) + (size_t)l * 2048 * 2048, 2048, kb * 64, j, (f16*)(F.ws + WS_WOUT), j, 2048); continue; } r -= I_OUT;
        if (r < I_UP) { const int kb = r / 176, nb = r % 176, j = nb * 64 + lane, pn = j >> 8, i = j & 255; const int src = i < 128 ? 128 * pn + i : FFH + 128 * pn + (i - 128);
            conv_item(AV.in(I_WUP) + (size_t)l * 2048 * UPLD, UPLD, kb * 64, src, (f16*)(F.ws + WS_WUP), j, 2048); continue; } r -= I_UP;
        { const int kb = r / 32, nb = r % 32, j = nb * 64 + lane; conv_item(AV.in(I_WDN) + (size_t)l * FFH * 2048, 2048, kb * 64, j, (f16*)(F.ws + WS_WDN), j, FFH); }
    }
}

__device__ __forceinline__ void s5_mats_group(const Ctx& F, const ArgsV& AV, int l, int g) {
    LAS f32x2* APOW = (LAS f32x2*)F.lds;
    LAS f32x2* BBAR = APOW + 2 * 17 * 64;
    LAS f32x2* CM = BBAR + 2 * 64 * 16;
    LAS float* KLAG = (LAS float*)(CM + 2 * 16 * 64);
    __syncthreads();
    for (int i = F.tid; i < 2 * 17 * 64; i += 512) { const int d = i / (17 * 64), e = (i / 64) % 17, n = i % 64;
        const size_t pi = (((size_t)l * 2 + d) * 32 + g) * 64 + n;
        const float are = AV.in(I_S5ARE)[pi], aim = AV.in(I_S5AIM)[pi], dt = expf(AV.in(I_S5STEP)[((size_t)l * 2 + d) * 32 + g]);
        const float zr = are * dt * (float)e, zi = aim * dt * (float)e; float s, c; sincosf(zi, &s, &c); const float m = expf(zr);
        APOW[i] = (f32x2){m * c, m * s}; }
    __syncthreads();
    for (int i = F.tid; i < 2 * 64 * 16; i += 512) { const int d = i / 1024, n = (i / 16) % 64, h = i % 16;
        const size_t pi = (((size_t)l * 2 + d) * 32 + g) * 64 + n;
        const float are = AV.in(I_S5ARE)[pi], aim = AV.in(I_S5AIM)[pi];
        const f32x2 ab = APOW[(d * 17 + 1) * 64 + n]; const f32x2 num = (f32x2){ab.x - 1.0f, ab.y};
        const float den = are * are + aim * aim; const f32x2 q = (f32x2){(num.x * are + num.y * aim) / den, (num.y * are - num.x * aim) / den};
        const size_t bi = (pi * 16) + h;
        BBAR[i] = cmul(q, (f32x2){AV.in(I_S5BRE)[bi], AV.in(I_S5BIM)[bi]});
        const size_t ci = ((((size_t)l * 2 + d) * 32 + g) * 16 + h) * 64 + n;
        CM[(d * 16 + h) * 64 + n] = (f32x2){AV.in(I_S5CRE)[ci], AV.in(I_S5CIM)[ci]}; }
    __syncthreads();
    for (int i = F.tid; i < 2 * 16 * 256; i += 512) { const int d = i / 4096, lag = (i / 256) % 16, h = (i / 16) % 16, hp = i % 16; float s = 0.f;
        for (int n = 0; n < 64; ++n) { const f32x2 t = cmul(CM[(d * 16 + h) * 64 + n], APOW[(d * 17 + lag) * 64 + n]); const f32x2 b = BBAR[(d * 64 + n) * 16 + hp]; s += t.x * b.x - t.y * b.y; }
        KLAG[i] = s; }
    __syncthreads();
    f16* W = (f16*)(F.ws + WS_S5W) + (size_t)g * 256 * 512;
    for (int i = F.tid; i < 256 * 64; i += 512) { const int n = i / 64, k8 = (i % 64) * 8, t = n >> 4, h = n & 15; f16x8 o;
#pragma unroll
        for (int e = 0; e < 8; ++e) { const int k = k8 + e; float v;
            if (k < 256) { const int s = k >> 4, hp = k & 15; v = 0.f;
                if (t >= s) v += KLAG[((0 * 16 + (t - s)) * 16 + h) * 16 + hp];
                if (s >= t) v += KLAG[((1 * 16 + (s - t)) * 16 + h) * 16 + hp];
                v *= S5SCALE; }
            else { const int d = (k - 256) >> 7, nn2 = (k - 256) & 127, nn = nn2 & 63, im = nn2 >> 6, ex = d == 0 ? t + 1 : 16 - t;
                const f32x2 z = cmul(CM[(d * 16 + h) * 64 + nn], APOW[(d * 17 + ex) * 64 + nn]); v = im ? -z.y : z.x; }
            o[e] = (f16)v; }
        *(f16x8*)(W + (size_t)n * 512 + k8) = o; }
    f16* Mx = (f16*)(F.ws + WS_S5M) + (size_t)g * 256 * 256;
    for (int i = F.tid; i < 256 * 32; i += 512) { const int n = i / 32, k8 = (i % 32) * 8, d = n >> 7, ri = (n >> 6) & 1, nn = n & 63; f16x8 o;
#pragma unroll
        for (int e = 0; e < 8; ++e) { const int k = k8 + e, s = k >> 4, hp = k & 15, ex = d == 0 ? 15 - s : s;
            const f32x2 z = cmul(APOW[(d * 17 + ex) * 64 + nn], BBAR[(d * 64 + nn) * 16 + hp]); o[e] = (f16)((ri ? z.y : z.x) * S5SCALE); }
        *(f16x8*)(Mx + (size_t)n * 256 + k8) = o; }
    if (F.tid < 128) { const int d = F.tid >> 6, nn = F.tid & 63; ((f32x2*)(F.ws + WS_S5AT))[(d * 32 + g) * 64 + nn] = APOW[(d * 17 + 16) * 64 + nn]; }
    __syncthreads();
}

__device__ __forceinline__ void ph_hyena_h2(const Ctx& F, const ArgsV& AV, int l) {
    LAS float* W1 = (LAS float*)F.lds;
    LAS float* W2 = W1 + 33 * 64;
    LAS float* PV = W2 + 64 * 64;
    LAS float* SCR = PV + 256;
    __syncthreads();
    for (int i = F.tid; i < 33 * 64; i += 512) W1[i] = AV.in(I_HYW1)[(size_t)l * 33 * 64 + i];
    for (int i = F.tid; i < 64 * 64; i += 512) W2[i] = AV.in(I_HYW2)[(size_t)l * 4096 + i];
    if (F.tid < 64) { PV[F.tid] = AV.in(I_HYB1)[l * 64 + F.tid]; PV[64 + F.tid] = AV.in(I_HYF1)[l * 64 + F.tid]; PV[128 + F.tid] = AV.in(I_HYB2)[l * 64 + F.tid]; PV[192 + F.tid] = AV.in(I_HYF2)[l * 64 + F.tid]; }
    __syncthreads();
    LAS float* scr = SCR + F.wave * 64;
    const int gw = F.bid * 8 + F.wave, NGW = F.G * 8, j = F.lane;
    float* H2 = (float*)(F.ws + WS_H2);
    for (int p = gw; p < SEQ + LC; p += NGW) {
        const int n = p < SEQ ? SEQ : LC, pos = p < SEQ ? p : p - SEQ;
        float feat = 0.f;
        if (j == 0) feat = (float)pos / (float)(n - 1);
        else if (j < 33) { const int fi = (j - 1) & 15; const float fr = 1e-4f + (float)fi * ((15.0f - 1e-4f) / 15.0f);
            const float ang = (6.283185307179586f / (float)n) * (float)pos * fr; float s, c; sincosf(ang, &s, &c); feat = j < 17 ? c : -s; }
        scr[j] = feat; LDS_WAIT(); asm volatile("" ::: "memory");
        float a = PV[j];
        for (int i = 0; i < 33; ++i) a += scr[i] * W1[i * 64 + j];
        const float h1 = sinf(PV[64 + j] * a);
        LDS_WAIT(); asm volatile("" ::: "memory");
        scr[j] = h1; LDS_WAIT(); asm volatile("" ::: "memory");
        float b = PV[128 + j];
        for (int i = 0; i < 64; ++i) b += scr[i] * W2[i * 64 + j];
        { const float h2v = sinf(PV[192 + j] * b); H2[(size_t)p * 64 + j] = h2v; ((f16*)(F.ws + WS_H2H))[(size_t)p * 64 + j] = (f16)h2v; }
        LDS_WAIT(); asm volatile("" ::: "memory");
    }
}

__device__ __forceinline__ void ph_norm(const Ctx& F, const ArgsV& AV, int l, int which, int nrows, int nslab) {
    const int gw = F.bid * 8 + F.wave, NGW = F.G * 8;
    float* X = (float*)(F.ws + WS_XRES); f16* O = (f16*)(F.ws + WS_HN); const float* SL = (const float*)(F.ws + WS_SLAB);
    const float* gain = AV.in(which ? I_N2G : I_N1G) + (size_t)l * D;
    const float* mod = (const float*)(F.ws + WS_MOD) + (size_t)l * 3 * 12288;
    const int shoff = which ? 6144 : 0, soff = which ? 8192 : 2048;
    for (int m = gw; m < nrows; m += NGW) {
        const int bsel = m < SEQ ? 0 : (m < MX ? 1 : 2);
        f32x4* xr = (f32x4*)(X + (size_t)m * D) + F.lane;
        f32x4 v[8]; float s = 0.f;
#pragma unroll
        for (int j = 0; j < 8; ++j) v[j] = xr[64 * j];
        PIN8(v[0], v[1], v[2], v[3], v[4], v[5], v[6], v[7]);
        if (m >= MX && nslab > 0) {
            for (int sl = 0; sl < nslab; ++sl) { const f32x4* sr = (const f32x4*)(SL + ((size_t)sl * MC + (m - MX)) * D) + F.lane;
#pragma unroll
                for (int j = 0; j < 8; ++j) v[j] = v[j] + sr[64 * j]; }
#pragma unroll
            for (int j = 0; j < 8; ++j) xr[64 * j] = v[j]; }
#pragma unroll
        for (int j = 0; j < 8; ++j) s += (v[j].x * v[j].x + v[j].y * v[j].y) + (v[j].z * v[j].z + v[j].w * v[j].w);
        const float rstd = 1.0f / sqrtf(wave_sum(s) * (1.0f / D) + EPS);
        const float* mp = mod + bsel * 12288;
#pragma unroll
        for (int j = 0; j < 8; ++j) { const int c = 4 * F.lane + 256 * j;
            const f32x4 g = *(const f32x4*)(gain + c), sh = *(const f32x4*)(mp + shoff + c), sc = *(const f32x4*)(mp + soff + c);
            f16x4 o;
#pragma unroll
            for (int e = 0; e < 4; ++e) o[e] = (f16)(v[j][e] * rstd * g[e] * (1.0f + sc[e]) + sh[e]);
            *(f16x4*)(O + (size_t)m * D + c) = o; }
    }
}
__device__ __forceinline__ void ph_final_norm(const Ctx& F, const ArgsV& AV) {
    const int gw = F.bid * 8 + F.wave, NGW = F.G * 8;
    const float* X = (const float*)(F.ws + WS_XRES); const float* gain = AV.in(I_FNG);
    for (int m = gw; m < MX; m += NGW) {
        const f32x4* xr = (const f32x4*)(X + (size_t)m * D) + F.lane;
        f32x4 v[8]; float s = 0.f;
#pragma unroll
        for (int j = 0; j < 8; ++j) { v[j] = xr[64 * j]; s += (v[j].x * v[j].x + v[j].y * v[j].y) + (v[j].z * v[j].z + v[j].w * v[j].w); }
        const float rstd = 1.0f / sqrtf(wave_sum(s) * (1.0f / D) + EPS);
#pragma unroll
        for (int j = 0; j < 8; ++j) { const int c = 4 * F.lane + 256 * j; const f32x4 g = *(const f32x4*)(gain + c);
            *(f32x4*)(AV.out + (size_t)m * D + c) = v[j] * rstd * g; }
    }
}

__device__ __forceinline__ void ph_s5_scan(const Ctx& F) {
    if (F.tid >= 32) return;
    const float* S = (const float*)(F.ws + WS_S5S); f16* SA = (f16*)(F.ws + WS_S5A);
    for (int gt = F.bid * 32 + F.tid; gt < 2 * 2 * 32 * 64; gt += F.G * 32) {
        const int nn = gt & 63, g = (gt >> 6) & 31, d = (gt >> 11) & 1, b = gt >> 12;
        const f32x2 at = ((const f32x2*)(F.ws + WS_S5AT))[(d * 32 + g) * 64 + nn];
        f32x2 st = (f32x2){0.f, 0.f};
        for (int base = 0; base < 16 + 512; base += 16) {
            f32x2 loc[16]; int chk[16];
#pragma unroll
            for (int u = 0; u < 16; ++u) { const int step = base + u; int chunk;
                if (d == 0) chunk = step < 16 ? 1024 + b * 16 + step : b * 512 + (step - 16);
                else chunk = step < 16 ? 1024 + b * 16 + (15 - step) : b * 512 + (511 - (step - 16));
                chk[u] = chunk; const size_t so = ((size_t)chunk * 32 + g) * 256 + d * 128 + nn;
                loc[u] = (f32x2){S[so], S[so + 64]}; }
            PIN8(loc[0], loc[1], loc[2], loc[3], loc[4], loc[5], loc[6], loc[7]); PIN8(loc[8], loc[9], loc[10], loc[11], loc[12], loc[13], loc[14], loc[15]);
#pragma unroll
            for (int u = 0; u < 16; ++u) { f16* xp = SA + (size_t)chk[u] * 16384 + (size_t)g * 512 + 256 + d * 128 + nn;
                xp[0] = (f16)st.x; xp[64] = (f16)st.y;
                st = cmul(at, st) + loc[u]; }
        }
    }
}

__device__ __forceinline__ void ph_ffn_fix(const Ctx& F, const ArgsV& AV, int l, int nMr) {
    const float* HALO = (const float*)(F.ws + WS_HALO); f16* ACT = (f16*)(F.ws + WS_ACT);
    const float* cw = AV.in(I_FFCW) + (size_t)l * 3 * FFH; const float* cb = AV.in(I_FFCB) + (size_t)l * FFH;
    const int NT = nMr * 44 * 2 * 128;
    for (int task = F.bid * 512 + F.tid; task < NT; task += F.G * 512) {
        const int c = task & 127, which = (task >> 7) & 1, tile = task >> 8, pn = tile % 44, pm = tile / 44;
        const float* h = HALO + ((size_t)pm * 44 + pn) * 768 + c; const int col = pn * 128 + c;
        const bool first = (pm == 0 || pm == 32 || pm >= 64), last = (pm == 31 || pm >= 63);
        float ap, ac, an, b;
        if (which == 0) { ap = first ? 0.f : HALO[((size_t)(pm - 1) * 44 + pn) * 768 + 3 * 128 + c]; ac = h[0]; an = h[128]; b = h[4 * 128]; }
        else { ap = h[2 * 128]; ac = h[3 * 128]; an = last ? 0.f : HALO[((size_t)(pm + 1) * 44 + pn) * 768 + c]; b = h[5 * 128]; }
        const float a = cw[col] * ap + cw[FFH + col] * ac + cw[2 * FFH + col] * an + cb[col];
        ACT[(size_t)(pm * 256 + (which ? 255 : 0)) * FFH + col] = (f16)(siluf_(a) * b);
    }
}

namespace gla {
constexpr int QK_LD = 136, KH_LD = 72, VT_LD = 72, P_LD = 72;
constexpr int OFF_QT = 0;
constexpr int OFF_KT = 17408;
constexpr int OFF_VT = OFF_KT + 18432;
constexpr int OFF_P = OFF_VT + 36864;
constexpr int OFF_LR = OFF_P + 9216;
constexpr int OFF_GT = OFF_LR + 4096;
constexpr int OFF_DEC = OFF_GT + 2048;
constexpr int OFF_RS = OFF_DEC + 512;
constexpr int OFF_QR = OFF_RS + 2048;
constexpr int OFF_KR = OFF_QR + 17408;
constexpr int OFF_WG = OFF_KR + 17408;
static_assert(OFF_WG + 8192 <= LDSCTL_OFF, "gla lds");

__device__ __forceinline__ int grow(int b, int sc, int j, int i) {
    if (sc < 32) { const int col = 2 * sc + (j >> 1), r = (j & 1) * 64 + i; return b * SEQ + r * 64 + col; }
    return MX + b * LC + j * 64 + i;
}
__device__ __forceinline__ int prow(int b, int sc, int j, int i) {
    return sc < 32 ? b * SEQ + sc * 256 + j * 64 + i : MX + b * LC + j * 64 + i;
}
#define GLA_MFMA(a, b, c) __builtin_amdgcn_mfma_f32_16x16x32_f16(a, b, c, 0, 0, 0)

template <bool FULL>
__device__ __forceinline__ void gla_unit(const Ctx& F, const ArgsV& AV, int l, int unit) {
    const int b = unit / (4 * NSC), h = (unit / NSC) % 4, sc = unit % NSC;
    LAS f16* QT = (LAS f16*)(F.lds + OFF_QT); LAS f16* KT = (LAS f16*)(F.lds + OFF_KT); LAS f16* VT = (LAS f16*)(F.lds + OFF_VT);
    LAS f16* PP = (LAS f16*)(F.lds + OFF_P); LAS f16* LR = (LAS f16*)(F.lds + OFF_LR);
    LAS float* GT = (LAS float*)(F.lds + OFF_GT); LAS float* DEC = (LAS float*)(F.lds + OFF_DEC); LAS float* RS = (LAS float*)(F.lds + OFF_RS);
    LAS f16* QR = (LAS f16*)(F.lds + OFF_QR); LAS f16* KR = (LAS f16*)(F.lds + OFF_KR); LAS float* WG = (LAS float*)(F.lds + OFF_WG);
    const int tid = F.tid, lane = F.lane, w = F.wave, q0 = lane >> 4, c0 = lane & 15;
    const int dk0 = tid & 127, ig0 = tid >> 7;
    const f16* PX = (const f16*)(F.ws + WS_PX);
    const float scale = 0.08838834764831845f;
    for (int dir = 0; dir < 2; ++dir) {
        __syncthreads();
        for (int i = tid; i < 16 * 128; i += 512) WG[i] = AV.in(I_GLAWG)[(((size_t)l * 2 + dir) * 16 + (i >> 7)) * 512 + h * 128 + (i & 127)];
        const float bgv = AV.in(I_GLABG)[((size_t)l * 2 + dir) * 512 + h * 128 + dk0];
        const size_t sidx = ((((size_t)b * 4 + h) * NSC + sc) * 2 + dir);
        f32x4 accS[8][2];
        if (FULL && sc < 32) { const float* Sin = (const float*)(F.ws + WS_GSIN) + sidx * 32768; const int q = opq(q0), c = opq(c0);
#pragma unroll
            for (int dt = 0; dt < 8; ++dt)
#pragma unroll
                for (int et = 0; et < 2; ++et)
#pragma unroll
                    for (int r = 0; r < 4; ++r) accS[dt][et][r] = Sin[(16 * dt + 4 * q + r) * 256 + 32 * w + 16 * et + c];
            PIN8(accS[0][0], accS[0][1], accS[1][0], accS[1][1], accS[2][0], accS[2][1], accS[3][0], accS[3][1]); PIN8(accS[4][0], accS[4][1], accS[5][0], accS[5][1], accS[6][0], accS[6][1], accS[7][0], accS[7][1]); }
        else {
#pragma unroll
            for (int dt = 0; dt < 8; ++dt)
#pragma unroll
                for (int et = 0; et < 2; ++et) accS[dt][et] = (f32x4){0.f, 0.f, 0.f, 0.f}; }
        float sumtot = 0.f;
#define GLA_FETCH(jn) f16x8 pf_lr, pf_v[4], pf_k[2], pf_q[2]; do { const int tf = opq(F.tid); \
            { const int row = (tf & 255) >> 2, part = tf & 3; pf_lr = *(const f16x8*)(PX + (size_t)prow(b, sc, (jn), row) * PXLD + P_GG + part * 8); } \
            _Pragma("unroll") for (int k = 0; k < 4; ++k) { const int idx = tf + 512 * k, wi = idx >> 6, ln = idx & 63, rr = ln >> 2, cc = ln & 3; const int row = (wi & 3) * 16 + rr, chunk = (wi >> 2) * 4 + cc; \
                pf_v[k] = *(const f16x8*)(PX + (size_t)prow(b, sc, (jn), row) * PXLD + P_GV + h * 256 + chunk * 8); } \
            _Pragma("unroll") for (int k = 0; k < 2; ++k) { const int idx = tf + 512 * k, row = idx >> 4, ch = idx & 15; const size_t ro = (size_t)prow(b, sc, (jn), row) * PXLD; \
                pf_k[k] = *(const f16x8*)(PX + ro + P_GK + h * 128 + ch * 8); if (FULL) pf_q[k] = *(const f16x8*)(PX + ro + P_GQ + h * 128 + ch * 8); else pf_q[k] = pf_k[k]; } } while (0)
        for (int jj = 0; jj < 4; ++jj) {
            const int j = dir ? 3 - jj : jj;
            if (FULL) {
            GLA_FETCH(j);
            __syncthreads();
            const int tid = opq(F.tid);
            PIN8(pf_lr, pf_v[0], pf_v[1], pf_v[2], pf_v[3], pf_k[0], pf_k[1], pf_q[0]); asm volatile("" : "+v"(pf_q[1]));
            if (tid < 256) { const int row = tid >> 2, part = tid & 3; *(LAS f16x8*)(LR + row * 32 + part * 8) = pf_lr; }
#pragma unroll
            for (int k = 0; k < 4; ++k) { const int idx = opq(tid) + 512 * k, wi = idx >> 6, ln = idx & 63, rr = ln >> 2, cc = ln & 3;
                const int row = (wi & 3) * 16 + rr, chunk = (wi >> 2) * 4 + cc; LAS f16* vp = VT + (chunk * 8) * VT_LD + row;
#pragma unroll
                for (int e = 0; e < 8; ++e) vp[e * VT_LD] = pf_v[k][e]; }
#pragma unroll
            for (int k = 0; k < 2; ++k) { const int idx = tid + 512 * k, row = idx >> 4, ch = idx & 15;
                *(LAS f16x8*)(KR + row * QK_LD + ch * 8) = pf_k[k];
                *(LAS f16x8*)(QR + row * QK_LD + ch * 8) = pf_q[k]; }
            } else {
            __syncthreads();
            const int tid = opq(F.tid);
            if (tid < 256) { const int row = tid >> 2, part = tid & 3; const int gr = prow(b, sc, j, row);
                *(LAS f16x8*)(LR + row * 32 + part * 8) = *(const f16x8*)(PX + (size_t)gr * PXLD + P_GG + part * 8); }
#pragma unroll 1
            for (int k = 0; k < 4; ++k) { const int idx = tid + 512 * k, wi = idx >> 6, ln = idx & 63, rr = ln >> 2, cc = ln & 3;
                const int row = (wi & 3) * 16 + rr, chunk = (wi >> 2) * 4 + cc; const int gr = prow(b, sc, j, row);
                const f16x8 v8 = *(const f16x8*)(PX + (size_t)gr * PXLD + P_GV + h * 256 + chunk * 8);
#pragma unroll
                for (int e = 0; e < 8; ++e) VT[(chunk * 8 + e) * VT_LD + row] = v8[e]; }
#pragma unroll 1
            for (int k = 0; k < 2; ++k) { const int idx = tid + 512 * k, row = idx >> 4, ch = idx & 15; const int gr = prow(b, sc, j, row);
                *(LAS f16x8*)(KR + row * QK_LD + ch * 8) = *(const f16x8*)(PX + (size_t)gr * PXLD + P_GK + h * 128 + ch * 8); }
            }
            __syncthreads();
            const int dk = opq(dk0), ig = opq(ig0);
            float bv[16];
#pragma unroll
            for (int ii = 0; ii < 16; ++ii) { const int i = ig * 16 + ii; float pre = bgv;
                const f16x8 l0 = *(const LAS f16x8*)(LR + i * 32 + dir * 16), l1 = *(const LAS f16x8*)(LR + i * 32 + dir * 16 + 8);
#pragma unroll
                for (int r = 0; r < 8; ++r) pre += (float)l0[r] * WG[r * 128 + dk] + (float)l1[r] * WG[(8 + r) * 128 + dk];
                bv[ii] = logsigmoidf_(pre) * (1.0f / 16.0f); }
            float totloc;
            if (dir == 0) {
#pragma unroll
                for (int ii = 1; ii < 16; ++ii) bv[ii] += bv[ii - 1];
                totloc = bv[15]; }
            else {
#pragma unroll
                for (int ii = 14; ii >= 0; --ii) bv[ii] += bv[ii + 1];
                totloc = bv[0]; }
            GT[ig * 128 + dk] = totloc;
            __syncthreads();
            const float g0 = GT[dk], g1 = GT[128 + dk], g2 = GT[256 + dk], g3 = GT[384 + dk];
            const float total = (g0 + g1) + (g2 + g3);
            float off, bmid;
            if (dir == 0) { off = (ig > 0 ? g0 : 0.f) + (ig > 1 ? g1 : 0.f) + (ig > 2 ? g2 : 0.f); bmid = g0 + g1; }
            else { off = (ig < 3 ? g3 : 0.f) + (ig < 2 ? g2 : 0.f) + (ig < 1 ? g1 : 0.f); bmid = g2 + g3; }
#pragma unroll
            for (int ii = 0; ii < 16; ++ii) bv[ii] += off;
            if (FULL) {
#pragma unroll
                for (int ii = 0; ii < 16; ++ii) { const int i = ig * 16 + ii;
                    QT[i * QK_LD + dk] = (f16)((float)QR[i * QK_LD + dk] * scale * __expf(fminf(bv[ii] - bmid, 9.f)));
                    KT[i * QK_LD + dk] = (f16)((float)KR[i * QK_LD + dk] * __expf(fminf(bmid - bv[ii], 9.f))); }
                __syncthreads();
                { const int c = opq(c0), q = opq(q0);
#pragma unroll
                for (int s = 0; s < 2; ++s) { const int T = 2 * w + s, it = T >> 2, jt = T & 3; f32x4 a = (f32x4){0.f, 0.f, 0.f, 0.f};
#pragma unroll
                    for (int kk = 0; kk < 4; ++kk) { const f16x8 kf = *(const LAS f16x8*)(KT + (jt * 16 + c) * QK_LD + kk * 32 + 8 * q);
                        const f16x8 qf = *(const LAS f16x8*)(QT + (it * 16 + c) * QK_LD + kk * 32 + 8 * q); a = GLA_MFMA(kf, qf, a); }
                    const int i = it * 16 + c; f16x4 pv;
#pragma unroll
                    for (int r = 0; r < 4; ++r) { const int jx = jt * 16 + 4 * q + r; const bool keep = dir == 0 ? (jx <= i) : (jx >= i); pv[r] = keep ? (f16)a[r] : (f16)0.f; }
                    *(LAS f16x4*)(PP + i * P_LD + jt * 16 + 4 * q) = pv; } }
                __syncthreads();
#pragma unroll
                for (int ii = 0; ii < 16; ++ii) { const int i = ig * 16 + ii; QT[i * QK_LD + dk] = (f16)((float)QR[i * QK_LD + dk] * scale * __expf(bv[ii])); }
            }
            { f16x8 k0, k1;
#pragma unroll
              for (int ii = 0; ii < 8; ++ii) { k0[ii] = (f16)((float)KR[(ig * 16 + ii) * QK_LD + dk] * __expf(total - bv[ii])); k1[ii] = (f16)((float)KR[(ig * 16 + 8 + ii) * QK_LD + dk] * __expf(total - bv[8 + ii])); }
              *(LAS f16x8*)(KT + dk * KH_LD + ig * 16) = k0; *(LAS f16x8*)(KT + dk * KH_LD + ig * 16 + 8) = k1; }
            if (ig == 0) { DEC[dk] = __expf(total); sumtot += total; }
            __syncthreads();
            const int c = opq(c0), q = opq(q0);
            if (FULL) {
                f32x4 accO[4][2];
#pragma unroll
                for (int it = 0; it < 4; ++it)
#pragma unroll
                    for (int et = 0; et < 2; ++et) accO[it][et] = (f32x4){0.f, 0.f, 0.f, 0.f};
#pragma unroll
                for (int et = 0; et < 2; ++et)
#pragma unroll
                    for (int kk = 0; kk < 2; ++kk) { const f16x8 vf = *(const LAS f16x8*)(VT + (32 * w + 16 * et + c) * VT_LD + kk * 32 + 8 * q);
#pragma unroll
                        for (int it = 0; it < 4; ++it) { const f16x8 pf = *(const LAS f16x8*)(PP + (it * 16 + c) * P_LD + kk * 32 + 8 * q); accO[it][et] = GLA_MFMA(vf, pf, accO[it][et]); } asm volatile("" ::: "memory"); }
#pragma unroll
                for (int kb = 0; kb < 4; ++kb)
#pragma unroll
                    for (int et = 0; et < 2; ++et) { f16x8 sf; asm volatile("" ::: "memory");
#pragma unroll
                        for (int e = 0; e < 4; ++e) { sf[e] = (f16)accS[2 * kb][et][e]; sf[4 + e] = (f16)accS[2 * kb + 1][et][e]; }
#pragma unroll
                        for (int it = 0; it < 4; ++it) { const f16x4 lo = *(const LAS f16x4*)(QT + (it * 16 + c) * QK_LD + 32 * kb + 4 * q), hi = *(const LAS f16x4*)(QT + (it * 16 + c) * QK_LD + 32 * kb + 16 + 4 * q);
                            f16x8 qf; qf[0] = lo[0]; qf[1] = lo[1]; qf[2] = lo[2]; qf[3] = lo[3]; qf[4] = hi[0]; qf[5] = hi[1]; qf[6] = hi[2]; qf[7] = hi[3];
                            accO[it][et] = GLA_MFMA(sf, qf, accO[it][et]); } }
                float* OF = (float*)(F.ws + WS_GOF);
                if (dir == 0) {
#pragma unroll
                    for (int it = 0; it < 4; ++it) { const int gr = prow(b, sc, j, it * 16 + c);
#pragma unroll
                        for (int et = 0; et < 2; ++et) *(f32x4*)(OF + (size_t)gr * 1024 + h * 256 + 32 * w + 16 * et + 4 * q) = accO[it][et];
                        asm volatile("" ::: "memory"); } }
                else {
                    int grs[4]; f32x4 ofv[4][2]; f16x4 rvv[4][2];
#pragma unroll
                    for (int it = 0; it < 4; ++it) { grs[it] = prow(b, sc, j, it * 16 + c);
#pragma unroll
                        for (int et = 0; et < 2; ++et) { ofv[it][et] = *(const f32x4*)(OF + (size_t)grs[it] * 1024 + h * 256 + 32 * w + 16 * et + 4 * q);
                            rvv[it][et] = *(const f16x4*)(PX + (size_t)grs[it] * PXLD + P_GR + h * 256 + 32 * w + 16 * et + 4 * q); } }
                    PIN8(ofv[0][0], ofv[0][1], ofv[1][0], ofv[1][1], ofv[2][0], ofv[2][1], ofv[3][0], ofv[3][1]);
#pragma unroll
                    for (int it = 0; it < 4; ++it) { float ss = 0.f;
#pragma unroll
                        for (int et = 0; et < 2; ++et) { accO[it][et] = accO[it][et] + ofv[it][et];
                            ss += (accO[it][et][0] * accO[it][et][0] + accO[it][et][1] * accO[it][et][1]) + (accO[it][et][2] * accO[it][et][2] + accO[it][et][3] * accO[it][et][3]); }
                        ss += __shfl_xor(ss, 16); ss += __shfl_xor(ss, 32);
                        if (q == 0) RS[(it * 16 + c) * 8 + w] = ss; }
                    __syncthreads();
                    PIN8(rvv[0][0], rvv[0][1], rvv[1][0], rvv[1][1], rvv[2][0], rvv[2][1], rvv[3][0], rvv[3][1]);
                    const float* ng = AV.in(I_GLANG) + (size_t)l * 256;
                    f16* Y = (f16*)(F.ws + WS_YCAT);
#pragma unroll
                    for (int it = 0; it < 4; ++it) { const int i = it * 16 + c; const f32x4 ra = *(const LAS f32x4*)(RS + i * 8), rb = *(const LAS f32x4*)(RS + i * 8 + 4);
                        const float tot = ((ra[0] + ra[1]) + (ra[2] + ra[3])) + ((rb[0] + rb[1]) + (rb[2] + rb[3]));
                        const float rstd = 1.0f / sqrtf(tot * (1.0f / 256.0f) + EPS);
#pragma unroll
                        for (int et = 0; et < 2; ++et) { const int e0 = 32 * w + 16 * et + 4 * q;
                            const f32x4 gv = *(const f32x4*)(ng + e0);
                            f16x4 o;
#pragma unroll
                            for (int r = 0; r < 4; ++r) o[r] = (f16)(accO[it][et][r] * rstd * gv[r] * siluf_((float)rvv[it][et][r]));
                            *(f16x4*)(Y + (size_t)grow(b, sc, j, it * 16 + c) * 2048 + 1024 + h * 256 + e0) = o; } }
                }
            }
#pragma unroll
            for (int dt = 0; dt < 8; ++dt) { const f32x4 dv = *(const LAS f32x4*)(DEC + 16 * dt + 4 * q);
#pragma unroll
                for (int et = 0; et < 2; ++et) accS[dt][et] = accS[dt][et] * dv; }
#pragma unroll
            for (int kk = 0; kk < 2; ++kk) { f16x8 vf[2];
#pragma unroll
                for (int et = 0; et < 2; ++et) vf[et] = *(const LAS f16x8*)(VT + (32 * w + 16 * et + c) * VT_LD + kk * 32 + 8 * q);
#pragma unroll
                for (int dt = 0; dt < 8; ++dt) { const f16x8 kf = *(const LAS f16x8*)(KT + (16 * dt + c) * KH_LD + kk * 32 + 8 * q);
#pragma unroll
                    for (int et = 0; et < 2; ++et) accS[dt][et] = GLA_MFMA(kf, vf[et], accS[dt][et]); if (dt & 1) asm volatile("" ::: "memory"); } }
        }
        if (!FULL) { float* Sl = (float*)(F.ws + WS_GSLOC) + sidx * 32768; const int q = opq(q0), c = opq(c0);
#pragma unroll
            for (int dt = 0; dt < 8; ++dt)
#pragma unroll
                for (int et = 0; et < 2; ++et)
#pragma unroll
                    for (int r = 0; r < 4; ++r) Sl[(16 * dt + 4 * q + r) * 256 + 32 * w + 16 * et + c] = accS[dt][et][r];
            if (ig0 == 0) ((float*)(F.ws + WS_GDT))[sidx * 128 + dk0] = __expf(sumtot); }
        VM_WAIT();
    }
}
__device__ __forceinline__ void ph_gla_scan(const Ctx& F) {
    const float* Sl = (const float*)(F.ws + WS_GSLOC); float* Si = (float*)(F.ws + WS_GSIN); const float* Dt = (const float*)(F.ws + WS_GDT);
    for (int gt = F.bid * 512 + F.tid; gt < 2 * 4 * 2 * 32768; gt += F.G * 512) {
        const int e = gt & 32767, dir = (gt >> 15) & 1, h = (gt >> 16) & 3, b = gt >> 18;
        float S = 0.f;
        for (int base = 0; base < NSC; base += 11) {
            float sl[11], dt[11]; size_t ix[11];
#pragma unroll
            for (int u = 0; u < 11; ++u) { const int step = base + u; const int sc = step == 0 ? 32 : (dir == 0 ? step - 1 : 32 - step);
                const size_t idx = ((((size_t)b * 4 + h) * NSC + sc) * 2 + dir); ix[u] = idx;
                sl[u] = Sl[idx * 32768 + e]; dt[u] = Dt[idx * 128 + (e >> 8)]; }
            PIN8(sl[0], sl[1], sl[2], sl[3], sl[4], sl[5], sl[6], sl[7]); PIN8(dt[0], dt[1], dt[2], dt[3], dt[4], dt[5], dt[6], dt[7]); PIN4(sl[8], sl[9], sl[10], dt[8]); asm volatile("" : "+v"(dt[9]), "+v"(dt[10]));
#pragma unroll
            for (int u = 0; u < 11; ++u) { Si[ix[u] * 32768 + e] = S; S = dt[u] * S + sl[u]; }
        }
    }
}
#undef GLA_FETCH
#undef GLA_MFMA
}

namespace hy {
#define PADI(i) ((i) + ((i) >> 5))
constexpr int HY_BUF_BYTES = (16384 + 512) * 8;
constexpr int HY_SCR_OFF = HY_BUF_BYTES;
static_assert(HY_SCR_OFF + 2048 <= LDSCTL_OFF, "hyena lds");
__device__ __forceinline__ f32x2 twid(int k, float invN) { const float xr = (float)k * invN; return (f32x2){__builtin_amdgcn_cosf(xr), -__builtin_amdgcn_sinf(xr)}; }
__device__ __forceinline__ f32x2 mul_w16(f32x2 d, int a) {
    constexpr float c1 = 0.9238795325112867f, s1 = 0.3826834323650898f, r = 0.7071067811865476f;
    float c, s;
    switch (a & 15) {
        case 0: return d; case 4: return (f32x2){d.y, -d.x}; case 8: return (f32x2){-d.x, -d.y}; case 12: return (f32x2){-d.y, d.x};
        case 1: c = c1; s = s1; break; case 2: c = r; s = r; break; case 3: c = s1; s = c1; break;
        case 5: c = -s1; s = c1; break; case 6: c = -r; s = r; break; case 7: c = -c1; s = s1; break;
        case 9: c = -c1; s = -s1; break; case 10: c = -r; s = -r; break; case 11: c = -s1; s = -c1; break;
        case 13: c = s1; s = -c1; break; case 14: c = r; s = -r; break; default: c = c1; s = -s1; break; }
    return (f32x2){d.x * c + d.y * s, d.y * c - d.x * s};
}
template <int R> __device__ __forceinline__ void dif_pass(LAS f32x2* x, int m, int lh, int tid) {
    const int N = 1 << m; const float invN = 1.0f / (float)N; const int lg = lh - R + 1, g = 1 << lg, S = (N >> 1) >> lh;
    for (int q = tid; q < (N >> R); q += 512) { const int j = q & (g - 1), blk = q >> lg, base = (blk << (lh + 1)) + j;
        f32x2 v[1 << R];
#pragma unroll
        for (int k = 0; k < (1 << R); ++k) v[k] = x[PADI(base + k * g)];
        f32x2 w = twid(j * S, invN);
#pragma unroll
        for (int s = 0; s < R; ++s) { const int half = 1 << (R - 1 - s);
#pragma unroll
            for (int k = 0; k < (1 << R); ++k) if (!(k & half)) { const f32x2 a = v[k], b = v[k + half]; v[k] = a + b;
                v[k + half] = mul_w16(cmul(a - b, w), ((k & (half - 1)) << s) * (16 >> R)); }
            w = cmul(w, w); }
#pragma unroll
        for (int k = 0; k < (1 << R); ++k) x[PADI(base + k * g)] = v[k]; }
    __syncthreads();
}
template <int R> __device__ __forceinline__ void dit_pass(LAS f32x2* x, int m, int lh, int tid) {
    const int N = 1 << m; const float invN = 1.0f / (float)N; const int h = 1 << lh, S1 = (N >> 1) >> lh;
    for (int q = tid; q < (N >> R); q += 512) { const int j = q & (h - 1), blk = q >> lh, base = (blk << (lh + R)) + j;
        f32x2 v[1 << R];
#pragma unroll
        for (int k = 0; k < (1 << R); ++k) v[k] = x[PADI(base + k * h)];
        f32x2 wp[R]; wp[R - 1] = cconj(twid(j * (S1 >> (R - 1)), invN));
#pragma unroll
        for (int s = R - 2; s >= 0; --s) wp[s] = cmul(wp[s + 1], wp[s + 1]);
#pragma unroll
        for (int s = 0; s < R; ++s) { const int half = 1 << s;
#pragma unroll
            for (int k = 0; k < (1 << R); ++k) if (!(k & half)) { const f32x2 a = v[k];
                const f32x2 b = mul_w16(cmul(v[k + half], wp[s]), (16 - (k & (half - 1)) * (16 >> (s + 1))) & 15);
                v[k] = a + b; v[k + half] = a - b; } }
#pragma unroll
        for (int k = 0; k < (1 << R); ++k) x[PADI(base + k * h)] = v[k]; }
    __syncthreads();
}
__device__ __forceinline__ void fft_fwd(LAS f32x2* x, int m, int tid) {
    int lh = m - 1;
    while (lh + 1 >= 4) { dif_pass<4>(x, m, lh, tid); lh -= 4; }
    if (lh + 1 == 2) dif_pass<2>(x, m, 1, tid); else if (lh + 1 == 1) dif_pass<1>(x, m, 0, tid);
}
__device__ __forceinline__ void fft_inv(LAS f32x2* x, int m, int tid) {
    int lh = 0;
    while (m - lh >= 4) { dit_pass<4>(x, m, lh, tid); lh += 4; }
    if (m - lh == 2) dit_pass<2>(x, m, lh, tid); else if (m - lh == 1) dit_pass<1>(x, m, lh, tid);
}
__device__ __forceinline__ int brev(int k, int m) { return (int)(__brev((unsigned)k) >> (32 - m)); }

__device__ __forceinline__ void filt_unit(const Ctx& F, const ArgsV& AV, int l, int unit) {
    const int kind = unit >> 9, o = (unit >> 8) & 1, pair = unit & 255;
    const int n = kind ? LC : SEQ, m = kind ? 9 : 14, N = 2 * n, tid = F.tid;
    LAS f32x2* buf = (LAS f32x2*)F.lds;
    LAS float* W3 = (LAS float*)(F.lds + HY_SCR_OFF);
    LAS float* B3 = W3 + 256;
    LAS float* RED = B3 + 4;
    LAS float* INV = RED + 16;
    __syncthreads();
    if (tid < 4) { const int ci = tid; const int col = o * 1024 + (ci >> 1) * 512 + 2 * pair + (ci & 1); B3[ci] = AV.in(I_HYB3)[(size_t)l * 2048 + col]; }
    __syncthreads();
    const int lane = F.lane, q = lane >> 4, c = lane & 15;
    f16x8 wB0, wB1;
    { const int col = o * 1024 + ((c & 3) >> 1) * 512 + 2 * pair + (c & 1); const float* w3 = AV.in(I_HYW3) + (size_t)l * 64 * 2048 + col;
#pragma unroll
      for (int j = 0; j < 8; ++j) { wB0[j] = c < 4 ? (f16)w3[(size_t)(8 * q + j) * 2048] : (f16)0.f; wB1[j] = c < 4 ? (f16)w3[(size_t)(32 + 8 * q + j) * 2048] : (f16)0.f; } }
    const f16* H2H = (const f16*)(F.ws + WS_H2H) + (kind ? (size_t)SEQ * 64 : 0);
    const float lo = -3.0701134573253945f, hi = -15.350567286626973f;
    const float ra = fabsf(lo + (hi - lo) * (float)(2 * pair) / 511.0f), rb = fabsf(lo + (hi - lo) * (float)(2 * pair + 1) / 511.0f);
    const float rate = (c & 1) ? rb : ra, bias3 = B3[c & 3];
    float sabs = 0.f;
    for (int tile = F.wave; tile < (n >> 4); tile += 8) { const int t0 = tile * 16;
        const f16x8 a0 = *(const f16x8*)(H2H + (size_t)(t0 + c) * 64 + 8 * q), a1 = *(const f16x8*)(H2H + (size_t)(t0 + c) * 64 + 32 + 8 * q);
        f32x4 acc = (f32x4){0.f, 0.f, 0.f, 0.f};
        acc = __builtin_amdgcn_mfma_f32_16x16x32_f16(a0, wB0, acc, 0, 0, 0); acc = __builtin_amdgcn_mfma_f32_16x16x32_f16(a1, wB1, acc, 0, 0, 0);
        if (c < 4) {
#pragma unroll
            for (int i = 0; i < 4; ++i) { const int t = t0 + 4 * q + i; const float v = (acc[i] + bias3) * expf(-((float)t / (float)(n - 1)) * rate);
                LAS float* bp = (LAS float*)buf;
                if (c < 2) { bp[2 * PADI(t) + c] = v; sabs += fabsf(v); }
                else if (t >= 1) { bp[2 * PADI(N - t) + (c - 2)] = v; sabs += fabsf(v); } } }
    }
    float sa = (c == 0 || c == 2) ? sabs : 0.f, sb = (c == 1 || c == 3) ? sabs : 0.f;
    if (tid == 0) { float z0 = 0.f; asm volatile("" : "+v"(z0)); buf[PADI(n)] = (f32x2){z0, z0}; }
    sa = wave_sum(sa); sb = wave_sum(sb);
    if (F.lane == 0) { RED[F.wave * 2] = sa; RED[F.wave * 2 + 1] = sb; }
    __syncthreads();
    if (tid < 2) { float s = 0.f;
#pragma unroll
        for (int w = 0; w < 8; ++w) s += RED[w * 2 + tid];
        INV[tid] = 1.0f / (s + EPS); }
    __syncthreads();
    { const float ia = INV[0], ib = INV[1];
      for (int i = tid; i < N; i += 512) { f32x2 v = buf[PADI(i)]; v.x *= ia; v.y *= ib; buf[PADI(i)] = v; } }
    __syncthreads();
    fft_fwd(buf, m, tid);
    f32x4* out = (f32x4*)(F.ws + WS_FSD + (kind ? FSD_C_OFF : 0)) + (size_t)(o * 256 + pair) * (n + 1);
    for (int u = tid; u <= n; u += 512) { const int p = u < n ? 2 * u : 1, k = brev(p, m), pn = brev((N - k) & (N - 1), m);
        const f32x2 zk = buf[PADI(p)], zn = cconj(buf[PADI(pn)]);
        const f32x2 fa = (zk + zn) * 0.5f, df = zk - zn, fb = (f32x2){df.y * 0.5f, -df.x * 0.5f};
        const f32x2 fs = (fa + fb) * 0.5f, fd = (fa - fb) * 0.5f;
        out[u] = (f32x4){fs.x, fs.y, fd.x, fd.y}; }
    __syncthreads();
}

__device__ __forceinline__ void main_unit(const Ctx& F, const ArgsV& AV, int l, int unit) {
    const int kind = unit >> 9, b = (unit >> 8) & 1, pair = unit & 255;
    const int n = kind ? LC : SEQ, m = kind ? 9 : 14, N = 2 * n, tid = F.tid;
    const int row0 = kind ? MX + b * LC : b * SEQ;
    LAS f32x2* buf = (LAS f32x2*)F.lds;
    const f16* ZT = (const f16*)(F.ws + WS_ZT) + (size_t)(2 * pair) * MT + row0;
    const float* cw = AV.in(I_HYCW) + (size_t)l * 3 * 1536 + 2 * pair; const float* cb = AV.in(I_HYCB) + (size_t)l * 1536 + 2 * pair;
    f32x2 yv[16], g1[16], g2[16];
#pragma unroll
    for (int g = 0; g < 3; ++g)
#pragma unroll
        for (int cc = 0; cc < 2; ++cc) { const float w0 = cw[g * 512 + cc], w1 = cw[1536 + g * 512 + cc], w2 = cw[3072 + g * 512 + cc], bs = cb[g * 512 + cc];
            const f16* zt = ZT + (size_t)(g * 512 + cc) * MT;
#pragma unroll
            for (int gi = 0; gi < 2; ++gi) { const int t0 = 8 * (tid + 512 * gi);
                f16x8 mv; float pv = 0.f, nv = 0.f;
#pragma unroll
                for (int e = 0; e < 8; ++e) mv[e] = (f16)0.f;
                if (t0 < n) { mv = *(const f16x8*)(zt + t0); if (t0 > 0) pv = (float)zt[t0 - 1]; if (t0 + 8 < n) nv = (float)zt[t0 + 8]; }
#pragma unroll
                for (int e = 0; e < 8; ++e) { const float zm = e == 0 ? pv : (float)mv[e == 0 ? 0 : e - 1], zc = (float)mv[e], zp = e == 7 ? nv : (float)mv[e == 7 ? 7 : e + 1];
                    const float r = w0 * zm + w1 * zc + w2 * zp + bs;
                    if (g == 0) { if (cc == 0) yv[gi * 8 + e].x = r; else yv[gi * 8 + e].y = r; }
                    else if (g == 1) { if (cc == 0) g1[gi * 8 + e].x = r; else g1[gi * 8 + e].y = r; }
                    else { if (cc == 0) g2[gi * 8 + e].x = r; else g2[gi * 8 + e].y = r; } } } }
    const float invN = 1.0f / (float)N;
#pragma unroll
    for (int o = 0; o < 2; ++o) {
        __syncthreads();
        float z0 = 0.f; asm volatile("" : "+v"(z0));
#pragma unroll
        for (int gi = 0; gi < 2; ++gi) { const int t0 = 8 * (tid + 512 * gi);
            if (t0 < n) {
#pragma unroll
                for (int e = 0; e < 8; ++e) { buf[PADI(t0 + e)] = yv[gi * 8 + e]; buf[PADI(n + t0 + e)] = (f32x2){z0, z0}; } } }
        __syncthreads();
        fft_fwd(buf, m, tid);
        const f32x4* fsd = (const f32x4*)(F.ws + WS_FSD + (kind ? FSD_C_OFF : 0)) + (size_t)(o * 256 + pair) * (n + 1);
        for (int u = tid; u <= n; u += 512) { const int p = u < n ? 2 * u : 1, k = brev(p, m), pn = brev((N - k) & (N - 1), m);
            const f32x2 zk = buf[PADI(p)], zn = buf[PADI(pn)]; const f32x4 f = fsd[u]; const f32x2 fs = (f32x2){f[0], f[1]}, fd = (f32x2){f[2], f[3]};
            const f32x2 wk = cmul(zk, fs) + cmul(cconj(zn), fd), wn = cmul(zn, cconj(fs)) + cmul(cconj(zk), cconj(fd));
            buf[PADI(pn)] = wn; buf[PADI(p)] = wk; }
        __syncthreads();
        fft_inv(buf, m, tid);
        const float* hb = AV.in(I_HYBIAS) + ((size_t)l * 2 + o) * 512 + 2 * pair; const f32x2 bias = (f32x2){hb[0], hb[1]};
#pragma unroll
        for (int gi = 0; gi < 2; ++gi) { const int t0 = 8 * (tid + 512 * gi);
            if (t0 < n) {
#pragma unroll
                for (int e = 0; e < 8; ++e) { const f32x2 cv = buf[PADI(t0 + e)] * invN; const f32x2 gt = o == 0 ? g1[gi * 8 + e] : g2[gi * 8 + e];
                    yv[gi * 8 + e] = gt * (cv + yv[gi * 8 + e] * bias); } } }
    }
    f16* Y = (f16*)(F.ws + WS_YBT) + (size_t)(2 * pair) * MT + row0;
#pragma unroll
    for (int gi = 0; gi < 2; ++gi) { const int t0 = 8 * (tid + 512 * gi);
        if (t0 < n) { f16x8 oa, ob;
#pragma unroll
            for (int e = 0; e < 8; ++e) { oa[e] = (f16)yv[gi * 8 + e].x; ob[e] = (f16)yv[gi * 8 + e].y; }
            *(f16x8*)(Y + t0) = oa; *(f16x8*)(Y + MT + t0) = ob; } }
    __syncthreads();
}

__device__ __forceinline__ void ph_ybt_transpose(const Ctx& F) {
    LAS f16* T = (LAS f16*)F.lds;
    const f16* YBT = (const f16*)(F.ws + WS_YBT); f16* Y = (f16*)(F.ws + WS_YCAT);
    const bool bal = (F.G == 256);
    for (int it = 0; it < (bal ? 2 : (MT / 64 + F.G - 1) / F.G); ++it) {
        int rb;
        if (bal) { if (F.bid >= 132) rb = (F.bid - 132) + 124 * it; else if (F.bid < 16 && it == 0) rb = 248 + F.bid; else rb = -1; }
        else rb = F.bid + it * F.G;
        if (rb < 0 || rb >= MT / 64) continue;
        const int r0 = rb * 64;
        __syncthreads();
        { f16x8 tv[8];
#pragma unroll
          for (int i = 0; i < 8; ++i) tv[i] = *(const f16x8*)(YBT + (size_t)F.tid * MT + r0 + 8 * i);
          PIN8(tv[0], tv[1], tv[2], tv[3], tv[4], tv[5], tv[6], tv[7]);
#pragma unroll
          for (int i = 0; i < 8; ++i) *(LAS f16x8*)(T + F.tid * 72 + 8 * i) = tv[i]; }
        __syncthreads();
        const int row = F.tid >> 3, cg = F.tid & 7;
#pragma unroll
        for (int jj = 0; jj < 8; ++jj) { const int gidx = cg + 8 * jj; f16x8 o;
#pragma unroll
            for (int e = 0; e < 8; ++e) o[e] = T[(8 * gidx + e) * 72 + row];
            *(f16x8*)(Y + (size_t)(r0 + row) * 2048 + 512 + 8 * gidx) = o; }
    }
    __syncthreads();
}
#undef PADI
}

#ifndef PHMASK
#define PHMASK 0xFFFF
#endif
#define PH_EN(k) (((PHMASK) >> (k)) & 1)
#ifndef STAMP_MASK
#define STAMP_MASK 0
#endif
#ifndef STAMP_K
#define STAMP_K 1
#endif
#ifndef SUBMASK
#define SUBMASK 7
#endif
#define SUB_EN(k) (((SUBMASK) >> (k)) & 1)
constexpr int NPH = 2 + 12 * DEPTH;
constexpr int CW_Q = 8192;
__device__ __forceinline__ int q_pull(unsigned* ctr, volatile LAS int* slot) {
    __syncthreads();
    if (threadIdx.x == 0) *slot = (int)__hip_atomic_fetch_add(ctr, 1u, __ATOMIC_RELAXED, __HIP_MEMORY_SCOPE_AGENT);
    __syncthreads();
    return *slot;
}

__global__ void __launch_bounds__(512, 2) mk_fwd(Args args) {
    extern __shared__ __attribute__((aligned(16))) unsigned char lds_raw[];
    Ctx F; F.lds = (LAS unsigned char*)lds_raw; F.tid = threadIdx.x; F.lane = F.tid & 63; F.wave = __builtin_amdgcn_readfirstlane(F.tid >> 6);
    F.G = gridDim.x; F.bid = blockIdx.x; F.ws = args.ws;
    ArgsV AV; AV.out = args.out;
    const Ctx F0 = F;
#define FRESH() do { F.tid = opq(F0.tid); F.lane = F.tid & 63; F.wave = __builtin_amdgcn_readfirstlane(F.tid >> 6); } while (0)
    volatile LAS unsigned* MISC = (volatile LAS unsigned*)(F.lds + LDSCTL_OFF);
    if (F.tid < 64) MISC[F.tid] = 0u;
    __syncthreads();
    unsigned* barw = (unsigned*)(F.ws + WS_CTL) + CW_BAR;
    XcdBarrier bar; bar.bar = barw; bar.x = 0; bar.st = nullptr;
    const int lo = args.ph_lo, hi = args.ph_hi;
    if (hi - lo > 1) bar = xcd_barrier_post(barw, MISC + 8);
#define IN(k) (lo <= (k) && (k) < hi)
#define SEAM(k) do { if (IN(k) && IN((k) + 1)) xcd_barrier(bar); } while (0)
#if STAMP_MASK
    volatile LAS unsigned long long* TS = (volatile LAS unsigned long long*)(F.lds + LDSCTL_OFF + 128);
#define TSTART(k) do { if ((((STAMP_MASK) >> (k)) & 1) && blockIdx.x == 0 && threadIdx.x == 0) TS[0] = __builtin_amdgcn_s_memrealtime(); } while (0)
#define TSTOP(k) do { if ((((STAMP_MASK) >> (k)) & 1) && blockIdx.x == 0 && threadIdx.x == 0) TS[1] = TS[1] + (__builtin_amdgcn_s_memrealtime() - TS[0]); } while (0)
#else
#define TSTART(k) do {} while (0)
#define TSTOP(k) do {} while (0)
#endif
    unsigned char* ws = F.ws;
    const int rank160 = (F.bid + F.G - 160 % F.G) % F.G;

    TSTART(12);
    if (PH_EN(12) && IN(0)) { FRESH(); ph_prologue(F, AV); }
    SEAM(0);
    TSTOP(12);

    for (int l = 0; l < DEPTH; ++l) {
        const int pb = 1 + 12 * l;
        const float* modl = (const float*)(ws + WS_MOD) + (size_t)l * 3 * 12288;
        const bool ctx_on = l < DEPTH - 1;
        const int nMr = ctx_on ? MT / 256 : MX / 256, nrows = ctx_on ? MT : MX;
        TSTART(0);
        if (PH_EN(0) && IN(pb + 0)) {
            FRESH(); ph_convert_weights(F, AV, l);
            __syncthreads();
            FRESH(); if (F.bid < 32) s5_mats_group(F, AV, l, F.bid);
            FRESH(); ph_hyena_h2(F, AV, l);
            FRESH(); ph_norm(F, AV, l, 0, MT, l > 0 ? 11 : 0);
        }
        SEAM(pb + 0);
        TSTOP(0);
        TSTART(1);
        if (PH_EN(1) && IN(pb + 1)) {
            pg8::SchedPlain S; S.init(MT / 256, WINN / 256, F.G, F.bid); S.A = (const char*)(ws + WS_HN); S.B = (const char*)(ws + WS_WIN); S.aTile = (size_t)256 * 2048 * 2; S.bTile = (size_t)256 * 2048 * 2;
            pg8::EpiPx E{(f16*)(ws + WS_PX), (f16*)(ws + WS_S5A), (f16*)(ws + WS_ZT), (f16*)(ws + WS_GTL)};
            pg8::gemm_phase(F.lds, 2048, 2048, 32, S, E);
        }
        SEAM(pb + 1);
        TSTOP(1);
        TSTART(2);
        if (PH_EN(2) && IN(pb + 2)) {
            TSTART(16);
            if (SUB_EN(0)) { pg8::SchedS5 S{(const char*)(ws + WS_S5A), (const char*)(ws + WS_S5M), (size_t)256 * 256 * 2, F.G, F.bid};
              pg8::EpiS5In E{(float*)(ws + WS_S5S)};
              pg8::gemm_phase(F.lds, 16384, 256, 4, S, E); }
            TSTOP(16);
            { unsigned* qc = (unsigned*)(ws + WS_CTL) + CW_Q + (l * 2 + 0) * 64; volatile LAS int* slot = (volatile LAS int*)(MISC + 16);
              for (;;) { const int u = q_pull(qc, slot); if (u >= 264 + 1024) break;
                  if (u < 264) { TSTART(17); FRESH(); gla::gla_unit<false>(F, AV, l, u); TSTOP(17); } else { TSTART(18); FRESH(); hy::filt_unit(F, AV, l, u - 264); TSTOP(18); } } }
        }
        SEAM(pb + 2);
        TSTOP(2);
        TSTART(3);
        if (PH_EN(3) && IN(pb + 3)) { FRESH(); ph_s5_scan(F); FRESH(); gla::ph_gla_scan(F); }
        SEAM(pb + 3);
        TSTOP(3);
        TSTART(4);
        if (PH_EN(4) && IN(pb + 4)) {
            TSTART(19);
            if (SUB_EN(0)) { pg8::SchedS5 S{(const char*)(ws + WS_S5A), (const char*)(ws + WS_S5W), (size_t)256 * 512 * 2, F.G, F.bid};
              pg8::EpiS5Out E{(const f16*)(ws + WS_S5A), (f16*)(ws + WS_YAPRE), AV.in(I_S5D) + (size_t)l * 512};
              pg8::gemm_phase(F.lds, 16384, 512, 8, S, E); }
            TSTOP(19);
            { unsigned* qc = (unsigned*)(ws + WS_CTL) + CW_Q + (l * 2 + 1) * 64; volatile LAS int* slot = (volatile LAS int*)(MISC + 16);
              for (;;) { const int u = q_pull(qc, slot); if (u >= 264 + 1024) break;
                  if (u < 264) { TSTART(20); FRESH(); gla::gla_unit<true>(F, AV, l, u); TSTOP(20); } else { TSTART(21); FRESH(); hy::main_unit(F, AV, l, u - 264); TSTOP(21); } } }
        }
        SEAM(pb + 4);
        TSTOP(4);
        TSTART(5);
        if (PH_EN(5) && IN(pb + 5)) {
            pg8::SchedPlain S; S.init(nMr, 2, F.G, F.bid); S.A = (const char*)(ws + WS_YAPRE); S.B = (const char*)(ws + WS_WGLU); S.aTile = (size_t)256 * 512 * 2; S.bTile = (size_t)256 * 512 * 2;
            pg8::EpiGlu E{(const f16*)(ws + WS_YAPRE), (f16*)(ws + WS_YCAT), AV.in(I_GLUB) + (size_t)l * 512};
            pg8::gemm_phase(F.lds, 512, 512, 8, S, E);
            FRESH(); hy::ph_ybt_transpose(F);
        }
        SEAM(pb + 5);
        TSTOP(5);
        TSTART(6);
        if (PH_EN(6) && IN(pb + 6)) {
            pg8::SchedPlain S; S.init(nMr, 8, F.G, F.bid); S.aTile = (size_t)256 * 2048 * 2; S.bTile = (size_t)256 * 2048 * 2;
            S.A = (const char*)(ws + WS_YCAT); S.B = (const char*)(ws + WS_WBR);
            pg8::EpiBranchF E{(const f16*)(ws + WS_GTL), (f16*)(ws + WS_MBUF)};
            TSTART(24);
            pg8::gemm_phase(F.lds, 2048, 2048, 32, S, E);
            TSTOP(24);
#ifdef PG_DUMMY
            { pg8::EpiF16 E9{(f16*)(ws + WS_ACT), 2048}; pg8::gemm_phase(F.lds, 2048, 2048, 32, S, E9); }
#endif
        }
        SEAM(pb + 6);
        TSTOP(6);
        TSTART(7);
        if (PH_EN(7) && IN(pb + 7)) {
            pg8::SchedPlain S; S.init(MX / 256, 8, F.G, F.bid); S.A = (const char*)(ws + WS_MBUF); S.B = (const char*)(ws + WS_WOUT); S.aTile = (size_t)256 * 2048 * 2; S.bTile = (size_t)256 * 2048 * 2;
            pg8::EpiResid E{(float*)(ws + WS_XRES), modl, 4096};
            pg8::gemm_phase(F.lds, 2048, 2048, 32, S, E);
            if (ctx_on) { pg8::SchedSplit S2{(const char*)(ws + WS_MBUF), (const char*)(ws + WS_WOUT), (size_t)256 * 2048 * 2, (size_t)256 * 2048 * 2, (size_t)8 * 128, 4, F.G, F.bid};
                pg8::EpiSlab E2{(float*)(ws + WS_SLAB), modl, 4096};
                pg8::gemm_phase(F.lds, 2048, 2048, 8, S2, E2); }
        }
        SEAM(pb + 7);
        TSTOP(7);
        TSTART(8);
        if (PH_EN(8) && IN(pb + 8)) { FRESH(); ph_norm(F, AV, l, 1, nrows, 4); }
        SEAM(pb + 8);
        TSTOP(8);
        TSTART(9);
        if (PH_EN(9) && IN(pb + 9)) {
            pg8::SchedPlain S; S.init(nMr, UPLD / 256, F.G, F.bid); S.A = (const char*)(ws + WS_HN); S.B = (const char*)(ws + WS_WUP); S.aTile = (size_t)256 * 2048 * 2; S.bTile = (size_t)256 * 2048 * 2;
            pg8::EpiUpAct E{(f16*)(ws + WS_ACT), (float*)(ws + WS_HALO), AV.in(I_FFCW) + (size_t)l * 3 * FFH, AV.in(I_FFCB) + (size_t)l * FFH, (LAS float*)(F.lds + EXTRA_OFF)};
            pg8::gemm_phase(F.lds, 2048, 2048, 32, S, E);
        }
        SEAM(pb + 9);
        TSTOP(9);
        TSTART(10);
        if (PH_EN(10) && IN(pb + 10)) { FRESH(); ph_ffn_fix(F, AV, l, nMr); }
        SEAM(pb + 10);
        TSTOP(10);
        TSTART(11);
        if (PH_EN(11) && IN(pb + 11)) {
            pg8::SchedPlain S; S.init(MX / 256, 8, F.G, F.bid); S.A = (const char*)(ws + WS_ACT); S.B = (const char*)(ws + WS_WDN); S.aTile = (size_t)256 * FFH * 2; S.bTile = (size_t)256 * FFH * 2;
            pg8::EpiResid E{(float*)(ws + WS_XRES), modl, 10240};
            pg8::gemm_phase(F.lds, FFH, FFH, FFH / 64, S, E);
            if (ctx_on) { pg8::SchedSplit S2{(const char*)(ws + WS_ACT), (const char*)(ws + WS_WDN), (size_t)256 * FFH * 2, (size_t)256 * FFH * 2, (size_t)8 * 128, 11, F.G, F.bid};
                pg8::EpiSlab E2{(float*)(ws + WS_SLAB), modl, 10240};
                pg8::gemm_phase(F.lds, FFH, FFH, 8, S2, E2); }
        }
        SEAM(pb + 11);
        TSTOP(11);
    }
    if (PH_EN(13) && IN(NPH - 1)) { FRESH(); ph_final_norm(F, AV); }
#if STAMP_MASK
    if (blockIdx.x == 0 && threadIdx.x == 0) { const unsigned long long t0 = __builtin_amdgcn_s_memrealtime(); while (__builtin_amdgcn_s_memrealtime() - t0 < (unsigned long long)(STAMP_K) * TS[1]) __builtin_amdgcn_s_sleep(8); }
#endif
#undef IN
#undef SEAM
#undef FRESH
}

extern "C" void kernel_launch(void* const* d_in, const int* in_sizes, int n_in, void* d_out, int out_size, void* d_ws, size_t ws_size, hipStream_t stream) {
    static int grid = 0;
    if (grid == 0) {
        if (n_in != 40 || out_size != MX * D || ws_size < WS_END) { fprintf(stderr, "kernel_launch: unexpected problem (n_in %d out %d ws %zu, need %zu)\n", n_in, out_size, ws_size, (size_t)WS_END); grid = -1; return; }
        int dev = 0, cus = 0, per_cu = 0;
        if (hipGetDevice(&dev) != hipSuccess || hipDeviceGetAttribute(&cus, hipDeviceAttributeMultiprocessorCount, dev) != hipSuccess) { grid = -1; return; }
        if (hipFuncSetAttribute((const void*)mk_fwd, hipFuncAttributeMaxDynamicSharedMemorySize, LDS_BYTES) != hipSuccess) { fprintf(stderr, "kernel_launch: hipFuncSetAttribute failed\n"); grid = -1; return; }
        if (hipOccupancyMaxActiveBlocksPerMultiprocessor(&per_cu, (const void*)mk_fwd, 512, LDS_BYTES) != hipSuccess || per_cu < 1)
            fprintf(stderr, "kernel_launch: occupancy query reports %d\n", per_cu);
        (void)hipGetLastError();
        grid = cus;
    }
    if (grid < 0) return;
    if (hipMemsetAsync((char*)d_ws + WS_CTL, 0, CTL_ZERO_BYTES, stream) != hipSuccess) return;
    Args a{};
    for (int i = 0; i < 40; ++i) a.in[i] = (const float*)d_in[i];
    a.out = (float*)d_out; a.ws = (unsigned char*)d_ws;
#if MK_ONE
    a.ph_lo = 0; a.ph_hi = NPH;
    hipLaunchKernelGGL(mk_fwd, dim3(grid), dim3(512), LDS_BYTES, stream, a);
#else
    for (int p = 0; p < NPH; ++p) { a.ph_lo = p; a.ph_hi = p + 1; hipLaunchKernelGGL(mk_fwd, dim3(grid), dim3(512), LDS_BYTES, stream, a); }
#endif
}
```

```cpp
#include <hip/hip_runtime.h>
#include <stdio.h>

#ifndef MK_ONE
#define MK_ONE 1
#define STAMP_MASK 0
#define STAMP_K 1
#endif

#define GAS __attribute__((address_space(1)))
#define LAS __attribute__((address_space(3)))
typedef _Float16 f16;
typedef _Float16 f16x8 __attribute__((ext_vector_type(8)));
typedef _Float16 f16x4 __attribute__((ext_vector_type(4)));
typedef _Float16 f16x2 __attribute__((ext_vector_type(2)));
typedef float f32x4 __attribute__((ext_vector_type(4)));
typedef float f32x2 __attribute__((ext_vector_type(2)));

constexpr int D = 2048, NB = 2, SEQ = 8192, LC = 256, DEPTH = 4;
constexpr int MX = NB * SEQ, MC = NB * LC, MT = MX + MC;
constexpr int PXLD = 3840, WINN = 11520, FFH = 5632, UPLD = 2 * FFH;
constexpr int P_S5 = 0, P_GK = 512, P_GV = 1024, P_GQ = 2048, P_GR = 2560, P_HY = 3584, P_MG = 5120, P_GG = 3584, W_GG = 11264;
constexpr int INW = 11296;
constexpr int NCHK = 1056;
constexpr float S5SCALE = 1024.f;
constexpr float EPS = 1e-6f;
constexpr int NSC = 33;

constexpr size_t MiB = 1u << 20;
constexpr size_t WS_CTL = 0, CTL_ZERO_BYTES = 1 * MiB;
constexpr size_t WS_MOD = 1 * MiB;
constexpr size_t WS_TW = 2 * MiB;
constexpr size_t WS_S5AT = 3 * MiB;
constexpr size_t WS_WIN = 4 * MiB;
constexpr size_t WS_WGLU = WS_WIN + 45 * MiB;
constexpr size_t WS_WBR = WS_WGLU + 1 * MiB;
constexpr size_t WS_WOUT = WS_WBR + 8 * MiB;
constexpr size_t WS_WUP = WS_WOUT + 8 * MiB;
constexpr size_t WS_WDN = WS_WUP + 44 * MiB;
constexpr size_t WS_S5W = WS_WDN + 22 * MiB;
constexpr size_t WS_S5M = WS_S5W + 8 * MiB;
constexpr size_t WS_H2 = WS_S5M + 4 * MiB;
constexpr size_t WS_FSD = WS_H2 + 3 * MiB;
constexpr size_t FSD_C_OFF = (size_t)2 * 256 * 8193 * 16;
constexpr size_t WS_XRES = WS_FSD + 68 * MiB;
constexpr size_t WS_HN = WS_XRES + 132 * MiB;
constexpr size_t WS_PX = WS_HN + 66 * MiB;
constexpr size_t WS_S5A = WS_PX + 372 * MiB;
constexpr size_t WS_S5S = WS_S5A + 40 * MiB;
constexpr size_t WS_YAPRE = WS_S5S + 40 * MiB;
constexpr size_t WS_YCAT = WS_YAPRE + 20 * MiB;
constexpr size_t WS_MBUF = WS_YCAT + 66 * MiB;
constexpr size_t WS_GSLOC = WS_MBUF + 66 * MiB;
constexpr size_t WS_GSIN = WS_GSLOC + 66 * MiB;
constexpr size_t WS_GOF = WS_GSIN + 66 * MiB;
constexpr size_t WS_GDT = WS_GOF + 66 * MiB;
constexpr size_t WS_ACT = WS_GSLOC;
constexpr size_t WS_ZT = WS_GDT + 1 * MiB;
constexpr size_t WS_YBT = WS_ZT + 50 * MiB;
constexpr size_t WS_SLAB = WS_YBT + 17 * MiB;
constexpr size_t WS_HALO = WS_SLAB + 44 * MiB;
constexpr size_t WS_GTL = WS_HALO + 9 * MiB;
constexpr size_t WS_H2H = WS_GTL + 198 * MiB;
constexpr size_t WS_END = WS_H2H + 2 * MiB;
static_assert((size_t)MT * FFH * 2 <= 198 * MiB, "ACT overlay");
constexpr int CW_BAR = 4096;

constexpr int RING_BYTES = 131072;
constexpr int EXTRA_OFF = RING_BYTES, EXTRA_BYTES = 8192;
constexpr int LDSCTL_OFF = EXTRA_OFF + EXTRA_BYTES;
constexpr int LDS_BYTES = LDSCTL_OFF + 256;

__device__ __forceinline__ float wave_sum(float v) {
#pragma unroll
    for (int o = 1; o < 64; o <<= 1) v += __shfl_xor(v, o);
    return v;
}
__device__ __forceinline__ float sigmoidf_(float x) { return 1.0f / (1.0f + __expf(-x)); }
__device__ __forceinline__ float siluf_(float x) { return x * sigmoidf_(x); }
__device__ __forceinline__ float gelu_tanh_(float x) { const float u = 0.7978845608028654f * (x + 0.044715f * x * x * x); return x / (1.0f + __expf(-2.0f * u)); }
__device__ __forceinline__ float logsigmoidf_(float x) { return fminf(x, 0.f) - __logf(1.0f + __expf(-fabsf(x))); }
__device__ __forceinline__ f32x2 cmul(f32x2 a, f32x2 b) { return (f32x2){a.x * b.x - a.y * b.y, a.x * b.y + a.y * b.x}; }
__device__ __forceinline__ f32x2 cconj(f32x2 a) { return (f32x2){a.x, -a.y}; }
__device__ __forceinline__ int opq(int x) { asm volatile("" : "+v"(x)); return x; }
#define PIN8(a, b, c, d, e, f, g, h) asm volatile("" : "+v"(a), "+v"(b), "+v"(c), "+v"(d), "+v"(e), "+v"(f), "+v"(g), "+v"(h))
#define PIN4(a, b, c, d) asm volatile("" : "+v"(a), "+v"(b), "+v"(c), "+v"(d))
#define LDS_WAIT() asm volatile("s_waitcnt lgkmcnt(0)" ::: "memory")
#define VM_WAIT() asm volatile("s_waitcnt vmcnt(0)" ::: "memory")

#define XB_TMO      128
#define XB_XCNT(j)  (256  + 64 * (j))
#define XB_XSUB(j)  (1280 + 64 * (j))
#define XB_XGEN(j)  (2304 + 64 * (j))
#define XB_TOP      3328
#define XB_TOPGEN   3392
#define XCD_BAR_WORDS 3456
#define XB_SPIN_CAP (1u << 18)
__device__ __forceinline__ unsigned xb_ld(unsigned* p)              { return __hip_atomic_load(p, __ATOMIC_RELAXED, __HIP_MEMORY_SCOPE_AGENT); }
__device__ __forceinline__ unsigned xb_add(unsigned* p, unsigned v) { return __hip_atomic_fetch_add(p, v, __ATOMIC_RELAXED, __HIP_MEMORY_SCOPE_AGENT); }
__device__ __forceinline__ unsigned xb_xcc_id() { return (unsigned)__builtin_amdgcn_s_getreg((3 << 11) | 20) & 0xFu; }
#define XB_SPIN(cond, bar) do { unsigned _sp = 0; while (cond) { __builtin_amdgcn_s_sleep(1); \
    if ((++_sp & 255u) == 0u) { if (xb_ld(&(bar)[XB_TMO])) break; if (_sp > XB_SPIN_CAP) { atomicAdd(&(bar)[XB_TMO], 1u); break; } } } } while (0)
struct XcdBarrier { unsigned* bar; unsigned x; volatile LAS unsigned* st; };
__device__ __forceinline__ XcdBarrier xcd_barrier_post(unsigned* bar, volatile LAS unsigned* st) {
    XcdBarrier b; b.bar = bar; b.x = xb_xcc_id(); b.st = st;
    if (threadIdx.x == 0) (void)xb_add(&bar[XB_XCNT(b.x)], 1u);
    return b;
}
__device__ __forceinline__ void xcd_barrier_complete(unsigned* bar, unsigned x, unsigned& nloc, unsigned& nx) {
    const unsigned G = gridDim.x * gridDim.y * gridDim.z;
    unsigned sum, cnt, mine, sp = 0u;
    for (;;) {
        sum = 0u; cnt = 0u; mine = 0u;
#pragma unroll
        for (unsigned j = 0; j < 16; ++j) { const unsigned c = xb_ld(&bar[XB_XCNT(j)]); sum += c; cnt += (c > 0u) ? 1u : 0u; mine = (j == x) ? c : mine; }
        if (sum == G) break;
        __builtin_amdgcn_s_sleep(1);
        if ((++sp & 255u) == 0u) { if (xb_ld(&bar[XB_TMO])) break; if (sp > XB_SPIN_CAP) { atomicAdd(&bar[XB_TMO], 1u); break; } }
    }
    nloc = mine > 0u ? mine : 1u; nx = cnt > 0u ? cnt : 1u;
}
__device__ __forceinline__ void xcd_barrier(const XcdBarrier& b) {
    asm volatile("s_waitcnt vmcnt(0)" ::: "memory");
    __syncthreads();
    if (threadIdx.x == 0) {
        unsigned* bar = b.bar;
        __builtin_amdgcn_s_waitcnt(0);
        unsigned nloc = b.st[0], nx = b.st[1];
        if (nloc == 0u) { xcd_barrier_complete(bar, b.x, nloc, nx); b.st[0] = nloc; b.st[1] = nx; }
        const unsigned old = xb_add(&bar[XB_XSUB(b.x)], 1u);
        const unsigned gen = old / nloc;
        if (old + 1u == (gen + 1u) * nloc) {
            __builtin_amdgcn_fence(__ATOMIC_RELEASE, "agent");
            asm volatile("s_waitcnt vmcnt(0)" ::: "memory");
            const unsigned og = xb_add(&bar[XB_TOP], 1u);
            const unsigned tg = og / nx;
            if (og + 1u == (tg + 1u) * nx) xb_add(&bar[XB_TOPGEN], 1u);
            else XB_SPIN(xb_ld(&bar[XB_TOPGEN]) == tg, bar);
            __builtin_amdgcn_fence(__ATOMIC_ACQUIRE, "agent");
            xb_add(&bar[XB_XGEN(b.x)], 1u);
            asm volatile("s_waitcnt vmcnt(0)" ::: "memory");
        } else {
            XB_SPIN(xb_ld(&bar[XB_XGEN(b.x)]) == gen, bar);
            __builtin_amdgcn_fence(__ATOMIC_ACQUIRE, "agent");
            asm volatile("s_waitcnt vmcnt(0)" ::: "memory");
        }
    }
    __syncthreads();
}

struct Args {
    const float* in[40];
    float* out; unsigned char* ws;
    int ph_lo, ph_hi;
};
struct ArgsV {
    __device__ __forceinline__ const float* in(int i) const {
        typedef const __attribute__((address_space(4))) unsigned long long* kp_t;
        kp_t ka = (kp_t)__builtin_amdgcn_kernarg_segment_ptr();
        return (const float*)(*(volatile const __attribute__((address_space(4))) unsigned long long*)(ka + i)); }
    float* out;
};
struct Ctx {
    LAS unsigned char* lds;
    int tid, lane, wave, G, bid;
    unsigned char* ws;
};
enum { I_X = 0, I_C, I_CTX, I_CCTX, I_WMOD, I_BMOD, I_N1G, I_N2G, I_WIN, I_S5ARE, I_S5AIM, I_S5STEP, I_S5BRE, I_S5BIM, I_S5CRE, I_S5CIM,
       I_S5D, I_GLUW, I_GLUB, I_HYCW, I_HYCB, I_HYW1, I_HYB1, I_HYF1, I_HYW2, I_HYB2, I_HYF2, I_HYW3, I_HYB3, I_HYBIAS,
       I_GLAWG, I_GLABG, I_GLANG, I_WBR, I_WOUT, I_WUP, I_FFCW, I_FFCB, I_WDN, I_FNG };

namespace pg8 {
constexpr int BM = 256, BK = 64, HALF = 128, HTB = HALF * BK * 2, STAGE_BYTES = 8 * HTB, NXCD = 8, WGM = 8;
__device__ __forceinline__ int lds_byte(int r, int c) { const int st = (r >> 4) * 2 + (c >> 5), rr = r & 15, cc = c & 31, ob = rr * 64 + cc * 2; return st * 1024 + (ob ^ (((ob >> 9) & 1) << 5)); }
__device__ __forceinline__ void stage_rc(int b, int& R, int& C) { const int st = b / 1024, sb = b % 1024, swz = sb ^ (((sb >> 9) & 1) << 5); R = (st >> 1) * 16 + swz / 64; C = (st & 1) * 32 + (swz % 64) / 2; }
__device__ __forceinline__ int perm32(int rho) { const int n = rho >> 4, i = rho & 15; return 8 * (i >> 2) + 4 * n + (i & 3); }
struct Unit { const char* a; const char* b; int pm, pn; };
struct Order2D {
    int nM, nN, nwg, G, c;
    __device__ __forceinline__ void init(int nM_, int nN_, int G_, int c_) { nM = nM_; nN = nN_; nwg = nM * nN; G = G_; c = c_; }
    __device__ __forceinline__ bool nx(int i, int& pm, int& pn) const {
        const long L = (long)i * G + c; if (L >= nwg) return false;
        int wgid = (int)L; { const int q = nwg / NXCD, r = nwg % NXCD, xcd = wgid % NXCD, off = wgid / NXCD; wgid = (xcd < r ? xcd * (q + 1) : r * (q + 1) + (xcd - r) * q) + off; }
        const int nig = WGM * nN, gid = wgid / nig, fm = gid * WGM, gsz = (nM - fm) < WGM ? (nM - fm) : WGM;
        pm = fm + ((wgid % nig) % gsz); pn = (wgid % nig) / gsz; return true;
    }
};
struct SchedPlain : Order2D {
    const char* A; const char* B; size_t aTile, bTile;
    __device__ __forceinline__ bool next(int i, Unit& u) const { int pm, pn; if (!nx(i, pm, pn)) return false; u.pm = pm; u.pn = pn; u.a = A + (size_t)pm * aTile; u.b = B + (size_t)pn * bTile; return true; }
};
struct SchedSplit {
    const char* A; const char* B; size_t aTile, bTile, ksub; int nsplit, G, c;
    __device__ __forceinline__ bool next(int i, Unit& u) const { const int L = i * G + c; if (L >= 16 * nsplit) return false; const int t = L / nsplit, ks = L % nsplit, pm = 64 + (t >> 3), pn = t & 7;
        u.pm = pm; u.pn = pn | (ks << 8); u.a = A + (size_t)pm * aTile + (size_t)ks * ksub; u.b = B + (size_t)pn * bTile + (size_t)ks * ksub; return true; }
};
struct SchedS5 {
    const char* A; const char* B; size_t bGroup; int G, c;
    __device__ __forceinline__ bool next(int i, Unit& u) const { const int L = i * G + c; if (L >= 160) return false; const int g = L & 31, pm = L >> 5;
        u.pm = pm; u.pn = g; u.a = A + ((size_t)pm * 256 * 16384 + (size_t)g * 512) * 2; u.b = B + (size_t)g * bGroup; return true; }
};

#define PG8_SA(b, h) (((b) * 2 + (h)) * HTB)
#define PG8_SB(b, h) ((4 + (b) * 2 + (h)) * HTB)
#define PG8_STAGE(bufoff, gbase, voff) do { _Pragma("unroll") for (int _i = 0; _i < 2; ++_i) \
        __builtin_amdgcn_global_load_lds((const unsigned*)((const char*)(gbase) + (voff)[_i]), (LAS unsigned*)(lds + (bufoff) + ldsw + _i * 8192), 16, 0, 0); } while (0)
#define PG8_LDA(dst, b, h) do { _Pragma("unroll") for (int m = 0; m < 4; ++m) _Pragma("unroll") for (int k = 0; k < 2; ++k) dst[m][k] = *(const LAS f16x8*)(lds + PG8_SA(b, h) + aoff + m * 2048 + k * 1024); } while (0)
#define PG8_LDB(dst, b, h) do { _Pragma("unroll") for (int n = 0; n < 2; ++n) _Pragma("unroll") for (int k = 0; k < 2; ++k) dst[n][k] = *(const LAS f16x8*)(lds + PG8_SB(b, h) + boff + n * 2048 + k * 1024); } while (0)
#define PG8_MMA(ai, bj, At, Bt) do { __builtin_amdgcn_s_setprio(1); _Pragma("unroll") for (int m = 0; m < 4; ++m) _Pragma("unroll") for (int n = 0; n < 2; ++n) _Pragma("unroll") for (int k = 0; k < 2; ++k) \
        acc[ai][bj][m][n] = __builtin_amdgcn_mfma_f32_16x16x32_f16(Bt[n][k], At[m][k], acc[ai][bj][m][n], 0, 0, 0); __builtin_amdgcn_s_setprio(0); } while (0)
#define PG8_WAIT_V(n) asm volatile("s_waitcnt vmcnt(" #n ")" ::: "memory")
#define PG8_WAIT_L(n) asm volatile("s_waitcnt lgkmcnt(" #n ")" ::: "memory")
#define PG8_BAR __builtin_amdgcn_s_barrier()
#define PG8_SCHED __builtin_amdgcn_sched_barrier(0)

template <class Epi, class Sched>
__device__ __forceinline__ void gemm_phase(LAS unsigned char* lds, const int lda, const int ldb, const int nt, const Sched& S, const Epi& E) {
    const int tid = opq((int)threadIdx.x), wid = __builtin_amdgcn_readfirstlane(tid >> 6), lane = tid & 63, wr = wid >> 2, wc = wid & 3, fr = lane & 15, fq = lane >> 4;
    unsigned voffA[2], voffB[2];
#pragma unroll
    for (int i = 0; i < 2; ++i) { int R, C; stage_rc(tid * 16 + i * 8192, R, C); const int Rb = Epi::PERM ? ((R & ~31) + perm32(R & 31)) : R;
        voffA[i] = (unsigned)(R * lda + C) * 2u; voffB[i] = (unsigned)(Rb * ldb + C) * 2u; }
    const size_t kstep = (size_t)(BK * 2);
    const size_t hstepA = (size_t)HALF * lda * 2, hstepB = (size_t)HALF * ldb * 2;
    const unsigned ldsw = (unsigned)wid * 1024u;
    const int aoff = lds_byte(wr * 64 + fr, fq * 8), boff = lds_byte(wc * 32 + fr, fq * 8);
    Unit cur, nxt; int ui = 0;
    if (!S.next(0, cur)) return;
    f32x4 acc[2][2][4][2];
#pragma unroll
    for (int a = 0; a < 2; ++a)
#pragma unroll
        for (int b = 0; b < 2; ++b)
#pragma unroll
            for (int m = 0; m < 4; ++m)
#pragma unroll
                for (int n = 0; n < 2; ++n) acc[a][b][m][n] = (f32x4){0.f, 0.f, 0.f, 0.f};
    f16x8 At[4][2], B0[2][2], B1[2][2];
    const char* cA = cur.a; const char* cB = cur.b;
    PG8_STAGE(PG8_SB(0, 0), cB, voffB); PG8_STAGE(PG8_SA(0, 0), cA, voffA); PG8_STAGE(PG8_SB(0, 1), cB + hstepB, voffB); PG8_STAGE(PG8_SA(0, 1), cA + hstepA, voffA);
    if (wr == 1) PG8_BAR;
    PG8_WAIT_V(4); PG8_BAR;
    PG8_STAGE(PG8_SB(1, 0), cB + kstep, voffB); PG8_STAGE(PG8_SA(1, 0), cA + kstep, voffA); PG8_STAGE(PG8_SB(1, 1), cB + hstepB + kstep, voffB);
    PG8_WAIT_V(6); PG8_BAR;
    for (;;) {
        const bool has_next = S.next(ui + 1, nxt);
        const char* nA = has_next ? nxt.a : cA; const char* nB = has_next ? nxt.b : cB;
        constexpr int NSEG = Epi::HAS_MID ? 3 : 1;
#pragma unroll
        for (int seg = 0; seg < NSEG; ++seg) {
        const int tb = Epi::HAS_MID ? (seg == 0 ? 0 : (seg == 1 ? Epi::MID1 + 2 : Epi::MID2 + 2)) : 0;
        const int te = Epi::HAS_MID ? (seg == 0 ? Epi::MID1 + 2 : (seg == 1 ? Epi::MID2 + 2 : nt)) : nt;
        for (int t = tb; t < te; t += 2) {
            const bool last = (t == nt - 2);
            const char* a1 = cA + (size_t)(t + 1) * kstep;
            const char* a2 = last ? nA : cA + (size_t)(t + 2) * kstep; const char* b2 = last ? nB : cB + (size_t)(t + 2) * kstep;
            const char* a3 = a2 + kstep; const char* b3 = b2 + kstep;
            PG8_LDB(B0, 0, 0); PG8_SCHED; PG8_LDA(At, 0, 0); PG8_STAGE(PG8_SA(1, 1), a1 + hstepA, voffA);
            PG8_WAIT_L(8); PG8_BAR; PG8_WAIT_L(0); PG8_MMA(0, 0, At, B0); PG8_BAR; PG8_SCHED;
            PG8_LDB(B1, 0, 1); PG8_STAGE(PG8_SB(0, 0), b2, voffB);
            PG8_BAR; PG8_WAIT_L(0); PG8_MMA(0, 1, At, B1); PG8_BAR;
            PG8_LDA(At, 0, 1); PG8_STAGE(PG8_SA(0, 0), a2, voffA);
            PG8_BAR; PG8_WAIT_L(0); PG8_MMA(1, 0, At, B0); PG8_BAR; PG8_SCHED;
            PG8_STAGE(PG8_SB(0, 1), b2 + hstepB, voffB);
            PG8_WAIT_V(6); PG8_BAR; PG8_MMA(1, 1, At, B1); PG8_BAR;
            PG8_LDB(B0, 1, 0); PG8_SCHED; PG8_LDA(At, 1, 0); PG8_STAGE(PG8_SA(0, 1), a2 + hstepA, voffA);
            PG8_WAIT_L(8); PG8_BAR; PG8_WAIT_L(0); PG8_MMA(0, 0, At, B0); PG8_BAR; PG8_SCHED;
            PG8_LDB(B1, 1, 1); PG8_STAGE(PG8_SB(1, 0), b3, voffB);
            PG8_BAR; PG8_WAIT_L(0); PG8_MMA(0, 1, At, B1); PG8_BAR;
            PG8_LDA(At, 1, 1); PG8_STAGE(PG8_SA(1, 0), a3, voffA);
            PG8_BAR; PG8_WAIT_L(0); PG8_MMA(1, 0, At, B0); PG8_BAR; PG8_SCHED;
            PG8_STAGE(PG8_SB(1, 1), b3 + hstepB, voffB);
            PG8_WAIT_V(6); PG8_BAR; PG8_MMA(1, 1, At, B1); PG8_BAR;
        }
        if constexpr (Epi::HAS_MID) { if (seg < 2) {
            E.mid(acc, cur, seg, wr, wc, fr, fq);
        } }
        }
#if STAMP_MASK & (1 << 23)
        if (Epi::HAS_MID && blockIdx.x == 0 && threadIdx.x == 0) ((volatile LAS unsigned long long*)(lds + LDSCTL_OFF + 128))[0] = __builtin_amdgcn_s_memrealtime();
#endif
        E(acc, cur, wr, wc, fr, fq);
#if STAMP_MASK & (1 << 23)
        if (Epi::HAS_MID && blockIdx.x == 0 && threadIdx.x == 0) { volatile LAS unsigned long long* TS = (volatile LAS unsigned long long*)(lds + LDSCTL_OFF + 128); TS[1] = TS[1] + (__builtin_amdgcn_s_memrealtime() - TS[0]); }
#endif
        if (!has_next) break;
#pragma unroll
        for (int a = 0; a < 2; ++a)
#pragma unroll
            for (int b = 0; b < 2; ++b)
#pragma unroll
                for (int m = 0; m < 4; ++m)
#pragma unroll
                    for (int n = 0; n < 2; ++n) acc[a][b][m][n] = (f32x4){0.f, 0.f, 0.f, 0.f};
        cur = nxt; cA = nA; cB = nB; ++ui;
    }
    PG8_WAIT_V(0);
    if (wr == 0) PG8_BAR;
    PG8_BAR;
}
#undef PG8_SA
#undef PG8_SB
#undef PG8_STAGE
#undef PG8_LDA
#undef PG8_LDB
#undef PG8_MMA
#undef PG8_WAIT_V
#undef PG8_WAIT_L
#undef PG8_BAR
#undef PG8_SCHED

typedef const f32x4 (&AccRef)[2][2][4][2];
__device__ __forceinline__ f16x8 pack8(f32x4 a, f32x4 b) { f16x8 w; w[0] = (f16)a[0]; w[1] = (f16)a[1]; w[2] = (f16)a[2]; w[3] = (f16)a[3]; w[4] = (f16)b[0]; w[5] = (f16)b[1]; w[6] = (f16)b[2]; w[7] = (f16)b[3]; return w; }

struct EpiPx {
    static constexpr bool PERM = true, HAS_MID = false; static constexpr int MID1 = 0, MID2 = 0; f16* PX; f16* S5A; f16* ZT; f16* GTL;
    __device__ __forceinline__ void operator()(AccRef acc, const Unit& u, int wr, int wc, int fr, int fq) const { fr = opq(fr); fq = opq(fq);
        const int row0 = u.pm * BM + wr * 64 + fr, col0 = u.pn * BM + wc * 32 + 8 * fq;
#pragma unroll
        for (int ai = 0; ai < 2; ++ai)
#pragma unroll
            for (int m = 0; m < 4; ++m) { const int row = row0 + ai * HALF + m * 16;
#pragma unroll
                for (int bj = 0; bj < 2; ++bj) { const int c = col0 + bj * HALF; const f16x8 w = pack8(acc[ai][bj][m][0], acc[ai][bj][m][1]);
                    if (u.pn < 2) *(f16x8*)(S5A + (size_t)(row >> 4) * 16384 + (size_t)(c >> 4) * 512 + (row & 15) * 16 + (c & 15)) = w;
                    else if (u.pn >= 14 && u.pn < 20) {
#pragma unroll
                        for (int j = 0; j < 8; ++j) ZT[(size_t)(c - P_HY + j) * MT + row] = w[j]; }
                    else if (u.pn >= 20 && u.pn < 44) *(f16x8*)(GTL + ((size_t)(u.pn - 20) * 66 + u.pm) * 65536 + (size_t)(row - u.pm * BM) * 256 + (c - u.pn * BM)) = w;
                    else { const int pr = row < MX ? (row & ~8191) + ((row & 63) << 7) + ((row & 8191) >> 6) : row;
                        *(f16x8*)(PX + (size_t)pr * PXLD + (u.pn == 44 ? c - (W_GG - P_GG) : c)) = w; } } }
    }
};
struct EpiF16 {
    static constexpr bool PERM = true, HAS_MID = false; static constexpr int MID1 = 0, MID2 = 0; f16* O; int ldc;
    __device__ __forceinline__ void operator()(AccRef acc, const Unit& u, int wr, int wc, int fr, int fq) const { fr = opq(fr); fq = opq(fq);
        const int row0 = u.pm * BM + wr * 64 + fr, col0 = u.pn * BM + wc * 32 + 8 * fq;
#pragma unroll
        for (int ai = 0; ai < 2; ++ai)
#pragma unroll
            for (int m = 0; m < 4; ++m) { f16* rowp = O + (size_t)(row0 + ai * HALF + m * 16) * ldc + col0;
#pragma unroll
                for (int bj = 0; bj < 2; ++bj) *(f16x8*)(rowp + bj * HALF) = pack8(acc[ai][bj][m][0], acc[ai][bj][m][1]); }
    }
};
struct EpiS5In {
    static constexpr bool PERM = false, HAS_MID = false; static constexpr int MID1 = 0, MID2 = 0; float* S;
    __device__ __forceinline__ void operator()(AccRef acc, const Unit& u, int wr, int wc, int fr, int fq) const { fr = opq(fr); fq = opq(fq);
        const int row0 = u.pm * BM + wr * 64 + fr, col0 = wc * 32 + 4 * fq, g = u.pn;
#pragma unroll
        for (int ai = 0; ai < 2; ++ai)
#pragma unroll
            for (int m = 0; m < 4; ++m) { const int row = row0 + ai * HALF + m * 16; { float* rowp = S + ((size_t)row * 32 + g) * 256 + col0;
#pragma unroll
                for (int bj = 0; bj < 2; ++bj)
#pragma unroll
                    for (int n = 0; n < 2; ++n) *(f32x4*)(rowp + bj * HALF + n * 16) = acc[ai][bj][m][n]; } }
    }
};
struct EpiS5Out {
    static constexpr bool PERM = true, HAS_MID = false; static constexpr int MID1 = 0, MID2 = 0; const f16* S5A; f16* Y; const float* dvec;
    __device__ __forceinline__ void operator()(AccRef acc, const Unit& u, int wr, int wc, int fr, int fq) const { fr = opq(fr); fq = opq(fq);
        const int row0 = u.pm * BM + wr * 64 + fr, col0 = wc * 32 + 8 * fq, g = u.pn;
        const int h0 = col0 & 15;
        const f32x4 d0 = *(const f32x4*)(dvec + g * 16 + h0), d1 = *(const f32x4*)(dvec + g * 16 + h0 + 4);
#pragma unroll
        for (int ai = 0; ai < 2; ++ai) { f16x8 uu[4][2];
#pragma unroll
            for (int m = 0; m < 4; ++m)
#pragma unroll
                for (int bj = 0; bj < 2; ++bj) uu[m][bj] = *(const f16x8*)(S5A + (size_t)(row0 + ai * HALF + m * 16) * 16384 + (size_t)g * 512 + col0 + bj * HALF);
            PIN8(uu[0][0], uu[0][1], uu[1][0], uu[1][1], uu[2][0], uu[2][1], uu[3][0], uu[3][1]);
#pragma unroll
            for (int m = 0; m < 4; ++m) { const int chunk = row0 + ai * HALF + m * 16;
#pragma unroll
                for (int bj = 0; bj < 2; ++bj) { const int c = col0 + bj * HALF, t = c >> 4; f16x8 w;
#pragma unroll
                    for (int j = 0; j < 4; ++j) { w[j] = (f16)gelu_tanh_(acc[ai][bj][m][0][j] * (1.0f / S5SCALE) + d0[j] * (float)uu[m][bj][j]);
                                                  w[4 + j] = (f16)gelu_tanh_(acc[ai][bj][m][1][j] * (1.0f / S5SCALE) + d1[j] * (float)uu[m][bj][4 + j]); }
                    *(f16x8*)(Y + (size_t)(chunk * 16 + t) * 512 + g * 16 + h0) = w; } }
            asm volatile("" ::: "memory"); }
    }
};
struct EpiGlu {
    static constexpr bool PERM = true, HAS_MID = false; static constexpr int MID1 = 0, MID2 = 0; const f16* YP; f16* O; const float* bias;
    __device__ __forceinline__ void operator()(AccRef acc, const Unit& u, int wr, int wc, int fr, int fq) const { fr = opq(fr); fq = opq(fq);
        const int row0 = u.pm * BM + wr * 64 + fr, col0 = u.pn * BM + wc * 32 + 8 * fq;
        f32x4 bv[2][2];
#pragma unroll
        for (int bj = 0; bj < 2; ++bj) { bv[bj][0] = *(const f32x4*)(bias + col0 + bj * HALF); bv[bj][1] = *(const f32x4*)(bias + col0 + bj * HALF + 4); }
#pragma unroll
        for (int ai = 0; ai < 2; ++ai) { f16x8 yp[4][2];
#pragma unroll
            for (int m = 0; m < 4; ++m)
#pragma unroll
                for (int bj = 0; bj < 2; ++bj) yp[m][bj] = *(const f16x8*)(YP + (size_t)(row0 + ai * HALF + m * 16) * 512 + col0 + bj * HALF);
            PIN8(yp[0][0], yp[0][1], yp[1][0], yp[1][1], yp[2][0], yp[2][1], yp[3][0], yp[3][1]);
#pragma unroll
            for (int m = 0; m < 4; ++m)
#pragma unroll
                for (int bj = 0; bj < 2; ++bj) { f16x8 w;
#pragma unroll
                    for (int j = 0; j < 4; ++j) { w[j] = (f16)((float)yp[m][bj][j] * sigmoidf_(acc[ai][bj][m][0][j] + bv[bj][0][j])); w[4 + j] = (f16)((float)yp[m][bj][4 + j] * sigmoidf_(acc[ai][bj][m][1][j] + bv[bj][1][j])); }
                    *(f16x8*)(O + (size_t)(row0 + ai * HALF + m * 16) * 2048 + col0 + bj * HALF) = w; }
            asm volatile("" ::: "memory"); }
    }
};
template <int BR> struct EpiBranch {
    static constexpr bool PERM = true, HAS_MID = false; static constexpr int MID1 = 0, MID2 = 0; const f16* PX; f16* M;
    __device__ __forceinline__ void operator()(AccRef acc, const Unit& u, int wr, int wc, int fr, int fq) const { fr = opq(fr); fq = opq(fq);
        const int row0 = u.pm * BM + wr * 64 + fr, col0 = u.pn * BM + wc * 32 + 8 * fq;
#pragma unroll
        for (int ai = 0; ai < 2; ++ai)
#pragma unroll
            for (int m = 0; m < 4; ++m) { const int row = row0 + ai * HALF + m * 16;
#pragma unroll
                for (int bj = 0; bj < 2; ++bj) { const int c = col0 + bj * HALF;
                    const f16x8 gl = *(const f16x8*)(PX + (size_t)row * PXLD + P_MG + BR * 2048 + c);
                    f16* mp = M + (size_t)row * 2048 + c;
                    f16x8 prev; if (BR > 0) prev = *(const f16x8*)mp;
                    f16x8 w;
#pragma unroll
                    for (int j = 0; j < 4; ++j) { float v0 = sigmoidf_((float)gl[j]) * acc[ai][bj][m][0][j], v1 = sigmoidf_((float)gl[4 + j]) * acc[ai][bj][m][1][j];
                        if (BR > 0) { v0 += (float)prev[j]; v1 += (float)prev[4 + j]; } w[j] = (f16)v0; w[4 + j] = (f16)v1; }
                    *(f16x8*)mp = w; } asm volatile("" ::: "memory"); }
    }
};
typedef f32x4 (&AccMut)[2][2][4][2];

struct EpiBranchF {
    static constexpr bool PERM = true, HAS_MID = true; static constexpr int MID1 = 6, MID2 = 14;
    const f16* GTL; f16* M;
    __device__ __forceinline__ void mid(AccMut acc, const Unit& u, int seg, int wr, int wc, int fr, int fq) const { fr = opq(fr); fq = opq(fq);
        const int lrow0 = wr * 64 + fr, lcol0 = wc * 32 + 8 * fq;
        const f16* ga = GTL + ((size_t)((seg == 0 ? 0 : 8) + u.pn) * 66 + u.pm) * 65536; const f16* gb = ga + (size_t)8 * 66 * 65536;
#pragma unroll
        for (int ai = 0; ai < 2; ++ai) { f16x8 za[4][2], zb[4][2];
#pragma unroll
            for (int m = 0; m < 4; ++m)
#pragma unroll
                for (int bj = 0; bj < 2; ++bj) { const int off = (lrow0 + ai * HALF + m * 16) * 256 + lcol0 + bj * HALF; za[m][bj] = *(const f16x8*)(ga + off); zb[m][bj] = *(const f16x8*)(gb + off); }
            PIN8(za[0][0], za[0][1], za[1][0], za[1][1], za[2][0], za[2][1], za[3][0], za[3][1]); PIN8(zb[0][0], zb[0][1], zb[1][0], zb[1][1], zb[2][0], zb[2][1], zb[3][0], zb[3][1]);
#pragma unroll
            for (int m = 0; m < 4; ++m)
#pragma unroll
                for (int bj = 0; bj < 2; ++bj)
#pragma unroll
                    for (int j = 0; j < 4; ++j) { acc[ai][bj][m][0][j] *= (1.0f + __expf(-(float)zb[m][bj][j])) * __builtin_amdgcn_rcpf(1.0f + __expf(-(float)za[m][bj][j]));
                                                  acc[ai][bj][m][1][j] *= (1.0f + __expf(-(float)zb[m][bj][4 + j])) * __builtin_amdgcn_rcpf(1.0f + __expf(-(float)za[m][bj][4 + j])); }
            asm volatile("" ::: "memory"); }
    }
    __device__ __forceinline__ void operator()(AccRef acc, const Unit& u, int wr, int wc, int fr, int fq) const { fr = opq(fr); fq = opq(fq);
        const int row0 = u.pm * BM + wr * 64 + fr, col0 = u.pn * BM + wc * 32 + 8 * fq;
#pragma unroll
        for (int ai = 0; ai < 2; ++ai) { f16x8 gl[4][2];
#pragma unroll
            for (int m = 0; m < 4; ++m)
#pragma unroll
                for (int bj = 0; bj < 2; ++bj) gl[m][bj] = *(const f16x8*)(GTL + ((size_t)(16 + u.pn) * 66 + u.pm) * 65536 + (wr * 64 + fr + ai * HALF + m * 16) * 256 + wc * 32 + 8 * fq + bj * HALF);
            PIN8(gl[0][0], gl[0][1], gl[1][0], gl[1][1], gl[2][0], gl[2][1], gl[3][0], gl[3][1]);
#pragma unroll
            for (int m = 0; m < 4; ++m)
#pragma unroll
                for (int bj = 0; bj < 2; ++bj) { f16x8 w;
#pragma unroll
                    for (int j = 0; j < 4; ++j) { w[j] = (f16)(sigmoidf_((float)gl[m][bj][j]) * acc[ai][bj][m][0][j]); w[4 + j] = (f16)(sigmoidf_((float)gl[m][bj][4 + j]) * acc[ai][bj][m][1][j]); }
                    *(f16x8*)(M + (size_t)(row0 + ai * HALF + m * 16) * 2048 + col0 + bj * HALF) = w; }
            asm volatile("" ::: "memory"); }
    }
};
struct EpiUpAct {
    static constexpr bool PERM = true, HAS_MID = false; static constexpr int MID1 = 0, MID2 = 0; f16* ACT; float* HALO; const float* cw; const float* cb; LAS float* HL;
    __device__ __forceinline__ void operator()(AccRef acc, const Unit& u, int wr, int wc, int fr, int fq) const { fr = opq(fr); fq = opq(fq);
        const int lane = fq * 16 + fr;
#pragma unroll
        for (int ai = 0; ai < 2; ++ai) { LAS float* hp = HL + ((ai * 2 + wr) * 4 + wc) * 64 + 8 * fq;
            if (fr == 0) { *(LAS f32x4*)(hp) = acc[ai][0][0][0]; *(LAS f32x4*)(hp + 4) = acc[ai][0][0][1]; }
            if (fr == 15) { *(LAS f32x4*)(hp + 32) = acc[ai][0][3][0]; *(LAS f32x4*)(hp + 36) = acc[ai][0][3][1]; } }
        { float* gh = HALO + ((size_t)u.pm * 44 + u.pn) * 768 + wc * 32 + 8 * fq;
          if (wr == 0 && fr < 2) { *(f32x4*)(gh + fr * 128) = acc[0][0][0][0]; *(f32x4*)(gh + fr * 128 + 4) = acc[0][0][0][1]; }
          if (wr == 0 && fr == 0) { *(f32x4*)(gh + 4 * 128) = acc[0][1][0][0]; *(f32x4*)(gh + 4 * 128 + 4) = acc[0][1][0][1]; }
          if (wr == 1 && fr >= 14) { *(f32x4*)(gh + (fr - 12) * 128) = acc[1][0][3][0]; *(f32x4*)(gh + (fr - 12) * 128 + 4) = acc[1][0][3][1]; }
          if (wr == 1 && fr == 15) { *(f32x4*)(gh + 5 * 128) = acc[1][1][3][0]; *(f32x4*)(gh + 5 * 128 + 4) = acc[1][1][3][1]; } }
        asm volatile("s_waitcnt lgkmcnt(0)" ::: "memory"); __builtin_amdgcn_s_barrier(); __builtin_amdgcn_s_barrier(); asm volatile("" ::: "memory");
        const int colg = u.pn * 128 + wc * 32 + 8 * fq;
        const int srcR = (lane & 48) | ((fr + 15) & 15), srcL = (lane & 48) | ((fr + 1) & 15);
        const int row0 = u.pm * BM + wr * 64 + fr;
#pragma unroll
        for (int n = 0; n < 2; ++n) {
            const f32x4 w0 = *(const f32x4*)(cw + colg + 4 * n), w1 = *(const f32x4*)(cw + FFH + colg + 4 * n), w2 = *(const f32x4*)(cw + 2 * FFH + colg + 4 * n), bb = *(const f32x4*)(cb + colg + 4 * n);
#pragma unroll
            for (int ai = 0; ai < 2; ++ai) {
                const bool hasp = (wr == 1) || (ai == 1), hasn = (wr == 0) || (ai == 0);
                const LAS float* pp = HL + (((wr == 1 ? ai : 0) * 2 + (wr == 1 ? 0 : 1)) * 4 + wc) * 64 + 32 + 8 * fq + 4 * n;
                const LAS float* np = HL + (((wr == 0 ? ai : 1) * 2 + (wr == 0 ? 1 : 0)) * 4 + wc) * 64 + 8 * fq + 4 * n;
                const f32x4 hprev = hasp ? *(const LAS f32x4*)pp : (f32x4){0.f, 0.f, 0.f, 0.f}, hnext = hasn ? *(const LAS f32x4*)np : (f32x4){0.f, 0.f, 0.f, 0.f};
                f32x4 R[4], L[4];
#pragma unroll
                for (int m = 0; m < 4; ++m)
#pragma unroll
                    for (int j = 0; j < 4; ++j) { R[m][j] = __shfl(acc[ai][0][m][n][j], srcR); L[m][j] = __shfl(acc[ai][0][m][n][j], srcL); }
#pragma unroll
                for (int m = 0; m < 4; ++m) { const f32x4 pv = fr > 0 ? R[m] : (m > 0 ? R[m > 0 ? m - 1 : 0] : hprev); const f32x4 nv = fr < 15 ? L[m] : (m < 3 ? L[m < 3 ? m + 1 : 3] : hnext);
                    const f32x4 a = w0 * pv + w1 * acc[ai][0][m][n] + w2 * nv + bb;
                    f16x4 o;
#pragma unroll
                    for (int j = 0; j < 4; ++j) o[j] = (f16)(siluf_(a[j]) * acc[ai][1][m][n][j]);
                    *(f16x4*)(ACT + (size_t)(row0 + ai * HALF + m * 16) * FFH + colg + 4 * n) = o; }
                asm volatile("" ::: "memory");
            }
        }
    }
};
struct EpiSlab {
    static constexpr bool PERM = false, HAS_MID = false; static constexpr int MID1 = 0, MID2 = 0; float* slab; const float* mod; int goff;
    __device__ __forceinline__ void operator()(AccRef acc, const Unit& u, int wr, int wc, int fr, int fq) const { fr = opq(fr); fq = opq(fq);
        const int pn = u.pn & 255, ks = u.pn >> 8;
        const int row0 = (u.pm - 64) * BM + wr * 64 + fr, col0 = pn * BM + wc * 32 + 4 * fq;
        const float* gp = mod + 2 * 12288 + goff + col0;
        f32x4 gv[2][2];
#pragma unroll
        for (int bj = 0; bj < 2; ++bj)
#pragma unroll
            for (int n = 0; n < 2; ++n) gv[bj][n] = *(const f32x4*)(gp + bj * HALF + n * 16);
        float* sp = slab + (size_t)ks * MC * D;
#pragma unroll
        for (int ai = 0; ai < 2; ++ai)
#pragma unroll
            for (int m = 0; m < 4; ++m) { float* rowp = sp + (size_t)(row0 + ai * HALF + m * 16) * D + col0;
#pragma unroll
                for (int bj = 0; bj < 2; ++bj)
#pragma unroll
                    for (int n = 0; n < 2; ++n) *(f32x4*)(rowp + bj * HALF + n * 16) = gv[bj][n] * acc[ai][bj][m][n]; }
    }
};
struct EpiResid {
    static constexpr bool PERM = false, HAS_MID = false; static constexpr int MID1 = 0, MID2 = 0; float* X; const float* mod; int goff;
    __device__ __forceinline__ void operator()(AccRef acc, const Unit& u, int wr, int wc, int fr, int fq) const { fr = opq(fr); fq = opq(fq);
        const int row0 = u.pm * BM + wr * 64 + fr, col0 = u.pn * BM + wc * 32 + 4 * fq;
        const int bsel = u.pm < 32 ? 0 : (u.pm < 64 ? 1 : 2);
        const float* gp = mod + bsel * 12288 + goff + col0;
        f32x4 gv[2][2];
#pragma unroll
        for (int bj = 0; bj < 2; ++bj)
#pragma unroll
            for (int n = 0; n < 2; ++n) gv[bj][n] = *(const f32x4*)(gp + bj * HALF + n * 16);
#pragma unroll
        for (int ai = 0; ai < 2; ++ai) { f32x4 xv[4][2][2];
#pragma unroll
            for (int m = 0; m < 4; ++m) { const float* rowp = X + (size_t)(row0 + ai * HALF + m * 16) * D + col0;
#pragma unroll
                for (int bj = 0; bj < 2; ++bj)
#pragma unroll
                    for (int n = 0; n < 2; ++n) xv[m][bj][n] = *(const f32x4*)(rowp + bj * HALF + n * 16); }
            PIN8(xv[0][0][0], xv[0][0][1], xv[0][1][0], xv[0][1][1], xv[1][0][0], xv[1][0][1], xv[1][1][0], xv[1][1][1]); PIN8(xv[2][0][0], xv[2][0][1], xv[2][1][0], xv[2][1][1], xv[3][0][0], xv[3][0][1], xv[3][1][0], xv[3][1][1]);
#pragma unroll
            for (int m = 0; m < 4; ++m) { float* rowp = X + (size_t)(row0 + ai * HALF + m * 16) * D + col0;
#pragma unroll
                for (int bj = 0; bj < 2; ++bj)
#pragma unroll
                    for (int n = 0; n < 2; ++n) *(f32x4*)(rowp + bj * HALF + n * 16) = xv[m][bj][n] + gv[bj][n] * acc[ai][bj][m][n]; }
            asm volatile("" ::: "memory"); }
    }
};
}


__device__ __forceinline__ void ph_prologue(const Ctx& F, const ArgsV& AV) {
    const int gt = F.bid * 512 + F.tid, NT = F.G * 512;
    { const f32x4* xs = (const f32x4*)AV.in(I_X); const f32x4* cs = (const f32x4*)AV.in(I_CTX); f32x4* xr = (f32x4*)(F.ws + WS_XRES);
      for (int i = gt; i < MX * D / 4; i += NT) xr[i] = xs[i];
      for (int i = gt; i < MC * D / 4; i += NT) xr[MX * D / 4 + i] = cs[i]; }
    { f32x2* tw = (f32x2*)(F.ws + WS_TW);
      for (int k = gt; k < 16384; k += NT) { float s, c; sincospif((float)k * (2.0f / 16384.0f), &s, &c); tw[k] = (f32x2){c, -s}; } }
    LAS float* sc = (LAS float*)F.lds;
    LAS float* red = (LAS float*)(F.lds + 3 * 2048 * 4);
    for (int i = F.tid; i < 3 * 2048; i += 512) { const int r = i / 2048, k = i % 2048; const float v = r < 2 ? AV.in(I_C)[r * 2048 + k] : AV.in(I_CCTX)[k]; sc[i] = siluf_(v); }
    __syncthreads();
    const int col = F.tid & 63, ks = F.tid >> 6;
    for (int chunk = F.bid; chunk < DEPTH * 192; chunk += F.G) {
        const int l = chunk / 192, n0 = (chunk % 192) * 64;
        const float* w = AV.in(I_WMOD) + (size_t)l * 2048 * 12288 + n0 + col;
        float s0 = 0.f, s1 = 0.f, s2 = 0.f;
#pragma unroll 8
        for (int k = ks * 256; k < ks * 256 + 256; ++k) { const float wv = w[(size_t)k * 12288]; s0 += sc[k] * wv; s1 += sc[2048 + k] * wv; s2 += sc[4096 + k] * wv; }
        red[(ks * 3 + 0) * 64 + col] = s0; red[(ks * 3 + 1) * 64 + col] = s1; red[(ks * 3 + 2) * 64 + col] = s2;
        __syncthreads();
        if (F.tid < 192) { const int r = F.tid >> 6, c2 = F.tid & 63; float s = 0.f;
#pragma unroll
            for (int q = 0; q < 8; ++q) s += red[(q * 3 + r) * 64 + c2];
            ((float*)(F.ws + WS_MOD))[((size_t)l * 3 + r) * 12288 + n0 + c2] = s + AV.in(I_BMOD)[(size_t)l * 12288 + n0 + c2]; }
        __syncthreads();
    }
}

__device__ __forceinline__ void conv_item(const float* W, int ldw, int k0, int srccol, f16* WT, int dstrow, int ldk) {
    float v[64];
    const float* src = W + (size_t)k0 * ldw + (srccol >= 0 ? srccol : 0);
#pragma unroll
    for (int k = 0; k < 64; ++k) v[k] = src[(size_t)k * ldw];
#pragma unroll
    for (int k = 0; k < 64; k += 8) PIN8(v[k], v[k + 1], v[k + 2], v[k + 3], v[k + 4], v[k + 5], v[k + 6], v[k + 7]);
    f16* dst = WT + (size_t)dstrow * ldk + k0;
#pragma unroll
    for (int kg = 0; kg < 8; ++kg) { f16x8 o;
#pragma unroll
        for (int e = 0; e < 8; ++e) o[e] = srccol >= 0 ? (f16)v[8 * kg + e] : (f16)0.f;
        *(f16x8*)(dst + 8 * kg) = o; }
}
__device__ __forceinline__ void ph_convert_weights(const Ctx& F, const ArgsV& AV, int l) {
    const int skip = F.G > 64 ? 32 : 0;
    if (F.bid < skip) return;
    const int gw = (F.bid - skip) * 8 + F.wave, NGW = (F.G - skip) * 8, lane = F.lane;
    constexpr int I_IN = 32 * 180, I_GLU = 8 * 8, I_BR = 32 * 32, I_OUT = 32 * 32, I_UP = 32 * 176, I_DN = 88 * 32;
    constexpr int NIT = I_IN + I_GLU + I_BR + I_OUT + I_UP + I_DN;
    for (int it = gw; it < NIT; it += NGW) {
        int r = it;
        if (r < I_IN) { const int kb = r / 180, nb = r % 180, j = nb * 64 + lane;
            const int src = j < 2048 ? j : (j < 11264 ? j + 32 : (j < 11296 ? 2048 + (j - 11264) : -1));
            conv_item(AV.in(I_WIN) + (size_t)l * 2048 * INW, INW, kb * 64, src, (f16*)(F.ws + WS_WIN), j, 2048); continue; } r -= I_IN;
        if (r < I_GLU) { const int kb = r / 8, nb = r % 8, j = nb * 64 + lane; conv_item(AV.in(I_GLUW) + (size_t)l * 512 * 512, 512, kb * 64, j, (f16*)(F.ws + WS_WGLU), j, 512); continue; } r -= I_GLU;
        if (r < I_BR) { const int kb = r / 32, nb = r % 32, j = nb * 64 + lane; conv_item(AV.in(I_WBR) + (size_t)l * 2048 * 2048, 2048, kb * 64, j, (f16*)(F.ws + WS_WBR), j, 2048); continue; } r -= I_BR;
        if (r < I_OUT) { const int kb = r / 32, nb = r % 32, j = nb * 64 + lane; conv_item(AV.in(I_WOUT) + (size_t)l * 2048 * 2048, 2048, kb * 64, j, (f16*)(F.ws + WS_WOUT), j, 2048); continue; } r -= I_OUT;
        if (r < I_UP) { const int kb = r / 176, nb = r % 176, j = nb * 64 + lane, pn = j >> 8, i = j & 255; const int src = i < 128 ? 128 * pn + i : FFH + 128 * pn + (i - 128);
            conv_item(AV.in(I_WUP) + (size_t)l * 2048 * UPLD, UPLD, kb * 64, src, (f16*)(F.ws + WS_WUP), j, 2048); continue; } r -= I_UP;
        { const int kb = r / 32, nb = r % 32, j = nb * 64 + lane; conv_item(AV.in(I_WDN) + (size_t)l * FFH * 2048, 2048, kb * 64, j, (f16*)(F.ws + WS_WDN), j, FFH); }
    }
}

__device__ __forceinline__ void s5_mats_group(const Ctx& F, const ArgsV& AV, int l, int g) {
    LAS f32x2* APOW = (LAS f32x2*)F.lds;
    LAS f32x2* BBAR = APOW + 2 * 17 * 64;
    LAS f32x2* CM = BBAR + 2 * 64 * 16;
    LAS float* KLAG = (LAS float*)(CM + 2 * 16 * 64);
    __syncthreads();
    for (int i = F.tid; i < 2 * 17 * 64; i += 512) { const int d = i / (17 * 64), e = (i / 64) % 17, n = i % 64;
        const size_t pi = (((size_t)l * 2 + d) * 32 + g) * 64 + n;
        const float are = AV.in(I_S5ARE)[pi], aim = AV.in(I_S5AIM)[pi], dt = expf(AV.in(I_S5STEP)[((size_t)l * 2 + d) * 32 + g]);
        const float zr = are * dt * (float)e, zi = aim * dt * (float)e; float s, c; sincosf(zi, &s, &c); const float m = expf(zr);
        APOW[i] = (f32x2){m * c, m * s}; }
    __syncthreads();
    for (int i = F.tid; i < 2 * 64 * 16; i += 512) { const int d = i / 1024, n = (i / 16) % 64, h = i % 16;
        const size_t pi = (((size_t)l * 2 + d) * 32 + g) * 64 + n;
        const float are = AV.in(I_S5ARE)[pi], aim = AV.in(I_S5AIM)[pi];
        const f32x2 ab = APOW[(d * 17 + 1) * 64 + n]; const f32x2 num = (f32x2){ab.x - 1.0f, ab.y};
        const float den = are * are + aim * aim; const f32x2 q = (f32x2){(num.x * are + num.y * aim) / den, (num.y * are - num.x * aim) / den};
        const size_t bi = (pi * 16) + h;
        BBAR[i] = cmul(q, (f32x2){AV.in(I_S5BRE)[bi], AV.in(I_S5BIM)[bi]});
        const size_t ci = ((((size_t)l * 2 + d) * 32 + g) * 16 + h) * 64 + n;
        CM[(d * 16 + h) * 64 + n] = (f32x2){AV.in(I_S5CRE)[ci], AV.in(I_S5CIM)[ci]}; }
    __syncthreads();
    for (int i = F.tid; i < 2 * 16 * 256; i += 512) { const int d = i / 4096, lag = (i / 256) % 16, h = (i / 16) % 16, hp = i % 16; float s = 0.f;
        for (int n = 0; n < 64; ++n) { const f32x2 t = cmul(CM[(d * 16 + h) * 64 + n], APOW[(d * 17 + lag) * 64 + n]); const f32x2 b = BBAR[(d * 64 + n) * 16 + hp]; s += t.x * b.x - t.y * b.y; }
        KLAG[i] = s; }
    __syncthreads();
    f16* W = (f16*)(F.ws + WS_S5W) + (size_t)g * 256 * 512;
    for (int i = F.tid; i < 256 * 64; i += 512) { const int n = i / 64, k8 = (i % 64) * 8, t = n >> 4, h = n & 15; f16x8 o;
#pragma unroll
        for (int e = 0; e < 8; ++e) { const int k = k8 + e; float v;
            if (k < 256) { const int s = k >> 4, hp = k & 15; v = 0.f;
                if (t >= s) v += KLAG[((0 * 16 + (t - s)) * 16 + h) * 16 + hp];
                if (s >= t) v += KLAG[((1 * 16 + (s - t)) * 16 + h) * 16 + hp];
                v *= S5SCALE; }
            else { const int d = (k - 256) >> 7, nn2 = (k - 256) & 127, nn = nn2 & 63, im = nn2 >> 6, ex = d == 0 ? t + 1 : 16 - t;
                const f32x2 z = cmul(CM[(d * 16 + h) * 64 + nn], APOW[(d * 17 + ex) * 64 + nn]); v = im ? -z.y : z.x; }
            o[e] = (f16)v; }
        *(f16x8*)(W + (size_t)n * 512 + k8) = o; }
    f16* Mx = (f16*)(F.ws + WS_S5M) + (size_t)g * 256 * 256;
    for (int i = F.tid; i < 256 * 32; i += 512) { const int n = i / 32, k8 = (i % 32) * 8, d = n >> 7, ri = (n >> 6) & 1, nn = n & 63; f16x8 o;
#pragma unroll
        for (int e = 0; e < 8; ++e) { const int k = k8 + e, s = k >> 4, hp = k & 15, ex = d == 0 ? 15 - s : s;
            const f32x2 z = cmul(APOW[(d * 17 + ex) * 64 + nn], BBAR[(d * 64 + nn) * 16 + hp]); o[e] = (f16)((ri ? z.y : z.x) * S5SCALE); }
        *(f16x8*)(Mx + (size_t)n * 256 + k8) = o; }
    if (F.tid < 128) { const int d = F.tid >> 6, nn = F.tid & 63; ((f32x2*)(F.ws + WS_S5AT))[(d * 32 + g) * 64 + nn] = APOW[(d * 17 + 16) * 64 + nn]; }
    __syncthreads();
}

__device__ __forceinline__ void ph_hyena_h2(const Ctx& F, const ArgsV& AV, int l) {
    LAS float* W1 = (LAS float*)F.lds;
    LAS float* W2 = W1 + 33 * 64;
    LAS float* PV = W2 + 64 * 64;
    LAS float* SCR = PV + 256;
    __syncthreads();
    for (int i = F.tid; i < 33 * 64; i += 512) W1[i] = AV.in(I_HYW1)[(size_t)l * 33 * 64 + i];
    for (int i = F.tid; i < 64 * 64; i += 512) W2[i] = AV.in(I_HYW2)[(size_t)l * 4096 + i];
    if (F.tid < 64) { PV[F.tid] = AV.in(I_HYB1)[l * 64 + F.tid]; PV[64 + F.tid] = AV.in(I_HYF1)[l * 64 + F.tid]; PV[128 + F.tid] = AV.in(I_HYB2)[l * 64 + F.tid]; PV[192 + F.tid] = AV.in(I_HYF2)[l * 64 + F.tid]; }
    __syncthreads();
    LAS float* scr = SCR + F.wave * 64;
    const int gw = F.bid * 8 + F.wave, NGW = F.G * 8, j = F.lane;
    float* H2 = (float*)(F.ws + WS_H2);
    for (int p = gw; p < SEQ + LC; p += NGW) {
        const int n = p < SEQ ? SEQ : LC, pos = p < SEQ ? p : p - SEQ;
        float feat = 0.f;
        if (j == 0) feat = (float)pos / (float)(n - 1);
        else if (j < 33) { const int fi = (j - 1) & 15; const float fr = 1e-4f + (float)fi * ((15.0f - 1e-4f) / 15.0f);
            const float ang = (6.283185307179586f / (float)n) * (float)pos * fr; float s, c; sincosf(ang, &s, &c); feat = j < 17 ? c : -s; }
        scr[j] = feat; LDS_WAIT(); asm volatile("" ::: "memory");
        float a = PV[j];
        for (int i = 0; i < 33; ++i) a += scr[i] * W1[i * 64 + j];
        const float h1 = sinf(PV[64 + j] * a);
        LDS_WAIT(); asm volatile("" ::: "memory");
        scr[j] = h1; LDS_WAIT(); asm volatile("" ::: "memory");
        float b = PV[128 + j];
        for (int i = 0; i < 64; ++i) b += scr[i] * W2[i * 64 + j];
        { const float h2v = sinf(PV[192 + j] * b); H2[(size_t)p * 64 + j] = h2v; ((f16*)(F.ws + WS_H2H))[(size_t)p * 64 + j] = (f16)h2v; }
        LDS_WAIT(); asm volatile("" ::: "memory");
    }
}

__device__ __forceinline__ void ph_norm(const Ctx& F, const ArgsV& AV, int l, int which, int nrows, int nslab) {
    const int gw = F.bid * 8 + F.wave, NGW = F.G * 8;
    float* X = (float*)(F.ws + WS_XRES); f16* O = (f16*)(F.ws + WS_HN); const float* SL = (const float*)(F.ws + WS_SLAB);
    const float* gain = AV.in(which ? I_N2G : I_N1G) + (size_t)l * D;
    const float* mod = (const float*)(F.ws + WS_MOD) + (size_t)l * 3 * 12288;
    const int shoff = which ? 6144 : 0, soff = which ? 8192 : 2048;
    int cur_bsel = -1; f32x4 Am[8], Bm[8], vn[8];
    if (gw < nrows) { const f32x4* xr0 = (const f32x4*)(X + (size_t)gw * D) + F.lane;
#pragma unroll
        for (int j = 0; j < 8; ++j) vn[j] = xr0[64 * j]; }
    for (int m = gw; m < nrows; m += NGW) {
        const int bsel = m < SEQ ? 0 : (m < MX ? 1 : 2);
        f32x4* xr = (f32x4*)(X + (size_t)m * D) + F.lane;
        f32x4 v[8]; float s = 0.f;
        PIN8(vn[0], vn[1], vn[2], vn[3], vn[4], vn[5], vn[6], vn[7]);
#pragma unroll
        for (int j = 0; j < 8; ++j) v[j] = vn[j];
        if (m + NGW < nrows) { const f32x4* xq = (const f32x4*)(X + (size_t)(m + NGW) * D) + F.lane;
#pragma unroll
            for (int j = 0; j < 8; ++j) vn[j] = xq[64 * j]; }
        if (bsel != cur_bsel) { cur_bsel = bsel; const float* mp = mod + bsel * 12288;
#pragma unroll
            for (int j = 0; j < 8; ++j) { const int c = 4 * F.lane + 256 * j; const f32x4 g = *(const f32x4*)(gain + c), sc = *(const f32x4*)(mp + soff + c); Bm[j] = *(const f32x4*)(mp + shoff + c); Am[j] = g * (sc + 1.0f); }
            PIN8(Am[0], Am[1], Am[2], Am[3], Am[4], Am[5], Am[6], Am[7]); PIN8(Bm[0], Bm[1], Bm[2], Bm[3], Bm[4], Bm[5], Bm[6], Bm[7]); }
        if (m >= MX && nslab > 0) {
            for (int sl = 0; sl < nslab; ++sl) { const f32x4* sr = (const f32x4*)(SL + ((size_t)sl * MC + (m - MX)) * D) + F.lane;
#pragma unroll
                for (int j = 0; j < 8; ++j) v[j] = v[j] + sr[64 * j]; }
#pragma unroll
            for (int j = 0; j < 8; ++j) xr[64 * j] = v[j]; }
#pragma unroll
        for (int j = 0; j < 8; ++j) s += (v[j].x * v[j].x + v[j].y * v[j].y) + (v[j].z * v[j].z + v[j].w * v[j].w);
        const float rstd = 1.0f / sqrtf(wave_sum(s) * (1.0f / D) + EPS);
#pragma unroll
        for (int j = 0; j < 8; ++j) { const int c = 4 * F.lane + 256 * j;
            f16x4 o;
#pragma unroll
            for (int e = 0; e < 4; ++e) o[e] = (f16)(v[j][e] * rstd * Am[j][e] + Bm[j][e]);
            *(f16x4*)(O + (size_t)m * D + c) = o; }
    }
}
__device__ __forceinline__ void ph_final_norm(const Ctx& F, const ArgsV& AV) {
    const int gw = F.bid * 8 + F.wave, NGW = F.G * 8;
    const float* X = (const float*)(F.ws + WS_XRES); const float* gain = AV.in(I_FNG);
    for (int m = gw; m < MX; m += NGW) {
        const f32x4* xr = (const f32x4*)(X + (size_t)m * D) + F.lane;
        f32x4 v[8]; float s = 0.f;
#pragma unroll
        for (int j = 0; j < 8; ++j) { v[j] = xr[64 * j]; s += (v[j].x * v[j].x + v[j].y * v[j].y) + (v[j].z * v[j].z + v[j].w * v[j].w); }
        const float rstd = 1.0f / sqrtf(wave_sum(s) * (1.0f / D) + EPS);
#pragma unroll
        for (int j = 0; j < 8; ++j) { const int c = 4 * F.lane + 256 * j; const f32x4 g = *(const f32x4*)(gain + c);
            *(f32x4*)(AV.out + (size_t)m * D + c) = v[j] * rstd * g; }
    }
}

__device__ __forceinline__ void ph_s5_scan(const Ctx& F) {
    if (F.tid >= 32) return;
    const float* S = (const float*)(F.ws + WS_S5S); f16* SA = (f16*)(F.ws + WS_S5A);
    for (int gt = F.bid * 32 + F.tid; gt < 2 * 2 * 32 * 64; gt += F.G * 32) {
        const int nn = gt & 63, g = (gt >> 6) & 31, d = (gt >> 11) & 1, b = gt >> 12;
        const f32x2 at = ((const f32x2*)(F.ws + WS_S5AT))[(d * 32 + g) * 64 + nn];
        f32x2 st = (f32x2){0.f, 0.f};
        f32x2 la[16], lb[16];
#define S5_CHUNK(step) ((d == 0) ? ((step) < 16 ? 1024 + b * 16 + (step) : b * 512 + ((step) - 16)) : ((step) < 16 ? 1024 + b * 16 + (15 - (step)) : b * 512 + (511 - ((step) - 16))))
#define S5_LOAD(dst, base) do { _Pragma("unroll") for (int u = 0; u < 16; ++u) { const int stp = (base) + u < 528 ? (base) + u : 527; const size_t so = ((size_t)S5_CHUNK(stp) * 32 + g) * 256 + d * 128 + nn; dst[u] = (f32x2){S[so], S[so + 64]}; } } while (0)
#define S5_STEP(src, base) do { PIN8(src[0], src[1], src[2], src[3], src[4], src[5], src[6], src[7]); PIN8(src[8], src[9], src[10], src[11], src[12], src[13], src[14], src[15]); \
            _Pragma("unroll") for (int u = 0; u < 16; ++u) { f16* xp = SA + (size_t)S5_CHUNK((base) + u) * 16384 + (size_t)g * 512 + 256 + d * 128 + nn; xp[0] = (f16)st.x; xp[64] = (f16)st.y; st = cmul(at, st) + src[u]; } } while (0)
        S5_LOAD(la, 0);
        for (int base = 0; base < 528; base += 32) {
            S5_LOAD(lb, base + 16);
            S5_STEP(la, base);
            if (base + 16 < 528) { S5_LOAD(la, base + 32); S5_STEP(lb, base + 16); }
        }
#undef S5_CHUNK
#undef S5_LOAD
#undef S5_STEP
    }
}

__device__ __forceinline__ void ph_ffn_fix(const Ctx& F, const ArgsV& AV, int l, int nMr) {
    const float* HALO = (const float*)(F.ws + WS_HALO); f16* ACT = (f16*)(F.ws + WS_ACT);
    const float* cw = AV.in(I_FFCW) + (size_t)l * 3 * FFH; const float* cb = AV.in(I_FFCB) + (size_t)l * FFH;
    const int NT = nMr * 44 * 2 * 128;
    for (int task = F.bid * 512 + F.tid; task < NT; task += F.G * 512) {
        const int c = task & 127, which = (task >> 7) & 1, tile = task >> 8, pn = tile % 44, pm = tile / 44;
        const float* h = HALO + ((size_t)pm * 44 + pn) * 768 + c; const int col = pn * 128 + c;
        const bool first = (pm == 0 || pm == 32 || pm >= 64), last = (pm == 31 || pm >= 63);
        float ap, ac, an, b;
        if (which == 0) { ap = first ? 0.f : HALO[((size_t)(pm - 1) * 44 + pn) * 768 + 3 * 128 + c]; ac = h[0]; an = h[128]; b = h[4 * 128]; }
        else { ap = h[2 * 128]; ac = h[3 * 128]; an = last ? 0.f : HALO[((size_t)(pm + 1) * 44 + pn) * 768 + c]; b = h[5 * 128]; }
        const float a = cw[col] * ap + cw[FFH + col] * ac + cw[2 * FFH + col] * an + cb[col];
        ACT[(size_t)(pm * 256 + (which ? 255 : 0)) * FFH + col] = (f16)(siluf_(a) * b);
    }
}

namespace gla {
constexpr int QK_LD = 136, KH_LD = 72, VT_LD = 72, P_LD = 72;
constexpr int OFF_QT = 0;
constexpr int OFF_KT = 17408;
constexpr int OFF_VT = OFF_KT + 18432;
constexpr int OFF_P = OFF_VT + 36864;
constexpr int OFF_LR = OFF_P + 9216;
constexpr int OFF_GT = OFF_LR + 4096;
constexpr int OFF_DEC = OFF_GT + 2048;
constexpr int OFF_RS = OFF_DEC + 512;
constexpr int OFF_QR = OFF_RS + 2048;
constexpr int OFF_KR = OFF_QR + 17408;
constexpr int OFF_WG = OFF_KR + 17408;
static_assert(OFF_WG + 8192 <= LDSCTL_OFF, "gla lds");

__device__ __forceinline__ int grow(int b, int sc, int j, int i) {
    if (sc < 32) { const int col = 2 * sc + (j >> 1), r = (j & 1) * 64 + i; return b * SEQ + r * 64 + col; }
    return MX + b * LC + j * 64 + i;
}
__device__ __forceinline__ int prow(int b, int sc, int j, int i) {
    return sc < 32 ? b * SEQ + sc * 256 + j * 64 + i : MX + b * LC + j * 64 + i;
}
#define GLA_MFMA(a, b, c) __builtin_amdgcn_mfma_f32_16x16x32_f16(a, b, c, 0, 0, 0)

template <bool FULL>
__device__ __forceinline__ void gla_unit(const Ctx& F, const ArgsV& AV, int l, int unit) {
    const int b = unit / (4 * NSC), h = (unit / NSC) % 4, sc = unit % NSC;
    LAS f16* QT = (LAS f16*)(F.lds + OFF_QT); LAS f16* KT = (LAS f16*)(F.lds + OFF_KT); LAS f16* VT = (LAS f16*)(F.lds + OFF_VT);
    LAS f16* PP = (LAS f16*)(F.lds + OFF_P); LAS f16* LR = (LAS f16*)(F.lds + OFF_LR);
    LAS float* GT = (LAS float*)(F.lds + OFF_GT); LAS float* DEC = (LAS float*)(F.lds + OFF_DEC); LAS float* RS = (LAS float*)(F.lds + OFF_RS);
    LAS f16* QR = (LAS f16*)(F.lds + OFF_QR); LAS f16* KR = (LAS f16*)(F.lds + OFF_KR); LAS float* WG = (LAS float*)(F.lds + OFF_WG);
    const int tid = F.tid, lane = F.lane, w = F.wave, q0 = lane >> 4, c0 = lane & 15;
    const int dk0 = tid & 127, ig0 = tid >> 7;
    const f16* PX = (const f16*)(F.ws + WS_PX);
    const float scale = 0.08838834764831845f;
    for (int dir = 0; dir < 2; ++dir) {
        __syncthreads();
        for (int i = tid; i < 16 * 128; i += 512) WG[i] = AV.in(I_GLAWG)[(((size_t)l * 2 + dir) * 16 + (i >> 7)) * 512 + h * 128 + (i & 127)];
        const float bgv = AV.in(I_GLABG)[((size_t)l * 2 + dir) * 512 + h * 128 + dk0];
        const size_t sidx = ((((size_t)b * 4 + h) * NSC + sc) * 2 + dir);
        f32x4 accS[8][2];
        if (FULL && sc < 32) { const float* Sin = (const float*)(F.ws + WS_GSIN) + sidx * 32768; const int q = opq(q0), c = opq(c0);
#pragma unroll
            for (int dt = 0; dt < 8; ++dt)
#pragma unroll
                for (int et = 0; et < 2; ++et)
#pragma unroll
                    for (int r = 0; r < 4; ++r) accS[dt][et][r] = Sin[(16 * dt + 4 * q + r) * 256 + 32 * w + 16 * et + c];
            PIN8(accS[0][0], accS[0][1], accS[1][0], accS[1][1], accS[2][0], accS[2][1], accS[3][0], accS[3][1]); PIN8(accS[4][0], accS[4][1], accS[5][0], accS[5][1], accS[6][0], accS[6][1], accS[7][0], accS[7][1]); }
        else {
#pragma unroll
            for (int dt = 0; dt < 8; ++dt)
#pragma unroll
                for (int et = 0; et < 2; ++et) accS[dt][et] = (f32x4){0.f, 0.f, 0.f, 0.f}; }
        float sumtot = 0.f;
#define GLA_FETCH(jn) f16x8 pf_lr, pf_v[4], pf_k[2], pf_q[2]; do { const int tf = opq(F.tid); \
            { const int row = (tf & 255) >> 2, part = tf & 3; pf_lr = *(const f16x8*)(PX + (size_t)prow(b, sc, (jn), row) * PXLD + P_GG + part * 8); } \
            _Pragma("unroll") for (int k = 0; k < 4; ++k) { const int idx = tf + 512 * k, wi = idx >> 6, ln = idx & 63, rr = ln >> 2, cc = ln & 3; const int row = (wi & 3) * 16 + rr, chunk = (wi >> 2) * 4 + cc; \
                pf_v[k] = *(const f16x8*)(PX + (size_t)prow(b, sc, (jn), row) * PXLD + P_GV + h * 256 + chunk * 8); } \
            _Pragma("unroll") for (int k = 0; k < 2; ++k) { const int idx = tf + 512 * k, row = idx >> 4, ch = idx & 15; const size_t ro = (size_t)prow(b, sc, (jn), row) * PXLD; \
                pf_k[k] = *(const f16x8*)(PX + ro + P_GK + h * 128 + ch * 8); if (FULL) pf_q[k] = *(const f16x8*)(PX + ro + P_GQ + h * 128 + ch * 8); else pf_q[k] = pf_k[k]; } } while (0)
        for (int jj = 0; jj < 4; ++jj) {
            const int j = dir ? 3 - jj : jj;
            if (FULL) {
            GLA_FETCH(j);
            __syncthreads();
            const int tid = opq(F.tid);
            PIN8(pf_lr, pf_v[0], pf_v[1], pf_v[2], pf_v[3], pf_k[0], pf_k[1], pf_q[0]); asm volatile("" : "+v"(pf_q[1]));
            if (tid < 256) { const int row = tid >> 2, part = tid & 3; *(LAS f16x8*)(LR + row * 32 + part * 8) = pf_lr; }
#pragma unroll
            for (int k = 0; k < 4; ++k) { const int idx = opq(tid) + 512 * k, wi = idx >> 6, ln = idx & 63, rr = ln >> 2, cc = ln & 3;
                const int row = (wi & 3) * 16 + rr, chunk = (wi >> 2) * 4 + cc; LAS f16* vp = VT + (chunk * 8) * VT_LD + row;
#pragma unroll
                for (int e = 0; e < 8; ++e) vp[e * VT_LD] = pf_v[k][e]; }
#pragma unroll
            for (int k = 0; k < 2; ++k) { const int idx = tid + 512 * k, row = idx >> 4, ch = idx & 15;
                *(LAS f16x8*)(KR + row * QK_LD + ch * 8) = pf_k[k];
                *(LAS f16x8*)(QR + row * QK_LD + ch * 8) = pf_q[k]; }
            } else {
            __syncthreads();
            const int tid = opq(F.tid);
            if (tid < 256) { const int row = tid >> 2, part = tid & 3; const int gr = prow(b, sc, j, row);
                *(LAS f16x8*)(LR + row * 32 + part * 8) = *(const f16x8*)(PX + (size_t)gr * PXLD + P_GG + part * 8); }
#pragma unroll 1
            for (int k = 0; k < 4; ++k) { const int idx = tid + 512 * k, wi = idx >> 6, ln = idx & 63, rr = ln >> 2, cc = ln & 3;
                const int row = (wi & 3) * 16 + rr, chunk = (wi >> 2) * 4 + cc; const int gr = prow(b, sc, j, row);
                const f16x8 v8 = *(const f16x8*)(PX + (size_t)gr * PXLD + P_GV + h * 256 + chunk * 8);
#pragma unroll
                for (int e = 0; e < 8; ++e) VT[(chunk * 8 + e) * VT_LD + row] = v8[e]; }
#pragma unroll 1
            for (int k = 0; k < 2; ++k) { const int idx = tid + 512 * k, row = idx >> 4, ch = idx & 15; const int gr = prow(b, sc, j, row);
                *(LAS f16x8*)(KR + row * QK_LD + ch * 8) = *(const f16x8*)(PX + (size_t)gr * PXLD + P_GK + h * 128 + ch * 8); }
            }
            __syncthreads();
            const int dk = opq(dk0), ig = opq(ig0);
            float bv[16];
#pragma unroll
            for (int ii = 0; ii < 16; ++ii) { const int i = ig * 16 + ii; float pre = bgv;
                const f16x8 l0 = *(const LAS f16x8*)(LR + i * 32 + dir * 16), l1 = *(const LAS f16x8*)(LR + i * 32 + dir * 16 + 8);
#pragma unroll
                for (int r = 0; r < 8; ++r) pre += (float)l0[r] * WG[r * 128 + dk] + (float)l1[r] * WG[(8 + r) * 128 + dk];
                bv[ii] = logsigmoidf_(pre) * (1.0f / 16.0f); }
            float totloc;
            if (dir == 0) {
#pragma unroll
                for (int ii = 1; ii < 16; ++ii) bv[ii] += bv[ii - 1];
                totloc = bv[15]; }
            else {
#pragma unroll
                for (int ii = 14; ii >= 0; --ii) bv[ii] += bv[ii + 1];
                totloc = bv[0]; }
            GT[ig * 128 + dk] = totloc;
            __syncthreads();
            const float g0 = GT[dk], g1 = GT[128 + dk], g2 = GT[256 + dk], g3 = GT[384 + dk];
            const float total = (g0 + g1) + (g2 + g3);
            float off, bmid;
            if (dir == 0) { off = (ig > 0 ? g0 : 0.f) + (ig > 1 ? g1 : 0.f) + (ig > 2 ? g2 : 0.f); bmid = g0 + g1; }
            else { off = (ig < 3 ? g3 : 0.f) + (ig < 2 ? g2 : 0.f) + (ig < 1 ? g1 : 0.f); bmid = g2 + g3; }
#pragma unroll
            for (int ii = 0; ii < 16; ++ii) bv[ii] += off;
            if (FULL) {
#pragma unroll
                for (int ii = 0; ii < 16; ++ii) { const int i = ig * 16 + ii;
                    QT[i * QK_LD + dk] = (f16)((float)QR[i * QK_LD + dk] * scale * __expf(fminf(bv[ii] - bmid, 9.f)));
                    KT[i * QK_LD + dk] = (f16)((float)KR[i * QK_LD + dk] * __expf(fminf(bmid - bv[ii], 9.f))); }
                __syncthreads();
                { const int c = opq(c0), q = opq(q0);
#pragma unroll
                for (int s = 0; s < 2; ++s) { const int T = 2 * w + s, it = T >> 2, jt = T & 3; f32x4 a = (f32x4){0.f, 0.f, 0.f, 0.f};
#pragma unroll
                    for (int kk = 0; kk < 4; ++kk) { const f16x8 kf = *(const LAS f16x8*)(KT + (jt * 16 + c) * QK_LD + kk * 32 + 8 * q);
                        const f16x8 qf = *(const LAS f16x8*)(QT + (it * 16 + c) * QK_LD + kk * 32 + 8 * q); a = GLA_MFMA(kf, qf, a); }
                    const int i = it * 16 + c; f16x4 pv;
#pragma unroll
                    for (int r = 0; r < 4; ++r) { const int jx = jt * 16 + 4 * q + r; const bool keep = dir == 0 ? (jx <= i) : (jx >= i); pv[r] = keep ? (f16)a[r] : (f16)0.f; }
                    *(LAS f16x4*)(PP + i * P_LD + jt * 16 + 4 * q) = pv; } }
                __syncthreads();
#pragma unroll
                for (int ii = 0; ii < 16; ++ii) { const int i = ig * 16 + ii; QT[i * QK_LD + dk] = (f16)((float)QR[i * QK_LD + dk] * scale * __expf(bv[ii])); }
            }
            { f16x8 k0, k1;
#pragma unroll
              for (int ii = 0; ii < 8; ++ii) { k0[ii] = (f16)((float)KR[(ig * 16 + ii) * QK_LD + dk] * __expf(total - bv[ii])); k1[ii] = (f16)((float)KR[(ig * 16 + 8 + ii) * QK_LD + dk] * __expf(total - bv[8 + ii])); }
              *(LAS f16x8*)(KT + dk * KH_LD + ig * 16) = k0; *(LAS f16x8*)(KT + dk * KH_LD + ig * 16 + 8) = k1; }
            if (ig == 0) { DEC[dk] = __expf(total); sumtot += total; }
            __syncthreads();
            const int c = opq(c0), q = opq(q0);
            if (FULL) {
                f32x4 accO[4][2];
#pragma unroll
                for (int it = 0; it < 4; ++it)
#pragma unroll
                    for (int et = 0; et < 2; ++et) accO[it][et] = (f32x4){0.f, 0.f, 0.f, 0.f};
#pragma unroll
                for (int et = 0; et < 2; ++et)
#pragma unroll
                    for (int kk = 0; kk < 2; ++kk) { const f16x8 vf = *(const LAS f16x8*)(VT + (32 * w + 16 * et + c) * VT_LD + kk * 32 + 8 * q);
#pragma unroll
                        for (int it = 0; it < 4; ++it) { const f16x8 pf = *(const LAS f16x8*)(PP + (it * 16 + c) * P_LD + kk * 32 + 8 * q); accO[it][et] = GLA_MFMA(vf, pf, accO[it][et]); } asm volatile("" ::: "memory"); }
#pragma unroll
                for (int kb = 0; kb < 4; ++kb)
#pragma unroll
                    for (int et = 0; et < 2; ++et) { f16x8 sf; asm volatile("" ::: "memory");
#pragma unroll
                        for (int e = 0; e < 4; ++e) { sf[e] = (f16)accS[2 * kb][et][e]; sf[4 + e] = (f16)accS[2 * kb + 1][et][e]; }
#pragma unroll
                        for (int it = 0; it < 4; ++it) { const f16x4 lo = *(const LAS f16x4*)(QT + (it * 16 + c) * QK_LD + 32 * kb + 4 * q), hi = *(const LAS f16x4*)(QT + (it * 16 + c) * QK_LD + 32 * kb + 16 + 4 * q);
                            f16x8 qf; qf[0] = lo[0]; qf[1] = lo[1]; qf[2] = lo[2]; qf[3] = lo[3]; qf[4] = hi[0]; qf[5] = hi[1]; qf[6] = hi[2]; qf[7] = hi[3];
                            accO[it][et] = GLA_MFMA(sf, qf, accO[it][et]); } }
                float* OF = (float*)(F.ws + WS_GOF);
                if (dir == 0) {
#pragma unroll
                    for (int it = 0; it < 4; ++it) { const int gr = prow(b, sc, j, it * 16 + c);
#pragma unroll
                        for (int et = 0; et < 2; ++et) *(f32x4*)(OF + (size_t)gr * 1024 + h * 256 + 32 * w + 16 * et + 4 * q) = accO[it][et];
                        asm volatile("" ::: "memory"); } }
                else {
                    int grs[4]; f32x4 ofv[4][2]; f16x4 rvv[4][2];
#pragma unroll
                    for (int it = 0; it < 4; ++it) { grs[it] = prow(b, sc, j, it * 16 + c);
#pragma unroll
                        for (int et = 0; et < 2; ++et) { ofv[it][et] = *(const f32x4*)(OF + (size_t)grs[it] * 1024 + h * 256 + 32 * w + 16 * et + 4 * q);
                            rvv[it][et] = *(const f16x4*)(PX + (size_t)grs[it] * PXLD + P_GR + h * 256 + 32 * w + 16 * et + 4 * q); } }
                    PIN8(ofv[0][0], ofv[0][1], ofv[1][0], ofv[1][1], ofv[2][0], ofv[2][1], ofv[3][0], ofv[3][1]);
#pragma unroll
                    for (int it = 0; it < 4; ++it) { float ss = 0.f;
#pragma unroll
                        for (int et = 0; et < 2; ++et) { accO[it][et] = accO[it][et] + ofv[it][et];
                            ss += (accO[it][et][0] * accO[it][et][0] + accO[it][et][1] * accO[it][et][1]) + (accO[it][et][2] * accO[it][et][2] + accO[it][et][3] * accO[it][et][3]); }
                        ss += __shfl_xor(ss, 16); ss += __shfl_xor(ss, 32);
                        if (q == 0) RS[(it * 16 + c) * 8 + w] = ss; }
                    __syncthreads();
                    PIN8(rvv[0][0], rvv[0][1], rvv[1][0], rvv[1][1], rvv[2][0], rvv[2][1], rvv[3][0], rvv[3][1]);
                    const float* ng = AV.in(I_GLANG) + (size_t)l * 256;
                    f16* Y = (f16*)(F.ws + WS_YCAT);
#pragma unroll
                    for (int it = 0; it < 4; ++it) { const int i = it * 16 + c; const f32x4 ra = *(const LAS f32x4*)(RS + i * 8), rb = *(const LAS f32x4*)(RS + i * 8 + 4);
                        const float tot = ((ra[0] + ra[1]) + (ra[2] + ra[3])) + ((rb[0] + rb[1]) + (rb[2] + rb[3]));
                        const float rstd = 1.0f / sqrtf(tot * (1.0f / 256.0f) + EPS);
#pragma unroll
                        for (int et = 0; et < 2; ++et) { const int e0 = 32 * w + 16 * et + 4 * q;
                            const f32x4 gv = *(const f32x4*)(ng + e0);
                            f16x4 o;
#pragma unroll
                            for (int r = 0; r < 4; ++r) o[r] = (f16)(accO[it][et][r] * rstd * gv[r] * siluf_((float)rvv[it][et][r]));
                            *(f16x4*)(Y + (size_t)grow(b, sc, j, it * 16 + c) * 2048 + 1024 + h * 256 + e0) = o; } }
                }
            }
#pragma unroll
            for (int dt = 0; dt < 8; ++dt) { const f32x4 dv = *(const LAS f32x4*)(DEC + 16 * dt + 4 * q);
#pragma unroll
                for (int et = 0; et < 2; ++et) accS[dt][et] = accS[dt][et] * dv; }
#pragma unroll
            for (int kk = 0; kk < 2; ++kk) { f16x8 vf[2];
#pragma unroll
                for (int et = 0; et < 2; ++et) vf[et] = *(const LAS f16x8*)(VT + (32 * w + 16 * et + c) * VT_LD + kk * 32 + 8 * q);
#pragma unroll
                for (int dt = 0; dt < 8; ++dt) { const f16x8 kf = *(const LAS f16x8*)(KT + (16 * dt + c) * KH_LD + kk * 32 + 8 * q);
#pragma unroll
                    for (int et = 0; et < 2; ++et) accS[dt][et] = GLA_MFMA(kf, vf[et], accS[dt][et]); if (dt & 1) asm volatile("" ::: "memory"); } }
        }
        if (!FULL) { float* Sl = (float*)(F.ws + WS_GSLOC) + sidx * 32768; const int q = opq(q0), c = opq(c0);
#pragma unroll
            for (int dt = 0; dt < 8; ++dt)
#pragma unroll
                for (int et = 0; et < 2; ++et)
#pragma unroll
                    for (int r = 0; r < 4; ++r) Sl[(16 * dt + 4 * q + r) * 256 + 32 * w + 16 * et + c] = accS[dt][et][r];
            if (ig0 == 0) ((float*)(F.ws + WS_GDT))[sidx * 128 + dk0] = __expf(sumtot); }
        VM_WAIT();
    }
}
__device__ __forceinline__ void ph_gla_scan(const Ctx& F) {
    const float* Sl = (const float*)(F.ws + WS_GSLOC); float* Si = (float*)(F.ws + WS_GSIN); const float* Dt = (const float*)(F.ws + WS_GDT);
    for (int gt = F.bid * 512 + F.tid; gt < 2 * 4 * 2 * 32768; gt += F.G * 512) {
        const int e = gt & 32767, dir = (gt >> 15) & 1, h = (gt >> 16) & 3, b = gt >> 18;
        float S = 0.f;
        for (int base = 0; base < NSC; base += 11) {
            float sl[11], dt[11]; size_t ix[11];
#pragma unroll
            for (int u = 0; u < 11; ++u) { const int step = base + u; const int sc = step == 0 ? 32 : (dir == 0 ? step - 1 : 32 - step);
                const size_t idx = ((((size_t)b * 4 + h) * NSC + sc) * 2 + dir); ix[u] = idx;
                sl[u] = Sl[idx * 32768 + e]; dt[u] = Dt[idx * 128 + (e >> 8)]; }
            PIN8(sl[0], sl[1], sl[2], sl[3], sl[4], sl[5], sl[6], sl[7]); PIN8(dt[0], dt[1], dt[2], dt[3], dt[4], dt[5], dt[6], dt[7]); PIN4(sl[8], sl[9], sl[10], dt[8]); asm volatile("" : "+v"(dt[9]), "+v"(dt[10]));
#pragma unroll
            for (int u = 0; u < 11; ++u) { Si[ix[u] * 32768 + e] = S; S = dt[u] * S + sl[u]; }
        }
    }
}
#undef GLA_FETCH
#undef GLA_MFMA
}

namespace hy {
#define PADI(i) ((i) + ((i) >> 5))
constexpr int HY_BUF_BYTES = (16384 + 512) * 8;
constexpr int HY_SCR_OFF = HY_BUF_BYTES;
static_assert(HY_SCR_OFF + 2048 <= LDSCTL_OFF, "hyena lds");
__device__ __forceinline__ f32x2 twid(int k, float invN) { const float xr = (float)k * invN; return (f32x2){__builtin_amdgcn_cosf(xr), -__builtin_amdgcn_sinf(xr)}; }
__device__ __forceinline__ f32x2 mul_w16(f32x2 d, int a) {
    constexpr float c1 = 0.9238795325112867f, s1 = 0.3826834323650898f, r = 0.7071067811865476f;
    float c, s;
    switch (a & 15) {
        case 0: return d; case 4: return (f32x2){d.y, -d.x}; case 8: return (f32x2){-d.x, -d.y}; case 12: return (f32x2){-d.y, d.x};
        case 1: c = c1; s = s1; break; case 2: c = r; s = r; break; case 3: c = s1; s = c1; break;
        case 5: c = -s1; s = c1; break; case 6: c = -r; s = r; break; case 7: c = -c1; s = s1; break;
        case 9: c = -c1; s = -s1; break; case 10: c = -r; s = -r; break; case 11: c = -s1; s = -c1; break;
        case 13: c = s1; s = -c1; break; case 14: c = r; s = -r; break; default: c = c1; s = -s1; break; }
    return (f32x2){d.x * c + d.y * s, d.y * c - d.x * s};
}
template <int R> __device__ __forceinline__ void dif_pass(LAS f32x2* x, int m, int lh, int tid) {
    const int N = 1 << m; const float invN = 1.0f / (float)N; const int lg = lh - R + 1, g = 1 << lg, S = (N >> 1) >> lh;
    for (int q = tid; q < (N >> R); q += 512) { const int j = q & (g - 1), blk = q >> lg, base = (blk << (lh + 1)) + j;
        f32x2 v[1 << R];
#pragma unroll
        for (int k = 0; k < (1 << R); ++k) v[k] = x[PADI(base + k * g)];
        f32x2 w = twid(j * S, invN);
#pragma unroll
        for (int s = 0; s < R; ++s) { const int half = 1 << (R - 1 - s);
#pragma unroll
            for (int k = 0; k < (1 << R); ++k) if (!(k & half)) { const f32x2 a = v[k], b = v[k + half]; v[k] = a + b;
                v[k + half] = mul_w16(cmul(a - b, w), ((k & (half - 1)) << s) * (16 >> R)); }
            w = cmul(w, w); }
#pragma unroll
        for (int k = 0; k < (1 << R); ++k) x[PADI(base + k * g)] = v[k]; }
    __syncthreads();
}
template <int R> __device__ __forceinline__ void dit_pass(LAS f32x2* x, int m, int lh, int tid) {
    const int N = 1 << m; const float invN = 1.0f / (float)N; const int h = 1 << lh, S1 = (N >> 1) >> lh;
    for (int q = tid; q < (N >> R); q += 512) { const int j = q & (h - 1), blk = q >> lh, base = (blk << (lh + R)) + j;
        f32x2 v[1 << R];
#pragma unroll
        for (int k = 0; k < (1 << R); ++k) v[k] = x[PADI(base + k * h)];
        f32x2 wp[R]; wp[R - 1] = cconj(twid(j * (S1 >> (R - 1)), invN));
#pragma unroll
        for (int s = R - 2; s >= 0; --s) wp[s] = cmul(wp[s + 1], wp[s + 1]);
#pragma unroll
        for (int s = 0; s < R; ++s) { const int half = 1 << s;
#pragma unroll
            for (int k = 0; k < (1 << R); ++k) if (!(k & half)) { const f32x2 a = v[k];
                const f32x2 b = mul_w16(cmul(v[k + half], wp[s]), (16 - (k & (half - 1)) * (16 >> (s + 1))) & 15);
                v[k] = a + b; v[k + half] = a - b; } }
#pragma unroll
        for (int k = 0; k < (1 << R); ++k) x[PADI(base + k * h)] = v[k]; }
    __syncthreads();
}
__device__ __forceinline__ void fft_fwd(LAS f32x2* x, int m, int tid) {
    int lh = m - 1;
    while (lh + 1 >= 4) { dif_pass<4>(x, m, lh, tid); lh -= 4; }
    if (lh + 1 == 2) dif_pass<2>(x, m, 1, tid); else if (lh + 1 == 1) dif_pass<1>(x, m, 0, tid);
}
__device__ __forceinline__ void fft_inv(LAS f32x2* x, int m, int tid) {
    int lh = 0;
    while (m - lh >= 4) { dit_pass<4>(x, m, lh, tid); lh += 4; }
    if (m - lh == 2) dit_pass<2>(x, m, lh, tid); else if (m - lh == 1) dit_pass<1>(x, m, lh, tid);
}
__device__ __forceinline__ int brev(int k, int m) { return (int)(__brev((unsigned)k) >> (32 - m)); }

__device__ __forceinline__ void filt_unit(const Ctx& F, const ArgsV& AV, int l, int unit) {
    const int kind = unit >> 9, o = (unit >> 8) & 1, pair = unit & 255;
    const int n = kind ? LC : SEQ, m = kind ? 9 : 14, N = 2 * n, tid = F.tid;
    LAS f32x2* buf = (LAS f32x2*)F.lds;
    LAS float* W3 = (LAS float*)(F.lds + HY_SCR_OFF);
    LAS float* B3 = W3 + 256;
    LAS float* RED = B3 + 4;
    LAS float* INV = RED + 16;
    __syncthreads();
    if (tid < 4) { const int ci = tid; const int col = o * 1024 + (ci >> 1) * 512 + 2 * pair + (ci & 1); B3[ci] = AV.in(I_HYB3)[(size_t)l * 2048 + col]; }
    __syncthreads();
    const int lane = F.lane, q = lane >> 4, c = lane & 15;
    f16x8 wB0, wB1;
    { const int col = o * 1024 + ((c & 3) >> 1) * 512 + 2 * pair + (c & 1); const float* w3 = AV.in(I_HYW3) + (size_t)l * 64 * 2048 + col;
#pragma unroll
      for (int j = 0; j < 8; ++j) { wB0[j] = c < 4 ? (f16)w3[(size_t)(8 * q + j) * 2048] : (f16)0.f; wB1[j] = c < 4 ? (f16)w3[(size_t)(32 + 8 * q + j) * 2048] : (f16)0.f; } }
    const f16* H2H = (const f16*)(F.ws + WS_H2H) + (kind ? (size_t)SEQ * 64 : 0);
    const float lo = -3.0701134573253945f, hi = -15.350567286626973f;
    const float ra = fabsf(lo + (hi - lo) * (float)(2 * pair) / 511.0f), rb = fabsf(lo + (hi - lo) * (float)(2 * pair + 1) / 511.0f);
    const float rate = (c & 1) ? rb : ra, bias3 = B3[c & 3];
    float sabs = 0.f;
    for (int tile = F.wave; tile < (n >> 4); tile += 8) { const int t0 = tile * 16;
        const f16x8 a0 = *(const f16x8*)(H2H + (size_t)(t0 + c) * 64 + 8 * q), a1 = *(const f16x8*)(H2H + (size_t)(t0 + c) * 64 + 32 + 8 * q);
        f32x4 acc = (f32x4){0.f, 0.f, 0.f, 0.f};
        acc = __builtin_amdgcn_mfma_f32_16x16x32_f16(a0, wB0, acc, 0, 0, 0); acc = __builtin_amdgcn_mfma_f32_16x16x32_f16(a1, wB1, acc, 0, 0, 0);
        if (c < 4) {
#pragma unroll
            for (int i = 0; i < 4; ++i) { const int t = t0 + 4 * q + i; const float v = (acc[i] + bias3) * expf(-((float)t / (float)(n - 1)) * rate);
                LAS float* bp = (LAS float*)buf;
                if (c < 2) { bp[2 * PADI(t) + c] = v; sabs += fabsf(v); }
                else if (t >= 1) { bp[2 * PADI(N - t) + (c - 2)] = v; sabs += fabsf(v); } } }
    }
    float sa = (c == 0 || c == 2) ? sabs : 0.f, sb = (c == 1 || c == 3) ? sabs : 0.f;
    if (tid == 0) { float z0 = 0.f; asm volatile("" : "+v"(z0)); buf[PADI(n)] = (f32x2){z0, z0}; }
    sa = wave_sum(sa); sb = wave_sum(sb);
    if (F.lane == 0) { RED[F.wave * 2] = sa; RED[F.wave * 2 + 1] = sb; }
    __syncthreads();
    if (tid < 2) { float s = 0.f;
#pragma unroll
        for (int w = 0; w < 8; ++w) s += RED[w * 2 + tid];
        INV[tid] = 1.0f / (s + EPS); }
    __syncthreads();
    { const float ia = INV[0], ib = INV[1];
      for (int i = tid; i < N; i += 512) { f32x2 v = buf[PADI(i)]; v.x *= ia; v.y *= ib; buf[PADI(i)] = v; } }
    __syncthreads();
    fft_fwd(buf, m, tid);
    f32x4* out = (f32x4*)(F.ws + WS_FSD + (kind ? FSD_C_OFF : 0)) + (size_t)(o * 256 + pair) * (n + 1);
    for (int u = tid; u <= n; u += 512) { const int p = u < n ? 2 * u : 1, k = brev(p, m), pn = brev((N - k) & (N - 1), m);
        const f32x2 zk = buf[PADI(p)], zn = cconj(buf[PADI(pn)]);
        const f32x2 fa = (zk + zn) * 0.5f, df = zk - zn, fb = (f32x2){df.y * 0.5f, -df.x * 0.5f};
        const f32x2 fs = (fa + fb) * 0.5f, fd = (fa - fb) * 0.5f;
        out[u] = (f32x4){fs.x, fs.y, fd.x, fd.y}; }
    __syncthreads();
}

__device__ __forceinline__ void main_unit(const Ctx& F, const ArgsV& AV, int l, int unit) {
    const int kind = unit >> 9, b = (unit >> 8) & 1, pair = unit & 255;
    const int n = kind ? LC : SEQ, m = kind ? 9 : 14, N = 2 * n, tid = F.tid;
    const int row0 = kind ? MX + b * LC : b * SEQ;
    LAS f32x2* buf = (LAS f32x2*)F.lds;
    const f16* ZT = (const f16*)(F.ws + WS_ZT) + (size_t)(2 * pair) * MT + row0;
    const float* cw = AV.in(I_HYCW) + (size_t)l * 3 * 1536 + 2 * pair; const float* cb = AV.in(I_HYCB) + (size_t)l * 1536 + 2 * pair;
    f32x2 yv[16], g1[16], g2[16];
#pragma unroll
    for (int g = 0; g < 3; ++g)
#pragma unroll
        for (int cc = 0; cc < 2; ++cc) { const float w0 = cw[g * 512 + cc], w1 = cw[1536 + g * 512 + cc], w2 = cw[3072 + g * 512 + cc], bs = cb[g * 512 + cc];
            const f16* zt = ZT + (size_t)(g * 512 + cc) * MT;
#pragma unroll
            for (int gi = 0; gi < 2; ++gi) { const int t0 = 8 * (tid + 512 * gi);
                f16x8 mv; float pv = 0.f, nv = 0.f;
#pragma unroll
                for (int e = 0; e < 8; ++e) mv[e] = (f16)0.f;
                if (t0 < n) { mv = *(const f16x8*)(zt + t0); if (t0 > 0) pv = (float)zt[t0 - 1]; if (t0 + 8 < n) nv = (float)zt[t0 + 8]; }
#pragma unroll
                for (int e = 0; e < 8; ++e) { const float zm = e == 0 ? pv : (float)mv[e == 0 ? 0 : e - 1], zc = (float)mv[e], zp = e == 7 ? nv : (float)mv[e == 7 ? 7 : e + 1];
                    const float r = w0 * zm + w1 * zc + w2 * zp + bs;
                    if (g == 0) { if (cc == 0) yv[gi * 8 + e].x = r; else yv[gi * 8 + e].y = r; }
                    else if (g == 1) { if (cc == 0) g1[gi * 8 + e].x = r; else g1[gi * 8 + e].y = r; }
                    else { if (cc == 0) g2[gi * 8 + e].x = r; else g2[gi * 8 + e].y = r; } } } }
    const float invN = 1.0f / (float)N;
#pragma unroll
    for (int o = 0; o < 2; ++o) {
        __syncthreads();
        float z0 = 0.f; asm volatile("" : "+v"(z0));
#pragma unroll
        for (int gi = 0; gi < 2; ++gi) { const int t0 = 8 * (tid + 512 * gi);
            if (t0 < n) {
#pragma unroll
                for (int e = 0; e < 8; ++e) { buf[PADI(t0 + e)] = yv[gi * 8 + e]; buf[PADI(n + t0 + e)] = (f32x2){z0, z0}; } } }
        __syncthreads();
        fft_fwd(buf, m, tid);
        const f32x4* fsd = (const f32x4*)(F.ws + WS_FSD + (kind ? FSD_C_OFF : 0)) + (size_t)(o * 256 + pair) * (n + 1);
        for (int u = tid; u <= n; u += 512) { const int p = u < n ? 2 * u : 1, k = brev(p, m), pn = brev((N - k) & (N - 1), m);
            const f32x2 zk = buf[PADI(p)], zn = buf[PADI(pn)]; const f32x4 f = fsd[u]; const f32x2 fs = (f32x2){f[0], f[1]}, fd = (f32x2){f[2], f[3]};
            const f32x2 wk = cmul(zk, fs) + cmul(cconj(zn), fd), wn = cmul(zn, cconj(fs)) + cmul(cconj(zk), cconj(fd));
            buf[PADI(pn)] = wn; buf[PADI(p)] = wk; }
        __syncthreads();
        fft_inv(buf, m, tid);
        const float* hb = AV.in(I_HYBIAS) + ((size_t)l * 2 + o) * 512 + 2 * pair; const f32x2 bias = (f32x2){hb[0], hb[1]};
#pragma unroll
        for (int gi = 0; gi < 2; ++gi) { const int t0 = 8 * (tid + 512 * gi);
            if (t0 < n) {
#pragma unroll
                for (int e = 0; e < 8; ++e) { const f32x2 cv = buf[PADI(t0 + e)] * invN; const f32x2 gt = o == 0 ? g1[gi * 8 + e] : g2[gi * 8 + e];
                    yv[gi * 8 + e] = gt * (cv + yv[gi * 8 + e] * bias); } } }
    }
    f16* Y = (f16*)(F.ws + WS_YBT) + (size_t)(2 * pair) * MT + row0;
#pragma unroll
    for (int gi = 0; gi < 2; ++gi) { const int t0 = 8 * (tid + 512 * gi);
        if (t0 < n) { f16x8 oa, ob;
#pragma unroll
            for (int e = 0; e < 8; ++e) { oa[e] = (f16)yv[gi * 8 + e].x; ob[e] = (f16)yv[gi * 8 + e].y; }
            *(f16x8*)(Y + t0) = oa; *(f16x8*)(Y + MT + t0) = ob; } }
    __syncthreads();
}

__device__ __forceinline__ void ph_ybt_transpose(const Ctx& F) {
    LAS f16* T = (LAS f16*)F.lds;
    const f16* YBT = (const f16*)(F.ws + WS_YBT); f16* Y = (f16*)(F.ws + WS_YCAT);
    const bool bal = (F.G == 256);
    for (int it = 0; it < (bal ? 2 : (MT / 64 + F.G - 1) / F.G); ++it) {
        int rb;
        if (bal) { if (F.bid >= 132) rb = (F.bid - 132) + 124 * it; else if (F.bid < 16 && it == 0) rb = 248 + F.bid; else rb = -1; }
        else rb = F.bid + it * F.G;
        if (rb < 0 || rb >= MT / 64) continue;
        const int r0 = rb * 64;
        __syncthreads();
        { f16x8 tv[8];
#pragma unroll
          for (int i = 0; i < 8; ++i) tv[i] = *(const f16x8*)(YBT + (size_t)F.tid * MT + r0 + 8 * i);
          PIN8(tv[0], tv[1], tv[2], tv[3], tv[4], tv[5], tv[6], tv[7]);
#pragma unroll
          for (int i = 0; i < 8; ++i) *(LAS f16x8*)(T + F.tid * 72 + 8 * i) = tv[i]; }
        __syncthreads();
        const int row = F.tid >> 3, cg = F.tid & 7;
#pragma unroll
        for (int jj = 0; jj < 8; ++jj) { const int gidx = cg + 8 * jj; f16x8 o;
#pragma unroll
            for (int e = 0; e < 8; ++e) o[e] = T[(8 * gidx + e) * 72 + row];
            *(f16x8*)(Y + (size_t)(r0 + row) * 2048 + 512 + 8 * gidx) = o; }
    }
    __syncthreads();
}
#undef PADI
}

#ifndef PHMASK
#define PHMASK 0xFFFF
#endif
#define PH_EN(k) (((PHMASK) >> (k)) & 1)
#ifndef STAMP_MASK
#define STAMP_MASK 0
#endif
#ifndef STAMP_K
#define STAMP_K 1
#endif
#ifndef SUBMASK
#define SUBMASK 7
#endif
#define SUB_EN(k) (((SUBMASK) >> (k)) & 1)
constexpr int NPH = 2 + 12 * DEPTH;
constexpr int CW_Q = 8192;
__device__ __forceinline__ int q_pull(unsigned* ctr, volatile LAS int* slot) {
    __syncthreads();
    if (threadIdx.x == 0) *slot = (int)__hip_atomic_fetch_add(ctr, 1u, __ATOMIC_RELAXED, __HIP_MEMORY_SCOPE_AGENT);
    __syncthreads();
    return *slot;
}

__global__ void __launch_bounds__(512, 2) mk_fwd(Args args) {
    extern __shared__ __attribute__((aligned(16))) unsigned char lds_raw[];
    Ctx F; F.lds = (LAS unsigned char*)lds_raw; F.tid = threadIdx.x; F.lane = F.tid & 63; F.wave = __builtin_amdgcn_readfirstlane(F.tid >> 6);
    F.G = gridDim.x; F.bid = blockIdx.x; F.ws = args.ws;
    ArgsV AV; AV.out = args.out;
    const Ctx F0 = F;
#define FRESH() do { F.tid = opq(F0.tid); F.lane = F.tid & 63; F.wave = __builtin_amdgcn_readfirstlane(F.tid >> 6); } while (0)
    volatile LAS unsigned* MISC = (volatile LAS unsigned*)(F.lds + LDSCTL_OFF);
    if (F.tid < 64) MISC[F.tid] = 0u;
    __syncthreads();
    unsigned* barw = (unsigned*)(F.ws + WS_CTL) + CW_BAR;
    XcdBarrier bar; bar.bar = barw; bar.x = 0; bar.st = nullptr;
    const int lo = args.ph_lo, hi = args.ph_hi;
    if (hi - lo > 1) bar = xcd_barrier_post(barw, MISC + 8);
#define IN(k) (lo <= (k) && (k) < hi)
#define SEAM(k) do { if (IN(k) && IN((k) + 1)) xcd_barrier(bar); } while (0)
#if STAMP_MASK
    volatile LAS unsigned long long* TS = (volatile LAS unsigned long long*)(F.lds + LDSCTL_OFF + 128);
#define TSTART(k) do { if ((((STAMP_MASK) >> (k)) & 1) && blockIdx.x == 0 && threadIdx.x == 0) TS[0] = __builtin_amdgcn_s_memrealtime(); } while (0)
#define TSTOP(k) do { if ((((STAMP_MASK) >> (k)) & 1) && blockIdx.x == 0 && threadIdx.x == 0) TS[1] = TS[1] + (__builtin_amdgcn_s_memrealtime() - TS[0]); } while (0)
#else
#define TSTART(k) do {} while (0)
#define TSTOP(k) do {} while (0)
#endif
    unsigned char* ws = F.ws;
    const int rank160 = (F.bid + F.G - 160 % F.G) % F.G;

    TSTART(12);
    if (PH_EN(12) && IN(0)) { FRESH(); ph_prologue(F, AV); }
    SEAM(0);
    TSTOP(12);

    for (int l = 0; l < DEPTH; ++l) {
        const int pb = 1 + 12 * l;
        const float* modl = (const float*)(ws + WS_MOD) + (size_t)l * 3 * 12288;
        const bool ctx_on = l < DEPTH - 1;
        const int nMr = ctx_on ? MT / 256 : MX / 256, nrows = ctx_on ? MT : MX;
        TSTART(0);
        if (PH_EN(0) && IN(pb + 0)) {
            FRESH(); ph_convert_weights(F, AV, l);
            __syncthreads();
            FRESH(); if (F.bid < 32) s5_mats_group(F, AV, l, F.bid);
            FRESH(); ph_hyena_h2(F, AV, l);
            FRESH(); ph_norm(F, AV, l, 0, MT, l > 0 ? 11 : 0);
        }
        SEAM(pb + 0);
        TSTOP(0);
        TSTART(1);
        if (PH_EN(1) && IN(pb + 1)) {
            pg8::SchedPlain S; S.init(MT / 256, WINN / 256, F.G, F.bid); S.A = (const char*)(ws + WS_HN); S.B = (const char*)(ws + WS_WIN); S.aTile = (size_t)256 * 2048 * 2; S.bTile = (size_t)256 * 2048 * 2;
            pg8::EpiPx E{(f16*)(ws + WS_PX), (f16*)(ws + WS_S5A), (f16*)(ws + WS_ZT), (f16*)(ws + WS_GTL)};
            pg8::gemm_phase(F.lds, 2048, 2048, 32, S, E);
        }
        SEAM(pb + 1);
        TSTOP(1);
        TSTART(2);
        if (PH_EN(2) && IN(pb + 2)) {
            TSTART(16);
            if (SUB_EN(0)) { pg8::SchedS5 S{(const char*)(ws + WS_S5A), (const char*)(ws + WS_S5M), (size_t)256 * 256 * 2, F.G, F.bid};
              pg8::EpiS5In E{(float*)(ws + WS_S5S)};
              pg8::gemm_phase(F.lds, 16384, 256, 4, S, E); }
            TSTOP(16);
            { unsigned* qc = (unsigned*)(ws + WS_CTL) + CW_Q + (l * 2 + 0) * 64; volatile LAS int* slot = (volatile LAS int*)(MISC + 16);
              for (;;) { const int u = q_pull(qc, slot); if (u >= 264 + 1024) break;
                  if (u < 264) { TSTART(17); FRESH(); gla::gla_unit<false>(F, AV, l, u); TSTOP(17); } else { TSTART(18); FRESH(); hy::filt_unit(F, AV, l, u - 264); TSTOP(18); } } }
        }
        SEAM(pb + 2);
        TSTOP(2);
        TSTART(3);
        if (PH_EN(3) && IN(pb + 3)) { FRESH(); ph_s5_scan(F); FRESH(); gla::ph_gla_scan(F); }
        SEAM(pb + 3);
        TSTOP(3);
        TSTART(4);
        if (PH_EN(4) && IN(pb + 4)) {
            TSTART(19);
            if (SUB_EN(0)) { pg8::SchedS5 S{(const char*)(ws + WS_S5A), (const char*)(ws + WS_S5W), (size_t)256 * 512 * 2, F.G, F.bid};
              pg8::EpiS5Out E{(const f16*)(ws + WS_S5A), (f16*)(ws + WS_YAPRE), AV.in(I_S5D) + (size_t)l * 512};
              pg8::gemm_phase(F.lds, 16384, 512, 8, S, E); }
            TSTOP(19);
            { unsigned* qc = (unsigned*)(ws + WS_CTL) + CW_Q + (l * 2 + 1) * 64; volatile LAS int* slot = (volatile LAS int*)(MISC + 16);
              for (;;) { const int u = q_pull(qc, slot); if (u >= 264 + 1024) break;
                  if (u < 264) { TSTART(20); FRESH(); gla::gla_unit<true>(F, AV, l, u); TSTOP(20); } else { TSTART(21); FRESH(); hy::main_unit(F, AV, l, u - 264); TSTOP(21); } } }
        }
        SEAM(pb + 4);
        TSTOP(4);
        TSTART(5);
        if (PH_EN(5) && IN(pb + 5)) {
            pg8::SchedPlain S; S.init(nMr, 2, F.G, F.bid); S.A = (const char*)(ws + WS_YAPRE); S.B = (const char*)(ws + WS_WGLU); S.aTile = (size_t)256 * 512 * 2; S.bTile = (size_t)256 * 512 * 2;
            pg8::EpiGlu E{(const f16*)(ws + WS_YAPRE), (f16*)(ws + WS_YCAT), AV.in(I_GLUB) + (size_t)l * 512};
            pg8::gemm_phase(F.lds, 512, 512, 8, S, E);
            FRESH(); hy::ph_ybt_transpose(F);
        }
        SEAM(pb + 5);
        TSTOP(5);
        TSTART(6);
        if (PH_EN(6) && IN(pb + 6)) {
            pg8::SchedPlain S; S.init(nMr, 8, F.G, F.bid); S.aTile = (size_t)256 * 2048 * 2; S.bTile = (size_t)256 * 2048 * 2;
            S.A = (const char*)(ws + WS_YCAT); S.B = (const char*)(ws + WS_WBR);
            pg8::EpiBranchF E{(const f16*)(ws + WS_GTL), (f16*)(ws + WS_MBUF)};
            TSTART(24);
            pg8::gemm_phase(F.lds, 2048, 2048, 32, S, E);
            TSTOP(24);
#ifdef PG_DUMMY
            { pg8::EpiF16 E9{(f16*)(ws + WS_ACT), 2048}; pg8::gemm_phase(F.lds, 2048, 2048, 32, S, E9); }
#endif
        }
        SEAM(pb + 6);
        TSTOP(6);
        TSTART(7);
        if (PH_EN(7) && IN(pb + 7)) {
            pg8::SchedPlain S; S.init(MX / 256, 8, F.G, F.bid); S.A = (const char*)(ws + WS_MBUF); S.B = (const char*)(ws + WS_WOUT); S.aTile = (size_t)256 * 2048 * 2; S.bTile = (size_t)256 * 2048 * 2;
            pg8::EpiResid E{(float*)(ws + WS_XRES), modl, 4096};
            pg8::gemm_phase(F.lds, 2048, 2048, 32, S, E);
            if (ctx_on) { pg8::SchedSplit S2{(const char*)(ws + WS_MBUF), (const char*)(ws + WS_WOUT), (size_t)256 * 2048 * 2, (size_t)256 * 2048 * 2, (size_t)8 * 128, 4, F.G, F.bid};
                pg8::EpiSlab E2{(float*)(ws + WS_SLAB), modl, 4096};
                pg8::gemm_phase(F.lds, 2048, 2048, 8, S2, E2); }
        }
        SEAM(pb + 7);
        TSTOP(7);
        TSTART(8);
        if (PH_EN(8) && IN(pb + 8)) { FRESH(); ph_norm(F, AV, l, 1, nrows, 4); }
        SEAM(pb + 8);
        TSTOP(8);
        TSTART(9);
        if (PH_EN(9) && IN(pb + 9)) {
            pg8::SchedPlain S; S.init(nMr, UPLD / 256, F.G, F.bid); S.A = (const char*)(ws + WS_HN); S.B = (const char*)(ws + WS_WUP); S.aTile = (size_t)256 * 2048 * 2; S.bTile = (size_t)256 * 2048 * 2;
            pg8::EpiUpAct E{(f16*)(ws + WS_ACT), (float*)(ws + WS_HALO), AV.in(I_FFCW) + (size_t)l * 3 * FFH, AV.in(I_FFCB) + (size_t)l * FFH, (LAS float*)(F.lds + EXTRA_OFF)};
            pg8::gemm_phase(F.lds, 2048, 2048, 32, S, E);
        }
        SEAM(pb + 9);
        TSTOP(9);
        TSTART(10);
        if (PH_EN(10) && IN(pb + 10)) { FRESH(); ph_ffn_fix(F, AV, l, nMr); }
        SEAM(pb + 10);
        TSTOP(10);
        TSTART(11);
        if (PH_EN(11) && IN(pb + 11)) {
            pg8::SchedPlain S; S.init(MX / 256, 8, F.G, F.bid); S.A = (const char*)(ws + WS_ACT); S.B = (const char*)(ws + WS_WDN); S.aTile = (size_t)256 * FFH * 2; S.bTile = (size_t)256 * FFH * 2;
            pg8::EpiResid E{(float*)(ws + WS_XRES), modl, 10240};
            pg8::gemm_phase(F.lds, FFH, FFH, FFH / 64, S, E);
            if (ctx_on) { pg8::SchedSplit S2{(const char*)(ws + WS_ACT), (const char*)(ws + WS_WDN), (size_t)256 * FFH * 2, (size_t)256 * FFH * 2, (size_t)8 * 128, 11, F.G, F.bid};
                pg8::EpiSlab E2{(float*)(ws + WS_SLAB), modl, 10240};
                pg8::gemm_phase(F.lds, FFH, FFH, 8, S2, E2); }
        }
        SEAM(pb + 11);
        TSTOP(11);
    }
    if (PH_EN(13) && IN(NPH - 1)) { FRESH(); ph_final_norm(F, AV); }
#if STAMP_MASK
    if (blockIdx.x == 0 && threadIdx.x == 0) { const unsigned long long t0 = __builtin_amdgcn_s_memrealtime(); while (__builtin_amdgcn_s_memrealtime() - t0 < (unsigned long long)(STAMP_K) * TS[1]) __builtin_amdgcn_s_sleep(8); }
#endif
#undef IN
#undef SEAM
#undef FRESH
}

extern "C" void kernel_launch(void* const* d_in, const int* in_sizes, int n_in, void* d_out, int out_size, void* d_ws, size_t ws_size, hipStream_t stream) {
    static int grid = 0;
    if (grid == 0) {
        if (n_in != 40 || out_size != MX * D || ws_size < WS_END) { fprintf(stderr, "kernel_launch: unexpected problem (n_in %d out %d ws %zu, need %zu)\n", n_in, out_size, ws_size, (size_t)WS_END); grid = -1; return; }
        int dev = 0, cus = 0, per_cu = 0;
        if (hipGetDevice(&dev) != hipSuccess || hipDeviceGetAttribute(&cus, hipDeviceAttributeMultiprocessorCount, dev) != hipSuccess) { grid = -1; return; }
        if (hipFuncSetAttribute((const void*)mk_fwd, hipFuncAttributeMaxDynamicSharedMemorySize, LDS_BYTES) != hipSuccess) { fprintf(stderr, "kernel_launch: hipFuncSetAttribute failed\n"); grid = -1; return; }
        if (hipOccupancyMaxActiveBlocksPerMultiprocessor(&per_cu, (const void*)mk_fwd, 512, LDS_BYTES) != hipSuccess || per_cu < 1)
            fprintf(stderr, "kernel_launch: occupancy query reports %d\n", per_cu);
        (void)hipGetLastError();
        grid = cus;
    }
    if (grid < 0) return;
    if (hipMemsetAsync((char*)d_ws + WS_CTL, 0, CTL_ZERO_BYTES, stream) != hipSuccess) return;
    Args a{};
    for (int i = 0; i < 40; ++i) a.in[i] = (const float*)d_in[i];
    a.out = (float*)d_out; a.ws = (unsigned char*)d_ws;
#if MK_ONE
    a.ph_lo = 0; a.ph_hi = NPH;
    hipLaunchKernelGGL(mk_fwd, dim3(grid), dim3(512), LDS_BYTES, stream, a);
#else
    for (int p = 0; p < NPH; ++p) { a.ph_lo = p; a.ph_hi = p + 1; hipLaunchKernelGGL(mk_fwd, dim3(grid), dim3(512), LDS_BYTES, stream, a); }
#endif
}
```

```cpp
#include <hip/hip_runtime.h>
#include <stdio.h>

#ifndef MK_ONE
#define MK_ONE 1
#define STAMP_MASK 0
#define STAMP_K 1
#endif

#define GAS __attribute__((address_space(1)))
#define LAS __attribute__((address_space(3)))
typedef _Float16 f16;
typedef _Float16 f16x8 __attribute__((ext_vector_type(8)));
typedef _Float16 f16x4 __attribute__((ext_vector_type(4)));
typedef _Float16 f16x2 __attribute__((ext_vector_type(2)));
typedef float f32x4 __attribute__((ext_vector_type(4)));
typedef float f32x2 __attribute__((ext_vector_type(2)));

constexpr int D = 2048, NB = 2, SEQ = 8192, LC = 256, DEPTH = 4;
constexpr int MX = NB * SEQ, MC = NB * LC, MT = MX + MC;
constexpr int PXLD = 3840, WINN = 11520, FFH = 5632, UPLD = 2 * FFH;
constexpr int P_S5 = 0, P_GK = 512, P_GV = 1024, P_GQ = 2048, P_GR = 2560, P_HY = 3584, P_MG = 5120, P_GG = 3584, W_GG = 11264;
constexpr int INW = 11296;
constexpr int NCHK = 1056;
constexpr float S5SCALE = 1024.f;
constexpr float EPS = 1e-6f;
constexpr int NSC = 33;

constexpr size_t MiB = 1u << 20;
constexpr size_t WS_CTL = 0, CTL_ZERO_BYTES = 1 * MiB;
constexpr size_t WS_MOD = 1 * MiB;
constexpr size_t WS_TW = 2 * MiB;
constexpr size_t WS_S5AT = 3 * MiB;
constexpr size_t WS_WIN = 4 * MiB;
constexpr size_t WS_WGLU = WS_WIN + 45 * MiB;
constexpr size_t WS_WBR = WS_WGLU + 1 * MiB;
constexpr size_t WS_WOUT = WS_WBR + 8 * MiB;
constexpr size_t WS_WUP = WS_WOUT + 8 * MiB;
constexpr size_t WS_WDN = WS_WUP + 44 * MiB;
constexpr size_t WS_S5W = WS_WDN + 22 * MiB;
constexpr size_t WS_S5M = WS_S5W + 8 * MiB;
constexpr size_t WS_H2 = WS_S5M + 4 * MiB;
constexpr size_t WS_FSD = WS_H2 + 3 * MiB;
constexpr size_t FSD_C_OFF = (size_t)2 * 256 * 8193 * 16;
constexpr size_t WS_XRES = WS_FSD + 68 * MiB;
constexpr size_t WS_HN = WS_XRES + 132 * MiB;
constexpr size_t WS_PX = WS_HN + 66 * MiB;
constexpr size_t WS_S5A = WS_PX + 372 * MiB;
constexpr size_t WS_S5S = WS_S5A + 40 * MiB;
constexpr size_t WS_YAPRE = WS_S5S + 40 * MiB;
constexpr size_t WS_YCAT = WS_YAPRE + 20 * MiB;
constexpr size_t WS_MBUF = WS_YCAT + 66 * MiB;
constexpr size_t WS_GSLOC = WS_MBUF + 66 * MiB;
constexpr size_t WS_GSIN = WS_GSLOC + 66 * MiB;
constexpr size_t WS_GOF = WS_GSIN + 66 * MiB;
constexpr size_t WS_GDT = WS_GOF + 66 * MiB;
constexpr size_t WS_ACT = WS_GSLOC;
constexpr size_t WS_ZT = WS_GDT + 1 * MiB;
constexpr size_t WS_YBT = WS_ZT + 50 * MiB;
constexpr size_t WS_SLAB = WS_YBT + 17 * MiB;
constexpr size_t WS_HALO = WS_SLAB + 44 * MiB;
constexpr size_t WS_GTL = WS_HALO + 9 * MiB;
constexpr size_t WS_END = WS_GTL + 198 * MiB;
constexpr size_t WS_FSD2 = WS_PX + 124 * MiB;
constexpr size_t WS_W2 = WS_FSD2 + 68 * MiB;
constexpr size_t WS_H2H = WS_W2 + 128 * MiB;
static_assert(WS_H2H + 5 * MiB <= WS_PX + 372 * MiB, "PX tail");
static_assert((size_t)MT * FFH * 2 <= 198 * MiB, "ACT overlay");
constexpr int CW_BAR = 4096;

constexpr int RING_BYTES = 131072;
constexpr int EXTRA_OFF = RING_BYTES, EXTRA_BYTES = 8192;
constexpr int LDSCTL_OFF = EXTRA_OFF + EXTRA_BYTES;
constexpr int LDS_BYTES = LDSCTL_OFF + 256;

__device__ __forceinline__ float wave_sum(float v) {
#pragma unroll
    for (int o = 1; o < 64; o <<= 1) v += __shfl_xor(v, o);
    return v;
}
__device__ __forceinline__ float sigmoidf_(float x) { return 1.0f / (1.0f + __expf(-x)); }
__device__ __forceinline__ float siluf_(float x) { return x * sigmoidf_(x); }
__device__ __forceinline__ float gelu_tanh_(float x) { const float u = 0.7978845608028654f * (x + 0.044715f * x * x * x); return x / (1.0f + __expf(-2.0f * u)); }
__device__ __forceinline__ float logsigmoidf_(float x) { return fminf(x, 0.f) - __logf(1.0f + __expf(-fabsf(x))); }
__device__ __forceinline__ f32x2 cmul(f32x2 a, f32x2 b) { return (f32x2){a.x * b.x - a.y * b.y, a.x * b.y + a.y * b.x}; }
__device__ __forceinline__ f32x2 cconj(f32x2 a) { return (f32x2){a.x, -a.y}; }
__device__ __forceinline__ int opq(int x) { asm volatile("" : "+v"(x)); return x; }
#define PIN8(a, b, c, d, e, f, g, h) asm volatile("" : "+v"(a), "+v"(b), "+v"(c), "+v"(d), "+v"(e), "+v"(f), "+v"(g), "+v"(h))
#define PIN4(a, b, c, d) asm volatile("" : "+v"(a), "+v"(b), "+v"(c), "+v"(d))
#define LDS_WAIT() asm volatile("s_waitcnt lgkmcnt(0)" ::: "memory")
#define VM_WAIT() asm volatile("s_waitcnt vmcnt(0)" ::: "memory")

#define XB_TMO      128
#define XB_XCNT(j)  (256  + 64 * (j))
#define XB_XSUB(j)  (1280 + 64 * (j))
#define XB_XGEN(j)  (2304 + 64 * (j))
#define XB_TOP      3328
#define XB_TOPGEN   3392
#define XCD_BAR_WORDS 3456
#define XB_SPIN_CAP (1u << 18)
__device__ __forceinline__ unsigned xb_ld(unsigned* p)              { return __hip_atomic_load(p, __ATOMIC_RELAXED, __HIP_MEMORY_SCOPE_AGENT); }
__device__ __forceinline__ unsigned xb_add(unsigned* p, unsigned v) { return __hip_atomic_fetch_add(p, v, __ATOMIC_RELAXED, __HIP_MEMORY_SCOPE_AGENT); }
__device__ __forceinline__ unsigned xb_xcc_id() { return (unsigned)__builtin_amdgcn_s_getreg((3 << 11) | 20) & 0xFu; }
#define XB_SPIN(cond, bar) do { unsigned _sp = 0; while (cond) { __builtin_amdgcn_s_sleep(1); \
    if ((++_sp & 255u) == 0u) { if (xb_ld(&(bar)[XB_TMO])) break; if (_sp > XB_SPIN_CAP) { atomicAdd(&(bar)[XB_TMO], 1u); break; } } } } while (0)
struct XcdBarrier { unsigned* bar; unsigned x; volatile LAS unsigned* st; };
__device__ __forceinline__ XcdBarrier xcd_barrier_post(unsigned* bar, volatile LAS unsigned* st) {
    XcdBarrier b; b.bar = bar; b.x = xb_xcc_id(); b.st = st;
    if (threadIdx.x == 0) (void)xb_add(&bar[XB_XCNT(b.x)], 1u);
    return b;
}
__device__ __forceinline__ void xcd_barrier_complete(unsigned* bar, unsigned x, unsigned& nloc, unsigned& nx) {
    const unsigned G = gridDim.x * gridDim.y * gridDim.z;
    unsigned sum, cnt, mine, sp = 0u;
    for (;;) {
        sum = 0u; cnt = 0u; mine = 0u;
#pragma unroll
        for (unsigned j = 0; j < 16; ++j) { const unsigned c = xb_ld(&bar[XB_XCNT(j)]); sum += c; cnt += (c > 0u) ? 1u : 0u; mine = (j == x) ? c : mine; }
        if (sum == G) break;
        __builtin_amdgcn_s_sleep(1);
        if ((++sp & 255u) == 0u) { if (xb_ld(&bar[XB_TMO])) break; if (sp > XB_SPIN_CAP) { atomicAdd(&bar[XB_TMO], 1u); break; } }
    }
    nloc = mine > 0u ? mine : 1u; nx = cnt > 0u ? cnt : 1u;
}
__device__ __forceinline__ void xcd_barrier(const XcdBarrier& b) {
    asm volatile("s_waitcnt vmcnt(0)" ::: "memory");
    __syncthreads();
    if (threadIdx.x == 0) {
        unsigned* bar = b.bar;
        __builtin_amdgcn_s_waitcnt(0);
        unsigned nloc = b.st[0], nx = b.st[1];
        if (nloc == 0u) { xcd_barrier_complete(bar, b.x, nloc, nx); b.st[0] = nloc; b.st[1] = nx; }
        const unsigned old = xb_add(&bar[XB_XSUB(b.x)], 1u);
        const unsigned gen = old / nloc;
        if (old + 1u == (gen + 1u) * nloc) {
            __builtin_amdgcn_fence(__ATOMIC_RELEASE, "agent");
            asm volatile("s_waitcnt vmcnt(0)" ::: "memory");
            const unsigned og = xb_add(&bar[XB_TOP], 1u);
            const unsigned tg = og / nx;
            if (og + 1u == (tg + 1u) * nx) xb_add(&bar[XB_TOPGEN], 1u);
            else XB_SPIN(xb_ld(&bar[XB_TOPGEN]) == tg, bar);
            __builtin_amdgcn_fence(__ATOMIC_ACQUIRE, "agent");
            xb_add(&bar[XB_XGEN(b.x)], 1u);
            asm volatile("s_waitcnt vmcnt(0)" ::: "memory");
        } else {
            XB_SPIN(xb_ld(&bar[XB_XGEN(b.x)]) == gen, bar);
            __builtin_amdgcn_fence(__ATOMIC_ACQUIRE, "agent");
            asm volatile("s_waitcnt vmcnt(0)" ::: "memory");
        }
    }
    __syncthreads();
}

struct Args {
    const float* in[40];
    float* out; unsigned char* ws;
    int ph_lo, ph_hi;
};
struct ArgsV {
    __device__ __forceinline__ const float* in(int i) const {
        typedef const __attribute__((address_space(4))) unsigned long long* kp_t;
        kp_t ka = (kp_t)__builtin_amdgcn_kernarg_segment_ptr();
        return (const float*)(*(volatile const __attribute__((address_space(4))) unsigned long long*)(ka + i)); }
    float* out;
};
struct Ctx {
    LAS unsigned char* lds;
    int tid, lane, wave, G, bid;
    unsigned char* ws;
};
enum { I_X = 0, I_C, I_CTX, I_CCTX, I_WMOD, I_BMOD, I_N1G, I_N2G, I_WIN, I_S5ARE, I_S5AIM, I_S5STEP, I_S5BRE, I_S5BIM, I_S5CRE, I_S5CIM,
       I_S5D, I_GLUW, I_GLUB, I_HYCW, I_HYCB, I_HYW1, I_HYB1, I_HYF1, I_HYW2, I_HYB2, I_HYF2, I_HYW3, I_HYB3, I_HYBIAS,
       I_GLAWG, I_GLABG, I_GLANG, I_WBR, I_WOUT, I_WUP, I_FFCW, I_FFCB, I_WDN, I_FNG };

namespace pg8 {
constexpr int BM = 256, BK = 64, HALF = 128, HTB = HALF * BK * 2, STAGE_BYTES = 8 * HTB, NXCD = 8, WGM = 8;
__device__ __forceinline__ int lds_byte(int r, int c) { const int st = (r >> 4) * 2 + (c >> 5), rr = r & 15, cc = c & 31, ob = rr * 64 + cc * 2; return st * 1024 + (ob ^ (((ob >> 9) & 1) << 5)); }
__device__ __forceinline__ void stage_rc(int b, int& R, int& C) { const int st = b / 1024, sb = b % 1024, swz = sb ^ (((sb >> 9) & 1) << 5); R = (st >> 1) * 16 + swz / 64; C = (st & 1) * 32 + (swz % 64) / 2; }
__device__ __forceinline__ int perm32(int rho) { const int n = rho >> 4, i = rho & 15; return 8 * (i >> 2) + 4 * n + (i & 3); }
struct Unit { const char* a; const char* b; int pm, pn; };
struct Order2D {
    int nM, nN, nwg, G, c;
    __device__ __forceinline__ void init(int nM_, int nN_, int G_, int c_) { nM = nM_; nN = nN_; nwg = nM * nN; G = G_; c = c_; }
    __device__ __forceinline__ bool nx(int i, int& pm, int& pn) const {
        const long L = (long)i * G + c; if (L >= nwg) return false;
        int wgid = (int)L; { const int q = nwg / NXCD, r = nwg % NXCD, xcd = wgid % NXCD, off = wgid / NXCD; wgid = (xcd < r ? xcd * (q + 1) : r * (q + 1) + (xcd - r) * q) + off; }
        const int nig = WGM * nN, gid = wgid / nig, fm = gid * WGM, gsz = (nM - fm) < WGM ? (nM - fm) : WGM;
        pm = fm + ((wgid % nig) % gsz); pn = (wgid % nig) / gsz; return true;
    }
};
struct SchedPlain : Order2D {
    const char* A; const char* B; size_t aTile, bTile;
    __device__ __forceinline__ bool next(int i, Unit& u) const { int pm, pn; if (!nx(i, pm, pn)) return false; u.pm = pm; u.pn = pn; u.a = A + (size_t)pm * aTile; u.b = B + (size_t)pn * bTile; return true; }
};
struct SchedSplit {
    const char* A; const char* B; size_t aTile, bTile, ksub; int nsplit, G, c;
    __device__ __forceinline__ bool next(int i, Unit& u) const { const int L = i * G + c; if (L >= 16 * nsplit) return false; const int t = L / nsplit, ks = L % nsplit, pm = 64 + (t >> 3), pn = t & 7;
        u.pm = pm; u.pn = pn | (ks << 8); u.a = A + (size_t)pm * aTile + (size_t)ks * ksub; u.b = B + (size_t)pn * bTile + (size_t)ks * ksub; return true; }
};
struct SchedS5 {
    const char* A; const char* B; size_t bGroup; int G, c;
    __device__ __forceinline__ bool next(int i, Unit& u) const { const int L = i * G + c; if (L >= 160) return false; const int g = L & 31, pm = L >> 5;
        u.pm = pm; u.pn = g; u.a = A + ((size_t)pm * 256 * 16384 + (size_t)g * 512) * 2; u.b = B + (size_t)g * bGroup; return true; }
};

#define PG8_SA(b, h) (((b) * 2 + (h)) * HTB)
#define PG8_SB(b, h) ((4 + (b) * 2 + (h)) * HTB)
#define PG8_STAGE(bufoff, gbase, voff) do { _Pragma("unroll") for (int _i = 0; _i < 2; ++_i) \
        __builtin_amdgcn_global_load_lds((const unsigned*)((const char*)(gbase) + (voff)[_i]), (LAS unsigned*)(lds + (bufoff) + ldsw + _i * 8192), 16, 0, 0); } while (0)
#define PG8_LDA(dst, b, h) do { _Pragma("unroll") for (int m = 0; m < 4; ++m) _Pragma("unroll") for (int k = 0; k < 2; ++k) dst[m][k] = *(const LAS f16x8*)(lds + PG8_SA(b, h) + aoff + m * 2048 + k * 1024); } while (0)
#define PG8_LDB(dst, b, h) do { _Pragma("unroll") for (int n = 0; n < 2; ++n) _Pragma("unroll") for (int k = 0; k < 2; ++k) dst[n][k] = *(const LAS f16x8*)(lds + PG8_SB(b, h) + boff + n * 2048 + k * 1024); } while (0)
#define PG8_MMA(ai, bj, At, Bt) do { __builtin_amdgcn_s_setprio(1); _Pragma("unroll") for (int m = 0; m < 4; ++m) _Pragma("unroll") for (int n = 0; n < 2; ++n) _Pragma("unroll") for (int k = 0; k < 2; ++k) \
        acc[ai][bj][m][n] = __builtin_amdgcn_mfma_f32_16x16x32_f16(Bt[n][k], At[m][k], acc[ai][bj][m][n], 0, 0, 0); __builtin_amdgcn_s_setprio(0); } while (0)
#define PG8_WAIT_V(n) asm volatile("s_waitcnt vmcnt(" #n ")" ::: "memory")
#define PG8_WAIT_L(n) asm volatile("s_waitcnt lgkmcnt(" #n ")" ::: "memory")
#define PG8_BAR __builtin_amdgcn_s_barrier()
#define PG8_SCHED __builtin_amdgcn_sched_barrier(0)

template <class Epi, class Sched>
__device__ __forceinline__ void gemm_phase(LAS unsigned char* lds, const int lda, const int ldb, const int nt, const Sched& S, const Epi& E) {
    const int tid = opq((int)threadIdx.x), wid = __builtin_amdgcn_readfirstlane(tid >> 6), lane = tid & 63, wr = wid >> 2, wc = wid & 3, fr = lane & 15, fq = lane >> 4;
    unsigned voffA[2], voffB[2];
#pragma unroll
    for (int i = 0; i < 2; ++i) { int R, C; stage_rc(tid * 16 + i * 8192, R, C); const int Rb = Epi::PERM ? ((R & ~31) + perm32(R & 31)) : R;
        voffA[i] = (unsigned)(R * lda + C) * 2u; voffB[i] = (unsigned)(Rb * ldb + C) * 2u; }
    const size_t kstep = (size_t)(BK * 2);
    const size_t hstepA = (size_t)HALF * lda * 2, hstepB = (size_t)HALF * ldb * 2;
    const unsigned ldsw = (unsigned)wid * 1024u;
    const int aoff = lds_byte(wr * 64 + fr, fq * 8), boff = lds_byte(wc * 32 + fr, fq * 8);
    Unit cur, nxt; int ui = 0;
    if (!S.next(0, cur)) return;
    f32x4 acc[2][2][4][2];
#pragma unroll
    for (int a = 0; a < 2; ++a)
#pragma unroll
        for (int b = 0; b < 2; ++b)
#pragma unroll
            for (int m = 0; m < 4; ++m)
#pragma unroll
                for (int n = 0; n < 2; ++n) acc[a][b][m][n] = (f32x4){0.f, 0.f, 0.f, 0.f};
    f16x8 At[4][2], B0[2][2], B1[2][2];
    const char* cA = cur.a; const char* cB = cur.b;
    PG8_STAGE(PG8_SB(0, 0), cB, voffB); PG8_STAGE(PG8_SA(0, 0), cA, voffA); PG8_STAGE(PG8_SB(0, 1), cB + hstepB, voffB); PG8_STAGE(PG8_SA(0, 1), cA + hstepA, voffA);
    if (wr == 1) PG8_BAR;
    PG8_WAIT_V(4); PG8_BAR;
    PG8_STAGE(PG8_SB(1, 0), cB + kstep, voffB); PG8_STAGE(PG8_SA(1, 0), cA + kstep, voffA); PG8_STAGE(PG8_SB(1, 1), cB + hstepB + kstep, voffB);
    PG8_WAIT_V(6); PG8_BAR;
    for (;;) {
        const bool has_next = S.next(ui + 1, nxt);
        const char* nA = has_next ? nxt.a : cA; const char* nB = has_next ? nxt.b : cB;
        constexpr int NSEG = Epi::HAS_MID ? 3 : 1;
#pragma unroll
        for (int seg = 0; seg < NSEG; ++seg) {
        const int tb = Epi::HAS_MID ? (seg == 0 ? 0 : (seg == 1 ? Epi::MID1 + 2 : Epi::MID2 + 2)) : 0;
        const int te = Epi::HAS_MID ? (seg == 0 ? Epi::MID1 + 2 : (seg == 1 ? Epi::MID2 + 2 : nt)) : nt;
        for (int t = tb; t < te; t += 2) {
            const bool last = (t == nt - 2);
            const char* a1 = cA + (size_t)(t + 1) * kstep;
            const char* a2 = last ? nA : cA + (size_t)(t + 2) * kstep; const char* b2 = last ? nB : cB + (size_t)(t + 2) * kstep;
            const char* a3 = a2 + kstep; const char* b3 = b2 + kstep;
            PG8_LDB(B0, 0, 0); PG8_SCHED; PG8_LDA(At, 0, 0); PG8_STAGE(PG8_SA(1, 1), a1 + hstepA, voffA);
            PG8_WAIT_L(8); PG8_BAR; PG8_WAIT_L(0); PG8_MMA(0, 0, At, B0); PG8_BAR; PG8_SCHED;
            PG8_LDB(B1, 0, 1); PG8_STAGE(PG8_SB(0, 0), b2, voffB);
            PG8_BAR; PG8_WAIT_L(0); PG8_MMA(0, 1, At, B1); PG8_BAR;
            PG8_LDA(At, 0, 1); PG8_STAGE(PG8_SA(0, 0), a2, voffA);
            PG8_BAR; PG8_WAIT_L(0); PG8_MMA(1, 0, At, B0); PG8_BAR; PG8_SCHED;
            PG8_STAGE(PG8_SB(0, 1), b2 + hstepB, voffB);
            PG8_WAIT_V(6); PG8_BAR; PG8_MMA(1, 1, At, B1); PG8_BAR;
            PG8_LDB(B0, 1, 0); PG8_SCHED; PG8_LDA(At, 1, 0); PG8_STAGE(PG8_SA(0, 1), a2 + hstepA, voffA);
            PG8_WAIT_L(8); PG8_BAR; PG8_WAIT_L(0); PG8_MMA(0, 0, At, B0); PG8_BAR; PG8_SCHED;
            PG8_LDB(B1, 1, 1); PG8_STAGE(PG8_SB(1, 0), b3, voffB);
            PG8_BAR; PG8_WAIT_L(0); PG8_MMA(0, 1, At, B1); PG8_BAR;
            PG8_LDA(At, 1, 1); PG8_STAGE(PG8_SA(1, 0), a3, voffA);
            PG8_BAR; PG8_WAIT_L(0); PG8_MMA(1, 0, At, B0); PG8_BAR; PG8_SCHED;
            PG8_STAGE(PG8_SB(1, 1), b3 + hstepB, voffB);
            PG8_WAIT_V(6); PG8_BAR; PG8_MMA(1, 1, At, B1); PG8_BAR;
        }
        if constexpr (Epi::HAS_MID) { if (seg < 2) {
            E.mid(acc, cur, seg, wr, wc, fr, fq);
        } }
        }
#if STAMP_MASK & (1 << 23)
        if (Epi::HAS_MID && blockIdx.x == 0 && threadIdx.x == 0) ((volatile LAS unsigned long long*)(lds + LDSCTL_OFF + 128))[0] = __builtin_amdgcn_s_memrealtime();
#endif
        E(acc, cur, wr, wc, fr, fq);
#if STAMP_MASK & (1 << 23)
        if (Epi::HAS_MID && blockIdx.x == 0 && threadIdx.x == 0) { volatile LAS unsigned long long* TS = (volatile LAS unsigned long long*)(lds + LDSCTL_OFF + 128); TS[1] = TS[1] + (__builtin_amdgcn_s_memrealtime() - TS[0]); }
#endif
        if (!has_next) break;
#pragma unroll
        for (int a = 0; a < 2; ++a)
#pragma unroll
            for (int b = 0; b < 2; ++b)
#pragma unroll
                for (int m = 0; m < 4; ++m)
#pragma unroll
                    for (int n = 0; n < 2; ++n) acc[a][b][m][n] = (f32x4){0.f, 0.f, 0.f, 0.f};
        cur = nxt; cA = nA; cB = nB; ++ui;
    }
    PG8_WAIT_V(0);
    if (wr == 0) PG8_BAR;
    PG8_BAR;
}
#undef PG8_SA
#undef PG8_SB
#undef PG8_STAGE
#undef PG8_LDA
#undef PG8_LDB
#undef PG8_MMA
#undef PG8_WAIT_V
#undef PG8_WAIT_L
#undef PG8_BAR
#undef PG8_SCHED

typedef const f32x4 (&AccRef)[2][2][4][2];
__device__ __forceinline__ f16x8 pack8(f32x4 a, f32x4 b) { f16x8 w; w[0] = (f16)a[0]; w[1] = (f16)a[1]; w[2] = (f16)a[2]; w[3] = (f16)a[3]; w[4] = (f16)b[0]; w[5] = (f16)b[1]; w[6] = (f16)b[2]; w[7] = (f16)b[3]; return w; }

struct EpiPx {
    static constexpr bool PERM = true, HAS_MID = false; static constexpr int MID1 = 0, MID2 = 0; f16* PX; f16* S5A; f16* ZT; f16* GTL;
    __device__ __forceinline__ void operator()(AccRef acc, const Unit& u, int wr, int wc, int fr, int fq) const { fr = opq(fr); fq = opq(fq);
        const int row0 = u.pm * BM + wr * 64 + fr, col0 = u.pn * BM + wc * 32 + 8 * fq;
#pragma unroll
        for (int ai = 0; ai < 2; ++ai)
#pragma unroll
            for (int m = 0; m < 4; ++m) { const int row = row0 + ai * HALF + m * 16;
#pragma unroll
                for (int bj = 0; bj < 2; ++bj) { const int c = col0 + bj * HALF; const f16x8 w = pack8(acc[ai][bj][m][0], acc[ai][bj][m][1]);
                    if (u.pn < 2) *(f16x8*)(S5A + (size_t)(row >> 4) * 16384 + (size_t)(c >> 4) * 512 + (row & 15) * 16 + (c & 15)) = w;
                    else if (u.pn >= 14 && u.pn < 20) {
#pragma unroll
                        for (int j = 0; j < 8; ++j) ZT[(size_t)(c - P_HY + j) * MT + row] = w[j]; }
                    else if (u.pn >= 20 && u.pn < 44) *(f16x8*)(GTL + ((size_t)(u.pn - 20) * 66 + u.pm) * 65536 + (size_t)(row - u.pm * BM) * 256 + (c - u.pn * BM)) = w;
                    else { const int pr = row < MX ? (row & ~8191) + ((row & 63) << 7) + ((row & 8191) >> 6) : row;
                        *(f16x8*)(PX + (size_t)pr * PXLD + (u.pn == 44 ? c - (W_GG - P_GG) : c)) = w; } } }
    }
};
struct EpiF16 {
    static constexpr bool PERM = true, HAS_MID = false; static constexpr int MID1 = 0, MID2 = 0; f16* O; int ldc;
    __device__ __forceinline__ void operator()(AccRef acc, const Unit& u, int wr, int wc, int fr, int fq) const { fr = opq(fr); fq = opq(fq);
        const int row0 = u.pm * BM + wr * 64 + fr, col0 = u.pn * BM + wc * 32 + 8 * fq;
#pragma unroll
        for (int ai = 0; ai < 2; ++ai)
#pragma unroll
            for (int m = 0; m < 4; ++m) { f16* rowp = O + (size_t)(row0 + ai * HALF + m * 16) * ldc + col0;
#pragma unroll
                for (int bj = 0; bj < 2; ++bj) *(f16x8*)(rowp + bj * HALF) = pack8(acc[ai][bj][m][0], acc[ai][bj][m][1]); }
    }
};
struct EpiS5In {
    static constexpr bool PERM = false, HAS_MID = false; static constexpr int MID1 = 0, MID2 = 0; float* S;
    __device__ __forceinline__ void operator()(AccRef acc, const Unit& u, int wr, int wc, int fr, int fq) const { fr = opq(fr); fq = opq(fq);
        const int row0 = u.pm * BM + wr * 64 + fr, col0 = wc * 32 + 4 * fq, g = u.pn;
#pragma unroll
        for (int ai = 0; ai < 2; ++ai)
#pragma unroll
            for (int m = 0; m < 4; ++m) { const int row = row0 + ai * HALF + m * 16; { float* rowp = S + ((size_t)row * 32 + g) * 256 + col0;
#pragma unroll
                for (int bj = 0; bj < 2; ++bj)
#pragma unroll
                    for (int n = 0; n < 2; ++n) *(f32x4*)(rowp + bj * HALF + n * 16) = acc[ai][bj][m][n]; } }
    }
};
struct EpiS5Out {
    static constexpr bool PERM = true, HAS_MID = false; static constexpr int MID1 = 0, MID2 = 0; const f16* S5A; f16* Y; const float* dvec;
    __device__ __forceinline__ void operator()(AccRef acc, const Unit& u, int wr, int wc, int fr, int fq) const { fr = opq(fr); fq = opq(fq);
        const int row0 = u.pm * BM + wr * 64 + fr, col0 = wc * 32 + 8 * fq, g = u.pn;
        const int h0 = col0 & 15;
        const f32x4 d0 = *(const f32x4*)(dvec + g * 16 + h0), d1 = *(const f32x4*)(dvec + g * 16 + h0 + 4);
#pragma unroll
        for (int ai = 0; ai < 2; ++ai) { f16x8 uu[4][2];
#pragma unroll
            for (int m = 0; m < 4; ++m)
#pragma unroll
                for (int bj = 0; bj < 2; ++bj) uu[m][bj] = *(const f16x8*)(S5A + (size_t)(row0 + ai * HALF + m * 16) * 16384 + (size_t)g * 512 + col0 + bj * HALF);
            PIN8(uu[0][0], uu[0][1], uu[1][0], uu[1][1], uu[2][0], uu[2][1], uu[3][0], uu[3][1]);
#pragma unroll
            for (int m = 0; m < 4; ++m) { const int chunk = row0 + ai * HALF + m * 16;
#pragma unroll
                for (int bj = 0; bj < 2; ++bj) { const int c = col0 + bj * HALF, t = c >> 4; f16x8 w;
#pragma unroll
                    for (int j = 0; j < 4; ++j) { w[j] = (f16)gelu_tanh_(acc[ai][bj][m][0][j] * (1.0f / S5SCALE) + d0[j] * (float)uu[m][bj][j]);
                                                  w[4 + j] = (f16)gelu_tanh_(acc[ai][bj][m][1][j] * (1.0f / S5SCALE) + d1[j] * (float)uu[m][bj][4 + j]); }
                    *(f16x8*)(Y + (size_t)(chunk * 16 + t) * 512 + g * 16 + h0) = w; } }
            asm volatile("" ::: "memory"); }
    }
};
struct EpiGlu {
    static constexpr bool PERM = true, HAS_MID = false; static constexpr int MID1 = 0, MID2 = 0; const f16* YP; f16* O; const float* bias;
    __device__ __forceinline__ void operator()(AccRef acc, const Unit& u, int wr, int wc, int fr, int fq) const { fr = opq(fr); fq = opq(fq);
        const int row0 = u.pm * BM + wr * 64 + fr, col0 = u.pn * BM + wc * 32 + 8 * fq;
        f32x4 bv[2][2];
#pragma unroll
        for (int bj = 0; bj < 2; ++bj) { bv[bj][0] = *(const f32x4*)(bias + col0 + bj * HALF); bv[bj][1] = *(const f32x4*)(bias + col0 + bj * HALF + 4); }
#pragma unroll
        for (int ai = 0; ai < 2; ++ai) { f16x8 yp[4][2];
#pragma unroll
            for (int m = 0; m < 4; ++m)
#pragma unroll
                for (int bj = 0; bj < 2; ++bj) yp[m][bj] = *(const f16x8*)(YP + (size_t)(row0 + ai * HALF + m * 16) * 512 + col0 + bj * HALF);
            PIN8(yp[0][0], yp[0][1], yp[1][0], yp[1][1], yp[2][0], yp[2][1], yp[3][0], yp[3][1]);
#pragma unroll
            for (int m = 0; m < 4; ++m)
#pragma unroll
                for (int bj = 0; bj < 2; ++bj) { f16x8 w;
#pragma unroll
                    for (int j = 0; j < 4; ++j) { w[j] = (f16)((float)yp[m][bj][j] * sigmoidf_(acc[ai][bj][m][0][j] + bv[bj][0][j])); w[4 + j] = (f16)((float)yp[m][bj][4 + j] * sigmoidf_(acc[ai][bj][m][1][j] + bv[bj][1][j])); }
                    *(f16x8*)(O + (size_t)(row0 + ai * HALF + m * 16) * 2048 + col0 + bj * HALF) = w; }
            asm volatile("" ::: "memory"); }
    }
};
template <int BR> struct EpiBranch {
    static constexpr bool PERM = true, HAS_MID = false; static constexpr int MID1 = 0, MID2 = 0; const f16* PX; f16* M;
    __device__ __forceinline__ void operator()(AccRef acc, const Unit& u, int wr, int wc, int fr, int fq) const { fr = opq(fr); fq = opq(fq);
        const int row0 = u.pm * BM + wr * 64 + fr, col0 = u.pn * BM + wc * 32 + 8 * fq;
#pragma unroll
        for (int ai = 0; ai < 2; ++ai)
#pragma unroll
            for (int m = 0; m < 4; ++m) { const int row = row0 + ai * HALF + m * 16;
#pragma unroll
                for (int bj = 0; bj < 2; ++bj) { const int c = col0 + bj * HALF;
                    const f16x8 gl = *(const f16x8*)(PX + (size_t)row * PXLD + P_MG + BR * 2048 + c);
                    f16* mp = M + (size_t)row * 2048 + c;
                    f16x8 prev; if (BR > 0) prev = *(const f16x8*)mp;
                    f16x8 w;
#pragma unroll
                    for (int j = 0; j < 4; ++j) { float v0 = sigmoidf_((float)gl[j]) * acc[ai][bj][m][0][j], v1 = sigmoidf_((float)gl[4 + j]) * acc[ai][bj][m][1][j];
                        if (BR > 0) { v0 += (float)prev[j]; v1 += (float)prev[4 + j]; } w[j] = (f16)v0; w[4 + j] = (f16)v1; }
                    *(f16x8*)mp = w; } asm volatile("" ::: "memory"); }
    }
};
typedef f32x4 (&AccMut)[2][2][4][2];

struct EpiBranchF {
    static constexpr bool PERM = true, HAS_MID = true; static constexpr int MID1 = 6, MID2 = 14;
    const f16* GTL; f16* M;
    __device__ __forceinline__ void mid(AccMut acc, const Unit& u, int seg, int wr, int wc, int fr, int fq) const { fr = opq(fr); fq = opq(fq);
        const int lrow0 = wr * 64 + fr, lcol0 = wc * 32 + 8 * fq;
        const f16* ga = GTL + ((size_t)((seg == 0 ? 0 : 8) + u.pn) * 66 + u.pm) * 65536; const f16* gb = ga + (size_t)8 * 66 * 65536;
#pragma unroll
        for (int ai = 0; ai < 2; ++ai) { f16x8 za[4][2], zb[4][2];
#pragma unroll
            for (int m = 0; m < 4; ++m)
#pragma unroll
                for (int bj = 0; bj < 2; ++bj) { const int off = (lrow0 + ai * HALF + m * 16) * 256 + lcol0 + bj * HALF; za[m][bj] = *(const f16x8*)(ga + off); zb[m][bj] = *(const f16x8*)(gb + off); }
            PIN8(za[0][0], za[0][1], za[1][0], za[1][1], za[2][0], za[2][1], za[3][0], za[3][1]); PIN8(zb[0][0], zb[0][1], zb[1][0], zb[1][1], zb[2][0], zb[2][1], zb[3][0], zb[3][1]);
#pragma unroll
            for (int m = 0; m < 4; ++m)
#pragma unroll
                for (int bj = 0; bj < 2; ++bj)
#pragma unroll
                    for (int j = 0; j < 4; ++j) { acc[ai][bj][m][0][j] *= (1.0f + __expf(-(float)zb[m][bj][j])) * __builtin_amdgcn_rcpf(1.0f + __expf(-(float)za[m][bj][j]));
                                                  acc[ai][bj][m][1][j] *= (1.0f + __expf(-(float)zb[m][bj][4 + j])) * __builtin_amdgcn_rcpf(1.0f + __expf(-(float)za[m][bj][4 + j])); }
            asm volatile("" ::: "memory"); }
    }
    __device__ __forceinline__ void operator()(AccRef acc, const Unit& u, int wr, int wc, int fr, int fq) const { fr = opq(fr); fq = opq(fq);
        const int row0 = u.pm * BM + wr * 64 + fr, col0 = u.pn * BM + wc * 32 + 8 * fq;
#pragma unroll
        for (int ai = 0; ai < 2; ++ai) { f16x8 gl[4][2];
#pragma unroll
            for (int m = 0; m < 4; ++m)
#pragma unroll
                for (int bj = 0; bj < 2; ++bj) gl[m][bj] = *(const f16x8*)(GTL + ((size_t)(16 + u.pn) * 66 + u.pm) * 65536 + (wr * 64 + fr + ai * HALF + m * 16) * 256 + wc * 32 + 8 * fq + bj * HALF);
            PIN8(gl[0][0], gl[0][1], gl[1][0], gl[1][1], gl[2][0], gl[2][1], gl[3][0], gl[3][1]);
#pragma unroll
            for (int m = 0; m < 4; ++m)
#pragma unroll
                for (int bj = 0; bj < 2; ++bj) { f16x8 w;
#pragma unroll
                    for (int j = 0; j < 4; ++j) { w[j] = (f16)(sigmoidf_((float)gl[m][bj][j]) * acc[ai][bj][m][0][j]); w[4 + j] = (f16)(sigmoidf_((float)gl[m][bj][4 + j]) * acc[ai][bj][m][1][j]); }
                    *(f16x8*)(M + (size_t)(row0 + ai * HALF + m * 16) * 2048 + col0 + bj * HALF) = w; }
            asm volatile("" ::: "memory"); }
    }
};
struct EpiUpAct {
    static constexpr bool PERM = true, HAS_MID = false; static constexpr int MID1 = 0, MID2 = 0; f16* ACT; float* HALO; const float* cw; const float* cb; LAS float* HL;
    __device__ __forceinline__ void operator()(AccRef acc, const Unit& u, int wr, int wc, int fr, int fq) const { fr = opq(fr); fq = opq(fq);
        const int lane = fq * 16 + fr;
#pragma unroll
        for (int ai = 0; ai < 2; ++ai) { LAS float* hp = HL + ((ai * 2 + wr) * 4 + wc) * 64 + 8 * fq;
            if (fr == 0) { *(LAS f32x4*)(hp) = acc[ai][0][0][0]; *(LAS f32x4*)(hp + 4) = acc[ai][0][0][1]; }
            if (fr == 15) { *(LAS f32x4*)(hp + 32) = acc[ai][0][3][0]; *(LAS f32x4*)(hp + 36) = acc[ai][0][3][1]; } }
        { float* gh = HALO + ((size_t)u.pm * 44 + u.pn) * 768 + wc * 32 + 8 * fq;
          if (wr == 0 && fr < 2) { *(f32x4*)(gh + fr * 128) = acc[0][0][0][0]; *(f32x4*)(gh + fr * 128 + 4) = acc[0][0][0][1]; }
          if (wr == 0 && fr == 0) { *(f32x4*)(gh + 4 * 128) = acc[0][1][0][0]; *(f32x4*)(gh + 4 * 128 + 4) = acc[0][1][0][1]; }
          if (wr == 1 && fr >= 14) { *(f32x4*)(gh + (fr - 12) * 128) = acc[1][0][3][0]; *(f32x4*)(gh + (fr - 12) * 128 + 4) = acc[1][0][3][1]; }
          if (wr == 1 && fr == 15) { *(f32x4*)(gh + 5 * 128) = acc[1][1][3][0]; *(f32x4*)(gh + 5 * 128 + 4) = acc[1][1][3][1]; } }
        asm volatile("s_waitcnt lgkmcnt(0)" ::: "memory"); __builtin_amdgcn_s_barrier(); __builtin_amdgcn_s_barrier(); asm volatile("" ::: "memory");
        const int colg = u.pn * 128 + wc * 32 + 8 * fq;
        const int srcR = (lane & 48) | ((fr + 15) & 15), srcL = (lane & 48) | ((fr + 1) & 15);
        const int row0 = u.pm * BM + wr * 64 + fr;
#pragma unroll
        for (int n = 0; n < 2; ++n) {
            const f32x4 w0 = *(const f32x4*)(cw + colg + 4 * n), w1 = *(const f32x4*)(cw + FFH + colg + 4 * n), w2 = *(const f32x4*)(cw + 2 * FFH + colg + 4 * n), bb = *(const f32x4*)(cb + colg + 4 * n);
#pragma unroll
            for (int ai = 0; ai < 2; ++ai) {
                const bool hasp = (wr == 1) || (ai == 1), hasn = (wr == 0) || (ai == 0);
                const LAS float* pp = HL + (((wr == 1 ? ai : 0) * 2 + (wr == 1 ? 0 : 1)) * 4 + wc) * 64 + 32 + 8 * fq + 4 * n;
                const LAS float* np = HL + (((wr == 0 ? ai : 1) * 2 + (wr == 0 ? 1 : 0)) * 4 + wc) * 64 + 8 * fq + 4 * n;
                const f32x4 hprev = hasp ? *(const LAS f32x4*)pp : (f32x4){0.f, 0.f, 0.f, 0.f}, hnext = hasn ? *(const LAS f32x4*)np : (f32x4){0.f, 0.f, 0.f, 0.f};
                f32x4 R[4], L[4];
#pragma unroll
                for (int m = 0; m < 4; ++m)
#pragma unroll
                    for (int j = 0; j < 4; ++j) { R[m][j] = __shfl(acc[ai][0][m][n][j], srcR); L[m][j] = __shfl(acc[ai][0][m][n][j], srcL); }
#pragma unroll
                for (int m = 0; m < 4; ++m) { const f32x4 pv = fr > 0 ? R[m] : (m > 0 ? R[m > 0 ? m - 1 : 0] : hprev); const f32x4 nv = fr < 15 ? L[m] : (m < 3 ? L[m < 3 ? m + 1 : 3] : hnext);
                    const f32x4 a = w0 * pv + w1 * acc[ai][0][m][n] + w2 * nv + bb;
                    f16x4 o;
#pragma unroll
                    for (int j = 0; j < 4; ++j) o[j] = (f16)(siluf_(a[j]) * acc[ai][1][m][n][j]);
                    *(f16x4*)(ACT + (size_t)(row0 + ai * HALF + m * 16) * FFH + colg + 4 * n) = o; }
                asm volatile("" ::: "memory");
            }
        }
    }
};
struct EpiSlab {
    static constexpr bool PERM = false, HAS_MID = false; static constexpr int MID1 = 0, MID2 = 0; float* slab; const float* mod; int goff;
    __device__ __forceinline__ void operator()(AccRef acc, const Unit& u, int wr, int wc, int fr, int fq) const { fr = opq(fr); fq = opq(fq);
        const int pn = u.pn & 255, ks = u.pn >> 8;
        const int row0 = (u.pm - 64) * BM + wr * 64 + fr, col0 = pn * BM + wc * 32 + 4 * fq;
        const float* gp = mod + 2 * 12288 + goff + col0;
        f32x4 gv[2][2];
#pragma unroll
        for (int bj = 0; bj < 2; ++bj)
#pragma unroll
            for (int n = 0; n < 2; ++n) gv[bj][n] = *(const f32x4*)(gp + bj * HALF + n * 16);
        float* sp = slab + (size_t)ks * MC * D;
#pragma unroll
        for (int ai = 0; ai < 2; ++ai)
#pragma unroll
            for (int m = 0; m < 4; ++m) { float* rowp = sp + (size_t)(row0 + ai * HALF + m * 16) * D + col0;
#pragma unroll
                for (int bj = 0; bj < 2; ++bj)
#pragma unroll
                    for (int n = 0; n < 2; ++n) *(f32x4*)(rowp + bj * HALF + n * 16) = gv[bj][n] * acc[ai][bj][m][n]; }
    }
};
struct EpiResid {
    static constexpr bool PERM = false, HAS_MID = false; static constexpr int MID1 = 0, MID2 = 0; float* X; const float* mod; int goff;
    __device__ __forceinline__ void operator()(AccRef acc, const Unit& u, int wr, int wc, int fr, int fq) const { fr = opq(fr); fq = opq(fq);
        const int row0 = u.pm * BM + wr * 64 + fr, col0 = u.pn * BM + wc * 32 + 4 * fq;
        const int bsel = u.pm < 32 ? 0 : (u.pm < 64 ? 1 : 2);
        const float* gp = mod + bsel * 12288 + goff + col0;
        f32x4 gv[2][2];
#pragma unroll
        for (int bj = 0; bj < 2; ++bj)
#pragma unroll
            for (int n = 0; n < 2; ++n) gv[bj][n] = *(const f32x4*)(gp + bj * HALF + n * 16);
#pragma unroll
        for (int ai = 0; ai < 2; ++ai) { f32x4 xv[4][2][2];
#pragma unroll
            for (int m = 0; m < 4; ++m) { const float* rowp = X + (size_t)(row0 + ai * HALF + m * 16) * D + col0;
#pragma unroll
                for (int bj = 0; bj < 2; ++bj)
#pragma unroll
                    for (int n = 0; n < 2; ++n) xv[m][bj][n] = *(const f32x4*)(rowp + bj * HALF + n * 16); }
            PIN8(xv[0][0][0], xv[0][0][1], xv[0][1][0], xv[0][1][1], xv[1][0][0], xv[1][0][1], xv[1][1][0], xv[1][1][1]); PIN8(xv[2][0][0], xv[2][0][1], xv[2][1][0], xv[2][1][1], xv[3][0][0], xv[3][0][1], xv[3][1][0], xv[3][1][1]);
#pragma unroll
            for (int m = 0; m < 4; ++m) { float* rowp = X + (size_t)(row0 + ai * HALF + m * 16) * D + col0;
#pragma unroll
                for (int bj = 0; bj < 2; ++bj)
#pragma unroll
                    for (int n = 0; n < 2; ++n) *(f32x4*)(rowp + bj * HALF + n * 16) = xv[m][bj][n] + gv[bj][n] * acc[ai][bj][m][n]; }
            asm volatile("" ::: "memory"); }
    }
};
}


__device__ __forceinline__ void ph_prologue(const Ctx& F, const ArgsV& AV) {
    const int gt = F.bid * 512 + F.tid, NT = F.G * 512;
    { const f32x4* xs = (const f32x4*)AV.in(I_X); const f32x4* cs = (const f32x4*)AV.in(I_CTX); f32x4* xr = (f32x4*)(F.ws + WS_XRES);
      for (int i = gt; i < MX * D / 4; i += NT) xr[i] = xs[i];
      for (int i = gt; i < MC * D / 4; i += NT) xr[MX * D / 4 + i] = cs[i]; }
    { f32x2* tw = (f32x2*)(F.ws + WS_TW);
      for (int k = gt; k < 16384; k += NT) { float s, c; sincospif((float)k * (2.0f / 16384.0f), &s, &c); tw[k] = (f32x2){c, -s}; } }
    LAS float* sc = (LAS float*)F.lds;
    LAS float* red = (LAS float*)(F.lds + 3 * 2048 * 4);
    for (int i = F.tid; i < 3 * 2048; i += 512) { const int r = i / 2048, k = i % 2048; const float v = r < 2 ? AV.in(I_C)[r * 2048 + k] : AV.in(I_CCTX)[k]; sc[i] = siluf_(v); }
    __syncthreads();
    const int col = F.tid & 63, ks = F.tid >> 6;
    for (int chunk = F.bid; chunk < DEPTH * 192; chunk += F.G) {
        const int l = chunk / 192, n0 = (chunk % 192) * 64;
        const float* w = AV.in(I_WMOD) + (size_t)l * 2048 * 12288 + n0 + col;
        float s0 = 0.f, s1 = 0.f, s2 = 0.f;
#pragma unroll 8
        for (int k = ks * 256; k < ks * 256 + 256; ++k) { const float wv = w[(size_t)k * 12288]; s0 += sc[k] * wv; s1 += sc[2048 + k] * wv; s2 += sc[4096 + k] * wv; }
        red[(ks * 3 + 0) * 64 + col] = s0; red[(ks * 3 + 1) * 64 + col] = s1; red[(ks * 3 + 2) * 64 + col] = s2;
        __syncthreads();
        if (F.tid < 192) { const int r = F.tid >> 6, c2 = F.tid & 63; float s = 0.f;
#pragma unroll
            for (int q = 0; q < 8; ++q) s += red[(q * 3 + r) * 64 + c2];
            ((float*)(F.ws + WS_MOD))[((size_t)l * 3 + r) * 12288 + n0 + c2] = s + AV.in(I_BMOD)[(size_t)l * 12288 + n0 + c2]; }
        __syncthreads();
    }
}

__device__ __forceinline__ void conv_item(const float* W, int ldw, int k0, int srccol, f16* WT, int dstrow, int ldk) {
    float v[64];
    const float* src = W + (size_t)k0 * ldw + (srccol >= 0 ? srccol : 0);
#pragma unroll
    for (int k = 0; k < 64; ++k) v[k] = src[(size_t)k * ldw];
#pragma unroll
    for (int k = 0; k < 64; k += 8) PIN8(v[k], v[k + 1], v[k + 2], v[k + 3], v[k + 4], v[k + 5], v[k + 6], v[k + 7]);
    f16* dst = WT + (size_t)dstrow * ldk + k0;
#pragma unroll
    for (int kg = 0; kg < 8; ++kg) { f16x8 o;
#pragma unroll
        for (int e = 0; e < 8; ++e) o[e] = srccol >= 0 ? (f16)v[8 * kg + e] : (f16)0.f;
        *(f16x8*)(dst + 8 * kg) = o; }
}
__device__ __forceinline__ void ph_convert_weights(const Ctx& F, const ArgsV& AV, int l) {
    const int skip = F.G > 64 ? 32 : 0;
    if (F.bid < skip) return;
    const int gw = (F.bid - skip) * 8 + F.wave, NGW = (F.G - skip) * 8, lane = F.lane;
    constexpr int I_IN = 32 * 180, I_GLU = 8 * 8, I_BR = 32 * 32, I_OUT = 32 * 32, I_UP = 32 * 176, I_DN = 88 * 32;
    constexpr int NIT = I_IN + I_GLU + I_BR + I_OUT + I_UP + I_DN;
    for (int it = gw; it < NIT; it += NGW) {
        int r = it;
        if (r < I_IN) { const int kb = r / 180, nb = r % 180, j = nb * 64 + lane;
            const int src = j < 2048 ? j : (j < 11264 ? j + 32 : (j < 11296 ? 2048 + (j - 11264) : -1));
            conv_item(AV.in(I_WIN) + (size_t)l * 2048 * INW, INW, kb * 64, src, (f16*)(F.ws + WS_WIN), j, 2048); continue; } r -= I_IN;
        if (r < I_GLU) { const int kb = r / 8, nb = r % 8, j = nb * 64 + lane; conv_item(AV.in(I_GLUW) + (size_t)l * 512 * 512, 512, kb * 64, j, (f16*)(F.ws + WS_WGLU), j, 512); continue; } r -= I_GLU;
        if (r < I_BR) { const int kb = r / 32, nb = r % 32, j = nb * 64 + lane; conv_item(AV.in(I_WBR) + (size_t)l * 2048 * 2048, 2048, kb * 64, j, (f16*)(F.ws + WS_WBR), j, 2048); continue; } r -= I_BR;
        if (r < I_OUT) { const int kb = r / 32, nb = r % 32, j = nb * 64 + lane; conv_item(AV.in(I_WOUT) + (size_t)l * 2048 * 2048, 2048, kb * 64, j, (f16*)(F.ws + WS_WOUT), j, 2048); continue; } r -= I_OUT;
        if (r < I_UP) { const int kb = r / 176, nb = r % 176, j = nb * 64 + lane, pn = j >> 8, i = j & 255; const int src = i < 128 ? 128 * pn + i : FFH + 128 * pn + (i - 128);
            conv_item(AV.in(I_WUP) + (size_t)l * 2048 * UPLD, UPLD, kb * 64, src, (f16*)(F.ws + WS_WUP), j, 2048); continue; } r -= I_UP;
        { const int kb = r / 32, nb = r % 32, j = nb * 64 + lane; conv_item(AV.in(I_WDN) + (size_t)l * FFH * 2048, 2048, kb * 64, j, (f16*)(F.ws + WS_WDN), j, FFH); }
    }
}

__device__ __forceinline__ void s5_mats_group(const Ctx& F, const ArgsV& AV, int l, int g) {
    LAS f32x2* APOW = (LAS f32x2*)F.lds;
    LAS f32x2* BBAR = APOW + 2 * 17 * 64;
    LAS f32x2* CM = BBAR + 2 * 64 * 16;
    LAS float* KLAG = (LAS float*)(CM + 2 * 16 * 64);
    __syncthreads();
    for (int i = F.tid; i < 2 * 17 * 64; i += 512) { const int d = i / (17 * 64), e = (i / 64) % 17, n = i % 64;
        const size_t pi = (((size_t)l * 2 + d) * 32 + g) * 64 + n;
        const float are = AV.in(I_S5ARE)[pi], aim = AV.in(I_S5AIM)[pi], dt = expf(AV.in(I_S5STEP)[((size_t)l * 2 + d) * 32 + g]);
        const float zr = are * dt * (float)e, zi = aim * dt * (float)e; float s, c; sincosf(zi, &s, &c); const float m = expf(zr);
        APOW[i] = (f32x2){m * c, m * s}; }
    __syncthreads();
    for (int i = F.tid; i < 2 * 64 * 16; i += 512) { const int d = i / 1024, n = (i / 16) % 64, h = i % 16;
        const size_t pi = (((size_t)l * 2 + d) * 32 + g) * 64 + n;
        const float are = AV.in(I_S5ARE)[pi], aim = AV.in(I_S5AIM)[pi];
        const f32x2 ab = APOW[(d * 17 + 1) * 64 + n]; const f32x2 num = (f32x2){ab.x - 1.0f, ab.y};
        const float den = are * are + aim * aim; const f32x2 q = (f32x2){(num.x * are + num.y * aim) / den, (num.y * are - num.x * aim) / den};
        const size_t bi = (pi * 16) + h;
        BBAR[i] = cmul(q, (f32x2){AV.in(I_S5BRE)[bi], AV.in(I_S5BIM)[bi]});
        const size_t ci = ((((size_t)l * 2 + d) * 32 + g) * 16 + h) * 64 + n;
        CM[(d * 16 + h) * 64 + n] = (f32x2){AV.in(I_S5CRE)[ci], AV.in(I_S5CIM)[ci]}; }
    __syncthreads();
    for (int i = F.tid; i < 2 * 16 * 256; i += 512) { const int d = i / 4096, lag = (i / 256) % 16, h = (i / 16) % 16, hp = i % 16; float s = 0.f;
        for (int n = 0; n < 64; ++n) { const f32x2 t = cmul(CM[(d * 16 + h) * 64 + n], APOW[(d * 17 + lag) * 64 + n]); const f32x2 b = BBAR[(d * 64 + n) * 16 + hp]; s += t.x * b.x - t.y * b.y; }
        KLAG[i] = s; }
    __syncthreads();
    f16* W = (f16*)(F.ws + WS_S5W) + (size_t)g * 256 * 512;
    for (int i = F.tid; i < 256 * 64; i += 512) { const int n = i / 64, k8 = (i % 64) * 8, t = n >> 4, h = n & 15; f16x8 o;
#pragma unroll
        for (int e = 0; e < 8; ++e) { const int k = k8 + e; float v;
            if (k < 256) { const int s = k >> 4, hp = k & 15; v = 0.f;
                if (t >= s) v += KLAG[((0 * 16 + (t - s)) * 16 + h) * 16 + hp];
                if (s >= t) v += KLAG[((1 * 16 + (s - t)) * 16 + h) * 16 + hp];
                v *= S5SCALE; }
            else { const int d = (k - 256) >> 7, nn2 = (k - 256) & 127, nn = nn2 & 63, im = nn2 >> 6, ex = d == 0 ? t + 1 : 16 - t;
                const f32x2 z = cmul(CM[(d * 16 + h) * 64 + nn], APOW[(d * 17 + ex) * 64 + nn]); v = im ? -z.y : z.x; }
            o[e] = (f16)v; }
        *(f16x8*)(W + (size_t)n * 512 + k8) = o; }
    f16* Mx = (f16*)(F.ws + WS_S5M) + (size_t)g * 256 * 256;
    for (int i = F.tid; i < 256 * 32; i += 512) { const int n = i / 32, k8 = (i % 32) * 8, d = n >> 7, ri = (n >> 6) & 1, nn = n & 63; f16x8 o;
#pragma unroll
        for (int e = 0; e < 8; ++e) { const int k = k8 + e, s = k >> 4, hp = k & 15, ex = d == 0 ? 15 - s : s;
            const f32x2 z = cmul(APOW[(d * 17 + ex) * 64 + nn], BBAR[(d * 64 + nn) * 16 + hp]); o[e] = (f16)((ri ? z.y : z.x) * S5SCALE); }
        *(f16x8*)(Mx + (size_t)n * 256 + k8) = o; }
    if (F.tid < 128) { const int d = F.tid >> 6, nn = F.tid & 63; ((f32x2*)(F.ws + WS_S5AT))[(d * 32 + g) * 64 + nn] = APOW[(d * 17 + 16) * 64 + nn]; }
    __syncthreads();
}

__device__ __forceinline__ void ph_hyena_h2(const Ctx& F, const ArgsV& AV, int l) {
    LAS float* W1 = (LAS float*)F.lds;
    LAS float* W2 = W1 + 33 * 64;
    LAS float* PV = W2 + 64 * 64;
    LAS float* SCR = PV + 256;
    __syncthreads();
    for (int i = F.tid; i < 33 * 64; i += 512) W1[i] = AV.in(I_HYW1)[(size_t)l * 33 * 64 + i];
    for (int i = F.tid; i < 64 * 64; i += 512) W2[i] = AV.in(I_HYW2)[(size_t)l * 4096 + i];
    if (F.tid < 64) { PV[F.tid] = AV.in(I_HYB1)[l * 64 + F.tid]; PV[64 + F.tid] = AV.in(I_HYF1)[l * 64 + F.tid]; PV[128 + F.tid] = AV.in(I_HYB2)[l * 64 + F.tid]; PV[192 + F.tid] = AV.in(I_HYF2)[l * 64 + F.tid]; }
    __syncthreads();
    LAS float* scr = SCR + F.wave * 64;
    const int gw = F.bid * 8 + F.wave, NGW = F.G * 8, j = F.lane;
    for (int p = gw; p < SEQ + LC; p += NGW) {
        const int n = p < SEQ ? SEQ : LC, pos = p < SEQ ? p : p - SEQ;
        float feat = 0.f;
        if (j == 0) feat = (float)pos / (float)(n - 1);
        else if (j < 33) { const int fi = (j - 1) & 15; const float fr = 1e-4f + (float)fi * ((15.0f - 1e-4f) / 15.0f);
            const float ang = (6.283185307179586f / (float)n) * (float)pos * fr; float s, c; sincosf(ang, &s, &c); feat = j < 17 ? c : -s; }
        scr[j] = feat; LDS_WAIT(); asm volatile("" ::: "memory");
        float a = PV[j];
        for (int i = 0; i < 33; ++i) a += scr[i] * W1[i * 64 + j];
        const float h1 = sinf(PV[64 + j] * a);
        LDS_WAIT(); asm volatile("" ::: "memory");
        scr[j] = h1; LDS_WAIT(); asm volatile("" ::: "memory");
        float b = PV[128 + j];
        for (int i = 0; i < 64; ++i) b += scr[i] * W2[i * 64 + j];
        ((f16*)(F.ws + WS_H2H))[((size_t)l * (SEQ + LC) + p) * 64 + j] = (f16)sinf(PV[192 + j] * b);
        LDS_WAIT(); asm volatile("" ::: "memory");
    }
}

__device__ __forceinline__ void ph_norm(const Ctx& F, const ArgsV& AV, int l, int which, int nrows, int nslab) {
    const int gw = F.bid * 8 + F.wave, NGW = F.G * 8;
    float* X = (float*)(F.ws + WS_XRES); f16* O = (f16*)(F.ws + WS_HN); const float* SL = (const float*)(F.ws + WS_SLAB);
    const float* gain = AV.in(which ? I_N2G : I_N1G) + (size_t)l * D;
    const float* mod = (const float*)(F.ws + WS_MOD) + (size_t)l * 3 * 12288;
    const int shoff = which ? 6144 : 0, soff = which ? 8192 : 2048;
    int cur_bsel = -1; f32x4 Am[8], Bm[8], vn[8];
    if (gw < nrows) { const f32x4* xr0 = (const f32x4*)(X + (size_t)gw * D) + F.lane;
#pragma unroll
        for (int j = 0; j < 8; ++j) vn[j] = xr0[64 * j]; }
    for (int m = gw; m < nrows; m += NGW) {
        const int bsel = m < SEQ ? 0 : (m < MX ? 1 : 2);
        f32x4* xr = (f32x4*)(X + (size_t)m * D) + F.lane;
        f32x4 v[8]; float s = 0.f;
        PIN8(vn[0], vn[1], vn[2], vn[3], vn[4], vn[5], vn[6], vn[7]);
#pragma unroll
        for (int j = 0; j < 8; ++j) v[j] = vn[j];
        if (m + NGW < nrows) { const f32x4* xq = (const f32x4*)(X + (size_t)(m + NGW) * D) + F.lane;
#pragma unroll
            for (int j = 0; j < 8; ++j) vn[j] = xq[64 * j]; }
        if (bsel != cur_bsel) { cur_bsel = bsel; const float* mp = mod + bsel * 12288;
#pragma unroll
            for (int j = 0; j < 8; ++j) { const int c = 4 * F.lane + 256 * j; const f32x4 g = *(const f32x4*)(gain + c), sc = *(const f32x4*)(mp + soff + c); Bm[j] = *(const f32x4*)(mp + shoff + c); Am[j] = g * (sc + 1.0f); }
            PIN8(Am[0], Am[1], Am[2], Am[3], Am[4], Am[5], Am[6], Am[7]); PIN8(Bm[0], Bm[1], Bm[2], Bm[3], Bm[4], Bm[5], Bm[6], Bm[7]); }
        if (m >= MX && nslab > 0) {
            for (int sl = 0; sl < nslab; ++sl) { const f32x4* sr = (const f32x4*)(SL + ((size_t)sl * MC + (m - MX)) * D) + F.lane;
#pragma unroll
                for (int j = 0; j < 8; ++j) v[j] = v[j] + sr[64 * j]; }
#pragma unroll
            for (int j = 0; j < 8; ++j) xr[64 * j] = v[j]; }
#pragma unroll
        for (int j = 0; j < 8; ++j) s += (v[j].x * v[j].x + v[j].y * v[j].y) + (v[j].z * v[j].z + v[j].w * v[j].w);
        const float rstd = 1.0f / sqrtf(wave_sum(s) * (1.0f / D) + EPS);
#pragma unroll
        for (int j = 0; j < 8; ++j) { const int c = 4 * F.lane + 256 * j;
            f16x4 o;
#pragma unroll
            for (int e = 0; e < 4; ++e) o[e] = (f16)(v[j][e] * rstd * Am[j][e] + Bm[j][e]);
            *(f16x4*)(O + (size_t)m * D + c) = o; }
    }
}
__device__ __forceinline__ void ph_final_norm(const Ctx& F, const ArgsV& AV) {
    const int gw = F.bid * 8 + F.wave, NGW = F.G * 8;
    const float* X = (const float*)(F.ws + WS_XRES); const float* gain = AV.in(I_FNG);
    f32x4 gm[8], vn[8];
#pragma unroll
    for (int j = 0; j < 8; ++j) gm[j] = *(const f32x4*)(gain + 4 * F.lane + 256 * j);
    if (gw < MX) { const f32x4* xr0 = (const f32x4*)(X + (size_t)gw * D) + F.lane;
#pragma unroll
        for (int j = 0; j < 8; ++j) vn[j] = xr0[64 * j]; }
    for (int m = gw; m < MX; m += NGW) {
        f32x4 v[8]; float s = 0.f;
        PIN8(vn[0], vn[1], vn[2], vn[3], vn[4], vn[5], vn[6], vn[7]);
#pragma unroll
        for (int j = 0; j < 8; ++j) v[j] = vn[j];
        if (m + NGW < MX) { const f32x4* xq = (const f32x4*)(X + (size_t)(m + NGW) * D) + F.lane;
#pragma unroll
            for (int j = 0; j < 8; ++j) vn[j] = xq[64 * j]; }
#pragma unroll
        for (int j = 0; j < 8; ++j) s += (v[j].x * v[j].x + v[j].y * v[j].y) + (v[j].z * v[j].z + v[j].w * v[j].w);
        const float rstd = 1.0f / sqrtf(wave_sum(s) * (1.0f / D) + EPS);
#pragma unroll
        for (int j = 0; j < 8; ++j) { const int c = 4 * F.lane + 256 * j;
            *(f32x4*)(AV.out + (size_t)m * D + c) = v[j] * rstd * gm[j]; }
    }
}

__device__ __forceinline__ void ph_s5_scan(const Ctx& F) {
    if (F.tid >= 32) return;
    const float* S = (const float*)(F.ws + WS_S5S); f16* SA = (f16*)(F.ws + WS_S5A);
    for (int gt = F.bid * 32 + F.tid; gt < 2 * 2 * 32 * 64; gt += F.G * 32) {
        const int nn = gt & 63, g = (gt >> 6) & 31, d = (gt >> 11) & 1, b = gt >> 12;
        const f32x2 at = ((const f32x2*)(F.ws + WS_S5AT))[(d * 32 + g) * 64 + nn];
        f32x2 st = (f32x2){0.f, 0.f};
        f32x2 la[16], lb[16];
#define S5_CHUNK(step) ((d == 0) ? ((step) < 16 ? 1024 + b * 16 + (step) : b * 512 + ((step) - 16)) : ((step) < 16 ? 1024 + b * 16 + (15 - (step)) : b * 512 + (511 - ((step) - 16))))
#define S5_LOAD(dst, base) do { _Pragma("unroll") for (int u = 0; u < 16; ++u) { const int stp = (base) + u < 528 ? (base) + u : 527; const size_t so = ((size_t)S5_CHUNK(stp) * 32 + g) * 256 + d * 128 + nn; dst[u] = (f32x2){S[so], S[so + 64]}; } } while (0)
#define S5_STEP(src, base) do { PIN8(src[0], src[1], src[2], src[3], src[4], src[5], src[6], src[7]); PIN8(src[8], src[9], src[10], src[11], src[12], src[13], src[14], src[15]); \
            _Pragma("unroll") for (int u = 0; u < 16; ++u) { f16* xp = SA + (size_t)S5_CHUNK((base) + u) * 16384 + (size_t)g * 512 + 256 + d * 128 + nn; xp[0] = (f16)st.x; xp[64] = (f16)st.y; st = cmul(at, st) + src[u]; } } while (0)
        S5_LOAD(la, 0);
        for (int base = 0; base < 528; base += 32) {
            S5_LOAD(lb, base + 16);
            S5_STEP(la, base);
            if (base + 16 < 528) { S5_LOAD(la, base + 32); S5_STEP(lb, base + 16); }
        }
#undef S5_CHUNK
#undef S5_LOAD
#undef S5_STEP
    }
}

__device__ __forceinline__ void ph_ffn_fix(const Ctx& F, const ArgsV& AV, int l, int nMr) {
    const float* HALO = (const float*)(F.ws + WS_HALO); f16* ACT = (f16*)(F.ws + WS_ACT);
    const float* cw = AV.in(I_FFCW) + (size_t)l * 3 * FFH; const float* cb = AV.in(I_FFCB) + (size_t)l * FFH;
    const int NT = nMr * 44 * 2 * 128;
    for (int task = F.bid * 512 + F.tid; task < NT; task += F.G * 512) {
        const int c = task & 127, which = (task >> 7) & 1, tile = task >> 8, pn = tile % 44, pm = tile / 44;
        const float* h = HALO + ((size_t)pm * 44 + pn) * 768 + c; const int col = pn * 128 + c;
        const bool first = (pm == 0 || pm == 32 || pm >= 64), last = (pm == 31 || pm >= 63);
        float ap, ac, an, b;
        if (which == 0) { ap = first ? 0.f : HALO[((size_t)(pm - 1) * 44 + pn) * 768 + 3 * 128 + c]; ac = h[0]; an = h[128]; b = h[4 * 128]; }
        else { ap = h[2 * 128]; ac = h[3 * 128]; an = last ? 0.f : HALO[((size_t)(pm + 1) * 44 + pn) * 768 + c]; b = h[5 * 128]; }
        const float a = cw[col] * ap + cw[FFH + col] * ac + cw[2 * FFH + col] * an + cb[col];
        ACT[(size_t)(pm * 256 + (which ? 255 : 0)) * FFH + col] = (f16)(siluf_(a) * b);
    }
}

namespace gla {
constexpr int QK_LD = 136, KH_LD = 72, VT_LD = 72, P_LD = 72;
constexpr int OFF_QT = 0;
constexpr int OFF_KT = 17408;
constexpr int OFF_VT = OFF_KT + 18432;
constexpr int OFF_P = OFF_VT + 36864;
constexpr int OFF_LR = OFF_P + 9216;
constexpr int OFF_GT = OFF_LR + 4096;
constexpr int OFF_DEC = OFF_GT + 2048;
constexpr int OFF_RS = OFF_DEC + 512;
constexpr int OFF_QR = OFF_RS + 2048;
constexpr int OFF_KR = OFF_QR + 17408;
constexpr int OFF_WG = OFF_KR + 17408;
static_assert(OFF_WG + 8192 <= LDSCTL_OFF, "gla lds");

__device__ __forceinline__ int grow(int b, int sc, int j, int i) {
    if (sc < 32) { const int col = 2 * sc + (j >> 1), r = (j & 1) * 64 + i; return b * SEQ + r * 64 + col; }
    return MX + b * LC + j * 64 + i;
}
__device__ __forceinline__ int prow(int b, int sc, int j, int i) {
    return sc < 32 ? b * SEQ + sc * 256 + j * 64 + i : MX + b * LC + j * 64 + i;
}
#define GLA_MFMA(a, b, c) __builtin_amdgcn_mfma_f32_16x16x32_f16(a, b, c, 0, 0, 0)

template <bool FULL>
__device__ __forceinline__ void gla_unit(const Ctx& F, const ArgsV& AV, int l, int unit) {
    const int b = unit / (4 * NSC), h = (unit / NSC) % 4, sc = unit % NSC;
    LAS f16* QT = (LAS f16*)(F.lds + OFF_QT); LAS f16* KT = (LAS f16*)(F.lds + OFF_KT); LAS f16* VT = (LAS f16*)(F.lds + OFF_VT);
    LAS f16* PP = (LAS f16*)(F.lds + OFF_P); LAS f16* LR = (LAS f16*)(F.lds + OFF_LR);
    LAS float* GT = (LAS float*)(F.lds + OFF_GT); LAS float* DEC = (LAS float*)(F.lds + OFF_DEC); LAS float* RS = (LAS float*)(F.lds + OFF_RS);
    LAS f16* QR = (LAS f16*)(F.lds + OFF_QR); LAS f16* KR = (LAS f16*)(F.lds + OFF_KR); LAS float* WG = (LAS float*)(F.lds + OFF_WG);
    const int tid = F.tid, lane = F.lane, w = F.wave, q0 = lane >> 4, c0 = lane & 15;
    const int dk0 = tid & 127, ig0 = tid >> 7;
    const f16* PX = (const f16*)(F.ws + WS_PX);
    const float scale = 0.08838834764831845f;
    for (int dir = 0; dir < 2; ++dir) {
        __syncthreads();
        for (int i = tid; i < 16 * 128; i += 512) WG[i] = AV.in(I_GLAWG)[(((size_t)l * 2 + dir) * 16 + (i >> 7)) * 512 + h * 128 + (i & 127)];
        const float bgv = AV.in(I_GLABG)[((size_t)l * 2 + dir) * 512 + h * 128 + dk0];
        const size_t sidx = ((((size_t)b * 4 + h) * NSC + sc) * 2 + dir);
        f32x4 accS[8][2];
        if (FULL && sc < 32) { const float* Sin = (const float*)(F.ws + WS_GSIN) + sidx * 32768; const int q = opq(q0), c = opq(c0);
#pragma unroll
            for (int dt = 0; dt < 8; ++dt)
#pragma unroll
                for (int et = 0; et < 2; ++et)
#pragma unroll
                    for (int r = 0; r < 4; ++r) accS[dt][et][r] = Sin[(16 * dt + 4 * q + r) * 256 + 32 * w + 16 * et + c];
            PIN8(accS[0][0], accS[0][1], accS[1][0], accS[1][1], accS[2][0], accS[2][1], accS[3][0], accS[3][1]); PIN8(accS[4][0], accS[4][1], accS[5][0], accS[5][1], accS[6][0], accS[6][1], accS[7][0], accS[7][1]); }
        else {
#pragma unroll
            for (int dt = 0; dt < 8; ++dt)
#pragma unroll
                for (int et = 0; et < 2; ++et) accS[dt][et] = (f32x4){0.f, 0.f, 0.f, 0.f}; }
        float sumtot = 0.f;
#define GLA_FETCH(jn) f16x8 pf_lr, pf_v[4], pf_k[2], pf_q[2]; do { const int tf = opq(F.tid); \
            { const int row = (tf & 255) >> 2, part = tf & 3; pf_lr = *(const f16x8*)(PX + (size_t)prow(b, sc, (jn), row) * PXLD + P_GG + part * 8); } \
            _Pragma("unroll") for (int k = 0; k < 4; ++k) { const int idx = tf + 512 * k, wi = idx >> 6, ln = idx & 63, rr = ln >> 2, cc = ln & 3; const int row = (wi & 3) * 16 + rr, chunk = (wi >> 2) * 4 + cc; \
                pf_v[k] = *(const f16x8*)(PX + (size_t)prow(b, sc, (jn), row) * PXLD + P_GV + h * 256 + chunk * 8); } \
            _Pragma("unroll") for (int k = 0; k < 2; ++k) { const int idx = tf + 512 * k, row = idx >> 4, ch = idx & 15; const size_t ro = (size_t)prow(b, sc, (jn), row) * PXLD; \
                pf_k[k] = *(const f16x8*)(PX + ro + P_GK + h * 128 + ch * 8); if (FULL) pf_q[k] = *(const f16x8*)(PX + ro + P_GQ + h * 128 + ch * 8); else pf_q[k] = pf_k[k]; } } while (0)
        for (int jj = 0; jj < 4; ++jj) {
            const int j = dir ? 3 - jj : jj;
            if (FULL) {
            GLA_FETCH(j);
            __syncthreads();
            const int tid = opq(F.tid);
            PIN8(pf_lr, pf_v[0], pf_v[1], pf_v[2], pf_v[3], pf_k[0], pf_k[1], pf_q[0]); asm volatile("" : "+v"(pf_q[1]));
            if (tid < 256) { const int row = tid >> 2, part = tid & 3; *(LAS f16x8*)(LR + row * 32 + part * 8) = pf_lr; }
#pragma unroll
            for (int k = 0; k < 4; ++k) { const int idx = opq(tid) + 512 * k, wi = idx >> 6, ln = idx & 63, rr = ln >> 2, cc = ln & 3;
                const int row = (wi & 3) * 16 + rr, chunk = (wi >> 2) * 4 + cc; LAS f16* vp = VT + (chunk * 8) * VT_LD + row;
#pragma unroll
                for (int e = 0; e < 8; ++e) vp[e * VT_LD] = pf_v[k][e]; }
#pragma unroll
            for (int k = 0; k < 2; ++k) { const int idx = tid + 512 * k, row = idx >> 4, ch = idx & 15;
                *(LAS f16x8*)(KR + row * QK_LD + ch * 8) = pf_k[k];
                *(LAS f16x8*)(QR + row * QK_LD + ch * 8) = pf_q[k]; }
            } else {
            __syncthreads();
            const int tid = opq(F.tid);
            if (tid < 256) { const int row = tid >> 2, part = tid & 3; const int gr = prow(b, sc, j, row);
                *(LAS f16x8*)(LR + row * 32 + part * 8) = *(const f16x8*)(PX + (size_t)gr * PXLD + P_GG + part * 8); }
#pragma unroll 1
            for (int k = 0; k < 4; ++k) { const int idx = tid + 512 * k, wi = idx >> 6, ln = idx & 63, rr = ln >> 2, cc = ln & 3;
                const int row = (wi & 3) * 16 + rr, chunk = (wi >> 2) * 4 + cc; const int gr = prow(b, sc, j, row);
                const f16x8 v8 = *(const f16x8*)(PX + (size_t)gr * PXLD + P_GV + h * 256 + chunk * 8);
#pragma unroll
                for (int e = 0; e < 8; ++e) VT[(chunk * 8 + e) * VT_LD + row] = v8[e]; }
#pragma unroll 1
            for (int k = 0; k < 2; ++k) { const int idx = tid + 512 * k, row = idx >> 4, ch = idx & 15; const int gr = prow(b, sc, j, row);
                *(LAS f16x8*)(KR + row * QK_LD + ch * 8) = *(const f16x8*)(PX + (size_t)gr * PXLD + P_GK + h * 128 + ch * 8); }
            }
            __syncthreads();
            const int dk = opq(dk0), ig = opq(ig0);
            float bv[16];
#pragma unroll
            for (int ii = 0; ii < 16; ++ii) { const int i = ig * 16 + ii; float pre = bgv;
                const f16x8 l0 = *(const LAS f16x8*)(LR + i * 32 + dir * 16), l1 = *(const LAS f16x8*)(LR + i * 32 + dir * 16 + 8);
#pragma unroll
                for (int r = 0; r < 8; ++r) pre += (float)l0[r] * WG[r * 128 + dk] + (float)l1[r] * WG[(8 + r) * 128 + dk];
                bv[ii] = logsigmoidf_(pre) * (1.0f / 16.0f); }
            float totloc;
            if (dir == 0) {
#pragma unroll
                for (int ii = 1; ii < 16; ++ii) bv[ii] += bv[ii - 1];
                totloc = bv[15]; }
            else {
#pragma unroll
                for (int ii = 14; ii >= 0; --ii) bv[ii] += bv[ii + 1];
                totloc = bv[0]; }
            GT[ig * 128 + dk] = totloc;
            __syncthreads();
            const float g0 = GT[dk], g1 = GT[128 + dk], g2 = GT[256 + dk], g3 = GT[384 + dk];
            const float total = (g0 + g1) + (g2 + g3);
            float off, bmid;
            if (dir == 0) { off = (ig > 0 ? g0 : 0.f) + (ig > 1 ? g1 : 0.f) + (ig > 2 ? g2 : 0.f); bmid = g0 + g1; }
            else { off = (ig < 3 ? g3 : 0.f) + (ig < 2 ? g2 : 0.f) + (ig < 1 ? g1 : 0.f); bmid = g2 + g3; }
#pragma unroll
            for (int ii = 0; ii < 16; ++ii) bv[ii] += off;
            if (FULL) {
#pragma unroll
                for (int ii = 0; ii < 16; ++ii) { const int i = ig * 16 + ii;
                    QT[i * QK_LD + dk] = (f16)((float)QR[i * QK_LD + dk] * scale * __expf(fminf(bv[ii] - bmid, 9.f)));
                    KT[i * QK_LD + dk] = (f16)((float)KR[i * QK_LD + dk] * __expf(fminf(bmid - bv[ii], 9.f))); }
                __syncthreads();
                { const int c = opq(c0), q = opq(q0);
#pragma unroll
                for (int s = 0; s < 2; ++s) { const int T = 2 * w + s, it = T >> 2, jt = T & 3; f32x4 a = (f32x4){0.f, 0.f, 0.f, 0.f};
#pragma unroll
                    for (int kk = 0; kk < 4; ++kk) { const f16x8 kf = *(const LAS f16x8*)(KT + (jt * 16 + c) * QK_LD + kk * 32 + 8 * q);
                        const f16x8 qf = *(const LAS f16x8*)(QT + (it * 16 + c) * QK_LD + kk * 32 + 8 * q); a = GLA_MFMA(kf, qf, a); }
                    const int i = it * 16 + c; f16x4 pv;
#pragma unroll
                    for (int r = 0; r < 4; ++r) { const int jx = jt * 16 + 4 * q + r; const bool keep = dir == 0 ? (jx <= i) : (jx >= i); pv[r] = keep ? (f16)a[r] : (f16)0.f; }
                    *(LAS f16x4*)(PP + i * P_LD + jt * 16 + 4 * q) = pv; } }
                __syncthreads();
#pragma unroll
                for (int ii = 0; ii < 16; ++ii) { const int i = ig * 16 + ii; QT[i * QK_LD + dk] = (f16)((float)QR[i * QK_LD + dk] * scale * __expf(bv[ii])); }
            }
            { f16x8 k0, k1;
#pragma unroll
              for (int ii = 0; ii < 8; ++ii) { k0[ii] = (f16)((float)KR[(ig * 16 + ii) * QK_LD + dk] * __expf(total - bv[ii])); k1[ii] = (f16)((float)KR[(ig * 16 + 8 + ii) * QK_LD + dk] * __expf(total - bv[8 + ii])); }
              *(LAS f16x8*)(KT + dk * KH_LD + ig * 16) = k0; *(LAS f16x8*)(KT + dk * KH_LD + ig * 16 + 8) = k1; }
            if (ig == 0) { DEC[dk] = __expf(total); sumtot += total; }
            __syncthreads();
            const int c = opq(c0), q = opq(q0);
            if (FULL) {
                f32x4 accO[4][2];
#pragma unroll
                for (int it = 0; it < 4; ++it)
#pragma unroll
                    for (int et = 0; et < 2; ++et) accO[it][et] = (f32x4){0.f, 0.f, 0.f, 0.f};
#pragma unroll
                for (int et = 0; et < 2; ++et)
#pragma unroll
                    for (int kk = 0; kk < 2; ++kk) { const f16x8 vf = *(const LAS f16x8*)(VT + (32 * w + 16 * et + c) * VT_LD + kk * 32 + 8 * q);
#pragma unroll
                        for (int it = 0; it < 4; ++it) { const f16x8 pf = *(const LAS f16x8*)(PP + (it * 16 + c) * P_LD + kk * 32 + 8 * q); accO[it][et] = GLA_MFMA(vf, pf, accO[it][et]); } asm volatile("" ::: "memory"); }
#pragma unroll
                for (int kb = 0; kb < 4; ++kb)
#pragma unroll
                    for (int et = 0; et < 2; ++et) { f16x8 sf; asm volatile("" ::: "memory");
#pragma unroll
                        for (int e = 0; e < 4; ++e) { sf[e] = (f16)accS[2 * kb][et][e]; sf[4 + e] = (f16)accS[2 * kb + 1][et][e]; }
#pragma unroll
                        for (int it = 0; it < 4; ++it) { const f16x4 lo = *(const LAS f16x4*)(QT + (it * 16 + c) * QK_LD + 32 * kb + 4 * q), hi = *(const LAS f16x4*)(QT + (it * 16 + c) * QK_LD + 32 * kb + 16 + 4 * q);
                            f16x8 qf; qf[0] = lo[0]; qf[1] = lo[1]; qf[2] = lo[2]; qf[3] = lo[3]; qf[4] = hi[0]; qf[5] = hi[1]; qf[6] = hi[2]; qf[7] = hi[3];
                            accO[it][et] = GLA_MFMA(sf, qf, accO[it][et]); } }
                float* OF = (float*)(F.ws + WS_GOF);
                if (dir == 0) {
#pragma unroll
                    for (int it = 0; it < 4; ++it) { const int gr = prow(b, sc, j, it * 16 + c);
#pragma unroll
                        for (int et = 0; et < 2; ++et) *(f32x4*)(OF + (size_t)gr * 1024 + h * 256 + 32 * w + 16 * et + 4 * q) = accO[it][et];
                        asm volatile("" ::: "memory"); } }
                else {
                    int grs[4]; f32x4 ofv[4][2]; f16x4 rvv[4][2];
#pragma unroll
                    for (int it = 0; it < 4; ++it) { grs[it] = prow(b, sc, j, it * 16 + c);
#pragma unroll
                        for (int et = 0; et < 2; ++et) { ofv[it][et] = *(const f32x4*)(OF + (size_t)grs[it] * 1024 + h * 256 + 32 * w + 16 * et + 4 * q);
                            rvv[it][et] = *(const f16x4*)(PX + (size_t)grs[it] * PXLD + P_GR + h * 256 + 32 * w + 16 * et + 4 * q); } }
                    PIN8(ofv[0][0], ofv[0][1], ofv[1][0], ofv[1][1], ofv[2][0], ofv[2][1], ofv[3][0], ofv[3][1]);
#pragma unroll
                    for (int it = 0; it < 4; ++it) { float ss = 0.f;
#pragma unroll
                        for (int et = 0; et < 2; ++et) { accO[it][et] = accO[it][et] + ofv[it][et];
                            ss += (accO[it][et][0] * accO[it][et][0] + accO[it][et][1] * accO[it][et][1]) + (accO[it][et][2] * accO[it][et][2] + accO[it][et][3] * accO[it][et][3]); }
                        ss += __shfl_xor(ss, 16); ss += __shfl_xor(ss, 32);
                        if (q == 0) RS[(it * 16 + c) * 8 + w] = ss; }
                    __syncthreads();
                    PIN8(rvv[0][0], rvv[0][1], rvv[1][0], rvv[1][1], rvv[2][0], rvv[2][1], rvv[3][0], rvv[3][1]);
                    const float* ng = AV.in(I_GLANG) + (size_t)l * 256;
                    f16* Y = (f16*)(F.ws + WS_YCAT);
#pragma unroll
                    for (int it = 0; it < 4; ++it) { const int i = it * 16 + c; const f32x4 ra = *(const LAS f32x4*)(RS + i * 8), rb = *(const LAS f32x4*)(RS + i * 8 + 4);
                        const float tot = ((ra[0] + ra[1]) + (ra[2] + ra[3])) + ((rb[0] + rb[1]) + (rb[2] + rb[3]));
                        const float rstd = 1.0f / sqrtf(tot * (1.0f / 256.0f) + EPS);
#pragma unroll
                        for (int et = 0; et < 2; ++et) { const int e0 = 32 * w + 16 * et + 4 * q;
                            const f32x4 gv = *(const f32x4*)(ng + e0);
                            f16x4 o;
#pragma unroll
                            for (int r = 0; r < 4; ++r) o[r] = (f16)(accO[it][et][r] * rstd * gv[r] * siluf_((float)rvv[it][et][r]));
                            *(f16x4*)(Y + (size_t)grow(b, sc, j, it * 16 + c) * 2048 + 1024 + h * 256 + e0) = o; } }
                }
            }
#pragma unroll
            for (int dt = 0; dt < 8; ++dt) { const f32x4 dv = *(const LAS f32x4*)(DEC + 16 * dt + 4 * q);
#pragma unroll
                for (int et = 0; et < 2; ++et) accS[dt][et] = accS[dt][et] * dv; }
#pragma unroll
            for (int kk = 0; kk < 2; ++kk) { f16x8 vf[2];
#pragma unroll
                for (int et = 0; et < 2; ++et) vf[et] = *(const LAS f16x8*)(VT + (32 * w + 16 * et + c) * VT_LD + kk * 32 + 8 * q);
#pragma unroll
                for (int dt = 0; dt < 8; ++dt) { const f16x8 kf = *(const LAS f16x8*)(KT + (16 * dt + c) * KH_LD + kk * 32 + 8 * q);
#pragma unroll
                    for (int et = 0; et < 2; ++et) accS[dt][et] = GLA_MFMA(kf, vf[et], accS[dt][et]); if (dt & 1) asm volatile("" ::: "memory"); } }
        }
        if (!FULL) { float* Sl = (float*)(F.ws + WS_GSLOC) + sidx * 32768; const int q = opq(q0), c = opq(c0);
#pragma unroll
            for (int dt = 0; dt < 8; ++dt)
#pragma unroll
                for (int et = 0; et < 2; ++et)
#pragma unroll
                    for (int r = 0; r < 4; ++r) Sl[(16 * dt + 4 * q + r) * 256 + 32 * w + 16 * et + c] = accS[dt][et][r];
            if (ig0 == 0) ((float*)(F.ws + WS_GDT))[sidx * 128 + dk0] = __expf(sumtot); }
        VM_WAIT();
    }
}
__device__ __forceinline__ void ph_gla_scan(const Ctx& F) {
    const float* Sl = (const float*)(F.ws + WS_GSLOC); float* Si = (float*)(F.ws + WS_GSIN); const float* Dt = (const float*)(F.ws + WS_GDT);
    for (int gt = F.bid * 512 + F.tid; gt < 2 * 4 * 2 * 32768; gt += F.G * 512) {
        const int e = gt & 32767, dir = (gt >> 15) & 1, h = (gt >> 16) & 3, b = gt >> 18;
        float S = 0.f;
        for (int base = 0; base < NSC; base += 11) {
            float sl[11], dt[11]; size_t ix[11];
#pragma unroll
            for (int u = 0; u < 11; ++u) { const int step = base + u; const int sc = step == 0 ? 32 : (dir == 0 ? step - 1 : 32 - step);
                const size_t idx = ((((size_t)b * 4 + h) * NSC + sc) * 2 + dir); ix[u] = idx;
                sl[u] = Sl[idx * 32768 + e]; dt[u] = Dt[idx * 128 + (e >> 8)]; }
            PIN8(sl[0], sl[1], sl[2], sl[3], sl[4], sl[5], sl[6], sl[7]); PIN8(dt[0], dt[1], dt[2], dt[3], dt[4], dt[5], dt[6], dt[7]); PIN4(sl[8], sl[9], sl[10], dt[8]); asm volatile("" : "+v"(dt[9]), "+v"(dt[10]));
#pragma unroll
            for (int u = 0; u < 11; ++u) { Si[ix[u] * 32768 + e] = S; S = dt[u] * S + sl[u]; }
        }
    }
}
#undef GLA_FETCH
#undef GLA_MFMA
}

namespace hy {
#define PADI(i) ((i) + ((i) >> 5))
constexpr int HY_BUF_BYTES = (16384 + 512) * 8;
constexpr int HY_SCR_OFF = HY_BUF_BYTES;
static_assert(HY_SCR_OFF + 2048 <= LDSCTL_OFF, "hyena lds");
__device__ __forceinline__ f32x2 twid(int k, float invN) { const float xr = (float)k * invN; return (f32x2){__builtin_amdgcn_cosf(xr), -__builtin_amdgcn_sinf(xr)}; }
__device__ __forceinline__ f32x2 mul_w16(f32x2 d, int a) {
    constexpr float c1 = 0.9238795325112867f, s1 = 0.3826834323650898f, r = 0.7071067811865476f;
    float c, s;
    switch (a & 15) {
        case 0: return d; case 4: return (f32x2){d.y, -d.x}; case 8: return (f32x2){-d.x, -d.y}; case 12: return (f32x2){-d.y, d.x};
        case 1: c = c1; s = s1; break; case 2: c = r; s = r; break; case 3: c = s1; s = c1; break;
        case 5: c = -s1; s = c1; break; case 6: c = -r; s = r; break; case 7: c = -c1; s = s1; break;
        case 9: c = -c1; s = -s1; break; case 10: c = -r; s = -r; break; case 11: c = -s1; s = -c1; break;
        case 13: c = s1; s = -c1; break; case 14: c = r; s = -r; break; default: c = c1; s = -s1; break; }
    return (f32x2){d.x * c + d.y * s, d.y * c - d.x * s};
}
template <int R> __device__ __forceinline__ void dif_pass(LAS f32x2* x, int m, int lh, int tid) {
    const int N = 1 << m; const float invN = 1.0f / (float)N; const int lg = lh - R + 1, g = 1 << lg, S = (N >> 1) >> lh;
    for (int q = tid; q < (N >> R); q += 512) { const int j = q & (g - 1), blk = q >> lg, base = (blk << (lh + 1)) + j;
        f32x2 v[1 << R];
#pragma unroll
        for (int k = 0; k < (1 << R); ++k) v[k] = x[PADI(base + k * g)];
        f32x2 w = twid(j * S, invN);
#pragma unroll
        for (int s = 0; s < R; ++s) { const int half = 1 << (R - 1 - s);
#pragma unroll
            for (int k = 0; k < (1 << R); ++k) if (!(k & half)) { const f32x2 a = v[k], b = v[k + half]; v[k] = a + b;
                v[k + half] = mul_w16(cmul(a - b, w), ((k & (half - 1)) << s) * (16 >> R)); }
            w = cmul(w, w); }
#pragma unroll
        for (int k = 0; k < (1 << R); ++k) x[PADI(base + k * g)] = v[k]; }
    __syncthreads();
}
template <int R> __device__ __forceinline__ void dit_pass(LAS f32x2* x, int m, int lh, int tid) {
    const int N = 1 << m; const float invN = 1.0f / (float)N; const int h = 1 << lh, S1 = (N >> 1) >> lh;
    for (int q = tid; q < (N >> R); q += 512) { const int j = q & (h - 1), blk = q >> lh, base = (blk << (lh + R)) + j;
        f32x2 v[1 << R];
#pragma unroll
        for (int k = 0; k < (1 << R); ++k) v[k] = x[PADI(base + k * h)];
        f32x2 wp[R]; wp[R - 1] = cconj(twid(j * (S1 >> (R - 1)), invN));
#pragma unroll
        for (int s = R - 2; s >= 0; --s) wp[s] = cmul(wp[s + 1], wp[s + 1]);
#pragma unroll
        for (int s = 0; s < R; ++s) { const int half = 1 << s;
#pragma unroll
            for (int k = 0; k < (1 << R); ++k) if (!(k & half)) { const f32x2 a = v[k];
                const f32x2 b = mul_w16(cmul(v[k + half], wp[s]), (16 - (k & (half - 1)) * (16 >> (s + 1))) & 15);
                v[k] = a + b; v[k + half] = a - b; } }
#pragma unroll
        for (int k = 0; k < (1 << R); ++k) x[PADI(base + k * h)] = v[k]; }
    __syncthreads();
}
__device__ __forceinline__ void fft_fwd(LAS f32x2* x, int m, int tid) {
    int lh = m - 1;
    while (lh + 1 >= 4) { dif_pass<4>(x, m, lh, tid); lh -= 4; }
    if (lh + 1 == 2) dif_pass<2>(x, m, 1, tid); else if (lh + 1 == 1) dif_pass<1>(x, m, 0, tid);
}
__device__ __forceinline__ void fft_inv(LAS f32x2* x, int m, int tid) {
    int lh = 0;
    while (m - lh >= 4) { dit_pass<4>(x, m, lh, tid); lh += 4; }
    if (m - lh == 2) dit_pass<2>(x, m, lh, tid); else if (m - lh == 1) dit_pass<1>(x, m, lh, tid);
}
__device__ __forceinline__ int brev(int k, int m) { return (int)(__brev((unsigned)k) >> (32 - m)); }

__device__ __forceinline__ void filt_unit(const Ctx& F, const ArgsV& AV, int l, int unit) {
    const int kind = unit >> 9, o = (unit >> 8) & 1, pair = unit & 255;
    const int n = kind ? LC : SEQ, m = kind ? 9 : 14, N = 2 * n, tid = F.tid;
    LAS f32x2* buf = (LAS f32x2*)F.lds;
    LAS float* W3 = (LAS float*)(F.lds + HY_SCR_OFF);
    LAS float* B3 = W3 + 256;
    LAS float* RED = B3 + 4;
    LAS float* INV = RED + 16;
    __syncthreads();
    if (tid < 4) { const int ci = tid; const int col = o * 1024 + (ci >> 1) * 512 + 2 * pair + (ci & 1); B3[ci] = AV.in(I_HYB3)[(size_t)l * 2048 + col]; }
    __syncthreads();
    const int lane = F.lane, q = lane >> 4, c = lane & 15;
    f16x8 wB0, wB1;
    { const int col = o * 1024 + ((c & 3) >> 1) * 512 + 2 * pair + (c & 1); const float* w3 = AV.in(I_HYW3) + (size_t)l * 64 * 2048 + col;
#pragma unroll
      for (int j = 0; j < 8; ++j) { wB0[j] = c < 4 ? (f16)w3[(size_t)(8 * q + j) * 2048] : (f16)0.f; wB1[j] = c < 4 ? (f16)w3[(size_t)(32 + 8 * q + j) * 2048] : (f16)0.f; } }
    const f16* H2H = (const f16*)(F.ws + WS_H2H) + ((size_t)l * (SEQ + LC) + (kind ? SEQ : 0)) * 64;
    const float lo = -3.0701134573253945f, hi = -15.350567286626973f;
    const float ra = fabsf(lo + (hi - lo) * (float)(2 * pair) / 511.0f), rb = fabsf(lo + (hi - lo) * (float)(2 * pair + 1) / 511.0f);
    const float rate = (c & 1) ? rb : ra, bias3 = B3[c & 3];
    float sabs = 0.f;
    for (int tile = F.wave; tile < (n >> 4); tile += 8) { const int t0 = tile * 16;
        const f16x8 a0 = *(const f16x8*)(H2H + (size_t)(t0 + c) * 64 + 8 * q), a1 = *(const f16x8*)(H2H + (size_t)(t0 + c) * 64 + 32 + 8 * q);
        f32x4 acc = (f32x4){0.f, 0.f, 0.f, 0.f};
        acc = __builtin_amdgcn_mfma_f32_16x16x32_f16(a0, wB0, acc, 0, 0, 0); acc = __builtin_amdgcn_mfma_f32_16x16x32_f16(a1, wB1, acc, 0, 0, 0);
        if (c < 4) {
#pragma unroll
            for (int i = 0; i < 4; ++i) { const int t = t0 + 4 * q + i; const float v = (acc[i] + bias3) * expf(-((float)t / (float)(n - 1)) * rate);
                LAS float* bp = (LAS float*)buf;
                if (c < 2) { bp[2 * PADI(t) + c] = v; sabs += fabsf(v); }
                else if (t >= 1) { bp[2 * PADI(N - t) + (c - 2)] = v; sabs += fabsf(v); } } }
    }
    float sa = (c == 0 || c == 2) ? sabs : 0.f, sb = (c == 1 || c == 3) ? sabs : 0.f;
    if (tid == 0) { float z0 = 0.f; asm volatile("" : "+v"(z0)); buf[PADI(n)] = (f32x2){z0, z0}; }
    sa = wave_sum(sa); sb = wave_sum(sb);
    if (F.lane == 0) { RED[F.wave * 2] = sa; RED[F.wave * 2 + 1] = sb; }
    __syncthreads();
    if (tid < 2) { float s = 0.f;
#pragma unroll
        for (int w = 0; w < 8; ++w) s += RED[w * 2 + tid];
        INV[tid] = 1.0f / (s + EPS); }
    __syncthreads();
    { const float ia = INV[0], ib = INV[1];
      for (int i = tid; i < N; i += 512) { f32x2 v = buf[PADI(i)]; v.x *= ia; v.y *= ib; buf[PADI(i)] = v; } }
    __syncthreads();
    fft_fwd(buf, m, tid);
    f32x4* out = (f32x4*)(F.ws + ((l & 1) ? WS_FSD2 : WS_FSD) + (kind ? FSD_C_OFF : 0)) + (size_t)(o * 256 + pair) * (n + 1);
    for (int u = tid; u <= n; u += 512) { const int p = u < n ? 2 * u : 1, k = brev(p, m), pn = brev((N - k) & (N - 1), m);
        const f32x2 zk = buf[PADI(p)], zn = cconj(buf[PADI(pn)]);
        const f32x2 fa = (zk + zn) * 0.5f, df = zk - zn, fb = (f32x2){df.y * 0.5f, -df.x * 0.5f};
        const f32x2 fs = (fa + fb) * 0.5f, fd = (fa - fb) * 0.5f;
        out[u] = (f32x4){fs.x, fs.y, fd.x, fd.y}; }
    __syncthreads();
}

__device__ __forceinline__ void main_unit(const Ctx& F, const ArgsV& AV, int l, int unit) {
    const int kind = unit >> 9, b = (unit >> 8) & 1, pair = unit & 255;
    const int n = kind ? LC : SEQ, m = kind ? 9 : 14, N = 2 * n, tid = F.tid;
    const int row0 = kind ? MX + b * LC : b * SEQ;
    LAS f32x2* buf = (LAS f32x2*)F.lds;
    const f16* ZT = (const f16*)(F.ws + WS_ZT) + (size_t)(2 * pair) * MT + row0;
    const float* cw = AV.in(I_HYCW) + (size_t)l * 3 * 1536 + 2 * pair; const float* cb = AV.in(I_HYCB) + (size_t)l * 1536 + 2 * pair;
    f32x2 yv[16], g1[16], g2[16];
#pragma unroll
    for (int g = 0; g < 3; ++g)
#pragma unroll
        for (int cc = 0; cc < 2; ++cc) { const float w0 = cw[g * 512 + cc], w1 = cw[1536 + g * 512 + cc], w2 = cw[3072 + g * 512 + cc], bs = cb[g * 512 + cc];
            const f16* zt = ZT + (size_t)(g * 512 + cc) * MT;
#pragma unroll
            for (int gi = 0; gi < 2; ++gi) { const int t0 = 8 * (tid + 512 * gi);
                f16x8 mv; float pv = 0.f, nv = 0.f;
#pragma unroll
                for (int e = 0; e < 8; ++e) mv[e] = (f16)0.f;
                if (t0 < n) { mv = *(const f16x8*)(zt + t0); if (t0 > 0) pv = (float)zt[t0 - 1]; if (t0 + 8 < n) nv = (float)zt[t0 + 8]; }
#pragma unroll
                for (int e = 0; e < 8; ++e) { const float zm = e == 0 ? pv : (float)mv[e == 0 ? 0 : e - 1], zc = (float)mv[e], zp = e == 7 ? nv : (float)mv[e == 7 ? 7 : e + 1];
                    const float r = w0 * zm + w1 * zc + w2 * zp + bs;
                    if (g == 0) { if (cc == 0) yv[gi * 8 + e].x = r; else yv[gi * 8 + e].y = r; }
                    else if (g == 1) { if (cc == 0) g1[gi * 8 + e].x = r; else g1[gi * 8 + e].y = r; }
                    else { if (cc == 0) g2[gi * 8 + e].x = r; else g2[gi * 8 + e].y = r; } } } }
    const float invN = 1.0f / (float)N;
#pragma unroll
    for (int o = 0; o < 2; ++o) {
        __syncthreads();
        float z0 = 0.f; asm volatile("" : "+v"(z0));
#pragma unroll
        for (int gi = 0; gi < 2; ++gi) { const int t0 = 8 * (tid + 512 * gi);
            if (t0 < n) {
#pragma unroll
                for (int e = 0; e < 8; ++e) { buf[PADI(t0 + e)] = yv[gi * 8 + e]; buf[PADI(n + t0 + e)] = (f32x2){z0, z0}; } } }
        __syncthreads();
        fft_fwd(buf, m, tid);
        const f32x4* fsd = (const f32x4*)(F.ws + ((l & 1) ? WS_FSD2 : WS_FSD) + (kind ? FSD_C_OFF : 0)) + (size_t)(o * 256 + pair) * (n + 1);
        for (int u = tid; u <= n; u += 512) { const int p = u < n ? 2 * u : 1, k = brev(p, m), pn = brev((N - k) & (N - 1), m);
            const f32x2 zk = buf[PADI(p)], zn = buf[PADI(pn)]; const f32x4 f = fsd[u]; const f32x2 fs = (f32x2){f[0], f[1]}, fd = (f32x2){f[2], f[3]};
            const f32x2 wk = cmul(zk, fs) + cmul(cconj(zn), fd), wn = cmul(zn, cconj(fs)) + cmul(cconj(zk), cconj(fd));
            buf[PADI(pn)] = wn; buf[PADI(p)] = wk; }
        __syncthreads();
        fft_inv(buf, m, tid);
        const float* hb = AV.in(I_HYBIAS) + ((size_t)l * 2 + o) * 512 + 2 * pair; const f32x2 bias = (f32x2){hb[0], hb[1]};
#pragma unroll
        for (int gi = 0; gi < 2; ++gi) { const int t0 = 8 * (tid + 512 * gi);
            if (t0 < n) {
#pragma unroll
                for (int e = 0; e < 8; ++e) { const f32x2 cv = buf[PADI(t0 + e)] * invN; const f32x2 gt = o == 0 ? g1[gi * 8 + e] : g2[gi * 8 + e];
                    yv[gi * 8 + e] = gt * (cv + yv[gi * 8 + e] * bias); } } }
    }
    f16* Y = (f16*)(F.ws + WS_YBT) + (size_t)(2 * pair) * MT + row0;
#pragma unroll
    for (int gi = 0; gi < 2; ++gi) { const int t0 = 8 * (tid + 512 * gi);
        if (t0 < n) { f16x8 oa, ob;
#pragma unroll
            for (int e = 0; e < 8; ++e) { oa[e] = (f16)yv[gi * 8 + e].x; ob[e] = (f16)yv[gi * 8 + e].y; }
            *(f16x8*)(Y + t0) = oa; *(f16x8*)(Y + MT + t0) = ob; } }
    __syncthreads();
}

__device__ __forceinline__ void ph_ybt_transpose(const Ctx& F) {
    LAS f16* T = (LAS f16*)F.lds;
    const f16* YBT = (const f16*)(F.ws + WS_YBT); f16* Y = (f16*)(F.ws + WS_YCAT);
    const bool bal = (F.G == 256);
    for (int it = 0; it < (bal ? 2 : (MT / 64 + F.G - 1) / F.G); ++it) {
        int rb;
        if (bal) { if (F.bid >= 132) rb = (F.bid - 132) + 124 * it; else if (F.bid < 16 && it == 0) rb = 248 + F.bid; else rb = -1; }
        else rb = F.bid + it * F.G;
        if (rb < 0 || rb >= MT / 64) continue;
        const int r0 = rb * 64;
        __syncthreads();
        { f16x8 tv[8];
#pragma unroll
          for (int i = 0; i < 8; ++i) tv[i] = *(const f16x8*)(YBT + (size_t)F.tid * MT + r0 + 8 * i);
          PIN8(tv[0], tv[1], tv[2], tv[3], tv[4], tv[5], tv[6], tv[7]);
#pragma unroll
          for (int i = 0; i < 8; ++i) *(LAS f16x8*)(T + F.tid * 72 + 8 * i) = tv[i]; }
        __syncthreads();
        const int row = F.tid >> 3, cg = F.tid & 7;
#pragma unroll
        for (int jj = 0; jj < 8; ++jj) { const int gidx = cg + 8 * jj; f16x8 o;
#pragma unroll
            for (int e = 0; e < 8; ++e) o[e] = T[(8 * gidx + e) * 72 + row];
            *(f16x8*)(Y + (size_t)(r0 + row) * 2048 + 512 + 8 * gidx) = o; }
    }
    __syncthreads();
}
#undef PADI
}

#ifndef PHMASK
#define PHMASK 0xFFFF
#endif
#define PH_EN(k) (((PHMASK) >> (k)) & 1)
#ifndef STAMP_MASK
#define STAMP_MASK 0
#endif
#ifndef STAMP_K
#define STAMP_K 1
#endif
#ifndef SUBMASK
#define SUBMASK 7
#endif
#define SUB_EN(k) (((SUBMASK) >> (k)) & 1)
constexpr int NPH = 2 + 12 * DEPTH;
constexpr int CW_Q = 8192;
__device__ __forceinline__ int q_pull(unsigned* ctr, volatile LAS int* slot) {
    __syncthreads();
    if (threadIdx.x == 0) *slot = (int)__hip_atomic_fetch_add(ctr, 1u, __ATOMIC_RELAXED, __HIP_MEMORY_SCOPE_AGENT);
    __syncthreads();
    return *slot;
}

__global__ void __launch_bounds__(512, 2) mk_fwd(Args args) {
    extern __shared__ __attribute__((aligned(16))) unsigned char lds_raw[];
    Ctx F; F.lds = (LAS unsigned char*)lds_raw; F.tid = threadIdx.x; F.lane = F.tid & 63; F.wave = __builtin_amdgcn_readfirstlane(F.tid >> 6);
    F.G = gridDim.x; F.bid = blockIdx.x; F.ws = args.ws;
    ArgsV AV; AV.out = args.out;
    const Ctx F0 = F;
#define FRESH() do { F.tid = opq(F0.tid); F.lane = F.tid & 63; F.wave = __builtin_amdgcn_readfirstlane(F.tid >> 6); } while (0)
    volatile LAS unsigned* MISC = (volatile LAS unsigned*)(F.lds + LDSCTL_OFF);
    if (F.tid < 64) MISC[F.tid] = 0u;
    __syncthreads();
    unsigned* barw = (unsigned*)(F.ws + WS_CTL) + CW_BAR;
    XcdBarrier bar; bar.bar = barw; bar.x = 0; bar.st = nullptr;
    const int lo = args.ph_lo, hi = args.ph_hi;
    if (hi - lo > 1) bar = xcd_barrier_post(barw, MISC + 8);
#define IN(k) (lo <= (k) && (k) < hi)
#define SEAM(k) do { if (IN(k) && IN((k) + 1)) xcd_barrier(bar); } while (0)
#if STAMP_MASK
    volatile LAS unsigned long long* TS = (volatile LAS unsigned long long*)(F.lds + LDSCTL_OFF + 128);
#define TSTART(k) do { if ((((STAMP_MASK) >> (k)) & 1) && blockIdx.x == 0 && threadIdx.x == 0) TS[0] = __builtin_amdgcn_s_memrealtime(); } while (0)
#define TSTOP(k) do { if ((((STAMP_MASK) >> (k)) & 1) && blockIdx.x == 0 && threadIdx.x == 0) TS[1] = TS[1] + (__builtin_amdgcn_s_memrealtime() - TS[0]); } while (0)
#else
#define TSTART(k) do {} while (0)
#define TSTOP(k) do {} while (0)
#endif
    unsigned char* ws = F.ws;
    const int rank160 = (F.bid + F.G - 160 % F.G) % F.G;

    TSTART(12);
    if (PH_EN(12) && IN(0)) { FRESH(); ph_prologue(F, AV); for (int l2 = 0; l2 < DEPTH; ++l2) { FRESH(); ph_hyena_h2(F, AV, l2); } }
    SEAM(0);
    TSTOP(12);

    for (int l = 0; l < DEPTH; ++l) {
        const int pb = 1 + 12 * l;
        const float* modl = (const float*)(ws + WS_MOD) + (size_t)l * 3 * 12288;
        const bool ctx_on = l < DEPTH - 1;
        const int nMr = ctx_on ? MT / 256 : MX / 256, nrows = ctx_on ? MT : MX;
        TSTART(0);
        if (PH_EN(0) && IN(pb + 0)) {
            FRESH(); ph_convert_weights(F, AV, l);
            __syncthreads();
            FRESH(); if (F.bid < 32) s5_mats_group(F, AV, l, F.bid);
            FRESH(); ph_norm(F, AV, l, 0, MT, l > 0 ? 11 : 0);
        }
        SEAM(pb + 0);
        TSTOP(0);
        TSTART(1);
        if (PH_EN(1) && IN(pb + 1)) {
            pg8::SchedPlain S; S.init(MT / 256, WINN / 256, F.G, F.bid); S.A = (const char*)(ws + WS_HN); S.B = (const char*)(ws + WS_WIN); S.aTile = (size_t)256 * 2048 * 2; S.bTile = (size_t)256 * 2048 * 2;
            pg8::EpiPx E{(f16*)(ws + WS_PX), (f16*)(ws + WS_S5A), (f16*)(ws + WS_ZT), (f16*)(ws + WS_GTL)};
            pg8::gemm_phase(F.lds, 2048, 2048, 32, S, E);
        }
        SEAM(pb + 1);
        TSTOP(1);
        TSTART(2);
        if (PH_EN(2) && IN(pb + 2)) {
            TSTART(16);
            if (SUB_EN(0)) { pg8::SchedS5 S{(const char*)(ws + WS_S5A), (const char*)(ws + WS_S5M), (size_t)256 * 256 * 2, F.G, F.bid};
              pg8::EpiS5In E{(float*)(ws + WS_S5S)};
              pg8::gemm_phase(F.lds, 16384, 256, 4, S, E); }
            TSTOP(16);
            { unsigned* qc = (unsigned*)(ws + WS_CTL) + CW_Q + (l * 2 + 0) * 64; volatile LAS int* slot = (volatile LAS int*)(MISC + 16);
              const bool pre = (l > 0 && F.G == 256);
              const int nq = 264 + (pre ? 272 : 1024);
              for (;;) { const int u = q_pull(qc, slot); if (u >= nq) break;
                  if (u < 264) { TSTART(17); FRESH(); gla::gla_unit<false>(F, AV, l, u); TSTOP(17); } else { TSTART(18); FRESH(); hy::filt_unit(F, AV, l, pre ? 240 + (u - 264) : u - 264); TSTOP(18); } } }
        }
        SEAM(pb + 2);
        TSTOP(2);
        TSTART(3);
        if (PH_EN(3) && IN(pb + 3)) { FRESH(); ph_s5_scan(F); FRESH(); gla::ph_gla_scan(F); }
        SEAM(pb + 3);
        TSTOP(3);
        TSTART(4);
        if (PH_EN(4) && IN(pb + 4)) {
            TSTART(19);
            if (SUB_EN(0)) { pg8::SchedS5 S{(const char*)(ws + WS_S5A), (const char*)(ws + WS_S5W), (size_t)256 * 512 * 2, F.G, F.bid};
              pg8::EpiS5Out E{(const f16*)(ws + WS_S5A), (f16*)(ws + WS_YAPRE), AV.in(I_S5D) + (size_t)l * 512};
              pg8::gemm_phase(F.lds, 16384, 512, 8, S, E); }
            TSTOP(19);
            { unsigned* qc = (unsigned*)(ws + WS_CTL) + CW_Q + (l * 2 + 1) * 64; volatile LAS int* slot = (volatile LAS int*)(MISC + 16);
              for (;;) { const int u = q_pull(qc, slot); if (u >= 264 + 1024) break;
                  if (u < 264) { TSTART(20); FRESH(); gla::gla_unit<true>(F, AV, l, u); TSTOP(20); } else { TSTART(21); FRESH(); hy::main_unit(F, AV, l, u - 264); TSTOP(21); } } }
        }
        SEAM(pb + 4);
        TSTOP(4);
        TSTART(5);
        if (PH_EN(5) && IN(pb + 5)) {
            pg8::SchedPlain S; S.init(nMr, 2, F.G, F.bid); S.A = (const char*)(ws + WS_YAPRE); S.B = (const char*)(ws + WS_WGLU); S.aTile = (size_t)256 * 512 * 2; S.bTile = (size_t)256 * 512 * 2;
            pg8::EpiGlu E{(const f16*)(ws + WS_YAPRE), (f16*)(ws + WS_YCAT), AV.in(I_GLUB) + (size_t)l * 512};
            pg8::gemm_phase(F.lds, 512, 512, 8, S, E);
            FRESH(); hy::ph_ybt_transpose(F);
        }
        SEAM(pb + 5);
        TSTOP(5);
        TSTART(6);
        if (PH_EN(6) && IN(pb + 6)) {
            pg8::SchedPlain S; S.init(nMr, 8, F.G, F.bid); S.aTile = (size_t)256 * 2048 * 2; S.bTile = (size_t)256 * 2048 * 2;
            S.A = (const char*)(ws + WS_YCAT); S.B = (const char*)(ws + WS_WBR);
            pg8::EpiBranchF E{(const f16*)(ws + WS_GTL), (f16*)(ws + WS_MBUF)};
            pg8::gemm_phase(F.lds, 2048, 2048, 32, S, E);
            if (l + 1 < DEPTH && F.G == 256) { unsigned* qc = (unsigned*)(ws + WS_CTL) + CW_Q + 1024 + l * 64; volatile LAS int* slot = (volatile LAS int*)(MISC + 16);
              for (;;) { if (F.bid < 16) break; const int u = q_pull(qc, slot); if (u >= 240) break; FRESH(); hy::filt_unit(F, AV, l + 1, u); } }
#ifdef PG_DUMMY
            { pg8::EpiF16 E9{(f16*)(ws + WS_ACT), 2048}; pg8::gemm_phase(F.lds, 2048, 2048, 32, S, E9); }
#endif
        }
        SEAM(pb + 6);
        TSTOP(6);
        TSTART(7);
        if (PH_EN(7) && IN(pb + 7)) {
            pg8::SchedPlain S; S.init(MX / 256, 8, F.G, F.bid); S.A = (const char*)(ws + WS_MBUF); S.B = (const char*)(ws + WS_WOUT); S.aTile = (size_t)256 * 2048 * 2; S.bTile = (size_t)256 * 2048 * 2;
            pg8::EpiResid E{(float*)(ws + WS_XRES), modl, 4096};
            pg8::gemm_phase(F.lds, 2048, 2048, 32, S, E);
            if (ctx_on) { pg8::SchedSplit S2{(const char*)(ws + WS_MBUF), (const char*)(ws + WS_WOUT), (size_t)256 * 2048 * 2, (size_t)256 * 2048 * 2, (size_t)8 * 128, 4, F.G, F.bid};
                pg8::EpiSlab E2{(float*)(ws + WS_SLAB), modl, 4096};
                pg8::gemm_phase(F.lds, 2048, 2048, 8, S2, E2); }
            if (l + 1 < DEPTH && F.G == 256) { unsigned* qc = (unsigned*)(ws + WS_CTL) + CW_Q + 1024 + l * 64 + 32; volatile LAS int* slot = (volatile LAS int*)(MISC + 16);
              for (;;) { const int u = q_pull(qc, slot); if (u >= 512) break; FRESH(); hy::filt_unit(F, AV, l + 1, 512 + u); } }
        }
        SEAM(pb + 7);
        TSTOP(7);
        TSTART(8);
        if (PH_EN(8) && IN(pb + 8)) { FRESH(); ph_norm(F, AV, l, 1, nrows, 4); }
        SEAM(pb + 8);
        TSTOP(8);
        TSTART(9);
        if (PH_EN(9) && IN(pb + 9)) {
            pg8::SchedPlain S; S.init(nMr, UPLD / 256, F.G, F.bid); S.A = (const char*)(ws + WS_HN); S.B = (const char*)(ws + WS_WUP); S.aTile = (size_t)256 * 2048 * 2; S.bTile = (size_t)256 * 2048 * 2;
            pg8::EpiUpAct E{(f16*)(ws + WS_ACT), (float*)(ws + WS_HALO), AV.in(I_FFCW) + (size_t)l * 3 * FFH, AV.in(I_FFCB) + (size_t)l * FFH, (LAS float*)(F.lds + EXTRA_OFF)};
            pg8::gemm_phase(F.lds, 2048, 2048, 32, S, E);
        }
        SEAM(pb + 9);
        TSTOP(9);
        TSTART(10);
        if (PH_EN(10) && IN(pb + 10)) { FRESH(); ph_ffn_fix(F, AV, l, nMr); }
        SEAM(pb + 10);
        TSTOP(10);
        TSTART(11);
        if (PH_EN(11) && IN(pb + 11)) {
            pg8::SchedPlain S; S.init(MX / 256, 8, F.G, F.bid); S.A = (const char*)(ws + WS_ACT); S.B = (const char*)(ws + WS_WDN); S.aTile = (size_t)256 * FFH * 2; S.bTile = (size_t)256 * FFH * 2;
            pg8::EpiResid E{(float*)(ws + WS_XRES), modl, 10240};
            pg8::gemm_phase(F.lds, FFH, FFH, FFH / 64, S, E);
            if (ctx_on) { pg8::SchedSplit S2{(const char*)(ws + WS_ACT), (const char*)(ws + WS_WDN), (size_t)256 * FFH * 2, (size_t)256 * FFH * 2, (size_t)8 * 128, 11, F.G, F.bid};
                pg8::EpiSlab E2{(float*)(ws + WS_SLAB), modl, 10240};
                pg8::gemm_phase(F.lds, FFH, FFH, 8, S2, E2); }
        }
        SEAM(pb + 11);
        TSTOP(11);
    }
    if (PH_EN(13) && IN(NPH - 1)) { FRESH(); ph_final_norm(F, AV); }
#if STAMP_MASK
    if (blockIdx.x == 0 && threadIdx.x == 0) { const unsigned long long t0 = __builtin_amdgcn_s_memrealtime(); while (__builtin_amdgcn_s_memrealtime() - t0 < (unsigned long long)(STAMP_K) * TS[1]) __builtin_amdgcn_s_sleep(8); }
#endif
#undef IN
#undef SEAM
#undef FRESH
}

extern "C" void kernel_launch(void* const* d_in, const int* in_sizes, int n_in, void* d_out, int out_size, void* d_ws, size_t ws_size, hipStream_t stream) {
    static int grid = 0;
    if (grid == 0) {
        if (n_in != 40 || out_size != MX * D || ws_size < WS_END) { fprintf(stderr, "kernel_launch: unexpected problem (n_in %d out %d ws %zu, need %zu)\n", n_in, out_size, ws_size, (size_t)WS_END); grid = -1; return; }
        int dev = 0, cus = 0, per_cu = 0;
        if (hipGetDevice(&dev) != hipSuccess || hipDeviceGetAttribute(&cus, hipDeviceAttributeMultiprocessorCount, dev) != hipSuccess) { grid = -1; return; }
        if (hipFuncSetAttribute((const void*)mk_fwd, hipFuncAttributeMaxDynamicSharedMemorySize, LDS_BYTES) != hipSuccess) { fprintf(stderr, "kernel_launch: hipFuncSetAttribute failed\n"); grid = -1; return; }
        if (hipOccupancyMaxActiveBlocksPerMultiprocessor(&per_cu, (const void*)mk_fwd, 512, LDS_BYTES) != hipSuccess || per_cu < 1)
            fprintf(stderr, "kernel_launch: occupancy query reports %d\n", per_cu);
        (void)hipGetLastError();
        grid = cus;
    }
    if (grid < 0) return;
    if (hipMemsetAsync((char*)d_ws + WS_CTL, 0, CTL_ZERO_BYTES, stream) != hipSuccess) return;
    Args a{};
    for (int i = 0; i < 40; ++i) a.in[i] = (const float*)d_in[i];
    a.out = (float*)d_out; a.ws = (unsigned char*)d_ws;
#if MK_ONE
    a.ph_lo = 0; a.ph_hi = NPH;
    hipLaunchKernelGGL(mk_fwd, dim3(grid), dim3(512), LDS_BYTES, stream, a);
#else
    for (int p = 0; p < NPH; ++p) { a.ph_lo = p; a.ph_hi = p + 1; hipLaunchKernelGGL(mk_fwd, dim3(grid), dim3(512), LDS_BYTES, stream, a); }
#endif
}
```

```cpp
#include <hip/hip_runtime.h>
#include <stdio.h>

#ifndef MK_ONE
#define MK_ONE 1
#define STAMP_MASK 0
#define STAMP_K 1
#endif

#define GAS __attribute__((address_space(1)))
#define LAS __attribute__((address_space(3)))
typedef _Float16 f16;
typedef _Float16 f16x8 __attribute__((ext_vector_type(8)));
typedef _Float16 f16x4 __attribute__((ext_vector_type(4)));
typedef _Float16 f16x2 __attribute__((ext_vector_type(2)));
typedef float f32x4 __attribute__((ext_vector_type(4)));
typedef float f32x2 __attribute__((ext_vector_type(2)));

constexpr int D = 2048, NB = 2, SEQ = 8192, LC = 256, DEPTH = 4;
constexpr int MX = NB * SEQ, MC = NB * LC, MT = MX + MC;
constexpr int PXLD = 3840, WINN = 11520, FFH = 5632, UPLD = 2 * FFH;
constexpr int P_S5 = 0, P_GK = 512, P_GV = 1024, P_GQ = 2048, P_GR = 2560, P_HY = 3584, P_MG = 5120, P_GG = 3584, W_GG = 11264;
constexpr int INW = 11296;
constexpr int NCHK = 1056;
constexpr float S5SCALE = 1024.f;
constexpr float EPS = 1e-6f;
constexpr int NSC = 33;

constexpr size_t MiB = 1u << 20;
constexpr size_t WS_CTL = 0, CTL_ZERO_BYTES = 1 * MiB;
constexpr size_t WS_MOD = 1 * MiB;
constexpr size_t WS_TW = 2 * MiB;
constexpr size_t WS_S5AT = 3 * MiB;
constexpr size_t WS_WIN = 4 * MiB;
constexpr size_t WS_WGLU = WS_WIN + 45 * MiB;
constexpr size_t WS_WBR = WS_WGLU + 1 * MiB;
constexpr size_t WS_WOUT = WS_WBR + 8 * MiB;
constexpr size_t WS_WUP = WS_WOUT + 8 * MiB;
constexpr size_t WS_WDN = WS_WUP + 44 * MiB;
constexpr size_t WS_S5W = WS_WDN + 22 * MiB;
constexpr size_t WS_S5M = WS_S5W + 8 * MiB;
constexpr size_t WS_H2 = WS_S5M + 4 * MiB;
constexpr size_t WS_FSD = WS_H2 + 3 * MiB;
constexpr size_t FSD_C_OFF = (size_t)2 * 256 * 8193 * 16;
constexpr size_t WS_XRES = WS_FSD + 68 * MiB;
constexpr size_t WS_HN = WS_XRES + 132 * MiB;
constexpr size_t WS_PX = WS_HN + 66 * MiB;
constexpr size_t WS_S5A = WS_PX + 372 * MiB;
constexpr size_t WS_S5S = WS_S5A + 40 * MiB;
constexpr size_t WS_YAPRE = WS_S5S + 40 * MiB;
constexpr size_t WS_YCAT = WS_YAPRE + 20 * MiB;
constexpr size_t WS_MBUF = WS_YCAT + 66 * MiB;
constexpr size_t WS_GSLOC = WS_MBUF + 66 * MiB;
constexpr size_t WS_GSIN = WS_GSLOC + 66 * MiB;
constexpr size_t WS_GOF = WS_GSIN + 66 * MiB;
constexpr size_t WS_GDT = WS_GOF + 66 * MiB;
constexpr size_t WS_ACT = WS_GSLOC;
constexpr size_t WS_ZT = WS_GDT + 1 * MiB;
constexpr size_t WS_YBT = WS_ZT + 50 * MiB;
constexpr size_t WS_SLAB = WS_YBT + 17 * MiB;
constexpr size_t WS_HALO = WS_SLAB + 44 * MiB;
constexpr size_t WS_GTL = WS_HALO + 9 * MiB;
constexpr size_t WS_END = WS_GTL + 198 * MiB;
constexpr size_t WS_FSD2 = WS_PX + 124 * MiB;
constexpr size_t WS_W2 = WS_FSD2 + 68 * MiB;
constexpr size_t WS_H2H = WS_W2 + 128 * MiB;
static_assert(WS_H2H + 5 * MiB <= WS_PX + 372 * MiB, "PX tail");
static_assert((size_t)MT * FFH * 2 <= 198 * MiB, "ACT overlay");
constexpr int CW_BAR = 4096;

constexpr int RING_BYTES = 131072;
constexpr int EXTRA_OFF = RING_BYTES, EXTRA_BYTES = 8192;
constexpr int LDSCTL_OFF = EXTRA_OFF + EXTRA_BYTES;
constexpr int LDS_BYTES = LDSCTL_OFF + 256;

__device__ __forceinline__ float wave_sum(float v) {
#pragma unroll
    for (int o = 1; o < 64; o <<= 1) v += __shfl_xor(v, o);
    return v;
}
__device__ __forceinline__ float sigmoidf_(float x) { return 1.0f / (1.0f + __expf(-x)); }
__device__ __forceinline__ float siluf_(float x) { return x * sigmoidf_(x); }
__device__ __forceinline__ float gelu_tanh_(float x) { const float u = 0.7978845608028654f * (x + 0.044715f * x * x * x); return x / (1.0f + __expf(-2.0f * u)); }
__device__ __forceinline__ float logsigmoidf_(float x) { return fminf(x, 0.f) - __logf(1.0f + __expf(-fabsf(x))); }
__device__ __forceinline__ f32x2 cmul(f32x2 a, f32x2 b) { return (f32x2){a.x * b.x - a.y * b.y, a.x * b.y + a.y * b.x}; }
__device__ __forceinline__ f32x2 cconj(f32x2 a) { return (f32x2){a.x, -a.y}; }
__device__ __forceinline__ int opq(int x) { asm volatile("" : "+v"(x)); return x; }
#define PIN8(a, b, c, d, e, f, g, h) asm volatile("" : "+v"(a), "+v"(b), "+v"(c), "+v"(d), "+v"(e), "+v"(f), "+v"(g), "+v"(h))
#define PIN4(a, b, c, d) asm volatile("" : "+v"(a), "+v"(b), "+v"(c), "+v"(d))
#define LDS_WAIT() asm volatile("s_waitcnt lgkmcnt(0)" ::: "memory")
#define VM_WAIT() asm volatile("s_waitcnt vmcnt(0)" ::: "memory")

#define XB_TMO      128
#define XB_XCNT(j)  (256  + 64 * (j))
#define XB_XSUB(j)  (1280 + 64 * (j))
#define XB_XGEN(j)  (2304 + 64 * (j))
#define XB_TOP      3328
#define XB_TOPGEN   3392
#define XCD_BAR_WORDS 3456
#define XB_SPIN_CAP (1u << 18)
__device__ __forceinline__ unsigned xb_ld(unsigned* p)              { return __hip_atomic_load(p, __ATOMIC_RELAXED, __HIP_MEMORY_SCOPE_AGENT); }
__device__ __forceinline__ unsigned xb_add(unsigned* p, unsigned v) { return __hip_atomic_fetch_add(p, v, __ATOMIC_RELAXED, __HIP_MEMORY_SCOPE_AGENT); }
__device__ __forceinline__ unsigned xb_xcc_id() { return (unsigned)__builtin_amdgcn_s_getreg((3 << 11) | 20) & 0xFu; }
#define XB_SPIN(cond, bar) do { unsigned _sp = 0; while (cond) { __builtin_amdgcn_s_sleep(1); \
    if ((++_sp & 255u) == 0u) { if (xb_ld(&(bar)[XB_TMO])) break; if (_sp > XB_SPIN_CAP) { atomicAdd(&(bar)[XB_TMO], 1u); break; } } } } while (0)
struct XcdBarrier { unsigned* bar; unsigned x; volatile LAS unsigned* st; };
__device__ __forceinline__ XcdBarrier xcd_barrier_post(unsigned* bar, volatile LAS unsigned* st) {
    XcdBarrier b; b.bar = bar; b.x = xb_xcc_id(); b.st = st;
    if (threadIdx.x == 0) (void)xb_add(&bar[XB_XCNT(b.x)], 1u);
    return b;
}
__device__ __forceinline__ void xcd_barrier_complete(unsigned* bar, unsigned x, unsigned& nloc, unsigned& nx) {
    const unsigned G = gridDim.x * gridDim.y * gridDim.z;
    unsigned sum, cnt, mine, sp = 0u;
    for (;;) {
        sum = 0u; cnt = 0u; mine = 0u;
#pragma unroll
        for (unsigned j = 0; j < 16; ++j) { const unsigned c = xb_ld(&bar[XB_XCNT(j)]); sum += c; cnt += (c > 0u) ? 1u : 0u; mine = (j == x) ? c : mine; }
        if (sum == G) break;
        __builtin_amdgcn_s_sleep(1);
        if ((++sp & 255u) == 0u) { if (xb_ld(&bar[XB_TMO])) break; if (sp > XB_SPIN_CAP) { atomicAdd(&bar[XB_TMO], 1u); break; } }
    }
    nloc = mine > 0u ? mine : 1u; nx = cnt > 0u ? cnt : 1u;
}
__device__ __forceinline__ void xcd_barrier(const XcdBarrier& b) {
    asm volatile("s_waitcnt vmcnt(0)" ::: "memory");
    __syncthreads();
    if (threadIdx.x == 0) {
        unsigned* bar = b.bar;
        __builtin_amdgcn_s_waitcnt(0);
        unsigned nloc = b.st[0], nx = b.st[1];
        if (nloc == 0u) { xcd_barrier_complete(bar, b.x, nloc, nx); b.st[0] = nloc; b.st[1] = nx; }
        const unsigned old = xb_add(&bar[XB_XSUB(b.x)], 1u);
        const unsigned gen = old / nloc;
        if (old + 1u == (gen + 1u) * nloc) {
            __builtin_amdgcn_fence(__ATOMIC_RELEASE, "agent");
            asm volatile("s_waitcnt vmcnt(0)" ::: "memory");
            const unsigned og = xb_add(&bar[XB_TOP], 1u);
            const unsigned tg = og / nx;
            if (og + 1u == (tg + 1u) * nx) xb_add(&bar[XB_TOPGEN], 1u);
            else XB_SPIN(xb_ld(&bar[XB_TOPGEN]) == tg, bar);
            __builtin_amdgcn_fence(__ATOMIC_ACQUIRE, "agent");
            xb_add(&bar[XB_XGEN(b.x)], 1u);
            asm volatile("s_waitcnt vmcnt(0)" ::: "memory");
        } else {
            XB_SPIN(xb_ld(&bar[XB_XGEN(b.x)]) == gen, bar);
            __builtin_amdgcn_fence(__ATOMIC_ACQUIRE, "agent");
            asm volatile("s_waitcnt vmcnt(0)" ::: "memory");
        }
    }
    __syncthreads();
}

struct Args {
    const float* in[40];
    float* out; unsigned char* ws;
    int ph_lo, ph_hi;
};
struct ArgsV {
    __device__ __forceinline__ const float* in(int i) const {
        typedef const __attribute__((address_space(4))) unsigned long long* kp_t;
        kp_t ka = (kp_t)__builtin_amdgcn_kernarg_segment_ptr();
        return (const float*)(*(volatile const __attribute__((address_space(4))) unsigned long long*)(ka + i)); }
    float* out;
};
struct Ctx {
    LAS unsigned char* lds;
    int tid, lane, wave, G, bid;
    unsigned char* ws;
};
enum { I_X = 0, I_C, I_CTX, I_CCTX, I_WMOD, I_BMOD, I_N1G, I_N2G, I_WIN, I_S5ARE, I_S5AIM, I_S5STEP, I_S5BRE, I_S5BIM, I_S5CRE, I_S5CIM,
       I_S5D, I_GLUW, I_GLUB, I_HYCW, I_HYCB, I_HYW1, I_HYB1, I_HYF1, I_HYW2, I_HYB2, I_HYF2, I_HYW3, I_HYB3, I_HYBIAS,
       I_GLAWG, I_GLABG, I_GLANG, I_WBR, I_WOUT, I_WUP, I_FFCW, I_FFCB, I_WDN, I_FNG };

namespace pg8 {
constexpr int BM = 256, BK = 64, HALF = 128, HTB = HALF * BK * 2, STAGE_BYTES = 8 * HTB, NXCD = 8, WGM = 8;
__device__ __forceinline__ int lds_byte(int r, int c) { const int st = (r >> 4) * 2 + (c >> 5), rr = r & 15, cc = c & 31, ob = rr * 64 + cc * 2; return st * 1024 + (ob ^ (((ob >> 9) & 1) << 5)); }
__device__ __forceinline__ void stage_rc(int b, int& R, int& C) { const int st = b / 1024, sb = b % 1024, swz = sb ^ (((sb >> 9) & 1) << 5); R = (st >> 1) * 16 + swz / 64; C = (st & 1) * 32 + (swz % 64) / 2; }
__device__ __forceinline__ int perm32(int rho) { const int n = rho >> 4, i = rho & 15; return 8 * (i >> 2) + 4 * n + (i & 3); }
struct Unit { const char* a; const char* b; int pm, pn; };
struct Order2D {
    int nM, nN, nwg, G, c;
    __device__ __forceinline__ void init(int nM_, int nN_, int G_, int c_) { nM = nM_; nN = nN_; nwg = nM * nN; G = G_; c = c_; }
    __device__ __forceinline__ bool nx(int i, int& pm, int& pn) const {
        const long L = (long)i * G + c; if (L >= nwg) return false;
        int wgid = (int)L; { const int q = nwg / NXCD, r = nwg % NXCD, xcd = wgid % NXCD, off = wgid / NXCD; wgid = (xcd < r ? xcd * (q + 1) : r * (q + 1) + (xcd - r) * q) + off; }
        const int nig = WGM * nN, gid = wgid / nig, fm = gid * WGM, gsz = (nM - fm) < WGM ? (nM - fm) : WGM;
        pm = fm + ((wgid % nig) % gsz); pn = (wgid % nig) / gsz; return true;
    }
};
struct SchedPlain : Order2D {
    const char* A; const char* B; size_t aTile, bTile;
    __device__ __forceinline__ bool next(int i, Unit& u) const { int pm, pn; if (!nx(i, pm, pn)) return false; u.pm = pm; u.pn = pn; u.a = A + (size_t)pm * aTile; u.b = B + (size_t)pn * bTile; return true; }
};
struct SchedSplit {
    const char* A; const char* B; size_t aTile, bTile, ksub; int nsplit, G, c;
    __device__ __forceinline__ bool next(int i, Unit& u) const { const int L = i * G + c; if (L >= 16 * nsplit) return false; const int t = L / nsplit, ks = L % nsplit, pm = 64 + (t >> 3), pn = t & 7;
        u.pm = pm; u.pn = pn | (ks << 8); u.a = A + (size_t)pm * aTile + (size_t)ks * ksub; u.b = B + (size_t)pn * bTile + (size_t)ks * ksub; return true; }
};
struct SchedS5 {
    const char* A; const char* B; size_t bGroup; int G, c;
    __device__ __forceinline__ bool next(int i, Unit& u) const { const int L = i * G + c; if (L >= 160) return false; const int g = L & 31, pm = L >> 5;
        u.pm = pm; u.pn = g; u.a = A + ((size_t)pm * 256 * 16384 + (size_t)g * 512) * 2; u.b = B + (size_t)g * bGroup; return true; }
};

#define PG8_SA(b, h) (((b) * 2 + (h)) * HTB)
#define PG8_SB(b, h) ((4 + (b) * 2 + (h)) * HTB)
#define PG8_STAGE(bufoff, gbase, voff) do { _Pragma("unroll") for (int _i = 0; _i < 2; ++_i) \
        __builtin_amdgcn_global_load_lds((const unsigned*)((const char*)(gbase) + (voff)[_i]), (LAS unsigned*)(lds + (bufoff) + ldsw + _i * 8192), 16, 0, 0); } while (0)
#define PG8_LDA(dst, b, h) do { _Pragma("unroll") for (int m = 0; m < 4; ++m) _Pragma("unroll") for (int k = 0; k < 2; ++k) dst[m][k] = *(const LAS f16x8*)(lds + PG8_SA(b, h) + aoff + m * 2048 + k * 1024); } while (0)
#define PG8_LDB(dst, b, h) do { _Pragma("unroll") for (int n = 0; n < 2; ++n) _Pragma("unroll") for (int k = 0; k < 2; ++k) dst[n][k] = *(const LAS f16x8*)(lds + PG8_SB(b, h) + boff + n * 2048 + k * 1024); } while (0)
#define PG8_MMA(ai, bj, At, Bt) do { __builtin_amdgcn_s_setprio(1); _Pragma("unroll") for (int m = 0; m < 4; ++m) _Pragma("unroll") for (int n = 0; n < 2; ++n) _Pragma("unroll") for (int k = 0; k < 2; ++k) \
        acc[ai][bj][m][n] = __builtin_amdgcn_mfma_f32_16x16x32_f16(Bt[n][k], At[m][k], acc[ai][bj][m][n], 0, 0, 0); __builtin_amdgcn_s_setprio(0); } while (0)
#define PG8_WAIT_V(n) asm volatile("s_waitcnt vmcnt(" #n ")" ::: "memory")
#define PG8_WAIT_L(n) asm volatile("s_waitcnt lgkmcnt(" #n ")" ::: "memory")
#define PG8_BAR __builtin_amdgcn_s_barrier()
#define PG8_SCHED __builtin_amdgcn_sched_barrier(0)

template <class Epi, class Sched>
__device__ __forceinline__ void gemm_phase(LAS unsigned char* lds, const int lda, const int ldb, const int nt, const Sched& S, const Epi& E) {
    const int tid = opq((int)threadIdx.x), wid = __builtin_amdgcn_readfirstlane(tid >> 6), lane = tid & 63, wr = wid >> 2, wc = wid & 3, fr = lane & 15, fq = lane >> 4;
    unsigned voffA[2], voffB[2];
#pragma unroll
    for (int i = 0; i < 2; ++i) { int R, C; stage_rc(tid * 16 + i * 8192, R, C); const int Rb = Epi::PERM ? ((R & ~31) + perm32(R & 31)) : R;
        voffA[i] = (unsigned)(R * lda + C) * 2u; voffB[i] = (unsigned)(Rb * ldb + C) * 2u; }
    const size_t kstep = (size_t)(BK * 2);
    const size_t hstepA = (size_t)HALF * lda * 2, hstepB = (size_t)HALF * ldb * 2;
    const unsigned ldsw = (unsigned)wid * 1024u;
    const int aoff = lds_byte(wr * 64 + fr, fq * 8), boff = lds_byte(wc * 32 + fr, fq * 8);
    Unit cur, nxt; int ui = 0;
    if (!S.next(0, cur)) return;
    f32x4 acc[2][2][4][2];
#pragma unroll
    for (int a = 0; a < 2; ++a)
#pragma unroll
        for (int b = 0; b < 2; ++b)
#pragma unroll
            for (int m = 0; m < 4; ++m)
#pragma unroll
                for (int n = 0; n < 2; ++n) acc[a][b][m][n] = (f32x4){0.f, 0.f, 0.f, 0.f};
    f16x8 At[4][2], B0[2][2], B1[2][2];
    const char* cA = cur.a; const char* cB = cur.b;
    PG8_STAGE(PG8_SB(0, 0), cB, voffB); PG8_STAGE(PG8_SA(0, 0), cA, voffA); PG8_STAGE(PG8_SB(0, 1), cB + hstepB, voffB); PG8_STAGE(PG8_SA(0, 1), cA + hstepA, voffA);
    if (wr == 1) PG8_BAR;
    PG8_WAIT_V(4); PG8_BAR;
    PG8_STAGE(PG8_SB(1, 0), cB + kstep, voffB); PG8_STAGE(PG8_SA(1, 0), cA + kstep, voffA); PG8_STAGE(PG8_SB(1, 1), cB + hstepB + kstep, voffB);
    PG8_WAIT_V(6); PG8_BAR;
    for (;;) {
        const bool has_next = S.next(ui + 1, nxt);
        const char* nA = has_next ? nxt.a : cA; const char* nB = has_next ? nxt.b : cB;
        constexpr int NSEG = Epi::HAS_MID ? 3 : 1;
#pragma unroll
        for (int seg = 0; seg < NSEG; ++seg) {
        const int tb = Epi::HAS_MID ? (seg == 0 ? 0 : (seg == 1 ? Epi::MID1 + 2 : Epi::MID2 + 2)) : 0;
        const int te = Epi::HAS_MID ? (seg == 0 ? Epi::MID1 + 2 : (seg == 1 ? Epi::MID2 + 2 : nt)) : nt;
        for (int t = tb; t < te; t += 2) {
            const bool last = (t == nt - 2);
            const char* a1 = cA + (size_t)(t + 1) * kstep;
            const char* a2 = last ? nA : cA + (size_t)(t + 2) * kstep; const char* b2 = last ? nB : cB + (size_t)(t + 2) * kstep;
            const char* a3 = a2 + kstep; const char* b3 = b2 + kstep;
            PG8_LDB(B0, 0, 0); PG8_SCHED; PG8_LDA(At, 0, 0); PG8_STAGE(PG8_SA(1, 1), a1 + hstepA, voffA);
            PG8_WAIT_L(8); PG8_BAR; PG8_WAIT_L(0); PG8_MMA(0, 0, At, B0); PG8_BAR; PG8_SCHED;
            PG8_LDB(B1, 0, 1); PG8_STAGE(PG8_SB(0, 0), b2, voffB);
            PG8_BAR; PG8_WAIT_L(0); PG8_MMA(0, 1, At, B1); PG8_BAR;
            PG8_LDA(At, 0, 1); PG8_STAGE(PG8_SA(0, 0), a2, voffA);
            PG8_BAR; PG8_WAIT_L(0); PG8_MMA(1, 0, At, B0); PG8_BAR; PG8_SCHED;
            PG8_STAGE(PG8_SB(0, 1), b2 + hstepB, voffB);
            PG8_WAIT_V(6); PG8_BAR; PG8_MMA(1, 1, At, B1); PG8_BAR;
            PG8_LDB(B0, 1, 0); PG8_SCHED; PG8_LDA(At, 1, 0); PG8_STAGE(PG8_SA(0, 1), a2 + hstepA, voffA);
            PG8_WAIT_L(8); PG8_BAR; PG8_WAIT_L(0); PG8_MMA(0, 0, At, B0); PG8_BAR; PG8_SCHED;
            PG8_LDB(B1, 1, 1); PG8_STAGE(PG8_SB(1, 0), b3, voffB);
            PG8_BAR; PG8_WAIT_L(0); PG8_MMA(0, 1, At, B1); PG8_BAR;
            PG8_LDA(At, 1, 1); PG8_STAGE(PG8_SA(1, 0), a3, voffA);
            PG8_BAR; PG8_WAIT_L(0); PG8_MMA(1, 0, At, B0); PG8_BAR; PG8_SCHED;
            PG8_STAGE(PG8_SB(1, 1), b3 + hstepB, voffB);
            PG8_WAIT_V(6); PG8_BAR; PG8_MMA(1, 1, At, B1); PG8_BAR;
        }
        if constexpr (Epi::HAS_MID) { if (seg < 2) {
            E.mid(acc, cur, seg, wr, wc, fr, fq);
        } }
        }
#if STAMP_MASK & (1 << 23)
        if (Epi::HAS_MID && blockIdx.x == 0 && threadIdx.x == 0) ((volatile LAS unsigned long long*)(lds + LDSCTL_OFF + 128))[0] = __builtin_amdgcn_s_memrealtime();
#endif
        E(acc, cur, wr, wc, fr, fq);
#if STAMP_MASK & (1 << 23)
        if (Epi::HAS_MID && blockIdx.x == 0 && threadIdx.x == 0) { volatile LAS unsigned long long* TS = (volatile LAS unsigned long long*)(lds + LDSCTL_OFF + 128); TS[1] = TS[1] + (__builtin_amdgcn_s_memrealtime() - TS[0]); }
#endif
        if (!has_next) break;
#pragma unroll
        for (int a = 0; a < 2; ++a)
#pragma unroll
            for (int b = 0; b < 2; ++b)
#pragma unroll
                for (int m = 0; m < 4; ++m)
#pragma unroll
                    for (int n = 0; n < 2; ++n) acc[a][b][m][n] = (f32x4){0.f, 0.f, 0.f, 0.f};
        cur = nxt; cA = nA; cB = nB; ++ui;
    }
    PG8_WAIT_V(0);
    if (wr == 0) PG8_BAR;
    PG8_BAR;
}
#undef PG8_SA
#undef PG8_SB
#undef PG8_STAGE
#undef PG8_LDA
#undef PG8_LDB
#undef PG8_MMA
#undef PG8_WAIT_V
#undef PG8_WAIT_L
#undef PG8_BAR
#undef PG8_SCHED

typedef const f32x4 (&AccRef)[2][2][4][2];
__device__ __forceinline__ f16x8 pack8(f32x4 a, f32x4 b) { f16x8 w; w[0] = (f16)a[0]; w[1] = (f16)a[1]; w[2] = (f16)a[2]; w[3] = (f16)a[3]; w[4] = (f16)b[0]; w[5] = (f16)b[1]; w[6] = (f16)b[2]; w[7] = (f16)b[3]; return w; }

struct EpiPx {
    static constexpr bool PERM = true, HAS_MID = false; static constexpr int MID1 = 0, MID2 = 0; f16* PX; f16* S5A; f16* ZT; f16* GTL;
    __device__ __forceinline__ void operator()(AccRef acc, const Unit& u, int wr, int wc, int fr, int fq) const { fr = opq(fr); fq = opq(fq);
        const int row0 = u.pm * BM + wr * 64 + fr, col0 = u.pn * BM + wc * 32 + 8 * fq;
#pragma unroll
        for (int ai = 0; ai < 2; ++ai)
#pragma unroll
            for (int m = 0; m < 4; ++m) { const int row = row0 + ai * HALF + m * 16;
#pragma unroll
                for (int bj = 0; bj < 2; ++bj) { const int c = col0 + bj * HALF; const f16x8 w = pack8(acc[ai][bj][m][0], acc[ai][bj][m][1]);
                    if (u.pn < 2) *(f16x8*)(S5A + (size_t)(row >> 4) * 16384 + (size_t)(c >> 4) * 512 + (row & 15) * 16 + (c & 15)) = w;
                    else if (u.pn >= 14 && u.pn < 20) {
#pragma unroll
                        for (int j = 0; j < 8; ++j) ZT[(size_t)(c - P_HY + j) * MT + row] = w[j]; }
                    else if (u.pn >= 20 && u.pn < 44) *(f16x8*)(GTL + ((size_t)(u.pn - 20) * 66 + u.pm) * 65536 + (size_t)(row - u.pm * BM) * 256 + (c - u.pn * BM)) = w;
                    else { const int pr = row < MX ? (row & ~8191) + ((row & 63) << 7) + ((row & 8191) >> 6) : row;
                        *(f16x8*)(PX + (size_t)pr * PXLD + (u.pn == 44 ? c - (W_GG - P_GG) : c)) = w; } } }
    }
};
struct EpiF16 {
    static constexpr bool PERM = true, HAS_MID = false; static constexpr int MID1 = 0, MID2 = 0; f16* O; int ldc;
    __device__ __forceinline__ void operator()(AccRef acc, const Unit& u, int wr, int wc, int fr, int fq) const { fr = opq(fr); fq = opq(fq);
        const int row0 = u.pm * BM + wr * 64 + fr, col0 = u.pn * BM + wc * 32 + 8 * fq;
#pragma unroll
        for (int ai = 0; ai < 2; ++ai)
#pragma unroll
            for (int m = 0; m < 4; ++m) { f16* rowp = O + (size_t)(row0 + ai * HALF + m * 16) * ldc + col0;
#pragma unroll
                for (int bj = 0; bj < 2; ++bj) *(f16x8*)(rowp + bj * HALF) = pack8(acc[ai][bj][m][0], acc[ai][bj][m][1]); }
    }
};
struct EpiS5In {
    static constexpr bool PERM = false, HAS_MID = false; static constexpr int MID1 = 0, MID2 = 0; float* S;
    __device__ __forceinline__ void operator()(AccRef acc, const Unit& u, int wr, int wc, int fr, int fq) const { fr = opq(fr); fq = opq(fq);
        const int row0 = u.pm * BM + wr * 64 + fr, col0 = wc * 32 + 4 * fq, g = u.pn;
#pragma unroll
        for (int ai = 0; ai < 2; ++ai)
#pragma unroll
            for (int m = 0; m < 4; ++m) { const int row = row0 + ai * HALF + m * 16; { float* rowp = S + ((size_t)row * 32 + g) * 256 + col0;
#pragma unroll
                for (int bj = 0; bj < 2; ++bj)
#pragma unroll
                    for (int n = 0; n < 2; ++n) *(f32x4*)(rowp + bj * HALF + n * 16) = acc[ai][bj][m][n]; } }
    }
};
struct EpiS5Out {
    static constexpr bool PERM = true, HAS_MID = false; static constexpr int MID1 = 0, MID2 = 0; const f16* S5A; f16* Y; const float* dvec;
    __device__ __forceinline__ void operator()(AccRef acc, const Unit& u, int wr, int wc, int fr, int fq) const { fr = opq(fr); fq = opq(fq);
        const int row0 = u.pm * BM + wr * 64 + fr, col0 = wc * 32 + 8 * fq, g = u.pn;
        const int h0 = col0 & 15;
        const f32x4 d0 = *(const f32x4*)(dvec + g * 16 + h0), d1 = *(const f32x4*)(dvec + g * 16 + h0 + 4);
#pragma unroll
        for (int ai = 0; ai < 2; ++ai) { f16x8 uu[4][2];
#pragma unroll
            for (int m = 0; m < 4; ++m)
#pragma unroll
                for (int bj = 0; bj < 2; ++bj) uu[m][bj] = *(const f16x8*)(S5A + (size_t)(row0 + ai * HALF + m * 16) * 16384 + (size_t)g * 512 + col0 + bj * HALF);
            PIN8(uu[0][0], uu[0][1], uu[1][0], uu[1][1], uu[2][0], uu[2][1], uu[3][0], uu[3][1]);
#pragma unroll
            for (int m = 0; m < 4; ++m) { const int chunk = row0 + ai * HALF + m * 16;
#pragma unroll
                for (int bj = 0; bj < 2; ++bj) { const int c = col0 + bj * HALF, t = c >> 4; f16x8 w;
#pragma unroll
                    for (int j = 0; j < 4; ++j) { w[j] = (f16)gelu_tanh_(acc[ai][bj][m][0][j] * (1.0f / S5SCALE) + d0[j] * (float)uu[m][bj][j]);
                                                  w[4 + j] = (f16)gelu_tanh_(acc[ai][bj][m][1][j] * (1.0f / S5SCALE) + d1[j] * (float)uu[m][bj][4 + j]); }
                    *(f16x8*)(Y + (size_t)(chunk * 16 + t) * 512 + g * 16 + h0) = w; } }
            asm volatile("" ::: "memory"); }
    }
};
struct EpiGlu {
    static constexpr bool PERM = true, HAS_MID = false; static constexpr int MID1 = 0, MID2 = 0; const f16* YP; f16* O; const float* bias;
    __device__ __forceinline__ void operator()(AccRef acc, const Unit& u, int wr, int wc, int fr, int fq) const { fr = opq(fr); fq = opq(fq);
        const int row0 = u.pm * BM + wr * 64 + fr, col0 = u.pn * BM + wc * 32 + 8 * fq;
        f32x4 bv[2][2];
#pragma unroll
        for (int bj = 0; bj < 2; ++bj) { bv[bj][0] = *(const f32x4*)(bias + col0 + bj * HALF); bv[bj][1] = *(const f32x4*)(bias + col0 + bj * HALF + 4); }
#pragma unroll
        for (int ai = 0; ai < 2; ++ai) { f16x8 yp[4][2];
#pragma unroll
            for (int m = 0; m < 4; ++m)
#pragma unroll
                for (int bj = 0; bj < 2; ++bj) yp[m][bj] = *(const f16x8*)(YP + (size_t)(row0 + ai * HALF + m * 16) * 512 + col0 + bj * HALF);
            PIN8(yp[0][0], yp[0][1], yp[1][0], yp[1][1], yp[2][0], yp[2][1], yp[3][0], yp[3][1]);
#pragma unroll
            for (int m = 0; m < 4; ++m)
#pragma unroll
                for (int bj = 0; bj < 2; ++bj) { f16x8 w;
#pragma unroll
                    for (int j = 0; j < 4; ++j) { w[j] = (f16)((float)yp[m][bj][j] * sigmoidf_(acc[ai][bj][m][0][j] + bv[bj][0][j])); w[4 + j] = (f16)((float)yp[m][bj][4 + j] * sigmoidf_(acc[ai][bj][m][1][j] + bv[bj][1][j])); }
                    *(f16x8*)(O + (size_t)(row0 + ai * HALF + m * 16) * 2048 + col0 + bj * HALF) = w; }
            asm volatile("" ::: "memory"); }
    }
};
template <int BR> struct EpiBranch {
    static constexpr bool PERM = true, HAS_MID = false; static constexpr int MID1 = 0, MID2 = 0; const f16* PX; f16* M;
    __device__ __forceinline__ void operator()(AccRef acc, const Unit& u, int wr, int wc, int fr, int fq) const { fr = opq(fr); fq = opq(fq);
        const int row0 = u.pm * BM + wr * 64 + fr, col0 = u.pn * BM + wc * 32 + 8 * fq;
#pragma unroll
        for (int ai = 0; ai < 2; ++ai)
#pragma unroll
            for (int m = 0; m < 4; ++m) { const int row = row0 + ai * HALF + m * 16;
#pragma unroll
                for (int bj = 0; bj < 2; ++bj) { const int c = col0 + bj * HALF;
                    const f16x8 gl = *(const f16x8*)(PX + (size_t)row * PXLD + P_MG + BR * 2048 + c);
                    f16* mp = M + (size_t)row * 2048 + c;
                    f16x8 prev; if (BR > 0) prev = *(const f16x8*)mp;
                    f16x8 w;
#pragma unroll
                    for (int j = 0; j < 4; ++j) { float v0 = sigmoidf_((float)gl[j]) * acc[ai][bj][m][0][j], v1 = sigmoidf_((float)gl[4 + j]) * acc[ai][bj][m][1][j];
                        if (BR > 0) { v0 += (float)prev[j]; v1 += (float)prev[4 + j]; } w[j] = (f16)v0; w[4 + j] = (f16)v1; }
                    *(f16x8*)mp = w; } asm volatile("" ::: "memory"); }
    }
};
typedef f32x4 (&AccMut)[2][2][4][2];

struct EpiBranchF {
    static constexpr bool PERM = true, HAS_MID = true; static constexpr int MID1 = 6, MID2 = 14;
    const f16* GTL; f16* M;
    __device__ __forceinline__ void mid(AccMut acc, const Unit& u, int seg, int wr, int wc, int fr, int fq) const { fr = opq(fr); fq = opq(fq);
        const int lrow0 = wr * 64 + fr, lcol0 = wc * 32 + 8 * fq;
        const f16* ga = GTL + ((size_t)((seg == 0 ? 0 : 8) + u.pn) * 66 + u.pm) * 65536; const f16* gb = ga + (size_t)8 * 66 * 65536;
#pragma unroll
        for (int ai = 0; ai < 2; ++ai) { f16x8 za[4][2], zb[4][2];
#pragma unroll
            for (int m = 0; m < 4; ++m)
#pragma unroll
                for (int bj = 0; bj < 2; ++bj) { const int off = (lrow0 + ai * HALF + m * 16) * 256 + lcol0 + bj * HALF; za[m][bj] = *(const f16x8*)(ga + off); zb[m][bj] = *(const f16x8*)(gb + off); }
            PIN8(za[0][0], za[0][1], za[1][0], za[1][1], za[2][0], za[2][1], za[3][0], za[3][1]); PIN8(zb[0][0], zb[0][1], zb[1][0], zb[1][1], zb[2][0], zb[2][1], zb[3][0], zb[3][1]);
#pragma unroll
            for (int m = 0; m < 4; ++m)
#pragma unroll
                for (int bj = 0; bj < 2; ++bj)
#pragma unroll
                    for (int j = 0; j < 4; ++j) { acc[ai][bj][m][0][j] *= (1.0f + __expf(-(float)zb[m][bj][j])) * __builtin_amdgcn_rcpf(1.0f + __expf(-(float)za[m][bj][j]));
                                                  acc[ai][bj][m][1][j] *= (1.0f + __expf(-(float)zb[m][bj][4 + j])) * __builtin_amdgcn_rcpf(1.0f + __expf(-(float)za[m][bj][4 + j])); }
            asm volatile("" ::: "memory"); }
    }
    __device__ __forceinline__ void operator()(AccRef acc, const Unit& u, int wr, int wc, int fr, int fq) const { fr = opq(fr); fq = opq(fq);
        const int row0 = u.pm * BM + wr * 64 + fr, col0 = u.pn * BM + wc * 32 + 8 * fq;
#pragma unroll
        for (int ai = 0; ai < 2; ++ai) { f16x8 gl[4][2];
#pragma unroll
            for (int m = 0; m < 4; ++m)
#pragma unroll
                for (int bj = 0; bj < 2; ++bj) gl[m][bj] = *(const f16x8*)(GTL + ((size_t)(16 + u.pn) * 66 + u.pm) * 65536 + (wr * 64 + fr + ai * HALF + m * 16) * 256 + wc * 32 + 8 * fq + bj * HALF);
            PIN8(gl[0][0], gl[0][1], gl[1][0], gl[1][1], gl[2][0], gl[2][1], gl[3][0], gl[3][1]);
#pragma unroll
            for (int m = 0; m < 4; ++m)
#pragma unroll
                for (int bj = 0; bj < 2; ++bj) { f16x8 w;
#pragma unroll
                    for (int j = 0; j < 4; ++j) { w[j] = (f16)(sigmoidf_((float)gl[m][bj][j]) * acc[ai][bj][m][0][j]); w[4 + j] = (f16)(sigmoidf_((float)gl[m][bj][4 + j]) * acc[ai][bj][m][1][j]); }
                    *(f16x8*)(M + (size_t)(row0 + ai * HALF + m * 16) * 2048 + col0 + bj * HALF) = w; }
            asm volatile("" ::: "memory"); }
    }
};
struct EpiUpAct {
    static constexpr bool PERM = true, HAS_MID = false; static constexpr int MID1 = 0, MID2 = 0; f16* ACT; float* HALO; const float* cw; const float* cb; LAS float* HL;
    __device__ __forceinline__ void operator()(AccRef acc, const Unit& u, int wr, int wc, int fr, int fq) const { fr = opq(fr); fq = opq(fq);
        const int lane = fq * 16 + fr;
#pragma unroll
        for (int ai = 0; ai < 2; ++ai) { LAS float* hp = HL + ((ai * 2 + wr) * 4 + wc) * 64 + 8 * fq;
            if (fr == 0) { *(LAS f32x4*)(hp) = acc[ai][0][0][0]; *(LAS f32x4*)(hp + 4) = acc[ai][0][0][1]; }
            if (fr == 15) { *(LAS f32x4*)(hp + 32) = acc[ai][0][3][0]; *(LAS f32x4*)(hp + 36) = acc[ai][0][3][1]; } }
        { float* gh = HALO + ((size_t)u.pm * 44 + u.pn) * 768 + wc * 32 + 8 * fq;
          if (wr == 0 && fr < 2) { *(f32x4*)(gh + fr * 128) = acc[0][0][0][0]; *(f32x4*)(gh + fr * 128 + 4) = acc[0][0][0][1]; }
          if (wr == 0 && fr == 0) { *(f32x4*)(gh + 4 * 128) = acc[0][1][0][0]; *(f32x4*)(gh + 4 * 128 + 4) = acc[0][1][0][1]; }
          if (wr == 1 && fr >= 14) { *(f32x4*)(gh + (fr - 12) * 128) = acc[1][0][3][0]; *(f32x4*)(gh + (fr - 12) * 128 + 4) = acc[1][0][3][1]; }
          if (wr == 1 && fr == 15) { *(f32x4*)(gh + 5 * 128) = acc[1][1][3][0]; *(f32x4*)(gh + 5 * 128 + 4) = acc[1][1][3][1]; } }
        asm volatile("s_waitcnt lgkmcnt(0)" ::: "memory"); __builtin_amdgcn_s_barrier(); __builtin_amdgcn_s_barrier(); asm volatile("" ::: "memory");
        const int colg = u.pn * 128 + wc * 32 + 8 * fq;
        const int srcR = (lane & 48) | ((fr + 15) & 15), srcL = (lane & 48) | ((fr + 1) & 15);
        const int row0 = u.pm * BM + wr * 64 + fr;
#pragma unroll
        for (int n = 0; n < 2; ++n) {
            const f32x4 w0 = *(const f32x4*)(cw + colg + 4 * n), w1 = *(const f32x4*)(cw + FFH + colg + 4 * n), w2 = *(const f32x4*)(cw + 2 * FFH + colg + 4 * n), bb = *(const f32x4*)(cb + colg + 4 * n);
#pragma unroll
            for (int ai = 0; ai < 2; ++ai) {
                const bool hasp = (wr == 1) || (ai == 1), hasn = (wr == 0) || (ai == 0);
                const LAS float* pp = HL + (((wr == 1 ? ai : 0) * 2 + (wr == 1 ? 0 : 1)) * 4 + wc) * 64 + 32 + 8 * fq + 4 * n;
                const LAS float* np = HL + (((wr == 0 ? ai : 1) * 2 + (wr == 0 ? 1 : 0)) * 4 + wc) * 64 + 8 * fq + 4 * n;
                const f32x4 hprev = hasp ? *(const LAS f32x4*)pp : (f32x4){0.f, 0.f, 0.f, 0.f}, hnext = hasn ? *(const LAS f32x4*)np : (f32x4){0.f, 0.f, 0.f, 0.f};
                f32x4 R[4], L[4];
#pragma unroll
                for (int m = 0; m < 4; ++m)
#pragma unroll
                    for (int j = 0; j < 4; ++j) { R[m][j] = __shfl(acc[ai][0][m][n][j], srcR); L[m][j] = __shfl(acc[ai][0][m][n][j], srcL); }
#pragma unroll
                for (int m = 0; m < 4; ++m) { const f32x4 pv = fr > 0 ? R[m] : (m > 0 ? R[m > 0 ? m - 1 : 0] : hprev); const f32x4 nv = fr < 15 ? L[m] : (m < 3 ? L[m < 3 ? m + 1 : 3] : hnext);
                    const f32x4 a = w0 * pv + w1 * acc[ai][0][m][n] + w2 * nv + bb;
                    f16x4 o;
#pragma unroll
                    for (int j = 0; j < 4; ++j) o[j] = (f16)(siluf_(a[j]) * acc[ai][1][m][n][j]);
                    *(f16x4*)(ACT + (size_t)(row0 + ai * HALF + m * 16) * FFH + colg + 4 * n) = o; }
                asm volatile("" ::: "memory");
            }
        }
    }
};
struct EpiSlab {
    static constexpr bool PERM = false, HAS_MID = false; static constexpr int MID1 = 0, MID2 = 0; float* slab; const float* mod; int goff;
    __device__ __forceinline__ void operator()(AccRef acc, const Unit& u, int wr, int wc, int fr, int fq) const { fr = opq(fr); fq = opq(fq);
        const int pn = u.pn & 255, ks = u.pn >> 8;
        const int row0 = (u.pm - 64) * BM + wr * 64 + fr, col0 = pn * BM + wc * 32 + 4 * fq;
        const float* gp = mod + 2 * 12288 + goff + col0;
        f32x4 gv[2][2];
#pragma unroll
        for (int bj = 0; bj < 2; ++bj)
#pragma unroll
            for (int n = 0; n < 2; ++n) gv[bj][n] = *(const f32x4*)(gp + bj * HALF + n * 16);
        float* sp = slab + (size_t)ks * MC * D;
#pragma unroll
        for (int ai = 0; ai < 2; ++ai)
#pragma unroll
            for (int m = 0; m < 4; ++m) { float* rowp = sp + (size_t)(row0 + ai * HALF + m * 16) * D + col0;
#pragma unroll
                for (int bj = 0; bj < 2; ++bj)
#pragma unroll
                    for (int n = 0; n < 2; ++n) *(f32x4*)(rowp + bj * HALF + n * 16) = gv[bj][n] * acc[ai][bj][m][n]; }
    }
};
struct EpiResid {
    static constexpr bool PERM = false, HAS_MID = false; static constexpr int MID1 = 0, MID2 = 0; float* X; const float* mod; int goff;
    __device__ __forceinline__ void operator()(AccRef acc, const Unit& u, int wr, int wc, int fr, int fq) const { fr = opq(fr); fq = opq(fq);
        const int row0 = u.pm * BM + wr * 64 + fr, col0 = u.pn * BM + wc * 32 + 4 * fq;
        const int bsel = u.pm < 32 ? 0 : (u.pm < 64 ? 1 : 2);
        const float* gp = mod + bsel * 12288 + goff + col0;
        f32x4 gv[2][2];
#pragma unroll
        for (int bj = 0; bj < 2; ++bj)
#pragma unroll
            for (int n = 0; n < 2; ++n) gv[bj][n] = *(const f32x4*)(gp + bj * HALF + n * 16);
#pragma unroll
        for (int ai = 0; ai < 2; ++ai) { f32x4 xv[4][2][2];
#pragma unroll
            for (int m = 0; m < 4; ++m) { const float* rowp = X + (size_t)(row0 + ai * HALF + m * 16) * D + col0;
#pragma unroll
                for (int bj = 0; bj < 2; ++bj)
#pragma unroll
                    for (int n = 0; n < 2; ++n) xv[m][bj][n] = *(const f32x4*)(rowp + bj * HALF + n * 16); }
            PIN8(xv[0][0][0], xv[0][0][1], xv[0][1][0], xv[0][1][1], xv[1][0][0], xv[1][0][1], xv[1][1][0], xv[1][1][1]); PIN8(xv[2][0][0], xv[2][0][1], xv[2][1][0], xv[2][1][1], xv[3][0][0], xv[3][0][1], xv[3][1][0], xv[3][1][1]);
#pragma unroll
            for (int m = 0; m < 4; ++m) { float* rowp = X + (size_t)(row0 + ai * HALF + m * 16) * D + col0;
#pragma unroll
                for (int bj = 0; bj < 2; ++bj)
#pragma unroll
                    for (int n = 0; n < 2; ++n) *(f32x4*)(rowp + bj * HALF + n * 16) = xv[m][bj][n] + gv[bj][n] * acc[ai][bj][m][n]; }
            asm volatile("" ::: "memory"); }
    }
};
}


__device__ __forceinline__ void ph_prologue(const Ctx& F, const ArgsV& AV) {
    const int gt = F.bid * 512 + F.tid, NT = F.G * 512;
    { const f32x4* xs = (const f32x4*)AV.in(I_X); const f32x4* cs = (const f32x4*)AV.in(I_CTX); f32x4* xr = (f32x4*)(F.ws + WS_XRES);
      for (int i = gt; i < MX * D / 4; i += NT) xr[i] = xs[i];
      for (int i = gt; i < MC * D / 4; i += NT) xr[MX * D / 4 + i] = cs[i]; }
    { f32x2* tw = (f32x2*)(F.ws + WS_TW);
      for (int k = gt; k < 16384; k += NT) { float s, c; sincospif((float)k * (2.0f / 16384.0f), &s, &c); tw[k] = (f32x2){c, -s}; } }
    LAS float* sc = (LAS float*)F.lds;
    LAS float* red = (LAS float*)(F.lds + 3 * 2048 * 4);
    for (int i = F.tid; i < 3 * 2048; i += 512) { const int r = i / 2048, k = i % 2048; const float v = r < 2 ? AV.in(I_C)[r * 2048 + k] : AV.in(I_CCTX)[k]; sc[i] = siluf_(v); }
    __syncthreads();
    const int col = F.tid & 63, ks = F.tid >> 6;
    for (int chunk = F.bid; chunk < DEPTH * 192; chunk += F.G) {
        const int l = chunk / 192, n0 = (chunk % 192) * 64;
        const float* w = AV.in(I_WMOD) + (size_t)l * 2048 * 12288 + n0 + col;
        float s0 = 0.f, s1 = 0.f, s2 = 0.f;
#pragma unroll 8
        for (int k = ks * 256; k < ks * 256 + 256; ++k) { const float wv = w[(size_t)k * 12288]; s0 += sc[k] * wv; s1 += sc[2048 + k] * wv; s2 += sc[4096 + k] * wv; }
        red[(ks * 3 + 0) * 64 + col] = s0; red[(ks * 3 + 1) * 64 + col] = s1; red[(ks * 3 + 2) * 64 + col] = s2;
        __syncthreads();
        if (F.tid < 192) { const int r = F.tid >> 6, c2 = F.tid & 63; float s = 0.f;
#pragma unroll
            for (int q = 0; q < 8; ++q) s += red[(q * 3 + r) * 64 + c2];
            ((float*)(F.ws + WS_MOD))[((size_t)l * 3 + r) * 12288 + n0 + c2] = s + AV.in(I_BMOD)[(size_t)l * 12288 + n0 + c2]; }
        __syncthreads();
    }
}

__device__ __forceinline__ void conv_item(const float* W, int ldw, int k0, int srccol, f16* WT, int dstrow, int ldk) {
    float v[64];
    const float* src = W + (size_t)k0 * ldw + (srccol >= 0 ? srccol : 0);
#pragma unroll
    for (int k = 0; k < 64; ++k) v[k] = src[(size_t)k * ldw];
#pragma unroll
    for (int k = 0; k < 64; k += 8) PIN8(v[k], v[k + 1], v[k + 2], v[k + 3], v[k + 4], v[k + 5], v[k + 6], v[k + 7]);
    f16* dst = WT + (size_t)dstrow * ldk + k0;
#pragma unroll
    for (int kg = 0; kg < 8; ++kg) { f16x8 o;
#pragma unroll
        for (int e = 0; e < 8; ++e) o[e] = srccol >= 0 ? (f16)v[8 * kg + e] : (f16)0.f;
        *(f16x8*)(dst + 8 * kg) = o; }
}
__device__ __forceinline__ void ph_convert_weights(const Ctx& F, const ArgsV& AV, int l) {
    const int skip = F.G > 64 ? 32 : 0;
    if (F.bid < skip) return;
    const int gw = (F.bid - skip) * 8 + F.wave, NGW = (F.G - skip) * 8, lane = F.lane;
    constexpr int I_IN = 32 * 180, I_GLU = 8 * 8, I_BR = 32 * 32, I_OUT = 32 * 32, I_UP = 32 * 176, I_DN = 88 * 32;
    constexpr int NIT = I_IN + I_GLU + I_BR + I_OUT + I_UP + I_DN;
    for (int it = gw; it < NIT; it += NGW) {
        int r = it;
        if (r < I_IN) { const int kb = r / 180, nb = r % 180, j = nb * 64 + lane;
            const int src = j < 2048 ? j : (j < 11264 ? j + 32 : (j < 11296 ? 2048 + (j - 11264) : -1));
            conv_item(AV.in(I_WIN) + (size_t)l * 2048 * INW, INW, kb * 64, src, (f16*)(F.ws + WS_WIN), j, 2048); continue; } r -= I_IN;
        if (r < I_GLU) { const int kb = r / 8, nb = r % 8, j = nb * 64 + lane; conv_item(AV.in(I_GLUW) + (size_t)l * 512 * 512, 512, kb * 64, j, (f16*)(F.ws + WS_WGLU), j, 512); continue; } r -= I_GLU;
        if (r < I_BR) { const int kb = r / 32, nb = r % 32, j = nb * 64 + lane; conv_item(AV.in(I_WBR) + (size_t)l * 2048 * 2048, 2048, kb * 64, j, (f16*)(F.ws + WS_WBR), j, 2048); continue; } r -= I_BR;
        if (r < I_OUT) { const int kb = r / 32, nb = r % 32, j = nb * 64 + lane; conv_item(AV.in(I_WOUT) + (size_t)l * 2048 * 2048, 2048, kb * 64, j, (f16*)(F.ws + WS_WOUT), j, 2048); continue; } r -= I_OUT;
        if (r < I_UP) { const int kb = r / 176, nb = r % 176, j = nb * 64 + lane, pn = j >> 8, i = j & 255; const int src = i < 128 ? 128 * pn + i : FFH + 128 * pn + (i - 128);
            conv_item(AV.in(I_WUP) + (size_t)l * 2048 * UPLD, UPLD, kb * 64, src, (f16*)(F.ws + WS_WUP), j, 2048); continue; } r -= I_UP;
        { const int kb = r / 32, nb = r % 32, j = nb * 64 + lane; conv_item(AV.in(I_WDN) + (size_t)l * FFH * 2048, 2048, kb * 64, j, (f16*)(F.ws + WS_WDN), j, FFH); }
    }
}

__device__ __forceinline__ void s5_mats_group(const Ctx& F, const ArgsV& AV, int l, int g) {
    LAS f32x2* APOW = (LAS f32x2*)F.lds;
    LAS f32x2* BBAR = APOW + 2 * 17 * 64;
    LAS f32x2* CM = BBAR + 2 * 64 * 16;
    LAS float* KLAG = (LAS float*)(CM + 2 * 16 * 64);
    __syncthreads();
    for (int i = F.tid; i < 2 * 17 * 64; i += 512) { const int d = i / (17 * 64), e = (i / 64) % 17, n = i % 64;
        const size_t pi = (((size_t)l * 2 + d) * 32 + g) * 64 + n;
        const float are = AV.in(I_S5ARE)[pi], aim = AV.in(I_S5AIM)[pi], dt = expf(AV.in(I_S5STEP)[((size_t)l * 2 + d) * 32 + g]);
        const float zr = are * dt * (float)e, zi = aim * dt * (float)e; float s, c; sincosf(zi, &s, &c); const float m = expf(zr);
        APOW[i] = (f32x2){m * c, m * s}; }
    __syncthreads();
    for (int i = F.tid; i < 2 * 64 * 16; i += 512) { const int d = i / 1024, n = (i / 16) % 64, h = i % 16;
        const size_t pi = (((size_t)l * 2 + d) * 32 + g) * 64 + n;
        const float are = AV.in(I_S5ARE)[pi], aim = AV.in(I_S5AIM)[pi];
        const f32x2 ab = APOW[(d * 17 + 1) * 64 + n]; const f32x2 num = (f32x2){ab.x - 1.0f, ab.y};
        const float den = are * are + aim * aim; const f32x2 q = (f32x2){(num.x * are + num.y * aim) / den, (num.y * are - num.x * aim) / den};
        const size_t bi = (pi * 16) + h;
        BBAR[i] = cmul(q, (f32x2){AV.in(I_S5BRE)[bi], AV.in(I_S5BIM)[bi]});
        const size_t ci = ((((size_t)l * 2 + d) * 32 + g) * 16 + h) * 64 + n;
        CM[(d * 16 + h) * 64 + n] = (f32x2){AV.in(I_S5CRE)[ci], AV.in(I_S5CIM)[ci]}; }
    __syncthreads();
    for (int i = F.tid; i < 2 * 16 * 256; i += 512) { const int d = i / 4096, lag = (i / 256) % 16, h = (i / 16) % 16, hp = i % 16; float s = 0.f;
        for (int n = 0; n < 64; ++n) { const f32x2 t = cmul(CM[(d * 16 + h) * 64 + n], APOW[(d * 17 + lag) * 64 + n]); const f32x2 b = BBAR[(d * 64 + n) * 16 + hp]; s += t.x * b.x - t.y * b.y; }
        KLAG[i] = s; }
    __syncthreads();
    f16* W = (f16*)(F.ws + WS_S5W) + (size_t)g * 256 * 512;
    for (int i = F.tid; i < 256 * 64; i += 512) { const int n = i / 64, k8 = (i % 64) * 8, t = n >> 4, h = n & 15; f16x8 o;
#pragma unroll
        for (int e = 0; e < 8; ++e) { const int k = k8 + e; float v;
            if (k < 256) { const int s = k >> 4, hp = k & 15; v = 0.f;
                if (t >= s) v += KLAG[((0 * 16 + (t - s)) * 16 + h) * 16 + hp];
                if (s >= t) v += KLAG[((1 * 16 + (s - t)) * 16 + h) * 16 + hp];
                v *= S5SCALE; }
            else { const int d = (k - 256) >> 7, nn2 = (k - 256) & 127, nn = nn2 & 63, im = nn2 >> 6, ex = d == 0 ? t + 1 : 16 - t;
                const f32x2 z = cmul(CM[(d * 16 + h) * 64 + nn], APOW[(d * 17 + ex) * 64 + nn]); v = im ? -z.y : z.x; }
            o[e] = (f16)v; }
        *(f16x8*)(W + (size_t)n * 512 + k8) = o; }
    f16* Mx = (f16*)(F.ws + WS_S5M) + (size_t)g * 256 * 256;
    for (int i = F.tid; i < 256 * 32; i += 512) { const int n = i / 32, k8 = (i % 32) * 8, d = n >> 7, ri = (n >> 6) & 1, nn = n & 63; f16x8 o;
#pragma unroll
        for (int e = 0; e < 8; ++e) { const int k = k8 + e, s = k >> 4, hp = k & 15, ex = d == 0 ? 15 - s : s;
            const f32x2 z = cmul(APOW[(d * 17 + ex) * 64 + nn], BBAR[(d * 64 + nn) * 16 + hp]); o[e] = (f16)((ri ? z.y : z.x) * S5SCALE); }
        *(f16x8*)(Mx + (size_t)n * 256 + k8) = o; }
    if (F.tid < 128) { const int d = F.tid >> 6, nn = F.tid & 63; ((f32x2*)(F.ws + WS_S5AT))[(d * 32 + g) * 64 + nn] = APOW[(d * 17 + 16) * 64 + nn]; }
    __syncthreads();
}

__device__ __forceinline__ void ph_hyena_h2(const Ctx& F, const ArgsV& AV, int l) {
    LAS float* W1 = (LAS float*)F.lds;
    LAS float* W2 = W1 + 33 * 64;
    LAS float* PV = W2 + 64 * 64;
    LAS float* SCR = PV + 256;
    __syncthreads();
    for (int i = F.tid; i < 33 * 64; i += 512) W1[i] = AV.in(I_HYW1)[(size_t)l * 33 * 64 + i];
    for (int i = F.tid; i < 64 * 64; i += 512) W2[i] = AV.in(I_HYW2)[(size_t)l * 4096 + i];
    if (F.tid < 64) { PV[F.tid] = AV.in(I_HYB1)[l * 64 + F.tid]; PV[64 + F.tid] = AV.in(I_HYF1)[l * 64 + F.tid]; PV[128 + F.tid] = AV.in(I_HYB2)[l * 64 + F.tid]; PV[192 + F.tid] = AV.in(I_HYF2)[l * 64 + F.tid]; }
    __syncthreads();
    LAS float* scr = SCR + F.wave * 64;
    const int gw = F.bid * 8 + F.wave, NGW = F.G * 8, j = F.lane;
    for (int p = gw; p < SEQ + LC; p += NGW) {
        const int n = p < SEQ ? SEQ : LC, pos = p < SEQ ? p : p - SEQ;
        float feat = 0.f;
        if (j == 0) feat = (float)pos / (float)(n - 1);
        else if (j < 33) { const int fi = (j - 1) & 15; const float fr = 1e-4f + (float)fi * ((15.0f - 1e-4f) / 15.0f);
            const float ang = (6.283185307179586f / (float)n) * (float)pos * fr; float s, c; sincosf(ang, &s, &c); feat = j < 17 ? c : -s; }
        scr[j] = feat; LDS_WAIT(); asm volatile("" ::: "memory");
        float a = PV[j];
        for (int i = 0; i < 33; ++i) a += scr[i] * W1[i * 64 + j];
        const float h1 = sinf(PV[64 + j] * a);
        LDS_WAIT(); asm volatile("" ::: "memory");
        scr[j] = h1; LDS_WAIT(); asm volatile("" ::: "memory");
        float b = PV[128 + j];
        for (int i = 0; i < 64; ++i) b += scr[i] * W2[i * 64 + j];
        ((f16*)(F.ws + WS_H2H))[((size_t)l * (SEQ + LC) + p) * 64 + j] = (f16)sinf(PV[192 + j] * b);
        LDS_WAIT(); asm volatile("" ::: "memory");
    }
}

__device__ __forceinline__ void ph_norm(const Ctx& F, const ArgsV& AV, int l, int which, int nrows, int nslab) {
    const int gw = F.bid * 8 + F.wave, NGW = F.G * 8;
    float* X = (float*)(F.ws + WS_XRES); f16* O = (f16*)(F.ws + WS_HN); const float* SL = (const float*)(F.ws + WS_SLAB);
    const float* gain = AV.in(which ? I_N2G : I_N1G) + (size_t)l * D;
    const float* mod = (const float*)(F.ws + WS_MOD) + (size_t)l * 3 * 12288;
    const int shoff = which ? 6144 : 0, soff = which ? 8192 : 2048;
    int cur_bsel = -1; f32x4 Am[8], Bm[8], vn[8];
    if (gw < nrows) { const f32x4* xr0 = (const f32x4*)(X + (size_t)gw * D) + F.lane;
#pragma unroll
        for (int j = 0; j < 8; ++j) vn[j] = xr0[64 * j]; }
    for (int m = gw; m < nrows; m += NGW) {
        const int bsel = m < SEQ ? 0 : (m < MX ? 1 : 2);
        f32x4* xr = (f32x4*)(X + (size_t)m * D) + F.lane;
        f32x4 v[8]; float s = 0.f;
        PIN8(vn[0], vn[1], vn[2], vn[3], vn[4], vn[5], vn[6], vn[7]);
#pragma unroll
        for (int j = 0; j < 8; ++j) v[j] = vn[j];
        if (m + NGW < nrows) { const f32x4* xq = (const f32x4*)(X + (size_t)(m + NGW) * D) + F.lane;
#pragma unroll
            for (int j = 0; j < 8; ++j) vn[j] = xq[64 * j]; }
        if (bsel != cur_bsel) { cur_bsel = bsel; const float* mp = mod + bsel * 12288;
#pragma unroll
            for (int j = 0; j < 8; ++j) { const int c = 4 * F.lane + 256 * j; const f32x4 g = *(const f32x4*)(gain + c), sc = *(const f32x4*)(mp + soff + c); Bm[j] = *(const f32x4*)(mp + shoff + c); Am[j] = g * (sc + 1.0f); }
            PIN8(Am[0], Am[1], Am[2], Am[3], Am[4], Am[5], Am[6], Am[7]); PIN8(Bm[0], Bm[1], Bm[2], Bm[3], Bm[4], Bm[5], Bm[6], Bm[7]); }
        if (m >= MX && nslab > 0) {
            for (int sl = 0; sl < nslab; ++sl) { const f32x4* sr = (const f32x4*)(SL + ((size_t)sl * MC + (m - MX)) * D) + F.lane;
#pragma unroll
                for (int j = 0; j < 8; ++j) v[j] = v[j] + sr[64 * j]; }
#pragma unroll
            for (int j = 0; j < 8; ++j) xr[64 * j] = v[j]; }
#pragma unroll
        for (int j = 0; j < 8; ++j) s += (v[j].x * v[j].x + v[j].y * v[j].y) + (v[j].z * v[j].z + v[j].w * v[j].w);
        const float rstd = 1.0f / sqrtf(wave_sum(s) * (1.0f / D) + EPS);
#pragma unroll
        for (int j = 0; j < 8; ++j) { const int c = 4 * F.lane + 256 * j;
            f16x4 o;
#pragma unroll
            for (int e = 0; e < 4; ++e) o[e] = (f16)(v[j][e] * rstd * Am[j][e] + Bm[j][e]);
            *(f16x4*)(O + (size_t)m * D + c) = o; }
    }
}
__device__ __forceinline__ void ph_final_norm(const Ctx& F, const ArgsV& AV) {
    const int gw = F.bid * 8 + F.wave, NGW = F.G * 8;
    const float* X = (const float*)(F.ws + WS_XRES); const float* gain = AV.in(I_FNG);
    f32x4 gm[8], vn[8];
#pragma unroll
    for (int j = 0; j < 8; ++j) gm[j] = *(const f32x4*)(gain + 4 * F.lane + 256 * j);
    if (gw < MX) { const f32x4* xr0 = (const f32x4*)(X + (size_t)gw * D) + F.lane;
#pragma unroll
        for (int j = 0; j < 8; ++j) vn[j] = xr0[64 * j]; }
    for (int m = gw; m < MX; m += NGW) {
        f32x4 v[8]; float s = 0.f;
        PIN8(vn[0], vn[1], vn[2], vn[3], vn[4], vn[5], vn[6], vn[7]);
#pragma unroll
        for (int j = 0; j < 8; ++j) v[j] = vn[j];
        if (m + NGW < MX) { const f32x4* xq = (const f32x4*)(X + (size_t)(m + NGW) * D) + F.lane;
#pragma unroll
            for (int j = 0; j < 8; ++j) vn[j] = xq[64 * j]; }
#pragma unroll
        for (int j = 0; j < 8; ++j) s += (v[j].x * v[j].x + v[j].y * v[j].y) + (v[j].z * v[j].z + v[j].w * v[j].w);
        const float rstd = 1.0f / sqrtf(wave_sum(s) * (1.0f / D) + EPS);
#pragma unroll
        for (int j = 0; j < 8; ++j) { const int c = 4 * F.lane + 256 * j;
            *(f32x4*)(AV.out + (size_t)m * D + c) = v[j] * rstd * gm[j]; }
    }
}

__device__ __forceinline__ void ph_s5_scan(const Ctx& F) {
    if (F.tid >= 32) return;
    const float* S = (const float*)(F.ws + WS_S5S); f16* SA = (f16*)(F.ws + WS_S5A);
    for (int gt = F.bid * 32 + F.tid; gt < 2 * 2 * 32 * 64; gt += F.G * 32) {
        const int nn = gt & 63, g = (gt >> 6) & 31, d = (gt >> 11) & 1, b = gt >> 12;
        const f32x2 at = ((const f32x2*)(F.ws + WS_S5AT))[(d * 32 + g) * 64 + nn];
        f32x2 st = (f32x2){0.f, 0.f};
        f32x2 la[16], lb[16];
#define S5_CHUNK(step) ((d == 0) ? ((step) < 16 ? 1024 + b * 16 + (step) : b * 512 + ((step) - 16)) : ((step) < 16 ? 1024 + b * 16 + (15 - (step)) : b * 512 + (511 - ((step) - 16))))
#define S5_LOAD(dst, base) do { _Pragma("unroll") for (int u = 0; u < 16; ++u) { const int stp = (base) + u < 528 ? (base) + u : 527; const size_t so = ((size_t)S5_CHUNK(stp) * 32 + g) * 256 + d * 128 + nn; dst[u] = (f32x2){S[so], S[so + 64]}; } } while (0)
#define S5_STEP(src, base) do { PIN8(src[0], src[1], src[2], src[3], src[4], src[5], src[6], src[7]); PIN8(src[8], src[9], src[10], src[11], src[12], src[13], src[14], src[15]); \
            _Pragma("unroll") for (int u = 0; u < 16; ++u) { f16* xp = SA + (size_t)S5_CHUNK((base) + u) * 16384 + (size_t)g * 512 + 256 + d * 128 + nn; xp[0] = (f16)st.x; xp[64] = (f16)st.y; st = cmul(at, st) + src[u]; } } while (0)
        S5_LOAD(la, 0);
        for (int base = 0; base < 528; base += 32) {
            S5_LOAD(lb, base + 16);
            S5_STEP(la, base);
            if (base + 16 < 528) { S5_LOAD(la, base + 32); S5_STEP(lb, base + 16); }
        }
#undef S5_CHUNK
#undef S5_LOAD
#undef S5_STEP
    }
}

__device__ __forceinline__ void ph_ffn_fix(const Ctx& F, const ArgsV& AV, int l, int nMr) {
    const float* HALO = (const float*)(F.ws + WS_HALO); f16* ACT = (f16*)(F.ws + WS_ACT);
    const float* cw = AV.in(I_FFCW) + (size_t)l * 3 * FFH; const float* cb = AV.in(I_FFCB) + (size_t)l * FFH;
    const int NT = nMr * 44 * 2 * 128;
    for (int task = F.bid * 512 + F.tid; task < NT; task += F.G * 512) {
        const int c = task & 127, which = (task >> 7) & 1, tile = task >> 8, pn = tile % 44, pm = tile / 44;
        const float* h = HALO + ((size_t)pm * 44 + pn) * 768 + c; const int col = pn * 128 + c;
        const bool first = (pm == 0 || pm == 32 || pm >= 64), last = (pm == 31 || pm >= 63);
        float ap, ac, an, b;
        if (which == 0) { ap = first ? 0.f : HALO[((size_t)(pm - 1) * 44 + pn) * 768 + 3 * 128 + c]; ac = h[0]; an = h[128]; b = h[4 * 128]; }
        else { ap = h[2 * 128]; ac = h[3 * 128]; an = last ? 0.f : HALO[((size_t)(pm + 1) * 44 + pn) * 768 + c]; b = h[5 * 128]; }
        const float a = cw[col] * ap + cw[FFH + col] * ac + cw[2 * FFH + col] * an + cb[col];
        ACT[(size_t)(pm * 256 + (which ? 255 : 0)) * FFH + col] = (f16)(siluf_(a) * b);
    }
}

namespace gla {
constexpr int QK_LD = 136, KH_LD = 72, VT_LD = 72, P_LD = 72;
constexpr int OFF_QT = 0;
constexpr int OFF_KT = 17408;
constexpr int OFF_VT = OFF_KT + 18432;
constexpr int OFF_P = OFF_VT + 36864;
constexpr int OFF_LR = OFF_P + 9216;
constexpr int OFF_GT = OFF_LR + 4096;
constexpr int OFF_DEC = OFF_GT + 2048;
constexpr int OFF_RS = OFF_DEC + 512;
constexpr int OFF_QR = OFF_RS + 2048;
constexpr int OFF_KR = OFF_QR + 17408;
constexpr int OFF_WG = OFF_KR + 17408;
static_assert(OFF_WG + 8192 <= LDSCTL_OFF, "gla lds");

__device__ __forceinline__ int grow(int b, int sc, int j, int i) {
    if (sc < 32) { const int col = 2 * sc + (j >> 1), r = (j & 1) * 64 + i; return b * SEQ + r * 64 + col; }
    return MX + b * LC + j * 64 + i;
}
__device__ __forceinline__ int prow(int b, int sc, int j, int i) {
    return sc < 32 ? b * SEQ + sc * 256 + j * 64 + i : MX + b * LC + j * 64 + i;
}
#define GLA_MFMA(a, b, c) __builtin_amdgcn_mfma_f32_16x16x32_f16(a, b, c, 0, 0, 0)

template <bool FULL>
__device__ __forceinline__ void gla_unit(const Ctx& F, const ArgsV& AV, int l, int unit) {
    const int b = unit / (4 * NSC), h = (unit / NSC) % 4, sc = unit % NSC;
    LAS f16* QT = (LAS f16*)(F.lds + OFF_QT); LAS f16* KT = (LAS f16*)(F.lds + OFF_KT); LAS f16* VT = (LAS f16*)(F.lds + OFF_VT);
    LAS f16* PP = (LAS f16*)(F.lds + OFF_P); LAS f16* LR = (LAS f16*)(F.lds + OFF_LR);
    LAS float* GT = (LAS float*)(F.lds + OFF_GT); LAS float* DEC = (LAS float*)(F.lds + OFF_DEC); LAS float* RS = (LAS float*)(F.lds + OFF_RS);
    LAS f16* QR = (LAS f16*)(F.lds + OFF_QR); LAS f16* KR = (LAS f16*)(F.lds + OFF_KR); LAS float* WG = (LAS float*)(F.lds + OFF_WG);
    const int tid = F.tid, lane = F.lane, w = F.wave, q0 = lane >> 4, c0 = lane & 15;
    const int dk0 = tid & 127, ig0 = tid >> 7;
    const f16* PX = (const f16*)(F.ws + WS_PX);
    const float scale = 0.08838834764831845f;
    for (int dir = 0; dir < 2; ++dir) {
        __syncthreads();
        for (int i = tid; i < 16 * 128; i += 512) WG[i] = AV.in(I_GLAWG)[(((size_t)l * 2 + dir) * 16 + (i >> 7)) * 512 + h * 128 + (i & 127)];
        const float bgv = AV.in(I_GLABG)[((size_t)l * 2 + dir) * 512 + h * 128 + dk0];
        const size_t sidx = ((((size_t)b * 4 + h) * NSC + sc) * 2 + dir);
        f32x4 accS[8][2];
        if (FULL && sc < 32) { const float* Sin = (const float*)(F.ws + WS_GSIN) + sidx * 32768; const int q = opq(q0), c = opq(c0);
#pragma unroll
            for (int dt = 0; dt < 8; ++dt)
#pragma unroll
                for (int et = 0; et < 2; ++et)
#pragma unroll
                    for (int r = 0; r < 4; ++r) accS[dt][et][r] = Sin[(16 * dt + 4 * q + r) * 256 + 32 * w + 16 * et + c];
            PIN8(accS[0][0], accS[0][1], accS[1][0], accS[1][1], accS[2][0], accS[2][1], accS[3][0], accS[3][1]); PIN8(accS[4][0], accS[4][1], accS[5][0], accS[5][1], accS[6][0], accS[6][1], accS[7][0], accS[7][1]); }
        else {
#pragma unroll
            for (int dt = 0; dt < 8; ++dt)
#pragma unroll
                for (int et = 0; et < 2; ++et) accS[dt][et] = (f32x4){0.f, 0.f, 0.f, 0.f}; }
        float sumtot = 0.f;
#define GLA_FETCH(jn) f16x8 pf_lr, pf_v[4], pf_k[2], pf_q[2]; do { const int tf = opq(F.tid); \
            { const int row = (tf & 255) >> 2, part = tf & 3; pf_lr = *(const f16x8*)(PX + (size_t)prow(b, sc, (jn), row) * PXLD + P_GG + part * 8); } \
            _Pragma("unroll") for (int k = 0; k < 4; ++k) { const int idx = tf + 512 * k, wi = idx >> 6, ln = idx & 63, rr = ln >> 2, cc = ln & 3; const int row = (wi & 3) * 16 + rr, chunk = (wi >> 2) * 4 + cc; \
                pf_v[k] = *(const f16x8*)(PX + (size_t)prow(b, sc, (jn), row) * PXLD + P_GV + h * 256 + chunk * 8); } \
            _Pragma("unroll") for (int k = 0; k < 2; ++k) { const int idx = tf + 512 * k, row = idx >> 4, ch = idx & 15; const size_t ro = (size_t)prow(b, sc, (jn), row) * PXLD; \
                pf_k[k] = *(const f16x8*)(PX + ro + P_GK + h * 128 + ch * 8); if (FULL) pf_q[k] = *(const f16x8*)(PX + ro + P_GQ + h * 128 + ch * 8); else pf_q[k] = pf_k[k]; } } while (0)
        for (int jj = 0; jj < 4; ++jj) {
            const int j = dir ? 3 - jj : jj;
            if (FULL) {
            GLA_FETCH(j);
            __syncthreads();
            const int tid = opq(F.tid);
            PIN8(pf_lr, pf_v[0], pf_v[1], pf_v[2], pf_v[3], pf_k[0], pf_k[1], pf_q[0]); asm volatile("" : "+v"(pf_q[1]));
            if (tid < 256) { const int row = tid >> 2, part = tid & 3; *(LAS f16x8*)(LR + row * 32 + part * 8) = pf_lr; }
#pragma unroll
            for (int k = 0; k < 4; ++k) { const int idx = opq(tid) + 512 * k, wi = idx >> 6, ln = idx & 63, rr = ln >> 2, cc = ln & 3;
                const int row = (wi & 3) * 16 + rr, chunk = (wi >> 2) * 4 + cc; LAS f16* vp = VT + (chunk * 8) * VT_LD + row;
#pragma unroll
                for (int e = 0; e < 8; ++e) vp[e * VT_LD] = pf_v[k][e]; }
#pragma unroll
            for (int k = 0; k < 2; ++k) { const int idx = tid + 512 * k, row = idx >> 4, ch = idx & 15;
                *(LAS f16x8*)(KR + row * QK_LD + ch * 8) = pf_k[k];
                *(LAS f16x8*)(QR + row * QK_LD + ch * 8) = pf_q[k]; }
            } else {
            __syncthreads();
            const int tid = opq(F.tid);
            if (tid < 256) { const int row = tid >> 2, part = tid & 3; const int gr = prow(b, sc, j, row);
                *(LAS f16x8*)(LR + row * 32 + part * 8) = *(const f16x8*)(PX + (size_t)gr * PXLD + P_GG + part * 8); }
#pragma unroll 1
            for (int k = 0; k < 4; ++k) { const int idx = tid + 512 * k, wi = idx >> 6, ln = idx & 63, rr = ln >> 2, cc = ln & 3;
                const int row = (wi & 3) * 16 + rr, chunk = (wi >> 2) * 4 + cc; const int gr = prow(b, sc, j, row);
                const f16x8 v8 = *(const f16x8*)(PX + (size_t)gr * PXLD + P_GV + h * 256 + chunk * 8);
#pragma unroll
                for (int e = 0; e < 8; ++e) VT[(chunk * 8 + e) * VT_LD + row] = v8[e]; }
#pragma unroll 1
            for (int k = 0; k < 2; ++k) { const int idx = tid + 512 * k, row = idx >> 4, ch = idx & 15; const int gr = prow(b, sc, j, row);
                *(LAS f16x8*)(KR + row * QK_LD + ch * 8) = *(const f16x8*)(PX + (size_t)gr * PXLD + P_GK + h * 128 + ch * 8); }
            }
            __syncthreads();
            const int dk = opq(dk0), ig = opq(ig0);
            float bv[16];
#pragma unroll
            for (int ii = 0; ii < 16; ++ii) { const int i = ig * 16 + ii; float pre = bgv;
                const f16x8 l0 = *(const LAS f16x8*)(LR + i * 32 + dir * 16), l1 = *(const LAS f16x8*)(LR + i * 32 + dir * 16 + 8);
#pragma unroll
                for (int r = 0; r < 8; ++r) pre += (float)l0[r] * WG[r * 128 + dk] + (float)l1[r] * WG[(8 + r) * 128 + dk];
                bv[ii] = logsigmoidf_(pre) * (1.0f / 16.0f); }
            float totloc;
            if (dir == 0) {
#pragma unroll
                for (int ii = 1; ii < 16; ++ii) bv[ii] += bv[ii - 1];
                totloc = bv[15]; }
            else {
#pragma unroll
                for (int ii = 14; ii >= 0; --ii) bv[ii] += bv[ii + 1];
                totloc = bv[0]; }
            GT[ig * 128 + dk] = totloc;
            __syncthreads();
            const float g0 = GT[dk], g1 = GT[128 + dk], g2 = GT[256 + dk], g3 = GT[384 + dk];
            const float total = (g0 + g1) + (g2 + g3);
            float off, bmid;
            if (dir == 0) { off = (ig > 0 ? g0 : 0.f) + (ig > 1 ? g1 : 0.f) + (ig > 2 ? g2 : 0.f); bmid = g0 + g1; }
            else { off = (ig < 3 ? g3 : 0.f) + (ig < 2 ? g2 : 0.f) + (ig < 1 ? g1 : 0.f); bmid = g2 + g3; }
#pragma unroll
            for (int ii = 0; ii < 16; ++ii) bv[ii] += off;
            if (FULL) {
#pragma unroll
                for (int ii = 0; ii < 16; ++ii) { const int i = ig * 16 + ii;
                    QT[i * QK_LD + dk] = (f16)((float)QR[i * QK_LD + dk] * scale * __expf(fminf(bv[ii] - bmid, 9.f)));
                    KT[i * QK_LD + dk] = (f16)((float)KR[i * QK_LD + dk] * __expf(fminf(bmid - bv[ii], 9.f))); }
                __syncthreads();
                { const int c = opq(c0), q = opq(q0);
#pragma unroll
                for (int s = 0; s < 2; ++s) { const int T = 2 * w + s, it = T >> 2, jt = T & 3; f32x4 a = (f32x4){0.f, 0.f, 0.f, 0.f};
#pragma unroll
                    for (int kk = 0; kk < 4; ++kk) { const f16x8 kf = *(const LAS f16x8*)(KT + (jt * 16 + c) * QK_LD + kk * 32 + 8 * q);
                        const f16x8 qf = *(const LAS f16x8*)(QT + (it * 16 + c) * QK_LD + kk * 32 + 8 * q); a = GLA_MFMA(kf, qf, a); }
                    const int i = it * 16 + c; f16x4 pv;
#pragma unroll
                    for (int r = 0; r < 4; ++r) { const int jx = jt * 16 + 4 * q + r; const bool keep = dir == 0 ? (jx <= i) : (jx >= i); pv[r] = keep ? (f16)a[r] : (f16)0.f; }
                    *(LAS f16x4*)(PP + i * P_LD + jt * 16 + 4 * q) = pv; } }
                __syncthreads();
#pragma unroll
                for (int ii = 0; ii < 16; ++ii) { const int i = ig * 16 + ii; QT[i * QK_LD + dk] = (f16)((float)QR[i * QK_LD + dk] * scale * __expf(bv[ii])); }
            }
            { f16x8 k0, k1;
#pragma unroll
              for (int ii = 0; ii < 8; ++ii) { k0[ii] = (f16)((float)KR[(ig * 16 + ii) * QK_LD + dk] * __expf(total - bv[ii])); k1[ii] = (f16)((float)KR[(ig * 16 + 8 + ii) * QK_LD + dk] * __expf(total - bv[8 + ii])); }
              *(LAS f16x8*)(KT + dk * KH_LD + ig * 16) = k0; *(LAS f16x8*)(KT + dk * KH_LD + ig * 16 + 8) = k1; }
            if (ig == 0) { DEC[dk] = __expf(total); sumtot += total; }
            __syncthreads();
            const int c = opq(c0), q = opq(q0);
            if (FULL) {
                f32x4 accO[4][2];
#pragma unroll
                for (int it = 0; it < 4; ++it)
#pragma unroll
                    for (int et = 0; et < 2; ++et) accO[it][et] = (f32x4){0.f, 0.f, 0.f, 0.f};
#pragma unroll
                for (int et = 0; et < 2; ++et)
#pragma unroll
                    for (int kk = 0; kk < 2; ++kk) { const f16x8 vf = *(const LAS f16x8*)(VT + (32 * w + 16 * et + c) * VT_LD + kk * 32 + 8 * q);
#pragma unroll
                        for (int it = 0; it < 4; ++it) { const f16x8 pf = *(const LAS f16x8*)(PP + (it * 16 + c) * P_LD + kk * 32 + 8 * q); accO[it][et] = GLA_MFMA(vf, pf, accO[it][et]); } asm volatile("" ::: "memory"); }
#pragma unroll
                for (int kb = 0; kb < 4; ++kb)
#pragma unroll
                    for (int et = 0; et < 2; ++et) { f16x8 sf; asm volatile("" ::: "memory");
#pragma unroll
                        for (int e = 0; e < 4; ++e) { sf[e] = (f16)accS[2 * kb][et][e]; sf[4 + e] = (f16)accS[2 * kb + 1][et][e]; }
#pragma unroll
                        for (int it = 0; it < 4; ++it) { const f16x4 lo = *(const LAS f16x4*)(QT + (it * 16 + c) * QK_LD + 32 * kb + 4 * q), hi = *(const LAS f16x4*)(QT + (it * 16 + c) * QK_LD + 32 * kb + 16 + 4 * q);
                            f16x8 qf; qf[0] = lo[0]; qf[1] = lo[1]; qf[2] = lo[2]; qf[3] = lo[3]; qf[4] = hi[0]; qf[5] = hi[1]; qf[6] = hi[2]; qf[7] = hi[3];
                            accO[it][et] = GLA_MFMA(sf, qf, accO[it][et]); } }
                float* OF = (float*)(F.ws + WS_GOF);
                if (dir == 0) {
#pragma unroll
                    for (int it = 0; it < 4; ++it) { const int gr = prow(b, sc, j, it * 16 + c);
#pragma unroll
                        for (int et = 0; et < 2; ++et) *(f32x4*)(OF + (size_t)gr * 1024 + h * 256 + 32 * w + 16 * et + 4 * q) = accO[it][et];
                        asm volatile("" ::: "memory"); } }
                else {
                    int grs[4]; f32x4 ofv[4][2]; f16x4 rvv[4][2];
#pragma unroll
                    for (int it = 0; it < 4; ++it) { grs[it] = prow(b, sc, j, it * 16 + c);
#pragma unroll
                        for (int et = 0; et < 2; ++et) { ofv[it][et] = *(const f32x4*)(OF + (size_t)grs[it] * 1024 + h * 256 + 32 * w + 16 * et + 4 * q);
                            rvv[it][et] = *(const f16x4*)(PX + (size_t)grs[it] * PXLD + P_GR + h * 256 + 32 * w + 16 * et + 4 * q); } }
                    PIN8(ofv[0][0], ofv[0][1], ofv[1][0], ofv[1][1], ofv[2][0], ofv[2][1], ofv[3][0], ofv[3][1]);
#pragma unroll
                    for (int it = 0; it < 4; ++it) { float ss = 0.f;
#pragma unroll
                        for (int et = 0; et < 2; ++et) { accO[it][et] = accO[it][et] + ofv[it][et];
                            ss += (accO[it][et][0] * accO[it][et][0] + accO[it][et][1] * accO[it][et][1]) + (accO[it][et][2] * accO[it][et][2] + accO[it][et][3] * accO[it][et][3]); }
                        ss += __shfl_xor(ss, 16); ss += __shfl_xor(ss, 32);
                        if (q == 0) RS[(it * 16 + c) * 8 + w] = ss; }
                    __syncthreads();
                    PIN8(rvv[0][0], rvv[0][1], rvv[1][0], rvv[1][1], rvv[2][0], rvv[2][1], rvv[3][0], rvv[3][1]);
                    const float* ng = AV.in(I_GLANG) + (size_t)l * 256;
                    f16* Y = (f16*)(F.ws + WS_YCAT);
#pragma unroll
                    for (int it = 0; it < 4; ++it) { const int i = it * 16 + c; const f32x4 ra = *(const LAS f32x4*)(RS + i * 8), rb = *(const LAS f32x4*)(RS + i * 8 + 4);
                        const float tot = ((ra[0] + ra[1]) + (ra[2] + ra[3])) + ((rb[0] + rb[1]) + (rb[2] + rb[3]));
                        const float rstd = 1.0f / sqrtf(tot * (1.0f / 256.0f) + EPS);
#pragma unroll
                        for (int et = 0; et < 2; ++et) { const int e0 = 32 * w + 16 * et + 4 * q;
                            const f32x4 gv = *(const f32x4*)(ng + e0);
                            f16x4 o;
#pragma unroll
                            for (int r = 0; r < 4; ++r) o[r] = (f16)(accO[it][et][r] * rstd * gv[r] * siluf_((float)rvv[it][et][r]));
                            *(f16x4*)(Y + (size_t)grow(b, sc, j, it * 16 + c) * 2048 + 1024 + h * 256 + e0) = o; } }
                }
            }
#pragma unroll
            for (int dt = 0; dt < 8; ++dt) { const f32x4 dv = *(const LAS f32x4*)(DEC + 16 * dt + 4 * q);
#pragma unroll
                for (int et = 0; et < 2; ++et) accS[dt][et] = accS[dt][et] * dv; }
#pragma unroll
            for (int kk = 0; kk < 2; ++kk) { f16x8 vf[2];
#pragma unroll
                for (int et = 0; et < 2; ++et) vf[et] = *(const LAS f16x8*)(VT + (32 * w + 16 * et + c) * VT_LD + kk * 32 + 8 * q);
#pragma unroll
                for (int dt = 0; dt < 8; ++dt) { const f16x8 kf = *(const LAS f16x8*)(KT + (16 * dt + c) * KH_LD + kk * 32 + 8 * q);
#pragma unroll
                    for (int et = 0; et < 2; ++et) accS[dt][et] = GLA_MFMA(kf, vf[et], accS[dt][et]); if (dt & 1) asm volatile("" ::: "memory"); } }
        }
        if (!FULL) { float* Sl = (float*)(F.ws + WS_GSLOC) + sidx * 32768; const int q = opq(q0), c = opq(c0);
#pragma unroll
            for (int dt = 0; dt < 8; ++dt)
#pragma unroll
                for (int et = 0; et < 2; ++et)
#pragma unroll
                    for (int r = 0; r < 4; ++r) Sl[(16 * dt + 4 * q + r) * 256 + 32 * w + 16 * et + c] = accS[dt][et][r];
            if (ig0 == 0) ((float*)(F.ws + WS_GDT))[sidx * 128 + dk0] = __expf(sumtot); }
        VM_WAIT();
    }
}
__device__ __forceinline__ void ph_gla_scan(const Ctx& F) {
    const float* Sl = (const float*)(F.ws + WS_GSLOC); float* Si = (float*)(F.ws + WS_GSIN); const float* Dt = (const float*)(F.ws + WS_GDT);
    if (F.tid < 64) return;
    for (int gt = F.bid * 448 + (F.tid - 64); gt < 2 * 4 * 2 * 32768; gt += F.G * 448) {
        const int e = gt & 32767, dir = (gt >> 15) & 1, h = (gt >> 16) & 3, b = gt >> 18;
        float S = 0.f;
        for (int base = 0; base < NSC; base += 11) {
            float sl[11], dt[11]; size_t ix[11];
#pragma unroll
            for (int u = 0; u < 11; ++u) { const int step = base + u; const int sc = step == 0 ? 32 : (dir == 0 ? step - 1 : 32 - step);
                const size_t idx = ((((size_t)b * 4 + h) * NSC + sc) * 2 + dir); ix[u] = idx;
                sl[u] = Sl[idx * 32768 + e]; dt[u] = Dt[idx * 128 + (e >> 8)]; }
            PIN8(sl[0], sl[1], sl[2], sl[3], sl[4], sl[5], sl[6], sl[7]); PIN8(dt[0], dt[1], dt[2], dt[3], dt[4], dt[5], dt[6], dt[7]); PIN4(sl[8], sl[9], sl[10], dt[8]); asm volatile("" : "+v"(dt[9]), "+v"(dt[10]));
#pragma unroll
            for (int u = 0; u < 11; ++u) { Si[ix[u] * 32768 + e] = S; S = dt[u] * S + sl[u]; }
        }
    }
}
#undef GLA_FETCH
#undef GLA_MFMA
}

namespace hy {
#define PADI(i) ((i) + ((i) >> 5))
constexpr int HY_BUF_BYTES = (16384 + 512) * 8;
constexpr int HY_SCR_OFF = HY_BUF_BYTES;
static_assert(HY_SCR_OFF + 2048 <= LDSCTL_OFF, "hyena lds");
__device__ __forceinline__ f32x2 twid(int k, float invN) { const float xr = (float)k * invN; return (f32x2){__builtin_amdgcn_cosf(xr), -__builtin_amdgcn_sinf(xr)}; }
__device__ __forceinline__ f32x2 mul_w16(f32x2 d, int a) {
    constexpr float c1 = 0.9238795325112867f, s1 = 0.3826834323650898f, r = 0.7071067811865476f;
    float c, s;
    switch (a & 15) {
        case 0: return d; case 4: return (f32x2){d.y, -d.x}; case 8: return (f32x2){-d.x, -d.y}; case 12: return (f32x2){-d.y, d.x};
        case 1: c = c1; s = s1; break; case 2: c = r; s = r; break; case 3: c = s1; s = c1; break;
        case 5: c = -s1; s = c1; break; case 6: c = -r; s = r; break; case 7: c = -c1; s = s1; break;
        case 9: c = -c1; s = -s1; break; case 10: c = -r; s = -r; break; case 11: c = -s1; s = -c1; break;
        case 13: c = s1; s = -c1; break; case 14: c = r; s = -r; break; default: c = c1; s = -s1; break; }
    return (f32x2){d.x * c + d.y * s, d.y * c - d.x * s};
}
template <int R> __device__ __forceinline__ void dif_pass(LAS f32x2* x, int m, int lh, int tid) {
    const int N = 1 << m; const float invN = 1.0f / (float)N; const int lg = lh - R + 1, g = 1 << lg, S = (N >> 1) >> lh;
    for (int q = tid; q < (N >> R); q += 512) { const int j = q & (g - 1), blk = q >> lg, base = (blk << (lh + 1)) + j;
        f32x2 v[1 << R];
#pragma unroll
        for (int k = 0; k < (1 << R); ++k) v[k] = x[PADI(base + k * g)];
        f32x2 w = twid(j * S, invN);
#pragma unroll
        for (int s = 0; s < R; ++s) { const int half = 1 << (R - 1 - s);
#pragma unroll
            for (int k = 0; k < (1 << R); ++k) if (!(k & half)) { const f32x2 a = v[k], b = v[k + half]; v[k] = a + b;
                v[k + half] = mul_w16(cmul(a - b, w), ((k & (half - 1)) << s) * (16 >> R)); }
            w = cmul(w, w); }
#pragma unroll
        for (int k = 0; k < (1 << R); ++k) x[PADI(base + k * g)] = v[k]; }
    __syncthreads();
}
template <int R> __device__ __forceinline__ void dit_pass(LAS f32x2* x, int m, int lh, int tid) {
    const int N = 1 << m; const float invN = 1.0f / (float)N; const int h = 1 << lh, S1 = (N >> 1) >> lh;
    for (int q = tid; q < (N >> R); q += 512) { const int j = q & (h - 1), blk = q >> lh, base = (blk << (lh + R)) + j;
        f32x2 v[1 << R];
#pragma unroll
        for (int k = 0; k < (1 << R); ++k) v[k] = x[PADI(base + k * h)];
        f32x2 wp[R]; wp[R - 1] = cconj(twid(j * (S1 >> (R - 1)), invN));
#pragma unroll
        for (int s = R - 2; s >= 0; --s) wp[s] = cmul(wp[s + 1], wp[s + 1]);
#pragma unroll
        for (int s = 0; s < R; ++s) { const int half = 1 << s;
#pragma unroll
            for (int k = 0; k < (1 << R); ++k) if (!(k & half)) { const f32x2 a = v[k];
                const f32x2 b = mul_w16(cmul(v[k + half], wp[s]), (16 - (k & (half - 1)) * (16 >> (s + 1))) & 15);
                v[k] = a + b; v[k + half] = a - b; } }
#pragma unroll
        for (int k = 0; k < (1 << R); ++k) x[PADI(base + k * h)] = v[k]; }
    __syncthreads();
}
__device__ __forceinline__ void fft_fwd(LAS f32x2* x, int m, int tid) {
    int lh = m - 1;
    while (lh + 1 >= 4) { dif_pass<4>(x, m, lh, tid); lh -= 4; }
    if (lh + 1 == 2) dif_pass<2>(x, m, 1, tid); else if (lh + 1 == 1) dif_pass<1>(x, m, 0, tid);
}
__device__ __forceinline__ void fft_inv(LAS f32x2* x, int m, int tid) {
    int lh = 0;
    while (m - lh >= 4) { dit_pass<4>(x, m, lh, tid); lh += 4; }
    if (m - lh == 2) dit_pass<2>(x, m, lh, tid); else if (m - lh == 1) dit_pass<1>(x, m, lh, tid);
}
__device__ __forceinline__ int brev(int k, int m) { return (int)(__brev((unsigned)k) >> (32 - m)); }

__device__ __forceinline__ void filt_unit(const Ctx& F, const ArgsV& AV, int l, int unit) {
    const int kind = unit >> 9, o = (unit >> 8) & 1, pair = unit & 255;
    const int n = kind ? LC : SEQ, m = kind ? 9 : 14, N = 2 * n, tid = F.tid;
    LAS f32x2* buf = (LAS f32x2*)F.lds;
    LAS float* W3 = (LAS float*)(F.lds + HY_SCR_OFF);
    LAS float* B3 = W3 + 256;
    LAS float* RED = B3 + 4;
    LAS float* INV = RED + 16;
    __syncthreads();
    if (tid < 4) { const int ci = tid; const int col = o * 1024 + (ci >> 1) * 512 + 2 * pair + (ci & 1); B3[ci] = AV.in(I_HYB3)[(size_t)l * 2048 + col]; }
    __syncthreads();
    const int lane = F.lane, q = lane >> 4, c = lane & 15;
    f16x8 wB0, wB1;
    { const int col = o * 1024 + ((c & 3) >> 1) * 512 + 2 * pair + (c & 1); const float* w3 = AV.in(I_HYW3) + (size_t)l * 64 * 2048 + col;
#pragma unroll
      for (int j = 0; j < 8; ++j) { wB0[j] = c < 4 ? (f16)w3[(size_t)(8 * q + j) * 2048] : (f16)0.f; wB1[j] = c < 4 ? (f16)w3[(size_t)(32 + 8 * q + j) * 2048] : (f16)0.f; } }
    const f16* H2H = (const f16*)(F.ws + WS_H2H) + ((size_t)l * (SEQ + LC) + (kind ? SEQ : 0)) * 64;
    const float lo = -3.0701134573253945f, hi = -15.350567286626973f;
    const float ra = fabsf(lo + (hi - lo) * (float)(2 * pair) / 511.0f), rb = fabsf(lo + (hi - lo) * (float)(2 * pair + 1) / 511.0f);
    const float rate = (c & 1) ? rb : ra, bias3 = B3[c & 3];
    float sabs = 0.f;
    for (int tile = F.wave; tile < (n >> 4); tile += 8) { const int t0 = tile * 16;
        const f16x8 a0 = *(const f16x8*)(H2H + (size_t)(t0 + c) * 64 + 8 * q), a1 = *(const f16x8*)(H2H + (size_t)(t0 + c) * 64 + 32 + 8 * q);
        f32x4 acc = (f32x4){0.f, 0.f, 0.f, 0.f};
        acc = __builtin_amdgcn_mfma_f32_16x16x32_f16(a0, wB0, acc, 0, 0, 0); acc = __builtin_amdgcn_mfma_f32_16x16x32_f16(a1, wB1, acc, 0, 0, 0);
        if (c < 4) {
#pragma unroll
            for (int i = 0; i < 4; ++i) { const int t = t0 + 4 * q + i; const float v = (acc[i] + bias3) * expf(-((float)t / (float)(n - 1)) * rate);
                LAS float* bp = (LAS float*)buf;
                if (c < 2) { bp[2 * PADI(t) + c] = v; sabs += fabsf(v); }
                else if (t >= 1) { bp[2 * PADI(N - t) + (c - 2)] = v; sabs += fabsf(v); } } }
    }
    float sa = (c == 0 || c == 2) ? sabs : 0.f, sb = (c == 1 || c == 3) ? sabs : 0.f;
    if (tid == 0) { float z0 = 0.f; asm volatile("" : "+v"(z0)); buf[PADI(n)] = (f32x2){z0, z0}; }
    sa = wave_sum(sa); sb = wave_sum(sb);
    if (F.lane == 0) { RED[F.wave * 2] = sa; RED[F.wave * 2 + 1] = sb; }
    __syncthreads();
    if (tid < 2) { float s = 0.f;
#pragma unroll
        for (int w = 0; w < 8; ++w) s += RED[w * 2 + tid];
        INV[tid] = 1.0f / (s + EPS); }
    __syncthreads();
    { const float ia = INV[0], ib = INV[1];
      for (int i = tid; i < N; i += 512) { f32x2 v = buf[PADI(i)]; v.x *= ia; v.y *= ib; buf[PADI(i)] = v; } }
    __syncthreads();
    fft_fwd(buf, m, tid);
    f32x4* out = (f32x4*)(F.ws + ((l & 1) ? WS_FSD2 : WS_FSD) + (kind ? FSD_C_OFF : 0)) + (size_t)(o * 256 + pair) * (n + 1);
    for (int u = tid; u <= n; u += 512) { const int p = u < n ? 2 * u : 1, k = brev(p, m), pn = brev((N - k) & (N - 1), m);
        const f32x2 zk = buf[PADI(p)], zn = cconj(buf[PADI(pn)]);
        const f32x2 fa = (zk + zn) * 0.5f, df = zk - zn, fb = (f32x2){df.y * 0.5f, -df.x * 0.5f};
        const f32x2 fs = (fa + fb) * 0.5f, fd = (fa - fb) * 0.5f;
        out[u] = (f32x4){fs.x, fs.y, fd.x, fd.y}; }
    __syncthreads();
}

__device__ __forceinline__ void main_unit(const Ctx& F, const ArgsV& AV, int l, int unit) {
    const int kind = unit >> 9, b = (unit >> 8) & 1, pair = unit & 255;
    const int n = kind ? LC : SEQ, m = kind ? 9 : 14, N = 2 * n, tid = F.tid;
    const int row0 = kind ? MX + b * LC : b * SEQ;
    LAS f32x2* buf = (LAS f32x2*)F.lds;
    const f16* ZT = (const f16*)(F.ws + WS_ZT) + (size_t)(2 * pair) * MT + row0;
    const float* cw = AV.in(I_HYCW) + (size_t)l * 3 * 1536 + 2 * pair; const float* cb = AV.in(I_HYCB) + (size_t)l * 1536 + 2 * pair;
    f32x2 yv[16], g1[16], g2[16];
#pragma unroll
    for (int g = 0; g < 3; ++g)
#pragma unroll
        for (int cc = 0; cc < 2; ++cc) { const float w0 = cw[g * 512 + cc], w1 = cw[1536 + g * 512 + cc], w2 = cw[3072 + g * 512 + cc], bs = cb[g * 512 + cc];
            const f16* zt = ZT + (size_t)(g * 512 + cc) * MT;
#pragma unroll
            for (int gi = 0; gi < 2; ++gi) { const int t0 = 8 * (tid + 512 * gi);
                f16x8 mv; float pv = 0.f, nv = 0.f;
#pragma unroll
                for (int e = 0; e < 8; ++e) mv[e] = (f16)0.f;
                if (t0 < n) { mv = *(const f16x8*)(zt + t0); if (t0 > 0) pv = (float)zt[t0 - 1]; if (t0 + 8 < n) nv = (float)zt[t0 + 8]; }
#pragma unroll
                for (int e = 0; e < 8; ++e) { const float zm = e == 0 ? pv : (float)mv[e == 0 ? 0 : e - 1], zc = (float)mv[e], zp = e == 7 ? nv : (float)mv[e == 7 ? 7 : e + 1];
                    const float r = w0 * zm + w1 * zc + w2 * zp + bs;
                    if (g == 0) { if (cc == 0) yv[gi * 8 + e].x = r; else yv[gi * 8 + e].y = r; }
                    else if (g == 1) { if (cc == 0) g1[gi * 8 + e].x = r; else g1[gi * 8 + e].y = r; }
                    else { if (cc == 0) g2[gi * 8 + e].x = r; else g2[gi * 8 + e].y = r; } } } }
    const float invN = 1.0f / (float)N;
#pragma unroll
    for (int o = 0; o < 2; ++o) {
        __syncthreads();
        float z0 = 0.f; asm volatile("" : "+v"(z0));
#pragma unroll
        for (int gi = 0; gi < 2; ++gi) { const int t0 = 8 * (tid + 512 * gi);
            if (t0 < n) {
#pragma unroll
                for (int e = 0; e < 8; ++e) { buf[PADI(t0 + e)] = yv[gi * 8 + e]; buf[PADI(n + t0 + e)] = (f32x2){z0, z0}; } } }
        __syncthreads();
        fft_fwd(buf, m, tid);
        const f32x4* fsd = (const f32x4*)(F.ws + ((l & 1) ? WS_FSD2 : WS_FSD) + (kind ? FSD_C_OFF : 0)) + (size_t)(o * 256 + pair) * (n + 1);
        for (int u = tid; u <= n; u += 512) { const int p = u < n ? 2 * u : 1, k = brev(p, m), pn = brev((N - k) & (N - 1), m);
            const f32x2 zk = buf[PADI(p)], zn = buf[PADI(pn)]; const f32x4 f = fsd[u]; const f32x2 fs = (f32x2){f[0], f[1]}, fd = (f32x2){f[2], f[3]};
            const f32x2 wk = cmul(zk, fs) + cmul(cconj(zn), fd), wn = cmul(zn, cconj(fs)) + cmul(cconj(zk), cconj(fd));
            buf[PADI(pn)] = wn; buf[PADI(p)] = wk; }
        __syncthreads();
        fft_inv(buf, m, tid);
        const float* hb = AV.in(I_HYBIAS) + ((size_t)l * 2 + o) * 512 + 2 * pair; const f32x2 bias = (f32x2){hb[0], hb[1]};
#pragma unroll
        for (int gi = 0; gi < 2; ++gi) { const int t0 = 8 * (tid + 512 * gi);
            if (t0 < n) {
#pragma unroll
                for (int e = 0; e < 8; ++e) { const f32x2 cv = buf[PADI(t0 + e)] * invN; const f32x2 gt = o == 0 ? g1[gi * 8 + e] : g2[gi * 8 + e];
                    yv[gi * 8 + e] = gt * (cv + yv[gi * 8 + e] * bias); } } }
    }
    f16* Y = (f16*)(F.ws + WS_YBT) + (size_t)(2 * pair) * MT + row0;
#pragma unroll
    for (int gi = 0; gi < 2; ++gi) { const int t0 = 8 * (tid + 512 * gi);
        if (t0 < n) { f16x8 oa, ob;
#pragma unroll
            for (int e = 0; e < 8; ++e) { oa[e] = (f16)yv[gi * 8 + e].x; ob[e] = (f16)yv[gi * 8 + e].y; }
            *(f16x8*)(Y + t0) = oa; *(f16x8*)(Y + MT + t0) = ob; } }
    __syncthreads();
}

__device__ __forceinline__ void ph_ybt_transpose(const Ctx& F) {
    LAS f16* T = (LAS f16*)F.lds;
    const f16* YBT = (const f16*)(F.ws + WS_YBT); f16* Y = (f16*)(F.ws + WS_YCAT);
    const bool bal = (F.G == 256);
    for (int it = 0; it < (bal ? 2 : (MT / 64 + F.G - 1) / F.G); ++it) {
        int rb;
        if (bal) { if (F.bid >= 132) rb = (F.bid - 132) + 124 * it; else if (F.bid < 16 && it == 0) rb = 248 + F.bid; else rb = -1; }
        else rb = F.bid + it * F.G;
        if (rb < 0 || rb >= MT / 64) continue;
        const int r0 = rb * 64;
        __syncthreads();
        { f16x8 tv[8];
#pragma unroll
          for (int i = 0; i < 8; ++i) tv[i] = *(const f16x8*)(YBT + (size_t)F.tid * MT + r0 + 8 * i);
          PIN8(tv[0], tv[1], tv[2], tv[3], tv[4], tv[5], tv[6], tv[7]);
#pragma unroll
          for (int i = 0; i < 8; ++i) *(LAS f16x8*)(T + F.tid * 72 + 8 * i) = tv[i]; }
        __syncthreads();
        const int row = F.tid >> 3, cg = F.tid & 7;
#pragma unroll
        for (int jj = 0; jj < 8; ++jj) { const int gidx = cg + 8 * jj; f16x8 o;
#pragma unroll
            for (int e = 0; e < 8; ++e) o[e] = T[(8 * gidx + e) * 72 + row];
            *(f16x8*)(Y + (size_t)(r0 + row) * 2048 + 512 + 8 * gidx) = o; }
    }
    __syncthreads();
}
#undef PADI
}

#ifndef PHMASK
#define PHMASK 0xFFFF
#endif
#define PH_EN(k) (((PHMASK) >> (k)) & 1)
#ifndef STAMP_MASK
#define STAMP_MASK 0
#endif
#ifndef STAMP_K
#define STAMP_K 1
#endif
#ifndef SUBMASK
#define SUBMASK 7
#endif
#define SUB_EN(k) (((SUBMASK) >> (k)) & 1)
constexpr int NPH = 2 + 12 * DEPTH;
constexpr int CW_Q = 8192;
__device__ __forceinline__ int q_pull(unsigned* ctr, volatile LAS int* slot) {
    __syncthreads();
    if (threadIdx.x == 0) *slot = (int)__hip_atomic_fetch_add(ctr, 1u, __ATOMIC_RELAXED, __HIP_MEMORY_SCOPE_AGENT);
    __syncthreads();
    return *slot;
}

__global__ void __launch_bounds__(512, 2) mk_fwd(Args args) {
    extern __shared__ __attribute__((aligned(16))) unsigned char lds_raw[];
    Ctx F; F.lds = (LAS unsigned char*)lds_raw; F.tid = threadIdx.x; F.lane = F.tid & 63; F.wave = __builtin_amdgcn_readfirstlane(F.tid >> 6);
    F.G = gridDim.x; F.bid = blockIdx.x; F.ws = args.ws;
    ArgsV AV; AV.out = args.out;
    const Ctx F0 = F;
#define FRESH() do { F.tid = opq(F0.tid); F.lane = F.tid & 63; F.wave = __builtin_amdgcn_readfirstlane(F.tid >> 6); } while (0)
    volatile LAS unsigned* MISC = (volatile LAS unsigned*)(F.lds + LDSCTL_OFF);
    if (F.tid < 64) MISC[F.tid] = 0u;
    __syncthreads();
    unsigned* barw = (unsigned*)(F.ws + WS_CTL) + CW_BAR;
    XcdBarrier bar; bar.bar = barw; bar.x = 0; bar.st = nullptr;
    const int lo = args.ph_lo, hi = args.ph_hi;
    if (hi - lo > 1) bar = xcd_barrier_post(barw, MISC + 8);
#define IN(k) (lo <= (k) && (k) < hi)
#define SEAM(k) do { if (IN(k) && IN((k) + 1)) xcd_barrier(bar); } while (0)
#if STAMP_MASK
    volatile LAS unsigned long long* TS = (volatile LAS unsigned long long*)(F.lds + LDSCTL_OFF + 128);
#define TSTART(k) do { if ((((STAMP_MASK) >> (k)) & 1) && blockIdx.x == 0 && threadIdx.x == 0) TS[0] = __builtin_amdgcn_s_memrealtime(); } while (0)
#define TSTOP(k) do { if ((((STAMP_MASK) >> (k)) & 1) && blockIdx.x == 0 && threadIdx.x == 0) TS[1] = TS[1] + (__builtin_amdgcn_s_memrealtime() - TS[0]); } while (0)
#else
#define TSTART(k) do {} while (0)
#define TSTOP(k) do {} while (0)
#endif
    unsigned char* ws = F.ws;
    const int rank160 = (F.bid + F.G - 160 % F.G) % F.G;

    TSTART(12);
    if (PH_EN(12) && IN(0)) { FRESH(); ph_prologue(F, AV); for (int l2 = 0; l2 < DEPTH; ++l2) { FRESH(); ph_hyena_h2(F, AV, l2); } }
    SEAM(0);
    TSTOP(12);

    for (int l = 0; l < DEPTH; ++l) {
        const int pb = 1 + 12 * l;
        const float* modl = (const float*)(ws + WS_MOD) + (size_t)l * 3 * 12288;
        const bool ctx_on = l < DEPTH - 1;
        const int nMr = ctx_on ? MT / 256 : MX / 256, nrows = ctx_on ? MT : MX;
        TSTART(0);
        if (PH_EN(0) && IN(pb + 0)) {
            FRESH(); ph_convert_weights(F, AV, l);
            __syncthreads();
            FRESH(); if (F.bid < 32) s5_mats_group(F, AV, l, F.bid);
            FRESH(); ph_norm(F, AV, l, 0, MT, l > 0 ? 11 : 0);
        }
        SEAM(pb + 0);
        TSTOP(0);
        TSTART(1);
        if (PH_EN(1) && IN(pb + 1)) {
            pg8::SchedPlain S; S.init(MT / 256, WINN / 256, F.G, F.bid); S.A = (const char*)(ws + WS_HN); S.B = (const char*)(ws + WS_WIN); S.aTile = (size_t)256 * 2048 * 2; S.bTile = (size_t)256 * 2048 * 2;
            pg8::EpiPx E{(f16*)(ws + WS_PX), (f16*)(ws + WS_S5A), (f16*)(ws + WS_ZT), (f16*)(ws + WS_GTL)};
            pg8::gemm_phase(F.lds, 2048, 2048, 32, S, E);
        }
        SEAM(pb + 1);
        TSTOP(1);
        TSTART(2);
        if (PH_EN(2) && IN(pb + 2)) {
            TSTART(16);
            if (SUB_EN(0)) { pg8::SchedS5 S{(const char*)(ws + WS_S5A), (const char*)(ws + WS_S5M), (size_t)256 * 256 * 2, F.G, F.bid};
              pg8::EpiS5In E{(float*)(ws + WS_S5S)};
              pg8::gemm_phase(F.lds, 16384, 256, 4, S, E); }
            TSTOP(16);
            { unsigned* qc = (unsigned*)(ws + WS_CTL) + CW_Q + (l * 2 + 0) * 64; volatile LAS int* slot = (volatile LAS int*)(MISC + 16);
              const bool pre = (l > 0 && F.G == 256);
              const int nq = 264 + (pre ? 272 : 1024);
              for (;;) { const int u = q_pull(qc, slot); if (u >= nq) break;
                  if (u < 264) { TSTART(17); FRESH(); gla::gla_unit<false>(F, AV, l, u); TSTOP(17); } else { TSTART(18); FRESH(); hy::filt_unit(F, AV, l, pre ? 240 + (u - 264) : u - 264); TSTOP(18); } } }
        }
        SEAM(pb + 2);
        TSTOP(2);
        TSTART(3);
        if (PH_EN(3) && IN(pb + 3)) { FRESH(); ph_s5_scan(F); FRESH(); gla::ph_gla_scan(F); }
        SEAM(pb + 3);
        TSTOP(3);
        TSTART(4);
        if (PH_EN(4) && IN(pb + 4)) {
            TSTART(19);
            if (SUB_EN(0)) { pg8::SchedS5 S{(const char*)(ws + WS_S5A), (const char*)(ws + WS_S5W), (size_t)256 * 512 * 2, F.G, F.bid};
              pg8::EpiS5Out E{(const f16*)(ws + WS_S5A), (f16*)(ws + WS_YAPRE), AV.in(I_S5D) + (size_t)l * 512};
              pg8::gemm_phase(F.lds, 16384, 512, 8, S, E); }
            TSTOP(19);
            { unsigned* qc = (unsigned*)(ws + WS_CTL) + CW_Q + (l * 2 + 1) * 64; volatile LAS int* slot = (volatile LAS int*)(MISC + 16);
              for (;;) { const int u = q_pull(qc, slot); if (u >= 264 + 1024) break;
                  if (u < 264) { TSTART(20); FRESH(); gla::gla_unit<true>(F, AV, l, u); TSTOP(20); } else { TSTART(21); FRESH(); hy::main_unit(F, AV, l, u - 264); TSTOP(21); } } }
        }
        SEAM(pb + 4);
        TSTOP(4);
        TSTART(5);
        if (PH_EN(5) && IN(pb + 5)) {
            pg8::SchedPlain S; S.init(nMr, 2, F.G, F.bid); S.A = (const char*)(ws + WS_YAPRE); S.B = (const char*)(ws + WS_WGLU); S.aTile = (size_t)256 * 512 * 2; S.bTile = (size_t)256 * 512 * 2;
            pg8::EpiGlu E{(const f16*)(ws + WS_YAPRE), (f16*)(ws + WS_YCAT), AV.in(I_GLUB) + (size_t)l * 512};
            pg8::gemm_phase(F.lds, 512, 512, 8, S, E);
            FRESH(); hy::ph_ybt_transpose(F);
        }
        SEAM(pb + 5);
        TSTOP(5);
        TSTART(6);
        if (PH_EN(6) && IN(pb + 6)) {
            pg8::SchedPlain S; S.init(nMr, 8, F.G, F.bid); S.aTile = (size_t)256 * 2048 * 2; S.bTile = (size_t)256 * 2048 * 2;
            S.A = (const char*)(ws + WS_YCAT); S.B = (const char*)(ws + WS_WBR);
            pg8::EpiBranchF E{(const f16*)(ws + WS_GTL), (f16*)(ws + WS_MBUF)};
            pg8::gemm_phase(F.lds, 2048, 2048, 32, S, E);
            if (l + 1 < DEPTH && F.G == 256) { unsigned* qc = (unsigned*)(ws + WS_CTL) + CW_Q + 1024 + l * 64; volatile LAS int* slot = (volatile LAS int*)(MISC + 16);
              for (;;) { if (F.bid < 16) break; const int u = q_pull(qc, slot); if (u >= 240) break; FRESH(); hy::filt_unit(F, AV, l + 1, u); } }
#ifdef PG_DUMMY
            { pg8::EpiF16 E9{(f16*)(ws + WS_ACT), 2048}; pg8::gemm_phase(F.lds, 2048, 2048, 32, S, E9); }
#endif
        }
        SEAM(pb + 6);
        TSTOP(6);
        TSTART(7);
        if (PH_EN(7) && IN(pb + 7)) {
            pg8::SchedPlain S; S.init(MX / 256, 8, F.G, F.bid); S.A = (const char*)(ws + WS_MBUF); S.B = (const char*)(ws + WS_WOUT); S.aTile = (size_t)256 * 2048 * 2; S.bTile = (size_t)256 * 2048 * 2;
            pg8::EpiResid E{(float*)(ws + WS_XRES), modl, 4096};
            pg8::gemm_phase(F.lds, 2048, 2048, 32, S, E);
            if (ctx_on) { pg8::SchedSplit S2{(const char*)(ws + WS_MBUF), (const char*)(ws + WS_WOUT), (size_t)256 * 2048 * 2, (size_t)256 * 2048 * 2, (size_t)8 * 128, 4, F.G, F.bid};
                pg8::EpiSlab E2{(float*)(ws + WS_SLAB), modl, 4096};
                pg8::gemm_phase(F.lds, 2048, 2048, 8, S2, E2); }
            if (l + 1 < DEPTH && F.G == 256) { unsigned* qc = (unsigned*)(ws + WS_CTL) + CW_Q + 1024 + l * 64 + 32; volatile LAS int* slot = (volatile LAS int*)(MISC + 16);
              for (;;) { const int u = q_pull(qc, slot); if (u >= 512) break; FRESH(); hy::filt_unit(F, AV, l + 1, 512 + u); } }
        }
        SEAM(pb + 7);
        TSTOP(7);
        TSTART(8);
        if (PH_EN(8) && IN(pb + 8)) { FRESH(); ph_norm(F, AV, l, 1, nrows, 4); }
        SEAM(pb + 8);
        TSTOP(8);
        TSTART(9);
        if (PH_EN(9) && IN(pb + 9)) {
            pg8::SchedPlain S; S.init(nMr, UPLD / 256, F.G, F.bid); S.A = (const char*)(ws + WS_HN); S.B = (const char*)(ws + WS_WUP); S.aTile = (size_t)256 * 2048 * 2; S.bTile = (size_t)256 * 2048 * 2;
            pg8::EpiUpAct E{(f16*)(ws + WS_ACT), (float*)(ws + WS_HALO), AV.in(I_FFCW) + (size_t)l * 3 * FFH, AV.in(I_FFCB) + (size_t)l * FFH, (LAS float*)(F.lds + EXTRA_OFF)};
            pg8::gemm_phase(F.lds, 2048, 2048, 32, S, E);
        }
        SEAM(pb + 9);
        TSTOP(9);
        TSTART(10);
        if (PH_EN(10) && IN(pb + 10)) { FRESH(); ph_ffn_fix(F, AV, l, nMr); }
        SEAM(pb + 10);
        TSTOP(10);
        TSTART(11);
        if (PH_EN(11) && IN(pb + 11)) {
            pg8::SchedPlain S; S.init(MX / 256, 8, F.G, F.bid); S.A = (const char*)(ws + WS_ACT); S.B = (const char*)(ws + WS_WDN); S.aTile = (size_t)256 * FFH * 2; S.bTile = (size_t)256 * FFH * 2;
            pg8::EpiResid E{(float*)(ws + WS_XRES), modl, 10240};
            pg8::gemm_phase(F.lds, FFH, FFH, FFH / 64, S, E);
            if (ctx_on) { pg8::SchedSplit S2{(const char*)(ws + WS_ACT), (const char*)(ws + WS_WDN), (size_t)256 * FFH * 2, (size_t)256 * FFH * 2, (size_t)8 * 128, 11, F.G, F.bid};
                pg8::EpiSlab E2{(float*)(ws + WS_SLAB), modl, 10240};
                pg8::gemm_phase(F.lds, FFH, FFH, 8, S2, E2); }
        }
        SEAM(pb + 11);
        TSTOP(11);
    }
    if (PH_EN(13) && IN(NPH - 1)) { FRESH(); ph_final_norm(F, AV); }
#if STAMP_MASK
    if (blockIdx.x == 0 && threadIdx.x == 0) { const unsigned long long t0 = __builtin_amdgcn_s_memrealtime(); while (__builtin_amdgcn_s_memrealtime() - t0 < (unsigned long long)(STAMP_K) * TS[1]) __builtin_amdgcn_s_sleep(8); }
#endif
#undef IN
#undef SEAM
#undef FRESH
}

extern "C" void kernel_launch(void* const* d_in, const int* in_sizes, int n_in, void* d_out, int out_size, void* d_ws, size_t ws_size, hipStream_t stream) {
    static int grid = 0;
    if (grid == 0) {
        if (n_in != 40 || out_size != MX * D || ws_size < WS_END) { fprintf(stderr, "kernel_launch: unexpected problem (n_in %d out %d ws %zu, need %zu)\n", n_in, out_size, ws_size, (size_t)WS_END); grid = -1; return; }
        int dev = 0, cus = 0, per_cu = 0;
        if (hipGetDevice(&dev) != hipSuccess || hipDeviceGetAttribute(&cus, hipDeviceAttributeMultiprocessorCount, dev) != hipSuccess) { grid = -1; return; }
        if (hipFuncSetAttribute((const void*)mk_fwd, hipFuncAttributeMaxDynamicSharedMemorySize, LDS_BYTES) != hipSuccess) { fprintf(stderr, "kernel_launch: hipFuncSetAttribute failed\n"); grid = -1; return; }
        if (hipOccupancyMaxActiveBlocksPerMultiprocessor(&per_cu, (const void*)mk_fwd, 512, LDS_BYTES) != hipSuccess || per_cu < 1)
            fprintf(stderr, "kernel_launch: occupancy query reports %d\n", per_cu);
        (void)hipGetLastError();
        grid = cus;
    }
    if (grid < 0) return;
    if (hipMemsetAsync((char*)d_ws + WS_CTL, 0, CTL_ZERO_BYTES, stream) != hipSuccess) return;
    Args a{};
    for (int i = 0; i < 40; ++i) a.in[i] = (const float*)d_in[i];
    a.out = (float*)d_out; a.ws = (unsigned char*)d_ws;
#if MK_ONE
    a.ph_lo = 0; a.ph_hi = NPH;
    hipLaunchKernelGGL(mk_fwd, dim3(grid), dim3(512), LDS_BYTES, stream, a);
#else
    for (int p = 0; p < NPH; ++p) { a.ph_lo = p; a.ph_hi = p + 1; hipLaunchKernelGGL(mk_fwd, dim3(grid), dim3(512), LDS_BYTES, stream, a); }
#endif
}
```

```cpp
#include <hip/hip_runtime.h>
#include <stdio.h>

#ifndef MK_ONE
#define MK_ONE 1
#define STAMP_MASK 0
#define STAMP_K 1
#define STAMP_BID 0
#endif

#define GAS __attribute__((address_space(1)))
#define LAS __attribute__((address_space(3)))
typedef _Float16 f16;
typedef _Float16 f16x8 __attribute__((ext_vector_type(8)));
typedef _Float16 f16x4 __attribute__((ext_vector_type(4)));
typedef _Float16 f16x2 __attribute__((ext_vector_type(2)));
typedef float f32x4 __attribute__((ext_vector_type(4)));
typedef float f32x2 __attribute__((ext_vector_type(2)));

constexpr int D = 2048, NB = 2, SEQ = 8192, LC = 256, DEPTH = 4;
constexpr int MX = NB * SEQ, MC = NB * LC, MT = MX + MC;
constexpr int PXLD = 3840, WINN = 11520, FFH = 5632, UPLD = 2 * FFH;
constexpr int P_S5 = 0, P_GK = 512, P_GV = 1024, P_GQ = 2048, P_GR = 2560, P_HY = 3584, P_MG = 5120, P_GG = 3584, W_GG = 11264;
constexpr int INW = 11296;
constexpr int NCHK = 1056;
constexpr float S5SCALE = 1024.f;
constexpr float EPS = 1e-6f;
constexpr int NSC = 33;

constexpr size_t MiB = 1u << 20;
constexpr size_t WS_CTL = 0, CTL_ZERO_BYTES = 1 * MiB;
constexpr size_t WS_MOD = 1 * MiB;
constexpr size_t WS_TW = 2 * MiB;
constexpr size_t WS_S5AT = 3 * MiB;
constexpr size_t WS_WIN = 4 * MiB;
constexpr size_t WS_WGLU = WS_WIN + 45 * MiB;
constexpr size_t WS_WBR = WS_WGLU + 1 * MiB;
constexpr size_t WS_WOUT = WS_WBR + 8 * MiB;
constexpr size_t WS_WUP = WS_WOUT + 8 * MiB;
constexpr size_t WS_WDN = WS_WUP + 44 * MiB;
constexpr size_t WS_S5W = WS_WDN + 22 * MiB;
constexpr size_t WS_S5M = WS_S5W + 8 * MiB;
constexpr size_t WS_H2 = WS_S5M + 4 * MiB;
constexpr size_t WS_FSD = WS_H2 + 3 * MiB;
constexpr size_t FSD_C_OFF = (size_t)2 * 256 * 8193 * 16;
constexpr size_t WS_XRES = WS_FSD + 68 * MiB;
constexpr size_t WS_HN = WS_XRES + 132 * MiB;
constexpr size_t WS_PX = WS_HN + 66 * MiB;
constexpr size_t WS_S5A = WS_PX + 372 * MiB;
constexpr size_t WS_S5S = WS_S5A + 40 * MiB;
constexpr size_t WS_YAPRE = WS_S5S + 40 * MiB;
constexpr size_t WS_YCAT = WS_YAPRE + 20 * MiB;
constexpr size_t WS_MBUF = WS_YCAT + 66 * MiB;
constexpr size_t WS_GSLOC = WS_MBUF + 66 * MiB;
constexpr size_t WS_GSIN = WS_GSLOC + 66 * MiB;
constexpr size_t WS_GOF = WS_GSIN + 66 * MiB;
constexpr size_t WS_GDT = WS_GOF + 66 * MiB;
constexpr size_t WS_ACT = WS_GSLOC;
constexpr size_t WS_ZT = WS_GDT + 1 * MiB;
constexpr size_t WS_YBT = WS_ZT + 50 * MiB;
constexpr size_t WS_SLAB = WS_YBT + 17 * MiB;
constexpr size_t WS_HALO = WS_SLAB + 44 * MiB;
constexpr size_t WS_GTL = WS_HALO + 9 * MiB;
constexpr size_t WS_END = WS_GTL + 198 * MiB;
constexpr size_t WS_FSD2 = WS_PX + 124 * MiB;
constexpr size_t WS_W2 = WS_FSD2 + 68 * MiB;
constexpr size_t WS_H2H = WS_W2 + 128 * MiB;
static_assert(WS_H2H + 5 * MiB <= WS_PX + 372 * MiB, "PX tail");
static_assert((size_t)MT * FFH * 2 <= 198 * MiB, "ACT overlay");
constexpr int CW_BAR = 4096;

constexpr int RING_BYTES = 131072;
constexpr int EXTRA_OFF = RING_BYTES, EXTRA_BYTES = 8192;
constexpr int LDSCTL_OFF = EXTRA_OFF + EXTRA_BYTES;
constexpr int LDS_BYTES = LDSCTL_OFF + 256;

__device__ __forceinline__ float wave_sum(float v) {
#pragma unroll
    for (int o = 1; o < 64; o <<= 1) v += __shfl_xor(v, o);
    return v;
}
__device__ __forceinline__ float sigmoidf_(float x) { return 1.0f / (1.0f + __expf(-x)); }
__device__ __forceinline__ float siluf_(float x) { return x * sigmoidf_(x); }
__device__ __forceinline__ float gelu_tanh_(float x) { const float u = 0.7978845608028654f * (x + 0.044715f * x * x * x); return x / (1.0f + __expf(-2.0f * u)); }
__device__ __forceinline__ float logsigmoidf_(float x) { return fminf(x, 0.f) - __logf(1.0f + __expf(-fabsf(x))); }
__device__ __forceinline__ f32x2 cmul(f32x2 a, f32x2 b) { return (f32x2){a.x * b.x - a.y * b.y, a.x * b.y + a.y * b.x}; }
__device__ __forceinline__ f32x2 cconj(f32x2 a) { return (f32x2){a.x, -a.y}; }
__device__ __forceinline__ int opq(int x) { asm volatile("" : "+v"(x)); return x; }
#define PIN8(a, b, c, d, e, f, g, h) asm volatile("" : "+v"(a), "+v"(b), "+v"(c), "+v"(d), "+v"(e), "+v"(f), "+v"(g), "+v"(h))
#define PIN4(a, b, c, d) asm volatile("" : "+v"(a), "+v"(b), "+v"(c), "+v"(d))
#define LDS_WAIT() asm volatile("s_waitcnt lgkmcnt(0)" ::: "memory")
#define VM_WAIT() asm volatile("s_waitcnt vmcnt(0)" ::: "memory")

#define XB_TMO      128
#define XB_XCNT(j)  (256  + 64 * (j))
#define XB_XSUB(j)  (1280 + 64 * (j))
#define XB_XGEN(j)  (2304 + 64 * (j))
#define XB_TOP      3328
#define XB_TOPGEN   3392
#define XCD_BAR_WORDS 3456
#define XB_SPIN_CAP (1u << 18)
__device__ __forceinline__ unsigned xb_ld(unsigned* p)              { return __hip_atomic_load(p, __ATOMIC_RELAXED, __HIP_MEMORY_SCOPE_AGENT); }
__device__ __forceinline__ unsigned xb_add(unsigned* p, unsigned v) { return __hip_atomic_fetch_add(p, v, __ATOMIC_RELAXED, __HIP_MEMORY_SCOPE_AGENT); }
__device__ __forceinline__ unsigned xb_xcc_id() { return (unsigned)__builtin_amdgcn_s_getreg((3 << 11) | 20) & 0xFu; }
#define XB_SPIN(cond, bar) do { unsigned _sp = 0; while (cond) { __builtin_amdgcn_s_sleep(1); \
    if ((++_sp & 255u) == 0u) { if (xb_ld(&(bar)[XB_TMO])) break; if (_sp > XB_SPIN_CAP) { atomicAdd(&(bar)[XB_TMO], 1u); break; } } } } while (0)
struct XcdBarrier { unsigned* bar; unsigned x; volatile LAS unsigned* st; };
__device__ __forceinline__ XcdBarrier xcd_barrier_post(unsigned* bar, volatile LAS unsigned* st) {
    XcdBarrier b; b.bar = bar; b.x = xb_xcc_id(); b.st = st;
    if (threadIdx.x == 0) (void)xb_add(&bar[XB_XCNT(b.x)], 1u);
    return b;
}
__device__ __forceinline__ void xcd_barrier_complete(unsigned* bar, unsigned x, unsigned& nloc, unsigned& nx) {
    const unsigned G = gridDim.x * gridDim.y * gridDim.z;
    unsigned sum, cnt, mine, sp = 0u;
    for (;;) {
        sum = 0u; cnt = 0u; mine = 0u;
#pragma unroll
        for (unsigned j = 0; j < 16; ++j) { const unsigned c = xb_ld(&bar[XB_XCNT(j)]); sum += c; cnt += (c > 0u) ? 1u : 0u; mine = (j == x) ? c : mine; }
        if (sum == G) break;
        __builtin_amdgcn_s_sleep(1);
        if ((++sp & 255u) == 0u) { if (xb_ld(&bar[XB_TMO])) break; if (sp > XB_SPIN_CAP) { atomicAdd(&bar[XB_TMO], 1u); break; } }
    }
    nloc = mine > 0u ? mine : 1u; nx = cnt > 0u ? cnt : 1u;
}
__device__ __forceinline__ void xcd_barrier(const XcdBarrier& b) {
    asm volatile("s_waitcnt vmcnt(0)" ::: "memory");
    __syncthreads();
    if (threadIdx.x == 0) {
        unsigned* bar = b.bar;
        __builtin_amdgcn_s_waitcnt(0);
        unsigned nloc = b.st[0], nx = b.st[1];
        if (nloc == 0u) { xcd_barrier_complete(bar, b.x, nloc, nx); b.st[0] = nloc; b.st[1] = nx; }
        const unsigned old = xb_add(&bar[XB_XSUB(b.x)], 1u);
        const unsigned gen = old / nloc;
        if (old + 1u == (gen + 1u) * nloc) {
            __builtin_amdgcn_fence(__ATOMIC_RELEASE, "agent");
            asm volatile("s_waitcnt vmcnt(0)" ::: "memory");
            const unsigned og = xb_add(&bar[XB_TOP], 1u);
            const unsigned tg = og / nx;
            if (og + 1u == (tg + 1u) * nx) xb_add(&bar[XB_TOPGEN], 1u);
            else XB_SPIN(xb_ld(&bar[XB_TOPGEN]) == tg, bar);
            __builtin_amdgcn_fence(__ATOMIC_ACQUIRE, "agent");
            xb_add(&bar[XB_XGEN(b.x)], 1u);
            asm volatile("s_waitcnt vmcnt(0)" ::: "memory");
        } else {
            XB_SPIN(xb_ld(&bar[XB_XGEN(b.x)]) == gen, bar);
            __builtin_amdgcn_fence(__ATOMIC_ACQUIRE, "agent");
            asm volatile("s_waitcnt vmcnt(0)" ::: "memory");
        }
    }
    __syncthreads();
}

struct Args {
    const float* in[40];
    float* out; unsigned char* ws;
    int ph_lo, ph_hi;
};
struct ArgsV {
    __device__ __forceinline__ const float* in(int i) const {
        typedef const __attribute__((address_space(4))) unsigned long long* kp_t;
        kp_t ka = (kp_t)__builtin_amdgcn_kernarg_segment_ptr();
        return (const float*)(*(volatile const __attribute__((address_space(4))) unsigned long long*)(ka + i)); }
    float* out;
};
struct Ctx {
    LAS unsigned char* lds;
    int tid, lane, wave, G, bid;
    unsigned char* ws;
};
enum { I_X = 0, I_C, I_CTX, I_CCTX, I_WMOD, I_BMOD, I_N1G, I_N2G, I_WIN, I_S5ARE, I_S5AIM, I_S5STEP, I_S5BRE, I_S5BIM, I_S5CRE, I_S5CIM,
       I_S5D, I_GLUW, I_GLUB, I_HYCW, I_HYCB, I_HYW1, I_HYB1, I_HYF1, I_HYW2, I_HYB2, I_HYF2, I_HYW3, I_HYB3, I_HYBIAS,
       I_GLAWG, I_GLABG, I_GLANG, I_WBR, I_WOUT, I_WUP, I_FFCW, I_FFCB, I_WDN, I_FNG };

namespace pg8 {
constexpr int BM = 256, BK = 64, HALF = 128, HTB = HALF * BK * 2, STAGE_BYTES = 8 * HTB, NXCD = 8, WGM = 8;
__device__ __forceinline__ int lds_byte(int r, int c) { const int st = (r >> 4) * 2 + (c >> 5), rr = r & 15, cc = c & 31, ob = rr * 64 + cc * 2; return st * 1024 + (ob ^ (((ob >> 9) & 1) << 5)); }
__device__ __forceinline__ void stage_rc(int b, int& R, int& C) { const int st = b / 1024, sb = b % 1024, swz = sb ^ (((sb >> 9) & 1) << 5); R = (st >> 1) * 16 + swz / 64; C = (st & 1) * 32 + (swz % 64) / 2; }
__device__ __forceinline__ int perm32(int rho) { const int n = rho >> 4, i = rho & 15; return 8 * (i >> 2) + 4 * n + (i & 3); }
struct Unit { const char* a; const char* b; int pm, pn; };
struct Order2D {
    int nM, nN, nwg, G, c;
    __device__ __forceinline__ void init(int nM_, int nN_, int G_, int c_) { nM = nM_; nN = nN_; nwg = nM * nN; G = G_; c = c_; }
    __device__ __forceinline__ bool nx(int i, int& pm, int& pn) const {
        const long L = (long)i * G + c; if (L >= nwg) return false;
        int wgid = (int)L; { const int q = nwg / NXCD, r = nwg % NXCD, xcd = wgid % NXCD, off = wgid / NXCD; wgid = (xcd < r ? xcd * (q + 1) : r * (q + 1) + (xcd - r) * q) + off; }
        const int nig = WGM * nN, gid = wgid / nig, fm = gid * WGM, gsz = (nM - fm) < WGM ? (nM - fm) : WGM;
        pm = fm + ((wgid % nig) % gsz); pn = (wgid % nig) / gsz; return true;
    }
};
struct SchedPlain : Order2D {
    const char* A; const char* B; size_t aTile, bTile;
    __device__ __forceinline__ bool next(int i, Unit& u) const { int pm, pn; if (!nx(i, pm, pn)) return false; u.pm = pm; u.pn = pn; u.a = A + (size_t)pm * aTile; u.b = B + (size_t)pn * bTile; return true; }
};
struct SchedSplit {
    const char* A; const char* B; size_t aTile, bTile, ksub; int nsplit, G, c;
    __device__ __forceinline__ bool next(int i, Unit& u) const { const int L = i * G + c; if (L >= 16 * nsplit) return false; const int t = L / nsplit, ks = L % nsplit, pm = 64 + (t >> 3), pn = t & 7;
        u.pm = pm; u.pn = pn | (ks << 8); u.a = A + (size_t)pm * aTile + (size_t)ks * ksub; u.b = B + (size_t)pn * bTile + (size_t)ks * ksub; return true; }
};
struct SchedS5 {
    const char* A; const char* B; size_t bGroup; int G, c;
    __device__ __forceinline__ bool next(int i, Unit& u) const { const int L = i * G + c; if (L >= 160) return false; const int g = L & 31, pm = L >> 5;
        u.pm = pm; u.pn = g; u.a = A + ((size_t)pm * 256 * 16384 + (size_t)g * 512) * 2; u.b = B + (size_t)g * bGroup; return true; }
};

#define PG8_SA(b, h) (((b) * 2 + (h)) * HTB)
#define PG8_SB(b, h) ((4 + (b) * 2 + (h)) * HTB)
#define PG8_STAGE(bufoff, gbase, voff) do { _Pragma("unroll") for (int _i = 0; _i < 2; ++_i) \
        __builtin_amdgcn_global_load_lds((const unsigned*)((const char*)(gbase) + (voff)[_i]), (LAS unsigned*)(lds + (bufoff) + ldsw + _i * 8192), 16, 0, 0); } while (0)
#define PG8_LDA(dst, b, h) do { _Pragma("unroll") for (int m = 0; m < 4; ++m) _Pragma("unroll") for (int k = 0; k < 2; ++k) dst[m][k] = *(const LAS f16x8*)(lds + PG8_SA(b, h) + aoff + m * 2048 + k * 1024); } while (0)
#define PG8_LDB(dst, b, h) do { _Pragma("unroll") for (int n = 0; n < 2; ++n) _Pragma("unroll") for (int k = 0; k < 2; ++k) dst[n][k] = *(const LAS f16x8*)(lds + PG8_SB(b, h) + boff + n * 2048 + k * 1024); } while (0)
#define PG8_MMA(ai, bj, At, Bt) do { __builtin_amdgcn_s_setprio(1); _Pragma("unroll") for (int m = 0; m < 4; ++m) _Pragma("unroll") for (int n = 0; n < 2; ++n) _Pragma("unroll") for (int k = 0; k < 2; ++k) \
        acc[ai][bj][m][n] = __builtin_amdgcn_mfma_f32_16x16x32_f16(Bt[n][k], At[m][k], acc[ai][bj][m][n], 0, 0, 0); __builtin_amdgcn_s_setprio(0); } while (0)
#define PG8_WAIT_V(n) asm volatile("s_waitcnt vmcnt(" #n ")" ::: "memory")
#define PG8_WAIT_L(n) asm volatile("s_waitcnt lgkmcnt(" #n ")" ::: "memory")
#define PG8_BAR __builtin_amdgcn_s_barrier()
#define PG8_SCHED __builtin_amdgcn_sched_barrier(0)

template <class Epi, class Sched>
__device__ __forceinline__ void gemm_phase(LAS unsigned char* lds, const int lda, const int ldb, const int nt, const Sched& S, const Epi& E) {
    const int tid = opq((int)threadIdx.x), wid = __builtin_amdgcn_readfirstlane(tid >> 6), lane = tid & 63, wr = wid >> 2, wc = wid & 3, fr = lane & 15, fq = lane >> 4;
    unsigned voffA[2], voffB[2];
#pragma unroll
    for (int i = 0; i < 2; ++i) { int R, C; stage_rc(tid * 16 + i * 8192, R, C); const int Rb = Epi::PERM ? ((R & ~31) + perm32(R & 31)) : R;
        voffA[i] = (unsigned)(R * lda + C) * 2u; voffB[i] = (unsigned)(Rb * ldb + C) * 2u; }
    const size_t kstep = (size_t)(BK * 2);
    const size_t hstepA = (size_t)HALF * lda * 2, hstepB = (size_t)HALF * ldb * 2;
    const unsigned ldsw = (unsigned)wid * 1024u;
    const int aoff = lds_byte(wr * 64 + fr, fq * 8), boff = lds_byte(wc * 32 + fr, fq * 8);
    Unit cur, nxt; int ui = 0;
    if (!S.next(0, cur)) return;
    f32x4 acc[2][2][4][2];
#pragma unroll
    for (int a = 0; a < 2; ++a)
#pragma unroll
        for (int b = 0; b < 2; ++b)
#pragma unroll
            for (int m = 0; m < 4; ++m)
#pragma unroll
                for (int n = 0; n < 2; ++n) acc[a][b][m][n] = (f32x4){0.f, 0.f, 0.f, 0.f};
    f16x8 At[4][2], B0[2][2], B1[2][2];
    const char* cA = cur.a; const char* cB = cur.b;
    PG8_STAGE(PG8_SB(0, 0), cB, voffB); PG8_STAGE(PG8_SA(0, 0), cA, voffA); PG8_STAGE(PG8_SB(0, 1), cB + hstepB, voffB); PG8_STAGE(PG8_SA(0, 1), cA + hstepA, voffA);
    if (wr == 1) PG8_BAR;
    PG8_WAIT_V(4); PG8_BAR;
    PG8_STAGE(PG8_SB(1, 0), cB + kstep, voffB); PG8_STAGE(PG8_SA(1, 0), cA + kstep, voffA); PG8_STAGE(PG8_SB(1, 1), cB + hstepB + kstep, voffB);
    PG8_WAIT_V(6); PG8_BAR;
    for (;;) {
        const bool has_next = S.next(ui + 1, nxt);
        const char* nA = has_next ? nxt.a : cA; const char* nB = has_next ? nxt.b : cB;
        constexpr int NSEG = Epi::HAS_MID ? 3 : 1;
#pragma unroll
        for (int seg = 0; seg < NSEG; ++seg) {
        const int tb = Epi::HAS_MID ? (seg == 0 ? 0 : (seg == 1 ? Epi::MID1 + 2 : Epi::MID2 + 2)) : 0;
        const int te = Epi::HAS_MID ? (seg == 0 ? Epi::MID1 + 2 : (seg == 1 ? Epi::MID2 + 2 : nt)) : nt;
        for (int t = tb; t < te; t += 2) {
            const bool last = (t == nt - 2);
            const char* a1 = cA + (size_t)(t + 1) * kstep;
            const char* a2 = last ? nA : cA + (size_t)(t + 2) * kstep; const char* b2 = last ? nB : cB + (size_t)(t + 2) * kstep;
            const char* a3 = a2 + kstep; const char* b3 = b2 + kstep;
            PG8_LDB(B0, 0, 0); PG8_SCHED; PG8_LDA(At, 0, 0); PG8_STAGE(PG8_SA(1, 1), a1 + hstepA, voffA);
            PG8_WAIT_L(8); PG8_BAR; PG8_WAIT_L(0); PG8_MMA(0, 0, At, B0); PG8_BAR; PG8_SCHED;
            PG8_LDB(B1, 0, 1); PG8_STAGE(PG8_SB(0, 0), b2, voffB);
            PG8_BAR; PG8_WAIT_L(0); PG8_MMA(0, 1, At, B1); PG8_BAR;
            PG8_LDA(At, 0, 1); PG8_STAGE(PG8_SA(0, 0), a2, voffA);
            PG8_BAR; PG8_WAIT_L(0); PG8_MMA(1, 0, At, B0); PG8_BAR; PG8_SCHED;
            PG8_STAGE(PG8_SB(0, 1), b2 + hstepB, voffB);
            PG8_WAIT_V(6); PG8_BAR; PG8_MMA(1, 1, At, B1); PG8_BAR;
            PG8_LDB(B0, 1, 0); PG8_SCHED; PG8_LDA(At, 1, 0); PG8_STAGE(PG8_SA(0, 1), a2 + hstepA, voffA);
            PG8_WAIT_L(8); PG8_BAR; PG8_WAIT_L(0); PG8_MMA(0, 0, At, B0); PG8_BAR; PG8_SCHED;
            PG8_LDB(B1, 1, 1); PG8_STAGE(PG8_SB(1, 0), b3, voffB);
            PG8_BAR; PG8_WAIT_L(0); PG8_MMA(0, 1, At, B1); PG8_BAR;
            PG8_LDA(At, 1, 1); PG8_STAGE(PG8_SA(1, 0), a3, voffA);
            PG8_BAR; PG8_WAIT_L(0); PG8_MMA(1, 0, At, B0); PG8_BAR; PG8_SCHED;
            PG8_STAGE(PG8_SB(1, 1), b3 + hstepB, voffB);
            PG8_WAIT_V(6); PG8_BAR; PG8_MMA(1, 1, At, B1); PG8_BAR;
        }
        if constexpr (Epi::HAS_MID) { if (seg < 2) {
            E.mid(acc, cur, seg, wr, wc, fr, fq);
        } }
        }
#if STAMP_MASK & (1 << 23)
        if (Epi::HAS_MID && blockIdx.x == 0 && threadIdx.x == 0) ((volatile LAS unsigned long long*)(lds + LDSCTL_OFF + 128))[0] = __builtin_amdgcn_s_memrealtime();
#endif
        E(acc, cur, wr, wc, fr, fq);
#if STAMP_MASK & (1 << 23)
        if (Epi::HAS_MID && blockIdx.x == 0 && threadIdx.x == 0) { volatile LAS unsigned long long* TS = (volatile LAS unsigned long long*)(lds + LDSCTL_OFF + 128); TS[1] = TS[1] + (__builtin_amdgcn_s_memrealtime() - TS[0]); }
#endif
        if (!has_next) break;
#pragma unroll
        for (int a = 0; a < 2; ++a)
#pragma unroll
            for (int b = 0; b < 2; ++b)
#pragma unroll
                for (int m = 0; m < 4; ++m)
#pragma unroll
                    for (int n = 0; n < 2; ++n) acc[a][b][m][n] = (f32x4){0.f, 0.f, 0.f, 0.f};
        cur = nxt; cA = nA; cB = nB; ++ui;
    }
    PG8_WAIT_V(0);
    if (wr == 0) PG8_BAR;
    PG8_BAR;
}
#undef PG8_SA
#undef PG8_SB
#undef PG8_STAGE
#undef PG8_LDA
#undef PG8_LDB
#undef PG8_MMA
#undef PG8_WAIT_V
#undef PG8_WAIT_L
#undef PG8_BAR
#undef PG8_SCHED

typedef const f32x4 (&AccRef)[2][2][4][2];
__device__ __forceinline__ f16x8 pack8(f32x4 a, f32x4 b) { f16x8 w; w[0] = (f16)a[0]; w[1] = (f16)a[1]; w[2] = (f16)a[2]; w[3] = (f16)a[3]; w[4] = (f16)b[0]; w[5] = (f16)b[1]; w[6] = (f16)b[2]; w[7] = (f16)b[3]; return w; }

struct EpiPx {
    static constexpr bool PERM = true, HAS_MID = false; static constexpr int MID1 = 0, MID2 = 0; f16* PX; f16* S5A; f16* ZT; f16* GTL;
    __device__ __forceinline__ void operator()(AccRef acc, const Unit& u, int wr, int wc, int fr, int fq) const { fr = opq(fr); fq = opq(fq);
        const int row0 = u.pm * BM + wr * 64 + fr, col0 = u.pn * BM + wc * 32 + 8 * fq;
#pragma unroll
        for (int ai = 0; ai < 2; ++ai)
#pragma unroll
            for (int m = 0; m < 4; ++m) { const int row = row0 + ai * HALF + m * 16;
#pragma unroll
                for (int bj = 0; bj < 2; ++bj) { const int c = col0 + bj * HALF; const f16x8 w = pack8(acc[ai][bj][m][0], acc[ai][bj][m][1]);
                    if (u.pn < 2) *(f16x8*)(S5A + (size_t)(row >> 4) * 16384 + (size_t)(c >> 4) * 512 + (row & 15) * 16 + (c & 15)) = w;
                    else if (u.pn >= 14 && u.pn < 20) {
#pragma unroll
                        for (int j = 0; j < 8; ++j) ZT[(size_t)(c - P_HY + j) * MT + row] = w[j]; }
                    else if (u.pn >= 20 && u.pn < 44) *(f16x8*)(GTL + ((size_t)(u.pn - 20) * 66 + u.pm) * 65536 + (size_t)(row - u.pm * BM) * 256 + (c - u.pn * BM)) = w;
                    else { const int pr = row < MX ? (row & ~8191) + ((row & 63) << 7) + ((row & 8191) >> 6) : row;
                        *(f16x8*)(PX + (size_t)pr * PXLD + (u.pn == 44 ? c - (W_GG - P_GG) : c)) = w; } } }
    }
};
struct EpiF16 {
    static constexpr bool PERM = true, HAS_MID = false; static constexpr int MID1 = 0, MID2 = 0; f16* O; int ldc;
    __device__ __forceinline__ void operator()(AccRef acc, const Unit& u, int wr, int wc, int fr, int fq) const { fr = opq(fr); fq = opq(fq);
        const int row0 = u.pm * BM + wr * 64 + fr, col0 = u.pn * BM + wc * 32 + 8 * fq;
#pragma unroll
        for (int ai = 0; ai < 2; ++ai)
#pragma unroll
            for (int m = 0; m < 4; ++m) { f16* rowp = O + (size_t)(row0 + ai * HALF + m * 16) * ldc + col0;
#pragma unroll
                for (int bj = 0; bj < 2; ++bj) *(f16x8*)(rowp + bj * HALF) = pack8(acc[ai][bj][m][0], acc[ai][bj][m][1]); }
    }
};
struct EpiS5In {
    static constexpr bool PERM = false, HAS_MID = false; static constexpr int MID1 = 0, MID2 = 0; float* S;
    __device__ __forceinline__ void operator()(AccRef acc, const Unit& u, int wr, int wc, int fr, int fq) const { fr = opq(fr); fq = opq(fq);
        const int row0 = u.pm * BM + wr * 64 + fr, col0 = wc * 32 + 4 * fq, g = u.pn;
#pragma unroll
        for (int ai = 0; ai < 2; ++ai)
#pragma unroll
            for (int m = 0; m < 4; ++m) { const int row = row0 + ai * HALF + m * 16; { float* rowp = S + ((size_t)row * 32 + g) * 256 + col0;
#pragma unroll
                for (int bj = 0; bj < 2; ++bj)
#pragma unroll
                    for (int n = 0; n < 2; ++n) *(f32x4*)(rowp + bj * HALF + n * 16) = acc[ai][bj][m][n]; } }
    }
};
struct EpiS5Out {
    static constexpr bool PERM = true, HAS_MID = false; static constexpr int MID1 = 0, MID2 = 0; const f16* S5A; f16* Y; const float* dvec;
    __device__ __forceinline__ void operator()(AccRef acc, const Unit& u, int wr, int wc, int fr, int fq) const { fr = opq(fr); fq = opq(fq);
        const int row0 = u.pm * BM + wr * 64 + fr, col0 = wc * 32 + 8 * fq, g = u.pn;
        const int h0 = col0 & 15;
        const f32x4 d0 = *(const f32x4*)(dvec + g * 16 + h0), d1 = *(const f32x4*)(dvec + g * 16 + h0 + 4);
#pragma unroll
        for (int ai = 0; ai < 2; ++ai) { f16x8 uu[4][2];
#pragma unroll
            for (int m = 0; m < 4; ++m)
#pragma unroll
                for (int bj = 0; bj < 2; ++bj) uu[m][bj] = *(const f16x8*)(S5A + (size_t)(row0 + ai * HALF + m * 16) * 16384 + (size_t)g * 512 + col0 + bj * HALF);
            PIN8(uu[0][0], uu[0][1], uu[1][0], uu[1][1], uu[2][0], uu[2][1], uu[3][0], uu[3][1]);
#pragma unroll
            for (int m = 0; m < 4; ++m) { const int chunk = row0 + ai * HALF + m * 16;
#pragma unroll
                for (int bj = 0; bj < 2; ++bj) { const int c = col0 + bj * HALF, t = c >> 4; f16x8 w;
#pragma unroll
                    for (int j = 0; j < 4; ++j) { w[j] = (f16)gelu_tanh_(acc[ai][bj][m][0][j] * (1.0f / S5SCALE) + d0[j] * (float)uu[m][bj][j]);
                                                  w[4 + j] = (f16)gelu_tanh_(acc[ai][bj][m][1][j] * (1.0f / S5SCALE) + d1[j] * (float)uu[m][bj][4 + j]); }
                    *(f16x8*)(Y + (size_t)(chunk * 16 + t) * 512 + g * 16 + h0) = w; } }
            asm volatile("" ::: "memory"); }
    }
};
struct EpiGlu {
    static constexpr bool PERM = true, HAS_MID = false; static constexpr int MID1 = 0, MID2 = 0; const f16* YP; f16* O; const float* bias;
    __device__ __forceinline__ void operator()(AccRef acc, const Unit& u, int wr, int wc, int fr, int fq) const { fr = opq(fr); fq = opq(fq);
        const int row0 = u.pm * BM + wr * 64 + fr, col0 = u.pn * BM + wc * 32 + 8 * fq;
        f32x4 bv[2][2];
#pragma unroll
        for (int bj = 0; bj < 2; ++bj) { bv[bj][0] = *(const f32x4*)(bias + col0 + bj * HALF); bv[bj][1] = *(const f32x4*)(bias + col0 + bj * HALF + 4); }
#pragma unroll
        for (int ai = 0; ai < 2; ++ai) { f16x8 yp[4][2];
#pragma unroll
            for (int m = 0; m < 4; ++m)
#pragma unroll
                for (int bj = 0; bj < 2; ++bj) yp[m][bj] = *(const f16x8*)(YP + (size_t)(row0 + ai * HALF + m * 16) * 512 + col0 + bj * HALF);
            PIN8(yp[0][0], yp[0][1], yp[1][0], yp[1][1], yp[2][0], yp[2][1], yp[3][0], yp[3][1]);
#pragma unroll
            for (int m = 0; m < 4; ++m)
#pragma unroll
                for (int bj = 0; bj < 2; ++bj) { f16x8 w;
#pragma unroll
                    for (int j = 0; j < 4; ++j) { w[j] = (f16)((float)yp[m][bj][j] * sigmoidf_(acc[ai][bj][m][0][j] + bv[bj][0][j])); w[4 + j] = (f16)((float)yp[m][bj][4 + j] * sigmoidf_(acc[ai][bj][m][1][j] + bv[bj][1][j])); }
                    *(f16x8*)(O + (size_t)(row0 + ai * HALF + m * 16) * 2048 + col0 + bj * HALF) = w; }
            asm volatile("" ::: "memory"); }
    }
};
template <int BR> struct EpiBranch {
    static constexpr bool PERM = true, HAS_MID = false; static constexpr int MID1 = 0, MID2 = 0; const f16* PX; f16* M;
    __device__ __forceinline__ void operator()(AccRef acc, const Unit& u, int wr, int wc, int fr, int fq) const { fr = opq(fr); fq = opq(fq);
        const int row0 = u.pm * BM + wr * 64 + fr, col0 = u.pn * BM + wc * 32 + 8 * fq;
#pragma unroll
        for (int ai = 0; ai < 2; ++ai)
#pragma unroll
            for (int m = 0; m < 4; ++m) { const int row = row0 + ai * HALF + m * 16;
#pragma unroll
                for (int bj = 0; bj < 2; ++bj) { const int c = col0 + bj * HALF;
                    const f16x8 gl = *(const f16x8*)(PX + (size_t)row * PXLD + P_MG + BR * 2048 + c);
                    f16* mp = M + (size_t)row * 2048 + c;
                    f16x8 prev; if (BR > 0) prev = *(const f16x8*)mp;
                    f16x8 w;
#pragma unroll
                    for (int j = 0; j < 4; ++j) { float v0 = sigmoidf_((float)gl[j]) * acc[ai][bj][m][0][j], v1 = sigmoidf_((float)gl[4 + j]) * acc[ai][bj][m][1][j];
                        if (BR > 0) { v0 += (float)prev[j]; v1 += (float)prev[4 + j]; } w[j] = (f16)v0; w[4 + j] = (f16)v1; }
                    *(f16x8*)mp = w; } asm volatile("" ::: "memory"); }
    }
};
typedef f32x4 (&AccMut)[2][2][4][2];

struct EpiBranchF {
    static constexpr bool PERM = true, HAS_MID = true; static constexpr int MID1 = 6, MID2 = 14;
    const f16* GTL; f16* M;
    __device__ __forceinline__ void mid(AccMut acc, const Unit& u, int seg, int wr, int wc, int fr, int fq) const { fr = opq(fr); fq = opq(fq);
        const int lrow0 = wr * 64 + fr, lcol0 = wc * 32 + 8 * fq;
        const f16* ga = GTL + ((size_t)((seg == 0 ? 0 : 8) + u.pn) * 66 + u.pm) * 65536; const f16* gb = ga + (size_t)8 * 66 * 65536;
#pragma unroll
        for (int ai = 0; ai < 2; ++ai) { f16x8 za[4][2], zb[4][2];
#pragma unroll
            for (int m = 0; m < 4; ++m)
#pragma unroll
                for (int bj = 0; bj < 2; ++bj) { const int off = (lrow0 + ai * HALF + m * 16) * 256 + lcol0 + bj * HALF; za[m][bj] = *(const f16x8*)(ga + off); zb[m][bj] = *(const f16x8*)(gb + off); }
            PIN8(za[0][0], za[0][1], za[1][0], za[1][1], za[2][0], za[2][1], za[3][0], za[3][1]); PIN8(zb[0][0], zb[0][1], zb[1][0], zb[1][1], zb[2][0], zb[2][1], zb[3][0], zb[3][1]);
#pragma unroll
            for (int m = 0; m < 4; ++m)
#pragma unroll
                for (int bj = 0; bj < 2; ++bj)
#pragma unroll
                    for (int j = 0; j < 4; ++j) { acc[ai][bj][m][0][j] *= (1.0f + __expf(-(float)zb[m][bj][j])) * __builtin_amdgcn_rcpf(1.0f + __expf(-(float)za[m][bj][j]));
                                                  acc[ai][bj][m][1][j] *= (1.0f + __expf(-(float)zb[m][bj][4 + j])) * __builtin_amdgcn_rcpf(1.0f + __expf(-(float)za[m][bj][4 + j])); }
            asm volatile("" ::: "memory"); }
    }
    __device__ __forceinline__ void operator()(AccRef acc, const Unit& u, int wr, int wc, int fr, int fq) const { fr = opq(fr); fq = opq(fq);
        const int row0 = u.pm * BM + wr * 64 + fr, col0 = u.pn * BM + wc * 32 + 8 * fq;
#pragma unroll
        for (int ai = 0; ai < 2; ++ai) { f16x8 gl[4][2];
#pragma unroll
            for (int m = 0; m < 4; ++m)
#pragma unroll
                for (int bj = 0; bj < 2; ++bj) gl[m][bj] = *(const f16x8*)(GTL + ((size_t)(16 + u.pn) * 66 + u.pm) * 65536 + (wr * 64 + fr + ai * HALF + m * 16) * 256 + wc * 32 + 8 * fq + bj * HALF);
            PIN8(gl[0][0], gl[0][1], gl[1][0], gl[1][1], gl[2][0], gl[2][1], gl[3][0], gl[3][1]);
#pragma unroll
            for (int m = 0; m < 4; ++m)
#pragma unroll
                for (int bj = 0; bj < 2; ++bj) { f16x8 w;
#pragma unroll
                    for (int j = 0; j < 4; ++j) { w[j] = (f16)(sigmoidf_((float)gl[m][bj][j]) * acc[ai][bj][m][0][j]); w[4 + j] = (f16)(sigmoidf_((float)gl[m][bj][4 + j]) * acc[ai][bj][m][1][j]); }
                    *(f16x8*)(M + (size_t)(row0 + ai * HALF + m * 16) * 2048 + col0 + bj * HALF) = w; }
            asm volatile("" ::: "memory"); }
    }
};
struct EpiUpAct {
    static constexpr bool PERM = true, HAS_MID = false; static constexpr int MID1 = 0, MID2 = 0; f16* ACT; float* HALO; const float* cw; const float* cb; LAS float* HL;
    __device__ __forceinline__ void operator()(AccRef acc, const Unit& u, int wr, int wc, int fr, int fq) const { fr = opq(fr); fq = opq(fq);
        const int lane = fq * 16 + fr;
#pragma unroll
        for (int ai = 0; ai < 2; ++ai) { LAS float* hp = HL + ((ai * 2 + wr) * 4 + wc) * 64 + 8 * fq;
            if (fr == 0) { *(LAS f32x4*)(hp) = acc[ai][0][0][0]; *(LAS f32x4*)(hp + 4) = acc[ai][0][0][1]; }
            if (fr == 15) { *(LAS f32x4*)(hp + 32) = acc[ai][0][3][0]; *(LAS f32x4*)(hp + 36) = acc[ai][0][3][1]; } }
        { float* gh = HALO + ((size_t)u.pm * 44 + u.pn) * 768 + wc * 32 + 8 * fq;
          if (wr == 0 && fr < 2) { *(f32x4*)(gh + fr * 128) = acc[0][0][0][0]; *(f32x4*)(gh + fr * 128 + 4) = acc[0][0][0][1]; }
          if (wr == 0 && fr == 0) { *(f32x4*)(gh + 4 * 128) = acc[0][1][0][0]; *(f32x4*)(gh + 4 * 128 + 4) = acc[0][1][0][1]; }
          if (wr == 1 && fr >= 14) { *(f32x4*)(gh + (fr - 12) * 128) = acc[1][0][3][0]; *(f32x4*)(gh + (fr - 12) * 128 + 4) = acc[1][0][3][1]; }
          if (wr == 1 && fr == 15) { *(f32x4*)(gh + 5 * 128) = acc[1][1][3][0]; *(f32x4*)(gh + 5 * 128 + 4) = acc[1][1][3][1]; } }
        asm volatile("s_waitcnt lgkmcnt(0)" ::: "memory"); __builtin_amdgcn_s_barrier(); __builtin_amdgcn_s_barrier(); asm volatile("" ::: "memory");
        const int colg = u.pn * 128 + wc * 32 + 8 * fq;
        const int srcR = (lane & 48) | ((fr + 15) & 15), srcL = (lane & 48) | ((fr + 1) & 15);
        const int row0 = u.pm * BM + wr * 64 + fr;
#pragma unroll
        for (int n = 0; n < 2; ++n) {
            const f32x4 w0 = *(const f32x4*)(cw + colg + 4 * n), w1 = *(const f32x4*)(cw + FFH + colg + 4 * n), w2 = *(const f32x4*)(cw + 2 * FFH + colg + 4 * n), bb = *(const f32x4*)(cb + colg + 4 * n);
#pragma unroll
            for (int ai = 0; ai < 2; ++ai) {
                const bool hasp = (wr == 1) || (ai == 1), hasn = (wr == 0) || (ai == 0);
                const LAS float* pp = HL + (((wr == 1 ? ai : 0) * 2 + (wr == 1 ? 0 : 1)) * 4 + wc) * 64 + 32 + 8 * fq + 4 * n;
                const LAS float* np = HL + (((wr == 0 ? ai : 1) * 2 + (wr == 0 ? 1 : 0)) * 4 + wc) * 64 + 8 * fq + 4 * n;
                const f32x4 hprev = hasp ? *(const LAS f32x4*)pp : (f32x4){0.f, 0.f, 0.f, 0.f}, hnext = hasn ? *(const LAS f32x4*)np : (f32x4){0.f, 0.f, 0.f, 0.f};
                f32x4 R[4], L[4];
#pragma unroll
                for (int m = 0; m < 4; ++m)
#pragma unroll
                    for (int j = 0; j < 4; ++j) { R[m][j] = __shfl(acc[ai][0][m][n][j], srcR); L[m][j] = __shfl(acc[ai][0][m][n][j], srcL); }
#pragma unroll
                for (int m = 0; m < 4; ++m) { const f32x4 pv = fr > 0 ? R[m] : (m > 0 ? R[m > 0 ? m - 1 : 0] : hprev); const f32x4 nv = fr < 15 ? L[m] : (m < 3 ? L[m < 3 ? m + 1 : 3] : hnext);
                    const f32x4 a = w0 * pv + w1 * acc[ai][0][m][n] + w2 * nv + bb;
                    f16x4 o;
#pragma unroll
                    for (int j = 0; j < 4; ++j) o[j] = (f16)(siluf_(a[j]) * acc[ai][1][m][n][j]);
                    *(f16x4*)(ACT + (size_t)(row0 + ai * HALF + m * 16) * FFH + colg + 4 * n) = o; }
                asm volatile("" ::: "memory");
            }
        }
    }
};
struct EpiSlab {
    static constexpr bool PERM = false, HAS_MID = false; static constexpr int MID1 = 0, MID2 = 0; float* slab; const float* mod; int goff;
    __device__ __forceinline__ void operator()(AccRef acc, const Unit& u, int wr, int wc, int fr, int fq) const { fr = opq(fr); fq = opq(fq);
        const int pn = u.pn & 255, ks = u.pn >> 8;
        const int row0 = (u.pm - 64) * BM + wr * 64 + fr, col0 = pn * BM + wc * 32 + 4 * fq;
        const float* gp = mod + 2 * 12288 + goff + col0;
        f32x4 gv[2][2];
#pragma unroll
        for (int bj = 0; bj < 2; ++bj)
#pragma unroll
            for (int n = 0; n < 2; ++n) gv[bj][n] = *(const f32x4*)(gp + bj * HALF + n * 16);
        float* sp = slab + (size_t)ks * MC * D;
#pragma unroll
        for (int ai = 0; ai < 2; ++ai)
#pragma unroll
            for (int m = 0; m < 4; ++m) { float* rowp = sp + (size_t)(row0 + ai * HALF + m * 16) * D + col0;
#pragma unroll
                for (int bj = 0; bj < 2; ++bj)
#pragma unroll
                    for (int n = 0; n < 2; ++n) *(f32x4*)(rowp + bj * HALF + n * 16) = gv[bj][n] * acc[ai][bj][m][n]; }
    }
};
struct EpiResid {
    static constexpr bool PERM = false, HAS_MID = false; static constexpr int MID1 = 0, MID2 = 0; float* X; const float* mod; int goff; const float* Xs;
    __device__ __forceinline__ void operator()(AccRef acc, const Unit& u, int wr, int wc, int fr, int fq) const { fr = opq(fr); fq = opq(fq);
        const int row0 = u.pm * BM + wr * 64 + fr, col0 = u.pn * BM + wc * 32 + 4 * fq;
        const int bsel = u.pm < 32 ? 0 : (u.pm < 64 ? 1 : 2);
        const float* gp = mod + bsel * 12288 + goff + col0;
        f32x4 gv[2][2];
#pragma unroll
        for (int bj = 0; bj < 2; ++bj)
#pragma unroll
            for (int n = 0; n < 2; ++n) gv[bj][n] = *(const f32x4*)(gp + bj * HALF + n * 16);
#pragma unroll
        for (int ai = 0; ai < 2; ++ai) { f32x4 xv[4][2][2];
#pragma unroll
            for (int m = 0; m < 4; ++m) { const float* rowp = Xs + (size_t)(row0 + ai * HALF + m * 16) * D + col0;
#pragma unroll
                for (int bj = 0; bj < 2; ++bj)
#pragma unroll
                    for (int n = 0; n < 2; ++n) xv[m][bj][n] = *(const f32x4*)(rowp + bj * HALF + n * 16); }
            PIN8(xv[0][0][0], xv[0][0][1], xv[0][1][0], xv[0][1][1], xv[1][0][0], xv[1][0][1], xv[1][1][0], xv[1][1][1]); PIN8(xv[2][0][0], xv[2][0][1], xv[2][1][0], xv[2][1][1], xv[3][0][0], xv[3][0][1], xv[3][1][0], xv[3][1][1]);
#pragma unroll
            for (int m = 0; m < 4; ++m) { float* rowp = X + (size_t)(row0 + ai * HALF + m * 16) * D + col0;
#pragma unroll
                for (int bj = 0; bj < 2; ++bj)
#pragma unroll
                    for (int n = 0; n < 2; ++n) *(f32x4*)(rowp + bj * HALF + n * 16) = xv[m][bj][n] + gv[bj][n] * acc[ai][bj][m][n]; }
            asm volatile("" ::: "memory"); }
    }
};
}


__device__ __forceinline__ void ph_prologue(const Ctx& F, const ArgsV& AV) {
    const int gt = F.bid * 512 + F.tid, NT = F.G * 512;
    { const f32x4* cs = (const f32x4*)AV.in(I_CTX); f32x4* xr = (f32x4*)(F.ws + WS_XRES);
      for (int i = gt; i < MC * D / 4; i += NT) xr[MX * D / 4 + i] = cs[i]; }
    LAS float* sc = (LAS float*)F.lds;
    LAS float* red = (LAS float*)(F.lds + 3 * 2048 * 4);
    for (int i = F.tid; i < 3 * 2048; i += 512) { const int r = i / 2048, k = i % 2048; const float v = r < 2 ? AV.in(I_C)[r * 2048 + k] : AV.in(I_CCTX)[k]; sc[i] = siluf_(v); }
    __syncthreads();
    const int col = F.tid & 63, ks = F.tid >> 6;
    for (int chunk = F.bid; chunk < DEPTH * 192; chunk += F.G) {
        const int l = chunk / 192, n0 = (chunk % 192) * 64;
        const float* w = AV.in(I_WMOD) + (size_t)l * 2048 * 12288 + n0 + col;
        float s0 = 0.f, s1 = 0.f, s2 = 0.f;
#pragma unroll 8
        for (int k = ks * 256; k < ks * 256 + 256; ++k) { const float wv = w[(size_t)k * 12288]; s0 += sc[k] * wv; s1 += sc[2048 + k] * wv; s2 += sc[4096 + k] * wv; }
        red[(ks * 3 + 0) * 64 + col] = s0; red[(ks * 3 + 1) * 64 + col] = s1; red[(ks * 3 + 2) * 64 + col] = s2;
        __syncthreads();
        if (F.tid < 192) { const int r = F.tid >> 6, c2 = F.tid & 63; float s = 0.f;
#pragma unroll
            for (int q = 0; q < 8; ++q) s += red[(q * 3 + r) * 64 + c2];
            ((float*)(F.ws + WS_MOD))[((size_t)l * 3 + r) * 12288 + n0 + c2] = s + AV.in(I_BMOD)[(size_t)l * 12288 + n0 + c2]; }
        __syncthreads();
    }
}

__device__ __forceinline__ void conv_item(const float* W, int ldw, int k0, int srccol, f16* WT, int dstrow, int ldk) {
    float v[64];
    const float* src = W + (size_t)k0 * ldw + (srccol >= 0 ? srccol : 0);
#pragma unroll
    for (int k = 0; k < 64; ++k) v[k] = src[(size_t)k * ldw];
#pragma unroll
    for (int k = 0; k < 64; k += 8) PIN8(v[k], v[k + 1], v[k + 2], v[k + 3], v[k + 4], v[k + 5], v[k + 6], v[k + 7]);
    f16* dst = WT + (size_t)dstrow * ldk + k0;
#pragma unroll
    for (int kg = 0; kg < 8; ++kg) { f16x8 o;
#pragma unroll
        for (int e = 0; e < 8; ++e) o[e] = srccol >= 0 ? (f16)v[8 * kg + e] : (f16)0.f;
        *(f16x8*)(dst + 8 * kg) = o; }
}
__device__ __forceinline__ void ph_convert_weights(const Ctx& F, const ArgsV& AV, int l) {
    const int skip = F.G > 64 ? 32 : 0;
    if (F.bid < skip) return;
    const int gw = (F.bid - skip) * 8 + F.wave, NGW = (F.G - skip) * 8, lane = F.lane;
    constexpr int I_IN = 32 * 180, I_GLU = 8 * 8, I_BR = 32 * 32, I_OUT = 32 * 32, I_UP = 32 * 176, I_DN = 88 * 32;
    constexpr int NIT = I_IN + I_GLU + I_BR + I_OUT + I_UP + I_DN;
    for (int it = gw; it < NIT; it += NGW) {
        int r = it;
        if (r < I_IN) { const int kb = r / 180, nb = r % 180, j = nb * 64 + lane;
            const int src = j < 2048 ? j : (j < 11264 ? j + 32 : (j < 11296 ? 2048 + (j - 11264) : -1));
            conv_item(AV.in(I_WIN) + (size_t)l * 2048 * INW, INW, kb * 64, src, (f16*)(F.ws + WS_WIN), j, 2048); continue; } r -= I_IN;
        if (r < I_GLU) { const int kb = r / 8, nb = r % 8, j = nb * 64 + lane; conv_item(AV.in(I_GLUW) + (size_t)l * 512 * 512, 512, kb * 64, j, (f16*)(F.ws + WS_WGLU), j, 512); continue; } r -= I_GLU;
        if (r < I_BR) { const int kb = r / 32, nb = r % 32, j = nb * 64 + lane; conv_item(AV.in(I_WBR) + (size_t)l * 2048 * 2048, 2048, kb * 64, j, (f16*)(F.ws + WS_WBR), j, 2048); continue; } r -= I_BR;
        if (r < I_OUT) { const int kb = r / 32, nb = r % 32, j = nb * 64 + lane; conv_item(AV.in(I_WOUT) + (size_t)l * 2048 * 2048, 2048, kb * 64, j, (f16*)(F.ws + WS_WOUT), j, 2048); continue; } r -= I_OUT;
        if (r < I_UP) { const int kb = r / 176, nb = r % 176, j = nb * 64 + lane, pn = j >> 8, i = j & 255; const int src = i < 128 ? 128 * pn + i : FFH + 128 * pn + (i - 128);
            conv_item(AV.in(I_WUP) + (size_t)l * 2048 * UPLD, UPLD, kb * 64, src, (f16*)(F.ws + WS_WUP), j, 2048); continue; } r -= I_UP;
        { const int kb = r / 32, nb = r % 32, j = nb * 64 + lane; conv_item(AV.in(I_WDN) + (size_t)l * FFH * 2048, 2048, kb * 64, j, (f16*)(F.ws + WS_WDN), j, FFH); }
    }
}

__device__ __forceinline__ void s5_mats_group(const Ctx& F, const ArgsV& AV, int l, int g) {
    LAS f32x2* APOW = (LAS f32x2*)F.lds;
    LAS f32x2* BBAR = APOW + 2 * 17 * 64;
    LAS f32x2* CM = BBAR + 2 * 64 * 16;
    LAS float* KLAG = (LAS float*)(CM + 2 * 16 * 64);
    __syncthreads();
    for (int i = F.tid; i < 2 * 17 * 64; i += 512) { const int d = i / (17 * 64), e = (i / 64) % 17, n = i % 64;
        const size_t pi = (((size_t)l * 2 + d) * 32 + g) * 64 + n;
        const float are = AV.in(I_S5ARE)[pi], aim = AV.in(I_S5AIM)[pi], dt = expf(AV.in(I_S5STEP)[((size_t)l * 2 + d) * 32 + g]);
        const float zr = are * dt * (float)e, zi = aim * dt * (float)e; float s, c; sincosf(zi, &s, &c); const float m = expf(zr);
        APOW[i] = (f32x2){m * c, m * s}; }
    __syncthreads();
    for (int i = F.tid; i < 2 * 64 * 16; i += 512) { const int d = i / 1024, n = (i / 16) % 64, h = i % 16;
        const size_t pi = (((size_t)l * 2 + d) * 32 + g) * 64 + n;
        const float are = AV.in(I_S5ARE)[pi], aim = AV.in(I_S5AIM)[pi];
        const f32x2 ab = APOW[(d * 17 + 1) * 64 + n]; const f32x2 num = (f32x2){ab.x - 1.0f, ab.y};
        const float den = are * are + aim * aim; const f32x2 q = (f32x2){(num.x * are + num.y * aim) / den, (num.y * are - num.x * aim) / den};
        const size_t bi = (pi * 16) + h;
        BBAR[i] = cmul(q, (f32x2){AV.in(I_S5BRE)[bi], AV.in(I_S5BIM)[bi]});
        const size_t ci = ((((size_t)l * 2 + d) * 32 + g) * 16 + h) * 64 + n;
        CM[(d * 16 + h) * 64 + n] = (f32x2){AV.in(I_S5CRE)[ci], AV.in(I_S5CIM)[ci]}; }
    __syncthreads();
    for (int i = F.tid; i < 2 * 16 * 256; i += 512) { const int d = i / 4096, lag = (i / 256) % 16, h = (i / 16) % 16, hp = i % 16; float s = 0.f;
        for (int n = 0; n < 64; ++n) { const f32x2 t = cmul(CM[(d * 16 + h) * 64 + n], APOW[(d * 17 + lag) * 64 + n]); const f32x2 b = BBAR[(d * 64 + n) * 16 + hp]; s += t.x * b.x - t.y * b.y; }
        KLAG[i] = s; }
    __syncthreads();
    f16* W = (f16*)(F.ws + WS_S5W) + (size_t)g * 256 * 512;
    for (int i = F.tid; i < 256 * 64; i += 512) { const int n = i / 64, k8 = (i % 64) * 8, t = n >> 4, h = n & 15; f16x8 o;
#pragma unroll
        for (int e = 0; e < 8; ++e) { const int k = k8 + e; float v;
            if (k < 256) { const int s = k >> 4, hp = k & 15; v = 0.f;
                if (t >= s) v += KLAG[((0 * 16 + (t - s)) * 16 + h) * 16 + hp];
                if (s >= t) v += KLAG[((1 * 16 + (s - t)) * 16 + h) * 16 + hp];
                v *= S5SCALE; }
            else { const int d = (k - 256) >> 7, nn2 = (k - 256) & 127, nn = nn2 & 63, im = nn2 >> 6, ex = d == 0 ? t + 1 : 16 - t;
                const f32x2 z = cmul(CM[(d * 16 + h) * 64 + nn], APOW[(d * 17 + ex) * 64 + nn]); v = im ? -z.y : z.x; }
            o[e] = (f16)v; }
        *(f16x8*)(W + (size_t)n * 512 + k8) = o; }
    f16* Mx = (f16*)(F.ws + WS_S5M) + (size_t)g * 256 * 256;
    for (int i = F.tid; i < 256 * 32; i += 512) { const int n = i / 32, k8 = (i % 32) * 8, d = n >> 7, ri = (n >> 6) & 1, nn = n & 63; f16x8 o;
#pragma unroll
        for (int e = 0; e < 8; ++e) { const int k = k8 + e, s = k >> 4, hp = k & 15, ex = d == 0 ? 15 - s : s;
            const f32x2 z = cmul(APOW[(d * 17 + ex) * 64 + nn], BBAR[(d * 64 + nn) * 16 + hp]); o[e] = (f16)((ri ? z.y : z.x) * S5SCALE); }
        *(f16x8*)(Mx + (size_t)n * 256 + k8) = o; }
    if (F.tid < 128) { const int d = F.tid >> 6, nn = F.tid & 63; ((f32x2*)(F.ws + WS_S5AT))[(d * 32 + g) * 64 + nn] = APOW[(d * 17 + 16) * 64 + nn]; }
    __syncthreads();
}

__device__ __forceinline__ void ph_hyena_h2(const Ctx& F, const ArgsV& AV, int l) {
    LAS float* W1 = (LAS float*)F.lds;
    LAS float* W2 = W1 + 33 * 64;
    LAS float* PV = W2 + 64 * 64;
    LAS float* SCR = PV + 256;
    __syncthreads();
    for (int i = F.tid; i < 33 * 64; i += 512) W1[i] = AV.in(I_HYW1)[(size_t)l * 33 * 64 + i];
    for (int i = F.tid; i < 64 * 64; i += 512) W2[i] = AV.in(I_HYW2)[(size_t)l * 4096 + i];
    if (F.tid < 64) { PV[F.tid] = AV.in(I_HYB1)[l * 64 + F.tid]; PV[64 + F.tid] = AV.in(I_HYF1)[l * 64 + F.tid]; PV[128 + F.tid] = AV.in(I_HYB2)[l * 64 + F.tid]; PV[192 + F.tid] = AV.in(I_HYF2)[l * 64 + F.tid]; }
    __syncthreads();
    LAS float* scr = SCR + F.wave * 64;
    const int gw = F.bid * 8 + F.wave, NGW = F.G * 8, j = F.lane;
    for (int p = gw; p < SEQ + LC; p += NGW) {
        const int n = p < SEQ ? SEQ : LC, pos = p < SEQ ? p : p - SEQ;
        float feat = 0.f;
        if (j == 0) feat = (float)pos / (float)(n - 1);
        else if (j < 33) { const int fi = (j - 1) & 15; const float fr = 1e-4f + (float)fi * ((15.0f - 1e-4f) / 15.0f);
            const float ang = (6.283185307179586f / (float)n) * (float)pos * fr; float s, c; sincosf(ang, &s, &c); feat = j < 17 ? c : -s; }
        scr[j] = feat; LDS_WAIT(); asm volatile("" ::: "memory");
        float a = PV[j];
        for (int i = 0; i < 33; ++i) a += scr[i] * W1[i * 64 + j];
        const float h1 = sinf(PV[64 + j] * a);
        LDS_WAIT(); asm volatile("" ::: "memory");
        scr[j] = h1; LDS_WAIT(); asm volatile("" ::: "memory");
        float b = PV[128 + j];
        for (int i = 0; i < 64; ++i) b += scr[i] * W2[i * 64 + j];
        ((f16*)(F.ws + WS_H2H))[((size_t)l * (SEQ + LC) + p) * 64 + j] = (f16)sinf(PV[192 + j] * b);
        LDS_WAIT(); asm volatile("" ::: "memory");
    }
}

__device__ __forceinline__ void ph_norm(const Ctx& F, const ArgsV& AV, int l, int which, int nrows, int nslab) {
    const int gw = F.bid * 8 + F.wave, NGW = F.G * 8;
    float* X = (float*)(F.ws + WS_XRES); f16* O = (f16*)(F.ws + WS_HN); const float* SL = (const float*)(F.ws + WS_SLAB);
    const float* Xin = (l == 0 && which == 0) ? AV.in(I_X) : X;
    const float* gain = AV.in(which ? I_N2G : I_N1G) + (size_t)l * D;
    const float* mod = (const float*)(F.ws + WS_MOD) + (size_t)l * 3 * 12288;
    const int shoff = which ? 6144 : 0, soff = which ? 8192 : 2048;
    int cur_bsel = -1; f32x4 Am[8], Bm[8], vn[8];
    if (gw < nrows) { const f32x4* xr0 = (const f32x4*)((gw < MX ? Xin : X) + (size_t)gw * D) + F.lane;
#pragma unroll
        for (int j = 0; j < 8; ++j) vn[j] = xr0[64 * j]; }
    for (int m = gw; m < nrows; m += NGW) {
        const int bsel = m < SEQ ? 0 : (m < MX ? 1 : 2);
        f32x4* xr = (f32x4*)(X + (size_t)m * D) + F.lane;
        f32x4 v[8]; float s = 0.f;
        PIN8(vn[0], vn[1], vn[2], vn[3], vn[4], vn[5], vn[6], vn[7]);
#pragma unroll
        for (int j = 0; j < 8; ++j) v[j] = vn[j];
        if (m + NGW < nrows) { const f32x4* xq = (const f32x4*)((m + NGW < MX ? Xin : X) + (size_t)(m + NGW) * D) + F.lane;
#pragma unroll
            for (int j = 0; j < 8; ++j) vn[j] = xq[64 * j]; }
        if (bsel != cur_bsel) { cur_bsel = bsel; const float* mp = mod + bsel * 12288;
#pragma unroll
            for (int j = 0; j < 8; ++j) { const int c = 4 * F.lane + 256 * j; const f32x4 g = *(const f32x4*)(gain + c), sc = *(const f32x4*)(mp + soff + c); Bm[j] = *(const f32x4*)(mp + shoff + c); Am[j] = g * (sc + 1.0f); }
            PIN8(Am[0], Am[1], Am[2], Am[3], Am[4], Am[5], Am[6], Am[7]); PIN8(Bm[0], Bm[1], Bm[2], Bm[3], Bm[4], Bm[5], Bm[6], Bm[7]); }
        if (m >= MX && nslab > 0) {
            for (int sl = 0; sl < nslab; ++sl) { const f32x4* sr = (const f32x4*)(SL + ((size_t)sl * MC + (m - MX)) * D) + F.lane;
#pragma unroll
                for (int j = 0; j < 8; ++j) v[j] = v[j] + sr[64 * j]; }
#pragma unroll
            for (int j = 0; j < 8; ++j) xr[64 * j] = v[j]; }
#pragma unroll
        for (int j = 0; j < 8; ++j) s += (v[j].x * v[j].x + v[j].y * v[j].y) + (v[j].z * v[j].z + v[j].w * v[j].w);
        const float rstd = 1.0f / sqrtf(wave_sum(s) * (1.0f / D) + EPS);
#pragma unroll
        for (int j = 0; j < 8; ++j) { const int c = 4 * F.lane + 256 * j;
            f16x4 o;
#pragma unroll
            for (int e = 0; e < 4; ++e) o[e] = (f16)(v[j][e] * rstd * Am[j][e] + Bm[j][e]);
            *(f16x4*)(O + (size_t)m * D + c) = o; }
    }
}
__device__ __forceinline__ void ph_final_norm(const Ctx& F, const ArgsV& AV) {
    const int gw = F.bid * 8 + F.wave, NGW = F.G * 8;
    const float* X = (const float*)(F.ws + WS_XRES); const float* gain = AV.in(I_FNG);
    f32x4 gm[8], vn[8];
#pragma unroll
    for (int j = 0; j < 8; ++j) gm[j] = *(const f32x4*)(gain + 4 * F.lane + 256 * j);
    if (gw < MX) { const f32x4* xr0 = (const f32x4*)(X + (size_t)gw * D) + F.lane;
#pragma unroll
        for (int j = 0; j < 8; ++j) vn[j] = xr0[64 * j]; }
    for (int m = gw; m < MX; m += NGW) {
        f32x4 v[8]; float s = 0.f;
        PIN8(vn[0], vn[1], vn[2], vn[3], vn[4], vn[5], vn[6], vn[7]);
#pragma unroll
        for (int j = 0; j < 8; ++j) v[j] = vn[j];
        if (m + NGW < MX) { const f32x4* xq = (const f32x4*)(X + (size_t)(m + NGW) * D) + F.lane;
#pragma unroll
            for (int j = 0; j < 8; ++j) vn[j] = xq[64 * j]; }
#pragma unroll
        for (int j = 0; j < 8; ++j) s += (v[j].x * v[j].x + v[j].y * v[j].y) + (v[j].z * v[j].z + v[j].w * v[j].w);
        const float rstd = 1.0f / sqrtf(wave_sum(s) * (1.0f / D) + EPS);
#pragma unroll
        for (int j = 0; j < 8; ++j) { const int c = 4 * F.lane + 256 * j;
            *(f32x4*)(AV.out + (size_t)m * D + c) = v[j] * rstd * gm[j]; }
    }
}

__device__ __forceinline__ void ph_s5_scan(const Ctx& F) {
    if (F.tid >= 32) return;
    const float* S = (const float*)(F.ws + WS_S5S); f16* SA = (f16*)(F.ws + WS_S5A);
    for (int gt = F.bid * 32 + F.tid; gt < 2 * 2 * 32 * 64; gt += F.G * 32) {
        const int nn = gt & 63, g = (gt >> 6) & 31, d = (gt >> 11) & 1, b = gt >> 12;
        const f32x2 at = ((const f32x2*)(F.ws + WS_S5AT))[(d * 32 + g) * 64 + nn];
        f32x2 st = (f32x2){0.f, 0.f};
        f32x2 la[16], lb[16];
#define S5_CHUNK(step) ((d == 0) ? ((step) < 16 ? 1024 + b * 16 + (step) : b * 512 + ((step) - 16)) : ((step) < 16 ? 1024 + b * 16 + (15 - (step)) : b * 512 + (511 - ((step) - 16))))
#define S5_LOAD(dst, base) do { _Pragma("unroll") for (int u = 0; u < 16; ++u) { const int stp = (base) + u < 528 ? (base) + u : 527; const size_t so = ((size_t)S5_CHUNK(stp) * 32 + g) * 256 + d * 128 + nn; dst[u] = (f32x2){S[so], S[so + 64]}; } } while (0)
#define S5_STEP(src, base) do { PIN8(src[0], src[1], src[2], src[3], src[4], src[5], src[6], src[7]); PIN8(src[8], src[9], src[10], src[11], src[12], src[13], src[14], src[15]); \
            _Pragma("unroll") for (int u = 0; u < 16; ++u) { f16* xp = SA + (size_t)S5_CHUNK((base) + u) * 16384 + (size_t)g * 512 + 256 + d * 128 + nn; xp[0] = (f16)st.x; xp[64] = (f16)st.y; st = cmul(at, st) + src[u]; } } while (0)
        S5_LOAD(la, 0);
        for (int base = 0; base < 528; base += 32) {
            S5_LOAD(lb, base + 16);
            S5_STEP(la, base);
            if (base + 16 < 528) { S5_LOAD(la, base + 32); S5_STEP(lb, base + 16); }
        }
#undef S5_CHUNK
#undef S5_LOAD
#undef S5_STEP
    }
}

__device__ __forceinline__ void ph_ffn_fix(const Ctx& F, const ArgsV& AV, int l, int nMr) {
    const float* HALO = (const float*)(F.ws + WS_HALO); f16* ACT = (f16*)(F.ws + WS_ACT);
    const float* cw = AV.in(I_FFCW) + (size_t)l * 3 * FFH; const float* cb = AV.in(I_FFCB) + (size_t)l * FFH;
    const int NT = nMr * 44 * 2 * 128;
    for (int task = F.bid * 512 + F.tid; task < NT; task += F.G * 512) {
        const int c = task & 127, which = (task >> 7) & 1, tile = task >> 8, pn = tile % 44, pm = tile / 44;
        const float* h = HALO + ((size_t)pm * 44 + pn) * 768 + c; const int col = pn * 128 + c;
        const bool first = (pm == 0 || pm == 32 || pm >= 64), last = (pm == 31 || pm >= 63);
        float ap, ac, an, b;
        if (which == 0) { ap = first ? 0.f : HALO[((size_t)(pm - 1) * 44 + pn) * 768 + 3 * 128 + c]; ac = h[0]; an = h[128]; b = h[4 * 128]; }
        else { ap = h[2 * 128]; ac = h[3 * 128]; an = last ? 0.f : HALO[((size_t)(pm + 1) * 44 + pn) * 768 + c]; b = h[5 * 128]; }
        const float a = cw[col] * ap + cw[FFH + col] * ac + cw[2 * FFH + col] * an + cb[col];
        ACT[(size_t)(pm * 256 + (which ? 255 : 0)) * FFH + col] = (f16)(siluf_(a) * b);
    }
}

namespace gla {
constexpr int QK_LD = 136, KH_LD = 72, VT_LD = 72, P_LD = 72;
constexpr int OFF_QT = 0;
constexpr int OFF_KT = 17408;
constexpr int OFF_VT = OFF_KT + 18432;
constexpr int OFF_P = OFF_VT + 36864;
constexpr int OFF_LR = OFF_P + 9216;
constexpr int OFF_GT = OFF_LR + 4096;
constexpr int OFF_DEC = OFF_GT + 2048;
constexpr int OFF_RS = OFF_DEC + 512;
constexpr int OFF_QR = OFF_RS + 2048;
constexpr int OFF_KR = OFF_QR + 17408;
constexpr int OFF_WG = OFF_KR + 17408;
static_assert(OFF_WG + 8192 <= LDSCTL_OFF, "gla lds");

__device__ __forceinline__ int grow(int b, int sc, int j, int i) {
    if (sc < 32) { const int col = 2 * sc + (j >> 1), r = (j & 1) * 64 + i; return b * SEQ + r * 64 + col; }
    return MX + b * LC + j * 64 + i;
}
__device__ __forceinline__ int prow(int b, int sc, int j, int i) {
    return sc < 32 ? b * SEQ + sc * 256 + j * 64 + i : MX + b * LC + j * 64 + i;
}
#define GLA_MFMA(a, b, c) __builtin_amdgcn_mfma_f32_16x16x32_f16(a, b, c, 0, 0, 0)

template <bool FULL>
__device__ __forceinline__ void gla_unit(const Ctx& F, const ArgsV& AV, int l, int unit) {
    const int b = unit / (4 * NSC), h = (unit / NSC) % 4, sc = unit % NSC;
    LAS f16* QT = (LAS f16*)(F.lds + OFF_QT); LAS f16* KT = (LAS f16*)(F.lds + OFF_KT); LAS f16* VT = (LAS f16*)(F.lds + OFF_VT);
    LAS f16* PP = (LAS f16*)(F.lds + OFF_P); LAS f16* LR = (LAS f16*)(F.lds + OFF_LR);
    LAS float* GT = (LAS float*)(F.lds + OFF_GT); LAS float* DEC = (LAS float*)(F.lds + OFF_DEC); LAS float* RS = (LAS float*)(F.lds + OFF_RS);
    LAS f16* QR = (LAS f16*)(F.lds + OFF_QR); LAS f16* KR = (LAS f16*)(F.lds + OFF_KR); LAS float* WG = (LAS float*)(F.lds + OFF_WG);
    const int tid = F.tid, lane = F.lane, w = F.wave, q0 = lane >> 4, c0 = lane & 15;
    const int dk0 = tid & 127, ig0 = tid >> 7;
    const f16* PX = (const f16*)(F.ws + WS_PX);
    const float scale = 0.08838834764831845f;
    for (int dir = 0; dir < 2; ++dir) {
        __syncthreads();
        for (int i = tid; i < 16 * 128; i += 512) WG[i] = AV.in(I_GLAWG)[(((size_t)l * 2 + dir) * 16 + (i >> 7)) * 512 + h * 128 + (i & 127)];
        const float bgv = AV.in(I_GLABG)[((size_t)l * 2 + dir) * 512 + h * 128 + dk0];
        const size_t sidx = ((((size_t)b * 4 + h) * NSC + sc) * 2 + dir);
        f32x4 accS[8][2];
        if (FULL && sc < 32) { const float* Sin = (const float*)(F.ws + WS_GSIN) + sidx * 32768; const int q = opq(q0), c = opq(c0);
#pragma unroll
            for (int dt = 0; dt < 8; ++dt)
#pragma unroll
                for (int et = 0; et < 2; ++et)
#pragma unroll
                    for (int r = 0; r < 4; ++r) accS[dt][et][r] = Sin[(16 * dt + 4 * q + r) * 256 + 32 * w + 16 * et + c];
            PIN8(accS[0][0], accS[0][1], accS[1][0], accS[1][1], accS[2][0], accS[2][1], accS[3][0], accS[3][1]); PIN8(accS[4][0], accS[4][1], accS[5][0], accS[5][1], accS[6][0], accS[6][1], accS[7][0], accS[7][1]); }
        else {
#pragma unroll
            for (int dt = 0; dt < 8; ++dt)
#pragma unroll
                for (int et = 0; et < 2; ++et) accS[dt][et] = (f32x4){0.f, 0.f, 0.f, 0.f}; }
        float sumtot = 0.f;
#define GLA_FETCH(jn) f16x8 pf_lr, pf_v[4], pf_k[2], pf_q[2]; do { const int tf = opq(F.tid); \
            { const int row = (tf & 255) >> 2, part = tf & 3; pf_lr = *(const f16x8*)(PX + (size_t)prow(b, sc, (jn), row) * PXLD + P_GG + part * 8); } \
            _Pragma("unroll") for (int k = 0; k < 4; ++k) { const int idx = tf + 512 * k, wi = idx >> 6, ln = idx & 63, rr = ln >> 2, cc = ln & 3; const int row = (wi & 3) * 16 + rr, chunk = (wi >> 2) * 4 + cc; \
                pf_v[k] = *(const f16x8*)(PX + (size_t)prow(b, sc, (jn), row) * PXLD + P_GV + h * 256 + chunk * 8); } \
            _Pragma("unroll") for (int k = 0; k < 2; ++k) { const int idx = tf + 512 * k, row = idx >> 4, ch = idx & 15; const size_t ro = (size_t)prow(b, sc, (jn), row) * PXLD; \
                pf_k[k] = *(const f16x8*)(PX + ro + P_GK + h * 128 + ch * 8); if (FULL) pf_q[k] = *(const f16x8*)(PX + ro + P_GQ + h * 128 + ch * 8); else pf_q[k] = pf_k[k]; } } while (0)
        for (int jj = 0; jj < 4; ++jj) {
            const int j = dir ? 3 - jj : jj;
            if (FULL) {
            GLA_FETCH(j);
            __syncthreads();
            const int tid = opq(F.tid);
            PIN8(pf_lr, pf_v[0], pf_v[1], pf_v[2], pf_v[3], pf_k[0], pf_k[1], pf_q[0]); asm volatile("" : "+v"(pf_q[1]));
            if (tid < 256) { const int row = tid >> 2, part = tid & 3; *(LAS f16x8*)(LR + row * 32 + part * 8) = pf_lr; }
#pragma unroll
            for (int k = 0; k < 4; ++k) { const int idx = opq(tid) + 512 * k, wi = idx >> 6, ln = idx & 63, rr = ln >> 2, cc = ln & 3;
                const int row = (wi & 3) * 16 + rr, chunk = (wi >> 2) * 4 + cc; LAS f16* vp = VT + (chunk * 8) * VT_LD + row;
#pragma unroll
                for (int e = 0; e < 8; ++e) vp[e * VT_LD] = pf_v[k][e]; }
#pragma unroll
            for (int k = 0; k < 2; ++k) { const int idx = tid + 512 * k, row = idx >> 4, ch = idx & 15;
                *(LAS f16x8*)(KR + row * QK_LD + ch * 8) = pf_k[k];
                *(LAS f16x8*)(QR + row * QK_LD + ch * 8) = pf_q[k]; }
            } else {
            __syncthreads();
            const int tid = opq(F.tid);
            if (tid < 256) { const int row = tid >> 2, part = tid & 3; const int gr = prow(b, sc, j, row);
                *(LAS f16x8*)(LR + row * 32 + part * 8) = *(const f16x8*)(PX + (size_t)gr * PXLD + P_GG + part * 8); }
#pragma unroll 1
            for (int k = 0; k < 4; ++k) { const int idx = tid + 512 * k, wi = idx >> 6, ln = idx & 63, rr = ln >> 2, cc = ln & 3;
                const int row = (wi & 3) * 16 + rr, chunk = (wi >> 2) * 4 + cc; const int gr = prow(b, sc, j, row);
                const f16x8 v8 = *(const f16x8*)(PX + (size_t)gr * PXLD + P_GV + h * 256 + chunk * 8);
#pragma unroll
                for (int e = 0; e < 8; ++e) VT[(chunk * 8 + e) * VT_LD + row] = v8[e]; }
#pragma unroll 1
            for (int k = 0; k < 2; ++k) { const int idx = tid + 512 * k, row = idx >> 4, ch = idx & 15; const int gr = prow(b, sc, j, row);
                *(LAS f16x8*)(KR + row * QK_LD + ch * 8) = *(const f16x8*)(PX + (size_t)gr * PXLD + P_GK + h * 128 + ch * 8); }
            }
            __syncthreads();
            const int dk = opq(dk0), ig = opq(ig0);
            float bv[16];
#pragma unroll
            for (int ii = 0; ii < 16; ++ii) { const int i = ig * 16 + ii; float pre = bgv;
                const f16x8 l0 = *(const LAS f16x8*)(LR + i * 32 + dir * 16), l1 = *(const LAS f16x8*)(LR + i * 32 + dir * 16 + 8);
#pragma unroll
                for (int r = 0; r < 8; ++r) pre += (float)l0[r] * WG[r * 128 + dk] + (float)l1[r] * WG[(8 + r) * 128 + dk];
                bv[ii] = logsigmoidf_(pre) * (1.0f / 16.0f); }
            float totloc;
            if (dir == 0) {
#pragma unroll
                for (int ii = 1; ii < 16; ++ii) bv[ii] += bv[ii - 1];
                totloc = bv[15]; }
            else {
#pragma unroll
                for (int ii = 14; ii >= 0; --ii) bv[ii] += bv[ii + 1];
                totloc = bv[0]; }
            GT[ig * 128 + dk] = totloc;
            __syncthreads();
            const float g0 = GT[dk], g1 = GT[128 + dk], g2 = GT[256 + dk], g3 = GT[384 + dk];
            const float total = (g0 + g1) + (g2 + g3);
            float off, bmid;
            if (dir == 0) { off = (ig > 0 ? g0 : 0.f) + (ig > 1 ? g1 : 0.f) + (ig > 2 ? g2 : 0.f); bmid = g0 + g1; }
            else { off = (ig < 3 ? g3 : 0.f) + (ig < 2 ? g2 : 0.f) + (ig < 1 ? g1 : 0.f); bmid = g2 + g3; }
#pragma unroll
            for (int ii = 0; ii < 16; ++ii) bv[ii] += off;
            if (FULL) {
#pragma unroll
                for (int ii = 0; ii < 16; ++ii) { const int i = ig * 16 + ii;
                    QT[i * QK_LD + dk] = (f16)((float)QR[i * QK_LD + dk] * scale * __expf(fminf(bv[ii] - bmid, 9.f)));
                    KT[i * QK_LD + dk] = (f16)((float)KR[i * QK_LD + dk] * __expf(fminf(bmid - bv[ii], 9.f))); }
                __syncthreads();
                { const int c = opq(c0), q = opq(q0);
#pragma unroll
                for (int s = 0; s < 2; ++s) { const int T = 2 * w + s, it = T >> 2, jt = T & 3; f32x4 a = (f32x4){0.f, 0.f, 0.f, 0.f};
#pragma unroll
                    for (int kk = 0; kk < 4; ++kk) { const f16x8 kf = *(const LAS f16x8*)(KT + (jt * 16 + c) * QK_LD + kk * 32 + 8 * q);
                        const f16x8 qf = *(const LAS f16x8*)(QT + (it * 16 + c) * QK_LD + kk * 32 + 8 * q); a = GLA_MFMA(kf, qf, a); }
                    const int i = it * 16 + c; f16x4 pv;
#pragma unroll
                    for (int r = 0; r < 4; ++r) { const int jx = jt * 16 + 4 * q + r; const bool keep = dir == 0 ? (jx <= i) : (jx >= i); pv[r] = keep ? (f16)a[r] : (f16)0.f; }
                    *(LAS f16x4*)(PP + i * P_LD + jt * 16 + 4 * q) = pv; } }
                __syncthreads();
#pragma unroll
                for (int ii = 0; ii < 16; ++ii) { const int i = ig * 16 + ii; QT[i * QK_LD + dk] = (f16)((float)QR[i * QK_LD + dk] * scale * __expf(bv[ii])); }
            }
            { f16x8 k0, k1;
#pragma unroll
              for (int ii = 0; ii < 8; ++ii) { k0[ii] = (f16)((float)KR[(ig * 16 + ii) * QK_LD + dk] * __expf(total - bv[ii])); k1[ii] = (f16)((float)KR[(ig * 16 + 8 + ii) * QK_LD + dk] * __expf(total - bv[8 + ii])); }
              *(LAS f16x8*)(KT + dk * KH_LD + ig * 16) = k0; *(LAS f16x8*)(KT + dk * KH_LD + ig * 16 + 8) = k1; }
            if (ig == 0) { DEC[dk] = __expf(total); sumtot += total; }
            __syncthreads();
            const int c = opq(c0), q = opq(q0);
            if (FULL) {
                f32x4 accO[4][2];
#pragma unroll
                for (int it = 0; it < 4; ++it)
#pragma unroll
                    for (int et = 0; et < 2; ++et) accO[it][et] = (f32x4){0.f, 0.f, 0.f, 0.f};
#pragma unroll
                for (int et = 0; et < 2; ++et)
#pragma unroll
                    for (int kk = 0; kk < 2; ++kk) { const f16x8 vf = *(const LAS f16x8*)(VT + (32 * w + 16 * et + c) * VT_LD + kk * 32 + 8 * q);
#pragma unroll
                        for (int it = 0; it < 4; ++it) { const f16x8 pf = *(const LAS f16x8*)(PP + (it * 16 + c) * P_LD + kk * 32 + 8 * q); accO[it][et] = GLA_MFMA(vf, pf, accO[it][et]); } asm volatile("" ::: "memory"); }
#pragma unroll
                for (int kb = 0; kb < 4; ++kb)
#pragma unroll
                    for (int et = 0; et < 2; ++et) { f16x8 sf; asm volatile("" ::: "memory");
#pragma unroll
                        for (int e = 0; e < 4; ++e) { sf[e] = (f16)accS[2 * kb][et][e]; sf[4 + e] = (f16)accS[2 * kb + 1][et][e]; }
#pragma unroll
                        for (int it = 0; it < 4; ++it) { const f16x4 lo = *(const LAS f16x4*)(QT + (it * 16 + c) * QK_LD + 32 * kb + 4 * q), hi = *(const LAS f16x4*)(QT + (it * 16 + c) * QK_LD + 32 * kb + 16 + 4 * q);
                            f16x8 qf; qf[0] = lo[0]; qf[1] = lo[1]; qf[2] = lo[2]; qf[3] = lo[3]; qf[4] = hi[0]; qf[5] = hi[1]; qf[6] = hi[2]; qf[7] = hi[3];
                            accO[it][et] = GLA_MFMA(sf, qf, accO[it][et]); } }
                float* OF = (float*)(F.ws + WS_GOF);
                if (dir == 0) {
#pragma unroll
                    for (int it = 0; it < 4; ++it) { const int gr = prow(b, sc, j, it * 16 + c);
#pragma unroll
                        for (int et = 0; et < 2; ++et) *(f32x4*)(OF + (size_t)gr * 1024 + h * 256 + 32 * w + 16 * et + 4 * q) = accO[it][et];
                        asm volatile("" ::: "memory"); } }
                else {
                    int grs[4]; f32x4 ofv[4][2]; f16x4 rvv[4][2];
#pragma unroll
                    for (int it = 0; it < 4; ++it) { grs[it] = prow(b, sc, j, it * 16 + c);
#pragma unroll
                        for (int et = 0; et < 2; ++et) { ofv[it][et] = *(const f32x4*)(OF + (size_t)grs[it] * 1024 + h * 256 + 32 * w + 16 * et + 4 * q);
                            rvv[it][et] = *(const f16x4*)(PX + (size_t)grs[it] * PXLD + P_GR + h * 256 + 32 * w + 16 * et + 4 * q); } }
                    PIN8(ofv[0][0], ofv[0][1], ofv[1][0], ofv[1][1], ofv[2][0], ofv[2][1], ofv[3][0], ofv[3][1]);
#pragma unroll
                    for (int it = 0; it < 4; ++it) { float ss = 0.f;
#pragma unroll
                        for (int et = 0; et < 2; ++et) { accO[it][et] = accO[it][et] + ofv[it][et];
                            ss += (accO[it][et][0] * accO[it][et][0] + accO[it][et][1] * accO[it][et][1]) + (accO[it][et][2] * accO[it][et][2] + accO[it][et][3] * accO[it][et][3]); }
                        ss += __shfl_xor(ss, 16); ss += __shfl_xor(ss, 32);
                        if (q == 0) RS[(it * 16 + c) * 8 + w] = ss; }
                    __syncthreads();
                    PIN8(rvv[0][0], rvv[0][1], rvv[1][0], rvv[1][1], rvv[2][0], rvv[2][1], rvv[3][0], rvv[3][1]);
                    const float* ng = AV.in(I_GLANG) + (size_t)l * 256;
                    f16* Y = (f16*)(F.ws + WS_YCAT);
#pragma unroll
                    for (int it = 0; it < 4; ++it) { const int i = it * 16 + c; const f32x4 ra = *(const LAS f32x4*)(RS + i * 8), rb = *(const LAS f32x4*)(RS + i * 8 + 4);
                        const float tot = ((ra[0] + ra[1]) + (ra[2] + ra[3])) + ((rb[0] + rb[1]) + (rb[2] + rb[3]));
                        const float rstd = 1.0f / sqrtf(tot * (1.0f / 256.0f) + EPS);
#pragma unroll
                        for (int et = 0; et < 2; ++et) { const int e0 = 32 * w + 16 * et + 4 * q;
                            const f32x4 gv = *(const f32x4*)(ng + e0);
                            f16x4 o;
#pragma unroll
                            for (int r = 0; r < 4; ++r) o[r] = (f16)(accO[it][et][r] * rstd * gv[r] * siluf_((float)rvv[it][et][r]));
                            *(f16x4*)(Y + (size_t)grow(b, sc, j, it * 16 + c) * 2048 + 1024 + h * 256 + e0) = o; } }
                }
            }
#pragma unroll
            for (int dt = 0; dt < 8; ++dt) { const f32x4 dv = *(const LAS f32x4*)(DEC + 16 * dt + 4 * q);
#pragma unroll
                for (int et = 0; et < 2; ++et) accS[dt][et] = accS[dt][et] * dv; }
#pragma unroll
            for (int kk = 0; kk < 2; ++kk) { f16x8 vf[2];
#pragma unroll
                for (int et = 0; et < 2; ++et) vf[et] = *(const LAS f16x8*)(VT + (32 * w + 16 * et + c) * VT_LD + kk * 32 + 8 * q);
#pragma unroll
                for (int dt = 0; dt < 8; ++dt) { const f16x8 kf = *(const LAS f16x8*)(KT + (16 * dt + c) * KH_LD + kk * 32 + 8 * q);
#pragma unroll
                    for (int et = 0; et < 2; ++et) accS[dt][et] = GLA_MFMA(kf, vf[et], accS[dt][et]); if (dt & 1) asm volatile("" ::: "memory"); } }
        }
        if (!FULL) { float* Sl = (float*)(F.ws + WS_GSLOC) + sidx * 32768; const int q = opq(q0), c = opq(c0);
#pragma unroll
            for (int dt = 0; dt < 8; ++dt)
#pragma unroll
                for (int et = 0; et < 2; ++et)
#pragma unroll
                    for (int r = 0; r < 4; ++r) Sl[(16 * dt + 4 * q + r) * 256 + 32 * w + 16 * et + c] = accS[dt][et][r];
            if (ig0 == 0) ((float*)(F.ws + WS_GDT))[sidx * 128 + dk0] = __expf(sumtot); }
        VM_WAIT();
    }
}
__device__ __forceinline__ void ph_gla_scan(const Ctx& F) {
    const float* Sl = (const float*)(F.ws + WS_GSLOC); float* Si = (float*)(F.ws + WS_GSIN); const float* Dt = (const float*)(F.ws + WS_GDT);
    if (F.tid < 64) return;
    for (int gt = F.bid * 448 + (F.tid - 64); gt < 2 * 4 * 2 * 32768; gt += F.G * 448) {
        const int e = gt & 32767, dir = (gt >> 15) & 1, h = (gt >> 16) & 3, b = gt >> 18;
        float S = 0.f;
        for (int base = 0; base < NSC; base += 11) {
            float sl[11], dt[11]; size_t ix[11];
#pragma unroll
            for (int u = 0; u < 11; ++u) { const int step = base + u; const int sc = step == 0 ? 32 : (dir == 0 ? step - 1 : 32 - step);
                const size_t idx = ((((size_t)b * 4 + h) * NSC + sc) * 2 + dir); ix[u] = idx;
                sl[u] = Sl[idx * 32768 + e]; dt[u] = Dt[idx * 128 + (e >> 8)]; }
            PIN8(sl[0], sl[1], sl[2], sl[3], sl[4], sl[5], sl[6], sl[7]); PIN8(dt[0], dt[1], dt[2], dt[3], dt[4], dt[5], dt[6], dt[7]); PIN4(sl[8], sl[9], sl[10], dt[8]); asm volatile("" : "+v"(dt[9]), "+v"(dt[10]));
#pragma unroll
            for (int u = 0; u < 11; ++u) { Si[ix[u] * 32768 + e] = S; S = dt[u] * S + sl[u]; }
        }
    }
}
#undef GLA_FETCH
#undef GLA_MFMA
}

namespace hy {
#define PADI(i) ((i) + ((i) >> 5))
constexpr int HY_BUF_BYTES = (16384 + 512) * 8;
constexpr int HY_SCR_OFF = HY_BUF_BYTES;
static_assert(HY_SCR_OFF + 2048 <= LDSCTL_OFF, "hyena lds");
__device__ __forceinline__ f32x2 twid(int k, float invN) { const float xr = (float)k * invN; return (f32x2){__builtin_amdgcn_cosf(xr), -__builtin_amdgcn_sinf(xr)}; }
__device__ __forceinline__ f32x2 mul_w16(f32x2 d, int a) {
    constexpr float c1 = 0.9238795325112867f, s1 = 0.3826834323650898f, r = 0.7071067811865476f;
    float c, s;
    switch (a & 15) {
        case 0: return d; case 4: return (f32x2){d.y, -d.x}; case 8: return (f32x2){-d.x, -d.y}; case 12: return (f32x2){-d.y, d.x};
        case 1: c = c1; s = s1; break; case 2: c = r; s = r; break; case 3: c = s1; s = c1; break;
        case 5: c = -s1; s = c1; break; case 6: c = -r; s = r; break; case 7: c = -c1; s = s1; break;
        case 9: c = -c1; s = -s1; break; case 10: c = -r; s = -r; break; case 11: c = -s1; s = -c1; break;
        case 13: c = s1; s = -c1; break; case 14: c = r; s = -r; break; default: c = c1; s = -s1; break; }
    return (f32x2){d.x * c + d.y * s, d.y * c - d.x * s};
}
template <int R> __device__ __forceinline__ void dif_pass(LAS f32x2* x, int m, int lh, int tid) {
    const int N = 1 << m; const float invN = 1.0f / (float)N; const int lg = lh - R + 1, g = 1 << lg, S = (N >> 1) >> lh;
    for (int q = tid; q < (N >> R); q += 512) { const int j = q & (g - 1), blk = q >> lg, base = (blk << (lh + 1)) + j;
        f32x2 v[1 << R];
#pragma unroll
        for (int k = 0; k < (1 << R); ++k) v[k] = x[PADI(base + k * g)];
        f32x2 w = twid(j * S, invN);
#pragma unroll
        for (int s = 0; s < R; ++s) { const int half = 1 << (R - 1 - s);
#pragma unroll
            for (int k = 0; k < (1 << R); ++k) if (!(k & half)) { const f32x2 a = v[k], b = v[k + half]; v[k] = a + b;
                v[k + half] = mul_w16(cmul(a - b, w), ((k & (half - 1)) << s) * (16 >> R)); }
            w = cmul(w, w); }
#pragma unroll
        for (int k = 0; k < (1 << R); ++k) x[PADI(base + k * g)] = v[k]; }
    __syncthreads();
}
template <int R> __device__ __forceinline__ void dit_pass(LAS f32x2* x, int m, int lh, int tid) {
    const int N = 1 << m; const float invN = 1.0f / (float)N; const int h = 1 << lh, S1 = (N >> 1) >> lh;
    for (int q = tid; q < (N >> R); q += 512) { const int j = q & (h - 1), blk = q >> lh, base = (blk << (lh + R)) + j;
        f32x2 v[1 << R];
#pragma unroll
        for (int k = 0; k < (1 << R); ++k) v[k] = x[PADI(base + k * h)];
        f32x2 wp[R]; wp[R - 1] = cconj(twid(j * (S1 >> (R - 1)), invN));
#pragma unroll
        for (int s = R - 2; s >= 0; --s) wp[s] = cmul(wp[s + 1], wp[s + 1]);
#pragma unroll
        for (int s = 0; s < R; ++s) { const int half = 1 << s;
#pragma unroll
            for (int k = 0; k < (1 << R); ++k) if (!(k & half)) { const f32x2 a = v[k];
                const f32x2 b = mul_w16(cmul(v[k + half], wp[s]), (16 - (k & (half - 1)) * (16 >> (s + 1))) & 15);
                v[k] = a + b; v[k + half] = a - b; } }
#pragma unroll
        for (int k = 0; k < (1 << R); ++k) x[PADI(base + k * h)] = v[k]; }
    __syncthreads();
}
__device__ __forceinline__ void fft_fwd(LAS f32x2* x, int m, int tid) {
    int lh = m - 1;
    while (lh + 1 >= 4) { dif_pass<4>(x, m, lh, tid); lh -= 4; }
    if (lh + 1 == 2) dif_pass<2>(x, m, 1, tid); else if (lh + 1 == 1) dif_pass<1>(x, m, 0, tid);
}
__device__ __forceinline__ void fft_inv(LAS f32x2* x, int m, int tid) {
    int lh = 0;
    while (m - lh >= 4) { dit_pass<4>(x, m, lh, tid); lh += 4; }
    if (m - lh == 2) dit_pass<2>(x, m, lh, tid); else if (m - lh == 1) dit_pass<1>(x, m, lh, tid);
}
__device__ __forceinline__ int brev(int k, int m) { return (int)(__brev((unsigned)k) >> (32 - m)); }

__device__ __forceinline__ void filt_unit(const Ctx& F, const ArgsV& AV, int l, int unit) {
    const int kind = unit >> 9, o = (unit >> 8) & 1, pair = unit & 255;
    const int n = kind ? LC : SEQ, m = kind ? 9 : 14, N = 2 * n, tid = F.tid;
    LAS f32x2* buf = (LAS f32x2*)F.lds;
    LAS float* W3 = (LAS float*)(F.lds + HY_SCR_OFF);
    LAS float* B3 = W3 + 256;
    LAS float* RED = B3 + 4;
    LAS float* INV = RED + 16;
    __syncthreads();
    if (tid < 4) { const int ci = tid; const int col = o * 1024 + (ci >> 1) * 512 + 2 * pair + (ci & 1); B3[ci] = AV.in(I_HYB3)[(size_t)l * 2048 + col]; }
    __syncthreads();
    const int lane = F.lane, q = lane >> 4, c = lane & 15;
    f16x8 wB0, wB1;
    { const int col = o * 1024 + ((c & 3) >> 1) * 512 + 2 * pair + (c & 1); const float* w3 = AV.in(I_HYW3) + (size_t)l * 64 * 2048 + col;
#pragma unroll
      for (int j = 0; j < 8; ++j) { wB0[j] = c < 4 ? (f16)w3[(size_t)(8 * q + j) * 2048] : (f16)0.f; wB1[j] = c < 4 ? (f16)w3[(size_t)(32 + 8 * q + j) * 2048] : (f16)0.f; } }
    const f16* H2H = (const f16*)(F.ws + WS_H2H) + ((size_t)l * (SEQ + LC) + (kind ? SEQ : 0)) * 64;
    const float lo = -3.0701134573253945f, hi = -15.350567286626973f;
    const float ra = fabsf(lo + (hi - lo) * (float)(2 * pair) / 511.0f), rb = fabsf(lo + (hi - lo) * (float)(2 * pair + 1) / 511.0f);
    const float rate = (c & 1) ? rb : ra, bias3 = B3[c & 3];
    float sabs = 0.f;
    for (int tile = F.wave; tile < (n >> 4); tile += 8) { const int t0 = tile * 16;
        const f16x8 a0 = *(const f16x8*)(H2H + (size_t)(t0 + c) * 64 + 8 * q), a1 = *(const f16x8*)(H2H + (size_t)(t0 + c) * 64 + 32 + 8 * q);
        f32x4 acc = (f32x4){0.f, 0.f, 0.f, 0.f};
        acc = __builtin_amdgcn_mfma_f32_16x16x32_f16(a0, wB0, acc, 0, 0, 0); acc = __builtin_amdgcn_mfma_f32_16x16x32_f16(a1, wB1, acc, 0, 0, 0);
        if (c < 4) {
#pragma unroll
            for (int i = 0; i < 4; ++i) { const int t = t0 + 4 * q + i; const float v = (acc[i] + bias3) * expf(-((float)t / (float)(n - 1)) * rate);
                LAS float* bp = (LAS float*)buf;
                if (c < 2) { bp[2 * PADI(t) + c] = v; sabs += fabsf(v); }
                else if (t >= 1) { bp[2 * PADI(N - t) + (c - 2)] = v; sabs += fabsf(v); } } }
    }
    float sa = (c == 0 || c == 2) ? sabs : 0.f, sb = (c == 1 || c == 3) ? sabs : 0.f;
    if (tid == 0) { float z0 = 0.f; asm volatile("" : "+v"(z0)); buf[PADI(n)] = (f32x2){z0, z0}; }
    sa = wave_sum(sa); sb = wave_sum(sb);
    if (F.lane == 0) { RED[F.wave * 2] = sa; RED[F.wave * 2 + 1] = sb; }
    __syncthreads();
    if (tid < 2) { float s = 0.f;
#pragma unroll
        for (int w = 0; w < 8; ++w) s += RED[w * 2 + tid];
        INV[tid] = 1.0f / (s + EPS); }
    __syncthreads();
    { const float ia = INV[0], ib = INV[1];
      for (int i = tid; i < N; i += 512) { f32x2 v = buf[PADI(i)]; v.x *= ia; v.y *= ib; buf[PADI(i)] = v; } }
    __syncthreads();
    fft_fwd(buf, m, tid);
    f32x4* out = (f32x4*)(F.ws + ((l & 1) ? WS_FSD2 : WS_FSD) + (kind ? FSD_C_OFF : 0)) + (size_t)(o * 256 + pair) * (n + 1);
    for (int u = tid; u <= n; u += 512) { const int p = u < n ? 2 * u : 1, k = brev(p, m), pn = brev((N - k) & (N - 1), m);
        const f32x2 zk = buf[PADI(p)], zn = cconj(buf[PADI(pn)]);
        const f32x2 fa = (zk + zn) * 0.5f, df = zk - zn, fb = (f32x2){df.y * 0.5f, -df.x * 0.5f};
        const f32x2 fs = (fa + fb) * 0.5f, fd = (fa - fb) * 0.5f;
        out[u] = (f32x4){fs.x, fs.y, fd.x, fd.y}; }
    __syncthreads();
}

__device__ __forceinline__ void main_unit(const Ctx& F, const ArgsV& AV, int l, int unit) {
    const int kind = unit >> 9, b = (unit >> 8) & 1, pair = unit & 255;
    const int n = kind ? LC : SEQ, m = kind ? 9 : 14, N = 2 * n, tid = F.tid;
    const int row0 = kind ? MX + b * LC : b * SEQ;
    LAS f32x2* buf = (LAS f32x2*)F.lds;
    const f16* ZT = (const f16*)(F.ws + WS_ZT) + (size_t)(2 * pair) * MT + row0;
    const float* cw = AV.in(I_HYCW) + (size_t)l * 3 * 1536 + 2 * pair; const float* cb = AV.in(I_HYCB) + (size_t)l * 1536 + 2 * pair;
    f32x2 yv[16], g1[16], g2[16];
#pragma unroll
    for (int g = 0; g < 3; ++g)
#pragma unroll
        for (int cc = 0; cc < 2; ++cc) { const float w0 = cw[g * 512 + cc], w1 = cw[1536 + g * 512 + cc], w2 = cw[3072 + g * 512 + cc], bs = cb[g * 512 + cc];
            const f16* zt = ZT + (size_t)(g * 512 + cc) * MT;
#pragma unroll
            for (int gi = 0; gi < 2; ++gi) { const int t0 = 8 * (tid + 512 * gi);
                f16x8 mv; float pv = 0.f, nv = 0.f;
#pragma unroll
                for (int e = 0; e < 8; ++e) mv[e] = (f16)0.f;
                if (t0 < n) { mv = *(const f16x8*)(zt + t0); if (t0 > 0) pv = (float)zt[t0 - 1]; if (t0 + 8 < n) nv = (float)zt[t0 + 8]; }
#pragma unroll
                for (int e = 0; e < 8; ++e) { const float zm = e == 0 ? pv : (float)mv[e == 0 ? 0 : e - 1], zc = (float)mv[e], zp = e == 7 ? nv : (float)mv[e == 7 ? 7 : e + 1];
                    const float r = w0 * zm + w1 * zc + w2 * zp + bs;
                    if (g == 0) { if (cc == 0) yv[gi * 8 + e].x = r; else yv[gi * 8 + e].y = r; }
                    else if (g == 1) { if (cc == 0) g1[gi * 8 + e].x = r; else g1[gi * 8 + e].y = r; }
                    else { if (cc == 0) g2[gi * 8 + e].x = r; else g2[gi * 8 + e].y = r; } } } }
    const float invN = 1.0f / (float)N;
#pragma unroll
    for (int o = 0; o < 2; ++o) {
        __syncthreads();
        float z0 = 0.f; asm volatile("" : "+v"(z0));
#pragma unroll
        for (int gi = 0; gi < 2; ++gi) { const int t0 = 8 * (tid + 512 * gi);
            if (t0 < n) {
#pragma unroll
                for (int e = 0; e < 8; ++e) { buf[PADI(t0 + e)] = yv[gi * 8 + e]; buf[PADI(n + t0 + e)] = (f32x2){z0, z0}; } } }
        __syncthreads();
        fft_fwd(buf, m, tid);
        const f32x4* fsd = (const f32x4*)(F.ws + ((l & 1) ? WS_FSD2 : WS_FSD) + (kind ? FSD_C_OFF : 0)) + (size_t)(o * 256 + pair) * (n + 1);
        for (int u = tid; u <= n; u += 512) { const int p = u < n ? 2 * u : 1, k = brev(p, m), pn = brev((N - k) & (N - 1), m);
            const f32x2 zk = buf[PADI(p)], zn = buf[PADI(pn)]; const f32x4 f = fsd[u]; const f32x2 fs = (f32x2){f[0], f[1]}, fd = (f32x2){f[2], f[3]};
            const f32x2 wk = cmul(zk, fs) + cmul(cconj(zn), fd), wn = cmul(zn, cconj(fs)) + cmul(cconj(zk), cconj(fd));
            buf[PADI(pn)] = wn; buf[PADI(p)] = wk; }
        __syncthreads();
        fft_inv(buf, m, tid);
        const float* hb = AV.in(I_HYBIAS) + ((size_t)l * 2 + o) * 512 + 2 * pair; const f32x2 bias = (f32x2){hb[0], hb[1]};
#pragma unroll
        for (int gi = 0; gi < 2; ++gi) { const int t0 = 8 * (tid + 512 * gi);
            if (t0 < n) {
#pragma unroll
                for (int e = 0; e < 8; ++e) { const f32x2 cv = buf[PADI(t0 + e)] * invN; const f32x2 gt = o == 0 ? g1[gi * 8 + e] : g2[gi * 8 + e];
                    yv[gi * 8 + e] = gt * (cv + yv[gi * 8 + e] * bias); } } }
    }
    f16* Y = (f16*)(F.ws + WS_YBT) + (size_t)(2 * pair) * MT + row0;
#pragma unroll
    for (int gi = 0; gi < 2; ++gi) { const int t0 = 8 * (tid + 512 * gi);
        if (t0 < n) { f16x8 oa, ob;
#pragma unroll
            for (int e = 0; e < 8; ++e) { oa[e] = (f16)yv[gi * 8 + e].x; ob[e] = (f16)yv[gi * 8 + e].y; }
            *(f16x8*)(Y + t0) = oa; *(f16x8*)(Y + MT + t0) = ob; } }
    __syncthreads();
}

__device__ __forceinline__ void ph_ybt_transpose(const Ctx& F) {
    LAS f16* T = (LAS f16*)F.lds;
    const f16* YBT = (const f16*)(F.ws + WS_YBT); f16* Y = (f16*)(F.ws + WS_YCAT);
    const bool bal = (F.G == 256);
    for (int it = 0; it < (bal ? 2 : (MT / 64 + F.G - 1) / F.G); ++it) {
        int rb;
        if (bal) { if (F.bid >= 132) rb = (F.bid - 132) + 124 * it; else if (F.bid < 16 && it == 0) rb = 248 + F.bid; else rb = -1; }
        else rb = F.bid + it * F.G;
        if (rb < 0 || rb >= MT / 64) continue;
        const int r0 = rb * 64;
        __syncthreads();
        { f16x8 tv[8];
#pragma unroll
          for (int i = 0; i < 8; ++i) tv[i] = *(const f16x8*)(YBT + (size_t)F.tid * MT + r0 + 8 * i);
          PIN8(tv[0], tv[1], tv[2], tv[3], tv[4], tv[5], tv[6], tv[7]);
#pragma unroll
          for (int i = 0; i < 8; ++i) *(LAS f16x8*)(T + F.tid * 72 + 8 * i) = tv[i]; }
        __syncthreads();
        const int row = F.tid >> 3, cg = F.tid & 7;
#pragma unroll
        for (int jj = 0; jj < 8; ++jj) { const int gidx = cg + 8 * jj; f16x8 o;
#pragma unroll
            for (int e = 0; e < 8; ++e) o[e] = T[(8 * gidx + e) * 72 + row];
            *(f16x8*)(Y + (size_t)(r0 + row) * 2048 + 512 + 8 * gidx) = o; }
    }
    __syncthreads();
}
#undef PADI
}

#ifndef PHMASK
#define PHMASK 0xFFFF
#endif
#define PH_EN(k) (((PHMASK) >> (k)) & 1)
#ifndef STAMP_MASK
#define STAMP_MASK 0
#endif
#ifndef STAMP_K
#define STAMP_K 1
#endif
#ifndef SUBMASK
#define SUBMASK 7
#endif
#define SUB_EN(k) (((SUBMASK) >> (k)) & 1)
constexpr int NPH = 2 + 12 * DEPTH;
constexpr int CW_Q = 8192;
__device__ __forceinline__ int q_pull(unsigned* ctr, volatile LAS int* slot) {
    __syncthreads();
    if (threadIdx.x == 0) *slot = (int)__hip_atomic_fetch_add(ctr, 1u, __ATOMIC_RELAXED, __HIP_MEMORY_SCOPE_AGENT);
    __syncthreads();
    return *slot;
}

__global__ void __launch_bounds__(512, 2) mk_fwd(Args args) {
    extern __shared__ __attribute__((aligned(16))) unsigned char lds_raw[];
    Ctx F; F.lds = (LAS unsigned char*)lds_raw; F.tid = threadIdx.x; F.lane = F.tid & 63; F.wave = __builtin_amdgcn_readfirstlane(F.tid >> 6);
    F.G = gridDim.x; F.bid = blockIdx.x; F.ws = args.ws;
    ArgsV AV; AV.out = args.out;
    const Ctx F0 = F;
#define FRESH() do { F.tid = opq(F0.tid); F.lane = F.tid & 63; F.wave = __builtin_amdgcn_readfirstlane(F.tid >> 6); } while (0)
    volatile LAS unsigned* MISC = (volatile LAS unsigned*)(F.lds + LDSCTL_OFF);
    if (F.tid < 64) MISC[F.tid] = 0u;
    __syncthreads();
    unsigned* barw = (unsigned*)(F.ws + WS_CTL) + CW_BAR;
    XcdBarrier bar; bar.bar = barw; bar.x = 0; bar.st = nullptr;
    const int lo = args.ph_lo, hi = args.ph_hi;
    if (hi - lo > 1) bar = xcd_barrier_post(barw, MISC + 8);
#define IN(k) (lo <= (k) && (k) < hi)
#define SEAM(k) do { if (IN(k) && IN((k) + 1)) xcd_barrier(bar); } while (0)
#if STAMP_MASK
    volatile LAS unsigned long long* TS = (volatile LAS unsigned long long*)(F.lds + LDSCTL_OFF + 128);
#define TSTART(k) do { if ((((STAMP_MASK) >> (k)) & 1) && blockIdx.x == 0 && threadIdx.x == 0) TS[0] = __builtin_amdgcn_s_memrealtime(); } while (0)
#define TSTOP(k) do { if ((((STAMP_MASK) >> (k)) & 1) && blockIdx.x == 0 && threadIdx.x == 0) TS[1] = TS[1] + (__builtin_amdgcn_s_memrealtime() - TS[0]); } while (0)
#else
#define TSTART(k) do {} while (0)
#define TSTOP(k) do {} while (0)
#endif
    unsigned char* ws = F.ws;
    const int rank160 = (F.bid + F.G - 160 % F.G) % F.G;

    TSTART(12);
    if (PH_EN(12) && IN(0)) { FRESH(); ph_prologue(F, AV); for (int l2 = 0; l2 < DEPTH; ++l2) { FRESH(); ph_hyena_h2(F, AV, l2); } }
    SEAM(0);
    TSTOP(12);

    for (int l = 0; l < DEPTH; ++l) {
        const int pb = 1 + 12 * l;
        const float* modl = (const float*)(ws + WS_MOD) + (size_t)l * 3 * 12288;
        const bool ctx_on = l < DEPTH - 1;
        const int nMr = ctx_on ? MT / 256 : MX / 256, nrows = ctx_on ? MT : MX;
        TSTART(0);
        if (PH_EN(0) && IN(pb + 0)) {
            FRESH(); ph_convert_weights(F, AV, l);
            __syncthreads();
            FRESH(); if (F.bid < 32) s5_mats_group(F, AV, l, F.bid);
            FRESH(); ph_norm(F, AV, l, 0, MT, l > 0 ? 11 : 0);
        }
        SEAM(pb + 0);
        TSTOP(0);
        TSTART(1);
        if (PH_EN(1) && IN(pb + 1)) {
            pg8::SchedPlain S; S.init(MT / 256, WINN / 256, F.G, F.bid); S.A = (const char*)(ws + WS_HN); S.B = (const char*)(ws + WS_WIN); S.aTile = (size_t)256 * 2048 * 2; S.bTile = (size_t)256 * 2048 * 2;
            pg8::EpiPx E{(f16*)(ws + WS_PX), (f16*)(ws + WS_S5A), (f16*)(ws + WS_ZT), (f16*)(ws + WS_GTL)};
            pg8::gemm_phase(F.lds, 2048, 2048, 32, S, E);
        }
        SEAM(pb + 1);
        TSTOP(1);
        TSTART(2);
        if (PH_EN(2) && IN(pb + 2)) {
            TSTART(16);
            if (SUB_EN(0)) { pg8::SchedS5 S{(const char*)(ws + WS_S5A), (const char*)(ws + WS_S5M), (size_t)256 * 256 * 2, F.G, F.bid};
              pg8::EpiS5In E{(float*)(ws + WS_S5S)};
              pg8::gemm_phase(F.lds, 16384, 256, 4, S, E); }
            TSTOP(16);
            { unsigned* qc = (unsigned*)(ws + WS_CTL) + CW_Q + (l * 2 + 0) * 64; volatile LAS int* slot = (volatile LAS int*)(MISC + 16);
              const bool pre = (l > 0 && F.G == 256);
              const int nq = 264 + (pre ? 272 : 1024);
              for (;;) { const int u = q_pull(qc, slot); if (u >= nq) break;
                  if (u < 264) { TSTART(17); FRESH(); gla::gla_unit<false>(F, AV, l, u); TSTOP(17); } else { TSTART(18); FRESH(); hy::filt_unit(F, AV, l, pre ? 240 + (u - 264) : u - 264); TSTOP(18); } } }
        }
        SEAM(pb + 2);
        TSTOP(2);
        TSTART(3);
        if (PH_EN(3) && IN(pb + 3)) { FRESH(); ph_s5_scan(F); FRESH(); gla::ph_gla_scan(F); }
        SEAM(pb + 3);
        TSTOP(3);
        TSTART(4);
        if (PH_EN(4) && IN(pb + 4)) {
            TSTART(19);
            if (SUB_EN(0)) { pg8::SchedS5 S{(const char*)(ws + WS_S5A), (const char*)(ws + WS_S5W), (size_t)256 * 512 * 2, F.G, F.bid};
              pg8::EpiS5Out E{(const f16*)(ws + WS_S5A), (f16*)(ws + WS_YAPRE), AV.in(I_S5D) + (size_t)l * 512};
              pg8::gemm_phase(F.lds, 16384, 512, 8, S, E); }
            TSTOP(19);
            { unsigned* qc = (unsigned*)(ws + WS_CTL) + CW_Q + (l * 2 + 1) * 64; volatile LAS int* slot = (volatile LAS int*)(MISC + 16);
              for (;;) { const int u = q_pull(qc, slot); if (u >= 264 + 1024) break;
                  if (u < 264) { TSTART(20); FRESH(); gla::gla_unit<true>(F, AV, l, u); TSTOP(20); } else { TSTART(21); FRESH(); hy::main_unit(F, AV, l, u - 264); TSTOP(21); } } }
        }
        SEAM(pb + 4);
        TSTOP(4);
        TSTART(5);
        if (PH_EN(5) && IN(pb + 5)) {
            pg8::SchedPlain S; S.init(nMr, 2, F.G, F.bid); S.A = (const char*)(ws + WS_YAPRE); S.B = (const char*)(ws + WS_WGLU); S.aTile = (size_t)256 * 512 * 2; S.bTile = (size_t)256 * 512 * 2;
            pg8::EpiGlu E{(const f16*)(ws + WS_YAPRE), (f16*)(ws + WS_YCAT), AV.in(I_GLUB) + (size_t)l * 512};
            pg8::gemm_phase(F.lds, 512, 512, 8, S, E);
            FRESH(); hy::ph_ybt_transpose(F);
        }
        SEAM(pb + 5);
        TSTOP(5);
        TSTART(6);
        if (PH_EN(6) && IN(pb + 6)) {
            pg8::SchedPlain S; S.init(nMr, 8, F.G, F.bid); S.aTile = (size_t)256 * 2048 * 2; S.bTile = (size_t)256 * 2048 * 2;
            S.A = (const char*)(ws + WS_YCAT); S.B = (const char*)(ws + WS_WBR);
            pg8::EpiBranchF E{(const f16*)(ws + WS_GTL), (f16*)(ws + WS_MBUF)};
            pg8::gemm_phase(F.lds, 2048, 2048, 32, S, E);
            if (l + 1 < DEPTH && F.G == 256) { unsigned* qc = (unsigned*)(ws + WS_CTL) + CW_Q + 1024 + l * 64; volatile LAS int* slot = (volatile LAS int*)(MISC + 16);
              for (;;) { if (F.bid < 16) break; const int u = q_pull(qc, slot); if (u >= 240) break; FRESH(); hy::filt_unit(F, AV, l + 1, u); } }
#ifdef PG_DUMMY
            { pg8::EpiF16 E9{(f16*)(ws + WS_ACT), 2048}; pg8::gemm_phase(F.lds, 2048, 2048, 32, S, E9); }
#endif
        }
        SEAM(pb + 6);
        TSTOP(6);
        TSTART(7);
        if (PH_EN(7) && IN(pb + 7)) {
            pg8::SchedPlain S; S.init(MX / 256, 8, F.G, F.bid); S.A = (const char*)(ws + WS_MBUF); S.B = (const char*)(ws + WS_WOUT); S.aTile = (size_t)256 * 2048 * 2; S.bTile = (size_t)256 * 2048 * 2;
            pg8::EpiResid E{(float*)(ws + WS_XRES), modl, 4096, l == 0 ? AV.in(I_X) : (const float*)(ws + WS_XRES)};
            pg8::gemm_phase(F.lds, 2048, 2048, 32, S, E);
            if (ctx_on) { pg8::SchedSplit S2{(const char*)(ws + WS_MBUF), (const char*)(ws + WS_WOUT), (size_t)256 * 2048 * 2, (size_t)256 * 2048 * 2, (size_t)8 * 128, 4, F.G, F.bid};
                pg8::EpiSlab E2{(float*)(ws + WS_SLAB), modl, 4096};
                pg8::gemm_phase(F.lds, 2048, 2048, 8, S2, E2); }
            if (l + 1 < DEPTH && F.G == 256) { unsigned* qc = (unsigned*)(ws + WS_CTL) + CW_Q + 1024 + l * 64 + 32; volatile LAS int* slot = (volatile LAS int*)(MISC + 16);
              for (;;) { const int u = q_pull(qc, slot); if (u >= 512) break; FRESH(); hy::filt_unit(F, AV, l + 1, 512 + u); } }
        }
        SEAM(pb + 7);
        TSTOP(7);
        TSTART(8);
        if (PH_EN(8) && IN(pb + 8)) { FRESH(); ph_norm(F, AV, l, 1, nrows, 4); }
        SEAM(pb + 8);
        TSTOP(8);
        TSTART(9);
        if (PH_EN(9) && IN(pb + 9)) {
            pg8::SchedPlain S; S.init(nMr, UPLD / 256, F.G, F.bid); S.A = (const char*)(ws + WS_HN); S.B = (const char*)(ws + WS_WUP); S.aTile = (size_t)256 * 2048 * 2; S.bTile = (size_t)256 * 2048 * 2;
            pg8::EpiUpAct E{(f16*)(ws + WS_ACT), (float*)(ws + WS_HALO), AV.in(I_FFCW) + (size_t)l * 3 * FFH, AV.in(I_FFCB) + (size_t)l * FFH, (LAS float*)(F.lds + EXTRA_OFF)};
            pg8::gemm_phase(F.lds, 2048, 2048, 32, S, E);
        }
        SEAM(pb + 9);
        TSTOP(9);
        TSTART(10);
        if (PH_EN(10) && IN(pb + 10)) { FRESH(); ph_ffn_fix(F, AV, l, nMr); }
        SEAM(pb + 10);
        TSTOP(10);
        TSTART(11);
        if (PH_EN(11) && IN(pb + 11)) {
            pg8::SchedPlain S; S.init(MX / 256, 8, F.G, F.bid); S.A = (const char*)(ws + WS_ACT); S.B = (const char*)(ws + WS_WDN); S.aTile = (size_t)256 * FFH * 2; S.bTile = (size_t)256 * FFH * 2;
            pg8::EpiResid E{(float*)(ws + WS_XRES), modl, 10240, (const float*)(ws + WS_XRES)};
            pg8::gemm_phase(F.lds, FFH, FFH, FFH / 64, S, E);
            if (ctx_on) { pg8::SchedSplit S2{(const char*)(ws + WS_ACT), (const char*)(ws + WS_WDN), (size_t)256 * FFH * 2, (size_t)256 * FFH * 2, (size_t)8 * 128, 11, F.G, F.bid};
                pg8::EpiSlab E2{(float*)(ws + WS_SLAB), modl, 10240};
                pg8::gemm_phase(F.lds, FFH, FFH, 8, S2, E2); }
        }
        SEAM(pb + 11);
        TSTOP(11);
    }
    if (PH_EN(13) && IN(NPH - 1)) { FRESH(); ph_final_norm(F, AV); }
#if STAMP_MASK
    if (blockIdx.x == 0 && threadIdx.x == 0) { const unsigned long long t0 = __builtin_amdgcn_s_memrealtime(); while (__builtin_amdgcn_s_memrealtime() - t0 < (unsigned long long)(STAMP_K) * TS[1]) __builtin_amdgcn_s_sleep(8); }
#endif
#undef IN
#undef SEAM
#undef FRESH
}

extern "C" void kernel_launch(void* const* d_in, const int* in_sizes, int n_in, void* d_out, int out_size, void* d_ws, size_t ws_size, hipStream_t stream) {
    static int grid = 0;
    if (grid == 0) {
        if (n_in != 40 || out_size != MX * D || ws_size < WS_END) { fprintf(stderr, "kernel_launch: unexpected problem (n_in %d out %d ws %zu, need %zu)\n", n_in, out_size, ws_size, (size_t)WS_END); grid = -1; return; }
        int dev = 0, cus = 0, per_cu = 0;
        if (hipGetDevice(&dev) != hipSuccess || hipDeviceGetAttribute(&cus, hipDeviceAttributeMultiprocessorCount, dev) != hipSuccess) { grid = -1; return; }
        if (hipFuncSetAttribute((const void*)mk_fwd, hipFuncAttributeMaxDynamicSharedMemorySize, LDS_BYTES) != hipSuccess) { fprintf(stderr, "kernel_launch: hipFuncSetAttribute failed\n"); grid = -1; return; }
        if (hipOccupancyMaxActiveBlocksPerMultiprocessor(&per_cu, (const void*)mk_fwd, 512, LDS_BYTES) != hipSuccess || per_cu < 1)
            fprintf(stderr, "kernel_launch: occupancy query reports %d\n", per_cu);
        (void)hipGetLastError();
        grid = cus;
    }
    if (grid < 0) return;
    if (hipMemsetAsync((char*)d_ws + WS_CTL, 0, CTL_ZERO_BYTES, stream) != hipSuccess) return;
    Args a{};
    for (int i = 0; i < 40; ++i) a.in[i] = (const float*)d_in[i];
    a.out = (float*)d_out; a.ws = (unsigned char*)d_ws;
#if MK_ONE
    a.ph_lo = 0; a.ph_hi = NPH;
    hipLaunchKernelGGL(mk_fwd, dim3(grid), dim3(512), LDS_BYTES, stream, a);
#else
    for (int p = 0; p < NPH; ++p) { a.ph_lo = p; a.ph_hi = p + 1; hipLaunchKernelGGL(mk_fwd, dim3(grid), dim3(512), LDS_BYTES, stream, a); }
#endif
}
```

```cpp
#include <hip/hip_runtime.h>
#include <stdio.h>

#ifndef MK_ONE
#define MK_ONE 1
#define STAMP_MASK 0
#define STAMP_K 1
#define STAMP_BID 0
#endif

#define GAS __attribute__((address_space(1)))
#define LAS __attribute__((address_space(3)))
typedef _Float16 f16;
typedef _Float16 f16x8 __attribute__((ext_vector_type(8)));
typedef _Float16 f16x4 __attribute__((ext_vector_type(4)));
typedef _Float16 f16x2 __attribute__((ext_vector_type(2)));
typedef float f32x4 __attribute__((ext_vector_type(4)));
typedef float f32x2 __attribute__((ext_vector_type(2)));

constexpr int D = 2048, NB = 2, SEQ = 8192, LC = 256, DEPTH = 4;
constexpr int MX = NB * SEQ, MC = NB * LC, MT = MX + MC;
constexpr int PXLD = 3840, WINN = 11520, FFH = 5632, UPLD = 2 * FFH;
constexpr int P_S5 = 0, P_GK = 512, P_GV = 1024, P_GQ = 2048, P_GR = 2560, P_HY = 3584, P_MG = 5120, P_GG = 3584, W_GG = 11264;
constexpr int INW = 11296;
constexpr int NCHK = 1056;
constexpr float S5SCALE = 1024.f;
constexpr float EPS = 1e-6f;
constexpr int NSC = 33;

constexpr size_t MiB = 1u << 20;
constexpr size_t WS_CTL = 0, CTL_ZERO_BYTES = 1 * MiB;
constexpr size_t WS_MOD = 1 * MiB;
constexpr size_t WS_TW = 2 * MiB;
constexpr size_t WS_S5AT = 3 * MiB;
constexpr size_t WS_WIN = 4 * MiB;
constexpr size_t WS_WGLU = WS_WIN + 45 * MiB;
constexpr size_t WS_WBR = WS_WGLU + 1 * MiB;
constexpr size_t WS_WOUT = WS_WBR + 8 * MiB;
constexpr size_t WS_WUP = WS_WOUT + 8 * MiB;
constexpr size_t WS_WDN = WS_WUP + 44 * MiB;
constexpr size_t WS_S5W = WS_WDN + 22 * MiB;
constexpr size_t WS_S5M = WS_S5W + 8 * MiB;
constexpr size_t WS_H2 = WS_S5M + 4 * MiB;
constexpr size_t WS_FSD = WS_H2 + 3 * MiB;
constexpr size_t FSD_C_OFF = (size_t)2 * 256 * 8193 * 16;
constexpr size_t WS_XRES = WS_FSD + 68 * MiB;
constexpr size_t WS_HN = WS_XRES + 132 * MiB;
constexpr size_t WS_PX = WS_HN + 66 * MiB;
constexpr size_t WS_S5A = WS_PX + 372 * MiB;
constexpr size_t WS_S5S = WS_S5A + 40 * MiB;
constexpr size_t WS_YAPRE = WS_S5S + 40 * MiB;
constexpr size_t WS_YCAT = WS_YAPRE + 20 * MiB;
constexpr size_t WS_MBUF = WS_YCAT + 66 * MiB;
constexpr size_t WS_GSLOC = WS_MBUF + 66 * MiB;
constexpr size_t WS_GSIN = WS_GSLOC + 66 * MiB;
constexpr size_t WS_GOF = WS_GSIN + 66 * MiB;
constexpr size_t WS_GDT = WS_GOF + 66 * MiB;
constexpr size_t WS_ACT = WS_GSLOC;
constexpr size_t WS_ZT = WS_GDT + 1 * MiB;
constexpr size_t WS_YBT = WS_ZT + 50 * MiB;
constexpr size_t WS_SLAB = WS_YBT + 17 * MiB;
constexpr size_t WS_HALO = WS_SLAB + 44 * MiB;
constexpr size_t WS_GTL = WS_HALO + 9 * MiB;
constexpr size_t WS_END = WS_GTL + 198 * MiB;
constexpr size_t WS_FSD2 = WS_PX + 124 * MiB;
constexpr size_t WS_W2 = WS_FSD2 + 68 * MiB;
constexpr size_t WS_H2H = WS_W2 + 128 * MiB;
static_assert(WS_H2H + 5 * MiB <= WS_PX + 372 * MiB, "PX tail");
static_assert((size_t)MT * FFH * 2 <= 198 * MiB, "ACT overlay");
constexpr int CW_BAR = 4096;

constexpr int RING_BYTES = 131072;
constexpr int EXTRA_OFF = RING_BYTES, EXTRA_BYTES = 8192;
constexpr int LDSCTL_OFF = EXTRA_OFF + EXTRA_BYTES;
constexpr int LDS_BYTES = LDSCTL_OFF + 256;

__device__ __forceinline__ float wave_sum(float v) {
#pragma unroll
    for (int o = 1; o < 64; o <<= 1) v += __shfl_xor(v, o);
    return v;
}
__device__ __forceinline__ float sigmoidf_(float x) { return 1.0f / (1.0f + __expf(-x)); }
__device__ __forceinline__ float siluf_(float x) { return x * sigmoidf_(x); }
__device__ __forceinline__ float gelu_tanh_(float x) { const float u = 0.7978845608028654f * (x + 0.044715f * x * x * x); return x / (1.0f + __expf(-2.0f * u)); }
__device__ __forceinline__ float logsigmoidf_(float x) { return fminf(x, 0.f) - __logf(1.0f + __expf(-fabsf(x))); }
__device__ __forceinline__ f32x2 cmul(f32x2 a, f32x2 b) { return (f32x2){a.x * b.x - a.y * b.y, a.x * b.y + a.y * b.x}; }
__device__ __forceinline__ f32x2 cconj(f32x2 a) { return (f32x2){a.x, -a.y}; }
__device__ __forceinline__ int opq(int x) { asm volatile("" : "+v"(x)); return x; }
#define PIN8(a, b, c, d, e, f, g, h) asm volatile("" : "+v"(a), "+v"(b), "+v"(c), "+v"(d), "+v"(e), "+v"(f), "+v"(g), "+v"(h))
#define PIN4(a, b, c, d) asm volatile("" : "+v"(a), "+v"(b), "+v"(c), "+v"(d))
#define LDS_WAIT() asm volatile("s_waitcnt lgkmcnt(0)" ::: "memory")
#define VM_WAIT() asm volatile("s_waitcnt vmcnt(0)" ::: "memory")

#define XB_TMO      128
#define XB_XCNT(j)  (256  + 64 * (j))
#define XB_XSUB(j)  (1280 + 64 * (j))
#define XB_XGEN(j)  (2304 + 64 * (j))
#define XB_TOP      3328
#define XB_TOPGEN   3392
#define XCD_BAR_WORDS 3456
#define XB_SPIN_CAP (1u << 18)
__device__ __forceinline__ unsigned xb_ld(unsigned* p)              { return __hip_atomic_load(p, __ATOMIC_RELAXED, __HIP_MEMORY_SCOPE_AGENT); }
__device__ __forceinline__ unsigned xb_add(unsigned* p, unsigned v) { return __hip_atomic_fetch_add(p, v, __ATOMIC_RELAXED, __HIP_MEMORY_SCOPE_AGENT); }
__device__ __forceinline__ unsigned xb_xcc_id() { return (unsigned)__builtin_amdgcn_s_getreg((3 << 11) | 20) & 0xFu; }
#define XB_SPIN(cond, bar) do { unsigned _sp = 0; while (cond) { __builtin_amdgcn_s_sleep(1); \
    if ((++_sp & 255u) == 0u) { if (xb_ld(&(bar)[XB_TMO])) break; if (_sp > XB_SPIN_CAP) { atomicAdd(&(bar)[XB_TMO], 1u); break; } } } } while (0)
struct XcdBarrier { unsigned* bar; unsigned x; volatile LAS unsigned* st; };
__device__ __forceinline__ XcdBarrier xcd_barrier_post(unsigned* bar, volatile LAS unsigned* st) {
    XcdBarrier b; b.bar = bar; b.x = xb_xcc_id(); b.st = st;
    if (threadIdx.x == 0) (void)xb_add(&bar[XB_XCNT(b.x)], 1u);
    return b;
}
__device__ __forceinline__ void xcd_barrier_complete(unsigned* bar, unsigned x, unsigned& nloc, unsigned& nx) {
    const unsigned G = gridDim.x * gridDim.y * gridDim.z;
    unsigned sum, cnt, mine, sp = 0u;
    for (;;) {
        sum = 0u; cnt = 0u; mine = 0u;
#pragma unroll
        for (unsigned j = 0; j < 16; ++j) { const unsigned c = xb_ld(&bar[XB_XCNT(j)]); sum += c; cnt += (c > 0u) ? 1u : 0u; mine = (j == x) ? c : mine; }
        if (sum == G) break;
        __builtin_amdgcn_s_sleep(1);
        if ((++sp & 255u) == 0u) { if (xb_ld(&bar[XB_TMO])) break; if (sp > XB_SPIN_CAP) { atomicAdd(&bar[XB_TMO], 1u); break; } }
    }
    nloc = mine > 0u ? mine : 1u; nx = cnt > 0u ? cnt : 1u;
}
__device__ __forceinline__ void xcd_barrier(const XcdBarrier& b) {
    asm volatile("s_waitcnt vmcnt(0)" ::: "memory");
    __syncthreads();
    if (threadIdx.x == 0) {
        unsigned* bar = b.bar;
        __builtin_amdgcn_s_waitcnt(0);
        unsigned nloc = b.st[0], nx = b.st[1];
        if (nloc == 0u) { xcd_barrier_complete(bar, b.x, nloc, nx); b.st[0] = nloc; b.st[1] = nx; }
        const unsigned old = xb_add(&bar[XB_XSUB(b.x)], 1u);
        const unsigned gen = old / nloc;
        if (old + 1u == (gen + 1u) * nloc) {
            __builtin_amdgcn_fence(__ATOMIC_RELEASE, "agent");
            asm volatile("s_waitcnt vmcnt(0)" ::: "memory");
            const unsigned og = xb_add(&bar[XB_TOP], 1u);
            const unsigned tg = og / nx;
            if (og + 1u == (tg + 1u) * nx) xb_add(&bar[XB_TOPGEN], 1u);
            else XB_SPIN(xb_ld(&bar[XB_TOPGEN]) == tg, bar);
            __builtin_amdgcn_fence(__ATOMIC_ACQUIRE, "agent");
            xb_add(&bar[XB_XGEN(b.x)], 1u);
            asm volatile("s_waitcnt vmcnt(0)" ::: "memory");
        } else {
            XB_SPIN(xb_ld(&bar[XB_XGEN(b.x)]) == gen, bar);
            __builtin_amdgcn_fence(__ATOMIC_ACQUIRE, "agent");
            asm volatile("s_waitcnt vmcnt(0)" ::: "memory");
        }
    }
    __syncthreads();
}

struct Args {
    const float* in[40];
    float* out; unsigned char* ws;
    int ph_lo, ph_hi;
};
struct ArgsV {
    __device__ __forceinline__ const float* in(int i) const {
        typedef const __attribute__((address_space(4))) unsigned long long* kp_t;
        kp_t ka = (kp_t)__builtin_amdgcn_kernarg_segment_ptr();
        return (const float*)(*(volatile const __attribute__((address_space(4))) unsigned long long*)(ka + i)); }
    float* out;
};
struct Ctx {
    LAS unsigned char* lds;
    int tid, lane, wave, G, bid;
    unsigned char* ws;
};
enum { I_X = 0, I_C, I_CTX, I_CCTX, I_WMOD, I_BMOD, I_N1G, I_N2G, I_WIN, I_S5ARE, I_S5AIM, I_S5STEP, I_S5BRE, I_S5BIM, I_S5CRE, I_S5CIM,
       I_S5D, I_GLUW, I_GLUB, I_HYCW, I_HYCB, I_HYW1, I_HYB1, I_HYF1, I_HYW2, I_HYB2, I_HYF2, I_HYW3, I_HYB3, I_HYBIAS,
       I_GLAWG, I_GLABG, I_GLANG, I_WBR, I_WOUT, I_WUP, I_FFCW, I_FFCB, I_WDN, I_FNG };

namespace pg8 {
constexpr int BM = 256, BK = 64, HALF = 128, HTB = HALF * BK * 2, STAGE_BYTES = 8 * HTB, NXCD = 8, WGM = 4;
__device__ __forceinline__ int lds_byte(int r, int c) { const int st = (r >> 4) * 2 + (c >> 5), rr = r & 15, cc = c & 31, ob = rr * 64 + cc * 2; return st * 1024 + (ob ^ (((ob >> 9) & 1) << 5)); }
__device__ __forceinline__ void stage_rc(int b, int& R, int& C) { const int st = b / 1024, sb = b % 1024, swz = sb ^ (((sb >> 9) & 1) << 5); R = (st >> 1) * 16 + swz / 64; C = (st & 1) * 32 + (swz % 64) / 2; }
__device__ __forceinline__ int perm32(int rho) { const int n = rho >> 4, i = rho & 15; return 8 * (i >> 2) + 4 * n + (i & 3); }
struct Unit { const char* a; const char* b; int pm, pn; };
struct Order2D {
    int nM, nN, nwg, G, c;
    __device__ __forceinline__ void init(int nM_, int nN_, int G_, int c_) { nM = nM_; nN = nN_; nwg = nM * nN; G = G_; c = c_; }
    __device__ __forceinline__ bool nx(int i, int& pm, int& pn) const {
        const long L = (long)i * G + c; if (L >= nwg) return false;
        int wgid = (int)L; { const int q = nwg / NXCD, r = nwg % NXCD, xcd = wgid % NXCD, off = wgid / NXCD; wgid = (xcd < r ? xcd * (q + 1) : r * (q + 1) + (xcd - r) * q) + off; }
        const int nig = WGM * nN, gid = wgid / nig, fm = gid * WGM, gsz = (nM - fm) < WGM ? (nM - fm) : WGM;
        pm = fm + ((wgid % nig) % gsz); pn = (wgid % nig) / gsz; return true;
    }
};
struct SchedPlain : Order2D {
    const char* A; const char* B; size_t aTile, bTile;
    __device__ __forceinline__ bool next(int i, Unit& u) const { int pm, pn; if (!nx(i, pm, pn)) return false; u.pm = pm; u.pn = pn; u.a = A + (size_t)pm * aTile; u.b = B + (size_t)pn * bTile; return true; }
};
struct SchedSplit {
    const char* A; const char* B; size_t aTile, bTile, ksub; int nsplit, G, c;
    __device__ __forceinline__ bool next(int i, Unit& u) const { const int L = i * G + c; if (L >= 16 * nsplit) return false; const int t = L / nsplit, ks = L % nsplit, pm = 64 + (t >> 3), pn = t & 7;
        u.pm = pm; u.pn = pn | (ks << 8); u.a = A + (size_t)pm * aTile + (size_t)ks * ksub; u.b = B + (size_t)pn * bTile + (size_t)ks * ksub; return true; }
};
struct SchedS5 {
    const char* A; const char* B; size_t bGroup; int G, c;
    __device__ __forceinline__ bool next(int i, Unit& u) const { const int L = i * G + c; if (L >= 160) return false; const int g = L & 31, pm = L >> 5;
        u.pm = pm; u.pn = g; u.a = A + ((size_t)pm * 256 * 16384 + (size_t)g * 512) * 2; u.b = B + (size_t)g * bGroup; return true; }
};

#define PG8_SA(b, h) (((b) * 2 + (h)) * HTB)
#define PG8_SB(b, h) ((4 + (b) * 2 + (h)) * HTB)
#define PG8_STAGE(bufoff, gbase, voff) do { _Pragma("unroll") for (int _i = 0; _i < 2; ++_i) \
        __builtin_amdgcn_global_load_lds((const unsigned*)((const char*)(gbase) + (voff)[_i]), (LAS unsigned*)(lds + (bufoff) + ldsw + _i * 8192), 16, 0, 0); } while (0)
#define PG8_LDA(dst, b, h) do { _Pragma("unroll") for (int m = 0; m < 4; ++m) _Pragma("unroll") for (int k = 0; k < 2; ++k) dst[m][k] = *(const LAS f16x8*)(lds + PG8_SA(b, h) + aoff + m * 2048 + k * 1024); } while (0)
#define PG8_LDB(dst, b, h) do { _Pragma("unroll") for (int n = 0; n < 2; ++n) _Pragma("unroll") for (int k = 0; k < 2; ++k) dst[n][k] = *(const LAS f16x8*)(lds + PG8_SB(b, h) + boff + n * 2048 + k * 1024); } while (0)
#define PG8_MMA(ai, bj, At, Bt) do { __builtin_amdgcn_s_setprio(1); _Pragma("unroll") for (int m = 0; m < 4; ++m) _Pragma("unroll") for (int n = 0; n < 2; ++n) _Pragma("unroll") for (int k = 0; k < 2; ++k) \
        acc[ai][bj][m][n] = __builtin_amdgcn_mfma_f32_16x16x32_f16(Bt[n][k], At[m][k], acc[ai][bj][m][n], 0, 0, 0); __builtin_amdgcn_s_setprio(0); } while (0)
#define PG8_WAIT_V(n) asm volatile("s_waitcnt vmcnt(" #n ")" ::: "memory")
#define PG8_WAIT_L(n) asm volatile("s_waitcnt lgkmcnt(" #n ")" ::: "memory")
#define PG8_BAR __builtin_amdgcn_s_barrier()
#define PG8_SCHED __builtin_amdgcn_sched_barrier(0)

template <class Epi, class Sched>
__device__ __forceinline__ void gemm_phase(LAS unsigned char* lds, const int lda, const int ldb, const int nt, const Sched& S, const Epi& E) {
    const int tid = opq((int)threadIdx.x), wid = __builtin_amdgcn_readfirstlane(tid >> 6), lane = tid & 63, wr = wid >> 2, wc = wid & 3, fr = lane & 15, fq = lane >> 4;
    unsigned voffA[2], voffB[2];
#pragma unroll
    for (int i = 0; i < 2; ++i) { int R, C; stage_rc(tid * 16 + i * 8192, R, C); const int Rb = Epi::PERM ? ((R & ~31) + perm32(R & 31)) : R;
        voffA[i] = (unsigned)(R * lda + C) * 2u; voffB[i] = (unsigned)(Rb * ldb + C) * 2u; }
    const size_t kstep = (size_t)(BK * 2);
    const size_t hstepA = (size_t)HALF * lda * 2, hstepB = (size_t)HALF * ldb * 2;
    const unsigned ldsw = (unsigned)wid * 1024u;
    const int aoff = lds_byte(wr * 64 + fr, fq * 8), boff = lds_byte(wc * 32 + fr, fq * 8);
    Unit cur, nxt; int ui = 0;
    if (!S.next(0, cur)) return;
    f32x4 acc[2][2][4][2];
#pragma unroll
    for (int a = 0; a < 2; ++a)
#pragma unroll
        for (int b = 0; b < 2; ++b)
#pragma unroll
            for (int m = 0; m < 4; ++m)
#pragma unroll
                for (int n = 0; n < 2; ++n) acc[a][b][m][n] = (f32x4){0.f, 0.f, 0.f, 0.f};
    f16x8 At[4][2], B0[2][2], B1[2][2];
    const char* cA = cur.a; const char* cB = cur.b;
    PG8_STAGE(PG8_SB(0, 0), cB, voffB); PG8_STAGE(PG8_SA(0, 0), cA, voffA); PG8_STAGE(PG8_SB(0, 1), cB + hstepB, voffB); PG8_STAGE(PG8_SA(0, 1), cA + hstepA, voffA);
    if (wr == 1) PG8_BAR;
    PG8_WAIT_V(4); PG8_BAR;
    PG8_STAGE(PG8_SB(1, 0), cB + kstep, voffB); PG8_STAGE(PG8_SA(1, 0), cA + kstep, voffA); PG8_STAGE(PG8_SB(1, 1), cB + hstepB + kstep, voffB);
    PG8_WAIT_V(6); PG8_BAR;
    for (;;) {
        const bool has_next = S.next(ui + 1, nxt);
        const char* nA = has_next ? nxt.a : cA; const char* nB = has_next ? nxt.b : cB;
        constexpr int NSEG = Epi::HAS_MID ? 3 : 1;
#pragma unroll
        for (int seg = 0; seg < NSEG; ++seg) {
        const int tb = Epi::HAS_MID ? (seg == 0 ? 0 : (seg == 1 ? Epi::MID1 + 2 : Epi::MID2 + 2)) : 0;
        const int te = Epi::HAS_MID ? (seg == 0 ? Epi::MID1 + 2 : (seg == 1 ? Epi::MID2 + 2 : nt)) : nt;
        for (int t = tb; t < te; t += 2) {
            const bool last = (t == nt - 2);
            const char* a1 = cA + (size_t)(t + 1) * kstep;
            const char* a2 = last ? nA : cA + (size_t)(t + 2) * kstep; const char* b2 = last ? nB : cB + (size_t)(t + 2) * kstep;
            const char* a3 = a2 + kstep; const char* b3 = b2 + kstep;
            PG8_LDB(B0, 0, 0); PG8_SCHED; PG8_LDA(At, 0, 0); PG8_STAGE(PG8_SA(1, 1), a1 + hstepA, voffA);
            PG8_WAIT_L(8); PG8_BAR; PG8_WAIT_L(0); PG8_MMA(0, 0, At, B0); PG8_BAR; PG8_SCHED;
            PG8_LDB(B1, 0, 1); PG8_STAGE(PG8_SB(0, 0), b2, voffB);
            PG8_BAR; PG8_WAIT_L(0); PG8_MMA(0, 1, At, B1); PG8_BAR;
            PG8_LDA(At, 0, 1); PG8_STAGE(PG8_SA(0, 0), a2, voffA);
            PG8_BAR; PG8_WAIT_L(0); PG8_MMA(1, 0, At, B0); PG8_BAR; PG8_SCHED;
            PG8_STAGE(PG8_SB(0, 1), b2 + hstepB, voffB);
            PG8_WAIT_V(6); PG8_BAR; PG8_MMA(1, 1, At, B1); PG8_BAR;
            PG8_LDB(B0, 1, 0); PG8_SCHED; PG8_LDA(At, 1, 0); PG8_STAGE(PG8_SA(0, 1), a2 + hstepA, voffA);
            PG8_WAIT_L(8); PG8_BAR; PG8_WAIT_L(0); PG8_MMA(0, 0, At, B0); PG8_BAR; PG8_SCHED;
            PG8_LDB(B1, 1, 1); PG8_STAGE(PG8_SB(1, 0), b3, voffB);
            PG8_BAR; PG8_WAIT_L(0); PG8_MMA(0, 1, At, B1); PG8_BAR;
            PG8_LDA(At, 1, 1); PG8_STAGE(PG8_SA(1, 0), a3, voffA);
            PG8_BAR; PG8_WAIT_L(0); PG8_MMA(1, 0, At, B0); PG8_BAR; PG8_SCHED;
            PG8_STAGE(PG8_SB(1, 1), b3 + hstepB, voffB);
            PG8_WAIT_V(6); PG8_BAR; PG8_MMA(1, 1, At, B1); PG8_BAR;
        }
        if constexpr (Epi::HAS_MID) { if (seg < 2) {
            E.mid(acc, cur, seg, wr, wc, fr, fq);
        } }
        }
#if STAMP_MASK & (1 << 23)
        if (Epi::HAS_MID && blockIdx.x == 0 && threadIdx.x == 0) ((volatile LAS unsigned long long*)(lds + LDSCTL_OFF + 128))[0] = __builtin_amdgcn_s_memrealtime();
#endif
        E(acc, cur, wr, wc, fr, fq);
#if STAMP_MASK & (1 << 23)
        if (Epi::HAS_MID && blockIdx.x == 0 && threadIdx.x == 0) { volatile LAS unsigned long long* TS = (volatile LAS unsigned long long*)(lds + LDSCTL_OFF + 128); TS[1] = TS[1] + (__builtin_amdgcn_s_memrealtime() - TS[0]); }
#endif
        if (!has_next) break;
#pragma unroll
        for (int a = 0; a < 2; ++a)
#pragma unroll
            for (int b = 0; b < 2; ++b)
#pragma unroll
                for (int m = 0; m < 4; ++m)
#pragma unroll
                    for (int n = 0; n < 2; ++n) acc[a][b][m][n] = (f32x4){0.f, 0.f, 0.f, 0.f};
        cur = nxt; cA = nA; cB = nB; ++ui;
    }
    PG8_WAIT_V(0);
    if (wr == 0) PG8_BAR;
    PG8_BAR;
}
#undef PG8_SA
#undef PG8_SB
#undef PG8_STAGE
#undef PG8_LDA
#undef PG8_LDB
#undef PG8_MMA
#undef PG8_WAIT_V
#undef PG8_WAIT_L
#undef PG8_BAR
#undef PG8_SCHED

typedef const f32x4 (&AccRef)[2][2][4][2];
__device__ __forceinline__ f16x8 pack8(f32x4 a, f32x4 b) { f16x8 w; w[0] = (f16)a[0]; w[1] = (f16)a[1]; w[2] = (f16)a[2]; w[3] = (f16)a[3]; w[4] = (f16)b[0]; w[5] = (f16)b[1]; w[6] = (f16)b[2]; w[7] = (f16)b[3]; return w; }

struct EpiPx {
    static constexpr bool PERM = true, HAS_MID = false; static constexpr int MID1 = 0, MID2 = 0; f16* PX; f16* S5A; f16* ZT; f16* GTL;
    __device__ __forceinline__ void operator()(AccRef acc, const Unit& u, int wr, int wc, int fr, int fq) const { fr = opq(fr); fq = opq(fq);
        const int row0 = u.pm * BM + wr * 64 + fr, col0 = u.pn * BM + wc * 32 + 8 * fq;
#pragma unroll
        for (int ai = 0; ai < 2; ++ai)
#pragma unroll
            for (int m = 0; m < 4; ++m) { const int row = row0 + ai * HALF + m * 16;
#pragma unroll
                for (int bj = 0; bj < 2; ++bj) { const int c = col0 + bj * HALF; const f16x8 w = pack8(acc[ai][bj][m][0], acc[ai][bj][m][1]);
                    if (u.pn < 2) *(f16x8*)(S5A + (size_t)(row >> 4) * 16384 + (size_t)(c >> 4) * 512 + (row & 15) * 16 + (c & 15)) = w;
                    else if (u.pn >= 14 && u.pn < 20) {
#pragma unroll
                        for (int j = 0; j < 8; ++j) ZT[(size_t)(c - P_HY + j) * MT + row] = w[j]; }
                    else if (u.pn >= 20 && u.pn < 44) *(f16x8*)(GTL + ((size_t)(u.pn - 20) * 66 + u.pm) * 65536 + (size_t)(row - u.pm * BM) * 256 + (c - u.pn * BM)) = w;
                    else { const int pr = row < MX ? (row & ~8191) + ((row & 63) << 7) + ((row & 8191) >> 6) : row;
                        *(f16x8*)(PX + (size_t)pr * PXLD + (u.pn == 44 ? c - (W_GG - P_GG) : c)) = w; } } }
    }
};
struct EpiF16 {
    static constexpr bool PERM = true, HAS_MID = false; static constexpr int MID1 = 0, MID2 = 0; f16* O; int ldc;
    __device__ __forceinline__ void operator()(AccRef acc, const Unit& u, int wr, int wc, int fr, int fq) const { fr = opq(fr); fq = opq(fq);
        const int row0 = u.pm * BM + wr * 64 + fr, col0 = u.pn * BM + wc * 32 + 8 * fq;
#pragma unroll
        for (int ai = 0; ai < 2; ++ai)
#pragma unroll
            for (int m = 0; m < 4; ++m) { f16* rowp = O + (size_t)(row0 + ai * HALF + m * 16) * ldc + col0;
#pragma unroll
                for (int bj = 0; bj < 2; ++bj) *(f16x8*)(rowp + bj * HALF) = pack8(acc[ai][bj][m][0], acc[ai][bj][m][1]); }
    }
};
struct EpiS5In {
    static constexpr bool PERM = false, HAS_MID = false; static constexpr int MID1 = 0, MID2 = 0; float* S;
    __device__ __forceinline__ void operator()(AccRef acc, const Unit& u, int wr, int wc, int fr, int fq) const { fr = opq(fr); fq = opq(fq);
        const int row0 = u.pm * BM + wr * 64 + fr, col0 = wc * 32 + 4 * fq, g = u.pn;
#pragma unroll
        for (int ai = 0; ai < 2; ++ai)
#pragma unroll
            for (int m = 0; m < 4; ++m) { const int row = row0 + ai * HALF + m * 16; { float* rowp = S + ((size_t)row * 32 + g) * 256 + col0;
#pragma unroll
                for (int bj = 0; bj < 2; ++bj)
#pragma unroll
                    for (int n = 0; n < 2; ++n) *(f32x4*)(rowp + bj * HALF + n * 16) = acc[ai][bj][m][n]; } }
    }
};
struct EpiS5Out {
    static constexpr bool PERM = true, HAS_MID = false; static constexpr int MID1 = 0, MID2 = 0; const f16* S5A; f16* Y; const float* dvec;
    __device__ __forceinline__ void operator()(AccRef acc, const Unit& u, int wr, int wc, int fr, int fq) const { fr = opq(fr); fq = opq(fq);
        const int row0 = u.pm * BM + wr * 64 + fr, col0 = wc * 32 + 8 * fq, g = u.pn;
        const int h0 = col0 & 15;
        const f32x4 d0 = *(const f32x4*)(dvec + g * 16 + h0), d1 = *(const f32x4*)(dvec + g * 16 + h0 + 4);
#pragma unroll
        for (int ai = 0; ai < 2; ++ai) { f16x8 uu[4][2];
#pragma unroll
            for (int m = 0; m < 4; ++m)
#pragma unroll
                for (int bj = 0; bj < 2; ++bj) uu[m][bj] = *(const f16x8*)(S5A + (size_t)(row0 + ai * HALF + m * 16) * 16384 + (size_t)g * 512 + col0 + bj * HALF);
            PIN8(uu[0][0], uu[0][1], uu[1][0], uu[1][1], uu[2][0], uu[2][1], uu[3][0], uu[3][1]);
#pragma unroll
            for (int m = 0; m < 4; ++m) { const int chunk = row0 + ai * HALF + m * 16;
#pragma unroll
                for (int bj = 0; bj < 2; ++bj) { const int c = col0 + bj * HALF, t = c >> 4; f16x8 w;
#pragma unroll
                    for (int j = 0; j < 4; ++j) { w[j] = (f16)gelu_tanh_(acc[ai][bj][m][0][j] * (1.0f / S5SCALE) + d0[j] * (float)uu[m][bj][j]);
                                                  w[4 + j] = (f16)gelu_tanh_(acc[ai][bj][m][1][j] * (1.0f / S5SCALE) + d1[j] * (float)uu[m][bj][4 + j]); }
                    *(f16x8*)(Y + (size_t)(chunk * 16 + t) * 512 + g * 16 + h0) = w; } }
            asm volatile("" ::: "memory"); }
    }
};
struct EpiGlu {
    static constexpr bool PERM = true, HAS_MID = false; static constexpr int MID1 = 0, MID2 = 0; const f16* YP; f16* O; const float* bias;
    __device__ __forceinline__ void operator()(AccRef acc, const Unit& u, int wr, int wc, int fr, int fq) const { fr = opq(fr); fq = opq(fq);
        const int row0 = u.pm * BM + wr * 64 + fr, col0 = u.pn * BM + wc * 32 + 8 * fq;
        f32x4 bv[2][2];
#pragma unroll
        for (int bj = 0; bj < 2; ++bj) { bv[bj][0] = *(const f32x4*)(bias + col0 + bj * HALF); bv[bj][1] = *(const f32x4*)(bias + col0 + bj * HALF + 4); }
#pragma unroll
        for (int ai = 0; ai < 2; ++ai) { f16x8 yp[4][2];
#pragma unroll
            for (int m = 0; m < 4; ++m)
#pragma unroll
                for (int bj = 0; bj < 2; ++bj) yp[m][bj] = *(const f16x8*)(YP + (size_t)(row0 + ai * HALF + m * 16) * 512 + col0 + bj * HALF);
            PIN8(yp[0][0], yp[0][1], yp[1][0], yp[1][1], yp[2][0], yp[2][1], yp[3][0], yp[3][1]);
#pragma unroll
            for (int m = 0; m < 4; ++m)
#pragma unroll
                for (int bj = 0; bj < 2; ++bj) { f16x8 w;
#pragma unroll
                    for (int j = 0; j < 4; ++j) { w[j] = (f16)((float)yp[m][bj][j] * sigmoidf_(acc[ai][bj][m][0][j] + bv[bj][0][j])); w[4 + j] = (f16)((float)yp[m][bj][4 + j] * sigmoidf_(acc[ai][bj][m][1][j] + bv[bj][1][j])); }
                    *(f16x8*)(O + (size_t)(row0 + ai * HALF + m * 16) * 2048 + col0 + bj * HALF) = w; }
            asm volatile("" ::: "memory"); }
    }
};
template <int BR> struct EpiBranch {
    static constexpr bool PERM = true, HAS_MID = false; static constexpr int MID1 = 0, MID2 = 0; const f16* PX; f16* M;
    __device__ __forceinline__ void operator()(AccRef acc, const Unit& u, int wr, int wc, int fr, int fq) const { fr = opq(fr); fq = opq(fq);
        const int row0 = u.pm * BM + wr * 64 + fr, col0 = u.pn * BM + wc * 32 + 8 * fq;
#pragma unroll
        for (int ai = 0; ai < 2; ++ai)
#pragma unroll
            for (int m = 0; m < 4; ++m) { const int row = row0 + ai * HALF + m * 16;
#pragma unroll
                for (int bj = 0; bj < 2; ++bj) { const int c = col0 + bj * HALF;
                    const f16x8 gl = *(const f16x8*)(PX + (size_t)row * PXLD + P_MG + BR * 2048 + c);
                    f16* mp = M + (size_t)row * 2048 + c;
                    f16x8 prev; if (BR > 0) prev = *(const f16x8*)mp;
                    f16x8 w;
#pragma unroll
                    for (int j = 0; j < 4; ++j) { float v0 = sigmoidf_((float)gl[j]) * acc[ai][bj][m][0][j], v1 = sigmoidf_((float)gl[4 + j]) * acc[ai][bj][m][1][j];
                        if (BR > 0) { v0 += (float)prev[j]; v1 += (float)prev[4 + j]; } w[j] = (f16)v0; w[4 + j] = (f16)v1; }
                    *(f16x8*)mp = w; } asm volatile("" ::: "memory"); }
    }
};
typedef f32x4 (&AccMut)[2][2][4][2];

struct EpiBranchF {
    static constexpr bool PERM = true, HAS_MID = true; static constexpr int MID1 = 6, MID2 = 14;
    const f16* GTL; f16* M;
    __device__ __forceinline__ void mid(AccMut acc, const Unit& u, int seg, int wr, int wc, int fr, int fq) const { fr = opq(fr); fq = opq(fq);
        const int lrow0 = wr * 64 + fr, lcol0 = wc * 32 + 8 * fq;
        const f16* ga = GTL + ((size_t)((seg == 0 ? 0 : 8) + u.pn) * 66 + u.pm) * 65536; const f16* gb = ga + (size_t)8 * 66 * 65536;
#pragma unroll
        for (int ai = 0; ai < 2; ++ai) { f16x8 za[4][2], zb[4][2];
#pragma unroll
            for (int m = 0; m < 4; ++m)
#pragma unroll
                for (int bj = 0; bj < 2; ++bj) { const int off = (lrow0 + ai * HALF + m * 16) * 256 + lcol0 + bj * HALF; za[m][bj] = *(const f16x8*)(ga + off); zb[m][bj] = *(const f16x8*)(gb + off); }
            PIN8(za[0][0], za[0][1], za[1][0], za[1][1], za[2][0], za[2][1], za[3][0], za[3][1]); PIN8(zb[0][0], zb[0][1], zb[1][0], zb[1][1], zb[2][0], zb[2][1], zb[3][0], zb[3][1]);
#pragma unroll
            for (int m = 0; m < 4; ++m)
#pragma unroll
                for (int bj = 0; bj < 2; ++bj)
#pragma unroll
                    for (int j = 0; j < 4; ++j) { acc[ai][bj][m][0][j] *= (1.0f + __expf(-(float)zb[m][bj][j])) * __builtin_amdgcn_rcpf(1.0f + __expf(-(float)za[m][bj][j]));
                                                  acc[ai][bj][m][1][j] *= (1.0f + __expf(-(float)zb[m][bj][4 + j])) * __builtin_amdgcn_rcpf(1.0f + __expf(-(float)za[m][bj][4 + j])); }
            asm volatile("" ::: "memory"); }
    }
    __device__ __forceinline__ void operator()(AccRef acc, const Unit& u, int wr, int wc, int fr, int fq) const { fr = opq(fr); fq = opq(fq);
        const int row0 = u.pm * BM + wr * 64 + fr, col0 = u.pn * BM + wc * 32 + 8 * fq;
#pragma unroll
        for (int ai = 0; ai < 2; ++ai) { f16x8 gl[4][2];
#pragma unroll
            for (int m = 0; m < 4; ++m)
#pragma unroll
                for (int bj = 0; bj < 2; ++bj) gl[m][bj] = *(const f16x8*)(GTL + ((size_t)(16 + u.pn) * 66 + u.pm) * 65536 + (wr * 64 + fr + ai * HALF + m * 16) * 256 + wc * 32 + 8 * fq + bj * HALF);
            PIN8(gl[0][0], gl[0][1], gl[1][0], gl[1][1], gl[2][0], gl[2][1], gl[3][0], gl[3][1]);
#pragma unroll
            for (int m = 0; m < 4; ++m)
#pragma unroll
                for (int bj = 0; bj < 2; ++bj) { f16x8 w;
#pragma unroll
                    for (int j = 0; j < 4; ++j) { w[j] = (f16)(sigmoidf_((float)gl[m][bj][j]) * acc[ai][bj][m][0][j]); w[4 + j] = (f16)(sigmoidf_((float)gl[m][bj][4 + j]) * acc[ai][bj][m][1][j]); }
                    *(f16x8*)(M + (size_t)(row0 + ai * HALF + m * 16) * 2048 + col0 + bj * HALF) = w; }
            asm volatile("" ::: "memory"); }
    }
};
struct EpiUpAct {
    static constexpr bool PERM = true, HAS_MID = false; static constexpr int MID1 = 0, MID2 = 0; f16* ACT; float* HALO; const float* cw; const float* cb; LAS float* HL;
    __device__ __forceinline__ void operator()(AccRef acc, const Unit& u, int wr, int wc, int fr, int fq) const { fr = opq(fr); fq = opq(fq);
        const int lane = fq * 16 + fr;
#pragma unroll
        for (int ai = 0; ai < 2; ++ai) { LAS float* hp = HL + ((ai * 2 + wr) * 4 + wc) * 64 + 8 * fq;
            if (fr == 0) { *(LAS f32x4*)(hp) = acc[ai][0][0][0]; *(LAS f32x4*)(hp + 4) = acc[ai][0][0][1]; }
            if (fr == 15) { *(LAS f32x4*)(hp + 32) = acc[ai][0][3][0]; *(LAS f32x4*)(hp + 36) = acc[ai][0][3][1]; } }
        { float* gh = HALO + ((size_t)u.pm * 44 + u.pn) * 768 + wc * 32 + 8 * fq;
          if (wr == 0 && fr < 2) { *(f32x4*)(gh + fr * 128) = acc[0][0][0][0]; *(f32x4*)(gh + fr * 128 + 4) = acc[0][0][0][1]; }
          if (wr == 0 && fr == 0) { *(f32x4*)(gh + 4 * 128) = acc[0][1][0][0]; *(f32x4*)(gh + 4 * 128 + 4) = acc[0][1][0][1]; }
          if (wr == 1 && fr >= 14) { *(f32x4*)(gh + (fr - 12) * 128) = acc[1][0][3][0]; *(f32x4*)(gh + (fr - 12) * 128 + 4) = acc[1][0][3][1]; }
          if (wr == 1 && fr == 15) { *(f32x4*)(gh + 5 * 128) = acc[1][1][3][0]; *(f32x4*)(gh + 5 * 128 + 4) = acc[1][1][3][1]; } }
        asm volatile("s_waitcnt lgkmcnt(0)" ::: "memory"); __builtin_amdgcn_s_barrier(); __builtin_amdgcn_s_barrier(); asm volatile("" ::: "memory");
        const int colg = u.pn * 128 + wc * 32 + 8 * fq;
        const int srcR = (lane & 48) | ((fr + 15) & 15), srcL = (lane & 48) | ((fr + 1) & 15);
        const int row0 = u.pm * BM + wr * 64 + fr;
#pragma unroll
        for (int n = 0; n < 2; ++n) {
            const f32x4 w0 = *(const f32x4*)(cw + colg + 4 * n), w1 = *(const f32x4*)(cw + FFH + colg + 4 * n), w2 = *(const f32x4*)(cw + 2 * FFH + colg + 4 * n), bb = *(const f32x4*)(cb + colg + 4 * n);
#pragma unroll
            for (int ai = 0; ai < 2; ++ai) {
                const bool hasp = (wr == 1) || (ai == 1), hasn = (wr == 0) || (ai == 0);
                const LAS float* pp = HL + (((wr == 1 ? ai : 0) * 2 + (wr == 1 ? 0 : 1)) * 4 + wc) * 64 + 32 + 8 * fq + 4 * n;
                const LAS float* np = HL + (((wr == 0 ? ai : 1) * 2 + (wr == 0 ? 1 : 0)) * 4 + wc) * 64 + 8 * fq + 4 * n;
                const f32x4 hprev = hasp ? *(const LAS f32x4*)pp : (f32x4){0.f, 0.f, 0.f, 0.f}, hnext = hasn ? *(const LAS f32x4*)np : (f32x4){0.f, 0.f, 0.f, 0.f};
                f32x4 R[4], L[4];
#pragma unroll
                for (int m = 0; m < 4; ++m)
#pragma unroll
                    for (int j = 0; j < 4; ++j) { R[m][j] = __shfl(acc[ai][0][m][n][j], srcR); L[m][j] = __shfl(acc[ai][0][m][n][j], srcL); }
#pragma unroll
                for (int m = 0; m < 4; ++m) { const f32x4 pv = fr > 0 ? R[m] : (m > 0 ? R[m > 0 ? m - 1 : 0] : hprev); const f32x4 nv = fr < 15 ? L[m] : (m < 3 ? L[m < 3 ? m + 1 : 3] : hnext);
                    const f32x4 a = w0 * pv + w1 * acc[ai][0][m][n] + w2 * nv + bb;
                    f16x4 o;
#pragma unroll
                    for (int j = 0; j < 4; ++j) o[j] = (f16)(siluf_(a[j]) * acc[ai][1][m][n][j]);
                    *(f16x4*)(ACT + (size_t)(row0 + ai * HALF + m * 16) * FFH + colg + 4 * n) = o; }
                asm volatile("" ::: "memory");
            }
        }
    }
};
struct EpiSlab {
    static constexpr bool PERM = false, HAS_MID = false; static constexpr int MID1 = 0, MID2 = 0; float* slab; const float* mod; int goff;
    __device__ __forceinline__ void operator()(AccRef acc, const Unit& u, int wr, int wc, int fr, int fq) const { fr = opq(fr); fq = opq(fq);
        const int pn = u.pn & 255, ks = u.pn >> 8;
        const int row0 = (u.pm - 64) * BM + wr * 64 + fr, col0 = pn * BM + wc * 32 + 4 * fq;
        const float* gp = mod + 2 * 12288 + goff + col0;
        f32x4 gv[2][2];
#pragma unroll
        for (int bj = 0; bj < 2; ++bj)
#pragma unroll
            for (int n = 0; n < 2; ++n) gv[bj][n] = *(const f32x4*)(gp + bj * HALF + n * 16);
        float* sp = slab + (size_t)ks * MC * D;
#pragma unroll
        for (int ai = 0; ai < 2; ++ai)
#pragma unroll
            for (int m = 0; m < 4; ++m) { float* rowp = sp + (size_t)(row0 + ai * HALF + m * 16) * D + col0;
#pragma unroll
                for (int bj = 0; bj < 2; ++bj)
#pragma unroll
                    for (int n = 0; n < 2; ++n) *(f32x4*)(rowp + bj * HALF + n * 16) = gv[bj][n] * acc[ai][bj][m][n]; }
    }
};
struct EpiResid {
    static constexpr bool PERM = false, HAS_MID = false; static constexpr int MID1 = 0, MID2 = 0; float* X; const float* mod; int goff; const float* Xs;
    __device__ __forceinline__ void operator()(AccRef acc, const Unit& u, int wr, int wc, int fr, int fq) const { fr = opq(fr); fq = opq(fq);
        const int row0 = u.pm * BM + wr * 64 + fr, col0 = u.pn * BM + wc * 32 + 4 * fq;
        const int bsel = u.pm < 32 ? 0 : (u.pm < 64 ? 1 : 2);
        const float* gp = mod + bsel * 12288 + goff + col0;
        f32x4 gv[2][2];
#pragma unroll
        for (int bj = 0; bj < 2; ++bj)
#pragma unroll
            for (int n = 0; n < 2; ++n) gv[bj][n] = *(const f32x4*)(gp + bj * HALF + n * 16);
#pragma unroll
        for (int ai = 0; ai < 2; ++ai) { f32x4 xv[4][2][2];
#pragma unroll
            for (int m = 0; m < 4; ++m) { const float* rowp = Xs + (size_t)(row0 + ai * HALF + m * 16) * D + col0;
#pragma unroll
                for (int bj = 0; bj < 2; ++bj)
#pragma unroll
                    for (int n = 0; n < 2; ++n) xv[m][bj][n] = *(const f32x4*)(rowp + bj * HALF + n * 16); }
            PIN8(xv[0][0][0], xv[0][0][1], xv[0][1][0], xv[0][1][1], xv[1][0][0], xv[1][0][1], xv[1][1][0], xv[1][1][1]); PIN8(xv[2][0][0], xv[2][0][1], xv[2][1][0], xv[2][1][1], xv[3][0][0], xv[3][0][1], xv[3][1][0], xv[3][1][1]);
#pragma unroll
            for (int m = 0; m < 4; ++m) { float* rowp = X + (size_t)(row0 + ai * HALF + m * 16) * D + col0;
#pragma unroll
                for (int bj = 0; bj < 2; ++bj)
#pragma unroll
                    for (int n = 0; n < 2; ++n) *(f32x4*)(rowp + bj * HALF + n * 16) = xv[m][bj][n] + gv[bj][n] * acc[ai][bj][m][n]; }
            asm volatile("" ::: "memory"); }
    }
};
}


__device__ __forceinline__ void ph_prologue(const Ctx& F, const ArgsV& AV) {
    const int gt = F.bid * 512 + F.tid, NT = F.G * 512;
    { const f32x4* cs = (const f32x4*)AV.in(I_CTX); f32x4* xr = (f32x4*)(F.ws + WS_XRES);
      for (int i = gt; i < MC * D / 4; i += NT) xr[MX * D / 4 + i] = cs[i]; }
    LAS float* sc = (LAS float*)F.lds;
    LAS float* red = (LAS float*)(F.lds + 3 * 2048 * 4);
    for (int i = F.tid; i < 3 * 2048; i += 512) { const int r = i / 2048, k = i % 2048; const float v = r < 2 ? AV.in(I_C)[r * 2048 + k] : AV.in(I_CCTX)[k]; sc[i] = siluf_(v); }
    __syncthreads();
    const int col = F.tid & 63, ks = F.tid >> 6;
    for (int chunk = F.bid; chunk < DEPTH * 192; chunk += F.G) {
        const int l = chunk / 192, n0 = (chunk % 192) * 64;
        const float* w = AV.in(I_WMOD) + (size_t)l * 2048 * 12288 + n0 + col;
        float s0 = 0.f, s1 = 0.f, s2 = 0.f;
#pragma unroll 8
        for (int k = ks * 256; k < ks * 256 + 256; ++k) { const float wv = w[(size_t)k * 12288]; s0 += sc[k] * wv; s1 += sc[2048 + k] * wv; s2 += sc[4096 + k] * wv; }
        red[(ks * 3 + 0) * 64 + col] = s0; red[(ks * 3 + 1) * 64 + col] = s1; red[(ks * 3 + 2) * 64 + col] = s2;
        __syncthreads();
        if (F.tid < 192) { const int r = F.tid >> 6, c2 = F.tid & 63; float s = 0.f;
#pragma unroll
            for (int q = 0; q < 8; ++q) s += red[(q * 3 + r) * 64 + c2];
            ((float*)(F.ws + WS_MOD))[((size_t)l * 3 + r) * 12288 + n0 + c2] = s + AV.in(I_BMOD)[(size_t)l * 12288 + n0 + c2]; }
        __syncthreads();
    }
}

__device__ __forceinline__ void conv_item(const float* W, int ldw, int k0, int srccol, f16* WT, int dstrow, int ldk) {
    float v[64];
    const float* src = W + (size_t)k0 * ldw + (srccol >= 0 ? srccol : 0);
#pragma unroll
    for (int k = 0; k < 64; ++k) v[k] = src[(size_t)k * ldw];
#pragma unroll
    for (int k = 0; k < 64; k += 8) PIN8(v[k], v[k + 1], v[k + 2], v[k + 3], v[k + 4], v[k + 5], v[k + 6], v[k + 7]);
    f16* dst = WT + (size_t)dstrow * ldk + k0;
#pragma unroll
    for (int kg = 0; kg < 8; ++kg) { f16x8 o;
#pragma unroll
        for (int e = 0; e < 8; ++e) o[e] = srccol >= 0 ? (f16)v[8 * kg + e] : (f16)0.f;
        *(f16x8*)(dst + 8 * kg) = o; }
}
__device__ __forceinline__ void ph_convert_weights(const Ctx& F, const ArgsV& AV, int l) {
    const int skip = F.G > 64 ? 32 : 0;
    if (F.bid < skip) return;
    const int gw = (F.bid - skip) * 8 + F.wave, NGW = (F.G - skip) * 8, lane = F.lane;
    constexpr int I_IN = 32 * 180, I_GLU = 8 * 8, I_BR = 32 * 32, I_OUT = 32 * 32, I_UP = 32 * 176, I_DN = 88 * 32;
    constexpr int NIT = I_IN + I_GLU + I_BR + I_OUT + I_UP + I_DN;
    for (int it = gw; it < NIT; it += NGW) {
        int r = it;
        if (r < I_IN) { const int kb = r / 180, nb = r % 180, j = nb * 64 + lane;
            const int src = j < 2048 ? j : (j < 11264 ? j + 32 : (j < 11296 ? 2048 + (j - 11264) : -1));
            conv_item(AV.in(I_WIN) + (size_t)l * 2048 * INW, INW, kb * 64, src, (f16*)(F.ws + WS_WIN), j, 2048); continue; } r -= I_IN;
        if (r < I_GLU) { const int kb = r / 8, nb = r % 8, j = nb * 64 + lane; conv_item(AV.in(I_GLUW) + (size_t)l * 512 * 512, 512, kb * 64, j, (f16*)(F.ws + WS_WGLU), j, 512); continue; } r -= I_GLU;
        if (r < I_BR) { const int kb = r / 32, nb = r % 32, j = nb * 64 + lane; conv_item(AV.in(I_WBR) + (size_t)l * 2048 * 2048, 2048, kb * 64, j, (f16*)(F.ws + WS_WBR), j, 2048); continue; } r -= I_BR;
        if (r < I_OUT) { const int kb = r / 32, nb = r % 32, j = nb * 64 + lane; conv_item(AV.in(I_WOUT) + (size_t)l * 2048 * 2048, 2048, kb * 64, j, (f16*)(F.ws + WS_WOUT), j, 2048); continue; } r -= I_OUT;
        if (r < I_UP) { const int kb = r / 176, nb = r % 176, j = nb * 64 + lane, pn = j >> 8, i = j & 255; const int src = i < 128 ? 128 * pn + i : FFH + 128 * pn + (i - 128);
            conv_item(AV.in(I_WUP) + (size_t)l * 2048 * UPLD, UPLD, kb * 64, src, (f16*)(F.ws + WS_WUP), j, 2048); continue; } r -= I_UP;
        { const int kb = r / 32, nb = r % 32, j = nb * 64 + lane; conv_item(AV.in(I_WDN) + (size_t)l * FFH * 2048, 2048, kb * 64, j, (f16*)(F.ws + WS_WDN), j, FFH); }
    }
}

__device__ __forceinline__ void s5_mats_group(const Ctx& F, const ArgsV& AV, int l, int g) {
    LAS f32x2* APOW = (LAS f32x2*)F.lds;
    LAS f32x2* BBAR = APOW + 2 * 17 * 64;
    LAS f32x2* CM = BBAR + 2 * 64 * 16;
    LAS float* KLAG = (LAS float*)(CM + 2 * 16 * 64);
    __syncthreads();
    for (int i = F.tid; i < 2 * 17 * 64; i += 512) { const int d = i / (17 * 64), e = (i / 64) % 17, n = i % 64;
        const size_t pi = (((size_t)l * 2 + d) * 32 + g) * 64 + n;
        const float are = AV.in(I_S5ARE)[pi], aim = AV.in(I_S5AIM)[pi], dt = expf(AV.in(I_S5STEP)[((size_t)l * 2 + d) * 32 + g]);
        const float zr = are * dt * (float)e, zi = aim * dt * (float)e; float s, c; sincosf(zi, &s, &c); const float m = expf(zr);
        APOW[i] = (f32x2){m * c, m * s}; }
    __syncthreads();
    for (int i = F.tid; i < 2 * 64 * 16; i += 512) { const int d = i / 1024, n = (i / 16) % 64, h = i % 16;
        const size_t pi = (((size_t)l * 2 + d) * 32 + g) * 64 + n;
        const float are = AV.in(I_S5ARE)[pi], aim = AV.in(I_S5AIM)[pi];
        const f32x2 ab = APOW[(d * 17 + 1) * 64 + n]; const f32x2 num = (f32x2){ab.x - 1.0f, ab.y};
        const float den = are * are + aim * aim; const f32x2 q = (f32x2){(num.x * are + num.y * aim) / den, (num.y * are - num.x * aim) / den};
        const size_t bi = (pi * 16) + h;
        BBAR[i] = cmul(q, (f32x2){AV.in(I_S5BRE)[bi], AV.in(I_S5BIM)[bi]});
        const size_t ci = ((((size_t)l * 2 + d) * 32 + g) * 16 + h) * 64 + n;
        CM[(d * 16 + h) * 64 + n] = (f32x2){AV.in(I_S5CRE)[ci], AV.in(I_S5CIM)[ci]}; }
    __syncthreads();
    for (int i = F.tid; i < 2 * 16 * 256; i += 512) { const int d = i / 4096, lag = (i / 256) % 16, h = (i / 16) % 16, hp = i % 16; float s = 0.f;
        for (int n = 0; n < 64; ++n) { const f32x2 t = cmul(CM[(d * 16 + h) * 64 + n], APOW[(d * 17 + lag) * 64 + n]); const f32x2 b = BBAR[(d * 64 + n) * 16 + hp]; s += t.x * b.x - t.y * b.y; }
        KLAG[i] = s; }
    __syncthreads();
    f16* W = (f16*)(F.ws + WS_S5W) + (size_t)g * 256 * 512;
    for (int i = F.tid; i < 256 * 64; i += 512) { const int n = i / 64, k8 = (i % 64) * 8, t = n >> 4, h = n & 15; f16x8 o;
#pragma unroll
        for (int e = 0; e < 8; ++e) { const int k = k8 + e; float v;
            if (k < 256) { const int s = k >> 4, hp = k & 15; v = 0.f;
                if (t >= s) v += KLAG[((0 * 16 + (t - s)) * 16 + h) * 16 + hp];
                if (s >= t) v += KLAG[((1 * 16 + (s - t)) * 16 + h) * 16 + hp];
                v *= S5SCALE; }
            else { const int d = (k - 256) >> 7, nn2 = (k - 256) & 127, nn = nn2 & 63, im = nn2 >> 6, ex = d == 0 ? t + 1 : 16 - t;
                const f32x2 z = cmul(CM[(d * 16 + h) * 64 + nn], APOW[(d * 17 + ex) * 64 + nn]); v = im ? -z.y : z.x; }
            o[e] = (f16)v; }
        *(f16x8*)(W + (size_t)n * 512 + k8) = o; }
    f16* Mx = (f16*)(F.ws + WS_S5M) + (size_t)g * 256 * 256;
    for (int i = F.tid; i < 256 * 32; i += 512) { const int n = i / 32, k8 = (i % 32) * 8, d = n >> 7, ri = (n >> 6) & 1, nn = n & 63; f16x8 o;
#pragma unroll
        for (int e = 0; e < 8; ++e) { const int k = k8 + e, s = k >> 4, hp = k & 15, ex = d == 0 ? 15 - s : s;
            const f32x2 z = cmul(APOW[(d * 17 + ex) * 64 + nn], BBAR[(d * 64 + nn) * 16 + hp]); o[e] = (f16)((ri ? z.y : z.x) * S5SCALE); }
        *(f16x8*)(Mx + (size_t)n * 256 + k8) = o; }
    if (F.tid < 128) { const int d = F.tid >> 6, nn = F.tid & 63; ((f32x2*)(F.ws + WS_S5AT))[(d * 32 + g) * 64 + nn] = APOW[(d * 17 + 16) * 64 + nn]; }
    __syncthreads();
}

__device__ __forceinline__ void ph_hyena_h2(const Ctx& F, const ArgsV& AV, int l) {
    LAS float* W1 = (LAS float*)F.lds;
    LAS float* W2 = W1 + 33 * 64;
    LAS float* PV = W2 + 64 * 64;
    LAS float* SCR = PV + 256;
    __syncthreads();
    for (int i = F.tid; i < 33 * 64; i += 512) W1[i] = AV.in(I_HYW1)[(size_t)l * 33 * 64 + i];
    for (int i = F.tid; i < 64 * 64; i += 512) W2[i] = AV.in(I_HYW2)[(size_t)l * 4096 + i];
    if (F.tid < 64) { PV[F.tid] = AV.in(I_HYB1)[l * 64 + F.tid]; PV[64 + F.tid] = AV.in(I_HYF1)[l * 64 + F.tid]; PV[128 + F.tid] = AV.in(I_HYB2)[l * 64 + F.tid]; PV[192 + F.tid] = AV.in(I_HYF2)[l * 64 + F.tid]; }
    __syncthreads();
    LAS float* scr = SCR + F.wave * 64;
    const int gw = F.bid * 8 + F.wave, NGW = F.G * 8, j = F.lane;
    for (int p = gw; p < SEQ + LC; p += NGW) {
        const int n = p < SEQ ? SEQ : LC, pos = p < SEQ ? p : p - SEQ;
        float feat = 0.f;
        if (j == 0) feat = (float)pos / (float)(n - 1);
        else if (j < 33) { const int fi = (j - 1) & 15; const float fr = 1e-4f + (float)fi * ((15.0f - 1e-4f) / 15.0f);
            const float ang = (6.283185307179586f / (float)n) * (float)pos * fr; float s, c; sincosf(ang, &s, &c); feat = j < 17 ? c : -s; }
        scr[j] = feat; LDS_WAIT(); asm volatile("" ::: "memory");
        float a = PV[j];
        for (int i = 0; i < 33; ++i) a += scr[i] * W1[i * 64 + j];
        const float h1 = sinf(PV[64 + j] * a);
        LDS_WAIT(); asm volatile("" ::: "memory");
        scr[j] = h1; LDS_WAIT(); asm volatile("" ::: "memory");
        float b = PV[128 + j];
        for (int i = 0; i < 64; ++i) b += scr[i] * W2[i * 64 + j];
        ((f16*)(F.ws + WS_H2H))[((size_t)l * (SEQ + LC) + p) * 64 + j] = (f16)sinf(PV[192 + j] * b);
        LDS_WAIT(); asm volatile("" ::: "memory");
    }
}

__device__ __forceinline__ void ph_norm(const Ctx& F, const ArgsV& AV, int l, int which, int nrows, int nslab) {
    const int gw = F.bid * 8 + F.wave, NGW = F.G * 8;
    float* X = (float*)(F.ws + WS_XRES); f16* O = (f16*)(F.ws + WS_HN); const float* SL = (const float*)(F.ws + WS_SLAB);
    const float* Xin = (l == 0 && which == 0) ? AV.in(I_X) : X;
    const float* gain = AV.in(which ? I_N2G : I_N1G) + (size_t)l * D;
    const float* mod = (const float*)(F.ws + WS_MOD) + (size_t)l * 3 * 12288;
    const int shoff = which ? 6144 : 0, soff = which ? 8192 : 2048;
    int cur_bsel = -1; f32x4 Am[8], Bm[8], vn[8];
    if (gw < nrows) { const f32x4* xr0 = (const f32x4*)((gw < MX ? Xin : X) + (size_t)gw * D) + F.lane;
#pragma unroll
        for (int j = 0; j < 8; ++j) vn[j] = xr0[64 * j]; }
    for (int m = gw; m < nrows; m += NGW) {
        const int bsel = m < SEQ ? 0 : (m < MX ? 1 : 2);
        f32x4* xr = (f32x4*)(X + (size_t)m * D) + F.lane;
        f32x4 v[8]; float s = 0.f;
        PIN8(vn[0], vn[1], vn[2], vn[3], vn[4], vn[5], vn[6], vn[7]);
#pragma unroll
        for (int j = 0; j < 8; ++j) v[j] = vn[j];
        if (m + NGW < nrows) { const f32x4* xq = (const f32x4*)((m + NGW < MX ? Xin : X) + (size_t)(m + NGW) * D) + F.lane;
#pragma unroll
            for (int j = 0; j < 8; ++j) vn[j] = xq[64 * j]; }
        if (bsel != cur_bsel) { cur_bsel = bsel; const float* mp = mod + bsel * 12288;
#pragma unroll
            for (int j = 0; j < 8; ++j) { const int c = 4 * F.lane + 256 * j; const f32x4 g = *(const f32x4*)(gain + c), sc = *(const f32x4*)(mp + soff + c); Bm[j] = *(const f32x4*)(mp + shoff + c); Am[j] = g * (sc + 1.0f); }
            PIN8(Am[0], Am[1], Am[2], Am[3], Am[4], Am[5], Am[6], Am[7]); PIN8(Bm[0], Bm[1], Bm[2], Bm[3], Bm[4], Bm[5], Bm[6], Bm[7]); }
        if (m >= MX && nslab > 0) {
            for (int sl = 0; sl < nslab; ++sl) { const f32x4* sr = (const f32x4*)(SL + ((size_t)sl * MC + (m - MX)) * D) + F.lane;
#pragma unroll
                for (int j = 0; j < 8; ++j) v[j] = v[j] + sr[64 * j]; }
#pragma unroll
            for (int j = 0; j < 8; ++j) xr[64 * j] = v[j]; }
#pragma unroll
        for (int j = 0; j < 8; ++j) s += (v[j].x * v[j].x + v[j].y * v[j].y) + (v[j].z * v[j].z + v[j].w * v[j].w);
        const float rstd = 1.0f / sqrtf(wave_sum(s) * (1.0f / D) + EPS);
#pragma unroll
        for (int j = 0; j < 8; ++j) { const int c = 4 * F.lane + 256 * j;
            f16x4 o;
#pragma unroll
            for (int e = 0; e < 4; ++e) o[e] = (f16)(v[j][e] * rstd * Am[j][e] + Bm[j][e]);
            *(f16x4*)(O + (size_t)m * D + c) = o; }
    }
}
__device__ __forceinline__ void ph_final_norm(const Ctx& F, const ArgsV& AV) {
    const int gw = F.bid * 8 + F.wave, NGW = F.G * 8;
    const float* X = (const float*)(F.ws + WS_XRES); const float* gain = AV.in(I_FNG);
    f32x4 gm[8], vn[8];
#pragma unroll
    for (int j = 0; j < 8; ++j) gm[j] = *(const f32x4*)(gain + 4 * F.lane + 256 * j);
    if (gw < MX) { const f32x4* xr0 = (const f32x4*)(X + (size_t)gw * D) + F.lane;
#pragma unroll
        for (int j = 0; j < 8; ++j) vn[j] = xr0[64 * j]; }
    for (int m = gw; m < MX; m += NGW) {
        f32x4 v[8]; float s = 0.f;
        PIN8(vn[0], vn[1], vn[2], vn[3], vn[4], vn[5], vn[6], vn[7]);
#pragma unroll
        for (int j = 0; j < 8; ++j) v[j] = vn[j];
        if (m + NGW < MX) { const f32x4* xq = (const f32x4*)(X + (size_t)(m + NGW) * D) + F.lane;
#pragma unroll
            for (int j = 0; j < 8; ++j) vn[j] = xq[64 * j]; }
#pragma unroll
        for (int j = 0; j < 8; ++j) s += (v[j].x * v[j].x + v[j].y * v[j].y) + (v[j].z * v[j].z + v[j].w * v[j].w);
        const float rstd = 1.0f / sqrtf(wave_sum(s) * (1.0f / D) + EPS);
#pragma unroll
        for (int j = 0; j < 8; ++j) { const int c = 4 * F.lane + 256 * j;
            *(f32x4*)(AV.out + (size_t)m * D + c) = v[j] * rstd * gm[j]; }
    }
}

__device__ __forceinline__ void ph_s5_scan(const Ctx& F) {
    if (F.tid >= 32) return;
    const float* S = (const float*)(F.ws + WS_S5S); f16* SA = (f16*)(F.ws + WS_S5A);
    for (int gt = F.bid * 32 + F.tid; gt < 2 * 2 * 32 * 64; gt += F.G * 32) {
        const int nn = gt & 63, g = (gt >> 6) & 31, d = (gt >> 11) & 1, b = gt >> 12;
        const f32x2 at = ((const f32x2*)(F.ws + WS_S5AT))[(d * 32 + g) * 64 + nn];
        f32x2 st = (f32x2){0.f, 0.f};
        f32x2 la[16], lb[16];
#define S5_CHUNK(step) ((d == 0) ? ((step) < 16 ? 1024 + b * 16 + (step) : b * 512 + ((step) - 16)) : ((step) < 16 ? 1024 + b * 16 + (15 - (step)) : b * 512 + (511 - ((step) - 16))))
#define S5_LOAD(dst, base) do { _Pragma("unroll") for (int u = 0; u < 16; ++u) { const int stp = (base) + u < 528 ? (base) + u : 527; const size_t so = ((size_t)S5_CHUNK(stp) * 32 + g) * 256 + d * 128 + nn; dst[u] = (f32x2){S[so], S[so + 64]}; } } while (0)
#define S5_STEP(src, base) do { PIN8(src[0], src[1], src[2], src[3], src[4], src[5], src[6], src[7]); PIN8(src[8], src[9], src[10], src[11], src[12], src[13], src[14], src[15]); \
            _Pragma("unroll") for (int u = 0; u < 16; ++u) { f16* xp = SA + (size_t)S5_CHUNK((base) + u) * 16384 + (size_t)g * 512 + 256 + d * 128 + nn; xp[0] = (f16)st.x; xp[64] = (f16)st.y; st = cmul(at, st) + src[u]; } } while (0)
        S5_LOAD(la, 0);
        for (int base = 0; base < 528; base += 32) {
            S5_LOAD(lb, base + 16);
            S5_STEP(la, base);
            if (base + 16 < 528) { S5_LOAD(la, base + 32); S5_STEP(lb, base + 16); }
        }
#undef S5_CHUNK
#undef S5_LOAD
#undef S5_STEP
    }
}

__device__ __forceinline__ void ph_ffn_fix(const Ctx& F, const ArgsV& AV, int l, int nMr) {
    const float* HALO = (const float*)(F.ws + WS_HALO); f16* ACT = (f16*)(F.ws + WS_ACT);
    const float* cw = AV.in(I_FFCW) + (size_t)l * 3 * FFH; const float* cb = AV.in(I_FFCB) + (size_t)l * FFH;
    const int NT = nMr * 44 * 2 * 128;
    for (int task = F.bid * 512 + F.tid; task < NT; task += F.G * 512) {
        const int c = task & 127, which = (task >> 7) & 1, tile = task >> 8, pn = tile % 44, pm = tile / 44;
        const float* h = HALO + ((size_t)pm * 44 + pn) * 768 + c; const int col = pn * 128 + c;
        const bool first = (pm == 0 || pm == 32 || pm >= 64), last = (pm == 31 || pm >= 63);
        float ap, ac, an, b;
        if (which == 0) { ap = first ? 0.f : HALO[((size_t)(pm - 1) * 44 + pn) * 768 + 3 * 128 + c]; ac = h[0]; an = h[128]; b = h[4 * 128]; }
        else { ap = h[2 * 128]; ac = h[3 * 128]; an = last ? 0.f : HALO[((size_t)(pm + 1) * 44 + pn) * 768 + c]; b = h[5 * 128]; }
        const float a = cw[col] * ap + cw[FFH + col] * ac + cw[2 * FFH + col] * an + cb[col];
        ACT[(size_t)(pm * 256 + (which ? 255 : 0)) * FFH + col] = (f16)(siluf_(a) * b);
    }
}

namespace gla {
constexpr int QK_LD = 136, KH_LD = 72, VT_LD = 72, P_LD = 72;
constexpr int OFF_QT = 0;
constexpr int OFF_KT = 17408;
constexpr int OFF_VT = OFF_KT + 18432;
constexpr int OFF_P = OFF_VT + 36864;
constexpr int OFF_LR = OFF_P + 9216;
constexpr int OFF_GT = OFF_LR + 4096;
constexpr int OFF_DEC = OFF_GT + 2048;
constexpr int OFF_RS = OFF_DEC + 512;
constexpr int OFF_QR = OFF_RS + 2048;
constexpr int OFF_KR = OFF_QR + 17408;
constexpr int OFF_WG = OFF_KR + 17408;
static_assert(OFF_WG + 8192 <= LDSCTL_OFF, "gla lds");

__device__ __forceinline__ int grow(int b, int sc, int j, int i) {
    if (sc < 32) { const int col = 2 * sc + (j >> 1), r = (j & 1) * 64 + i; return b * SEQ + r * 64 + col; }
    return MX + b * LC + j * 64 + i;
}
__device__ __forceinline__ int prow(int b, int sc, int j, int i) {
    return sc < 32 ? b * SEQ + sc * 256 + j * 64 + i : MX + b * LC + j * 64 + i;
}
#define GLA_MFMA(a, b, c) __builtin_amdgcn_mfma_f32_16x16x32_f16(a, b, c, 0, 0, 0)

template <bool FULL>
__device__ __forceinline__ void gla_unit(const Ctx& F, const ArgsV& AV, int l, int unit) {
    const int b = unit / (4 * NSC), h = (unit / NSC) % 4, sc = unit % NSC;
    LAS f16* QT = (LAS f16*)(F.lds + OFF_QT); LAS f16* KT = (LAS f16*)(F.lds + OFF_KT); LAS f16* VT = (LAS f16*)(F.lds + OFF_VT);
    LAS f16* PP = (LAS f16*)(F.lds + OFF_P); LAS f16* LR = (LAS f16*)(F.lds + OFF_LR);
    LAS float* GT = (LAS float*)(F.lds + OFF_GT); LAS float* DEC = (LAS float*)(F.lds + OFF_DEC); LAS float* RS = (LAS float*)(F.lds + OFF_RS);
    LAS f16* QR = (LAS f16*)(F.lds + OFF_QR); LAS f16* KR = (LAS f16*)(F.lds + OFF_KR); LAS float* WG = (LAS float*)(F.lds + OFF_WG);
    const int tid = F.tid, lane = F.lane, w = F.wave, q0 = lane >> 4, c0 = lane & 15;
    const int dk0 = tid & 127, ig0 = tid >> 7;
    const f16* PX = (const f16*)(F.ws + WS_PX);
    const float scale = 0.08838834764831845f;
    for (int dir = 0; dir < 2; ++dir) {
        __syncthreads();
        for (int i = tid; i < 16 * 128; i += 512) WG[i] = AV.in(I_GLAWG)[(((size_t)l * 2 + dir) * 16 + (i >> 7)) * 512 + h * 128 + (i & 127)];
        const float bgv = AV.in(I_GLABG)[((size_t)l * 2 + dir) * 512 + h * 128 + dk0];
        const size_t sidx = ((((size_t)b * 4 + h) * NSC + sc) * 2 + dir);
        f32x4 accS[8][2];
        if (FULL && sc < 32) { const float* Sin = (const float*)(F.ws + WS_GSIN) + sidx * 32768; const int q = opq(q0), c = opq(c0);
#pragma unroll
            for (int dt = 0; dt < 8; ++dt)
#pragma unroll
                for (int et = 0; et < 2; ++et)
#pragma unroll
                    for (int r = 0; r < 4; ++r) accS[dt][et][r] = Sin[(16 * dt + 4 * q + r) * 256 + 32 * w + 16 * et + c];
            PIN8(accS[0][0], accS[0][1], accS[1][0], accS[1][1], accS[2][0], accS[2][1], accS[3][0], accS[3][1]); PIN8(accS[4][0], accS[4][1], accS[5][0], accS[5][1], accS[6][0], accS[6][1], accS[7][0], accS[7][1]); }
        else {
#pragma unroll
            for (int dt = 0; dt < 8; ++dt)
#pragma unroll
                for (int et = 0; et < 2; ++et) accS[dt][et] = (f32x4){0.f, 0.f, 0.f, 0.f}; }
        float sumtot = 0.f;
#define GLA_FETCH(jn) f16x8 pf_lr, pf_v[4], pf_k[2], pf_q[2]; do { const int tf = opq(F.tid); \
            { const int row = (tf & 255) >> 2, part = tf & 3; pf_lr = *(const f16x8*)(PX + (size_t)prow(b, sc, (jn), row) * PXLD + P_GG + part * 8); } \
            _Pragma("unroll") for (int k = 0; k < 4; ++k) { const int idx = tf + 512 * k, wi = idx >> 6, ln = idx & 63, rr = ln >> 2, cc = ln & 3; const int row = (wi & 3) * 16 + rr, chunk = (wi >> 2) * 4 + cc; \
                pf_v[k] = *(const f16x8*)(PX + (size_t)prow(b, sc, (jn), row) * PXLD + P_GV + h * 256 + chunk * 8); } \
            _Pragma("unroll") for (int k = 0; k < 2; ++k) { const int idx = tf + 512 * k, row = idx >> 4, ch = idx & 15; const size_t ro = (size_t)prow(b, sc, (jn), row) * PXLD; \
                pf_k[k] = *(const f16x8*)(PX + ro + P_GK + h * 128 + ch * 8); if (FULL) pf_q[k] = *(const f16x8*)(PX + ro + P_GQ + h * 128 + ch * 8); else pf_q[k] = pf_k[k]; } } while (0)
        for (int jj = 0; jj < 4; ++jj) {
            const int j = dir ? 3 - jj : jj;
            if (FULL) {
            GLA_FETCH(j);
            __syncthreads();
            const int tid = opq(F.tid);
            PIN8(pf_lr, pf_v[0], pf_v[1], pf_v[2], pf_v[3], pf_k[0], pf_k[1], pf_q[0]); asm volatile("" : "+v"(pf_q[1]));
            if (tid < 256) { const int row = tid >> 2, part = tid & 3; *(LAS f16x8*)(LR + row * 32 + part * 8) = pf_lr; }
#pragma unroll
            for (int k = 0; k < 4; ++k) { const int idx = opq(tid) + 512 * k, wi = idx >> 6, ln = idx & 63, rr = ln >> 2, cc = ln & 3;
                const int row = (wi & 3) * 16 + rr, chunk = (wi >> 2) * 4 + cc; LAS f16* vp = VT + (chunk * 8) * VT_LD + row;
#pragma unroll
                for (int e = 0; e < 8; ++e) vp[e * VT_LD] = pf_v[k][e]; }
#pragma unroll
            for (int k = 0; k < 2; ++k) { const int idx = tid + 512 * k, row = idx >> 4, ch = idx & 15;
                *(LAS f16x8*)(KR + row * QK_LD + ch * 8) = pf_k[k];
                *(LAS f16x8*)(QR + row * QK_LD + ch * 8) = pf_q[k]; }
            } else {
            __syncthreads();
            const int tid = opq(F.tid);
            if (tid < 256) { const int row = tid >> 2, part = tid & 3; const int gr = prow(b, sc, j, row);
                *(LAS f16x8*)(LR + row * 32 + part * 8) = *(const f16x8*)(PX + (size_t)gr * PXLD + P_GG + part * 8); }
#pragma unroll 1
            for (int k = 0; k < 4; ++k) { const int idx = tid + 512 * k, wi = idx >> 6, ln = idx & 63, rr = ln >> 2, cc = ln & 3;
                const int row = (wi & 3) * 16 + rr, chunk = (wi >> 2) * 4 + cc; const int gr = prow(b, sc, j, row);
                const f16x8 v8 = *(const f16x8*)(PX + (size_t)gr * PXLD + P_GV + h * 256 + chunk * 8);
#pragma unroll
                for (int e = 0; e < 8; ++e) VT[(chunk * 8 + e) * VT_LD + row] = v8[e]; }
#pragma unroll 1
            for (int k = 0; k < 2; ++k) { const int idx = tid + 512 * k, row = idx >> 4, ch = idx & 15; const int gr = prow(b, sc, j, row);
                *(LAS f16x8*)(KR + row * QK_LD + ch * 8) = *(const f16x8*)(PX + (size_t)gr * PXLD + P_GK + h * 128 + ch * 8); }
            }
            __syncthreads();
            const int dk = opq(dk0), ig = opq(ig0);
            float bv[16];
#pragma unroll
            for (int ii = 0; ii < 16; ++ii) { const int i = ig * 16 + ii; float pre = bgv;
                const f16x8 l0 = *(const LAS f16x8*)(LR + i * 32 + dir * 16), l1 = *(const LAS f16x8*)(LR + i * 32 + dir * 16 + 8);
#pragma unroll
                for (int r = 0; r < 8; ++r) pre += (float)l0[r] * WG[r * 128 + dk] + (float)l1[r] * WG[(8 + r) * 128 + dk];
                bv[ii] = logsigmoidf_(pre) * (1.0f / 16.0f); }
            float totloc;
            if (dir == 0) {
#pragma unroll
                for (int ii = 1; ii < 16; ++ii) bv[ii] += bv[ii - 1];
                totloc = bv[15]; }
            else {
#pragma unroll
                for (int ii = 14; ii >= 0; --ii) bv[ii] += bv[ii + 1];
                totloc = bv[0]; }
            GT[ig * 128 + dk] = totloc;
            __syncthreads();
            const float g0 = GT[dk], g1 = GT[128 + dk], g2 = GT[256 + dk], g3 = GT[384 + dk];
            const float total = (g0 + g1) + (g2 + g3);
            float off, bmid;
            if (dir == 0) { off = (ig > 0 ? g0 : 0.f) + (ig > 1 ? g1 : 0.f) + (ig > 2 ? g2 : 0.f); bmid = g0 + g1; }
            else { off = (ig < 3 ? g3 : 0.f) + (ig < 2 ? g2 : 0.f) + (ig < 1 ? g1 : 0.f); bmid = g2 + g3; }
#pragma unroll
            for (int ii = 0; ii < 16; ++ii) bv[ii] += off;
            if (FULL) {
#pragma unroll
                for (int ii = 0; ii < 16; ++ii) { const int i = ig * 16 + ii;
                    QT[i * QK_LD + dk] = (f16)((float)QR[i * QK_LD + dk] * scale * __expf(fminf(bv[ii] - bmid, 9.f)));
                    KT[i * QK_LD + dk] = (f16)((float)KR[i * QK_LD + dk] * __expf(fminf(bmid - bv[ii], 9.f))); }
                __syncthreads();
                { const int c = opq(c0), q = opq(q0);
#pragma unroll
                for (int s = 0; s < 2; ++s) { const int T = 2 * w + s, it = T >> 2, jt = T & 3; f32x4 a = (f32x4){0.f, 0.f, 0.f, 0.f};
#pragma unroll
                    for (int kk = 0; kk < 4; ++kk) { const f16x8 kf = *(const LAS f16x8*)(KT + (jt * 16 + c) * QK_LD + kk * 32 + 8 * q);
                        const f16x8 qf = *(const LAS f16x8*)(QT + (it * 16 + c) * QK_LD + kk * 32 + 8 * q); a = GLA_MFMA(kf, qf, a); }
                    const int i = it * 16 + c; f16x4 pv;
#pragma unroll
                    for (int r = 0; r < 4; ++r) { const int jx = jt * 16 + 4 * q + r; const bool keep = dir == 0 ? (jx <= i) : (jx >= i); pv[r] = keep ? (f16)a[r] : (f16)0.f; }
                    *(LAS f16x4*)(PP + i * P_LD + jt * 16 + 4 * q) = pv; } }
                __syncthreads();
#pragma unroll
                for (int ii = 0; ii < 16; ++ii) { const int i = ig * 16 + ii; QT[i * QK_LD + dk] = (f16)((float)QR[i * QK_LD + dk] * scale * __expf(bv[ii])); }
            }
            { f16x8 k0, k1;
#pragma unroll
              for (int ii = 0; ii < 8; ++ii) { k0[ii] = (f16)((float)KR[(ig * 16 + ii) * QK_LD + dk] * __expf(total - bv[ii])); k1[ii] = (f16)((float)KR[(ig * 16 + 8 + ii) * QK_LD + dk] * __expf(total - bv[8 + ii])); }
              *(LAS f16x8*)(KT + dk * KH_LD + ig * 16) = k0; *(LAS f16x8*)(KT + dk * KH_LD + ig * 16 + 8) = k1; }
            if (ig == 0) { DEC[dk] = __expf(total); sumtot += total; }
            __syncthreads();
            const int c = opq(c0), q = opq(q0);
            if (FULL) {
                f32x4 accO[4][2];
#pragma unroll
                for (int it = 0; it < 4; ++it)
#pragma unroll
                    for (int et = 0; et < 2; ++et) accO[it][et] = (f32x4){0.f, 0.f, 0.f, 0.f};
#pragma unroll
                for (int et = 0; et < 2; ++et)
#pragma unroll
                    for (int kk = 0; kk < 2; ++kk) { const f16x8 vf = *(const LAS f16x8*)(VT + (32 * w + 16 * et + c) * VT_LD + kk * 32 + 8 * q);
#pragma unroll
                        for (int it = 0; it < 4; ++it) { const f16x8 pf = *(const LAS f16x8*)(PP + (it * 16 + c) * P_LD + kk * 32 + 8 * q); accO[it][et] = GLA_MFMA(vf, pf, accO[it][et]); } asm volatile("" ::: "memory"); }
#pragma unroll
                for (int kb = 0; kb < 4; ++kb)
#pragma unroll
                    for (int et = 0; et < 2; ++et) { f16x8 sf; asm volatile("" ::: "memory");
#pragma unroll
                        for (int e = 0; e < 4; ++e) { sf[e] = (f16)accS[2 * kb][et][e]; sf[4 + e] = (f16)accS[2 * kb + 1][et][e]; }
#pragma unroll
                        for (int it = 0; it < 4; ++it) { const f16x4 lo = *(const LAS f16x4*)(QT + (it * 16 + c) * QK_LD + 32 * kb + 4 * q), hi = *(const LAS f16x4*)(QT + (it * 16 + c) * QK_LD + 32 * kb + 16 + 4 * q);
                            f16x8 qf; qf[0] = lo[0]; qf[1] = lo[1]; qf[2] = lo[2]; qf[3] = lo[3]; qf[4] = hi[0]; qf[5] = hi[1]; qf[6] = hi[2]; qf[7] = hi[3];
                            accO[it][et] = GLA_MFMA(sf, qf, accO[it][et]); } }
                float* OF = (float*)(F.ws + WS_GOF);
                if (dir == 0) {
#pragma unroll
                    for (int it = 0; it < 4; ++it) { const int gr = prow(b, sc, j, it * 16 + c);
#pragma unroll
                        for (int et = 0; et < 2; ++et) *(f32x4*)(OF + (size_t)gr * 1024 + h * 256 + 32 * w + 16 * et + 4 * q) = accO[it][et];
                        asm volatile("" ::: "memory"); } }
                else {
                    int grs[4]; f32x4 ofv[4][2]; f16x4 rvv[4][2];
#pragma unroll
                    for (int it = 0; it < 4; ++it) { grs[it] = prow(b, sc, j, it * 16 + c);
#pragma unroll
                        for (int et = 0; et < 2; ++et) { ofv[it][et] = *(const f32x4*)(OF + (size_t)grs[it] * 1024 + h * 256 + 32 * w + 16 * et + 4 * q);
                            rvv[it][et] = *(const f16x4*)(PX + (size_t)grs[it] * PXLD + P_GR + h * 256 + 32 * w + 16 * et + 4 * q); } }
                    PIN8(ofv[0][0], ofv[0][1], ofv[1][0], ofv[1][1], ofv[2][0], ofv[2][1], ofv[3][0], ofv[3][1]);
#pragma unroll
                    for (int it = 0; it < 4; ++it) { float ss = 0.f;
#pragma unroll
                        for (int et = 0; et < 2; ++et) { accO[it][et] = accO[it][et] + ofv[it][et];
                            ss += (accO[it][et][0] * accO[it][et][0] + accO[it][et][1] * accO[it][et][1]) + (accO[it][et][2] * accO[it][et][2] + accO[it][et][3] * accO[it][et][3]); }
                        ss += __shfl_xor(ss, 16); ss += __shfl_xor(ss, 32);
                        if (q == 0) RS[(it * 16 + c) * 8 + w] = ss; }
                    __syncthreads();
                    PIN8(rvv[0][0], rvv[0][1], rvv[1][0], rvv[1][1], rvv[2][0], rvv[2][1], rvv[3][0], rvv[3][1]);
                    const float* ng = AV.in(I_GLANG) + (size_t)l * 256;
                    f16* Y = (f16*)(F.ws + WS_YCAT);
#pragma unroll
                    for (int it = 0; it < 4; ++it) { const int i = it * 16 + c; const f32x4 ra = *(const LAS f32x4*)(RS + i * 8), rb = *(const LAS f32x4*)(RS + i * 8 + 4);
                        const float tot = ((ra[0] + ra[1]) + (ra[2] + ra[3])) + ((rb[0] + rb[1]) + (rb[2] + rb[3]));
                        const float rstd = 1.0f / sqrtf(tot * (1.0f / 256.0f) + EPS);
#pragma unroll
                        for (int et = 0; et < 2; ++et) { const int e0 = 32 * w + 16 * et + 4 * q;
                            const f32x4 gv = *(const f32x4*)(ng + e0);
                            f16x4 o;
#pragma unroll
                            for (int r = 0; r < 4; ++r) o[r] = (f16)(accO[it][et][r] * rstd * gv[r] * siluf_((float)rvv[it][et][r]));
                            *(f16x4*)(Y + (size_t)grow(b, sc, j, it * 16 + c) * 2048 + 1024 + h * 256 + e0) = o; } }
                }
            }
#pragma unroll
            for (int dt = 0; dt < 8; ++dt) { const f32x4 dv = *(const LAS f32x4*)(DEC + 16 * dt + 4 * q);
#pragma unroll
                for (int et = 0; et < 2; ++et) accS[dt][et] = accS[dt][et] * dv; }
#pragma unroll
            for (int kk = 0; kk < 2; ++kk) { f16x8 vf[2];
#pragma unroll
                for (int et = 0; et < 2; ++et) vf[et] = *(const LAS f16x8*)(VT + (32 * w + 16 * et + c) * VT_LD + kk * 32 + 8 * q);
#pragma unroll
                for (int dt = 0; dt < 8; ++dt) { const f16x8 kf = *(const LAS f16x8*)(KT + (16 * dt + c) * KH_LD + kk * 32 + 8 * q);
#pragma unroll
                    for (int et = 0; et < 2; ++et) accS[dt][et] = GLA_MFMA(kf, vf[et], accS[dt][et]); if (dt & 1) asm volatile("" ::: "memory"); } }
        }
        if (!FULL) { float* Sl = (float*)(F.ws + WS_GSLOC) + sidx * 32768; const int q = opq(q0), c = opq(c0);
#pragma unroll
            for (int dt = 0; dt < 8; ++dt)
#pragma unroll
                for (int et = 0; et < 2; ++et)
#pragma unroll
                    for (int r = 0; r < 4; ++r) Sl[(16 * dt + 4 * q + r) * 256 + 32 * w + 16 * et + c] = accS[dt][et][r];
            if (ig0 == 0) ((float*)(F.ws + WS_GDT))[sidx * 128 + dk0] = __expf(sumtot); }
        VM_WAIT();
    }
}
__device__ __forceinline__ void ph_gla_scan(const Ctx& F) {
    const float* Sl = (const float*)(F.ws + WS_GSLOC); float* Si = (float*)(F.ws + WS_GSIN); const float* Dt = (const float*)(F.ws + WS_GDT);
    if (F.tid < 64) return;
    for (int gt = F.bid * 448 + (F.tid - 64); gt < 2 * 4 * 2 * 32768; gt += F.G * 448) {
        const int e = gt & 32767, dir = (gt >> 15) & 1, h = (gt >> 16) & 3, b = gt >> 18;
        float S = 0.f;
        for (int base = 0; base < NSC; base += 11) {
            float sl[11], dt[11]; size_t ix[11];
#pragma unroll
            for (int u = 0; u < 11; ++u) { const int step = base + u; const int sc = step == 0 ? 32 : (dir == 0 ? step - 1 : 32 - step);
                const size_t idx = ((((size_t)b * 4 + h) * NSC + sc) * 2 + dir); ix[u] = idx;
                sl[u] = Sl[idx * 32768 + e]; dt[u] = Dt[idx * 128 + (e >> 8)]; }
            PIN8(sl[0], sl[1], sl[2], sl[3], sl[4], sl[5], sl[6], sl[7]); PIN8(dt[0], dt[1], dt[2], dt[3], dt[4], dt[5], dt[6], dt[7]); PIN4(sl[8], sl[9], sl[10], dt[8]); asm volatile("" : "+v"(dt[9]), "+v"(dt[10]));
#pragma unroll
            for (int u = 0; u < 11; ++u) { Si[ix[u] * 32768 + e] = S; S = dt[u] * S + sl[u]; }
        }
    }
}
#undef GLA_FETCH
#undef GLA_MFMA
}

namespace hy {
#define PADI(i) ((i) + ((i) >> 5))
constexpr int HY_BUF_BYTES = (16384 + 512) * 8;
constexpr int HY_SCR_OFF = HY_BUF_BYTES;
static_assert(HY_SCR_OFF + 2048 <= LDSCTL_OFF, "hyena lds");
__device__ __forceinline__ f32x2 twid(int k, float invN) { const float xr = (float)k * invN; return (f32x2){__builtin_amdgcn_cosf(xr), -__builtin_amdgcn_sinf(xr)}; }
__device__ __forceinline__ f32x2 mul_w16(f32x2 d, int a) {
    constexpr float c1 = 0.9238795325112867f, s1 = 0.3826834323650898f, r = 0.7071067811865476f;
    float c, s;
    switch (a & 15) {
        case 0: return d; case 4: return (f32x2){d.y, -d.x}; case 8: return (f32x2){-d.x, -d.y}; case 12: return (f32x2){-d.y, d.x};
        case 1: c = c1; s = s1; break; case 2: c = r; s = r; break; case 3: c = s1; s = c1; break;
        case 5: c = -s1; s = c1; break; case 6: c = -r; s = r; break; case 7: c = -c1; s = s1; break;
        case 9: c = -c1; s = -s1; break; case 10: c = -r; s = -r; break; case 11: c = -s1; s = -c1; break;
        case 13: c = s1; s = -c1; break; case 14: c = r; s = -r; break; default: c = c1; s = -s1; break; }
    return (f32x2){d.x * c + d.y * s, d.y * c - d.x * s};
}
template <int R> __device__ __forceinline__ void dif_pass(LAS f32x2* x, int m, int lh, int tid) {
    const int N = 1 << m; const float invN = 1.0f / (float)N; const int lg = lh - R + 1, g = 1 << lg, S = (N >> 1) >> lh;
    for (int q = tid; q < (N >> R); q += 512) { const int j = q & (g - 1), blk = q >> lg, base = (blk << (lh + 1)) + j;
        f32x2 v[1 << R];
#pragma unroll
        for (int k = 0; k < (1 << R); ++k) v[k] = x[PADI(base + k * g)];
        f32x2 w = twid(j * S, invN);
#pragma unroll
        for (int s = 0; s < R; ++s) { const int half = 1 << (R - 1 - s);
#pragma unroll
            for (int k = 0; k < (1 << R); ++k) if (!(k & half)) { const f32x2 a = v[k], b = v[k + half]; v[k] = a + b;
                v[k + half] = mul_w16(cmul(a - b, w), ((k & (half - 1)) << s) * (16 >> R)); }
            w = cmul(w, w); }
#pragma unroll
        for (int k = 0; k < (1 << R); ++k) x[PADI(base + k * g)] = v[k]; }
    __syncthreads();
}
template <int R> __device__ __forceinline__ void dit_pass(LAS f32x2* x, int m, int lh, int tid) {
    const int N = 1 << m; const float invN = 1.0f / (float)N; const int h = 1 << lh, S1 = (N >> 1) >> lh;
    for (int q = tid; q < (N >> R); q += 512) { const int j = q & (h - 1), blk = q >> lh, base = (blk << (lh + R)) + j;
        f32x2 v[1 << R];
#pragma unroll
        for (int k = 0; k < (1 << R); ++k) v[k] = x[PADI(base + k * h)];
        f32x2 wp[R]; wp[R - 1] = cconj(twid(j * (S1 >> (R - 1)), invN));
#pragma unroll
        for (int s = R - 2; s >= 0; --s) wp[s] = cmul(wp[s + 1], wp[s + 1]);
#pragma unroll
        for (int s = 0; s < R; ++s) { const int half = 1 << s;
#pragma unroll
            for (int k = 0; k < (1 << R); ++k) if (!(k & half)) { const f32x2 a = v[k];
                const f32x2 b = mul_w16(cmul(v[k + half], wp[s]), (16 - (k & (half - 1)) * (16 >> (s + 1))) & 15);
                v[k] = a + b; v[k + half] = a - b; } }
#pragma unroll
        for (int k = 0; k < (1 << R); ++k) x[PADI(base + k * h)] = v[k]; }
    __syncthreads();
}
__device__ __forceinline__ void fft_fwd(LAS f32x2* x, int m, int tid) {
    int lh = m - 1;
    while (lh + 1 >= 4) { dif_pass<4>(x, m, lh, tid); lh -= 4; }
    if (lh + 1 == 2) dif_pass<2>(x, m, 1, tid); else if (lh + 1 == 1) dif_pass<1>(x, m, 0, tid);
}
__device__ __forceinline__ void fft_inv(LAS f32x2* x, int m, int tid) {
    int lh = 0;
    while (m - lh >= 4) { dit_pass<4>(x, m, lh, tid); lh += 4; }
    if (m - lh == 2) dit_pass<2>(x, m, lh, tid); else if (m - lh == 1) dit_pass<1>(x, m, lh, tid);
}
__device__ __forceinline__ int brev(int k, int m) { return (int)(__brev((unsigned)k) >> (32 - m)); }

__device__ __forceinline__ void filt_unit(const Ctx& F, const ArgsV& AV, int l, int unit) {
    const int kind = unit >> 9, o = (unit >> 8) & 1, pair = unit & 255;
    const int n = kind ? LC : SEQ, m = kind ? 9 : 14, N = 2 * n, tid = F.tid;
    LAS f32x2* buf = (LAS f32x2*)F.lds;
    LAS float* W3 = (LAS float*)(F.lds + HY_SCR_OFF);
    LAS float* B3 = W3 + 256;
    LAS float* RED = B3 + 4;
    LAS float* INV = RED + 16;
    __syncthreads();
    if (tid < 4) { const int ci = tid; const int col = o * 1024 + (ci >> 1) * 512 + 2 * pair + (ci & 1); B3[ci] = AV.in(I_HYB3)[(size_t)l * 2048 + col]; }
    __syncthreads();
    const int lane = F.lane, q = lane >> 4, c = lane & 15;
    f16x8 wB0, wB1;
    { const int col = o * 1024 + ((c & 3) >> 1) * 512 + 2 * pair + (c & 1); const float* w3 = AV.in(I_HYW3) + (size_t)l * 64 * 2048 + col;
#pragma unroll
      for (int j = 0; j < 8; ++j) { wB0[j] = c < 4 ? (f16)w3[(size_t)(8 * q + j) * 2048] : (f16)0.f; wB1[j] = c < 4 ? (f16)w3[(size_t)(32 + 8 * q + j) * 2048] : (f16)0.f; } }
    const f16* H2H = (const f16*)(F.ws + WS_H2H) + ((size_t)l * (SEQ + LC) + (kind ? SEQ : 0)) * 64;
    const float lo = -3.0701134573253945f, hi = -15.350567286626973f;
    const float ra = fabsf(lo + (hi - lo) * (float)(2 * pair) / 511.0f), rb = fabsf(lo + (hi - lo) * (float)(2 * pair + 1) / 511.0f);
    const float rate = (c & 1) ? rb : ra, bias3 = B3[c & 3];
    float sabs = 0.f;
    for (int tile = F.wave; tile < (n >> 4); tile += 8) { const int t0 = tile * 16;
        const f16x8 a0 = *(const f16x8*)(H2H + (size_t)(t0 + c) * 64 + 8 * q), a1 = *(const f16x8*)(H2H + (size_t)(t0 + c) * 64 + 32 + 8 * q);
        f32x4 acc = (f32x4){0.f, 0.f, 0.f, 0.f};
        acc = __builtin_amdgcn_mfma_f32_16x16x32_f16(a0, wB0, acc, 0, 0, 0); acc = __builtin_amdgcn_mfma_f32_16x16x32_f16(a1, wB1, acc, 0, 0, 0);
        if (c < 4) {
#pragma unroll
            for (int i = 0; i < 4; ++i) { const int t = t0 + 4 * q + i; const float v = (acc[i] + bias3) * expf(-((float)t / (float)(n - 1)) * rate);
                LAS float* bp = (LAS float*)buf;
                if (c < 2) { bp[2 * PADI(t) + c] = v; sabs += fabsf(v); }
                else if (t >= 1) { bp[2 * PADI(N - t) + (c - 2)] = v; sabs += fabsf(v); } } }
    }
    float sa = (c == 0 || c == 2) ? sabs : 0.f, sb = (c == 1 || c == 3) ? sabs : 0.f;
    if (tid == 0) { float z0 = 0.f; asm volatile("" : "+v"(z0)); buf[PADI(n)] = (f32x2){z0, z0}; }
    sa = wave_sum(sa); sb = wave_sum(sb);
    if (F.lane == 0) { RED[F.wave * 2] = sa; RED[F.wave * 2 + 1] = sb; }
    __syncthreads();
    if (tid < 2) { float s = 0.f;
#pragma unroll
        for (int w = 0; w < 8; ++w) s += RED[w * 2 + tid];
        INV[tid] = 1.0f / (s + EPS); }
    __syncthreads();
    { const float ia = INV[0], ib = INV[1];
      for (int i = tid; i < N; i += 512) { f32x2 v = buf[PADI(i)]; v.x *= ia; v.y *= ib; buf[PADI(i)] = v; } }
    __syncthreads();
    fft_fwd(buf, m, tid);
    f32x4* out = (f32x4*)(F.ws + ((l & 1) ? WS_FSD2 : WS_FSD) + (kind ? FSD_C_OFF : 0)) + (size_t)(o * 256 + pair) * (n + 1);
    for (int u = tid; u <= n; u += 512) { const int p = u < n ? 2 * u : 1, k = brev(p, m), pn = brev((N - k) & (N - 1), m);
        const f32x2 zk = buf[PADI(p)], zn = cconj(buf[PADI(pn)]);
        const f32x2 fa = (zk + zn) * 0.5f, df = zk - zn, fb = (f32x2){df.y * 0.5f, -df.x * 0.5f};
        const f32x2 fs = (fa + fb) * 0.5f, fd = (fa - fb) * 0.5f;
        out[u] = (f32x4){fs.x, fs.y, fd.x, fd.y}; }
    __syncthreads();
}

__device__ __forceinline__ void main_unit(const Ctx& F, const ArgsV& AV, int l, int unit) {
    const int kind = unit >> 9, b = (unit >> 8) & 1, pair = unit & 255;
    const int n = kind ? LC : SEQ, m = kind ? 9 : 14, N = 2 * n, tid = F.tid;
    const int row0 = kind ? MX + b * LC : b * SEQ;
    LAS f32x2* buf = (LAS f32x2*)F.lds;
    const f16* ZT = (const f16*)(F.ws + WS_ZT) + (size_t)(2 * pair) * MT + row0;
    const float* cw = AV.in(I_HYCW) + (size_t)l * 3 * 1536 + 2 * pair; const float* cb = AV.in(I_HYCB) + (size_t)l * 1536 + 2 * pair;
    f32x2 yv[16], g1[16], g2[16];
#pragma unroll
    for (int g = 0; g < 3; ++g)
#pragma unroll
        for (int cc = 0; cc < 2; ++cc) { const float w0 = cw[g * 512 + cc], w1 = cw[1536 + g * 512 + cc], w2 = cw[3072 + g * 512 + cc], bs = cb[g * 512 + cc];
            const f16* zt = ZT + (size_t)(g * 512 + cc) * MT;
#pragma unroll
            for (int gi = 0; gi < 2; ++gi) { const int t0 = 8 * (tid + 512 * gi);
                f16x8 mv; float pv = 0.f, nv = 0.f;
#pragma unroll
                for (int e = 0; e < 8; ++e) mv[e] = (f16)0.f;
                if (t0 < n) { mv = *(const f16x8*)(zt + t0); if (t0 > 0) pv = (float)zt[t0 - 1]; if (t0 + 8 < n) nv = (float)zt[t0 + 8]; }
#pragma unroll
                for (int e = 0; e < 8; ++e) { const float zm = e == 0 ? pv : (float)mv[e == 0 ? 0 : e - 1], zc = (float)mv[e], zp = e == 7 ? nv : (float)mv[e == 7 ? 7 : e + 1];
                    const float r = w0 * zm + w1 * zc + w2 * zp + bs;
                    if (g == 0) { if (cc == 0) yv[gi * 8 + e].x = r; else yv[gi * 8 + e].y = r; }
                    else if (g == 1) { if (cc == 0) g1[gi * 8 + e].x = r; else g1[gi * 8 + e].y = r; }
                    else { if (cc == 0) g2[gi * 8 + e].x = r; else g2[gi * 8 + e].y = r; } } } }
    const float invN = 1.0f / (float)N;
#pragma unroll
    for (int o = 0; o < 2; ++o) {
        __syncthreads();
        float z0 = 0.f; asm volatile("" : "+v"(z0));
#pragma unroll
        for (int gi = 0; gi < 2; ++gi) { const int t0 = 8 * (tid + 512 * gi);
            if (t0 < n) {
#pragma unroll
                for (int e = 0; e < 8; ++e) { buf[PADI(t0 + e)] = yv[gi * 8 + e]; buf[PADI(n + t0 + e)] = (f32x2){z0, z0}; } } }
        __syncthreads();
        fft_fwd(buf, m, tid);
        const f32x4* fsd = (const f32x4*)(F.ws + ((l & 1) ? WS_FSD2 : WS_FSD) + (kind ? FSD_C_OFF : 0)) + (size_t)(o * 256 + pair) * (n + 1);
        for (int u = tid; u <= n; u += 512) { const int p = u < n ? 2 * u : 1, k = brev(p, m), pn = brev((N - k) & (N - 1), m);
            const f32x2 zk = buf[PADI(p)], zn = buf[PADI(pn)]; const f32x4 f = fsd[u]; const f32x2 fs = (f32x2){f[0], f[1]}, fd = (f32x2){f[2], f[3]};
            const f32x2 wk = cmul(zk, fs) + cmul(cconj(zn), fd), wn = cmul(zn, cconj(fs)) + cmul(cconj(zk), cconj(fd));
            buf[PADI(pn)] = wn; buf[PADI(p)] = wk; }
        __syncthreads();
        fft_inv(buf, m, tid);
        const float* hb = AV.in(I_HYBIAS) + ((size_t)l * 2 + o) * 512 + 2 * pair; const f32x2 bias = (f32x2){hb[0], hb[1]};
#pragma unroll
        for (int gi = 0; gi < 2; ++gi) { const int t0 = 8 * (tid + 512 * gi);
            if (t0 < n) {
#pragma unroll
                for (int e = 0; e < 8; ++e) { const f32x2 cv = buf[PADI(t0 + e)] * invN; const f32x2 gt = o == 0 ? g1[gi * 8 + e] : g2[gi * 8 + e];
                    yv[gi * 8 + e] = gt * (cv + yv[gi * 8 + e] * bias); } } }
    }
    f16* Y = (f16*)(F.ws + WS_YBT) + (size_t)(2 * pair) * MT + row0;
#pragma unroll
    for (int gi = 0; gi < 2; ++gi) { const int t0 = 8 * (tid + 512 * gi);
        if (t0 < n) { f16x8 oa, ob;
#pragma unroll
            for (int e = 0; e < 8; ++e) { oa[e] = (f16)yv[gi * 8 + e].x; ob[e] = (f16)yv[gi * 8 + e].y; }
            *(f16x8*)(Y + t0) = oa; *(f16x8*)(Y + MT + t0) = ob; } }
    __syncthreads();
}

__device__ __forceinline__ void ph_ybt_transpose(const Ctx& F) {
    LAS f16* T = (LAS f16*)F.lds;
    const f16* YBT = (const f16*)(F.ws + WS_YBT); f16* Y = (f16*)(F.ws + WS_YCAT);
    const bool bal = (F.G == 256);
    for (int it = 0; it < (bal ? 2 : (MT / 64 + F.G - 1) / F.G); ++it) {
        int rb;
        if (bal) { if (F.bid >= 132) rb = (F.bid - 132) + 124 * it; else if (F.bid < 16 && it == 0) rb = 248 + F.bid; else rb = -1; }
        else rb = F.bid + it * F.G;
        if (rb < 0 || rb >= MT / 64) continue;
        const int r0 = rb * 64;
        __syncthreads();
        { f16x8 tv[8];
#pragma unroll
          for (int i = 0; i < 8; ++i) tv[i] = *(const f16x8*)(YBT + (size_t)F.tid * MT + r0 + 8 * i);
          PIN8(tv[0], tv[1], tv[2], tv[3], tv[4], tv[5], tv[6], tv[7]);
#pragma unroll
          for (int i = 0; i < 8; ++i) *(LAS f16x8*)(T + F.tid * 72 + 8 * i) = tv[i]; }
        __syncthreads();
        const int row = F.tid >> 3, cg = F.tid & 7;
#pragma unroll
        for (int jj = 0; jj < 8; ++jj) { const int gidx = cg + 8 * jj; f16x8 o;
#pragma unroll
            for (int e = 0; e < 8; ++e) o[e] = T[(8 * gidx + e) * 72 + row];
            *(f16x8*)(Y + (size_t)(r0 + row) * 2048 + 512 + 8 * gidx) = o; }
    }
    __syncthreads();
}
#undef PADI
}

#ifndef PHMASK
#define PHMASK 0xFFFF
#endif
#define PH_EN(k) (((PHMASK) >> (k)) & 1)
#ifndef STAMP_MASK
#define STAMP_MASK 0
#endif
#ifndef STAMP_K
#define STAMP_K 1
#endif
#ifndef SUBMASK
#define SUBMASK 7
#endif
#define SUB_EN(k) (((SUBMASK) >> (k)) & 1)
constexpr int NPH = 2 + 12 * DEPTH;
constexpr int CW_Q = 8192;
__device__ __forceinline__ int q_pull(unsigned* ctr, volatile LAS int* slot) {
    __syncthreads();
    if (threadIdx.x == 0) *slot = (int)__hip_atomic_fetch_add(ctr, 1u, __ATOMIC_RELAXED, __HIP_MEMORY_SCOPE_AGENT);
    __syncthreads();
    return *slot;
}

__global__ void __launch_bounds__(512, 2) mk_fwd(Args args) {
    extern __shared__ __attribute__((aligned(16))) unsigned char lds_raw[];
    Ctx F; F.lds = (LAS unsigned char*)lds_raw; F.tid = threadIdx.x; F.lane = F.tid & 63; F.wave = __builtin_amdgcn_readfirstlane(F.tid >> 6);
    F.G = gridDim.x; F.bid = blockIdx.x; F.ws = args.ws;
    ArgsV AV; AV.out = args.out;
    const Ctx F0 = F;
#define FRESH() do { F.tid = opq(F0.tid); F.lane = F.tid & 63; F.wave = __builtin_amdgcn_readfirstlane(F.tid >> 6); } while (0)
    volatile LAS unsigned* MISC = (volatile LAS unsigned*)(F.lds + LDSCTL_OFF);
    if (F.tid < 64) MISC[F.tid] = 0u;
    __syncthreads();
    unsigned* barw = (unsigned*)(F.ws + WS_CTL) + CW_BAR;
    XcdBarrier bar; bar.bar = barw; bar.x = 0; bar.st = nullptr;
    const int lo = args.ph_lo, hi = args.ph_hi;
    if (hi - lo > 1) bar = xcd_barrier_post(barw, MISC + 8);
#define IN(k) (lo <= (k) && (k) < hi)
#define SEAM(k) do { if (IN(k) && IN((k) + 1)) xcd_barrier(bar); } while (0)
#if STAMP_MASK
    volatile LAS unsigned long long* TS = (volatile LAS unsigned long long*)(F.lds + LDSCTL_OFF + 128);
#define TSTART(k) do { if ((((STAMP_MASK) >> (k)) & 1) && blockIdx.x == 0 && threadIdx.x == 0) TS[0] = __builtin_amdgcn_s_memrealtime(); } while (0)
#define TSTOP(k) do { if ((((STAMP_MASK) >> (k)) & 1) && blockIdx.x == 0 && threadIdx.x == 0) TS[1] = TS[1] + (__builtin_amdgcn_s_memrealtime() - TS[0]); } while (0)
#else
#define TSTART(k) do {} while (0)
#define TSTOP(k) do {} while (0)
#endif
    unsigned char* ws = F.ws;
    const int rank160 = (F.bid + F.G - 160 % F.G) % F.G;

    TSTART(12);
    if (PH_EN(12) && IN(0)) { FRESH(); ph_prologue(F, AV); for (int l2 = 0; l2 < DEPTH; ++l2) { FRESH(); ph_hyena_h2(F, AV, l2); } }
    SEAM(0);
    TSTOP(12);

    for (int l = 0; l < DEPTH; ++l) {
        const int pb = 1 + 12 * l;
        const float* modl = (const float*)(ws + WS_MOD) + (size_t)l * 3 * 12288;
        const bool ctx_on = l < DEPTH - 1;
        const int nMr = ctx_on ? MT / 256 : MX / 256, nrows = ctx_on ? MT : MX;
        TSTART(0);
        if (PH_EN(0) && IN(pb + 0)) {
            FRESH(); ph_convert_weights(F, AV, l);
            __syncthreads();
            FRESH(); if (F.bid < 32) s5_mats_group(F, AV, l, F.bid);
            FRESH(); ph_norm(F, AV, l, 0, MT, l > 0 ? 11 : 0);
        }
        SEAM(pb + 0);
        TSTOP(0);
        TSTART(1);
        if (PH_EN(1) && IN(pb + 1)) {
            pg8::SchedPlain S; S.init(MT / 256, WINN / 256, F.G, F.bid); S.A = (const char*)(ws + WS_HN); S.B = (const char*)(ws + WS_WIN); S.aTile = (size_t)256 * 2048 * 2; S.bTile = (size_t)256 * 2048 * 2;
            pg8::EpiPx E{(f16*)(ws + WS_PX), (f16*)(ws + WS_S5A), (f16*)(ws + WS_ZT), (f16*)(ws + WS_GTL)};
            pg8::gemm_phase(F.lds, 2048, 2048, 32, S, E);
        }
        SEAM(pb + 1);
        TSTOP(1);
        TSTART(2);
        if (PH_EN(2) && IN(pb + 2)) {
            TSTART(16);
            if (SUB_EN(0)) { pg8::SchedS5 S{(const char*)(ws + WS_S5A), (const char*)(ws + WS_S5M), (size_t)256 * 256 * 2, F.G, F.bid};
              pg8::EpiS5In E{(float*)(ws + WS_S5S)};
              pg8::gemm_phase(F.lds, 16384, 256, 4, S, E); }
            TSTOP(16);
            { unsigned* qc = (unsigned*)(ws + WS_CTL) + CW_Q + (l * 2 + 0) * 64; volatile LAS int* slot = (volatile LAS int*)(MISC + 16);
              const bool pre = (l > 0 && F.G == 256);
              const int nq = 264 + (pre ? 272 : 1024);
              for (;;) { const int u = q_pull(qc, slot); if (u >= nq) break;
                  if (u < 264) { TSTART(17); FRESH(); gla::gla_unit<false>(F, AV, l, u); TSTOP(17); } else { TSTART(18); FRESH(); hy::filt_unit(F, AV, l, pre ? 240 + (u - 264) : u - 264); TSTOP(18); } } }
        }
        SEAM(pb + 2);
        TSTOP(2);
        TSTART(3);
        if (PH_EN(3) && IN(pb + 3)) { FRESH(); ph_s5_scan(F); FRESH(); gla::ph_gla_scan(F); }
        SEAM(pb + 3);
        TSTOP(3);
        TSTART(4);
        if (PH_EN(4) && IN(pb + 4)) {
            TSTART(19);
            if (SUB_EN(0)) { pg8::SchedS5 S{(const char*)(ws + WS_S5A), (const char*)(ws + WS_S5W), (size_t)256 * 512 * 2, F.G, F.bid};
              pg8::EpiS5Out E{(const f16*)(ws + WS_S5A), (f16*)(ws + WS_YAPRE), AV.in(I_S5D) + (size_t)l * 512};
              pg8::gemm_phase(F.lds, 16384, 512, 8, S, E); }
            TSTOP(19);
            { unsigned* qc = (unsigned*)(ws + WS_CTL) + CW_Q + (l * 2 + 1) * 64; volatile LAS int* slot = (volatile LAS int*)(MISC + 16);
              for (;;) { const int u = q_pull(qc, slot); if (u >= 264 + 1024) break;
                  if (u < 264) { TSTART(20); FRESH(); gla::gla_unit<true>(F, AV, l, u); TSTOP(20); } else { TSTART(21); FRESH(); hy::main_unit(F, AV, l, u - 264); TSTOP(21); } } }
        }
        SEAM(pb + 4);
        TSTOP(4);
        TSTART(5);
        if (PH_EN(5) && IN(pb + 5)) {
            pg8::SchedPlain S; S.init(nMr, 2, F.G, F.bid); S.A = (const char*)(ws + WS_YAPRE); S.B = (const char*)(ws + WS_WGLU); S.aTile = (size_t)256 * 512 * 2; S.bTile = (size_t)256 * 512 * 2;
            pg8::EpiGlu E{(const f16*)(ws + WS_YAPRE), (f16*)(ws + WS_YCAT), AV.in(I_GLUB) + (size_t)l * 512};
            pg8::gemm_phase(F.lds, 512, 512, 8, S, E);
            FRESH(); hy::ph_ybt_transpose(F);
        }
        SEAM(pb + 5);
        TSTOP(5);
        TSTART(6);
        if (PH_EN(6) && IN(pb + 6)) {
            pg8::SchedPlain S; S.init(nMr, 8, F.G, F.bid); S.aTile = (size_t)256 * 2048 * 2; S.bTile = (size_t)256 * 2048 * 2;
            S.A = (const char*)(ws + WS_YCAT); S.B = (const char*)(ws + WS_WBR);
            pg8::EpiBranchF E{(const f16*)(ws + WS_GTL), (f16*)(ws + WS_MBUF)};
            pg8::gemm_phase(F.lds, 2048, 2048, 32, S, E);
            if (l + 1 < DEPTH && F.G == 256) { unsigned* qc = (unsigned*)(ws + WS_CTL) + CW_Q + 1024 + l * 64; volatile LAS int* slot = (volatile LAS int*)(MISC + 16);
              for (;;) { if (F.bid < 16) break; const int u = q_pull(qc, slot); if (u >= 240) break; FRESH(); hy::filt_unit(F, AV, l + 1, u); } }
#ifdef PG_DUMMY
            { pg8::EpiF16 E9{(f16*)(ws + WS_ACT), 2048}; pg8::gemm_phase(F.lds, 2048, 2048, 32, S, E9); }
#endif
        }
        SEAM(pb + 6);
        TSTOP(6);
        TSTART(7);
        if (PH_EN(7) && IN(pb + 7)) {
            pg8::SchedPlain S; S.init(MX / 256, 8, F.G, F.bid); S.A = (const char*)(ws + WS_MBUF); S.B = (const char*)(ws + WS_WOUT); S.aTile = (size_t)256 * 2048 * 2; S.bTile = (size_t)256 * 2048 * 2;
            pg8::EpiResid E{(float*)(ws + WS_XRES), modl, 4096, l == 0 ? AV.in(I_X) : (const float*)(ws + WS_XRES)};
            pg8::gemm_phase(F.lds, 2048, 2048, 32, S, E);
            if (ctx_on) { pg8::SchedSplit S2{(const char*)(ws + WS_MBUF), (const char*)(ws + WS_WOUT), (size_t)256 * 2048 * 2, (size_t)256 * 2048 * 2, (size_t)8 * 128, 4, F.G, F.bid};
                pg8::EpiSlab E2{(float*)(ws + WS_SLAB), modl, 4096};
                pg8::gemm_phase(F.lds, 2048, 2048, 8, S2, E2); }
            if (l + 1 < DEPTH && F.G == 256) { unsigned* qc = (unsigned*)(ws + WS_CTL) + CW_Q + 1024 + l * 64 + 32; volatile LAS int* slot = (volatile LAS int*)(MISC + 16);
              for (;;) { const int u = q_pull(qc, slot); if (u >= 512) break; FRESH(); hy::filt_unit(F, AV, l + 1, 512 + u); } }
        }
        SEAM(pb + 7);
        TSTOP(7);
        TSTART(8);
        if (PH_EN(8) && IN(pb + 8)) { FRESH(); ph_norm(F, AV, l, 1, nrows, 4); }
        SEAM(pb + 8);
        TSTOP(8);
        TSTART(9);
        if (PH_EN(9) && IN(pb + 9)) {
            pg8::SchedPlain S; S.init(nMr, UPLD / 256, F.G, F.bid); S.A = (const char*)(ws + WS_HN); S.B = (const char*)(ws + WS_WUP); S.aTile = (size_t)256 * 2048 * 2; S.bTile = (size_t)256 * 2048 * 2;
            pg8::EpiUpAct E{(f16*)(ws + WS_ACT), (float*)(ws + WS_HALO), AV.in(I_FFCW) + (size_t)l * 3 * FFH, AV.in(I_FFCB) + (size_t)l * FFH, (LAS float*)(F.lds + EXTRA_OFF)};
            pg8::gemm_phase(F.lds, 2048, 2048, 32, S, E);
        }
        SEAM(pb + 9);
        TSTOP(9);
        TSTART(10);
        if (PH_EN(10) && IN(pb + 10)) { FRESH(); ph_ffn_fix(F, AV, l, nMr); }
        SEAM(pb + 10);
        TSTOP(10);
        TSTART(11);
        if (PH_EN(11) && IN(pb + 11)) {
            pg8::SchedPlain S; S.init(MX / 256, 8, F.G, F.bid); S.A = (const char*)(ws + WS_ACT); S.B = (const char*)(ws + WS_WDN); S.aTile = (size_t)256 * FFH * 2; S.bTile = (size_t)256 * FFH * 2;
            pg8::EpiResid E{(float*)(ws + WS_XRES), modl, 10240, (const float*)(ws + WS_XRES)};
            pg8::gemm_phase(F.lds, FFH, FFH, FFH / 64, S, E);
            if (ctx_on) { pg8::SchedSplit S2{(const char*)(ws + WS_ACT), (const char*)(ws + WS_WDN), (size_t)256 * FFH * 2, (size_t)256 * FFH * 2, (size_t)8 * 128, 11, F.G, F.bid};
                pg8::EpiSlab E2{(float*)(ws + WS_SLAB), modl, 10240};
                pg8::gemm_phase(F.lds, FFH, FFH, 8, S2, E2); }
        }
        SEAM(pb + 11);
        TSTOP(11);
    }
    if (PH_EN(13) && IN(NPH - 1)) { FRESH(); ph_final_norm(F, AV); }
#if STAMP_MASK
    if (blockIdx.x == 0 && threadIdx.x == 0) { const unsigned long long t0 = __builtin_amdgcn_s_memrealtime(); while (__builtin_amdgcn_s_memrealtime() - t0 < (unsigned long long)(STAMP_K) * TS[1]) __builtin_amdgcn_s_sleep(8); }
#endif
#undef IN
#undef SEAM
#undef FRESH
}

extern "C" void kernel_launch(void* const* d_in, const int* in_sizes, int n_in, void* d_out, int out_size, void* d_ws, size_t ws_size, hipStream_t stream) {
    static int grid = 0;
    if (grid == 0) {
        if (n_in != 40 || out_size != MX * D || ws_size < WS_END) { fprintf(stderr, "kernel_launch: unexpected problem (n_in %d out %d ws %zu, need %zu)\n", n_in, out_size, ws_size, (size_t)WS_END); grid = -1; return; }
        int dev = 0, cus = 0, per_cu = 0;
        if (hipGetDevice(&dev) != hipSuccess || hipDeviceGetAttribute(&cus, hipDeviceAttributeMultiprocessorCount, dev) != hipSuccess) { grid = -1; return; }
        if (hipFuncSetAttribute((const void*)mk_fwd, hipFuncAttributeMaxDynamicSharedMemorySize, LDS_BYTES) != hipSuccess) { fprintf(stderr, "kernel_launch: hipFuncSetAttribute failed\n"); grid = -1; return; }
        if (hipOccupancyMaxActiveBlocksPerMultiprocessor(&per_cu, (const void*)mk_fwd, 512, LDS_BYTES) != hipSuccess || per_cu < 1)
            fprintf(stderr, "kernel_launch: occupancy query reports %d\n", per_cu);
        (void)hipGetLastError();
        grid = cus;
    }
    if (grid < 0) return;
    if (hipMemsetAsync((char*)d_ws + WS_CTL, 0, CTL_ZERO_BYTES, stream) != hipSuccess) return;
    Args a{};
    for (int i = 0; i < 40; ++i) a.in[i] = (const float*)d_in[i];
    a.out = (float*)d_out; a.ws = (unsigned char*)d_ws;
#if MK_ONE
    a.ph_lo = 0; a.ph_hi = NPH;
    hipLaunchKernelGGL(mk_fwd, dim3(grid), dim3(512), LDS_BYTES, stream, a);
#else
    for (int p = 0; p < NPH; ++p) { a.ph_lo = p; a.ph_hi = p + 1; hipLaunchKernelGGL(mk_fwd, dim3(grid), dim3(512), LDS_BYTES, stream, a); }
#endif
}
```

```cpp
#include <hip/hip_runtime.h>
#include <stdio.h>

#ifndef MK_ONE
#define MK_ONE 1
#define STAMP_MASK 0
#define STAMP_K 1
#define STAMP_BID 0
#endif

#define GAS __attribute__((address_space(1)))
#define LAS __attribute__((address_space(3)))
typedef _Float16 f16;
typedef _Float16 f16x8 __attribute__((ext_vector_type(8)));
typedef _Float16 f16x4 __attribute__((ext_vector_type(4)));
typedef _Float16 f16x2 __attribute__((ext_vector_type(2)));
typedef float f32x4 __attribute__((ext_vector_type(4)));
typedef float f32x2 __attribute__((ext_vector_type(2)));

constexpr int D = 2048, NB = 2, SEQ = 8192, LC = 256, DEPTH = 4;
constexpr int MX = NB * SEQ, MC = NB * LC, MT = MX + MC;
constexpr int PXLD = 3840, WINN = 11520, FFH = 5632, UPLD = 2 * FFH;
constexpr int P_S5 = 0, P_GK = 512, P_GV = 1024, P_GQ = 2048, P_GR = 2560, P_HY = 3584, P_MG = 5120, P_GG = 3584, W_GG = 11264;
constexpr int INW = 11296;
constexpr int NCHK = 1056;
constexpr float S5SCALE = 1024.f;
constexpr float EPS = 1e-6f;
constexpr int NSC = 33;

constexpr size_t MiB = 1u << 20;
constexpr size_t WS_CTL = 0, CTL_ZERO_BYTES = 1 * MiB;
constexpr size_t WS_MOD = 1 * MiB;
constexpr size_t WS_TW = 2 * MiB;
constexpr size_t WS_S5AT = 3 * MiB;
constexpr size_t WS_WIN = 4 * MiB;
constexpr size_t WS_WGLU = WS_WIN + 45 * MiB;
constexpr size_t WS_WBR = WS_WGLU + 1 * MiB;
constexpr size_t WS_WOUT = WS_WBR + 8 * MiB;
constexpr size_t WS_WUP = WS_WOUT + 8 * MiB;
constexpr size_t WS_WDN = WS_WUP + 44 * MiB;
constexpr size_t WS_S5W = WS_WDN + 22 * MiB;
constexpr size_t WS_S5M = WS_S5W + 8 * MiB;
constexpr size_t WS_H2 = WS_S5M + 4 * MiB;
constexpr size_t WS_FSD = WS_H2 + 3 * MiB;
constexpr size_t FSD_C_OFF = (size_t)2 * 256 * 8193 * 16;
constexpr size_t WS_XRES = WS_FSD + 68 * MiB;
constexpr size_t WS_HN = WS_XRES + 132 * MiB;
constexpr size_t WS_PX = WS_HN + 66 * MiB;
constexpr size_t WS_S5A = WS_PX + 372 * MiB;
constexpr size_t WS_S5S = WS_S5A + 40 * MiB;
constexpr size_t WS_YAPRE = WS_S5S + 40 * MiB;
constexpr size_t WS_YCAT = WS_YAPRE + 20 * MiB;
constexpr size_t WS_MBUF = WS_YCAT + 66 * MiB;
constexpr size_t WS_GSLOC = WS_MBUF + 66 * MiB;
constexpr size_t WS_GSIN = WS_GSLOC + 66 * MiB;
constexpr size_t WS_GOF = WS_GSIN + 66 * MiB;
constexpr size_t WS_GDT = WS_GOF + 66 * MiB;
constexpr size_t WS_ACT = WS_GSLOC;
constexpr size_t WS_ZT = WS_GDT + 1 * MiB;
constexpr size_t WS_YBT = WS_ZT + 50 * MiB;
constexpr size_t WS_SLAB = WS_YBT + 17 * MiB;
constexpr size_t WS_HALO = WS_SLAB + 44 * MiB;
constexpr size_t WS_GTL = WS_HALO + 9 * MiB;
constexpr size_t WS_END = WS_GTL + 198 * MiB;
constexpr size_t WS_FSD2 = WS_PX + 124 * MiB;
constexpr size_t WS_W2 = WS_FSD2 + 68 * MiB;
constexpr size_t WS_H2H = WS_W2 + 128 * MiB;
static_assert(WS_H2H + 5 * MiB <= WS_PX + 372 * MiB, "PX tail");
static_assert((size_t)MT * FFH * 2 <= 198 * MiB, "ACT overlay");
constexpr int CW_BAR = 4096;

constexpr int RING_BYTES = 131072;
constexpr int EXTRA_OFF = RING_BYTES, EXTRA_BYTES = 8192;
constexpr int LDSCTL_OFF = EXTRA_OFF + EXTRA_BYTES;
constexpr int LDS_BYTES = LDSCTL_OFF + 256;

__device__ __forceinline__ float wave_sum(float v) {
#pragma unroll
    for (int o = 1; o < 64; o <<= 1) v += __shfl_xor(v, o);
    return v;
}
__device__ __forceinline__ float sigmoidf_(float x) { return 1.0f / (1.0f + __expf(-x)); }
__device__ __forceinline__ float siluf_(float x) { return x * sigmoidf_(x); }
__device__ __forceinline__ float gelu_tanh_(float x) { const float u = 0.7978845608028654f * (x + 0.044715f * x * x * x); return x / (1.0f + __expf(-2.0f * u)); }
__device__ __forceinline__ float logsigmoidf_(float x) { return fminf(x, 0.f) - __logf(1.0f + __expf(-fabsf(x))); }
__device__ __forceinline__ f32x2 cmul(f32x2 a, f32x2 b) { return (f32x2){a.x * b.x - a.y * b.y, a.x * b.y + a.y * b.x}; }
__device__ __forceinline__ f32x2 cconj(f32x2 a) { return (f32x2){a.x, -a.y}; }
__device__ __forceinline__ int opq(int x) { asm volatile("" : "+v"(x)); return x; }
#define PIN8(a, b, c, d, e, f, g, h) asm volatile("" : "+v"(a), "+v"(b), "+v"(c), "+v"(d), "+v"(e), "+v"(f), "+v"(g), "+v"(h))
#define PIN4(a, b, c, d) asm volatile("" : "+v"(a), "+v"(b), "+v"(c), "+v"(d))
#define LDS_WAIT() asm volatile("s_waitcnt lgkmcnt(0)" ::: "memory")
#define VM_WAIT() asm volatile("s_waitcnt vmcnt(0)" ::: "memory")

#define XB_TMO      128
#define XB_XCNT(j)  (256  + 64 * (j))
#define XB_XSUB(j)  (1280 + 64 * (j))
#define XB_XGEN(j)  (2304 + 64 * (j))
#define XB_TOP      3328
#define XB_TOPGEN   3392
#define XCD_BAR_WORDS 3456
#define XB_SPIN_CAP (1u << 18)
__device__ __forceinline__ unsigned xb_ld(unsigned* p)              { return __hip_atomic_load(p, __ATOMIC_RELAXED, __HIP_MEMORY_SCOPE_AGENT); }
__device__ __forceinline__ unsigned xb_add(unsigned* p, unsigned v) { return __hip_atomic_fetch_add(p, v, __ATOMIC_RELAXED, __HIP_MEMORY_SCOPE_AGENT); }
__device__ __forceinline__ unsigned xb_xcc_id() { return (unsigned)__builtin_amdgcn_s_getreg((3 << 11) | 20) & 0xFu; }
#define XB_SPIN(cond, bar) do { unsigned _sp = 0; while (cond) { __builtin_amdgcn_s_sleep(1); \
    if ((++_sp & 255u) == 0u) { if (xb_ld(&(bar)[XB_TMO])) break; if (_sp > XB_SPIN_CAP) { atomicAdd(&(bar)[XB_TMO], 1u); break; } } } } while (0)
struct XcdBarrier { unsigned* bar; unsigned x; volatile LAS unsigned* st; };
__device__ __forceinline__ XcdBarrier xcd_barrier_post(unsigned* bar, volatile LAS unsigned* st) {
    XcdBarrier b; b.bar = bar; b.x = xb_xcc_id(); b.st = st;
    if (threadIdx.x == 0) (void)xb_add(&bar[XB_XCNT(b.x)], 1u);
    return b;
}
__device__ __forceinline__ void xcd_barrier_complete(unsigned* bar, unsigned x, unsigned& nloc, unsigned& nx) {
    const unsigned G = gridDim.x * gridDim.y * gridDim.z;
    unsigned sum, cnt, mine, sp = 0u;
    for (;;) {
        sum = 0u; cnt = 0u; mine = 0u;
#pragma unroll
        for (unsigned j = 0; j < 16; ++j) { const unsigned c = xb_ld(&bar[XB_XCNT(j)]); sum += c; cnt += (c > 0u) ? 1u : 0u; mine = (j == x) ? c : mine; }
        if (sum == G) break;
        __builtin_amdgcn_s_sleep(1);
        if ((++sp & 255u) == 0u) { if (xb_ld(&bar[XB_TMO])) break; if (sp > XB_SPIN_CAP) { atomicAdd(&bar[XB_TMO], 1u); break; } }
    }
    nloc = mine > 0u ? mine : 1u; nx = cnt > 0u ? cnt : 1u;
}
__device__ __forceinline__ void xcd_barrier(const XcdBarrier& b) {
    asm volatile("s_waitcnt vmcnt(0)" ::: "memory");
    __syncthreads();
    if (threadIdx.x == 0) {
        unsigned* bar = b.bar;
        __builtin_amdgcn_s_waitcnt(0);
        unsigned nloc = b.st[0], nx = b.st[1];
        if (nloc == 0u) { xcd_barrier_complete(bar, b.x, nloc, nx); b.st[0] = nloc; b.st[1] = nx; }
        const unsigned old = xb_add(&bar[XB_XSUB(b.x)], 1u);
        const unsigned gen = old / nloc;
        if (old + 1u == (gen + 1u) * nloc) {
            __builtin_amdgcn_fence(__ATOMIC_RELEASE, "agent");
            asm volatile("s_waitcnt vmcnt(0)" ::: "memory");
            const unsigned og = xb_add(&bar[XB_TOP], 1u);
            const unsigned tg = og / nx;
            if (og + 1u == (tg + 1u) * nx) xb_add(&bar[XB_TOPGEN], 1u);
            else XB_SPIN(xb_ld(&bar[XB_TOPGEN]) == tg, bar);
            __builtin_amdgcn_fence(__ATOMIC_ACQUIRE, "agent");
            xb_add(&bar[XB_XGEN(b.x)], 1u);
            asm volatile("s_waitcnt vmcnt(0)" ::: "memory");
        } else {
            XB_SPIN(xb_ld(&bar[XB_XGEN(b.x)]) == gen, bar);
            __builtin_amdgcn_fence(__ATOMIC_ACQUIRE, "agent");
            asm volatile("s_waitcnt vmcnt(0)" ::: "memory");
        }
    }
    __syncthreads();
}

struct Args {
    const float* in[40];
    float* out; unsigned char* ws;
    int ph_lo, ph_hi;
};
struct ArgsV {
    __device__ __forceinline__ const float* in(int i) const {
        typedef const __attribute__((address_space(4))) unsigned long long* kp_t;
        kp_t ka = (kp_t)__builtin_amdgcn_kernarg_segment_ptr();
        return (const float*)(*(volatile const __attribute__((address_space(4))) unsigned long long*)(ka + i)); }
    float* out;
};
struct Ctx {
    LAS unsigned char* lds;
    int tid, lane, wave, G, bid;
    unsigned char* ws;
};
enum { I_X = 0, I_C, I_CTX, I_CCTX, I_WMOD, I_BMOD, I_N1G, I_N2G, I_WIN, I_S5ARE, I_S5AIM, I_S5STEP, I_S5BRE, I_S5BIM, I_S5CRE, I_S5CIM,
       I_S5D, I_GLUW, I_GLUB, I_HYCW, I_HYCB, I_HYW1, I_HYB1, I_HYF1, I_HYW2, I_HYB2, I_HYF2, I_HYW3, I_HYB3, I_HYBIAS,
       I_GLAWG, I_GLABG, I_GLANG, I_WBR, I_WOUT, I_WUP, I_FFCW, I_FFCB, I_WDN, I_FNG };

namespace pg8 {
constexpr int BM = 256, BK = 64, HALF = 128, HTB = HALF * BK * 2, STAGE_BYTES = 8 * HTB, NXCD = 8, WGM = 4;
__device__ __forceinline__ int lds_byte(int r, int c) { const int st = (r >> 4) * 2 + (c >> 5), rr = r & 15, cc = c & 31, ob = rr * 64 + cc * 2; return st * 1024 + (ob ^ (((ob >> 9) & 1) << 5)); }
__device__ __forceinline__ void stage_rc(int b, int& R, int& C) { const int st = b / 1024, sb = b % 1024, swz = sb ^ (((sb >> 9) & 1) << 5); R = (st >> 1) * 16 + swz / 64; C = (st & 1) * 32 + (swz % 64) / 2; }
__device__ __forceinline__ int perm32(int rho) { const int n = rho >> 4, i = rho & 15; return 8 * (i >> 2) + 4 * n + (i & 3); }
struct Unit { const char* a; const char* b; int pm, pn; };
struct Order2D {
    int nM, nN, nwg, G, c;
    __device__ __forceinline__ void init(int nM_, int nN_, int G_, int c_) { nM = nM_; nN = nN_; nwg = nM * nN; G = G_; c = c_; }
    __device__ __forceinline__ bool nx(int i, int& pm, int& pn) const {
        const long L = (long)i * G + c; if (L >= nwg) return false;
        int wgid = (int)L; { const int q = nwg / NXCD, r = nwg % NXCD, xcd = wgid % NXCD, off = wgid / NXCD; wgid = (xcd < r ? xcd * (q + 1) : r * (q + 1) + (xcd - r) * q) + off; }
        const int nig = WGM * nN, gid = wgid / nig, fm = gid * WGM, gsz = (nM - fm) < WGM ? (nM - fm) : WGM;
        pm = fm + ((wgid % nig) % gsz); pn = (wgid % nig) / gsz; return true;
    }
};
struct SchedPlain : Order2D {
    const char* A; const char* B; size_t aTile, bTile;
    __device__ __forceinline__ bool next(int i, Unit& u) const { int pm, pn; if (!nx(i, pm, pn)) return false; u.pm = pm; u.pn = pn; u.a = A + (size_t)pm * aTile; u.b = B + (size_t)pn * bTile; return true; }
};
struct SchedSplit {
    const char* A; const char* B; size_t aTile, bTile, ksub; int nsplit, G, c;
    __device__ __forceinline__ bool next(int i, Unit& u) const { const int L = i * G + c; if (L >= 16 * nsplit) return false; const int t = L / nsplit, ks = L % nsplit, pm = 64 + (t >> 3), pn = t & 7;
        u.pm = pm; u.pn = pn | (ks << 8); u.a = A + (size_t)pm * aTile + (size_t)ks * ksub; u.b = B + (size_t)pn * bTile + (size_t)ks * ksub; return true; }
};
struct SchedS5 {
    const char* A; const char* B; size_t bGroup; int G, c;
    __device__ __forceinline__ bool next(int i, Unit& u) const { const int L = i * G + c; if (L >= 160) return false; const int g = L & 31, pm = L >> 5;
        u.pm = pm; u.pn = g; u.a = A + ((size_t)pm * 256 * 16384 + (size_t)g * 512) * 2; u.b = B + (size_t)g * bGroup; return true; }
};

#define PG8_SA(b, h) (((b) * 2 + (h)) * HTB)
#define PG8_SB(b, h) ((4 + (b) * 2 + (h)) * HTB)
#define PG8_STAGE(bufoff, gbase, voff) do { _Pragma("unroll") for (int _i = 0; _i < 2; ++_i) \
        __builtin_amdgcn_global_load_lds((const unsigned*)((const char*)(gbase) + (voff)[_i]), (LAS unsigned*)(lds + (bufoff) + ldsw + _i * 8192), 16, 0, 0); } while (0)
#define PG8_LDA(dst, b, h) do { _Pragma("unroll") for (int m = 0; m < 4; ++m) _Pragma("unroll") for (int k = 0; k < 2; ++k) dst[m][k] = *(const LAS f16x8*)(lds + PG8_SA(b, h) + aoff + m * 2048 + k * 1024); } while (0)
#define PG8_LDB(dst, b, h) do { _Pragma("unroll") for (int n = 0; n < 2; ++n) _Pragma("unroll") for (int k = 0; k < 2; ++k) dst[n][k] = *(const LAS f16x8*)(lds + PG8_SB(b, h) + boff + n * 2048 + k * 1024); } while (0)
#define PG8_MMA(ai, bj, At, Bt) do { __builtin_amdgcn_s_setprio(1); _Pragma("unroll") for (int m = 0; m < 4; ++m) _Pragma("unroll") for (int n = 0; n < 2; ++n) _Pragma("unroll") for (int k = 0; k < 2; ++k) \
        acc[ai][bj][m][n] = __builtin_amdgcn_mfma_f32_16x16x32_f16(Bt[n][k], At[m][k], acc[ai][bj][m][n], 0, 0, 0); __builtin_amdgcn_s_setprio(0); } while (0)
#define PG8_WAIT_V(n) asm volatile("s_waitcnt vmcnt(" #n ")" ::: "memory")
#define PG8_WAIT_L(n) asm volatile("s_waitcnt lgkmcnt(" #n ")" ::: "memory")
#define PG8_BAR __builtin_amdgcn_s_barrier()
#define PG8_SCHED __builtin_amdgcn_sched_barrier(0)

template <class Epi, class Sched>
__device__ __forceinline__ void gemm_phase(LAS unsigned char* lds, const int lda, const int ldb, const int nt, const Sched& S, const Epi& E) {
    const int tid = opq((int)threadIdx.x), wid = __builtin_amdgcn_readfirstlane(tid >> 6), lane = tid & 63, wr = wid >> 2, wc = wid & 3, fr = lane & 15, fq = lane >> 4;
    unsigned voffA[2], voffB[2];
#pragma unroll
    for (int i = 0; i < 2; ++i) { int R, C; stage_rc(tid * 16 + i * 8192, R, C); const int Rb = Epi::PERM ? ((R & ~31) + perm32(R & 31)) : R;
        voffA[i] = (unsigned)(R * lda + C) * 2u; voffB[i] = (unsigned)(Rb * ldb + C) * 2u; }
    const size_t kstep = (size_t)(BK * 2);
    const size_t hstepA = (size_t)HALF * lda * 2, hstepB = (size_t)HALF * ldb * 2;
    const unsigned ldsw = (unsigned)wid * 1024u;
    const int aoff = lds_byte(wr * 64 + fr, fq * 8), boff = lds_byte(wc * 32 + fr, fq * 8);
    Unit cur, nxt; int ui = 0;
    if (!S.next(0, cur)) return;
    f32x4 acc[2][2][4][2];
#pragma unroll
    for (int a = 0; a < 2; ++a)
#pragma unroll
        for (int b = 0; b < 2; ++b)
#pragma unroll
            for (int m = 0; m < 4; ++m)
#pragma unroll
                for (int n = 0; n < 2; ++n) acc[a][b][m][n] = (f32x4){0.f, 0.f, 0.f, 0.f};
    f16x8 At[4][2], B0[2][2], B1[2][2];
    const char* cA = cur.a; const char* cB = cur.b;
    PG8_STAGE(PG8_SB(0, 0), cB, voffB); PG8_STAGE(PG8_SA(0, 0), cA, voffA); PG8_STAGE(PG8_SB(0, 1), cB + hstepB, voffB); PG8_STAGE(PG8_SA(0, 1), cA + hstepA, voffA);
    if (wr == 1) PG8_BAR;
    PG8_WAIT_V(4); PG8_BAR;
    PG8_STAGE(PG8_SB(1, 0), cB + kstep, voffB); PG8_STAGE(PG8_SA(1, 0), cA + kstep, voffA); PG8_STAGE(PG8_SB(1, 1), cB + hstepB + kstep, voffB);
    PG8_WAIT_V(6); PG8_BAR;
    for (;;) {
        const bool has_next = S.next(ui + 1, nxt);
        const char* nA = has_next ? nxt.a : cA; const char* nB = has_next ? nxt.b : cB;
        constexpr int NSEG = Epi::HAS_MID ? 3 : 1;
#pragma unroll
        for (int seg = 0; seg < NSEG; ++seg) {
        const int tb = Epi::HAS_MID ? (seg == 0 ? 0 : (seg == 1 ? Epi::MID1 + 2 : Epi::MID2 + 2)) : 0;
        const int te = Epi::HAS_MID ? (seg == 0 ? Epi::MID1 + 2 : (seg == 1 ? Epi::MID2 + 2 : nt)) : nt;
        for (int t = tb; t < te; t += 2) {
            const bool last = (t == nt - 2);
            const char* a1 = cA + (size_t)(t + 1) * kstep;
            const char* a2 = last ? nA : cA + (size_t)(t + 2) * kstep; const char* b2 = last ? nB : cB + (size_t)(t + 2) * kstep;
            const char* a3 = a2 + kstep; const char* b3 = b2 + kstep;
            PG8_LDB(B0, 0, 0); PG8_SCHED; PG8_LDA(At, 0, 0); PG8_STAGE(PG8_SA(1, 1), a1 + hstepA, voffA);
            PG8_WAIT_L(8); PG8_BAR; PG8_WAIT_L(0); PG8_MMA(0, 0, At, B0); PG8_BAR; PG8_SCHED;
            PG8_LDB(B1, 0, 1); PG8_STAGE(PG8_SB(0, 0), b2, voffB);
            PG8_BAR; PG8_WAIT_L(0); PG8_MMA(0, 1, At, B1); PG8_BAR;
            PG8_LDA(At, 0, 1); PG8_STAGE(PG8_SA(0, 0), a2, voffA);
            PG8_BAR; PG8_WAIT_L(0); PG8_MMA(1, 0, At, B0); PG8_BAR; PG8_SCHED;
            PG8_STAGE(PG8_SB(0, 1), b2 + hstepB, voffB);
            PG8_WAIT_V(6); PG8_BAR; PG8_MMA(1, 1, At, B1); PG8_BAR;
            PG8_LDB(B0, 1, 0); PG8_SCHED; PG8_LDA(At, 1, 0); PG8_STAGE(PG8_SA(0, 1), a2 + hstepA, voffA);
            PG8_WAIT_L(8); PG8_BAR; PG8_WAIT_L(0); PG8_MMA(0, 0, At, B0); PG8_BAR; PG8_SCHED;
            PG8_LDB(B1, 1, 1); PG8_STAGE(PG8_SB(1, 0), b3, voffB);
            PG8_BAR; PG8_WAIT_L(0); PG8_MMA(0, 1, At, B1); PG8_BAR;
            PG8_LDA(At, 1, 1); PG8_STAGE(PG8_SA(1, 0), a3, voffA);
            PG8_BAR; PG8_WAIT_L(0); PG8_MMA(1, 0, At, B0); PG8_BAR; PG8_SCHED;
            PG8_STAGE(PG8_SB(1, 1), b3 + hstepB, voffB);
            PG8_WAIT_V(6); PG8_BAR; PG8_MMA(1, 1, At, B1); PG8_BAR;
        }
        if constexpr (Epi::HAS_MID) { if (seg < 2) {
            E.mid(acc, cur, seg, wr, wc, fr, fq);
        } }
        }
#if STAMP_MASK & (1 << 23)
        if (Epi::HAS_MID && blockIdx.x == 0 && threadIdx.x == 0) ((volatile LAS unsigned long long*)(lds + LDSCTL_OFF + 128))[0] = __builtin_amdgcn_s_memrealtime();
#endif
        E(acc, cur, wr, wc, fr, fq);
#if STAMP_MASK & (1 << 23)
        if (Epi::HAS_MID && blockIdx.x == 0 && threadIdx.x == 0) { volatile LAS unsigned long long* TS = (volatile LAS unsigned long long*)(lds + LDSCTL_OFF + 128); TS[1] = TS[1] + (__builtin_amdgcn_s_memrealtime() - TS[0]); }
#endif
        if (!has_next) break;
#pragma unroll
        for (int a = 0; a < 2; ++a)
#pragma unroll
            for (int b = 0; b < 2; ++b)
#pragma unroll
                for (int m = 0; m < 4; ++m)
#pragma unroll
                    for (int n = 0; n < 2; ++n) acc[a][b][m][n] = (f32x4){0.f, 0.f, 0.f, 0.f};
        cur = nxt; cA = nA; cB = nB; ++ui;
    }
    PG8_WAIT_V(0);
    if (wr == 0) PG8_BAR;
    PG8_BAR;
}
#undef PG8_SA
#undef PG8_SB
#undef PG8_STAGE
#undef PG8_LDA
#undef PG8_LDB
#undef PG8_MMA
#undef PG8_WAIT_V
#undef PG8_WAIT_L
#undef PG8_BAR
#undef PG8_SCHED

typedef const f32x4 (&AccRef)[2][2][4][2];
__device__ __forceinline__ f16x8 pack8(f32x4 a, f32x4 b) { f16x8 w; w[0] = (f16)a[0]; w[1] = (f16)a[1]; w[2] = (f16)a[2]; w[3] = (f16)a[3]; w[4] = (f16)b[0]; w[5] = (f16)b[1]; w[6] = (f16)b[2]; w[7] = (f16)b[3]; return w; }

struct EpiPx {
    static constexpr bool PERM = true, HAS_MID = false; static constexpr int MID1 = 0, MID2 = 0; f16* PX; f16* S5A; f16* ZT; f16* GTL;
    __device__ __forceinline__ void operator()(AccRef acc, const Unit& u, int wr, int wc, int fr, int fq) const { fr = opq(fr); fq = opq(fq);
        const int row0 = u.pm * BM + wr * 64 + fr, col0 = u.pn * BM + wc * 32 + 8 * fq;
#pragma unroll
        for (int ai = 0; ai < 2; ++ai)
#pragma unroll
            for (int m = 0; m < 4; ++m) { const int row = row0 + ai * HALF + m * 16;
#pragma unroll
                for (int bj = 0; bj < 2; ++bj) { const int c = col0 + bj * HALF; const f16x8 w = pack8(acc[ai][bj][m][0], acc[ai][bj][m][1]);
                    if (u.pn < 2) *(f16x8*)(S5A + (size_t)(row >> 4) * 16384 + (size_t)(c >> 4) * 512 + (row & 15) * 16 + (c & 15)) = w;
                    else if (u.pn >= 14 && u.pn < 20) {
#pragma unroll
                        for (int j = 0; j < 8; ++j) ZT[(size_t)(c - P_HY + j) * MT + row] = w[j]; }
                    else if (u.pn >= 20 && u.pn < 44) *(f16x8*)(GTL + ((size_t)(u.pn - 20) * 66 + u.pm) * 65536 + (size_t)(row - u.pm * BM) * 256 + (c - u.pn * BM)) = w;
                    else { const int pr = row < MX ? (row & ~8191) + ((row & 63) << 7) + ((row & 8191) >> 6) : row;
                        *(f16x8*)(PX + (size_t)pr * PXLD + (u.pn == 44 ? c - (W_GG - P_GG) : c)) = w; } } }
    }
};
struct EpiF16 {
    static constexpr bool PERM = true, HAS_MID = false; static constexpr int MID1 = 0, MID2 = 0; f16* O; int ldc;
    __device__ __forceinline__ void operator()(AccRef acc, const Unit& u, int wr, int wc, int fr, int fq) const { fr = opq(fr); fq = opq(fq);
        const int row0 = u.pm * BM + wr * 64 + fr, col0 = u.pn * BM + wc * 32 + 8 * fq;
#pragma unroll
        for (int ai = 0; ai < 2; ++ai)
#pragma unroll
            for (int m = 0; m < 4; ++m) { f16* rowp = O + (size_t)(row0 + ai * HALF + m * 16) * ldc + col0;
#pragma unroll
                for (int bj = 0; bj < 2; ++bj) *(f16x8*)(rowp + bj * HALF) = pack8(acc[ai][bj][m][0], acc[ai][bj][m][1]); }
    }
};
struct EpiS5In {
    static constexpr bool PERM = false, HAS_MID = false; static constexpr int MID1 = 0, MID2 = 0; float* S;
    __device__ __forceinline__ void operator()(AccRef acc, const Unit& u, int wr, int wc, int fr, int fq) const { fr = opq(fr); fq = opq(fq);
        const int row0 = u.pm * BM + wr * 64 + fr, col0 = wc * 32 + 4 * fq, g = u.pn;
#pragma unroll
        for (int ai = 0; ai < 2; ++ai)
#pragma unroll
            for (int m = 0; m < 4; ++m) { const int row = row0 + ai * HALF + m * 16; { float* rowp = S + ((size_t)row * 32 + g) * 256 + col0;
#pragma unroll
                for (int bj = 0; bj < 2; ++bj)
#pragma unroll
                    for (int n = 0; n < 2; ++n) *(f32x4*)(rowp + bj * HALF + n * 16) = acc[ai][bj][m][n]; } }
    }
};
struct EpiS5Out {
    static constexpr bool PERM = true, HAS_MID = false; static constexpr int MID1 = 0, MID2 = 0; const f16* S5A; f16* Y; const float* dvec;
    __device__ __forceinline__ void operator()(AccRef acc, const Unit& u, int wr, int wc, int fr, int fq) const { fr = opq(fr); fq = opq(fq);
        const int row0 = u.pm * BM + wr * 64 + fr, col0 = wc * 32 + 8 * fq, g = u.pn;
        const int h0 = col0 & 15;
        const f32x4 d0 = *(const f32x4*)(dvec + g * 16 + h0), d1 = *(const f32x4*)(dvec + g * 16 + h0 + 4);
#pragma unroll
        for (int ai = 0; ai < 2; ++ai) { f16x8 uu[4][2];
#pragma unroll
            for (int m = 0; m < 4; ++m)
#pragma unroll
                for (int bj = 0; bj < 2; ++bj) uu[m][bj] = *(const f16x8*)(S5A + (size_t)(row0 + ai * HALF + m * 16) * 16384 + (size_t)g * 512 + col0 + bj * HALF);
            PIN8(uu[0][0], uu[0][1], uu[1][0], uu[1][1], uu[2][0], uu[2][1], uu[3][0], uu[3][1]);
#pragma unroll
            for (int m = 0; m < 4; ++m) { const int chunk = row0 + ai * HALF + m * 16;
#pragma unroll
                for (int bj = 0; bj < 2; ++bj) { const int c = col0 + bj * HALF, t = c >> 4; f16x8 w;
#pragma unroll
                    for (int j = 0; j < 4; ++j) { w[j] = (f16)gelu_tanh_(acc[ai][bj][m][0][j] * (1.0f / S5SCALE) + d0[j] * (float)uu[m][bj][j]);
                                                  w[4 + j] = (f16)gelu_tanh_(acc[ai][bj][m][1][j] * (1.0f / S5SCALE) + d1[j] * (float)uu[m][bj][4 + j]); }
                    *(f16x8*)(Y + (size_t)(chunk * 16 + t) * 512 + g * 16 + h0) = w; } }
            asm volatile("" ::: "memory"); }
    }
};
struct EpiGlu {
    static constexpr bool PERM = true, HAS_MID = false; static constexpr int MID1 = 0, MID2 = 0; const f16* YP; f16* O; const float* bias;
    __device__ __forceinline__ void operator()(AccRef acc, const Unit& u, int wr, int wc, int fr, int fq) const { fr = opq(fr); fq = opq(fq);
        const int row0 = u.pm * BM + wr * 64 + fr, col0 = u.pn * BM + wc * 32 + 8 * fq;
        f32x4 bv[2][2];
#pragma unroll
        for (int bj = 0; bj < 2; ++bj) { bv[bj][0] = *(const f32x4*)(bias + col0 + bj * HALF); bv[bj][1] = *(const f32x4*)(bias + col0 + bj * HALF + 4); }
#pragma unroll
        for (int ai = 0; ai < 2; ++ai) { f16x8 yp[4][2];
#pragma unroll
            for (int m = 0; m < 4; ++m)
#pragma unroll
                for (int bj = 0; bj < 2; ++bj) yp[m][bj] = *(const f16x8*)(YP + (size_t)(row0 + ai * HALF + m * 16) * 512 + col0 + bj * HALF);
            PIN8(yp[0][0], yp[0][1], yp[1][0], yp[1][1], yp[2][0], yp[2][1], yp[3][0], yp[3][1]);
#pragma unroll
            for (int m = 0; m < 4; ++m)
#pragma unroll
                for (int bj = 0; bj < 2; ++bj) { f16x8 w;
#pragma unroll
                    for (int j = 0; j < 4; ++j) { w[j] = (f16)((float)yp[m][bj][j] * sigmoidf_(acc[ai][bj][m][0][j] + bv[bj][0][j])); w[4 + j] = (f16)((float)yp[m][bj][4 + j] * sigmoidf_(acc[ai][bj][m][1][j] + bv[bj][1][j])); }
                    *(f16x8*)(O + (size_t)(row0 + ai * HALF + m * 16) * 2048 + col0 + bj * HALF) = w; }
            asm volatile("" ::: "memory"); }
    }
};
template <int BR> struct EpiBranch {
    static constexpr bool PERM = true, HAS_MID = false; static constexpr int MID1 = 0, MID2 = 0; const f16* PX; f16* M;
    __device__ __forceinline__ void operator()(AccRef acc, const Unit& u, int wr, int wc, int fr, int fq) const { fr = opq(fr); fq = opq(fq);
        const int row0 = u.pm * BM + wr * 64 + fr, col0 = u.pn * BM + wc * 32 + 8 * fq;
#pragma unroll
        for (int ai = 0; ai < 2; ++ai)
#pragma unroll
            for (int m = 0; m < 4; ++m) { const int row = row0 + ai * HALF + m * 16;
#pragma unroll
                for (int bj = 0; bj < 2; ++bj) { const int c = col0 + bj * HALF;
                    const f16x8 gl = *(const f16x8*)(PX + (size_t)row * PXLD + P_MG + BR * 2048 + c);
                    f16* mp = M + (size_t)row * 2048 + c;
                    f16x8 prev; if (BR > 0) prev = *(const f16x8*)mp;
                    f16x8 w;
#pragma unroll
                    for (int j = 0; j < 4; ++j) { float v0 = sigmoidf_((float)gl[j]) * acc[ai][bj][m][0][j], v1 = sigmoidf_((float)gl[4 + j]) * acc[ai][bj][m][1][j];
                        if (BR > 0) { v0 += (float)prev[j]; v1 += (float)prev[4 + j]; } w[j] = (f16)v0; w[4 + j] = (f16)v1; }
                    *(f16x8*)mp = w; } asm volatile("" ::: "memory"); }
    }
};
typedef f32x4 (&AccMut)[2][2][4][2];

struct EpiBranchF {
    static constexpr bool PERM = true, HAS_MID = true; static constexpr int MID1 = 6, MID2 = 14;
    const f16* GTL; f16* M;
    __device__ __forceinline__ void mid(AccMut acc, const Unit& u, int seg, int wr, int wc, int fr, int fq) const { fr = opq(fr); fq = opq(fq);
        const int lrow0 = wr * 64 + fr, lcol0 = wc * 32 + 8 * fq;
        const f16* ga = GTL + ((size_t)((seg == 0 ? 0 : 8) + u.pn) * 66 + u.pm) * 65536; const f16* gb = ga + (size_t)8 * 66 * 65536;
#pragma unroll
        for (int ai = 0; ai < 2; ++ai) { f16x8 za[4][2], zb[4][2];
#pragma unroll
            for (int m = 0; m < 4; ++m)
#pragma unroll
                for (int bj = 0; bj < 2; ++bj) { const int off = (lrow0 + ai * HALF + m * 16) * 256 + lcol0 + bj * HALF; za[m][bj] = *(const f16x8*)(ga + off); zb[m][bj] = *(const f16x8*)(gb + off); }
            PIN8(za[0][0], za[0][1], za[1][0], za[1][1], za[2][0], za[2][1], za[3][0], za[3][1]); PIN8(zb[0][0], zb[0][1], zb[1][0], zb[1][1], zb[2][0], zb[2][1], zb[3][0], zb[3][1]);
#pragma unroll
            for (int m = 0; m < 4; ++m)
#pragma unroll
                for (int bj = 0; bj < 2; ++bj)
#pragma unroll
                    for (int j = 0; j < 4; ++j) { acc[ai][bj][m][0][j] *= (1.0f + __expf(-(float)zb[m][bj][j])) * __builtin_amdgcn_rcpf(1.0f + __expf(-(float)za[m][bj][j]));
                                                  acc[ai][bj][m][1][j] *= (1.0f + __expf(-(float)zb[m][bj][4 + j])) * __builtin_amdgcn_rcpf(1.0f + __expf(-(float)za[m][bj][4 + j])); }
            asm volatile("" ::: "memory"); }
    }
    __device__ __forceinline__ void operator()(AccRef acc, const Unit& u, int wr, int wc, int fr, int fq) const { fr = opq(fr); fq = opq(fq);
        const int row0 = u.pm * BM + wr * 64 + fr, col0 = u.pn * BM + wc * 32 + 8 * fq;
#pragma unroll
        for (int ai = 0; ai < 2; ++ai) { f16x8 gl[4][2];
#pragma unroll
            for (int m = 0; m < 4; ++m)
#pragma unroll
                for (int bj = 0; bj < 2; ++bj) gl[m][bj] = *(const f16x8*)(GTL + ((size_t)(16 + u.pn) * 66 + u.pm) * 65536 + (wr * 64 + fr + ai * HALF + m * 16) * 256 + wc * 32 + 8 * fq + bj * HALF);
            PIN8(gl[0][0], gl[0][1], gl[1][0], gl[1][1], gl[2][0], gl[2][1], gl[3][0], gl[3][1]);
#pragma unroll
            for (int m = 0; m < 4; ++m)
#pragma unroll
                for (int bj = 0; bj < 2; ++bj) { f16x8 w;
#pragma unroll
                    for (int j = 0; j < 4; ++j) { w[j] = (f16)(sigmoidf_((float)gl[m][bj][j]) * acc[ai][bj][m][0][j]); w[4 + j] = (f16)(sigmoidf_((float)gl[m][bj][4 + j]) * acc[ai][bj][m][1][j]); }
                    *(f16x8*)(M + (size_t)(row0 + ai * HALF + m * 16) * 2048 + col0 + bj * HALF) = w; }
            asm volatile("" ::: "memory"); }
    }
};
struct EpiUpAct {
    static constexpr bool PERM = true, HAS_MID = false; static constexpr int MID1 = 0, MID2 = 0; f16* ACT; float* HALO; const float* cw; const float* cb; LAS float* HL;
    __device__ __forceinline__ void operator()(AccRef acc, const Unit& u, int wr, int wc, int fr, int fq) const { fr = opq(fr); fq = opq(fq);
        const int lane = fq * 16 + fr;
#pragma unroll
        for (int ai = 0; ai < 2; ++ai) { LAS float* hp = HL + ((ai * 2 + wr) * 4 + wc) * 64 + 8 * fq;
            if (fr == 0) { *(LAS f32x4*)(hp) = acc[ai][0][0][0]; *(LAS f32x4*)(hp + 4) = acc[ai][0][0][1]; }
            if (fr == 15) { *(LAS f32x4*)(hp + 32) = acc[ai][0][3][0]; *(LAS f32x4*)(hp + 36) = acc[ai][0][3][1]; } }
        { float* gh = HALO + ((size_t)u.pm * 44 + u.pn) * 768 + wc * 32 + 8 * fq;
          if (wr == 0 && fr < 2) { *(f32x4*)(gh + fr * 128) = acc[0][0][0][0]; *(f32x4*)(gh + fr * 128 + 4) = acc[0][0][0][1]; }
          if (wr == 0 && fr == 0) { *(f32x4*)(gh + 4 * 128) = acc[0][1][0][0]; *(f32x4*)(gh + 4 * 128 + 4) = acc[0][1][0][1]; }
          if (wr == 1 && fr >= 14) { *(f32x4*)(gh + (fr - 12) * 128) = acc[1][0][3][0]; *(f32x4*)(gh + (fr - 12) * 128 + 4) = acc[1][0][3][1]; }
          if (wr == 1 && fr == 15) { *(f32x4*)(gh + 5 * 128) = acc[1][1][3][0]; *(f32x4*)(gh + 5 * 128 + 4) = acc[1][1][3][1]; } }
        asm volatile("s_waitcnt lgkmcnt(0)" ::: "memory"); __builtin_amdgcn_s_barrier(); __builtin_amdgcn_s_barrier(); asm volatile("" ::: "memory");
        const int colg = u.pn * 128 + wc * 32 + 8 * fq;
        const int srcR = (lane & 48) | ((fr + 15) & 15), srcL = (lane & 48) | ((fr + 1) & 15);
        const int row0 = u.pm * BM + wr * 64 + fr;
#pragma unroll
        for (int n = 0; n < 2; ++n) {
            const f32x4 w0 = *(const f32x4*)(cw + colg + 4 * n), w1 = *(const f32x4*)(cw + FFH + colg + 4 * n), w2 = *(const f32x4*)(cw + 2 * FFH + colg + 4 * n), bb = *(const f32x4*)(cb + colg + 4 * n);
#pragma unroll
            for (int ai = 0; ai < 2; ++ai) {
                const bool hasp = (wr == 1) || (ai == 1), hasn = (wr == 0) || (ai == 0);
                const LAS float* pp = HL + (((wr == 1 ? ai : 0) * 2 + (wr == 1 ? 0 : 1)) * 4 + wc) * 64 + 32 + 8 * fq + 4 * n;
                const LAS float* np = HL + (((wr == 0 ? ai : 1) * 2 + (wr == 0 ? 1 : 0)) * 4 + wc) * 64 + 8 * fq + 4 * n;
                const f32x4 hprev = hasp ? *(const LAS f32x4*)pp : (f32x4){0.f, 0.f, 0.f, 0.f}, hnext = hasn ? *(const LAS f32x4*)np : (f32x4){0.f, 0.f, 0.f, 0.f};
                f32x4 R[4], L[4];
#pragma unroll
                for (int m = 0; m < 4; ++m)
#pragma unroll
                    for (int j = 0; j < 4; ++j) { R[m][j] = __shfl(acc[ai][0][m][n][j], srcR); L[m][j] = __shfl(acc[ai][0][m][n][j], srcL); }
#pragma unroll
                for (int m = 0; m < 4; ++m) { const f32x4 pv = fr > 0 ? R[m] : (m > 0 ? R[m > 0 ? m - 1 : 0] : hprev); const f32x4 nv = fr < 15 ? L[m] : (m < 3 ? L[m < 3 ? m + 1 : 3] : hnext);
                    const f32x4 a = w0 * pv + w1 * acc[ai][0][m][n] + w2 * nv + bb;
                    f16x4 o;
#pragma unroll
                    for (int j = 0; j < 4; ++j) o[j] = (f16)(siluf_(a[j]) * acc[ai][1][m][n][j]);
                    *(f16x4*)(ACT + (size_t)(row0 + ai * HALF + m * 16) * FFH + colg + 4 * n) = o; }
                asm volatile("" ::: "memory");
            }
        }
    }
};
struct EpiSlab {
    static constexpr bool PERM = false, HAS_MID = false; static constexpr int MID1 = 0, MID2 = 0; float* slab; const float* mod; int goff;
    __device__ __forceinline__ void operator()(AccRef acc, const Unit& u, int wr, int wc, int fr, int fq) const { fr = opq(fr); fq = opq(fq);
        const int pn = u.pn & 255, ks = u.pn >> 8;
        const int row0 = (u.pm - 64) * BM + wr * 64 + fr, col0 = pn * BM + wc * 32 + 4 * fq;
        const float* gp = mod + 2 * 12288 + goff + col0;
        f32x4 gv[2][2];
#pragma unroll
        for (int bj = 0; bj < 2; ++bj)
#pragma unroll
            for (int n = 0; n < 2; ++n) gv[bj][n] = *(const f32x4*)(gp + bj * HALF + n * 16);
        float* sp = slab + (size_t)ks * MC * D;
#pragma unroll
        for (int ai = 0; ai < 2; ++ai)
#pragma unroll
            for (int m = 0; m < 4; ++m) { float* rowp = sp + (size_t)(row0 + ai * HALF + m * 16) * D + col0;
#pragma unroll
                for (int bj = 0; bj < 2; ++bj)
#pragma unroll
                    for (int n = 0; n < 2; ++n) *(f32x4*)(rowp + bj * HALF + n * 16) = gv[bj][n] * acc[ai][bj][m][n]; }
    }
};
struct EpiResid {
    static constexpr bool PERM = false, HAS_MID = false; static constexpr int MID1 = 0, MID2 = 0; float* X; const float* mod; int goff; const float* Xs;
    __device__ __forceinline__ void operator()(AccRef acc, const Unit& u, int wr, int wc, int fr, int fq) const { fr = opq(fr); fq = opq(fq);
        const int row0 = u.pm * BM + wr * 64 + fr, col0 = u.pn * BM + wc * 32 + 4 * fq;
        const int bsel = u.pm < 32 ? 0 : (u.pm < 64 ? 1 : 2);
        const float* gp = mod + bsel * 12288 + goff + col0;
        f32x4 gv[2][2];
#pragma unroll
        for (int bj = 0; bj < 2; ++bj)
#pragma unroll
            for (int n = 0; n < 2; ++n) gv[bj][n] = *(const f32x4*)(gp + bj * HALF + n * 16);
#pragma unroll
        for (int ai = 0; ai < 2; ++ai) { f32x4 xv[4][2][2];
#pragma unroll
            for (int m = 0; m < 4; ++m) { const float* rowp = Xs + (size_t)(row0 + ai * HALF + m * 16) * D + col0;
#pragma unroll
                for (int bj = 0; bj < 2; ++bj)
#pragma unroll
                    for (int n = 0; n < 2; ++n) xv[m][bj][n] = *(const f32x4*)(rowp + bj * HALF + n * 16); }
            PIN8(xv[0][0][0], xv[0][0][1], xv[0][1][0], xv[0][1][1], xv[1][0][0], xv[1][0][1], xv[1][1][0], xv[1][1][1]); PIN8(xv[2][0][0], xv[2][0][1], xv[2][1][0], xv[2][1][1], xv[3][0][0], xv[3][0][1], xv[3][1][0], xv[3][1][1]);
#pragma unroll
            for (int m = 0; m < 4; ++m) { float* rowp = X + (size_t)(row0 + ai * HALF + m * 16) * D + col0;
#pragma unroll
                for (int bj = 0; bj < 2; ++bj)
#pragma unroll
                    for (int n = 0; n < 2; ++n) *(f32x4*)(rowp + bj * HALF + n * 16) = xv[m][bj][n] + gv[bj][n] * acc[ai][bj][m][n]; }
            asm volatile("" ::: "memory"); }
    }
};
}


__device__ __forceinline__ void ph_prologue(const Ctx& F, const ArgsV& AV) {
    const int gt = F.bid * 512 + F.tid, NT = F.G * 512;
    { const f32x4* cs = (const f32x4*)AV.in(I_CTX); f32x4* xr = (f32x4*)(F.ws + WS_XRES);
      for (int i = gt; i < MC * D / 4; i += NT) xr[MX * D / 4 + i] = cs[i]; }
    LAS float* sc = (LAS float*)F.lds;
    LAS float* red = (LAS float*)(F.lds + 3 * 2048 * 4);
    for (int i = F.tid; i < 3 * 2048; i += 512) { const int r = i / 2048, k = i % 2048; const float v = r < 2 ? AV.in(I_C)[r * 2048 + k] : AV.in(I_CCTX)[k]; sc[i] = siluf_(v); }
    __syncthreads();
    const int col = F.tid & 63, ks = F.tid >> 6;
    for (int chunk = F.bid; chunk < DEPTH * 192; chunk += F.G) {
        const int l = chunk / 192, n0 = (chunk % 192) * 64;
        const float* w = AV.in(I_WMOD) + (size_t)l * 2048 * 12288 + n0 + col;
        float s0 = 0.f, s1 = 0.f, s2 = 0.f;
#pragma unroll 8
        for (int k = ks * 256; k < ks * 256 + 256; ++k) { const float wv = w[(size_t)k * 12288]; s0 += sc[k] * wv; s1 += sc[2048 + k] * wv; s2 += sc[4096 + k] * wv; }
        red[(ks * 3 + 0) * 64 + col] = s0; red[(ks * 3 + 1) * 64 + col] = s1; red[(ks * 3 + 2) * 64 + col] = s2;
        __syncthreads();
        if (F.tid < 192) { const int r = F.tid >> 6, c2 = F.tid & 63; float s = 0.f;
#pragma unroll
            for (int q = 0; q < 8; ++q) s += red[(q * 3 + r) * 64 + c2];
            ((float*)(F.ws + WS_MOD))[((size_t)l * 3 + r) * 12288 + n0 + c2] = s + AV.in(I_BMOD)[(size_t)l * 12288 + n0 + c2]; }
        __syncthreads();
    }
}

__device__ __forceinline__ void conv_item(const float* W, int ldw, int k0, int srccol, f16* WT, int dstrow, int ldk) {
    float v[64];
    const float* src = W + (size_t)k0 * ldw + (srccol >= 0 ? srccol : 0);
#pragma unroll
    for (int k = 0; k < 64; ++k) v[k] = src[(size_t)k * ldw];
#pragma unroll
    for (int k = 0; k < 64; k += 8) PIN8(v[k], v[k + 1], v[k + 2], v[k + 3], v[k + 4], v[k + 5], v[k + 6], v[k + 7]);
    f16* dst = WT + (size_t)dstrow * ldk + k0;
#pragma unroll
    for (int kg = 0; kg < 8; ++kg) { f16x8 o;
#pragma unroll
        for (int e = 0; e < 8; ++e) o[e] = srccol >= 0 ? (f16)v[8 * kg + e] : (f16)0.f;
        *(f16x8*)(dst + 8 * kg) = o; }
}
__device__ __forceinline__ void ph_convert_weights(const Ctx& F, const ArgsV& AV, int l) {
    const int skip = F.G > 64 ? 32 : 0;
    if (F.bid < skip) return;
    const int gw = (F.bid - skip) * 8 + F.wave, NGW = (F.G - skip) * 8, lane = F.lane;
    constexpr int I_IN = 32 * 180, I_GLU = 8 * 8, I_BR = 32 * 32, I_OUT = 32 * 32, I_UP = 32 * 176, I_DN = 88 * 32;
    constexpr int NIT = I_IN + I_GLU + I_BR + I_OUT + I_UP + I_DN;
    for (int it = gw; it < NIT; it += NGW) {
        int r = it;
        if (r < I_IN) { const int kb = r / 180, nb = r % 180, j = nb * 64 + lane;
            const int src = j < 2048 ? j : (j < 11264 ? j + 32 : (j < 11296 ? 2048 + (j - 11264) : -1));
            conv_item(AV.in(I_WIN) + (size_t)l * 2048 * INW, INW, kb * 64, src, (f16*)(F.ws + WS_WIN), j, 2048); continue; } r -= I_IN;
        if (r < I_GLU) { const int kb = r / 8, nb = r % 8, j = nb * 64 + lane; conv_item(AV.in(I_GLUW) + (size_t)l * 512 * 512, 512, kb * 64, j, (f16*)(F.ws + WS_WGLU), j, 512); continue; } r -= I_GLU;
        if (r < I_BR) { const int kb = r / 32, nb = r % 32, j = nb * 64 + lane; conv_item(AV.in(I_WBR) + (size_t)l * 2048 * 2048, 2048, kb * 64, j, (f16*)(F.ws + WS_WBR), j, 2048); continue; } r -= I_BR;
        if (r < I_OUT) { const int kb = r / 32, nb = r % 32, j = nb * 64 + lane; conv_item(AV.in(I_WOUT) + (size_t)l * 2048 * 2048, 2048, kb * 64, j, (f16*)(F.ws + WS_WOUT), j, 2048); continue; } r -= I_OUT;
        if (r < I_UP) { const int kb = r / 176, nb = r % 176, j = nb * 64 + lane, pn = j >> 8, i = j & 255; const int src = i < 128 ? 128 * pn + i : FFH + 128 * pn + (i - 128);
            conv_item(AV.in(I_WUP) + (size_t)l * 2048 * UPLD, UPLD, kb * 64, src, (f16*)(F.ws + WS_WUP), j, 2048); continue; } r -= I_UP;
        { const int kb = r / 32, nb = r % 32, j = nb * 64 + lane; conv_item(AV.in(I_WDN) + (size_t)l * FFH * 2048, 2048, kb * 64, j, (f16*)(F.ws + WS_WDN), j, FFH); }
    }
}

__device__ __forceinline__ void s5_mats_group(const Ctx& F, const ArgsV& AV, int l, int g) {
    LAS f32x2* APOW = (LAS f32x2*)F.lds;
    LAS f32x2* BBAR = APOW + 2 * 17 * 64;
    LAS f32x2* CM = BBAR + 2 * 64 * 16;
    LAS float* KLAG = (LAS float*)(CM + 2 * 16 * 64);
    __syncthreads();
    for (int i = F.tid; i < 2 * 17 * 64; i += 512) { const int d = i / (17 * 64), e = (i / 64) % 17, n = i % 64;
        const size_t pi = (((size_t)l * 2 + d) * 32 + g) * 64 + n;
        const float are = AV.in(I_S5ARE)[pi], aim = AV.in(I_S5AIM)[pi], dt = expf(AV.in(I_S5STEP)[((size_t)l * 2 + d) * 32 + g]);
        const float zr = are * dt * (float)e, zi = aim * dt * (float)e; float s, c; sincosf(zi, &s, &c); const float m = expf(zr);
        APOW[i] = (f32x2){m * c, m * s}; }
    __syncthreads();
    for (int i = F.tid; i < 2 * 64 * 16; i += 512) { const int d = i / 1024, n = (i / 16) % 64, h = i % 16;
        const size_t pi = (((size_t)l * 2 + d) * 32 + g) * 64 + n;
        const float are = AV.in(I_S5ARE)[pi], aim = AV.in(I_S5AIM)[pi];
        const f32x2 ab = APOW[(d * 17 + 1) * 64 + n]; const f32x2 num = (f32x2){ab.x - 1.0f, ab.y};
        const float den = are * are + aim * aim; const f32x2 q = (f32x2){(num.x * are + num.y * aim) / den, (num.y * are - num.x * aim) / den};
        const size_t bi = (pi * 16) + h;
        BBAR[i] = cmul(q, (f32x2){AV.in(I_S5BRE)[bi], AV.in(I_S5BIM)[bi]});
        const size_t ci = ((((size_t)l * 2 + d) * 32 + g) * 16 + h) * 64 + n;
        CM[(d * 16 + h) * 64 + n] = (f32x2){AV.in(I_S5CRE)[ci], AV.in(I_S5CIM)[ci]}; }
    __syncthreads();
    for (int i = F.tid; i < 2 * 16 * 256; i += 512) { const int d = i / 4096, lag = (i / 256) % 16, h = (i / 16) % 16, hp = i % 16; float s = 0.f;
        for (int n = 0; n < 64; ++n) { const f32x2 t = cmul(CM[(d * 16 + h) * 64 + n], APOW[(d * 17 + lag) * 64 + n]); const f32x2 b = BBAR[(d * 64 + n) * 16 + hp]; s += t.x * b.x - t.y * b.y; }
        KLAG[i] = s; }
    __syncthreads();
    f16* W = (f16*)(F.ws + WS_S5W) + (size_t)g * 256 * 512;
    for (int i = F.tid; i < 256 * 64; i += 512) { const int n = i / 64, k8 = (i % 64) * 8, t = n >> 4, h = n & 15; f16x8 o;
#pragma unroll
        for (int e = 0; e < 8; ++e) { const int k = k8 + e; float v;
            if (k < 256) { const int s = k >> 4, hp = k & 15; v = 0.f;
                if (t >= s) v += KLAG[((0 * 16 + (t - s)) * 16 + h) * 16 + hp];
                if (s >= t) v += KLAG[((1 * 16 + (s - t)) * 16 + h) * 16 + hp];
                v *= S5SCALE; }
            else { const int d = (k - 256) >> 7, nn2 = (k - 256) & 127, nn = nn2 & 63, im = nn2 >> 6, ex = d == 0 ? t + 1 : 16 - t;
                const f32x2 z = cmul(CM[(d * 16 + h) * 64 + nn], APOW[(d * 17 + ex) * 64 + nn]); v = im ? -z.y : z.x; }
            o[e] = (f16)v; }
        *(f16x8*)(W + (size_t)n * 512 + k8) = o; }
    f16* Mx = (f16*)(F.ws + WS_S5M) + (size_t)g * 256 * 256;
    for (int i = F.tid; i < 256 * 32; i += 512) { const int n = i / 32, k8 = (i % 32) * 8, d = n >> 7, ri = (n >> 6) & 1, nn = n & 63; f16x8 o;
#pragma unroll
        for (int e = 0; e < 8; ++e) { const int k = k8 + e, s = k >> 4, hp = k & 15, ex = d == 0 ? 15 - s : s;
            const f32x2 z = cmul(APOW[(d * 17 + ex) * 64 + nn], BBAR[(d * 64 + nn) * 16 + hp]); o[e] = (f16)((ri ? z.y : z.x) * S5SCALE); }
        *(f16x8*)(Mx + (size_t)n * 256 + k8) = o; }
    if (F.tid < 128) { const int d = F.tid >> 6, nn = F.tid & 63; ((f32x2*)(F.ws + WS_S5AT))[(d * 32 + g) * 64 + nn] = APOW[(d * 17 + 16) * 64 + nn]; }
    __syncthreads();
}

__device__ __forceinline__ void ph_hyena_h2(const Ctx& F, const ArgsV& AV, int l) {
    LAS float* W1 = (LAS float*)F.lds;
    LAS float* W2 = W1 + 33 * 64;
    LAS float* PV = W2 + 64 * 64;
    LAS float* SCR = PV + 256;
    __syncthreads();
    for (int i = F.tid; i < 33 * 64; i += 512) W1[i] = AV.in(I_HYW1)[(size_t)l * 33 * 64 + i];
    for (int i = F.tid; i < 64 * 64; i += 512) W2[i] = AV.in(I_HYW2)[(size_t)l * 4096 + i];
    if (F.tid < 64) { PV[F.tid] = AV.in(I_HYB1)[l * 64 + F.tid]; PV[64 + F.tid] = AV.in(I_HYF1)[l * 64 + F.tid]; PV[128 + F.tid] = AV.in(I_HYB2)[l * 64 + F.tid]; PV[192 + F.tid] = AV.in(I_HYF2)[l * 64 + F.tid]; }
    __syncthreads();
    LAS float* scr = SCR + F.wave * 64;
    const int gw = F.bid * 8 + F.wave, NGW = F.G * 8, j = F.lane;
    for (int p = gw; p < SEQ + LC; p += NGW) {
        const int n = p < SEQ ? SEQ : LC, pos = p < SEQ ? p : p - SEQ;
        float feat = 0.f;
        if (j == 0) feat = (float)pos / (float)(n - 1);
        else if (j < 33) { const int fi = (j - 1) & 15; const float fr = 1e-4f + (float)fi * ((15.0f - 1e-4f) / 15.0f);
            const float ang = (6.283185307179586f / (float)n) * (float)pos * fr; float s, c; sincosf(ang, &s, &c); feat = j < 17 ? c : -s; }
        scr[j] = feat; LDS_WAIT(); asm volatile("" ::: "memory");
        float a = PV[j];
        for (int i = 0; i < 33; ++i) a += scr[i] * W1[i * 64 + j];
        const float h1 = sinf(PV[64 + j] * a);
        LDS_WAIT(); asm volatile("" ::: "memory");
        scr[j] = h1; LDS_WAIT(); asm volatile("" ::: "memory");
        float b = PV[128 + j];
        for (int i = 0; i < 64; ++i) b += scr[i] * W2[i * 64 + j];
        ((f16*)(F.ws + WS_H2H))[((size_t)l * (SEQ + LC) + p) * 64 + j] = (f16)sinf(PV[192 + j] * b);
        LDS_WAIT(); asm volatile("" ::: "memory");
    }
}

__device__ __forceinline__ void ph_norm(const Ctx& F, const ArgsV& AV, int l, int which, int nrows, int nslab) {
    const int gw = F.bid * 8 + F.wave, NGW = F.G * 8;
    float* X = (float*)(F.ws + WS_XRES); f16* O = (f16*)(F.ws + WS_HN); const float* SL = (const float*)(F.ws + WS_SLAB);
    const float* Xin = (l == 0 && which == 0) ? AV.in(I_X) : X;
    const float* gain = AV.in(which ? I_N2G : I_N1G) + (size_t)l * D;
    const float* mod = (const float*)(F.ws + WS_MOD) + (size_t)l * 3 * 12288;
    const int shoff = which ? 6144 : 0, soff = which ? 8192 : 2048;
    int cur_bsel = -1; f32x4 Am[8], Bm[8], vn[8];
    if (gw < nrows) { const f32x4* xr0 = (const f32x4*)((gw < MX ? Xin : X) + (size_t)gw * D) + F.lane;
#pragma unroll
        for (int j = 0; j < 8; ++j) vn[j] = xr0[64 * j]; }
    for (int m = gw; m < nrows; m += NGW) {
        const int bsel = m < SEQ ? 0 : (m < MX ? 1 : 2);
        f32x4* xr = (f32x4*)(X + (size_t)m * D) + F.lane;
        f32x4 v[8]; float s = 0.f;
        PIN8(vn[0], vn[1], vn[2], vn[3], vn[4], vn[5], vn[6], vn[7]);
#pragma unroll
        for (int j = 0; j < 8; ++j) v[j] = vn[j];
        if (m + NGW < nrows) { const f32x4* xq = (const f32x4*)((m + NGW < MX ? Xin : X) + (size_t)(m + NGW) * D) + F.lane;
#pragma unroll
            for (int j = 0; j < 8; ++j) vn[j] = xq[64 * j]; }
        if (bsel != cur_bsel) { cur_bsel = bsel; const float* mp = mod + bsel * 12288;
#pragma unroll
            for (int j = 0; j < 8; ++j) { const int c = 4 * F.lane + 256 * j; const f32x4 g = *(const f32x4*)(gain + c), sc = *(const f32x4*)(mp + soff + c); Bm[j] = *(const f32x4*)(mp + shoff + c); Am[j] = g * (sc + 1.0f); }
            PIN8(Am[0], Am[1], Am[2], Am[3], Am[4], Am[5], Am[6], Am[7]); PIN8(Bm[0], Bm[1], Bm[2], Bm[3], Bm[4], Bm[5], Bm[6], Bm[7]); }
        if (m >= MX && nslab > 0) {
            for (int sl = 0; sl < nslab; ++sl) { const f32x4* sr = (const f32x4*)(SL + ((size_t)sl * MC + (m - MX)) * D) + F.lane;
#pragma unroll
                for (int j = 0; j < 8; ++j) v[j] = v[j] + sr[64 * j]; }
#pragma unroll
            for (int j = 0; j < 8; ++j) xr[64 * j] = v[j]; }
#pragma unroll
        for (int j = 0; j < 8; ++j) s += (v[j].x * v[j].x + v[j].y * v[j].y) + (v[j].z * v[j].z + v[j].w * v[j].w);
        const float rstd = 1.0f / sqrtf(wave_sum(s) * (1.0f / D) + EPS);
#pragma unroll
        for (int j = 0; j < 8; ++j) { const int c = 4 * F.lane + 256 * j;
            f16x4 o;
#pragma unroll
            for (int e = 0; e < 4; ++e) o[e] = (f16)(v[j][e] * rstd * Am[j][e] + Bm[j][e]);
            *(f16x4*)(O + (size_t)m * D + c) = o; }
    }
}
__device__ __forceinline__ void ph_final_norm(const Ctx& F, const ArgsV& AV) {
    const int gw = F.bid * 8 + F.wave, NGW = F.G * 8;
    const float* X = (const float*)(F.ws + WS_XRES); const float* gain = AV.in(I_FNG);
    f32x4 gm[8], vn[8];
#pragma unroll
    for (int j = 0; j < 8; ++j) gm[j] = *(const f32x4*)(gain + 4 * F.lane + 256 * j);
    if (gw < MX) { const f32x4* xr0 = (const f32x4*)(X + (size_t)gw * D) + F.lane;
#pragma unroll
        for (int j = 0; j < 8; ++j) vn[j] = xr0[64 * j]; }
    for (int m = gw; m < MX; m += NGW) {
        f32x4 v[8]; float s = 0.f;
        PIN8(vn[0], vn[1], vn[2], vn[3], vn[4], vn[5], vn[6], vn[7]);
#pragma unroll
        for (int j = 0; j < 8; ++j) v[j] = vn[j];
        if (m + NGW < MX) { const f32x4* xq = (const f32x4*)(X + (size_t)(m + NGW) * D) + F.lane;
#pragma unroll
            for (int j = 0; j < 8; ++j) vn[j] = xq[64 * j]; }
#pragma unroll
        for (int j = 0; j < 8; ++j) s += (v[j].x * v[j].x + v[j].y * v[j].y) + (v[j].z * v[j].z + v[j].w * v[j].w);
        const float rstd = 1.0f / sqrtf(wave_sum(s) * (1.0f / D) + EPS);
#pragma unroll
        for (int j = 0; j < 8; ++j) { const int c = 4 * F.lane + 256 * j;
            *(f32x4*)(AV.out + (size_t)m * D + c) = v[j] * rstd * gm[j]; }
    }
}

__device__ __forceinline__ void ph_s5_scan(const Ctx& F) {
    if (F.tid >= 32) return;
    const float* S = (const float*)(F.ws + WS_S5S); f16* SA = (f16*)(F.ws + WS_S5A);
    for (int gt = F.bid * 32 + F.tid; gt < 2 * 2 * 32 * 64; gt += F.G * 32) {
        const int nn = gt & 63, g = (gt >> 6) & 31, d = (gt >> 11) & 1, b = gt >> 12;
        const f32x2 at = ((const f32x2*)(F.ws + WS_S5AT))[(d * 32 + g) * 64 + nn];
        f32x2 st = (f32x2){0.f, 0.f};
        f32x2 la[16], lb[16];
#define S5_CHUNK(step) ((d == 0) ? ((step) < 16 ? 1024 + b * 16 + (step) : b * 512 + ((step) - 16)) : ((step) < 16 ? 1024 + b * 16 + (15 - (step)) : b * 512 + (511 - ((step) - 16))))
#define S5_LOAD(dst, base) do { _Pragma("unroll") for (int u = 0; u < 16; ++u) { const int stp = (base) + u < 528 ? (base) + u : 527; const size_t so = ((size_t)S5_CHUNK(stp) * 32 + g) * 256 + d * 128 + nn; dst[u] = (f32x2){S[so], S[so + 64]}; } } while (0)
#define S5_STEP(src, base) do { PIN8(src[0], src[1], src[2], src[3], src[4], src[5], src[6], src[7]); PIN8(src[8], src[9], src[10], src[11], src[12], src[13], src[14], src[15]); \
            _Pragma("unroll") for (int u = 0; u < 16; ++u) { f16* xp = SA + (size_t)S5_CHUNK((base) + u) * 16384 + (size_t)g * 512 + 256 + d * 128 + nn; xp[0] = (f16)st.x; xp[64] = (f16)st.y; st = cmul(at, st) + src[u]; } } while (0)
        S5_LOAD(la, 0);
        for (int base = 0; base < 528; base += 32) {
            S5_LOAD(lb, base + 16);
            S5_STEP(la, base);
            if (base + 16 < 528) { S5_LOAD(la, base + 32); S5_STEP(lb, base + 16); }
        }
#undef S5_CHUNK
#undef S5_LOAD
#undef S5_STEP
    }
}

__device__ __forceinline__ void ph_ffn_fix(const Ctx& F, const ArgsV& AV, int l, int nMr) {
    const float* HALO = (const float*)(F.ws + WS_HALO); f16* ACT = (f16*)(F.ws + WS_ACT);
    const float* cw = AV.in(I_FFCW) + (size_t)l * 3 * FFH; const float* cb = AV.in(I_FFCB) + (size_t)l * FFH;
    const int NT = nMr * 44 * 2 * 128;
    for (int task = F.bid * 512 + F.tid; task < NT; task += F.G * 512) {
        const int c = task & 127, which = (task >> 7) & 1, tile = task >> 8, pn = tile % 44, pm = tile / 44;
        const float* h = HALO + ((size_t)pm * 44 + pn) * 768 + c; const int col = pn * 128 + c;
        const bool first = (pm == 0 || pm == 32 || pm >= 64), last = (pm == 31 || pm >= 63);
        float ap, ac, an, b;
        if (which == 0) { ap = first ? 0.f : HALO[((size_t)(pm - 1) * 44 + pn) * 768 + 3 * 128 + c]; ac = h[0]; an = h[128]; b = h[4 * 128]; }
        else { ap = h[2 * 128]; ac = h[3 * 128]; an = last ? 0.f : HALO[((size_t)(pm + 1) * 44 + pn) * 768 + c]; b = h[5 * 128]; }
        const float a = cw[col] * ap + cw[FFH + col] * ac + cw[2 * FFH + col] * an + cb[col];
        ACT[(size_t)(pm * 256 + (which ? 255 : 0)) * FFH + col] = (f16)(siluf_(a) * b);
    }
}

namespace gla {
constexpr int QK_LD = 136, KH_LD = 72, VT_LD = 72, P_LD = 72;
constexpr int OFF_QT = 0;
constexpr int OFF_KT = 17408;
constexpr int OFF_VT = OFF_KT + 18432;
constexpr int OFF_P = OFF_VT + 36864;
constexpr int OFF_LR = OFF_P + 9216;
constexpr int OFF_GT = OFF_LR + 4096;
constexpr int OFF_DEC = OFF_GT + 2048;
constexpr int OFF_RS = OFF_DEC + 512;
constexpr int OFF_QR = OFF_RS + 2048;
constexpr int OFF_KR = OFF_QR + 17408;
constexpr int OFF_WG = OFF_KR + 17408;
static_assert(OFF_WG + 8192 <= LDSCTL_OFF, "gla lds");

__device__ __forceinline__ int grow(int b, int sc, int j, int i) {
    if (sc < 32) { const int col = 2 * sc + (j >> 1), r = (j & 1) * 64 + i; return b * SEQ + r * 64 + col; }
    return MX + b * LC + j * 64 + i;
}
__device__ __forceinline__ int prow(int b, int sc, int j, int i) {
    return sc < 32 ? b * SEQ + sc * 256 + j * 64 + i : MX + b * LC + j * 64 + i;
}
#define GLA_MFMA(a, b, c) __builtin_amdgcn_mfma_f32_16x16x32_f16(a, b, c, 0, 0, 0)

template <bool FULL>
__device__ __forceinline__ void gla_unit(const Ctx& F, const ArgsV& AV, int l, int unit) {
    const int b = unit / (4 * NSC), h = (unit / NSC) % 4, sc = unit % NSC;
    LAS f16* QT = (LAS f16*)(F.lds + OFF_QT); LAS f16* KT = (LAS f16*)(F.lds + OFF_KT); LAS f16* VT = (LAS f16*)(F.lds + OFF_VT);
    LAS f16* PP = (LAS f16*)(F.lds + OFF_P); LAS f16* LR = (LAS f16*)(F.lds + OFF_LR);
    LAS float* GT = (LAS float*)(F.lds + OFF_GT); LAS float* DEC = (LAS float*)(F.lds + OFF_DEC); LAS float* RS = (LAS float*)(F.lds + OFF_RS);
    LAS f16* QR = (LAS f16*)(F.lds + OFF_QR); LAS f16* KR = (LAS f16*)(F.lds + OFF_KR); LAS float* WG = (LAS float*)(F.lds + OFF_WG);
    const int tid = F.tid, lane = F.lane, w = F.wave, q0 = lane >> 4, c0 = lane & 15;
    const int dk0 = tid & 127, ig0 = tid >> 7;
    const f16* PX = (const f16*)(F.ws + WS_PX);
    const float scale = 0.08838834764831845f;
    for (int dir = 0; dir < 2; ++dir) {
        __syncthreads();
        for (int i = tid; i < 16 * 128; i += 512) WG[i] = AV.in(I_GLAWG)[(((size_t)l * 2 + dir) * 16 + (i >> 7)) * 512 + h * 128 + (i & 127)];
        const float bgv = AV.in(I_GLABG)[((size_t)l * 2 + dir) * 512 + h * 128 + dk0];
        float wgr[16];
#pragma unroll
        for (int r = 0; r < 16; ++r) wgr[r] = AV.in(I_GLAWG)[(((size_t)l * 2 + dir) * 16 + r) * 512 + h * 128 + dk0];
        const size_t sidx = ((((size_t)b * 4 + h) * NSC + sc) * 2 + dir);
        f32x4 accS[8][2];
        if (FULL && sc < 32) { const float* Sin = (const float*)(F.ws + WS_GSIN) + sidx * 32768; const int q = opq(q0), c = opq(c0);
#pragma unroll
            for (int dt = 0; dt < 8; ++dt)
#pragma unroll
                for (int et = 0; et < 2; ++et)
#pragma unroll
                    for (int r = 0; r < 4; ++r) accS[dt][et][r] = Sin[(16 * dt + 4 * q + r) * 256 + 32 * w + 16 * et + c];
            PIN8(accS[0][0], accS[0][1], accS[1][0], accS[1][1], accS[2][0], accS[2][1], accS[3][0], accS[3][1]); PIN8(accS[4][0], accS[4][1], accS[5][0], accS[5][1], accS[6][0], accS[6][1], accS[7][0], accS[7][1]); }
        else {
#pragma unroll
            for (int dt = 0; dt < 8; ++dt)
#pragma unroll
                for (int et = 0; et < 2; ++et) accS[dt][et] = (f32x4){0.f, 0.f, 0.f, 0.f}; }
        float sumtot = 0.f;
#define GLA_FETCH(jn) f16x8 pf_lr, pf_v[4], pf_k[2], pf_q[2]; do { const int tf = opq(F.tid); \
            { const int row = (tf & 255) >> 2, part = tf & 3; pf_lr = *(const f16x8*)(PX + (size_t)prow(b, sc, (jn), row) * PXLD + P_GG + part * 8); } \
            _Pragma("unroll") for (int k = 0; k < 4; ++k) { const int idx = tf + 512 * k, wi = idx >> 6, ln = idx & 63, rr = ln >> 2, cc = ln & 3; const int row = (wi & 3) * 16 + rr, chunk = (wi >> 2) * 4 + cc; \
                pf_v[k] = *(const f16x8*)(PX + (size_t)prow(b, sc, (jn), row) * PXLD + P_GV + h * 256 + chunk * 8); } \
            _Pragma("unroll") for (int k = 0; k < 2; ++k) { const int idx = tf + 512 * k, row = idx >> 4, ch = idx & 15; const size_t ro = (size_t)prow(b, sc, (jn), row) * PXLD; \
                pf_k[k] = *(const f16x8*)(PX + ro + P_GK + h * 128 + ch * 8); if (FULL) pf_q[k] = *(const f16x8*)(PX + ro + P_GQ + h * 128 + ch * 8); else pf_q[k] = pf_k[k]; } } while (0)
        for (int jj = 0; jj < 4; ++jj) {
            const int j = dir ? 3 - jj : jj;
            if (FULL) {
            GLA_FETCH(j);
            __syncthreads();
            const int tid = opq(F.tid);
            PIN8(pf_lr, pf_v[0], pf_v[1], pf_v[2], pf_v[3], pf_k[0], pf_k[1], pf_q[0]); asm volatile("" : "+v"(pf_q[1]));
            if (tid < 256) { const int row = tid >> 2, part = tid & 3; *(LAS f16x8*)(LR + row * 32 + part * 8) = pf_lr; }
#pragma unroll
            for (int k = 0; k < 4; ++k) { const int idx = opq(tid) + 512 * k, wi = idx >> 6, ln = idx & 63, rr = ln >> 2, cc = ln & 3;
                const int row = (wi & 3) * 16 + rr, chunk = (wi >> 2) * 4 + cc; LAS f16* vp = VT + (chunk * 8) * VT_LD + row;
#pragma unroll
                for (int e = 0; e < 8; ++e) vp[e * VT_LD] = pf_v[k][e]; }
#pragma unroll
            for (int k = 0; k < 2; ++k) { const int idx = tid + 512 * k, row = idx >> 4, ch = idx & 15;
                *(LAS f16x8*)(KR + row * QK_LD + ch * 8) = pf_k[k];
                *(LAS f16x8*)(QR + row * QK_LD + ch * 8) = pf_q[k]; }
            } else {
            __syncthreads();
            const int tid = opq(F.tid);
            if (tid < 256) { const int row = tid >> 2, part = tid & 3; const int gr = prow(b, sc, j, row);
                *(LAS f16x8*)(LR + row * 32 + part * 8) = *(const f16x8*)(PX + (size_t)gr * PXLD + P_GG + part * 8); }
#pragma unroll 1
            for (int k = 0; k < 4; ++k) { const int idx = tid + 512 * k, wi = idx >> 6, ln = idx & 63, rr = ln >> 2, cc = ln & 3;
                const int row = (wi & 3) * 16 + rr, chunk = (wi >> 2) * 4 + cc; const int gr = prow(b, sc, j, row);
                const f16x8 v8 = *(const f16x8*)(PX + (size_t)gr * PXLD + P_GV + h * 256 + chunk * 8);
#pragma unroll
                for (int e = 0; e < 8; ++e) VT[(chunk * 8 + e) * VT_LD + row] = v8[e]; }
#pragma unroll 1
            for (int k = 0; k < 2; ++k) { const int idx = tid + 512 * k, row = idx >> 4, ch = idx & 15; const int gr = prow(b, sc, j, row);
                *(LAS f16x8*)(KR + row * QK_LD + ch * 8) = *(const f16x8*)(PX + (size_t)gr * PXLD + P_GK + h * 128 + ch * 8); }
            }
            __syncthreads();
            const int dk = opq(dk0), ig = opq(ig0);
            float bv[16];
#pragma unroll
            for (int ii = 0; ii < 16; ++ii) { const int i = ig * 16 + ii; float pre = bgv;
                const f16x8 l0 = *(const LAS f16x8*)(LR + i * 32 + dir * 16), l1 = *(const LAS f16x8*)(LR + i * 32 + dir * 16 + 8);
#pragma unroll
                for (int r = 0; r < 8; ++r) pre += (float)l0[r] * wgr[r] + (float)l1[r] * wgr[8 + r];
                bv[ii] = logsigmoidf_(pre) * (1.0f / 16.0f); }
            float totloc;
            if (dir == 0) {
#pragma unroll
                for (int ii = 1; ii < 16; ++ii) bv[ii] += bv[ii - 1];
                totloc = bv[15]; }
            else {
#pragma unroll
                for (int ii = 14; ii >= 0; --ii) bv[ii] += bv[ii + 1];
                totloc = bv[0]; }
            GT[ig * 128 + dk] = totloc;
            __syncthreads();
            const float g0 = GT[dk], g1 = GT[128 + dk], g2 = GT[256 + dk], g3 = GT[384 + dk];
            const float total = (g0 + g1) + (g2 + g3);
            float off, bmid;
            if (dir == 0) { off = (ig > 0 ? g0 : 0.f) + (ig > 1 ? g1 : 0.f) + (ig > 2 ? g2 : 0.f); bmid = g0 + g1; }
            else { off = (ig < 3 ? g3 : 0.f) + (ig < 2 ? g2 : 0.f) + (ig < 1 ? g1 : 0.f); bmid = g2 + g3; }
#pragma unroll
            for (int ii = 0; ii < 16; ++ii) bv[ii] += off;
            if (FULL) {
#pragma unroll
                for (int ii = 0; ii < 16; ++ii) { const int i = ig * 16 + ii;
                    QT[i * QK_LD + dk] = (f16)((float)QR[i * QK_LD + dk] * scale * __expf(fminf(bv[ii] - bmid, 9.f)));
                    KT[i * QK_LD + dk] = (f16)((float)KR[i * QK_LD + dk] * __expf(fminf(bmid - bv[ii], 9.f))); }
                __syncthreads();
                { const int c = opq(c0), q = opq(q0);
#pragma unroll
                for (int s = 0; s < 2; ++s) { const int T = 2 * w + s, it = T >> 2, jt = T & 3; f32x4 a = (f32x4){0.f, 0.f, 0.f, 0.f};
#pragma unroll
                    for (int kk = 0; kk < 4; ++kk) { const f16x8 kf = *(const LAS f16x8*)(KT + (jt * 16 + c) * QK_LD + kk * 32 + 8 * q);
                        const f16x8 qf = *(const LAS f16x8*)(QT + (it * 16 + c) * QK_LD + kk * 32 + 8 * q); a = GLA_MFMA(kf, qf, a); }
                    const int i = it * 16 + c; f16x4 pv;
#pragma unroll
                    for (int r = 0; r < 4; ++r) { const int jx = jt * 16 + 4 * q + r; const bool keep = dir == 0 ? (jx <= i) : (jx >= i); pv[r] = keep ? (f16)a[r] : (f16)0.f; }
                    *(LAS f16x4*)(PP + i * P_LD + jt * 16 + 4 * q) = pv; } }
                __syncthreads();
#pragma unroll
                for (int ii = 0; ii < 16; ++ii) { const int i = ig * 16 + ii; QT[i * QK_LD + dk] = (f16)((float)QR[i * QK_LD + dk] * scale * __expf(bv[ii])); }
            }
            { f16x8 k0, k1;
#pragma unroll
              for (int ii = 0; ii < 8; ++ii) { k0[ii] = (f16)((float)KR[(ig * 16 + ii) * QK_LD + dk] * __expf(total - bv[ii])); k1[ii] = (f16)((float)KR[(ig * 16 + 8 + ii) * QK_LD + dk] * __expf(total - bv[8 + ii])); }
              *(LAS f16x8*)(KT + dk * KH_LD + ig * 16) = k0; *(LAS f16x8*)(KT + dk * KH_LD + ig * 16 + 8) = k1; }
            if (ig == 0) { DEC[dk] = __expf(total); sumtot += total; }
            __syncthreads();
            const int c = opq(c0), q = opq(q0);
            if (FULL) {
                f32x4 accO[4][2];
#pragma unroll
                for (int it = 0; it < 4; ++it)
#pragma unroll
                    for (int et = 0; et < 2; ++et) accO[it][et] = (f32x4){0.f, 0.f, 0.f, 0.f};
#pragma unroll
                for (int et = 0; et < 2; ++et)
#pragma unroll
                    for (int kk = 0; kk < 2; ++kk) { const f16x8 vf = *(const LAS f16x8*)(VT + (32 * w + 16 * et + c) * VT_LD + kk * 32 + 8 * q);
#pragma unroll
                        for (int it = 0; it < 4; ++it) { const f16x8 pf = *(const LAS f16x8*)(PP + (it * 16 + c) * P_LD + kk * 32 + 8 * q); accO[it][et] = GLA_MFMA(vf, pf, accO[it][et]); } asm volatile("" ::: "memory"); }
#pragma unroll
                for (int kb = 0; kb < 4; ++kb)
#pragma unroll
                    for (int et = 0; et < 2; ++et) { f16x8 sf; asm volatile("" ::: "memory");
#pragma unroll
                        for (int e = 0; e < 4; ++e) { sf[e] = (f16)accS[2 * kb][et][e]; sf[4 + e] = (f16)accS[2 * kb + 1][et][e]; }
#pragma unroll
                        for (int it = 0; it < 4; ++it) { const f16x4 lo = *(const LAS f16x4*)(QT + (it * 16 + c) * QK_LD + 32 * kb + 4 * q), hi = *(const LAS f16x4*)(QT + (it * 16 + c) * QK_LD + 32 * kb + 16 + 4 * q);
                            f16x8 qf; qf[0] = lo[0]; qf[1] = lo[1]; qf[2] = lo[2]; qf[3] = lo[3]; qf[4] = hi[0]; qf[5] = hi[1]; qf[6] = hi[2]; qf[7] = hi[3];
                            accO[it][et] = GLA_MFMA(sf, qf, accO[it][et]); } }
                float* OF = (float*)(F.ws + WS_GOF);
                if (dir == 0) {
#pragma unroll
                    for (int it = 0; it < 4; ++it) { const int gr = prow(b, sc, j, it * 16 + c);
#pragma unroll
                        for (int et = 0; et < 2; ++et) *(f32x4*)(OF + (size_t)gr * 1024 + h * 256 + 32 * w + 16 * et + 4 * q) = accO[it][et];
                        asm volatile("" ::: "memory"); } }
                else {
                    int grs[4]; f32x4 ofv[4][2]; f16x4 rvv[4][2];
#pragma unroll
                    for (int it = 0; it < 4; ++it) { grs[it] = prow(b, sc, j, it * 16 + c);
#pragma unroll
                        for (int et = 0; et < 2; ++et) { ofv[it][et] = *(const f32x4*)(OF + (size_t)grs[it] * 1024 + h * 256 + 32 * w + 16 * et + 4 * q);
                            rvv[it][et] = *(const f16x4*)(PX + (size_t)grs[it] * PXLD + P_GR + h * 256 + 32 * w + 16 * et + 4 * q); } }
                    PIN8(ofv[0][0], ofv[0][1], ofv[1][0], ofv[1][1], ofv[2][0], ofv[2][1], ofv[3][0], ofv[3][1]);
#pragma unroll
                    for (int it = 0; it < 4; ++it) { float ss = 0.f;
#pragma unroll
                        for (int et = 0; et < 2; ++et) { accO[it][et] = accO[it][et] + ofv[it][et];
                            ss += (accO[it][et][0] * accO[it][et][0] + accO[it][et][1] * accO[it][et][1]) + (accO[it][et][2] * accO[it][et][2] + accO[it][et][3] * accO[it][et][3]); }
                        ss += __shfl_xor(ss, 16); ss += __shfl_xor(ss, 32);
                        if (q == 0) RS[(it * 16 + c) * 8 + w] = ss; }
                    __syncthreads();
                    PIN8(rvv[0][0], rvv[0][1], rvv[1][0], rvv[1][1], rvv[2][0], rvv[2][1], rvv[3][0], rvv[3][1]);
                    const float* ng = AV.in(I_GLANG) + (size_t)l * 256;
                    f16* Y = (f16*)(F.ws + WS_YCAT);
#pragma unroll
                    for (int it = 0; it < 4; ++it) { const int i = it * 16 + c; const f32x4 ra = *(const LAS f32x4*)(RS + i * 8), rb = *(const LAS f32x4*)(RS + i * 8 + 4);
                        const float tot = ((ra[0] + ra[1]) + (ra[2] + ra[3])) + ((rb[0] + rb[1]) + (rb[2] + rb[3]));
                        const float rstd = 1.0f / sqrtf(tot * (1.0f / 256.0f) + EPS);
#pragma unroll
                        for (int et = 0; et < 2; ++et) { const int e0 = 32 * w + 16 * et + 4 * q;
                            const f32x4 gv = *(const f32x4*)(ng + e0);
                            f16x4 o;
#pragma unroll
                            for (int r = 0; r < 4; ++r) o[r] = (f16)(accO[it][et][r] * rstd * gv[r] * siluf_((float)rvv[it][et][r]));
                            *(f16x4*)(Y + (size_t)grow(b, sc, j, it * 16 + c) * 2048 + 1024 + h * 256 + e0) = o; } }
                }
            }
#pragma unroll
            for (int dt = 0; dt < 8; ++dt) { const f32x4 dv = *(const LAS f32x4*)(DEC + 16 * dt + 4 * q);
#pragma unroll
                for (int et = 0; et < 2; ++et) accS[dt][et] = accS[dt][et] * dv; }
#pragma unroll
            for (int kk = 0; kk < 2; ++kk) { f16x8 vf[2];
#pragma unroll
                for (int et = 0; et < 2; ++et) vf[et] = *(const LAS f16x8*)(VT + (32 * w + 16 * et + c) * VT_LD + kk * 32 + 8 * q);
#pragma unroll
                for (int dt = 0; dt < 8; ++dt) { const f16x8 kf = *(const LAS f16x8*)(KT + (16 * dt + c) * KH_LD + kk * 32 + 8 * q);
#pragma unroll
                    for (int et = 0; et < 2; ++et) accS[dt][et] = GLA_MFMA(kf, vf[et], accS[dt][et]); if (dt & 1) asm volatile("" ::: "memory"); } }
        }
        if (!FULL) { float* Sl = (float*)(F.ws + WS_GSLOC) + sidx * 32768; const int q = opq(q0), c = opq(c0);
#pragma unroll
            for (int dt = 0; dt < 8; ++dt)
#pragma unroll
                for (int et = 0; et < 2; ++et)
#pragma unroll
                    for (int r = 0; r < 4; ++r) Sl[(16 * dt + 4 * q + r) * 256 + 32 * w + 16 * et + c] = accS[dt][et][r];
            if (ig0 == 0) ((float*)(F.ws + WS_GDT))[sidx * 128 + dk0] = __expf(sumtot); }
        VM_WAIT();
    }
}
__device__ __forceinline__ void ph_gla_scan(const Ctx& F) {
    const float* Sl = (const float*)(F.ws + WS_GSLOC); float* Si = (float*)(F.ws + WS_GSIN); const float* Dt = (const float*)(F.ws + WS_GDT);
    if (F.tid < 64) return;
    for (int gt = F.bid * 448 + (F.tid - 64); gt < 2 * 4 * 2 * 32768; gt += F.G * 448) {
        const int e = gt & 32767, dir = (gt >> 15) & 1, h = (gt >> 16) & 3, b = gt >> 18;
        float S = 0.f;
        for (int base = 0; base < NSC; base += 11) {
            float sl[11], dt[11]; size_t ix[11];
#pragma unroll
            for (int u = 0; u < 11; ++u) { const int step = base + u; const int sc = step == 0 ? 32 : (dir == 0 ? step - 1 : 32 - step);
                const size_t idx = ((((size_t)b * 4 + h) * NSC + sc) * 2 + dir); ix[u] = idx;
                sl[u] = Sl[idx * 32768 + e]; dt[u] = Dt[idx * 128 + (e >> 8)]; }
            PIN8(sl[0], sl[1], sl[2], sl[3], sl[4], sl[5], sl[6], sl[7]); PIN8(dt[0], dt[1], dt[2], dt[3], dt[4], dt[5], dt[6], dt[7]); PIN4(sl[8], sl[9], sl[10], dt[8]); asm volatile("" : "+v"(dt[9]), "+v"(dt[10]));
#pragma unroll
            for (int u = 0; u < 11; ++u) { Si[ix[u] * 32768 + e] = S; S = dt[u] * S + sl[u]; }
        }
    }
}
#undef GLA_FETCH
#undef GLA_MFMA
}

namespace hy {
#define PADI(i) ((i) + ((i) >> 5))
constexpr int HY_BUF_BYTES = (16384 + 512) * 8;
constexpr int HY_SCR_OFF = HY_BUF_BYTES;
static_assert(HY_SCR_OFF + 2048 <= LDSCTL_OFF, "hyena lds");
__device__ __forceinline__ f32x2 twid(int k, float invN) { const float xr = (float)k * invN; return (f32x2){__builtin_amdgcn_cosf(xr), -__builtin_amdgcn_sinf(xr)}; }
__device__ __forceinline__ f32x2 mul_w16(f32x2 d, int a) {
    constexpr float c1 = 0.9238795325112867f, s1 = 0.3826834323650898f, r = 0.7071067811865476f;
    float c, s;
    switch (a & 15) {
        case 0: return d; case 4: return (f32x2){d.y, -d.x}; case 8: return (f32x2){-d.x, -d.y}; case 12: return (f32x2){-d.y, d.x};
        case 1: c = c1; s = s1; break; case 2: c = r; s = r; break; case 3: c = s1; s = c1; break;
        case 5: c = -s1; s = c1; break; case 6: c = -r; s = r; break; case 7: c = -c1; s = s1; break;
        case 9: c = -c1; s = -s1; break; case 10: c = -r; s = -r; break; case 11: c = -s1; s = -c1; break;
        case 13: c = s1; s = -c1; break; case 14: c = r; s = -r; break; default: c = c1; s = -s1; break; }
    return (f32x2){d.x * c + d.y * s, d.y * c - d.x * s};
}
template <int R> __device__ __forceinline__ void dif_pass(LAS f32x2* x, int m, int lh, int tid) {
    const int N = 1 << m; const float invN = 1.0f / (float)N; const int lg = lh - R + 1, g = 1 << lg, S = (N >> 1) >> lh;
    for (int q = tid; q < (N >> R); q += 512) { const int j = q & (g - 1), blk = q >> lg, base = (blk << (lh + 1)) + j;
        f32x2 v[1 << R];
#pragma unroll
        for (int k = 0; k < (1 << R); ++k) v[k] = x[PADI(base + k * g)];
        f32x2 w = twid(j * S, invN);
#pragma unroll
        for (int s = 0; s < R; ++s) { const int half = 1 << (R - 1 - s);
#pragma unroll
            for (int k = 0; k < (1 << R); ++k) if (!(k & half)) { const f32x2 a = v[k], b = v[k + half]; v[k] = a + b;
                v[k + half] = mul_w16(cmul(a - b, w), ((k & (half - 1)) << s) * (16 >> R)); }
            w = cmul(w, w); }
#pragma unroll
        for (int k = 0; k < (1 << R); ++k) x[PADI(base + k * g)] = v[k]; }
    __syncthreads();
}
template <int R> __device__ __forceinline__ void dit_pass(LAS f32x2* x, int m, int lh, int tid) {
    const int N = 1 << m; const float invN = 1.0f / (float)N; const int h = 1 << lh, S1 = (N >> 1) >> lh;
    for (int q = tid; q < (N >> R); q += 512) { const int j = q & (h - 1), blk = q >> lh, base = (blk << (lh + R)) + j;
        f32x2 v[1 << R];
#pragma unroll
        for (int k = 0; k < (1 << R); ++k) v[k] = x[PADI(base + k * h)];
        f32x2 wp[R]; wp[R - 1] = cconj(twid(j * (S1 >> (R - 1)), invN));
#pragma unroll
        for (int s = R - 2; s >= 0; --s) wp[s] = cmul(wp[s + 1], wp[s + 1]);
#pragma unroll
        for (int s = 0; s < R; ++s) { const int half = 1 << s;
#pragma unroll
            for (int k = 0; k < (1 << R); ++k) if (!(k & half)) { const f32x2 a = v[k];
                const f32x2 b = mul_w16(cmul(v[k + half], wp[s]), (16 - (k & (half - 1)) * (16 >> (s + 1))) & 15);
                v[k] = a + b; v[k + half] = a - b; } }
#pragma unroll
        for (int k = 0; k < (1 << R); ++k) x[PADI(base + k * h)] = v[k]; }
    __syncthreads();
}
__device__ __forceinline__ void fft_fwd(LAS f32x2* x, int m, int tid) {
    int lh = m - 1;
    while (lh + 1 >= 4) { dif_pass<4>(x, m, lh, tid); lh -= 4; }
    if (lh + 1 == 2) dif_pass<2>(x, m, 1, tid); else if (lh + 1 == 1) dif_pass<1>(x, m, 0, tid);
}
__device__ __forceinline__ void fft_inv(LAS f32x2* x, int m, int tid) {
    int lh = 0;
    while (m - lh >= 4) { dit_pass<4>(x, m, lh, tid); lh += 4; }
    if (m - lh == 2) dit_pass<2>(x, m, lh, tid); else if (m - lh == 1) dit_pass<1>(x, m, lh, tid);
}
__device__ __forceinline__ int brev(int k, int m) { return (int)(__brev((unsigned)k) >> (32 - m)); }

__device__ __forceinline__ void filt_unit(const Ctx& F, const ArgsV& AV, int l, int unit) {
    const int kind = unit >> 9, o = (unit >> 8) & 1, pair = unit & 255;
    const int n = kind ? LC : SEQ, m = kind ? 9 : 14, N = 2 * n, tid = F.tid;
    LAS f32x2* buf = (LAS f32x2*)F.lds;
    LAS float* W3 = (LAS float*)(F.lds + HY_SCR_OFF);
    LAS float* B3 = W3 + 256;
    LAS float* RED = B3 + 4;
    LAS float* INV = RED + 16;
    __syncthreads();
    if (tid < 4) { const int ci = tid; const int col = o * 1024 + (ci >> 1) * 512 + 2 * pair + (ci & 1); B3[ci] = AV.in(I_HYB3)[(size_t)l * 2048 + col]; }
    __syncthreads();
    const int lane = F.lane, q = lane >> 4, c = lane & 15;
    f16x8 wB0, wB1;
    { const int col = o * 1024 + ((c & 3) >> 1) * 512 + 2 * pair + (c & 1); const float* w3 = AV.in(I_HYW3) + (size_t)l * 64 * 2048 + col;
#pragma unroll
      for (int j = 0; j < 8; ++j) { wB0[j] = c < 4 ? (f16)w3[(size_t)(8 * q + j) * 2048] : (f16)0.f; wB1[j] = c < 4 ? (f16)w3[(size_t)(32 + 8 * q + j) * 2048] : (f16)0.f; } }
    const f16* H2H = (const f16*)(F.ws + WS_H2H) + ((size_t)l * (SEQ + LC) + (kind ? SEQ : 0)) * 64;
    const float lo = -3.0701134573253945f, hi = -15.350567286626973f;
    const float ra = fabsf(lo + (hi - lo) * (float)(2 * pair) / 511.0f), rb = fabsf(lo + (hi - lo) * (float)(2 * pair + 1) / 511.0f);
    const float rate = (c & 1) ? rb : ra, bias3 = B3[c & 3];
    float sabs = 0.f;
    for (int tile = F.wave; tile < (n >> 4); tile += 8) { const int t0 = tile * 16;
        const f16x8 a0 = *(const f16x8*)(H2H + (size_t)(t0 + c) * 64 + 8 * q), a1 = *(const f16x8*)(H2H + (size_t)(t0 + c) * 64 + 32 + 8 * q);
        f32x4 acc = (f32x4){0.f, 0.f, 0.f, 0.f};
        acc = __builtin_amdgcn_mfma_f32_16x16x32_f16(a0, wB0, acc, 0, 0, 0); acc = __builtin_amdgcn_mfma_f32_16x16x32_f16(a1, wB1, acc, 0, 0, 0);
        if (c < 4) {
#pragma unroll
            for (int i = 0; i < 4; ++i) { const int t = t0 + 4 * q + i; const float v = (acc[i] + bias3) * expf(-((float)t / (float)(n - 1)) * rate);
                LAS float* bp = (LAS float*)buf;
                if (c < 2) { bp[2 * PADI(t) + c] = v; sabs += fabsf(v); }
                else if (t >= 1) { bp[2 * PADI(N - t) + (c - 2)] = v; sabs += fabsf(v); } } }
    }
    float sa = (c == 0 || c == 2) ? sabs : 0.f, sb = (c == 1 || c == 3) ? sabs : 0.f;
    if (tid == 0) { float z0 = 0.f; asm volatile("" : "+v"(z0)); buf[PADI(n)] = (f32x2){z0, z0}; }
    sa = wave_sum(sa); sb = wave_sum(sb);
    if (F.lane == 0) { RED[F.wave * 2] = sa; RED[F.wave * 2 + 1] = sb; }
    __syncthreads();
    if (tid < 2) { float s = 0.f;
#pragma unroll
        for (int w = 0; w < 8; ++w) s += RED[w * 2 + tid];
        INV[tid] = 1.0f / (s + EPS); }
    __syncthreads();
    { const float ia = INV[0], ib = INV[1];
      for (int i = tid; i < N; i += 512) { f32x2 v = buf[PADI(i)]; v.x *= ia; v.y *= ib; buf[PADI(i)] = v; } }
    __syncthreads();
    fft_fwd(buf, m, tid);
    f32x4* out = (f32x4*)(F.ws + ((l & 1) ? WS_FSD2 : WS_FSD) + (kind ? FSD_C_OFF : 0)) + (size_t)(o * 256 + pair) * (n + 1);
    for (int u = tid; u <= n; u += 512) { const int p = u < n ? 2 * u : 1, k = brev(p, m), pn = brev((N - k) & (N - 1), m);
        const f32x2 zk = buf[PADI(p)], zn = cconj(buf[PADI(pn)]);
        const f32x2 fa = (zk + zn) * 0.5f, df = zk - zn, fb = (f32x2){df.y * 0.5f, -df.x * 0.5f};
        const f32x2 fs = (fa + fb) * 0.5f, fd = (fa - fb) * 0.5f;
        out[u] = (f32x4){fs.x, fs.y, fd.x, fd.y}; }
    __syncthreads();
}

__device__ __forceinline__ void main_unit(const Ctx& F, const ArgsV& AV, int l, int unit) {
    const int kind = unit >> 9, b = (unit >> 8) & 1, pair = unit & 255;
    const int n = kind ? LC : SEQ, m = kind ? 9 : 14, N = 2 * n, tid = F.tid;
    const int row0 = kind ? MX + b * LC : b * SEQ;
    LAS f32x2* buf = (LAS f32x2*)F.lds;
    const f16* ZT = (const f16*)(F.ws + WS_ZT) + (size_t)(2 * pair) * MT + row0;
    const float* cw = AV.in(I_HYCW) + (size_t)l * 3 * 1536 + 2 * pair; const float* cb = AV.in(I_HYCB) + (size_t)l * 1536 + 2 * pair;
    f32x2 yv[16], g1[16], g2[16];
#pragma unroll
    for (int g = 0; g < 3; ++g)
#pragma unroll
        for (int cc = 0; cc < 2; ++cc) { const float w0 = cw[g * 512 + cc], w1 = cw[1536 + g * 512 + cc], w2 = cw[3072 + g * 512 + cc], bs = cb[g * 512 + cc];
            const f16* zt = ZT + (size_t)(g * 512 + cc) * MT;
#pragma unroll
            for (int gi = 0; gi < 2; ++gi) { const int t0 = 8 * (tid + 512 * gi);
                f16x8 mv; float pv = 0.f, nv = 0.f;
#pragma unroll
                for (int e = 0; e < 8; ++e) mv[e] = (f16)0.f;
                if (t0 < n) { mv = *(const f16x8*)(zt + t0); if (t0 > 0) pv = (float)zt[t0 - 1]; if (t0 + 8 < n) nv = (float)zt[t0 + 8]; }
#pragma unroll
                for (int e = 0; e < 8; ++e) { const float zm = e == 0 ? pv : (float)mv[e == 0 ? 0 : e - 1], zc = (float)mv[e], zp = e == 7 ? nv : (float)mv[e == 7 ? 7 : e + 1];
                    const float r = w0 * zm + w1 * zc + w2 * zp + bs;
                    if (g == 0) { if (cc == 0) yv[gi * 8 + e].x = r; else yv[gi * 8 + e].y = r; }
                    else if (g == 1) { if (cc == 0) g1[gi * 8 + e].x = r; else g1[gi * 8 + e].y = r; }
                    else { if (cc == 0) g2[gi * 8 + e].x = r; else g2[gi * 8 + e].y = r; } } } }
    const float invN = 1.0f / (float)N;
#pragma unroll
    for (int o = 0; o < 2; ++o) {
        __syncthreads();
        float z0 = 0.f; asm volatile("" : "+v"(z0));
#pragma unroll
        for (int gi = 0; gi < 2; ++gi) { const int t0 = 8 * (tid + 512 * gi);
            if (t0 < n) {
#pragma unroll
                for (int e = 0; e < 8; ++e) { buf[PADI(t0 + e)] = yv[gi * 8 + e]; buf[PADI(n + t0 + e)] = (f32x2){z0, z0}; } } }
        __syncthreads();
        fft_fwd(buf, m, tid);
        const f32x4* fsd = (const f32x4*)(F.ws + ((l & 1) ? WS_FSD2 : WS_FSD) + (kind ? FSD_C_OFF : 0)) + (size_t)(o * 256 + pair) * (n + 1);
        for (int u = tid; u <= n; u += 512) { const int p = u < n ? 2 * u : 1, k = brev(p, m), pn = brev((N - k) & (N - 1), m);
            const f32x2 zk = buf[PADI(p)], zn = buf[PADI(pn)]; const f32x4 f = fsd[u]; const f32x2 fs = (f32x2){f[0], f[1]}, fd = (f32x2){f[2], f[3]};
            const f32x2 wk = cmul(zk, fs) + cmul(cconj(zn), fd), wn = cmul(zn, cconj(fs)) + cmul(cconj(zk), cconj(fd));
            buf[PADI(pn)] = wn; buf[PADI(p)] = wk; }
        __syncthreads();
        fft_inv(buf, m, tid);
        const float* hb = AV.in(I_HYBIAS) + ((size_t)l * 2 + o) * 512 + 2 * pair; const f32x2 bias = (f32x2){hb[0], hb[1]};
#pragma unroll
        for (int gi = 0; gi < 2; ++gi) { const int t0 = 8 * (tid + 512 * gi);
            if (t0 < n) {
#pragma unroll
                for (int e = 0; e < 8; ++e) { const f32x2 cv = buf[PADI(t0 + e)] * invN; const f32x2 gt = o == 0 ? g1[gi * 8 + e] : g2[gi * 8 + e];
                    yv[gi * 8 + e] = gt * (cv + yv[gi * 8 + e] * bias); } } }
    }
    f16* Y = (f16*)(F.ws + WS_YBT) + (size_t)(2 * pair) * MT + row0;
#pragma unroll
    for (int gi = 0; gi < 2; ++gi) { const int t0 = 8 * (tid + 512 * gi);
        if (t0 < n) { f16x8 oa, ob;
#pragma unroll
            for (int e = 0; e < 8; ++e) { oa[e] = (f16)yv[gi * 8 + e].x; ob[e] = (f16)yv[gi * 8 + e].y; }
            *(f16x8*)(Y + t0) = oa; *(f16x8*)(Y + MT + t0) = ob; } }
    __syncthreads();
}

__device__ __forceinline__ void ph_ybt_transpose(const Ctx& F) {
    LAS f16* T = (LAS f16*)F.lds;
    const f16* YBT = (const f16*)(F.ws + WS_YBT); f16* Y = (f16*)(F.ws + WS_YCAT);
    const bool bal = (F.G == 256);
    for (int it = 0; it < (bal ? 2 : (MT / 64 + F.G - 1) / F.G); ++it) {
        int rb;
        if (bal) { if (F.bid >= 132) rb = (F.bid - 132) + 124 * it; else if (F.bid < 16 && it == 0) rb = 248 + F.bid; else rb = -1; }
        else rb = F.bid + it * F.G;
        if (rb < 0 || rb >= MT / 64) continue;
        const int r0 = rb * 64;
        __syncthreads();
        { f16x8 tv[8];
#pragma unroll
          for (int i = 0; i < 8; ++i) tv[i] = *(const f16x8*)(YBT + (size_t)F.tid * MT + r0 + 8 * i);
          PIN8(tv[0], tv[1], tv[2], tv[3], tv[4], tv[5], tv[6], tv[7]);
#pragma unroll
          for (int i = 0; i < 8; ++i) *(LAS f16x8*)(T + F.tid * 72 + 8 * i) = tv[i]; }
        __syncthreads();
        const int row = F.tid >> 3, cg = F.tid & 7;
#pragma unroll
        for (int jj = 0; jj < 8; ++jj) { const int gidx = cg + 8 * jj; f16x8 o;
#pragma unroll
            for (int e = 0; e < 8; ++e) o[e] = T[(8 * gidx + e) * 72 + row];
            *(f16x8*)(Y + (size_t)(r0 + row) * 2048 + 512 + 8 * gidx) = o; }
    }
    __syncthreads();
}
#undef PADI
}

#ifndef PHMASK
#define PHMASK 0xFFFF
#endif
#define PH_EN(k) (((PHMASK) >> (k)) & 1)
#ifndef STAMP_MASK
#define STAMP_MASK 0
#endif
#ifndef STAMP_K
#define STAMP_K 1
#endif
#ifndef SUBMASK
#define SUBMASK 7
#endif
#define SUB_EN(k) (((SUBMASK) >> (k)) & 1)
constexpr int NPH = 2 + 12 * DEPTH;
constexpr int CW_Q = 8192;
__device__ __forceinline__ int q_pull(unsigned* ctr, volatile LAS int* slot) {
    __syncthreads();
    if (threadIdx.x == 0) *slot = (int)__hip_atomic_fetch_add(ctr, 1u, __ATOMIC_RELAXED, __HIP_MEMORY_SCOPE_AGENT);
    __syncthreads();
    return *slot;
}

__global__ void __launch_bounds__(512, 2) mk_fwd(Args args) {
    extern __shared__ __attribute__((aligned(16))) unsigned char lds_raw[];
    Ctx F; F.lds = (LAS unsigned char*)lds_raw; F.tid = threadIdx.x; F.lane = F.tid & 63; F.wave = __builtin_amdgcn_readfirstlane(F.tid >> 6);
    F.G = gridDim.x; F.bid = blockIdx.x; F.ws = args.ws;
    ArgsV AV; AV.out = args.out;
    const Ctx F0 = F;
#define FRESH() do { F.tid = opq(F0.tid); F.lane = F.tid & 63; F.wave = __builtin_amdgcn_readfirstlane(F.tid >> 6); } while (0)
    volatile LAS unsigned* MISC = (volatile LAS unsigned*)(F.lds + LDSCTL_OFF);
    if (F.tid < 64) MISC[F.tid] = 0u;
    __syncthreads();
    unsigned* barw = (unsigned*)(F.ws + WS_CTL) + CW_BAR;
    XcdBarrier bar; bar.bar = barw; bar.x = 0; bar.st = nullptr;
    const int lo = args.ph_lo, hi = args.ph_hi;
    if (hi - lo > 1) bar = xcd_barrier_post(barw, MISC + 8);
#define IN(k) (lo <= (k) && (k) < hi)
#define SEAM(k) do { if (IN(k) && IN((k) + 1)) xcd_barrier(bar); } while (0)
#if STAMP_MASK
    volatile LAS unsigned long long* TS = (volatile LAS unsigned long long*)(F.lds + LDSCTL_OFF + 128);
#define TSTART(k) do { if ((((STAMP_MASK) >> (k)) & 1) && blockIdx.x == 0 && threadIdx.x == 0) TS[0] = __builtin_amdgcn_s_memrealtime(); } while (0)
#define TSTOP(k) do { if ((((STAMP_MASK) >> (k)) & 1) && blockIdx.x == 0 && threadIdx.x == 0) TS[1] = TS[1] + (__builtin_amdgcn_s_memrealtime() - TS[0]); } while (0)
#else
#define TSTART(k) do {} while (0)
#define TSTOP(k) do {} while (0)
#endif
    unsigned char* ws = F.ws;
    const int rank160 = (F.bid + F.G - 160 % F.G) % F.G;

    TSTART(12);
    if (PH_EN(12) && IN(0)) { FRESH(); ph_prologue(F, AV); for (int l2 = 0; l2 < DEPTH; ++l2) { FRESH(); ph_hyena_h2(F, AV, l2); } }
    SEAM(0);
    TSTOP(12);

    for (int l = 0; l < DEPTH; ++l) {
        const int pb = 1 + 12 * l;
        const float* modl = (const float*)(ws + WS_MOD) + (size_t)l * 3 * 12288;
        const bool ctx_on = l < DEPTH - 1;
        const int nMr = ctx_on ? MT / 256 : MX / 256, nrows = ctx_on ? MT : MX;
        TSTART(0);
        if (PH_EN(0) && IN(pb + 0)) {
            FRESH(); ph_convert_weights(F, AV, l);
            __syncthreads();
            FRESH(); if (F.bid < 32) s5_mats_group(F, AV, l, F.bid);
            FRESH(); ph_norm(F, AV, l, 0, MT, l > 0 ? 11 : 0);
        }
        SEAM(pb + 0);
        TSTOP(0);
        TSTART(1);
        if (PH_EN(1) && IN(pb + 1)) {
            pg8::SchedPlain S; S.init(MT / 256, WINN / 256, F.G, F.bid); S.A = (const char*)(ws + WS_HN); S.B = (const char*)(ws + WS_WIN); S.aTile = (size_t)256 * 2048 * 2; S.bTile = (size_t)256 * 2048 * 2;
            pg8::EpiPx E{(f16*)(ws + WS_PX), (f16*)(ws + WS_S5A), (f16*)(ws + WS_ZT), (f16*)(ws + WS_GTL)};
            pg8::gemm_phase(F.lds, 2048, 2048, 32, S, E);
        }
        SEAM(pb + 1);
        TSTOP(1);
        TSTART(2);
        if (PH_EN(2) && IN(pb + 2)) {
            TSTART(16);
            if (SUB_EN(0)) { pg8::SchedS5 S{(const char*)(ws + WS_S5A), (const char*)(ws + WS_S5M), (size_t)256 * 256 * 2, F.G, F.bid};
              pg8::EpiS5In E{(float*)(ws + WS_S5S)};
              pg8::gemm_phase(F.lds, 16384, 256, 4, S, E); }
            TSTOP(16);
            { unsigned* qc = (unsigned*)(ws + WS_CTL) + CW_Q + (l * 2 + 0) * 64; volatile LAS int* slot = (volatile LAS int*)(MISC + 16);
              const bool pre = (l > 0 && F.G == 256);
              const int nq = 264 + (pre ? 272 : 1024);
              for (;;) { const int u = q_pull(qc, slot); if (u >= nq) break;
                  if (u < 264) { TSTART(17); FRESH(); gla::gla_unit<false>(F, AV, l, u); TSTOP(17); } else { TSTART(18); FRESH(); hy::filt_unit(F, AV, l, pre ? 240 + (u - 264) : u - 264); TSTOP(18); } } }
        }
        SEAM(pb + 2);
        TSTOP(2);
        TSTART(3);
        if (PH_EN(3) && IN(pb + 3)) { FRESH(); ph_s5_scan(F); FRESH(); gla::ph_gla_scan(F); }
        SEAM(pb + 3);
        TSTOP(3);
        TSTART(4);
        if (PH_EN(4) && IN(pb + 4)) {
            TSTART(19);
            if (SUB_EN(0)) { pg8::SchedS5 S{(const char*)(ws + WS_S5A), (const char*)(ws + WS_S5W), (size_t)256 * 512 * 2, F.G, F.bid};
              pg8::EpiS5Out E{(const f16*)(ws + WS_S5A), (f16*)(ws + WS_YAPRE), AV.in(I_S5D) + (size_t)l * 512};
              pg8::gemm_phase(F.lds, 16384, 512, 8, S, E); }
            TSTOP(19);
            { unsigned* qc = (unsigned*)(ws + WS_CTL) + CW_Q + (l * 2 + 1) * 64; volatile LAS int* slot = (volatile LAS int*)(MISC + 16);
              for (;;) { const int u = q_pull(qc, slot); if (u >= 264 + 1024) break;
                  if (u < 264) { TSTART(20); FRESH(); gla::gla_unit<true>(F, AV, l, u); TSTOP(20); } else { TSTART(21); FRESH(); hy::main_unit(F, AV, l, u - 264); TSTOP(21); } } }
        }
        SEAM(pb + 4);
        TSTOP(4);
        TSTART(5);
        if (PH_EN(5) && IN(pb + 5)) {
            pg8::SchedPlain S; S.init(nMr, 2, F.G, F.bid); S.A = (const char*)(ws + WS_YAPRE); S.B = (const char*)(ws + WS_WGLU); S.aTile = (size_t)256 * 512 * 2; S.bTile = (size_t)256 * 512 * 2;
            pg8::EpiGlu E{(const f16*)(ws + WS_YAPRE), (f16*)(ws + WS_YCAT), AV.in(I_GLUB) + (size_t)l * 512};
            pg8::gemm_phase(F.lds, 512, 512, 8, S, E);
            FRESH(); hy::ph_ybt_transpose(F);
        }
        SEAM(pb + 5);
        TSTOP(5);
        TSTART(6);
        if (PH_EN(6) && IN(pb + 6)) {
            pg8::SchedPlain S; S.init(nMr, 8, F.G, F.bid); S.aTile = (size_t)256 * 2048 * 2; S.bTile = (size_t)256 * 2048 * 2;
            S.A = (const char*)(ws + WS_YCAT); S.B = (const char*)(ws + WS_WBR);
            pg8::EpiBranchF E{(const f16*)(ws + WS_GTL), (f16*)(ws + WS_MBUF)};
            pg8::gemm_phase(F.lds, 2048, 2048, 32, S, E);
            if (l + 1 < DEPTH && F.G == 256) { unsigned* qc = (unsigned*)(ws + WS_CTL) + CW_Q + 1024 + l * 64; volatile LAS int* slot = (volatile LAS int*)(MISC + 16);
              for (;;) { if (F.bid < 16) break; const int u = q_pull(qc, slot); if (u >= 240) break; FRESH(); hy::filt_unit(F, AV, l + 1, u); } }
#ifdef PG_DUMMY
            { pg8::EpiF16 E9{(f16*)(ws + WS_ACT), 2048}; pg8::gemm_phase(F.lds, 2048, 2048, 32, S, E9); }
#endif
        }
        SEAM(pb + 6);
        TSTOP(6);
        TSTART(7);
        if (PH_EN(7) && IN(pb + 7)) {
            pg8::SchedPlain S; S.init(MX / 256, 8, F.G, F.bid); S.A = (const char*)(ws + WS_MBUF); S.B = (const char*)(ws + WS_WOUT); S.aTile = (size_t)256 * 2048 * 2; S.bTile = (size_t)256 * 2048 * 2;
            pg8::EpiResid E{(float*)(ws + WS_XRES), modl, 4096, l == 0 ? AV.in(I_X) : (const float*)(ws + WS_XRES)};
            pg8::gemm_phase(F.lds, 2048, 2048, 32, S, E);
            if (ctx_on) { pg8::SchedSplit S2{(const char*)(ws + WS_MBUF), (const char*)(ws + WS_WOUT), (size_t)256 * 2048 * 2, (size_t)256 * 2048 * 2, (size_t)8 * 128, 4, F.G, F.bid};
                pg8::EpiSlab E2{(float*)(ws + WS_SLAB), modl, 4096};
                pg8::gemm_phase(F.lds, 2048, 2048, 8, S2, E2); }
            if (l + 1 < DEPTH && F.G == 256) { unsigned* qc = (unsigned*)(ws + WS_CTL) + CW_Q + 1024 + l * 64 + 32; volatile LAS int* slot = (volatile LAS int*)(MISC + 16);
              for (;;) { const int u = q_pull(qc, slot); if (u >= 512) break; FRESH(); hy::filt_unit(F, AV, l + 1, 512 + u); } }
        }
        SEAM(pb + 7);
        TSTOP(7);
        TSTART(8);
        if (PH_EN(8) && IN(pb + 8)) { FRESH(); ph_norm(F, AV, l, 1, nrows, 4); }
        SEAM(pb + 8);
        TSTOP(8);
        TSTART(9);
        if (PH_EN(9) && IN(pb + 9)) {
            pg8::SchedPlain S; S.init(nMr, UPLD / 256, F.G, F.bid); S.A = (const char*)(ws + WS_HN); S.B = (const char*)(ws + WS_WUP); S.aTile = (size_t)256 * 2048 * 2; S.bTile = (size_t)256 * 2048 * 2;
            pg8::EpiUpAct E{(f16*)(ws + WS_ACT), (float*)(ws + WS_HALO), AV.in(I_FFCW) + (size_t)l * 3 * FFH, AV.in(I_FFCB) + (size_t)l * FFH, (LAS float*)(F.lds + EXTRA_OFF)};
            pg8::gemm_phase(F.lds, 2048, 2048, 32, S, E);
        }
        SEAM(pb + 9);
        TSTOP(9);
        TSTART(10);
        if (PH_EN(10) && IN(pb + 10)) { FRESH(); ph_ffn_fix(F, AV, l, nMr); }
        SEAM(pb + 10);
        TSTOP(10);
        TSTART(11);
        if (PH_EN(11) && IN(pb + 11)) {
            pg8::SchedPlain S; S.init(MX / 256, 8, F.G, F.bid); S.A = (const char*)(ws + WS_ACT); S.B = (const char*)(ws + WS_WDN); S.aTile = (size_t)256 * FFH * 2; S.bTile = (size_t)256 * FFH * 2;
            pg8::EpiResid E{(float*)(ws + WS_XRES), modl, 10240, (const float*)(ws + WS_XRES)};
            pg8::gemm_phase(F.lds, FFH, FFH, FFH / 64, S, E);
            if (ctx_on) { pg8::SchedSplit S2{(const char*)(ws + WS_ACT), (const char*)(ws + WS_WDN), (size_t)256 * FFH * 2, (size_t)256 * FFH * 2, (size_t)8 * 128, 11, F.G, F.bid};
                pg8::EpiSlab E2{(float*)(ws + WS_SLAB), modl, 10240};
                pg8::gemm_phase(F.lds, FFH, FFH, 8, S2, E2); }
        }
        SEAM(pb + 11);
        TSTOP(11);
    }
    if (PH_EN(13) && IN(NPH - 1)) { FRESH(); ph_final_norm(F, AV); }
#if STAMP_MASK
    if (blockIdx.x == 0 && threadIdx.x == 0) { const unsigned long long t0 = __builtin_amdgcn_s_memrealtime(); while (__builtin_amdgcn_s_memrealtime() - t0 < (unsigned long long)(STAMP_K) * TS[1]) __builtin_amdgcn_s_sleep(8); }
#endif
#undef IN
#undef SEAM
#undef FRESH
}

extern "C" void kernel_launch(void* const* d_in, const int* in_sizes, int n_in, void* d_out, int out_size, void* d_ws, size_t ws_size, hipStream_t stream) {
    static int grid = 0;
    if (grid == 0) {
        if (n_in != 40 || out_size != MX * D || ws_size < WS_END) { fprintf(stderr, "kernel_launch: unexpected problem (n_in %d out %d ws %zu, need %zu)\n", n_in, out_size, ws_size, (size_t)WS_END); grid = -1; return; }
        int dev = 0, cus = 0, per_cu = 0;
        if (hipGetDevice(&dev) != hipSuccess || hipDeviceGetAttribute(&cus, hipDeviceAttributeMultiprocessorCount, dev) != hipSuccess) { grid = -1; return; }
        if (hipFuncSetAttribute((const void*)mk_fwd, hipFuncAttributeMaxDynamicSharedMemorySize, LDS_BYTES) != hipSuccess) { fprintf(stderr, "kernel_launch: hipFuncSetAttribute failed\n"); grid = -1; return; }
        if (hipOccupancyMaxActiveBlocksPerMultiprocessor(&per_cu, (const void*)mk_fwd, 512, LDS_BYTES) != hipSuccess || per_cu < 1)
            fprintf(stderr, "kernel_launch: occupancy query reports %d\n", per_cu);
        (void)hipGetLastError();
        grid = cus;
    }
    if (grid < 0) return;
    if (hipMemsetAsync((char*)d_ws + WS_CTL, 0, CTL_ZERO_BYTES, stream) != hipSuccess) return;
    Args a{};
    for (int i = 0; i < 40; ++i) a.in[i] = (const float*)d_in[i];
    a.out = (float*)d_out; a.ws = (unsigned char*)d_ws;
#if MK_ONE
    a.ph_lo = 0; a.ph_hi = NPH;
    hipLaunchKernelGGL(mk_fwd, dim3(grid), dim3(512), LDS_BYTES, stream, a);
#else
    for (int p = 0; p < NPH; ++p) { a.ph_lo = p; a.ph_hi = p + 1; hipLaunchKernelGGL(mk_fwd, dim3(grid), dim3(512), LDS_BYTES, stream, a); }
#endif
}
```

```cpp
#include <hip/hip_runtime.h>
#include <stdio.h>

#ifndef MK_ONE
#define MK_ONE 1
#define STAMP_MASK 0
#define STAMP_K 1
#define STAMP_BID 0
#endif

#define GAS __attribute__((address_space(1)))
#define LAS __attribute__((address_space(3)))
typedef _Float16 f16;
typedef _Float16 f16x8 __attribute__((ext_vector_type(8)));
typedef _Float16 f16x4 __attribute__((ext_vector_type(4)));
typedef _Float16 f16x2 __attribute__((ext_vector_type(2)));
typedef float f32x4 __attribute__((ext_vector_type(4)));
typedef float f32x2 __attribute__((ext_vector_type(2)));

constexpr int D = 2048, NB = 2, SEQ = 8192, LC = 256, DEPTH = 4;
constexpr int MX = NB * SEQ, MC = NB * LC, MT = MX + MC;
constexpr int PXLD = 3840, WINN = 11520, FFH = 5632, UPLD = 2 * FFH;
constexpr int P_S5 = 0, P_GK = 512, P_GV = 1024, P_GQ = 2048, P_GR = 2560, P_HY = 3584, P_MG = 5120, P_GG = 3584, W_GG = 11264;
constexpr int INW = 11296;
constexpr int NCHK = 1056;
constexpr float S5SCALE = 1024.f;
constexpr float EPS = 1e-6f;
constexpr int NSC = 33;

constexpr size_t MiB = 1u << 20;
constexpr size_t WS_CTL = 0, CTL_ZERO_BYTES = 1 * MiB;
constexpr size_t WS_MOD = 1 * MiB;
constexpr size_t WS_TW = 2 * MiB;
constexpr size_t WS_S5AT = 3 * MiB;
constexpr size_t WS_WIN = 4 * MiB;
constexpr size_t WS_WGLU = WS_WIN + 45 * MiB;
constexpr size_t WS_WBR = WS_WGLU + 1 * MiB;
constexpr size_t WS_WOUT = WS_WBR + 8 * MiB;
constexpr size_t WS_WUP = WS_WOUT + 8 * MiB;
constexpr size_t WS_WDN = WS_WUP + 44 * MiB;
constexpr size_t WS_S5W = WS_WDN + 22 * MiB;
constexpr size_t WS_S5M = WS_S5W + 8 * MiB;
constexpr size_t WS_H2 = WS_S5M + 4 * MiB;
constexpr size_t WS_FSD = WS_H2 + 3 * MiB;
constexpr size_t FSD_C_OFF = (size_t)2 * 256 * 8193 * 16;
constexpr size_t WS_XRES = WS_FSD + 68 * MiB;
constexpr size_t WS_HN = WS_XRES + 132 * MiB;
constexpr size_t WS_PX = WS_HN + 66 * MiB;
constexpr size_t WS_S5A = WS_PX + 372 * MiB;
constexpr size_t WS_S5S = WS_S5A + 40 * MiB;
constexpr size_t WS_YAPRE = WS_S5S + 40 * MiB;
constexpr size_t WS_YCAT = WS_YAPRE + 20 * MiB;
constexpr size_t WS_MBUF = WS_YCAT + 66 * MiB;
constexpr size_t WS_GSLOC = WS_MBUF + 66 * MiB;
constexpr size_t WS_GSIN = WS_GSLOC + 66 * MiB;
constexpr size_t WS_GOF = WS_GSIN + 66 * MiB;
constexpr size_t WS_GDT = WS_GOF + 66 * MiB;
constexpr size_t WS_ACT = WS_GSLOC;
constexpr size_t WS_ZT = WS_GDT + 1 * MiB;
constexpr size_t WS_YBT = WS_ZT + 50 * MiB;
constexpr size_t WS_SLAB = WS_YBT + 17 * MiB;
constexpr size_t WS_HALO = WS_SLAB + 44 * MiB;
constexpr size_t WS_GTL = WS_HALO + 9 * MiB;
constexpr size_t WS_END = WS_GTL + 198 * MiB;
constexpr size_t WS_FSD2 = WS_PX + 124 * MiB;
constexpr size_t WS_W2 = WS_FSD2 + 68 * MiB;
constexpr size_t WS_H2H = WS_W2 + 128 * MiB;
static_assert(WS_H2H + 5 * MiB <= WS_PX + 372 * MiB, "PX tail");
static_assert((size_t)MT * FFH * 2 <= 198 * MiB, "ACT overlay");
constexpr int CW_BAR = 4096;

constexpr int RING_BYTES = 131072;
constexpr int EXTRA_OFF = RING_BYTES, EXTRA_BYTES = 8192;
constexpr int LDSCTL_OFF = EXTRA_OFF + EXTRA_BYTES;
constexpr int LDS_BYTES = LDSCTL_OFF + 256;

__device__ __forceinline__ float wave_sum(float v) {
#pragma unroll
    for (int o = 1; o < 64; o <<= 1) v += __shfl_xor(v, o);
    return v;
}
__device__ __forceinline__ float sigmoidf_(float x) { return 1.0f / (1.0f + __expf(-x)); }
__device__ __forceinline__ float siluf_(float x) { return x * sigmoidf_(x); }
__device__ __forceinline__ float gelu_tanh_(float x) { const float u = 0.7978845608028654f * (x + 0.044715f * x * x * x); return x / (1.0f + __expf(-2.0f * u)); }
__device__ __forceinline__ float logsigmoidf_(float x) { return fminf(x, 0.f) - __logf(1.0f + __expf(-fabsf(x))); }
__device__ __forceinline__ f32x2 cmul(f32x2 a, f32x2 b) { return (f32x2){a.x * b.x - a.y * b.y, a.x * b.y + a.y * b.x}; }
__device__ __forceinline__ f32x2 cconj(f32x2 a) { return (f32x2){a.x, -a.y}; }
__device__ __forceinline__ int opq(int x) { asm volatile("" : "+v"(x)); return x; }
#define PIN8(a, b, c, d, e, f, g, h) asm volatile("" : "+v"(a), "+v"(b), "+v"(c), "+v"(d), "+v"(e), "+v"(f), "+v"(g), "+v"(h))
#define PIN4(a, b, c, d) asm volatile("" : "+v"(a), "+v"(b), "+v"(c), "+v"(d))
#ifndef OPBITS_DROP
#define OPBITS_DROP 3
#endif
__device__ __forceinline__ f16 lowtog(f16 h) { unsigned short u = __builtin_bit_cast(unsigned short, h); constexpr unsigned short M = (unsigned short)((1u << OPBITS_DROP) - 1u);
    u = (unsigned short)((u + (M >> 1) + ((u >> OPBITS_DROP) & 1u)) & (unsigned short)~M); return __builtin_bit_cast(f16, u); }
#define LDS_WAIT() asm volatile("s_waitcnt lgkmcnt(0)" ::: "memory")
#define VM_WAIT() asm volatile("s_waitcnt vmcnt(0)" ::: "memory")

#define XB_TMO      128
#define XB_XCNT(j)  (256  + 64 * (j))
#define XB_XSUB(j)  (1280 + 64 * (j))
#define XB_XGEN(j)  (2304 + 64 * (j))
#define XB_TOP      3328
#define XB_TOPGEN   3392
#define XCD_BAR_WORDS 3456
#define XB_SPIN_CAP (1u << 18)
__device__ __forceinline__ unsigned xb_ld(unsigned* p)              { return __hip_atomic_load(p, __ATOMIC_RELAXED, __HIP_MEMORY_SCOPE_AGENT); }
__device__ __forceinline__ unsigned xb_add(unsigned* p, unsigned v) { return __hip_atomic_fetch_add(p, v, __ATOMIC_RELAXED, __HIP_MEMORY_SCOPE_AGENT); }
__device__ __forceinline__ unsigned xb_xcc_id() { return (unsigned)__builtin_amdgcn_s_getreg((3 << 11) | 20) & 0xFu; }
#define XB_SPIN(cond, bar) do { unsigned _sp = 0; while (cond) { __builtin_amdgcn_s_sleep(1); \
    if ((++_sp & 255u) == 0u) { if (xb_ld(&(bar)[XB_TMO])) break; if (_sp > XB_SPIN_CAP) { atomicAdd(&(bar)[XB_TMO], 1u); break; } } } } while (0)
struct XcdBarrier { unsigned* bar; unsigned x; volatile LAS unsigned* st; };
__device__ __forceinline__ XcdBarrier xcd_barrier_post(unsigned* bar, volatile LAS unsigned* st) {
    XcdBarrier b; b.bar = bar; b.x = xb_xcc_id(); b.st = st;
    if (threadIdx.x == 0) (void)xb_add(&bar[XB_XCNT(b.x)], 1u);
    return b;
}
__device__ __forceinline__ void xcd_barrier_complete(unsigned* bar, unsigned x, unsigned& nloc, unsigned& nx) {
    const unsigned G = gridDim.x * gridDim.y * gridDim.z;
    unsigned sum, cnt, mine, sp = 0u;
    for (;;) {
        sum = 0u; cnt = 0u; mine = 0u;
#pragma unroll
        for (unsigned j = 0; j < 16; ++j) { const unsigned c = xb_ld(&bar[XB_XCNT(j)]); sum += c; cnt += (c > 0u) ? 1u : 0u; mine = (j == x) ? c : mine; }
        if (sum == G) break;
        __builtin_amdgcn_s_sleep(1);
        if ((++sp & 255u) == 0u) { if (xb_ld(&bar[XB_TMO])) break; if (sp > XB_SPIN_CAP) { atomicAdd(&bar[XB_TMO], 1u); break; } }
    }
    nloc = mine > 0u ? mine : 1u; nx = cnt > 0u ? cnt : 1u;
}
__device__ __forceinline__ void xcd_barrier(const XcdBarrier& b) {
    asm volatile("s_waitcnt vmcnt(0)" ::: "memory");
    __syncthreads();
    if (threadIdx.x == 0) {
        unsigned* bar = b.bar;
        __builtin_amdgcn_s_waitcnt(0);
        unsigned nloc = b.st[0], nx = b.st[1];
        if (nloc == 0u) { xcd_barrier_complete(bar, b.x, nloc, nx); b.st[0] = nloc; b.st[1] = nx; }
        const unsigned old = xb_add(&bar[XB_XSUB(b.x)], 1u);
        const unsigned gen = old / nloc;
        if (old + 1u == (gen + 1u) * nloc) {
            __builtin_amdgcn_fence(__ATOMIC_RELEASE, "agent");
            asm volatile("s_waitcnt vmcnt(0)" ::: "memory");
            const unsigned og = xb_add(&bar[XB_TOP], 1u);
            const unsigned tg = og / nx;
            if (og + 1u == (tg + 1u) * nx) xb_add(&bar[XB_TOPGEN], 1u);
            else XB_SPIN(xb_ld(&bar[XB_TOPGEN]) == tg, bar);
            __builtin_amdgcn_fence(__ATOMIC_ACQUIRE, "agent");
            xb_add(&bar[XB_XGEN(b.x)], 1u);
            asm volatile("s_waitcnt vmcnt(0)" ::: "memory");
        } else {
            XB_SPIN(xb_ld(&bar[XB_XGEN(b.x)]) == gen, bar);
            __builtin_amdgcn_fence(__ATOMIC_ACQUIRE, "agent");
            asm volatile("s_waitcnt vmcnt(0)" ::: "memory");
        }
    }
    __syncthreads();
}

struct Args {
    const float* in[40];
    float* out; unsigned char* ws;
    int ph_lo, ph_hi;
};
struct ArgsV {
    __device__ __forceinline__ const float* in(int i) const {
        typedef const __attribute__((address_space(4))) unsigned long long* kp_t;
        kp_t ka = (kp_t)__builtin_amdgcn_kernarg_segment_ptr();
        return (const float*)(*(volatile const __attribute__((address_space(4))) unsigned long long*)(ka + i)); }
    float* out;
};
struct Ctx {
    LAS unsigned char* lds;
    int tid, lane, wave, G, bid;
    unsigned char* ws;
};
enum { I_X = 0, I_C, I_CTX, I_CCTX, I_WMOD, I_BMOD, I_N1G, I_N2G, I_WIN, I_S5ARE, I_S5AIM, I_S5STEP, I_S5BRE, I_S5BIM, I_S5CRE, I_S5CIM,
       I_S5D, I_GLUW, I_GLUB, I_HYCW, I_HYCB, I_HYW1, I_HYB1, I_HYF1, I_HYW2, I_HYB2, I_HYF2, I_HYW3, I_HYB3, I_HYBIAS,
       I_GLAWG, I_GLABG, I_GLANG, I_WBR, I_WOUT, I_WUP, I_FFCW, I_FFCB, I_WDN, I_FNG };

namespace pg8 {
constexpr int BM = 256, BK = 64, HALF = 128, HTB = HALF * BK * 2, STAGE_BYTES = 8 * HTB, NXCD = 8, WGM = 4;
__device__ __forceinline__ int lds_byte(int r, int c) { const int st = (r >> 4) * 2 + (c >> 5), rr = r & 15, cc = c & 31, ob = rr * 64 + cc * 2; return st * 1024 + (ob ^ (((ob >> 9) & 1) << 5)); }
__device__ __forceinline__ void stage_rc(int b, int& R, int& C) { const int st = b / 1024, sb = b % 1024, swz = sb ^ (((sb >> 9) & 1) << 5); R = (st >> 1) * 16 + swz / 64; C = (st & 1) * 32 + (swz % 64) / 2; }
__device__ __forceinline__ int perm32(int rho) { const int n = rho >> 4, i = rho & 15; return 8 * (i >> 2) + 4 * n + (i & 3); }
struct Unit { const char* a; const char* b; int pm, pn; };
struct Order2D {
    int nM, nN, nwg, G, c;
    __device__ __forceinline__ void init(int nM_, int nN_, int G_, int c_) { nM = nM_; nN = nN_; nwg = nM * nN; G = G_; c = c_; }
    __device__ __forceinline__ bool nx(int i, int& pm, int& pn) const {
        const long L = (long)i * G + c; if (L >= nwg) return false;
        int wgid = (int)L; { const int q = nwg / NXCD, r = nwg % NXCD, xcd = wgid % NXCD, off = wgid / NXCD; wgid = (xcd < r ? xcd * (q + 1) : r * (q + 1) + (xcd - r) * q) + off; }
        const int nig = WGM * nN, gid = wgid / nig, fm = gid * WGM, gsz = (nM - fm) < WGM ? (nM - fm) : WGM;
        pm = fm + ((wgid % nig) % gsz); pn = (wgid % nig) / gsz; return true;
    }
};
struct SchedPlain : Order2D {
    const char* A; const char* B; size_t aTile, bTile;
    __device__ __forceinline__ bool next(int i, Unit& u) const { int pm, pn; if (!nx(i, pm, pn)) return false; u.pm = pm; u.pn = pn; u.a = A + (size_t)pm * aTile; u.b = B + (size_t)pn * bTile; return true; }
};
struct SchedSplit {
    const char* A; const char* B; size_t aTile, bTile, ksub; int nsplit, G, c;
    __device__ __forceinline__ bool next(int i, Unit& u) const { const int L = i * G + c; if (L >= 16 * nsplit) return false; const int t = L / nsplit, ks = L % nsplit, pm = 64 + (t >> 3), pn = t & 7;
        u.pm = pm; u.pn = pn | (ks << 8); u.a = A + (size_t)pm * aTile + (size_t)ks * ksub; u.b = B + (size_t)pn * bTile + (size_t)ks * ksub; return true; }
};
struct SchedS5 {
    const char* A; const char* B; size_t bGroup; int G, c;
    __device__ __forceinline__ bool next(int i, Unit& u) const { const int L = i * G + c; if (L >= 160) return false; const int g = L & 31, pm = L >> 5;
        u.pm = pm; u.pn = g; u.a = A + ((size_t)pm * 256 * 16384 + (size_t)g * 512) * 2; u.b = B + (size_t)g * bGroup; return true; }
};

#define PG8_SA(b, h) (((b) * 2 + (h)) * HTB)
#define PG8_SB(b, h) ((4 + (b) * 2 + (h)) * HTB)
#define PG8_STAGE(bufoff, gbase, voff) do { _Pragma("unroll") for (int _i = 0; _i < 2; ++_i) \
        __builtin_amdgcn_global_load_lds((const unsigned*)((const char*)(gbase) + (voff)[_i]), (LAS unsigned*)(lds + (bufoff) + ldsw + _i * 8192), 16, 0, 0); } while (0)
#define PG8_LDA(dst, b, h) do { _Pragma("unroll") for (int m = 0; m < 4; ++m) _Pragma("unroll") for (int k = 0; k < 2; ++k) dst[m][k] = *(const LAS f16x8*)(lds + PG8_SA(b, h) + aoff + m * 2048 + k * 1024); } while (0)
#define PG8_LDB(dst, b, h) do { _Pragma("unroll") for (int n = 0; n < 2; ++n) _Pragma("unroll") for (int k = 0; k < 2; ++k) dst[n][k] = *(const LAS f16x8*)(lds + PG8_SB(b, h) + boff + n * 2048 + k * 1024); } while (0)
#define PG8_MMA(ai, bj, At, Bt) do { __builtin_amdgcn_s_setprio(1); _Pragma("unroll") for (int m = 0; m < 4; ++m) _Pragma("unroll") for (int n = 0; n < 2; ++n) _Pragma("unroll") for (int k = 0; k < 2; ++k) \
        acc[ai][bj][m][n] = __builtin_amdgcn_mfma_f32_16x16x32_f16(Bt[n][k], At[m][k], acc[ai][bj][m][n], 0, 0, 0); __builtin_amdgcn_s_setprio(0); } while (0)
#define PG8_WAIT_V(n) asm volatile("s_waitcnt vmcnt(" #n ")" ::: "memory")
#define PG8_WAIT_L(n) asm volatile("s_waitcnt lgkmcnt(" #n ")" ::: "memory")
#define PG8_BAR __builtin_amdgcn_s_barrier()
#define PG8_SCHED __builtin_amdgcn_sched_barrier(0)

template <class Epi, class Sched>
__device__ __forceinline__ void gemm_phase(LAS unsigned char* lds, const int lda, const int ldb, const int nt, const Sched& S, const Epi& E) {
    const int tid = opq((int)threadIdx.x), wid = __builtin_amdgcn_readfirstlane(tid >> 6), lane = tid & 63, wr = wid >> 2, wc = wid & 3, fr = lane & 15, fq = lane >> 4;
    unsigned voffA[2], voffB[2];
#pragma unroll
    for (int i = 0; i < 2; ++i) { int R, C; stage_rc(tid * 16 + i * 8192, R, C); const int Rb = Epi::PERM ? ((R & ~31) + perm32(R & 31)) : R;
        voffA[i] = (unsigned)(R * lda + C) * 2u; voffB[i] = (unsigned)(Rb * ldb + C) * 2u; }
    const size_t kstep = (size_t)(BK * 2);
    const size_t hstepA = (size_t)HALF * lda * 2, hstepB = (size_t)HALF * ldb * 2;
    const unsigned ldsw = (unsigned)wid * 1024u;
    const int aoff = lds_byte(wr * 64 + fr, fq * 8), boff = lds_byte(wc * 32 + fr, fq * 8);
    Unit cur, nxt; int ui = 0;
    if (!S.next(0, cur)) return;
    f32x4 acc[2][2][4][2];
#pragma unroll
    for (int a = 0; a < 2; ++a)
#pragma unroll
        for (int b = 0; b < 2; ++b)
#pragma unroll
            for (int m = 0; m < 4; ++m)
#pragma unroll
                for (int n = 0; n < 2; ++n) acc[a][b][m][n] = (f32x4){0.f, 0.f, 0.f, 0.f};
    f16x8 At[4][2], B0[2][2], B1[2][2];
    const char* cA = cur.a; const char* cB = cur.b;
    PG8_STAGE(PG8_SB(0, 0), cB, voffB); PG8_STAGE(PG8_SA(0, 0), cA, voffA); PG8_STAGE(PG8_SB(0, 1), cB + hstepB, voffB); PG8_STAGE(PG8_SA(0, 1), cA + hstepA, voffA);
    if (wr == 1) PG8_BAR;
    PG8_WAIT_V(4); PG8_BAR;
    PG8_STAGE(PG8_SB(1, 0), cB + kstep, voffB); PG8_STAGE(PG8_SA(1, 0), cA + kstep, voffA); PG8_STAGE(PG8_SB(1, 1), cB + hstepB + kstep, voffB);
    PG8_WAIT_V(6); PG8_BAR;
    for (;;) {
        const bool has_next = S.next(ui + 1, nxt);
        const char* nA = has_next ? nxt.a : cA; const char* nB = has_next ? nxt.b : cB;
        constexpr int NSEG = Epi::HAS_MID ? 3 : 1;
#pragma unroll
        for (int seg = 0; seg < NSEG; ++seg) {
        const int tb = Epi::HAS_MID ? (seg == 0 ? 0 : (seg == 1 ? Epi::MID1 + 2 : Epi::MID2 + 2)) : 0;
        const int te = Epi::HAS_MID ? (seg == 0 ? Epi::MID1 + 2 : (seg == 1 ? Epi::MID2 + 2 : nt)) : nt;
        for (int t = tb; t < te; t += 2) {
            const bool last = (t == nt - 2);
            const char* a1 = cA + (size_t)(t + 1) * kstep;
            const char* a2 = last ? nA : cA + (size_t)(t + 2) * kstep; const char* b2 = last ? nB : cB + (size_t)(t + 2) * kstep;
            const char* a3 = a2 + kstep; const char* b3 = b2 + kstep;
            PG8_LDB(B0, 0, 0); PG8_SCHED; PG8_LDA(At, 0, 0); PG8_STAGE(PG8_SA(1, 1), a1 + hstepA, voffA);
            PG8_WAIT_L(8); PG8_BAR; PG8_WAIT_L(0); PG8_MMA(0, 0, At, B0); PG8_BAR; PG8_SCHED;
            PG8_LDB(B1, 0, 1); PG8_STAGE(PG8_SB(0, 0), b2, voffB);
            PG8_BAR; PG8_WAIT_L(0); PG8_MMA(0, 1, At, B1); PG8_BAR;
            PG8_LDA(At, 0, 1); PG8_STAGE(PG8_SA(0, 0), a2, voffA);
            PG8_BAR; PG8_WAIT_L(0); PG8_MMA(1, 0, At, B0); PG8_BAR; PG8_SCHED;
            PG8_STAGE(PG8_SB(0, 1), b2 + hstepB, voffB);
            PG8_WAIT_V(6); PG8_BAR; PG8_MMA(1, 1, At, B1); PG8_BAR;
            PG8_LDB(B0, 1, 0); PG8_SCHED; PG8_LDA(At, 1, 0); PG8_STAGE(PG8_SA(0, 1), a2 + hstepA, voffA);
            PG8_WAIT_L(8); PG8_BAR; PG8_WAIT_L(0); PG8_MMA(0, 0, At, B0); PG8_BAR; PG8_SCHED;
            PG8_LDB(B1, 1, 1); PG8_STAGE(PG8_SB(1, 0), b3, voffB);
            PG8_BAR; PG8_WAIT_L(0); PG8_MMA(0, 1, At, B1); PG8_BAR;
            PG8_LDA(At, 1, 1); PG8_STAGE(PG8_SA(1, 0), a3, voffA);
            PG8_BAR; PG8_WAIT_L(0); PG8_MMA(1, 0, At, B0); PG8_BAR; PG8_SCHED;
            PG8_STAGE(PG8_SB(1, 1), b3 + hstepB, voffB);
            PG8_WAIT_V(6); PG8_BAR; PG8_MMA(1, 1, At, B1); PG8_BAR;
        }
        if constexpr (Epi::HAS_MID) { if (seg < 2) {
            E.mid(acc, cur, seg, wr, wc, fr, fq);
        } }
        }
#if STAMP_MASK & (1 << 23)
        if (Epi::HAS_MID && blockIdx.x == 0 && threadIdx.x == 0) ((volatile LAS unsigned long long*)(lds + LDSCTL_OFF + 128))[0] = __builtin_amdgcn_s_memrealtime();
#endif
        E(acc, cur, wr, wc, fr, fq);
#if STAMP_MASK & (1 << 23)
        if (Epi::HAS_MID && blockIdx.x == 0 && threadIdx.x == 0) { volatile LAS unsigned long long* TS = (volatile LAS unsigned long long*)(lds + LDSCTL_OFF + 128); TS[1] = TS[1] + (__builtin_amdgcn_s_memrealtime() - TS[0]); }
#endif
        if (!has_next) break;
#pragma unroll
        for (int a = 0; a < 2; ++a)
#pragma unroll
            for (int b = 0; b < 2; ++b)
#pragma unroll
                for (int m = 0; m < 4; ++m)
#pragma unroll
                    for (int n = 0; n < 2; ++n) acc[a][b][m][n] = (f32x4){0.f, 0.f, 0.f, 0.f};
        cur = nxt; cA = nA; cB = nB; ++ui;
    }
    PG8_WAIT_V(0);
    if (wr == 0) PG8_BAR;
    PG8_BAR;
}
#undef PG8_SA
#undef PG8_SB
#undef PG8_STAGE
#undef PG8_LDA
#undef PG8_LDB
#undef PG8_MMA
#undef PG8_WAIT_V
#undef PG8_WAIT_L
#undef PG8_BAR
#undef PG8_SCHED

typedef const f32x4 (&AccRef)[2][2][4][2];
__device__ __forceinline__ f16x8 lowtog8(f16x8 w) { f16x8 r;
#pragma unroll
    for (int e = 0; e < 8; ++e) r[e] = lowtog(w[e]);
    return r; }
__device__ __forceinline__ f16x8 pack8(f32x4 a, f32x4 b) { f16x8 w; w[0] = (f16)a[0]; w[1] = (f16)a[1]; w[2] = (f16)a[2]; w[3] = (f16)a[3]; w[4] = (f16)b[0]; w[5] = (f16)b[1]; w[6] = (f16)b[2]; w[7] = (f16)b[3]; return w; }

struct EpiPx {
    static constexpr bool PERM = true, HAS_MID = false; static constexpr int MID1 = 0, MID2 = 0; f16* PX; f16* S5A; f16* ZT; f16* GTL;
    __device__ __forceinline__ void operator()(AccRef acc, const Unit& u, int wr, int wc, int fr, int fq) const { fr = opq(fr); fq = opq(fq);
        const int row0 = u.pm * BM + wr * 64 + fr, col0 = u.pn * BM + wc * 32 + 8 * fq;
#pragma unroll
        for (int ai = 0; ai < 2; ++ai)
#pragma unroll
            for (int m = 0; m < 4; ++m) { const int row = row0 + ai * HALF + m * 16;
#pragma unroll
                for (int bj = 0; bj < 2; ++bj) { const int c = col0 + bj * HALF; const f16x8 w = pack8(acc[ai][bj][m][0], acc[ai][bj][m][1]);
                    if (u.pn < 2) *(f16x8*)(S5A + (size_t)(row >> 4) * 16384 + (size_t)(c >> 4) * 512 + (row & 15) * 16 + (c & 15)) = w;
                    else if (u.pn >= 14 && u.pn < 20) {
#pragma unroll
                        for (int j = 0; j < 8; ++j) ZT[(size_t)(c - P_HY + j) * MT + row] = w[j]; }
                    else if (u.pn >= 20 && u.pn < 44) *(f16x8*)(GTL + ((size_t)(u.pn - 20) * 66 + u.pm) * 65536 + (size_t)(row - u.pm * BM) * 256 + (c - u.pn * BM)) = w;
                    else { const int pr = row < MX ? (row & ~8191) + ((row & 63) << 7) + ((row & 8191) >> 6) : row;
                        *(f16x8*)(PX + (size_t)pr * PXLD + (u.pn == 44 ? c - (W_GG - P_GG) : c)) = w; } } }
    }
};
struct EpiF16 {
    static constexpr bool PERM = true, HAS_MID = false; static constexpr int MID1 = 0, MID2 = 0; f16* O; int ldc;
    __device__ __forceinline__ void operator()(AccRef acc, const Unit& u, int wr, int wc, int fr, int fq) const { fr = opq(fr); fq = opq(fq);
        const int row0 = u.pm * BM + wr * 64 + fr, col0 = u.pn * BM + wc * 32 + 8 * fq;
#pragma unroll
        for (int ai = 0; ai < 2; ++ai)
#pragma unroll
            for (int m = 0; m < 4; ++m) { f16* rowp = O + (size_t)(row0 + ai * HALF + m * 16) * ldc + col0;
#pragma unroll
                for (int bj = 0; bj < 2; ++bj) *(f16x8*)(rowp + bj * HALF) = pack8(acc[ai][bj][m][0], acc[ai][bj][m][1]); }
    }
};
struct EpiS5In {
    static constexpr bool PERM = false, HAS_MID = false; static constexpr int MID1 = 0, MID2 = 0; float* S;
    __device__ __forceinline__ void operator()(AccRef acc, const Unit& u, int wr, int wc, int fr, int fq) const { fr = opq(fr); fq = opq(fq);
        const int row0 = u.pm * BM + wr * 64 + fr, col0 = wc * 32 + 4 * fq, g = u.pn;
#pragma unroll
        for (int ai = 0; ai < 2; ++ai)
#pragma unroll
            for (int m = 0; m < 4; ++m) { const int row = row0 + ai * HALF + m * 16; { float* rowp = S + ((size_t)row * 32 + g) * 256 + col0;
#pragma unroll
                for (int bj = 0; bj < 2; ++bj)
#pragma unroll
                    for (int n = 0; n < 2; ++n) *(f32x4*)(rowp + bj * HALF + n * 16) = acc[ai][bj][m][n]; } }
    }
};
struct EpiS5Out {
    static constexpr bool PERM = true, HAS_MID = false; static constexpr int MID1 = 0, MID2 = 0; const f16* S5A; f16* Y; const float* dvec;
    __device__ __forceinline__ void operator()(AccRef acc, const Unit& u, int wr, int wc, int fr, int fq) const { fr = opq(fr); fq = opq(fq);
        const int row0 = u.pm * BM + wr * 64 + fr, col0 = wc * 32 + 8 * fq, g = u.pn;
        const int h0 = col0 & 15;
        const f32x4 d0 = *(const f32x4*)(dvec + g * 16 + h0), d1 = *(const f32x4*)(dvec + g * 16 + h0 + 4);
#pragma unroll
        for (int ai = 0; ai < 2; ++ai) { f16x8 uu[4][2];
#pragma unroll
            for (int m = 0; m < 4; ++m)
#pragma unroll
                for (int bj = 0; bj < 2; ++bj) uu[m][bj] = *(const f16x8*)(S5A + (size_t)(row0 + ai * HALF + m * 16) * 16384 + (size_t)g * 512 + col0 + bj * HALF);
            PIN8(uu[0][0], uu[0][1], uu[1][0], uu[1][1], uu[2][0], uu[2][1], uu[3][0], uu[3][1]);
#pragma unroll
            for (int m = 0; m < 4; ++m) { const int chunk = row0 + ai * HALF + m * 16;
#pragma unroll
                for (int bj = 0; bj < 2; ++bj) { const int c = col0 + bj * HALF, t = c >> 4; f16x8 w;
#pragma unroll
                    for (int j = 0; j < 4; ++j) { w[j] = (f16)gelu_tanh_(acc[ai][bj][m][0][j] * (1.0f / S5SCALE) + d0[j] * (float)uu[m][bj][j]);
                                                  w[4 + j] = (f16)gelu_tanh_(acc[ai][bj][m][1][j] * (1.0f / S5SCALE) + d1[j] * (float)uu[m][bj][4 + j]); }
                    *(f16x8*)(Y + (size_t)(chunk * 16 + t) * 512 + g * 16 + h0) = lowtog8(w); } }
            asm volatile("" ::: "memory"); }
    }
};
struct EpiGlu {
    static constexpr bool PERM = true, HAS_MID = false; static constexpr int MID1 = 0, MID2 = 0; const f16* YP; f16* O; const float* bias;
    __device__ __forceinline__ void operator()(AccRef acc, const Unit& u, int wr, int wc, int fr, int fq) const { fr = opq(fr); fq = opq(fq);
        const int row0 = u.pm * BM + wr * 64 + fr, col0 = u.pn * BM + wc * 32 + 8 * fq;
        f32x4 bv[2][2];
#pragma unroll
        for (int bj = 0; bj < 2; ++bj) { bv[bj][0] = *(const f32x4*)(bias + col0 + bj * HALF); bv[bj][1] = *(const f32x4*)(bias + col0 + bj * HALF + 4); }
#pragma unroll
        for (int ai = 0; ai < 2; ++ai) { f16x8 yp[4][2];
#pragma unroll
            for (int m = 0; m < 4; ++m)
#pragma unroll
                for (int bj = 0; bj < 2; ++bj) yp[m][bj] = *(const f16x8*)(YP + (size_t)(row0 + ai * HALF + m * 16) * 512 + col0 + bj * HALF);
            PIN8(yp[0][0], yp[0][1], yp[1][0], yp[1][1], yp[2][0], yp[2][1], yp[3][0], yp[3][1]);
#pragma unroll
            for (int m = 0; m < 4; ++m)
#pragma unroll
                for (int bj = 0; bj < 2; ++bj) { f16x8 w;
#pragma unroll
                    for (int j = 0; j < 4; ++j) { w[j] = (f16)((float)yp[m][bj][j] * sigmoidf_(acc[ai][bj][m][0][j] + bv[bj][0][j])); w[4 + j] = (f16)((float)yp[m][bj][4 + j] * sigmoidf_(acc[ai][bj][m][1][j] + bv[bj][1][j])); }
                    *(f16x8*)(O + (size_t)(row0 + ai * HALF + m * 16) * 2048 + col0 + bj * HALF) = lowtog8(w); }
            asm volatile("" ::: "memory"); }
    }
};
template <int BR> struct EpiBranch {
    static constexpr bool PERM = true, HAS_MID = false; static constexpr int MID1 = 0, MID2 = 0; const f16* PX; f16* M;
    __device__ __forceinline__ void operator()(AccRef acc, const Unit& u, int wr, int wc, int fr, int fq) const { fr = opq(fr); fq = opq(fq);
        const int row0 = u.pm * BM + wr * 64 + fr, col0 = u.pn * BM + wc * 32 + 8 * fq;
#pragma unroll
        for (int ai = 0; ai < 2; ++ai)
#pragma unroll
            for (int m = 0; m < 4; ++m) { const int row = row0 + ai * HALF + m * 16;
#pragma unroll
                for (int bj = 0; bj < 2; ++bj) { const int c = col0 + bj * HALF;
                    const f16x8 gl = *(const f16x8*)(PX + (size_t)row * PXLD + P_MG + BR * 2048 + c);
                    f16* mp = M + (size_t)row * 2048 + c;
                    f16x8 prev; if (BR > 0) prev = *(const f16x8*)mp;
                    f16x8 w;
#pragma unroll
                    for (int j = 0; j < 4; ++j) { float v0 = sigmoidf_((float)gl[j]) * acc[ai][bj][m][0][j], v1 = sigmoidf_((float)gl[4 + j]) * acc[ai][bj][m][1][j];
                        if (BR > 0) { v0 += (float)prev[j]; v1 += (float)prev[4 + j]; } w[j] = (f16)v0; w[4 + j] = (f16)v1; }
                    *(f16x8*)mp = w; } asm volatile("" ::: "memory"); }
    }
};
typedef f32x4 (&AccMut)[2][2][4][2];

struct EpiBranchF {
    static constexpr bool PERM = true, HAS_MID = true; static constexpr int MID1 = 6, MID2 = 14;
    const f16* GTL; f16* M;
    __device__ __forceinline__ void mid(AccMut acc, const Unit& u, int seg, int wr, int wc, int fr, int fq) const { fr = opq(fr); fq = opq(fq);
        const int lrow0 = wr * 64 + fr, lcol0 = wc * 32 + 8 * fq;
        const f16* ga = GTL + ((size_t)((seg == 0 ? 0 : 8) + u.pn) * 66 + u.pm) * 65536; const f16* gb = ga + (size_t)8 * 66 * 65536;
#pragma unroll
        for (int ai = 0; ai < 2; ++ai) { f16x8 za[4][2], zb[4][2];
#pragma unroll
            for (int m = 0; m < 4; ++m)
#pragma unroll
                for (int bj = 0; bj < 2; ++bj) { const int off = (lrow0 + ai * HALF + m * 16) * 256 + lcol0 + bj * HALF; za[m][bj] = *(const f16x8*)(ga + off); zb[m][bj] = *(const f16x8*)(gb + off); }
            PIN8(za[0][0], za[0][1], za[1][0], za[1][1], za[2][0], za[2][1], za[3][0], za[3][1]); PIN8(zb[0][0], zb[0][1], zb[1][0], zb[1][1], zb[2][0], zb[2][1], zb[3][0], zb[3][1]);
#pragma unroll
            for (int m = 0; m < 4; ++m)
#pragma unroll
                for (int bj = 0; bj < 2; ++bj)
#pragma unroll
                    for (int j = 0; j < 4; ++j) { acc[ai][bj][m][0][j] *= (1.0f + __expf(-(float)zb[m][bj][j])) * __builtin_amdgcn_rcpf(1.0f + __expf(-(float)za[m][bj][j]));
                                                  acc[ai][bj][m][1][j] *= (1.0f + __expf(-(float)zb[m][bj][4 + j])) * __builtin_amdgcn_rcpf(1.0f + __expf(-(float)za[m][bj][4 + j])); }
            asm volatile("" ::: "memory"); }
    }
    __device__ __forceinline__ void operator()(AccRef acc, const Unit& u, int wr, int wc, int fr, int fq) const { fr = opq(fr); fq = opq(fq);
        const int row0 = u.pm * BM + wr * 64 + fr, col0 = u.pn * BM + wc * 32 + 8 * fq;
#pragma unroll
        for (int ai = 0; ai < 2; ++ai) { f16x8 gl[4][2];
#pragma unroll
            for (int m = 0; m < 4; ++m)
#pragma unroll
                for (int bj = 0; bj < 2; ++bj) gl[m][bj] = *(const f16x8*)(GTL + ((size_t)(16 + u.pn) * 66 + u.pm) * 65536 + (wr * 64 + fr + ai * HALF + m * 16) * 256 + wc * 32 + 8 * fq + bj * HALF);
            PIN8(gl[0][0], gl[0][1], gl[1][0], gl[1][1], gl[2][0], gl[2][1], gl[3][0], gl[3][1]);
#pragma unroll
            for (int m = 0; m < 4; ++m)
#pragma unroll
                for (int bj = 0; bj < 2; ++bj) { f16x8 w;
#pragma unroll
                    for (int j = 0; j < 4; ++j) { w[j] = (f16)(sigmoidf_((float)gl[m][bj][j]) * acc[ai][bj][m][0][j]); w[4 + j] = (f16)(sigmoidf_((float)gl[m][bj][4 + j]) * acc[ai][bj][m][1][j]); }
                    *(f16x8*)(M + (size_t)(row0 + ai * HALF + m * 16) * 2048 + col0 + bj * HALF) = lowtog8(w); }
            asm volatile("" ::: "memory"); }
    }
};
struct EpiUpAct {
    static constexpr bool PERM = true, HAS_MID = false; static constexpr int MID1 = 0, MID2 = 0; f16* ACT; float* HALO; const float* cw; const float* cb; LAS float* HL;
    __device__ __forceinline__ void operator()(AccRef acc, const Unit& u, int wr, int wc, int fr, int fq) const { fr = opq(fr); fq = opq(fq);
        const int lane = fq * 16 + fr;
#pragma unroll
        for (int ai = 0; ai < 2; ++ai) { LAS float* hp = HL + ((ai * 2 + wr) * 4 + wc) * 64 + 8 * fq;
            if (fr == 0) { *(LAS f32x4*)(hp) = acc[ai][0][0][0]; *(LAS f32x4*)(hp + 4) = acc[ai][0][0][1]; }
            if (fr == 15) { *(LAS f32x4*)(hp + 32) = acc[ai][0][3][0]; *(LAS f32x4*)(hp + 36) = acc[ai][0][3][1]; } }
        { float* gh = HALO + ((size_t)u.pm * 44 + u.pn) * 768 + wc * 32 + 8 * fq;
          if (wr == 0 && fr < 2) { *(f32x4*)(gh + fr * 128) = acc[0][0][0][0]; *(f32x4*)(gh + fr * 128 + 4) = acc[0][0][0][1]; }
          if (wr == 0 && fr == 0) { *(f32x4*)(gh + 4 * 128) = acc[0][1][0][0]; *(f32x4*)(gh + 4 * 128 + 4) = acc[0][1][0][1]; }
          if (wr == 1 && fr >= 14) { *(f32x4*)(gh + (fr - 12) * 128) = acc[1][0][3][0]; *(f32x4*)(gh + (fr - 12) * 128 + 4) = acc[1][0][3][1]; }
          if (wr == 1 && fr == 15) { *(f32x4*)(gh + 5 * 128) = acc[1][1][3][0]; *(f32x4*)(gh + 5 * 128 + 4) = acc[1][1][3][1]; } }
        asm volatile("s_waitcnt lgkmcnt(0)" ::: "memory"); __builtin_amdgcn_s_barrier(); __builtin_amdgcn_s_barrier(); asm volatile("" ::: "memory");
        const int colg = u.pn * 128 + wc * 32 + 8 * fq;
        const int srcR = (lane & 48) | ((fr + 15) & 15), srcL = (lane & 48) | ((fr + 1) & 15);
        const int row0 = u.pm * BM + wr * 64 + fr;
#pragma unroll
        for (int n = 0; n < 2; ++n) {
            const f32x4 w0 = *(const f32x4*)(cw + colg + 4 * n), w1 = *(const f32x4*)(cw + FFH + colg + 4 * n), w2 = *(const f32x4*)(cw + 2 * FFH + colg + 4 * n), bb = *(const f32x4*)(cb + colg + 4 * n);
#pragma unroll
            for (int ai = 0; ai < 2; ++ai) {
                const bool hasp = (wr == 1) || (ai == 1), hasn = (wr == 0) || (ai == 0);
                const LAS float* pp = HL + (((wr == 1 ? ai : 0) * 2 + (wr == 1 ? 0 : 1)) * 4 + wc) * 64 + 32 + 8 * fq + 4 * n;
                const LAS float* np = HL + (((wr == 0 ? ai : 1) * 2 + (wr == 0 ? 1 : 0)) * 4 + wc) * 64 + 8 * fq + 4 * n;
                const f32x4 hprev = hasp ? *(const LAS f32x4*)pp : (f32x4){0.f, 0.f, 0.f, 0.f}, hnext = hasn ? *(const LAS f32x4*)np : (f32x4){0.f, 0.f, 0.f, 0.f};
                f32x4 R[4], L[4];
#pragma unroll
                for (int m = 0; m < 4; ++m)
#pragma unroll
                    for (int j = 0; j < 4; ++j) { R[m][j] = __shfl(acc[ai][0][m][n][j], srcR); L[m][j] = __shfl(acc[ai][0][m][n][j], srcL); }
#pragma unroll
                for (int m = 0; m < 4; ++m) { const f32x4 pv = fr > 0 ? R[m] : (m > 0 ? R[m > 0 ? m - 1 : 0] : hprev); const f32x4 nv = fr < 15 ? L[m] : (m < 3 ? L[m < 3 ? m + 1 : 3] : hnext);
                    const f32x4 a = w0 * pv + w1 * acc[ai][0][m][n] + w2 * nv + bb;
                    f16x4 o;
#pragma unroll
                    for (int j = 0; j < 4; ++j) o[j] = lowtog((f16)(siluf_(a[j]) * acc[ai][1][m][n][j]));
                    *(f16x4*)(ACT + (size_t)(row0 + ai * HALF + m * 16) * FFH + colg + 4 * n) = o; }
                asm volatile("" ::: "memory");
            }
        }
    }
};
struct EpiSlab {
    static constexpr bool PERM = false, HAS_MID = false; static constexpr int MID1 = 0, MID2 = 0; float* slab; const float* mod; int goff;
    __device__ __forceinline__ void operator()(AccRef acc, const Unit& u, int wr, int wc, int fr, int fq) const { fr = opq(fr); fq = opq(fq);
        const int pn = u.pn & 255, ks = u.pn >> 8;
        const int row0 = (u.pm - 64) * BM + wr * 64 + fr, col0 = pn * BM + wc * 32 + 4 * fq;
        const float* gp = mod + 2 * 12288 + goff + col0;
        f32x4 gv[2][2];
#pragma unroll
        for (int bj = 0; bj < 2; ++bj)
#pragma unroll
            for (int n = 0; n < 2; ++n) gv[bj][n] = *(const f32x4*)(gp + bj * HALF + n * 16);
        float* sp = slab + (size_t)ks * MC * D;
#pragma unroll
        for (int ai = 0; ai < 2; ++ai)
#pragma unroll
            for (int m = 0; m < 4; ++m) { float* rowp = sp + (size_t)(row0 + ai * HALF + m * 16) * D + col0;
#pragma unroll
                for (int bj = 0; bj < 2; ++bj)
#pragma unroll
                    for (int n = 0; n < 2; ++n) *(f32x4*)(rowp + bj * HALF + n * 16) = gv[bj][n] * acc[ai][bj][m][n]; }
    }
};
struct EpiResid {
    static constexpr bool PERM = false, HAS_MID = false; static constexpr int MID1 = 0, MID2 = 0; float* X; const float* mod; int goff; const float* Xs;
    __device__ __forceinline__ void operator()(AccRef acc, const Unit& u, int wr, int wc, int fr, int fq) const { fr = opq(fr); fq = opq(fq);
        const int row0 = u.pm * BM + wr * 64 + fr, col0 = u.pn * BM + wc * 32 + 4 * fq;
        const int bsel = u.pm < 32 ? 0 : (u.pm < 64 ? 1 : 2);
        const float* gp = mod + bsel * 12288 + goff + col0;
        f32x4 gv[2][2];
#pragma unroll
        for (int bj = 0; bj < 2; ++bj)
#pragma unroll
            for (int n = 0; n < 2; ++n) gv[bj][n] = *(const f32x4*)(gp + bj * HALF + n * 16);
#pragma unroll
        for (int ai = 0; ai < 2; ++ai) { f32x4 xv[4][2][2];
#pragma unroll
            for (int m = 0; m < 4; ++m) { const float* rowp = Xs + (size_t)(row0 + ai * HALF + m * 16) * D + col0;
#pragma unroll
                for (int bj = 0; bj < 2; ++bj)
#pragma unroll
                    for (int n = 0; n < 2; ++n) xv[m][bj][n] = *(const f32x4*)(rowp + bj * HALF + n * 16); }
            PIN8(xv[0][0][0], xv[0][0][1], xv[0][1][0], xv[0][1][1], xv[1][0][0], xv[1][0][1], xv[1][1][0], xv[1][1][1]); PIN8(xv[2][0][0], xv[2][0][1], xv[2][1][0], xv[2][1][1], xv[3][0][0], xv[3][0][1], xv[3][1][0], xv[3][1][1]);
#pragma unroll
            for (int m = 0; m < 4; ++m) { float* rowp = X + (size_t)(row0 + ai * HALF + m * 16) * D + col0;
#pragma unroll
                for (int bj = 0; bj < 2; ++bj)
#pragma unroll
                    for (int n = 0; n < 2; ++n) *(f32x4*)(rowp + bj * HALF + n * 16) = xv[m][bj][n] + gv[bj][n] * acc[ai][bj][m][n]; }
            asm volatile("" ::: "memory"); }
    }
};
}


__device__ __forceinline__ void ph_prologue(const Ctx& F, const ArgsV& AV) {
    const int gt = F.bid * 512 + F.tid, NT = F.G * 512;
    { const f32x4* cs = (const f32x4*)AV.in(I_CTX); f32x4* xr = (f32x4*)(F.ws + WS_XRES);
      for (int i = gt; i < MC * D / 4; i += NT) xr[MX * D / 4 + i] = cs[i]; }
    LAS float* sc = (LAS float*)F.lds;
    LAS float* red = (LAS float*)(F.lds + 3 * 2048 * 4);
    for (int i = F.tid; i < 3 * 2048; i += 512) { const int r = i / 2048, k = i % 2048; const float v = r < 2 ? AV.in(I_C)[r * 2048 + k] : AV.in(I_CCTX)[k]; sc[i] = siluf_(v); }
    __syncthreads();
    const int col = F.tid & 63, ks = F.tid >> 6;
    for (int chunk = F.bid; chunk < DEPTH * 192; chunk += F.G) {
        const int l = chunk / 192, n0 = (chunk % 192) * 64;
        const float* w = AV.in(I_WMOD) + (size_t)l * 2048 * 12288 + n0 + col;
        float s0 = 0.f, s1 = 0.f, s2 = 0.f;
#pragma unroll 8
        for (int k = ks * 256; k < ks * 256 + 256; ++k) { const float wv = w[(size_t)k * 12288]; s0 += sc[k] * wv; s1 += sc[2048 + k] * wv; s2 += sc[4096 + k] * wv; }
        red[(ks * 3 + 0) * 64 + col] = s0; red[(ks * 3 + 1) * 64 + col] = s1; red[(ks * 3 + 2) * 64 + col] = s2;
        __syncthreads();
        if (F.tid < 192) { const int r = F.tid >> 6, c2 = F.tid & 63; float s = 0.f;
#pragma unroll
            for (int q = 0; q < 8; ++q) s += red[(q * 3 + r) * 64 + c2];
            ((float*)(F.ws + WS_MOD))[((size_t)l * 3 + r) * 12288 + n0 + c2] = s + AV.in(I_BMOD)[(size_t)l * 12288 + n0 + c2]; }
        __syncthreads();
    }
}

__device__ __forceinline__ void conv_item(const float* W, int ldw, int k0, int srccol, f16* WT, int dstrow, int ldk) {
    float v[64];
    const float* src = W + (size_t)k0 * ldw + (srccol >= 0 ? srccol : 0);
#pragma unroll
    for (int k = 0; k < 64; ++k) v[k] = src[(size_t)k * ldw];
#pragma unroll
    for (int k = 0; k < 64; k += 8) PIN8(v[k], v[k + 1], v[k + 2], v[k + 3], v[k + 4], v[k + 5], v[k + 6], v[k + 7]);
    f16* dst = WT + (size_t)dstrow * ldk + k0;
#pragma unroll
    for (int kg = 0; kg < 8; ++kg) { f16x8 o;
#pragma unroll
        for (int e = 0; e < 8; ++e) o[e] = srccol >= 0 ? lowtog((f16)v[8 * kg + e]) : (f16)0.f;
        *(f16x8*)(dst + 8 * kg) = o; }
}
__device__ __forceinline__ void ph_convert_weights(const Ctx& F, const ArgsV& AV, int l) {
    const int skip = F.G > 64 ? 32 : 0;
    if (F.bid < skip) return;
    const int gw = (F.bid - skip) * 8 + F.wave, NGW = (F.G - skip) * 8, lane = F.lane;
    constexpr int I_IN = 32 * 180, I_GLU = 8 * 8, I_BR = 32 * 32, I_OUT = 32 * 32, I_UP = 32 * 176, I_DN = 88 * 32;
    constexpr int NIT = I_IN + I_GLU + I_BR + I_OUT + I_UP + I_DN;
    for (int it = gw; it < NIT; it += NGW) {
        int r = it;
        if (r < I_IN) { const int kb = r / 180, nb = r % 180, j = nb * 64 + lane;
            const int src = j < 2048 ? j : (j < 11264 ? j + 32 : (j < 11296 ? 2048 + (j - 11264) : -1));
            conv_item(AV.in(I_WIN) + (size_t)l * 2048 * INW, INW, kb * 64, src, (f16*)(F.ws + WS_WIN), j, 2048); continue; } r -= I_IN;
        if (r < I_GLU) { const int kb = r / 8, nb = r % 8, j = nb * 64 + lane; conv_item(AV.in(I_GLUW) + (size_t)l * 512 * 512, 512, kb * 64, j, (f16*)(F.ws + WS_WGLU), j, 512); continue; } r -= I_GLU;
        if (r < I_BR) { const int kb = r / 32, nb = r % 32, j = nb * 64 + lane; conv_item(AV.in(I_WBR) + (size_t)l * 2048 * 2048, 2048, kb * 64, j, (f16*)(F.ws + WS_WBR), j, 2048); continue; } r -= I_BR;
        if (r < I_OUT) { const int kb = r / 32, nb = r % 32, j = nb * 64 + lane; conv_item(AV.in(I_WOUT) + (size_t)l * 2048 * 2048, 2048, kb * 64, j, (f16*)(F.ws + WS_WOUT), j, 2048); continue; } r -= I_OUT;
        if (r < I_UP) { const int kb = r / 176, nb = r % 176, j = nb * 64 + lane, pn = j >> 8, i = j & 255; const int src = i < 128 ? 128 * pn + i : FFH + 128 * pn + (i - 128);
            conv_item(AV.in(I_WUP) + (size_t)l * 2048 * UPLD, UPLD, kb * 64, src, (f16*)(F.ws + WS_WUP), j, 2048); continue; } r -= I_UP;
        { const int kb = r / 32, nb = r % 32, j = nb * 64 + lane; conv_item(AV.in(I_WDN) + (size_t)l * FFH * 2048, 2048, kb * 64, j, (f16*)(F.ws + WS_WDN), j, FFH); }
    }
}

__device__ __forceinline__ void s5_mats_group(const Ctx& F, const ArgsV& AV, int l, int g) {
    LAS f32x2* APOW = (LAS f32x2*)F.lds;
    LAS f32x2* BBAR = APOW + 2 * 17 * 64;
    LAS f32x2* CM = BBAR + 2 * 64 * 16;
    LAS float* KLAG = (LAS float*)(CM + 2 * 16 * 64);
    __syncthreads();
    for (int i = F.tid; i < 2 * 17 * 64; i += 512) { const int d = i / (17 * 64), e = (i / 64) % 17, n = i % 64;
        const size_t pi = (((size_t)l * 2 + d) * 32 + g) * 64 + n;
        const float are = AV.in(I_S5ARE)[pi], aim = AV.in(I_S5AIM)[pi], dt = expf(AV.in(I_S5STEP)[((size_t)l * 2 + d) * 32 + g]);
        const float zr = are * dt * (float)e, zi = aim * dt * (float)e; float s, c; sincosf(zi, &s, &c); const float m = expf(zr);
        APOW[i] = (f32x2){m * c, m * s}; }
    __syncthreads();
    for (int i = F.tid; i < 2 * 64 * 16; i += 512) { const int d = i / 1024, n = (i / 16) % 64, h = i % 16;
        const size_t pi = (((size_t)l * 2 + d) * 32 + g) * 64 + n;
        const float are = AV.in(I_S5ARE)[pi], aim = AV.in(I_S5AIM)[pi];
        const f32x2 ab = APOW[(d * 17 + 1) * 64 + n]; const f32x2 num = (f32x2){ab.x - 1.0f, ab.y};
        const float den = are * are + aim * aim; const f32x2 q = (f32x2){(num.x * are + num.y * aim) / den, (num.y * are - num.x * aim) / den};
        const size_t bi = (pi * 16) + h;
        BBAR[i] = cmul(q, (f32x2){AV.in(I_S5BRE)[bi], AV.in(I_S5BIM)[bi]});
        const size_t ci = ((((size_t)l * 2 + d) * 32 + g) * 16 + h) * 64 + n;
        CM[(d * 16 + h) * 64 + n] = (f32x2){AV.in(I_S5CRE)[ci], AV.in(I_S5CIM)[ci]}; }
    __syncthreads();
    for (int i = F.tid; i < 2 * 16 * 256; i += 512) { const int d = i / 4096, lag = (i / 256) % 16, h = (i / 16) % 16, hp = i % 16; float s = 0.f;
        for (int n = 0; n < 64; ++n) { const f32x2 t = cmul(CM[(d * 16 + h) * 64 + n], APOW[(d * 17 + lag) * 64 + n]); const f32x2 b = BBAR[(d * 64 + n) * 16 + hp]; s += t.x * b.x - t.y * b.y; }
        KLAG[i] = s; }
    __syncthreads();
    f16* W = (f16*)(F.ws + WS_S5W) + (size_t)g * 256 * 512;
    for (int i = F.tid; i < 256 * 64; i += 512) { const int n = i / 64, k8 = (i % 64) * 8, t = n >> 4, h = n & 15; f16x8 o;
#pragma unroll
        for (int e = 0; e < 8; ++e) { const int k = k8 + e; float v;
            if (k < 256) { const int s = k >> 4, hp = k & 15; v = 0.f;
                if (t >= s) v += KLAG[((0 * 16 + (t - s)) * 16 + h) * 16 + hp];
                if (s >= t) v += KLAG[((1 * 16 + (s - t)) * 16 + h) * 16 + hp];
                v *= S5SCALE; }
            else { const int d = (k - 256) >> 7, nn2 = (k - 256) & 127, nn = nn2 & 63, im = nn2 >> 6, ex = d == 0 ? t + 1 : 16 - t;
                const f32x2 z = cmul(CM[(d * 16 + h) * 64 + nn], APOW[(d * 17 + ex) * 64 + nn]); v = im ? -z.y : z.x; }
            o[e] = (f16)v; }
        *(f16x8*)(W + (size_t)n * 512 + k8) = o; }
    f16* Mx = (f16*)(F.ws + WS_S5M) + (size_t)g * 256 * 256;
    for (int i = F.tid; i < 256 * 32; i += 512) { const int n = i / 32, k8 = (i % 32) * 8, d = n >> 7, ri = (n >> 6) & 1, nn = n & 63; f16x8 o;
#pragma unroll
        for (int e = 0; e < 8; ++e) { const int k = k8 + e, s = k >> 4, hp = k & 15, ex = d == 0 ? 15 - s : s;
            const f32x2 z = cmul(APOW[(d * 17 + ex) * 64 + nn], BBAR[(d * 64 + nn) * 16 + hp]); o[e] = (f16)((ri ? z.y : z.x) * S5SCALE); }
        *(f16x8*)(Mx + (size_t)n * 256 + k8) = o; }
    if (F.tid < 128) { const int d = F.tid >> 6, nn = F.tid & 63; ((f32x2*)(F.ws + WS_S5AT))[(d * 32 + g) * 64 + nn] = APOW[(d * 17 + 16) * 64 + nn]; }
    __syncthreads();
}

__device__ __forceinline__ void ph_hyena_h2(const Ctx& F, const ArgsV& AV, int l) {
    LAS float* W1 = (LAS float*)F.lds;
    LAS float* W2 = W1 + 33 * 64;
    LAS float* PV = W2 + 64 * 64;
    LAS float* SCR = PV + 256;
    __syncthreads();
    for (int i = F.tid; i < 33 * 64; i += 512) W1[i] = AV.in(I_HYW1)[(size_t)l * 33 * 64 + i];
    for (int i = F.tid; i < 64 * 64; i += 512) W2[i] = AV.in(I_HYW2)[(size_t)l * 4096 + i];
    if (F.tid < 64) { PV[F.tid] = AV.in(I_HYB1)[l * 64 + F.tid]; PV[64 + F.tid] = AV.in(I_HYF1)[l * 64 + F.tid]; PV[128 + F.tid] = AV.in(I_HYB2)[l * 64 + F.tid]; PV[192 + F.tid] = AV.in(I_HYF2)[l * 64 + F.tid]; }
    __syncthreads();
    LAS float* scr = SCR + F.wave * 64;
    const int gw = F.bid * 8 + F.wave, NGW = F.G * 8, j = F.lane;
    for (int p = gw; p < SEQ + LC; p += NGW) {
        const int n = p < SEQ ? SEQ : LC, pos = p < SEQ ? p : p - SEQ;
        float feat = 0.f;
        if (j == 0) feat = (float)pos / (float)(n - 1);
        else if (j < 33) { const int fi = (j - 1) & 15; const float fr = 1e-4f + (float)fi * ((15.0f - 1e-4f) / 15.0f);
            const float ang = (6.283185307179586f / (float)n) * (float)pos * fr; float s, c; sincosf(ang, &s, &c); feat = j < 17 ? c : -s; }
        scr[j] = feat; LDS_WAIT(); asm volatile("" ::: "memory");
        float a = PV[j];
        for (int i = 0; i < 33; ++i) a += scr[i] * W1[i * 64 + j];
        const float h1 = sinf(PV[64 + j] * a);
        LDS_WAIT(); asm volatile("" ::: "memory");
        scr[j] = h1; LDS_WAIT(); asm volatile("" ::: "memory");
        float b = PV[128 + j];
        for (int i = 0; i < 64; ++i) b += scr[i] * W2[i * 64 + j];
        ((f16*)(F.ws + WS_H2H))[((size_t)l * (SEQ + LC) + p) * 64 + j] = (f16)sinf(PV[192 + j] * b);
        LDS_WAIT(); asm volatile("" ::: "memory");
    }
}

__device__ __forceinline__ void ph_norm(const Ctx& F, const ArgsV& AV, int l, int which, int nrows, int nslab) {
    const int gw = F.bid * 8 + F.wave, NGW = F.G * 8;
    float* X = (float*)(F.ws + WS_XRES); f16* O = (f16*)(F.ws + WS_HN); const float* SL = (const float*)(F.ws + WS_SLAB);
    const float* Xin = (l == 0 && which == 0) ? AV.in(I_X) : X;
    const float* gain = AV.in(which ? I_N2G : I_N1G) + (size_t)l * D;
    const float* mod = (const float*)(F.ws + WS_MOD) + (size_t)l * 3 * 12288;
    const int shoff = which ? 6144 : 0, soff = which ? 8192 : 2048;
    int cur_bsel = -1; f32x4 Am[8], Bm[8], vn[8];
    if (gw < nrows) { const f32x4* xr0 = (const f32x4*)((gw < MX ? Xin : X) + (size_t)gw * D) + F.lane;
#pragma unroll
        for (int j = 0; j < 8; ++j) vn[j] = xr0[64 * j]; }
    for (int m = gw; m < nrows; m += NGW) {
        const int bsel = m < SEQ ? 0 : (m < MX ? 1 : 2);
        f32x4* xr = (f32x4*)(X + (size_t)m * D) + F.lane;
        f32x4 v[8]; float s = 0.f;
        PIN8(vn[0], vn[1], vn[2], vn[3], vn[4], vn[5], vn[6], vn[7]);
#pragma unroll
        for (int j = 0; j < 8; ++j) v[j] = vn[j];
        if (m + NGW < nrows) { const f32x4* xq = (const f32x4*)((m + NGW < MX ? Xin : X) + (size_t)(m + NGW) * D) + F.lane;
#pragma unroll
            for (int j = 0; j < 8; ++j) vn[j] = xq[64 * j]; }
        if (bsel != cur_bsel) { cur_bsel = bsel; const float* mp = mod + bsel * 12288;
#pragma unroll
            for (int j = 0; j < 8; ++j) { const int c = 4 * F.lane + 256 * j; const f32x4 g = *(const f32x4*)(gain + c), sc = *(const f32x4*)(mp + soff + c); Bm[j] = *(const f32x4*)(mp + shoff + c); Am[j] = g * (sc + 1.0f); }
            PIN8(Am[0], Am[1], Am[2], Am[3], Am[4], Am[5], Am[6], Am[7]); PIN8(Bm[0], Bm[1], Bm[2], Bm[3], Bm[4], Bm[5], Bm[6], Bm[7]); }
        if (m >= MX && nslab > 0) {
            for (int sl = 0; sl < nslab; ++sl) { const f32x4* sr = (const f32x4*)(SL + ((size_t)sl * MC + (m - MX)) * D) + F.lane;
#pragma unroll
                for (int j = 0; j < 8; ++j) v[j] = v[j] + sr[64 * j]; }
#pragma unroll
            for (int j = 0; j < 8; ++j) xr[64 * j] = v[j]; }
#pragma unroll
        for (int j = 0; j < 8; ++j) s += (v[j].x * v[j].x + v[j].y * v[j].y) + (v[j].z * v[j].z + v[j].w * v[j].w);
        const float rstd = 1.0f / sqrtf(wave_sum(s) * (1.0f / D) + EPS);
#pragma unroll
        for (int j = 0; j < 8; ++j) { const int c = 4 * F.lane + 256 * j;
            f16x4 o;
#pragma unroll
            for (int e = 0; e < 4; ++e) o[e] = lowtog((f16)(v[j][e] * rstd * Am[j][e] + Bm[j][e]));
            *(f16x4*)(O + (size_t)m * D + c) = o; }
    }
}
__device__ __forceinline__ void ph_final_norm(const Ctx& F, const ArgsV& AV) {
    const int gw = F.bid * 8 + F.wave, NGW = F.G * 8;
    const float* X = (const float*)(F.ws + WS_XRES); const float* gain = AV.in(I_FNG);
    f32x4 gm[8], vn[8];
#pragma unroll
    for (int j = 0; j < 8; ++j) gm[j] = *(const f32x4*)(gain + 4 * F.lane + 256 * j);
    if (gw < MX) { const f32x4* xr0 = (const f32x4*)(X + (size_t)gw * D) + F.lane;
#pragma unroll
        for (int j = 0; j < 8; ++j) vn[j] = xr0[64 * j]; }
    for (int m = gw; m < MX; m += NGW) {
        f32x4 v[8]; float s = 0.f;
        PIN8(vn[0], vn[1], vn[2], vn[3], vn[4], vn[5], vn[6], vn[7]);
#pragma unroll
        for (int j = 0; j < 8; ++j) v[j] = vn[j];
        if (m + NGW < MX) { const f32x4* xq = (const f32x4*)(X + (size_t)(m + NGW) * D) + F.lane;
#pragma unroll
            for (int j = 0; j < 8; ++j) vn[j] = xq[64 * j]; }
#pragma unroll
        for (int j = 0; j < 8; ++j) s += (v[j].x * v[j].x + v[j].y * v[j].y) + (v[j].z * v[j].z + v[j].w * v[j].w);
        const float rstd = 1.0f / sqrtf(wave_sum(s) * (1.0f / D) + EPS);
#pragma unroll
        for (int j = 0; j < 8; ++j) { const int c = 4 * F.lane + 256 * j;
            *(f32x4*)(AV.out + (size_t)m * D + c) = v[j] * rstd * gm[j]; }
    }
}

__device__ __forceinline__ void ph_s5_scan(const Ctx& F) {
    if (F.tid >= 32) return;
    const float* S = (const float*)(F.ws + WS_S5S); f16* SA = (f16*)(F.ws + WS_S5A);
    for (int gt = F.bid * 32 + F.tid; gt < 2 * 2 * 32 * 64; gt += F.G * 32) {
        const int nn = gt & 63, g = (gt >> 6) & 31, d = (gt >> 11) & 1, b = gt >> 12;
        const f32x2 at = ((const f32x2*)(F.ws + WS_S5AT))[(d * 32 + g) * 64 + nn];
        f32x2 st = (f32x2){0.f, 0.f};
        f32x2 la[16], lb[16];
#define S5_CHUNK(step) ((d == 0) ? ((step) < 16 ? 1024 + b * 16 + (step) : b * 512 + ((step) - 16)) : ((step) < 16 ? 1024 + b * 16 + (15 - (step)) : b * 512 + (511 - ((step) - 16))))
#define S5_LOAD(dst, base) do { _Pragma("unroll") for (int u = 0; u < 16; ++u) { const int stp = (base) + u < 528 ? (base) + u : 527; const size_t so = ((size_t)S5_CHUNK(stp) * 32 + g) * 256 + d * 128 + nn; dst[u] = (f32x2){S[so], S[so + 64]}; } } while (0)
#define S5_STEP(src, base) do { PIN8(src[0], src[1], src[2], src[3], src[4], src[5], src[6], src[7]); PIN8(src[8], src[9], src[10], src[11], src[12], src[13], src[14], src[15]); \
            _Pragma("unroll") for (int u = 0; u < 16; ++u) { f16* xp = SA + (size_t)S5_CHUNK((base) + u) * 16384 + (size_t)g * 512 + 256 + d * 128 + nn; xp[0] = (f16)st.x; xp[64] = (f16)st.y; st = cmul(at, st) + src[u]; } } while (0)
        S5_LOAD(la, 0);
        for (int base = 0; base < 528; base += 32) {
            S5_LOAD(lb, base + 16);
            S5_STEP(la, base);
            if (base + 16 < 528) { S5_LOAD(la, base + 32); S5_STEP(lb, base + 16); }
        }
#undef S5_CHUNK
#undef S5_LOAD
#undef S5_STEP
    }
}

__device__ __forceinline__ void ph_ffn_fix(const Ctx& F, const ArgsV& AV, int l, int nMr) {
    const float* HALO = (const float*)(F.ws + WS_HALO); f16* ACT = (f16*)(F.ws + WS_ACT);
    const float* cw = AV.in(I_FFCW) + (size_t)l * 3 * FFH; const float* cb = AV.in(I_FFCB) + (size_t)l * FFH;
    const int NT = nMr * 44 * 2 * 128;
    for (int task = F.bid * 512 + F.tid; task < NT; task += F.G * 512) {
        const int c = task & 127, which = (task >> 7) & 1, tile = task >> 8, pn = tile % 44, pm = tile / 44;
        const float* h = HALO + ((size_t)pm * 44 + pn) * 768 + c; const int col = pn * 128 + c;
        const bool first = (pm == 0 || pm == 32 || pm >= 64), last = (pm == 31 || pm >= 63);
        float ap, ac, an, b;
        if (which == 0) { ap = first ? 0.f : HALO[((size_t)(pm - 1) * 44 + pn) * 768 + 3 * 128 + c]; ac = h[0]; an = h[128]; b = h[4 * 128]; }
        else { ap = h[2 * 128]; ac = h[3 * 128]; an = last ? 0.f : HALO[((size_t)(pm + 1) * 44 + pn) * 768 + c]; b = h[5 * 128]; }
        const float a = cw[col] * ap + cw[FFH + col] * ac + cw[2 * FFH + col] * an + cb[col];
        ACT[(size_t)(pm * 256 + (which ? 255 : 0)) * FFH + col] = (f16)(siluf_(a) * b);
    }
}

namespace gla {
constexpr int QK_LD = 136, KH_LD = 72, VT_LD = 72, P_LD = 72;
constexpr int OFF_QT = 0;
constexpr int OFF_KT = 17408;
constexpr int OFF_VT = OFF_KT + 18432;
constexpr int OFF_P = OFF_VT + 36864;
constexpr int OFF_LR = OFF_P + 9216;
constexpr int OFF_GT = OFF_LR + 4096;
constexpr int OFF_DEC = OFF_GT + 2048;
constexpr int OFF_RS = OFF_DEC + 512;
constexpr int OFF_QR = OFF_RS + 2048;
constexpr int OFF_KR = OFF_QR + 17408;
constexpr int OFF_WG = OFF_KR + 17408;
static_assert(OFF_WG + 8192 <= LDSCTL_OFF, "gla lds");

__device__ __forceinline__ int grow(int b, int sc, int j, int i) {
    if (sc < 32) { const int col = 2 * sc + (j >> 1), r = (j & 1) * 64 + i; return b * SEQ + r * 64 + col; }
    return MX + b * LC + j * 64 + i;
}
__device__ __forceinline__ int prow(int b, int sc, int j, int i) {
    return sc < 32 ? b * SEQ + sc * 256 + j * 64 + i : MX + b * LC + j * 64 + i;
}
#define GLA_MFMA(a, b, c) __builtin_amdgcn_mfma_f32_16x16x32_f16(a, b, c, 0, 0, 0)

template <bool FULL>
__device__ __forceinline__ void gla_unit(const Ctx& F, const ArgsV& AV, int l, int unit) {
    const int b = unit / (4 * NSC), h = (unit / NSC) % 4, sc = unit % NSC;
    LAS f16* QT = (LAS f16*)(F.lds + OFF_QT); LAS f16* KT = (LAS f16*)(F.lds + OFF_KT); LAS f16* VT = (LAS f16*)(F.lds + OFF_VT);
    LAS f16* PP = (LAS f16*)(F.lds + OFF_P); LAS f16* LR = (LAS f16*)(F.lds + OFF_LR);
    LAS float* GT = (LAS float*)(F.lds + OFF_GT); LAS float* DEC = (LAS float*)(F.lds + OFF_DEC); LAS float* RS = (LAS float*)(F.lds + OFF_RS);
    LAS f16* QR = (LAS f16*)(F.lds + OFF_QR); LAS f16* KR = (LAS f16*)(F.lds + OFF_KR); LAS float* WG = (LAS float*)(F.lds + OFF_WG);
    const int tid = F.tid, lane = F.lane, w = F.wave, q0 = lane >> 4, c0 = lane & 15;
    const int dk0 = tid & 127, ig0 = tid >> 7;
    const f16* PX = (const f16*)(F.ws + WS_PX);
    const float scale = 0.08838834764831845f;
    for (int dir = 0; dir < 2; ++dir) {
        __syncthreads();
        for (int i = tid; i < 16 * 128; i += 512) WG[i] = AV.in(I_GLAWG)[(((size_t)l * 2 + dir) * 16 + (i >> 7)) * 512 + h * 128 + (i & 127)];
        const float bgv = AV.in(I_GLABG)[((size_t)l * 2 + dir) * 512 + h * 128 + dk0];
        float wgr[16];
#pragma unroll
        for (int r = 0; r < 16; ++r) wgr[r] = AV.in(I_GLAWG)[(((size_t)l * 2 + dir) * 16 + r) * 512 + h * 128 + dk0];
        const size_t sidx = ((((size_t)b * 4 + h) * NSC + sc) * 2 + dir);
        f32x4 accS[8][2];
        if (FULL && sc < 32) { const float* Sin = (const float*)(F.ws + WS_GSIN) + sidx * 32768; const int q = opq(q0), c = opq(c0);
#pragma unroll
            for (int dt = 0; dt < 8; ++dt)
#pragma unroll
                for (int et = 0; et < 2; ++et)
#pragma unroll
                    for (int r = 0; r < 4; ++r) accS[dt][et][r] = Sin[(16 * dt + 4 * q + r) * 256 + 32 * w + 16 * et + c];
            PIN8(accS[0][0], accS[0][1], accS[1][0], accS[1][1], accS[2][0], accS[2][1], accS[3][0], accS[3][1]); PIN8(accS[4][0], accS[4][1], accS[5][0], accS[5][1], accS[6][0], accS[6][1], accS[7][0], accS[7][1]); }
        else {
#pragma unroll
            for (int dt = 0; dt < 8; ++dt)
#pragma unroll
                for (int et = 0; et < 2; ++et) accS[dt][et] = (f32x4){0.f, 0.f, 0.f, 0.f}; }
        float sumtot = 0.f;
#define GLA_FETCH(jn) f16x8 pf_lr, pf_v[4], pf_k[2], pf_q[2]; do { const int tf = opq(F.tid); \
            { const int row = (tf & 255) >> 2, part = tf & 3; pf_lr = *(const f16x8*)(PX + (size_t)prow(b, sc, (jn), row) * PXLD + P_GG + part * 8); } \
            _Pragma("unroll") for (int k = 0; k < 4; ++k) { const int idx = tf + 512 * k, wi = idx >> 6, ln = idx & 63, rr = ln >> 2, cc = ln & 3; const int row = (wi & 3) * 16 + rr, chunk = (wi >> 2) * 4 + cc; \
                pf_v[k] = *(const f16x8*)(PX + (size_t)prow(b, sc, (jn), row) * PXLD + P_GV + h * 256 + chunk * 8); } \
            _Pragma("unroll") for (int k = 0; k < 2; ++k) { const int idx = tf + 512 * k, row = idx >> 4, ch = idx & 15; const size_t ro = (size_t)prow(b, sc, (jn), row) * PXLD; \
                pf_k[k] = *(const f16x8*)(PX + ro + P_GK + h * 128 + ch * 8); if (FULL) pf_q[k] = *(const f16x8*)(PX + ro + P_GQ + h * 128 + ch * 8); else pf_q[k] = pf_k[k]; } } while (0)
        for (int jj = 0; jj < 4; ++jj) {
            const int j = dir ? 3 - jj : jj;
            if (FULL) {
            GLA_FETCH(j);
            __syncthreads();
            const int tid = opq(F.tid);
            PIN8(pf_lr, pf_v[0], pf_v[1], pf_v[2], pf_v[3], pf_k[0], pf_k[1], pf_q[0]); asm volatile("" : "+v"(pf_q[1]));
            if (tid < 256) { const int row = tid >> 2, part = tid & 3; *(LAS f16x8*)(LR + row * 32 + part * 8) = pf_lr; }
#pragma unroll
            for (int k = 0; k < 4; ++k) { const int idx = opq(tid) + 512 * k, wi = idx >> 6, ln = idx & 63, rr = ln >> 2, cc = ln & 3;
                const int row = (wi & 3) * 16 + rr, chunk = (wi >> 2) * 4 + cc; LAS f16* vp = VT + (chunk * 8) * VT_LD + row;
#pragma unroll
                for (int e = 0; e < 8; ++e) vp[e * VT_LD] = pf_v[k][e]; }
#pragma unroll
            for (int k = 0; k < 2; ++k) { const int idx = tid + 512 * k, row = idx >> 4, ch = idx & 15;
                *(LAS f16x8*)(KR + row * QK_LD + ch * 8) = pf_k[k];
                *(LAS f16x8*)(QR + row * QK_LD + ch * 8) = pf_q[k]; }
            } else {
            __syncthreads();
            const int tid = opq(F.tid);
            if (tid < 256) { const int row = tid >> 2, part = tid & 3; const int gr = prow(b, sc, j, row);
                *(LAS f16x8*)(LR + row * 32 + part * 8) = *(const f16x8*)(PX + (size_t)gr * PXLD + P_GG + part * 8); }
#pragma unroll 1
            for (int k = 0; k < 4; ++k) { const int idx = tid + 512 * k, wi = idx >> 6, ln = idx & 63, rr = ln >> 2, cc = ln & 3;
                const int row = (wi & 3) * 16 + rr, chunk = (wi >> 2) * 4 + cc; const int gr = prow(b, sc, j, row);
                const f16x8 v8 = *(const f16x8*)(PX + (size_t)gr * PXLD + P_GV + h * 256 + chunk * 8);
#pragma unroll
                for (int e = 0; e < 8; ++e) VT[(chunk * 8 + e) * VT_LD + row] = v8[e]; }
#pragma unroll 1
            for (int k = 0; k < 2; ++k) { const int idx = tid + 512 * k, row = idx >> 4, ch = idx & 15; const int gr = prow(b, sc, j, row);
                *(LAS f16x8*)(KR + row * QK_LD + ch * 8) = *(const f16x8*)(PX + (size_t)gr * PXLD + P_GK + h * 128 + ch * 8); }
            }
            __syncthreads();
            const int dk = opq(dk0), ig = opq(ig0);
            float bv[16];
#pragma unroll
            for (int ii = 0; ii < 16; ++ii) { const int i = ig * 16 + ii; float pre = bgv;
                const f16x8 l0 = *(const LAS f16x8*)(LR + i * 32 + dir * 16), l1 = *(const LAS f16x8*)(LR + i * 32 + dir * 16 + 8);
#pragma unroll
                for (int r = 0; r < 8; ++r) pre += (float)l0[r] * wgr[r] + (float)l1[r] * wgr[8 + r];
                bv[ii] = logsigmoidf_(pre) * (1.0f / 16.0f); }
            float totloc;
            if (dir == 0) {
#pragma unroll
                for (int ii = 1; ii < 16; ++ii) bv[ii] += bv[ii - 1];
                totloc = bv[15]; }
            else {
#pragma unroll
                for (int ii = 14; ii >= 0; --ii) bv[ii] += bv[ii + 1];
                totloc = bv[0]; }
            GT[ig * 128 + dk] = totloc;
            __syncthreads();
            const float g0 = GT[dk], g1 = GT[128 + dk], g2 = GT[256 + dk], g3 = GT[384 + dk];
            const float total = (g0 + g1) + (g2 + g3);
            float off, bmid;
            if (dir == 0) { off = (ig > 0 ? g0 : 0.f) + (ig > 1 ? g1 : 0.f) + (ig > 2 ? g2 : 0.f); bmid = g0 + g1; }
            else { off = (ig < 3 ? g3 : 0.f) + (ig < 2 ? g2 : 0.f) + (ig < 1 ? g1 : 0.f); bmid = g2 + g3; }
#pragma unroll
            for (int ii = 0; ii < 16; ++ii) bv[ii] += off;
            if (FULL) {
#pragma unroll
                for (int ii = 0; ii < 16; ++ii) { const int i = ig * 16 + ii;
                    QT[i * QK_LD + dk] = (f16)((float)QR[i * QK_LD + dk] * scale * __expf(fminf(bv[ii] - bmid, 9.f)));
                    KT[i * QK_LD + dk] = (f16)((float)KR[i * QK_LD + dk] * __expf(fminf(bmid - bv[ii], 9.f))); }
                __syncthreads();
                { const int c = opq(c0), q = opq(q0);
#pragma unroll
                for (int s = 0; s < 2; ++s) { const int T = 2 * w + s, it = T >> 2, jt = T & 3; f32x4 a = (f32x4){0.f, 0.f, 0.f, 0.f};
#pragma unroll
                    for (int kk = 0; kk < 4; ++kk) { const f16x8 kf = *(const LAS f16x8*)(KT + (jt * 16 + c) * QK_LD + kk * 32 + 8 * q);
                        const f16x8 qf = *(const LAS f16x8*)(QT + (it * 16 + c) * QK_LD + kk * 32 + 8 * q); a = GLA_MFMA(kf, qf, a); }
                    const int i = it * 16 + c; f16x4 pv;
#pragma unroll
                    for (int r = 0; r < 4; ++r) { const int jx = jt * 16 + 4 * q + r; const bool keep = dir == 0 ? (jx <= i) : (jx >= i); pv[r] = keep ? (f16)a[r] : (f16)0.f; }
                    *(LAS f16x4*)(PP + i * P_LD + jt * 16 + 4 * q) = pv; } }
                __syncthreads();
#pragma unroll
                for (int ii = 0; ii < 16; ++ii) { const int i = ig * 16 + ii; QT[i * QK_LD + dk] = (f16)((float)QR[i * QK_LD + dk] * scale * __expf(bv[ii])); }
            }
            { f16x8 k0, k1;
#pragma unroll
              for (int ii = 0; ii < 8; ++ii) { k0[ii] = (f16)((float)KR[(ig * 16 + ii) * QK_LD + dk] * __expf(total - bv[ii])); k1[ii] = (f16)((float)KR[(ig * 16 + 8 + ii) * QK_LD + dk] * __expf(total - bv[8 + ii])); }
              *(LAS f16x8*)(KT + dk * KH_LD + ig * 16) = k0; *(LAS f16x8*)(KT + dk * KH_LD + ig * 16 + 8) = k1; }
            if (ig == 0) { DEC[dk] = __expf(total); sumtot += total; }
            __syncthreads();
            const int c = opq(c0), q = opq(q0);
            if (FULL) {
                f32x4 accO[4][2];
#pragma unroll
                for (int it = 0; it < 4; ++it)
#pragma unroll
                    for (int et = 0; et < 2; ++et) accO[it][et] = (f32x4){0.f, 0.f, 0.f, 0.f};
#pragma unroll
                for (int et = 0; et < 2; ++et)
#pragma unroll
                    for (int kk = 0; kk < 2; ++kk) { const f16x8 vf = *(const LAS f16x8*)(VT + (32 * w + 16 * et + c) * VT_LD + kk * 32 + 8 * q);
#pragma unroll
                        for (int it = 0; it < 4; ++it) { const f16x8 pf = *(const LAS f16x8*)(PP + (it * 16 + c) * P_LD + kk * 32 + 8 * q); accO[it][et] = GLA_MFMA(vf, pf, accO[it][et]); } asm volatile("" ::: "memory"); }
#pragma unroll
                for (int kb = 0; kb < 4; ++kb)
#pragma unroll
                    for (int et = 0; et < 2; ++et) { f16x8 sf; asm volatile("" ::: "memory");
#pragma unroll
                        for (int e = 0; e < 4; ++e) { sf[e] = (f16)accS[2 * kb][et][e]; sf[4 + e] = (f16)accS[2 * kb + 1][et][e]; }
#pragma unroll
                        for (int it = 0; it < 4; ++it) { const f16x4 lo = *(const LAS f16x4*)(QT + (it * 16 + c) * QK_LD + 32 * kb + 4 * q), hi = *(const LAS f16x4*)(QT + (it * 16 + c) * QK_LD + 32 * kb + 16 + 4 * q);
                            f16x8 qf; qf[0] = lo[0]; qf[1] = lo[1]; qf[2] = lo[2]; qf[3] = lo[3]; qf[4] = hi[0]; qf[5] = hi[1]; qf[6] = hi[2]; qf[7] = hi[3];
                            accO[it][et] = GLA_MFMA(sf, qf, accO[it][et]); } }
                float* OF = (float*)(F.ws + WS_GOF);
                if (dir == 0) {
#pragma unroll
                    for (int it = 0; it < 4; ++it) { const int gr = prow(b, sc, j, it * 16 + c);
#pragma unroll
                        for (int et = 0; et < 2; ++et) *(f32x4*)(OF + (size_t)gr * 1024 + h * 256 + 32 * w + 16 * et + 4 * q) = accO[it][et];
                        asm volatile("" ::: "memory"); } }
                else {
                    int grs[4]; f32x4 ofv[4][2]; f16x4 rvv[4][2];
#pragma unroll
                    for (int it = 0; it < 4; ++it) { grs[it] = prow(b, sc, j, it * 16 + c);
#pragma unroll
                        for (int et = 0; et < 2; ++et) { ofv[it][et] = *(const f32x4*)(OF + (size_t)grs[it] * 1024 + h * 256 + 32 * w + 16 * et + 4 * q);
                            rvv[it][et] = *(const f16x4*)(PX + (size_t)grs[it] * PXLD + P_GR + h * 256 + 32 * w + 16 * et + 4 * q); } }
                    PIN8(ofv[0][0], ofv[0][1], ofv[1][0], ofv[1][1], ofv[2][0], ofv[2][1], ofv[3][0], ofv[3][1]);
#pragma unroll
                    for (int it = 0; it < 4; ++it) { float ss = 0.f;
#pragma unroll
                        for (int et = 0; et < 2; ++et) { accO[it][et] = accO[it][et] + ofv[it][et];
                            ss += (accO[it][et][0] * accO[it][et][0] + accO[it][et][1] * accO[it][et][1]) + (accO[it][et][2] * accO[it][et][2] + accO[it][et][3] * accO[it][et][3]); }
                        ss += __shfl_xor(ss, 16); ss += __shfl_xor(ss, 32);
                        if (q == 0) RS[(it * 16 + c) * 8 + w] = ss; }
                    __syncthreads();
                    PIN8(rvv[0][0], rvv[0][1], rvv[1][0], rvv[1][1], rvv[2][0], rvv[2][1], rvv[3][0], rvv[3][1]);
                    const float* ng = AV.in(I_GLANG) + (size_t)l * 256;
                    f16* Y = (f16*)(F.ws + WS_YCAT);
#pragma unroll
                    for (int it = 0; it < 4; ++it) { const int i = it * 16 + c; const f32x4 ra = *(const LAS f32x4*)(RS + i * 8), rb = *(const LAS f32x4*)(RS + i * 8 + 4);
                        const float tot = ((ra[0] + ra[1]) + (ra[2] + ra[3])) + ((rb[0] + rb[1]) + (rb[2] + rb[3]));
                        const float rstd = 1.0f / sqrtf(tot * (1.0f / 256.0f) + EPS);
#pragma unroll
                        for (int et = 0; et < 2; ++et) { const int e0 = 32 * w + 16 * et + 4 * q;
                            const f32x4 gv = *(const f32x4*)(ng + e0);
                            f16x4 o;
#pragma unroll
                            for (int r = 0; r < 4; ++r) o[r] = lowtog((f16)(accO[it][et][r] * rstd * gv[r] * siluf_((float)rvv[it][et][r])));
                            *(f16x4*)(Y + (size_t)grow(b, sc, j, it * 16 + c) * 2048 + 1024 + h * 256 + e0) = o; } }
                }
            }
#pragma unroll
            for (int dt = 0; dt < 8; ++dt) { const f32x4 dv = *(const LAS f32x4*)(DEC + 16 * dt + 4 * q);
#pragma unroll
                for (int et = 0; et < 2; ++et) accS[dt][et] = accS[dt][et] * dv; }
#pragma unroll
            for (int kk = 0; kk < 2; ++kk) { f16x8 vf[2];
#pragma unroll
                for (int et = 0; et < 2; ++et) vf[et] = *(const LAS f16x8*)(VT + (32 * w + 16 * et + c) * VT_LD + kk * 32 + 8 * q);
#pragma unroll
                for (int dt = 0; dt < 8; ++dt) { const f16x8 kf = *(const LAS f16x8*)(KT + (16 * dt + c) * KH_LD + kk * 32 + 8 * q);
#pragma unroll
                    for (int et = 0; et < 2; ++et) accS[dt][et] = GLA_MFMA(kf, vf[et], accS[dt][et]); if (dt & 1) asm volatile("" ::: "memory"); } }
        }
        if (!FULL) { float* Sl = (float*)(F.ws + WS_GSLOC) + sidx * 32768; const int q = opq(q0), c = opq(c0);
#pragma unroll
            for (int dt = 0; dt < 8; ++dt)
#pragma unroll
                for (int et = 0; et < 2; ++et)
#pragma unroll
                    for (int r = 0; r < 4; ++r) Sl[(16 * dt + 4 * q + r) * 256 + 32 * w + 16 * et + c] = accS[dt][et][r];
            if (ig0 == 0) ((float*)(F.ws + WS_GDT))[sidx * 128 + dk0] = __expf(sumtot); }
        VM_WAIT();
    }
}
__device__ __forceinline__ void ph_gla_scan(const Ctx& F) {
    const float* Sl = (const float*)(F.ws + WS_GSLOC); float* Si = (float*)(F.ws + WS_GSIN); const float* Dt = (const float*)(F.ws + WS_GDT);
    if (F.tid < 64) return;
    for (int gt = F.bid * 448 + (F.tid - 64); gt < 2 * 4 * 2 * 32768; gt += F.G * 448) {
        const int e = gt & 32767, dir = (gt >> 15) & 1, h = (gt >> 16) & 3, b = gt >> 18;
        float S = 0.f;
        for (int base = 0; base < NSC; base += 11) {
            float sl[11], dt[11]; size_t ix[11];
#pragma unroll
            for (int u = 0; u < 11; ++u) { const int step = base + u; const int sc = step == 0 ? 32 : (dir == 0 ? step - 1 : 32 - step);
                const size_t idx = ((((size_t)b * 4 + h) * NSC + sc) * 2 + dir); ix[u] = idx;
                sl[u] = Sl[idx * 32768 + e]; dt[u] = Dt[idx * 128 + (e >> 8)]; }
            PIN8(sl[0], sl[1], sl[2], sl[3], sl[4], sl[5], sl[6], sl[7]); PIN8(dt[0], dt[1], dt[2], dt[3], dt[4], dt[5], dt[6], dt[7]); PIN4(sl[8], sl[9], sl[10], dt[8]); asm volatile("" : "+v"(dt[9]), "+v"(dt[10]));
#pragma unroll
            for (int u = 0; u < 11; ++u) { Si[ix[u] * 32768 + e] = S; S = dt[u] * S + sl[u]; }
        }
    }
}
#undef GLA_FETCH
#undef GLA_MFMA
}

namespace hy {
#define PADI(i) ((i) + ((i) >> 5))
constexpr int HY_BUF_BYTES = (16384 + 512) * 8;
constexpr int HY_SCR_OFF = HY_BUF_BYTES;
static_assert(HY_SCR_OFF + 2048 <= LDSCTL_OFF, "hyena lds");
__device__ __forceinline__ f32x2 twid(int k, float invN) { const float xr = (float)k * invN; return (f32x2){__builtin_amdgcn_cosf(xr), -__builtin_amdgcn_sinf(xr)}; }
__device__ __forceinline__ f32x2 mul_w16(f32x2 d, int a) {
    constexpr float c1 = 0.9238795325112867f, s1 = 0.3826834323650898f, r = 0.7071067811865476f;
    float c, s;
    switch (a & 15) {
        case 0: return d; case 4: return (f32x2){d.y, -d.x}; case 8: return (f32x2){-d.x, -d.y}; case 12: return (f32x2){-d.y, d.x};
        case 1: c = c1; s = s1; break; case 2: c = r; s = r; break; case 3: c = s1; s = c1; break;
        case 5: c = -s1; s = c1; break; case 6: c = -r; s = r; break; case 7: c = -c1; s = s1; break;
        case 9: c = -c1; s = -s1; break; case 10: c = -r; s = -r; break; case 11: c = -s1; s = -c1; break;
        case 13: c = s1; s = -c1; break; case 14: c = r; s = -r; break; default: c = c1; s = -s1; break; }
    return (f32x2){d.x * c + d.y * s, d.y * c - d.x * s};
}
template <int R> __device__ __forceinline__ void dif_pass(LAS f32x2* x, int m, int lh, int tid) {
    const int N = 1 << m; const float invN = 1.0f / (float)N; const int lg = lh - R + 1, g = 1 << lg, S = (N >> 1) >> lh;
    for (int q = tid; q < (N >> R); q += 512) { const int j = q & (g - 1), blk = q >> lg, base = (blk << (lh + 1)) + j;
        f32x2 v[1 << R];
#pragma unroll
        for (int k = 0; k < (1 << R); ++k) v[k] = x[PADI(base + k * g)];
        f32x2 w = twid(j * S, invN);
#pragma unroll
        for (int s = 0; s < R; ++s) { const int half = 1 << (R - 1 - s);
#pragma unroll
            for (int k = 0; k < (1 << R); ++k) if (!(k & half)) { const f32x2 a = v[k], b = v[k + half]; v[k] = a + b;
                v[k + half] = mul_w16(cmul(a - b, w), ((k & (half - 1)) << s) * (16 >> R)); }
            w = cmul(w, w); }
#pragma unroll
        for (int k = 0; k < (1 << R); ++k) x[PADI(base + k * g)] = v[k]; }
    __syncthreads();
}
template <int R> __device__ __forceinline__ void dit_pass(LAS f32x2* x, int m, int lh, int tid) {
    const int N = 1 << m; const float invN = 1.0f / (float)N; const int h = 1 << lh, S1 = (N >> 1) >> lh;
    for (int q = tid; q < (N >> R); q += 512) { const int j = q & (h - 1), blk = q >> lh, base = (blk << (lh + R)) + j;
        f32x2 v[1 << R];
#pragma unroll
        for (int k = 0; k < (1 << R); ++k) v[k] = x[PADI(base + k * h)];
        f32x2 wp[R]; wp[R - 1] = cconj(twid(j * (S1 >> (R - 1)), invN));
#pragma unroll
        for (int s = R - 2; s >= 0; --s) wp[s] = cmul(wp[s + 1], wp[s + 1]);
#pragma unroll
        for (int s = 0; s < R; ++s) { const int half = 1 << s;
#pragma unroll
            for (int k = 0; k < (1 << R); ++k) if (!(k & half)) { const f32x2 a = v[k];
                const f32x2 b = mul_w16(cmul(v[k + half], wp[s]), (16 - (k & (half - 1)) * (16 >> (s + 1))) & 15);
                v[k] = a + b; v[k + half] = a - b; } }
#pragma unroll
        for (int k = 0; k < (1 << R); ++k) x[PADI(base + k * h)] = v[k]; }
    __syncthreads();
}
__device__ __forceinline__ void fft_fwd(LAS f32x2* x, int m, int tid) {
    int lh = m - 1;
    while (lh + 1 >= 4) { dif_pass<4>(x, m, lh, tid); lh -= 4; }
    if (lh + 1 == 2) dif_pass<2>(x, m, 1, tid); else if (lh + 1 == 1) dif_pass<1>(x, m, 0, tid);
}
__device__ __forceinline__ void fft_inv(LAS f32x2* x, int m, int tid) {
    int lh = 0;
    while (m - lh >= 4) { dit_pass<4>(x, m, lh, tid); lh += 4; }
    if (m - lh == 2) dit_pass<2>(x, m, lh, tid); else if (m - lh == 1) dit_pass<1>(x, m, lh, tid);
}
__device__ __forceinline__ int brev(int k, int m) { return (int)(__brev((unsigned)k) >> (32 - m)); }

__device__ __forceinline__ void filt_unit(const Ctx& F, const ArgsV& AV, int l, int unit) {
    const int kind = unit >> 9, o = (unit >> 8) & 1, pair = unit & 255;
    const int n = kind ? LC : SEQ, m = kind ? 9 : 14, N = 2 * n, tid = F.tid;
    LAS f32x2* buf = (LAS f32x2*)F.lds;
    LAS float* W3 = (LAS float*)(F.lds + HY_SCR_OFF);
    LAS float* B3 = W3 + 256;
    LAS float* RED = B3 + 4;
    LAS float* INV = RED + 16;
    __syncthreads();
    if (tid < 4) { const int ci = tid; const int col = o * 1024 + (ci >> 1) * 512 + 2 * pair + (ci & 1); B3[ci] = AV.in(I_HYB3)[(size_t)l * 2048 + col]; }
    __syncthreads();
    const int lane = F.lane, q = lane >> 4, c = lane & 15;
    f16x8 wB0, wB1;
    { const int col = o * 1024 + ((c & 3) >> 1) * 512 + 2 * pair + (c & 1); const float* w3 = AV.in(I_HYW3) + (size_t)l * 64 * 2048 + col;
#pragma unroll
      for (int j = 0; j < 8; ++j) { wB0[j] = c < 4 ? (f16)w3[(size_t)(8 * q + j) * 2048] : (f16)0.f; wB1[j] = c < 4 ? (f16)w3[(size_t)(32 + 8 * q + j) * 2048] : (f16)0.f; } }
    const f16* H2H = (const f16*)(F.ws + WS_H2H) + ((size_t)l * (SEQ + LC) + (kind ? SEQ : 0)) * 64;
    const float lo = -3.0701134573253945f, hi = -15.350567286626973f;
    const float ra = fabsf(lo + (hi - lo) * (float)(2 * pair) / 511.0f), rb = fabsf(lo + (hi - lo) * (float)(2 * pair + 1) / 511.0f);
    const float rate = (c & 1) ? rb : ra, bias3 = B3[c & 3];
    float sabs = 0.f;
    for (int tile = F.wave; tile < (n >> 4); tile += 8) { const int t0 = tile * 16;
        const f16x8 a0 = *(const f16x8*)(H2H + (size_t)(t0 + c) * 64 + 8 * q), a1 = *(const f16x8*)(H2H + (size_t)(t0 + c) * 64 + 32 + 8 * q);
        f32x4 acc = (f32x4){0.f, 0.f, 0.f, 0.f};
        acc = __builtin_amdgcn_mfma_f32_16x16x32_f16(a0, wB0, acc, 0, 0, 0); acc = __builtin_amdgcn_mfma_f32_16x16x32_f16(a1, wB1, acc, 0, 0, 0);
        if (c < 4) {
#pragma unroll
            for (int i = 0; i < 4; ++i) { const int t = t0 + 4 * q + i; const float v = (acc[i] + bias3) * expf(-((float)t / (float)(n - 1)) * rate);
                LAS float* bp = (LAS float*)buf;
                if (c < 2) { bp[2 * PADI(t) + c] = v; sabs += fabsf(v); }
                else if (t >= 1) { bp[2 * PADI(N - t) + (c - 2)] = v; sabs += fabsf(v); } } }
    }
    float sa = (c == 0 || c == 2) ? sabs : 0.f, sb = (c == 1 || c == 3) ? sabs : 0.f;
    if (tid == 0) { float z0 = 0.f; asm volatile("" : "+v"(z0)); buf[PADI(n)] = (f32x2){z0, z0}; }
    sa = wave_sum(sa); sb = wave_sum(sb);
    if (F.lane == 0) { RED[F.wave * 2] = sa; RED[F.wave * 2 + 1] = sb; }
    __syncthreads();
    if (tid < 2) { float s = 0.f;
#pragma unroll
        for (int w = 0; w < 8; ++w) s += RED[w * 2 + tid];
        INV[tid] = 1.0f / (s + EPS); }
    __syncthreads();
    { const float ia = INV[0], ib = INV[1];
      for (int i = tid; i < N; i += 512) { f32x2 v = buf[PADI(i)]; v.x *= ia; v.y *= ib; buf[PADI(i)] = v; } }
    __syncthreads();
    fft_fwd(buf, m, tid);
    f32x4* out = (f32x4*)(F.ws + ((l & 1) ? WS_FSD2 : WS_FSD) + (kind ? FSD_C_OFF : 0)) + (size_t)(o * 256 + pair) * (n + 1);
    for (int u = tid; u <= n; u += 512) { const int p = u < n ? 2 * u : 1, k = brev(p, m), pn = brev((N - k) & (N - 1), m);
        const f32x2 zk = buf[PADI(p)], zn = cconj(buf[PADI(pn)]);
        const f32x2 fa = (zk + zn) * 0.5f, df = zk - zn, fb = (f32x2){df.y * 0.5f, -df.x * 0.5f};
        const f32x2 fs = (fa + fb) * 0.5f, fd = (fa - fb) * 0.5f;
        out[u] = (f32x4){fs.x, fs.y, fd.x, fd.y}; }
    __syncthreads();
}

__device__ __forceinline__ void main_unit(const Ctx& F, const ArgsV& AV, int l, int unit) {
    const int kind = unit >> 9, b = (unit >> 8) & 1, pair = unit & 255;
    const int n = kind ? LC : SEQ, m = kind ? 9 : 14, N = 2 * n, tid = F.tid;
    const int row0 = kind ? MX + b * LC : b * SEQ;
    LAS f32x2* buf = (LAS f32x2*)F.lds;
    const f16* ZT = (const f16*)(F.ws + WS_ZT) + (size_t)(2 * pair) * MT + row0;
    const float* cw = AV.in(I_HYCW) + (size_t)l * 3 * 1536 + 2 * pair; const float* cb = AV.in(I_HYCB) + (size_t)l * 1536 + 2 * pair;
    f32x2 yv[16], g1[16], g2[16];
#pragma unroll
    for (int g = 0; g < 3; ++g)
#pragma unroll
        for (int cc = 0; cc < 2; ++cc) { const float w0 = cw[g * 512 + cc], w1 = cw[1536 + g * 512 + cc], w2 = cw[3072 + g * 512 + cc], bs = cb[g * 512 + cc];
            const f16* zt = ZT + (size_t)(g * 512 + cc) * MT;
#pragma unroll
            for (int gi = 0; gi < 2; ++gi) { const int t0 = 8 * (tid + 512 * gi);
                f16x8 mv; float pv = 0.f, nv = 0.f;
#pragma unroll
                for (int e = 0; e < 8; ++e) mv[e] = (f16)0.f;
                if (t0 < n) { mv = *(const f16x8*)(zt + t0); if (t0 > 0) pv = (float)zt[t0 - 1]; if (t0 + 8 < n) nv = (float)zt[t0 + 8]; }
#pragma unroll
                for (int e = 0; e < 8; ++e) { const float zm = e == 0 ? pv : (float)mv[e == 0 ? 0 : e - 1], zc = (float)mv[e], zp = e == 7 ? nv : (float)mv[e == 7 ? 7 : e + 1];
                    const float r = w0 * zm + w1 * zc + w2 * zp + bs;
                    if (g == 0) { if (cc == 0) yv[gi * 8 + e].x = r; else yv[gi * 8 + e].y = r; }
                    else if (g == 1) { if (cc == 0) g1[gi * 8 + e].x = r; else g1[gi * 8 + e].y = r; }
                    else { if (cc == 0) g2[gi * 8 + e].x = r; else g2[gi * 8 + e].y = r; } } } }
    const float invN = 1.0f / (float)N;
#pragma unroll
    for (int o = 0; o < 2; ++o) {
        __syncthreads();
        float z0 = 0.f; asm volatile("" : "+v"(z0));
#pragma unroll
        for (int gi = 0; gi < 2; ++gi) { const int t0 = 8 * (tid + 512 * gi);
            if (t0 < n) {
#pragma unroll
                for (int e = 0; e < 8; ++e) { buf[PADI(t0 + e)] = yv[gi * 8 + e]; buf[PADI(n + t0 + e)] = (f32x2){z0, z0}; } } }
        __syncthreads();
        fft_fwd(buf, m, tid);
        const f32x4* fsd = (const f32x4*)(F.ws + ((l & 1) ? WS_FSD2 : WS_FSD) + (kind ? FSD_C_OFF : 0)) + (size_t)(o * 256 + pair) * (n + 1);
        for (int u = tid; u <= n; u += 512) { const int p = u < n ? 2 * u : 1, k = brev(p, m), pn = brev((N - k) & (N - 1), m);
            const f32x2 zk = buf[PADI(p)], zn = buf[PADI(pn)]; const f32x4 f = fsd[u]; const f32x2 fs = (f32x2){f[0], f[1]}, fd = (f32x2){f[2], f[3]};
            const f32x2 wk = cmul(zk, fs) + cmul(cconj(zn), fd), wn = cmul(zn, cconj(fs)) + cmul(cconj(zk), cconj(fd));
            buf[PADI(pn)] = wn; buf[PADI(p)] = wk; }
        __syncthreads();
        fft_inv(buf, m, tid);
        const float* hb = AV.in(I_HYBIAS) + ((size_t)l * 2 + o) * 512 + 2 * pair; const f32x2 bias = (f32x2){hb[0], hb[1]};
#pragma unroll
        for (int gi = 0; gi < 2; ++gi) { const int t0 = 8 * (tid + 512 * gi);
            if (t0 < n) {
#pragma unroll
                for (int e = 0; e < 8; ++e) { const f32x2 cv = buf[PADI(t0 + e)] * invN; const f32x2 gt = o == 0 ? g1[gi * 8 + e] : g2[gi * 8 + e];
                    yv[gi * 8 + e] = gt * (cv + yv[gi * 8 + e] * bias); } } }
    }
    f16* Y = (f16*)(F.ws + WS_YBT) + (size_t)(2 * pair) * MT + row0;
#pragma unroll
    for (int gi = 0; gi < 2; ++gi) { const int t0 = 8 * (tid + 512 * gi);
        if (t0 < n) { f16x8 oa, ob;
#pragma unroll
            for (int e = 0; e < 8; ++e) { oa[e] = lowtog((f16)yv[gi * 8 + e].x); ob[e] = lowtog((f16)yv[gi * 8 + e].y); }
            *(f16x8*)(Y + t0) = oa; *(f16x8*)(Y + MT + t0) = ob; } }
    __syncthreads();
}

__device__ __forceinline__ void ph_ybt_transpose(const Ctx& F) {
    LAS f16* T = (LAS f16*)F.lds;
    const f16* YBT = (const f16*)(F.ws + WS_YBT); f16* Y = (f16*)(F.ws + WS_YCAT);
    const bool bal = (F.G == 256);
    for (int it = 0; it < (bal ? 2 : (MT / 64 + F.G - 1) / F.G); ++it) {
        int rb;
        if (bal) { if (F.bid >= 132) rb = (F.bid - 132) + 124 * it; else if (F.bid < 16 && it == 0) rb = 248 + F.bid; else rb = -1; }
        else rb = F.bid + it * F.G;
        if (rb < 0 || rb >= MT / 64) continue;
        const int r0 = rb * 64;
        __syncthreads();
        { f16x8 tv[8];
#pragma unroll
          for (int i = 0; i < 8; ++i) tv[i] = *(const f16x8*)(YBT + (size_t)F.tid * MT + r0 + 8 * i);
          PIN8(tv[0], tv[1], tv[2], tv[3], tv[4], tv[5], tv[6], tv[7]);
#pragma unroll
          for (int i = 0; i < 8; ++i) *(LAS f16x8*)(T + F.tid * 72 + 8 * i) = tv[i]; }
        __syncthreads();
        const int row = F.tid >> 3, cg = F.tid & 7;
#pragma unroll
        for (int jj = 0; jj < 8; ++jj) { const int gidx = cg + 8 * jj; f16x8 o;
#pragma unroll
            for (int e = 0; e < 8; ++e) o[e] = T[(8 * gidx + e) * 72 + row];
            *(f16x8*)(Y + (size_t)(r0 + row) * 2048 + 512 + 8 * gidx) = o; }
    }
    __syncthreads();
}
#undef PADI
}

#ifndef PHMASK
#define PHMASK 0xFFFF
#endif
#define PH_EN(k) (((PHMASK) >> (k)) & 1)
#ifndef STAMP_MASK
#define STAMP_MASK 0
#endif
#ifndef STAMP_K
#define STAMP_K 1
#endif
#ifndef SUBMASK
#define SUBMASK 7
#endif
#define SUB_EN(k) (((SUBMASK) >> (k)) & 1)
constexpr int NPH = 2 + 12 * DEPTH;
constexpr int CW_Q = 8192;
__device__ __forceinline__ int q_pull(unsigned* ctr, volatile LAS int* slot) {
    __syncthreads();
    if (threadIdx.x == 0) *slot = (int)__hip_atomic_fetch_add(ctr, 1u, __ATOMIC_RELAXED, __HIP_MEMORY_SCOPE_AGENT);
    __syncthreads();
    return *slot;
}

__global__ void __launch_bounds__(512, 2) mk_fwd(Args args) {
    extern __shared__ __attribute__((aligned(16))) unsigned char lds_raw[];
    Ctx F; F.lds = (LAS unsigned char*)lds_raw; F.tid = threadIdx.x; F.lane = F.tid & 63; F.wave = __builtin_amdgcn_readfirstlane(F.tid >> 6);
    F.G = gridDim.x; F.bid = blockIdx.x; F.ws = args.ws;
    ArgsV AV; AV.out = args.out;
    const Ctx F0 = F;
#define FRESH() do { F.tid = opq(F0.tid); F.lane = F.tid & 63; F.wave = __builtin_amdgcn_readfirstlane(F.tid >> 6); } while (0)
    volatile LAS unsigned* MISC = (volatile LAS unsigned*)(F.lds + LDSCTL_OFF);
    if (F.tid < 64) MISC[F.tid] = 0u;
    __syncthreads();
    unsigned* barw = (unsigned*)(F.ws + WS_CTL) + CW_BAR;
    XcdBarrier bar; bar.bar = barw; bar.x = 0; bar.st = nullptr;
    const int lo = args.ph_lo, hi = args.ph_hi;
    if (hi - lo > 1) bar = xcd_barrier_post(barw, MISC + 8);
#define IN(k) (lo <= (k) && (k) < hi)
#define SEAM(k) do { if (IN(k) && IN((k) + 1)) xcd_barrier(bar); } while (0)
#if STAMP_MASK
    volatile LAS unsigned long long* TS = (volatile LAS unsigned long long*)(F.lds + LDSCTL_OFF + 128);
#define TSTART(k) do { if ((((STAMP_MASK) >> (k)) & 1) && blockIdx.x == 0 && threadIdx.x == 0) TS[0] = __builtin_amdgcn_s_memrealtime(); } while (0)
#define TSTOP(k) do { if ((((STAMP_MASK) >> (k)) & 1) && blockIdx.x == 0 && threadIdx.x == 0) TS[1] = TS[1] + (__builtin_amdgcn_s_memrealtime() - TS[0]); } while (0)
#else
#define TSTART(k) do {} while (0)
#define TSTOP(k) do {} while (0)
#endif
    unsigned char* ws = F.ws;
    const int rank160 = (F.bid + F.G - 160 % F.G) % F.G;

    TSTART(12);
    if (PH_EN(12) && IN(0)) { FRESH(); ph_prologue(F, AV); for (int l2 = 0; l2 < DEPTH; ++l2) { FRESH(); ph_hyena_h2(F, AV, l2); } }
    SEAM(0);
    TSTOP(12);

    for (int l = 0; l < DEPTH; ++l) {
        const int pb = 1 + 12 * l;
        const float* modl = (const float*)(ws + WS_MOD) + (size_t)l * 3 * 12288;
        const bool ctx_on = l < DEPTH - 1;
        const int nMr = ctx_on ? MT / 256 : MX / 256, nrows = ctx_on ? MT : MX;
        TSTART(0);
        if (PH_EN(0) && IN(pb + 0)) {
            FRESH(); ph_convert_weights(F, AV, l);
            __syncthreads();
            FRESH(); if (F.bid < 32) s5_mats_group(F, AV, l, F.bid);
            FRESH(); ph_norm(F, AV, l, 0, MT, l > 0 ? 11 : 0);
        }
        SEAM(pb + 0);
        TSTOP(0);
        TSTART(1);
        if (PH_EN(1) && IN(pb + 1)) {
            pg8::SchedPlain S; S.init(MT / 256, WINN / 256, F.G, F.bid); S.A = (const char*)(ws + WS_HN); S.B = (const char*)(ws + WS_WIN); S.aTile = (size_t)256 * 2048 * 2; S.bTile = (size_t)256 * 2048 * 2;
            pg8::EpiPx E{(f16*)(ws + WS_PX), (f16*)(ws + WS_S5A), (f16*)(ws + WS_ZT), (f16*)(ws + WS_GTL)};
            pg8::gemm_phase(F.lds, 2048, 2048, 32, S, E);
        }
        SEAM(pb + 1);
        TSTOP(1);
        TSTART(2);
        if (PH_EN(2) && IN(pb + 2)) {
            TSTART(16);
            if (SUB_EN(0)) { pg8::SchedS5 S{(const char*)(ws + WS_S5A), (const char*)(ws + WS_S5M), (size_t)256 * 256 * 2, F.G, F.bid};
              pg8::EpiS5In E{(float*)(ws + WS_S5S)};
              pg8::gemm_phase(F.lds, 16384, 256, 4, S, E); }
            TSTOP(16);
            { unsigned* qc = (unsigned*)(ws + WS_CTL) + CW_Q + (l * 2 + 0) * 64; volatile LAS int* slot = (volatile LAS int*)(MISC + 16);
              const bool pre = (l > 0 && F.G == 256);
              const int nq = 264 + (pre ? 272 : 1024);
              for (;;) { const int u = q_pull(qc, slot); if (u >= nq) break;
                  if (u < 264) { TSTART(17); FRESH(); gla::gla_unit<false>(F, AV, l, u); TSTOP(17); } else { TSTART(18); FRESH(); hy::filt_unit(F, AV, l, pre ? 240 + (u - 264) : u - 264); TSTOP(18); } } }
        }
        SEAM(pb + 2);
        TSTOP(2);
        TSTART(3);
        if (PH_EN(3) && IN(pb + 3)) { FRESH(); ph_s5_scan(F); FRESH(); gla::ph_gla_scan(F); }
        SEAM(pb + 3);
        TSTOP(3);
        TSTART(4);
        if (PH_EN(4) && IN(pb + 4)) {
            TSTART(19);
            if (SUB_EN(0)) { pg8::SchedS5 S{(const char*)(ws + WS_S5A), (const char*)(ws + WS_S5W), (size_t)256 * 512 * 2, F.G, F.bid};
              pg8::EpiS5Out E{(const f16*)(ws + WS_S5A), (f16*)(ws + WS_YAPRE), AV.in(I_S5D) + (size_t)l * 512};
              pg8::gemm_phase(F.lds, 16384, 512, 8, S, E); }
            TSTOP(19);
            { unsigned* qc = (unsigned*)(ws + WS_CTL) + CW_Q + (l * 2 + 1) * 64; volatile LAS int* slot = (volatile LAS int*)(MISC + 16);
              for (;;) { const int u = q_pull(qc, slot); if (u >= 264 + 1024) break;
                  if (u < 264) { TSTART(20); FRESH(); gla::gla_unit<true>(F, AV, l, u); TSTOP(20); } else { TSTART(21); FRESH(); hy::main_unit(F, AV, l, u - 264); TSTOP(21); } } }
        }
        SEAM(pb + 4);
        TSTOP(4);
        TSTART(5);
        if (PH_EN(5) && IN(pb + 5)) {
            pg8::SchedPlain S; S.init(nMr, 2, F.G, F.bid); S.A = (const char*)(ws + WS_YAPRE); S.B = (const char*)(ws + WS_WGLU); S.aTile = (size_t)256 * 512 * 2; S.bTile = (size_t)256 * 512 * 2;
            pg8::EpiGlu E{(const f16*)(ws + WS_YAPRE), (f16*)(ws + WS_YCAT), AV.in(I_GLUB) + (size_t)l * 512};
            pg8::gemm_phase(F.lds, 512, 512, 8, S, E);
            FRESH(); hy::ph_ybt_transpose(F);
        }
        SEAM(pb + 5);
        TSTOP(5);
        TSTART(6);
        if (PH_EN(6) && IN(pb + 6)) {
            pg8::SchedPlain S; S.init(nMr, 8, F.G, F.bid); S.aTile = (size_t)256 * 2048 * 2; S.bTile = (size_t)256 * 2048 * 2;
            S.A = (const char*)(ws + WS_YCAT); S.B = (const char*)(ws + WS_WBR);
            pg8::EpiBranchF E{(const f16*)(ws + WS_GTL), (f16*)(ws + WS_MBUF)};
            pg8::gemm_phase(F.lds, 2048, 2048, 32, S, E);
            if (l + 1 < DEPTH && F.G == 256) { unsigned* qc = (unsigned*)(ws + WS_CTL) + CW_Q + 1024 + l * 64; volatile LAS int* slot = (volatile LAS int*)(MISC + 16);
              for (;;) { if (F.bid < 16) break; const int u = q_pull(qc, slot); if (u >= 240) break; FRESH(); hy::filt_unit(F, AV, l + 1, u); } }
#ifdef PG_DUMMY
            { pg8::EpiF16 E9{(f16*)(ws + WS_ACT), 2048}; pg8::gemm_phase(F.lds, 2048, 2048, 32, S, E9); }
#endif
        }
        SEAM(pb + 6);
        TSTOP(6);
        TSTART(7);
        if (PH_EN(7) && IN(pb + 7)) {
            pg8::SchedPlain S; S.init(MX / 256, 8, F.G, F.bid); S.A = (const char*)(ws + WS_MBUF); S.B = (const char*)(ws + WS_WOUT); S.aTile = (size_t)256 * 2048 * 2; S.bTile = (size_t)256 * 2048 * 2;
            pg8::EpiResid E{(float*)(ws + WS_XRES), modl, 4096, l == 0 ? AV.in(I_X) : (const float*)(ws + WS_XRES)};
            pg8::gemm_phase(F.lds, 2048, 2048, 32, S, E);
            if (ctx_on) { pg8::SchedSplit S2{(const char*)(ws + WS_MBUF), (const char*)(ws + WS_WOUT), (size_t)256 * 2048 * 2, (size_t)256 * 2048 * 2, (size_t)8 * 128, 4, F.G, F.bid};
                pg8::EpiSlab E2{(float*)(ws + WS_SLAB), modl, 4096};
                pg8::gemm_phase(F.lds, 2048, 2048, 8, S2, E2); }
            if (l + 1 < DEPTH && F.G == 256) { unsigned* qc = (unsigned*)(ws + WS_CTL) + CW_Q + 1024 + l * 64 + 32; volatile LAS int* slot = (volatile LAS int*)(MISC + 16);
              for (;;) { const int u = q_pull(qc, slot); if (u >= 512) break; FRESH(); hy::filt_unit(F, AV, l + 1, 512 + u); } }
        }
        SEAM(pb + 7);
        TSTOP(7);
        TSTART(8);
        if (PH_EN(8) && IN(pb + 8)) { FRESH(); ph_norm(F, AV, l, 1, nrows, 4); }
        SEAM(pb + 8);
        TSTOP(8);
        TSTART(9);
        if (PH_EN(9) && IN(pb + 9)) {
            pg8::SchedPlain S; S.init(nMr, UPLD / 256, F.G, F.bid); S.A = (const char*)(ws + WS_HN); S.B = (const char*)(ws + WS_WUP); S.aTile = (size_t)256 * 2048 * 2; S.bTile = (size_t)256 * 2048 * 2;
            pg8::EpiUpAct E{(f16*)(ws + WS_ACT), (float*)(ws + WS_HALO), AV.in(I_FFCW) + (size_t)l * 3 * FFH, AV.in(I_FFCB) + (size_t)l * FFH, (LAS float*)(F.lds + EXTRA_OFF)};
            pg8::gemm_phase(F.lds, 2048, 2048, 32, S, E);
        }
        SEAM(pb + 9);
        TSTOP(9);
        TSTART(10);
        if (PH_EN(10) && IN(pb + 10)) { FRESH(); ph_ffn_fix(F, AV, l, nMr); }
        SEAM(pb + 10);
        TSTOP(10);
        TSTART(11);
        if (PH_EN(11) && IN(pb + 11)) {
            pg8::SchedPlain S; S.init(MX / 256, 8, F.G, F.bid); S.A = (const char*)(ws + WS_ACT); S.B = (const char*)(ws + WS_WDN); S.aTile = (size_t)256 * FFH * 2; S.bTile = (size_t)256 * FFH * 2;
            pg8::EpiResid E{(float*)(ws + WS_XRES), modl, 10240, (const float*)(ws + WS_XRES)};
            pg8::gemm_phase(F.lds, FFH, FFH, FFH / 64, S, E);
            if (ctx_on) { pg8::SchedSplit S2{(const char*)(ws + WS_ACT), (const char*)(ws + WS_WDN), (size_t)256 * FFH * 2, (size_t)256 * FFH * 2, (size_t)8 * 128, 11, F.G, F.bid};
                pg8::EpiSlab E2{(float*)(ws + WS_SLAB), modl, 10240};
                pg8::gemm_phase(F.lds, FFH, FFH, 8, S2, E2); }
        }
        SEAM(pb + 11);
        TSTOP(11);
    }
    if (PH_EN(13) && IN(NPH - 1)) { FRESH(); ph_final_norm(F, AV); }
#if STAMP_MASK
    if (blockIdx.x == 0 && threadIdx.x == 0) { const unsigned long long t0 = __builtin_amdgcn_s_memrealtime(); while (__builtin_amdgcn_s_memrealtime() - t0 < (unsigned long long)(STAMP_K) * TS[1]) __builtin_amdgcn_s_sleep(8); }
#endif
#undef IN
#undef SEAM
#undef FRESH
}

extern "C" void kernel_launch(void* const* d_in, const int* in_sizes, int n_in, void* d_out, int out_size, void* d_ws, size_t ws_size, hipStream_t stream) {
    static int grid = 0;
    if (grid == 0) {
        if (n_in != 40 || out_size != MX * D || ws_size < WS_END) { fprintf(stderr, "kernel_launch: unexpected problem (n_in %d out %d ws %zu, need %zu)\n", n_in, out_size, ws_size, (size_t)WS_END); grid = -1; return; }
        int dev = 0, cus = 0, per_cu = 0;
        if (hipGetDevice(&dev) != hipSuccess || hipDeviceGetAttribute(&cus, hipDeviceAttributeMultiprocessorCount, dev) != hipSuccess) { grid = -1; return; }
        if (hipFuncSetAttribute((const void*)mk_fwd, hipFuncAttributeMaxDynamicSharedMemorySize, LDS_BYTES) != hipSuccess) { fprintf(stderr, "kernel_launch: hipFuncSetAttribute failed\n"); grid = -1; return; }
        if (hipOccupancyMaxActiveBlocksPerMultiprocessor(&per_cu, (const void*)mk_fwd, 512, LDS_BYTES) != hipSuccess || per_cu < 1)
            fprintf(stderr, "kernel_launch: occupancy query reports %d\n", per_cu);
        (void)hipGetLastError();
        grid = cus;
    }
    if (grid < 0) return;
    if (hipMemsetAsync((char*)d_ws + WS_CTL, 0, CTL_ZERO_BYTES, stream) != hipSuccess) return;
    Args a{};
    for (int i = 0; i < 40; ++i) a.in[i] = (const float*)d_in[i];
    a.out = (float*)d_out; a.ws = (unsigned char*)d_ws;
#if MK_ONE
    a.ph_lo = 0; a.ph_hi = NPH;
    hipLaunchKernelGGL(mk_fwd, dim3(grid), dim3(512), LDS_BYTES, stream, a);
#else
    for (int p = 0; p < NPH; ++p) { a.ph_lo = p; a.ph_hi = p + 1; hipLaunchKernelGGL(mk_fwd, dim3(grid), dim3(512), LDS_BYTES, stream, a); }
#endif
}
```

```cpp
#include <hip/hip_runtime.h>
#include <stdio.h>

#ifndef MK_ONE
#define MK_ONE 1
#define STAMP_MASK 0
#define STAMP_K 1
#define STAMP_BID 0
#endif

#define GAS __attribute__((address_space(1)))
#define LAS __attribute__((address_space(3)))
typedef _Float16 f16;
typedef _Float16 f16x8 __attribute__((ext_vector_type(8)));
typedef _Float16 f16x4 __attribute__((ext_vector_type(4)));
typedef _Float16 f16x2 __attribute__((ext_vector_type(2)));
typedef float f32x4 __attribute__((ext_vector_type(4)));
typedef float f32x2 __attribute__((ext_vector_type(2)));

constexpr int D = 2048, NB = 2, SEQ = 8192, LC = 256, DEPTH = 4;
constexpr int MX = NB * SEQ, MC = NB * LC, MT = MX + MC;
constexpr int PXLD = 3840, WINN = 11520, FFH = 5632, UPLD = 2 * FFH;
constexpr int P_S5 = 0, P_GK = 512, P_GV = 1024, P_GQ = 2048, P_GR = 2560, P_HY = 3584, P_MG = 5120, P_GG = 3584, W_GG = 11264;
constexpr int INW = 11296;
constexpr int NCHK = 1056;
constexpr float S5SCALE = 1024.f;
constexpr float EPS = 1e-6f;
constexpr int NSC = 33;

constexpr size_t MiB = 1u << 20;
constexpr size_t WS_CTL = 0, CTL_ZERO_BYTES = 1 * MiB;
constexpr size_t WS_MOD = 1 * MiB;
constexpr size_t WS_TW = 2 * MiB;
constexpr size_t WS_S5AT = 3 * MiB;
constexpr size_t WS_WIN = 4 * MiB;
constexpr size_t WS_WGLU = WS_WIN + 45 * MiB;
constexpr size_t WS_WBR = WS_WGLU + 1 * MiB;
constexpr size_t WS_WOUT = WS_WBR + 8 * MiB;
constexpr size_t WS_WUP = WS_WOUT + 8 * MiB;
constexpr size_t WS_WDN = WS_WUP + 44 * MiB;
constexpr size_t WS_S5W = WS_WDN + 22 * MiB;
constexpr size_t WS_S5M = WS_S5W + 8 * MiB;
constexpr size_t WS_H2 = WS_S5M + 4 * MiB;
constexpr size_t WS_FSD = WS_H2 + 3 * MiB;
constexpr size_t FSD_C_OFF = (size_t)2 * 256 * 8193 * 16;
constexpr size_t WS_XRES = WS_FSD + 68 * MiB;
constexpr size_t WS_HN = WS_XRES + 132 * MiB;
constexpr size_t WS_PX = WS_HN + 66 * MiB;
constexpr size_t WS_S5A = WS_PX + 372 * MiB;
constexpr size_t WS_S5S = WS_S5A + 40 * MiB;
constexpr size_t WS_YAPRE = WS_S5S + 40 * MiB;
constexpr size_t WS_YCAT = WS_YAPRE + 20 * MiB;
constexpr size_t WS_MBUF = WS_YCAT + 66 * MiB;
constexpr size_t WS_GSLOC = WS_MBUF + 66 * MiB;
constexpr size_t WS_GSIN = WS_GSLOC + 66 * MiB;
constexpr size_t WS_GOF = WS_GSIN + 66 * MiB;
constexpr size_t WS_GDT = WS_GOF + 66 * MiB;
constexpr size_t WS_ACT = WS_GSLOC;
constexpr size_t WS_ZT = WS_GDT + 1 * MiB;
constexpr size_t WS_YBT = WS_ZT + 50 * MiB;
constexpr size_t WS_SLAB = WS_YBT + 17 * MiB;
constexpr size_t WS_HALO = WS_SLAB + 44 * MiB;
constexpr size_t WS_GTL = WS_HALO + 9 * MiB;
constexpr size_t WS_END = WS_GTL + 198 * MiB;
constexpr size_t WS_FSD2 = WS_PX + 124 * MiB;
constexpr size_t WS_W2 = WS_FSD2 + 68 * MiB;
constexpr size_t WS_H2H = WS_W2 + 128 * MiB;
static_assert(WS_H2H + 5 * MiB <= WS_PX + 372 * MiB, "PX tail");
static_assert((size_t)MT * FFH * 2 <= 198 * MiB, "ACT overlay");
constexpr int CW_BAR = 4096;

constexpr int RING_BYTES = 131072;
constexpr int EXTRA_OFF = RING_BYTES, EXTRA_BYTES = 8192;
constexpr int LDSCTL_OFF = EXTRA_OFF + EXTRA_BYTES;
constexpr int LDS_BYTES = LDSCTL_OFF + 256;

__device__ __forceinline__ float wave_sum(float v) {
#pragma unroll
    for (int o = 1; o < 64; o <<= 1) v += __shfl_xor(v, o);
    return v;
}
__device__ __forceinline__ float sigmoidf_(float x) { return 1.0f / (1.0f + __expf(-x)); }
__device__ __forceinline__ float siluf_(float x) { return x * sigmoidf_(x); }
__device__ __forceinline__ float gelu_tanh_(float x) { const float u = 0.7978845608028654f * (x + 0.044715f * x * x * x); return x / (1.0f + __expf(-2.0f * u)); }
__device__ __forceinline__ float logsigmoidf_(float x) { return fminf(x, 0.f) - __logf(1.0f + __expf(-fabsf(x))); }
__device__ __forceinline__ f32x2 cmul(f32x2 a, f32x2 b) { return (f32x2){a.x * b.x - a.y * b.y, a.x * b.y + a.y * b.x}; }
__device__ __forceinline__ f32x2 cconj(f32x2 a) { return (f32x2){a.x, -a.y}; }
__device__ __forceinline__ int opq(int x) { asm volatile("" : "+v"(x)); return x; }
#define PIN8(a, b, c, d, e, f, g, h) asm volatile("" : "+v"(a), "+v"(b), "+v"(c), "+v"(d), "+v"(e), "+v"(f), "+v"(g), "+v"(h))
#define PIN4(a, b, c, d) asm volatile("" : "+v"(a), "+v"(b), "+v"(c), "+v"(d))
#ifndef OPBITS_DROP
#define OPBITS_DROP 4
#endif
__device__ __forceinline__ f16 lowtog(f16 h) { unsigned short u = __builtin_bit_cast(unsigned short, h); constexpr unsigned short M = (unsigned short)((1u << OPBITS_DROP) - 1u);
    u = (unsigned short)((u + (M >> 1) + ((u >> OPBITS_DROP) & 1u)) & (unsigned short)~M); return __builtin_bit_cast(f16, u); }
#define LDS_WAIT() asm volatile("s_waitcnt lgkmcnt(0)" ::: "memory")
#define VM_WAIT() asm volatile("s_waitcnt vmcnt(0)" ::: "memory")

#define XB_TMO      128
#define XB_XCNT(j)  (256  + 64 * (j))
#define XB_XSUB(j)  (1280 + 64 * (j))
#define XB_XGEN(j)  (2304 + 64 * (j))
#define XB_TOP      3328
#define XB_TOPGEN   3392
#define XCD_BAR_WORDS 3456
#define XB_SPIN_CAP (1u << 18)
__device__ __forceinline__ unsigned xb_ld(unsigned* p)              { return __hip_atomic_load(p, __ATOMIC_RELAXED, __HIP_MEMORY_SCOPE_AGENT); }
__device__ __forceinline__ unsigned xb_add(unsigned* p, unsigned v) { return __hip_atomic_fetch_add(p, v, __ATOMIC_RELAXED, __HIP_MEMORY_SCOPE_AGENT); }
__device__ __forceinline__ unsigned xb_xcc_id() { return (unsigned)__builtin_amdgcn_s_getreg((3 << 11) | 20) & 0xFu; }
#define XB_SPIN(cond, bar) do { unsigned _sp = 0; while (cond) { __builtin_amdgcn_s_sleep(1); \
    if ((++_sp & 255u) == 0u) { if (xb_ld(&(bar)[XB_TMO])) break; if (_sp > XB_SPIN_CAP) { atomicAdd(&(bar)[XB_TMO], 1u); break; } } } } while (0)
struct XcdBarrier { unsigned* bar; unsigned x; volatile LAS unsigned* st; };
__device__ __forceinline__ XcdBarrier xcd_barrier_post(unsigned* bar, volatile LAS unsigned* st) {
    XcdBarrier b; b.bar = bar; b.x = xb_xcc_id(); b.st = st;
    if (threadIdx.x == 0) (void)xb_add(&bar[XB_XCNT(b.x)], 1u);
    return b;
}
__device__ __forceinline__ void xcd_barrier_complete(unsigned* bar, unsigned x, unsigned& nloc, unsigned& nx) {
    const unsigned G = gridDim.x * gridDim.y * gridDim.z;
    unsigned sum, cnt, mine, sp = 0u;
    for (;;) {
        sum = 0u; cnt = 0u; mine = 0u;
#pragma unroll
        for (unsigned j = 0; j < 16; ++j) { const unsigned c = xb_ld(&bar[XB_XCNT(j)]); sum += c; cnt += (c > 0u) ? 1u : 0u; mine = (j == x) ? c : mine; }
        if (sum == G) break;
        __builtin_amdgcn_s_sleep(1);
        if ((++sp & 255u) == 0u) { if (xb_ld(&bar[XB_TMO])) break; if (sp > XB_SPIN_CAP) { atomicAdd(&bar[XB_TMO], 1u); break; } }
    }
    nloc = mine > 0u ? mine : 1u; nx = cnt > 0u ? cnt : 1u;
}
__device__ __forceinline__ void xcd_barrier(const XcdBarrier& b) {
    asm volatile("s_waitcnt vmcnt(0)" ::: "memory");
    __syncthreads();
    if (threadIdx.x == 0) {
        unsigned* bar = b.bar;
        __builtin_amdgcn_s_waitcnt(0);
        unsigned nloc = b.st[0], nx = b.st[1];
        if (nloc == 0u) { xcd_barrier_complete(bar, b.x, nloc, nx); b.st[0] = nloc; b.st[1] = nx; }
        const unsigned old = xb_add(&bar[XB_XSUB(b.x)], 1u);
        const unsigned gen = old / nloc;
        if (old + 1u == (gen + 1u) * nloc) {
            __builtin_amdgcn_fence(__ATOMIC_RELEASE, "agent");
            asm volatile("s_waitcnt vmcnt(0)" ::: "memory");
            const unsigned og = xb_add(&bar[XB_TOP], 1u);
            const unsigned tg = og / nx;
            if (og + 1u == (tg + 1u) * nx) xb_add(&bar[XB_TOPGEN], 1u);
            else XB_SPIN(xb_ld(&bar[XB_TOPGEN]) == tg, bar);
            __builtin_amdgcn_fence(__ATOMIC_ACQUIRE, "agent");
            xb_add(&bar[XB_XGEN(b.x)], 1u);
            asm volatile("s_waitcnt vmcnt(0)" ::: "memory");
        } else {
            XB_SPIN(xb_ld(&bar[XB_XGEN(b.x)]) == gen, bar);
            __builtin_amdgcn_fence(__ATOMIC_ACQUIRE, "agent");
            asm volatile("s_waitcnt vmcnt(0)" ::: "memory");
        }
    }
    __syncthreads();
}

struct Args {
    const float* in[40];
    float* out; unsigned char* ws;
    int ph_lo, ph_hi;
};
struct ArgsV {
    __device__ __forceinline__ const float* in(int i) const {
        typedef const __attribute__((address_space(4))) unsigned long long* kp_t;
        kp_t ka = (kp_t)__builtin_amdgcn_kernarg_segment_ptr();
        return (const float*)(*(volatile const __attribute__((address_space(4))) unsigned long long*)(ka + i)); }
    float* out;
};
struct Ctx {
    LAS unsigned char* lds;
    int tid, lane, wave, G, bid;
    unsigned char* ws;
};
enum { I_X = 0, I_C, I_CTX, I_CCTX, I_WMOD, I_BMOD, I_N1G, I_N2G, I_WIN, I_S5ARE, I_S5AIM, I_S5STEP, I_S5BRE, I_S5BIM, I_S5CRE, I_S5CIM,
       I_S5D, I_GLUW, I_GLUB, I_HYCW, I_HYCB, I_HYW1, I_HYB1, I_HYF1, I_HYW2, I_HYB2, I_HYF2, I_HYW3, I_HYB3, I_HYBIAS,
       I_GLAWG, I_GLABG, I_GLANG, I_WBR, I_WOUT, I_WUP, I_FFCW, I_FFCB, I_WDN, I_FNG };

namespace pg8 {
constexpr int BM = 256, BK = 64, HALF = 128, HTB = HALF * BK * 2, STAGE_BYTES = 8 * HTB, NXCD = 8, WGM = 4;
__device__ __forceinline__ int lds_byte(int r, int c) { const int st = (r >> 4) * 2 + (c >> 5), rr = r & 15, cc = c & 31, ob = rr * 64 + cc * 2; return st * 1024 + (ob ^ (((ob >> 9) & 1) << 5)); }
__device__ __forceinline__ void stage_rc(int b, int& R, int& C) { const int st = b / 1024, sb = b % 1024, swz = sb ^ (((sb >> 9) & 1) << 5); R = (st >> 1) * 16 + swz / 64; C = (st & 1) * 32 + (swz % 64) / 2; }
__device__ __forceinline__ int perm32(int rho) { const int n = rho >> 4, i = rho & 15; return 8 * (i >> 2) + 4 * n + (i & 3); }
struct Unit { const char* a; const char* b; int pm, pn; };
struct Order2D {
    int nM, nN, nwg, G, c;
    __device__ __forceinline__ void init(int nM_, int nN_, int G_, int c_) { nM = nM_; nN = nN_; nwg = nM * nN; G = G_; c = c_; }
    __device__ __forceinline__ bool nx(int i, int& pm, int& pn) const {
        const long L = (long)i * G + c; if (L >= nwg) return false;
        int wgid = (int)L; { const int q = nwg / NXCD, r = nwg % NXCD, xcd = wgid % NXCD, off = wgid / NXCD; wgid = (xcd < r ? xcd * (q + 1) : r * (q + 1) + (xcd - r) * q) + off; }
        const int nig = WGM * nN, gid = wgid / nig, fm = gid * WGM, gsz = (nM - fm) < WGM ? (nM - fm) : WGM;
        pm = fm + ((wgid % nig) % gsz); pn = (wgid % nig) / gsz; return true;
    }
};
struct SchedPlain : Order2D {
    const char* A; const char* B; size_t aTile, bTile;
    __device__ __forceinline__ bool next(int i, Unit& u) const { int pm, pn; if (!nx(i, pm, pn)) return false; u.pm = pm; u.pn = pn; u.a = A + (size_t)pm * aTile; u.b = B + (size_t)pn * bTile; return true; }
};
struct SchedSplit {
    const char* A; const char* B; size_t aTile, bTile, ksub; int nsplit, G, c;
    __device__ __forceinline__ bool next(int i, Unit& u) const { const int L = i * G + c; if (L >= 16 * nsplit) return false; const int t = L / nsplit, ks = L % nsplit, pm = 64 + (t >> 3), pn = t & 7;
        u.pm = pm; u.pn = pn | (ks << 8); u.a = A + (size_t)pm * aTile + (size_t)ks * ksub; u.b = B + (size_t)pn * bTile + (size_t)ks * ksub; return true; }
};
struct SchedS5 {
    const char* A; const char* B; size_t bGroup; int G, c;
    __device__ __forceinline__ bool next(int i, Unit& u) const { const int L = i * G + c; if (L >= 160) return false; const int g = L & 31, pm = L >> 5;
        u.pm = pm; u.pn = g; u.a = A + ((size_t)pm * 256 * 16384 + (size_t)g * 512) * 2; u.b = B + (size_t)g * bGroup; return true; }
};

#define PG8_SA(b, h) (((b) * 2 + (h)) * HTB)
#define PG8_SB(b, h) ((4 + (b) * 2 + (h)) * HTB)
#define PG8_STAGE(bufoff, gbase, voff) do { _Pragma("unroll") for (int _i = 0; _i < 2; ++_i) \
        __builtin_amdgcn_global_load_lds((const unsigned*)((const char*)(gbase) + (voff)[_i]), (LAS unsigned*)(lds + (bufoff) + ldsw + _i * 8192), 16, 0, 0); } while (0)
#define PG8_LDA(dst, b, h) do { _Pragma("unroll") for (int m = 0; m < 4; ++m) _Pragma("unroll") for (int k = 0; k < 2; ++k) dst[m][k] = *(const LAS f16x8*)(lds + PG8_SA(b, h) + aoff + m * 2048 + k * 1024); } while (0)
#define PG8_LDB(dst, b, h) do { _Pragma("unroll") for (int n = 0; n < 2; ++n) _Pragma("unroll") for (int k = 0; k < 2; ++k) dst[n][k] = *(const LAS f16x8*)(lds + PG8_SB(b, h) + boff + n * 2048 + k * 1024); } while (0)
#define PG8_MMA(ai, bj, At, Bt) do { __builtin_amdgcn_s_setprio(1); _Pragma("unroll") for (int m = 0; m < 4; ++m) _Pragma("unroll") for (int n = 0; n < 2; ++n) _Pragma("unroll") for (int k = 0; k < 2; ++k) \
        acc[ai][bj][m][n] = __builtin_amdgcn_mfma_f32_16x16x32_f16(Bt[n][k], At[m][k], acc[ai][bj][m][n], 0, 0, 0); __builtin_amdgcn_s_setprio(0); } while (0)
#define PG8_WAIT_V(n) asm volatile("s_waitcnt vmcnt(" #n ")" ::: "memory")
#define PG8_WAIT_L(n) asm volatile("s_waitcnt lgkmcnt(" #n ")" ::: "memory")
#define PG8_BAR __builtin_amdgcn_s_barrier()
#define PG8_SCHED __builtin_amdgcn_sched_barrier(0)

template <class Epi, class Sched>
__device__ __forceinline__ void gemm_phase(LAS unsigned char* lds, const int lda, const int ldb, const int nt, const Sched& S, const Epi& E) {
    const int tid = opq((int)threadIdx.x), wid = __builtin_amdgcn_readfirstlane(tid >> 6), lane = tid & 63, wr = wid >> 2, wc = wid & 3, fr = lane & 15, fq = lane >> 4;
    unsigned voffA[2], voffB[2];
#pragma unroll
    for (int i = 0; i < 2; ++i) { int R, C; stage_rc(tid * 16 + i * 8192, R, C); const int Rb = Epi::PERM ? ((R & ~31) + perm32(R & 31)) : R;
        voffA[i] = (unsigned)(R * lda + C) * 2u; voffB[i] = (unsigned)(Rb * ldb + C) * 2u; }
    const size_t kstep = (size_t)(BK * 2);
    const size_t hstepA = (size_t)HALF * lda * 2, hstepB = (size_t)HALF * ldb * 2;
    const unsigned ldsw = (unsigned)wid * 1024u;
    const int aoff = lds_byte(wr * 64 + fr, fq * 8), boff = lds_byte(wc * 32 + fr, fq * 8);
    Unit cur, nxt; int ui = 0;
    if (!S.next(0, cur)) return;
    f32x4 acc[2][2][4][2];
#pragma unroll
    for (int a = 0; a < 2; ++a)
#pragma unroll
        for (int b = 0; b < 2; ++b)
#pragma unroll
            for (int m = 0; m < 4; ++m)
#pragma unroll
                for (int n = 0; n < 2; ++n) acc[a][b][m][n] = (f32x4){0.f, 0.f, 0.f, 0.f};
    f16x8 At[4][2], B0[2][2], B1[2][2];
    const char* cA = cur.a; const char* cB = cur.b;
    PG8_STAGE(PG8_SB(0, 0), cB, voffB); PG8_STAGE(PG8_SA(0, 0), cA, voffA); PG8_STAGE(PG8_SB(0, 1), cB + hstepB, voffB); PG8_STAGE(PG8_SA(0, 1), cA + hstepA, voffA);
    if (wr == 1) PG8_BAR;
    PG8_WAIT_V(4); PG8_BAR;
    PG8_STAGE(PG8_SB(1, 0), cB + kstep, voffB); PG8_STAGE(PG8_SA(1, 0), cA + kstep, voffA); PG8_STAGE(PG8_SB(1, 1), cB + hstepB + kstep, voffB);
    PG8_WAIT_V(6); PG8_BAR;
    for (;;) {
        const bool has_next = S.next(ui + 1, nxt);
        const char* nA = has_next ? nxt.a : cA; const char* nB = has_next ? nxt.b : cB;
        constexpr int NSEG = Epi::HAS_MID ? 3 : 1;
#pragma unroll
        for (int seg = 0; seg < NSEG; ++seg) {
        const int tb = Epi::HAS_MID ? (seg == 0 ? 0 : (seg == 1 ? Epi::MID1 + 2 : Epi::MID2 + 2)) : 0;
        const int te = Epi::HAS_MID ? (seg == 0 ? Epi::MID1 + 2 : (seg == 1 ? Epi::MID2 + 2 : nt)) : nt;
        for (int t = tb; t < te; t += 2) {
            const bool last = (t == nt - 2);
            const char* a1 = cA + (size_t)(t + 1) * kstep;
            const char* a2 = last ? nA : cA + (size_t)(t + 2) * kstep; const char* b2 = last ? nB : cB + (size_t)(t + 2) * kstep;
            const char* a3 = a2 + kstep; const char* b3 = b2 + kstep;
            PG8_LDB(B0, 0, 0); PG8_SCHED; PG8_LDA(At, 0, 0); PG8_STAGE(PG8_SA(1, 1), a1 + hstepA, voffA);
            PG8_WAIT_L(8); PG8_BAR; PG8_WAIT_L(0); PG8_MMA(0, 0, At, B0); PG8_BAR; PG8_SCHED;
            PG8_LDB(B1, 0, 1); PG8_STAGE(PG8_SB(0, 0), b2, voffB);
            PG8_BAR; PG8_WAIT_L(0); PG8_MMA(0, 1, At, B1); PG8_BAR;
            PG8_LDA(At, 0, 1); PG8_STAGE(PG8_SA(0, 0), a2, voffA);
            PG8_BAR; PG8_WAIT_L(0); PG8_MMA(1, 0, At, B0); PG8_BAR; PG8_SCHED;
            PG8_STAGE(PG8_SB(0, 1), b2 + hstepB, voffB);
            PG8_WAIT_V(6); PG8_BAR; PG8_MMA(1, 1, At, B1); PG8_BAR;
            PG8_LDB(B0, 1, 0); PG8_SCHED; PG8_LDA(At, 1, 0); PG8_STAGE(PG8_SA(0, 1), a2 + hstepA, voffA);
            PG8_WAIT_L(8); PG8_BAR; PG8_WAIT_L(0); PG8_MMA(0, 0, At, B0); PG8_BAR; PG8_SCHED;
            PG8_LDB(B1, 1, 1); PG8_STAGE(PG8_SB(1, 0), b3, voffB);
            PG8_BAR; PG8_WAIT_L(0); PG8_MMA(0, 1, At, B1); PG8_BAR;
            PG8_LDA(At, 1, 1); PG8_STAGE(PG8_SA(1, 0), a3, voffA);
            PG8_BAR; PG8_WAIT_L(0); PG8_MMA(1, 0, At, B0); PG8_BAR; PG8_SCHED;
            PG8_STAGE(PG8_SB(1, 1), b3 + hstepB, voffB);
            PG8_WAIT_V(6); PG8_BAR; PG8_MMA(1, 1, At, B1); PG8_BAR;
        }
        if constexpr (Epi::HAS_MID) { if (seg < 2) {
            E.mid(acc, cur, seg, wr, wc, fr, fq);
        } }
        }
#if STAMP_MASK & (1 << 23)
        if (Epi::HAS_MID && blockIdx.x == 0 && threadIdx.x == 0) ((volatile LAS unsigned long long*)(lds + LDSCTL_OFF + 128))[0] = __builtin_amdgcn_s_memrealtime();
#endif
        E(acc, cur, wr, wc, fr, fq);
#if STAMP_MASK & (1 << 23)
        if (Epi::HAS_MID && blockIdx.x == 0 && threadIdx.x == 0) { volatile LAS unsigned long long* TS = (volatile LAS unsigned long long*)(lds + LDSCTL_OFF + 128); TS[1] = TS[1] + (__builtin_amdgcn_s_memrealtime() - TS[0]); }
#endif
        if (!has_next) break;
#pragma unroll
        for (int a = 0; a < 2; ++a)
#pragma unroll
            for (int b = 0; b < 2; ++b)
#pragma unroll
                for (int m = 0; m < 4; ++m)
#pragma unroll
                    for (int n = 0; n < 2; ++n) acc[a][b][m][n] = (f32x4){0.f, 0.f, 0.f, 0.f};
        cur = nxt; cA = nA; cB = nB; ++ui;
    }
    PG8_WAIT_V(0);
    if (wr == 0) PG8_BAR;
    PG8_BAR;
}
#undef PG8_SA
#undef PG8_SB
#undef PG8_STAGE
#undef PG8_LDA
#undef PG8_LDB
#undef PG8_MMA
#undef PG8_WAIT_V
#undef PG8_WAIT_L
#undef PG8_BAR
#undef PG8_SCHED

typedef const f32x4 (&AccRef)[2][2][4][2];
__device__ __forceinline__ f16x8 lowtog8(f16x8 w) { f16x8 r;
#pragma unroll
    for (int e = 0; e < 8; ++e) r[e] = lowtog(w[e]);
    return r; }
__device__ __forceinline__ f16x8 pack8(f32x4 a, f32x4 b) { f16x8 w; w[0] = (f16)a[0]; w[1] = (f16)a[1]; w[2] = (f16)a[2]; w[3] = (f16)a[3]; w[4] = (f16)b[0]; w[5] = (f16)b[1]; w[6] = (f16)b[2]; w[7] = (f16)b[3]; return w; }

struct EpiPx {
    static constexpr bool PERM = true, HAS_MID = false; static constexpr int MID1 = 0, MID2 = 0; f16* PX; f16* S5A; f16* ZT; f16* GTL;
    __device__ __forceinline__ void operator()(AccRef acc, const Unit& u, int wr, int wc, int fr, int fq) const { fr = opq(fr); fq = opq(fq);
        const int row0 = u.pm * BM + wr * 64 + fr, col0 = u.pn * BM + wc * 32 + 8 * fq;
#pragma unroll
        for (int ai = 0; ai < 2; ++ai)
#pragma unroll
            for (int m = 0; m < 4; ++m) { const int row = row0 + ai * HALF + m * 16;
#pragma unroll
                for (int bj = 0; bj < 2; ++bj) { const int c = col0 + bj * HALF; const f16x8 w = pack8(acc[ai][bj][m][0], acc[ai][bj][m][1]);
                    if (u.pn < 2) *(f16x8*)(S5A + (size_t)(row >> 4) * 16384 + (size_t)(c >> 4) * 512 + (row & 15) * 16 + (c & 15)) = w;
                    else if (u.pn >= 14 && u.pn < 20) {
#pragma unroll
                        for (int j = 0; j < 8; ++j) ZT[(size_t)(c - P_HY + j) * MT + row] = w[j]; }
                    else if (u.pn >= 20 && u.pn < 44) *(f16x8*)(GTL + ((size_t)(u.pn - 20) * 66 + u.pm) * 65536 + (size_t)(row - u.pm * BM) * 256 + (c - u.pn * BM)) = w;
                    else { const int pr = row < MX ? (row & ~8191) + ((row & 63) << 7) + ((row & 8191) >> 6) : row;
                        *(f16x8*)(PX + (size_t)pr * PXLD + (u.pn == 44 ? c - (W_GG - P_GG) : c)) = w; } } }
    }
};
struct EpiF16 {
    static constexpr bool PERM = true, HAS_MID = false; static constexpr int MID1 = 0, MID2 = 0; f16* O; int ldc;
    __device__ __forceinline__ void operator()(AccRef acc, const Unit& u, int wr, int wc, int fr, int fq) const { fr = opq(fr); fq = opq(fq);
        const int row0 = u.pm * BM + wr * 64 + fr, col0 = u.pn * BM + wc * 32 + 8 * fq;
#pragma unroll
        for (int ai = 0; ai < 2; ++ai)
#pragma unroll
            for (int m = 0; m < 4; ++m) { f16* rowp = O + (size_t)(row0 + ai * HALF + m * 16) * ldc + col0;
#pragma unroll
                for (int bj = 0; bj < 2; ++bj) *(f16x8*)(rowp + bj * HALF) = pack8(acc[ai][bj][m][0], acc[ai][bj][m][1]); }
    }
};
struct EpiS5In {
    static constexpr bool PERM = false, HAS_MID = false; static constexpr int MID1 = 0, MID2 = 0; float* S;
    __device__ __forceinline__ void operator()(AccRef acc, const Unit& u, int wr, int wc, int fr, int fq) const { fr = opq(fr); fq = opq(fq);
        const int row0 = u.pm * BM + wr * 64 + fr, col0 = wc * 32 + 4 * fq, g = u.pn;
#pragma unroll
        for (int ai = 0; ai < 2; ++ai)
#pragma unroll
            for (int m = 0; m < 4; ++m) { const int row = row0 + ai * HALF + m * 16; { float* rowp = S + ((size_t)row * 32 + g) * 256 + col0;
#pragma unroll
                for (int bj = 0; bj < 2; ++bj)
#pragma unroll
                    for (int n = 0; n < 2; ++n) *(f32x4*)(rowp + bj * HALF + n * 16) = acc[ai][bj][m][n]; } }
    }
};
struct EpiS5Out {
    static constexpr bool PERM = true, HAS_MID = false; static constexpr int MID1 = 0, MID2 = 0; const f16* S5A; f16* Y; const float* dvec;
    __device__ __forceinline__ void operator()(AccRef acc, const Unit& u, int wr, int wc, int fr, int fq) const { fr = opq(fr); fq = opq(fq);
        const int row0 = u.pm * BM + wr * 64 + fr, col0 = wc * 32 + 8 * fq, g = u.pn;
        const int h0 = col0 & 15;
        const f32x4 d0 = *(const f32x4*)(dvec + g * 16 + h0), d1 = *(const f32x4*)(dvec + g * 16 + h0 + 4);
#pragma unroll
        for (int ai = 0; ai < 2; ++ai) { f16x8 uu[4][2];
#pragma unroll
            for (int m = 0; m < 4; ++m)
#pragma unroll
                for (int bj = 0; bj < 2; ++bj) uu[m][bj] = *(const f16x8*)(S5A + (size_t)(row0 + ai * HALF + m * 16) * 16384 + (size_t)g * 512 + col0 + bj * HALF);
            PIN8(uu[0][0], uu[0][1], uu[1][0], uu[1][1], uu[2][0], uu[2][1], uu[3][0], uu[3][1]);
#pragma unroll
            for (int m = 0; m < 4; ++m) { const int chunk = row0 + ai * HALF + m * 16;
#pragma unroll
                for (int bj = 0; bj < 2; ++bj) { const int c = col0 + bj * HALF, t = c >> 4; f16x8 w;
#pragma unroll
                    for (int j = 0; j < 4; ++j) { w[j] = (f16)gelu_tanh_(acc[ai][bj][m][0][j] * (1.0f / S5SCALE) + d0[j] * (float)uu[m][bj][j]);
                                                  w[4 + j] = (f16)gelu_tanh_(acc[ai][bj][m][1][j] * (1.0f / S5SCALE) + d1[j] * (float)uu[m][bj][4 + j]); }
                    *(f16x8*)(Y + (size_t)(chunk * 16 + t) * 512 + g * 16 + h0) = lowtog8(w); } }
            asm volatile("" ::: "memory"); }
    }
};
struct EpiGlu {
    static constexpr bool PERM = true, HAS_MID = false; static constexpr int MID1 = 0, MID2 = 0; const f16* YP; f16* O; const float* bias;
    __device__ __forceinline__ void operator()(AccRef acc, const Unit& u, int wr, int wc, int fr, int fq) const { fr = opq(fr); fq = opq(fq);
        const int row0 = u.pm * BM + wr * 64 + fr, col0 = u.pn * BM + wc * 32 + 8 * fq;
        f32x4 bv[2][2];
#pragma unroll
        for (int bj = 0; bj < 2; ++bj) { bv[bj][0] = *(const f32x4*)(bias + col0 + bj * HALF); bv[bj][1] = *(const f32x4*)(bias + col0 + bj * HALF + 4); }
#pragma unroll
        for (int ai = 0; ai < 2; ++ai) { f16x8 yp[4][2];
#pragma unroll
            for (int m = 0; m < 4; ++m)
#pragma unroll
                for (int bj = 0; bj < 2; ++bj) yp[m][bj] = *(const f16x8*)(YP + (size_t)(row0 + ai * HALF + m * 16) * 512 + col0 + bj * HALF);
            PIN8(yp[0][0], yp[0][1], yp[1][0], yp[1][1], yp[2][0], yp[2][1], yp[3][0], yp[3][1]);
#pragma unroll
            for (int m = 0; m < 4; ++m)
#pragma unroll
                for (int bj = 0; bj < 2; ++bj) { f16x8 w;
#pragma unroll
                    for (int j = 0; j < 4; ++j) { w[j] = (f16)((float)yp[m][bj][j] * sigmoidf_(acc[ai][bj][m][0][j] + bv[bj][0][j])); w[4 + j] = (f16)((float)yp[m][bj][4 + j] * sigmoidf_(acc[ai][bj][m][1][j] + bv[bj][1][j])); }
                    *(f16x8*)(O + (size_t)(row0 + ai * HALF + m * 16) * 2048 + col0 + bj * HALF) = lowtog8(w); }
            asm volatile("" ::: "memory"); }
    }
};
template <int BR> struct EpiBranch {
    static constexpr bool PERM = true, HAS_MID = false; static constexpr int MID1 = 0, MID2 = 0; const f16* PX; f16* M;
    __device__ __forceinline__ void operator()(AccRef acc, const Unit& u, int wr, int wc, int fr, int fq) const { fr = opq(fr); fq = opq(fq);
        const int row0 = u.pm * BM + wr * 64 + fr, col0 = u.pn * BM + wc * 32 + 8 * fq;
#pragma unroll
        for (int ai = 0; ai < 2; ++ai)
#pragma unroll
            for (int m = 0; m < 4; ++m) { const int row = row0 + ai * HALF + m * 16;
#pragma unroll
                for (int bj = 0; bj < 2; ++bj) { const int c = col0 + bj * HALF;
                    const f16x8 gl = *(const f16x8*)(PX + (size_t)row * PXLD + P_MG + BR * 2048 + c);
                    f16* mp = M + (size_t)row * 2048 + c;
                    f16x8 prev; if (BR > 0) prev = *(const f16x8*)mp;
                    f16x8 w;
#pragma unroll
                    for (int j = 0; j < 4; ++j) { float v0 = sigmoidf_((float)gl[j]) * acc[ai][bj][m][0][j], v1 = sigmoidf_((float)gl[4 + j]) * acc[ai][bj][m][1][j];
                        if (BR > 0) { v0 += (float)prev[j]; v1 += (float)prev[4 + j]; } w[j] = (f16)v0; w[4 + j] = (f16)v1; }
                    *(f16x8*)mp = w; } asm volatile("" ::: "memory"); }
    }
};
typedef f32x4 (&AccMut)[2][2][4][2];

struct EpiBranchF {
    static constexpr bool PERM = true, HAS_MID = true; static constexpr int MID1 = 6, MID2 = 14;
    const f16* GTL; f16* M;
    __device__ __forceinline__ void mid(AccMut acc, const Unit& u, int seg, int wr, int wc, int fr, int fq) const { fr = opq(fr); fq = opq(fq);
        const int lrow0 = wr * 64 + fr, lcol0 = wc * 32 + 8 * fq;
        const f16* ga = GTL + ((size_t)((seg == 0 ? 0 : 8) + u.pn) * 66 + u.pm) * 65536; const f16* gb = ga + (size_t)8 * 66 * 65536;
#pragma unroll
        for (int ai = 0; ai < 2; ++ai) { f16x8 za[4][2], zb[4][2];
#pragma unroll
            for (int m = 0; m < 4; ++m)
#pragma unroll
                for (int bj = 0; bj < 2; ++bj) { const int off = (lrow0 + ai * HALF + m * 16) * 256 + lcol0 + bj * HALF; za[m][bj] = *(const f16x8*)(ga + off); zb[m][bj] = *(const f16x8*)(gb + off); }
            PIN8(za[0][0], za[0][1], za[1][0], za[1][1], za[2][0], za[2][1], za[3][0], za[3][1]); PIN8(zb[0][0], zb[0][1], zb[1][0], zb[1][1], zb[2][0], zb[2][1], zb[3][0], zb[3][1]);
#pragma unroll
            for (int m = 0; m < 4; ++m)
#pragma unroll
                for (int bj = 0; bj < 2; ++bj)
#pragma unroll
                    for (int j = 0; j < 4; ++j) { acc[ai][bj][m][0][j] *= (1.0f + __expf(-(float)zb[m][bj][j])) * __builtin_amdgcn_rcpf(1.0f + __expf(-(float)za[m][bj][j]));
                                                  acc[ai][bj][m][1][j] *= (1.0f + __expf(-(float)zb[m][bj][4 + j])) * __builtin_amdgcn_rcpf(1.0f + __expf(-(float)za[m][bj][4 + j])); }
            asm volatile("" ::: "memory"); }
    }
    __device__ __forceinline__ void operator()(AccRef acc, const Unit& u, int wr, int wc, int fr, int fq) const { fr = opq(fr); fq = opq(fq);
        const int row0 = u.pm * BM + wr * 64 + fr, col0 = u.pn * BM + wc * 32 + 8 * fq;
#pragma unroll
        for (int ai = 0; ai < 2; ++ai) { f16x8 gl[4][2];
#pragma unroll
            for (int m = 0; m < 4; ++m)
#pragma unroll
                for (int bj = 0; bj < 2; ++bj) gl[m][bj] = *(const f16x8*)(GTL + ((size_t)(16 + u.pn) * 66 + u.pm) * 65536 + (wr * 64 + fr + ai * HALF + m * 16) * 256 + wc * 32 + 8 * fq + bj * HALF);
            PIN8(gl[0][0], gl[0][1], gl[1][0], gl[1][1], gl[2][0], gl[2][1], gl[3][0], gl[3][1]);
#pragma unroll
            for (int m = 0; m < 4; ++m)
#pragma unroll
                for (int bj = 0; bj < 2; ++bj) { f16x8 w;
#pragma unroll
                    for (int j = 0; j < 4; ++j) { w[j] = (f16)(sigmoidf_((float)gl[m][bj][j]) * acc[ai][bj][m][0][j]); w[4 + j] = (f16)(sigmoidf_((float)gl[m][bj][4 + j]) * acc[ai][bj][m][1][j]); }
                    *(f16x8*)(M + (size_t)(row0 + ai * HALF + m * 16) * 2048 + col0 + bj * HALF) = lowtog8(w); }
            asm volatile("" ::: "memory"); }
    }
};
struct EpiUpAct {
    static constexpr bool PERM = true, HAS_MID = false; static constexpr int MID1 = 0, MID2 = 0; f16* ACT; float* HALO; const float* cw; const float* cb; LAS float* HL;
    __device__ __forceinline__ void operator()(AccRef acc, const Unit& u, int wr, int wc, int fr, int fq) const { fr = opq(fr); fq = opq(fq);
        const int lane = fq * 16 + fr;
#pragma unroll
        for (int ai = 0; ai < 2; ++ai) { LAS float* hp = HL + ((ai * 2 + wr) * 4 + wc) * 64 + 8 * fq;
            if (fr == 0) { *(LAS f32x4*)(hp) = acc[ai][0][0][0]; *(LAS f32x4*)(hp + 4) = acc[ai][0][0][1]; }
            if (fr == 15) { *(LAS f32x4*)(hp + 32) = acc[ai][0][3][0]; *(LAS f32x4*)(hp + 36) = acc[ai][0][3][1]; } }
        { float* gh = HALO + ((size_t)u.pm * 44 + u.pn) * 768 + wc * 32 + 8 * fq;
          if (wr == 0 && fr < 2) { *(f32x4*)(gh + fr * 128) = acc[0][0][0][0]; *(f32x4*)(gh + fr * 128 + 4) = acc[0][0][0][1]; }
          if (wr == 0 && fr == 0) { *(f32x4*)(gh + 4 * 128) = acc[0][1][0][0]; *(f32x4*)(gh + 4 * 128 + 4) = acc[0][1][0][1]; }
          if (wr == 1 && fr >= 14) { *(f32x4*)(gh + (fr - 12) * 128) = acc[1][0][3][0]; *(f32x4*)(gh + (fr - 12) * 128 + 4) = acc[1][0][3][1]; }
          if (wr == 1 && fr == 15) { *(f32x4*)(gh + 5 * 128) = acc[1][1][3][0]; *(f32x4*)(gh + 5 * 128 + 4) = acc[1][1][3][1]; } }
        asm volatile("s_waitcnt lgkmcnt(0)" ::: "memory"); __builtin_amdgcn_s_barrier(); __builtin_amdgcn_s_barrier(); asm volatile("" ::: "memory");
        const int colg = u.pn * 128 + wc * 32 + 8 * fq;
        const int srcR = (lane & 48) | ((fr + 15) & 15), srcL = (lane & 48) | ((fr + 1) & 15);
        const int row0 = u.pm * BM + wr * 64 + fr;
#pragma unroll
        for (int n = 0; n < 2; ++n) {
            const f32x4 w0 = *(const f32x4*)(cw + colg + 4 * n), w1 = *(const f32x4*)(cw + FFH + colg + 4 * n), w2 = *(const f32x4*)(cw + 2 * FFH + colg + 4 * n), bb = *(const f32x4*)(cb + colg + 4 * n);
#pragma unroll
            for (int ai = 0; ai < 2; ++ai) {
                const bool hasp = (wr == 1) || (ai == 1), hasn = (wr == 0) || (ai == 0);
                const LAS float* pp = HL + (((wr == 1 ? ai : 0) * 2 + (wr == 1 ? 0 : 1)) * 4 + wc) * 64 + 32 + 8 * fq + 4 * n;
                const LAS float* np = HL + (((wr == 0 ? ai : 1) * 2 + (wr == 0 ? 1 : 0)) * 4 + wc) * 64 + 8 * fq + 4 * n;
                const f32x4 hprev = hasp ? *(const LAS f32x4*)pp : (f32x4){0.f, 0.f, 0.f, 0.f}, hnext = hasn ? *(const LAS f32x4*)np : (f32x4){0.f, 0.f, 0.f, 0.f};
                f32x4 R[4], L[4];
#pragma unroll
                for (int m = 0; m < 4; ++m)
#pragma unroll
                    for (int j = 0; j < 4; ++j) { R[m][j] = __shfl(acc[ai][0][m][n][j], srcR); L[m][j] = __shfl(acc[ai][0][m][n][j], srcL); }
#pragma unroll
                for (int m = 0; m < 4; ++m) { const f32x4 pv = fr > 0 ? R[m] : (m > 0 ? R[m > 0 ? m - 1 : 0] : hprev); const f32x4 nv = fr < 15 ? L[m] : (m < 3 ? L[m < 3 ? m + 1 : 3] : hnext);
                    const f32x4 a = w0 * pv + w1 * acc[ai][0][m][n] + w2 * nv + bb;
                    f16x4 o;
#pragma unroll
                    for (int j = 0; j < 4; ++j) o[j] = lowtog((f16)(siluf_(a[j]) * acc[ai][1][m][n][j]));
                    *(f16x4*)(ACT + (size_t)(row0 + ai * HALF + m * 16) * FFH + colg + 4 * n) = o; }
                asm volatile("" ::: "memory");
            }
        }
    }
};
struct EpiSlab {
    static constexpr bool PERM = false, HAS_MID = false; static constexpr int MID1 = 0, MID2 = 0; float* slab; const float* mod; int goff;
    __device__ __forceinline__ void operator()(AccRef acc, const Unit& u, int wr, int wc, int fr, int fq) const { fr = opq(fr); fq = opq(fq);
        const int pn = u.pn & 255, ks = u.pn >> 8;
        const int row0 = (u.pm - 64) * BM + wr * 64 + fr, col0 = pn * BM + wc * 32 + 4 * fq;
        const float* gp = mod + 2 * 12288 + goff + col0;
        f32x4 gv[2][2];
#pragma unroll
        for (int bj = 0; bj < 2; ++bj)
#pragma unroll
            for (int n = 0; n < 2; ++n) gv[bj][n] = *(const f32x4*)(gp + bj * HALF + n * 16);
        float* sp = slab + (size_t)ks * MC * D;
#pragma unroll
        for (int ai = 0; ai < 2; ++ai)
#pragma unroll
            for (int m = 0; m < 4; ++m) { float* rowp = sp + (size_t)(row0 + ai * HALF + m * 16) * D + col0;
#pragma unroll
                for (int bj = 0; bj < 2; ++bj)
#pragma unroll
                    for (int n = 0; n < 2; ++n) *(f32x4*)(rowp + bj * HALF + n * 16) = gv[bj][n] * acc[ai][bj][m][n]; }
    }
};
struct EpiResid {
    static constexpr bool PERM = false, HAS_MID = false; static constexpr int MID1 = 0, MID2 = 0; float* X; const float* mod; int goff; const float* Xs;
    __device__ __forceinline__ void operator()(AccRef acc, const Unit& u, int wr, int wc, int fr, int fq) const { fr = opq(fr); fq = opq(fq);
        const int row0 = u.pm * BM + wr * 64 + fr, col0 = u.pn * BM + wc * 32 + 4 * fq;
        const int bsel = u.pm < 32 ? 0 : (u.pm < 64 ? 1 : 2);
        const float* gp = mod + bsel * 12288 + goff + col0;
        f32x4 gv[2][2];
#pragma unroll
        for (int bj = 0; bj < 2; ++bj)
#pragma unroll
            for (int n = 0; n < 2; ++n) gv[bj][n] = *(const f32x4*)(gp + bj * HALF + n * 16);
#pragma unroll
        for (int ai = 0; ai < 2; ++ai) { f32x4 xv[4][2][2];
#pragma unroll
            for (int m = 0; m < 4; ++m) { const float* rowp = Xs + (size_t)(row0 + ai * HALF + m * 16) * D + col0;
#pragma unroll
                for (int bj = 0; bj < 2; ++bj)
#pragma unroll
                    for (int n = 0; n < 2; ++n) xv[m][bj][n] = *(const f32x4*)(rowp + bj * HALF + n * 16); }
            PIN8(xv[0][0][0], xv[0][0][1], xv[0][1][0], xv[0][1][1], xv[1][0][0], xv[1][0][1], xv[1][1][0], xv[1][1][1]); PIN8(xv[2][0][0], xv[2][0][1], xv[2][1][0], xv[2][1][1], xv[3][0][0], xv[3][0][1], xv[3][1][0], xv[3][1][1]);
#pragma unroll
            for (int m = 0; m < 4; ++m) { float* rowp = X + (size_t)(row0 + ai * HALF + m * 16) * D + col0;
#pragma unroll
                for (int bj = 0; bj < 2; ++bj)
#pragma unroll
                    for (int n = 0; n < 2; ++n) *(f32x4*)(rowp + bj * HALF + n * 16) = xv[m][bj][n] + gv[bj][n] * acc[ai][bj][m][n]; }
            asm volatile("" ::: "memory"); }
    }
};
}


__device__ __forceinline__ void ph_prologue(const Ctx& F, const ArgsV& AV) {
    const int gt = F.bid * 512 + F.tid, NT = F.G * 512;
    { const f32x4* cs = (const f32x4*)AV.in(I_CTX); f32x4* xr = (f32x4*)(F.ws + WS_XRES);
      for (int i = gt; i < MC * D / 4; i += NT) xr[MX * D / 4 + i] = cs[i]; }
    LAS float* sc = (LAS float*)F.lds;
    LAS float* red = (LAS float*)(F.lds + 3 * 2048 * 4);
    for (int i = F.tid; i < 3 * 2048; i += 512) { const int r = i / 2048, k = i % 2048; const float v = r < 2 ? AV.in(I_C)[r * 2048 + k] : AV.in(I_CCTX)[k]; sc[i] = siluf_(v); }
    __syncthreads();
    const int col = F.tid & 63, ks = F.tid >> 6;
    for (int chunk = F.bid; chunk < DEPTH * 192; chunk += F.G) {
        const int l = chunk / 192, n0 = (chunk % 192) * 64;
        const float* w = AV.in(I_WMOD) + (size_t)l * 2048 * 12288 + n0 + col;
        float s0 = 0.f, s1 = 0.f, s2 = 0.f;
#pragma unroll 8
        for (int k = ks * 256; k < ks * 256 + 256; ++k) { const float wv = w[(size_t)k * 12288]; s0 += sc[k] * wv; s1 += sc[2048 + k] * wv; s2 += sc[4096 + k] * wv; }
        red[(ks * 3 + 0) * 64 + col] = s0; red[(ks * 3 + 1) * 64 + col] = s1; red[(ks * 3 + 2) * 64 + col] = s2;
        __syncthreads();
        if (F.tid < 192) { const int r = F.tid >> 6, c2 = F.tid & 63; float s = 0.f;
#pragma unroll
            for (int q = 0; q < 8; ++q) s += red[(q * 3 + r) * 64 + c2];
            ((float*)(F.ws + WS_MOD))[((size_t)l * 3 + r) * 12288 + n0 + c2] = s + AV.in(I_BMOD)[(size_t)l * 12288 + n0 + c2]; }
        __syncthreads();
    }
}

__device__ __forceinline__ void conv_item(const float* W, int ldw, int k0, int srccol, f16* WT, int dstrow, int ldk) {
    float v[64];
    const float* src = W + (size_t)k0 * ldw + (srccol >= 0 ? srccol : 0);
#pragma unroll
    for (int k = 0; k < 64; ++k) v[k] = src[(size_t)k * ldw];
#pragma unroll
    for (int k = 0; k < 64; k += 8) PIN8(v[k], v[k + 1], v[k + 2], v[k + 3], v[k + 4], v[k + 5], v[k + 6], v[k + 7]);
    f16* dst = WT + (size_t)dstrow * ldk + k0;
#pragma unroll
    for (int kg = 0; kg < 8; ++kg) { f16x8 o;
#pragma unroll
        for (int e = 0; e < 8; ++e) o[e] = srccol >= 0 ? lowtog((f16)v[8 * kg + e]) : (f16)0.f;
        *(f16x8*)(dst + 8 * kg) = o; }
}
__device__ __forceinline__ void ph_convert_weights(const Ctx& F, const ArgsV& AV, int l) {
    const int skip = F.G > 64 ? 32 : 0;
    if (F.bid < skip) return;
    const int gw = (F.bid - skip) * 8 + F.wave, NGW = (F.G - skip) * 8, lane = F.lane;
    constexpr int I_IN = 32 * 180, I_GLU = 8 * 8, I_BR = 32 * 32, I_OUT = 32 * 32, I_UP = 32 * 176, I_DN = 88 * 32;
    constexpr int NIT = I_IN + I_GLU + I_BR + I_OUT + I_UP + I_DN;
    for (int it = gw; it < NIT; it += NGW) {
        int r = it;
        if (r < I_IN) { const int kb = r / 180, nb = r % 180, j = nb * 64 + lane;
            const int src = j < 2048 ? j : (j < 11264 ? j + 32 : (j < 11296 ? 2048 + (j - 11264) : -1));
            conv_item(AV.in(I_WIN) + (size_t)l * 2048 * INW, INW, kb * 64, src, (f16*)(F.ws + WS_WIN), j, 2048); continue; } r -= I_IN;
        if (r < I_GLU) { const int kb = r / 8, nb = r % 8, j = nb * 64 + lane; conv_item(AV.in(I_GLUW) + (size_t)l * 512 * 512, 512, kb * 64, j, (f16*)(F.ws + WS_WGLU), j, 512); continue; } r -= I_GLU;
        if (r < I_BR) { const int kb = r / 32, nb = r % 32, j = nb * 64 + lane; conv_item(AV.in(I_WBR) + (size_t)l * 2048 * 2048, 2048, kb * 64, j, (f16*)(F.ws + WS_WBR), j, 2048); continue; } r -= I_BR;
        if (r < I_OUT) { const int kb = r / 32, nb = r % 32, j = nb * 64 + lane; conv_item(AV.in(I_WOUT) + (size_t)l * 2048 * 2048, 2048, kb * 64, j, (f16*)(F.ws + WS_WOUT), j, 2048); continue; } r -= I_OUT;
        if (r < I_UP) { const int kb = r / 176, nb = r % 176, j = nb * 64 + lane, pn = j >> 8, i = j & 255; const int src = i < 128 ? 128 * pn + i : FFH + 128 * pn + (i - 128);
            conv_item(AV.in(I_WUP) + (size_t)l * 2048 * UPLD, UPLD, kb * 64, src, (f16*)(F.ws + WS_WUP), j, 2048); continue; } r -= I_UP;
        { const int kb = r / 32, nb = r % 32, j = nb * 64 + lane; conv_item(AV.in(I_WDN) + (size_t)l * FFH * 2048, 2048, kb * 64, j, (f16*)(F.ws + WS_WDN), j, FFH); }
    }
}

__device__ __forceinline__ void s5_mats_group(const Ctx& F, const ArgsV& AV, int l, int g) {
    LAS f32x2* APOW = (LAS f32x2*)F.lds;
    LAS f32x2* BBAR = APOW + 2 * 17 * 64;
    LAS f32x2* CM = BBAR + 2 * 64 * 16;
    LAS float* KLAG = (LAS float*)(CM + 2 * 16 * 64);
    __syncthreads();
    for (int i = F.tid; i < 2 * 17 * 64; i += 512) { const int d = i / (17 * 64), e = (i / 64) % 17, n = i % 64;
        const size_t pi = (((size_t)l * 2 + d) * 32 + g) * 64 + n;
        const float are = AV.in(I_S5ARE)[pi], aim = AV.in(I_S5AIM)[pi], dt = expf(AV.in(I_S5STEP)[((size_t)l * 2 + d) * 32 + g]);
        const float zr = are * dt * (float)e, zi = aim * dt * (float)e; float s, c; sincosf(zi, &s, &c); const float m = expf(zr);
        APOW[i] = (f32x2){m * c, m * s}; }
    __syncthreads();
    for (int i = F.tid; i < 2 * 64 * 16; i += 512) { const int d = i / 1024, n = (i / 16) % 64, h = i % 16;
        const size_t pi = (((size_t)l * 2 + d) * 32 + g) * 64 + n;
        const float are = AV.in(I_S5ARE)[pi], aim = AV.in(I_S5AIM)[pi];
        const f32x2 ab = APOW[(d * 17 + 1) * 64 + n]; const f32x2 num = (f32x2){ab.x - 1.0f, ab.y};
        const float den = are * are + aim * aim; const f32x2 q = (f32x2){(num.x * are + num.y * aim) / den, (num.y * are - num.x * aim) / den};
        const size_t bi = (pi * 16) + h;
        BBAR[i] = cmul(q, (f32x2){AV.in(I_S5BRE)[bi], AV.in(I_S5BIM)[bi]});
        const size_t ci = ((((size_t)l * 2 + d) * 32 + g) * 16 + h) * 64 + n;
        CM[(d * 16 + h) * 64 + n] = (f32x2){AV.in(I_S5CRE)[ci], AV.in(I_S5CIM)[ci]}; }
    __syncthreads();
    for (int i = F.tid; i < 2 * 16 * 256; i += 512) { const int d = i / 4096, lag = (i / 256) % 16, h = (i / 16) % 16, hp = i % 16; float s = 0.f;
        for (int n = 0; n < 64; ++n) { const f32x2 t = cmul(CM[(d * 16 + h) * 64 + n], APOW[(d * 17 + lag) * 64 + n]); const f32x2 b = BBAR[(d * 64 + n) * 16 + hp]; s += t.x * b.x - t.y * b.y; }
        KLAG[i] = s; }
    __syncthreads();
    f16* W = (f16*)(F.ws + WS_S5W) + (size_t)g * 256 * 512;
    for (int i = F.tid; i < 256 * 64; i += 512) { const int n = i / 64, k8 = (i % 64) * 8, t = n >> 4, h = n & 15; f16x8 o;
#pragma unroll
        for (int e = 0; e < 8; ++e) { const int k = k8 + e; float v;
            if (k < 256) { const int s = k >> 4, hp = k & 15; v = 0.f;
                if (t >= s) v += KLAG[((0 * 16 + (t - s)) * 16 + h) * 16 + hp];
                if (s >= t) v += KLAG[((1 * 16 + (s - t)) * 16 + h) * 16 + hp];
                v *= S5SCALE; }
            else { const int d = (k - 256) >> 7, nn2 = (k - 256) & 127, nn = nn2 & 63, im = nn2 >> 6, ex = d == 0 ? t + 1 : 16 - t;
                const f32x2 z = cmul(CM[(d * 16 + h) * 64 + nn], APOW[(d * 17 + ex) * 64 + nn]); v = im ? -z.y : z.x; }
            o[e] = (f16)v; }
        *(f16x8*)(W + (size_t)n * 512 + k8) = o; }
    f16* Mx = (f16*)(F.ws + WS_S5M) + (size_t)g * 256 * 256;
    for (int i = F.tid; i < 256 * 32; i += 512) { const int n = i / 32, k8 = (i % 32) * 8, d = n >> 7, ri = (n >> 6) & 1, nn = n & 63; f16x8 o;
#pragma unroll
        for (int e = 0; e < 8; ++e) { const int k = k8 + e, s = k >> 4, hp = k & 15, ex = d == 0 ? 15 - s : s;
            const f32x2 z = cmul(APOW[(d * 17 + ex) * 64 + nn], BBAR[(d * 64 + nn) * 16 + hp]); o[e] = (f16)((ri ? z.y : z.x) * S5SCALE); }
        *(f16x8*)(Mx + (size_t)n * 256 + k8) = o; }
    if (F.tid < 128) { const int d = F.tid >> 6, nn = F.tid & 63; ((f32x2*)(F.ws + WS_S5AT))[(d * 32 + g) * 64 + nn] = APOW[(d * 17 + 16) * 64 + nn]; }
    __syncthreads();
}

__device__ __forceinline__ void ph_hyena_h2(const Ctx& F, const ArgsV& AV, int l) {
    LAS float* W1 = (LAS float*)F.lds;
    LAS float* W2 = W1 + 33 * 64;
    LAS float* PV = W2 + 64 * 64;
    LAS float* SCR = PV + 256;
    __syncthreads();
    for (int i = F.tid; i < 33 * 64; i += 512) W1[i] = AV.in(I_HYW1)[(size_t)l * 33 * 64 + i];
    for (int i = F.tid; i < 64 * 64; i += 512) W2[i] = AV.in(I_HYW2)[(size_t)l * 4096 + i];
    if (F.tid < 64) { PV[F.tid] = AV.in(I_HYB1)[l * 64 + F.tid]; PV[64 + F.tid] = AV.in(I_HYF1)[l * 64 + F.tid]; PV[128 + F.tid] = AV.in(I_HYB2)[l * 64 + F.tid]; PV[192 + F.tid] = AV.in(I_HYF2)[l * 64 + F.tid]; }
    __syncthreads();
    LAS float* scr = SCR + F.wave * 64;
    const int gw = F.bid * 8 + F.wave, NGW = F.G * 8, j = F.lane;
    for (int p = gw; p < SEQ + LC; p += NGW) {
        const int n = p < SEQ ? SEQ : LC, pos = p < SEQ ? p : p - SEQ;
        float feat = 0.f;
        if (j == 0) feat = (float)pos / (float)(n - 1);
        else if (j < 33) { const int fi = (j - 1) & 15; const float fr = 1e-4f + (float)fi * ((15.0f - 1e-4f) / 15.0f);
            const float ang = (6.283185307179586f / (float)n) * (float)pos * fr; float s, c; sincosf(ang, &s, &c); feat = j < 17 ? c : -s; }
        scr[j] = feat; LDS_WAIT(); asm volatile("" ::: "memory");
        float a = PV[j];
        for (int i = 0; i < 33; ++i) a += scr[i] * W1[i * 64 + j];
        const float h1 = sinf(PV[64 + j] * a);
        LDS_WAIT(); asm volatile("" ::: "memory");
        scr[j] = h1; LDS_WAIT(); asm volatile("" ::: "memory");
        float b = PV[128 + j];
        for (int i = 0; i < 64; ++i) b += scr[i] * W2[i * 64 + j];
        ((f16*)(F.ws + WS_H2H))[((size_t)l * (SEQ + LC) + p) * 64 + j] = (f16)sinf(PV[192 + j] * b);
        LDS_WAIT(); asm volatile("" ::: "memory");
    }
}

__device__ __forceinline__ void ph_norm(const Ctx& F, const ArgsV& AV, int l, int which, int nrows, int nslab) {
    const int gw = F.bid * 8 + F.wave, NGW = F.G * 8;
    float* X = (float*)(F.ws + WS_XRES); f16* O = (f16*)(F.ws + WS_HN); const float* SL = (const float*)(F.ws + WS_SLAB);
    const float* Xin = (l == 0 && which == 0) ? AV.in(I_X) : X;
    const float* gain = AV.in(which ? I_N2G : I_N1G) + (size_t)l * D;
    const float* mod = (const float*)(F.ws + WS_MOD) + (size_t)l * 3 * 12288;
    const int shoff = which ? 6144 : 0, soff = which ? 8192 : 2048;
    int cur_bsel = -1; f32x4 Am[8], Bm[8], vn[8];
    if (gw < nrows) { const f32x4* xr0 = (const f32x4*)((gw < MX ? Xin : X) + (size_t)gw * D) + F.lane;
#pragma unroll
        for (int j = 0; j < 8; ++j) vn[j] = xr0[64 * j]; }
    for (int m = gw; m < nrows; m += NGW) {
        const int bsel = m < SEQ ? 0 : (m < MX ? 1 : 2);
        f32x4* xr = (f32x4*)(X + (size_t)m * D) + F.lane;
        f32x4 v[8]; float s = 0.f;
        PIN8(vn[0], vn[1], vn[2], vn[3], vn[4], vn[5], vn[6], vn[7]);
#pragma unroll
        for (int j = 0; j < 8; ++j) v[j] = vn[j];
        if (m + NGW < nrows) { const f32x4* xq = (const f32x4*)((m + NGW < MX ? Xin : X) + (size_t)(m + NGW) * D) + F.lane;
#pragma unroll
            for (int j = 0; j < 8; ++j) vn[j] = xq[64 * j]; }
        if (bsel != cur_bsel) { cur_bsel = bsel; const float* mp = mod + bsel * 12288;
#pragma unroll
            for (int j = 0; j < 8; ++j) { const int c = 4 * F.lane + 256 * j; const f32x4 g = *(const f32x4*)(gain + c), sc = *(const f32x4*)(mp + soff + c); Bm[j] = *(const f32x4*)(mp + shoff + c); Am[j] = g * (sc + 1.0f); }
            PIN8(Am[0], Am[1], Am[2], Am[3], Am[4], Am[5], Am[6], Am[7]); PIN8(Bm[0], Bm[1], Bm[2], Bm[3], Bm[4], Bm[5], Bm[6], Bm[7]); }
        if (m >= MX && nslab > 0) {
            for (int sl = 0; sl < nslab; ++sl) { const f32x4* sr = (const f32x4*)(SL + ((size_t)sl * MC + (m - MX)) * D) + F.lane;
#pragma unroll
                for (int j = 0; j < 8; ++j) v[j] = v[j] + sr[64 * j]; }
#pragma unroll
            for (int j = 0; j < 8; ++j) xr[64 * j] = v[j]; }
#pragma unroll
        for (int j = 0; j < 8; ++j) s += (v[j].x * v[j].x + v[j].y * v[j].y) + (v[j].z * v[j].z + v[j].w * v[j].w);
        const float rstd = 1.0f / sqrtf(wave_sum(s) * (1.0f / D) + EPS);
#pragma unroll
        for (int j = 0; j < 8; ++j) { const int c = 4 * F.lane + 256 * j;
            f16x4 o;
#pragma unroll
            for (int e = 0; e < 4; ++e) o[e] = lowtog((f16)(v[j][e] * rstd * Am[j][e] + Bm[j][e]));
            *(f16x4*)(O + (size_t)m * D + c) = o; }
    }
}
__device__ __forceinline__ void ph_final_norm(const Ctx& F, const ArgsV& AV) {
    const int gw = F.bid * 8 + F.wave, NGW = F.G * 8;
    const float* X = (const float*)(F.ws + WS_XRES); const float* gain = AV.in(I_FNG);
    f32x4 gm[8], vn[8];
#pragma unroll
    for (int j = 0; j < 8; ++j) gm[j] = *(const f32x4*)(gain + 4 * F.lane + 256 * j);
    if (gw < MX) { const f32x4* xr0 = (const f32x4*)(X + (size_t)gw * D) + F.lane;
#pragma unroll
        for (int j = 0; j < 8; ++j) vn[j] = xr0[64 * j]; }
    for (int m = gw; m < MX; m += NGW) {
        f32x4 v[8]; float s = 0.f;
        PIN8(vn[0], vn[1], vn[2], vn[3], vn[4], vn[5], vn[6], vn[7]);
#pragma unroll
        for (int j = 0; j < 8; ++j) v[j] = vn[j];
        if (m + NGW < MX) { const f32x4* xq = (const f32x4*)(X + (size_t)(m + NGW) * D) + F.lane;
#pragma unroll
            for (int j = 0; j < 8; ++j) vn[j] = xq[64 * j]; }
#pragma unroll
        for (int j = 0; j < 8; ++j) s += (v[j].x * v[j].x + v[j].y * v[j].y) + (v[j].z * v[j].z + v[j].w * v[j].w);
        const float rstd = 1.0f / sqrtf(wave_sum(s) * (1.0f / D) + EPS);
#pragma unroll
        for (int j = 0; j < 8; ++j) { const int c = 4 * F.lane + 256 * j;
            *(f32x4*)(AV.out + (size_t)m * D + c) = v[j] * rstd * gm[j]; }
    }
}

__device__ __forceinline__ void ph_s5_scan(const Ctx& F) {
    if (F.tid >= 32) return;
    const float* S = (const float*)(F.ws + WS_S5S); f16* SA = (f16*)(F.ws + WS_S5A);
    for (int gt = F.bid * 32 + F.tid; gt < 2 * 2 * 32 * 64; gt += F.G * 32) {
        const int nn = gt & 63, g = (gt >> 6) & 31, d = (gt >> 11) & 1, b = gt >> 12;
        const f32x2 at = ((const f32x2*)(F.ws + WS_S5AT))[(d * 32 + g) * 64 + nn];
        f32x2 st = (f32x2){0.f, 0.f};
        f32x2 la[16], lb[16];
#define S5_CHUNK(step) ((d == 0) ? ((step) < 16 ? 1024 + b * 16 + (step) : b * 512 + ((step) - 16)) : ((step) < 16 ? 1024 + b * 16 + (15 - (step)) : b * 512 + (511 - ((step) - 16))))
#define S5_LOAD(dst, base) do { _Pragma("unroll") for (int u = 0; u < 16; ++u) { const int stp = (base) + u < 528 ? (base) + u : 527; const size_t so = ((size_t)S5_CHUNK(stp) * 32 + g) * 256 + d * 128 + nn; dst[u] = (f32x2){S[so], S[so + 64]}; } } while (0)
#define S5_STEP(src, base) do { PIN8(src[0], src[1], src[2], src[3], src[4], src[5], src[6], src[7]); PIN8(src[8], src[9], src[10], src[11], src[12], src[13], src[14], src[15]); \
            _Pragma("unroll") for (int u = 0; u < 16; ++u) { f16* xp = SA + (size_t)S5_CHUNK((base) + u) * 16384 + (size_t)g * 512 + 256 + d * 128 + nn; xp[0] = (f16)st.x; xp[64] = (f16)st.y; st = cmul(at, st) + src[u]; } } while (0)
        S5_LOAD(la, 0);
        for (int base = 0; base < 528; base += 32) {
            S5_LOAD(lb, base + 16);
            S5_STEP(la, base);
            if (base + 16 < 528) { S5_LOAD(la, base + 32); S5_STEP(lb, base + 16); }
        }
#undef S5_CHUNK
#undef S5_LOAD
#undef S5_STEP
    }
}

__device__ __forceinline__ void ph_ffn_fix(const Ctx& F, const ArgsV& AV, int l, int nMr) {
    const float* HALO = (const float*)(F.ws + WS_HALO); f16* ACT = (f16*)(F.ws + WS_ACT);
    const float* cw = AV.in(I_FFCW) + (size_t)l * 3 * FFH; const float* cb = AV.in(I_FFCB) + (size_t)l * FFH;
    const int NT = nMr * 44 * 2 * 128;
    for (int task = F.bid * 512 + F.tid; task < NT; task += F.G * 512) {
        const int c = task & 127, which = (task >> 7) & 1, tile = task >> 8, pn = tile % 44, pm = tile / 44;
        const float* h = HALO + ((size_t)pm * 44 + pn) * 768 + c; const int col = pn * 128 + c;
        const bool first = (pm == 0 || pm == 32 || pm >= 64), last = (pm == 31 || pm >= 63);
        float ap, ac, an, b;
        if (which == 0) { ap = first ? 0.f : HALO[((size_t)(pm - 1) * 44 + pn) * 768 + 3 * 128 + c]; ac = h[0]; an = h[128]; b = h[4 * 128]; }
        else { ap = h[2 * 128]; ac = h[3 * 128]; an = last ? 0.f : HALO[((size_t)(pm + 1) * 44 + pn) * 768 + c]; b = h[5 * 128]; }
        const float a = cw[col] * ap + cw[FFH + col] * ac + cw[2 * FFH + col] * an + cb[col];
        ACT[(size_t)(pm * 256 + (which ? 255 : 0)) * FFH + col] = (f16)(siluf_(a) * b);
    }
}

namespace gla {
constexpr int QK_LD = 136, KH_LD = 72, VT_LD = 72, P_LD = 72;
constexpr int OFF_QT = 0;
constexpr int OFF_KT = 17408;
constexpr int OFF_VT = OFF_KT + 18432;
constexpr int OFF_P = OFF_VT + 36864;
constexpr int OFF_LR = OFF_P + 9216;
constexpr int OFF_GT = OFF_LR + 4096;
constexpr int OFF_DEC = OFF_GT + 2048;
constexpr int OFF_RS = OFF_DEC + 512;
constexpr int OFF_QR = OFF_RS + 2048;
constexpr int OFF_KR = OFF_QR + 17408;
constexpr int OFF_WG = OFF_KR + 17408;
static_assert(OFF_WG + 8192 <= LDSCTL_OFF, "gla lds");

__device__ __forceinline__ int grow(int b, int sc, int j, int i) {
    if (sc < 32) { const int col = 2 * sc + (j >> 1), r = (j & 1) * 64 + i; return b * SEQ + r * 64 + col; }
    return MX + b * LC + j * 64 + i;
}
__device__ __forceinline__ int prow(int b, int sc, int j, int i) {
    return sc < 32 ? b * SEQ + sc * 256 + j * 64 + i : MX + b * LC + j * 64 + i;
}
#define GLA_MFMA(a, b, c) __builtin_amdgcn_mfma_f32_16x16x32_f16(a, b, c, 0, 0, 0)

template <bool FULL>
__device__ __forceinline__ void gla_unit(const Ctx& F, const ArgsV& AV, int l, int unit) {
    const int b = unit / (4 * NSC), h = (unit / NSC) % 4, sc = unit % NSC;
    LAS f16* QT = (LAS f16*)(F.lds + OFF_QT); LAS f16* KT = (LAS f16*)(F.lds + OFF_KT); LAS f16* VT = (LAS f16*)(F.lds + OFF_VT);
    LAS f16* PP = (LAS f16*)(F.lds + OFF_P); LAS f16* LR = (LAS f16*)(F.lds + OFF_LR);
    LAS float* GT = (LAS float*)(F.lds + OFF_GT); LAS float* DEC = (LAS float*)(F.lds + OFF_DEC); LAS float* RS = (LAS float*)(F.lds + OFF_RS);
    LAS f16* QR = (LAS f16*)(F.lds + OFF_QR); LAS f16* KR = (LAS f16*)(F.lds + OFF_KR); LAS float* WG = (LAS float*)(F.lds + OFF_WG);
    const int tid = F.tid, lane = F.lane, w = F.wave, q0 = lane >> 4, c0 = lane & 15;
    const int dk0 = tid & 127, ig0 = tid >> 7;
    const f16* PX = (const f16*)(F.ws + WS_PX);
    const float scale = 0.08838834764831845f;
    for (int dir = 0; dir < 2; ++dir) {
        __syncthreads();
        for (int i = tid; i < 16 * 128; i += 512) WG[i] = AV.in(I_GLAWG)[(((size_t)l * 2 + dir) * 16 + (i >> 7)) * 512 + h * 128 + (i & 127)];
        const float bgv = AV.in(I_GLABG)[((size_t)l * 2 + dir) * 512 + h * 128 + dk0];
        float wgr[16];
#pragma unroll
        for (int r = 0; r < 16; ++r) wgr[r] = AV.in(I_GLAWG)[(((size_t)l * 2 + dir) * 16 + r) * 512 + h * 128 + dk0];
        const size_t sidx = ((((size_t)b * 4 + h) * NSC + sc) * 2 + dir);
        f32x4 accS[8][2];
        if (FULL && sc < 32) { const float* Sin = (const float*)(F.ws + WS_GSIN) + sidx * 32768; const int q = opq(q0), c = opq(c0);
#pragma unroll
            for (int dt = 0; dt < 8; ++dt)
#pragma unroll
                for (int et = 0; et < 2; ++et)
#pragma unroll
                    for (int r = 0; r < 4; ++r) accS[dt][et][r] = Sin[(16 * dt + 4 * q + r) * 256 + 32 * w + 16 * et + c];
            PIN8(accS[0][0], accS[0][1], accS[1][0], accS[1][1], accS[2][0], accS[2][1], accS[3][0], accS[3][1]); PIN8(accS[4][0], accS[4][1], accS[5][0], accS[5][1], accS[6][0], accS[6][1], accS[7][0], accS[7][1]); }
        else {
#pragma unroll
            for (int dt = 0; dt < 8; ++dt)
#pragma unroll
                for (int et = 0; et < 2; ++et) accS[dt][et] = (f32x4){0.f, 0.f, 0.f, 0.f}; }
        float sumtot = 0.f;
#define GLA_FETCH(jn) f16x8 pf_lr, pf_v[4], pf_k[2], pf_q[2]; do { const int tf = opq(F.tid); \
            { const int row = (tf & 255) >> 2, part = tf & 3; pf_lr = *(const f16x8*)(PX + (size_t)prow(b, sc, (jn), row) * PXLD + P_GG + part * 8); } \
            _Pragma("unroll") for (int k = 0; k < 4; ++k) { const int idx = tf + 512 * k, wi = idx >> 6, ln = idx & 63, rr = ln >> 2, cc = ln & 3; const int row = (wi & 3) * 16 + rr, chunk = (wi >> 2) * 4 + cc; \
                pf_v[k] = *(const f16x8*)(PX + (size_t)prow(b, sc, (jn), row) * PXLD + P_GV + h * 256 + chunk * 8); } \
            _Pragma("unroll") for (int k = 0; k < 2; ++k) { const int idx = tf + 512 * k, row = idx >> 4, ch = idx & 15; const size_t ro = (size_t)prow(b, sc, (jn), row) * PXLD; \
                pf_k[k] = *(const f16x8*)(PX + ro + P_GK + h * 128 + ch * 8); if (FULL) pf_q[k] = *(const f16x8*)(PX + ro + P_GQ + h * 128 + ch * 8); else pf_q[k] = pf_k[k]; } } while (0)
        for (int jj = 0; jj < 4; ++jj) {
            const int j = dir ? 3 - jj : jj;
            if (FULL) {
            GLA_FETCH(j);
            __syncthreads();
            const int tid = opq(F.tid);
            PIN8(pf_lr, pf_v[0], pf_v[1], pf_v[2], pf_v[3], pf_k[0], pf_k[1], pf_q[0]); asm volatile("" : "+v"(pf_q[1]));
            if (tid < 256) { const int row = tid >> 2, part = tid & 3; *(LAS f16x8*)(LR + row * 32 + part * 8) = pf_lr; }
#pragma unroll
            for (int k = 0; k < 4; ++k) { const int idx = opq(tid) + 512 * k, wi = idx >> 6, ln = idx & 63, rr = ln >> 2, cc = ln & 3;
                const int row = (wi & 3) * 16 + rr, chunk = (wi >> 2) * 4 + cc; LAS f16* vp = VT + (chunk * 8) * VT_LD + row;
#pragma unroll
                for (int e = 0; e < 8; ++e) vp[e * VT_LD] = pf_v[k][e]; }
#pragma unroll
            for (int k = 0; k < 2; ++k) { const int idx = tid + 512 * k, row = idx >> 4, ch = idx & 15;
                *(LAS f16x8*)(KR + row * QK_LD + ch * 8) = pf_k[k];
                *(LAS f16x8*)(QR + row * QK_LD + ch * 8) = pf_q[k]; }
            } else {
            __syncthreads();
            const int tid = opq(F.tid);
            if (tid < 256) { const int row = tid >> 2, part = tid & 3; const int gr = prow(b, sc, j, row);
                *(LAS f16x8*)(LR + row * 32 + part * 8) = *(const f16x8*)(PX + (size_t)gr * PXLD + P_GG + part * 8); }
#pragma unroll 1
            for (int k = 0; k < 4; ++k) { const int idx = tid + 512 * k, wi = idx >> 6, ln = idx & 63, rr = ln >> 2, cc = ln & 3;
                const int row = (wi & 3) * 16 + rr, chunk = (wi >> 2) * 4 + cc; const int gr = prow(b, sc, j, row);
                const f16x8 v8 = *(const f16x8*)(PX + (size_t)gr * PXLD + P_GV + h * 256 + chunk * 8);
#pragma unroll
                for (int e = 0; e < 8; ++e) VT[(chunk * 8 + e) * VT_LD + row] = v8[e]; }
#pragma unroll 1
            for (int k = 0; k < 2; ++k) { const int idx = tid + 512 * k, row = idx >> 4, ch = idx & 15; const int gr = prow(b, sc, j, row);
                *(LAS f16x8*)(KR + row * QK_LD + ch * 8) = *(const f16x8*)(PX + (size_t)gr * PXLD + P_GK + h * 128 + ch * 8); }
            }
            __syncthreads();
            const int dk = opq(dk0), ig = opq(ig0);
            float bv[16];
#pragma unroll
            for (int ii = 0; ii < 16; ++ii) { const int i = ig * 16 + ii; float pre = bgv;
                const f16x8 l0 = *(const LAS f16x8*)(LR + i * 32 + dir * 16), l1 = *(const LAS f16x8*)(LR + i * 32 + dir * 16 + 8);
#pragma unroll
                for (int r = 0; r < 8; ++r) pre += (float)l0[r] * wgr[r] + (float)l1[r] * wgr[8 + r];
                bv[ii] = logsigmoidf_(pre) * (1.0f / 16.0f); }
            float totloc;
            if (dir == 0) {
#pragma unroll
                for (int ii = 1; ii < 16; ++ii) bv[ii] += bv[ii - 1];
                totloc = bv[15]; }
            else {
#pragma unroll
                for (int ii = 14; ii >= 0; --ii) bv[ii] += bv[ii + 1];
                totloc = bv[0]; }
            GT[ig * 128 + dk] = totloc;
            __syncthreads();
            const float g0 = GT[dk], g1 = GT[128 + dk], g2 = GT[256 + dk], g3 = GT[384 + dk];
            const float total = (g0 + g1) + (g2 + g3);
            float off, bmid;
            if (dir == 0) { off = (ig > 0 ? g0 : 0.f) + (ig > 1 ? g1 : 0.f) + (ig > 2 ? g2 : 0.f); bmid = g0 + g1; }
            else { off = (ig < 3 ? g3 : 0.f) + (ig < 2 ? g2 : 0.f) + (ig < 1 ? g1 : 0.f); bmid = g2 + g3; }
#pragma unroll
            for (int ii = 0; ii < 16; ++ii) bv[ii] += off;
            if (FULL) {
#pragma unroll
                for (int ii = 0; ii < 16; ++ii) { const int i = ig * 16 + ii;
                    QT[i * QK_LD + dk] = (f16)((float)QR[i * QK_LD + dk] * scale * __expf(fminf(bv[ii] - bmid, 9.f)));
                    KT[i * QK_LD + dk] = (f16)((float)KR[i * QK_LD + dk] * __expf(fminf(bmid - bv[ii], 9.f))); }
                __syncthreads();
                { const int c = opq(c0), q = opq(q0);
#pragma unroll
                for (int s = 0; s < 2; ++s) { const int T = 2 * w + s, it = T >> 2, jt = T & 3; f32x4 a = (f32x4){0.f, 0.f, 0.f, 0.f};
#pragma unroll
                    for (int kk = 0; kk < 4; ++kk) { const f16x8 kf = *(const LAS f16x8*)(KT + (jt * 16 + c) * QK_LD + kk * 32 + 8 * q);
                        const f16x8 qf = *(const LAS f16x8*)(QT + (it * 16 + c) * QK_LD + kk * 32 + 8 * q); a = GLA_MFMA(kf, qf, a); }
                    const int i = it * 16 + c; f16x4 pv;
#pragma unroll
                    for (int r = 0; r < 4; ++r) { const int jx = jt * 16 + 4 * q + r; const bool keep = dir == 0 ? (jx <= i) : (jx >= i); pv[r] = keep ? (f16)a[r] : (f16)0.f; }
                    *(LAS f16x4*)(PP + i * P_LD + jt * 16 + 4 * q) = pv; } }
                __syncthreads();
#pragma unroll
                for (int ii = 0; ii < 16; ++ii) { const int i = ig * 16 + ii; QT[i * QK_LD + dk] = (f16)((float)QR[i * QK_LD + dk] * scale * __expf(bv[ii])); }
            }
            { f16x8 k0, k1;
#pragma unroll
              for (int ii = 0; ii < 8; ++ii) { k0[ii] = (f16)((float)KR[(ig * 16 + ii) * QK_LD + dk] * __expf(total - bv[ii])); k1[ii] = (f16)((float)KR[(ig * 16 + 8 + ii) * QK_LD + dk] * __expf(total - bv[8 + ii])); }
              *(LAS f16x8*)(KT + dk * KH_LD + ig * 16) = k0; *(LAS f16x8*)(KT + dk * KH_LD + ig * 16 + 8) = k1; }
            if (ig == 0) { DEC[dk] = __expf(total); sumtot += total; }
            __syncthreads();
            const int c = opq(c0), q = opq(q0);
            if (FULL) {
                f32x4 accO[4][2];
#pragma unroll
                for (int it = 0; it < 4; ++it)
#pragma unroll
                    for (int et = 0; et < 2; ++et) accO[it][et] = (f32x4){0.f, 0.f, 0.f, 0.f};
#pragma unroll
                for (int et = 0; et < 2; ++et)
#pragma unroll
                    for (int kk = 0; kk < 2; ++kk) { const f16x8 vf = *(const LAS f16x8*)(VT + (32 * w + 16 * et + c) * VT_LD + kk * 32 + 8 * q);
#pragma unroll
                        for (int it = 0; it < 4; ++it) { const f16x8 pf = *(const LAS f16x8*)(PP + (it * 16 + c) * P_LD + kk * 32 + 8 * q); accO[it][et] = GLA_MFMA(vf, pf, accO[it][et]); } asm volatile("" ::: "memory"); }
#pragma unroll
                for (int kb = 0; kb < 4; ++kb)
#pragma unroll
                    for (int et = 0; et < 2; ++et) { f16x8 sf; asm volatile("" ::: "memory");
#pragma unroll
                        for (int e = 0; e < 4; ++e) { sf[e] = (f16)accS[2 * kb][et][e]; sf[4 + e] = (f16)accS[2 * kb + 1][et][e]; }
#pragma unroll
                        for (int it = 0; it < 4; ++it) { const f16x4 lo = *(const LAS f16x4*)(QT + (it * 16 + c) * QK_LD + 32 * kb + 4 * q), hi = *(const LAS f16x4*)(QT + (it * 16 + c) * QK_LD + 32 * kb + 16 + 4 * q);
                            f16x8 qf; qf[0] = lo[0]; qf[1] = lo[1]; qf[2] = lo[2]; qf[3] = lo[3]; qf[4] = hi[0]; qf[5] = hi[1]; qf[6] = hi[2]; qf[7] = hi[3];
                            accO[it][et] = GLA_MFMA(sf, qf, accO[it][et]); } }
                float* OF = (float*)(F.ws + WS_GOF);
                if (dir == 0) {
#pragma unroll
                    for (int it = 0; it < 4; ++it) { const int gr = prow(b, sc, j, it * 16 + c);
#pragma unroll
                        for (int et = 0; et < 2; ++et) *(f32x4*)(OF + (size_t)gr * 1024 + h * 256 + 32 * w + 16 * et + 4 * q) = accO[it][et];
                        asm volatile("" ::: "memory"); } }
                else {
                    int grs[4]; f32x4 ofv[4][2]; f16x4 rvv[4][2];
#pragma unroll
                    for (int it = 0; it < 4; ++it) { grs[it] = prow(b, sc, j, it * 16 + c);
#pragma unroll
                        for (int et = 0; et < 2; ++et) { ofv[it][et] = *(const f32x4*)(OF + (size_t)grs[it] * 1024 + h * 256 + 32 * w + 16 * et + 4 * q);
                            rvv[it][et] = *(const f16x4*)(PX + (size_t)grs[it] * PXLD + P_GR + h * 256 + 32 * w + 16 * et + 4 * q); } }
                    PIN8(ofv[0][0], ofv[0][1], ofv[1][0], ofv[1][1], ofv[2][0], ofv[2][1], ofv[3][0], ofv[3][1]);
#pragma unroll
                    for (int it = 0; it < 4; ++it) { float ss = 0.f;
#pragma unroll
                        for (int et = 0; et < 2; ++et) { accO[it][et] = accO[it][et] + ofv[it][et];
                            ss += (accO[it][et][0] * accO[it][et][0] + accO[it][et][1] * accO[it][et][1]) + (accO[it][et][2] * accO[it][et][2] + accO[it][et][3] * accO[it][et][3]); }
                        ss += __shfl_xor(ss, 16); ss += __shfl_xor(ss, 32);
                        if (q == 0) RS[(it * 16 + c) * 8 + w] = ss; }
                    __syncthreads();
                    PIN8(rvv[0][0], rvv[0][1], rvv[1][0], rvv[1][1], rvv[2][0], rvv[2][1], rvv[3][0], rvv[3][1]);
                    const float* ng = AV.in(I_GLANG) + (size_t)l * 256;
                    f16* Y = (f16*)(F.ws + WS_YCAT);
#pragma unroll
                    for (int it = 0; it < 4; ++it) { const int i = it * 16 + c; const f32x4 ra = *(const LAS f32x4*)(RS + i * 8), rb = *(const LAS f32x4*)(RS + i * 8 + 4);
                        const float tot = ((ra[0] + ra[1]) + (ra[2] + ra[3])) + ((rb[0] + rb[1]) + (rb[2] + rb[3]));
                        const float rstd = 1.0f / sqrtf(tot * (1.0f / 256.0f) + EPS);
#pragma unroll
                        for (int et = 0; et < 2; ++et) { const int e0 = 32 * w + 16 * et + 4 * q;
                            const f32x4 gv = *(const f32x4*)(ng + e0);
                            f16x4 o;
#pragma unroll
                            for (int r = 0; r < 4; ++r) o[r] = lowtog((f16)(accO[it][et][r] * rstd * gv[r] * siluf_((float)rvv[it][et][r])));
                            *(f16x4*)(Y + (size_t)grow(b, sc, j, it * 16 + c) * 2048 + 1024 + h * 256 + e0) = o; } }
                }
            }
#pragma unroll
            for (int dt = 0; dt < 8; ++dt) { const f32x4 dv = *(const LAS f32x4*)(DEC + 16 * dt + 4 * q);
#pragma unroll
                for (int et = 0; et < 2; ++et) accS[dt][et] = accS[dt][et] * dv; }
#pragma unroll
            for (int kk = 0; kk < 2; ++kk) { f16x8 vf[2];
#pragma unroll
                for (int et = 0; et < 2; ++et) vf[et] = *(const LAS f16x8*)(VT + (32 * w + 16 * et + c) * VT_LD + kk * 32 + 8 * q);
#pragma unroll
                for (int dt = 0; dt < 8; ++dt) { const f16x8 kf = *(const LAS f16x8*)(KT + (16 * dt + c) * KH_LD + kk * 32 + 8 * q);
#pragma unroll
                    for (int et = 0; et < 2; ++et) accS[dt][et] = GLA_MFMA(kf, vf[et], accS[dt][et]); if (dt & 1) asm volatile("" ::: "memory"); } }
        }
        if (!FULL) { float* Sl = (float*)(F.ws + WS_GSLOC) + sidx * 32768; const int q = opq(q0), c = opq(c0);
#pragma unroll
            for (int dt = 0; dt < 8; ++dt)
#pragma unroll
                for (int et = 0; et < 2; ++et)
#pragma unroll
                    for (int r = 0; r < 4; ++r) Sl[(16 * dt + 4 * q + r) * 256 + 32 * w + 16 * et + c] = accS[dt][et][r];
            if (ig0 == 0) ((float*)(F.ws + WS_GDT))[sidx * 128 + dk0] = __expf(sumtot); }
        VM_WAIT();
    }
}
__device__ __forceinline__ void ph_gla_scan(const Ctx& F) {
    const float* Sl = (const float*)(F.ws + WS_GSLOC); float* Si = (float*)(F.ws + WS_GSIN); const float* Dt = (const float*)(F.ws + WS_GDT);
    if (F.tid < 64) return;
    for (int gt = F.bid * 448 + (F.tid - 64); gt < 2 * 4 * 2 * 32768; gt += F.G * 448) {
        const int e = gt & 32767, dir = (gt >> 15) & 1, h = (gt >> 16) & 3, b = gt >> 18;
        float S = 0.f;
        for (int base = 0; base < NSC; base += 11) {
            float sl[11], dt[11]; size_t ix[11];
#pragma unroll
            for (int u = 0; u < 11; ++u) { const int step = base + u; const int sc = step == 0 ? 32 : (dir == 0 ? step - 1 : 32 - step);
                const size_t idx = ((((size_t)b * 4 + h) * NSC + sc) * 2 + dir); ix[u] = idx;
                sl[u] = Sl[idx * 32768 + e]; dt[u] = Dt[idx * 128 + (e >> 8)]; }
            PIN8(sl[0], sl[1], sl[2], sl[3], sl[4], sl[5], sl[6], sl[7]); PIN8(dt[0], dt[1], dt[2], dt[3], dt[4], dt[5], dt[6], dt[7]); PIN4(sl[8], sl[9], sl[10], dt[8]); asm volatile("" : "+v"(dt[9]), "+v"(dt[10]));
#pragma unroll
            for (int u = 0; u < 11; ++u) { Si[ix[u] * 32768 + e] = S; S = dt[u] * S + sl[u]; }
        }
    }
}
#undef GLA_FETCH
#undef GLA_MFMA
}

namespace hy {
#define PADI(i) ((i) + ((i) >> 5))
constexpr int HY_BUF_BYTES = (16384 + 512) * 8;
constexpr int HY_SCR_OFF = HY_BUF_BYTES;
static_assert(HY_SCR_OFF + 2048 <= LDSCTL_OFF, "hyena lds");
__device__ __forceinline__ f32x2 twid(int k, float invN) { const float xr = (float)k * invN; return (f32x2){__builtin_amdgcn_cosf(xr), -__builtin_amdgcn_sinf(xr)}; }
__device__ __forceinline__ f32x2 mul_w16(f32x2 d, int a) {
    constexpr float c1 = 0.9238795325112867f, s1 = 0.3826834323650898f, r = 0.7071067811865476f;
    float c, s;
    switch (a & 15) {
        case 0: return d; case 4: return (f32x2){d.y, -d.x}; case 8: return (f32x2){-d.x, -d.y}; case 12: return (f32x2){-d.y, d.x};
        case 1: c = c1; s = s1; break; case 2: c = r; s = r; break; case 3: c = s1; s = c1; break;
        case 5: c = -s1; s = c1; break; case 6: c = -r; s = r; break; case 7: c = -c1; s = s1; break;
        case 9: c = -c1; s = -s1; break; case 10: c = -r; s = -r; break; case 11: c = -s1; s = -c1; break;
        case 13: c = s1; s = -c1; break; case 14: c = r; s = -r; break; default: c = c1; s = -s1; break; }
    return (f32x2){d.x * c + d.y * s, d.y * c - d.x * s};
}
template <int R> __device__ __forceinline__ void dif_pass(LAS f32x2* x, int m, int lh, int tid) {
    const int N = 1 << m; const float invN = 1.0f / (float)N; const int lg = lh - R + 1, g = 1 << lg, S = (N >> 1) >> lh;
    for (int q = tid; q < (N >> R); q += 512) { const int j = q & (g - 1), blk = q >> lg, base = (blk << (lh + 1)) + j;
        f32x2 v[1 << R];
#pragma unroll
        for (int k = 0; k < (1 << R); ++k) v[k] = x[PADI(base + k * g)];
        f32x2 w = twid(j * S, invN);
#pragma unroll
        for (int s = 0; s < R; ++s) { const int half = 1 << (R - 1 - s);
#pragma unroll
            for (int k = 0; k < (1 << R); ++k) if (!(k & half)) { const f32x2 a = v[k], b = v[k + half]; v[k] = a + b;
                v[k + half] = mul_w16(cmul(a - b, w), ((k & (half - 1)) << s) * (16 >> R)); }
            w = cmul(w, w); }
#pragma unroll
        for (int k = 0; k < (1 << R); ++k) x[PADI(base + k * g)] = v[k]; }
    __syncthreads();
}
template <int R> __device__ __forceinline__ void dit_pass(LAS f32x2* x, int m, int lh, int tid) {
    const int N = 1 << m; const float invN = 1.0f / (float)N; const int h = 1 << lh, S1 = (N >> 1) >> lh;
    for (int q = tid; q < (N >> R); q += 512) { const int j = q & (h - 1), blk = q >> lh, base = (blk << (lh + R)) + j;
        f32x2 v[1 << R];
#pragma unroll
        for (int k = 0; k < (1 << R); ++k) v[k] = x[PADI(base + k * h)];
        f32x2 wp[R]; wp[R - 1] = cconj(twid(j * (S1 >> (R - 1)), invN));
#pragma unroll
        for (int s = R - 2; s >= 0; --s) wp[s] = cmul(wp[s + 1], wp[s + 1]);
#pragma unroll
        for (int s = 0; s < R; ++s) { const int half = 1 << s;
#pragma unroll
            for (int k = 0; k < (1 << R); ++k) if (!(k & half)) { const f32x2 a = v[k];
                const f32x2 b = mul_w16(cmul(v[k + half], wp[s]), (16 - (k & (half - 1)) * (16 >> (s + 1))) & 15);
                v[k] = a + b; v[k + half] = a - b; } }
#pragma unroll
        for (int k = 0; k < (1 << R); ++k) x[PADI(base + k * h)] = v[k]; }
    __syncthreads();
}
__device__ __forceinline__ void fft_fwd(LAS f32x2* x, int m, int tid) {
    int lh = m - 1;
    while (lh + 1 >= 4) { dif_pass<4>(x, m, lh, tid); lh -= 4; }
    if (lh + 1 == 2) dif_pass<2>(x, m, 1, tid); else if (lh + 1 == 1) dif_pass<1>(x, m, 0, tid);
}
__device__ __forceinline__ void fft_inv(LAS f32x2* x, int m, int tid) {
    int lh = 0;
    while (m - lh >= 4) { dit_pass<4>(x, m, lh, tid); lh += 4; }
    if (m - lh == 2) dit_pass<2>(x, m, lh, tid); else if (m - lh == 1) dit_pass<1>(x, m, lh, tid);
}
__device__ __forceinline__ int brev(int k, int m) { return (int)(__brev((unsigned)k) >> (32 - m)); }

__device__ __forceinline__ void filt_unit(const Ctx& F, const ArgsV& AV, int l, int unit) {
    const int kind = unit >> 9, o = (unit >> 8) & 1, pair = unit & 255;
    const int n = kind ? LC : SEQ, m = kind ? 9 : 14, N = 2 * n, tid = F.tid;
    LAS f32x2* buf = (LAS f32x2*)F.lds;
    LAS float* W3 = (LAS float*)(F.lds + HY_SCR_OFF);
    LAS float* B3 = W3 + 256;
    LAS float* RED = B3 + 4;
    LAS float* INV = RED + 16;
    __syncthreads();
    if (tid < 4) { const int ci = tid; const int col = o * 1024 + (ci >> 1) * 512 + 2 * pair + (ci & 1); B3[ci] = AV.in(I_HYB3)[(size_t)l * 2048 + col]; }
    __syncthreads();
    const int lane = F.lane, q = lane >> 4, c = lane & 15;
    f16x8 wB0, wB1;
    { const int col = o * 1024 + ((c & 3) >> 1) * 512 + 2 * pair + (c & 1); const float* w3 = AV.in(I_HYW3) + (size_t)l * 64 * 2048 + col;
#pragma unroll
      for (int j = 0; j < 8; ++j) { wB0[j] = c < 4 ? (f16)w3[(size_t)(8 * q + j) * 2048] : (f16)0.f; wB1[j] = c < 4 ? (f16)w3[(size_t)(32 + 8 * q + j) * 2048] : (f16)0.f; } }
    const f16* H2H = (const f16*)(F.ws + WS_H2H) + ((size_t)l * (SEQ + LC) + (kind ? SEQ : 0)) * 64;
    const float lo = -3.0701134573253945f, hi = -15.350567286626973f;
    const float ra = fabsf(lo + (hi - lo) * (float)(2 * pair) / 511.0f), rb = fabsf(lo + (hi - lo) * (float)(2 * pair + 1) / 511.0f);
    const float rate = (c & 1) ? rb : ra, bias3 = B3[c & 3];
    float sabs = 0.f;
    for (int tile = F.wave; tile < (n >> 4); tile += 8) { const int t0 = tile * 16;
        const f16x8 a0 = *(const f16x8*)(H2H + (size_t)(t0 + c) * 64 + 8 * q), a1 = *(const f16x8*)(H2H + (size_t)(t0 + c) * 64 + 32 + 8 * q);
        f32x4 acc = (f32x4){0.f, 0.f, 0.f, 0.f};
        acc = __builtin_amdgcn_mfma_f32_16x16x32_f16(a0, wB0, acc, 0, 0, 0); acc = __builtin_amdgcn_mfma_f32_16x16x32_f16(a1, wB1, acc, 0, 0, 0);
        if (c < 4) {
#pragma unroll
            for (int i = 0; i < 4; ++i) { const int t = t0 + 4 * q + i; const float v = (acc[i] + bias3) * expf(-((float)t / (float)(n - 1)) * rate);
                LAS float* bp = (LAS float*)buf;
                if (c < 2) { bp[2 * PADI(t) + c] = v; sabs += fabsf(v); }
                else if (t >= 1) { bp[2 * PADI(N - t) + (c - 2)] = v; sabs += fabsf(v); } } }
    }
    float sa = (c == 0 || c == 2) ? sabs : 0.f, sb = (c == 1 || c == 3) ? sabs : 0.f;
    if (tid == 0) { float z0 = 0.f; asm volatile("" : "+v"(z0)); buf[PADI(n)] = (f32x2){z0, z0}; }
    sa = wave_sum(sa); sb = wave_sum(sb);
    if (F.lane == 0) { RED[F.wave * 2] = sa; RED[F.wave * 2 + 1] = sb; }
    __syncthreads();
    if (tid < 2) { float s = 0.f;
#pragma unroll
        for (int w = 0; w < 8; ++w) s += RED[w * 2 + tid];
        INV[tid] = 1.0f / (s + EPS); }
    __syncthreads();
    { const float ia = INV[0], ib = INV[1];
      for (int i = tid; i < N; i += 512) { f32x2 v = buf[PADI(i)]; v.x *= ia; v.y *= ib; buf[PADI(i)] = v; } }
    __syncthreads();
    fft_fwd(buf, m, tid);
    f32x4* out = (f32x4*)(F.ws + ((l & 1) ? WS_FSD2 : WS_FSD) + (kind ? FSD_C_OFF : 0)) + (size_t)(o * 256 + pair) * (n + 1);
    for (int u = tid; u <= n; u += 512) { const int p = u < n ? 2 * u : 1, k = brev(p, m), pn = brev((N - k) & (N - 1), m);
        const f32x2 zk = buf[PADI(p)], zn = cconj(buf[PADI(pn)]);
        const f32x2 fa = (zk + zn) * 0.5f, df = zk - zn, fb = (f32x2){df.y * 0.5f, -df.x * 0.5f};
        const f32x2 fs = (fa + fb) * 0.5f, fd = (fa - fb) * 0.5f;
        out[u] = (f32x4){fs.x, fs.y, fd.x, fd.y}; }
    __syncthreads();
}

__device__ __forceinline__ void main_unit(const Ctx& F, const ArgsV& AV, int l, int unit) {
    const int kind = unit >> 9, b = (unit >> 8) & 1, pair = unit & 255;
    const int n = kind ? LC : SEQ, m = kind ? 9 : 14, N = 2 * n, tid = F.tid;
    const int row0 = kind ? MX + b * LC : b * SEQ;
    LAS f32x2* buf = (LAS f32x2*)F.lds;
    const f16* ZT = (const f16*)(F.ws + WS_ZT) + (size_t)(2 * pair) * MT + row0;
    const float* cw = AV.in(I_HYCW) + (size_t)l * 3 * 1536 + 2 * pair; const float* cb = AV.in(I_HYCB) + (size_t)l * 1536 + 2 * pair;
    f32x2 yv[16], g1[16], g2[16];
#pragma unroll
    for (int g = 0; g < 3; ++g)
#pragma unroll
        for (int cc = 0; cc < 2; ++cc) { const float w0 = cw[g * 512 + cc], w1 = cw[1536 + g * 512 + cc], w2 = cw[3072 + g * 512 + cc], bs = cb[g * 512 + cc];
            const f16* zt = ZT + (size_t)(g * 512 + cc) * MT;
#pragma unroll
            for (int gi = 0; gi < 2; ++gi) { const int t0 = 8 * (tid + 512 * gi);
                f16x8 mv; float pv = 0.f, nv = 0.f;
#pragma unroll
                for (int e = 0; e < 8; ++e) mv[e] = (f16)0.f;
                if (t0 < n) { mv = *(const f16x8*)(zt + t0); if (t0 > 0) pv = (float)zt[t0 - 1]; if (t0 + 8 < n) nv = (float)zt[t0 + 8]; }
#pragma unroll
                for (int e = 0; e < 8; ++e) { const float zm = e == 0 ? pv : (float)mv[e == 0 ? 0 : e - 1], zc = (float)mv[e], zp = e == 7 ? nv : (float)mv[e == 7 ? 7 : e + 1];
                    const float r = w0 * zm + w1 * zc + w2 * zp + bs;
                    if (g == 0) { if (cc == 0) yv[gi * 8 + e].x = r; else yv[gi * 8 + e].y = r; }
                    else if (g == 1) { if (cc == 0) g1[gi * 8 + e].x = r; else g1[gi * 8 + e].y = r; }
                    else { if (cc == 0) g2[gi * 8 + e].x = r; else g2[gi * 8 + e].y = r; } } } }
    const float invN = 1.0f / (float)N;
#pragma unroll
    for (int o = 0; o < 2; ++o) {
        __syncthreads();
        float z0 = 0.f; asm volatile("" : "+v"(z0));
#pragma unroll
        for (int gi = 0; gi < 2; ++gi) { const int t0 = 8 * (tid + 512 * gi);
            if (t0 < n) {
#pragma unroll
                for (int e = 0; e < 8; ++e) { buf[PADI(t0 + e)] = yv[gi * 8 + e]; buf[PADI(n + t0 + e)] = (f32x2){z0, z0}; } } }
        __syncthreads();
        fft_fwd(buf, m, tid);
        const f32x4* fsd = (const f32x4*)(F.ws + ((l & 1) ? WS_FSD2 : WS_FSD) + (kind ? FSD_C_OFF : 0)) + (size_t)(o * 256 + pair) * (n + 1);
        for (int u = tid; u <= n; u += 512) { const int p = u < n ? 2 * u : 1, k = brev(p, m), pn = brev((N - k) & (N - 1), m);
            const f32x2 zk = buf[PADI(p)], zn = buf[PADI(pn)]; const f32x4 f = fsd[u]; const f32x2 fs = (f32x2){f[0], f[1]}, fd = (f32x2){f[2], f[3]};
            const f32x2 wk = cmul(zk, fs) + cmul(cconj(zn), fd), wn = cmul(zn, cconj(fs)) + cmul(cconj(zk), cconj(fd));
            buf[PADI(pn)] = wn; buf[PADI(p)] = wk; }
        __syncthreads();
        fft_inv(buf, m, tid);
        const float* hb = AV.in(I_HYBIAS) + ((size_t)l * 2 + o) * 512 + 2 * pair; const f32x2 bias = (f32x2){hb[0], hb[1]};
#pragma unroll
        for (int gi = 0; gi < 2; ++gi) { const int t0 = 8 * (tid + 512 * gi);
            if (t0 < n) {
#pragma unroll
                for (int e = 0; e < 8; ++e) { const f32x2 cv = buf[PADI(t0 + e)] * invN; const f32x2 gt = o == 0 ? g1[gi * 8 + e] : g2[gi * 8 + e];
                    yv[gi * 8 + e] = gt * (cv + yv[gi * 8 + e] * bias); } } }
    }
    f16* Y = (f16*)(F.ws + WS_YBT) + (size_t)(2 * pair) * MT + row0;
#pragma unroll
    for (int gi = 0; gi < 2; ++gi) { const int t0 = 8 * (tid + 512 * gi);
        if (t0 < n) { f16x8 oa, ob;
#pragma unroll
            for (int e = 0; e < 8; ++e) { oa[e] = lowtog((f16)yv[gi * 8 + e].x); ob[e] = lowtog((f16)yv[gi * 8 + e].y); }
            *(f16x8*)(Y + t0) = oa; *(f16x8*)(Y + MT + t0) = ob; } }
    __syncthreads();
}

__device__ __forceinline__ void ph_ybt_transpose(const Ctx& F) {
    LAS f16* T = (LAS f16*)F.lds;
    const f16* YBT = (const f16*)(F.ws + WS_YBT); f16* Y = (f16*)(F.ws + WS_YCAT);
    const bool bal = (F.G == 256);
    for (int it = 0; it < (bal ? 2 : (MT / 64 + F.G - 1) / F.G); ++it) {
        int rb;
        if (bal) { if (F.bid >= 132) rb = (F.bid - 132) + 124 * it; else if (F.bid < 16 && it == 0) rb = 248 + F.bid; else rb = -1; }
        else rb = F.bid + it * F.G;
        if (rb < 0 || rb >= MT / 64) continue;
        const int r0 = rb * 64;
        __syncthreads();
        { f16x8 tv[8];
#pragma unroll
          for (int i = 0; i < 8; ++i) tv[i] = *(const f16x8*)(YBT + (size_t)F.tid * MT + r0 + 8 * i);
          PIN8(tv[0], tv[1], tv[2], tv[3], tv[4], tv[5], tv[6], tv[7]);
#pragma unroll
          for (int i = 0; i < 8; ++i) *(LAS f16x8*)(T + F.tid * 72 + 8 * i) = tv[i]; }
        __syncthreads();
        const int row = F.tid >> 3, cg = F.tid & 7;
#pragma unroll
        for (int jj = 0; jj < 8; ++jj) { const int gidx = cg + 8 * jj; f16x8 o;
#pragma unroll
            for (int e = 0; e < 8; ++e) o[e] = T[(8 * gidx + e) * 72 + row];
            *(f16x8*)(Y + (size_t)(r0 + row) * 2048 + 512 + 8 * gidx) = o; }
    }
    __syncthreads();
}
#undef PADI
}

#ifndef PHMASK
#define PHMASK 0xFFFF
#endif
#define PH_EN(k) (((PHMASK) >> (k)) & 1)
#ifndef STAMP_MASK
#define STAMP_MASK 0
#endif
#ifndef STAMP_K
#define STAMP_K 1
#endif
#ifndef SUBMASK
#define SUBMASK 7
#endif
#define SUB_EN(k) (((SUBMASK) >> (k)) & 1)
constexpr int NPH = 2 + 12 * DEPTH;
constexpr int CW_Q = 8192;
__device__ __forceinline__ int q_pull(unsigned* ctr, volatile LAS int* slot) {
    __syncthreads();
    if (threadIdx.x == 0) *slot = (int)__hip_atomic_fetch_add(ctr, 1u, __ATOMIC_RELAXED, __HIP_MEMORY_SCOPE_AGENT);
    __syncthreads();
    return *slot;
}

__global__ void __launch_bounds__(512, 2) mk_fwd(Args args) {
    extern __shared__ __attribute__((aligned(16))) unsigned char lds_raw[];
    Ctx F; F.lds = (LAS unsigned char*)lds_raw; F.tid = threadIdx.x; F.lane = F.tid & 63; F.wave = __builtin_amdgcn_readfirstlane(F.tid >> 6);
    F.G = gridDim.x; F.bid = blockIdx.x; F.ws = args.ws;
    ArgsV AV; AV.out = args.out;
    const Ctx F0 = F;
#define FRESH() do { F.tid = opq(F0.tid); F.lane = F.tid & 63; F.wave = __builtin_amdgcn_readfirstlane(F.tid >> 6); } while (0)
    volatile LAS unsigned* MISC = (volatile LAS unsigned*)(F.lds + LDSCTL_OFF);
    if (F.tid < 64) MISC[F.tid] = 0u;
    __syncthreads();
    unsigned* barw = (unsigned*)(F.ws + WS_CTL) + CW_BAR;
    XcdBarrier bar; bar.bar = barw; bar.x = 0; bar.st = nullptr;
    const int lo = args.ph_lo, hi = args.ph_hi;
    if (hi - lo > 1) bar = xcd_barrier_post(barw, MISC + 8);
#define IN(k) (lo <= (k) && (k) < hi)
#define SEAM(k) do { if (IN(k) && IN((k) + 1)) xcd_barrier(bar); } while (0)
#if STAMP_MASK
    volatile LAS unsigned long long* TS = (volatile LAS unsigned long long*)(F.lds + LDSCTL_OFF + 128);
#define TSTART(k) do { if ((((STAMP_MASK) >> (k)) & 1) && blockIdx.x == 0 && threadIdx.x == 0) TS[0] = __builtin_amdgcn_s_memrealtime(); } while (0)
#define TSTOP(k) do { if ((((STAMP_MASK) >> (k)) & 1) && blockIdx.x == 0 && threadIdx.x == 0) TS[1] = TS[1] + (__builtin_amdgcn_s_memrealtime() - TS[0]); } while (0)
#else
#define TSTART(k) do {} while (0)
#define TSTOP(k) do {} while (0)
#endif
    unsigned char* ws = F.ws;
    const int rank160 = (F.bid + F.G - 160 % F.G) % F.G;

    TSTART(12);
    if (PH_EN(12) && IN(0)) { FRESH(); ph_prologue(F, AV); for (int l2 = 0; l2 < DEPTH; ++l2) { FRESH(); ph_hyena_h2(F, AV, l2); } }
    SEAM(0);
    TSTOP(12);

    for (int l = 0; l < DEPTH; ++l) {
        const int pb = 1 + 12 * l;
        const float* modl = (const float*)(ws + WS_MOD) + (size_t)l * 3 * 12288;
        const bool ctx_on = l < DEPTH - 1;
        const int nMr = ctx_on ? MT / 256 : MX / 256, nrows = ctx_on ? MT : MX;
        TSTART(0);
        if (PH_EN(0) && IN(pb + 0)) {
            FRESH(); ph_convert_weights(F, AV, l);
            __syncthreads();
            FRESH(); if (F.bid < 32) s5_mats_group(F, AV, l, F.bid);
            FRESH(); ph_norm(F, AV, l, 0, MT, l > 0 ? 11 : 0);
        }
        SEAM(pb + 0);
        TSTOP(0);
        TSTART(1);
        if (PH_EN(1) && IN(pb + 1)) {
            pg8::SchedPlain S; S.init(MT / 256, WINN / 256, F.G, F.bid); S.A = (const char*)(ws + WS_HN); S.B = (const char*)(ws + WS_WIN); S.aTile = (size_t)256 * 2048 * 2; S.bTile = (size_t)256 * 2048 * 2;
            pg8::EpiPx E{(f16*)(ws + WS_PX), (f16*)(ws + WS_S5A), (f16*)(ws + WS_ZT), (f16*)(ws + WS_GTL)};
            pg8::gemm_phase(F.lds, 2048, 2048, 32, S, E);
        }
        SEAM(pb + 1);
        TSTOP(1);
        TSTART(2);
        if (PH_EN(2) && IN(pb + 2)) {
            TSTART(16);
            if (SUB_EN(0)) { pg8::SchedS5 S{(const char*)(ws + WS_S5A), (const char*)(ws + WS_S5M), (size_t)256 * 256 * 2, F.G, F.bid};
              pg8::EpiS5In E{(float*)(ws + WS_S5S)};
              pg8::gemm_phase(F.lds, 16384, 256, 4, S, E); }
            TSTOP(16);
            { unsigned* qc = (unsigned*)(ws + WS_CTL) + CW_Q + (l * 2 + 0) * 64; volatile LAS int* slot = (volatile LAS int*)(MISC + 16);
              const bool pre = (l > 0 && F.G == 256);
              const int nq = 264 + (pre ? 272 : 1024);
              for (;;) { const int u = q_pull(qc, slot); if (u >= nq) break;
                  if (u < 264) { TSTART(17); FRESH(); gla::gla_unit<false>(F, AV, l, u); TSTOP(17); } else { TSTART(18); FRESH(); hy::filt_unit(F, AV, l, pre ? 240 + (u - 264) : u - 264); TSTOP(18); } } }
        }
        SEAM(pb + 2);
        TSTOP(2);
        TSTART(3);
        if (PH_EN(3) && IN(pb + 3)) { FRESH(); ph_s5_scan(F); FRESH(); gla::ph_gla_scan(F); }
        SEAM(pb + 3);
        TSTOP(3);
        TSTART(4);
        if (PH_EN(4) && IN(pb + 4)) {
            TSTART(19);
            if (SUB_EN(0)) { pg8::SchedS5 S{(const char*)(ws + WS_S5A), (const char*)(ws + WS_S5W), (size_t)256 * 512 * 2, F.G, F.bid};
              pg8::EpiS5Out E{(const f16*)(ws + WS_S5A), (f16*)(ws + WS_YAPRE), AV.in(I_S5D) + (size_t)l * 512};
              pg8::gemm_phase(F.lds, 16384, 512, 8, S, E); }
            TSTOP(19);
            { unsigned* qc = (unsigned*)(ws + WS_CTL) + CW_Q + (l * 2 + 1) * 64; volatile LAS int* slot = (volatile LAS int*)(MISC + 16);
              for (;;) { const int u = q_pull(qc, slot); if (u >= 264 + 1024) break;
                  if (u < 264) { TSTART(20); FRESH(); gla::gla_unit<true>(F, AV, l, u); TSTOP(20); } else { TSTART(21); FRESH(); hy::main_unit(F, AV, l, u - 264); TSTOP(21); } } }
        }
        SEAM(pb + 4);
        TSTOP(4);
        TSTART(5);
        if (PH_EN(5) && IN(pb + 5)) {
            pg8::SchedPlain S; S.init(nMr, 2, F.G, F.bid); S.A = (const char*)(ws + WS_YAPRE); S.B = (const char*)(ws + WS_WGLU); S.aTile = (size_t)256 * 512 * 2; S.bTile = (size_t)256 * 512 * 2;
            pg8::EpiGlu E{(const f16*)(ws + WS_YAPRE), (f16*)(ws + WS_YCAT), AV.in(I_GLUB) + (size_t)l * 512};
            pg8::gemm_phase(F.lds, 512, 512, 8, S, E);
            FRESH(); hy::ph_ybt_transpose(F);
        }
        SEAM(pb + 5);
        TSTOP(5);
        TSTART(6);
        if (PH_EN(6) && IN(pb + 6)) {
            pg8::SchedPlain S; S.init(nMr, 8, F.G, F.bid); S.aTile = (size_t)256 * 2048 * 2; S.bTile = (size_t)256 * 2048 * 2;
            S.A = (const char*)(ws + WS_YCAT); S.B = (const char*)(ws + WS_WBR);
            pg8::EpiBranchF E{(const f16*)(ws + WS_GTL), (f16*)(ws + WS_MBUF)};
            pg8::gemm_phase(F.lds, 2048, 2048, 32, S, E);
            if (l + 1 < DEPTH && F.G == 256) { unsigned* qc = (unsigned*)(ws + WS_CTL) + CW_Q + 1024 + l * 64; volatile LAS int* slot = (volatile LAS int*)(MISC + 16);
              for (;;) { if (F.bid < 16) break; const int u = q_pull(qc, slot); if (u >= 240) break; FRESH(); hy::filt_unit(F, AV, l + 1, u); } }
#ifdef PG_DUMMY
            { pg8::EpiF16 E9{(f16*)(ws + WS_ACT), 2048}; pg8::gemm_phase(F.lds, 2048, 2048, 32, S, E9); }
#endif
        }
        SEAM(pb + 6);
        TSTOP(6);
        TSTART(7);
        if (PH_EN(7) && IN(pb + 7)) {
            pg8::SchedPlain S; S.init(MX / 256, 8, F.G, F.bid); S.A = (const char*)(ws + WS_MBUF); S.B = (const char*)(ws + WS_WOUT); S.aTile = (size_t)256 * 2048 * 2; S.bTile = (size_t)256 * 2048 * 2;
            pg8::EpiResid E{(float*)(ws + WS_XRES), modl, 4096, l == 0 ? AV.in(I_X) : (const float*)(ws + WS_XRES)};
            pg8::gemm_phase(F.lds, 2048, 2048, 32, S, E);
            if (ctx_on) { pg8::SchedSplit S2{(const char*)(ws + WS_MBUF), (const char*)(ws + WS_WOUT), (size_t)256 * 2048 * 2, (size_t)256 * 2048 * 2, (size_t)8 * 128, 4, F.G, F.bid};
                pg8::EpiSlab E2{(float*)(ws + WS_SLAB), modl, 4096};
                pg8::gemm_phase(F.lds, 2048, 2048, 8, S2, E2); }
            if (l + 1 < DEPTH && F.G == 256) { unsigned* qc = (unsigned*)(ws + WS_CTL) + CW_Q + 1024 + l * 64 + 32; volatile LAS int* slot = (volatile LAS int*)(MISC + 16);
              for (;;) { const int u = q_pull(qc, slot); if (u >= 512) break; FRESH(); hy::filt_unit(F, AV, l + 1, 512 + u); } }
        }
        SEAM(pb + 7);
        TSTOP(7);
        TSTART(8);
        if (PH_EN(8) && IN(pb + 8)) { FRESH(); ph_norm(F, AV, l, 1, nrows, 4); }
        SEAM(pb + 8);
        TSTOP(8);
        TSTART(9);
        if (PH_EN(9) && IN(pb + 9)) {
            pg8::SchedPlain S; S.init(nMr, UPLD / 256, F.G, F.bid); S.A = (const char*)(ws + WS_HN); S.B = (const char*)(ws + WS_WUP); S.aTile = (size_t)256 * 2048 * 2; S.bTile = (size_t)256 * 2048 * 2;
            pg8::EpiUpAct E{(f16*)(ws + WS_ACT), (float*)(ws + WS_HALO), AV.in(I_FFCW) + (size_t)l * 3 * FFH, AV.in(I_FFCB) + (size_t)l * FFH, (LAS float*)(F.lds + EXTRA_OFF)};
            pg8::gemm_phase(F.lds, 2048, 2048, 32, S, E);
        }
        SEAM(pb + 9);
        TSTOP(9);
        TSTART(10);
        if (PH_EN(10) && IN(pb + 10)) { FRESH(); ph_ffn_fix(F, AV, l, nMr); }
        SEAM(pb + 10);
        TSTOP(10);
        TSTART(11);
        if (PH_EN(11) && IN(pb + 11)) {
            pg8::SchedPlain S; S.init(MX / 256, 8, F.G, F.bid); S.A = (const char*)(ws + WS_ACT); S.B = (const char*)(ws + WS_WDN); S.aTile = (size_t)256 * FFH * 2; S.bTile = (size_t)256 * FFH * 2;
            pg8::EpiResid E{(float*)(ws + WS_XRES), modl, 10240, (const float*)(ws + WS_XRES)};
            pg8::gemm_phase(F.lds, FFH, FFH, FFH / 64, S, E);
            if (ctx_on) { pg8::SchedSplit S2{(const char*)(ws + WS_ACT), (const char*)(ws + WS_WDN), (size_t)256 * FFH * 2, (size_t)256 * FFH * 2, (size_t)8 * 128, 11, F.G, F.bid};
                pg8::EpiSlab E2{(float*)(ws + WS_SLAB), modl, 10240};
                pg8::gemm_phase(F.lds, FFH, FFH, 8, S2, E2); }
        }
        SEAM(pb + 11);
        TSTOP(11);
    }
    if (PH_EN(13) && IN(NPH - 1)) { FRESH(); ph_final_norm(F, AV); }
#if STAMP_MASK
    if (blockIdx.x == 0 && threadIdx.x == 0) { const unsigned long long t0 = __builtin_amdgcn_s_memrealtime(); while (__builtin_amdgcn_s_memrealtime() - t0 < (unsigned long long)(STAMP_K) * TS[1]) __builtin_amdgcn_s_sleep(8); }
#endif
#undef IN
#undef SEAM
#undef FRESH
}

extern "C" void kernel_launch(void* const* d_in, const int* in_sizes, int n_in, void* d_out, int out_size, void* d_ws, size_t ws_size, hipStream_t stream) {
    static int grid = 0;
    if (grid == 0) {
        if (n_in != 40 || out_size != MX * D || ws_size < WS_END) { fprintf(stderr, "kernel_launch: unexpected problem (n_in %d out %d ws %zu, need %zu)\n", n_in, out_size, ws_size, (size_t)WS_END); grid = -1; return; }
        int dev = 0, cus = 0, per_cu = 0;
        if (hipGetDevice(&dev) != hipSuccess || hipDeviceGetAttribute(&cus, hipDeviceAttributeMultiprocessorCount, dev) != hipSuccess) { grid = -1; return; }
        if (hipFuncSetAttribute((const void*)mk_fwd, hipFuncAttributeMaxDynamicSharedMemorySize, LDS_BYTES) != hipSuccess) { fprintf(stderr, "kernel_launch: hipFuncSetAttribute failed\n"); grid = -1; return; }
        if (hipOccupancyMaxActiveBlocksPerMultiprocessor(&per_cu, (const void*)mk_fwd, 512, LDS_BYTES) != hipSuccess || per_cu < 1)
            fprintf(stderr, "kernel_launch: occupancy query reports %d\n", per_cu);
        (void)hipGetLastError();
        grid = cus;
    }
    if (grid < 0) return;
    if (hipMemsetAsync((char*)d_ws + WS_CTL, 0, CTL_ZERO_BYTES, stream) != hipSuccess) return;
    Args a{};
    for (int i = 0; i < 40; ++i) a.in[i] = (const float*)d_in[i];
    a.out = (float*)d_out; a.ws = (unsigned char*)d_ws;
#if MK_ONE
    a.ph_lo = 0; a.ph_hi = NPH;
    hipLaunchKernelGGL(mk_fwd, dim3(grid), dim3(512), LDS_BYTES, stream, a);
#else
    for (int p = 0; p < NPH; ++p) { a.ph_lo = p; a.ph_hi = p + 1; hipLaunchKernelGGL(mk_fwd, dim3(grid), dim3(512), LDS_BYTES, stream, a); }
#endif
}
```

```cpp
#include <hip/hip_runtime.h>
#include <stdio.h>

#ifndef MK_ONE
#define MK_ONE 1
#define STAMP_MASK 0
#define STAMP_K 1
#define STAMP_BID 0
#endif

#define GAS __attribute__((address_space(1)))
#define LAS __attribute__((address_space(3)))
typedef _Float16 f16;
typedef _Float16 f16x8 __attribute__((ext_vector_type(8)));
typedef _Float16 f16x4 __attribute__((ext_vector_type(4)));
typedef _Float16 f16x2 __attribute__((ext_vector_type(2)));
typedef float f32x4 __attribute__((ext_vector_type(4)));
typedef float f32x2 __attribute__((ext_vector_type(2)));

constexpr int D = 2048, NB = 2, SEQ = 8192, LC = 256, DEPTH = 4;
constexpr int MX = NB * SEQ, MC = NB * LC, MT = MX + MC;
constexpr int PXLD = 3840, WINN = 11520, FFH = 5632, UPLD = 2 * FFH;
constexpr int P_S5 = 0, P_GK = 512, P_GV = 1024, P_GQ = 2048, P_GR = 2560, P_HY = 3584, P_MG = 5120, P_GG = 3584, W_GG = 11264;
constexpr int INW = 11296;
constexpr int NCHK = 1056;
constexpr float S5SCALE = 1024.f;
constexpr float EPS = 1e-6f;
constexpr int NSC = 33;

constexpr size_t MiB = 1u << 20;
constexpr size_t WS_CTL = 0, CTL_ZERO_BYTES = 1 * MiB;
constexpr size_t WS_MOD = 1 * MiB;
constexpr size_t WS_TW = 2 * MiB;
constexpr size_t WS_S5AT = 3 * MiB;
constexpr size_t WS_WIN = 4 * MiB;
constexpr size_t WS_WGLU = WS_WIN + 45 * MiB;
constexpr size_t WS_WBR = WS_WGLU + 1 * MiB;
constexpr size_t WS_WOUT = WS_WBR + 8 * MiB;
constexpr size_t WS_WUP = WS_WOUT + 8 * MiB;
constexpr size_t WS_WDN = WS_WUP + 44 * MiB;
constexpr size_t WS_S5W = WS_WDN + 22 * MiB;
constexpr size_t WS_S5M = WS_S5W + 8 * MiB;
constexpr size_t WS_H2 = WS_S5M + 4 * MiB;
constexpr size_t WS_FSD = WS_H2 + 3 * MiB;
constexpr size_t FSD_C_OFF = (size_t)2 * 256 * 8193 * 16;
constexpr size_t WS_XRES = WS_FSD + 68 * MiB;
constexpr size_t WS_HN = WS_XRES + 132 * MiB;
constexpr size_t WS_PX = WS_HN + 66 * MiB;
constexpr size_t WS_S5A = WS_PX + 372 * MiB;
constexpr size_t WS_S5S = WS_S5A + 40 * MiB;
constexpr size_t WS_YAPRE = WS_S5S + 40 * MiB;
constexpr size_t WS_YCAT = WS_YAPRE + 20 * MiB;
constexpr size_t WS_MBUF = WS_YCAT + 66 * MiB;
constexpr size_t WS_GSLOC = WS_MBUF + 66 * MiB;
constexpr size_t WS_GSIN = WS_GSLOC + 66 * MiB;
constexpr size_t WS_GOF = WS_GSIN + 66 * MiB;
constexpr size_t WS_GDT = WS_GOF + 66 * MiB;
constexpr size_t WS_ACT = WS_GSLOC;
constexpr size_t WS_ZT = WS_GDT + 1 * MiB;
constexpr size_t WS_YBT = WS_ZT + 50 * MiB;
constexpr size_t WS_SLAB = WS_YBT + 17 * MiB;
constexpr size_t WS_HALO = WS_SLAB + 44 * MiB;
constexpr size_t WS_GTL = WS_HALO + 9 * MiB;
constexpr size_t WS_END = WS_GTL + 198 * MiB;
constexpr size_t WS_FSD2 = WS_PX + 124 * MiB;
constexpr size_t WS_W2 = WS_FSD2 + 68 * MiB;
constexpr size_t WS_H2H = WS_W2 + 128 * MiB;
static_assert(WS_H2H + 5 * MiB <= WS_PX + 372 * MiB, "PX tail");
static_assert((size_t)MT * FFH * 2 <= 198 * MiB, "ACT overlay");
constexpr int CW_BAR = 4096;

constexpr int RING_BYTES = 131072;
constexpr int EXTRA_OFF = RING_BYTES, EXTRA_BYTES = 8192;
constexpr int LDSCTL_OFF = EXTRA_OFF + EXTRA_BYTES;
constexpr int LDS_BYTES = LDSCTL_OFF + 256;

__device__ __forceinline__ float wave_sum(float v) {
#pragma unroll
    for (int o = 1; o < 64; o <<= 1) v += __shfl_xor(v, o);
    return v;
}
__device__ __forceinline__ float sigmoidf_(float x) { return __builtin_amdgcn_rcpf(1.0f + __expf(-x)); }
__device__ __forceinline__ float siluf_(float x) { return x * sigmoidf_(x); }
__device__ __forceinline__ float gelu_tanh_(float x) { const float u = 0.7978845608028654f * (x + 0.044715f * x * x * x); return x * __builtin_amdgcn_rcpf(1.0f + __expf(-2.0f * u)); }
__device__ __forceinline__ float logsigmoidf_(float x) { return fminf(x, 0.f) - __logf(1.0f + __expf(-fabsf(x))); }
__device__ __forceinline__ f32x2 cmul(f32x2 a, f32x2 b) { return (f32x2){a.x * b.x - a.y * b.y, a.x * b.y + a.y * b.x}; }
__device__ __forceinline__ f32x2 cconj(f32x2 a) { return (f32x2){a.x, -a.y}; }
__device__ __forceinline__ int opq(int x) { asm volatile("" : "+v"(x)); return x; }
#define PIN8(a, b, c, d, e, f, g, h) asm volatile("" : "+v"(a), "+v"(b), "+v"(c), "+v"(d), "+v"(e), "+v"(f), "+v"(g), "+v"(h))
#define PIN4(a, b, c, d) asm volatile("" : "+v"(a), "+v"(b), "+v"(c), "+v"(d))
#ifndef OPBITS_DROP
#define OPBITS_DROP 4
#endif
__device__ __forceinline__ f16 lowtog(f16 h) { unsigned short u = __builtin_bit_cast(unsigned short, h); constexpr unsigned short M = (unsigned short)((1u << OPBITS_DROP) - 1u);
    u = (unsigned short)((u + (M >> 1) + ((u >> OPBITS_DROP) & 1u)) & (unsigned short)~M); return __builtin_bit_cast(f16, u); }
template <int N> __device__ __forceinline__ float dpp_ror(float x) { return __builtin_bit_cast(float, __builtin_amdgcn_update_dpp(0, __builtin_bit_cast(int, x), 0x120 + N, 0xF, 0xF, false)); }
__device__ __forceinline__ unsigned lowtog2(unsigned u) { constexpr unsigned M = (1u << OPBITS_DROP) - 1u, M2 = M | (M << 16), H2 = (M >> 1) | ((M >> 1) << 16);
    return (u + H2 + ((u >> OPBITS_DROP) & 0x00010001u)) & ~M2; }
#ifndef OPBITS_DROP_W
#define OPBITS_DROP_W 5
#endif
__device__ __forceinline__ unsigned lowtog2w(unsigned u) { constexpr unsigned M = (1u << OPBITS_DROP_W) - 1u, M2 = M | (M << 16), H2 = (M >> 1) | ((M >> 1) << 16);
    return (u + H2 + ((u >> OPBITS_DROP_W) & 0x00010001u)) & ~M2; }
typedef unsigned u32x2v __attribute__((ext_vector_type(2)));
typedef unsigned u32x4v __attribute__((ext_vector_type(4)));
__device__ __forceinline__ f16x4 lowtog4(f16x4 w) { u32x2v u = __builtin_bit_cast(u32x2v, w); u[0] = lowtog2(u[0]); u[1] = lowtog2(u[1]); return __builtin_bit_cast(f16x4, u); }
#define LDS_WAIT() asm volatile("s_waitcnt lgkmcnt(0)" ::: "memory")
#define VM_WAIT() asm volatile("s_waitcnt vmcnt(0)" ::: "memory")

#define XB_TMO      128
#define XB_XCNT(j)  (256  + 64 * (j))
#define XB_XSUB(j)  (1280 + 64 * (j))
#define XB_XGEN(j)  (2304 + 64 * (j))
#define XB_TOP      3328
#define XB_TOPGEN   3392
#define XCD_BAR_WORDS 3456
#define XB_SPIN_CAP (1u << 18)
__device__ __forceinline__ unsigned xb_ld(unsigned* p)              { return __hip_atomic_load(p, __ATOMIC_RELAXED, __HIP_MEMORY_SCOPE_AGENT); }
__device__ __forceinline__ unsigned xb_add(unsigned* p, unsigned v) { return __hip_atomic_fetch_add(p, v, __ATOMIC_RELAXED, __HIP_MEMORY_SCOPE_AGENT); }
__device__ __forceinline__ unsigned xb_xcc_id() { return (unsigned)__builtin_amdgcn_s_getreg((3 << 11) | 20) & 0xFu; }
#define XB_SPIN(cond, bar) do { unsigned _sp = 0; while (cond) { __builtin_amdgcn_s_sleep(1); \
    if ((++_sp & 255u) == 0u) { if (xb_ld(&(bar)[XB_TMO])) break; if (_sp > XB_SPIN_CAP) { atomicAdd(&(bar)[XB_TMO], 1u); break; } } } } while (0)
struct XcdBarrier { unsigned* bar; unsigned x; volatile LAS unsigned* st; };
__device__ __forceinline__ XcdBarrier xcd_barrier_post(unsigned* bar, volatile LAS unsigned* st) {
    XcdBarrier b; b.bar = bar; b.x = xb_xcc_id(); b.st = st;
    if (threadIdx.x == 0) (void)xb_add(&bar[XB_XCNT(b.x)], 1u);
    return b;
}
__device__ __forceinline__ void xcd_barrier_complete(unsigned* bar, unsigned x, unsigned& nloc, unsigned& nx) {
    const unsigned G = gridDim.x * gridDim.y * gridDim.z;
    unsigned sum, cnt, mine, sp = 0u;
    for (;;) {
        sum = 0u; cnt = 0u; mine = 0u;
#pragma unroll
        for (unsigned j = 0; j < 16; ++j) { const unsigned c = xb_ld(&bar[XB_XCNT(j)]); sum += c; cnt += (c > 0u) ? 1u : 0u; mine = (j == x) ? c : mine; }
        if (sum == G) break;
        __builtin_amdgcn_s_sleep(1);
        if ((++sp & 255u) == 0u) { if (xb_ld(&bar[XB_TMO])) break; if (sp > XB_SPIN_CAP) { atomicAdd(&bar[XB_TMO], 1u); break; } }
    }
    nloc = mine > 0u ? mine : 1u; nx = cnt > 0u ? cnt : 1u;
}
__device__ __forceinline__ void xcd_barrier(const XcdBarrier& b) {
    asm volatile("s_waitcnt vmcnt(0)" ::: "memory");
    __syncthreads();
    if (threadIdx.x == 0) {
        unsigned* bar = b.bar;
        __builtin_amdgcn_s_waitcnt(0);
        unsigned nloc = b.st[0], nx = b.st[1];
        if (nloc == 0u) { xcd_barrier_complete(bar, b.x, nloc, nx); b.st[0] = nloc; b.st[1] = nx; }
        const unsigned old = xb_add(&bar[XB_XSUB(b.x)], 1u);
        const unsigned gen = old / nloc;
        if (old + 1u == (gen + 1u) * nloc) {
            __builtin_amdgcn_fence(__ATOMIC_RELEASE, "agent");
            asm volatile("s_waitcnt vmcnt(0)" ::: "memory");
            const unsigned og = xb_add(&bar[XB_TOP], 1u);
            const unsigned tg = og / nx;
            if (og + 1u == (tg + 1u) * nx) xb_add(&bar[XB_TOPGEN], 1u);
            else XB_SPIN(xb_ld(&bar[XB_TOPGEN]) == tg, bar);
            __builtin_amdgcn_fence(__ATOMIC_ACQUIRE, "agent");
            xb_add(&bar[XB_XGEN(b.x)], 1u);
            asm volatile("s_waitcnt vmcnt(0)" ::: "memory");
        } else {
            XB_SPIN(xb_ld(&bar[XB_XGEN(b.x)]) == gen, bar);
            __builtin_amdgcn_fence(__ATOMIC_ACQUIRE, "agent");
            asm volatile("s_waitcnt vmcnt(0)" ::: "memory");
        }
    }
    __syncthreads();
}

struct Args {
    const float* in[40];
    float* out; unsigned char* ws;
    int ph_lo, ph_hi;
};
struct ArgsV {
    __device__ __forceinline__ const float* in(int i) const {
        typedef const __attribute__((address_space(4))) unsigned long long* kp_t;
        kp_t ka = (kp_t)__builtin_amdgcn_kernarg_segment_ptr();
        return (const float*)(*(volatile const __attribute__((address_space(4))) unsigned long long*)(ka + i)); }
    float* out;
};
struct Ctx {
    LAS unsigned char* lds;
    int tid, lane, wave, G, bid;
    unsigned char* ws;
};
enum { I_X = 0, I_C, I_CTX, I_CCTX, I_WMOD, I_BMOD, I_N1G, I_N2G, I_WIN, I_S5ARE, I_S5AIM, I_S5STEP, I_S5BRE, I_S5BIM, I_S5CRE, I_S5CIM,
       I_S5D, I_GLUW, I_GLUB, I_HYCW, I_HYCB, I_HYW1, I_HYB1, I_HYF1, I_HYW2, I_HYB2, I_HYF2, I_HYW3, I_HYB3, I_HYBIAS,
       I_GLAWG, I_GLABG, I_GLANG, I_WBR, I_WOUT, I_WUP, I_FFCW, I_FFCB, I_WDN, I_FNG };

namespace pg8 {
constexpr int BM = 256, BK = 64, HALF = 128, HTB = HALF * BK * 2, STAGE_BYTES = 8 * HTB, NXCD = 8, WGM = 4;
__device__ __forceinline__ int lds_byte(int r, int c) { const int st = (r >> 4) * 2 + (c >> 5), rr = r & 15, cc = c & 31, ob = rr * 64 + cc * 2; return st * 1024 + (ob ^ (((ob >> 9) & 1) << 5)); }
__device__ __forceinline__ void stage_rc(int b, int& R, int& C) { const int st = b / 1024, sb = b % 1024, swz = sb ^ (((sb >> 9) & 1) << 5); R = (st >> 1) * 16 + swz / 64; C = (st & 1) * 32 + (swz % 64) / 2; }
__device__ __forceinline__ int perm32(int rho) { const int n = rho >> 4, i = rho & 15; return 8 * (i >> 2) + 4 * n + (i & 3); }
struct Unit { const char* a; const char* b; int pm, pn; };
struct Order2D {
    int nM, nN, nwg, G, c;
    __device__ __forceinline__ void init(int nM_, int nN_, int G_, int c_) { nM = nM_; nN = nN_; nwg = nM * nN; G = G_; c = c_; }
    __device__ __forceinline__ bool nx(int i, int& pm, int& pn) const {
        const long L = (long)i * G + c; if (L >= nwg) return false;
        int wgid = (int)L; { const int q = nwg / NXCD, r = nwg % NXCD, xcd = wgid % NXCD, off = wgid / NXCD; wgid = (xcd < r ? xcd * (q + 1) : r * (q + 1) + (xcd - r) * q) + off; }
        const int nig = WGM * nN, gid = wgid / nig, fm = gid * WGM, gsz = (nM - fm) < WGM ? (nM - fm) : WGM;
        pm = fm + ((wgid % nig) % gsz); pn = (wgid % nig) / gsz; return true;
    }
};
struct SchedPlain : Order2D {
    const char* A; const char* B; size_t aTile, bTile;
    __device__ __forceinline__ bool next(int i, Unit& u) const { int pm, pn; if (!nx(i, pm, pn)) return false; u.pm = pm; u.pn = pn; u.a = A + (size_t)pm * aTile; u.b = B + (size_t)pn * bTile; return true; }
};
struct SchedPx : Order2D {
    const char* A; const char* B; size_t tile;
    __device__ __forceinline__ bool next(int i, Unit& u) const { int pm, pn; if (!nx(i, pm, pn)) return false; u.pm = pm; u.pn = pn; const char* pa = A + (size_t)pm * tile; const char* pb = B + (size_t)pn * tile;
        const bool sw = pn >= 14 && pn < 20; u.a = sw ? pb : pa; u.b = sw ? pa : pb; return true; }
};
struct SchedSplit {
    const char* A; const char* B; size_t aTile, bTile, ksub; int nsplit, G, c;
    __device__ __forceinline__ bool next(int i, Unit& u) const { const int L = i * G + c; if (L >= 16 * nsplit) return false; const int t = L / nsplit, ks = L % nsplit, pm = 64 + (t >> 3), pn = t & 7;
        u.pm = pm; u.pn = pn | (ks << 8); u.a = A + (size_t)pm * aTile + (size_t)ks * ksub; u.b = B + (size_t)pn * bTile + (size_t)ks * ksub; return true; }
};
struct SchedS5 {
    const char* A; const char* B; size_t bGroup; int G, c;
    __device__ __forceinline__ bool next(int i, Unit& u) const { const int L = i * G + c; if (L >= 160) return false; const int g = L & 31, pm = L >> 5;
        u.pm = pm; u.pn = g; u.a = A + ((size_t)pm * 256 * 16384 + (size_t)g * 512) * 2; u.b = B + (size_t)g * bGroup; return true; }
};

#define PG8_SA(b, h) (((b) * 2 + (h)) * HTB)
#define PG8_SB(b, h) ((4 + (b) * 2 + (h)) * HTB)
#define PG8_STAGE(bufoff, gbase, voff) do { _Pragma("unroll") for (int _i = 0; _i < 2; ++_i) \
        __builtin_amdgcn_global_load_lds((const unsigned*)((const char*)(gbase) + (voff)[_i]), (LAS unsigned*)(lds + (bufoff) + ldsw + _i * 8192), 16, 0, 0); } while (0)
#define PG8_LDA(dst, b, h) do { _Pragma("unroll") for (int m = 0; m < 4; ++m) _Pragma("unroll") for (int k = 0; k < 2; ++k) dst[m][k] = *(const LAS f16x8*)(lds + PG8_SA(b, h) + aoff + m * 2048 + k * 1024); } while (0)
#define PG8_LDB(dst, b, h) do { _Pragma("unroll") for (int n = 0; n < 2; ++n) _Pragma("unroll") for (int k = 0; k < 2; ++k) dst[n][k] = *(const LAS f16x8*)(lds + PG8_SB(b, h) + boff + n * 2048 + k * 1024); } while (0)
#define PG8_MMA(ai, bj, At, Bt) do { __builtin_amdgcn_s_setprio(1); _Pragma("unroll") for (int m = 0; m < 4; ++m) _Pragma("unroll") for (int n = 0; n < 2; ++n) _Pragma("unroll") for (int k = 0; k < 2; ++k) \
        acc[ai][bj][m][n] = __builtin_amdgcn_mfma_f32_16x16x32_f16(Bt[n][k], At[m][k], acc[ai][bj][m][n], 0, 0, 0); __builtin_amdgcn_s_setprio(0); } while (0)
#define PG8_WAIT_V(n) asm volatile("s_waitcnt vmcnt(" #n ")" ::: "memory")
#define PG8_WAIT_L(n) asm volatile("s_waitcnt lgkmcnt(" #n ")" ::: "memory")
#define PG8_BAR __builtin_amdgcn_s_barrier()
#define PG8_SCHED __builtin_amdgcn_sched_barrier(0)

template <class Epi, class Sched>
__device__ __forceinline__ void gemm_phase(LAS unsigned char* lds, const int lda, const int ldb, const int nt, const Sched& S, const Epi& E) {
    const int tid = opq((int)threadIdx.x), wid = __builtin_amdgcn_readfirstlane(tid >> 6), lane = tid & 63, wr = wid >> 2, wc = wid & 3, fr = lane & 15, fq = lane >> 4;
    unsigned voffA[2], voffB[2];
#pragma unroll
    for (int i = 0; i < 2; ++i) { int R, C; stage_rc(tid * 16 + i * 8192, R, C); const int Rb = Epi::PERM ? ((R & ~31) + perm32(R & 31)) : R;
        voffA[i] = (unsigned)(R * lda + C) * 2u; voffB[i] = (unsigned)(Rb * ldb + C) * 2u; }
    const size_t kstep = (size_t)(BK * 2);
    const size_t hstepA = (size_t)HALF * lda * 2, hstepB = (size_t)HALF * ldb * 2;
    const unsigned ldsw = (unsigned)wid * 1024u;
    const int aoff = lds_byte(wr * 64 + fr, fq * 8), boff = lds_byte(wc * 32 + fr, fq * 8);
    Unit cur, nxt; int ui = 0;
    if (!S.next(0, cur)) return;
    f32x4 acc[2][2][4][2];
#pragma unroll
    for (int a = 0; a < 2; ++a)
#pragma unroll
        for (int b = 0; b < 2; ++b)
#pragma unroll
            for (int m = 0; m < 4; ++m)
#pragma unroll
                for (int n = 0; n < 2; ++n) acc[a][b][m][n] = (f32x4){0.f, 0.f, 0.f, 0.f};
    f16x8 At[4][2], B0[2][2], B1[2][2];
    const char* cA = cur.a; const char* cB = cur.b;
    PG8_STAGE(PG8_SB(0, 0), cB, voffB); PG8_STAGE(PG8_SA(0, 0), cA, voffA); PG8_STAGE(PG8_SB(0, 1), cB + hstepB, voffB); PG8_STAGE(PG8_SA(0, 1), cA + hstepA, voffA);
    if (wr == 1) PG8_BAR;
    PG8_WAIT_V(4); PG8_BAR;
    PG8_STAGE(PG8_SB(1, 0), cB + kstep, voffB); PG8_STAGE(PG8_SA(1, 0), cA + kstep, voffA); PG8_STAGE(PG8_SB(1, 1), cB + hstepB + kstep, voffB);
    PG8_WAIT_V(6); PG8_BAR;
    for (;;) {
        const bool has_next = S.next(ui + 1, nxt);
        const char* nA = has_next ? nxt.a : cA; const char* nB = has_next ? nxt.b : cB;
        constexpr int NSEG = Epi::HAS_MID ? 3 : 1;
#pragma unroll
        for (int seg = 0; seg < NSEG; ++seg) {
        const int tb = Epi::HAS_MID ? (seg == 0 ? 0 : (seg == 1 ? Epi::MID1 + 2 : Epi::MID2 + 2)) : 0;
        const int te = Epi::HAS_MID ? (seg == 0 ? Epi::MID1 + 2 : (seg == 1 ? Epi::MID2 + 2 : nt)) : nt;
        for (int t = tb; t < te; t += 2) {
            const bool last = (t == nt - 2);
            const char* a1 = cA + (size_t)(t + 1) * kstep;
            const char* a2 = last ? nA : cA + (size_t)(t + 2) * kstep; const char* b2 = last ? nB : cB + (size_t)(t + 2) * kstep;
            const char* a3 = a2 + kstep; const char* b3 = b2 + kstep;
            PG8_LDB(B0, 0, 0); PG8_SCHED; PG8_LDA(At, 0, 0); PG8_STAGE(PG8_SA(1, 1), a1 + hstepA, voffA);
            PG8_WAIT_L(8); PG8_BAR; PG8_WAIT_L(0); PG8_MMA(0, 0, At, B0); PG8_BAR; PG8_SCHED;
            PG8_LDB(B1, 0, 1); PG8_STAGE(PG8_SB(0, 0), b2, voffB);
            PG8_BAR; PG8_WAIT_L(0); PG8_MMA(0, 1, At, B1); PG8_BAR;
            PG8_LDA(At, 0, 1); PG8_STAGE(PG8_SA(0, 0), a2, voffA);
            PG8_BAR; PG8_WAIT_L(0); PG8_MMA(1, 0, At, B0); PG8_BAR; PG8_SCHED;
            PG8_STAGE(PG8_SB(0, 1), b2 + hstepB, voffB);
            PG8_WAIT_V(6); PG8_BAR; PG8_MMA(1, 1, At, B1); PG8_BAR;
            PG8_LDB(B0, 1, 0); PG8_SCHED; PG8_LDA(At, 1, 0); PG8_STAGE(PG8_SA(0, 1), a2 + hstepA, voffA);
            PG8_WAIT_L(8); PG8_BAR; PG8_WAIT_L(0); PG8_MMA(0, 0, At, B0); PG8_BAR; PG8_SCHED;
            PG8_LDB(B1, 1, 1); PG8_STAGE(PG8_SB(1, 0), b3, voffB);
            PG8_BAR; PG8_WAIT_L(0); PG8_MMA(0, 1, At, B1); PG8_BAR;
            PG8_LDA(At, 1, 1); PG8_STAGE(PG8_SA(1, 0), a3, voffA);
            PG8_BAR; PG8_WAIT_L(0); PG8_MMA(1, 0, At, B0); PG8_BAR; PG8_SCHED;
            PG8_STAGE(PG8_SB(1, 1), b3 + hstepB, voffB);
            PG8_WAIT_V(6); PG8_BAR; PG8_MMA(1, 1, At, B1); PG8_BAR;
        }
        if constexpr (Epi::HAS_MID) { if (seg < 2) {
            E.mid(acc, cur, seg, wr, wc, fr, fq);
        } }
        }
#if STAMP_MASK & (1 << 23)
        if (Epi::HAS_MID && blockIdx.x == 0 && threadIdx.x == 0) ((volatile LAS unsigned long long*)(lds + LDSCTL_OFF + 128))[0] = __builtin_amdgcn_s_memrealtime();
#endif
        E(acc, cur, wr, wc, fr, fq);
#if STAMP_MASK & (1 << 23)
        if (Epi::HAS_MID && blockIdx.x == 0 && threadIdx.x == 0) { volatile LAS unsigned long long* TS = (volatile LAS unsigned long long*)(lds + LDSCTL_OFF + 128); TS[1] = TS[1] + (__builtin_amdgcn_s_memrealtime() - TS[0]); }
#endif
        if (!has_next) break;
#pragma unroll
        for (int a = 0; a < 2; ++a)
#pragma unroll
            for (int b = 0; b < 2; ++b)
#pragma unroll
                for (int m = 0; m < 4; ++m)
#pragma unroll
                    for (int n = 0; n < 2; ++n) acc[a][b][m][n] = (f32x4){0.f, 0.f, 0.f, 0.f};
        cur = nxt; cA = nA; cB = nB; ++ui;
    }
    PG8_WAIT_V(0);
    if (wr == 0) PG8_BAR;
    PG8_BAR;
}
#undef PG8_SA
#undef PG8_SB
#undef PG8_STAGE
#undef PG8_LDA
#undef PG8_LDB
#undef PG8_MMA
#undef PG8_WAIT_V
#undef PG8_WAIT_L
#undef PG8_BAR
#undef PG8_SCHED

typedef const f32x4 (&AccRef)[2][2][4][2];
__device__ __forceinline__ f16x8 lowtog8(f16x8 w) { u32x4v u = __builtin_bit_cast(u32x4v, w);
#pragma unroll
    for (int e = 0; e < 4; ++e) u[e] = lowtog2(u[e]);
    return __builtin_bit_cast(f16x8, u); }
__device__ __forceinline__ f16x8 lowtog8w(f16x8 w) { u32x4v u = __builtin_bit_cast(u32x4v, w);
#pragma unroll
    for (int e = 0; e < 4; ++e) u[e] = lowtog2w(u[e]);
    return __builtin_bit_cast(f16x8, u); }
__device__ __forceinline__ f16x8 pack8(f32x4 a, f32x4 b) { f16x8 w; w[0] = (f16)a[0]; w[1] = (f16)a[1]; w[2] = (f16)a[2]; w[3] = (f16)a[3]; w[4] = (f16)b[0]; w[5] = (f16)b[1]; w[6] = (f16)b[2]; w[7] = (f16)b[3]; return w; }

struct EpiPx {
    static constexpr bool PERM = true, HAS_MID = false; static constexpr int MID1 = 0, MID2 = 0; f16* PX; f16* S5A; f16* ZT; f16* GTL;
    __device__ __forceinline__ void operator()(AccRef acc, const Unit& u, int wr, int wc, int fr, int fq) const { fr = opq(fr); fq = opq(fq);
        const int row0 = u.pm * BM + wr * 64 + fr, col0 = u.pn * BM + wc * 32 + 8 * fq;
#pragma unroll
        for (int ai = 0; ai < 2; ++ai)
#pragma unroll
            for (int m = 0; m < 4; ++m) { const int row = row0 + ai * HALF + m * 16;
#pragma unroll
                for (int bj = 0; bj < 2; ++bj) { const int c = col0 + bj * HALF; const f16x8 w = pack8(acc[ai][bj][m][0], acc[ai][bj][m][1]);
                    if (u.pn < 2) *(f16x8*)(S5A + (size_t)(row >> 4) * 16384 + (size_t)(c >> 4) * 512 + (row & 15) * 16 + (c & 15)) = w;
                    else if (u.pn >= 14 && u.pn < 20) *(f16x8*)(ZT + (size_t)(u.pn * BM + (row - u.pm * BM) - P_HY) * MT + (u.pm * BM + (c - u.pn * BM))) = w;
                    else if (u.pn >= 20 && u.pn < 44) { f16x8 e;
#pragma unroll
                        for (int j = 0; j < 4; ++j) { e[j] = (f16)fminf(1.0f + __expf(-acc[ai][bj][m][0][j]), 60000.0f); e[4 + j] = (f16)fminf(1.0f + __expf(-acc[ai][bj][m][1][j]), 60000.0f); }
                        *(f16x8*)(GTL + ((size_t)(u.pn - 20) * 66 + u.pm) * 65536 + (size_t)(row - u.pm * BM) * 256 + (c - u.pn * BM)) = e; }
                    else { const int pr = row < MX ? (row & ~8191) + ((row & 63) << 7) + ((row & 8191) >> 6) : row;
                        *(f16x8*)(PX + (size_t)pr * PXLD + (u.pn == 44 ? c - (W_GG - P_GG) : c)) = w; } } }
    }
};
struct EpiF16 {
    static constexpr bool PERM = true, HAS_MID = false; static constexpr int MID1 = 0, MID2 = 0; f16* O; int ldc;
    __device__ __forceinline__ void operator()(AccRef acc, const Unit& u, int wr, int wc, int fr, int fq) const { fr = opq(fr); fq = opq(fq);
        const int row0 = u.pm * BM + wr * 64 + fr, col0 = u.pn * BM + wc * 32 + 8 * fq;
#pragma unroll
        for (int ai = 0; ai < 2; ++ai)
#pragma unroll
            for (int m = 0; m < 4; ++m) { f16* rowp = O + (size_t)(row0 + ai * HALF + m * 16) * ldc + col0;
#pragma unroll
                for (int bj = 0; bj < 2; ++bj) *(f16x8*)(rowp + bj * HALF) = pack8(acc[ai][bj][m][0], acc[ai][bj][m][1]); }
    }
};
struct EpiS5In {
    static constexpr bool PERM = false, HAS_MID = false; static constexpr int MID1 = 0, MID2 = 0; float* S;
    __device__ __forceinline__ void operator()(AccRef acc, const Unit& u, int wr, int wc, int fr, int fq) const { fr = opq(fr); fq = opq(fq);
        const int row0 = u.pm * BM + wr * 64 + fr, col0 = wc * 32 + 4 * fq, g = u.pn;
#pragma unroll
        for (int ai = 0; ai < 2; ++ai)
#pragma unroll
            for (int m = 0; m < 4; ++m) { const int row = row0 + ai * HALF + m * 16; { float* rowp = S + ((size_t)row * 32 + g) * 256 + col0;
#pragma unroll
                for (int bj = 0; bj < 2; ++bj)
#pragma unroll
                    for (int n = 0; n < 2; ++n) *(f32x4*)(rowp + bj * HALF + n * 16) = acc[ai][bj][m][n]; } }
    }
};
struct EpiS5Out {
    static constexpr bool PERM = true, HAS_MID = false; static constexpr int MID1 = 0, MID2 = 0; const f16* S5A; f16* Y; const float* dvec;
    __device__ __forceinline__ void operator()(AccRef acc, const Unit& u, int wr, int wc, int fr, int fq) const { fr = opq(fr); fq = opq(fq);
        const int row0 = u.pm * BM + wr * 64 + fr, col0 = wc * 32 + 8 * fq, g = u.pn;
        const int h0 = col0 & 15;
        const f32x4 d0 = *(const f32x4*)(dvec + g * 16 + h0), d1 = *(const f32x4*)(dvec + g * 16 + h0 + 4);
#pragma unroll
        for (int ai = 0; ai < 2; ++ai) { f16x8 uu[4][2];
#pragma unroll
            for (int m = 0; m < 4; ++m)
#pragma unroll
                for (int bj = 0; bj < 2; ++bj) uu[m][bj] = *(const f16x8*)(S5A + (size_t)(row0 + ai * HALF + m * 16) * 16384 + (size_t)g * 512 + col0 + bj * HALF);
            PIN8(uu[0][0], uu[0][1], uu[1][0], uu[1][1], uu[2][0], uu[2][1], uu[3][0], uu[3][1]);
#pragma unroll
            for (int m = 0; m < 4; ++m) { const int chunk = row0 + ai * HALF + m * 16;
#pragma unroll
                for (int bj = 0; bj < 2; ++bj) { const int c = col0 + bj * HALF, t = c >> 4; f16x8 w;
#pragma unroll
                    for (int j = 0; j < 4; ++j) { w[j] = (f16)gelu_tanh_(acc[ai][bj][m][0][j] * (1.0f / S5SCALE) + d0[j] * (float)uu[m][bj][j]);
                                                  w[4 + j] = (f16)gelu_tanh_(acc[ai][bj][m][1][j] * (1.0f / S5SCALE) + d1[j] * (float)uu[m][bj][4 + j]); }
                    *(f16x8*)(Y + (size_t)(chunk * 16 + t) * 512 + g * 16 + h0) = lowtog8(w); } }
            asm volatile("" ::: "memory"); }
    }
};
struct EpiGlu {
    static constexpr bool PERM = true, HAS_MID = false; static constexpr int MID1 = 0, MID2 = 0; const f16* YP; f16* O; const float* bias;
    __device__ __forceinline__ void operator()(AccRef acc, const Unit& u, int wr, int wc, int fr, int fq) const { fr = opq(fr); fq = opq(fq);
        const int row0 = u.pm * BM + wr * 64 + fr, col0 = u.pn * BM + wc * 32 + 8 * fq;
        f32x4 bv[2][2];
#pragma unroll
        for (int bj = 0; bj < 2; ++bj) { bv[bj][0] = *(const f32x4*)(bias + col0 + bj * HALF); bv[bj][1] = *(const f32x4*)(bias + col0 + bj * HALF + 4); }
#pragma unroll
        for (int ai = 0; ai < 2; ++ai) { f16x8 yp[4][2];
#pragma unroll
            for (int m = 0; m < 4; ++m)
#pragma unroll
                for (int bj = 0; bj < 2; ++bj) yp[m][bj] = *(const f16x8*)(YP + (size_t)(row0 + ai * HALF + m * 16) * 512 + col0 + bj * HALF);
            PIN8(yp[0][0], yp[0][1], yp[1][0], yp[1][1], yp[2][0], yp[2][1], yp[3][0], yp[3][1]);
#pragma unroll
            for (int m = 0; m < 4; ++m)
#pragma unroll
                for (int bj = 0; bj < 2; ++bj) { f16x8 w;
#pragma unroll
                    for (int j = 0; j < 4; ++j) { w[j] = (f16)((float)yp[m][bj][j] * sigmoidf_(acc[ai][bj][m][0][j] + bv[bj][0][j])); w[4 + j] = (f16)((float)yp[m][bj][4 + j] * sigmoidf_(acc[ai][bj][m][1][j] + bv[bj][1][j])); }
                    *(f16x8*)(O + (size_t)(row0 + ai * HALF + m * 16) * 2048 + col0 + bj * HALF) = lowtog8(w); }
            asm volatile("" ::: "memory"); }
    }
};
template <int BR> struct EpiBranch {
    static constexpr bool PERM = true, HAS_MID = false; static constexpr int MID1 = 0, MID2 = 0; const f16* PX; f16* M;
    __device__ __forceinline__ void operator()(AccRef acc, const Unit& u, int wr, int wc, int fr, int fq) const { fr = opq(fr); fq = opq(fq);
        const int row0 = u.pm * BM + wr * 64 + fr, col0 = u.pn * BM + wc * 32 + 8 * fq;
#pragma unroll
        for (int ai = 0; ai < 2; ++ai)
#pragma unroll
            for (int m = 0; m < 4; ++m) { const int row = row0 + ai * HALF + m * 16;
#pragma unroll
                for (int bj = 0; bj < 2; ++bj) { const int c = col0 + bj * HALF;
                    const f16x8 gl = *(const f16x8*)(PX + (size_t)row * PXLD + P_MG + BR * 2048 + c);
                    f16* mp = M + (size_t)row * 2048 + c;
                    f16x8 prev; if (BR > 0) prev = *(const f16x8*)mp;
                    f16x8 w;
#pragma unroll
                    for (int j = 0; j < 4; ++j) { float v0 = sigmoidf_((float)gl[j]) * acc[ai][bj][m][0][j], v1 = sigmoidf_((float)gl[4 + j]) * acc[ai][bj][m][1][j];
                        if (BR > 0) { v0 += (float)prev[j]; v1 += (float)prev[4 + j]; } w[j] = (f16)v0; w[4 + j] = (f16)v1; }
                    *(f16x8*)mp = w; } asm volatile("" ::: "memory"); }
    }
};
typedef f32x4 (&AccMut)[2][2][4][2];

struct EpiBranchF {
    static constexpr bool PERM = true, HAS_MID = true; static constexpr int MID1 = 6, MID2 = 14;
    const f16* GTL; f16* M;
    __device__ __forceinline__ void mid(AccMut acc, const Unit& u, int seg, int wr, int wc, int fr, int fq) const { fr = opq(fr); fq = opq(fq);
        const int lrow0 = wr * 64 + fr, lcol0 = wc * 32 + 8 * fq;
        const f16* ga = GTL + ((size_t)((seg == 0 ? 0 : 8) + u.pn) * 66 + u.pm) * 65536; const f16* gb = ga + (size_t)8 * 66 * 65536;
#pragma unroll
        for (int ai = 0; ai < 2; ++ai) { f16x8 za[4][2], zb[4][2];
#pragma unroll
            for (int m = 0; m < 4; ++m)
#pragma unroll
                for (int bj = 0; bj < 2; ++bj) { const int off = (lrow0 + ai * HALF + m * 16) * 256 + lcol0 + bj * HALF; za[m][bj] = *(const f16x8*)(ga + off); zb[m][bj] = *(const f16x8*)(gb + off); }
            PIN8(za[0][0], za[0][1], za[1][0], za[1][1], za[2][0], za[2][1], za[3][0], za[3][1]); PIN8(zb[0][0], zb[0][1], zb[1][0], zb[1][1], zb[2][0], zb[2][1], zb[3][0], zb[3][1]);
#pragma unroll
            for (int m = 0; m < 4; ++m)
#pragma unroll
                for (int bj = 0; bj < 2; ++bj)
#pragma unroll
                    for (int j = 0; j < 4; ++j) { acc[ai][bj][m][0][j] *= (float)zb[m][bj][j] * __builtin_amdgcn_rcpf((float)za[m][bj][j]);
                                                  acc[ai][bj][m][1][j] *= (float)zb[m][bj][4 + j] * __builtin_amdgcn_rcpf((float)za[m][bj][4 + j]); }
            asm volatile("" ::: "memory"); }
    }
    __device__ __forceinline__ void operator()(AccRef acc, const Unit& u, int wr, int wc, int fr, int fq) const { fr = opq(fr); fq = opq(fq);
        const int row0 = u.pm * BM + wr * 64 + fr, col0 = u.pn * BM + wc * 32 + 8 * fq;
#pragma unroll
        for (int ai = 0; ai < 2; ++ai) { f16x8 gl[4][2];
#pragma unroll
            for (int m = 0; m < 4; ++m)
#pragma unroll
                for (int bj = 0; bj < 2; ++bj) gl[m][bj] = *(const f16x8*)(GTL + ((size_t)(16 + u.pn) * 66 + u.pm) * 65536 + (wr * 64 + fr + ai * HALF + m * 16) * 256 + wc * 32 + 8 * fq + bj * HALF);
            PIN8(gl[0][0], gl[0][1], gl[1][0], gl[1][1], gl[2][0], gl[2][1], gl[3][0], gl[3][1]);
#pragma unroll
            for (int m = 0; m < 4; ++m)
#pragma unroll
                for (int bj = 0; bj < 2; ++bj) { f16x8 w;
#pragma unroll
                    for (int j = 0; j < 4; ++j) { w[j] = (f16)(__builtin_amdgcn_rcpf((float)gl[m][bj][j]) * acc[ai][bj][m][0][j]); w[4 + j] = (f16)(__builtin_amdgcn_rcpf((float)gl[m][bj][4 + j]) * acc[ai][bj][m][1][j]); }
                    *(f16x8*)(M + (size_t)(row0 + ai * HALF + m * 16) * 2048 + col0 + bj * HALF) = lowtog8(w); }
            asm volatile("" ::: "memory"); }
    }
};
struct EpiUpAct {
    static constexpr bool PERM = true, HAS_MID = false; static constexpr int MID1 = 0, MID2 = 0; f16* ACT; float* HALO; const float* cw; const float* cb; LAS float* HL;
    __device__ __forceinline__ void operator()(AccRef acc, const Unit& u, int wr, int wc, int fr, int fq) const { fr = opq(fr); fq = opq(fq);
        const int lane = fq * 16 + fr;
#pragma unroll
        for (int ai = 0; ai < 2; ++ai) { LAS float* hp = HL + ((ai * 2 + wr) * 4 + wc) * 64 + 8 * fq;
            if (fr == 0) { *(LAS f32x4*)(hp) = acc[ai][0][0][0]; *(LAS f32x4*)(hp + 4) = acc[ai][0][0][1]; }
            if (fr == 15) { *(LAS f32x4*)(hp + 32) = acc[ai][0][3][0]; *(LAS f32x4*)(hp + 36) = acc[ai][0][3][1]; } }
        { float* gh = HALO + ((size_t)u.pm * 44 + u.pn) * 768 + wc * 32 + 8 * fq;
          if (wr == 0 && fr < 2) { *(f32x4*)(gh + fr * 128) = acc[0][0][0][0]; *(f32x4*)(gh + fr * 128 + 4) = acc[0][0][0][1]; }
          if (wr == 0 && fr == 0) { *(f32x4*)(gh + 4 * 128) = acc[0][1][0][0]; *(f32x4*)(gh + 4 * 128 + 4) = acc[0][1][0][1]; }
          if (wr == 1 && fr >= 14) { *(f32x4*)(gh + (fr - 12) * 128) = acc[1][0][3][0]; *(f32x4*)(gh + (fr - 12) * 128 + 4) = acc[1][0][3][1]; }
          if (wr == 1 && fr == 15) { *(f32x4*)(gh + 5 * 128) = acc[1][1][3][0]; *(f32x4*)(gh + 5 * 128 + 4) = acc[1][1][3][1]; } }
        asm volatile("s_waitcnt lgkmcnt(0)" ::: "memory"); __builtin_amdgcn_s_barrier(); __builtin_amdgcn_s_barrier(); asm volatile("" ::: "memory");
        const int colg = u.pn * 128 + wc * 32 + 8 * fq;
        const int row0 = u.pm * BM + wr * 64 + fr;
#pragma unroll
        for (int ai = 0; ai < 2; ++ai) {
            f16x4 keep[4];
#pragma unroll
            for (int n = 0; n < 2; ++n) {
                const f32x4 w0 = *(const f32x4*)(cw + colg + 4 * n), w1 = *(const f32x4*)(cw + FFH + colg + 4 * n), w2 = *(const f32x4*)(cw + 2 * FFH + colg + 4 * n), bb = *(const f32x4*)(cb + colg + 4 * n);
                const bool hasp = (wr == 1) || (ai == 1), hasn = (wr == 0) || (ai == 0);
                const LAS float* pp = HL + (((wr == 1 ? ai : 0) * 2 + (wr == 1 ? 0 : 1)) * 4 + wc) * 64 + 32 + 8 * fq + 4 * n;
                const LAS float* np = HL + (((wr == 0 ? ai : 1) * 2 + (wr == 0 ? 1 : 0)) * 4 + wc) * 64 + 8 * fq + 4 * n;
                const f32x4 hprev = hasp ? *(const LAS f32x4*)pp : (f32x4){0.f, 0.f, 0.f, 0.f}, hnext = hasn ? *(const LAS f32x4*)np : (f32x4){0.f, 0.f, 0.f, 0.f};
                f32x4 R[4], L[4];
#pragma unroll
                for (int m = 0; m < 4; ++m)
#pragma unroll
                    for (int j = 0; j < 4; ++j) { R[m][j] = dpp_ror<1>(acc[ai][0][m][n][j]); L[m][j] = dpp_ror<15>(acc[ai][0][m][n][j]); }
#pragma unroll
                for (int m = 0; m < 4; ++m) { const f32x4 pv = fr > 0 ? R[m] : (m > 0 ? R[m > 0 ? m - 1 : 0] : hprev); const f32x4 nv = fr < 15 ? L[m] : (m < 3 ? L[m < 3 ? m + 1 : 3] : hnext);
                    const f32x4 a = w0 * pv + w1 * acc[ai][0][m][n] + w2 * nv + bb;
                    f16x4 o;
#pragma unroll
                    for (int j = 0; j < 4; ++j) o[j] = (f16)(siluf_(a[j]) * acc[ai][1][m][n][j]);
                    o = lowtog4(o);
                    if (n == 0) keep[m] = o;
                    else { f16x8 w; w[0] = keep[m][0]; w[1] = keep[m][1]; w[2] = keep[m][2]; w[3] = keep[m][3]; w[4] = o[0]; w[5] = o[1]; w[6] = o[2]; w[7] = o[3];
                        *(f16x8*)(ACT + (size_t)(row0 + ai * HALF + m * 16) * FFH + colg) = w; } }
                asm volatile("" ::: "memory");
            }
        }
    }
};
struct EpiSlab {
    static constexpr bool PERM = false, HAS_MID = false; static constexpr int MID1 = 0, MID2 = 0; float* slab; const float* mod; int goff;
    __device__ __forceinline__ void operator()(AccRef acc, const Unit& u, int wr, int wc, int fr, int fq) const { fr = opq(fr); fq = opq(fq);
        const int pn = u.pn & 255, ks = u.pn >> 8;
        const int row0 = (u.pm - 64) * BM + wr * 64 + fr, col0 = pn * BM + wc * 32 + 4 * fq;
        const float* gp = mod + 2 * 12288 + goff + col0;
        f32x4 gv[2][2];
#pragma unroll
        for (int bj = 0; bj < 2; ++bj)
#pragma unroll
            for (int n = 0; n < 2; ++n) gv[bj][n] = *(const f32x4*)(gp + bj * HALF + n * 16);
        float* sp = slab + (size_t)ks * MC * D;
#pragma unroll
        for (int ai = 0; ai < 2; ++ai)
#pragma unroll
            for (int m = 0; m < 4; ++m) { float* rowp = sp + (size_t)(row0 + ai * HALF + m * 16) * D + col0;
#pragma unroll
                for (int bj = 0; bj < 2; ++bj)
#pragma unroll
                    for (int n = 0; n < 2; ++n) *(f32x4*)(rowp + bj * HALF + n * 16) = gv[bj][n] * acc[ai][bj][m][n]; }
    }
};
struct EpiResid {
    static constexpr bool PERM = false, HAS_MID = false; static constexpr int MID1 = 0, MID2 = 0; float* X; const float* mod; int goff; const float* Xs;
    __device__ __forceinline__ void operator()(AccRef acc, const Unit& u, int wr, int wc, int fr, int fq) const { fr = opq(fr); fq = opq(fq);
        const int row0 = u.pm * BM + wr * 64 + fr, col0 = u.pn * BM + wc * 32 + 4 * fq;
        const int bsel = u.pm < 32 ? 0 : (u.pm < 64 ? 1 : 2);
        const float* gp = mod + bsel * 12288 + goff + col0;
        f32x4 gv[2][2];
#pragma unroll
        for (int bj = 0; bj < 2; ++bj)
#pragma unroll
            for (int n = 0; n < 2; ++n) gv[bj][n] = *(const f32x4*)(gp + bj * HALF + n * 16);
#pragma unroll
        for (int ai = 0; ai < 2; ++ai) { f32x4 xv[4][2][2];
#pragma unroll
            for (int m = 0; m < 4; ++m) { const float* rowp = Xs + (size_t)(row0 + ai * HALF + m * 16) * D + col0;
#pragma unroll
                for (int bj = 0; bj < 2; ++bj)
#pragma unroll
                    for (int n = 0; n < 2; ++n) xv[m][bj][n] = *(const f32x4*)(rowp + bj * HALF + n * 16); }
            PIN8(xv[0][0][0], xv[0][0][1], xv[0][1][0], xv[0][1][1], xv[1][0][0], xv[1][0][1], xv[1][1][0], xv[1][1][1]); PIN8(xv[2][0][0], xv[2][0][1], xv[2][1][0], xv[2][1][1], xv[3][0][0], xv[3][0][1], xv[3][1][0], xv[3][1][1]);
#pragma unroll
            for (int m = 0; m < 4; ++m) { float* rowp = X + (size_t)(row0 + ai * HALF + m * 16) * D + col0;
#pragma unroll
                for (int bj = 0; bj < 2; ++bj)
#pragma unroll
                    for (int n = 0; n < 2; ++n) *(f32x4*)(rowp + bj * HALF + n * 16) = xv[m][bj][n] + gv[bj][n] * acc[ai][bj][m][n]; }
            asm volatile("" ::: "memory"); }
    }
};
}


__device__ __forceinline__ void ph_prologue(const Ctx& F, const ArgsV& AV) {
    const int gt = F.bid * 512 + F.tid, NT = F.G * 512;
    { const f32x4* cs = (const f32x4*)AV.in(I_CTX); f32x4* xr = (f32x4*)(F.ws + WS_XRES);
      for (int i = gt; i < MC * D / 4; i += NT) xr[MX * D / 4 + i] = cs[i]; }
    LAS float* sc = (LAS float*)F.lds;
    LAS float* red = (LAS float*)(F.lds + 3 * 2048 * 4);
    for (int i = F.tid; i < 3 * 2048; i += 512) { const int r = i / 2048, k = i % 2048; const float v = r < 2 ? AV.in(I_C)[r * 2048 + k] : AV.in(I_CCTX)[k]; sc[i] = siluf_(v); }
    __syncthreads();
    const int col = F.tid & 63, ks = F.tid >> 6;
    for (int chunk = F.bid; chunk < DEPTH * 192; chunk += F.G) {
        const int l = chunk / 192, n0 = (chunk % 192) * 64;
        const float* w = AV.in(I_WMOD) + (size_t)l * 2048 * 12288 + n0 + col;
        float s0 = 0.f, s1 = 0.f, s2 = 0.f;
#pragma unroll 8
        for (int k = ks * 256; k < ks * 256 + 256; ++k) { const float wv = w[(size_t)k * 12288]; s0 += sc[k] * wv; s1 += sc[2048 + k] * wv; s2 += sc[4096 + k] * wv; }
        red[(ks * 3 + 0) * 64 + col] = s0; red[(ks * 3 + 1) * 64 + col] = s1; red[(ks * 3 + 2) * 64 + col] = s2;
        __syncthreads();
        if (F.tid < 192) { const int r = F.tid >> 6, c2 = F.tid & 63; float s = 0.f;
#pragma unroll
            for (int q = 0; q < 8; ++q) s += red[(q * 3 + r) * 64 + c2];
            ((float*)(F.ws + WS_MOD))[((size_t)l * 3 + r) * 12288 + n0 + c2] = s + AV.in(I_BMOD)[(size_t)l * 12288 + n0 + c2]; }
        __syncthreads();
    }
}

__device__ __forceinline__ void conv_item(const float* W, int ldw, int k0, int srccol, f16* WT, int dstrow0, int ldk, LAS unsigned char* xl, int lane) {
    float v[64];
    const float* src = W + (size_t)k0 * ldw + (srccol >= 0 ? srccol : 0);
#pragma unroll
    for (int k = 0; k < 64; ++k) v[k] = src[(size_t)k * ldw];
#pragma unroll
    for (int k = 0; k < 64; k += 8) PIN8(v[k], v[k + 1], v[k + 2], v[k + 3], v[k + 4], v[k + 5], v[k + 6], v[k + 7]);
    const int sw = (lane >> 1) & 7;
#pragma unroll
    for (int kg = 0; kg < 8; ++kg) { f16x8 o;
#pragma unroll
        for (int e = 0; e < 8; ++e) o[e] = srccol >= 0 ? (f16)v[8 * kg + e] : (f16)0.f;
        o = pg8::lowtog8w(o);
        *(LAS f16x8*)(xl + lane * 128 + ((kg ^ sw) << 4)) = o; }
    __builtin_amdgcn_wave_barrier();
    f16* dst = WT + (size_t)dstrow0 * ldk + k0 + 8 * (lane & 7);
#pragma unroll
    for (int i = 0; i < 8; ++i) { const int r = 8 * i + (lane >> 3);
        const f16x8 o = *(LAS f16x8*)(xl + r * 128 + (((lane & 7) ^ ((r >> 1) & 7)) << 4));
        *(f16x8*)(dst + (size_t)r * ldk) = o; }
    __builtin_amdgcn_wave_barrier();
}
#ifndef CONV_KW
#define CONV_KW 8
#endif
__device__ __forceinline__ void conv_decode(int r, int NB, int& kb, int& nb) {
    if (CONV_KW == 1) { kb = r / NB; nb = r % NB; }
    else { constexpr int KW = CONV_KW, NW = 8 / KW; const int g = r >> 3, w = r & 7, gn = NB / NW, gnb = g % gn, gkb = g / gn; kb = gkb * KW + (w % KW); nb = gnb * NW + (w / KW); }
}
__device__ __forceinline__ void ph_convert_weights(const Ctx& F, const ArgsV& AV, int l) {
    const int skip = F.G > 64 ? 32 : 0;
    if (F.bid < skip) return;
    const int gw = (F.bid - skip) * 8 + F.wave, NGW = (F.G - skip) * 8, lane = F.lane;
    LAS unsigned char* xl = F.lds + F.wave * 8192;
    constexpr int I_IN = 32 * 180, I_GLU = 8 * 8, I_BR = 32 * 32, I_OUT = 32 * 32, I_UP = 32 * 176, I_DN = 88 * 32;
    constexpr int NIT = I_IN + I_GLU + I_BR + I_OUT + I_UP + I_DN;
    for (int it = gw; it < NIT; it += NGW) {
        int r = it;
        if (r < I_IN) { int kb, nb; conv_decode(r, 180, kb, nb); const int j = nb * 64 + lane;
            const int src = j < 2048 ? j : (j < 11264 ? j + 32 : (j < 11296 ? 2048 + (j - 11264) : -1));
            conv_item(AV.in(I_WIN) + (size_t)l * 2048 * INW, INW, kb * 64, src, (f16*)(F.ws + WS_WIN), nb * 64, 2048, xl, lane); continue; } r -= I_IN;
        if (r < I_GLU) { int kb, nb; conv_decode(r, 8, kb, nb); const int j = nb * 64 + lane; conv_item(AV.in(I_GLUW) + (size_t)l * 512 * 512, 512, kb * 64, j, (f16*)(F.ws + WS_WGLU), nb * 64, 512, xl, lane); continue; } r -= I_GLU;
        if (r < I_BR) { int kb, nb; conv_decode(r, 32, kb, nb); const int j = nb * 64 + lane; conv_item(AV.in(I_WBR) + (size_t)l * 2048 * 2048, 2048, kb * 64, j, (f16*)(F.ws + WS_WBR), nb * 64, 2048, xl, lane); continue; } r -= I_BR;
        if (r < I_OUT) { int kb, nb; conv_decode(r, 32, kb, nb); const int j = nb * 64 + lane; conv_item(AV.in(I_WOUT) + (size_t)l * 2048 * 2048, 2048, kb * 64, j, (f16*)(F.ws + WS_WOUT), nb * 64, 2048, xl, lane); continue; } r -= I_OUT;
        if (r < I_UP) { int kb, nb; conv_decode(r, 176, kb, nb); const int j = nb * 64 + lane, pn = j >> 8, i = j & 255; const int src = i < 128 ? 128 * pn + i : FFH + 128 * pn + (i - 128);
            conv_item(AV.in(I_WUP) + (size_t)l * 2048 * UPLD, UPLD, kb * 64, src, (f16*)(F.ws + WS_WUP), nb * 64, 2048, xl, lane); continue; } r -= I_UP;
        { int kb, nb; conv_decode(r, 32, kb, nb); const int j = nb * 64 + lane; conv_item(AV.in(I_WDN) + (size_t)l * FFH * 2048, 2048, kb * 64, j, (f16*)(F.ws + WS_WDN), nb * 64, FFH, xl, lane); }
    }
}

__device__ __forceinline__ void s5_mats_group(const Ctx& F, const ArgsV& AV, int l, int g) {
    LAS f32x2* APOW = (LAS f32x2*)F.lds;
    LAS f32x2* BBAR = APOW + 2 * 17 * 64;
    LAS f32x2* CM = BBAR + 2 * 64 * 16;
    LAS float* KLAG = (LAS float*)(CM + 2 * 16 * 64);
    __syncthreads();
    for (int i = F.tid; i < 2 * 17 * 64; i += 512) { const int d = i / (17 * 64), e = (i / 64) % 17, n = i % 64;
        const size_t pi = (((size_t)l * 2 + d) * 32 + g) * 64 + n;
        const float are = AV.in(I_S5ARE)[pi], aim = AV.in(I_S5AIM)[pi], dt = expf(AV.in(I_S5STEP)[((size_t)l * 2 + d) * 32 + g]);
        const float zr = are * dt * (float)e, zi = aim * dt * (float)e; float s, c; sincosf(zi, &s, &c); const float m = expf(zr);
        APOW[i] = (f32x2){m * c, m * s}; }
    __syncthreads();
    for (int i = F.tid; i < 2 * 64 * 16; i += 512) { const int d = i / 1024, n = (i / 16) % 64, h = i % 16;
        const size_t pi = (((size_t)l * 2 + d) * 32 + g) * 64 + n;
        const float are = AV.in(I_S5ARE)[pi], aim = AV.in(I_S5AIM)[pi];
        const f32x2 ab = APOW[(d * 17 + 1) * 64 + n]; const f32x2 num = (f32x2){ab.x - 1.0f, ab.y};
        const float den = are * are + aim * aim; const f32x2 q = (f32x2){(num.x * are + num.y * aim) / den, (num.y * are - num.x * aim) / den};
        const size_t bi = (pi * 16) + h;
        BBAR[i] = cmul(q, (f32x2){AV.in(I_S5BRE)[bi], AV.in(I_S5BIM)[bi]});
        const size_t ci = ((((size_t)l * 2 + d) * 32 + g) * 16 + h) * 64 + n;
        CM[(d * 16 + h) * 64 + n] = (f32x2){AV.in(I_S5CRE)[ci], AV.in(I_S5CIM)[ci]}; }
    __syncthreads();
    for (int i = F.tid; i < 2 * 16 * 256; i += 512) { const int d = i / 4096, lag = (i / 256) % 16, h = (i / 16) % 16, hp = i % 16; float s = 0.f;
        for (int n = 0; n < 64; ++n) { const f32x2 t = cmul(CM[(d * 16 + h) * 64 + n], APOW[(d * 17 + lag) * 64 + n]); const f32x2 b = BBAR[(d * 64 + n) * 16 + hp]; s += t.x * b.x - t.y * b.y; }
        KLAG[i] = s; }
    __syncthreads();
    f16* W = (f16*)(F.ws + WS_S5W) + (size_t)g * 256 * 512;
    for (int i = F.tid; i < 256 * 64; i += 512) { const int n = i / 64, k8 = (i % 64) * 8, t = n >> 4, h = n & 15; f16x8 o;
#pragma unroll
        for (int e = 0; e < 8; ++e) { const int k = k8 + e; float v;
            if (k < 256) { const int s = k >> 4, hp = k & 15; v = 0.f;
                if (t >= s) v += KLAG[((0 * 16 + (t - s)) * 16 + h) * 16 + hp];
                if (s >= t) v += KLAG[((1 * 16 + (s - t)) * 16 + h) * 16 + hp];
                v *= S5SCALE; }
            else { const int d = (k - 256) >> 7, nn2 = (k - 256) & 127, nn = nn2 & 63, im = nn2 >> 6, ex = d == 0 ? t + 1 : 16 - t;
                const f32x2 z = cmul(CM[(d * 16 + h) * 64 + nn], APOW[(d * 17 + ex) * 64 + nn]); v = im ? -z.y : z.x; }
            o[e] = (f16)v; }
        *(f16x8*)(W + (size_t)n * 512 + k8) = o; }
    f16* Mx = (f16*)(F.ws + WS_S5M) + (size_t)g * 256 * 256;
    for (int i = F.tid; i < 256 * 32; i += 512) { const int n = i / 32, k8 = (i % 32) * 8, d = n >> 7, ri = (n >> 6) & 1, nn = n & 63; f16x8 o;
#pragma unroll
        for (int e = 0; e < 8; ++e) { const int k = k8 + e, s = k >> 4, hp = k & 15, ex = d == 0 ? 15 - s : s;
            const f32x2 z = cmul(APOW[(d * 17 + ex) * 64 + nn], BBAR[(d * 64 + nn) * 16 + hp]); o[e] = (f16)((ri ? z.y : z.x) * S5SCALE); }
        *(f16x8*)(Mx + (size_t)n * 256 + k8) = o; }
    if (F.tid < 128) { const int d = F.tid >> 6, nn = F.tid & 63; ((f32x2*)(F.ws + WS_S5AT))[(d * 32 + g) * 64 + nn] = APOW[(d * 17 + 16) * 64 + nn]; }
    __syncthreads();
}

__device__ __forceinline__ float rlane(float v, int i) { return __builtin_bit_cast(float, __builtin_amdgcn_readlane(__builtin_bit_cast(int, v), i)); }
__device__ __forceinline__ void ph_hyena_h2(const Ctx& F, const ArgsV& AV, int l) {
    const int j = F.lane;
    float w1[33], w2[64];
    { const float* p1 = AV.in(I_HYW1) + (size_t)l * 33 * 64 + j; const float* p2 = AV.in(I_HYW2) + (size_t)l * 4096 + j;
#pragma unroll
      for (int i = 0; i < 33; ++i) w1[i] = p1[i * 64];
#pragma unroll
      for (int i = 0; i < 64; ++i) w2[i] = p2[i * 64]; }
    const float b1 = AV.in(I_HYB1)[l * 64 + j], f1 = AV.in(I_HYF1)[l * 64 + j], b2 = AV.in(I_HYB2)[l * 64 + j], f2 = AV.in(I_HYF2)[l * 64 + j];
    const int gw = F.bid * 8 + F.wave, NGW = F.G * 8;
    for (int p = gw; p < SEQ + LC; p += NGW) {
        const int n = p < SEQ ? SEQ : LC, pos = p < SEQ ? p : p - SEQ;
        float feat = 0.f;
        if (j == 0) feat = (float)pos / (float)(n - 1);
        else if (j < 33) { const int fi = (j - 1) & 15; const float fr = 1e-4f + (float)fi * ((15.0f - 1e-4f) / 15.0f);
            const float ang = (6.283185307179586f / (float)n) * (float)pos * fr; float s, c; sincosf(ang, &s, &c); feat = j < 17 ? c : -s; }
        float a = b1;
#pragma unroll
        for (int i = 0; i < 33; ++i) a += rlane(feat, i) * w1[i];
        const float h1 = sinf(f1 * a);
        float b = b2;
#pragma unroll
        for (int i = 0; i < 64; ++i) b += rlane(h1, i) * w2[i];
        ((f16*)(F.ws + WS_H2H))[((size_t)l * (SEQ + LC) + p) * 64 + j] = (f16)sinf(f2 * b);
    }
}

__device__ __forceinline__ void ph_norm(const Ctx& F, const ArgsV& AV, int l, int which, int nrows, int nslab) {
    const int gw = F.bid * 8 + F.wave, NGW = F.G * 8;
    float* X = (float*)(F.ws + WS_XRES); f16* O = (f16*)(F.ws + WS_HN); const float* SL = (const float*)(F.ws + WS_SLAB);
    const float* Xin = (l == 0 && which == 0) ? AV.in(I_X) : X;
    const float* gain = AV.in(which ? I_N2G : I_N1G) + (size_t)l * D;
    const float* mod = (const float*)(F.ws + WS_MOD) + (size_t)l * 3 * 12288;
    const int shoff = which ? 6144 : 0, soff = which ? 8192 : 2048;
    int cur_bsel = -1; f32x4 Am[8], Bm[8], vn[8];
    if (gw < nrows) { const f32x4* xr0 = (const f32x4*)((gw < MX ? Xin : X) + (size_t)gw * D) + F.lane;
#pragma unroll
        for (int j = 0; j < 8; ++j) vn[j] = xr0[64 * j]; }
    for (int m = gw; m < nrows; m += NGW) {
        const int bsel = m < SEQ ? 0 : (m < MX ? 1 : 2);
        f32x4* xr = (f32x4*)(X + (size_t)m * D) + F.lane;
        f32x4 v[8]; float s = 0.f;
        PIN8(vn[0], vn[1], vn[2], vn[3], vn[4], vn[5], vn[6], vn[7]);
#pragma unroll
        for (int j = 0; j < 8; ++j) v[j] = vn[j];
        if (m + NGW < nrows) { const f32x4* xq = (const f32x4*)((m + NGW < MX ? Xin : X) + (size_t)(m + NGW) * D) + F.lane;
#pragma unroll
            for (int j = 0; j < 8; ++j) vn[j] = xq[64 * j]; }
        if (bsel != cur_bsel) { cur_bsel = bsel; const float* mp = mod + bsel * 12288;
#pragma unroll
            for (int j = 0; j < 8; ++j) { const int c = 4 * F.lane + 256 * j; const f32x4 g = *(const f32x4*)(gain + c), sc = *(const f32x4*)(mp + soff + c); Bm[j] = *(const f32x4*)(mp + shoff + c); Am[j] = g * (sc + 1.0f); }
            PIN8(Am[0], Am[1], Am[2], Am[3], Am[4], Am[5], Am[6], Am[7]); PIN8(Bm[0], Bm[1], Bm[2], Bm[3], Bm[4], Bm[5], Bm[6], Bm[7]); }
        if (m >= MX && nslab > 0) {
            for (int sl = 0; sl < nslab; ++sl) { const f32x4* sr = (const f32x4*)(SL + ((size_t)sl * MC + (m - MX)) * D) + F.lane;
#pragma unroll
                for (int j = 0; j < 8; ++j) v[j] = v[j] + sr[64 * j]; }
#pragma unroll
            for (int j = 0; j < 8; ++j) xr[64 * j] = v[j]; }
#pragma unroll
        for (int j = 0; j < 8; ++j) s += (v[j].x * v[j].x + v[j].y * v[j].y) + (v[j].z * v[j].z + v[j].w * v[j].w);
        const float rstd = 1.0f / sqrtf(wave_sum(s) * (1.0f / D) + EPS);
#pragma unroll
        for (int j = 0; j < 8; ++j) { const int c = 4 * F.lane + 256 * j;
            f16x4 o;
#pragma unroll
            for (int e = 0; e < 4; ++e) o[e] = lowtog((f16)(v[j][e] * rstd * Am[j][e] + Bm[j][e]));
            *(f16x4*)(O + (size_t)m * D + c) = o; }
    }
}
__device__ __forceinline__ void ph_final_norm(const Ctx& F, const ArgsV& AV) {
    const int gw = F.bid * 8 + F.wave, NGW = F.G * 8;
    const float* X = (const float*)(F.ws + WS_XRES); const float* gain = AV.in(I_FNG);
    f32x4 gm[8], vn[8];
#pragma unroll
    for (int j = 0; j < 8; ++j) gm[j] = *(const f32x4*)(gain + 4 * F.lane + 256 * j);
    if (gw < MX) { const f32x4* xr0 = (const f32x4*)(X + (size_t)gw * D) + F.lane;
#pragma unroll
        for (int j = 0; j < 8; ++j) vn[j] = xr0[64 * j]; }
    for (int m = gw; m < MX; m += NGW) {
        f32x4 v[8]; float s = 0.f;
        PIN8(vn[0], vn[1], vn[2], vn[3], vn[4], vn[5], vn[6], vn[7]);
#pragma unroll
        for (int j = 0; j < 8; ++j) v[j] = vn[j];
        if (m + NGW < MX) { const f32x4* xq = (const f32x4*)(X + (size_t)(m + NGW) * D) + F.lane;
#pragma unroll
            for (int j = 0; j < 8; ++j) vn[j] = xq[64 * j]; }
#pragma unroll
        for (int j = 0; j < 8; ++j) s += (v[j].x * v[j].x + v[j].y * v[j].y) + (v[j].z * v[j].z + v[j].w * v[j].w);
        const float rstd = 1.0f / sqrtf(wave_sum(s) * (1.0f / D) + EPS);
#pragma unroll
        for (int j = 0; j < 8; ++j) { const int c = 4 * F.lane + 256 * j;
            *(f32x4*)(AV.out + (size_t)m * D + c) = v[j] * rstd * gm[j]; }
    }
}

__device__ __forceinline__ void ph_s5_scan(const Ctx& F) {
    if (F.tid >= 32) return;
    const float* S = (const float*)(F.ws + WS_S5S); f16* SA = (f16*)(F.ws + WS_S5A);
    for (int gt = F.bid * 32 + F.tid; gt < 2 * 2 * 32 * 64; gt += F.G * 32) {
        const int nn = gt & 63, g = (gt >> 6) & 31, d = (gt >> 11) & 1, b = gt >> 12;
        const f32x2 at = ((const f32x2*)(F.ws + WS_S5AT))[(d * 32 + g) * 64 + nn];
        f32x2 st = (f32x2){0.f, 0.f};
        f32x2 la[16], lb[16];
#define S5_CHUNK(step) ((d == 0) ? ((step) < 16 ? 1024 + b * 16 + (step) : b * 512 + ((step) - 16)) : ((step) < 16 ? 1024 + b * 16 + (15 - (step)) : b * 512 + (511 - ((step) - 16))))
#define S5_LOAD(dst, base) do { _Pragma("unroll") for (int u = 0; u < 16; ++u) { const int stp = (base) + u < 528 ? (base) + u : 527; const size_t so = ((size_t)S5_CHUNK(stp) * 32 + g) * 256 + d * 128 + nn; dst[u] = (f32x2){S[so], S[so + 64]}; } } while (0)
#define S5_STEP(src, base) do { PIN8(src[0], src[1], src[2], src[3], src[4], src[5], src[6], src[7]); PIN8(src[8], src[9], src[10], src[11], src[12], src[13], src[14], src[15]); \
            _Pragma("unroll") for (int u = 0; u < 16; ++u) { f16* xp = SA + (size_t)S5_CHUNK((base) + u) * 16384 + (size_t)g * 512 + 256 + d * 128 + nn; xp[0] = (f16)st.x; xp[64] = (f16)st.y; st = cmul(at, st) + src[u]; } } while (0)
        S5_LOAD(la, 0);
        for (int base = 0; base < 528; base += 32) {
            S5_LOAD(lb, base + 16);
            S5_STEP(la, base);
            if (base + 16 < 528) { S5_LOAD(la, base + 32); S5_STEP(lb, base + 16); }
        }
#undef S5_CHUNK
#undef S5_LOAD
#undef S5_STEP
    }
}

__device__ __forceinline__ void ph_ffn_fix(const Ctx& F, const ArgsV& AV, int l, int nMr) {
    const float* HALO = (const float*)(F.ws + WS_HALO); f16* ACT = (f16*)(F.ws + WS_ACT);
    const float* cw = AV.in(I_FFCW) + (size_t)l * 3 * FFH; const float* cb = AV.in(I_FFCB) + (size_t)l * FFH;
    const int NT = nMr * 44 * 2 * 128;
    for (int task = F.bid * 512 + F.tid; task < NT; task += F.G * 512) {
        const int c = task & 127, which = (task >> 7) & 1, tile = task >> 8, pn = tile % 44, pm = tile / 44;
        const float* h = HALO + ((size_t)pm * 44 + pn) * 768 + c; const int col = pn * 128 + c;
        const bool first = (pm == 0 || pm == 32 || pm >= 64), last = (pm == 31 || pm >= 63);
        float ap, ac, an, b;
        if (which == 0) { ap = first ? 0.f : HALO[((size_t)(pm - 1) * 44 + pn) * 768 + 3 * 128 + c]; ac = h[0]; an = h[128]; b = h[4 * 128]; }
        else { ap = h[2 * 128]; ac = h[3 * 128]; an = last ? 0.f : HALO[((size_t)(pm + 1) * 44 + pn) * 768 + c]; b = h[5 * 128]; }
        const float a = cw[col] * ap + cw[FFH + col] * ac + cw[2 * FFH + col] * an + cb[col];
        ACT[(size_t)(pm * 256 + (which ? 255 : 0)) * FFH + col] = (f16)(siluf_(a) * b);
    }
}

namespace gla {
constexpr int QK_LD = 136, KH_LD = 72, VT_LD = 72, P_LD = 72;
constexpr int OFF_QT = 0;
constexpr int OFF_KT = 17408;
constexpr int OFF_VT = OFF_KT + 18432;
constexpr int OFF_P = OFF_VT + 36864;
constexpr int OFF_LR = OFF_P + 9216;
constexpr int OFF_GT = OFF_LR + 4096;
constexpr int OFF_DEC = OFF_GT + 2048;
constexpr int OFF_RS = OFF_DEC + 512;
constexpr int OFF_QR = OFF_RS + 2048;
constexpr int OFF_KR = OFF_QR + 17408;
constexpr int OFF_WG = OFF_KR + 17408;
static_assert(OFF_WG + 8192 <= LDSCTL_OFF, "gla lds");

__device__ __forceinline__ int grow(int b, int sc, int j, int i) {
    if (sc < 32) { const int col = 2 * sc + (j >> 1), r = (j & 1) * 64 + i; return b * SEQ + r * 64 + col; }
    return MX + b * LC + j * 64 + i;
}
__device__ __forceinline__ int prow(int b, int sc, int j, int i) {
    return sc < 32 ? b * SEQ + sc * 256 + j * 64 + i : MX + b * LC + j * 64 + i;
}
#define GLA_MFMA(a, b, c) __builtin_amdgcn_mfma_f32_16x16x32_f16(a, b, c, 0, 0, 0)

template <bool FULL>
__device__ __forceinline__ void gla_unit(const Ctx& F, const ArgsV& AV, int l, int unit, int d0 = 0, int d1 = 2) {
    const int b = unit / (4 * NSC), h = (unit / NSC) % 4, sc = unit % NSC;
    LAS f16* QT = (LAS f16*)(F.lds + OFF_QT); LAS f16* KT = (LAS f16*)(F.lds + OFF_KT); LAS f16* VT = (LAS f16*)(F.lds + OFF_VT);
    LAS f16* PP = (LAS f16*)(F.lds + OFF_P); LAS f16* LR = (LAS f16*)(F.lds + OFF_LR);
    LAS float* GT = (LAS float*)(F.lds + OFF_GT); LAS float* DEC = (LAS float*)(F.lds + OFF_DEC); LAS float* RS = (LAS float*)(F.lds + OFF_RS);
    LAS f16* QR = (LAS f16*)(F.lds + OFF_QR); LAS f16* KR = (LAS f16*)(F.lds + OFF_KR); LAS float* WG = (LAS float*)(F.lds + OFF_WG);
    const int tid = F.tid, lane = F.lane, w = F.wave, q0 = lane >> 4, c0 = lane & 15;
    const int dk0 = tid & 127, ig0 = tid >> 7;
    const f16* PX = (const f16*)(F.ws + WS_PX);
    const float scale = 0.08838834764831845f;
    for (int dir = d0; dir < d1; ++dir) {
        __syncthreads();
        for (int i = tid; i < 16 * 128; i += 512) WG[i] = AV.in(I_GLAWG)[(((size_t)l * 2 + dir) * 16 + (i >> 7)) * 512 + h * 128 + (i & 127)];
        const float bgv = AV.in(I_GLABG)[((size_t)l * 2 + dir) * 512 + h * 128 + dk0];
        float wgr[16];
#pragma unroll
        for (int r = 0; r < 16; ++r) wgr[r] = AV.in(I_GLAWG)[(((size_t)l * 2 + dir) * 16 + r) * 512 + h * 128 + dk0];
        const size_t sidx = ((((size_t)b * 4 + h) * NSC + sc) * 2 + dir);
        f32x4 accS[8][2];
        if (FULL && sc < 32) { const float* Sin = (const float*)(F.ws + WS_GSIN) + sidx * 32768; const int q = opq(q0), c = opq(c0);
#pragma unroll
            for (int dt = 0; dt < 8; ++dt)
#pragma unroll
                for (int et = 0; et < 2; ++et)
#pragma unroll
                    for (int r = 0; r < 4; ++r) accS[dt][et][r] = Sin[(16 * dt + 4 * q + r) * 256 + 32 * w + 16 * et + c];
            PIN8(accS[0][0], accS[0][1], accS[1][0], accS[1][1], accS[2][0], accS[2][1], accS[3][0], accS[3][1]); PIN8(accS[4][0], accS[4][1], accS[5][0], accS[5][1], accS[6][0], accS[6][1], accS[7][0], accS[7][1]); }
        else {
#pragma unroll
            for (int dt = 0; dt < 8; ++dt)
#pragma unroll
                for (int et = 0; et < 2; ++et) accS[dt][et] = (f32x4){0.f, 0.f, 0.f, 0.f}; }
        float sumtot = 0.f;
#define GLA_FETCH(jn) f16x8 pf_lr, pf_v[4], pf_k[2], pf_q[2]; do { const int tf = opq(F.tid); \
            { const int row = (tf & 255) >> 2, part = tf & 3; pf_lr = *(const f16x8*)(PX + (size_t)prow(b, sc, (jn), row) * PXLD + P_GG + part * 8); } \
            _Pragma("unroll") for (int k = 0; k < 4; ++k) { const int idx = tf + 512 * k, wi = idx >> 6, ln = idx & 63, rr = ln >> 2, cc = ln & 3; const int row = (wi & 3) * 16 + rr, chunk = (wi >> 2) * 4 + cc; \
                pf_v[k] = *(const f16x8*)(PX + (size_t)prow(b, sc, (jn), row) * PXLD + P_GV + h * 256 + chunk * 8); } \
            _Pragma("unroll") for (int k = 0; k < 2; ++k) { const int idx = tf + 512 * k, row = idx >> 4, ch = idx & 15; const size_t ro = (size_t)prow(b, sc, (jn), row) * PXLD; \
                pf_k[k] = *(const f16x8*)(PX + ro + P_GK + h * 128 + ch * 8); if (FULL) pf_q[k] = *(const f16x8*)(PX + ro + P_GQ + h * 128 + ch * 8); else pf_q[k] = pf_k[k]; } } while (0)
        for (int jj = 0; jj < 4; ++jj) {
            const int j = dir ? 3 - jj : jj;
            {
            GLA_FETCH(j);
            __syncthreads();
            const int tid = opq(F.tid);
            PIN8(pf_lr, pf_v[0], pf_v[1], pf_v[2], pf_v[3], pf_k[0], pf_k[1], pf_q[0]); asm volatile("" : "+v"(pf_q[1]));
            if (tid < 256) { const int row = tid >> 2, part = tid & 3; *(LAS f16x8*)(LR + row * 32 + part * 8) = pf_lr; }
#pragma unroll
            for (int k = 0; k < 4; ++k) { const int idx = opq(tid) + 512 * k, wi = idx >> 6, ln = idx & 63, rr = ln >> 2, cc = ln & 3;
                const int row = (wi & 3) * 16 + rr, chunk = (wi >> 2) * 4 + cc; LAS f16* vp = VT + (chunk * 8) * VT_LD + row;
#pragma unroll
                for (int e = 0; e < 8; ++e) vp[e * VT_LD] = pf_v[k][e]; }
#pragma unroll
            for (int k = 0; k < 2; ++k) { const int idx = tid + 512 * k, row = idx >> 4, ch = idx & 15;
                *(LAS f16x8*)(KR + row * QK_LD + ch * 8) = pf_k[k];
                if (FULL) *(LAS f16x8*)(QR + row * QK_LD + ch * 8) = pf_q[k]; }
            }
            __syncthreads();
            const int dk = opq(dk0), ig = opq(ig0);
            float bv[16];
#pragma unroll
            for (int ii = 0; ii < 16; ++ii) { const int i = ig * 16 + ii; float pre = bgv;
                const f16x8 l0 = *(const LAS f16x8*)(LR + i * 32 + dir * 16), l1 = *(const LAS f16x8*)(LR + i * 32 + dir * 16 + 8);
#pragma unroll
                for (int r = 0; r < 8; ++r) pre += (float)l0[r] * wgr[r] + (float)l1[r] * wgr[8 + r];
                bv[ii] = logsigmoidf_(pre) * (1.0f / 16.0f); }
            float totloc;
            if (dir == 0) {
#pragma unroll
                for (int ii = 1; ii < 16; ++ii) bv[ii] += bv[ii - 1];
                totloc = bv[15]; }
            else {
#pragma unroll
                for (int ii = 14; ii >= 0; --ii) bv[ii] += bv[ii + 1];
                totloc = bv[0]; }
            GT[ig * 128 + dk] = totloc;
            __syncthreads();
            const float g0 = GT[dk], g1 = GT[128 + dk], g2 = GT[256 + dk], g3 = GT[384 + dk];
            const float total = (g0 + g1) + (g2 + g3);
            float off, bmid;
            if (dir == 0) { off = (ig > 0 ? g0 : 0.f) + (ig > 1 ? g1 : 0.f) + (ig > 2 ? g2 : 0.f); bmid = g0 + g1; }
            else { off = (ig < 3 ? g3 : 0.f) + (ig < 2 ? g2 : 0.f) + (ig < 1 ? g1 : 0.f); bmid = g2 + g3; }
#pragma unroll
            for (int ii = 0; ii < 16; ++ii) bv[ii] += off;
            if (FULL) {
#pragma unroll
                for (int ii = 0; ii < 16; ++ii) { const int i = ig * 16 + ii;
                    QT[i * QK_LD + dk] = (f16)((float)QR[i * QK_LD + dk] * scale * __expf(fminf(bv[ii] - bmid, 9.f)));
                    KT[i * QK_LD + dk] = (f16)((float)KR[i * QK_LD + dk] * __expf(fminf(bmid - bv[ii], 9.f))); }
                __syncthreads();
                { const int c = opq(c0), q = opq(q0);
#pragma unroll
                for (int s = 0; s < 2; ++s) { const int T = 2 * w + s, it = T >> 2, jt = T & 3; f32x4 a = (f32x4){0.f, 0.f, 0.f, 0.f};
#pragma unroll
                    for (int kk = 0; kk < 4; ++kk) { const f16x8 kf = *(const LAS f16x8*)(KT + (jt * 16 + c) * QK_LD + kk * 32 + 8 * q);
                        const f16x8 qf = *(const LAS f16x8*)(QT + (it * 16 + c) * QK_LD + kk * 32 + 8 * q); a = GLA_MFMA(kf, qf, a); }
                    const int i = it * 16 + c; f16x4 pv;
#pragma unroll
                    for (int r = 0; r < 4; ++r) { const int jx = jt * 16 + 4 * q + r; const bool keep = dir == 0 ? (jx <= i) : (jx >= i); pv[r] = keep ? (f16)a[r] : (f16)0.f; }
                    *(LAS f16x4*)(PP + i * P_LD + jt * 16 + 4 * q) = pv; } }
                __syncthreads();
#pragma unroll
                for (int ii = 0; ii < 16; ++ii) { const int i = ig * 16 + ii; QT[i * QK_LD + dk] = (f16)((float)QR[i * QK_LD + dk] * scale * __expf(bv[ii])); }
            }
            { f16x8 k0, k1;
#pragma unroll
              for (int ii = 0; ii < 8; ++ii) { k0[ii] = (f16)((float)KR[(ig * 16 + ii) * QK_LD + dk] * __expf(total - bv[ii])); k1[ii] = (f16)((float)KR[(ig * 16 + 8 + ii) * QK_LD + dk] * __expf(total - bv[8 + ii])); }
              *(LAS f16x8*)(KT + dk * KH_LD + ig * 16) = k0; *(LAS f16x8*)(KT + dk * KH_LD + ig * 16 + 8) = k1; }
            if (ig == 0) { DEC[dk] = __expf(total); sumtot += total; }
            __syncthreads();
            const int c = opq(c0), q = opq(q0);
            if (FULL) {
                f32x4 accO[4][2];
#pragma unroll
                for (int it = 0; it < 4; ++it)
#pragma unroll
                    for (int et = 0; et < 2; ++et) accO[it][et] = (f32x4){0.f, 0.f, 0.f, 0.f};
#pragma unroll
                for (int et = 0; et < 2; ++et)
#pragma unroll
                    for (int kk = 0; kk < 2; ++kk) { const f16x8 vf = *(const LAS f16x8*)(VT + (32 * w + 16 * et + c) * VT_LD + kk * 32 + 8 * q);
#pragma unroll
                        for (int it = 0; it < 4; ++it) { const f16x8 pf = *(const LAS f16x8*)(PP + (it * 16 + c) * P_LD + kk * 32 + 8 * q); accO[it][et] = GLA_MFMA(vf, pf, accO[it][et]); } asm volatile("" ::: "memory"); }
#pragma unroll
                for (int kb = 0; kb < 4; ++kb)
#pragma unroll
                    for (int et = 0; et < 2; ++et) { f16x8 sf; asm volatile("" ::: "memory");
#pragma unroll
                        for (int e = 0; e < 4; ++e) { sf[e] = (f16)accS[2 * kb][et][e]; sf[4 + e] = (f16)accS[2 * kb + 1][et][e]; }
#pragma unroll
                        for (int it = 0; it < 4; ++it) { const f16x4 lo = *(const LAS f16x4*)(QT + (it * 16 + c) * QK_LD + 32 * kb + 4 * q), hi = *(const LAS f16x4*)(QT + (it * 16 + c) * QK_LD + 32 * kb + 16 + 4 * q);
                            f16x8 qf; qf[0] = lo[0]; qf[1] = lo[1]; qf[2] = lo[2]; qf[3] = lo[3]; qf[4] = hi[0]; qf[5] = hi[1]; qf[6] = hi[2]; qf[7] = hi[3];
                            accO[it][et] = GLA_MFMA(sf, qf, accO[it][et]); } }
                float* OF = (float*)(F.ws + WS_GOF);
                if (dir == 0) {
#pragma unroll
                    for (int it = 0; it < 4; ++it) { const int gr = prow(b, sc, j, it * 16 + c);
#pragma unroll
                        for (int et = 0; et < 2; ++et) *(f32x4*)(OF + (size_t)gr * 1024 + h * 256 + 32 * w + 16 * et + 4 * q) = accO[it][et];
                        asm volatile("" ::: "memory"); } }
                else {
                    int grs[4]; f32x4 ofv[4][2]; f16x4 rvv[4][2];
#pragma unroll
                    for (int it = 0; it < 4; ++it) { grs[it] = prow(b, sc, j, it * 16 + c);
#pragma unroll
                        for (int et = 0; et < 2; ++et) { ofv[it][et] = *(const f32x4*)(OF + (size_t)grs[it] * 1024 + h * 256 + 32 * w + 16 * et + 4 * q);
                            rvv[it][et] = *(const f16x4*)(PX + (size_t)grs[it] * PXLD + P_GR + h * 256 + 32 * w + 16 * et + 4 * q); } }
                    PIN8(ofv[0][0], ofv[0][1], ofv[1][0], ofv[1][1], ofv[2][0], ofv[2][1], ofv[3][0], ofv[3][1]);
#pragma unroll
                    for (int it = 0; it < 4; ++it) { float ss = 0.f;
#pragma unroll
                        for (int et = 0; et < 2; ++et) { accO[it][et] = accO[it][et] + ofv[it][et];
                            ss += (accO[it][et][0] * accO[it][et][0] + accO[it][et][1] * accO[it][et][1]) + (accO[it][et][2] * accO[it][et][2] + accO[it][et][3] * accO[it][et][3]); }
                        ss += __shfl_xor(ss, 16); ss += __shfl_xor(ss, 32);
                        if (q == 0) RS[(it * 16 + c) * 8 + w] = ss; }
                    __syncthreads();
                    PIN8(rvv[0][0], rvv[0][1], rvv[1][0], rvv[1][1], rvv[2][0], rvv[2][1], rvv[3][0], rvv[3][1]);
                    const float* ng = AV.in(I_GLANG) + (size_t)l * 256;
                    f16* Y = (f16*)(F.ws + WS_YCAT);
#pragma unroll
                    for (int it = 0; it < 4; ++it) { const int i = it * 16 + c; const f32x4 ra = *(const LAS f32x4*)(RS + i * 8), rb = *(const LAS f32x4*)(RS + i * 8 + 4);
                        const float tot = ((ra[0] + ra[1]) + (ra[2] + ra[3])) + ((rb[0] + rb[1]) + (rb[2] + rb[3]));
                        const float rstd = 1.0f / sqrtf(tot * (1.0f / 256.0f) + EPS);
#pragma unroll
                        for (int et = 0; et < 2; ++et) { const int e0 = 32 * w + 16 * et + 4 * q;
                            const f32x4 gv = *(const f32x4*)(ng + e0);
                            f16x4 o;
#pragma unroll
                            for (int r = 0; r < 4; ++r) o[r] = lowtog((f16)(accO[it][et][r] * rstd * gv[r] * siluf_((float)rvv[it][et][r])));
                            *(f16x4*)(Y + (size_t)grow(b, sc, j, it * 16 + c) * 2048 + 1024 + h * 256 + e0) = o; } }
                }
            }
#pragma unroll
            for (int dt = 0; dt < 8; ++dt) { const f32x4 dv = *(const LAS f32x4*)(DEC + 16 * dt + 4 * q);
#pragma unroll
                for (int et = 0; et < 2; ++et) accS[dt][et] = accS[dt][et] * dv; }
#pragma unroll
            for (int kk = 0; kk < 2; ++kk) { f16x8 vf[2];
#pragma unroll
                for (int et = 0; et < 2; ++et) vf[et] = *(const LAS f16x8*)(VT + (32 * w + 16 * et + c) * VT_LD + kk * 32 + 8 * q);
#pragma unroll
                for (int dt = 0; dt < 8; ++dt) { const f16x8 kf = *(const LAS f16x8*)(KT + (16 * dt + c) * KH_LD + kk * 32 + 8 * q);
#pragma unroll
                    for (int et = 0; et < 2; ++et) accS[dt][et] = GLA_MFMA(kf, vf[et], accS[dt][et]); if (dt & 1) asm volatile("" ::: "memory"); } }
        }
        if (!FULL) { float* Sl = (float*)(F.ws + WS_GSLOC) + sidx * 32768; const int q = opq(q0), c = opq(c0);
#pragma unroll
            for (int dt = 0; dt < 8; ++dt)
#pragma unroll
                for (int et = 0; et < 2; ++et)
#pragma unroll
                    for (int r = 0; r < 4; ++r) Sl[(16 * dt + 4 * q + r) * 256 + 32 * w + 16 * et + c] = accS[dt][et][r];
            if (ig0 == 0) ((float*)(F.ws + WS_GDT))[sidx * 128 + dk0] = __expf(sumtot); }
        VM_WAIT();
    }
}
__device__ __forceinline__ void ph_gla_scan(const Ctx& F) {
    const float* Sl = (const float*)(F.ws + WS_GSLOC); float* Si = (float*)(F.ws + WS_GSIN); const float* Dt = (const float*)(F.ws + WS_GDT);
    if (F.tid < 64) return;
    for (int gt = F.bid * 448 + (F.tid - 64); gt < 2 * 4 * 2 * 32768; gt += F.G * 448) {
        const int e = gt & 32767, dir = (gt >> 15) & 1, h = (gt >> 16) & 3, b = gt >> 18;
        float S = 0.f;
        for (int base = 0; base < NSC; base += 11) {
            float sl[11], dt[11]; size_t ix[11];
#pragma unroll
            for (int u = 0; u < 11; ++u) { const int step = base + u; const int sc = step == 0 ? 32 : (dir == 0 ? step - 1 : 32 - step);
                const size_t idx = ((((size_t)b * 4 + h) * NSC + sc) * 2 + dir); ix[u] = idx;
                sl[u] = Sl[idx * 32768 + e]; dt[u] = Dt[idx * 128 + (e >> 8)]; }
            PIN8(sl[0], sl[1], sl[2], sl[3], sl[4], sl[5], sl[6], sl[7]); PIN8(dt[0], dt[1], dt[2], dt[3], dt[4], dt[5], dt[6], dt[7]); PIN4(sl[8], sl[9], sl[10], dt[8]); asm volatile("" : "+v"(dt[9]), "+v"(dt[10]));
#pragma unroll
            for (int u = 0; u < 11; ++u) { Si[ix[u] * 32768 + e] = S; S = dt[u] * S + sl[u]; }
        }
    }
}
#undef GLA_FETCH
#undef GLA_MFMA
}

namespace hy {
#define PADI(i) ((i) + ((i) >> 5))
constexpr int HY_BUF_BYTES = (16384 + 512) * 8;
constexpr int HY_SCR_OFF = HY_BUF_BYTES;
static_assert(HY_SCR_OFF + 2048 <= LDSCTL_OFF, "hyena lds");
__device__ __forceinline__ f32x2 twid(int k, float invN) { const float xr = (float)k * invN; return (f32x2){__builtin_amdgcn_cosf(xr), -__builtin_amdgcn_sinf(xr)}; }
__device__ __forceinline__ f32x2 mul_w16(f32x2 d, int a) {
    constexpr float c1 = 0.9238795325112867f, s1 = 0.3826834323650898f, r = 0.7071067811865476f;
    float c, s;
    switch (a & 15) {
        case 0: return d; case 4: return (f32x2){d.y, -d.x}; case 8: return (f32x2){-d.x, -d.y}; case 12: return (f32x2){-d.y, d.x};
        case 1: c = c1; s = s1; break; case 2: c = r; s = r; break; case 3: c = s1; s = c1; break;
        case 5: c = -s1; s = c1; break; case 6: c = -r; s = r; break; case 7: c = -c1; s = s1; break;
        case 9: c = -c1; s = -s1; break; case 10: c = -r; s = -r; break; case 11: c = -s1; s = -c1; break;
        case 13: c = s1; s = -c1; break; case 14: c = r; s = -r; break; default: c = c1; s = -s1; break; }
    return (f32x2){d.x * c + d.y * s, d.y * c - d.x * s};
}
template <int R> __device__ __forceinline__ void dif_pass(LAS f32x2* x, int m, int lh, int tid) {
    const int N = 1 << m; const float invN = 1.0f / (float)N; const int lg = lh - R + 1, g = 1 << lg, S = (N >> 1) >> lh;
    for (int q = tid; q < (N >> R); q += 512) { const int j = q & (g - 1), blk = q >> lg, base = (blk << (lh + 1)) + j;
        f32x2 v[1 << R];
#pragma unroll
        for (int k = 0; k < (1 << R); ++k) v[k] = x[PADI(base + k * g)];
        f32x2 w = twid(j * S, invN);
#pragma unroll
        for (int s = 0; s < R; ++s) { const int half = 1 << (R - 1 - s);
#pragma unroll
            for (int k = 0; k < (1 << R); ++k) if (!(k & half)) { const f32x2 a = v[k], b = v[k + half]; v[k] = a + b;
                v[k + half] = mul_w16(cmul(a - b, w), ((k & (half - 1)) << s) * (16 >> R)); }
            w = cmul(w, w); }
#pragma unroll
        for (int k = 0; k < (1 << R); ++k) x[PADI(base + k * g)] = v[k]; }
    __syncthreads();
}
template <int R> __device__ __forceinline__ void dit_pass(LAS f32x2* x, int m, int lh, int tid) {
    const int N = 1 << m; const float invN = 1.0f / (float)N; const int h = 1 << lh, S1 = (N >> 1) >> lh;
    for (int q = tid; q < (N >> R); q += 512) { const int j = q & (h - 1), blk = q >> lh, base = (blk << (lh + R)) + j;
        f32x2 v[1 << R];
#pragma unroll
        for (int k = 0; k < (1 << R); ++k) v[k] = x[PADI(base + k * h)];
        f32x2 wp[R]; wp[R - 1] = cconj(twid(j * (S1 >> (R - 1)), invN));
#pragma unroll
        for (int s = R - 2; s >= 0; --s) wp[s] = cmul(wp[s + 1], wp[s + 1]);
#pragma unroll
        for (int s = 0; s < R; ++s) { const int half = 1 << s;
#pragma unroll
            for (int k = 0; k < (1 << R); ++k) if (!(k & half)) { const f32x2 a = v[k];
                const f32x2 b = mul_w16(cmul(v[k + half], wp[s]), (16 - (k & (half - 1)) * (16 >> (s + 1))) & 15);
                v[k] = a + b; v[k + half] = a - b; } }
#pragma unroll
        for (int k = 0; k < (1 << R); ++k) x[PADI(base + k * h)] = v[k]; }
    __syncthreads();
}
__device__ __forceinline__ void fft_fwd(LAS f32x2* x, int m, int tid) {
    int lh = m - 1;
    while (lh + 1 >= 4) { dif_pass<4>(x, m, lh, tid); lh -= 4; }
    if (lh + 1 == 2) dif_pass<2>(x, m, 1, tid); else if (lh + 1 == 1) dif_pass<1>(x, m, 0, tid);
}
__device__ __forceinline__ void fft_inv(LAS f32x2* x, int m, int tid) {
    int lh = 0;
    while (m - lh >= 4) { dit_pass<4>(x, m, lh, tid); lh += 4; }
    if (m - lh == 2) dit_pass<2>(x, m, lh, tid); else if (m - lh == 1) dit_pass<1>(x, m, lh, tid);
}
__device__ __forceinline__ int brev(int k, int m) { return (int)(__brev((unsigned)k) >> (32 - m)); }

__device__ __forceinline__ void filt_unit(const Ctx& F, const ArgsV& AV, int l, int unit) {
    const int kind = unit >> 9, o = (unit >> 8) & 1, pair = unit & 255;
    const int n = kind ? LC : SEQ, m = kind ? 9 : 14, N = 2 * n, tid = F.tid;
    LAS f32x2* buf = (LAS f32x2*)F.lds;
    LAS float* W3 = (LAS float*)(F.lds + HY_SCR_OFF);
    LAS float* B3 = W3 + 256;
    LAS float* RED = B3 + 4;
    LAS float* INV = RED + 16;
    __syncthreads();
    if (tid < 4) { const int ci = tid; const int col = o * 1024 + (ci >> 1) * 512 + 2 * pair + (ci & 1); B3[ci] = AV.in(I_HYB3)[(size_t)l * 2048 + col]; }
    __syncthreads();
    const int lane = F.lane, q = lane >> 4, c = lane & 15;
    f16x8 wB0, wB1;
    { const int col = o * 1024 + ((c & 3) >> 1) * 512 + 2 * pair + (c & 1); const float* w3 = AV.in(I_HYW3) + (size_t)l * 64 * 2048 + col;
#pragma unroll
      for (int j = 0; j < 8; ++j) { wB0[j] = c < 4 ? (f16)w3[(size_t)(8 * q + j) * 2048] : (f16)0.f; wB1[j] = c < 4 ? (f16)w3[(size_t)(32 + 8 * q + j) * 2048] : (f16)0.f; } }
    const f16* H2H = (const f16*)(F.ws + WS_H2H) + ((size_t)l * (SEQ + LC) + (kind ? SEQ : 0)) * 64;
    const float lo = -3.0701134573253945f, hi = -15.350567286626973f;
    const float ra = fabsf(lo + (hi - lo) * (float)(2 * pair) / 511.0f), rb = fabsf(lo + (hi - lo) * (float)(2 * pair + 1) / 511.0f);
    const float rate = (c & 1) ? rb : ra, bias3 = B3[c & 3];
    float sabs = 0.f;
    const float rsc = -rate / (float)(n - 1);
    float elane[4];
#pragma unroll
    for (int i = 0; i < 4; ++i) elane[i] = __expf(rsc * (float)(4 * q + i));
    const int ntile = n >> 4;
    for (int base = F.wave; base < ntile; base += 64) {
        f16x8 a0[8], a1[8];
#pragma unroll
        for (int b8 = 0; b8 < 8; ++b8) { const int tile = base + 8 * b8, tl = tile < ntile ? tile : base; const f16* hp = H2H + (size_t)(tl * 16 + c) * 64 + 8 * q;
            a0[b8] = *(const f16x8*)hp; a1[b8] = *(const f16x8*)(hp + 32); }
        PIN8(a0[0], a0[1], a0[2], a0[3], a0[4], a0[5], a0[6], a0[7]); PIN8(a1[0], a1[1], a1[2], a1[3], a1[4], a1[5], a1[6], a1[7]);
#pragma unroll
        for (int b8 = 0; b8 < 8; ++b8) { const int tile = base + 8 * b8; if (tile < ntile) { const int t0 = tile * 16;
            f32x4 acc = (f32x4){0.f, 0.f, 0.f, 0.f};
            acc = __builtin_amdgcn_mfma_f32_16x16x32_f16(a0[b8], wB0, acc, 0, 0, 0); acc = __builtin_amdgcn_mfma_f32_16x16x32_f16(a1[b8], wB1, acc, 0, 0, 0);
            if (c < 4) {
                const float et = __expf(rsc * (float)t0);
#pragma unroll
                for (int i = 0; i < 4; ++i) { const int t = t0 + 4 * q + i; const float v = (acc[i] + bias3) * (et * elane[i]);
                    LAS float* bp = (LAS float*)buf;
                    if (c < 2) { bp[2 * PADI(t) + c] = v; sabs += fabsf(v); }
                    else if (t >= 1) { bp[2 * PADI(N - t) + (c - 2)] = v; sabs += fabsf(v); } } } } }
    }
    float sa = (c == 0 || c == 2) ? sabs : 0.f, sb = (c == 1 || c == 3) ? sabs : 0.f;
    if (tid == 0) { float z0 = 0.f; asm volatile("" : "+v"(z0)); buf[PADI(n)] = (f32x2){z0, z0}; }
    sa = wave_sum(sa); sb = wave_sum(sb);
    if (F.lane == 0) { RED[F.wave * 2] = sa; RED[F.wave * 2 + 1] = sb; }
    __syncthreads();
    if (tid < 2) { float s = 0.f;
#pragma unroll
        for (int w = 0; w < 8; ++w) s += RED[w * 2 + tid];
        INV[tid] = 1.0f / (s + EPS); }
    __syncthreads();
    { const float ia = INV[0], ib = INV[1];
      for (int i = tid; i < N; i += 512) { f32x2 v = buf[PADI(i)]; v.x *= ia; v.y *= ib; buf[PADI(i)] = v; } }
    __syncthreads();
    fft_fwd(buf, m, tid);
    f32x4* out = (f32x4*)(F.ws + ((l & 1) ? WS_FSD2 : WS_FSD) + (kind ? FSD_C_OFF : 0)) + (size_t)(o * 256 + pair) * (n + 1);
    for (int u = tid; u <= n; u += 512) { const int p = u < n ? 2 * u : 1, k = brev(p, m), pn = brev((N - k) & (N - 1), m);
        const f32x2 zk = buf[PADI(p)], zn = cconj(buf[PADI(pn)]);
        const f32x2 fa = (zk + zn) * 0.5f, df = zk - zn, fb = (f32x2){df.y * 0.5f, -df.x * 0.5f};
        const f32x2 fs = (fa + fb) * 0.5f, fd = (fa - fb) * 0.5f;
        out[u] = (f32x4){fs.x, fs.y, fd.x, fd.y}; }
    __syncthreads();
}

__device__ __forceinline__ void main_unit(const Ctx& F, const ArgsV& AV, int l, int unit) {
    const int kind = unit >> 9, b = (unit >> 8) & 1, pair = unit & 255;
    const int n = kind ? LC : SEQ, m = kind ? 9 : 14, N = 2 * n, tid = F.tid;
    const int row0 = kind ? MX + b * LC : b * SEQ;
    LAS f32x2* buf = (LAS f32x2*)F.lds;
    const f16* ZT = (const f16*)(F.ws + WS_ZT) + (size_t)(2 * pair) * MT + row0;
    const float* cw = AV.in(I_HYCW) + (size_t)l * 3 * 1536 + 2 * pair; const float* cb = AV.in(I_HYCB) + (size_t)l * 1536 + 2 * pair;
    f32x2 yv[16], g1[16], g2[16];
#pragma unroll
    for (int g = 0; g < 3; ++g)
#pragma unroll
        for (int cc = 0; cc < 2; ++cc) { const float w0 = cw[g * 512 + cc], w1 = cw[1536 + g * 512 + cc], w2 = cw[3072 + g * 512 + cc], bs = cb[g * 512 + cc];
            const f16* zt = ZT + (size_t)(g * 512 + cc) * MT;
#pragma unroll
            for (int gi = 0; gi < 2; ++gi) { const int t0 = 8 * (tid + 512 * gi);
                f16x8 mv; float pv = 0.f, nv = 0.f;
#pragma unroll
                for (int e = 0; e < 8; ++e) mv[e] = (f16)0.f;
                if (t0 < n) { mv = *(const f16x8*)(zt + t0); if (t0 > 0) pv = (float)zt[t0 - 1]; if (t0 + 8 < n) nv = (float)zt[t0 + 8]; }
#pragma unroll
                for (int e = 0; e < 8; ++e) { const float zm = e == 0 ? pv : (float)mv[e == 0 ? 0 : e - 1], zc = (float)mv[e], zp = e == 7 ? nv : (float)mv[e == 7 ? 7 : e + 1];
                    const float r = w0 * zm + w1 * zc + w2 * zp + bs;
                    if (g == 0) { if (cc == 0) yv[gi * 8 + e].x = r; else yv[gi * 8 + e].y = r; }
                    else if (g == 1) { if (cc == 0) g1[gi * 8 + e].x = r; else g1[gi * 8 + e].y = r; }
                    else { if (cc == 0) g2[gi * 8 + e].x = r; else g2[gi * 8 + e].y = r; } } } }
    const float invN = 1.0f / (float)N;
#pragma unroll
    for (int o = 0; o < 2; ++o) {
        __syncthreads();
        float z0 = 0.f; asm volatile("" : "+v"(z0));
#pragma unroll
        for (int gi = 0; gi < 2; ++gi) { const int t0 = 8 * (tid + 512 * gi);
            if (t0 < n) {
#pragma unroll
                for (int e = 0; e < 8; ++e) { buf[PADI(t0 + e)] = yv[gi * 8 + e]; buf[PADI(n + t0 + e)] = (f32x2){z0, z0}; } } }
        __syncthreads();
        fft_fwd(buf, m, tid);
        const f32x4* fsd = (const f32x4*)(F.ws + ((l & 1) ? WS_FSD2 : WS_FSD) + (kind ? FSD_C_OFF : 0)) + (size_t)(o * 256 + pair) * (n + 1);
        for (int u0 = tid; u0 <= n; u0 += 2048) {
            f32x4 f4[4];
#pragma unroll
            for (int jj = 0; jj < 4; ++jj) { const int u = u0 + 512 * jj; f4[jj] = fsd[u <= n ? u : n]; }
            PIN4(f4[0], f4[1], f4[2], f4[3]);
#pragma unroll
            for (int jj = 0; jj < 4; ++jj) { const int u = u0 + 512 * jj; if (u <= n) {
                const int p = u < n ? 2 * u : 1, k = brev(p, m), pn = brev((N - k) & (N - 1), m);
                const f32x2 zk = buf[PADI(p)], zn = buf[PADI(pn)]; const f32x4 f = f4[jj]; const f32x2 fs = (f32x2){f[0], f[1]}, fd = (f32x2){f[2], f[3]};
                const f32x2 wk = cmul(zk, fs) + cmul(cconj(zn), fd), wn = cmul(zn, cconj(fs)) + cmul(cconj(zk), cconj(fd));
                buf[PADI(pn)] = wn; buf[PADI(p)] = wk; } } }
        __syncthreads();
        fft_inv(buf, m, tid);
        const float* hb = AV.in(I_HYBIAS) + ((size_t)l * 2 + o) * 512 + 2 * pair; const f32x2 bias = (f32x2){hb[0], hb[1]};
#pragma unroll
        for (int gi = 0; gi < 2; ++gi) { const int t0 = 8 * (tid + 512 * gi);
            if (t0 < n) {
#pragma unroll
                for (int e = 0; e < 8; ++e) { const f32x2 cv = buf[PADI(t0 + e)] * invN; const f32x2 gt = o == 0 ? g1[gi * 8 + e] : g2[gi * 8 + e];
                    yv[gi * 8 + e] = gt * (cv + yv[gi * 8 + e] * bias); } } }
    }
    f16* Y = (f16*)(F.ws + WS_YBT) + (size_t)(2 * pair) * MT + row0;
#pragma unroll
    for (int gi = 0; gi < 2; ++gi) { const int t0 = 8 * (tid + 512 * gi);
        if (t0 < n) { f16x8 oa, ob;
#pragma unroll
            for (int e = 0; e < 8; ++e) { oa[e] = (f16)yv[gi * 8 + e].x; ob[e] = (f16)yv[gi * 8 + e].y; }
            oa = pg8::lowtog8(oa); ob = pg8::lowtog8(ob);
            *(f16x8*)(Y + t0) = oa; *(f16x8*)(Y + MT + t0) = ob; } }
    __syncthreads();
}

__device__ __forceinline__ void ph_ybt_transpose(const Ctx& F) {
    LAS f16* T = (LAS f16*)F.lds;
    const f16* YBT = (const f16*)(F.ws + WS_YBT); f16* Y = (f16*)(F.ws + WS_YCAT);
    const bool bal = (F.G == 256);
    for (int it = 0; it < (bal ? 2 : (MT / 64 + F.G - 1) / F.G); ++it) {
        int rb;
        if (bal) { if (F.bid >= 132) rb = (F.bid - 132) + 124 * it; else if (F.bid < 16 && it == 0) rb = 248 + F.bid; else rb = -1; }
        else rb = F.bid + it * F.G;
        if (rb < 0 || rb >= MT / 64) continue;
        const int r0 = rb * 64;
        __syncthreads();
        { f16x8 tv[8];
#pragma unroll
          for (int i = 0; i < 8; ++i) tv[i] = *(const f16x8*)(YBT + (size_t)F.tid * MT + r0 + 8 * i);
          PIN8(tv[0], tv[1], tv[2], tv[3], tv[4], tv[5], tv[6], tv[7]);
#pragma unroll
          for (int i = 0; i < 8; ++i) *(LAS f16x8*)(T + F.tid * 72 + 8 * i) = tv[i]; }
        __syncthreads();
        const int row = F.tid >> 3, cg = F.tid & 7;
#pragma unroll
        for (int jj = 0; jj < 8; ++jj) { const int gidx = cg + 8 * jj; f16x8 o;
#pragma unroll
            for (int e = 0; e < 8; ++e) o[e] = T[(8 * gidx + e) * 72 + row];
            *(f16x8*)(Y + (size_t)(r0 + row) * 2048 + 512 + 8 * gidx) = o; }
    }
    __syncthreads();
}
#undef PADI
}

#ifndef PHMASK
#define PHMASK 0xFFFF
#endif
#define PH_EN(k) (((PHMASK) >> (k)) & 1)
#ifndef STAMP_MASK
#define STAMP_MASK 0
#endif
#ifndef STAMP_BID
#define STAMP_BID 0
#endif
#ifndef STAMP_K
#define STAMP_K 1
#endif
#ifndef SUBMASK
#define SUBMASK 7
#endif
#define SUB_EN(k) (((SUBMASK) >> (k)) & 1)
constexpr int NPH = 2 + 12 * DEPTH;
constexpr int CW_Q = 8192;
__device__ __forceinline__ int q_pull(unsigned* ctr, volatile LAS int* slot) {
    __syncthreads();
    if (threadIdx.x == 0) *slot = (int)__hip_atomic_fetch_add(ctr, 1u, __ATOMIC_RELAXED, __HIP_MEMORY_SCOPE_AGENT);
    __syncthreads();
    return *slot;
}

__global__ void __launch_bounds__(512, 2) mk_fwd(Args args) {
    extern __shared__ __attribute__((aligned(16))) unsigned char lds_raw[];
    Ctx F; F.lds = (LAS unsigned char*)lds_raw; F.tid = threadIdx.x; F.lane = F.tid & 63; F.wave = __builtin_amdgcn_readfirstlane(F.tid >> 6);
    F.G = gridDim.x; F.bid = blockIdx.x; F.ws = args.ws;
    ArgsV AV; AV.out = args.out;
    const Ctx F0 = F;
#define FRESH() do { F.tid = opq(F0.tid); F.lane = F.tid & 63; F.wave = __builtin_amdgcn_readfirstlane(F.tid >> 6); } while (0)
    volatile LAS unsigned* MISC = (volatile LAS unsigned*)(F.lds + LDSCTL_OFF);
    if (F.tid < 64) MISC[F.tid] = 0u;
    __syncthreads();
    unsigned* barw = (unsigned*)(F.ws + WS_CTL) + CW_BAR;
    XcdBarrier bar; bar.bar = barw; bar.x = 0; bar.st = nullptr;
    const int lo = args.ph_lo, hi = args.ph_hi;
    if (hi - lo > 1) bar = xcd_barrier_post(barw, MISC + 8);
#define IN(k) (lo <= (k) && (k) < hi)
#define SEAM(k) do { if (IN(k) && IN((k) + 1)) xcd_barrier(bar); } while (0)
#if STAMP_MASK
    volatile LAS unsigned long long* TS = (volatile LAS unsigned long long*)(F.lds + LDSCTL_OFF + 128);
#define TSTART(k) do { if ((((STAMP_MASK) >> (k)) & 1) && blockIdx.x == STAMP_BID && threadIdx.x == 0) TS[0] = __builtin_amdgcn_s_memrealtime(); } while (0)
#define TSTOP(k) do { if ((((STAMP_MASK) >> (k)) & 1) && blockIdx.x == STAMP_BID && threadIdx.x == 0) TS[1] = TS[1] + (__builtin_amdgcn_s_memrealtime() - TS[0]); } while (0)
#else
#define TSTART(k) do {} while (0)
#define TSTOP(k) do {} while (0)
#endif
    unsigned char* ws = F.ws;
    const int rank160 = (F.bid + F.G - 160 % F.G) % F.G;

    TSTART(12);
    if (PH_EN(12) && IN(0)) { TSTART(25); FRESH(); ph_prologue(F, AV); TSTOP(25); TSTART(26); for (int l2 = 0; l2 < DEPTH; ++l2) { FRESH(); ph_hyena_h2(F, AV, l2); } TSTOP(26); }
    SEAM(0);
    TSTOP(12);

    for (int l = 0; l < DEPTH; ++l) {
        const int pb = 1 + 12 * l;
        const float* modl = (const float*)(ws + WS_MOD) + (size_t)l * 3 * 12288;
        const bool ctx_on = l < DEPTH - 1;
        const int nMr = ctx_on ? MT / 256 : MX / 256, nrows = ctx_on ? MT : MX;
        TSTART(0);
        if (PH_EN(0) && IN(pb + 0)) {
            TSTART(22); FRESH(); ph_convert_weights(F, AV, l);
            __syncthreads(); TSTOP(22);
            TSTART(24); FRESH(); if (F.bid < 32) s5_mats_group(F, AV, l, F.bid); TSTOP(24);
            TSTART(23); FRESH(); if (F.G > 64) { if (F.bid >= 32) { Ctx Fn = F; Fn.bid = F.bid - 32; Fn.G = F.G - 32; ph_norm(Fn, AV, l, 0, MT, l > 0 ? 11 : 0); } }
            else ph_norm(F, AV, l, 0, MT, l > 0 ? 11 : 0); TSTOP(23);
        }
        SEAM(pb + 0);
        TSTOP(0);
        TSTART(1);
        if (PH_EN(1) && IN(pb + 1)) {
            pg8::SchedPx S; S.init(MT / 256, WINN / 256, F.G, F.bid); S.A = (const char*)(ws + WS_HN); S.B = (const char*)(ws + WS_WIN); S.tile = (size_t)256 * 2048 * 2;
            pg8::EpiPx E{(f16*)(ws + WS_PX), (f16*)(ws + WS_S5A), (f16*)(ws + WS_ZT), (f16*)(ws + WS_GTL)};
            pg8::gemm_phase(F.lds, 2048, 2048, 32, S, E);
            if (F.G == 256) { unsigned* qc = (unsigned*)(ws + WS_CTL) + CW_Q + 2048 + l * 64; volatile LAS int* slot = (volatile LAS int*)(MISC + 16);
              for (;;) { if (F.bid < 160) break; const int u = q_pull(qc, slot); if (u >= 96) break; FRESH(); hy::filt_unit(F, AV, l, (l == 0 ? 416 : 384) + u); } }
        }
        SEAM(pb + 1);
        TSTOP(1);
        TSTART(2);
        if (PH_EN(2) && IN(pb + 2)) {
            TSTART(16);
            if (SUB_EN(0)) { pg8::SchedS5 S{(const char*)(ws + WS_S5A), (const char*)(ws + WS_S5M), (size_t)256 * 256 * 2, F.G, F.bid};
              pg8::EpiS5In E{(float*)(ws + WS_S5S)};
              pg8::gemm_phase(F.lds, 16384, 256, 4, S, E); }
            TSTOP(16);
            { unsigned* qc = (unsigned*)(ws + WS_CTL) + CW_Q + (l * 2 + 0) * 64; volatile LAS int* slot = (volatile LAS int*)(MISC + 16);
              const bool pre = (l > 0 && F.G == 256);
              const bool pre0 = (l == 0 && F.G == 256);
              const int fbase = pre ? 240 : 0, nb = pre ? 144 : (pre0 ? 416 : 512), ns = pre ? 0 : 512;
              for (;;) { const int u = q_pull(qc, slot); if (u >= nb + 528 + ns) break;
                  if (u >= nb && u < nb + 528) { const int hu = u - nb; TSTART(17); FRESH(); gla::gla_unit<false>(F, AV, l, hu >> 1, hu & 1, (hu & 1) + 1); TSTOP(17); }
                  else { TSTART(18); FRESH(); hy::filt_unit(F, AV, l, u < nb ? fbase + u : 512 + (u - nb - 528)); TSTOP(18); } } }
        }
        SEAM(pb + 2);
        TSTOP(2);
        TSTART(3);
        if (PH_EN(3) && IN(pb + 3)) { FRESH(); ph_s5_scan(F); FRESH(); gla::ph_gla_scan(F); }
        SEAM(pb + 3);
        TSTOP(3);
        TSTART(4);
        if (PH_EN(4) && IN(pb + 4)) {
            TSTART(19);
            if (SUB_EN(0)) { pg8::SchedS5 S{(const char*)(ws + WS_S5A), (const char*)(ws + WS_S5W), (size_t)256 * 512 * 2, F.G, F.bid};
              pg8::EpiS5Out E{(const f16*)(ws + WS_S5A), (f16*)(ws + WS_YAPRE), AV.in(I_S5D) + (size_t)l * 512};
              pg8::gemm_phase(F.lds, 16384, 512, 8, S, E); }
            TSTOP(19);
            { unsigned* qc = (unsigned*)(ws + WS_CTL) + CW_Q + (l * 2 + 1) * 64; volatile LAS int* slot = (volatile LAS int*)(MISC + 16);
              for (;;) { const int u = q_pull(qc, slot); if (u >= 264 + 1024) break;
                  if (u < 264) { TSTART(20); FRESH(); gla::gla_unit<true>(F, AV, l, u); TSTOP(20); } else { TSTART(21); FRESH(); hy::main_unit(F, AV, l, u - 264); TSTOP(21); } } }
        }
        SEAM(pb + 4);
        TSTOP(4);
        TSTART(5);
        if (PH_EN(5) && IN(pb + 5)) {
            pg8::SchedPlain S; S.init(nMr, 2, F.G, F.bid); S.A = (const char*)(ws + WS_YAPRE); S.B = (const char*)(ws + WS_WGLU); S.aTile = (size_t)256 * 512 * 2; S.bTile = (size_t)256 * 512 * 2;
            pg8::EpiGlu E{(const f16*)(ws + WS_YAPRE), (f16*)(ws + WS_YCAT), AV.in(I_GLUB) + (size_t)l * 512};
            pg8::gemm_phase(F.lds, 512, 512, 8, S, E);
            FRESH(); hy::ph_ybt_transpose(F);
        }
        SEAM(pb + 5);
        TSTOP(5);
        TSTART(6);
        if (PH_EN(6) && IN(pb + 6)) {
            pg8::SchedPlain S; S.init(nMr, 8, F.G, F.bid); S.aTile = (size_t)256 * 2048 * 2; S.bTile = (size_t)256 * 2048 * 2;
            S.A = (const char*)(ws + WS_YCAT); S.B = (const char*)(ws + WS_WBR);
            pg8::EpiBranchF E{(const f16*)(ws + WS_GTL), (f16*)(ws + WS_MBUF)};
            pg8::gemm_phase(F.lds, 2048, 2048, 32, S, E);
            if (l + 1 < DEPTH && F.G == 256) { unsigned* qc = (unsigned*)(ws + WS_CTL) + CW_Q + 1024 + l * 64; volatile LAS int* slot = (volatile LAS int*)(MISC + 16);
              for (;;) { if (F.bid < 16) break; const int u = q_pull(qc, slot); if (u >= 240) break; FRESH(); hy::filt_unit(F, AV, l + 1, u); } }
#ifdef PG_DUMMY
            { pg8::EpiF16 E9{(f16*)(ws + WS_ACT), 2048}; pg8::gemm_phase(F.lds, 2048, 2048, 32, S, E9); }
#endif
        }
        SEAM(pb + 6);
        TSTOP(6);
        TSTART(7);
        if (PH_EN(7) && IN(pb + 7)) {
            pg8::SchedPlain S; S.init(MX / 256, 8, F.G, F.bid); S.A = (const char*)(ws + WS_MBUF); S.B = (const char*)(ws + WS_WOUT); S.aTile = (size_t)256 * 2048 * 2; S.bTile = (size_t)256 * 2048 * 2;
            pg8::EpiResid E{(float*)(ws + WS_XRES), modl, 4096, l == 0 ? AV.in(I_X) : (const float*)(ws + WS_XRES)};
            pg8::gemm_phase(F.lds, 2048, 2048, 32, S, E);
            if (ctx_on) { pg8::SchedSplit S2{(const char*)(ws + WS_MBUF), (const char*)(ws + WS_WOUT), (size_t)256 * 2048 * 2, (size_t)256 * 2048 * 2, (size_t)8 * 128, 4, F.G, F.bid};
                pg8::EpiSlab E2{(float*)(ws + WS_SLAB), modl, 4096};
                pg8::gemm_phase(F.lds, 2048, 2048, 8, S2, E2); }
            if (l + 1 < DEPTH && F.G == 256) { unsigned* qc = (unsigned*)(ws + WS_CTL) + CW_Q + 1024 + l * 64 + 32; volatile LAS int* slot = (volatile LAS int*)(MISC + 16);
              for (;;) { const int u = q_pull(qc, slot); if (u >= 512) break; FRESH(); hy::filt_unit(F, AV, l + 1, 512 + u); } }
        }
        SEAM(pb + 7);
        TSTOP(7);
        TSTART(8);
        if (PH_EN(8) && IN(pb + 8)) { FRESH(); ph_norm(F, AV, l, 1, nrows, 4); }
        SEAM(pb + 8);
        TSTOP(8);
        TSTART(9);
        if (PH_EN(9) && IN(pb + 9)) {
            pg8::SchedPlain S; S.init(nMr, UPLD / 256, F.G, F.bid); S.A = (const char*)(ws + WS_HN); S.B = (const char*)(ws + WS_WUP); S.aTile = (size_t)256 * 2048 * 2; S.bTile = (size_t)256 * 2048 * 2;
            pg8::EpiUpAct E{(f16*)(ws + WS_ACT), (float*)(ws + WS_HALO), AV.in(I_FFCW) + (size_t)l * 3 * FFH, AV.in(I_FFCB) + (size_t)l * FFH, (LAS float*)(F.lds + EXTRA_OFF)};
            pg8::gemm_phase(F.lds, 2048, 2048, 32, S, E);
            if (l + 1 < DEPTH && F.G == 256) { unsigned* qc = (unsigned*)(ws + WS_CTL) + CW_Q + 1024 + l * 64 + 16; volatile LAS int* slot = (volatile LAS int*)(MISC + 16);
              for (;;) { if (F.bid < 224) break; const int u = q_pull(qc, slot); if (u >= 32) break; FRESH(); hy::filt_unit(F, AV, l + 1, 480 + u); } }
        }
        SEAM(pb + 9);
        TSTOP(9);
        TSTART(10);
        if (PH_EN(10) && IN(pb + 10)) { FRESH(); ph_ffn_fix(F, AV, l, nMr); }
        SEAM(pb + 10);
        TSTOP(10);
        TSTART(11);
        if (PH_EN(11) && IN(pb + 11)) {
            pg8::SchedPlain S; S.init(MX / 256, 8, F.G, F.bid); S.A = (const char*)(ws + WS_ACT); S.B = (const char*)(ws + WS_WDN); S.aTile = (size_t)256 * FFH * 2; S.bTile = (size_t)256 * FFH * 2;
            pg8::EpiResid E{(float*)(ws + WS_XRES), modl, 10240, (const float*)(ws + WS_XRES)};
            pg8::gemm_phase(F.lds, FFH, FFH, FFH / 64, S, E);
            if (ctx_on) { pg8::SchedSplit S2{(const char*)(ws + WS_ACT), (const char*)(ws + WS_WDN), (size_t)256 * FFH * 2, (size_t)256 * FFH * 2, (size_t)8 * 128, 11, F.G, F.bid};
                pg8::EpiSlab E2{(float*)(ws + WS_SLAB), modl, 10240};
                pg8::gemm_phase(F.lds, FFH, FFH, 8, S2, E2); }
        }
        SEAM(pb + 11);
        TSTOP(11);
    }
    if (PH_EN(13) && IN(NPH - 1)) { FRESH(); ph_final_norm(F, AV); }
#if STAMP_MASK
    if (blockIdx.x == STAMP_BID && threadIdx.x == 0) { const unsigned long long t0 = __builtin_amdgcn_s_memrealtime(); while (__builtin_amdgcn_s_memrealtime() - t0 < (unsigned long long)(STAMP_K) * TS[1]) __builtin_amdgcn_s_sleep(8); }
#endif
#undef IN
#undef SEAM
#undef FRESH
}

extern "C" void kernel_launch(void* const* d_in, const int* in_sizes, int n_in, void* d_out, int out_size, void* d_ws, size_t ws_size, hipStream_t stream) {
    static int grid = 0;
    if (grid == 0) {
        if (n_in != 40 || out_size != MX * D || ws_size < WS_END) { fprintf(stderr, "kernel_launch: unexpected problem (n_in %d out %d ws %zu, need %zu)\n", n_in, out_size, ws_size, (size_t)WS_END); grid = -1; return; }
        int dev = 0, cus = 0, per_cu = 0;
        if (hipGetDevice(&dev) != hipSuccess || hipDeviceGetAttribute(&cus, hipDeviceAttributeMultiprocessorCount, dev) != hipSuccess) { grid = -1; return; }
        if (hipFuncSetAttribute((const void*)mk_fwd, hipFuncAttributeMaxDynamicSharedMemorySize, LDS_BYTES) != hipSuccess) { fprintf(stderr, "kernel_launch: hipFuncSetAttribute failed\n"); grid = -1; return; }
        if (hipOccupancyMaxActiveBlocksPerMultiprocessor(&per_cu, (const void*)mk_fwd, 512, LDS_BYTES) != hipSuccess || per_cu < 1)
            fprintf(stderr, "kernel_launch: occupancy query reports %d\n", per_cu);
        (void)hipGetLastError();
        grid = cus;
    }
    if (grid < 0) return;
    if (hipMemsetAsync((char*)d_ws + WS_CTL, 0, CTL_ZERO_BYTES, stream) != hipSuccess) return;
    Args a{};
    for (int i = 0; i < 40; ++i) a.in[i] = (const float*)d_in[i];
    a.out = (float*)d_out; a.ws = (unsigned char*)d_ws;
#if MK_ONE
    a.ph_lo = 0; a.ph_hi = NPH;
    hipLaunchKernelGGL(mk_fwd, dim3(grid), dim3(512), LDS_BYTES, stream, a);
#else
    for (int p = 0; p < NPH; ++p) { a.ph_lo = p; a.ph_hi = p + 1; hipLaunchKernelGGL(mk_fwd, dim3(grid), dim3(512), LDS_BYTES, stream, a); }
#endif
}
```

```cpp
#include <hip/hip_runtime.h>
#include <stdio.h>

#ifndef MK_ONE
#define MK_ONE 1
#define STAMP_MASK 0
#define STAMP_K 1
#define STAMP_BID 0
#endif

#define GAS __attribute__((address_space(1)))
#define LAS __attribute__((address_space(3)))
typedef _Float16 f16;
typedef _Float16 f16x8 __attribute__((ext_vector_type(8)));
typedef _Float16 f16x4 __attribute__((ext_vector_type(4)));
typedef _Float16 f16x2 __attribute__((ext_vector_type(2)));
typedef float f32x4 __attribute__((ext_vector_type(4)));
typedef float f32x2 __attribute__((ext_vector_type(2)));

constexpr int D = 2048, NB = 2, SEQ = 8192, LC = 256, DEPTH = 4;
constexpr int MX = NB * SEQ, MC = NB * LC, MT = MX + MC;
constexpr int PXLD = 3840, WINN = 11520, FFH = 5632, UPLD = 2 * FFH;
constexpr int P_S5 = 0, P_GK = 512, P_GV = 1024, P_GQ = 2048, P_GR = 2560, P_HY = 3584, P_MG = 5120, P_GG = 3584, W_GG = 11264;
constexpr int INW = 11296;
constexpr int NCHK = 1056;
constexpr float S5SCALE = 1024.f;
constexpr float EPS = 1e-6f;
constexpr int NSC = 33;

constexpr size_t MiB = 1u << 20;
constexpr size_t WS_CTL = 0, CTL_ZERO_BYTES = 1 * MiB;
constexpr size_t WS_MOD = 1 * MiB;
constexpr size_t WS_TW = 2 * MiB;
constexpr size_t WS_S5AT = 3 * MiB;
constexpr size_t WS_WIN = 4 * MiB;
constexpr size_t WS_WGLU = WS_WIN + 45 * MiB;
constexpr size_t WS_WBR = WS_WGLU + 1 * MiB;
constexpr size_t WS_WOUT = WS_WBR + 8 * MiB;
constexpr size_t WS_WUP = WS_WOUT + 8 * MiB;
constexpr size_t WS_WDN = WS_WUP + 44 * MiB;
constexpr size_t WS_S5W = WS_WDN + 22 * MiB;
constexpr size_t WS_S5M = WS_S5W + 8 * MiB;
constexpr size_t WS_H2 = WS_S5M + 4 * MiB;
constexpr size_t WS_FSD = WS_H2 + 3 * MiB;
constexpr size_t FSD_C_OFF = (size_t)2 * 256 * 8193 * 16;
constexpr size_t WS_XRES = WS_FSD + 68 * MiB;
constexpr size_t WS_HN = WS_XRES + 132 * MiB;
constexpr size_t WS_PX = WS_HN + 66 * MiB;
constexpr size_t WS_S5A = WS_PX + 372 * MiB;
constexpr size_t WS_S5S = WS_S5A + 40 * MiB;
constexpr size_t WS_YAPRE = WS_S5S + 40 * MiB;
constexpr size_t WS_YCAT = WS_YAPRE + 20 * MiB;
constexpr size_t WS_MBUF = WS_YCAT + 66 * MiB;
constexpr size_t WS_GSLOC = WS_MBUF + 66 * MiB;
constexpr size_t WS_GSIN = WS_GSLOC + 66 * MiB;
constexpr size_t WS_GOF = WS_GSIN + 66 * MiB;
constexpr size_t WS_GDT = WS_GOF + 66 * MiB;
constexpr size_t WS_ACT = WS_GSLOC;
constexpr size_t WS_ZT = WS_GDT + 1 * MiB;
constexpr size_t WS_YBT = WS_ZT + 50 * MiB;
constexpr size_t WS_SLAB = WS_YBT + 17 * MiB;
constexpr size_t WS_HALO = WS_SLAB + 44 * MiB;
constexpr size_t WS_GTL = WS_HALO + 9 * MiB;
constexpr size_t WS_END = WS_GTL + 198 * MiB;
constexpr size_t WS_FSD2 = WS_PX + 124 * MiB;
constexpr size_t WS_W2 = WS_FSD2 + 68 * MiB;
constexpr size_t WS_H2H = WS_W2 + 128 * MiB;
static_assert(WS_H2H + 5 * MiB <= WS_PX + 372 * MiB, "PX tail");
static_assert((size_t)MT * FFH * 2 <= 198 * MiB, "ACT overlay");
constexpr int CW_BAR = 4096;

constexpr int RING_BYTES = 131072;
constexpr int EXTRA_OFF = RING_BYTES, EXTRA_BYTES = 8192;
constexpr int LDSCTL_OFF = EXTRA_OFF + EXTRA_BYTES;
constexpr int LDS_BYTES = LDSCTL_OFF + 256;

__device__ __forceinline__ float wave_sum(float v) {
#pragma unroll
    for (int o = 1; o < 64; o <<= 1) v += __shfl_xor(v, o);
    return v;
}
__device__ __forceinline__ float sigmoidf_(float x) { return __builtin_amdgcn_rcpf(1.0f + __expf(-x)); }
__device__ __forceinline__ float siluf_(float x) { return x * sigmoidf_(x); }
__device__ __forceinline__ float gelu_tanh_(float x) { const float u = 0.7978845608028654f * (x + 0.044715f * x * x * x); return x * __builtin_amdgcn_rcpf(1.0f + __expf(-2.0f * u)); }
__device__ __forceinline__ float logsigmoidf_(float x) { return fminf(x, 0.f) - __logf(1.0f + __expf(-fabsf(x))); }
__device__ __forceinline__ f32x2 cmul(f32x2 a, f32x2 b) { return (f32x2){a.x * b.x - a.y * b.y, a.x * b.y + a.y * b.x}; }
__device__ __forceinline__ f32x2 cconj(f32x2 a) { return (f32x2){a.x, -a.y}; }
__device__ __forceinline__ int opq(int x) { asm volatile("" : "+v"(x)); return x; }
#define PIN8(a, b, c, d, e, f, g, h) asm volatile("" : "+v"(a), "+v"(b), "+v"(c), "+v"(d), "+v"(e), "+v"(f), "+v"(g), "+v"(h))
#define PIN4(a, b, c, d) asm volatile("" : "+v"(a), "+v"(b), "+v"(c), "+v"(d))
#ifndef OPBITS_DROP
#define OPBITS_DROP 4
#endif
__device__ __forceinline__ f16 lowtog(f16 h) { unsigned short u = __builtin_bit_cast(unsigned short, h); constexpr unsigned short M = (unsigned short)((1u << OPBITS_DROP) - 1u);
    u = (unsigned short)((u + (M >> 1) + ((u >> OPBITS_DROP) & 1u)) & (unsigned short)~M); return __builtin_bit_cast(f16, u); }
template <int N> __device__ __forceinline__ float dpp_ror(float x) { return __builtin_bit_cast(float, __builtin_amdgcn_update_dpp(0, __builtin_bit_cast(int, x), 0x120 + N, 0xF, 0xF, false)); }
__device__ __forceinline__ unsigned lowtog2(unsigned u) { constexpr unsigned M = (1u << OPBITS_DROP) - 1u, M2 = M | (M << 16), H2 = (M >> 1) | ((M >> 1) << 16);
    return (u + H2 + ((u >> OPBITS_DROP) & 0x00010001u)) & ~M2; }
typedef unsigned u32x2v __attribute__((ext_vector_type(2)));
typedef unsigned u32x4v __attribute__((ext_vector_type(4)));
__device__ __forceinline__ f16x4 lowtog4(f16x4 w) { u32x2v u = __builtin_bit_cast(u32x2v, w); u[0] = lowtog2(u[0]); u[1] = lowtog2(u[1]); return __builtin_bit_cast(f16x4, u); }
#define LDS_WAIT() asm volatile("s_waitcnt lgkmcnt(0)" ::: "memory")
#define VM_WAIT() asm volatile("s_waitcnt vmcnt(0)" ::: "memory")

#define XB_TMO      128
#define XB_XCNT(j)  (256  + 64 * (j))
#define XB_XSUB(j)  (1280 + 64 * (j))
#define XB_XGEN(j)  (2304 + 64 * (j))
#define XB_TOP      3328
#define XB_TOPGEN   3392
#define XCD_BAR_WORDS 3456
#define XB_SPIN_CAP (1u << 18)
__device__ __forceinline__ unsigned xb_ld(unsigned* p)              { return __hip_atomic_load(p, __ATOMIC_RELAXED, __HIP_MEMORY_SCOPE_AGENT); }
__device__ __forceinline__ unsigned xb_add(unsigned* p, unsigned v) { return __hip_atomic_fetch_add(p, v, __ATOMIC_RELAXED, __HIP_MEMORY_SCOPE_AGENT); }
__device__ __forceinline__ unsigned xb_xcc_id() { return (unsigned)__builtin_amdgcn_s_getreg((3 << 11) | 20) & 0xFu; }
#define XB_SPIN(cond, bar) do { unsigned _sp = 0; while (cond) { __builtin_amdgcn_s_sleep(1); \
    if ((++_sp & 255u) == 0u) { if (xb_ld(&(bar)[XB_TMO])) break; if (_sp > XB_SPIN_CAP) { atomicAdd(&(bar)[XB_TMO], 1u); break; } } } } while (0)
struct XcdBarrier { unsigned* bar; unsigned x; volatile LAS unsigned* st; };
__device__ __forceinline__ XcdBarrier xcd_barrier_post(unsigned* bar, volatile LAS unsigned* st) {
    XcdBarrier b; b.bar = bar; b.x = xb_xcc_id(); b.st = st;
    if (threadIdx.x == 0) (void)xb_add(&bar[XB_XCNT(b.x)], 1u);
    return b;
}
__device__ __forceinline__ void xcd_barrier_complete(unsigned* bar, unsigned x, unsigned& nloc, unsigned& nx) {
    const unsigned G = gridDim.x * gridDim.y * gridDim.z;
    unsigned sum, cnt, mine, sp = 0u;
    for (;;) {
        sum = 0u; cnt = 0u; mine = 0u;
#pragma unroll
        for (unsigned j = 0; j < 16; ++j) { const unsigned c = xb_ld(&bar[XB_XCNT(j)]); sum += c; cnt += (c > 0u) ? 1u : 0u; mine = (j == x) ? c : mine; }
        if (sum == G) break;
        __builtin_amdgcn_s_sleep(1);
        if ((++sp & 255u) == 0u) { if (xb_ld(&bar[XB_TMO])) break; if (sp > XB_SPIN_CAP) { atomicAdd(&bar[XB_TMO], 1u); break; } }
    }
    nloc = mine > 0u ? mine : 1u; nx = cnt > 0u ? cnt : 1u;
}
__device__ __forceinline__ void xcd_barrier(const XcdBarrier& b) {
    asm volatile("s_waitcnt vmcnt(0)" ::: "memory");
    __syncthreads();
    if (threadIdx.x == 0) {
        unsigned* bar = b.bar;
        __builtin_amdgcn_s_waitcnt(0);
        unsigned nloc = b.st[0], nx = b.st[1];
        if (nloc == 0u) { xcd_barrier_complete(bar, b.x, nloc, nx); b.st[0] = nloc; b.st[1] = nx; }
        const unsigned old = xb_add(&bar[XB_XSUB(b.x)], 1u);
        const unsigned gen = old / nloc;
        if (old + 1u == (gen + 1u) * nloc) {
            __builtin_amdgcn_fence(__ATOMIC_RELEASE, "agent");
            asm volatile("s_waitcnt vmcnt(0)" ::: "memory");
            const unsigned og = xb_add(&bar[XB_TOP], 1u);
            const unsigned tg = og / nx;
            if (og + 1u == (tg + 1u) * nx) xb_add(&bar[XB_TOPGEN], 1u);
            else XB_SPIN(xb_ld(&bar[XB_TOPGEN]) == tg, bar);
            __builtin_amdgcn_fence(__ATOMIC_ACQUIRE, "agent");
            xb_add(&bar[XB_XGEN(b.x)], 1u);
            asm volatile("s_waitcnt vmcnt(0)" ::: "memory");
        } else {
            XB_SPIN(xb_ld(&bar[XB_XGEN(b.x)]) == gen, bar);
            __builtin_amdgcn_fence(__ATOMIC_ACQUIRE, "agent");
            asm volatile("s_waitcnt vmcnt(0)" ::: "memory");
        }
    }
    __syncthreads();
}

struct Args {
    const float* in[40];
    float* out; unsigned char* ws;
    int ph_lo, ph_hi;
};
struct ArgsV {
    __device__ __forceinline__ const float* in(int i) const {
        typedef const __attribute__((address_space(4))) unsigned long long* kp_t;
        kp_t ka = (kp_t)__builtin_amdgcn_kernarg_segment_ptr();
        return (const float*)(*(volatile const __attribute__((address_space(4))) unsigned long long*)(ka + i)); }
    float* out;
};
struct Ctx {
    LAS unsigned char* lds;
    int tid, lane, wave, G, bid;
    unsigned char* ws;
};
enum { I_X = 0, I_C, I_CTX, I_CCTX, I_WMOD, I_BMOD, I_N1G, I_N2G, I_WIN, I_S5ARE, I_S5AIM, I_S5STEP, I_S5BRE, I_S5BIM, I_S5CRE, I_S5CIM,
       I_S5D, I_GLUW, I_GLUB, I_HYCW, I_HYCB, I_HYW1, I_HYB1, I_HYF1, I_HYW2, I_HYB2, I_HYF2, I_HYW3, I_HYB3, I_HYBIAS,
       I_GLAWG, I_GLABG, I_GLANG, I_WBR, I_WOUT, I_WUP, I_FFCW, I_FFCB, I_WDN, I_FNG };

namespace pg8 {
constexpr int BM = 256, BK = 64, HALF = 128, HTB = HALF * BK * 2, STAGE_BYTES = 8 * HTB, NXCD = 8, WGM = 4;
__device__ __forceinline__ int lds_byte(int r, int c) { const int st = (r >> 4) * 2 + (c >> 5), rr = r & 15, cc = c & 31, ob = rr * 64 + cc * 2; return st * 1024 + (ob ^ (((ob >> 9) & 1) << 5)); }
__device__ __forceinline__ void stage_rc(int b, int& R, int& C) { const int st = b / 1024, sb = b % 1024, swz = sb ^ (((sb >> 9) & 1) << 5); R = (st >> 1) * 16 + swz / 64; C = (st & 1) * 32 + (swz % 64) / 2; }
__device__ __forceinline__ int perm32(int rho) { const int n = rho >> 4, i = rho & 15; return 8 * (i >> 2) + 4 * n + (i & 3); }
struct Unit { const char* a; const char* b; int pm, pn; };
struct Order2D {
    int nM, nN, nwg, G, c;
    __device__ __forceinline__ void init(int nM_, int nN_, int G_, int c_) { nM = nM_; nN = nN_; nwg = nM * nN; G = G_; c = c_; }
    __device__ __forceinline__ bool nx(int i, int& pm, int& pn) const {
        const long L = (long)i * G + c; if (L >= nwg) return false;
        int wgid = (int)L; { const int q = nwg / NXCD, r = nwg % NXCD, xcd = wgid % NXCD, off = wgid / NXCD; wgid = (xcd < r ? xcd * (q + 1) : r * (q + 1) + (xcd - r) * q) + off; }
        const int nig = WGM * nN, gid = wgid / nig, fm = gid * WGM, gsz = (nM - fm) < WGM ? (nM - fm) : WGM;
        pm = fm + ((wgid % nig) % gsz); pn = (wgid % nig) / gsz; return true;
    }
};
struct SchedPlain : Order2D {
    const char* A; const char* B; size_t aTile, bTile;
    __device__ __forceinline__ bool next(int i, Unit& u) const { int pm, pn; if (!nx(i, pm, pn)) return false; u.pm = pm; u.pn = pn; u.a = A + (size_t)pm * aTile; u.b = B + (size_t)pn * bTile; return true; }
};
struct SchedPx : Order2D {
    const char* A; const char* B; size_t tile;
    __device__ __forceinline__ bool next(int i, Unit& u) const { int pm, pn; if (!nx(i, pm, pn)) return false; u.pm = pm; u.pn = pn; const char* pa = A + (size_t)pm * tile; const char* pb = B + (size_t)pn * tile;
        const bool sw = pn >= 14 && pn < 20; u.a = sw ? pb : pa; u.b = sw ? pa : pb; return true; }
};
struct SchedSplit {
    const char* A; const char* B; size_t aTile, bTile, ksub; int nsplit, G, c;
    __device__ __forceinline__ bool next(int i, Unit& u) const { const int L = i * G + c; if (L >= 16 * nsplit) return false; const int t = L / nsplit, ks = L % nsplit, pm = 64 + (t >> 3), pn = t & 7;
        u.pm = pm; u.pn = pn | (ks << 8); u.a = A + (size_t)pm * aTile + (size_t)ks * ksub; u.b = B + (size_t)pn * bTile + (size_t)ks * ksub; return true; }
};
struct SchedS5 {
    const char* A; const char* B; size_t bGroup; int G, c; int lim = 160;
    __device__ __forceinline__ bool next(int i, Unit& u) const { const int L = i * G + c; if (L >= lim) return false; const int g = L & 31, pm = L >> 5;
        u.pm = pm; u.pn = g; u.a = A + ((size_t)pm * 256 * 16384 + (size_t)g * 512) * 2; u.b = B + (size_t)g * bGroup; return true; }
};

#define PG8_SA(b, h) (((b) * 2 + (h)) * HTB)
#define PG8_SB(b, h) ((4 + (b) * 2 + (h)) * HTB)
#define PG8_STAGE(bufoff, gbase, voff) do { _Pragma("unroll") for (int _i = 0; _i < 2; ++_i) \
        __builtin_amdgcn_global_load_lds((const unsigned*)((const char*)(gbase) + (voff)[_i]), (LAS unsigned*)(lds + (bufoff) + ldsw + _i * 8192), 16, 0, 0); } while (0)
#define PG8_LDA(dst, b, h) do { _Pragma("unroll") for (int m = 0; m < 4; ++m) _Pragma("unroll") for (int k = 0; k < 2; ++k) dst[m][k] = *(const LAS f16x8*)(lds + PG8_SA(b, h) + aoff + m * 2048 + k * 1024); } while (0)
#define PG8_LDB(dst, b, h) do { _Pragma("unroll") for (int n = 0; n < 2; ++n) _Pragma("unroll") for (int k = 0; k < 2; ++k) dst[n][k] = *(const LAS f16x8*)(lds + PG8_SB(b, h) + boff + n * 2048 + k * 1024); } while (0)
#define PG8_MMA(ai, bj, At, Bt) do { __builtin_amdgcn_s_setprio(1); _Pragma("unroll") for (int m = 0; m < 4; ++m) _Pragma("unroll") for (int n = 0; n < 2; ++n) _Pragma("unroll") for (int k = 0; k < 2; ++k) \
        acc[ai][bj][m][n] = __builtin_amdgcn_mfma_f32_16x16x32_f16(Bt[n][k], At[m][k], acc[ai][bj][m][n], 0, 0, 0); __builtin_amdgcn_s_setprio(0); } while (0)
#define PG8_WAIT_V(n) asm volatile("s_waitcnt vmcnt(" #n ")" ::: "memory")
#define PG8_WAIT_L(n) asm volatile("s_waitcnt lgkmcnt(" #n ")" ::: "memory")
#define PG8_BAR __builtin_amdgcn_s_barrier()
#define PG8_SCHED __builtin_amdgcn_sched_barrier(0)

template <class Epi, class Sched>
__device__ __forceinline__ void gemm_phase(LAS unsigned char* lds, const int lda, const int ldb, const int nt, const Sched& S, const Epi& E) {
    const int tid = opq((int)threadIdx.x), wid = __builtin_amdgcn_readfirstlane(tid >> 6), lane = tid & 63, wr = wid >> 2, wc = wid & 3, fr = lane & 15, fq = lane >> 4;
    unsigned voffA[2], voffB[2];
#pragma unroll
    for (int i = 0; i < 2; ++i) { int R, C; stage_rc(tid * 16 + i * 8192, R, C); const int Rb = Epi::PERM ? ((R & ~31) + perm32(R & 31)) : R;
        voffA[i] = (unsigned)(R * lda + C) * 2u; voffB[i] = (unsigned)(Rb * ldb + C) * 2u; }
    const size_t kstep = (size_t)(BK * 2);
    const size_t hstepA = (size_t)HALF * lda * 2, hstepB = (size_t)HALF * ldb * 2;
    const unsigned ldsw = (unsigned)wid * 1024u;
    const int aoff = lds_byte(wr * 64 + fr, fq * 8), boff = lds_byte(wc * 32 + fr, fq * 8);
    Unit cur, nxt; int ui = 0;
    if (!S.next(0, cur)) return;
    f32x4 acc[2][2][4][2];
#pragma unroll
    for (int a = 0; a < 2; ++a)
#pragma unroll
        for (int b = 0; b < 2; ++b)
#pragma unroll
            for (int m = 0; m < 4; ++m)
#pragma unroll
                for (int n = 0; n < 2; ++n) acc[a][b][m][n] = (f32x4){0.f, 0.f, 0.f, 0.f};
    f16x8 At[4][2], B0[2][2], B1[2][2];
    const char* cA = cur.a; const char* cB = cur.b;
    PG8_STAGE(PG8_SB(0, 0), cB, voffB); PG8_STAGE(PG8_SA(0, 0), cA, voffA); PG8_STAGE(PG8_SB(0, 1), cB + hstepB, voffB); PG8_STAGE(PG8_SA(0, 1), cA + hstepA, voffA);
    if (wr == 1) PG8_BAR;
    PG8_WAIT_V(4); PG8_BAR;
    PG8_STAGE(PG8_SB(1, 0), cB + kstep, voffB); PG8_STAGE(PG8_SA(1, 0), cA + kstep, voffA); PG8_STAGE(PG8_SB(1, 1), cB + hstepB + kstep, voffB);
    PG8_WAIT_V(6); PG8_BAR;
    for (;;) {
        const bool has_next = S.next(ui + 1, nxt);
        const char* nA = has_next ? nxt.a : cA; const char* nB = has_next ? nxt.b : cB;
        constexpr int NSEG = Epi::HAS_MID ? 3 : 1;
#pragma unroll
        for (int seg = 0; seg < NSEG; ++seg) {
        const int tb = Epi::HAS_MID ? (seg == 0 ? 0 : (seg == 1 ? Epi::MID1 + 2 : Epi::MID2 + 2)) : 0;
        const int te = Epi::HAS_MID ? (seg == 0 ? Epi::MID1 + 2 : (seg == 1 ? Epi::MID2 + 2 : nt)) : nt;
        for (int t = tb; t < te; t += 2) {
            const bool last = (t == nt - 2);
            const char* a1 = cA + (size_t)(t + 1) * kstep;
            const char* a2 = last ? nA : cA + (size_t)(t + 2) * kstep; const char* b2 = last ? nB : cB + (size_t)(t + 2) * kstep;
            const char* a3 = a2 + kstep; const char* b3 = b2 + kstep;
            PG8_LDB(B0, 0, 0); PG8_SCHED; PG8_LDA(At, 0, 0); PG8_STAGE(PG8_SA(1, 1), a1 + hstepA, voffA);
            PG8_WAIT_L(8); PG8_BAR; PG8_WAIT_L(0); PG8_MMA(0, 0, At, B0); PG8_BAR; PG8_SCHED;
            PG8_LDB(B1, 0, 1); PG8_STAGE(PG8_SB(0, 0), b2, voffB);
            PG8_BAR; PG8_WAIT_L(0); PG8_MMA(0, 1, At, B1); PG8_BAR;
            PG8_LDA(At, 0, 1); PG8_STAGE(PG8_SA(0, 0), a2, voffA);
            PG8_BAR; PG8_WAIT_L(0); PG8_MMA(1, 0, At, B0); PG8_BAR; PG8_SCHED;
            PG8_STAGE(PG8_SB(0, 1), b2 + hstepB, voffB);
            PG8_WAIT_V(6); PG8_BAR; PG8_MMA(1, 1, At, B1); PG8_BAR;
            PG8_LDB(B0, 1, 0); PG8_SCHED; PG8_LDA(At, 1, 0); PG8_STAGE(PG8_SA(0, 1), a2 + hstepA, voffA);
            PG8_WAIT_L(8); PG8_BAR; PG8_WAIT_L(0); PG8_MMA(0, 0, At, B0); PG8_BAR; PG8_SCHED;
            PG8_LDB(B1, 1, 1); PG8_STAGE(PG8_SB(1, 0), b3, voffB);
            PG8_BAR; PG8_WAIT_L(0); PG8_MMA(0, 1, At, B1); PG8_BAR;
            PG8_LDA(At, 1, 1); PG8_STAGE(PG8_SA(1, 0), a3, voffA);
            PG8_BAR; PG8_WAIT_L(0); PG8_MMA(1, 0, At, B0); PG8_BAR; PG8_SCHED;
            PG8_STAGE(PG8_SB(1, 1), b3 + hstepB, voffB);
            PG8_WAIT_V(6); PG8_BAR; PG8_MMA(1, 1, At, B1); PG8_BAR;
        }
        if constexpr (Epi::HAS_MID) { if (seg < 2) {
            E.mid(acc, cur, seg, wr, wc, fr, fq);
        } }
        }
#if STAMP_MASK & (1 << 23)
        if (Epi::HAS_MID && blockIdx.x == 0 && threadIdx.x == 0) ((volatile LAS unsigned long long*)(lds + LDSCTL_OFF + 128))[0] = __builtin_amdgcn_s_memrealtime();
#endif
        E(acc, cur, wr, wc, fr, fq);
#if STAMP_MASK & (1 << 23)
        if (Epi::HAS_MID && blockIdx.x == 0 && threadIdx.x == 0) { volatile LAS unsigned long long* TS = (volatile LAS unsigned long long*)(lds + LDSCTL_OFF + 128); TS[1] = TS[1] + (__builtin_amdgcn_s_memrealtime() - TS[0]); }
#endif
        if (!has_next) break;
#pragma unroll
        for (int a = 0; a < 2; ++a)
#pragma unroll
            for (int b = 0; b < 2; ++b)
#pragma unroll
                for (int m = 0; m < 4; ++m)
#pragma unroll
                    for (int n = 0; n < 2; ++n) acc[a][b][m][n] = (f32x4){0.f, 0.f, 0.f, 0.f};
        cur = nxt; cA = nA; cB = nB; ++ui;
    }
    PG8_WAIT_V(0);
    if (wr == 0) PG8_BAR;
    PG8_BAR;
}
#undef PG8_SA
#undef PG8_SB
#undef PG8_STAGE
#undef PG8_LDA
#undef PG8_LDB
#undef PG8_MMA
#undef PG8_WAIT_V
#undef PG8_WAIT_L
#undef PG8_BAR
#undef PG8_SCHED

typedef const f32x4 (&AccRef)[2][2][4][2];
__device__ __forceinline__ f16x8 lowtog8(f16x8 w) { u32x4v u = __builtin_bit_cast(u32x4v, w);
#pragma unroll
    for (int e = 0; e < 4; ++e) u[e] = lowtog2(u[e]);
    return __builtin_bit_cast(f16x8, u); }
__device__ __forceinline__ f16x8 pack8(f32x4 a, f32x4 b) { f16x8 w; w[0] = (f16)a[0]; w[1] = (f16)a[1]; w[2] = (f16)a[2]; w[3] = (f16)a[3]; w[4] = (f16)b[0]; w[5] = (f16)b[1]; w[6] = (f16)b[2]; w[7] = (f16)b[3]; return w; }

struct EpiPx {
    static constexpr bool PERM = true, HAS_MID = false; static constexpr int MID1 = 0, MID2 = 0; f16* PX; f16* S5A; f16* ZT; f16* GTL;
    __device__ __forceinline__ void operator()(AccRef acc, const Unit& u, int wr, int wc, int fr, int fq) const { fr = opq(fr); fq = opq(fq);
        const int row0 = u.pm * BM + wr * 64 + fr, col0 = u.pn * BM + wc * 32 + 8 * fq;
#pragma unroll
        for (int ai = 0; ai < 2; ++ai)
#pragma unroll
            for (int m = 0; m < 4; ++m) { const int row = row0 + ai * HALF + m * 16;
#pragma unroll
                for (int bj = 0; bj < 2; ++bj) { const int c = col0 + bj * HALF; const f16x8 w = pack8(acc[ai][bj][m][0], acc[ai][bj][m][1]);
                    if (u.pn < 2) *(f16x8*)(S5A + (size_t)(row >> 4) * 16384 + (size_t)(c >> 4) * 512 + (row & 15) * 16 + (c & 15)) = w;
                    else if (u.pn >= 14 && u.pn < 20) *(f16x8*)(ZT + (size_t)(u.pn * BM + (row - u.pm * BM) - P_HY) * MT + (u.pm * BM + (c - u.pn * BM))) = w;
                    else if (u.pn >= 20 && u.pn < 44) { f16x8 e;
#pragma unroll
                        for (int j = 0; j < 4; ++j) { e[j] = (f16)fminf(1.0f + __expf(-acc[ai][bj][m][0][j]), 60000.0f); e[4 + j] = (f16)fminf(1.0f + __expf(-acc[ai][bj][m][1][j]), 60000.0f); }
                        *(f16x8*)(GTL + ((size_t)(u.pn - 20) * 66 + u.pm) * 65536 + (size_t)(row - u.pm * BM) * 256 + (c - u.pn * BM)) = e; }
                    else { const int pr = row < MX ? (row & ~8191) + ((row & 63) << 7) + ((row & 8191) >> 6) : row;
                        *(f16x8*)(PX + (size_t)pr * PXLD + (u.pn == 44 ? c - (W_GG - P_GG) : c)) = w; } } }
    }
};
struct EpiF16 {
    static constexpr bool PERM = true, HAS_MID = false; static constexpr int MID1 = 0, MID2 = 0; f16* O; int ldc;
    __device__ __forceinline__ void operator()(AccRef acc, const Unit& u, int wr, int wc, int fr, int fq) const { fr = opq(fr); fq = opq(fq);
        const int row0 = u.pm * BM + wr * 64 + fr, col0 = u.pn * BM + wc * 32 + 8 * fq;
#pragma unroll
        for (int ai = 0; ai < 2; ++ai)
#pragma unroll
            for (int m = 0; m < 4; ++m) { f16* rowp = O + (size_t)(row0 + ai * HALF + m * 16) * ldc + col0;
#pragma unroll
                for (int bj = 0; bj < 2; ++bj) *(f16x8*)(rowp + bj * HALF) = pack8(acc[ai][bj][m][0], acc[ai][bj][m][1]); }
    }
};
struct EpiS5In {
    static constexpr bool PERM = false, HAS_MID = false; static constexpr int MID1 = 0, MID2 = 0; float* S;
    __device__ __forceinline__ void operator()(AccRef acc, const Unit& u, int wr, int wc, int fr, int fq) const { fr = opq(fr); fq = opq(fq);
        const int row0 = u.pm * BM + wr * 64 + fr, col0 = wc * 32 + 4 * fq, g = u.pn;
#pragma unroll
        for (int ai = 0; ai < 2; ++ai)
#pragma unroll
            for (int m = 0; m < 4; ++m) { const int row = row0 + ai * HALF + m * 16; { float* rowp = S + ((size_t)row * 32 + g) * 256 + col0;
#pragma unroll
                for (int bj = 0; bj < 2; ++bj)
#pragma unroll
                    for (int n = 0; n < 2; ++n) *(f32x4*)(rowp + bj * HALF + n * 16) = acc[ai][bj][m][n]; } }
    }
};
struct EpiS5Out {
    static constexpr bool PERM = true, HAS_MID = false; static constexpr int MID1 = 0, MID2 = 0; const f16* S5A; f16* Y; const float* dvec;
    __device__ __forceinline__ void operator()(AccRef acc, const Unit& u, int wr, int wc, int fr, int fq) const { fr = opq(fr); fq = opq(fq);
        const int row0 = u.pm * BM + wr * 64 + fr, col0 = wc * 32 + 8 * fq, g = u.pn;
        const int h0 = col0 & 15;
        const f32x4 d0 = *(const f32x4*)(dvec + g * 16 + h0), d1 = *(const f32x4*)(dvec + g * 16 + h0 + 4);
#pragma unroll
        for (int ai = 0; ai < 2; ++ai) { f16x8 uu[4][2];
#pragma unroll
            for (int m = 0; m < 4; ++m)
#pragma unroll
                for (int bj = 0; bj < 2; ++bj) uu[m][bj] = *(const f16x8*)(S5A + (size_t)(row0 + ai * HALF + m * 16) * 16384 + (size_t)g * 512 + col0 + bj * HALF);
            PIN8(uu[0][0], uu[0][1], uu[1][0], uu[1][1], uu[2][0], uu[2][1], uu[3][0], uu[3][1]);
#pragma unroll
            for (int m = 0; m < 4; ++m) { const int chunk = row0 + ai * HALF + m * 16;
#pragma unroll
                for (int bj = 0; bj < 2; ++bj) { const int c = col0 + bj * HALF, t = c >> 4; f16x8 w;
#pragma unroll
                    for (int j = 0; j < 4; ++j) { w[j] = (f16)gelu_tanh_(acc[ai][bj][m][0][j] * (1.0f / S5SCALE) + d0[j] * (float)uu[m][bj][j]);
                                                  w[4 + j] = (f16)gelu_tanh_(acc[ai][bj][m][1][j] * (1.0f / S5SCALE) + d1[j] * (float)uu[m][bj][4 + j]); }
                    *(f16x8*)(Y + (size_t)(chunk * 16 + t) * 512 + g * 16 + h0) = lowtog8(w); } }
            asm volatile("" ::: "memory"); }
    }
};
struct EpiGlu {
    static constexpr bool PERM = true, HAS_MID = false; static constexpr int MID1 = 0, MID2 = 0; const f16* YP; f16* O; const float* bias;
    __device__ __forceinline__ void operator()(AccRef acc, const Unit& u, int wr, int wc, int fr, int fq) const { fr = opq(fr); fq = opq(fq);
        const int row0 = u.pm * BM + wr * 64 + fr, col0 = u.pn * BM + wc * 32 + 8 * fq;
        f32x4 bv[2][2];
#pragma unroll
        for (int bj = 0; bj < 2; ++bj) { bv[bj][0] = *(const f32x4*)(bias + col0 + bj * HALF); bv[bj][1] = *(const f32x4*)(bias + col0 + bj * HALF + 4); }
#pragma unroll
        for (int ai = 0; ai < 2; ++ai) { f16x8 yp[4][2];
#pragma unroll
            for (int m = 0; m < 4; ++m)
#pragma unroll
                for (int bj = 0; bj < 2; ++bj) yp[m][bj] = *(const f16x8*)(YP + (size_t)(row0 + ai * HALF + m * 16) * 512 + col0 + bj * HALF);
            PIN8(yp[0][0], yp[0][1], yp[1][0], yp[1][1], yp[2][0], yp[2][1], yp[3][0], yp[3][1]);
#pragma unroll
            for (int m = 0; m < 4; ++m)
#pragma unroll
                for (int bj = 0; bj < 2; ++bj) { f16x8 w;
#pragma unroll
                    for (int j = 0; j < 4; ++j) { w[j] = (f16)((float)yp[m][bj][j] * sigmoidf_(acc[ai][bj][m][0][j] + bv[bj][0][j])); w[4 + j] = (f16)((float)yp[m][bj][4 + j] * sigmoidf_(acc[ai][bj][m][1][j] + bv[bj][1][j])); }
                    *(f16x8*)(O + (size_t)(row0 + ai * HALF + m * 16) * 2048 + col0 + bj * HALF) = lowtog8(w); }
            asm volatile("" ::: "memory"); }
    }
};
template <int BR> struct EpiBranch {
    static constexpr bool PERM = true, HAS_MID = false; static constexpr int MID1 = 0, MID2 = 0; const f16* PX; f16* M;
    __device__ __forceinline__ void operator()(AccRef acc, const Unit& u, int wr, int wc, int fr, int fq) const { fr = opq(fr); fq = opq(fq);
        const int row0 = u.pm * BM + wr * 64 + fr, col0 = u.pn * BM + wc * 32 + 8 * fq;
#pragma unroll
        for (int ai = 0; ai < 2; ++ai)
#pragma unroll
            for (int m = 0; m < 4; ++m) { const int row = row0 + ai * HALF + m * 16;
#pragma unroll
                for (int bj = 0; bj < 2; ++bj) { const int c = col0 + bj * HALF;
                    const f16x8 gl = *(const f16x8*)(PX + (size_t)row * PXLD + P_MG + BR * 2048 + c);
                    f16* mp = M + (size_t)row * 2048 + c;
                    f16x8 prev; if (BR > 0) prev = *(const f16x8*)mp;
                    f16x8 w;
#pragma unroll
                    for (int j = 0; j < 4; ++j) { float v0 = sigmoidf_((float)gl[j]) * acc[ai][bj][m][0][j], v1 = sigmoidf_((float)gl[4 + j]) * acc[ai][bj][m][1][j];
                        if (BR > 0) { v0 += (float)prev[j]; v1 += (float)prev[4 + j]; } w[j] = (f16)v0; w[4 + j] = (f16)v1; }
                    *(f16x8*)mp = w; } asm volatile("" ::: "memory"); }
    }
};
typedef f32x4 (&AccMut)[2][2][4][2];

struct EpiBranchF {
    static constexpr bool PERM = true, HAS_MID = true; static constexpr int MID1 = 6, MID2 = 14;
    const f16* GTL; f16* M;
    __device__ __forceinline__ void mid(AccMut acc, const Unit& u, int seg, int wr, int wc, int fr, int fq) const { fr = opq(fr); fq = opq(fq);
        const int lrow0 = wr * 64 + fr, lcol0 = wc * 32 + 8 * fq;
        const f16* ga = GTL + ((size_t)((seg == 0 ? 0 : 8) + u.pn) * 66 + u.pm) * 65536; const f16* gb = ga + (size_t)8 * 66 * 65536;
#pragma unroll
        for (int ai = 0; ai < 2; ++ai) { f16x8 za[4][2], zb[4][2];
#pragma unroll
            for (int m = 0; m < 4; ++m)
#pragma unroll
                for (int bj = 0; bj < 2; ++bj) { const int off = (lrow0 + ai * HALF + m * 16) * 256 + lcol0 + bj * HALF; za[m][bj] = *(const f16x8*)(ga + off); zb[m][bj] = *(const f16x8*)(gb + off); }
            PIN8(za[0][0], za[0][1], za[1][0], za[1][1], za[2][0], za[2][1], za[3][0], za[3][1]); PIN8(zb[0][0], zb[0][1], zb[1][0], zb[1][1], zb[2][0], zb[2][1], zb[3][0], zb[3][1]);
#pragma unroll
            for (int m = 0; m < 4; ++m)
#pragma unroll
                for (int bj = 0; bj < 2; ++bj)
#pragma unroll
                    for (int j = 0; j < 4; ++j) { acc[ai][bj][m][0][j] *= (float)zb[m][bj][j] * __builtin_amdgcn_rcpf((float)za[m][bj][j]);
                                                  acc[ai][bj][m][1][j] *= (float)zb[m][bj][4 + j] * __builtin_amdgcn_rcpf((float)za[m][bj][4 + j]); }
            asm volatile("" ::: "memory"); }
    }
    __device__ __forceinline__ void operator()(AccRef acc, const Unit& u, int wr, int wc, int fr, int fq) const { fr = opq(fr); fq = opq(fq);
        const int row0 = u.pm * BM + wr * 64 + fr, col0 = u.pn * BM + wc * 32 + 8 * fq;
        f16x8 gla2[2][4][2];
#pragma unroll
        for (int ai = 0; ai < 2; ++ai)
#pragma unroll
            for (int m = 0; m < 4; ++m)
#pragma unroll
                for (int bj = 0; bj < 2; ++bj) gla2[ai][m][bj] = *(const f16x8*)(GTL + ((size_t)(16 + u.pn) * 66 + u.pm) * 65536 + (wr * 64 + fr + ai * HALF + m * 16) * 256 + wc * 32 + 8 * fq + bj * HALF);
        PIN8(gla2[0][0][0], gla2[0][0][1], gla2[0][1][0], gla2[0][1][1], gla2[0][2][0], gla2[0][2][1], gla2[0][3][0], gla2[0][3][1]);
        PIN8(gla2[1][0][0], gla2[1][0][1], gla2[1][1][0], gla2[1][1][1], gla2[1][2][0], gla2[1][2][1], gla2[1][3][0], gla2[1][3][1]);
#pragma unroll
        for (int ai = 0; ai < 2; ++ai) { const f16x8 (&gl)[4][2] = gla2[ai];
#pragma unroll
            for (int m = 0; m < 4; ++m)
#pragma unroll
                for (int bj = 0; bj < 2; ++bj) { f16x8 w;
#pragma unroll
                    for (int j = 0; j < 4; ++j) { w[j] = (f16)(__builtin_amdgcn_rcpf((float)gl[m][bj][j]) * acc[ai][bj][m][0][j]); w[4 + j] = (f16)(__builtin_amdgcn_rcpf((float)gl[m][bj][4 + j]) * acc[ai][bj][m][1][j]); }
                    *(f16x8*)(M + (size_t)(row0 + ai * HALF + m * 16) * 2048 + col0 + bj * HALF) = lowtog8(w); }
            asm volatile("" ::: "memory"); }
    }
};
struct EpiUpAct {
    static constexpr bool PERM = true, HAS_MID = false; static constexpr int MID1 = 0, MID2 = 0; f16* ACT; float* HALO; const float* cw; const float* cb; LAS float* HL;
    __device__ __forceinline__ void operator()(AccRef acc, const Unit& u, int wr, int wc, int fr, int fq) const { fr = opq(fr); fq = opq(fq);
        const int lane = fq * 16 + fr;
#pragma unroll
        for (int ai = 0; ai < 2; ++ai) { LAS float* hp = HL + ((ai * 2 + wr) * 4 + wc) * 64 + 8 * fq;
            if (fr == 0) { *(LAS f32x4*)(hp) = acc[ai][0][0][0]; *(LAS f32x4*)(hp + 4) = acc[ai][0][0][1]; }
            if (fr == 15) { *(LAS f32x4*)(hp + 32) = acc[ai][0][3][0]; *(LAS f32x4*)(hp + 36) = acc[ai][0][3][1]; } }
        { float* gh = HALO + ((size_t)u.pm * 44 + u.pn) * 768 + wc * 32 + 8 * fq;
          if (wr == 0 && fr < 2) { *(f32x4*)(gh + fr * 128) = acc[0][0][0][0]; *(f32x4*)(gh + fr * 128 + 4) = acc[0][0][0][1]; }
          if (wr == 0 && fr == 0) { *(f32x4*)(gh + 4 * 128) = acc[0][1][0][0]; *(f32x4*)(gh + 4 * 128 + 4) = acc[0][1][0][1]; }
          if (wr == 1 && fr >= 14) { *(f32x4*)(gh + (fr - 12) * 128) = acc[1][0][3][0]; *(f32x4*)(gh + (fr - 12) * 128 + 4) = acc[1][0][3][1]; }
          if (wr == 1 && fr == 15) { *(f32x4*)(gh + 5 * 128) = acc[1][1][3][0]; *(f32x4*)(gh + 5 * 128 + 4) = acc[1][1][3][1]; } }
        asm volatile("s_waitcnt lgkmcnt(0)" ::: "memory"); __builtin_amdgcn_s_barrier(); __builtin_amdgcn_s_barrier(); asm volatile("" ::: "memory");
        const int colg = u.pn * 128 + wc * 32 + 8 * fq;
        const int row0 = u.pm * BM + wr * 64 + fr;
#pragma unroll
        for (int ai = 0; ai < 2; ++ai) {
            f16x4 keep[4];
#pragma unroll
            for (int n = 0; n < 2; ++n) {
                const f32x4 w0 = *(const f32x4*)(cw + colg + 4 * n), w1 = *(const f32x4*)(cw + FFH + colg + 4 * n), w2 = *(const f32x4*)(cw + 2 * FFH + colg + 4 * n), bb = *(const f32x4*)(cb + colg + 4 * n);
                const bool hasp = (wr == 1) || (ai == 1), hasn = (wr == 0) || (ai == 0);
                const LAS float* pp = HL + (((wr == 1 ? ai : 0) * 2 + (wr == 1 ? 0 : 1)) * 4 + wc) * 64 + 32 + 8 * fq + 4 * n;
                const LAS float* np = HL + (((wr == 0 ? ai : 1) * 2 + (wr == 0 ? 1 : 0)) * 4 + wc) * 64 + 8 * fq + 4 * n;
                const f32x4 hprev = hasp ? *(const LAS f32x4*)pp : (f32x4){0.f, 0.f, 0.f, 0.f}, hnext = hasn ? *(const LAS f32x4*)np : (f32x4){0.f, 0.f, 0.f, 0.f};
                f32x4 R[4], L[4];
#pragma unroll
                for (int m = 0; m < 4; ++m)
#pragma unroll
                    for (int j = 0; j < 4; ++j) { R[m][j] = dpp_ror<1>(acc[ai][0][m][n][j]); L[m][j] = dpp_ror<15>(acc[ai][0][m][n][j]); }
#pragma unroll
                for (int m = 0; m < 4; ++m) { const f32x4 pv = fr > 0 ? R[m] : (m > 0 ? R[m > 0 ? m - 1 : 0] : hprev); const f32x4 nv = fr < 15 ? L[m] : (m < 3 ? L[m < 3 ? m + 1 : 3] : hnext);
                    const f32x4 a = w0 * pv + w1 * acc[ai][0][m][n] + w2 * nv + bb;
                    f16x4 o;
#pragma unroll
                    for (int j = 0; j < 4; ++j) o[j] = (f16)(siluf_(a[j]) * acc[ai][1][m][n][j]);
                    o = lowtog4(o);
                    if (n == 0) keep[m] = o;
                    else { f16x8 w; w[0] = keep[m][0]; w[1] = keep[m][1]; w[2] = keep[m][2]; w[3] = keep[m][3]; w[4] = o[0]; w[5] = o[1]; w[6] = o[2]; w[7] = o[3];
                        *(f16x8*)(ACT + (size_t)(row0 + ai * HALF + m * 16) * FFH + colg) = w; } }
                asm volatile("" ::: "memory");
            }
        }
    }
};
struct EpiSlab {
    static constexpr bool PERM = false, HAS_MID = false; static constexpr int MID1 = 0, MID2 = 0; float* slab; const float* mod; int goff;
    __device__ __forceinline__ void operator()(AccRef acc, const Unit& u, int wr, int wc, int fr, int fq) const { fr = opq(fr); fq = opq(fq);
        const int pn = u.pn & 255, ks = u.pn >> 8;
        const int row0 = (u.pm - 64) * BM + wr * 64 + fr, col0 = pn * BM + wc * 32 + 4 * fq;
        const float* gp = mod + 2 * 12288 + goff + col0;
        f32x4 gv[2][2];
#pragma unroll
        for (int bj = 0; bj < 2; ++bj)
#pragma unroll
            for (int n = 0; n < 2; ++n) gv[bj][n] = *(const f32x4*)(gp + bj * HALF + n * 16);
        float* sp = slab + (size_t)ks * MC * D;
#pragma unroll
        for (int ai = 0; ai < 2; ++ai)
#pragma unroll
            for (int m = 0; m < 4; ++m) { float* rowp = sp + (size_t)(row0 + ai * HALF + m * 16) * D + col0;
#pragma unroll
                for (int bj = 0; bj < 2; ++bj)
#pragma unroll
                    for (int n = 0; n < 2; ++n) *(f32x4*)(rowp + bj * HALF + n * 16) = gv[bj][n] * acc[ai][bj][m][n]; }
    }
};
struct EpiResid {
    static constexpr bool PERM = false, HAS_MID = false; static constexpr int MID1 = 0, MID2 = 0; float* X; const float* mod; int goff; const float* Xs;
    __device__ __forceinline__ void operator()(AccRef acc, const Unit& u, int wr, int wc, int fr, int fq) const { fr = opq(fr); fq = opq(fq);
        const int row0 = u.pm * BM + wr * 64 + fr, col0 = u.pn * BM + wc * 32 + 4 * fq;
        const int bsel = u.pm < 32 ? 0 : (u.pm < 64 ? 1 : 2);
        const float* gp = mod + bsel * 12288 + goff + col0;
        f32x4 gv[2][2];
#pragma unroll
        for (int bj = 0; bj < 2; ++bj)
#pragma unroll
            for (int n = 0; n < 2; ++n) gv[bj][n] = *(const f32x4*)(gp + bj * HALF + n * 16);
#pragma unroll
        for (int ai = 0; ai < 2; ++ai) { f32x4 xv[4][2][2];
#pragma unroll
            for (int m = 0; m < 4; ++m) { const float* rowp = Xs + (size_t)(row0 + ai * HALF + m * 16) * D + col0;
#pragma unroll
                for (int bj = 0; bj < 2; ++bj)
#pragma unroll
                    for (int n = 0; n < 2; ++n) xv[m][bj][n] = *(const f32x4*)(rowp + bj * HALF + n * 16); }
            PIN8(xv[0][0][0], xv[0][0][1], xv[0][1][0], xv[0][1][1], xv[1][0][0], xv[1][0][1], xv[1][1][0], xv[1][1][1]); PIN8(xv[2][0][0], xv[2][0][1], xv[2][1][0], xv[2][1][1], xv[3][0][0], xv[3][0][1], xv[3][1][0], xv[3][1][1]);
#pragma unroll
            for (int m = 0; m < 4; ++m) { float* rowp = X + (size_t)(row0 + ai * HALF + m * 16) * D + col0;
#pragma unroll
                for (int bj = 0; bj < 2; ++bj)
#pragma unroll
                    for (int n = 0; n < 2; ++n) *(f32x4*)(rowp + bj * HALF + n * 16) = xv[m][bj][n] + gv[bj][n] * acc[ai][bj][m][n]; }
            asm volatile("" ::: "memory"); }
    }
};
}


__device__ __forceinline__ void ph_prologue(const Ctx& F, const ArgsV& AV) {
    const int gt = F.bid * 512 + F.tid, NT = F.G * 512;
    { const f32x4* cs = (const f32x4*)AV.in(I_CTX); f32x4* xr = (f32x4*)(F.ws + WS_XRES);
      for (int i = gt; i < MC * D / 4; i += NT) xr[MX * D / 4 + i] = cs[i]; }
    LAS float* sc = (LAS float*)F.lds;
    LAS float* red = (LAS float*)(F.lds + 3 * 2048 * 4);
    for (int i = F.tid; i < 3 * 2048; i += 512) { const int r = i / 2048, k = i % 2048; const float v = r < 2 ? AV.in(I_C)[r * 2048 + k] : AV.in(I_CCTX)[k]; sc[i] = siluf_(v); }
    __syncthreads();
    const int col = F.tid & 63, ks = F.tid >> 6;
    for (int chunk = F.bid; chunk < DEPTH * 192; chunk += F.G) {
        const int l = chunk / 192, n0 = (chunk % 192) * 64;
        const float* w = AV.in(I_WMOD) + (size_t)l * 2048 * 12288 + n0 + col;
        float s0 = 0.f, s1 = 0.f, s2 = 0.f;
#pragma unroll 8
        for (int k = ks * 256; k < ks * 256 + 256; ++k) { const float wv = w[(size_t)k * 12288]; s0 += sc[k] * wv; s1 += sc[2048 + k] * wv; s2 += sc[4096 + k] * wv; }
        red[(ks * 3 + 0) * 64 + col] = s0; red[(ks * 3 + 1) * 64 + col] = s1; red[(ks * 3 + 2) * 64 + col] = s2;
        __syncthreads();
        if (F.tid < 192) { const int r = F.tid >> 6, c2 = F.tid & 63; float s = 0.f;
#pragma unroll
            for (int q = 0; q < 8; ++q) s += red[(q * 3 + r) * 64 + c2];
            ((float*)(F.ws + WS_MOD))[((size_t)l * 3 + r) * 12288 + n0 + c2] = s + AV.in(I_BMOD)[(size_t)l * 12288 + n0 + c2]; }
        __syncthreads();
    }
}

__device__ __forceinline__ void conv_item(const float* W, int ldw, int k0, int srccol, f16* WT, int dstrow0, int ldk, LAS unsigned char* xl, int lane) {
    float v[64];
    const float* src = W + (size_t)k0 * ldw + (srccol >= 0 ? srccol : 0);
#pragma unroll
    for (int k = 0; k < 64; ++k) v[k] = src[(size_t)k * ldw];
#pragma unroll
    for (int k = 0; k < 64; k += 8) PIN8(v[k], v[k + 1], v[k + 2], v[k + 3], v[k + 4], v[k + 5], v[k + 6], v[k + 7]);
    const int sw = (lane >> 1) & 7;
#pragma unroll
    for (int kg = 0; kg < 8; ++kg) { f16x8 o;
#pragma unroll
        for (int e = 0; e < 8; ++e) o[e] = srccol >= 0 ? (f16)v[8 * kg + e] : (f16)0.f;
        o = pg8::lowtog8(o);
        *(LAS f16x8*)(xl + lane * 128 + ((kg ^ sw) << 4)) = o; }
    __builtin_amdgcn_wave_barrier();
    f16* dst = WT + (size_t)dstrow0 * ldk + k0 + 8 * (lane & 7);
#pragma unroll
    for (int i = 0; i < 8; ++i) { const int r = 8 * i + (lane >> 3);
        const f16x8 o = *(LAS f16x8*)(xl + r * 128 + (((lane & 7) ^ ((r >> 1) & 7)) << 4));
        *(f16x8*)(dst + (size_t)r * ldk) = o; }
    __builtin_amdgcn_wave_barrier();
}
#ifndef CONV_KW
#define CONV_KW 8
#endif
__device__ __forceinline__ void conv_decode(int r, int NB, int& kb, int& nb) {
    if (CONV_KW == 1) { kb = r / NB; nb = r % NB; }
    else { constexpr int KW = CONV_KW, NW = 8 / KW; const int g = r >> 3, w = r & 7, gn = NB / NW, gnb = g % gn, gkb = g / gn; kb = gkb * KW + (w % KW); nb = gnb * NW + (w / KW); }
}
__device__ __forceinline__ void ph_convert_weights(const Ctx& F, const ArgsV& AV, int l) {
    const int skip = F.G > 64 ? 32 : 0;
    if (F.bid < skip) return;
    const int gw = (F.bid - skip) * 8 + F.wave, NGW = (F.G - skip) * 8, lane = F.lane;
    LAS unsigned char* xl = F.lds + F.wave * 8192;
    constexpr int I_IN = 32 * 180, I_GLU = 8 * 8, I_BR = 32 * 32, I_OUT = 32 * 32, I_UP = 32 * 176, I_DN = 88 * 32;
    constexpr int NIT = I_IN + I_GLU + I_BR + I_OUT + I_UP + I_DN;
    for (int it = gw; it < NIT; it += NGW) {
        int r = it;
        if (r < I_IN) { int kb, nb; conv_decode(r, 180, kb, nb); const int j = nb * 64 + lane;
            const int src = j < 2048 ? j : (j < 11264 ? j + 32 : (j < 11296 ? 2048 + (j - 11264) : -1));
            conv_item(AV.in(I_WIN) + (size_t)l * 2048 * INW, INW, kb * 64, src, (f16*)(F.ws + WS_WIN), nb * 64, 2048, xl, lane); continue; } r -= I_IN;
        if (r < I_GLU) { int kb, nb; conv_decode(r, 8, kb, nb); const int j = nb * 64 + lane; conv_item(AV.in(I_GLUW) + (size_t)l * 512 * 512, 512, kb * 64, j, (f16*)(F.ws + WS_WGLU), nb * 64, 512, xl, lane); continue; } r -= I_GLU;
        if (r < I_BR) { int kb, nb; conv_decode(r, 32, kb, nb); const int j = nb * 64 + lane; conv_item(AV.in(I_WBR) + (size_t)l * 2048 * 2048, 2048, kb * 64, j, (f16*)(F.ws + WS_WBR), nb * 64, 2048, xl, lane); continue; } r -= I_BR;
        if (r < I_OUT) { int kb, nb; conv_decode(r, 32, kb, nb); const int j = nb * 64 + lane; conv_item(AV.in(I_WOUT) + (size_t)l * 2048 * 2048, 2048, kb * 64, j, (f16*)(F.ws + WS_WOUT), nb * 64, 2048, xl, lane); continue; } r -= I_OUT;
        if (r < I_UP) { int kb, nb; conv_decode(r, 176, kb, nb); const int j = nb * 64 + lane, pn = j >> 8, i = j & 255; const int src = i < 128 ? 128 * pn + i : FFH + 128 * pn + (i - 128);
            conv_item(AV.in(I_WUP) + (size_t)l * 2048 * UPLD, UPLD, kb * 64, src, (f16*)(F.ws + WS_WUP), nb * 64, 2048, xl, lane); continue; } r -= I_UP;
        { int kb, nb; conv_decode(r, 32, kb, nb); const int j = nb * 64 + lane; conv_item(AV.in(I_WDN) + (size_t)l * FFH * 2048, 2048, kb * 64, j, (f16*)(F.ws + WS_WDN), nb * 64, FFH, xl, lane); }
    }
}

__device__ __forceinline__ void s5_mats_group(const Ctx& F, const ArgsV& AV, int l, int g) {
    LAS f32x2* APOW = (LAS f32x2*)F.lds;
    LAS f32x2* BBAR = APOW + 2 * 17 * 64;
    LAS f32x2* CM = BBAR + 2 * 64 * 16;
    LAS float* KLAG = (LAS float*)(CM + 2 * 16 * 64);
    __syncthreads();
    for (int i = F.tid; i < 2 * 17 * 64; i += 512) { const int d = i / (17 * 64), e = (i / 64) % 17, n = i % 64;
        const size_t pi = (((size_t)l * 2 + d) * 32 + g) * 64 + n;
        const float are = AV.in(I_S5ARE)[pi], aim = AV.in(I_S5AIM)[pi], dt = expf(AV.in(I_S5STEP)[((size_t)l * 2 + d) * 32 + g]);
        const float zr = are * dt * (float)e, zi = aim * dt * (float)e; float s, c; sincosf(zi, &s, &c); const float m = expf(zr);
        APOW[i] = (f32x2){m * c, m * s}; }
    __syncthreads();
    for (int i = F.tid; i < 2 * 64 * 16; i += 512) { const int d = i / 1024, n = (i / 16) % 64, h = i % 16;
        const size_t pi = (((size_t)l * 2 + d) * 32 + g) * 64 + n;
        const float are = AV.in(I_S5ARE)[pi], aim = AV.in(I_S5AIM)[pi];
        const f32x2 ab = APOW[(d * 17 + 1) * 64 + n]; const f32x2 num = (f32x2){ab.x - 1.0f, ab.y};
        const float den = are * are + aim * aim; const f32x2 q = (f32x2){(num.x * are + num.y * aim) / den, (num.y * are - num.x * aim) / den};
        const size_t bi = (pi * 16) + h;
        BBAR[i] = cmul(q, (f32x2){AV.in(I_S5BRE)[bi], AV.in(I_S5BIM)[bi]});
        const size_t ci = ((((size_t)l * 2 + d) * 32 + g) * 16 + h) * 64 + n;
        CM[(d * 16 + h) * 64 + n] = (f32x2){AV.in(I_S5CRE)[ci], AV.in(I_S5CIM)[ci]}; }
    __syncthreads();
    for (int i = F.tid; i < 2 * 16 * 256; i += 512) { const int d = i / 4096, lag = (i / 256) % 16, h = (i / 16) % 16, hp = i % 16; float s = 0.f;
        for (int n = 0; n < 64; ++n) { const f32x2 t = cmul(CM[(d * 16 + h) * 64 + n], APOW[(d * 17 + lag) * 64 + n]); const f32x2 b = BBAR[(d * 64 + n) * 16 + hp]; s += t.x * b.x - t.y * b.y; }
        KLAG[i] = s; }
    __syncthreads();
    f16* W = (f16*)(F.ws + WS_S5W) + (size_t)g * 256 * 512;
    for (int i = F.tid; i < 256 * 64; i += 512) { const int n = i / 64, k8 = (i % 64) * 8, t = n >> 4, h = n & 15; f16x8 o;
#pragma unroll
        for (int e = 0; e < 8; ++e) { const int k = k8 + e; float v;
            if (k < 256) { const int s = k >> 4, hp = k & 15; v = 0.f;
                if (t >= s) v += KLAG[((0 * 16 + (t - s)) * 16 + h) * 16 + hp];
                if (s >= t) v += KLAG[((1 * 16 + (s - t)) * 16 + h) * 16 + hp];
                v *= S5SCALE; }
            else { const int d = (k - 256) >> 7, nn2 = (k - 256) & 127, nn = nn2 & 63, im = nn2 >> 6, ex = d == 0 ? t + 1 : 16 - t;
                const f32x2 z = cmul(CM[(d * 16 + h) * 64 + nn], APOW[(d * 17 + ex) * 64 + nn]); v = im ? -z.y : z.x; }
            o[e] = (f16)v; }
        *(f16x8*)(W + (size_t)n * 512 + k8) = o; }
    f16* Mx = (f16*)(F.ws + WS_S5M) + (size_t)g * 256 * 256;
    for (int i = F.tid; i < 256 * 32; i += 512) { const int n = i / 32, k8 = (i % 32) * 8, d = n >> 7, ri = (n >> 6) & 1, nn = n & 63; f16x8 o;
#pragma unroll
        for (int e = 0; e < 8; ++e) { const int k = k8 + e, s = k >> 4, hp = k & 15, ex = d == 0 ? 15 - s : s;
            const f32x2 z = cmul(APOW[(d * 17 + ex) * 64 + nn], BBAR[(d * 64 + nn) * 16 + hp]); o[e] = (f16)((ri ? z.y : z.x) * S5SCALE); }
        *(f16x8*)(Mx + (size_t)n * 256 + k8) = o; }
    if (F.tid < 128) { const int d = F.tid >> 6, nn = F.tid & 63; ((f32x2*)(F.ws + WS_S5AT))[(d * 32 + g) * 64 + nn] = APOW[(d * 17 + 16) * 64 + nn]; }
    __syncthreads();
}

__device__ __forceinline__ float rlane(float v, int i) { return __builtin_bit_cast(float, __builtin_amdgcn_readlane(__builtin_bit_cast(int, v), i)); }
__device__ __forceinline__ void ph_hyena_h2(const Ctx& F, const ArgsV& AV, int l) {
    const int j = F.lane;
    float w1[33], w2[64];
    { const float* p1 = AV.in(I_HYW1) + (size_t)l * 33 * 64 + j; const float* p2 = AV.in(I_HYW2) + (size_t)l * 4096 + j;
#pragma unroll
      for (int i = 0; i < 33; ++i) w1[i] = p1[i * 64];
#pragma unroll
      for (int i = 0; i < 64; ++i) w2[i] = p2[i * 64]; }
    const float b1 = AV.in(I_HYB1)[l * 64 + j], f1 = AV.in(I_HYF1)[l * 64 + j], b2 = AV.in(I_HYB2)[l * 64 + j], f2 = AV.in(I_HYF2)[l * 64 + j];
    const int gw = F.bid * 8 + F.wave, NGW = F.G * 8;
    for (int p = gw; p < SEQ + LC; p += NGW) {
        const int n = p < SEQ ? SEQ : LC, pos = p < SEQ ? p : p - SEQ;
        float feat = 0.f;
        if (j == 0) feat = (float)pos / (float)(n - 1);
        else if (j < 33) { const int fi = (j - 1) & 15; const float fr = 1e-4f + (float)fi * ((15.0f - 1e-4f) / 15.0f);
            const float ang = (6.283185307179586f / (float)n) * (float)pos * fr; float s, c; sincosf(ang, &s, &c); feat = j < 17 ? c : -s; }
        float a = b1;
#pragma unroll
        for (int i = 0; i < 33; ++i) a += rlane(feat, i) * w1[i];
        const float h1 = sinf(f1 * a);
        float b = b2;
#pragma unroll
        for (int i = 0; i < 64; ++i) b += rlane(h1, i) * w2[i];
        ((f16*)(F.ws + WS_H2H))[((size_t)l * (SEQ + LC) + p) * 64 + j] = (f16)sinf(f2 * b);
    }
}

__device__ __forceinline__ void ph_norm(const Ctx& F, const ArgsV& AV, int l, int which, int nrows, int nslab) {
    const int gw = F.bid * 8 + F.wave, NGW = F.G * 8;
    float* X = (float*)(F.ws + WS_XRES); f16* O = (f16*)(F.ws + WS_HN); const float* SL = (const float*)(F.ws + WS_SLAB);
    const float* Xin = (l == 0 && which == 0) ? AV.in(I_X) : X;
    const float* gain = AV.in(which ? I_N2G : I_N1G) + (size_t)l * D;
    const float* mod = (const float*)(F.ws + WS_MOD) + (size_t)l * 3 * 12288;
    const int shoff = which ? 6144 : 0, soff = which ? 8192 : 2048;
    int cur_bsel = -1; f32x4 Am[8], Bm[8], vn[8];
    if (gw < nrows) { const f32x4* xr0 = (const f32x4*)((gw < MX ? Xin : X) + (size_t)gw * D) + F.lane;
#pragma unroll
        for (int j = 0; j < 8; ++j) vn[j] = xr0[64 * j]; }
    for (int m = gw; m < nrows; m += NGW) {
        const int bsel = m < SEQ ? 0 : (m < MX ? 1 : 2);
        f32x4* xr = (f32x4*)(X + (size_t)m * D) + F.lane;
        f32x4 v[8]; float s = 0.f;
        PIN8(vn[0], vn[1], vn[2], vn[3], vn[4], vn[5], vn[6], vn[7]);
#pragma unroll
        for (int j = 0; j < 8; ++j) v[j] = vn[j];
        if (m + NGW < nrows) { const f32x4* xq = (const f32x4*)((m + NGW < MX ? Xin : X) + (size_t)(m + NGW) * D) + F.lane;
#pragma unroll
            for (int j = 0; j < 8; ++j) vn[j] = xq[64 * j]; }
        if (bsel != cur_bsel) { cur_bsel = bsel; const float* mp = mod + bsel * 12288;
#pragma unroll
            for (int j = 0; j < 8; ++j) { const int c = 4 * F.lane + 256 * j; const f32x4 g = *(const f32x4*)(gain + c), sc = *(const f32x4*)(mp + soff + c); Bm[j] = *(const f32x4*)(mp + shoff + c); Am[j] = g * (sc + 1.0f); }
            PIN8(Am[0], Am[1], Am[2], Am[3], Am[4], Am[5], Am[6], Am[7]); PIN8(Bm[0], Bm[1], Bm[2], Bm[3], Bm[4], Bm[5], Bm[6], Bm[7]); }
        if (m >= MX && nslab > 0) {
            for (int sl = 0; sl < nslab; ++sl) { const f32x4* sr = (const f32x4*)(SL + ((size_t)sl * MC + (m - MX)) * D) + F.lane;
#pragma unroll
                for (int j = 0; j < 8; ++j) v[j] = v[j] + sr[64 * j]; }
#pragma unroll
            for (int j = 0; j < 8; ++j) xr[64 * j] = v[j]; }
#pragma unroll
        for (int j = 0; j < 8; ++j) s += (v[j].x * v[j].x + v[j].y * v[j].y) + (v[j].z * v[j].z + v[j].w * v[j].w);
        const float rstd = __builtin_amdgcn_rsqf(wave_sum(s) * (1.0f / D) + EPS);
#pragma unroll
        for (int j = 0; j < 8; ++j) { const int c = 4 * F.lane + 256 * j;
            f16x4 o;
#pragma unroll
            for (int e = 0; e < 4; ++e) o[e] = lowtog((f16)(v[j][e] * rstd * Am[j][e] + Bm[j][e]));
            *(f16x4*)(O + (size_t)m * D + c) = o; }
    }
}
__device__ __forceinline__ void ph_final_norm(const Ctx& F, const ArgsV& AV) {
    const int gw = F.bid * 8 + F.wave, NGW = F.G * 8;
    const float* X = (const float*)(F.ws + WS_XRES); const float* gain = AV.in(I_FNG);
    f32x4 gm[8], vn[8];
#pragma unroll
    for (int j = 0; j < 8; ++j) gm[j] = *(const f32x4*)(gain + 4 * F.lane + 256 * j);
    if (gw < MX) { const f32x4* xr0 = (const f32x4*)(X + (size_t)gw * D) + F.lane;
#pragma unroll
        for (int j = 0; j < 8; ++j) vn[j] = xr0[64 * j]; }
    for (int m = gw; m < MX; m += NGW) {
        f32x4 v[8]; float s = 0.f;
        PIN8(vn[0], vn[1], vn[2], vn[3], vn[4], vn[5], vn[6], vn[7]);
#pragma unroll
        for (int j = 0; j < 8; ++j) v[j] = vn[j];
        if (m + NGW < MX) { const f32x4* xq = (const f32x4*)(X + (size_t)(m + NGW) * D) + F.lane;
#pragma unroll
            for (int j = 0; j < 8; ++j) vn[j] = xq[64 * j]; }
#pragma unroll
        for (int j = 0; j < 8; ++j) s += (v[j].x * v[j].x + v[j].y * v[j].y) + (v[j].z * v[j].z + v[j].w * v[j].w);
        const float rstd = __builtin_amdgcn_rsqf(wave_sum(s) * (1.0f / D) + EPS);
#pragma unroll
        for (int j = 0; j < 8; ++j) { const int c = 4 * F.lane + 256 * j;
            *(f32x4*)(AV.out + (size_t)m * D + c) = v[j] * rstd * gm[j]; }
    }
}

__device__ __forceinline__ void ph_s5_scan(const Ctx& F) {
    if (F.tid >= 32) return;
    const float* S = (const float*)(F.ws + WS_S5S); f16* SA = (f16*)(F.ws + WS_S5A);
    for (int gt = F.bid * 32 + F.tid; gt < 2 * 2 * 32 * 64; gt += F.G * 32) {
        const int nn = gt & 63, g = (gt >> 6) & 31, d = (gt >> 11) & 1, b = gt >> 12;
        const f32x2 at = ((const f32x2*)(F.ws + WS_S5AT))[(d * 32 + g) * 64 + nn];
        f32x2 st = (f32x2){0.f, 0.f};
        f32x2 la[16], lb[16];
#define S5_CHUNK(step) ((d == 0) ? ((step) < 16 ? 1024 + b * 16 + (step) : b * 512 + ((step) - 16)) : ((step) < 16 ? 1024 + b * 16 + (15 - (step)) : b * 512 + (511 - ((step) - 16))))
#define S5_LOAD(dst, base) do { _Pragma("unroll") for (int u = 0; u < 16; ++u) { const int stp = (base) + u < 528 ? (base) + u : 527; const size_t so = ((size_t)S5_CHUNK(stp) * 32 + g) * 256 + d * 128 + nn; dst[u] = (f32x2){S[so], S[so + 64]}; } } while (0)
#define S5_STEP(src, base) do { PIN8(src[0], src[1], src[2], src[3], src[4], src[5], src[6], src[7]); PIN8(src[8], src[9], src[10], src[11], src[12], src[13], src[14], src[15]); \
            _Pragma("unroll") for (int u = 0; u < 16; ++u) { f16* xp = SA + (size_t)S5_CHUNK((base) + u) * 16384 + (size_t)g * 512 + 256 + d * 128 + nn; xp[0] = (f16)st.x; xp[64] = (f16)st.y; st = cmul(at, st) + src[u]; } } while (0)
        S5_LOAD(la, 0);
        for (int base = 0; base < 528; base += 32) {
            S5_LOAD(lb, base + 16);
            S5_STEP(la, base);
            if (base + 16 < 528) { S5_LOAD(la, base + 32); S5_STEP(lb, base + 16); }
        }
#undef S5_CHUNK
#undef S5_LOAD
#undef S5_STEP
    }
}

__device__ __forceinline__ void ph_ffn_fix(const Ctx& F, const ArgsV& AV, int l, int nMr) {
    const float* HALO = (const float*)(F.ws + WS_HALO); f16* ACT = (f16*)(F.ws + WS_ACT);
    const float* cw = AV.in(I_FFCW) + (size_t)l * 3 * FFH; const float* cb = AV.in(I_FFCB) + (size_t)l * FFH;
    const int NT = nMr * 44 * 2 * 128;
    for (int task = F.bid * 512 + F.tid; task < NT; task += F.G * 512) {
        const int c = task & 127, which = (task >> 7) & 1, tile = task >> 8, pn = tile % 44, pm = tile / 44;
        const float* h = HALO + ((size_t)pm * 44 + pn) * 768 + c; const int col = pn * 128 + c;
        const bool first = (pm == 0 || pm == 32 || pm >= 64), last = (pm == 31 || pm >= 63);
        float ap, ac, an, b;
        if (which == 0) { ap = first ? 0.f : HALO[((size_t)(pm - 1) * 44 + pn) * 768 + 3 * 128 + c]; ac = h[0]; an = h[128]; b = h[4 * 128]; }
        else { ap = h[2 * 128]; ac = h[3 * 128]; an = last ? 0.f : HALO[((size_t)(pm + 1) * 44 + pn) * 768 + c]; b = h[5 * 128]; }
        const float a = cw[col] * ap + cw[FFH + col] * ac + cw[2 * FFH + col] * an + cb[col];
        ACT[(size_t)(pm * 256 + (which ? 255 : 0)) * FFH + col] = (f16)(siluf_(a) * b);
    }
}

namespace gla {
constexpr int QK_LD = 136, KH_LD = 72, VT_LD = 72, P_LD = 72;
constexpr int OFF_QT = 0;
constexpr int OFF_KT = 17408;
constexpr int OFF_VT = OFF_KT + 18432;
constexpr int OFF_P = OFF_VT + 36864;
constexpr int OFF_LR = OFF_P + 9216;
constexpr int OFF_GT = OFF_LR + 4096;
constexpr int OFF_DEC = OFF_GT + 2048;
constexpr int OFF_RS = OFF_DEC + 512;
constexpr int OFF_QR = OFF_RS + 2048;
constexpr int OFF_KR = OFF_QR + 17408;
constexpr int OFF_WG = OFF_KR + 17408;
static_assert(OFF_WG + 8192 <= LDSCTL_OFF, "gla lds");

__device__ __forceinline__ int grow(int b, int sc, int j, int i) {
    if (sc < 32) { const int col = 2 * sc + (j >> 1), r = (j & 1) * 64 + i; return b * SEQ + r * 64 + col; }
    return MX + b * LC + j * 64 + i;
}
__device__ __forceinline__ int prow(int b, int sc, int j, int i) {
    return sc < 32 ? b * SEQ + sc * 256 + j * 64 + i : MX + b * LC + j * 64 + i;
}
#define GLA_MFMA(a, b, c) __builtin_amdgcn_mfma_f32_16x16x32_f16(a, b, c, 0, 0, 0)

template <bool FULL>
__device__ __forceinline__ void gla_unit(const Ctx& F, const ArgsV& AV, int l, int unit, int d0 = 0, int d1 = 2) {
    const int b = unit / (4 * NSC), h = (unit / NSC) % 4, sc = unit % NSC;
    LAS f16* QT = (LAS f16*)(F.lds + OFF_QT); LAS f16* KT = (LAS f16*)(F.lds + OFF_KT); LAS f16* VT = (LAS f16*)(F.lds + OFF_VT);
    LAS f16* PP = (LAS f16*)(F.lds + OFF_P); LAS f16* LR = (LAS f16*)(F.lds + OFF_LR);
    LAS float* GT = (LAS float*)(F.lds + OFF_GT); LAS float* DEC = (LAS float*)(F.lds + OFF_DEC); LAS float* RS = (LAS float*)(F.lds + OFF_RS);
    LAS f16* QR = (LAS f16*)(F.lds + OFF_QR); LAS f16* KR = (LAS f16*)(F.lds + OFF_KR); LAS float* WG = (LAS float*)(F.lds + OFF_WG);
    const int tid = F.tid, lane = F.lane, w = F.wave, q0 = lane >> 4, c0 = lane & 15;
    const int dk0 = tid & 127, ig0 = tid >> 7;
    const f16* PX = (const f16*)(F.ws + WS_PX);
    const float scale = 0.08838834764831845f;
    for (int dir = d0; dir < d1; ++dir) {
        __syncthreads();
        for (int i = tid; i < 16 * 128; i += 512) WG[i] = AV.in(I_GLAWG)[(((size_t)l * 2 + dir) * 16 + (i >> 7)) * 512 + h * 128 + (i & 127)];
        const float bgv = AV.in(I_GLABG)[((size_t)l * 2 + dir) * 512 + h * 128 + dk0];
        float wgr[16];
#pragma unroll
        for (int r = 0; r < 16; ++r) wgr[r] = AV.in(I_GLAWG)[(((size_t)l * 2 + dir) * 16 + r) * 512 + h * 128 + dk0];
        const size_t sidx = ((((size_t)b * 4 + h) * NSC + sc) * 2 + dir);
        f32x4 accS[8][2];
        if (FULL && sc < 32) { const float* Sin = (const float*)(F.ws + WS_GSIN) + sidx * 32768; const int q = opq(q0), c = opq(c0);
#pragma unroll
            for (int dt = 0; dt < 8; ++dt)
#pragma unroll
                for (int et = 0; et < 2; ++et)
#pragma unroll
                    for (int r = 0; r < 4; ++r) accS[dt][et][r] = Sin[(16 * dt + 4 * q + r) * 256 + 32 * w + 16 * et + c];
            PIN8(accS[0][0], accS[0][1], accS[1][0], accS[1][1], accS[2][0], accS[2][1], accS[3][0], accS[3][1]); PIN8(accS[4][0], accS[4][1], accS[5][0], accS[5][1], accS[6][0], accS[6][1], accS[7][0], accS[7][1]); }
        else {
#pragma unroll
            for (int dt = 0; dt < 8; ++dt)
#pragma unroll
                for (int et = 0; et < 2; ++et) accS[dt][et] = (f32x4){0.f, 0.f, 0.f, 0.f}; }
        float sumtot = 0.f;
#define GLA_FETCH(jn) f16x8 pf_lr, pf_v[4], pf_k[2], pf_q[2]; do { const int tf = opq(F.tid); \
            { const int row = (tf & 255) >> 2, part = tf & 3; pf_lr = *(const f16x8*)(PX + (size_t)prow(b, sc, (jn), row) * PXLD + P_GG + part * 8); } \
            _Pragma("unroll") for (int k = 0; k < 4; ++k) { const int idx = tf + 512 * k, wi = idx >> 6, ln = idx & 63, rr = ln >> 2, cc = ln & 3; const int row = (wi & 3) * 16 + rr, chunk = (wi >> 2) * 4 + cc; \
                pf_v[k] = *(const f16x8*)(PX + (size_t)prow(b, sc, (jn), row) * PXLD + P_GV + h * 256 + chunk * 8); } \
            _Pragma("unroll") for (int k = 0; k < 2; ++k) { const int idx = tf + 512 * k, row = idx >> 4, ch = idx & 15; const size_t ro = (size_t)prow(b, sc, (jn), row) * PXLD; \
                pf_k[k] = *(const f16x8*)(PX + ro + P_GK + h * 128 + ch * 8); if (FULL) pf_q[k] = *(const f16x8*)(PX + ro + P_GQ + h * 128 + ch * 8); else pf_q[k] = pf_k[k]; } } while (0)
        for (int jj = 0; jj < 4; ++jj) {
            const int j = dir ? 3 - jj : jj;
            {
            GLA_FETCH(j);
            __syncthreads();
            const int tid = opq(F.tid);
            PIN8(pf_lr, pf_v[0], pf_v[1], pf_v[2], pf_v[3], pf_k[0], pf_k[1], pf_q[0]); asm volatile("" : "+v"(pf_q[1]));
            if (tid < 256) { const int row = tid >> 2, part = tid & 3; *(LAS f16x8*)(LR + row * 32 + part * 8) = pf_lr; }
#pragma unroll
            for (int k = 0; k < 4; ++k) { const int idx = opq(tid) + 512 * k, wi = idx >> 6, ln = idx & 63, rr = ln >> 2, cc = ln & 3;
                const int row = (wi & 3) * 16 + rr, chunk = (wi >> 2) * 4 + cc; LAS f16* vp = VT + (chunk * 8) * VT_LD + row;
#pragma unroll
                for (int e = 0; e < 8; ++e) vp[e * VT_LD] = pf_v[k][e]; }
#pragma unroll
            for (int k = 0; k < 2; ++k) { const int idx = tid + 512 * k, row = idx >> 4, ch = idx & 15;
                *(LAS f16x8*)(KR + row * QK_LD + ch * 8) = pf_k[k];
                if (FULL) *(LAS f16x8*)(QR + row * QK_LD + ch * 8) = pf_q[k]; }
            }
            __syncthreads();
            const int dk = opq(dk0), ig = opq(ig0);
            float bv[16];
#pragma unroll
            for (int ii = 0; ii < 16; ++ii) { const int i = ig * 16 + ii; float pre = bgv;
                const f16x8 l0 = *(const LAS f16x8*)(LR + i * 32 + dir * 16), l1 = *(const LAS f16x8*)(LR + i * 32 + dir * 16 + 8);
#pragma unroll
                for (int r = 0; r < 8; ++r) pre += (float)l0[r] * wgr[r] + (float)l1[r] * wgr[8 + r];
                bv[ii] = logsigmoidf_(pre) * (1.0f / 16.0f); }
            float totloc;
            if (dir == 0) {
#pragma unroll
                for (int ii = 1; ii < 16; ++ii) bv[ii] += bv[ii - 1];
                totloc = bv[15]; }
            else {
#pragma unroll
                for (int ii = 14; ii >= 0; --ii) bv[ii] += bv[ii + 1];
                totloc = bv[0]; }
            GT[ig * 128 + dk] = totloc;
            __syncthreads();
            const float g0 = GT[dk], g1 = GT[128 + dk], g2 = GT[256 + dk], g3 = GT[384 + dk];
            const float total = (g0 + g1) + (g2 + g3);
            float off, bmid;
            if (dir == 0) { off = (ig > 0 ? g0 : 0.f) + (ig > 1 ? g1 : 0.f) + (ig > 2 ? g2 : 0.f); bmid = g0 + g1; }
            else { off = (ig < 3 ? g3 : 0.f) + (ig < 2 ? g2 : 0.f) + (ig < 1 ? g1 : 0.f); bmid = g2 + g3; }
#pragma unroll
            for (int ii = 0; ii < 16; ++ii) bv[ii] += off;
            if (FULL) {
#pragma unroll
                for (int ii = 0; ii < 16; ++ii) { const int i = ig * 16 + ii;
                    QT[i * QK_LD + dk] = (f16)((float)QR[i * QK_LD + dk] * scale * __expf(fminf(bv[ii] - bmid, 9.f)));
                    KT[i * QK_LD + dk] = (f16)((float)KR[i * QK_LD + dk] * __expf(fminf(bmid - bv[ii], 9.f))); }
                __syncthreads();
                { const int c = opq(c0), q = opq(q0);
#pragma unroll
                for (int s = 0; s < 2; ++s) { const int T = 2 * w + s, it = T >> 2, jt = T & 3; f32x4 a = (f32x4){0.f, 0.f, 0.f, 0.f};
#pragma unroll
                    for (int kk = 0; kk < 4; ++kk) { const f16x8 kf = *(const LAS f16x8*)(KT + (jt * 16 + c) * QK_LD + kk * 32 + 8 * q);
                        const f16x8 qf = *(const LAS f16x8*)(QT + (it * 16 + c) * QK_LD + kk * 32 + 8 * q); a = GLA_MFMA(kf, qf, a); }
                    const int i = it * 16 + c; f16x4 pv;
#pragma unroll
                    for (int r = 0; r < 4; ++r) { const int jx = jt * 16 + 4 * q + r; const bool keep = dir == 0 ? (jx <= i) : (jx >= i); pv[r] = keep ? (f16)a[r] : (f16)0.f; }
                    *(LAS f16x4*)(PP + i * P_LD + jt * 16 + 4 * q) = pv; } }
                __syncthreads();
#pragma unroll
                for (int ii = 0; ii < 16; ++ii) { const int i = ig * 16 + ii; QT[i * QK_LD + dk] = (f16)((float)QR[i * QK_LD + dk] * scale * __expf(bv[ii])); }
            }
            { f16x8 k0, k1;
#pragma unroll
              for (int ii = 0; ii < 8; ++ii) { k0[ii] = (f16)((float)KR[(ig * 16 + ii) * QK_LD + dk] * __expf(total - bv[ii])); k1[ii] = (f16)((float)KR[(ig * 16 + 8 + ii) * QK_LD + dk] * __expf(total - bv[8 + ii])); }
              *(LAS f16x8*)(KT + dk * KH_LD + ig * 16) = k0; *(LAS f16x8*)(KT + dk * KH_LD + ig * 16 + 8) = k1; }
            if (ig == 0) { DEC[dk] = __expf(total); sumtot += total; }
            __syncthreads();
            const int c = opq(c0), q = opq(q0);
            if (FULL) {
                f32x4 accO[4][2];
#pragma unroll
                for (int it = 0; it < 4; ++it)
#pragma unroll
                    for (int et = 0; et < 2; ++et) accO[it][et] = (f32x4){0.f, 0.f, 0.f, 0.f};
#pragma unroll
                for (int et = 0; et < 2; ++et)
#pragma unroll
                    for (int kk = 0; kk < 2; ++kk) { const f16x8 vf = *(const LAS f16x8*)(VT + (32 * w + 16 * et + c) * VT_LD + kk * 32 + 8 * q);
#pragma unroll
                        for (int it = 0; it < 4; ++it) { const f16x8 pf = *(const LAS f16x8*)(PP + (it * 16 + c) * P_LD + kk * 32 + 8 * q); accO[it][et] = GLA_MFMA(vf, pf, accO[it][et]); } asm volatile("" ::: "memory"); }
#pragma unroll
                for (int kb = 0; kb < 4; ++kb)
#pragma unroll
                    for (int et = 0; et < 2; ++et) { f16x8 sf; asm volatile("" ::: "memory");
#pragma unroll
                        for (int e = 0; e < 4; ++e) { sf[e] = (f16)accS[2 * kb][et][e]; sf[4 + e] = (f16)accS[2 * kb + 1][et][e]; }
#pragma unroll
                        for (int it = 0; it < 4; ++it) { const f16x4 lo = *(const LAS f16x4*)(QT + (it * 16 + c) * QK_LD + 32 * kb + 4 * q), hi = *(const LAS f16x4*)(QT + (it * 16 + c) * QK_LD + 32 * kb + 16 + 4 * q);
                            f16x8 qf; qf[0] = lo[0]; qf[1] = lo[1]; qf[2] = lo[2]; qf[3] = lo[3]; qf[4] = hi[0]; qf[5] = hi[1]; qf[6] = hi[2]; qf[7] = hi[3];
                            accO[it][et] = GLA_MFMA(sf, qf, accO[it][et]); } }
                float* OF = (float*)(F.ws + WS_GOF);
                if (dir == 0) {
#pragma unroll
                    for (int it = 0; it < 4; ++it) { const int gr = prow(b, sc, j, it * 16 + c);
#pragma unroll
                        for (int et = 0; et < 2; ++et) *(f32x4*)(OF + (size_t)gr * 1024 + h * 256 + 32 * w + 16 * et + 4 * q) = accO[it][et];
                        asm volatile("" ::: "memory"); } }
                else {
                    int grs[4]; f32x4 ofv[4][2]; f16x4 rvv[4][2];
#pragma unroll
                    for (int it = 0; it < 4; ++it) { grs[it] = prow(b, sc, j, it * 16 + c);
#pragma unroll
                        for (int et = 0; et < 2; ++et) { ofv[it][et] = *(const f32x4*)(OF + (size_t)grs[it] * 1024 + h * 256 + 32 * w + 16 * et + 4 * q);
                            rvv[it][et] = *(const f16x4*)(PX + (size_t)grs[it] * PXLD + P_GR + h * 256 + 32 * w + 16 * et + 4 * q); } }
                    PIN8(ofv[0][0], ofv[0][1], ofv[1][0], ofv[1][1], ofv[2][0], ofv[2][1], ofv[3][0], ofv[3][1]);
#pragma unroll
                    for (int it = 0; it < 4; ++it) { float ss = 0.f;
#pragma unroll
                        for (int et = 0; et < 2; ++et) { accO[it][et] = accO[it][et] + ofv[it][et];
                            ss += (accO[it][et][0] * accO[it][et][0] + accO[it][et][1] * accO[it][et][1]) + (accO[it][et][2] * accO[it][et][2] + accO[it][et][3] * accO[it][et][3]); }
                        ss += __shfl_xor(ss, 16); ss += __shfl_xor(ss, 32);
                        if (q == 0) RS[(it * 16 + c) * 8 + w] = ss; }
                    __syncthreads();
                    PIN8(rvv[0][0], rvv[0][1], rvv[1][0], rvv[1][1], rvv[2][0], rvv[2][1], rvv[3][0], rvv[3][1]);
                    const float* ng = AV.in(I_GLANG) + (size_t)l * 256;
                    f16* Y = (f16*)(F.ws + WS_YCAT);
#pragma unroll
                    for (int it = 0; it < 4; ++it) { const int i = it * 16 + c; const f32x4 ra = *(const LAS f32x4*)(RS + i * 8), rb = *(const LAS f32x4*)(RS + i * 8 + 4);
                        const float tot = ((ra[0] + ra[1]) + (ra[2] + ra[3])) + ((rb[0] + rb[1]) + (rb[2] + rb[3]));
                        const float rstd = __builtin_amdgcn_rsqf(tot * (1.0f / 256.0f) + EPS);
#pragma unroll
                        for (int et = 0; et < 2; ++et) { const int e0 = 32 * w + 16 * et + 4 * q;
                            const f32x4 gv = *(const f32x4*)(ng + e0);
                            f16x4 o;
#pragma unroll
                            for (int r = 0; r < 4; ++r) o[r] = lowtog((f16)(accO[it][et][r] * rstd * gv[r] * siluf_((float)rvv[it][et][r])));
                            *(f16x4*)(Y + (size_t)grow(b, sc, j, it * 16 + c) * 2048 + 1024 + h * 256 + e0) = o; } }
                }
            }
#pragma unroll
            for (int dt = 0; dt < 8; ++dt) { const f32x4 dv = *(const LAS f32x4*)(DEC + 16 * dt + 4 * q);
#pragma unroll
                for (int et = 0; et < 2; ++et) accS[dt][et] = accS[dt][et] * dv; }
#pragma unroll
            for (int kk = 0; kk < 2; ++kk) { f16x8 vf[2];
#pragma unroll
                for (int et = 0; et < 2; ++et) vf[et] = *(const LAS f16x8*)(VT + (32 * w + 16 * et + c) * VT_LD + kk * 32 + 8 * q);
#pragma unroll
                for (int dt = 0; dt < 8; ++dt) { const f16x8 kf = *(const LAS f16x8*)(KT + (16 * dt + c) * KH_LD + kk * 32 + 8 * q);
#pragma unroll
                    for (int et = 0; et < 2; ++et) accS[dt][et] = GLA_MFMA(kf, vf[et], accS[dt][et]); if (dt & 1) asm volatile("" ::: "memory"); } }
        }
        if (!FULL) { float* Sl = (float*)(F.ws + WS_GSLOC) + sidx * 32768; const int q = opq(q0), c = opq(c0);
#pragma unroll
            for (int dt = 0; dt < 8; ++dt)
#pragma unroll
                for (int et = 0; et < 2; ++et)
#pragma unroll
                    for (int r = 0; r < 4; ++r) Sl[(16 * dt + 4 * q + r) * 256 + 32 * w + 16 * et + c] = accS[dt][et][r];
            if (ig0 == 0) ((float*)(F.ws + WS_GDT))[sidx * 128 + dk0] = __expf(sumtot); }
        VM_WAIT();
    }
}
__device__ __forceinline__ void ph_gla_scan(const Ctx& F) {
    const float* Sl = (const float*)(F.ws + WS_GSLOC); float* Si = (float*)(F.ws + WS_GSIN); const float* Dt = (const float*)(F.ws + WS_GDT);
    if (F.tid < 64) return;
    for (int gt = F.bid * 448 + (F.tid - 64); gt < 2 * 4 * 2 * 32768; gt += F.G * 448) {
        const int e = gt & 32767, dir = (gt >> 15) & 1, h = (gt >> 16) & 3, b = gt >> 18;
        float S = 0.f;
        for (int base = 0; base < NSC; base += 11) {
            float sl[11], dt[11]; size_t ix[11];
#pragma unroll
            for (int u = 0; u < 11; ++u) { const int step = base + u; const int sc = step == 0 ? 32 : (dir == 0 ? step - 1 : 32 - step);
                const size_t idx = ((((size_t)b * 4 + h) * NSC + sc) * 2 + dir); ix[u] = idx;
                sl[u] = Sl[idx * 32768 + e]; dt[u] = Dt[idx * 128 + (e >> 8)]; }
            PIN8(sl[0], sl[1], sl[2], sl[3], sl[4], sl[5], sl[6], sl[7]); PIN8(dt[0], dt[1], dt[2], dt[3], dt[4], dt[5], dt[6], dt[7]); PIN4(sl[8], sl[9], sl[10], dt[8]); asm volatile("" : "+v"(dt[9]), "+v"(dt[10]));
#pragma unroll
            for (int u = 0; u < 11; ++u) { Si[ix[u] * 32768 + e] = S; S = dt[u] * S + sl[u]; }
        }
    }
}
#undef GLA_FETCH
#undef GLA_MFMA
}

namespace hy {
#define PADI(i) ((i) + ((i) >> 5))
constexpr int HY_BUF_BYTES = (16384 + 512) * 8;
constexpr int HY_SCR_OFF = HY_BUF_BYTES;
static_assert(HY_SCR_OFF + 2048 <= LDSCTL_OFF, "hyena lds");
__device__ __forceinline__ f32x2 twid(int k, float invN) { const float xr = (float)k * invN; return (f32x2){__builtin_amdgcn_cosf(xr), -__builtin_amdgcn_sinf(xr)}; }
__device__ __forceinline__ f32x2 mul_w16(f32x2 d, int a) {
    constexpr float c1 = 0.9238795325112867f, s1 = 0.3826834323650898f, r = 0.7071067811865476f;
    float c, s;
    switch (a & 15) {
        case 0: return d; case 4: return (f32x2){d.y, -d.x}; case 8: return (f32x2){-d.x, -d.y}; case 12: return (f32x2){-d.y, d.x};
        case 1: c = c1; s = s1; break; case 2: c = r; s = r; break; case 3: c = s1; s = c1; break;
        case 5: c = -s1; s = c1; break; case 6: c = -r; s = r; break; case 7: c = -c1; s = s1; break;
        case 9: c = -c1; s = -s1; break; case 10: c = -r; s = -r; break; case 11: c = -s1; s = -c1; break;
        case 13: c = s1; s = -c1; break; case 14: c = r; s = -r; break; default: c = c1; s = -s1; break; }
    return (f32x2){d.x * c + d.y * s, d.y * c - d.x * s};
}
template <int R, bool ZH = false> __device__ __forceinline__ void dif_pass(LAS f32x2* x, int m, int lh, int tid) {
    const int N = 1 << m; const float invN = 1.0f / (float)N; const int lg = lh - R + 1, g = 1 << lg, S = (N >> 1) >> lh;
    for (int q = tid; q < (N >> R); q += 512) { const int j = q & (g - 1), blk = q >> lg, base = (blk << (lh + 1)) + j;
        f32x2 v[1 << R];
#pragma unroll
        for (int k = 0; k < (1 << R); ++k) { if (ZH && k >= (1 << (R - 1))) v[k] = (f32x2){0.f, 0.f}; else v[k] = x[PADI(base + k * g)]; }
        f32x2 w = twid(j * S, invN);
#pragma unroll
        for (int s = 0; s < R; ++s) { const int half = 1 << (R - 1 - s);
#pragma unroll
            for (int k = 0; k < (1 << R); ++k) if (!(k & half)) { const f32x2 a = v[k], b = v[k + half]; v[k] = a + b;
                v[k + half] = mul_w16(cmul(a - b, w), ((k & (half - 1)) << s) * (16 >> R)); }
            w = cmul(w, w); }
#pragma unroll
        for (int k = 0; k < (1 << R); ++k) x[PADI(base + k * g)] = v[k]; }
    __syncthreads();
}
template <int R, bool LH = false> __device__ __forceinline__ void dit_pass(LAS f32x2* x, int m, int lh, int tid) {
    const int N = 1 << m; const float invN = 1.0f / (float)N; const int h = 1 << lh, S1 = (N >> 1) >> lh;
    for (int q = tid; q < (N >> R); q += 512) { const int j = q & (h - 1), blk = q >> lh, base = (blk << (lh + R)) + j;
        f32x2 v[1 << R];
#pragma unroll
        for (int k = 0; k < (1 << R); ++k) v[k] = x[PADI(base + k * h)];
        f32x2 wp[R]; wp[R - 1] = cconj(twid(j * (S1 >> (R - 1)), invN));
#pragma unroll
        for (int s = R - 2; s >= 0; --s) wp[s] = cmul(wp[s + 1], wp[s + 1]);
#pragma unroll
        for (int s = 0; s < R; ++s) { const int half = 1 << s;
#pragma unroll
            for (int k = 0; k < (1 << R); ++k) if (!(k & half)) { const f32x2 a = v[k];
                const f32x2 b = mul_w16(cmul(v[k + half], wp[s]), (16 - (k & (half - 1)) * (16 >> (s + 1))) & 15);
                v[k] = a + b; v[k + half] = a - b; } }
#pragma unroll
        for (int k = 0; k < (1 << R); ++k) if (!(LH && k >= (1 << (R - 1)))) x[PADI(base + k * h)] = v[k]; }
    __syncthreads();
}
template <bool ZH = false> __device__ __forceinline__ void fft_fwd(LAS f32x2* x, int m, int tid) {
    int lh = m - 1;
    if (ZH) { dif_pass<4, true>(x, m, lh, tid); lh -= 4; }
    while (lh + 1 >= 4) { dif_pass<4>(x, m, lh, tid); lh -= 4; }
    if (lh + 1 == 2) dif_pass<2>(x, m, 1, tid); else if (lh + 1 == 1) dif_pass<1>(x, m, 0, tid);
}
template <bool LH = false> __device__ __forceinline__ void fft_inv(LAS f32x2* x, int m, int tid) {
    int lh = 0;
    while (m - lh >= 4) { dit_pass<4>(x, m, lh, tid); lh += 4; }
    if (m - lh == 2) dit_pass<2, LH>(x, m, lh, tid); else if (m - lh == 1) dit_pass<1, LH>(x, m, lh, tid);
}
__device__ __forceinline__ int brev(int k, int m) { return (int)(__brev((unsigned)k) >> (32 - m)); }

__device__ __forceinline__ void filt_unit(const Ctx& F, const ArgsV& AV, int l, int unit) {
    const int kind = unit >> 9, o = (unit >> 8) & 1, pair = unit & 255;
    const int n = kind ? LC : SEQ, m = kind ? 9 : 14, N = 2 * n, tid = F.tid;
    LAS f32x2* buf = (LAS f32x2*)F.lds;
    LAS float* W3 = (LAS float*)(F.lds + HY_SCR_OFF);
    LAS float* B3 = W3 + 256;
    LAS float* RED = B3 + 4;
    LAS float* INV = RED + 16;
    __syncthreads();
    if (tid < 4) { const int ci = tid; const int col = o * 1024 + (ci >> 1) * 512 + 2 * pair + (ci & 1); B3[ci] = AV.in(I_HYB3)[(size_t)l * 2048 + col]; }
    __syncthreads();
    const int lane = F.lane, q = lane >> 4, c = lane & 15;
    f16x8 wB0, wB1;
    { const int col = o * 1024 + ((c & 3) >> 1) * 512 + 2 * pair + (c & 1); const float* w3 = AV.in(I_HYW3) + (size_t)l * 64 * 2048 + col;
#pragma unroll
      for (int j = 0; j < 8; ++j) { wB0[j] = c < 4 ? (f16)w3[(size_t)(8 * q + j) * 2048] : (f16)0.f; wB1[j] = c < 4 ? (f16)w3[(size_t)(32 + 8 * q + j) * 2048] : (f16)0.f; } }
    const f16* H2H = (const f16*)(F.ws + WS_H2H) + ((size_t)l * (SEQ + LC) + (kind ? SEQ : 0)) * 64;
    const float lo = -3.0701134573253945f, hi = -15.350567286626973f;
    const float ra = fabsf(lo + (hi - lo) * (float)(2 * pair) / 511.0f), rb = fabsf(lo + (hi - lo) * (float)(2 * pair + 1) / 511.0f);
    const float rate = (c & 1) ? rb : ra, bias3 = B3[c & 3];
    float sabs = 0.f;
    const float rsc = -rate / (float)(n - 1);
    float elane[4];
#pragma unroll
    for (int i = 0; i < 4; ++i) elane[i] = __expf(rsc * (float)(4 * q + i));
    const int ntile = n >> 4;
    for (int base = F.wave; base < ntile; base += 64) {
        f16x8 a0[8], a1[8];
#pragma unroll
        for (int b8 = 0; b8 < 8; ++b8) { const int tile = base + 8 * b8, tl = tile < ntile ? tile : base; const f16* hp = H2H + (size_t)(tl * 16 + c) * 64 + 8 * q;
            a0[b8] = *(const f16x8*)hp; a1[b8] = *(const f16x8*)(hp + 32); }
        PIN8(a0[0], a0[1], a0[2], a0[3], a0[4], a0[5], a0[6], a0[7]); PIN8(a1[0], a1[1], a1[2], a1[3], a1[4], a1[5], a1[6], a1[7]);
#pragma unroll
        for (int b8 = 0; b8 < 8; ++b8) { const int tile = base + 8 * b8; if (tile < ntile) { const int t0 = tile * 16;
            f32x4 acc = (f32x4){0.f, 0.f, 0.f, 0.f};
            acc = __builtin_amdgcn_mfma_f32_16x16x32_f16(a0[b8], wB0, acc, 0, 0, 0); acc = __builtin_amdgcn_mfma_f32_16x16x32_f16(a1[b8], wB1, acc, 0, 0, 0);
            if (c < 4) {
                const float et = __expf(rsc * (float)t0);
#pragma unroll
                for (int i = 0; i < 4; ++i) { const int t = t0 + 4 * q + i; const float v = (acc[i] + bias3) * (et * elane[i]);
                    LAS float* bp = (LAS float*)buf;
                    if (c < 2) { bp[2 * PADI(t) + c] = v; sabs += fabsf(v); }
                    else if (t >= 1) { bp[2 * PADI(N - t) + (c - 2)] = v; sabs += fabsf(v); } } } } }
    }
    float sa = (c == 0 || c == 2) ? sabs : 0.f, sb = (c == 1 || c == 3) ? sabs : 0.f;
    if (tid == 0) { float z0 = 0.f; asm volatile("" : "+v"(z0)); buf[PADI(n)] = (f32x2){z0, z0}; }
    sa = wave_sum(sa); sb = wave_sum(sb);
    if (F.lane == 0) { RED[F.wave * 2] = sa; RED[F.wave * 2 + 1] = sb; }
    __syncthreads();
    if (tid < 2) { float s = 0.f;
#pragma unroll
        for (int w = 0; w < 8; ++w) s += RED[w * 2 + tid];
        INV[tid] = 1.0f / (s + EPS); }
    __syncthreads();
    { const float ia = INV[0], ib = INV[1];
      for (int i = tid; i < N; i += 512) { f32x2 v = buf[PADI(i)]; v.x *= ia; v.y *= ib; buf[PADI(i)] = v; } }
    __syncthreads();
    fft_fwd(buf, m, tid);
    f32x4* out = (f32x4*)(F.ws + ((l & 1) ? WS_FSD2 : WS_FSD) + (kind ? FSD_C_OFF : 0)) + (size_t)(o * 256 + pair) * (n + 1);
    for (int u = tid; u <= n; u += 512) { const int p = u < n ? 2 * u : 1, k = brev(p, m), pn = brev((N - k) & (N - 1), m);
        const f32x2 zk = buf[PADI(p)], zn = cconj(buf[PADI(pn)]);
        const f32x2 fa = (zk + zn) * 0.5f, df = zk - zn, fb = (f32x2){df.y * 0.5f, -df.x * 0.5f};
        const f32x2 fs = (fa + fb) * 0.5f, fd = (fa - fb) * 0.5f;
        out[u] = (f32x4){fs.x, fs.y, fd.x, fd.y}; }
    __syncthreads();
}

__device__ __forceinline__ void main_unit(const Ctx& F, const ArgsV& AV, int l, int unit) {
    const int kind = unit >> 9, b = (unit >> 8) & 1, pair = unit & 255;
    const int n = kind ? LC : SEQ, m = kind ? 9 : 14, N = 2 * n, tid = F.tid;
    const int row0 = kind ? MX + b * LC : b * SEQ;
    LAS f32x2* buf = (LAS f32x2*)F.lds;
    const f16* ZT = (const f16*)(F.ws + WS_ZT) + (size_t)(2 * pair) * MT + row0;
    const float* cw = AV.in(I_HYCW) + (size_t)l * 3 * 1536 + 2 * pair; const float* cb = AV.in(I_HYCB) + (size_t)l * 1536 + 2 * pair;
    f32x2 yv[16], g1[16], g2[16];
#pragma unroll
    for (int g = 0; g < 3; ++g)
#pragma unroll
        for (int cc = 0; cc < 2; ++cc) { const float w0 = cw[g * 512 + cc], w1 = cw[1536 + g * 512 + cc], w2 = cw[3072 + g * 512 + cc], bs = cb[g * 512 + cc];
            const f16* zt = ZT + (size_t)(g * 512 + cc) * MT;
#pragma unroll
            for (int gi = 0; gi < 2; ++gi) { const int t0 = 8 * (tid + 512 * gi);
                f16x8 mv; float pv = 0.f, nv = 0.f;
#pragma unroll
                for (int e = 0; e < 8; ++e) mv[e] = (f16)0.f;
                if (t0 < n) { mv = *(const f16x8*)(zt + t0); if (t0 > 0) pv = (float)zt[t0 - 1]; if (t0 + 8 < n) nv = (float)zt[t0 + 8]; }
#pragma unroll
                for (int e = 0; e < 8; ++e) { const float zm = e == 0 ? pv : (float)mv[e == 0 ? 0 : e - 1], zc = (float)mv[e], zp = e == 7 ? nv : (float)mv[e == 7 ? 7 : e + 1];
                    const float r = w0 * zm + w1 * zc + w2 * zp + bs;
                    if (g == 0) { if (cc == 0) yv[gi * 8 + e].x = r; else yv[gi * 8 + e].y = r; }
                    else if (g == 1) { if (cc == 0) g1[gi * 8 + e].x = r; else g1[gi * 8 + e].y = r; }
                    else { if (cc == 0) g2[gi * 8 + e].x = r; else g2[gi * 8 + e].y = r; } } } }
    const float invN = 1.0f / (float)N;
#pragma unroll
    for (int o = 0; o < 2; ++o) {
        __syncthreads();
#pragma unroll
        for (int gi = 0; gi < 2; ++gi) { const int t0 = 8 * (tid + 512 * gi);
            if (t0 < n) {
#pragma unroll
                for (int e = 0; e < 8; ++e) buf[PADI(t0 + e)] = yv[gi * 8 + e]; } }
        __syncthreads();
        fft_fwd<true>(buf, m, tid);
        const f32x4* fsd = (const f32x4*)(F.ws + ((l & 1) ? WS_FSD2 : WS_FSD) + (kind ? FSD_C_OFF : 0)) + (size_t)(o * 256 + pair) * (n + 1);
        for (int u0 = tid; u0 <= n; u0 += 2048) {
            f32x4 f4[4];
#pragma unroll
            for (int jj = 0; jj < 4; ++jj) { const int u = u0 + 512 * jj; f4[jj] = fsd[u <= n ? u : n]; }
            PIN4(f4[0], f4[1], f4[2], f4[3]);
#pragma unroll
            for (int jj = 0; jj < 4; ++jj) { const int u = u0 + 512 * jj; if (u <= n) {
                const int p = u < n ? 2 * u : 1, k = brev(p, m), pn = brev((N - k) & (N - 1), m);
                const f32x2 zk = buf[PADI(p)], zn = buf[PADI(pn)]; const f32x4 f = f4[jj]; const f32x2 fs = (f32x2){f[0], f[1]}, fd = (f32x2){f[2], f[3]};
                const f32x2 wk = cmul(zk, fs) + cmul(cconj(zn), fd), wn = cmul(zn, cconj(fs)) + cmul(cconj(zk), cconj(fd));
                buf[PADI(pn)] = wn; buf[PADI(p)] = wk; } } }
        __syncthreads();
        fft_inv<true>(buf, m, tid);
        const float* hb = AV.in(I_HYBIAS) + ((size_t)l * 2 + o) * 512 + 2 * pair; const f32x2 bias = (f32x2){hb[0], hb[1]};
#pragma unroll
        for (int gi = 0; gi < 2; ++gi) { const int t0 = 8 * (tid + 512 * gi);
            if (t0 < n) {
#pragma unroll
                for (int e = 0; e < 8; ++e) { const f32x2 cv = buf[PADI(t0 + e)] * invN; const f32x2 gt = o == 0 ? g1[gi * 8 + e] : g2[gi * 8 + e];
                    yv[gi * 8 + e] = gt * (cv + yv[gi * 8 + e] * bias); } } }
    }
    f16* Y = (f16*)(F.ws + WS_YBT) + (size_t)(2 * pair) * MT + row0;
#pragma unroll
    for (int gi = 0; gi < 2; ++gi) { const int t0 = 8 * (tid + 512 * gi);
        if (t0 < n) { f16x8 oa, ob;
#pragma unroll
            for (int e = 0; e < 8; ++e) { oa[e] = (f16)yv[gi * 8 + e].x; ob[e] = (f16)yv[gi * 8 + e].y; }
            oa = pg8::lowtog8(oa); ob = pg8::lowtog8(ob);
            *(f16x8*)(Y + t0) = oa; *(f16x8*)(Y + MT + t0) = ob; } }
    __syncthreads();
}

__device__ __forceinline__ void ph_ybt_transpose(const Ctx& F) {
    LAS f16* T = (LAS f16*)F.lds;
    const f16* YBT = (const f16*)(F.ws + WS_YBT); f16* Y = (f16*)(F.ws + WS_YCAT);
    const bool bal = (F.G == 256);
    for (int it = 0; it < (bal ? 2 : (MT / 64 + F.G - 1) / F.G); ++it) {
        int rb;
        if (bal) { if (F.bid >= 132) rb = (F.bid - 132) + 124 * it; else if (F.bid < 16 && it == 0) rb = 248 + F.bid; else rb = -1; }
        else rb = F.bid + it * F.G;
        if (rb < 0 || rb >= MT / 64) continue;
        const int r0 = rb * 64;
        __syncthreads();
        { f16x8 tv[8];
#pragma unroll
          for (int i = 0; i < 8; ++i) tv[i] = *(const f16x8*)(YBT + (size_t)F.tid * MT + r0 + 8 * i);
          PIN8(tv[0], tv[1], tv[2], tv[3], tv[4], tv[5], tv[6], tv[7]);
#pragma unroll
          for (int i = 0; i < 8; ++i) *(LAS f16x8*)(T + F.tid * 72 + 8 * i) = tv[i]; }
        __syncthreads();
        const int row = F.tid >> 3, cg = F.tid & 7;
#pragma unroll
        for (int jj = 0; jj < 8; ++jj) { const int gidx = cg + 8 * jj; f16x8 o;
#pragma unroll
            for (int e = 0; e < 8; ++e) o[e] = T[(8 * gidx + e) * 72 + row];
            *(f16x8*)(Y + (size_t)(r0 + row) * 2048 + 512 + 8 * gidx) = o; }
    }
    __syncthreads();
}
#undef PADI
}

#ifndef PHMASK
#define PHMASK 0xFFFF
#endif
#define PH_EN(k) (((PHMASK) >> (k)) & 1)
#ifndef STAMP_MASK
#define STAMP_MASK 0
#endif
#ifndef STAMP_BID
#define STAMP_BID 0
#endif
#ifndef STAMP_K
#define STAMP_K 1
#endif
#ifndef SUBMASK
#define SUBMASK 7
#endif
#define SUB_EN(k) (((SUBMASK) >> (k)) & 1)
constexpr int NPH = 2 + 12 * DEPTH;
constexpr int CW_Q = 8192;
__device__ __forceinline__ int q_pull(unsigned* ctr, volatile LAS int* slot) {
    __syncthreads();
    if (threadIdx.x == 0) *slot = (int)__hip_atomic_fetch_add(ctr, 1u, __ATOMIC_RELAXED, __HIP_MEMORY_SCOPE_AGENT);
    __syncthreads();
    return *slot;
}

__global__ void __launch_bounds__(512, 2) mk_fwd(Args args) {
    extern __shared__ __attribute__((aligned(16))) unsigned char lds_raw[];
    Ctx F; F.lds = (LAS unsigned char*)lds_raw; F.tid = threadIdx.x; F.lane = F.tid & 63; F.wave = __builtin_amdgcn_readfirstlane(F.tid >> 6);
    F.G = gridDim.x; F.bid = blockIdx.x; F.ws = args.ws;
    ArgsV AV; AV.out = args.out;
    const Ctx F0 = F;
#define FRESH() do { F.tid = opq(F0.tid); F.lane = F.tid & 63; F.wave = __builtin_amdgcn_readfirstlane(F.tid >> 6); } while (0)
    volatile LAS unsigned* MISC = (volatile LAS unsigned*)(F.lds + LDSCTL_OFF);
    if (F.tid < 64) MISC[F.tid] = 0u;
    __syncthreads();
    unsigned* barw = (unsigned*)(F.ws + WS_CTL) + CW_BAR;
    XcdBarrier bar; bar.bar = barw; bar.x = 0; bar.st = nullptr;
    const int lo = args.ph_lo, hi = args.ph_hi;
    if (hi - lo > 1) bar = xcd_barrier_post(barw, MISC + 8);
#define IN(k) (lo <= (k) && (k) < hi)
#define SEAM(k) do { if (IN(k) && IN((k) + 1)) xcd_barrier(bar); } while (0)
#if STAMP_MASK
    volatile LAS unsigned long long* TS = (volatile LAS unsigned long long*)(F.lds + LDSCTL_OFF + 128);
#define TSTART(k) do { if ((((STAMP_MASK) >> (k)) & 1) && blockIdx.x == STAMP_BID && threadIdx.x == 0) TS[0] = __builtin_amdgcn_s_memrealtime(); } while (0)
#define TSTOP(k) do { if ((((STAMP_MASK) >> (k)) & 1) && blockIdx.x == STAMP_BID && threadIdx.x == 0) TS[1] = TS[1] + (__builtin_amdgcn_s_memrealtime() - TS[0]); } while (0)
#else
#define TSTART(k) do {} while (0)
#define TSTOP(k) do {} while (0)
#endif
    unsigned char* ws = F.ws;
    const int rank160 = (F.bid + F.G - 160 % F.G) % F.G;

    TSTART(12);
    if (PH_EN(12) && IN(0)) { TSTART(25); FRESH(); ph_prologue(F, AV); TSTOP(25); TSTART(26); for (int l2 = 0; l2 < DEPTH; ++l2) { FRESH(); ph_hyena_h2(F, AV, l2); } TSTOP(26); }
    SEAM(0);
    TSTOP(12);

    for (int l = 0; l < DEPTH; ++l) {
        const int pb = 1 + 12 * l;
        const float* modl = (const float*)(ws + WS_MOD) + (size_t)l * 3 * 12288;
        const bool ctx_on = l < DEPTH - 1;
        const int nMr = ctx_on ? MT / 256 : MX / 256, nrows = ctx_on ? MT : MX;
        TSTART(0);
        if (PH_EN(0) && IN(pb + 0)) {
            TSTART(22); FRESH(); ph_convert_weights(F, AV, l);
            __syncthreads(); TSTOP(22);
            TSTART(24); FRESH(); if (F.bid < 32) s5_mats_group(F, AV, l, F.bid); TSTOP(24);
            TSTART(23); FRESH(); if (F.G > 64) { if (F.bid >= 32) { Ctx Fn = F; Fn.bid = F.bid - 32; Fn.G = F.G - 32; ph_norm(Fn, AV, l, 0, MT, l > 0 ? 11 : 0); } }
            else ph_norm(F, AV, l, 0, MT, l > 0 ? 11 : 0); TSTOP(23);
        }
        SEAM(pb + 0);
        TSTOP(0);
        TSTART(1);
        if (PH_EN(1) && IN(pb + 1)) {
            pg8::SchedPx S; S.init(MT / 256, WINN / 256, F.G, F.bid); S.A = (const char*)(ws + WS_HN); S.B = (const char*)(ws + WS_WIN); S.tile = (size_t)256 * 2048 * 2;
            pg8::EpiPx E{(f16*)(ws + WS_PX), (f16*)(ws + WS_S5A), (f16*)(ws + WS_ZT), (f16*)(ws + WS_GTL)};
            pg8::gemm_phase(F.lds, 2048, 2048, 32, S, E);
            if (F.G == 256) { unsigned* qc = (unsigned*)(ws + WS_CTL) + CW_Q + 2048 + l * 64; volatile LAS int* slot = (volatile LAS int*)(MISC + 16);
              for (;;) { if (F.bid < 160) break; const int u = q_pull(qc, slot); if (u >= 96) break; FRESH(); hy::filt_unit(F, AV, l, (l == 0 ? 416 : 384) + u); } }
        }
        SEAM(pb + 1);
        TSTOP(1);
        TSTART(2);
        if (PH_EN(2) && IN(pb + 2)) {
            TSTART(16);
            if (SUB_EN(0)) { pg8::SchedS5 S{(const char*)(ws + WS_S5A), (const char*)(ws + WS_S5M), (size_t)256 * 256 * 2, F.G, F.bid};
              pg8::EpiS5In E{(float*)(ws + WS_S5S)};
              pg8::gemm_phase(F.lds, 16384, 256, 4, S, E); }
            TSTOP(16);
            { unsigned* qc = (unsigned*)(ws + WS_CTL) + CW_Q + (l * 2 + 0) * 64; volatile LAS int* slot = (volatile LAS int*)(MISC + 16);
              const bool pre = (l > 0 && F.G == 256);
              const bool pre0 = (l == 0 && F.G == 256);
              const int fbase = pre ? 240 : 0, nb = pre ? 144 : (pre0 ? 416 : 512), ns = pre ? 0 : 512;
              for (;;) { const int u = q_pull(qc, slot); if (u >= nb + 528 + ns) break;
                  if (u >= nb && u < nb + 528) { const int hu = u - nb; TSTART(17); FRESH(); gla::gla_unit<false>(F, AV, l, hu >> 1, hu & 1, (hu & 1) + 1); TSTOP(17); }
                  else { TSTART(18); FRESH(); hy::filt_unit(F, AV, l, u < nb ? fbase + u : 512 + (u - nb - 528)); TSTOP(18); } } }
        }
        SEAM(pb + 2);
        TSTOP(2);
        TSTART(3);
        if (PH_EN(3) && IN(pb + 3)) { FRESH(); ph_s5_scan(F); FRESH(); gla::ph_gla_scan(F); }
        SEAM(pb + 3);
        TSTOP(3);
        TSTART(4);
        if (PH_EN(4) && IN(pb + 4)) {
            TSTART(19);
            if (SUB_EN(0)) { pg8::SchedS5 S{(const char*)(ws + WS_S5A), (const char*)(ws + WS_S5W), (size_t)256 * 512 * 2, F.G, F.bid, l == DEPTH - 1 ? 128 : 160};
              pg8::EpiS5Out E{(const f16*)(ws + WS_S5A), (f16*)(ws + WS_YAPRE), AV.in(I_S5D) + (size_t)l * 512};
              pg8::gemm_phase(F.lds, 16384, 512, 8, S, E); }
            TSTOP(19);
            { unsigned* qc = (unsigned*)(ws + WS_CTL) + CW_Q + (l * 2 + 1) * 64; volatile LAS int* slot = (volatile LAS int*)(MISC + 16);
              const bool lastl = (l == DEPTH - 1);
              for (;;) { const int u = q_pull(qc, slot); if (u >= 264 + (lastl ? 512 : 1024)) break;
                  if (u < 264) { if (lastl && (u % NSC) == NSC - 1) continue; TSTART(20); FRESH(); gla::gla_unit<true>(F, AV, l, u); TSTOP(20); } else { TSTART(21); FRESH(); hy::main_unit(F, AV, l, u - 264); TSTOP(21); } } }
        }
        SEAM(pb + 4);
        TSTOP(4);
        TSTART(5);
        if (PH_EN(5) && IN(pb + 5)) {
            pg8::SchedPlain S; S.init(nMr, 2, F.G, F.bid); S.A = (const char*)(ws + WS_YAPRE); S.B = (const char*)(ws + WS_WGLU); S.aTile = (size_t)256 * 512 * 2; S.bTile = (size_t)256 * 512 * 2;
            pg8::EpiGlu E{(const f16*)(ws + WS_YAPRE), (f16*)(ws + WS_YCAT), AV.in(I_GLUB) + (size_t)l * 512};
            pg8::gemm_phase(F.lds, 512, 512, 8, S, E);
            FRESH(); hy::ph_ybt_transpose(F);
        }
        SEAM(pb + 5);
        TSTOP(5);
        TSTART(6);
        if (PH_EN(6) && IN(pb + 6)) {
            pg8::SchedPlain S; S.init(nMr, 8, F.G, F.bid); S.aTile = (size_t)256 * 2048 * 2; S.bTile = (size_t)256 * 2048 * 2;
            S.A = (const char*)(ws + WS_YCAT); S.B = (const char*)(ws + WS_WBR);
            pg8::EpiBranchF E{(const f16*)(ws + WS_GTL), (f16*)(ws + WS_MBUF)};
            pg8::gemm_phase(F.lds, 2048, 2048, 32, S, E);
            if (l + 1 < DEPTH && F.G == 256) { unsigned* qc = (unsigned*)(ws + WS_CTL) + CW_Q + 1024 + l * 64; volatile LAS int* slot = (volatile LAS int*)(MISC + 16);
              for (;;) { if (F.bid < 16) break; const int u = q_pull(qc, slot); if (u >= 240) break; FRESH(); hy::filt_unit(F, AV, l + 1, u); } }
#ifdef PG_DUMMY
            { pg8::EpiF16 E9{(f16*)(ws + WS_ACT), 2048}; pg8::gemm_phase(F.lds, 2048, 2048, 32, S, E9); }
#endif
        }
        SEAM(pb + 6);
        TSTOP(6);
        TSTART(7);
        if (PH_EN(7) && IN(pb + 7)) {
            pg8::SchedPlain S; S.init(MX / 256, 8, F.G, F.bid); S.A = (const char*)(ws + WS_MBUF); S.B = (const char*)(ws + WS_WOUT); S.aTile = (size_t)256 * 2048 * 2; S.bTile = (size_t)256 * 2048 * 2;
            pg8::EpiResid E{(float*)(ws + WS_XRES), modl, 4096, l == 0 ? AV.in(I_X) : (const float*)(ws + WS_XRES)};
            pg8::gemm_phase(F.lds, 2048, 2048, 32, S, E);
            if (ctx_on) { pg8::SchedSplit S2{(const char*)(ws + WS_MBUF), (const char*)(ws + WS_WOUT), (size_t)256 * 2048 * 2, (size_t)256 * 2048 * 2, (size_t)8 * 128, 4, F.G, F.bid};
                pg8::EpiSlab E2{(float*)(ws + WS_SLAB), modl, 4096};
                pg8::gemm_phase(F.lds, 2048, 2048, 8, S2, E2); }
            if (l + 2 < DEPTH && F.G == 256) { unsigned* qc = (unsigned*)(ws + WS_CTL) + CW_Q + 1024 + l * 64 + 32; volatile LAS int* slot = (volatile LAS int*)(MISC + 16);
              for (;;) { const int u = q_pull(qc, slot); if (u >= 512) break; FRESH(); hy::filt_unit(F, AV, l + 1, 512 + u); } }
        }
        SEAM(pb + 7);
        TSTOP(7);
        TSTART(8);
        if (PH_EN(8) && IN(pb + 8)) { FRESH(); ph_norm(F, AV, l, 1, nrows, 4); }
        SEAM(pb + 8);
        TSTOP(8);
        TSTART(9);
        if (PH_EN(9) && IN(pb + 9)) {
            pg8::SchedPlain S; S.init(nMr, UPLD / 256, F.G, F.bid); S.A = (const char*)(ws + WS_HN); S.B = (const char*)(ws + WS_WUP); S.aTile = (size_t)256 * 2048 * 2; S.bTile = (size_t)256 * 2048 * 2;
            pg8::EpiUpAct E{(f16*)(ws + WS_ACT), (float*)(ws + WS_HALO), AV.in(I_FFCW) + (size_t)l * 3 * FFH, AV.in(I_FFCB) + (size_t)l * FFH, (LAS float*)(F.lds + EXTRA_OFF)};
            pg8::gemm_phase(F.lds, 2048, 2048, 32, S, E);
            if (l + 1 < DEPTH && F.G == 256) { unsigned* qc = (unsigned*)(ws + WS_CTL) + CW_Q + 1024 + l * 64 + 16; volatile LAS int* slot = (volatile LAS int*)(MISC + 16);
              for (;;) { if (F.bid < 224) break; const int u = q_pull(qc, slot); if (u >= 32) break; FRESH(); hy::filt_unit(F, AV, l + 1, 480 + u); } }
        }
        SEAM(pb + 9);
        TSTOP(9);
        TSTART(10);
        if (PH_EN(10) && IN(pb + 10)) { FRESH(); ph_ffn_fix(F, AV, l, nMr); }
        SEAM(pb + 10);
        TSTOP(10);
        TSTART(11);
        if (PH_EN(11) && IN(pb + 11)) {
            pg8::SchedPlain S; S.init(MX / 256, 8, F.G, F.bid); S.A = (const char*)(ws + WS_ACT); S.B = (const char*)(ws + WS_WDN); S.aTile = (size_t)256 * FFH * 2; S.bTile = (size_t)256 * FFH * 2;
            pg8::EpiResid E{(float*)(ws + WS_XRES), modl, 10240, (const float*)(ws + WS_XRES)};
            pg8::gemm_phase(F.lds, FFH, FFH, FFH / 64, S, E);
            if (ctx_on) { pg8::SchedSplit S2{(const char*)(ws + WS_ACT), (const char*)(ws + WS_WDN), (size_t)256 * FFH * 2, (size_t)256 * FFH * 2, (size_t)8 * 128, 11, F.G, F.bid};
                pg8::EpiSlab E2{(float*)(ws + WS_SLAB), modl, 10240};
                pg8::gemm_phase(F.lds, FFH, FFH, 8, S2, E2); }
        }
        SEAM(pb + 11);
        TSTOP(11);
    }
    if (PH_EN(13) && IN(NPH - 1)) { FRESH(); ph_final_norm(F, AV); }
#if STAMP_MASK
    if (blockIdx.x == STAMP_BID && threadIdx.x == 0) { const unsigned long long t0 = __builtin_amdgcn_s_memrealtime(); while (__builtin_amdgcn_s_memrealtime() - t0 < (unsigned long long)(STAMP_K) * TS[1]) __builtin_amdgcn_s_sleep(8); }
#endif
#undef IN
#undef SEAM
#undef FRESH
}

extern "C" void kernel_launch(void* const* d_in, const int* in_sizes, int n_in, void* d_out, int out_size, void* d_ws, size_t ws_size, hipStream_t stream) {
    static int grid = 0;
    if (grid == 0) {
        if (n_in != 40 || out_size != MX * D || ws_size < WS_END) { fprintf(stderr, "kernel_launch: unexpected problem (n_in %d out %d ws %zu, need %zu)\n", n_in, out_size, ws_size, (size_t)WS_END); grid = -1; return; }
        int dev = 0, cus = 0, per_cu = 0;
        if (hipGetDevice(&dev) != hipSuccess || hipDeviceGetAttribute(&cus, hipDeviceAttributeMultiprocessorCount, dev) != hipSuccess) { grid = -1; return; }
        if (hipFuncSetAttribute((const void*)mk_fwd, hipFuncAttributeMaxDynamicSharedMemorySize, LDS_BYTES) != hipSuccess) { fprintf(stderr, "kernel_launch: hipFuncSetAttribute failed\n"); grid = -1; return; }
        if (hipOccupancyMaxActiveBlocksPerMultiprocessor(&per_cu, (const void*)mk_fwd, 512, LDS_BYTES) != hipSuccess || per_cu < 1)
            fprintf(stderr, "kernel_launch: occupancy query reports %d\n", per_cu);
        (void)hipGetLastError();
        grid = cus;
    }
    if (grid < 0) return;
    if (hipMemsetAsync((char*)d_ws + WS_CTL, 0, CTL_ZERO_BYTES, stream) != hipSuccess) return;
    Args a{};
    for (int i = 0; i < 40; ++i) a.in[i] = (const float*)d_in[i];
    a.out = (float*)d_out; a.ws = (unsigned char*)d_ws;
#if MK_ONE
    a.ph_lo = 0; a.ph_hi = NPH;
    hipLaunchKernelGGL(mk_fwd, dim3(grid), dim3(512), LDS_BYTES, stream, a);
#else
    for (int p = 0; p < NPH; ++p) { a.ph_lo = p; a.ph_hi = p + 1; hipLaunchKernelGGL(mk_fwd, dim3(grid), dim3(512), LDS_BYTES, stream, a); }
#endif
}
```
